# Optimizing an MI355X kernel written in HIP

```python
import math
import jax, jax.numpy as jnp
from jax import lax
import numpy as np

D_MODEL = 1024
BATCH = 32
SEQ = 2048
DEPTH = 2

GRID_W = 64
CTX_LEN = 256
N_EVEN = (DEPTH + 1) // 2
N_ODD = DEPTH // 2
RMS_EPS = 1e-6
N_MOD = 6

A_HEADS = 4
A_DQK = 64
A_DV = 128
Q_BLOCK = 128
ROPE_BASE = 10000.0
ROPE_AXIS_PAIRS = A_DQK // 4

B_HEADS = 4
B_DH = 128
B_WIDTH = B_HEADS * B_DH
CHUNK = 64
SHORT_CONV = 3

A_QW = A_HEADS * 2 * A_DQK
A_VW = A_HEADS * A_DV
GATE_W = 4 * B_HEADS
Q_SIDE = A_QW + 2 * B_WIDTH
KV_SIDE = A_QW + A_VW + 2 * B_WIDTH + GATE_W
P_AB = Q_SIDE + KV_SIDE
MIX_W = A_VW + B_WIDTH

HY_ORDER = 2
POS_EMB_DIM = 33
FILTER_HIDDEN = 64
FILTER_SIN_W = 1.0
DECAY_FAST_PCT = 0.3
DECAY_SLOW_PCT = 1.5
DECAY_TARGET = 1e-2

N_EXPERTS = 64
TOP_K = 8
N_GROUPS = 8
TOPK_GROUPS = 4
D_EXPERT = 256
D_SHARED = 256
ROUTED_SCALE = 2.5

kernel_name = 'hybrid_diffattn_mlstm_hyena_moe_dit'

f32 = jnp.float32


def _rms(x, g):
    xf = x.astype(f32)
    y = xf * lax.rsqrt(jnp.mean(xf * xf, axis=-1, keepdims=True) + RMS_EPS)
    return (y * g.astype(f32)).astype(x.dtype)


def _rms_heads(o, n_heads, g):
    B, L, W = o.shape
    of = o.astype(f32).reshape(B, L, n_heads, W // n_heads)
    of = of * lax.rsqrt(jnp.mean(of * of, axis=-1, keepdims=True) + RMS_EPS)
    return (of.reshape(B, L, W) * g.astype(f32)).astype(o.dtype)


def _modulate(h, shift, scale):
    return h * (1 + scale[:, None, :]) + shift[:, None, :]


def _split(t, widths):
    idx, acc = [], 0
    for w in widths[:-1]:
        acc += w
        idx.append(acc)
    return jnp.split(t, idx, axis=-1)


def _dwconv_centred(x, w, b):
    K = w.shape[0]
    L = x.shape[1]
    xp = jnp.pad(x, ((0, 0), (K // 2, K // 2), (0, 0)))
    return sum(xp[:, j:j + L] * w[j] for j in range(K)) + b


def _axial_rope(L):
    rows = L // GRID_W
    row = jnp.repeat(jnp.arange(rows), GRID_W)
    col = jnp.tile(jnp.arange(GRID_W), rows)
    inv = ROPE_BASE ** (-jnp.arange(ROPE_AXIS_PAIRS, dtype=f32) / ROPE_AXIS_PAIRS)
    ang = jnp.stack([row, col], axis=-1).astype(f32)[..., None] * inv
    ang = jnp.broadcast_to(ang[:, :, None, :], (L, 2, 2, ROPE_AXIS_PAIRS)).reshape(L, A_DQK)
    return jnp.cos(ang), jnp.sin(ang)


def _rope_2d(x, cos, sin):
    xa = x.reshape(*x.shape[:-1], 2, 2, ROPE_AXIS_PAIRS)
    rot = jnp.concatenate([-xa[..., 1:, :], xa[..., :1, :]], axis=-2).reshape(x.shape)
    c = cos[None, :, None, None, :].astype(x.dtype)
    s = sin[None, :, None, None, :].astype(x.dtype)
    return x * c + rot * s


def _diff_attention(q, k, v, lam):
    B, S, H = q.shape[:3]
    nb = S // Q_BLOCK
    qb = jnp.moveaxis(q.reshape(B, nb, Q_BLOCK, H, 2, A_DQK), 1, 0)

    def one_block(qi):
        s = jnp.einsum('bqhcd,bkhcd->bhcqk', qi, k).astype(f32) * (A_DQK ** -0.5)
        p = jax.nn.softmax(s, axis=-1)
        a = (p[:, :, 0] - lam * p[:, :, 1]).astype(v.dtype)
        return jnp.einsum('bhqk,bkhd->bqhd', a, v)

    o = lax.map(one_block, qb)
    return jnp.moveaxis(o, 0, 1).reshape(B, S, H * A_DV)


def _to_heads(t, n_heads):
    B, L, W = t.shape
    return t.astype(f32).reshape(B, L, n_heads, W // n_heads).transpose(0, 2, 1, 3)


def _gate_logs(g):
    B, L, _ = g.shape
    g = g.astype(f32).reshape(B, L, 2, 2, B_HEADS).transpose(0, 2, 3, 4, 1)
    return g[:, :, 0], jax.nn.log_sigmoid(g[:, :, 1])


def _mlstm_absorb(state, k, v, li, lf):
    C, n, m = state
    b = jnp.cumsum(lf, axis=-1)
    bL = b[..., -1]
    g = bL[..., None] - b + li
    m_new = jnp.maximum(bL + m, jnp.max(g, axis=-1))
    w = jnp.exp(g - m_new[..., None])
    decay = jnp.exp(bL + m - m_new)
    C = decay[..., None, None] * C + jnp.einsum('bhsd,bhse->bhde', k * w[..., None], v)
    n = decay[..., None] * n + jnp.einsum('bhs,bhsd->bhd', w, k)
    return (C, n, m_new)


def _mlstm_chunkwise(q, k, v, li, lf, state):
    B, H, L, dk = q.shape
    nc = L // CHUNK

    def chunks(a):
        return jnp.moveaxis(a.reshape(B, H, nc, CHUNK, *a.shape[3:]), 2, 0)

    causal = jnp.tril(jnp.ones((CHUNK, CHUNK), dtype=bool))

    def step(carry, inp):
        C, n, m = carry
        qc, kc, vc, ic, fc = inp
        b = jnp.cumsum(fc, axis=-1)
        d = jnp.where(causal, b[..., :, None] - b[..., None, :] + ic[..., None, :], -jnp.inf)
        inter = b + m[..., None]
        m_t = jnp.maximum(inter, jnp.max(d, axis=-1))
        s = jnp.einsum('bhtd,bhsd->bhts', qc, kc) * jnp.exp(d - m_t[..., None])
        sc = jnp.exp(inter - m_t)
        num = sc[..., None] * jnp.einsum('bhtd,bhde->bhte', qc, C) + jnp.einsum('bhts,bhse->bhte', s, vc)
        den = sc * jnp.einsum('bhtd,bhd->bht', qc, n) + jnp.sum(s, axis=-1)
        h = num / jnp.maximum(jnp.abs(den), jnp.exp(-m_t))[..., None]
        return _mlstm_absorb((C, n, m), kc, vc, ic, fc), h

    _, h = lax.scan(step, state, (chunks(q), chunks(k), chunks(v), chunks(li), chunks(lf)))
    return jnp.moveaxis(h, 0, 2).reshape(B, H, L, v.shape[-1])


def _flip(a, rev):
    return jnp.flip(a, axis=2) if rev else a


def _mlstm_bidirectional(q, k, v, gts, ck, cv, cgts):
    B, S, _ = q.shape
    q = _to_heads(q, B_HEADS) * (B_DH ** -0.5)
    k, v = _to_heads(k, B_HEADS), _to_heads(v, B_HEADS)
    ck, cv = _to_heads(ck, B_HEADS), _to_heads(cv, B_HEADS)
    li, lf = _gate_logs(gts)
    cli, clf = _gate_logs(cgts)
    zero = (jnp.zeros((B, B_HEADS, B_DH, B_DH), f32), jnp.zeros((B, B_HEADS, B_DH), f32),
            jnp.zeros((B, B_HEADS), f32))
    out = 0.0
    for d in range(2):
        rev = d == 1
        st = _mlstm_absorb(zero, _flip(ck, rev), _flip(cv, rev), _flip(cli[:, d], rev), _flip(clf[:, d], rev))
        hd = _mlstm_chunkwise(_flip(q, rev), _flip(k, rev), _flip(v, rev),
                              _flip(li[:, d], rev), _flip(lf[:, d], rev), st)
        out = out + _flip(hd, rev)
    return out.transpose(0, 2, 1, 3).reshape(B, S, B_WIDTH)


def _ab_mixer(h, hc, w_in, conv_w, conv_b, gate_b, lam_vecs, g_a, g_b, w_out, lam_init):
    B, S, _ = h.shape
    Lc = hc.shape[1]
    a_q, b_q, b_o, a_k, a_v, b_k, b_v, b_g = _split(
        h @ w_in, (A_QW, B_WIDTH, B_WIDTH, A_QW, A_VW, B_WIDTH, B_WIDTH, GATE_W))
    ca_k, ca_v, cb_k, cb_v, cb_g = _split(hc @ w_in[:, Q_SIDE:], (A_QW, A_VW, B_WIDTH, B_WIDTH, GATE_W))

    cos, sin = _axial_rope(S)
    q = _rope_2d(a_q.reshape(B, S, A_HEADS, 2, A_DQK), cos, sin)
    k_lat = _rope_2d(a_k.reshape(B, S, A_HEADS, 2, A_DQK), cos, sin)
    keys = jnp.concatenate([ca_k.reshape(B, Lc, A_HEADS, 2, A_DQK), k_lat], axis=1)
    vals = jnp.concatenate([ca_v.reshape(B, Lc, A_HEADS, A_DV), a_v.reshape(B, S, A_HEADS, A_DV)], axis=1)
    lv = lam_vecs.astype(f32)
    lam = jnp.exp(jnp.sum(lv[0] * lv[1])) - jnp.exp(jnp.sum(lv[2] * lv[3])) + lam_init
    out_a = _rms_heads(_diff_attention(q, keys, vals, lam), A_HEADS, g_a) * (1.0 - lam_init)

    qk = jax.nn.silu(_dwconv_centred(jnp.concatenate([b_q, b_k], axis=-1), conv_w, conv_b))
    mq, mk = jnp.split(qk, 2, axis=-1)
    cmk = jax.nn.silu(_dwconv_centred(cb_k, conv_w[:, B_WIDTH:], conv_b[B_WIDTH:]))
    hb = _mlstm_bidirectional(mq, mk, b_v, b_g + gate_b, cmk, cb_v, cb_g + gate_b)
    out_b = _rms_heads(hb.astype(h.dtype), B_HEADS, g_b) * jax.nn.sigmoid(b_o)

    return jnp.concatenate([out_a, out_b], axis=-1) @ w_out


def _hyena_filters(L, fw1, fb1, fw2, fb2, fw3):
    j = jnp.arange(L, dtype=f32)
    bands = (POS_EMB_DIM - 1) // 2
    freqs = jnp.linspace(1e-4, bands - 1, bands, dtype=f32)
    ang = (2.0 * math.pi / L) * j[:, None] * freqs[None, :]
    z = jnp.concatenate([(j / (L - 1))[:, None], jnp.cos(ang), -jnp.sin(ang)], axis=-1)
    hid = jnp.sin(FILTER_SIN_W * (z @ fw1.astype(f32) + fb1.astype(f32)))
    hid = jnp.sin(FILTER_SIN_W * (hid @ fw2.astype(f32) + fb2.astype(f32)))
    filt = (hid @ fw3.astype(f32)).reshape(L, HY_ORDER, D_MODEL)
    dist = jnp.abs(j - L // 2) / (L // 2)
    max_decay = math.log(DECAY_TARGET) / DECAY_FAST_PCT
    min_decay = math.log(DECAY_TARGET) / DECAY_SLOW_PCT
    deltas = jnp.abs(jnp.linspace(min_decay, max_decay, D_MODEL, dtype=f32))
    window = jnp.exp(-dist[:, None] * deltas[None, :])
    return filt * window[:, None, :]


def _fft_conv_centred(u, filt):
    L = u.shape[1]
    n = 2 * L
    U = jnp.fft.rfft(u.astype(f32), n=n, axis=1)
    K = jnp.fft.rfft(filt.astype(f32), n=n, axis=0)
    y = jnp.fft.irfft(U * K[None], n=n, axis=1)[:, L // 2:L // 2 + L]
    return y.astype(u.dtype)


def _hyena_mixer(h, w_in, conv_w, conv_b, fw1, fb1, fw2, fb2, fw3, fbias, w_out):
    L = h.shape[1]
    u = _dwconv_centred(h @ w_in, conv_w, conv_b)
    v, x1, x2 = jnp.split(u, 3, axis=-1)
    filt = _hyena_filters(L, fw1, fb1, fw2, fb2, fw3)
    z = x1 * (_fft_conv_centred(v, filt[:, 0]) + v * fbias[0])
    y = x2 * (_fft_conv_centred(z, filt[:, 1]) + z * fbias[1])
    return y @ w_out


def _swiglu(t, w_gu, w_dn):
    gate, up = jnp.split(t @ w_gu, 2, axis=-1)
    return (jax.nn.silu(gate) * up) @ w_dn


def _moe(h, router_w, router_b, exp_gu, exp_down, sh_gu, sh_down):
    B, L, D = h.shape
    t = h.reshape(B * L, D)
    T = t.shape[0]
    scores = jax.nn.sigmoid((t @ router_w).astype(f32))
    biased = scores + router_b.astype(f32)
    grp = lax.top_k(biased.reshape(T, N_GROUPS, N_EXPERTS // N_GROUPS), 2)[0].sum(-1)
    _, gidx = lax.top_k(grp, TOPK_GROUPS)
    gmask = jax.nn.one_hot(gidx, N_GROUPS, dtype=f32).sum(-2) > 0
    emask = jnp.repeat(gmask, N_EXPERTS // N_GROUPS, axis=-1)
    _, eidx = lax.top_k(jnp.where(emask, biased, -jnp.inf), TOP_K)
    sel = jnp.take_along_axis(scores, eidx, axis=-1)
    wts = ROUTED_SCALE * sel / jnp.sum(sel, axis=-1, keepdims=True)
    gates = jnp.zeros((T, N_EXPERTS), f32).at[jnp.arange(T)[:, None], eidx].set(wts)

    def expert_step(acc, e):
        gu_e, dn_e, g_e = e
        return acc + g_e[:, None] * _swiglu(t, gu_e, dn_e), None

    routed, _ = lax.scan(expert_step, jnp.zeros_like(t), (exp_gu, exp_down, gates.T.astype(t.dtype)))
    return (_swiglu(t, sh_gu, sh_down) + routed).reshape(B, L, D)


def setup_inputs(seed: int = 0) -> dict:
    key = jax.random.key(seed)
    ks = iter(jax.random.split(key, 40))

    def nrm(shape, scale):
        return jax.random.normal(next(ks), shape, f32) * scale

    D = D_MODEL
    i_b = nrm((N_EVEN, 2, 1, B_HEADS), 0.1)
    f_b = jnp.linspace(3.0, 6.0, B_HEADS, dtype=f32)[None, None, None, :] + nrm((N_EVEN, 2, 1, B_HEADS), 0.1)
    return {
        'x': nrm((BATCH, SEQ, D), 1.0),
        'c': nrm((BATCH, D), 1.0),
        'ctx': nrm((BATCH, CTX_LEN, D), 1.0),
        'c_ctx': nrm((D,), 1.0),
        'w_mod': nrm((DEPTH, D, N_MOD * D), 0.5 * D ** -0.5),
        'b_mod': nrm((DEPTH, N_MOD * D), 0.02),
        'norm_g': 1.0 + nrm((DEPTH, 4, D), 0.05),
        'w_in_ab': nrm((N_EVEN, D, P_AB), D ** -0.5),
        'conv_ab_w': nrm((N_EVEN, SHORT_CONV, 2 * B_WIDTH), SHORT_CONV ** -0.5),
        'conv_ab_b': nrm((N_EVEN, 2 * B_WIDTH), 0.02),
        'gate_b_ab': jnp.concatenate([i_b, f_b], axis=2).reshape(N_EVEN, GATE_W),
        'diff_lambda': nrm((N_EVEN, 4, A_DQK), 0.1),
        'head_g_a': 1.0 + nrm((N_EVEN, A_VW), 0.05),
        'head_g_b': 1.0 + nrm((N_EVEN, B_WIDTH), 0.05),
        'w_out_ab': nrm((N_EVEN, MIX_W, D), MIX_W ** -0.5),
        'w_in_hy': nrm((N_ODD, D, 3 * D), D ** -0.5),
        'conv_hy_w': nrm((N_ODD, SHORT_CONV, 3 * D), SHORT_CONV ** -0.5),
        'conv_hy_b': nrm((N_ODD, 3 * D), 0.02),
        'filt_w1': nrm((N_ODD, POS_EMB_DIM, FILTER_HIDDEN), POS_EMB_DIM ** -0.5),
        'filt_b1': nrm((N_ODD, FILTER_HIDDEN), 0.1),
        'filt_w2': nrm((N_ODD, FILTER_HIDDEN, FILTER_HIDDEN), FILTER_HIDDEN ** -0.5),
        'filt_b2': nrm((N_ODD, FILTER_HIDDEN), 0.1),
        'filt_w3': nrm((N_ODD, FILTER_HIDDEN, HY_ORDER * D), 0.1 * FILTER_HIDDEN ** -0.5),
        'filt_bias': nrm((N_ODD, HY_ORDER, D), 0.1),
        'w_out_hy': nrm((N_ODD, D, D), D ** -0.5),
        'router_w': nrm((DEPTH, D, N_EXPERTS), D ** -0.5),
        'router_b': nrm((DEPTH, N_EXPERTS), 0.01),
        'exp_gu': nrm((DEPTH, N_EXPERTS, D, 2 * D_EXPERT), D ** -0.5),
        'exp_down': nrm((DEPTH, N_EXPERTS, D_EXPERT, D), D_EXPERT ** -0.5),
        'sh_gu': nrm((DEPTH, D, 2 * D_SHARED), D ** -0.5),
        'sh_down': nrm((DEPTH, D_SHARED, D), D_SHARED ** -0.5),
    }


def reference(x, c, ctx, c_ctx, w_mod, b_mod, norm_g, w_in_ab, conv_ab_w, conv_ab_b, gate_b_ab,
              diff_lambda, head_g_a, head_g_b, w_out_ab, w_in_hy, conv_hy_w, conv_hy_b,
              filt_w1, filt_b1, filt_w2, filt_b2, filt_w3, filt_bias, w_out_hy,
              router_w, router_b, exp_gu, exp_down, sh_gu, sh_down):
    silu_c = jax.nn.silu(c)
    silu_cc = jax.nn.silu(c_ctx)
    for l in range(DEPTH):
        mod = silu_c @ w_mod[l] + b_mod[l]
        sh_m, sc_m, g_m, sh_f, sc_f, g_f = jnp.split(mod, N_MOD, axis=-1)
        h = _modulate(_rms(x, norm_g[l, 0]), sh_m, sc_m)
        if l % 2 == 0:
            e = l // 2
            lam_init = 0.8 - 0.6 * math.exp(-0.3 * l)
            mod_c = silu_cc @ w_mod[l, :, :2 * D_MODEL] + b_mod[l, :2 * D_MODEL]
            shift_c, scale_c = jnp.split(mod_c, 2)
            hc = _rms(ctx, norm_g[l, 0]) * (1 + scale_c) + shift_c
            mix = _ab_mixer(h, hc, w_in_ab[e], conv_ab_w[e], conv_ab_b[e], gate_b_ab[e], diff_lambda[e],
                            head_g_a[e], head_g_b[e], w_out_ab[e], lam_init)
        else:
            o = l // 2
            mix = _hyena_mixer(h, w_in_hy[o], conv_hy_w[o], conv_hy_b[o], filt_w1[o], filt_b1[o],
                               filt_w2[o], filt_b2[o], filt_w3[o], filt_bias[o], w_out_hy[o])
        x = x + g_m[:, None, :] * _rms(mix, norm_g[l, 1])
        h = _modulate(_rms(x, norm_g[l, 2]), sh_f, sc_f)
        x = x + g_f[:, None, :] * _rms(_moe(h, router_w[l], router_b[l], exp_gu[l], exp_down[l],
                                            sh_gu[l], sh_down[l]), norm_g[l, 3])
    return x
```

```cpp
#include <hip/hip_runtime.h>
#include <cstdio>
#include <cstdint>
namespace pg8 {
#define PG8_LAS __attribute__((address_space(3)))
typedef unsigned short bf16_t;
typedef short bf16x8 __attribute__((ext_vector_type(8)));
typedef float f32x4 __attribute__((ext_vector_type(4)));
typedef unsigned u32x4 __attribute__((ext_vector_type(4)));
typedef unsigned u32x2 __attribute__((ext_vector_type(2)));
constexpr int BM = 256, BK = 64, HALF = 128, HTB = HALF * BK * 2  , STAGE_BYTES = 8 * HTB;

__host__ __device__ __forceinline__ int lds_byte(int r, int c) { const int st = (r >> 4) * 2 + (c >> 5), rr = r & 15, cc = c & 31, ob = rr * 64 + cc * 2; return st * 1024 + (ob ^ (((ob >> 9) & 1) << 5)); }
__host__ __device__ __forceinline__ void stage_rc(int b, int& R, int& C) { const int st = b / 1024, sb = b % 1024, swz = sb ^ (((sb >> 9) & 1) << 5); R = (st >> 1) * 16 + swz / 64; C = (st & 1) * 32 + (swz % 64) / 2; }
__host__ __device__ __forceinline__ int perm32(int rho) { const int n = rho >> 4, i = rho & 15; return 8 * (i >> 2) + 4 * n + (i & 3); }

struct Unit { int pm, pn; };
__device__ __forceinline__ unsigned cvt_pk_bf16(float lo, float hi) { unsigned r; asm volatile("v_cvt_pk_bf16_f32 %0, %1, %2" : "=v"(r) : "v"(lo), "v"(hi)); return r; }
struct Gemm { const bf16_t* A; const bf16_t* Bt; int K; unsigned lda_bytes; };
template <class Epi, class Sched>
__device__ __forceinline__ void gemm_phase(PG8_LAS unsigned char* lds, const Gemm g, const Sched& S, const Epi& E) {
    int tid_ = threadIdx.x; asm volatile("" : "+v"(tid_));
    const int tid = tid_, wid = __builtin_amdgcn_readfirstlane(tid >> 6), lane = tid & 63, wr = wid >> 2, wc = wid & 3, fr = lane & 15, fq = lane >> 4;
    const int K = g.K, nt = K / BK;
    unsigned voffB[2];
#pragma unroll
    for (int i = 0; i < 2; ++i) { int R, C; stage_rc(tid * 16 + i * 8192, R, C); const int Rb = Epi::PERM ? ((R & ~31) + perm32(R & 31)) : R;
        voffB[i] = (unsigned)(Rb * K + C) * 2u; }
    const size_t kstep = (size_t)(BK * 2);
    const size_t hstep = (size_t)HALF * K * 2;
    const size_t tstep = 2 * hstep;
    const unsigned ldsw = (unsigned)wid * 1024u;
    const int aoff = lds_byte(wr * 64 + fr, fq * 8), boff = lds_byte(wc * 32 + fr, fq * 8);
    const char* Ab = (const char*)g.A;
#define PG8_SA(b, h) (((b) * 2 + (h)) * HTB)
#define PG8_SB(b, h) ((4 + (b) * 2 + (h)) * HTB)
#define PG8_STAGE(bufoff, gbase, voff) do { _Pragma("unroll") for (int _i = 0; _i < 2; ++_i) \
        __builtin_amdgcn_global_load_lds((const unsigned*)((const char*)(gbase) + (voff)[_i]), (PG8_LAS unsigned*)(lds + (bufoff) + ldsw + _i * 8192), 16, 0, 0); } while (0)
#define PG8_STAGEA(bufoff, o0, o1, kb) do { \
        __builtin_amdgcn_global_load_lds((const unsigned*)(Ab + (size_t)(o0) + (size_t)(kb)), (PG8_LAS unsigned*)(lds + (bufoff) + ldsw), 16, 0, 0); \
        __builtin_amdgcn_global_load_lds((const unsigned*)(Ab + (size_t)(o1) + (size_t)(kb)), (PG8_LAS unsigned*)(lds + (bufoff) + ldsw + 8192), 16, 0, 0); } while (0)
#define PG8_LDA(dst, b, h) do { _Pragma("unroll") for (int m = 0; m < 4; ++m) _Pragma("unroll") for (int k = 0; k < 2; ++k) dst[m][k] = *(const PG8_LAS bf16x8*)(lds + PG8_SA(b, h) + aoff + m * 2048 + k * 1024); } while (0)
#define PG8_LDB(dst, b, h) do { _Pragma("unroll") for (int n = 0; n < 2; ++n) _Pragma("unroll") for (int k = 0; k < 2; ++k) dst[n][k] = *(const PG8_LAS bf16x8*)(lds + PG8_SB(b, h) + boff + n * 2048 + k * 1024); } while (0)
#define PG8_MMA(ai, bj, At, Bt) do { __builtin_amdgcn_s_setprio(1); _Pragma("unroll") for (int m = 0; m < 4; ++m) _Pragma("unroll") for (int n = 0; n < 2; ++n) _Pragma("unroll") for (int k = 0; k < 2; ++k) \
        acc[ai][bj][m][n] = __builtin_amdgcn_mfma_f32_16x16x32_bf16(Bt[n][k], At[m][k], acc[ai][bj][m][n], 0, 0, 0); __builtin_amdgcn_s_setprio(0); } while (0)
#define PG8_WAIT_V(n) asm volatile("s_waitcnt vmcnt(" #n ")" ::: "memory")
#define PG8_WAIT_L(n) asm volatile("s_waitcnt lgkmcnt(" #n ")" ::: "memory")
#define PG8_BAR __builtin_amdgcn_s_barrier()
#define PG8_SCHED __builtin_amdgcn_sched_barrier(0)
#define PG8_OFFS(dst, u) do { _Pragma("unroll") for (int _i = 0; _i < 2; ++_i) { int _R, _C; stage_rc(tid * 16 + _i * 8192, _R, _C); _Pragma("unroll") for (int _h = 0; _h < 2; ++_h) \
        dst[_h][_i] = (unsigned)S.arow((u).pm * BM + _h * HALF + _R) * g.lda_bytes + (unsigned)(_C * 2); } } while (0)
    Unit cur, nxt; int ui = 0;
    if (!S.next(0, cur)) return;
    f32x4 acc[2][2][4][2];
#pragma unroll
    for (int a = 0; a < 2; ++a)
#pragma unroll
        for (int b = 0; b < 2; ++b)
#pragma unroll
            for (int m = 0; m < 4; ++m)
#pragma unroll
                for (int n = 0; n < 2; ++n) acc[a][b][m][n] = (f32x4){0.f, 0.f, 0.f, 0.f};
    bf16x8 At[4][2], B0[2][2], B1[2][2];
    unsigned oC[2][2], oN[2][2];
    PG8_OFFS(oC, cur);
    const char* cB = (const char*)g.Bt + (size_t)cur.pn * tstep;
    PG8_STAGE(PG8_SB(0, 0), cB, voffB); PG8_STAGE(PG8_SB(0, 1), cB + hstep, voffB); PG8_STAGEA(PG8_SA(0, 0), oC[0][0], oC[0][1], 0); PG8_STAGEA(PG8_SA(0, 1), oC[1][0], oC[1][1], 0);
    if (wr == 1) PG8_BAR;
    PG8_WAIT_V(2); PG8_BAR;
    PG8_STAGE(PG8_SB(1, 0), cB + kstep, voffB); PG8_STAGEA(PG8_SA(1, 0), oC[0][0], oC[0][1], kstep); PG8_STAGE(PG8_SB(1, 1), cB + hstep + kstep, voffB);
    PG8_WAIT_V(6); PG8_BAR;
    for (;;) {
        const bool has_next = S.next(ui + 1, nxt);
        if (has_next) { PG8_OFFS(oN, nxt); } else {
#pragma unroll
            for (int _h = 0; _h < 2; ++_h)
#pragma unroll
                for (int _i = 0; _i < 2; ++_i) oN[_h][_i] = oC[_h][_i]; }
        const char* nB = has_next ? (const char*)g.Bt + (size_t)nxt.pn * tstep : cB;
#pragma unroll 1
        for (int t = 0; t < nt; t += 2) {
            const bool last = (t == nt - 2);
            const size_t k1 = (size_t)(t + 1) * kstep;
            const size_t k2 = last ? 0 : (size_t)(t + 2) * kstep, k3 = k2 + kstep;
            const char* b2 = last ? nB : cB + (size_t)(t + 2) * kstep; const char* b3 = b2 + kstep;
            PG8_LDB(B0, 0, 0); PG8_LDB(B1, 0, 1); PG8_SCHED; PG8_LDA(At, 0, 0); PG8_STAGEA(PG8_SA(1, 1), oC[1][0], oC[1][1], k1);
            if (last) { oC[0][0] = oN[0][0]; oC[0][1] = oN[0][1]; oC[1][0] = oN[1][0]; oC[1][1] = oN[1][1]; }
            PG8_WAIT_V(8); PG8_WAIT_L(0); PG8_BAR; PG8_MMA(0, 0, At, B0); PG8_MMA(0, 1, At, B1); PG8_BAR; PG8_SCHED;
            PG8_LDA(At, 0, 1); PG8_STAGE(PG8_SB(0, 0), b2, voffB); PG8_STAGE(PG8_SB(0, 1), b2 + hstep, voffB); PG8_STAGEA(PG8_SA(0, 0), oC[0][0], oC[0][1], k2);
            PG8_WAIT_V(8); PG8_WAIT_L(0); PG8_BAR; PG8_MMA(1, 0, At, B0); PG8_MMA(1, 1, At, B1); PG8_BAR; PG8_SCHED;
            PG8_LDB(B0, 1, 0); PG8_LDB(B1, 1, 1); PG8_SCHED; PG8_LDA(At, 1, 0); PG8_STAGEA(PG8_SA(0, 1), oC[1][0], oC[1][1], k2);
            PG8_WAIT_V(8); PG8_WAIT_L(0); PG8_BAR; PG8_MMA(0, 0, At, B0); PG8_MMA(0, 1, At, B1); PG8_BAR; PG8_SCHED;
            PG8_LDA(At, 1, 1); PG8_STAGE(PG8_SB(1, 0), b3, voffB); PG8_STAGE(PG8_SB(1, 1), b3 + hstep, voffB); PG8_STAGEA(PG8_SA(1, 0), oC[0][0], oC[0][1], k3);
            PG8_WAIT_V(8); PG8_WAIT_L(0); PG8_BAR; PG8_MMA(1, 0, At, B0); PG8_MMA(1, 1, At, B1); PG8_BAR; PG8_SCHED;
        }
        if (wr == 0) PG8_BAR;
        E(acc, cur, wr, wc, fr, fq);
        if (!has_next) break;
#pragma unroll
        for (int a = 0; a < 2; ++a)
#pragma unroll
            for (int b = 0; b < 2; ++b)
#pragma unroll
                for (int m = 0; m < 4; ++m)
#pragma unroll
                    for (int n = 0; n < 2; ++n) acc[a][b][m][n] = (f32x4){0.f, 0.f, 0.f, 0.f};
        cur = nxt; cB = nB; ++ui;
#pragma unroll
        for (int _h = 0; _h < 2; ++_h)
#pragma unroll
            for (int _i = 0; _i < 2; ++_i) oC[_h][_i] = oN[_h][_i];
        if (wr == 1) PG8_BAR;
    }
    PG8_WAIT_V(0);
    PG8_BAR;
#undef PG8_SA
#undef PG8_SB
#undef PG8_STAGE
#undef PG8_STAGEA
#undef PG8_LDA
#undef PG8_LDB
#undef PG8_MMA
#undef PG8_WAIT_V
#undef PG8_WAIT_L
#undef PG8_BAR
#undef PG8_SCHED
#undef PG8_OFFS
}

template <class Epi, class Sched>
__device__ __noinline__ void gemm_phase_ni(PG8_LAS unsigned char* lds, Gemm g, Sched S, Epi E) { gemm_phase<Epi, Sched>(lds, g, S, E); }
}

namespace mk {
using namespace pg8;
constexpr int D = 1024, NB = 32, SEQ = 2048, T = NB * SEQ, LC = 256, TC = NB * LC, TT = T + TC;
constexpr int NMOD = 6 * D;
constexpr int NE = 64, NEX = 65, DE = 256;
constexpr int NCH = 4, CHT = T / NCH;
constexpr int MAXTILES = 640, CHROWS = MAXTILES * 256;
constexpr float RMS_EPS = 1e-6f;
constexpr int NWAVES = 8, NTHR = 512;

constexpr size_t MiB = 1u << 20;
constexpr size_t WS_CTL = 0, CTL_ZERO_BYTES = 64 * 1024;
constexpr size_t WS_MOD = 1 * MiB;
constexpr size_t WS_ROPE = 3 * MiB;
constexpr size_t WS_BC = 3 * MiB + 65536;
constexpr size_t WS_GATES = 4 * MiB;
constexpr size_t WS_FILT = 10 * MiB;
constexpr size_t WS_EIDX = 18 * MiB, WS_WTS = 20 * MiB, WS_PSLOT = 22 * MiB, WS_SORT = 26 * MiB;
constexpr size_t WS_WIN0 = 30 * MiB;
constexpr size_t WS_WOUT0 = 38 * MiB, WS_WIN1 = 40 * MiB, WS_WOUT1 = 46 * MiB, WS_WR = 48 * MiB;
constexpr size_t WS_GU = 50 * MiB;
constexpr size_t WS_DN = 180 * MiB;
constexpr size_t WS_BIG = 246 * MiB;
constexpr size_t WS_END = 1024 * MiB;
static_assert(WS_PSLOT + (size_t)T * 16 * 4 <= WS_SORT && WS_SORT + (size_t)4 * CHROWS * 4 <= WS_WIN0 && WS_WIN0 + (size_t)3840 * 2048 <= WS_WOUT0 && WS_WR + (size_t)2 * 256 * 2048 <= WS_GU && WS_GU + (size_t)2 * 65 * 512 * 2048 <= WS_DN && WS_DN + (size_t)2 * 65 * 1024 * 512 <= WS_BIG, "ws map");
constexpr size_t A0_H = 0, A0_QA = 144 * MiB, A0_KA = 208 * MiB, A0_VA = 280 * MiB, A0_BQ = 352 * MiB, A0_BK = 416 * MiB, A0_BV = 488 * MiB, A0_BO = 560 * MiB, A0_VT = 624 * MiB;
constexpr size_t A0_MIXIN = 0, A0_HB = 144 * MiB, A0_MIX = 352 * MiB;
constexpr int CW_BAR = 4096;

constexpr int LDS_BYTES = 160 * 1024;
constexpr int LDS_TAB = 131072;
constexpr int LDS_MISC = 131072 + 24 * 1024;

#define GAS __attribute__((address_space(1)))
#define LAS __attribute__((address_space(3)))
typedef unsigned short bf16;
typedef unsigned v4u __attribute__((ext_vector_type(4)));
typedef unsigned v2u __attribute__((ext_vector_type(2)));
#define LDS_WAIT() asm volatile("s_waitcnt lgkmcnt(0)" ::: "memory")
#define VM_WAIT() asm volatile("s_waitcnt vmcnt(0)" ::: "memory")
__device__ __forceinline__ unsigned f2bf(float f) { unsigned u = __builtin_bit_cast(unsigned, f); return (u + 0x7fffu + ((u >> 16) & 1u)) >> 16; }
__device__ __forceinline__ unsigned pk2(float lo, float hi) { return f2bf(lo) | (f2bf(hi) << 16); }
__device__ __forceinline__ float bf_lo(unsigned w) { return __builtin_bit_cast(float, w << 16); }
__device__ __forceinline__ float bf_hi(unsigned w) { return __builtin_bit_cast(float, w & 0xffff0000u); }
__device__ __forceinline__ float bf1(bf16 h) { return __builtin_bit_cast(float, (unsigned)h << 16); }
__device__ __forceinline__ float wave_sum(float v) {
#pragma unroll
    for (int o = 1; o < 64; o <<= 1) v += __shfl_xor(v, o);
    return v;
}
__device__ __forceinline__ float wave_max(float v) {
#pragma unroll
    for (int o = 1; o < 64; o <<= 1) v = fmaxf(v, __shfl_xor(v, o));
    return v;
}
__device__ __forceinline__ float sigmoidf_(float x) { return 1.f / (1.f + __expf(-x)); }
__device__ __forceinline__ float siluf_(float x) { return x / (1.f + __expf(-x)); }
#define XB_TMO      128
#define XB_XCNT(j)  (256  + 64 * (j))
#define XB_XSUB(j)  (1280 + 64 * (j))
#define XB_XGEN(j)  (2304 + 64 * (j))
#define XB_TOP      3328
#define XB_TOPGEN   3392
#define XCD_BAR_WORDS 3456
#define XB_SPIN_CAP (1u << 18)

__device__ __forceinline__ unsigned xb_ld(unsigned* p)              { return __hip_atomic_load(p, __ATOMIC_RELAXED, __HIP_MEMORY_SCOPE_AGENT); }
__device__ __forceinline__ unsigned xb_add(unsigned* p, unsigned v) { return __hip_atomic_fetch_add(p, v, __ATOMIC_RELAXED, __HIP_MEMORY_SCOPE_AGENT); }
__device__ __forceinline__ unsigned xb_xcc_id() { return (unsigned)__builtin_amdgcn_s_getreg((3 << 11) | 20) & 0xFu; }
#define XB_SPIN(cond, bar) do { unsigned _sp = 0; while (cond) { __builtin_amdgcn_s_sleep(1); \
    if ((++_sp & 255u) == 0u) { if (xb_ld(&(bar)[XB_TMO])) break; if (_sp > XB_SPIN_CAP) { atomicAdd(&(bar)[XB_TMO], 1u); break; } } } } while (0)

struct XcdBarrier {
    unsigned* bar; unsigned x;
    volatile LAS unsigned* st;
};

__device__ __forceinline__ XcdBarrier xcd_barrier_post(unsigned* bar, volatile LAS unsigned* st) {
    XcdBarrier b; b.bar = bar; b.x = xb_xcc_id(); b.st = st;
    if (threadIdx.x == 0) (void)xb_add(&bar[XB_XCNT(b.x)], 1u);
    return b;
}
__device__ __forceinline__ void xcd_barrier_complete(unsigned* bar, unsigned x, unsigned& nloc, unsigned& nx) {
    const unsigned G = gridDim.x * gridDim.y * gridDim.z;
    unsigned sum, cnt, mine, sp = 0u;
    for (;;) {
        sum = 0u; cnt = 0u; mine = 0u;
#pragma unroll
        for (unsigned j = 0; j < 16; ++j) { const unsigned c = xb_ld(&bar[XB_XCNT(j)]); sum += c; cnt += (c > 0u) ? 1u : 0u; mine = (j == x) ? c : mine; }
        if (sum == G) break;
        __builtin_amdgcn_s_sleep(1);
        if ((++sp & 255u) == 0u) { if (xb_ld(&bar[XB_TMO])) break; if (sp > XB_SPIN_CAP) { atomicAdd(&bar[XB_TMO], 1u); break; } }
    }
    nloc = mine > 0u ? mine : 1u; nx = cnt > 0u ? cnt : 1u;
}

__device__ __forceinline__ void xcd_barrier(const XcdBarrier& b) {
    asm volatile("s_waitcnt vmcnt(0)" ::: "memory");
    __syncthreads();
    if (threadIdx.x == 0) {
        unsigned* bar = b.bar;
        __builtin_amdgcn_s_waitcnt(0);
        unsigned nloc = b.st[0], nx = b.st[1];
        if (nloc == 0u) { xcd_barrier_complete(bar, b.x, nloc, nx); b.st[0] = nloc; b.st[1] = nx; }
        const unsigned old = xb_add(&bar[XB_XSUB(b.x)], 1u);
        const unsigned gen = old / nloc;
        if (old + 1u == (gen + 1u) * nloc) {
            __builtin_amdgcn_fence(__ATOMIC_RELEASE, "agent");
            asm volatile("s_waitcnt vmcnt(0)" ::: "memory");
            const unsigned og = xb_add(&bar[XB_TOP], 1u);
            const unsigned tg = og / nx;
            if (og + 1u == (tg + 1u) * nx) xb_add(&bar[XB_TOPGEN], 1u);
            else XB_SPIN(xb_ld(&bar[XB_TOPGEN]) == tg, bar);
            __builtin_amdgcn_fence(__ATOMIC_ACQUIRE, "agent");
            xb_add(&bar[XB_XGEN(b.x)], 1u);
            asm volatile("s_waitcnt vmcnt(0)" ::: "memory");
        } else {
            XB_SPIN(xb_ld(&bar[XB_XGEN(b.x)]) == gen, bar);
            __builtin_amdgcn_fence(__ATOMIC_ACQUIRE, "agent");
            asm volatile("s_waitcnt vmcnt(0)" ::: "memory");
        }
    }
    __syncthreads();
}

struct Params { const float* in[31]; float* out; unsigned char* ws; int ph_lo, ph_hi; };
enum { I_X = 0, I_C, I_CTX, I_CCTX, I_WMOD, I_BMOD, I_NORMG, I_WINAB, I_CONVABW, I_CONVABB, I_GATEB, I_DLAM, I_HGA, I_HGB, I_WOUTAB, I_WINHY, I_CONVHYW, I_CONVHYB,
       I_FW1, I_FB1, I_FW2, I_FB2, I_FW3, I_FBIAS, I_WOUTHY, I_RW, I_RB, I_EGU, I_EDN, I_SGU, I_SDN };

__device__ __forceinline__ void row_ld_f32(const float* row, int lane, f32x4 (&v)[4]) { const f32x4* r = (const f32x4*)row + lane;
#pragma unroll
    for (int j = 0; j < 4; ++j) v[j] = r[64 * j]; }
__device__ __forceinline__ void row_st_f32(float* row, int lane, const f32x4 (&v)[4]) { f32x4* r = (f32x4*)row + lane;
#pragma unroll
    for (int j = 0; j < 4; ++j) r[64 * j] = v[j]; }
__device__ __forceinline__ void row_ld_bf16(const bf16* row, int lane, f32x4 (&v)[4]) { const v2u* r = (const v2u*)row + lane;
#pragma unroll
    for (int j = 0; j < 4; ++j) { const v2u w = r[64 * j]; v[j] = (f32x4){bf_lo(w.x), bf_hi(w.x), bf_lo(w.y), bf_hi(w.y)}; } }
__device__ __forceinline__ void row_st_bf16(bf16* row, int lane, const f32x4 (&v)[4]) { v2u* r = (v2u*)row + lane;
#pragma unroll
    for (int j = 0; j < 4; ++j) { v2u w; w.x = pk2(v[j].x, v[j].y); w.y = pk2(v[j].z, v[j].w); r[64 * j] = w; } }
__device__ __forceinline__ float row_ss(const f32x4 (&v)[4]) { float s = 0.f;
#pragma unroll
    for (int j = 0; j < 4; ++j) s += (v[j].x * v[j].x + v[j].y * v[j].y) + (v[j].z * v[j].z + v[j].w * v[j].w);
    return wave_sum(s); }
__device__ __forceinline__ void row_modulate(const f32x4 (&x)[4], float rstd, const float* g, const float* shift, const float* scale, int lane, f32x4 (&h)[4]) {
    const f32x4* gp = (const f32x4*)g + lane; const f32x4* sh = (const f32x4*)shift + lane; const f32x4* sc = (const f32x4*)scale + lane;
#pragma unroll
    for (int j = 0; j < 4; ++j) { const f32x4 gg = gp[64 * j], s1 = sc[64 * j], s0 = sh[64 * j]; h[j] = x[j] * rstd * gg * (1.f + s1) + s0; } }

__device__ __forceinline__ void pro_mod(const Params& p, LAS unsigned char* lds, int tid, int lane, int wave) {
    const int u = blockIdx.x; if (u >= 192) return;
    LAS float* S = (LAS float*)lds;
    const float* c = p.in[I_C]; const float* cc = p.in[I_CCTX];
#pragma unroll 1
    for (int i = tid; i < 33 * 1024; i += NTHR) { const int b = i >> 10, k = i & 1023; const float v = b < 32 ? c[b * 1024 + k] : cc[k]; S[i] = siluf_(v); }
    __syncthreads();
    const int l = u / 96, cg = (u % 96) * 64, col = cg + lane;
    const float* W = p.in[I_WMOD] + (size_t)l * 1024 * NMOD;
    float acc[33];
#pragma unroll
    for (int b = 0; b < 33; ++b) acc[b] = 0.f;
    const int k0 = wave * 128;
#pragma unroll 1
    for (int kk = 0; kk < 128; kk += 4) { const int k = k0 + kk;
        const float w0 = W[(size_t)k * NMOD + col], w1 = W[(size_t)(k + 1) * NMOD + col], w2 = W[(size_t)(k + 2) * NMOD + col], w3 = W[(size_t)(k + 3) * NMOD + col];
#pragma unroll
        for (int b = 0; b < 33; ++b) { const f32x4 s = *(const LAS f32x4*)(S + b * 1024 + k); acc[b] += (s.x * w0 + s.y * w1) + (s.z * w2 + s.w * w3); } }
    __syncthreads();
    LAS float* P = (LAS float*)lds;
#pragma unroll
    for (int b = 0; b < 33; ++b) P[(wave * 33 + b) * 64 + lane] = acc[b];
    __syncthreads();
    float* MOD = (float*)(p.ws + WS_MOD);
#pragma unroll 1
    for (int i = tid; i < 33 * 64; i += NTHR) { const int b = i >> 6, ln = i & 63; float s = 0.f;
#pragma unroll
        for (int w = 0; w < 8; ++w) s += P[(w * 33 + b) * 64 + ln];
        MOD[(size_t)(l * 33 + b) * NMOD + cg + ln] = s + p.in[I_BMOD][l * NMOD + cg + ln]; }
    __syncthreads();
}
__device__ __forceinline__ int rowmap(int kind, int n) {
    if (kind == 1) { const int o = n & 31; return (n & ~31) + (((o & 15) >> 2) * 8 + (o >> 4) * 4 + (o & 3)); }
    if (kind == 2) { return n < 256 ? ((n >> 7) * 256 + (n & 127)) : ((((n - 256) >> 7) * 256) + 128 + ((n - 256) & 127)); }
    return n;
}
__device__ __forceinline__ void tr_item(const float* W, int ldn, int k0, int n0, int nvalid, bf16* WT, int dK, int kind, int row_base, LAS float* scr, int lane) {
    const int nn = n0 + (lane & 31);
#pragma unroll 8
    for (int i = 0; i < 32; ++i) { const int kk = 2 * i + (lane >> 5); scr[kk * 33 + (lane & 31)] = nn < nvalid ? W[(size_t)(k0 + kk) * ldn + nn] : 0.f; }
    LDS_WAIT(); asm volatile("" ::: "memory");
    const int c = lane & 7;
#pragma unroll
    for (int j = 0; j < 4; ++j) { const int n = (lane >> 3) + 8 * j; const LAS float* s = scr + (8 * c) * 33 + n;
        v4u o; o.x = pk2(s[0 * 33], s[1 * 33]); o.y = pk2(s[2 * 33], s[3 * 33]); o.z = pk2(s[4 * 33], s[5 * 33]); o.w = pk2(s[6 * 33], s[7 * 33]);
        const int row = row_base + rowmap(kind, n0 + n);
        *(v4u*)(WT + (size_t)row * dK + k0 + 8 * c) = o; }
    LDS_WAIT(); asm volatile("" ::: "memory");
}
__device__ __forceinline__ void pro_transposes(const Params& p, LAS unsigned char* lds, int lane, int wave) {
    LAS float* scr = (LAS float*)(lds + wave * 16384);
    const int gw = blockIdx.x * NWAVES + wave, NGW = gridDim.x * NWAVES;
    constexpr int I_A = 16 * 113, I_B = 512, I_C2 = 1536, I_D = 512, I_E = 64, I_F = 130 * 256, I_G = 130 * 128;
    constexpr int NITEMS = I_A + I_B + I_C2 + I_D + I_E + I_F + I_G;
    unsigned char* ws = p.ws;
    for (int it = gw; it < NITEMS; it += NGW) {
        int r = it;
        if (r < I_A) { const int kb = r / 113, nb = r % 113, n0 = nb * 32; const int kind = (n0 < 512 || (n0 >= 1536 && n0 < 2048)) ? 1 : 0;
            tr_item(p.in[I_WINAB], 3600, kb * 64, n0, 3600, (bf16*)(ws + WS_WIN0), 1024, kind, 0, scr, lane); continue; } r -= I_A;
        if (r < I_B) { tr_item(p.in[I_WOUTAB], 1024, (r / 32) * 64, (r % 32) * 32, 1024, (bf16*)(ws + WS_WOUT0), 1024, 0, 0, scr, lane); continue; } r -= I_B;
        if (r < I_C2) { tr_item(p.in[I_WINHY], 3072, (r / 96) * 64, (r % 96) * 32, 3072, (bf16*)(ws + WS_WIN1), 1024, 0, 0, scr, lane); continue; } r -= I_C2;
        if (r < I_D) { tr_item(p.in[I_WOUTHY], 1024, (r / 32) * 64, (r % 32) * 32, 1024, (bf16*)(ws + WS_WOUT1), 1024, 0, 0, scr, lane); continue; } r -= I_D;
        if (r < I_E) { const int l = r / 32, q = r % 32;
            tr_item(p.in[I_RW] + (size_t)l * 1024 * 64, 64, (q / 2) * 64, (q % 2) * 32, 64, (bf16*)(ws + WS_WR) + (size_t)l * 256 * 1024, 1024, 0, 0, scr, lane); continue; } r -= I_E;
        if (r < I_F) { const int mat = r / 256, q = r % 256, l = mat / 65, e = mat % 65;
            const float* src = e < 64 ? p.in[I_EGU] + (size_t)(l * 64 + e) * 1024 * 512 : p.in[I_SGU] + (size_t)l * 1024 * 512;
            tr_item(src, 512, (q / 16) * 64, (q % 16) * 32, 512, (bf16*)(ws + WS_GU) + (size_t)l * (65 * 512) * 1024, 1024, 2, e * 512, scr, lane); continue; } r -= I_F;
        { const int mat = r / 128, q = r % 128, l = mat / 65, e = mat % 65;
            const float* src = e < 64 ? p.in[I_EDN] + (size_t)(l * 64 + e) * 256 * 1024 : p.in[I_SDN] + (size_t)l * 256 * 1024;
            tr_item(src, 1024, (q / 32) * 64, (q % 32) * 32, 1024, (bf16*)(ws + WS_DN) + (size_t)l * (65 * 1024) * 256, 256, 0, e * 1024, scr, lane); }
    }
}
__device__ __forceinline__ void pro_rope(const Params& p, int tid) {
    if (blockIdx.x != 255) return;
    float* R = (float*)(p.ws + WS_ROPE);
    for (int i = tid; i < 64 * 16; i += NTHR) { const int pos = i >> 4, f = i & 15; const float inv = exp2f(-(float)f * (13.287712379549449f / 16.f)); const float ang = (float)pos * inv;
        float sn, cs; sincosf(ang, &sn, &cs); R[2 * i] = cs; R[2 * i + 1] = sn; }
}
__device__ __forceinline__ void pro_filters(const Params& p, LAS unsigned char* lds, int tid, int lane, int wave) {
    LAS float* Z = (LAS float*)lds;
    LAS float* H1 = Z + 512;
    LAS float* H2 = H1 + 512;
    const int j0 = 8 * blockIdx.x, j = j0 + wave;
    const float* fw1 = p.in[I_FW1]; const float* fb1 = p.in[I_FB1]; const float* fw2 = p.in[I_FW2]; const float* fb2 = p.in[I_FB2]; const float* fw3 = p.in[I_FW3];
    {   float z = 0.f;
        if (lane == 0) z = (float)j / 2047.f;
        else if (lane < 33) { const int k = (lane - 1) & 15; const float fr = 1e-4f + (float)k * ((15.f - 1e-4f) / 15.f); const float ang = (6.283185307179586f / 2048.f) * (float)j * fr;
            float sn, cs; sincosf(ang, &sn, &cs); z = lane < 17 ? cs : -sn; }
        Z[wave * 64 + lane] = z; }
    LDS_WAIT(); asm volatile("" ::: "memory");
    {   float a = fb1[lane];
#pragma unroll 1
        for (int k = 0; k < 33; ++k) a += Z[wave * 64 + k] * fw1[k * 64 + lane];
        H1[wave * 64 + lane] = sinf(a); }
    LDS_WAIT(); asm volatile("" ::: "memory");
    {   float a = fb2[lane];
#pragma unroll 1
        for (int k = 0; k < 64; ++k) a += H1[wave * 64 + k] * fw2[k * 64 + lane];
        H2[wave * 64 + lane] = sinf(a); }
    __syncthreads();
    bf16* F = (bf16*)(p.ws + WS_FILT);
    const float mind = -4.605170185988091f / 1.5f, maxd = -4.605170185988091f / 0.3f;
#pragma unroll 1
    for (int i = 0; i < 4; ++i) { const int n = tid + NTHR * i, c = n & 1023;
        float acc[8];
#pragma unroll
        for (int q = 0; q < 8; ++q) acc[q] = 0.f;
#pragma unroll 2
        for (int k = 0; k < 64; ++k) { const float w = fw3[k * 2048 + n];
#pragma unroll
            for (int q = 0; q < 8; ++q) acc[q] += H2[q * 64 + k] * w; }
        const float delta = fabsf(mind + (float)c * ((maxd - mind) / 1023.f));
        float o[8];
#pragma unroll
        for (int q = 0; q < 8; ++q) { const float dist = fabsf((float)(j0 + q) - 1024.f) * (1.f / 1024.f); o[q] = acc[q] * expf(-dist * delta); }
        v4u w; w.x = pk2(o[0], o[1]); w.y = pk2(o[2], o[3]); w.z = pk2(o[4], o[5]); w.w = pk2(o[6], o[7]);
        *(v4u*)(F + (size_t)n * 2048 + j0) = w; }
    __syncthreads();
}

__device__ __forceinline__ void ph_l0_norm(const Params& p, int lane, int wave) {
    const int gw = blockIdx.x * NWAVES + wave, NGW = gridDim.x * NWAVES;
    const float* MOD = (const float*)(p.ws + WS_MOD); bf16* H = (bf16*)(p.ws + WS_BIG + A0_H);
    const float* g = p.in[I_NORMG];
    for (int m = gw; m < TT; m += NGW) {
        const float* src; int bi;
        if (m < T) { src = p.in[I_X] + (size_t)m * D; bi = m >> 11; } else { src = p.in[I_CTX] + (size_t)(m - T) * D; bi = 32; }
        f32x4 x[4], h[4]; row_ld_f32(src, lane, x);
        const float rstd = rsqrtf(row_ss(x) * (1.f / D) + RMS_EPS);
        const float* md = MOD + (size_t)bi * NMOD;
        row_modulate(x, rstd, g, md, md + D, lane, h);
        row_st_bf16(H + (size_t)m * D, lane, h);
    }
}
__device__ __forceinline__ void ph_mid(const Params& p, int l, const bf16* MIX, bf16* H2, bool has_mix, int lane, int wave) {
    const int gw = blockIdx.x * NWAVES + wave, NGW = gridDim.x * NWAVES;
    const float* MOD = (const float*)(p.ws + WS_MOD) + (size_t)l * 33 * NMOD;
    const float* g1 = p.in[I_NORMG] + (size_t)(l * 4 + 1) * D; const float* g2 = p.in[I_NORMG] + (size_t)(l * 4 + 2) * D;
    const float* xin = l == 0 ? p.in[I_X] : p.out;
    for (int m = gw; m < T; m += NGW) {
        const float* md = MOD + (size_t)(m >> 11) * NMOD;
        f32x4 x[4], h[4]; row_ld_f32(xin + (size_t)m * D, lane, x);
        if (has_mix) { f32x4 mx[4]; row_ld_bf16(MIX + (size_t)m * D, lane, mx);
            const float r = rsqrtf(row_ss(mx) * (1.f / D) + RMS_EPS);
            const f32x4* gp = (const f32x4*)g1 + lane; const f32x4* gm = (const f32x4*)(md + 2 * D) + lane;
#pragma unroll
            for (int j = 0; j < 4; ++j) x[j] = x[j] + gm[64 * j] * (mx[j] * r * gp[64 * j]); }
        row_st_f32(p.out + (size_t)m * D, lane, x);
        const float rstd = rsqrtf(row_ss(x) * (1.f / D) + RMS_EPS);
        row_modulate(x, rstd, g2, md + 3 * D, md + 4 * D, lane, h);
        row_st_bf16(H2 + (size_t)m * D, lane, h);
    }
}
__device__ __forceinline__ void ph_combine(const Params& p, int l, int ch, const bf16* Y, bf16* Hn, int lane, int wave) {
    const int gw = blockIdx.x * NWAVES + wave, NGW = gridDim.x * NWAVES;
    const float* MOD = (const float*)(p.ws + WS_MOD) + (size_t)l * 33 * NMOD;
    const float* g3 = p.in[I_NORMG] + (size_t)(l * 4 + 3) * D;
    const int* PSLOT = (const int*)(p.ws + WS_PSLOT); const float* WTS = (const float*)(p.ws + WS_WTS);
    for (int mm = gw; mm < CHT; mm += NGW) { const int m = ch * CHT + mm;
        const float* md = MOD + (size_t)(m >> 11) * NMOD;
        f32x4 a[4];
#pragma unroll
        for (int j = 0; j < 4; ++j) a[j] = (f32x4){0.f, 0.f, 0.f, 0.f};
#pragma unroll
        for (int k = 0; k < 9; ++k) { const int slot = PSLOT[(size_t)m * 16 + k]; const float w = k < 8 ? WTS[(size_t)m * 8 + k] : 1.f;
            f32x4 y[4]; row_ld_bf16(Y + (size_t)slot * D, lane, y);
#pragma unroll
            for (int j = 0; j < 4; ++j) a[j] = a[j] + y[j] * w; }
        const float r = rsqrtf(row_ss(a) * (1.f / D) + RMS_EPS);
        f32x4 x[4]; row_ld_f32(p.out + (size_t)m * D, lane, x);
        const f32x4* gp = (const f32x4*)g3 + lane; const f32x4* gf = (const f32x4*)(md + 5 * D) + lane;
#pragma unroll
        for (int j = 0; j < 4; ++j) x[j] = x[j] + gf[64 * j] * (a[j] * r * gp[64 * j]);
        row_st_f32(p.out + (size_t)m * D, lane, x);
        if (l == 0) { const float* md1 = MOD + (size_t)(33 + (m >> 11)) * NMOD; f32x4 h[4];
            const float rstd = rsqrtf(row_ss(x) * (1.f / D) + RMS_EPS);
            row_modulate(x, rstd, p.in[I_NORMG] + (size_t)4 * D, md1, md1 + D, lane, h);
            row_st_bf16(Hn + (size_t)m * D, lane, h); }
    }
}

struct DenseSched { int NN, NU, G, c, NMs;
    __device__ __forceinline__ bool next(int i, Unit& u) const { const int L = i * G + c; if (L >= NU) return false; if (NMs > 0) { u.pm = L % NMs; u.pn = L / NMs; } else { u.pm = L / NN; u.pn = L % NN; } return true; }
    __device__ __forceinline__ int arow(int r) const { return r; } };
struct EpiBf16 { static constexpr bool PERM = true; bf16* O; size_t ldc; int cmask;
    __device__ __forceinline__ void operator()(const f32x4 (&acc)[2][2][4][2], const Unit& u, int wr, int wc, int fr, int fq) const {
        const int row0 = u.pm * BM + wr * 64 + fr, col0 = (u.pn & cmask) * BM + wc * 32 + 8 * fq;
#pragma unroll
        for (int ai = 0; ai < 2; ++ai)
#pragma unroll
            for (int m = 0; m < 4; ++m) { bf16* rowp = O + (size_t)(row0 + ai * HALF + m * 16) * ldc + col0;
#pragma unroll
                for (int bj = 0; bj < 2; ++bj) { const f32x4 v0 = acc[ai][bj][m][0], v1 = acc[ai][bj][m][1];
                    u32x4 w; w.x = cvt_pk_bf16(v0[0], v0[1]); w.y = cvt_pk_bf16(v0[2], v0[3]); w.z = cvt_pk_bf16(v1[0], v1[1]); w.w = cvt_pk_bf16(v1[2], v1[3]);
                    *(u32x4*)(rowp + bj * HALF) = w; } }
    } };
struct EpiRouter { static constexpr bool PERM = false; float* LOG;
    __device__ __forceinline__ void operator()(const f32x4 (&acc)[2][2][4][2], const Unit& u, int wr, int wc, int fr, int fq) const {
        if (wc >= 2) return;
        const int row0 = u.pm * BM + wr * 64 + fr, col0 = wc * 32 + 4 * fq;
#pragma unroll
        for (int ai = 0; ai < 2; ++ai)
#pragma unroll
            for (int m = 0; m < 4; ++m) { float* rowp = LOG + (size_t)(row0 + ai * HALF + m * 16) * 64 + col0;
#pragma unroll
                for (int n = 0; n < 2; ++n) *(f32x4*)(rowp + n * 16) = acc[ai][0][m][n]; }
    } };
struct MoeSched { const LAS int* te; const int* sort; int NU, G, c, sh, per;
    __device__ __forceinline__ bool next(int i, Unit& u) const { const int L = i * G + c; if (L >= NU) return false; const int tile = L >> sh; u.pm = tile; u.pn = te[tile] * per + (L & (per - 1)); return true; }
    __device__ __forceinline__ int arow(int r) const { return sort ? sort[r] : r; } };
struct EpiSwiglu { static constexpr bool PERM = true; bf16* ACT;
    __device__ __forceinline__ void operator()(const f32x4 (&acc)[2][2][4][2], const Unit& u, int wr, int wc, int fr, int fq) const {
        const int row0 = u.pm * BM + wr * 64 + fr, col0 = (u.pn & 1) * 128 + wc * 32 + 8 * fq;
#pragma unroll
        for (int ai = 0; ai < 2; ++ai)
#pragma unroll
            for (int m = 0; m < 4; ++m) { bf16* rowp = ACT + (size_t)(row0 + ai * HALF + m * 16) * DE + col0;
                const f32x4 g0 = acc[ai][0][m][0], g1 = acc[ai][0][m][1], u0 = acc[ai][1][m][0], u1 = acc[ai][1][m][1];
                float o[8];
#pragma unroll
                for (int q = 0; q < 4; ++q) { o[q] = siluf_(g0[q]) * u0[q]; o[4 + q] = siluf_(g1[q]) * u1[q]; }
                u32x4 w; w.x = cvt_pk_bf16(o[0], o[1]); w.y = cvt_pk_bf16(o[2], o[3]); w.z = cvt_pk_bf16(o[4], o[5]); w.w = cvt_pk_bf16(o[6], o[7]);
                *(u32x4*)rowp = w; }
    } };
__device__ __forceinline__ int moe_tables(const Params& p, int ch, LAS unsigned char* lds, int tid) {
    LAS int* TE = (LAS int*)(lds + LDS_TAB);
    LAS int* TB = TE + 640;
    LAS int* CN = TB + 80;
    const int* BC = (const int*)(p.ws + WS_BC) + (size_t)ch * 64 * 64;
    __syncthreads();
    if (tid < 64) CN[tid] = 0;
    __syncthreads();
#pragma unroll 1
    for (int i = tid; i < 4096; i += NTHR) __hip_atomic_fetch_add(&CN[i & 63], BC[i], __ATOMIC_RELAXED, __HIP_MEMORY_SCOPE_WORKGROUP);
    __syncthreads();
    if (tid == 0) { int b = 0;
#pragma unroll 1
        for (int e = 0; e < 64; ++e) { TB[e] = b; b += (CN[e] + 255) >> 8; } TB[64] = b; TB[65] = b + 64; }
    __syncthreads();
    const int NT = TB[65];
#pragma unroll 1
    for (int i = tid; i < NT; i += NTHR) { int e = 0;
#pragma unroll 1
        while (e < 64 && i >= TB[e + 1]) ++e;
        TE[i] = e; }
    __syncthreads();
    return NT;
}

__device__ __forceinline__ void ph_route_a(const Params& p, int l, const float* LOG, LAS unsigned char* lds, int tid) {
    LAS float* SC = (LAS float*)lds;
    LAS float* RBs = (LAS float*)(lds + 68 * 1024);
    LAS unsigned* MASK = (LAS unsigned*)(lds + 69 * 1024);
    const int b = blockIdx.x, tok0 = 256 * b;
#pragma unroll 1
    for (int i = tid; i < 256 * 64; i += NTHR) { const int t = i >> 6, e = i & 63; SC[t * 65 + e] = sigmoidf_(LOG[(size_t)(tok0 + t) * 64 + e]); }
    if (tid < 64) RBs[tid] = p.in[I_RB][l * 64 + tid];
    MASK[tid] = 0u;
    __syncthreads();
    int eidx[8]; float wts[8];
    if (tid < 256) { const int t = tid; const LAS float* sc = SC + t * 65;
        float gs[8];
#pragma unroll
        for (int g = 0; g < 8; ++g) { float m1 = -3.0e38f, m2 = -3.0e38f;
#pragma unroll
            for (int j = 0; j < 8; ++j) { const float v = sc[8 * g + j] + RBs[8 * g + j]; if (v > m1) { m2 = m1; m1 = v; } else if (v > m2) m2 = v; }
            gs[g] = m1 + m2; }
        unsigned gmask = 0u;
#pragma unroll
        for (int r = 0; r < 4; ++r) { float best = -3.0e38f; int bi = 0; bool found = false;
#pragma unroll
            for (int g = 0; g < 8; ++g) { const bool free_ = ((gmask >> g) & 1u) == 0u; if (free_ && (!found || gs[g] > best)) { best = gs[g]; bi = g; found = true; } }
            gmask |= 1u << bi; }
        unsigned long long taken = 0ull; float ssum = 0.f;
#pragma unroll
        for (int k = 0; k < 8; ++k) { float best = -3.0e38f; int be = -1;
#pragma unroll 1
            for (int e = 0; e < 64; ++e) { const bool ok = ((gmask >> (e >> 3)) & 1u) && !((taken >> e) & 1ull); const float v = sc[e] + RBs[e]; if (ok && (be < 0 || v > best)) { best = v; be = e; } }
            taken |= 1ull << be; eidx[k] = be; wts[k] = sc[be]; ssum += wts[k]; }
        const float inv = 2.5f / ssum;
#pragma unroll
        for (int k = 0; k < 8; ++k) { wts[k] *= inv; __hip_atomic_fetch_or(&MASK[eidx[k] * 8 + (t >> 5)], 1u << (t & 31), __ATOMIC_RELAXED, __HIP_MEMORY_SCOPE_WORKGROUP); }
    }
    __syncthreads();
    if (tid < 256) { const int t = tid; int* EIDX = (int*)(p.ws + WS_EIDX); float* WTS = (float*)(p.ws + WS_WTS);
#pragma unroll
        for (int k = 0; k < 8; ++k) { const int e = eidx[k]; int r = 0;
#pragma unroll 1
            for (int w = 0; w < (t >> 5); ++w) r += __popc(MASK[e * 8 + w]);
            r += __popc(MASK[e * 8 + (t >> 5)] & ((1u << (t & 31)) - 1u));
            EIDX[(size_t)(tok0 + t) * 8 + k] = e | (r << 8); WTS[(size_t)(tok0 + t) * 8 + k] = wts[k]; } }
    if (tid < 64) { int c = 0;
#pragma unroll
        for (int w = 0; w < 8; ++w) c += __popc(MASK[tid * 8 + w]);
        ((int*)(p.ws + WS_BC))[b * 64 + tid] = c; }
    __syncthreads();
}
__device__ __forceinline__ void ph_route_b(const Params& p, LAS unsigned char* lds, int tid) {
    LAS int* BCS = (LAS int*)lds;
    LAS int* CNT = BCS + 4096; LAS int* PRE = CNT + 64; LAS int* SEG = PRE + 64;
    const int b = blockIdx.x, ch = b >> 6, bl = b & 63;
    const int* BC = (const int*)(p.ws + WS_BC) + (size_t)ch * 64 * 64;
#pragma unroll 1
    for (int i = tid; i < 4096; i += NTHR) BCS[i] = BC[i];
    __syncthreads();
    if (tid < 64) { int c = 0, pr = 0;
#pragma unroll 1
        for (int i = 0; i < 64; ++i) { const int v = BCS[i * 64 + tid]; c += v; if (i < bl) pr += v; } CNT[tid] = c; PRE[tid] = pr; }
    __syncthreads();
    if (tid == 0) { int base = 0;
#pragma unroll 1
        for (int e = 0; e < 64; ++e) { SEG[e] = base; base += ((CNT[e] + 255) >> 8) << 8; } SEG[64] = base; }
    __syncthreads();
    int* SORT = (int*)(p.ws + WS_SORT) + (size_t)ch * CHROWS; int* PSLOT = (int*)(p.ws + WS_PSLOT); const int* EIDX = (const int*)(p.ws + WS_EIDX);
    if (tid < 256) { const int tok = 256 * b + tid;
#pragma unroll
        for (int k = 0; k < 8; ++k) { const int w = EIDX[(size_t)tok * 8 + k], e = w & 255, r = w >> 8; const int slot = SEG[e] + PRE[e] + r; SORT[slot] = tok; PSLOT[(size_t)tok * 16 + k] = slot; }
        const int s8 = SEG[64] + (tok - ch * CHT); SORT[s8] = tok; PSLOT[(size_t)tok * 16 + 8] = s8; }
    { const int e = bl, lo = SEG[e] + CNT[e], hi = SEG[e] + (((CNT[e] + 255) >> 8) << 8); for (int s = lo + tid; s < hi; s += NTHR) SORT[s] = ch * CHT; }
    __syncthreads();
}

typedef float f32x16 __attribute__((ext_vector_type(16)));
__device__ __forceinline__ void ph_sconv(const Params& p, const bf16* UT, bf16* UC, int tid) {
    const float* cw = p.in[I_CONVHYW]; const float* cbias = p.in[I_CONVHYB];
    const unsigned NIT = 3072u * 32u * 256u; const unsigned gt = blockIdx.x * NTHR + tid, NG = gridDim.x * NTHR;
#pragma unroll 1
    for (unsigned it = gt; it < NIT; it += NG) {
        const unsigned c = it >> 13, k = it & 255u; const size_t base = (size_t)it * 8;
        const v4u w = *(const v4u*)(UT + base);
        const float w0 = cw[c], w1 = cw[3072 + c], w2 = cw[6144 + c], bb = cbias[c];
        float x[10];
        x[0] = k > 0 ? bf1(UT[base - 1]) : 0.f; x[9] = k < 255 ? bf1(UT[base + 8]) : 0.f;
        x[1] = bf_lo(w.x); x[2] = bf_hi(w.x); x[3] = bf_lo(w.y); x[4] = bf_hi(w.y); x[5] = bf_lo(w.z); x[6] = bf_hi(w.z); x[7] = bf_lo(w.w); x[8] = bf_hi(w.w);
        float o[8];
#pragma unroll
        for (int j = 0; j < 8; ++j) o[j] = bb + w0 * x[j] + w1 * x[j + 1] + w2 * x[j + 2];
        v4u r; r.x = pk2(o[0], o[1]); r.y = pk2(o[2], o[3]); r.z = pk2(o[4], o[5]); r.w = pk2(o[6], o[7]);
        *(v4u*)(UC + base) = r;
    }
}
constexpr int LC_CPB = 8224, LC_VBP = 1040, LC_VB0 = 8 * LC_CPB, LC_VBSZ = 32 * LC_VBP;
__device__ __forceinline__ void lconv_unit(const bf16* v, const bf16* F, const bf16* xg, float fb, bf16* out, LAS unsigned char* lds, int tid, int lane, int wave) {
    __syncthreads();
#pragma unroll 1
    for (int idx = tid; idx < 8 * 2056; idx += NTHR) { const int a = idx / 2056, m = (idx % 2056) * 2; const int x0 = 3079 - m - a, x1 = x0 - 1;
        const unsigned lo = (x0 >= 0 && x0 <= 2047) ? (unsigned)F[x0] : 0u, hi = (x1 >= 0 && x1 <= 2047) ? (unsigned)F[x1] : 0u;
        *(LAS unsigned*)(lds + a * LC_CPB + m * 2) = lo | (hi << 16); }
    const int r = lane & 31, h = lane >> 5, a = (7 - r) & 7;
    const LAS unsigned char* cpA = lds + a * LC_CPB + 2 * (1023 - r + 8 * h - a + 1032) - 512 * wave;
    const int laneB = r * LC_VBP + 16 * h;
#define LC_DMA(ch, buf) do { _Pragma("unroll") for (int q = 0; q < 4; ++q) { const int row = wave * 4 + q; \
        __builtin_amdgcn_global_load_lds((const unsigned*)(v + (size_t)row * 2048 + (ch) * 512 + lane * 8), (LAS unsigned*)(lds + LC_VB0 + (buf) * LC_VBSZ + row * LC_VBP), 16, 0, 0); } } while (0)
    LC_DMA(0, 0);
    asm volatile("s_waitcnt vmcnt(0)" ::: "memory");
    __syncthreads();
    f32x16 acc[8];
#pragma unroll
    for (int i = 0; i < 8; ++i)
#pragma unroll
        for (int q = 0; q < 16; ++q) acc[i][q] = 0.f;
    bf16x8 E[8], O[8];
#pragma unroll
    for (int i = 1; i < 8; ++i) { E[(8 - i) & 7] = *(const LAS bf16x8*)(cpA + 32 * (-2 * i)); O[(8 - i) & 7] = *(const LAS bf16x8*)(cpA + 32 * (-2 * i + 1)); }
#pragma unroll 1
    for (int ch = 0; ch < 4; ++ch) {
        if (ch < 3) LC_DMA(ch + 1, (ch + 1) & 1);
        const LAS unsigned char* vb = lds + LC_VB0 + (ch & 1) * LC_VBSZ + laneB;
#pragma unroll 1
        for (int half = 0; half < 2; ++half) {
            const LAS unsigned char* ca = cpA + 64 * (ch * 16 + half * 8); const LAS unsigned char* vbh = vb + 64 * (half * 8);
#pragma unroll
            for (int mm = 0; mm < 8; ++mm) {
                E[mm] = *(const LAS bf16x8*)(ca + 64 * mm); O[mm] = *(const LAS bf16x8*)(ca + 64 * mm + 32);
                const bf16x8 b0 = *(const LAS bf16x8*)(vbh + 64 * mm), b1 = *(const LAS bf16x8*)(vbh + 64 * mm + 32);
#pragma unroll
                for (int i = 0; i < 8; ++i) { acc[i] = __builtin_amdgcn_mfma_f32_32x32x16_bf16(E[(mm - i) & 7], b0, acc[i], 0, 0, 0);
                                              acc[i] = __builtin_amdgcn_mfma_f32_32x32x16_bf16(O[(mm - i) & 7], b1, acc[i], 0, 0, 0); }
            }
        }
        asm volatile("s_waitcnt vmcnt(0)" ::: "memory");
        __syncthreads();
    }
#undef LC_DMA
#pragma unroll
    for (int i = 0; i < 8; ++i)
#pragma unroll
        for (int g = 0; g < 4; ++g) { const size_t off = (size_t)r * 2048 + 256 * wave + 32 * i + 8 * g + 4 * h;
            const v2u vv = *(const v2u*)(v + off), xx = *(const v2u*)(xg + off);
            const float o0 = bf_lo(xx.x) * (acc[i][4 * g + 0] + bf_lo(vv.x) * fb), o1 = bf_hi(xx.x) * (acc[i][4 * g + 1] + bf_hi(vv.x) * fb);
            const float o2 = bf_lo(xx.y) * (acc[i][4 * g + 2] + bf_lo(vv.y) * fb), o3 = bf_hi(xx.y) * (acc[i][4 * g + 3] + bf_hi(vv.y) * fb);
            v2u w; w.x = pk2(o0, o1); w.y = pk2(o2, o3); *(v2u*)(out + off) = w; }
}
__device__ __forceinline__ void ph_lconv(const Params& p, int o, const bf16* IN, const bf16* UC, bf16* OUT, LAS unsigned char* lds, int tid, int lane, int wave) {
    const bf16* FILT = (const bf16*)(p.ws + WS_FILT);
#pragma unroll 1
    for (int c = blockIdx.x; c < 1024; c += gridDim.x)
        lconv_unit(IN + (size_t)c * T, FILT + (size_t)(o * 1024 + c) * 2048, UC + (size_t)((1 + o) * 1024 + c) * T, p.in[I_FBIAS][o * 1024 + c], OUT + (size_t)c * T, lds, tid, lane, wave);
}
__device__ __forceinline__ void ph_transpose(const bf16* Y2T, bf16* Y2, LAS unsigned char* lds, int lane, int wave) {
    LAS unsigned char* tl = lds + wave * 16384;
    const int gw = blockIdx.x * NWAVES + wave, NGW = gridDim.x * NWAVES;
#pragma unroll 1
    for (int tile = gw; tile < 16 * 1024; tile += NGW) { const int c0 = (tile & 15) * 64, t0 = (tile >> 4) * 64;
#pragma unroll
        for (int rr = 0; rr < 8; ++rr) { const int row = rr * 8 + (lane >> 3), pc = lane & 7;
            *(LAS v4u*)(tl + row * 144 + pc * 16) = *(const v4u*)(Y2T + (size_t)(c0 + row) * T + t0 + pc * 8); }
        LDS_WAIT(); asm volatile("" ::: "memory");
#pragma unroll
        for (int rr = 0; rr < 8; ++rr) { const int tk = rr * 8 + (lane >> 3), cp = (lane & 7) * 8;
            unsigned short e[8];
#pragma unroll
            for (int j = 0; j < 8; ++j) e[j] = *(const LAS unsigned short*)(tl + (cp + j) * 144 + tk * 2);
            v4u w; w.x = e[0] | ((unsigned)e[1] << 16); w.y = e[2] | ((unsigned)e[3] << 16); w.z = e[4] | ((unsigned)e[5] << 16); w.w = e[6] | ((unsigned)e[7] << 16);
            *(v4u*)(Y2 + (size_t)(t0 + tk) * D + c0 + cp) = w; }
        LDS_WAIT(); asm volatile("" ::: "memory");
    }
}

constexpr float QSCALE = 0.125f * 1.4426950408889634f;
struct InprojSched { int G, c;
    __device__ __forceinline__ bool next(int i, Unit& u) const { const int L = i * G + c; if (L >= 3840 + 288) return false;
        if (L < 3840) { u.pm = L / 15; u.pn = L % 15; } else { const int q = L - 3840; u.pm = 256 + q / 9; u.pn = 6 + q % 9; } return true; }
    __device__ __forceinline__ int arow(int r) const { return r; } };
struct EpiInproj { static constexpr bool PERM = true; unsigned char* big; const float* rope; float* gates; const float* gate_b;
    __device__ __forceinline__ void operator()(const f32x4 (&acc)[2][2][4][2], const Unit& u, int wr, int wc, int fr, int fq) const {
        const bool ctx = u.pm >= 256; const int b = ctx ? u.pm - 256 : (u.pm >> 3), r0 = ctx ? 0 : (u.pm & 7) * 256;
        if (u.pn == 14) {
            if (wc != 0 || fq >= 2) return;
            const f32x4 gb0 = *(const f32x4*)(gate_b + 8 * fq), gb1 = *(const f32x4*)(gate_b + 8 * fq + 4);
#pragma unroll
            for (int ai = 0; ai < 2; ++ai)
#pragma unroll
                for (int m = 0; m < 4; ++m) { const int rr = r0 + wr * 64 + fr + ai * HALF + m * 16; const size_t grow = ctx ? (size_t)T + b * LC + rr : (size_t)b * SEQ + rr;
                    float* gp = gates + grow * 16 + 8 * fq; *(f32x4*)gp = acc[ai][0][m][0] + gb0; *(f32x4*)(gp + 4) = acc[ai][0][m][1] + gb1; }
            return; }
        const int t = u.pn >> 1;
        constexpr size_t offs[7] = {A0_QA, A0_BQ, A0_BO, A0_KA, A0_VA, A0_BK, A0_BV};
        const bool kv = t >= 3;
        size_t toff = A0_QA;
#pragma unroll
        for (int q = 0; q < 7; ++q) if (t == q) toff = offs[q];
        bf16* O = (bf16*)(big + toff) + (size_t)b * (kv ? (SEQ + LC) : SEQ) * 512 + (size_t)((kv && !ctx) ? LC : 0) * 512;
        const bool rope_on = (t == 0 || t == 3) && !ctx; const float qs = t == 0 ? QSCALE : 1.f;
        const int col0 = (u.pn & 1) * 256 + wc * 32 + 8 * fq;
#pragma unroll
        for (int ai = 0; ai < 2; ++ai)
#pragma unroll
            for (int m = 0; m < 4; ++m) { const int rr = r0 + wr * 64 + fr + ai * HALF + m * 16; bf16* rowp = O + (size_t)rr * 512 + col0;
                f32x4 cs0 = (f32x4){1.f, 0.f, 1.f, 0.f}, cs1 = cs0;
                if (rope_on) { const int pos = (wc & 1) ? (rr & 63) : (rr >> 6); const float* rp = rope + (size_t)(pos * 16 + 4 * fq) * 2; cs0 = *(const f32x4*)rp; cs1 = *(const f32x4*)(rp + 4); }
#pragma unroll
                for (int bj = 0; bj < 2; ++bj) { const f32x4 x0 = acc[ai][bj][m][0], x1 = acc[ai][bj][m][1];
                    f32x4 o0, o1;
                    o0[0] = x0[0] * cs0[0] - x1[0] * cs0[1]; o1[0] = x1[0] * cs0[0] + x0[0] * cs0[1];
                    o0[1] = x0[1] * cs0[2] - x1[1] * cs0[3]; o1[1] = x1[1] * cs0[2] + x0[1] * cs0[3];
                    o0[2] = x0[2] * cs1[0] - x1[2] * cs1[1]; o1[2] = x1[2] * cs1[0] + x0[2] * cs1[1];
                    o0[3] = x0[3] * cs1[2] - x1[3] * cs1[3]; o1[3] = x1[3] * cs1[2] + x0[3] * cs1[3];
                    o0 = o0 * qs; o1 = o1 * qs;
                    u32x4 w; w.x = cvt_pk_bf16(o0[0], o0[1]); w.y = cvt_pk_bf16(o0[2], o0[3]); w.z = cvt_pk_bf16(o1[0], o1[1]); w.w = cvt_pk_bf16(o1[2], o1[3]);
                    *(u32x4*)(rowp + bj * HALF) = w; } }
    } };
__device__ __forceinline__ void ph_transpose_b(const bf16* src, bf16* dst, int NBt, int R, int C, LAS unsigned char* lds, int lane, int wave) {
    LAS unsigned char* tl = lds + wave * 16384;
    const int gw = blockIdx.x * NWAVES + wave, NGW = gridDim.x * NWAVES; const int tr = R / 64, tc = C / 64, per = tr * tc;
#pragma unroll 1
    for (int tile = gw; tile < NBt * per; tile += NGW) { const int bt = tile / per, q = tile % per, c0 = (q % tc) * 64, r0 = (q / tc) * 64;
        const bf16* s = src + (size_t)bt * R * C; bf16* d = dst + (size_t)bt * R * C;
#pragma unroll
        for (int rr = 0; rr < 8; ++rr) { const int row = rr * 8 + (lane >> 3), pc = lane & 7;
            *(LAS v4u*)(tl + row * 144 + pc * 16) = *(const v4u*)(s + (size_t)(r0 + row) * C + c0 + pc * 8); }
        LDS_WAIT(); asm volatile("" ::: "memory");
#pragma unroll
        for (int rr = 0; rr < 8; ++rr) { const int cc = rr * 8 + (lane >> 3), rp = (lane & 7) * 8;
            unsigned short e[8];
#pragma unroll
            for (int j = 0; j < 8; ++j) e[j] = *(const LAS unsigned short*)(tl + (rp + j) * 144 + cc * 2);
            v4u w; w.x = e[0] | ((unsigned)e[1] << 16); w.y = e[2] | ((unsigned)e[3] << 16); w.z = e[4] | ((unsigned)e[5] << 16); w.w = e[6] | ((unsigned)e[7] << 16);
            *(v4u*)(d + (size_t)(c0 + cc) * R + r0 + rp) = w; }
        LDS_WAIT(); asm volatile("" ::: "memory");
    }
}

constexpr int AT_KP = 272, AT_VP = 144, AT_KB = 64 * AT_KP, AT_VB = 128 * AT_VP, AT_STAGE = AT_KB + AT_VB;
__device__ __forceinline__ void ph_attn(const Params& p, unsigned char* big, LAS unsigned char* lds, int tid, int lane, int wave) {
    const bf16* QA = (const bf16*)(big + A0_QA); const bf16* KA = (const bf16*)(big + A0_KA); const bf16* VT = (const bf16*)(big + A0_VT); bf16* MIXIN = (bf16*)(big + A0_MIXIN);
    const int comp = wave >> 2, qw = wave & 3, r = lane & 31, hh = lane >> 5;
    float lam; { const float* lv = p.in[I_DLAM]; const float a = wave_sum(lv[lane] * lv[64 + lane]), b2 = wave_sum(lv[128 + lane] * lv[192 + lane]); lam = expf(a) - expf(b2) + 0.2f; }
#pragma unroll 1
    for (int unit = blockIdx.x; unit < 2048; unit += gridDim.x) {
        const int b = unit >> 6, h = (unit >> 4) & 3, qblk = unit & 15, q0 = qblk * 128 + qw * 32;
        const bf16* Kg = KA + (size_t)b * (SEQ + LC) * 512 + h * 128; const bf16* Vg = VT + ((size_t)b * 512 + h * 128) * (SEQ + LC);
        bf16x8 qf[4];
#pragma unroll
        for (int ds = 0; ds < 4; ++ds) qf[ds] = *(const bf16x8*)(QA + ((size_t)b * SEQ + q0 + r) * 512 + h * 128 + comp * 64 + ds * 16 + hh * 8);
        f32x16 oacc[4];
#pragma unroll
        for (int i = 0; i < 4; ++i)
#pragma unroll
            for (int q = 0; q < 16; ++q) oacc[i][q] = 0.f;
        float m_run = -1.0e30f, l_run = 0.f;
        v4u pre[4];
#define AT_LOADG(kt) do { _Pragma("unroll") for (int q = 0; q < 2; ++q) { const int idx = tid + NTHR * q; \
            pre[q] = *(const v4u*)(Kg + (size_t)((kt) * 64 + (idx >> 4)) * 512 + (idx & 15) * 8); \
            pre[2 + q] = *(const v4u*)(Vg + (size_t)(idx >> 3) * (SEQ + LC) + (kt) * 64 + (idx & 7) * 8); } } while (0)
#define AT_STORES(buf) do { _Pragma("unroll") for (int q = 0; q < 2; ++q) { const int idx = tid + NTHR * q; \
            *(LAS v4u*)(lds + (buf) * AT_STAGE + (idx >> 4) * AT_KP + (idx & 15) * 16) = pre[q]; \
            *(LAS v4u*)(lds + (buf) * AT_STAGE + AT_KB + (idx >> 3) * AT_VP + (idx & 7) * 16) = pre[2 + q]; } } while (0)
        __syncthreads();
        AT_LOADG(0); AT_STORES(0);
        __syncthreads();
#pragma unroll 1
        for (int kt = 0; kt < 36; ++kt) {
            if (kt < 35) AT_LOADG(kt + 1);
            const LAS unsigned char* Kt = lds + (kt & 1) * AT_STAGE; const LAS unsigned char* Vt = Kt + AT_KB;
            f32x16 sacc[2];
#pragma unroll
            for (int kb = 0; kb < 2; ++kb) {
#pragma unroll
                for (int q = 0; q < 16; ++q) sacc[kb][q] = 0.f;
#pragma unroll
                for (int ds = 0; ds < 4; ++ds) { const bf16x8 kf = *(const LAS bf16x8*)(Kt + (32 * kb + r) * AT_KP + comp * 128 + ds * 32 + hh * 16);
                    sacc[kb] = __builtin_amdgcn_mfma_f32_32x32x16_bf16(kf, qf[ds], sacc[kb], 0, 0, 0); } }
            float mx = sacc[0][0];
#pragma unroll
            for (int kb = 0; kb < 2; ++kb)
#pragma unroll
                for (int q = 0; q < 16; ++q) mx = fmaxf(mx, sacc[kb][q]);
            mx = fmaxf(mx, __shfl_xor(mx, 32));
            const float m_new = fmaxf(m_run, mx), alpha = exp2f(m_run - m_new); m_run = m_new;
            float ps = 0.f;
#pragma unroll
            for (int kb = 0; kb < 2; ++kb)
#pragma unroll
                for (int q = 0; q < 16; ++q) { const float e = exp2f(sacc[kb][q] - m_new); sacc[kb][q] = e; ps += e; }
            l_run = l_run * alpha + ps;
#pragma unroll
            for (int i = 0; i < 4; ++i) oacc[i] = oacc[i] * alpha;
#pragma unroll
            for (int kb = 0; kb < 2; ++kb)
#pragma unroll
                for (int s = 0; s < 2; ++s) {
                    u32x4 pw; pw.x = cvt_pk_bf16(sacc[kb][8 * s + 0], sacc[kb][8 * s + 1]); pw.y = cvt_pk_bf16(sacc[kb][8 * s + 2], sacc[kb][8 * s + 3]);
                    pw.z = cvt_pk_bf16(sacc[kb][8 * s + 4], sacc[kb][8 * s + 5]); pw.w = cvt_pk_bf16(sacc[kb][8 * s + 6], sacc[kb][8 * s + 7]);
                    const bf16x8 pf = __builtin_bit_cast(bf16x8, pw);
#pragma unroll
                    for (int dvb = 0; dvb < 4; ++dvb) { const LAS unsigned char* vp = Vt + (32 * dvb + r) * AT_VP + (32 * kb + 16 * s + 4 * hh) * 2;
                        const u32x2 lo = *(const LAS u32x2*)vp, hi = *(const LAS u32x2*)(vp + 16);
                        u32x4 vw; vw.x = lo.x; vw.y = lo.y; vw.z = hi.x; vw.w = hi.y;
                        oacc[dvb] = __builtin_amdgcn_mfma_f32_32x32x16_bf16(__builtin_bit_cast(bf16x8, vw), pf, oacc[dvb], 0, 0, 0); } }
            if (kt < 35) AT_STORES((kt + 1) & 1);
            __syncthreads();
        }
#undef AT_LOADG
#undef AT_STORES
        const float lsum = l_run + __shfl_xor(l_run, 32), inv = 1.f / lsum;
        LAS float* X = (LAS float*)lds;
        if (comp == 1) {
#pragma unroll
            for (int dvb = 0; dvb < 4; ++dvb)
#pragma unroll
                for (int q = 0; q < 16; ++q) X[(qw * 64 + dvb * 16 + q) * 64 + lane] = oacc[dvb][q] * inv; }
        __syncthreads();
        if (comp == 0) {
            float ss = 0.f;
#pragma unroll
            for (int dvb = 0; dvb < 4; ++dvb)
#pragma unroll
                for (int q = 0; q < 16; ++q) { const float o = oacc[dvb][q] * inv - lam * X[(qw * 64 + dvb * 16 + q) * 64 + lane]; oacc[dvb][q] = o; ss += o * o; }
            ss += __shfl_xor(ss, 32);
            const float rn = rsqrtf(ss * (1.f / 128.f) + RMS_EPS) * 0.8f;
            const float* ga = p.in[I_HGA] + h * 128; bf16* orow = MIXIN + ((size_t)b * SEQ + q0 + r) * D + h * 128;
#pragma unroll
            for (int dvb = 0; dvb < 4; ++dvb)
#pragma unroll
                for (int g = 0; g < 4; ++g) { const int dv = 32 * dvb + 8 * g + 4 * hh; const f32x4 gg = *(const f32x4*)(ga + dv);
                    v2u w; w.x = pk2(oacc[dvb][4 * g + 0] * rn * gg[0], oacc[dvb][4 * g + 1] * rn * gg[1]); w.y = pk2(oacc[dvb][4 * g + 2] * rn * gg[2], oacc[dvb][4 * g + 3] * rn * gg[3]);
                    *(v2u*)(orow + dv) = w; }
        }
    }
    __syncthreads();
}

constexpr int ML_P = 272, ML_TILE = 64 * ML_P;
constexpr int ML_VOFF = 3 * ML_TILE, ML_VSZ = 64 * 256;
constexpr int ML_RQ = ML_VOFF + 2 * ML_VSZ, ML_RSZ = 68 * 256, ML_RK = ML_RQ + ML_RSZ;
constexpr int ML_NOFF = ML_RK + ML_RSZ, ML_AOFF = ML_NOFF + 2 * 512;
static_assert(ML_AOFF + 8 * 256 <= LDS_TAB, "mLSTM LDS map");
typedef short s16x4 __attribute__((ext_vector_type(4)));
__device__ __forceinline__ u32x2 tr16(const LAS unsigned char* p) { return __builtin_bit_cast(u32x2, __builtin_amdgcn_ds_read_tr16_b64_v4i16((LAS s16x4*)p)); }
__device__ __forceinline__ float logsigmoidf_(float x) { return x >= 0.f ? -__logf(1.f + __expf(-x)) : x - __logf(1.f + __expf(x)); }
__device__ __forceinline__ bf16x8 pack8(const f32x16& v, int s) { u32x4 w; w.x = cvt_pk_bf16(v[8 * s + 0], v[8 * s + 1]); w.y = cvt_pk_bf16(v[8 * s + 2], v[8 * s + 3]); w.z = cvt_pk_bf16(v[8 * s + 4], v[8 * s + 5]); w.w = cvt_pk_bf16(v[8 * s + 6], v[8 * s + 7]); return __builtin_bit_cast(bf16x8, w); }
__device__ __forceinline__ void ph_mlstm(const Params& p, unsigned char* big, LAS unsigned char* lds, int tid, int lane, int wave) {
    const int bid = blockIdx.x; if (bid >= 256) return;
    const int b = bid >> 3, h = (bid >> 1) & 3, dir = bid & 1;
    const bf16* BQ = (const bf16*)(big + A0_BQ) + (size_t)b * SEQ * 512 + h * 128;
    const bf16* BK = (const bf16*)(big + A0_BK) + (size_t)b * (SEQ + LC) * 512 + h * 128;
    const bf16* BV = (const bf16*)(big + A0_BV) + (size_t)b * (SEQ + LC) * 512 + h * 128;
    bf16* HB = (bf16*)(big + A0_HB) + (size_t)dir * T * 512 + (size_t)b * SEQ * 512 + h * 128;
    const float* GT = (const float*)(p.ws + WS_GATES);
    const float* cw = p.in[I_CONVABW]; const float* cb = p.in[I_CONVABB];
    const int eb = wave & 3, tb = wave >> 2, r = lane & 31, hh = lane >> 5;
    const int blk = (lane >> 4) & 1, tq = (lane & 15) >> 2, tp = lane & 3;
    LAS float* nbuf = (LAS float*)(lds + ML_NOFF); LAS float* aw = (LAS float*)(lds + ML_AOFF) + wave * 64;
    if (tid < 256) nbuf[tid] = 0.f;
    f32x16 cacc[4];
#pragma unroll
    for (int i = 0; i < 4; ++i)
#pragma unroll
        for (int q = 0; q < 16; ++q) cacc[i][q] = 0.f;
    float m_state = 0.f;
    float a_c = 0.f, M_c = 0.f, b_c = 0.f, decay_c = 1.f, m_after = 0.f;
    float a_n = 0.f, M_n = 0.f, b_n = 0.f, w_n = 0.f, decay_n = 1.f, m_next = 0.f;
#define ML_POS(cc, t) ((cc) < 4 ? (dir ? 255 - ((cc) * 64 + (t)) : (cc) * 64 + (t)) : (dir ? 2047 - (((cc) - 4) * 64 + (t)) : ((cc) - 4) * 64 + (t)))
#define ML_GLOAD(cc, li_, fp_) do { const int pos_ = ML_POS(cc, lane); const size_t grow_ = (cc) < 4 ? (size_t)T + b * LC + pos_ : (size_t)b * SEQ + pos_; \
        li_ = GT[grow_ * 16 + dir * 8 + h]; fp_ = GT[grow_ * 16 + dir * 8 + 4 + h]; } while (0)
#define ML_SCAN(li_, fp_, m_in) do { const float lf_ = logsigmoidf_(fp_); \
        float bs_ = lf_; _Pragma("unroll") for (int o_ = 1; o_ < 64; o_ <<= 1) { const float v_ = __shfl_up(bs_, o_); if (lane >= o_) bs_ += v_; } \
        const float aa_ = (li_) - bs_; float pm_ = aa_; _Pragma("unroll") for (int o_ = 1; o_ < 64; o_ <<= 1) { const float v_ = __shfl_up(pm_, o_); if (lane >= o_) pm_ = fmaxf(pm_, v_); } \
        const float MM_ = fmaxf(m_in, pm_); const float M63_ = __shfl(MM_, 63), b63_ = __shfl(bs_, 63); \
        a_n = aa_; M_n = MM_; b_n = bs_; w_n = expf(aa_ - M63_); decay_n = expf((m_in) - M63_); m_next = b63_ + M63_; } while (0)
#define ML_DMA(cc, vbuf) do { const int lim_ = (cc) < 4 ? LC : SEQ, kvb_ = (cc) < 4 ? 0 : LC; \
        _Pragma("unroll 1") for (int ins_ = wave; ins_ < 17; ins_ += NWAVES) { const int rr_ = ins_ * 4 + (lane >> 4), pc_ = lane & 15; int pos_ = ML_POS(cc, rr_ - 1); pos_ = pos_ < 0 ? 0 : (pos_ >= lim_ ? lim_ - 1 : pos_); \
            __builtin_amdgcn_global_load_lds((const unsigned*)(BK + (size_t)(kvb_ + pos_) * 512 + pc_ * 8), (LAS unsigned*)(lds + ML_RK + ins_ * 1024), 16, 0, 0); \
            if ((cc) >= 4) __builtin_amdgcn_global_load_lds((const unsigned*)(BQ + (size_t)pos_ * 512 + pc_ * 8), (LAS unsigned*)(lds + ML_RQ + ins_ * 1024), 16, 0, 0); } \
        _Pragma("unroll") for (int q_ = 0; q_ < 2; ++q_) { const int ins_ = wave * 2 + q_, t_ = ins_ * 4 + (lane >> 4), pc_ = lane & 15; const int pos_ = ML_POS(cc, t_); \
            __builtin_amdgcn_global_load_lds((const unsigned*)(BV + (size_t)(kvb_ + pos_) * 512 + pc_ * 8), (LAS unsigned*)(lds + ML_VOFF + (vbuf) * ML_VSZ + ins_ * 1024), 16, 0, 0); } } while (0)
#define ML_CONV8(dst, rawoff, cc, t_, d8_, ch0, scl) do { const int pos_ = ML_POS(cc, t_), lim_ = (cc) < 4 ? LC : SEQ; const int rm_ = dir ? (t_) + 2 : (t_), rp_ = dir ? (t_) : (t_) + 2; \
        v4u x_[3]; x_[0] = *(const LAS v4u*)(lds + (rawoff) + rm_ * 256 + (d8_) * 16); x_[1] = *(const LAS v4u*)(lds + (rawoff) + ((t_) + 1) * 256 + (d8_) * 16); x_[2] = *(const LAS v4u*)(lds + (rawoff) + rp_ * 256 + (d8_) * 16); \
        if (pos_ - 1 < 0) x_[0] = (v4u){0u, 0u, 0u, 0u}; if (pos_ + 1 >= lim_) x_[2] = (v4u){0u, 0u, 0u, 0u}; \
        _Pragma("unroll") for (int e_ = 0; e_ < 8; ++e_) { float s_ = cb[(ch0) + e_]; \
            _Pragma("unroll") for (int j_ = 0; j_ < 3; ++j_) { const unsigned w_ = e_ < 2 ? x_[j_].x : e_ < 4 ? x_[j_].y : e_ < 6 ? x_[j_].z : x_[j_].w; s_ += cw[j_ * 1024 + (ch0) + e_] * ((e_ & 1) ? bf_hi(w_) : bf_lo(w_)); } \
            dst[e_] = siluf_(s_) * (scl); } } while (0)
#define ML_BUILD(cc) do { _Pragma("unroll 1") for (int q_ = 0; q_ < 2; ++q_) { const int idx_ = tid + NTHR * q_, t_ = idx_ >> 4, d8_ = idx_ & 15; \
        float kk_[8]; ML_CONV8(kk_, ML_RK, cc, t_, d8_, 512 + h * 128 + d8_ * 8, 1.f); const float wt_ = __shfl(w_n, t_); \
        v4u o_; o_.x = pk2(kk_[0], kk_[1]); o_.y = pk2(kk_[2], kk_[3]); o_.z = pk2(kk_[4], kk_[5]); o_.w = pk2(kk_[6], kk_[7]); *(LAS v4u*)(lds + ML_TILE + t_ * ML_P + d8_ * 16) = o_; \
        o_.x = pk2(kk_[0] * wt_, kk_[1] * wt_); o_.y = pk2(kk_[2] * wt_, kk_[3] * wt_); o_.z = pk2(kk_[4] * wt_, kk_[5] * wt_); o_.w = pk2(kk_[6] * wt_, kk_[7] * wt_); *(LAS v4u*)(lds + 2 * ML_TILE + t_ * ML_P + d8_ * 16) = o_; \
        if ((cc) >= 4) { float qq_[8]; ML_CONV8(qq_, ML_RQ, cc, t_, d8_, h * 128 + d8_ * 8, 0.08838834764831845f); \
            o_.x = pk2(qq_[0], qq_[1]); o_.y = pk2(qq_[2], qq_[3]); o_.z = pk2(qq_[4], qq_[5]); o_.w = pk2(qq_[6], qq_[7]); *(LAS v4u*)(lds + t_ * ML_P + d8_ * 16) = o_; } } } while (0)
    __syncthreads();
    { float li0, fp0; ML_GLOAD(0, li0, fp0); ML_DMA(0, 0); ML_SCAN(li0, fp0, m_state); }
    asm volatile("s_waitcnt vmcnt(0)" ::: "memory");
    __syncthreads();
    ML_BUILD(0);
    a_c = a_n; M_c = M_n; b_c = b_n; decay_c = decay_n; m_after = m_next;
    __syncthreads();
#pragma unroll 1
    for (int cc = 0; cc < 36; ++cc) {
        const LAS unsigned char* Qs = lds; const LAS unsigned char* Ks = lds + ML_TILE; const LAS unsigned char* Kw = lds + 2 * ML_TILE; const LAS unsigned char* Vs = lds + ML_VOFF + (cc & 1) * ML_VSZ;
        const LAS float* ncur = nbuf + (cc & 1) * 128; LAS float* nnew = nbuf + ((cc + 1) & 1) * 128;
        float li1 = 0.f, fp1 = 0.f;
        if (cc < 35) { ML_GLOAD(cc + 1, li1, fp1); ML_DMA(cc + 1, (cc + 1) & 1); }
        if (cc >= 4) {
            aw[lane] = a_c;
            const int tcol = 32 * tb + r; const float Mt = __shfl(M_c, tcol), bt = __shfl(b_c, tcol);
            f32x16 nacc;
#pragma unroll
            for (int q = 0; q < 16; ++q) nacc[q] = 0.f;
#pragma unroll
            for (int db = 0; db < 4; ++db)
#pragma unroll
                for (int s2 = 0; s2 < 2; ++s2) { const LAS unsigned char* qp = Qs + tcol * ML_P + (32 * db + 16 * s2 + 4 * hh) * 2; const u32x2 lo = *(const LAS u32x2*)qp, hi = *(const LAS u32x2*)(qp + 16);
                    u32x4 qw; qw.x = lo.x; qw.y = lo.y; qw.z = hi.x; qw.w = hi.y;
                    nacc = __builtin_amdgcn_mfma_f32_32x32x16_bf16(pack8(cacc[db], s2), __builtin_bit_cast(bf16x8, qw), nacc, 0, 0, 0); }
            const float sc = expf(m_state - Mt);
            nacc = nacc * sc;
            float rs = 0.f;
#pragma unroll
            for (int sb = 0; sb < 2; ++sb) if (sb <= tb) {
                f32x16 sacc;
#pragma unroll
                for (int q = 0; q < 16; ++q) sacc[q] = 0.f;
#pragma unroll
                for (int ds = 0; ds < 8; ++ds) { const bf16x8 kf = *(const LAS bf16x8*)(Ks + (32 * sb + r) * ML_P + (16 * ds + 8 * hh) * 2), qf = *(const LAS bf16x8*)(Qs + tcol * ML_P + (16 * ds + 8 * hh) * 2);
                    sacc = __builtin_amdgcn_mfma_f32_32x32x16_bf16(kf, qf, sacc, 0, 0, 0); }
#pragma unroll
                for (int g = 0; g < 4; ++g) { const int s0 = 32 * sb + 8 * g + 4 * hh; const f32x4 av = *(const LAS f32x4*)(aw + s0);
#pragma unroll
                    for (int j = 0; j < 4; ++j) { const bool keep = (s0 + j) <= tcol; const float v = keep ? sacc[4 * g + j] * expf(av[j] - Mt) : 0.f; sacc[4 * g + j] = v; rs += v; } }
#pragma unroll
                for (int s2 = 0; s2 < 2; ++s2) { u32x4 vw;
                    { const u32x2 t0 = tr16(Vs + (32 * sb + 16 * s2 + 4 * hh + tq) * 256 + (32 * eb + 16 * blk + 4 * tp) * 2), t1 = tr16(Vs + (32 * sb + 16 * s2 + 8 + 4 * hh + tq) * 256 + (32 * eb + 16 * blk + 4 * tp) * 2);
                      vw.x = t0.x; vw.y = t0.y; vw.z = t1.x; vw.w = t1.y; }
                    nacc = __builtin_amdgcn_mfma_f32_32x32x16_bf16(__builtin_bit_cast(bf16x8, vw), pack8(sacc, s2), nacc, 0, 0, 0); } }
            rs += __shfl_xor(rs, 32);
            float qn = 0.f;
            { const LAS unsigned char* qp = Qs + tcol * ML_P + (64 * hh) * 2;
#pragma unroll
              for (int c8 = 0; c8 < 8; ++c8) { const v4u w = *(const LAS v4u*)(qp + c8 * 16); const f32x4 n0 = *(const LAS f32x4*)(ncur + 64 * hh + 8 * c8), n1 = *(const LAS f32x4*)(ncur + 64 * hh + 8 * c8 + 4);
                  qn += bf_lo(w.x) * n0[0] + bf_hi(w.x) * n0[1] + bf_lo(w.y) * n0[2] + bf_hi(w.y) * n0[3] + bf_lo(w.z) * n1[0] + bf_hi(w.z) * n1[1] + bf_lo(w.w) * n1[2] + bf_hi(w.w) * n1[3]; } }
            qn += __shfl_xor(qn, 32);
            const float den = sc * qn + rs; const float dd = 1.f / fmaxf(fabsf(den), expf(-(bt + Mt)));
            { const int pos = ML_POS(cc, tcol); bf16* hrow = HB + (size_t)pos * 512 + 32 * eb;
#pragma unroll
              for (int g = 0; g < 4; ++g) { v2u w; w.x = pk2(nacc[4 * g + 0] * dd, nacc[4 * g + 1] * dd); w.y = pk2(nacc[4 * g + 2] * dd, nacc[4 * g + 3] * dd); *(v2u*)(hrow + 8 * g + 4 * hh) = w; } }
        }
#pragma unroll
        for (int db = 0; db < 4; ++db) { cacc[db] = cacc[db] * decay_c;
#pragma unroll
            for (int s4 = 0; s4 < 4; ++s4) { u32x4 ka, vb;
                { const u32x2 t0 = tr16(Kw + (16 * s4 + 8 * hh + tq) * ML_P + (32 * db + 16 * blk + 4 * tp) * 2), t1 = tr16(Kw + (16 * s4 + 8 * hh + 4 + tq) * ML_P + (32 * db + 16 * blk + 4 * tp) * 2);
                  ka.x = t0.x; ka.y = t0.y; ka.z = t1.x; ka.w = t1.y; }
                { const u32x2 t0 = tr16(Vs + (16 * s4 + 8 * hh + tq) * 256 + (32 * eb + 16 * blk + 4 * tp) * 2), t1 = tr16(Vs + (16 * s4 + 8 * hh + 4 + tq) * 256 + (32 * eb + 16 * blk + 4 * tp) * 2);
                  vb.x = t0.x; vb.y = t0.y; vb.z = t1.x; vb.w = t1.y; }
                cacc[db] = __builtin_amdgcn_mfma_f32_32x32x16_bf16(__builtin_bit_cast(bf16x8, ka), __builtin_bit_cast(bf16x8, vb), cacc[db], 0, 0, 0); } }
        if (tid < 128) { float s = 0.f;
#pragma unroll 8
            for (int t = 0; t < 64; ++t) s += bf1(*(const LAS bf16*)(Kw + t * ML_P + tid * 2));
            nnew[tid] = decay_c * ncur[tid] + s; }
        m_state = m_after;
        asm volatile("s_waitcnt vmcnt(0)" ::: "memory");
        __syncthreads();
        if (cc < 35) { ML_SCAN(li1, fp1, m_state); ML_BUILD(cc + 1); a_c = a_n; M_c = M_n; b_c = b_n; decay_c = decay_n; m_after = m_next; }
        __syncthreads();
    }
#undef ML_POS
#undef ML_GLOAD
#undef ML_SCAN
#undef ML_DMA
#undef ML_CONV8
#undef ML_BUILD
}
__device__ __forceinline__ void ph_outb(const Params& p, unsigned char* big, int lane, int wave) {
    const int gw = blockIdx.x * NWAVES + wave, NGW = gridDim.x * NWAVES;
    const bf16* HBf = (const bf16*)(big + A0_HB); const bf16* HBb = HBf + (size_t)T * 512; const bf16* BO = (const bf16*)(big + A0_BO); bf16* MIXIN = (bf16*)(big + A0_MIXIN);
    const float* gb = p.in[I_HGB];
#pragma unroll 1
    for (int m = gw; m < T; m += NGW) {
        const v4u f = *(const v4u*)(HBf + (size_t)m * 512 + lane * 8), bw = *(const v4u*)(HBb + (size_t)m * 512 + lane * 8), go = *(const v4u*)(BO + (size_t)m * 512 + lane * 8);
        float x[8], o[8]; x[0] = bf_lo(f.x) + bf_lo(bw.x); x[1] = bf_hi(f.x) + bf_hi(bw.x); x[2] = bf_lo(f.y) + bf_lo(bw.y); x[3] = bf_hi(f.y) + bf_hi(bw.y);
        x[4] = bf_lo(f.z) + bf_lo(bw.z); x[5] = bf_hi(f.z) + bf_hi(bw.z); x[6] = bf_lo(f.w) + bf_lo(bw.w); x[7] = bf_hi(f.w) + bf_hi(bw.w);
        o[0] = bf_lo(go.x); o[1] = bf_hi(go.x); o[2] = bf_lo(go.y); o[3] = bf_hi(go.y); o[4] = bf_lo(go.z); o[5] = bf_hi(go.z); o[6] = bf_lo(go.w); o[7] = bf_hi(go.w);
        float ss = 0.f;
#pragma unroll
        for (int j = 0; j < 8; ++j) ss += x[j] * x[j];
        ss += __shfl_xor(ss, 1); ss += __shfl_xor(ss, 2); ss += __shfl_xor(ss, 4); ss += __shfl_xor(ss, 8);
        const float rn = rsqrtf(ss * (1.f / 128.f) + RMS_EPS);
        const f32x4 g0 = *(const f32x4*)(gb + lane * 8), g1 = *(const f32x4*)(gb + lane * 8 + 4);
        float y[8];
#pragma unroll
        for (int j = 0; j < 8; ++j) y[j] = x[j] * rn * (j < 4 ? g0[j] : g1[j - 4]) * sigmoidf_(o[j]);
        v4u w; w.x = pk2(y[0], y[1]); w.y = pk2(y[2], y[3]); w.z = pk2(y[4], y[5]); w.w = pk2(y[6], y[7]);
        *(v4u*)(MIXIN + (size_t)m * D + 512 + lane * 8) = w;
    }
}

constexpr int CW_DBG = 16;
#ifndef DBG_MODE
#define DBG_MODE 0
#endif
#ifndef DBG_L
#define DBG_L 0
#endif
#ifndef DBG_CH
#define DBG_CH 0
#endif
__device__ __forceinline__ void dbg_report(const Params& p, float d) {
    if (!(d >= 0.f)) d = 1.0e6f;
    atomicMax((unsigned*)(p.ws + WS_CTL) + CW_DBG, __float_as_uint(d));
}
__device__ __forceinline__ float block_max(float v, LAS float* red, int tid) { v = wave_max(v); __syncthreads(); if ((tid & 63) == 0) red[tid >> 6] = v; __syncthreads(); float r = red[0];
#pragma unroll
    for (int w = 1; w < 8; ++w) r = fmaxf(r, red[w]); __syncthreads(); return r; }
__device__ __forceinline__ float block_sum(float v, LAS float* red, int tid) { v = wave_sum(v); __syncthreads(); if ((tid & 63) == 0) red[tid >> 6] = v; __syncthreads(); float r = 0.f;
#pragma unroll
    for (int w = 0; w < 8; ++w) r += red[w]; __syncthreads(); return r; }
__device__ __forceinline__ void dbg_moe_check(const Params& p, int l, int ch, const bf16* H2, const bf16* Y, LAS unsigned char* lds, int tid) {
    LAS float* hrow = (LAS float*)lds; LAS float* gu = hrow + 1024; LAS float* a = gu + 512; LAS float* red = a + 256;
    const int t = ch * CHT + blockIdx.x * 64 + 5;
    __syncthreads();
    for (int i = tid; i < 1024; i += NTHR) hrow[i] = bf1(H2[(size_t)t * D + i]);
    __syncthreads();
    const int* EIDX = (const int*)(p.ws + WS_EIDX); const float* WTS = (const float*)(p.ws + WS_WTS); const int* PSLOT = (const int*)(p.ws + WS_PSLOT);
    float yacc[2] = {0.f, 0.f};
#pragma unroll 1
    for (int k = 0; k < 9; ++k) {
        const int e = k < 8 ? (EIDX[(size_t)t * 8 + k] & 255) : 64; const float w = k < 8 ? WTS[(size_t)t * 8 + k] : 1.f;
        const float* Wgu = e < 64 ? p.in[I_EGU] + (size_t)(l * 64 + e) * 1024 * 512 : p.in[I_SGU] + (size_t)l * 1024 * 512;
        const float* Wdn = e < 64 ? p.in[I_EDN] + (size_t)(l * 64 + e) * 256 * 1024 : p.in[I_SDN] + (size_t)l * 256 * 1024;
        float s = 0.f;
#pragma unroll 4
        for (int kk = 0; kk < 1024; ++kk) s += hrow[kk] * Wgu[(size_t)kk * 512 + tid];
        gu[tid] = s;
        __syncthreads();
        if (tid < 256) a[tid] = siluf_(gu[tid]) * gu[256 + tid];
        __syncthreads();
#pragma unroll
        for (int q = 0; q < 2; ++q) { const int n = tid + 512 * q; float s2 = 0.f;
#pragma unroll 4
            for (int j = 0; j < 256; ++j) s2 += a[j] * Wdn[(size_t)j * 1024 + n];
            yacc[q] += w * s2; }
        __syncthreads();
    }
    float err = 0.f, ss = 0.f;
#pragma unroll
    for (int q = 0; q < 2; ++q) { const int n = tid + 512 * q; float f = 0.f;
#pragma unroll 1
        for (int k = 0; k < 9; ++k) { const int slot = PSLOT[(size_t)t * 16 + k]; const float w = k < 8 ? WTS[(size_t)t * 8 + k] : 1.f; f += w * bf1(Y[(size_t)slot * D + n]); }
        err = fmaxf(err, fabsf(f - yacc[q])); ss += yacc[q] * yacc[q]; }
    const float me = block_max(err, red, tid), sq = block_sum(ss, red, tid);
    if (tid == 0) dbg_report(p, me / sqrtf(sq * (1.f / 1024.f) + 1e-30f));
}
__device__ __forceinline__ void dbg_route_check(const Params& p, int l, const bf16* H2, const float* LOG, LAS unsigned char* lds, int tid) {
    LAS float* hrow = (LAS float*)lds; LAS float* lg = hrow + 1024; LAS float* bi = lg + 64; LAS float* sc = bi + 64; LAS float* red = sc + 64;
    const int t = blockIdx.x * 256 + 77;
    __syncthreads();
    for (int i = tid; i < 1024; i += NTHR) hrow[i] = bf1(H2[(size_t)t * D + i]);
    __syncthreads();
    if (tid < 64) { float s = 0.f; const float* W = p.in[I_RW] + (size_t)l * 1024 * 64;
#pragma unroll 4
        for (int k = 0; k < 1024; ++k) s += hrow[k] * W[k * 64 + tid];
        lg[tid] = s; sc[tid] = 1.f / (1.f + expf(-s)); bi[tid] = sc[tid] + p.in[I_RB][l * 64 + tid]; }
    __syncthreads();
    if (tid == 0) {
        float lerr = 0.f;
#pragma unroll 1
        for (int e = 0; e < 64; ++e) lerr = fmaxf(lerr, fabsf(lg[e] - LOG[(size_t)t * 64 + e]));
        float grp[8];
#pragma unroll
        for (int g = 0; g < 8; ++g) { float a = -1e30f, b = -1e30f;
#pragma unroll 1
            for (int j = 0; j < 8; ++j) { const float v = bi[g * 8 + j]; if (v > a) { b = a; a = v; } else if (v > b) b = v; } grp[g] = a + b; }
        unsigned gm = 0;
#pragma unroll 1
        for (int r = 0; r < 4; ++r) { int best = -1; float bv = 0.f;
#pragma unroll
            for (int g = 0; g < 8; ++g) if (!((gm >> g) & 1u) && (best < 0 || grp[g] > bv)) { best = g; bv = grp[g]; }
            gm |= 1u << best; }
        unsigned long long set_ref = 0ull; float ssum = 0.f;
#pragma unroll 1
        for (int r = 0; r < 8; ++r) { int best = -1; float bv = 0.f;
#pragma unroll 1
            for (int e = 0; e < 64; ++e) if (((gm >> (e >> 3)) & 1u) && !((set_ref >> e) & 1ull) && (best < 0 || bi[e] > bv)) { best = e; bv = bi[e]; }
            set_ref |= 1ull << best; ssum += sc[best]; }
        const int* EIDX = (const int*)(p.ws + WS_EIDX); const float* WTS = (const float*)(p.ws + WS_WTS);
        unsigned long long set_f = 0ull; float werr = 0.f, wsum = 0.f;
#pragma unroll 1
        for (int k = 0; k < 8; ++k) { const int e = EIDX[(size_t)t * 8 + k] & 255; set_f |= 1ull << e; const float wr = 2.5f * sc[e] / ssum; werr = fmaxf(werr, fabsf(wr - WTS[(size_t)t * 8 + k])); wsum += WTS[(size_t)t * 8 + k]; }
        float d = 0.f;
        if (DBG_MODE == 0) d = (set_f != set_ref) ? (1.f / 256.f) : 0.f;
        if (DBG_MODE == 1) d = (set_f != set_ref) ? 0.f : werr + fabsf(wsum - 2.5f);
        if (DBG_MODE == 2) d = lerr * (1.f / 256.f);
        atomicAdd((float*)((unsigned*)(p.ws + WS_CTL) + CW_DBG), d);
    }
    __syncthreads();
}
__device__ __forceinline__ unsigned dbg_hash(unsigned x) { x ^= x >> 16; x *= 0x7feb352du; x ^= x >> 15; x *= 0x846ca68bu; x ^= x >> 16; return x; }
__device__ __forceinline__ void dbg_report_wave(const Params& p, float d, int lane) { if (lane == 0) dbg_report(p, d); }
__device__ __forceinline__ void dbg_hyena_check(const Params& p, int mode, const bf16* HN, const bf16* UC, const bf16* ZT, const bf16* Y2T, const bf16* MIX, LAS unsigned char* lds, int lane, int wave) {
    const unsigned hsh = dbg_hash(blockIdx.x * 8u + wave + 12345u), h2 = dbg_hash(hsh), h3 = dbg_hash(h2);
    const bf16* FILT = (const bf16*)(p.ws + WS_FILT);
    float d = 0.f;
    if (mode == 0) {
        const int c = hsh % 3072u, b = h2 % 32u, s = h3 % 2048u; float acc = 0.f;
#pragma unroll 1
        for (int k = lane; k < 1024; k += 64) acc += bf1(HN[(size_t)(b * 2048 + s) * D + k]) * p.in[I_WINHY][(size_t)k * 3072 + c];
        acc = wave_sum(acc);
        const float got = bf1(UC[(size_t)c * T + b * 2048 + s]); d = fabsf(got - acc) / (fabsf(acc) + 0.1f);
    } else if (mode == 5) {
        const int c = hsh % 3072u, b = h2 % 32u; int s = h3 % 2048u; if ((h3 >> 20) % 8u == 0u) s = 0; if ((h3 >> 20) % 8u == 1u) s = 2047;
        float val = p.in[I_CONVHYB][c];
#pragma unroll 1
        for (int j = 0; j < 3; ++j) { const int sj = s + j - 1; if (sj < 0 || sj > 2047) continue; val += p.in[I_CONVHYW][j * 3072 + c] * bf1(ZT[(size_t)c * T + b * 2048 + sj]); }
        const float got = bf1(UC[(size_t)c * T + b * 2048 + s]); d = fabsf(got - val) / (fabsf(val) + 0.1f);
    } else if (mode == 1) {
        LAS float* Z = (LAS float*)(lds + wave * 1024); LAS float* A1 = Z + 64; LAS float* A2 = A1 + 64;
        const int o = hsh & 1u, c = h2 % 1024u, j = h3 % 2048u;
        float z = 0.f; if (lane == 0) z = (float)j / 2047.f; else if (lane < 33) { const int k = (lane - 1) & 15; const float fr = 1e-4f + (float)k * ((15.f - 1e-4f) / 15.f); const float ang = (6.283185307179586f / 2048.f) * (float)j * fr; z = lane < 17 ? cosf(ang) : -sinf(ang); }
        Z[lane] = z; LDS_WAIT(); asm volatile("" ::: "memory");
        float a = p.in[I_FB1][lane];
#pragma unroll 1
        for (int k = 0; k < 33; ++k) a += Z[k] * p.in[I_FW1][k * 64 + lane];
        A1[lane] = sinf(a); LDS_WAIT(); asm volatile("" ::: "memory");
        a = p.in[I_FB2][lane];
#pragma unroll 1
        for (int k = 0; k < 64; ++k) a += A1[k] * p.in[I_FW2][k * 64 + lane];
        A2[lane] = sinf(a); LDS_WAIT(); asm volatile("" ::: "memory");
        float v = wave_sum(A2[lane] * p.in[I_FW3][lane * 2048 + o * 1024 + c]);
        const float mind = -4.605170185988091f / 1.5f, maxd = -4.605170185988091f / 0.3f; const float delta = fabsf(mind + (float)c * ((maxd - mind) / 1023.f));
        v *= expf(-fabsf((float)j - 1024.f) / 1024.f * delta);
        const float got = bf1(FILT[(size_t)(o * 1024 + c) * 2048 + j]); d = fabsf(got - v) / (fabsf(v) + 1e-4f);
    } else if (mode == 2 || mode == 3) {
        const int o = mode - 2, c = hsh % 1024u, b = h2 % 32u; int t = h3 % 2048u; if ((h3 >> 20) % 8u == 0u) t = 0; if ((h3 >> 20) % 8u == 1u) t = 2047;
        const bf16* in = (o == 0 ? UC : ZT) + (size_t)c * T + b * 2048; const bf16* f = FILT + (size_t)(o * 1024 + c) * 2048; float acc = 0.f;
#pragma unroll 1
        for (int s = lane; s < 2048; s += 64) { const int x = 1024 + t - s; if (x >= 0 && x <= 2047) acc += bf1(f[x]) * bf1(in[s]); }
        acc = wave_sum(acc);
        const float gate = bf1(UC[(size_t)((1 + o) * 1024 + c) * T + b * 2048 + t]);
        const float val = gate * (acc + bf1(in[t]) * p.in[I_FBIAS][o * 1024 + c]);
        const float got = bf1((o == 0 ? ZT : Y2T)[(size_t)c * T + b * 2048 + t]); d = fabsf(got - val) / (fabsf(val) + 0.1f);
    } else if (mode == 4) {
        const int tok = hsh % 65536u, n = h2 % 1024u; float acc = 0.f;
#pragma unroll 1
        for (int c = lane; c < 1024; c += 64) acc += bf1(Y2T[(size_t)c * T + tok]) * p.in[I_WOUTHY][(size_t)c * 1024 + n];
        acc = wave_sum(acc);
        const float got = bf1(MIX[(size_t)tok * D + n]); d = fabsf(got - acc) / (fabsf(acc) + 0.1f);
    }
    dbg_report_wave(p, d, lane);
}
__device__ __forceinline__ void dbg_inproj_check(const Params& p, unsigned char* big, int lane, int wave) {
    const unsigned hsh = dbg_hash(blockIdx.x * 8u + wave + 777u), h2 = dbg_hash(hsh);
    const bf16* H0 = (const bf16*)(big + A0_H); const float* W = p.in[I_WINAB];
    int m = hsh % (unsigned)TT; int n = h2 % 3600u;
    const bool ctx = m >= T; if (ctx && n < 1536) n += 1536;
    const int b = ctx ? (m - T) / LC : m / SEQ, s = ctx ? (m - T) % LC : m % SEQ;
    float x = 0.f, xp = 0.f; const bool rope_col = (n < 512) || (n >= 1536 && n < 2048); const int np = rope_col ? (n ^ 16) : n;
#pragma unroll 1
    for (int k = lane; k < 1024; k += 64) { const float hv = bf1(H0[(size_t)m * D + k]); x += hv * W[(size_t)k * 3600 + n]; xp += hv * W[(size_t)k * 3600 + np]; }
    x = wave_sum(x); xp = wave_sum(xp);
    float val = x, got = 0.f;
    if (n >= 3584) { val = x + p.in[I_GATEB][n - 3584]; got = ((const float*)(p.ws + WS_GATES))[(size_t)m * 16 + (n - 3584)]; }
    else { const int t = n / 512, cn = n % 512; int pc = cn;
        if (rope_col) { const int o = cn & 31; pc = (cn & ~31) + (((o & 15) >> 2) * 8 + (o >> 4) * 4 + (o & 3));
            if (!ctx) { const int d = cn & 63, axis = d >> 5, half = (d >> 4) & 1, i = d & 15; const float pos = (float)(axis == 0 ? (s >> 6) : (s & 63)); const float ang = pos * powf(10000.f, -(float)i / 16.f);
                val = half == 0 ? x * cosf(ang) - xp * sinf(ang) : x * cosf(ang) + xp * sinf(ang); } }
        if (t == 0) val *= QSCALE;
        const size_t offs[7] = {A0_QA, A0_BQ, A0_BO, A0_KA, A0_VA, A0_BK, A0_BV}; const bool kv = t >= 3;
        const bf16* O = (const bf16*)(big + offs[t]) + (size_t)b * (kv ? (SEQ + LC) : SEQ) * 512 + (size_t)((kv && !ctx) ? LC : 0) * 512;
        got = bf1(O[(size_t)s * 512 + pc]); }
    dbg_report_wave(p, fabsf(got - val) / (fabsf(val) + 0.1f), lane);
}
__device__ __forceinline__ void dbg_attn_check(const Params& p, unsigned char* big, LAS unsigned char* lds, int lane, int wave) {
    const unsigned hsh = dbg_hash(blockIdx.x * 8u + wave + 4242u), h2 = dbg_hash(hsh);
    const int b = hsh % 32u, h = (hsh >> 8) % 4u, q = h2 % 2048u;
    const bf16* QA = (const bf16*)(big + A0_QA) + ((size_t)b * SEQ + q) * 512 + h * 128; const bf16* KA = (const bf16*)(big + A0_KA) + (size_t)b * 2304 * 512 + h * 128;
    const bf16* VA = (const bf16*)(big + A0_VA) + (size_t)b * 2304 * 512 + h * 128; const bf16* MIXIN = (const bf16*)(big + A0_MIXIN) + ((size_t)b * SEQ + q) * D + h * 128;
    LAS float* Aw = (LAS float*)(lds + wave * 18432);
    const float* lv = p.in[I_DLAM]; const float lam = expf(wave_sum(lv[lane] * lv[64 + lane])) - expf(wave_sum(lv[128 + lane] * lv[192 + lane])) + 0.2f;
    float mx0 = -1e30f, mx1 = -1e30f;
#pragma unroll 1
    for (int key = lane; key < 2304; key += 64) { float s0 = 0.f, s1 = 0.f;
#pragma unroll 1
        for (int d = 0; d < 64; ++d) { s0 += bf1(QA[d]) * bf1(KA[(size_t)key * 512 + d]); s1 += bf1(QA[64 + d]) * bf1(KA[(size_t)key * 512 + 64 + d]); }
        Aw[key] = s0; Aw[2304 + key] = s1; mx0 = fmaxf(mx0, s0); mx1 = fmaxf(mx1, s1); }
    mx0 = wave_max(mx0); mx1 = wave_max(mx1);
    float l0 = 0.f, l1 = 0.f;
#pragma unroll 1
    for (int key = lane; key < 2304; key += 64) { const float e0 = exp2f(Aw[key] - mx0), e1 = exp2f(Aw[2304 + key] - mx1); Aw[key] = e0; Aw[2304 + key] = e1; l0 += e0; l1 += e1; }
    l0 = wave_sum(l0); l1 = wave_sum(l1);
    LDS_WAIT(); asm volatile("" ::: "memory");
    float o[2] = {0.f, 0.f};
#pragma unroll 1
    for (int key = 0; key < 2304; ++key) { const float a = Aw[key] / l0 - lam * Aw[2304 + key] / l1; o[0] += a * bf1(VA[(size_t)key * 512 + lane]); o[1] += a * bf1(VA[(size_t)key * 512 + 64 + lane]); }
    const float ms = wave_sum(o[0] * o[0] + o[1] * o[1]) * (1.f / 128.f); const float rn = rsqrtf(ms + RMS_EPS) * 0.8f;
    float err = 0.f, sc = 0.f;
#pragma unroll
    for (int j = 0; j < 2; ++j) { const float val = o[j] * rn * p.in[I_HGA][h * 128 + 64 * j + lane]; err = fmaxf(err, fabsf(val - bf1(MIXIN[64 * j + lane]))); sc += val * val; }
    err = wave_max(err); sc = sqrtf(wave_sum(sc) * (1.f / 128.f));
    dbg_report_wave(p, err / (sc + 1e-3f), lane);
}
__device__ __forceinline__ float dbg_convsilu(const bf16* base, int pos, int lim, int ch, int d, const float* cw, const float* cb) {
    float s = cb[ch];
#pragma unroll
    for (int j = 0; j < 3; ++j) { const int pj = pos + j - 1; if (pj >= 0 && pj < lim) s += cw[j * 1024 + ch] * bf1(base[(size_t)pj * 512 + d]); }
    return s / (1.f + expf(-s));
}
__device__ __forceinline__ void dbg_mlstm_check(const Params& p, unsigned char* big, LAS unsigned char* lds, int lane, int wave) {
    const unsigned hsh = dbg_hash(blockIdx.x * 8u + wave + 991u), h2 = dbg_hash(hsh);
    const int b = hsh % 32u, h = (hsh >> 8) % 4u, dir = (hsh >> 12) & 1; int tau = h2 % 2048u; if ((h2 >> 16) % 4u == 0u) tau = (h2 >> 20) % 130u;
    const bf16* BQ = (const bf16*)(big + A0_BQ) + (size_t)b * SEQ * 512 + h * 128; const bf16* BK = (const bf16*)(big + A0_BK) + (size_t)b * (SEQ + LC) * 512 + h * 128;
    const bf16* BV = (const bf16*)(big + A0_BV) + (size_t)b * (SEQ + LC) * 512 + h * 128;
    const float* GT = (const float*)(p.ws + WS_GATES); const float* cw = p.in[I_CONVABW]; const float* cb = p.in[I_CONVABB];
    LAS float* F = (LAS float*)(lds + wave * 18432); LAS float* qv = F + 2304 + 64;
    const int N = 256 + tau + 1;
#define DBG_POS(u) ((u) < 256 ? (dir ? 255 - (u) : (u)) : (dir ? 2047 - ((u) - 256) : (u) - 256))
#define DBG_GROW(u) ((u) < 256 ? (size_t)T + b * LC + DBG_POS(u) : (size_t)b * SEQ + DBG_POS(u))
    float carry = 0.f;
#pragma unroll 1
    for (int u0 = 0; u0 < N; u0 += 64) { const int u = u0 + lane; float lf = 0.f;
        if (u < N) { const float x = GT[DBG_GROW(u) * 16 + dir * 8 + 4 + h]; lf = x >= 0.f ? -__logf(1.f + __expf(-x)) : x - __logf(1.f + __expf(x)); }
        float s = lf;
#pragma unroll
        for (int o = 1; o < 64; o <<= 1) { const float v = __shfl_up(s, o); if (lane >= o) s += v; }
        if (u < N) F[u] = carry + s; carry += __shfl(s, 63); }
    LDS_WAIT(); asm volatile("" ::: "memory");
    const float Ft = F[N - 1];
    float mm = Ft;
#pragma unroll 1
    for (int u = lane; u < N; u += 64) mm = fmaxf(mm, Ft - F[u] + GT[DBG_GROW(u) * 16 + dir * 8 + h]);
    mm = wave_max(mm);
    { const int pos = DBG_POS(N - 1);
      for (int d = lane; d < 128; d += 64) qv[d] = dbg_convsilu(BQ, pos, SEQ, h * 128 + d, d, cw, cb) * 0.08838834764831845f; }
    LDS_WAIT(); asm volatile("" ::: "memory");
    float den = 0.f;
#pragma unroll 1
    for (int u = lane; u < N; u += 64) { const bool ctx = u < 256; const int pos = DBG_POS(u); const bf16* kb = ctx ? BK : BK + (size_t)LC * 512; float qk = 0.f;
#pragma unroll 1
        for (int d = 0; d < 128; ++d) qk += qv[d] * dbg_convsilu(kb, pos, ctx ? LC : SEQ, 512 + h * 128 + d, d, cw, cb);
        const float om = qk * expf(Ft - F[u] + GT[DBG_GROW(u) * 16 + dir * 8 + h] - mm); F[u] = om; den += om; }
    den = wave_sum(den);
    LDS_WAIT(); asm volatile("" ::: "memory");
    float num[2] = {0.f, 0.f};
#pragma unroll 1
    for (int u = 0; u < N; ++u) { const bool ctx = u < 256; const int pos = DBG_POS(u); const bf16* vb = BV + (size_t)((ctx ? 0 : LC) + pos) * 512; num[0] += F[u] * bf1(vb[lane]); num[1] += F[u] * bf1(vb[64 + lane]); }
    const float dd = 1.f / fmaxf(fabsf(den), expf(-mm));
    const bf16* HB = (const bf16*)(big + A0_HB) + (size_t)dir * T * 512 + ((size_t)b * SEQ + DBG_POS(N - 1)) * 512 + h * 128;
    float err = 0.f, sc = 0.f;
#pragma unroll
    for (int j = 0; j < 2; ++j) { const float val = num[j] * dd; err = fmaxf(err, fabsf(val - bf1(HB[64 * j + lane]))); sc += val * val; }
    err = wave_max(err); sc = sqrtf(wave_sum(sc) * (1.f / 128.f));
    dbg_report_wave(p, err / (sc + 1e-3f), lane);
#undef DBG_POS
#undef DBG_GROW
}

__global__ void __launch_bounds__(NTHR, 2) mk_fwd(Params p0) {
    extern __shared__ __attribute__((aligned(16))) unsigned char lds_raw[];
    LAS unsigned char* lds = (LAS unsigned char*)lds_raw;
    if (threadIdx.x < 64) ((LAS unsigned*)(lds + LDS_MISC))[threadIdx.x] = 0u;
    __syncthreads();
    XcdBarrier bar = xcd_barrier_post((unsigned*)(p0.ws + WS_CTL) + CW_BAR, (volatile LAS unsigned*)(lds + LDS_MISC + 32));
    const int lo = p0.ph_lo, hi = p0.ph_hi; int ph = 0;
    const int G = gridDim.x, cb = blockIdx.x;
#define LAYER_PTRS bf16* H2 = (bf16*)(big + (l == 0 ? 0 : 128 * MiB)); float* LOG = (float*)(big + (l == 0 ? 128 * MiB : 256 * MiB)); bf16* ACT = (bf16*)(big + (l == 0 ? 144 * MiB : 272 * MiB)); \
        bf16* Y = (bf16*)(big + (l == 0 ? 224 * MiB : 352 * MiB)); bf16* HN = (bf16*)(big + 544 * MiB); const bf16* MIX = (const bf16*)(big + (l == 0 ? A0_MIX : 0)); \
        bf16* UT = (bf16*)big; bf16* UC = (bf16*)(big + 384 * MiB); bf16* ZT = (bf16*)big; bf16* Y2T = (bf16*)(big + 128 * MiB); bf16* Y2 = (bf16*)(big + 256 * MiB); \
        (void)H2; (void)LOG; (void)ACT; (void)Y; (void)HN; (void)MIX; (void)UT; (void)UC; (void)ZT; (void)Y2T; (void)Y2;
#define RUN(...) do { if (ph >= lo && ph < hi) { { int tid_ = threadIdx.x; asm volatile("" : "+v"(tid_)); const int tid = tid_, lane = tid & 63, wave = __builtin_amdgcn_readfirstlane(tid >> 6); (void)lane; (void)wave; \
        Params p = p0; { unsigned char* w_ = p0.ws; asm volatile("" : "+s"(w_)); p.ws = w_; } unsigned char* ws = p.ws; unsigned char* big = ws + WS_BIG; (void)big; LAYER_PTRS __VA_ARGS__; } if (ph + 1 < hi) xcd_barrier(bar); } ++ph; } while (0)

    { const int l = 0; RUN({ pro_mod(p, lds, tid, lane, wave); __syncthreads(); pro_filters(p, lds, tid, lane, wave); pro_rope(p, tid); pro_transposes(p, lds, lane, wave); }); }

    for (int l = 0; l < 2; ++l) {
        if (l == 0) {
            RUN({ ph_l0_norm(p, lane, wave); });
            RUN({ Gemm g{(const bf16*)(big + A0_H), (const bf16*)(ws + WS_WIN0), 1024, 2048u}; InprojSched S{G, cb};
                  EpiInproj E{big, (const float*)(ws + WS_ROPE), (float*)(ws + WS_GATES), p.in[I_GATEB]};
                  gemm_phase<EpiInproj, InprojSched>(lds, g, S, E); });
#ifdef DBG_INPROJ
            RUN({ dbg_inproj_check(p, big, lane, wave); });
#endif
            RUN({ ph_transpose_b((const bf16*)(big + A0_VA), (bf16*)(big + A0_VT), NB, SEQ + LC, 512, lds, lane, wave); });
            RUN({ ph_attn(p, big, lds, tid, lane, wave); });
#ifdef DBG_ATTN
            RUN({ dbg_attn_check(p, big, lds, lane, wave); });
#endif
            RUN({ ph_mlstm(p, big, lds, tid, lane, wave); });
#ifdef DBG_MLSTM
            RUN({ dbg_mlstm_check(p, big, lds, lane, wave); });
#endif
            RUN({ ph_outb(p, big, lane, wave); });
            RUN({ Gemm g{(const bf16*)(big + A0_MIXIN), (const bf16*)(ws + WS_WOUT0), 1024, 2048u}; DenseSched S{4, 1024, G, cb, 0}; EpiBf16 E{(bf16*)(big + A0_MIX), 1024, 3};
                  gemm_phase<EpiBf16, DenseSched>(lds, g, S, E); });
        }
        if (l == 1) {
            RUN({ Gemm g{(const bf16*)(ws + WS_WIN1), HN, 1024, 2048u}; DenseSched S{256, 12 * 256, G, cb, 12}; EpiBf16 E{UT, (size_t)T, 0xffff};
                  gemm_phase<EpiBf16, DenseSched>(lds, g, S, E); });
#ifdef DBG_HY
            if (DBG_MODE == 0) { RUN({ dbg_hyena_check(p, 0, HN, UT, UT, UT, UT, lds, lane, wave); }); }
#endif
            RUN({ ph_sconv(p, UT, UC, tid); });
#ifdef DBG_HY
            if (DBG_MODE == 5) { RUN({ dbg_hyena_check(p, 5, HN, UC, UT, UT, UT, lds, lane, wave); }); }
#endif
            RUN({ ph_lconv(p, 0, UC, UC, ZT, lds, tid, lane, wave); });
#ifdef DBG_HY
            if (DBG_MODE == 2) { RUN({ dbg_hyena_check(p, 2, HN, UC, ZT, Y2T, UT, lds, lane, wave); }); }
#endif
            RUN({ ph_lconv(p, 1, ZT, UC, Y2T, lds, tid, lane, wave); });
#ifdef DBG_HY
            if (DBG_MODE == 3) { RUN({ dbg_hyena_check(p, 3, HN, UC, ZT, Y2T, UT, lds, lane, wave); }); }
#endif
            RUN({ ph_transpose(Y2T, Y2, lds, lane, wave); });
            RUN({ Gemm g{Y2, (const bf16*)(ws + WS_WOUT1), 1024, 2048u}; DenseSched S{4, 1024, G, cb, 0}; EpiBf16 E{(bf16*)big, 1024, 3};
                  gemm_phase<EpiBf16, DenseSched>(lds, g, S, E); });
        }
#ifdef DBG_HY
        if (l == 1 && (DBG_MODE == 1 || DBG_MODE == 4)) { RUN({ dbg_hyena_check(p, DBG_MODE, HN, (const bf16*)(big + 384 * MiB), (const bf16*)big, (const bf16*)(big + 128 * MiB), (const bf16*)big, lds, lane, wave); }); }
#endif
        RUN({ ph_mid(p, l, MIX, H2, true, lane, wave); });
        RUN({ Gemm g{H2, (const bf16*)(ws + WS_WR) + (size_t)l * 256 * 1024, 1024, 2048u}; DenseSched S{1, 256, G, cb, 0}; EpiRouter E{LOG};
              gemm_phase<EpiRouter, DenseSched>(lds, g, S, E); });
        RUN({ ph_route_a(p, l, LOG, lds, tid); });
#ifdef DBG_ROUTE
        RUN({ if (l == DBG_L) dbg_route_check(p, l, H2, LOG, lds, tid); ph_route_b(p, lds, tid); });
#else
        RUN({ ph_route_b(p, lds, tid); });
#endif
        for (int ch = 0; ch < NCH; ++ch) {
            RUN({ const int NT = moe_tables(p, ch, lds, tid);
                  Gemm g{H2, (const bf16*)(ws + WS_GU) + (size_t)l * (65 * 512) * 1024, 1024, 2048u};
                  MoeSched S{(const LAS int*)(lds + LDS_TAB), (const int*)(ws + WS_SORT) + (size_t)ch * CHROWS, NT * 2, G, cb, 1, 2}; EpiSwiglu E{ACT};
                  gemm_phase<EpiSwiglu, MoeSched>(lds, g, S, E); });
            RUN({ const int NT = moe_tables(p, ch, lds, tid);
                  Gemm g{ACT, (const bf16*)(ws + WS_DN) + (size_t)l * (65 * 1024) * 256, 256, 512u};
                  MoeSched S{(const LAS int*)(lds + LDS_TAB), nullptr, NT * 4, G, cb, 2, 4}; EpiBf16 E{Y, 1024, 3};
                  gemm_phase<EpiBf16, MoeSched>(lds, g, S, E); });
#ifdef DBG_MOE
            RUN({ if (l == DBG_L && ch == DBG_CH) dbg_moe_check(p, l, ch, H2, Y, lds, tid); ph_combine(p, l, ch, Y, HN, lane, wave); });
#else
            RUN({ ph_combine(p, l, ch, Y, HN, lane, wave); });
#endif
        }
    }
#ifdef DBG_ANY
    xcd_barrier(bar);
    if (blockIdx.x == 0 && threadIdx.x == 0) p0.out[0] += 1.0e7f * __uint_as_float(((const unsigned*)(p0.ws + WS_CTL))[CW_DBG]);
#endif
#undef RUN
}
constexpr int NPHASES = 1 + 2 * (4 + 3 * NCH) + 6 + 64;
}

extern "C" void kernel_launch(void* const* d_in, const int* in_sizes, int n_in, void* d_out, int out_size, void* d_ws, size_t ws_size, hipStream_t stream) {
    using namespace mk;
    static int grid = 0;
    if (grid == 0) {
        if (n_in != 31 || out_size != T * D || ws_size < WS_END) { fprintf(stderr, "kernel_launch: unexpected shapes (n_in %d, out %d, ws %zu)\n", n_in, out_size, ws_size); grid = -1; return; }
        int dev = 0, cus = 0;
        if (hipGetDevice(&dev) != hipSuccess || hipDeviceGetAttribute(&cus, hipDeviceAttributeMultiprocessorCount, dev) != hipSuccess) { grid = -1; return; }
        if (hipFuncSetAttribute((const void*)mk_fwd, hipFuncAttributeMaxDynamicSharedMemorySize, LDS_BYTES) != hipSuccess) { fprintf(stderr, "kernel_launch: hipFuncSetAttribute failed\n"); grid = -1; return; }
        int per_cu = 0;
        if (hipOccupancyMaxActiveBlocksPerMultiprocessor(&per_cu, (const void*)mk_fwd, NTHR, LDS_BYTES) != hipSuccess || per_cu < 1) { fprintf(stderr, "kernel_launch: occupancy query says %d\n", per_cu); }
        (void)hipGetLastError();
        grid = cus;
        if (grid != 256) { fprintf(stderr, "kernel_launch: built for 256 CUs, found %d\n", grid); grid = -1; return; }
    }
    if (grid < 0) return;
    (void)hipMemsetAsync((char*)d_ws + WS_CTL, 0, CTL_ZERO_BYTES, stream);
    Params a{};
    for (int i = 0; i < 31; ++i) a.in[i] = (const float*)d_in[i];
    a.out = (float*)d_out; a.ws = (unsigned char*)d_ws; a.ph_lo = 0; a.ph_hi = NPHASES;
    hipLaunchKernelGGL(mk_fwd, dim3(grid), dim3(NTHR), LDS_BYTES, stream, a);
}
```

```cpp
#include <hip/hip_runtime.h>
#include <cstdio>
#include <cstdint>
namespace pg8 {
#define PG8_LAS __attribute__((address_space(3)))
typedef unsigned short bf16_t;
typedef short bf16x8 __attribute__((ext_vector_type(8)));
typedef float f32x4 __attribute__((ext_vector_type(4)));
typedef unsigned u32x4 __attribute__((ext_vector_type(4)));
typedef unsigned u32x2 __attribute__((ext_vector_type(2)));
constexpr int BM = 256, BK = 64, HALF = 128, HTB = HALF * BK * 2  , STAGE_BYTES = 8 * HTB;

__host__ __device__ __forceinline__ int lds_byte(int r, int c) { const int st = (r >> 4) * 2 + (c >> 5), rr = r & 15, cc = c & 31, ob = rr * 64 + cc * 2; return st * 1024 + (ob ^ (((ob >> 9) & 1) << 5)); }
__host__ __device__ __forceinline__ void stage_rc(int b, int& R, int& C) { const int st = b / 1024, sb = b % 1024, swz = sb ^ (((sb >> 9) & 1) << 5); R = (st >> 1) * 16 + swz / 64; C = (st & 1) * 32 + (swz % 64) / 2; }
__host__ __device__ __forceinline__ int perm32(int rho) { const int n = rho >> 4, i = rho & 15; return 8 * (i >> 2) + 4 * n + (i & 3); }

struct Unit { int pm, pn; };
__device__ __forceinline__ unsigned cvt_pk_bf16(float lo, float hi) { unsigned r; asm volatile("v_cvt_pk_bf16_f32 %0, %1, %2" : "=v"(r) : "v"(lo), "v"(hi)); return r; }
struct Gemm { const bf16_t* A; const bf16_t* Bt; int K; unsigned lda_bytes; };
template <class Epi, class Sched>
__device__ __forceinline__ void gemm_phase(PG8_LAS unsigned char* lds, const Gemm g, const Sched& S, const Epi& E, const int tid_in) {
    int tid_ = tid_in; asm volatile("" : "+v"(tid_));
    const int tid = tid_, wid = __builtin_amdgcn_readfirstlane(tid >> 6), lane = tid & 63, wr = wid >> 2, wc = wid & 3, fr = lane & 15, fq = lane >> 4;
    const int K = g.K, nt = K / BK;
    unsigned voffB[2];
#pragma unroll
    for (int i = 0; i < 2; ++i) { int R, C; stage_rc(tid * 16 + i * 8192, R, C); const int Rb = Epi::PERM ? ((R & ~31) + perm32(R & 31)) : R;
        voffB[i] = (unsigned)(Rb * K + C) * 2u; }
    const size_t kstep = (size_t)(BK * 2);
    const size_t hstep = (size_t)HALF * K * 2;
    const size_t tstep = 2 * hstep;
    const unsigned ldsw = (unsigned)wid * 1024u;
    const int aoff = lds_byte(wr * 64 + fr, fq * 8), boff = lds_byte(wc * 32 + fr, fq * 8);
    const char* Ab = (const char*)g.A;
#define PG8_SA(b, h) (((b) * 2 + (h)) * HTB)
#define PG8_SB(b, h) ((4 + (b) * 2 + (h)) * HTB)
#define PG8_STAGE(bufoff, gbase, voff) do { _Pragma("unroll") for (int _i = 0; _i < 2; ++_i) \
        __builtin_amdgcn_global_load_lds((const unsigned*)((const char*)(gbase) + (voff)[_i]), (PG8_LAS unsigned*)(lds + (bufoff) + ldsw + _i * 8192), 16, 0, 0); } while (0)
#define PG8_STAGEA(bufoff, o0, o1, kb) do { \
        __builtin_amdgcn_global_load_lds((const unsigned*)(Ab + (size_t)(o0) + (size_t)(kb)), (PG8_LAS unsigned*)(lds + (bufoff) + ldsw), 16, 0, 0); \
        __builtin_amdgcn_global_load_lds((const unsigned*)(Ab + (size_t)(o1) + (size_t)(kb)), (PG8_LAS unsigned*)(lds + (bufoff) + ldsw + 8192), 16, 0, 0); } while (0)
#define PG8_LDA(dst, b, h) do { _Pragma("unroll") for (int m = 0; m < 4; ++m) _Pragma("unroll") for (int k = 0; k < 2; ++k) dst[m][k] = *(const PG8_LAS bf16x8*)(lds + PG8_SA(b, h) + aoff + m * 2048 + k * 1024); } while (0)
#define PG8_LDB(dst, b, h) do { _Pragma("unroll") for (int n = 0; n < 2; ++n) _Pragma("unroll") for (int k = 0; k < 2; ++k) dst[n][k] = *(const PG8_LAS bf16x8*)(lds + PG8_SB(b, h) + boff + n * 2048 + k * 1024); } while (0)
#define PG8_MMA(ai, bj, At, Bt) do { __builtin_amdgcn_s_setprio(1); _Pragma("unroll") for (int m = 0; m < 4; ++m) _Pragma("unroll") for (int n = 0; n < 2; ++n) _Pragma("unroll") for (int k = 0; k < 2; ++k) \
        acc[ai][bj][m][n] = __builtin_amdgcn_mfma_f32_16x16x32_bf16(Bt[n][k], At[m][k], acc[ai][bj][m][n], 0, 0, 0); __builtin_amdgcn_s_setprio(0); } while (0)
#define PG8_WAIT_V(n) asm volatile("s_waitcnt vmcnt(" #n ")" ::: "memory")
#define PG8_WAIT_L(n) asm volatile("s_waitcnt lgkmcnt(" #n ")" ::: "memory")
#define PG8_BAR __builtin_amdgcn_s_barrier()
#define PG8_SCHED __builtin_amdgcn_sched_barrier(0)
#define PG8_OFFS(dst, u) do { _Pragma("unroll") for (int _i = 0; _i < 2; ++_i) { int _R, _C; stage_rc(tid * 16 + _i * 8192, _R, _C); _Pragma("unroll") for (int _h = 0; _h < 2; ++_h) \
        dst[_h][_i] = (unsigned)S.arow((u).pm * BM + _h * HALF + _R) * g.lda_bytes + (unsigned)(_C * 2); } } while (0)
    Unit cur, nxt; int ui = 0;
    if (!S.next(0, cur)) return;
    f32x4 acc[2][2][4][2];
#pragma unroll
    for (int a = 0; a < 2; ++a)
#pragma unroll
        for (int b = 0; b < 2; ++b)
#pragma unroll
            for (int m = 0; m < 4; ++m)
#pragma unroll
                for (int n = 0; n < 2; ++n) acc[a][b][m][n] = (f32x4){0.f, 0.f, 0.f, 0.f};
    bf16x8 At[4][2], B0[2][2], B1[2][2];
    unsigned oC[2][2], oN[2][2];
    PG8_OFFS(oC, cur);
    const char* cB = (const char*)g.Bt + (size_t)cur.pn * tstep;
    PG8_STAGE(PG8_SB(0, 0), cB, voffB); PG8_STAGE(PG8_SB(0, 1), cB + hstep, voffB); PG8_STAGEA(PG8_SA(0, 0), oC[0][0], oC[0][1], 0); PG8_STAGEA(PG8_SA(0, 1), oC[1][0], oC[1][1], 0);
    if (wr == 1) PG8_BAR;
    PG8_WAIT_V(2); PG8_BAR;
    PG8_STAGE(PG8_SB(1, 0), cB + kstep, voffB); PG8_STAGEA(PG8_SA(1, 0), oC[0][0], oC[0][1], kstep); PG8_STAGE(PG8_SB(1, 1), cB + hstep + kstep, voffB);
    PG8_WAIT_V(6); PG8_BAR;
    for (;;) {
        const bool has_next = S.next(ui + 1, nxt);
        if (has_next) { PG8_OFFS(oN, nxt); } else {
#pragma unroll
            for (int _h = 0; _h < 2; ++_h)
#pragma unroll
                for (int _i = 0; _i < 2; ++_i) oN[_h][_i] = oC[_h][_i]; }
        const char* nB = has_next ? (const char*)g.Bt + (size_t)nxt.pn * tstep : cB;
#pragma unroll 1
        for (int t = 0; t < nt; t += 2) {
            const bool last = (t == nt - 2);
            const size_t k1 = (size_t)(t + 1) * kstep;
            const size_t k2 = last ? 0 : (size_t)(t + 2) * kstep, k3 = k2 + kstep;
            const char* b2 = last ? nB : cB + (size_t)(t + 2) * kstep; const char* b3 = b2 + kstep;
            PG8_LDB(B0, 0, 0); PG8_LDB(B1, 0, 1); PG8_SCHED; PG8_LDA(At, 0, 0); PG8_STAGEA(PG8_SA(1, 1), oC[1][0], oC[1][1], k1);
            if (last) { oC[0][0] = oN[0][0]; oC[0][1] = oN[0][1]; oC[1][0] = oN[1][0]; oC[1][1] = oN[1][1]; }
            PG8_WAIT_V(8); PG8_WAIT_L(0); PG8_BAR; PG8_MMA(0, 0, At, B0); PG8_MMA(0, 1, At, B1); PG8_BAR; PG8_SCHED;
            PG8_LDA(At, 0, 1); PG8_STAGE(PG8_SB(0, 0), b2, voffB); PG8_STAGE(PG8_SB(0, 1), b2 + hstep, voffB); PG8_STAGEA(PG8_SA(0, 0), oC[0][0], oC[0][1], k2);
            PG8_WAIT_V(8); PG8_WAIT_L(0); PG8_BAR; PG8_MMA(1, 0, At, B0); PG8_MMA(1, 1, At, B1); PG8_BAR; PG8_SCHED;
            PG8_LDB(B0, 1, 0); PG8_LDB(B1, 1, 1); PG8_SCHED; PG8_LDA(At, 1, 0); PG8_STAGEA(PG8_SA(0, 1), oC[1][0], oC[1][1], k2);
            PG8_WAIT_V(8); PG8_WAIT_L(0); PG8_BAR; PG8_MMA(0, 0, At, B0); PG8_MMA(0, 1, At, B1); PG8_BAR; PG8_SCHED;
            PG8_LDA(At, 1, 1); PG8_STAGE(PG8_SB(1, 0), b3, voffB); PG8_STAGE(PG8_SB(1, 1), b3 + hstep, voffB); PG8_STAGEA(PG8_SA(1, 0), oC[0][0], oC[0][1], k3);
            PG8_WAIT_V(8); PG8_WAIT_L(0); PG8_BAR; PG8_MMA(1, 0, At, B0); PG8_MMA(1, 1, At, B1); PG8_BAR; PG8_SCHED;
        }
        if (wr == 0) PG8_BAR;
        E(acc, cur, wr, wc, fr, fq);
        if (!has_next) break;
#pragma unroll
        for (int a = 0; a < 2; ++a)
#pragma unroll
            for (int b = 0; b < 2; ++b)
#pragma unroll
                for (int m = 0; m < 4; ++m)
#pragma unroll
                    for (int n = 0; n < 2; ++n) acc[a][b][m][n] = (f32x4){0.f, 0.f, 0.f, 0.f};
        cur = nxt; cB = nB; ++ui;
#pragma unroll
        for (int _h = 0; _h < 2; ++_h)
#pragma unroll
            for (int _i = 0; _i < 2; ++_i) oC[_h][_i] = oN[_h][_i];
        if (wr == 1) PG8_BAR;
    }
    PG8_WAIT_V(0);
    PG8_BAR;
#undef PG8_SA
#undef PG8_SB
#undef PG8_STAGE
#undef PG8_STAGEA
#undef PG8_LDA
#undef PG8_LDB
#undef PG8_MMA
#undef PG8_WAIT_V
#undef PG8_WAIT_L
#undef PG8_BAR
#undef PG8_SCHED
#undef PG8_OFFS
}

template <class Epi, class Sched>
__device__ __noinline__ void gemm_phase_ni(PG8_LAS unsigned char* lds, Gemm g, Sched S, Epi E) { gemm_phase<Epi, Sched>(lds, g, S, E, (int)threadIdx.x); }
}

namespace mk {
using namespace pg8;
constexpr int D = 1024, NB = 32, SEQ = 2048, T = NB * SEQ, LC = 256, TC = NB * LC, TT = T + TC;
constexpr int NMOD = 6 * D;
constexpr int NE = 64, NEX = 65, DE = 256;
constexpr int NCH = 4, CHT = T / NCH;
constexpr int MAXTILES = 640, CHROWS = MAXTILES * 256;
constexpr float RMS_EPS = 1e-6f;
constexpr int NWAVES = 8, NTHR = 512;

constexpr size_t MiB = 1u << 20;
constexpr size_t WS_CTL = 0, CTL_ZERO_BYTES = 64 * 1024;
constexpr size_t WS_MOD = 1 * MiB;
constexpr size_t WS_ROPE = 3 * MiB;
constexpr size_t WS_BC = 3 * MiB + 65536;
constexpr size_t WS_GATES = 4 * MiB;
constexpr size_t WS_FILT = 10 * MiB;
constexpr size_t WS_EIDX = 18 * MiB, WS_WTS = 20 * MiB, WS_PSLOT = 22 * MiB, WS_SORT = 26 * MiB;
constexpr size_t WS_WIN0 = 30 * MiB;
constexpr size_t WS_WOUT0 = 38 * MiB, WS_WIN1 = 40 * MiB, WS_WOUT1 = 46 * MiB, WS_WR = 48 * MiB;
constexpr size_t WS_GU = 50 * MiB;
constexpr size_t WS_DN = 180 * MiB;
constexpr size_t WS_BIG = 246 * MiB;
constexpr size_t WS_END = 1024 * MiB;
static_assert(WS_PSLOT + (size_t)T * 16 * 4 <= WS_SORT && WS_SORT + (size_t)4 * CHROWS * 4 <= WS_WIN0 && WS_WIN0 + (size_t)3840 * 2048 <= WS_WOUT0 && WS_WR + (size_t)2 * 256 * 2048 <= WS_GU && WS_GU + (size_t)2 * 65 * 512 * 2048 <= WS_DN && WS_DN + (size_t)2 * 65 * 1024 * 512 <= WS_BIG, "ws map");
constexpr size_t A0_H = 0, A0_QA = 144 * MiB, A0_KA = 208 * MiB, A0_VA = 280 * MiB, A0_BQ = 352 * MiB, A0_BK = 416 * MiB, A0_BV = 488 * MiB, A0_BO = 560 * MiB, A0_VT = 624 * MiB;
constexpr size_t A0_MIXIN = 0, A0_HB = 144 * MiB, A0_MIX = 352 * MiB;
constexpr int CW_BAR = 4096;

constexpr int LDS_BYTES = 160 * 1024;
constexpr int LDS_TAB = 131072;
constexpr int LDS_MISC = 131072 + 24 * 1024;

#define GAS __attribute__((address_space(1)))
#define LAS __attribute__((address_space(3)))
typedef unsigned short bf16;
typedef unsigned v4u __attribute__((ext_vector_type(4)));
typedef unsigned v2u __attribute__((ext_vector_type(2)));
#define LDS_WAIT() asm volatile("s_waitcnt lgkmcnt(0)" ::: "memory")
#define VM_WAIT() asm volatile("s_waitcnt vmcnt(0)" ::: "memory")
__device__ __forceinline__ unsigned f2bf(float f) { unsigned u = __builtin_bit_cast(unsigned, f); return (u + 0x7fffu + ((u >> 16) & 1u)) >> 16; }
__device__ __forceinline__ unsigned pk2(float lo, float hi) { return f2bf(lo) | (f2bf(hi) << 16); }
__device__ __forceinline__ float bf_lo(unsigned w) { return __builtin_bit_cast(float, w << 16); }
__device__ __forceinline__ float bf_hi(unsigned w) { return __builtin_bit_cast(float, w & 0xffff0000u); }
__device__ __forceinline__ float bf1(bf16 h) { return __builtin_bit_cast(float, (unsigned)h << 16); }
__device__ __forceinline__ int lane_opq() { int l = (int)__builtin_amdgcn_mbcnt_hi(~0u, __builtin_amdgcn_mbcnt_lo(~0u, 0u)); asm volatile("" : "+v"(l)); return l; }
__device__ __forceinline__ float shx(float v, int m) { return __builtin_bit_cast(float, __builtin_amdgcn_ds_bpermute((lane_opq() ^ m) << 2, __builtin_bit_cast(int, v))); }
__device__ __forceinline__ float shup(float v, int o) { const int l = lane_opq(); return __builtin_bit_cast(float, __builtin_amdgcn_ds_bpermute((l >= o ? l - o : l) << 2, __builtin_bit_cast(int, v))); }
__device__ __forceinline__ float shidx(float v, int idx) { return __builtin_bit_cast(float, __builtin_amdgcn_ds_bpermute(idx << 2, __builtin_bit_cast(int, v))); }
__device__ __forceinline__ float wave_sum(float v) {
#pragma unroll
    for (int o = 1; o < 64; o <<= 1) v += shx(v, o);
    return v;
}
__device__ __forceinline__ float wave_max(float v) {
#pragma unroll
    for (int o = 1; o < 64; o <<= 1) v = fmaxf(v, shx(v, o));
    return v;
}
__device__ __forceinline__ float sigmoidf_(float x) { return 1.f / (1.f + __expf(-x)); }
__device__ __forceinline__ float siluf_(float x) { return x / (1.f + __expf(-x)); }
#define XB_TMO      128
#define XB_XCNT(j)  (256  + 64 * (j))
#define XB_XSUB(j)  (1280 + 64 * (j))
#define XB_XGEN(j)  (2304 + 64 * (j))
#define XB_TOP      3328
#define XB_TOPGEN   3392
#define XCD_BAR_WORDS 3456
#define XB_SPIN_CAP (1u << 18)

__device__ __forceinline__ unsigned xb_ld(unsigned* p)              { return __hip_atomic_load(p, __ATOMIC_RELAXED, __HIP_MEMORY_SCOPE_AGENT); }
__device__ __forceinline__ unsigned xb_add(unsigned* p, unsigned v) { return __hip_atomic_fetch_add(p, v, __ATOMIC_RELAXED, __HIP_MEMORY_SCOPE_AGENT); }
__device__ __forceinline__ unsigned xb_xcc_id() { return (unsigned)__builtin_amdgcn_s_getreg((3 << 11) | 20) & 0xFu; }
#define XB_SPIN(cond, bar) do { unsigned _sp = 0; while (cond) { __builtin_amdgcn_s_sleep(1); \
    if ((++_sp & 255u) == 0u) { if (xb_ld(&(bar)[XB_TMO])) break; if (_sp > XB_SPIN_CAP) { atomicAdd(&(bar)[XB_TMO], 1u); break; } } } } while (0)

struct XcdBarrier {
    unsigned* bar; unsigned x;
    volatile LAS unsigned* st;
};

__device__ __forceinline__ XcdBarrier xcd_barrier_post(unsigned* bar, volatile LAS unsigned* st) {
    XcdBarrier b; b.bar = bar; b.x = xb_xcc_id(); b.st = st;
    if (threadIdx.x == 0) (void)xb_add(&bar[XB_XCNT(b.x)], 1u);
    return b;
}
__device__ __forceinline__ void xcd_barrier_complete(unsigned* bar, unsigned x, unsigned& nloc, unsigned& nx) {
    const unsigned G = gridDim.x * gridDim.y * gridDim.z;
    unsigned sum, cnt, mine, sp = 0u;
    for (;;) {
        sum = 0u; cnt = 0u; mine = 0u;
#pragma unroll
        for (unsigned j = 0; j < 16; ++j) { const unsigned c = xb_ld(&bar[XB_XCNT(j)]); sum += c; cnt += (c > 0u) ? 1u : 0u; mine = (j == x) ? c : mine; }
        if (sum == G) break;
        __builtin_amdgcn_s_sleep(1);
        if ((++sp & 255u) == 0u) { if (xb_ld(&bar[XB_TMO])) break; if (sp > XB_SPIN_CAP) { atomicAdd(&bar[XB_TMO], 1u); break; } }
    }
    nloc = mine > 0u ? mine : 1u; nx = cnt > 0u ? cnt : 1u;
}

__device__ __forceinline__ void xcd_barrier(const XcdBarrier& b, const bool t0  ) {
    asm volatile("s_waitcnt vmcnt(0)" ::: "memory");
    __syncthreads();
    if (t0) {
        unsigned* bar = b.bar;
        __builtin_amdgcn_s_waitcnt(0);
        unsigned nloc = b.st[0], nx = b.st[1];
        if (nloc == 0u) { xcd_barrier_complete(bar, b.x, nloc, nx); b.st[0] = nloc; b.st[1] = nx; }
        const unsigned old = xb_add(&bar[XB_XSUB(b.x)], 1u);
        const unsigned gen = old / nloc;
        if (old + 1u == (gen + 1u) * nloc) {
            __builtin_amdgcn_fence(__ATOMIC_RELEASE, "agent");
            asm volatile("s_waitcnt vmcnt(0)" ::: "memory");
            const unsigned og = xb_add(&bar[XB_TOP], 1u);
            const unsigned tg = og / nx;
            if (og + 1u == (tg + 1u) * nx) xb_add(&bar[XB_TOPGEN], 1u);
            else XB_SPIN(xb_ld(&bar[XB_TOPGEN]) == tg, bar);
            __builtin_amdgcn_fence(__ATOMIC_ACQUIRE, "agent");
            xb_add(&bar[XB_XGEN(b.x)], 1u);
            asm volatile("s_waitcnt vmcnt(0)" ::: "memory");
        } else {
            XB_SPIN(xb_ld(&bar[XB_XGEN(b.x)]) == gen, bar);
            __builtin_amdgcn_fence(__ATOMIC_ACQUIRE, "agent");
            asm volatile("s_waitcnt vmcnt(0)" ::: "memory");
        }
    }
    __syncthreads();
}

struct Params { const float* in[31]; float* out; unsigned char* ws; int ph_lo, ph_hi; };
enum { I_X = 0, I_C, I_CTX, I_CCTX, I_WMOD, I_BMOD, I_NORMG, I_WINAB, I_CONVABW, I_CONVABB, I_GATEB, I_DLAM, I_HGA, I_HGB, I_WOUTAB, I_WINHY, I_CONVHYW, I_CONVHYB,
       I_FW1, I_FB1, I_FW2, I_FB2, I_FW3, I_FBIAS, I_WOUTHY, I_RW, I_RB, I_EGU, I_EDN, I_SGU, I_SDN };

__device__ __forceinline__ void row_ld_f32(const float* row, int lane, f32x4 (&v)[4]) { const f32x4* r = (const f32x4*)row + lane;
#pragma unroll
    for (int j = 0; j < 4; ++j) v[j] = r[64 * j]; }
__device__ __forceinline__ void row_st_f32(float* row, int lane, const f32x4 (&v)[4]) { f32x4* r = (f32x4*)row + lane;
#pragma unroll
    for (int j = 0; j < 4; ++j) r[64 * j] = v[j]; }
__device__ __forceinline__ void row_ld_bf16(const bf16* row, int lane, f32x4 (&v)[4]) { const v2u* r = (const v2u*)row + lane;
#pragma unroll
    for (int j = 0; j < 4; ++j) { const v2u w = r[64 * j]; v[j] = (f32x4){bf_lo(w.x), bf_hi(w.x), bf_lo(w.y), bf_hi(w.y)}; } }
__device__ __forceinline__ void row_st_bf16(bf16* row, int lane, const f32x4 (&v)[4]) { v2u* r = (v2u*)row + lane;
#pragma unroll
    for (int j = 0; j < 4; ++j) { v2u w; w.x = pk2(v[j].x, v[j].y); w.y = pk2(v[j].z, v[j].w); r[64 * j] = w; } }
__device__ __forceinline__ float row_ss(const f32x4 (&v)[4]) { float s = 0.f;
#pragma unroll
    for (int j = 0; j < 4; ++j) s += (v[j].x * v[j].x + v[j].y * v[j].y) + (v[j].z * v[j].z + v[j].w * v[j].w);
    return wave_sum(s); }
__device__ __forceinline__ void row_modulate(const f32x4 (&x)[4], float rstd, const float* g, const float* shift, const float* scale, int lane, f32x4 (&h)[4]) {
    const f32x4* gp = (const f32x4*)g + lane; const f32x4* sh = (const f32x4*)shift + lane; const f32x4* sc = (const f32x4*)scale + lane;
#pragma unroll
    for (int j = 0; j < 4; ++j) { const f32x4 gg = gp[64 * j], s1 = sc[64 * j], s0 = sh[64 * j]; h[j] = x[j] * rstd * gg * (1.f + s1) + s0; } }

__device__ __forceinline__ void pro_mod(const Params& p, LAS unsigned char* lds, int tid, int lane, int wave) {
    const int u = blockIdx.x; if (u >= 192) return;
    LAS float* S = (LAS float*)lds;
    const float* c = p.in[I_C]; const float* cc = p.in[I_CCTX];
#pragma unroll 1
    for (int i = tid; i < 33 * 1024; i += NTHR) { const int b = i >> 10, k = i & 1023; const float v = b < 32 ? c[b * 1024 + k] : cc[k]; S[i] = siluf_(v); }
    __syncthreads();
    const int l = u / 96, cg = (u % 96) * 64, col = cg + lane;
    const float* W = p.in[I_WMOD] + (size_t)l * 1024 * NMOD;
    float acc[33];
#pragma unroll
    for (int b = 0; b < 33; ++b) acc[b] = 0.f;
    const int k0 = wave * 128;
#pragma unroll 1
    for (int kk = 0; kk < 128; kk += 4) { const int k = k0 + kk;
        const float w0 = W[(size_t)k * NMOD + col], w1 = W[(size_t)(k + 1) * NMOD + col], w2 = W[(size_t)(k + 2) * NMOD + col], w3 = W[(size_t)(k + 3) * NMOD + col];
#pragma unroll
        for (int b = 0; b < 33; ++b) { const f32x4 s = *(const LAS f32x4*)(S + b * 1024 + k); acc[b] += (s.x * w0 + s.y * w1) + (s.z * w2 + s.w * w3); } }
    __syncthreads();
    LAS float* P = (LAS float*)lds;
#pragma unroll
    for (int b = 0; b < 33; ++b) P[(wave * 33 + b) * 64 + lane] = acc[b];
    __syncthreads();
    float* MOD = (float*)(p.ws + WS_MOD);
#pragma unroll 1
    for (int i = tid; i < 33 * 64; i += NTHR) { const int b = i >> 6, ln = i & 63; float s = 0.f;
#pragma unroll
        for (int w = 0; w < 8; ++w) s += P[(w * 33 + b) * 64 + ln];
        MOD[(size_t)(l * 33 + b) * NMOD + cg + ln] = s + p.in[I_BMOD][l * NMOD + cg + ln]; }
    __syncthreads();
}
__device__ __forceinline__ int rowmap(int kind, int n) {
    if (kind == 1) { const int o = n & 31; return (n & ~31) + (((o & 15) >> 2) * 8 + (o >> 4) * 4 + (o & 3)); }
    if (kind == 2) { return n < 256 ? ((n >> 7) * 256 + (n & 127)) : ((((n - 256) >> 7) * 256) + 128 + ((n - 256) & 127)); }
    return n;
}
__device__ __forceinline__ void tr_item(const float* W, int ldn, int k0, int n0, int nvalid, bf16* WT, int dK, int kind, int row_base, LAS float* scr, int lane) {
    const int nn = n0 + (lane & 31);
#pragma unroll 8
    for (int i = 0; i < 32; ++i) { const int kk = 2 * i + (lane >> 5); scr[kk * 33 + (lane & 31)] = nn < nvalid ? W[(size_t)(k0 + kk) * ldn + nn] : 0.f; }
    LDS_WAIT(); asm volatile("" ::: "memory");
    const int c = lane & 7;
#pragma unroll
    for (int j = 0; j < 4; ++j) { const int n = (lane >> 3) + 8 * j; const LAS float* s = scr + (8 * c) * 33 + n;
        v4u o; o.x = pk2(s[0 * 33], s[1 * 33]); o.y = pk2(s[2 * 33], s[3 * 33]); o.z = pk2(s[4 * 33], s[5 * 33]); o.w = pk2(s[6 * 33], s[7 * 33]);
        const int row = row_base + rowmap(kind, n0 + n);
        *(v4u*)(WT + (size_t)row * dK + k0 + 8 * c) = o; }
    LDS_WAIT(); asm volatile("" ::: "memory");
}
__device__ __forceinline__ void pro_transposes(const Params& p, LAS unsigned char* lds, int lane, int wave) {
    LAS float* scr = (LAS float*)(lds + wave * 16384);
    const int gw = blockIdx.x * NWAVES + wave, NGW = gridDim.x * NWAVES;
    constexpr int I_A = 16 * 113, I_B = 512, I_C2 = 1536, I_D = 512, I_E = 64, I_F = 130 * 256, I_G = 130 * 128;
    constexpr int NITEMS = I_A + I_B + I_C2 + I_D + I_E + I_F + I_G;
    unsigned char* ws = p.ws;
    for (int it = gw; it < NITEMS; it += NGW) {
        int r = it;
        if (r < I_A) { const int kb = r / 113, nb = r % 113, n0 = nb * 32; const int kind = (n0 < 512 || (n0 >= 1536 && n0 < 2048)) ? 1 : 0;
            tr_item(p.in[I_WINAB], 3600, kb * 64, n0, 3600, (bf16*)(ws + WS_WIN0), 1024, kind, 0, scr, lane); continue; } r -= I_A;
        if (r < I_B) { tr_item(p.in[I_WOUTAB], 1024, (r / 32) * 64, (r % 32) * 32, 1024, (bf16*)(ws + WS_WOUT0), 1024, 0, 0, scr, lane); continue; } r -= I_B;
        if (r < I_C2) { tr_item(p.in[I_WINHY], 3072, (r / 96) * 64, (r % 96) * 32, 3072, (bf16*)(ws + WS_WIN1), 1024, 0, 0, scr, lane); continue; } r -= I_C2;
        if (r < I_D) { tr_item(p.in[I_WOUTHY], 1024, (r / 32) * 64, (r % 32) * 32, 1024, (bf16*)(ws + WS_WOUT1), 1024, 0, 0, scr, lane); continue; } r -= I_D;
        if (r < I_E) { const int l = r / 32, q = r % 32;
            tr_item(p.in[I_RW] + (size_t)l * 1024 * 64, 64, (q / 2) * 64, (q % 2) * 32, 64, (bf16*)(ws + WS_WR) + (size_t)l * 256 * 1024, 1024, 0, 0, scr, lane); continue; } r -= I_E;
        if (r < I_F) { const int mat = r / 256, q = r % 256, l = mat / 65, e = mat % 65;
            const float* src = e < 64 ? p.in[I_EGU] + (size_t)(l * 64 + e) * 1024 * 512 : p.in[I_SGU] + (size_t)l * 1024 * 512;
            tr_item(src, 512, (q / 16) * 64, (q % 16) * 32, 512, (bf16*)(ws + WS_GU) + (size_t)l * (65 * 512) * 1024, 1024, 2, e * 512, scr, lane); continue; } r -= I_F;
        { const int mat = r / 128, q = r % 128, l = mat / 65, e = mat % 65;
            const float* src = e < 64 ? p.in[I_EDN] + (size_t)(l * 64 + e) * 256 * 1024 : p.in[I_SDN] + (size_t)l * 256 * 1024;
            tr_item(src, 1024, (q / 32) * 64, (q % 32) * 32, 1024, (bf16*)(ws + WS_DN) + (size_t)l * (65 * 1024) * 256, 256, 0, e * 1024, scr, lane); }
    }
}
__device__ __forceinline__ void pro_rope(const Params& p, int tid) {
    if (blockIdx.x != 255) return;
    float* R = (float*)(p.ws + WS_ROPE);
    for (int i = tid; i < 64 * 16; i += NTHR) { const int pos = i >> 4, f = i & 15; const float inv = exp2f(-(float)f * (13.287712379549449f / 16.f)); const float ang = (float)pos * inv;
        float sn, cs; sincosf(ang, &sn, &cs); R[2 * i] = cs; R[2 * i + 1] = sn; }
}
__device__ __forceinline__ void pro_filters(const Params& p, LAS unsigned char* lds, int tid, int lane, int wave) {
    LAS float* Z = (LAS float*)lds;
    LAS float* H1 = Z + 512;
    LAS float* H2 = H1 + 512;
    const int j0 = 8 * blockIdx.x, j = j0 + wave;
    const float* fw1 = p.in[I_FW1]; const float* fb1 = p.in[I_FB1]; const float* fw2 = p.in[I_FW2]; const float* fb2 = p.in[I_FB2]; const float* fw3 = p.in[I_FW3];
    {   float z = 0.f;
        if (lane == 0) z = (float)j / 2047.f;
        else if (lane < 33) { const int k = (lane - 1) & 15; const float fr = 1e-4f + (float)k * ((15.f - 1e-4f) / 15.f); const float ang = (6.283185307179586f / 2048.f) * (float)j * fr;
            float sn, cs; sincosf(ang, &sn, &cs); z = lane < 17 ? cs : -sn; }
        Z[wave * 64 + lane] = z; }
    LDS_WAIT(); asm volatile("" ::: "memory");
    {   float a = fb1[lane];
#pragma unroll 1
        for (int k = 0; k < 33; ++k) a += Z[wave * 64 + k] * fw1[k * 64 + lane];
        H1[wave * 64 + lane] = sinf(a); }
    LDS_WAIT(); asm volatile("" ::: "memory");
    {   float a = fb2[lane];
#pragma unroll 1
        for (int k = 0; k < 64; ++k) a += H1[wave * 64 + k] * fw2[k * 64 + lane];
        H2[wave * 64 + lane] = sinf(a); }
    __syncthreads();
    bf16* F = (bf16*)(p.ws + WS_FILT);
    const float mind = -4.605170185988091f / 1.5f, maxd = -4.605170185988091f / 0.3f;
#pragma unroll 1
    for (int i = 0; i < 4; ++i) { const int n = tid + NTHR * i, c = n & 1023;
        float acc[8];
#pragma unroll
        for (int q = 0; q < 8; ++q) acc[q] = 0.f;
#pragma unroll 2
        for (int k = 0; k < 64; ++k) { const float w = fw3[k * 2048 + n];
#pragma unroll
            for (int q = 0; q < 8; ++q) acc[q] += H2[q * 64 + k] * w; }
        const float delta = fabsf(mind + (float)c * ((maxd - mind) / 1023.f));
        float o[8];
#pragma unroll
        for (int q = 0; q < 8; ++q) { const float dist = fabsf((float)(j0 + q) - 1024.f) * (1.f / 1024.f); o[q] = acc[q] * expf(-dist * delta); }
        v4u w; w.x = pk2(o[0], o[1]); w.y = pk2(o[2], o[3]); w.z = pk2(o[4], o[5]); w.w = pk2(o[6], o[7]);
        *(v4u*)(F + (size_t)n * 2048 + j0) = w; }
    __syncthreads();
}

__device__ __forceinline__ void ph_l0_norm(const Params& p, int lane, int wave) {
    const int gw = blockIdx.x * NWAVES + wave, NGW = gridDim.x * NWAVES;
    const float* MOD = (const float*)(p.ws + WS_MOD); bf16* H = (bf16*)(p.ws + WS_BIG + A0_H);
    const float* g = p.in[I_NORMG];
    for (int m = gw; m < TT; m += NGW) {
        const float* src; int bi;
        if (m < T) { src = p.in[I_X] + (size_t)m * D; bi = m >> 11; } else { src = p.in[I_CTX] + (size_t)(m - T) * D; bi = 32; }
        f32x4 x[4], h[4]; row_ld_f32(src, lane, x);
        const float rstd = rsqrtf(row_ss(x) * (1.f / D) + RMS_EPS);
        const float* md = MOD + (size_t)bi * NMOD;
        row_modulate(x, rstd, g, md, md + D, lane, h);
        row_st_bf16(H + (size_t)m * D, lane, h);
    }
}
__device__ __forceinline__ void ph_mid(const Params& p, int l, const bf16* MIX, bf16* H2, bool has_mix, int lane, int wave) {
    const int gw = blockIdx.x * NWAVES + wave, NGW = gridDim.x * NWAVES;
    const float* MOD = (const float*)(p.ws + WS_MOD) + (size_t)l * 33 * NMOD;
    const float* g1 = p.in[I_NORMG] + (size_t)(l * 4 + 1) * D; const float* g2 = p.in[I_NORMG] + (size_t)(l * 4 + 2) * D;
    const float* xin = l == 0 ? p.in[I_X] : p.out;
    for (int m = gw; m < T; m += NGW) {
        const float* md = MOD + (size_t)(m >> 11) * NMOD;
        f32x4 x[4], h[4]; row_ld_f32(xin + (size_t)m * D, lane, x);
        if (has_mix) { f32x4 mx[4]; row_ld_bf16(MIX + (size_t)m * D, lane, mx);
            const float r = rsqrtf(row_ss(mx) * (1.f / D) + RMS_EPS);
            const f32x4* gp = (const f32x4*)g1 + lane; const f32x4* gm = (const f32x4*)(md + 2 * D) + lane;
#pragma unroll
            for (int j = 0; j < 4; ++j) x[j] = x[j] + gm[64 * j] * (mx[j] * r * gp[64 * j]); }
        row_st_f32(p.out + (size_t)m * D, lane, x);
        const float rstd = rsqrtf(row_ss(x) * (1.f / D) + RMS_EPS);
        row_modulate(x, rstd, g2, md + 3 * D, md + 4 * D, lane, h);
        row_st_bf16(H2 + (size_t)m * D, lane, h);
    }
}
__device__ __forceinline__ void ph_combine(const Params& p, int l, int ch, const bf16* Y, bf16* Hn, int lane, int wave) {
    const int gw = blockIdx.x * NWAVES + wave, NGW = gridDim.x * NWAVES;
    const float* MOD = (const float*)(p.ws + WS_MOD) + (size_t)l * 33 * NMOD;
    const float* g3 = p.in[I_NORMG] + (size_t)(l * 4 + 3) * D;
    const int* PSLOT = (const int*)(p.ws + WS_PSLOT); const float* WTS = (const float*)(p.ws + WS_WTS);
    for (int mm = gw; mm < CHT; mm += NGW) { const int m = ch * CHT + mm;
        const float* md = MOD + (size_t)(m >> 11) * NMOD;
        f32x4 a[4];
#pragma unroll
        for (int j = 0; j < 4; ++j) a[j] = (f32x4){0.f, 0.f, 0.f, 0.f};
#pragma unroll
        for (int k = 0; k < 9; ++k) { const int slot = PSLOT[(size_t)m * 16 + k]; const float w = k < 8 ? WTS[(size_t)m * 8 + k] : 1.f;
            f32x4 y[4]; row_ld_bf16(Y + (size_t)slot * D, lane, y);
#pragma unroll
            for (int j = 0; j < 4; ++j) a[j] = a[j] + y[j] * w; }
        const float r = rsqrtf(row_ss(a) * (1.f / D) + RMS_EPS);
        f32x4 x[4]; row_ld_f32(p.out + (size_t)m * D, lane, x);
        const f32x4* gp = (const f32x4*)g3 + lane; const f32x4* gf = (const f32x4*)(md + 5 * D) + lane;
#pragma unroll
        for (int j = 0; j < 4; ++j) x[j] = x[j] + gf[64 * j] * (a[j] * r * gp[64 * j]);
        row_st_f32(p.out + (size_t)m * D, lane, x);
        if (l == 0) { const float* md1 = MOD + (size_t)(33 + (m >> 11)) * NMOD; f32x4 h[4];
            const float rstd = rsqrtf(row_ss(x) * (1.f / D) + RMS_EPS);
            row_modulate(x, rstd, p.in[I_NORMG] + (size_t)4 * D, md1, md1 + D, lane, h);
            row_st_bf16(Hn + (size_t)m * D, lane, h); }
    }
}

struct DenseSched { int NN, NU, G, c, NMs;
    __device__ __forceinline__ bool next(int i, Unit& u) const { const int L = i * G + c; if (L >= NU) return false; if (NMs > 0) { u.pm = L % NMs; u.pn = L / NMs; } else { u.pm = L / NN; u.pn = L % NN; } return true; }
    __device__ __forceinline__ int arow(int r) const { return r; } };
struct EpiBf16 { static constexpr bool PERM = true; bf16* O; size_t ldc; int cmask;
    __device__ __forceinline__ void operator()(const f32x4 (&acc)[2][2][4][2], const Unit& u, int wr, int wc, int fr, int fq) const {
        const int row0 = u.pm * BM + wr * 64 + fr, col0 = (u.pn & cmask) * BM + wc * 32 + 8 * fq;
#pragma unroll
        for (int ai = 0; ai < 2; ++ai)
#pragma unroll
            for (int m = 0; m < 4; ++m) { bf16* rowp = O + (size_t)(row0 + ai * HALF + m * 16) * ldc + col0;
#pragma unroll
                for (int bj = 0; bj < 2; ++bj) { const f32x4 v0 = acc[ai][bj][m][0], v1 = acc[ai][bj][m][1];
                    u32x4 w; w.x = cvt_pk_bf16(v0[0], v0[1]); w.y = cvt_pk_bf16(v0[2], v0[3]); w.z = cvt_pk_bf16(v1[0], v1[1]); w.w = cvt_pk_bf16(v1[2], v1[3]);
                    *(u32x4*)(rowp + bj * HALF) = w; } }
    } };
struct EpiRouter { static constexpr bool PERM = false; float* LOG;
    __device__ __forceinline__ void operator()(const f32x4 (&acc)[2][2][4][2], const Unit& u, int wr, int wc, int fr, int fq) const {
        if (wc >= 2) return;
        const int row0 = u.pm * BM + wr * 64 + fr, col0 = wc * 32 + 4 * fq;
#pragma unroll
        for (int ai = 0; ai < 2; ++ai)
#pragma unroll
            for (int m = 0; m < 4; ++m) { float* rowp = LOG + (size_t)(row0 + ai * HALF + m * 16) * 64 + col0;
#pragma unroll
                for (int n = 0; n < 2; ++n) *(f32x4*)(rowp + n * 16) = acc[ai][0][m][n]; }
    } };
struct MoeSched { const LAS int* te; const int* sort; int NU, G, c, sh, per;
    __device__ __forceinline__ bool next(int i, Unit& u) const { const int L = i * G + c; if (L >= NU) return false; const int tile = L >> sh; u.pm = tile; u.pn = te[tile] * per + (L & (per - 1)); return true; }
    __device__ __forceinline__ int arow(int r) const { return sort ? sort[r] : r; } };
struct EpiSwiglu { static constexpr bool PERM = true; bf16* ACT;
    __device__ __forceinline__ void operator()(const f32x4 (&acc)[2][2][4][2], const Unit& u, int wr, int wc, int fr, int fq) const {
        const int row0 = u.pm * BM + wr * 64 + fr, col0 = (u.pn & 1) * 128 + wc * 32 + 8 * fq;
#pragma unroll
        for (int ai = 0; ai < 2; ++ai)
#pragma unroll
            for (int m = 0; m < 4; ++m) { bf16* rowp = ACT + (size_t)(row0 + ai * HALF + m * 16) * DE + col0;
                const f32x4 g0 = acc[ai][0][m][0], g1 = acc[ai][0][m][1], u0 = acc[ai][1][m][0], u1 = acc[ai][1][m][1];
                float o[8];
#pragma unroll
                for (int q = 0; q < 4; ++q) { o[q] = siluf_(g0[q]) * u0[q]; o[4 + q] = siluf_(g1[q]) * u1[q]; }
                u32x4 w; w.x = cvt_pk_bf16(o[0], o[1]); w.y = cvt_pk_bf16(o[2], o[3]); w.z = cvt_pk_bf16(o[4], o[5]); w.w = cvt_pk_bf16(o[6], o[7]);
                *(u32x4*)rowp = w; }
    } };
__device__ __forceinline__ int moe_tables(const Params& p, int ch, LAS unsigned char* lds, int tid) {
    LAS int* TE = (LAS int*)(lds + LDS_TAB);
    LAS int* TB = TE + 640;
    LAS int* CN = TB + 80;
    const int* BC = (const int*)(p.ws + WS_BC) + (size_t)ch * 64 * 64;
    __syncthreads();
    if (tid < 64) CN[tid] = 0;
    __syncthreads();
#pragma unroll 1
    for (int i = tid; i < 4096; i += NTHR) __hip_atomic_fetch_add(&CN[i & 63], BC[i], __ATOMIC_RELAXED, __HIP_MEMORY_SCOPE_WORKGROUP);
    __syncthreads();
    if (tid == 0) { int b = 0;
#pragma unroll 1
        for (int e = 0; e < 64; ++e) { TB[e] = b; b += (CN[e] + 255) >> 8; } TB[64] = b; TB[65] = b + 64; }
    __syncthreads();
    const int NT = TB[65];
#pragma unroll 1
    for (int i = tid; i < NT; i += NTHR) { int e = 0;
#pragma unroll 1
        while (e < 64 && i >= TB[e + 1]) ++e;
        TE[i] = e; }
    __syncthreads();
    return NT;
}

__device__ __forceinline__ void ph_route_a(const Params& p, int l, const float* LOG, LAS unsigned char* lds, int tid) {
    LAS float* SC = (LAS float*)lds;
    LAS float* RBs = (LAS float*)(lds + 68 * 1024);
    LAS unsigned* MASK = (LAS unsigned*)(lds + 69 * 1024);
    const int b = blockIdx.x, tok0 = 256 * b;
#pragma unroll 1
    for (int i = tid; i < 256 * 64; i += NTHR) { const int t = i >> 6, e = i & 63; SC[t * 65 + e] = sigmoidf_(LOG[(size_t)(tok0 + t) * 64 + e]); }
    if (tid < 64) RBs[tid] = p.in[I_RB][l * 64 + tid];
    MASK[tid] = 0u;
    __syncthreads();
    int eidx[8]; float wts[8];
    if (tid < 256) { const int t = tid; const LAS float* sc = SC + t * 65;
        float gs[8];
#pragma unroll
        for (int g = 0; g < 8; ++g) { float m1 = -3.0e38f, m2 = -3.0e38f;
#pragma unroll
            for (int j = 0; j < 8; ++j) { const float v = sc[8 * g + j] + RBs[8 * g + j]; if (v > m1) { m2 = m1; m1 = v; } else if (v > m2) m2 = v; }
            gs[g] = m1 + m2; }
        unsigned gmask = 0u;
#pragma unroll
        for (int r = 0; r < 4; ++r) { float best = -3.0e38f; int bi = 0; bool found = false;
#pragma unroll
            for (int g = 0; g < 8; ++g) { const bool free_ = ((gmask >> g) & 1u) == 0u; if (free_ && (!found || gs[g] > best)) { best = gs[g]; bi = g; found = true; } }
            gmask |= 1u << bi; }
        unsigned long long taken = 0ull; float ssum = 0.f;
#pragma unroll
        for (int k = 0; k < 8; ++k) { float best = -3.0e38f; int be = -1;
#pragma unroll 1
            for (int e = 0; e < 64; ++e) { const bool ok = ((gmask >> (e >> 3)) & 1u) && !((taken >> e) & 1ull); const float v = sc[e] + RBs[e]; if (ok && (be < 0 || v > best)) { best = v; be = e; } }
            taken |= 1ull << be; eidx[k] = be; wts[k] = sc[be]; ssum += wts[k]; }
        const float inv = 2.5f / ssum;
#pragma unroll
        for (int k = 0; k < 8; ++k) { wts[k] *= inv; __hip_atomic_fetch_or(&MASK[eidx[k] * 8 + (t >> 5)], 1u << (t & 31), __ATOMIC_RELAXED, __HIP_MEMORY_SCOPE_WORKGROUP); }
    }
    __syncthreads();
    if (tid < 256) { const int t = tid; int* EIDX = (int*)(p.ws + WS_EIDX); float* WTS = (float*)(p.ws + WS_WTS);
#pragma unroll
        for (int k = 0; k < 8; ++k) { const int e = eidx[k]; int r = 0;
#pragma unroll 1
            for (int w = 0; w < (t >> 5); ++w) r += __popc(MASK[e * 8 + w]);
            r += __popc(MASK[e * 8 + (t >> 5)] & ((1u << (t & 31)) - 1u));
            EIDX[(size_t)(tok0 + t) * 8 + k] = e | (r << 8); WTS[(size_t)(tok0 + t) * 8 + k] = wts[k]; } }
    if (tid < 64) { int c = 0;
#pragma unroll
        for (int w = 0; w < 8; ++w) c += __popc(MASK[tid * 8 + w]);
        ((int*)(p.ws + WS_BC))[b * 64 + tid] = c; }
    __syncthreads();
}
__device__ __forceinline__ void ph_route_b(const Params& p, LAS unsigned char* lds, int tid) {
    LAS int* BCS = (LAS int*)lds;
    LAS int* CNT = BCS + 4096; LAS int* PRE = CNT + 64; LAS int* SEG = PRE + 64;
    const int b = blockIdx.x, ch = b >> 6, bl = b & 63;
    const int* BC = (const int*)(p.ws + WS_BC) + (size_t)ch * 64 * 64;
#pragma unroll 1
    for (int i = tid; i < 4096; i += NTHR) BCS[i] = BC[i];
    __syncthreads();
    if (tid < 64) { int c = 0, pr = 0;
#pragma unroll 1
        for (int i = 0; i < 64; ++i) { const int v = BCS[i * 64 + tid]; c += v; if (i < bl) pr += v; } CNT[tid] = c; PRE[tid] = pr; }
    __syncthreads();
    if (tid == 0) { int base = 0;
#pragma unroll 1
        for (int e = 0; e < 64; ++e) { SEG[e] = base; base += ((CNT[e] + 255) >> 8) << 8; } SEG[64] = base; }
    __syncthreads();
    int* SORT = (int*)(p.ws + WS_SORT) + (size_t)ch * CHROWS; int* PSLOT = (int*)(p.ws + WS_PSLOT); const int* EIDX = (const int*)(p.ws + WS_EIDX);
    if (tid < 256) { const int tok = 256 * b + tid;
#pragma unroll
        for (int k = 0; k < 8; ++k) { const int w = EIDX[(size_t)tok * 8 + k], e = w & 255, r = w >> 8; const int slot = SEG[e] + PRE[e] + r; SORT[slot] = tok; PSLOT[(size_t)tok * 16 + k] = slot; }
        const int s8 = SEG[64] + (tok - ch * CHT); SORT[s8] = tok; PSLOT[(size_t)tok * 16 + 8] = s8; }
    { const int e = bl, lo = SEG[e] + CNT[e], hi = SEG[e] + (((CNT[e] + 255) >> 8) << 8); for (int s = lo + tid; s < hi; s += NTHR) SORT[s] = ch * CHT; }
    __syncthreads();
}

typedef float f32x16 __attribute__((ext_vector_type(16)));
__device__ __forceinline__ void ph_sconv(const Params& p, const bf16* UT, bf16* UC, int tid) {
    const float* cw = p.in[I_CONVHYW]; const float* cbias = p.in[I_CONVHYB];
    const unsigned NIT = 3072u * 32u * 256u; const unsigned gt = blockIdx.x * NTHR + tid, NG = gridDim.x * NTHR;
#pragma unroll 1
    for (unsigned it = gt; it < NIT; it += NG) {
        const unsigned c = it >> 13, k = it & 255u; const size_t base = (size_t)it * 8;
        const v4u w = *(const v4u*)(UT + base);
        const float w0 = cw[c], w1 = cw[3072 + c], w2 = cw[6144 + c], bb = cbias[c];
        float x[10];
        x[0] = k > 0 ? bf1(UT[base - 1]) : 0.f; x[9] = k < 255 ? bf1(UT[base + 8]) : 0.f;
        x[1] = bf_lo(w.x); x[2] = bf_hi(w.x); x[3] = bf_lo(w.y); x[4] = bf_hi(w.y); x[5] = bf_lo(w.z); x[6] = bf_hi(w.z); x[7] = bf_lo(w.w); x[8] = bf_hi(w.w);
        float o[8];
#pragma unroll
        for (int j = 0; j < 8; ++j) o[j] = bb + w0 * x[j] + w1 * x[j + 1] + w2 * x[j + 2];
        v4u r; r.x = pk2(o[0], o[1]); r.y = pk2(o[2], o[3]); r.z = pk2(o[4], o[5]); r.w = pk2(o[6], o[7]);
        *(v4u*)(UC + base) = r;
    }
}
constexpr int LC_CPB = 8224, LC_VBP = 1040, LC_VB0 = 8 * LC_CPB, LC_VBSZ = 32 * LC_VBP;
__device__ __forceinline__ void lconv_unit(const bf16* v, const bf16* F, const bf16* xg, float fb, bf16* out, LAS unsigned char* lds, int tid, int lane, int wave) {
    __syncthreads();
#pragma unroll 1
    for (int idx = tid; idx < 8 * 2056; idx += NTHR) { const int a = idx / 2056, m = (idx % 2056) * 2; const int x0 = 3079 - m - a, x1 = x0 - 1;
        const unsigned lo = (x0 >= 0 && x0 <= 2047) ? (unsigned)F[x0] : 0u, hi = (x1 >= 0 && x1 <= 2047) ? (unsigned)F[x1] : 0u;
        *(LAS unsigned*)(lds + a * LC_CPB + m * 2) = lo | (hi << 16); }
    const int r = lane & 31, h = lane >> 5, a = (7 - r) & 7;
    const LAS unsigned char* cpA = lds + a * LC_CPB + 2 * (1023 - r + 8 * h - a + 1032) - 512 * wave;
    const int laneB = r * LC_VBP + 16 * h;
#define LC_DMA(ch, buf) do { _Pragma("unroll") for (int q = 0; q < 4; ++q) { const int row = wave * 4 + q; \
        __builtin_amdgcn_global_load_lds((const unsigned*)(v + (size_t)row * 2048 + (ch) * 512 + lane * 8), (LAS unsigned*)(lds + LC_VB0 + (buf) * LC_VBSZ + row * LC_VBP), 16, 0, 0); } } while (0)
    LC_DMA(0, 0);
    asm volatile("s_waitcnt vmcnt(0)" ::: "memory");
    __syncthreads();
    f32x16 acc[8];
#pragma unroll
    for (int i = 0; i < 8; ++i)
#pragma unroll
        for (int q = 0; q < 16; ++q) acc[i][q] = 0.f;
    bf16x8 E[8], O[8];
#pragma unroll
    for (int i = 1; i < 8; ++i) { E[(8 - i) & 7] = *(const LAS bf16x8*)(cpA + 32 * (-2 * i)); O[(8 - i) & 7] = *(const LAS bf16x8*)(cpA + 32 * (-2 * i + 1)); }
#pragma unroll 1
    for (int ch = 0; ch < 4; ++ch) {
        if (ch < 3) LC_DMA(ch + 1, (ch + 1) & 1);
        const LAS unsigned char* vb = lds + LC_VB0 + (ch & 1) * LC_VBSZ + laneB;
#pragma unroll 1
        for (int half = 0; half < 2; ++half) {
            const LAS unsigned char* ca = cpA + 64 * (ch * 16 + half * 8); const LAS unsigned char* vbh = vb + 64 * (half * 8);
#pragma unroll
            for (int mm = 0; mm < 8; ++mm) {
                E[mm] = *(const LAS bf16x8*)(ca + 64 * mm); O[mm] = *(const LAS bf16x8*)(ca + 64 * mm + 32);
                const bf16x8 b0 = *(const LAS bf16x8*)(vbh + 64 * mm), b1 = *(const LAS bf16x8*)(vbh + 64 * mm + 32);
#pragma unroll
                for (int i = 0; i < 8; ++i) { acc[i] = __builtin_amdgcn_mfma_f32_32x32x16_bf16(E[(mm - i) & 7], b0, acc[i], 0, 0, 0);
                                              acc[i] = __builtin_amdgcn_mfma_f32_32x32x16_bf16(O[(mm - i) & 7], b1, acc[i], 0, 0, 0); }
            }
        }
        asm volatile("s_waitcnt vmcnt(0)" ::: "memory");
        __syncthreads();
    }
#undef LC_DMA
#pragma unroll
    for (int i = 0; i < 8; ++i)
#pragma unroll
        for (int g = 0; g < 4; ++g) { const size_t off = (size_t)r * 2048 + 256 * wave + 32 * i + 8 * g + 4 * h;
            const v2u vv = *(const v2u*)(v + off), xx = *(const v2u*)(xg + off);
            const float o0 = bf_lo(xx.x) * (acc[i][4 * g + 0] + bf_lo(vv.x) * fb), o1 = bf_hi(xx.x) * (acc[i][4 * g + 1] + bf_hi(vv.x) * fb);
            const float o2 = bf_lo(xx.y) * (acc[i][4 * g + 2] + bf_lo(vv.y) * fb), o3 = bf_hi(xx.y) * (acc[i][4 * g + 3] + bf_hi(vv.y) * fb);
            v2u w; w.x = pk2(o0, o1); w.y = pk2(o2, o3); *(v2u*)(out + off) = w; }
}
__device__ __forceinline__ void ph_lconv(const Params& p, int o, const bf16* IN, const bf16* UC, bf16* OUT, LAS unsigned char* lds, int tid, int lane, int wave) {
    const bf16* FILT = (const bf16*)(p.ws + WS_FILT);
#pragma unroll 1
    for (int c = blockIdx.x; c < 1024; c += gridDim.x)
        lconv_unit(IN + (size_t)c * T, FILT + (size_t)(o * 1024 + c) * 2048, UC + (size_t)((1 + o) * 1024 + c) * T, p.in[I_FBIAS][o * 1024 + c], OUT + (size_t)c * T, lds, tid, lane, wave);
}
__device__ __forceinline__ void ph_transpose(const bf16* Y2T, bf16* Y2, LAS unsigned char* lds, int lane, int wave) {
    LAS unsigned char* tl = lds + wave * 16384;
    const int gw = blockIdx.x * NWAVES + wave, NGW = gridDim.x * NWAVES;
#pragma unroll 1
    for (int tile = gw; tile < 16 * 1024; tile += NGW) { const int c0 = (tile & 15) * 64, t0 = (tile >> 4) * 64;
#pragma unroll
        for (int rr = 0; rr < 8; ++rr) { const int row = rr * 8 + (lane >> 3), pc = lane & 7;
            *(LAS v4u*)(tl + row * 144 + pc * 16) = *(const v4u*)(Y2T + (size_t)(c0 + row) * T + t0 + pc * 8); }
        LDS_WAIT(); asm volatile("" ::: "memory");
#pragma unroll
        for (int rr = 0; rr < 8; ++rr) { const int tk = rr * 8 + (lane >> 3), cp = (lane & 7) * 8;
            unsigned short e[8];
#pragma unroll
            for (int j = 0; j < 8; ++j) e[j] = *(const LAS unsigned short*)(tl + (cp + j) * 144 + tk * 2);
            v4u w; w.x = e[0] | ((unsigned)e[1] << 16); w.y = e[2] | ((unsigned)e[3] << 16); w.z = e[4] | ((unsigned)e[5] << 16); w.w = e[6] | ((unsigned)e[7] << 16);
            *(v4u*)(Y2 + (size_t)(t0 + tk) * D + c0 + cp) = w; }
        LDS_WAIT(); asm volatile("" ::: "memory");
    }
}

constexpr float QSCALE = 0.125f * 1.4426950408889634f;
struct InprojSched { int G, c;
    __device__ __forceinline__ bool next(int i, Unit& u) const { const int L = i * G + c; if (L >= 3840 + 288) return false;
        if (L < 3840) { u.pm = L / 15; u.pn = L % 15; } else { const int q = L - 3840; u.pm = 256 + q / 9; u.pn = 6 + q % 9; } return true; }
    __device__ __forceinline__ int arow(int r) const { return r; } };
struct EpiInproj { static constexpr bool PERM = true; unsigned char* big; const float* rope; float* gates; const float* gate_b;
    __device__ __forceinline__ void operator()(const f32x4 (&acc)[2][2][4][2], const Unit& u, int wr, int wc, int fr, int fq) const {
        const bool ctx = u.pm >= 256; const int b = ctx ? u.pm - 256 : (u.pm >> 3), r0 = ctx ? 0 : (u.pm & 7) * 256;
        if (u.pn == 14) {
            if (wc != 0 || fq >= 2) return;
            const f32x4 gb0 = *(const f32x4*)(gate_b + 8 * fq), gb1 = *(const f32x4*)(gate_b + 8 * fq + 4);
#pragma unroll
            for (int ai = 0; ai < 2; ++ai)
#pragma unroll
                for (int m = 0; m < 4; ++m) { const int rr = r0 + wr * 64 + fr + ai * HALF + m * 16; const size_t grow = ctx ? (size_t)T + b * LC + rr : (size_t)b * SEQ + rr;
                    float* gp = gates + grow * 16 + 8 * fq; *(f32x4*)gp = acc[ai][0][m][0] + gb0; *(f32x4*)(gp + 4) = acc[ai][0][m][1] + gb1; }
            return; }
        const int t = u.pn >> 1;
        constexpr size_t offs[7] = {A0_QA, A0_BQ, A0_BO, A0_KA, A0_VA, A0_BK, A0_BV};
        const bool kv = t >= 3;
        size_t toff = A0_QA;
#pragma unroll
        for (int q = 0; q < 7; ++q) if (t == q) toff = offs[q];
        bf16* O = (bf16*)(big + toff) + (size_t)b * (kv ? (SEQ + LC) : SEQ) * 512 + (size_t)((kv && !ctx) ? LC : 0) * 512;
        const bool rope_on = (t == 0 || t == 3) && !ctx; const float qs = t == 0 ? QSCALE : 1.f;
        const int col0 = (u.pn & 1) * 256 + wc * 32 + 8 * fq;
#pragma unroll
        for (int ai = 0; ai < 2; ++ai)
#pragma unroll
            for (int m = 0; m < 4; ++m) { const int rr = r0 + wr * 64 + fr + ai * HALF + m * 16; bf16* rowp = O + (size_t)rr * 512 + col0;
                f32x4 cs0 = (f32x4){1.f, 0.f, 1.f, 0.f}, cs1 = cs0;
                if (rope_on) { const int pos = (wc & 1) ? (rr & 63) : (rr >> 6); const float* rp = rope + (size_t)(pos * 16 + 4 * fq) * 2; cs0 = *(const f32x4*)rp; cs1 = *(const f32x4*)(rp + 4); }
#pragma unroll
                for (int bj = 0; bj < 2; ++bj) { const f32x4 x0 = acc[ai][bj][m][0], x1 = acc[ai][bj][m][1];
                    f32x4 o0, o1;
                    o0[0] = x0[0] * cs0[0] - x1[0] * cs0[1]; o1[0] = x1[0] * cs0[0] + x0[0] * cs0[1];
                    o0[1] = x0[1] * cs0[2] - x1[1] * cs0[3]; o1[1] = x1[1] * cs0[2] + x0[1] * cs0[3];
                    o0[2] = x0[2] * cs1[0] - x1[2] * cs1[1]; o1[2] = x1[2] * cs1[0] + x0[2] * cs1[1];
                    o0[3] = x0[3] * cs1[2] - x1[3] * cs1[3]; o1[3] = x1[3] * cs1[2] + x0[3] * cs1[3];
                    o0 = o0 * qs; o1 = o1 * qs;
                    u32x4 w; w.x = cvt_pk_bf16(o0[0], o0[1]); w.y = cvt_pk_bf16(o0[2], o0[3]); w.z = cvt_pk_bf16(o1[0], o1[1]); w.w = cvt_pk_bf16(o1[2], o1[3]);
                    *(u32x4*)(rowp + bj * HALF) = w; } }
    } };
__device__ __forceinline__ void ph_transpose_b(const bf16* src, bf16* dst, int NBt, int R, int C, LAS unsigned char* lds, int lane, int wave) {
    LAS unsigned char* tl = lds + wave * 16384;
    const int gw = blockIdx.x * NWAVES + wave, NGW = gridDim.x * NWAVES; const int tr = R / 64, tc = C / 64, per = tr * tc;
#pragma unroll 1
    for (int tile = gw; tile < NBt * per; tile += NGW) { const int bt = tile / per, q = tile % per, c0 = (q % tc) * 64, r0 = (q / tc) * 64;
        const bf16* s = src + (size_t)bt * R * C; bf16* d = dst + (size_t)bt * R * C;
#pragma unroll
        for (int rr = 0; rr < 8; ++rr) { const int row = rr * 8 + (lane >> 3), pc = lane & 7;
            *(LAS v4u*)(tl + row * 144 + pc * 16) = *(const v4u*)(s + (size_t)(r0 + row) * C + c0 + pc * 8); }
        LDS_WAIT(); asm volatile("" ::: "memory");
#pragma unroll
        for (int rr = 0; rr < 8; ++rr) { const int cc = rr * 8 + (lane >> 3), rp = (lane & 7) * 8;
            unsigned short e[8];
#pragma unroll
            for (int j = 0; j < 8; ++j) e[j] = *(const LAS unsigned short*)(tl + (rp + j) * 144 + cc * 2);
            v4u w; w.x = e[0] | ((unsigned)e[1] << 16); w.y = e[2] | ((unsigned)e[3] << 16); w.z = e[4] | ((unsigned)e[5] << 16); w.w = e[6] | ((unsigned)e[7] << 16);
            *(v4u*)(d + (size_t)(c0 + cc) * R + r0 + rp) = w; }
        LDS_WAIT(); asm volatile("" ::: "memory");
    }
}

constexpr int AT_KP = 272, AT_VP = 144, AT_KB = 64 * AT_KP, AT_VB = 128 * AT_VP, AT_STAGE = AT_KB + AT_VB;
__device__ __forceinline__ void ph_attn(const Params& p, unsigned char* big, LAS unsigned char* lds, int tid, int lane, int wave) {
    const bf16* QA = (const bf16*)(big + A0_QA); const bf16* KA = (const bf16*)(big + A0_KA); const bf16* VT = (const bf16*)(big + A0_VT); bf16* MIXIN = (bf16*)(big + A0_MIXIN);
    const int comp = wave >> 2, qw = wave & 3, r = lane & 31, hh = lane >> 5;
    float lam; { const float* lv = p.in[I_DLAM]; const float a = wave_sum(lv[lane] * lv[64 + lane]), b2 = wave_sum(lv[128 + lane] * lv[192 + lane]); lam = expf(a) - expf(b2) + 0.2f; }
#pragma unroll 1
    for (int unit = blockIdx.x; unit < 2048; unit += gridDim.x) {
        const int b = unit >> 6, h = (unit >> 4) & 3, qblk = unit & 15, q0 = qblk * 128 + qw * 32;
        const bf16* Kg = KA + (size_t)b * (SEQ + LC) * 512 + h * 128; const bf16* Vg = VT + ((size_t)b * 512 + h * 128) * (SEQ + LC);
        bf16x8 qf[4];
#pragma unroll
        for (int ds = 0; ds < 4; ++ds) qf[ds] = *(const bf16x8*)(QA + ((size_t)b * SEQ + q0 + r) * 512 + h * 128 + comp * 64 + ds * 16 + hh * 8);
        f32x16 oacc[4];
#pragma unroll
        for (int i = 0; i < 4; ++i)
#pragma unroll
            for (int q = 0; q < 16; ++q) oacc[i][q] = 0.f;
        float m_run = -1.0e30f, l_run = 0.f;
        v4u pre[4];
#define AT_LOADG(kt) do { _Pragma("unroll") for (int q = 0; q < 2; ++q) { const int idx = tid + NTHR * q; \
            pre[q] = *(const v4u*)(Kg + (size_t)((kt) * 64 + (idx >> 4)) * 512 + (idx & 15) * 8); \
            pre[2 + q] = *(const v4u*)(Vg + (size_t)(idx >> 3) * (SEQ + LC) + (kt) * 64 + (idx & 7) * 8); } } while (0)
#define AT_STORES(buf) do { _Pragma("unroll") for (int q = 0; q < 2; ++q) { const int idx = tid + NTHR * q; \
            *(LAS v4u*)(lds + (buf) * AT_STAGE + (idx >> 4) * AT_KP + (idx & 15) * 16) = pre[q]; \
            *(LAS v4u*)(lds + (buf) * AT_STAGE + AT_KB + (idx >> 3) * AT_VP + (idx & 7) * 16) = pre[2 + q]; } } while (0)
        __syncthreads();
        AT_LOADG(0); AT_STORES(0);
        __syncthreads();
#pragma unroll 1
        for (int kt = 0; kt < 36; ++kt) {
            if (kt < 35) AT_LOADG(kt + 1);
            const LAS unsigned char* Kt = lds + (kt & 1) * AT_STAGE; const LAS unsigned char* Vt = Kt + AT_KB;
            f32x16 sacc[2];
#pragma unroll
            for (int kb = 0; kb < 2; ++kb) {
#pragma unroll
                for (int q = 0; q < 16; ++q) sacc[kb][q] = 0.f;
#pragma unroll
                for (int ds = 0; ds < 4; ++ds) { const bf16x8 kf = *(const LAS bf16x8*)(Kt + (32 * kb + r) * AT_KP + comp * 128 + ds * 32 + hh * 16);
                    sacc[kb] = __builtin_amdgcn_mfma_f32_32x32x16_bf16(kf, qf[ds], sacc[kb], 0, 0, 0); } }
            float mx = sacc[0][0];
#pragma unroll
            for (int kb = 0; kb < 2; ++kb)
#pragma unroll
                for (int q = 0; q < 16; ++q) mx = fmaxf(mx, sacc[kb][q]);
            mx = fmaxf(mx, shx(mx, 32));
            const float m_new = fmaxf(m_run, mx), alpha = exp2f(m_run - m_new); m_run = m_new;
            float ps = 0.f;
#pragma unroll
            for (int kb = 0; kb < 2; ++kb)
#pragma unroll
                for (int q = 0; q < 16; ++q) { const float e = exp2f(sacc[kb][q] - m_new); sacc[kb][q] = e; ps += e; }
            l_run = l_run * alpha + ps;
#pragma unroll
            for (int i = 0; i < 4; ++i) oacc[i] = oacc[i] * alpha;
#pragma unroll
            for (int kb = 0; kb < 2; ++kb)
#pragma unroll
                for (int s = 0; s < 2; ++s) {
                    u32x4 pw; pw.x = cvt_pk_bf16(sacc[kb][8 * s + 0], sacc[kb][8 * s + 1]); pw.y = cvt_pk_bf16(sacc[kb][8 * s + 2], sacc[kb][8 * s + 3]);
                    pw.z = cvt_pk_bf16(sacc[kb][8 * s + 4], sacc[kb][8 * s + 5]); pw.w = cvt_pk_bf16(sacc[kb][8 * s + 6], sacc[kb][8 * s + 7]);
                    const bf16x8 pf = __builtin_bit_cast(bf16x8, pw);
#pragma unroll
                    for (int dvb = 0; dvb < 4; ++dvb) { const LAS unsigned char* vp = Vt + (32 * dvb + r) * AT_VP + (32 * kb + 16 * s + 4 * hh) * 2;
                        const u32x2 lo = *(const LAS u32x2*)vp, hi = *(const LAS u32x2*)(vp + 16);
                        u32x4 vw; vw.x = lo.x; vw.y = lo.y; vw.z = hi.x; vw.w = hi.y;
                        oacc[dvb] = __builtin_amdgcn_mfma_f32_32x32x16_bf16(__builtin_bit_cast(bf16x8, vw), pf, oacc[dvb], 0, 0, 0); } }
            if (kt < 35) AT_STORES((kt + 1) & 1);
            __syncthreads();
        }
#undef AT_LOADG
#undef AT_STORES
        const float lsum = l_run + shx(l_run, 32), inv = 1.f / lsum;
        LAS float* X = (LAS float*)lds;
        if (comp == 1) {
#pragma unroll
            for (int dvb = 0; dvb < 4; ++dvb)
#pragma unroll
                for (int q = 0; q < 16; ++q) X[(qw * 64 + dvb * 16 + q) * 64 + lane] = oacc[dvb][q] * inv; }
        __syncthreads();
        if (comp == 0) {
            float ss = 0.f;
#pragma unroll
            for (int dvb = 0; dvb < 4; ++dvb)
#pragma unroll
                for (int q = 0; q < 16; ++q) { const float o = oacc[dvb][q] * inv - lam * X[(qw * 64 + dvb * 16 + q) * 64 + lane]; oacc[dvb][q] = o; ss += o * o; }
            ss += shx(ss, 32);
            const float rn = rsqrtf(ss * (1.f / 128.f) + RMS_EPS) * 0.8f;
            const float* ga = p.in[I_HGA] + h * 128; bf16* orow = MIXIN + ((size_t)b * SEQ + q0 + r) * D + h * 128;
#pragma unroll
            for (int dvb = 0; dvb < 4; ++dvb)
#pragma unroll
                for (int g = 0; g < 4; ++g) { const int dv = 32 * dvb + 8 * g + 4 * hh; const f32x4 gg = *(const f32x4*)(ga + dv);
                    v2u w; w.x = pk2(oacc[dvb][4 * g + 0] * rn * gg[0], oacc[dvb][4 * g + 1] * rn * gg[1]); w.y = pk2(oacc[dvb][4 * g + 2] * rn * gg[2], oacc[dvb][4 * g + 3] * rn * gg[3]);
                    *(v2u*)(orow + dv) = w; }
        }
    }
    __syncthreads();
}

constexpr int ML_P = 272, ML_TILE = 64 * ML_P;
constexpr int ML_VOFF = 3 * ML_TILE, ML_VSZ = 64 * 256;
constexpr int ML_RQ = ML_VOFF + 2 * ML_VSZ, ML_RSZ = 68 * 256, ML_RK = ML_RQ + ML_RSZ;
constexpr int ML_NOFF = ML_RK + ML_RSZ, ML_AOFF = ML_NOFF + 2 * 512;
constexpr int ML_CW = ML_AOFF + 8 * 256;
static_assert(ML_CW + 8 * 512 <= LDS_TAB, "mLSTM LDS map");
typedef short s16x4 __attribute__((ext_vector_type(4)));
__device__ __forceinline__ u32x2 tr16(const LAS unsigned char* p) { return __builtin_bit_cast(u32x2, __builtin_amdgcn_ds_read_tr16_b64_v4i16((LAS s16x4*)p)); }
__device__ __forceinline__ float logsigmoidf_(float x) { return x >= 0.f ? -__logf(1.f + __expf(-x)) : x - __logf(1.f + __expf(x)); }
__device__ __forceinline__ bf16x8 pack8(const f32x16& v, int s) { u32x4 w; w.x = cvt_pk_bf16(v[8 * s + 0], v[8 * s + 1]); w.y = cvt_pk_bf16(v[8 * s + 2], v[8 * s + 3]); w.z = cvt_pk_bf16(v[8 * s + 4], v[8 * s + 5]); w.w = cvt_pk_bf16(v[8 * s + 6], v[8 * s + 7]); return __builtin_bit_cast(bf16x8, w); }
__device__ __forceinline__ void ph_mlstm(const Params& p, unsigned char* big, LAS unsigned char* lds, int tid, int lane, int wave) {
    const int bid = blockIdx.x; if (bid >= 256) return;
    const int b = bid >> 3, h = (bid >> 1) & 3, dir = bid & 1;
    const bf16* BQ = (const bf16*)(big + A0_BQ) + (size_t)b * SEQ * 512 + h * 128;
    const bf16* BK = (const bf16*)(big + A0_BK) + (size_t)b * (SEQ + LC) * 512 + h * 128;
    const bf16* BV = (const bf16*)(big + A0_BV) + (size_t)b * (SEQ + LC) * 512 + h * 128;
    bf16* HB = (bf16*)(big + A0_HB) + (size_t)dir * T * 512 + (size_t)b * SEQ * 512 + h * 128;
    const float* GT = (const float*)(p.ws + WS_GATES);
    const float* cw = p.in[I_CONVABW]; const float* cb = p.in[I_CONVABB];
    const int eb = wave & 3, tb = wave >> 2, r = lane & 31, hh = lane >> 5;
    const int blk = (lane >> 4) & 1, tq = (lane & 15) >> 2, tp = lane & 3;
    LAS float* nbuf = (LAS float*)(lds + ML_NOFF); LAS float* aw = (LAS float*)(lds + ML_AOFF) + wave * 64;
    if (tid < 256) nbuf[tid] = 0.f;
    LAS float* cwl = (LAS float*)(lds + ML_CW);
    for (int i = tid; i < 1024; i += NTHR) { const int ten = i >> 9, j = (i >> 7) & 3, d = i & 127, ch = ten * 512 + h * 128 + d; cwl[i] = j < 3 ? cw[j * 1024 + ch] : cb[ch]; }
    f32x16 cacc[4];
#pragma unroll
    for (int i = 0; i < 4; ++i)
#pragma unroll
        for (int q = 0; q < 16; ++q) cacc[i][q] = 0.f;
    float m_state = 0.f;
    float a_c = 0.f, M_c = 0.f, b_c = 0.f, decay_c = 1.f, m_after = 0.f;
    float a_n = 0.f, M_n = 0.f, b_n = 0.f, w_n = 0.f, decay_n = 1.f, m_next = 0.f;
#define ML_POS(cc, t) ((cc) < 4 ? (dir ? 255 - ((cc) * 64 + (t)) : (cc) * 64 + (t)) : (dir ? 2047 - (((cc) - 4) * 64 + (t)) : ((cc) - 4) * 64 + (t)))
#define ML_GLOAD(cc, li_, fp_) do { const int pos_ = ML_POS(cc, lane); const size_t grow_ = (cc) < 4 ? (size_t)T + b * LC + pos_ : (size_t)b * SEQ + pos_; \
        li_ = GT[grow_ * 16 + dir * 8 + h]; fp_ = GT[grow_ * 16 + dir * 8 + 4 + h]; } while (0)
#define ML_SCAN(li_, fp_, m_in) do { const float lf_ = logsigmoidf_(fp_); \
        float bs_ = lf_; _Pragma("unroll") for (int o_ = 1; o_ < 64; o_ <<= 1) { const float v_ = shup(bs_, o_); if (lane >= o_) bs_ += v_; } \
        const float aa_ = (li_) - bs_; float pm_ = aa_; _Pragma("unroll") for (int o_ = 1; o_ < 64; o_ <<= 1) { const float v_ = shup(pm_, o_); if (lane >= o_) pm_ = fmaxf(pm_, v_); } \
        const float MM_ = fmaxf(m_in, pm_); const float M63_ = shidx(MM_, 63), b63_ = shidx(bs_, 63); \
        a_n = aa_; M_n = MM_; b_n = bs_; w_n = __expf(aa_ - M63_); decay_n = __expf((m_in) - M63_); m_next = b63_ + M63_; } while (0)
#define ML_DMA(cc, vbuf) do { const int lim_ = (cc) < 4 ? LC : SEQ, kvb_ = (cc) < 4 ? 0 : LC; \
        _Pragma("unroll 1") for (int ins_ = wave; ins_ < 17; ins_ += NWAVES) { const int rr_ = ins_ * 4 + (lane >> 4), pc_ = lane & 15; int pos_ = ML_POS(cc, rr_ - 1); pos_ = pos_ < 0 ? 0 : (pos_ >= lim_ ? lim_ - 1 : pos_); \
            __builtin_amdgcn_global_load_lds((const unsigned*)(BK + (size_t)(kvb_ + pos_) * 512 + pc_ * 8), (LAS unsigned*)(lds + ML_RK + ins_ * 1024), 16, 0, 0); \
            if ((cc) >= 4) __builtin_amdgcn_global_load_lds((const unsigned*)(BQ + (size_t)pos_ * 512 + pc_ * 8), (LAS unsigned*)(lds + ML_RQ + ins_ * 1024), 16, 0, 0); } \
        _Pragma("unroll") for (int q_ = 0; q_ < 2; ++q_) { const int ins_ = wave * 2 + q_, t_ = ins_ * 4 + (lane >> 4), pc_ = lane & 15; const int pos_ = ML_POS(cc, t_); \
            __builtin_amdgcn_global_load_lds((const unsigned*)(BV + (size_t)(kvb_ + pos_) * 512 + pc_ * 8), (LAS unsigned*)(lds + ML_VOFF + (vbuf) * ML_VSZ + ins_ * 1024), 16, 0, 0); } } while (0)
#define ML_CONV8(dst, rawoff, cc, t_, d8_, ten, scl) do { const int pos_ = ML_POS(cc, t_), lim_ = (cc) < 4 ? LC : SEQ; const int rm_ = dir ? (t_) + 2 : (t_), rp_ = dir ? (t_) : (t_) + 2; \
        v4u x_[3]; x_[0] = *(const LAS v4u*)(lds + (rawoff) + rm_ * 256 + (d8_) * 16); x_[1] = *(const LAS v4u*)(lds + (rawoff) + ((t_) + 1) * 256 + (d8_) * 16); x_[2] = *(const LAS v4u*)(lds + (rawoff) + rp_ * 256 + (d8_) * 16); \
        if (pos_ - 1 < 0) x_[0] = (v4u){0u, 0u, 0u, 0u}; if (pos_ + 1 >= lim_) x_[2] = (v4u){0u, 0u, 0u, 0u}; \
        const LAS float* wl_ = cwl + (ten) * 512 + (d8_) * 8; \
        _Pragma("unroll") for (int e_ = 0; e_ < 8; ++e_) { float s_ = wl_[3 * 128 + e_]; \
            _Pragma("unroll") for (int j_ = 0; j_ < 3; ++j_) { const unsigned w_ = e_ < 2 ? x_[j_].x : e_ < 4 ? x_[j_].y : e_ < 6 ? x_[j_].z : x_[j_].w; s_ += wl_[j_ * 128 + e_] * ((e_ & 1) ? bf_hi(w_) : bf_lo(w_)); } \
            dst[e_] = __fdividef(s_, 1.f + __expf(-s_)) * (scl); } } while (0)
#define ML_BUILD(cc) do { _Pragma("unroll 1") for (int q_ = 0; q_ < 2; ++q_) { const int idx_ = tid + NTHR * q_, t_ = idx_ >> 4, d8_ = idx_ & 15; \
        float kk_[8]; ML_CONV8(kk_, ML_RK, cc, t_, d8_, 1, 1.f); const float wt_ = shidx(w_n, t_); \
        v4u o_; o_.x = pk2(kk_[0], kk_[1]); o_.y = pk2(kk_[2], kk_[3]); o_.z = pk2(kk_[4], kk_[5]); o_.w = pk2(kk_[6], kk_[7]); *(LAS v4u*)(lds + ML_TILE + t_ * ML_P + d8_ * 16) = o_; \
        o_.x = pk2(kk_[0] * wt_, kk_[1] * wt_); o_.y = pk2(kk_[2] * wt_, kk_[3] * wt_); o_.z = pk2(kk_[4] * wt_, kk_[5] * wt_); o_.w = pk2(kk_[6] * wt_, kk_[7] * wt_); *(LAS v4u*)(lds + 2 * ML_TILE + t_ * ML_P + d8_ * 16) = o_; \
        if ((cc) >= 4) { float qq_[8]; ML_CONV8(qq_, ML_RQ, cc, t_, d8_, 0, 0.08838834764831845f); \
            o_.x = pk2(qq_[0], qq_[1]); o_.y = pk2(qq_[2], qq_[3]); o_.z = pk2(qq_[4], qq_[5]); o_.w = pk2(qq_[6], qq_[7]); *(LAS v4u*)(lds + t_ * ML_P + d8_ * 16) = o_; } } } while (0)
    __syncthreads();
    { float li0, fp0; ML_GLOAD(0, li0, fp0); ML_DMA(0, 0); ML_SCAN(li0, fp0, m_state); }
    asm volatile("s_waitcnt vmcnt(0)" ::: "memory");
    __syncthreads();
    ML_BUILD(0);
    a_c = a_n; M_c = M_n; b_c = b_n; decay_c = decay_n; m_after = m_next;
    __syncthreads();
#pragma unroll 1
    for (int cc = 0; cc < 36; ++cc) {
        const LAS unsigned char* Qs = lds; const LAS unsigned char* Ks = lds + ML_TILE; const LAS unsigned char* Kw = lds + 2 * ML_TILE; const LAS unsigned char* Vs = lds + ML_VOFF + (cc & 1) * ML_VSZ;
        const LAS float* ncur = nbuf + (cc & 1) * 128; LAS float* nnew = nbuf + ((cc + 1) & 1) * 128;
        float li1 = 0.f, fp1 = 0.f;
        if (cc < 35) { ML_GLOAD(cc + 1, li1, fp1); ML_DMA(cc + 1, (cc + 1) & 1); }
        if (cc >= 4) {
            aw[lane] = a_c;
            const int tcol = 32 * tb + r; const float Mt = shidx(M_c, tcol), bt = shidx(b_c, tcol);
            f32x16 nacc;
#pragma unroll
            for (int q = 0; q < 16; ++q) nacc[q] = 0.f;
#pragma unroll
            for (int db = 0; db < 4; ++db)
#pragma unroll
                for (int s2 = 0; s2 < 2; ++s2) { const LAS unsigned char* qp = Qs + tcol * ML_P + (32 * db + 16 * s2 + 4 * hh) * 2; const u32x2 lo = *(const LAS u32x2*)qp, hi = *(const LAS u32x2*)(qp + 16);
                    u32x4 qw; qw.x = lo.x; qw.y = lo.y; qw.z = hi.x; qw.w = hi.y;
                    nacc = __builtin_amdgcn_mfma_f32_32x32x16_bf16(pack8(cacc[db], s2), __builtin_bit_cast(bf16x8, qw), nacc, 0, 0, 0); }
            const float sc = __expf(m_state - Mt);
            nacc = nacc * sc;
            float rs = 0.f;
#pragma unroll
            for (int sb = 0; sb < 2; ++sb) if (sb <= tb) {
                f32x16 sacc;
#pragma unroll
                for (int q = 0; q < 16; ++q) sacc[q] = 0.f;
#pragma unroll
                for (int ds = 0; ds < 8; ++ds) { const bf16x8 kf = *(const LAS bf16x8*)(Ks + (32 * sb + r) * ML_P + (16 * ds + 8 * hh) * 2), qf = *(const LAS bf16x8*)(Qs + tcol * ML_P + (16 * ds + 8 * hh) * 2);
                    sacc = __builtin_amdgcn_mfma_f32_32x32x16_bf16(kf, qf, sacc, 0, 0, 0); }
#pragma unroll
                for (int g = 0; g < 4; ++g) { const int s0 = 32 * sb + 8 * g + 4 * hh; const f32x4 av = *(const LAS f32x4*)(aw + s0);
#pragma unroll
                    for (int j = 0; j < 4; ++j) { const bool keep = (s0 + j) <= tcol; const float v = keep ? sacc[4 * g + j] * __expf(av[j] - Mt) : 0.f; sacc[4 * g + j] = v; rs += v; } }
#pragma unroll
                for (int s2 = 0; s2 < 2; ++s2) { u32x4 vw;
                    { const u32x2 t0 = tr16(Vs + (32 * sb + 16 * s2 + 4 * hh + tq) * 256 + (32 * eb + 16 * blk + 4 * tp) * 2), t1 = tr16(Vs + (32 * sb + 16 * s2 + 8 + 4 * hh + tq) * 256 + (32 * eb + 16 * blk + 4 * tp) * 2);
                      vw.x = t0.x; vw.y = t0.y; vw.z = t1.x; vw.w = t1.y; }
                    nacc = __builtin_amdgcn_mfma_f32_32x32x16_bf16(__builtin_bit_cast(bf16x8, vw), pack8(sacc, s2), nacc, 0, 0, 0); } }
            rs += shx(rs, 32);
            float qn = 0.f;
            { const LAS unsigned char* qp = Qs + tcol * ML_P + (64 * hh) * 2;
#pragma unroll
              for (int c8 = 0; c8 < 8; ++c8) { const v4u w = *(const LAS v4u*)(qp + c8 * 16); const f32x4 n0 = *(const LAS f32x4*)(ncur + 64 * hh + 8 * c8), n1 = *(const LAS f32x4*)(ncur + 64 * hh + 8 * c8 + 4);
                  qn += bf_lo(w.x) * n0[0] + bf_hi(w.x) * n0[1] + bf_lo(w.y) * n0[2] + bf_hi(w.y) * n0[3] + bf_lo(w.z) * n1[0] + bf_hi(w.z) * n1[1] + bf_lo(w.w) * n1[2] + bf_hi(w.w) * n1[3]; } }
            qn += shx(qn, 32);
            const float den = sc * qn + rs; const float dd = __frcp_rn(fmaxf(fabsf(den), __expf(-(bt + Mt))));
            { const int pos = ML_POS(cc, tcol); bf16* hrow = HB + (size_t)pos * 512 + 32 * eb;
#pragma unroll
              for (int g = 0; g < 4; ++g) { v2u w; w.x = pk2(nacc[4 * g + 0] * dd, nacc[4 * g + 1] * dd); w.y = pk2(nacc[4 * g + 2] * dd, nacc[4 * g + 3] * dd); *(v2u*)(hrow + 8 * g + 4 * hh) = w; } }
        }
#pragma unroll
        for (int db = 0; db < 4; ++db) { cacc[db] = cacc[db] * decay_c;
#pragma unroll
            for (int s4 = 0; s4 < 4; ++s4) { u32x4 ka, vb;
                { const u32x2 t0 = tr16(Kw + (16 * s4 + 8 * hh + tq) * ML_P + (32 * db + 16 * blk + 4 * tp) * 2), t1 = tr16(Kw + (16 * s4 + 8 * hh + 4 + tq) * ML_P + (32 * db + 16 * blk + 4 * tp) * 2);
                  ka.x = t0.x; ka.y = t0.y; ka.z = t1.x; ka.w = t1.y; }
                { const u32x2 t0 = tr16(Vs + (16 * s4 + 8 * hh + tq) * 256 + (32 * eb + 16 * blk + 4 * tp) * 2), t1 = tr16(Vs + (16 * s4 + 8 * hh + 4 + tq) * 256 + (32 * eb + 16 * blk + 4 * tp) * 2);
                  vb.x = t0.x; vb.y = t0.y; vb.z = t1.x; vb.w = t1.y; }
                cacc[db] = __builtin_amdgcn_mfma_f32_32x32x16_bf16(__builtin_bit_cast(bf16x8, ka), __builtin_bit_cast(bf16x8, vb), cacc[db], 0, 0, 0); } }
        if (tid < 128) { float s = 0.f;
#pragma unroll 8
            for (int t = 0; t < 64; ++t) s += bf1(*(const LAS bf16*)(Kw + t * ML_P + tid * 2));
            nnew[tid] = decay_c * ncur[tid] + s; }
        m_state = m_after;
        asm volatile("s_waitcnt vmcnt(0)" ::: "memory");
        __syncthreads();
        if (cc < 35) { ML_SCAN(li1, fp1, m_state); ML_BUILD(cc + 1); a_c = a_n; M_c = M_n; b_c = b_n; decay_c = decay_n; m_after = m_next; }
        __syncthreads();
    }
#undef ML_POS
#undef ML_GLOAD
#undef ML_SCAN
#undef ML_DMA
#undef ML_CONV8
#undef ML_BUILD
}
__device__ __forceinline__ void ph_outb(const Params& p, unsigned char* big, int lane, int wave) {
    const int gw = blockIdx.x * NWAVES + wave, NGW = gridDim.x * NWAVES;
    const bf16* HBf = (const bf16*)(big + A0_HB); const bf16* HBb = HBf + (size_t)T * 512; const bf16* BO = (const bf16*)(big + A0_BO); bf16* MIXIN = (bf16*)(big + A0_MIXIN);
    const float* gb = p.in[I_HGB];
#pragma unroll 1
    for (int m = gw; m < T; m += NGW) {
        const v4u f = *(const v4u*)(HBf + (size_t)m * 512 + lane * 8), bw = *(const v4u*)(HBb + (size_t)m * 512 + lane * 8), go = *(const v4u*)(BO + (size_t)m * 512 + lane * 8);
        float x[8], o[8]; x[0] = bf_lo(f.x) + bf_lo(bw.x); x[1] = bf_hi(f.x) + bf_hi(bw.x); x[2] = bf_lo(f.y) + bf_lo(bw.y); x[3] = bf_hi(f.y) + bf_hi(bw.y);
        x[4] = bf_lo(f.z) + bf_lo(bw.z); x[5] = bf_hi(f.z) + bf_hi(bw.z); x[6] = bf_lo(f.w) + bf_lo(bw.w); x[7] = bf_hi(f.w) + bf_hi(bw.w);
        o[0] = bf_lo(go.x); o[1] = bf_hi(go.x); o[2] = bf_lo(go.y); o[3] = bf_hi(go.y); o[4] = bf_lo(go.z); o[5] = bf_hi(go.z); o[6] = bf_lo(go.w); o[7] = bf_hi(go.w);
        float ss = 0.f;
#pragma unroll
        for (int j = 0; j < 8; ++j) ss += x[j] * x[j];
        ss += shx(ss, 1); ss += shx(ss, 2); ss += shx(ss, 4); ss += shx(ss, 8);
        const float rn = rsqrtf(ss * (1.f / 128.f) + RMS_EPS);
        const f32x4 g0 = *(const f32x4*)(gb + lane * 8), g1 = *(const f32x4*)(gb + lane * 8 + 4);
        float y[8];
#pragma unroll
        for (int j = 0; j < 8; ++j) y[j] = x[j] * rn * (j < 4 ? g0[j] : g1[j - 4]) * sigmoidf_(o[j]);
        v4u w; w.x = pk2(y[0], y[1]); w.y = pk2(y[2], y[3]); w.z = pk2(y[4], y[5]); w.w = pk2(y[6], y[7]);
        *(v4u*)(MIXIN + (size_t)m * D + 512 + lane * 8) = w;
    }
}

constexpr int CW_DBG = 16;
#ifndef DBG_MODE
#define DBG_MODE 0
#endif
#ifndef DBG_L
#define DBG_L 0
#endif
#ifndef DBG_CH
#define DBG_CH 0
#endif
__device__ __forceinline__ void dbg_report(const Params& p, float d) {
    if (!(d >= 0.f)) d = 1.0e6f;
    atomicMax((unsigned*)(p.ws + WS_CTL) + CW_DBG, __float_as_uint(d));
}
__device__ __forceinline__ float block_max(float v, LAS float* red, int tid) { v = wave_max(v); __syncthreads(); if ((tid & 63) == 0) red[tid >> 6] = v; __syncthreads(); float r = red[0];
#pragma unroll
    for (int w = 1; w < 8; ++w) r = fmaxf(r, red[w]); __syncthreads(); return r; }
__device__ __forceinline__ float block_sum(float v, LAS float* red, int tid) { v = wave_sum(v); __syncthreads(); if ((tid & 63) == 0) red[tid >> 6] = v; __syncthreads(); float r = 0.f;
#pragma unroll
    for (int w = 0; w < 8; ++w) r += red[w]; __syncthreads(); return r; }
__device__ __forceinline__ void dbg_moe_check(const Params& p, int l, int ch, const bf16* H2, const bf16* Y, LAS unsigned char* lds, int tid) {
    LAS float* hrow = (LAS float*)lds; LAS float* gu = hrow + 1024; LAS float* a = gu + 512; LAS float* red = a + 256;
    const int t = ch * CHT + blockIdx.x * 64 + 5;
    __syncthreads();
    for (int i = tid; i < 1024; i += NTHR) hrow[i] = bf1(H2[(size_t)t * D + i]);
    __syncthreads();
    const int* EIDX = (const int*)(p.ws + WS_EIDX); const float* WTS = (const float*)(p.ws + WS_WTS); const int* PSLOT = (const int*)(p.ws + WS_PSLOT);
    float yacc[2] = {0.f, 0.f};
#pragma unroll 1
    for (int k = 0; k < 9; ++k) {
        const int e = k < 8 ? (EIDX[(size_t)t * 8 + k] & 255) : 64; const float w = k < 8 ? WTS[(size_t)t * 8 + k] : 1.f;
        const float* Wgu = e < 64 ? p.in[I_EGU] + (size_t)(l * 64 + e) * 1024 * 512 : p.in[I_SGU] + (size_t)l * 1024 * 512;
        const float* Wdn = e < 64 ? p.in[I_EDN] + (size_t)(l * 64 + e) * 256 * 1024 : p.in[I_SDN] + (size_t)l * 256 * 1024;
        float s = 0.f;
#pragma unroll 4
        for (int kk = 0; kk < 1024; ++kk) s += hrow[kk] * Wgu[(size_t)kk * 512 + tid];
        gu[tid] = s;
        __syncthreads();
        if (tid < 256) a[tid] = siluf_(gu[tid]) * gu[256 + tid];
        __syncthreads();
#pragma unroll
        for (int q = 0; q < 2; ++q) { const int n = tid + 512 * q; float s2 = 0.f;
#pragma unroll 4
            for (int j = 0; j < 256; ++j) s2 += a[j] * Wdn[(size_t)j * 1024 + n];
            yacc[q] += w * s2; }
        __syncthreads();
    }
    float err = 0.f, ss = 0.f;
#pragma unroll
    for (int q = 0; q < 2; ++q) { const int n = tid + 512 * q; float f = 0.f;
#pragma unroll 1
        for (int k = 0; k < 9; ++k) { const int slot = PSLOT[(size_t)t * 16 + k]; const float w = k < 8 ? WTS[(size_t)t * 8 + k] : 1.f; f += w * bf1(Y[(size_t)slot * D + n]); }
        err = fmaxf(err, fabsf(f - yacc[q])); ss += yacc[q] * yacc[q]; }
    const float me = block_max(err, red, tid), sq = block_sum(ss, red, tid);
    if (tid == 0) dbg_report(p, me / sqrtf(sq * (1.f / 1024.f) + 1e-30f));
}
__device__ __forceinline__ void dbg_route_check(const Params& p, int l, const bf16* H2, const float* LOG, LAS unsigned char* lds, int tid) {
    LAS float* hrow = (LAS float*)lds; LAS float* lg = hrow + 1024; LAS float* bi = lg + 64; LAS float* sc = bi + 64; LAS float* red = sc + 64;
    const int t = blockIdx.x * 256 + 77;
    __syncthreads();
    for (int i = tid; i < 1024; i += NTHR) hrow[i] = bf1(H2[(size_t)t * D + i]);
    __syncthreads();
    if (tid < 64) { float s = 0.f; const float* W = p.in[I_RW] + (size_t)l * 1024 * 64;
#pragma unroll 4
        for (int k = 0; k < 1024; ++k) s += hrow[k] * W[k * 64 + tid];
        lg[tid] = s; sc[tid] = 1.f / (1.f + expf(-s)); bi[tid] = sc[tid] + p.in[I_RB][l * 64 + tid]; }
    __syncthreads();
    if (tid == 0) {
        float lerr = 0.f;
#pragma unroll 1
        for (int e = 0; e < 64; ++e) lerr = fmaxf(lerr, fabsf(lg[e] - LOG[(size_t)t * 64 + e]));
        float grp[8];
#pragma unroll
        for (int g = 0; g < 8; ++g) { float a = -1e30f, b = -1e30f;
#pragma unroll 1
            for (int j = 0; j < 8; ++j) { const float v = bi[g * 8 + j]; if (v > a) { b = a; a = v; } else if (v > b) b = v; } grp[g] = a + b; }
        unsigned gm = 0;
#pragma unroll 1
        for (int r = 0; r < 4; ++r) { int best = -1; float bv = 0.f;
#pragma unroll
            for (int g = 0; g < 8; ++g) if (!((gm >> g) & 1u) && (best < 0 || grp[g] > bv)) { best = g; bv = grp[g]; }
            gm |= 1u << best; }
        unsigned long long set_ref = 0ull; float ssum = 0.f;
#pragma unroll 1
        for (int r = 0; r < 8; ++r) { int best = -1; float bv = 0.f;
#pragma unroll 1
            for (int e = 0; e < 64; ++e) if (((gm >> (e >> 3)) & 1u) && !((set_ref >> e) & 1ull) && (best < 0 || bi[e] > bv)) { best = e; bv = bi[e]; }
            set_ref |= 1ull << best; ssum += sc[best]; }
        const int* EIDX = (const int*)(p.ws + WS_EIDX); const float* WTS = (const float*)(p.ws + WS_WTS);
        unsigned long long set_f = 0ull; float werr = 0.f, wsum = 0.f;
#pragma unroll 1
        for (int k = 0; k < 8; ++k) { const int e = EIDX[(size_t)t * 8 + k] & 255; set_f |= 1ull << e; const float wr = 2.5f * sc[e] / ssum; werr = fmaxf(werr, fabsf(wr - WTS[(size_t)t * 8 + k])); wsum += WTS[(size_t)t * 8 + k]; }
        float d = 0.f;
        if (DBG_MODE == 0) d = (set_f != set_ref) ? (1.f / 256.f) : 0.f;
        if (DBG_MODE == 1) d = (set_f != set_ref) ? 0.f : werr + fabsf(wsum - 2.5f);
        if (DBG_MODE == 2) d = lerr * (1.f / 256.f);
        atomicAdd((float*)((unsigned*)(p.ws + WS_CTL) + CW_DBG), d);
    }
    __syncthreads();
}
__device__ __forceinline__ unsigned dbg_hash(unsigned x) { x ^= x >> 16; x *= 0x7feb352du; x ^= x >> 15; x *= 0x846ca68bu; x ^= x >> 16; return x; }
__device__ __forceinline__ void dbg_report_wave(const Params& p, float d, int lane) { if (lane == 0) dbg_report(p, d); }
__device__ __forceinline__ void dbg_hyena_check(const Params& p, int mode, const bf16* HN, const bf16* UC, const bf16* ZT, const bf16* Y2T, const bf16* MIX, LAS unsigned char* lds, int lane, int wave) {
    const unsigned hsh = dbg_hash(blockIdx.x * 8u + wave + 12345u), h2 = dbg_hash(hsh), h3 = dbg_hash(h2);
    const bf16* FILT = (const bf16*)(p.ws + WS_FILT);
    float d = 0.f;
    if (mode == 0) {
        const int c = hsh % 3072u, b = h2 % 32u, s = h3 % 2048u; float acc = 0.f;
#pragma unroll 1
        for (int k = lane; k < 1024; k += 64) acc += bf1(HN[(size_t)(b * 2048 + s) * D + k]) * p.in[I_WINHY][(size_t)k * 3072 + c];
        acc = wave_sum(acc);
        const float got = bf1(UC[(size_t)c * T + b * 2048 + s]); d = fabsf(got - acc) / (fabsf(acc) + 0.1f);
    } else if (mode == 5) {
        const int c = hsh % 3072u, b = h2 % 32u; int s = h3 % 2048u; if ((h3 >> 20) % 8u == 0u) s = 0; if ((h3 >> 20) % 8u == 1u) s = 2047;
        float val = p.in[I_CONVHYB][c];
#pragma unroll 1
        for (int j = 0; j < 3; ++j) { const int sj = s + j - 1; if (sj < 0 || sj > 2047) continue; val += p.in[I_CONVHYW][j * 3072 + c] * bf1(ZT[(size_t)c * T + b * 2048 + sj]); }
        const float got = bf1(UC[(size_t)c * T + b * 2048 + s]); d = fabsf(got - val) / (fabsf(val) + 0.1f);
    } else if (mode == 1) {
        LAS float* Z = (LAS float*)(lds + wave * 1024); LAS float* A1 = Z + 64; LAS float* A2 = A1 + 64;
        const int o = hsh & 1u, c = h2 % 1024u, j = h3 % 2048u;
        float z = 0.f; if (lane == 0) z = (float)j / 2047.f; else if (lane < 33) { const int k = (lane - 1) & 15; const float fr = 1e-4f + (float)k * ((15.f - 1e-4f) / 15.f); const float ang = (6.283185307179586f / 2048.f) * (float)j * fr; z = lane < 17 ? cosf(ang) : -sinf(ang); }
        Z[lane] = z; LDS_WAIT(); asm volatile("" ::: "memory");
        float a = p.in[I_FB1][lane];
#pragma unroll 1
        for (int k = 0; k < 33; ++k) a += Z[k] * p.in[I_FW1][k * 64 + lane];
        A1[lane] = sinf(a); LDS_WAIT(); asm volatile("" ::: "memory");
        a = p.in[I_FB2][lane];
#pragma unroll 1
        for (int k = 0; k < 64; ++k) a += A1[k] * p.in[I_FW2][k * 64 + lane];
        A2[lane] = sinf(a); LDS_WAIT(); asm volatile("" ::: "memory");
        float v = wave_sum(A2[lane] * p.in[I_FW3][lane * 2048 + o * 1024 + c]);
        const float mind = -4.605170185988091f / 1.5f, maxd = -4.605170185988091f / 0.3f; const float delta = fabsf(mind + (float)c * ((maxd - mind) / 1023.f));
        v *= expf(-fabsf((float)j - 1024.f) / 1024.f * delta);
        const float got = bf1(FILT[(size_t)(o * 1024 + c) * 2048 + j]); d = fabsf(got - v) / (fabsf(v) + 1e-4f);
    } else if (mode == 2 || mode == 3) {
        const int o = mode - 2, c = hsh % 1024u, b = h2 % 32u; int t = h3 % 2048u; if ((h3 >> 20) % 8u == 0u) t = 0; if ((h3 >> 20) % 8u == 1u) t = 2047;
        const bf16* in = (o == 0 ? UC : ZT) + (size_t)c * T + b * 2048; const bf16* f = FILT + (size_t)(o * 1024 + c) * 2048; float acc = 0.f;
#pragma unroll 1
        for (int s = lane; s < 2048; s += 64) { const int x = 1024 + t - s; if (x >= 0 && x <= 2047) acc += bf1(f[x]) * bf1(in[s]); }
        acc = wave_sum(acc);
        const float gate = bf1(UC[(size_t)((1 + o) * 1024 + c) * T + b * 2048 + t]);
        const float val = gate * (acc + bf1(in[t]) * p.in[I_FBIAS][o * 1024 + c]);
        const float got = bf1((o == 0 ? ZT : Y2T)[(size_t)c * T + b * 2048 + t]); d = fabsf(got - val) / (fabsf(val) + 0.1f);
    } else if (mode == 4) {
        const int tok = hsh % 65536u, n = h2 % 1024u; float acc = 0.f;
#pragma unroll 1
        for (int c = lane; c < 1024; c += 64) acc += bf1(Y2T[(size_t)c * T + tok]) * p.in[I_WOUTHY][(size_t)c * 1024 + n];
        acc = wave_sum(acc);
        const float got = bf1(MIX[(size_t)tok * D + n]); d = fabsf(got - acc) / (fabsf(acc) + 0.1f);
    }
    dbg_report_wave(p, d, lane);
}
__device__ __forceinline__ void dbg_inproj_check(const Params& p, unsigned char* big, int lane, int wave) {
    const unsigned hsh = dbg_hash(blockIdx.x * 8u + wave + 777u), h2 = dbg_hash(hsh);
    const bf16* H0 = (const bf16*)(big + A0_H); const float* W = p.in[I_WINAB];
    int m = hsh % (unsigned)TT; int n = h2 % 3600u;
    const bool ctx = m >= T; if (ctx && n < 1536) n += 1536;
    const int b = ctx ? (m - T) / LC : m / SEQ, s = ctx ? (m - T) % LC : m % SEQ;
    float x = 0.f, xp = 0.f; const bool rope_col = (n < 512) || (n >= 1536 && n < 2048); const int np = rope_col ? (n ^ 16) : n;
#pragma unroll 1
    for (int k = lane; k < 1024; k += 64) { const float hv = bf1(H0[(size_t)m * D + k]); x += hv * W[(size_t)k * 3600 + n]; xp += hv * W[(size_t)k * 3600 + np]; }
    x = wave_sum(x); xp = wave_sum(xp);
    float val = x, got = 0.f;
    if (n >= 3584) { val = x + p.in[I_GATEB][n - 3584]; got = ((const float*)(p.ws + WS_GATES))[(size_t)m * 16 + (n - 3584)]; }
    else { const int t = n / 512, cn = n % 512; int pc = cn;
        if (rope_col) { const int o = cn & 31; pc = (cn & ~31) + (((o & 15) >> 2) * 8 + (o >> 4) * 4 + (o & 3));
            if (!ctx) { const int d = cn & 63, axis = d >> 5, half = (d >> 4) & 1, i = d & 15; const float pos = (float)(axis == 0 ? (s >> 6) : (s & 63)); const float ang = pos * powf(10000.f, -(float)i / 16.f);
                val = half == 0 ? x * cosf(ang) - xp * sinf(ang) : x * cosf(ang) + xp * sinf(ang); } }
        if (t == 0) val *= QSCALE;
        const size_t offs[7] = {A0_QA, A0_BQ, A0_BO, A0_KA, A0_VA, A0_BK, A0_BV}; const bool kv = t >= 3;
        const bf16* O = (const bf16*)(big + offs[t]) + (size_t)b * (kv ? (SEQ + LC) : SEQ) * 512 + (size_t)((kv && !ctx) ? LC : 0) * 512;
        got = bf1(O[(size_t)s * 512 + pc]); }
    dbg_report_wave(p, fabsf(got - val) / (fabsf(val) + 0.1f), lane);
}
__device__ __forceinline__ void dbg_attn_check(const Params& p, unsigned char* big, LAS unsigned char* lds, int lane, int wave) {
    const unsigned hsh = dbg_hash(blockIdx.x * 8u + wave + 4242u), h2 = dbg_hash(hsh);
    const int b = hsh % 32u, h = (hsh >> 8) % 4u, q = h2 % 2048u;
    const bf16* QA = (const bf16*)(big + A0_QA) + ((size_t)b * SEQ + q) * 512 + h * 128; const bf16* KA = (const bf16*)(big + A0_KA) + (size_t)b * 2304 * 512 + h * 128;
    const bf16* VA = (const bf16*)(big + A0_VA) + (size_t)b * 2304 * 512 + h * 128; const bf16* MIXIN = (const bf16*)(big + A0_MIXIN) + ((size_t)b * SEQ + q) * D + h * 128;
    LAS float* Aw = (LAS float*)(lds + wave * 18432);
    const float* lv = p.in[I_DLAM]; const float lam = expf(wave_sum(lv[lane] * lv[64 + lane])) - expf(wave_sum(lv[128 + lane] * lv[192 + lane])) + 0.2f;
    float mx0 = -1e30f, mx1 = -1e30f;
#pragma unroll 1
    for (int key = lane; key < 2304; key += 64) { float s0 = 0.f, s1 = 0.f;
#pragma unroll 1
        for (int d = 0; d < 64; ++d) { s0 += bf1(QA[d]) * bf1(KA[(size_t)key * 512 + d]); s1 += bf1(QA[64 + d]) * bf1(KA[(size_t)key * 512 + 64 + d]); }
        Aw[key] = s0; Aw[2304 + key] = s1; mx0 = fmaxf(mx0, s0); mx1 = fmaxf(mx1, s1); }
    mx0 = wave_max(mx0); mx1 = wave_max(mx1);
    float l0 = 0.f, l1 = 0.f;
#pragma unroll 1
    for (int key = lane; key < 2304; key += 64) { const float e0 = exp2f(Aw[key] - mx0), e1 = exp2f(Aw[2304 + key] - mx1); Aw[key] = e0; Aw[2304 + key] = e1; l0 += e0; l1 += e1; }
    l0 = wave_sum(l0); l1 = wave_sum(l1);
    LDS_WAIT(); asm volatile("" ::: "memory");
    float o[2] = {0.f, 0.f};
#pragma unroll 1
    for (int key = 0; key < 2304; ++key) { const float a = Aw[key] / l0 - lam * Aw[2304 + key] / l1; o[0] += a * bf1(VA[(size_t)key * 512 + lane]); o[1] += a * bf1(VA[(size_t)key * 512 + 64 + lane]); }
    const float ms = wave_sum(o[0] * o[0] + o[1] * o[1]) * (1.f / 128.f); const float rn = rsqrtf(ms + RMS_EPS) * 0.8f;
    float err = 0.f, sc = 0.f;
#pragma unroll
    for (int j = 0; j < 2; ++j) { const float val = o[j] * rn * p.in[I_HGA][h * 128 + 64 * j + lane]; err = fmaxf(err, fabsf(val - bf1(MIXIN[64 * j + lane]))); sc += val * val; }
    err = wave_max(err); sc = sqrtf(wave_sum(sc) * (1.f / 128.f));
    dbg_report_wave(p, err / (sc + 1e-3f), lane);
}
__device__ __forceinline__ float dbg_convsilu(const bf16* base, int pos, int lim, int ch, int d, const float* cw, const float* cb) {
    float s = cb[ch];
#pragma unroll
    for (int j = 0; j < 3; ++j) { const int pj = pos + j - 1; if (pj >= 0 && pj < lim) s += cw[j * 1024 + ch] * bf1(base[(size_t)pj * 512 + d]); }
    return s / (1.f + expf(-s));
}
__device__ __forceinline__ void dbg_mlstm_check(const Params& p, unsigned char* big, LAS unsigned char* lds, int lane, int wave) {
    const unsigned hsh = dbg_hash(blockIdx.x * 8u + wave + 991u), h2 = dbg_hash(hsh);
    const int b = hsh % 32u, h = (hsh >> 8) % 4u, dir = (hsh >> 12) & 1; int tau = h2 % 2048u; if ((h2 >> 16) % 4u == 0u) tau = (h2 >> 20) % 130u;
    const bf16* BQ = (const bf16*)(big + A0_BQ) + (size_t)b * SEQ * 512 + h * 128; const bf16* BK = (const bf16*)(big + A0_BK) + (size_t)b * (SEQ + LC) * 512 + h * 128;
    const bf16* BV = (const bf16*)(big + A0_BV) + (size_t)b * (SEQ + LC) * 512 + h * 128;
    const float* GT = (const float*)(p.ws + WS_GATES); const float* cw = p.in[I_CONVABW]; const float* cb = p.in[I_CONVABB];
    LAS float* F = (LAS float*)(lds + wave * 18432); LAS float* qv = F + 2304 + 64;
    const int N = 256 + tau + 1;
#define DBG_POS(u) ((u) < 256 ? (dir ? 255 - (u) : (u)) : (dir ? 2047 - ((u) - 256) : (u) - 256))
#define DBG_GROW(u) ((u) < 256 ? (size_t)T + b * LC + DBG_POS(u) : (size_t)b * SEQ + DBG_POS(u))
    float carry = 0.f;
#pragma unroll 1
    for (int u0 = 0; u0 < N; u0 += 64) { const int u = u0 + lane; float lf = 0.f;
        if (u < N) { const float x = GT[DBG_GROW(u) * 16 + dir * 8 + 4 + h]; lf = x >= 0.f ? -__logf(1.f + __expf(-x)) : x - __logf(1.f + __expf(x)); }
        float s = lf;
#pragma unroll
        for (int o = 1; o < 64; o <<= 1) { const float v = shup(s, o); if (lane >= o) s += v; }
        if (u < N) F[u] = carry + s; carry += shidx(s, 63); }
    LDS_WAIT(); asm volatile("" ::: "memory");
    const float Ft = F[N - 1];
    float mm = Ft;
#pragma unroll 1
    for (int u = lane; u < N; u += 64) mm = fmaxf(mm, Ft - F[u] + GT[DBG_GROW(u) * 16 + dir * 8 + h]);
    mm = wave_max(mm);
    { const int pos = DBG_POS(N - 1);
      for (int d = lane; d < 128; d += 64) qv[d] = dbg_convsilu(BQ, pos, SEQ, h * 128 + d, d, cw, cb) * 0.08838834764831845f; }
    LDS_WAIT(); asm volatile("" ::: "memory");
    float den = 0.f;
#pragma unroll 1
    for (int u = lane; u < N; u += 64) { const bool ctx = u < 256; const int pos = DBG_POS(u); const bf16* kb = ctx ? BK : BK + (size_t)LC * 512; float qk = 0.f;
#pragma unroll 1
        for (int d = 0; d < 128; ++d) qk += qv[d] * dbg_convsilu(kb, pos, ctx ? LC : SEQ, 512 + h * 128 + d, d, cw, cb);
        const float om = qk * expf(Ft - F[u] + GT[DBG_GROW(u) * 16 + dir * 8 + h] - mm); F[u] = om; den += om; }
    den = wave_sum(den);
    LDS_WAIT(); asm volatile("" ::: "memory");
    float num[2] = {0.f, 0.f};
#pragma unroll 1
    for (int u = 0; u < N; ++u) { const bool ctx = u < 256; const int pos = DBG_POS(u); const bf16* vb = BV + (size_t)((ctx ? 0 : LC) + pos) * 512; num[0] += F[u] * bf1(vb[lane]); num[1] += F[u] * bf1(vb[64 + lane]); }
    const float dd = 1.f / fmaxf(fabsf(den), expf(-mm));
    const bf16* HB = (const bf16*)(big + A0_HB) + (size_t)dir * T * 512 + ((size_t)b * SEQ + DBG_POS(N - 1)) * 512 + h * 128;
    float err = 0.f, sc = 0.f;
#pragma unroll
    for (int j = 0; j < 2; ++j) { const float val = num[j] * dd; err = fmaxf(err, fabsf(val - bf1(HB[64 * j + lane]))); sc += val * val; }
    err = wave_max(err); sc = sqrtf(wave_sum(sc) * (1.f / 128.f));
    dbg_report_wave(p, err / (sc + 1e-3f), lane);
#undef DBG_POS
#undef DBG_GROW
}

__global__ void __launch_bounds__(NTHR, 2) mk_fwd(Params p0) {
    extern __shared__ __attribute__((aligned(16))) unsigned char lds_raw[];
    LAS unsigned char* lds = (LAS unsigned char*)lds_raw;
    const int wave0 = __builtin_amdgcn_readfirstlane((int)threadIdx.x >> 6);
    if (threadIdx.x < 64) ((LAS unsigned*)(lds + LDS_MISC))[threadIdx.x] = 0u;
    __syncthreads();
    XcdBarrier bar = xcd_barrier_post((unsigned*)(p0.ws + WS_CTL) + CW_BAR, (volatile LAS unsigned*)(lds + LDS_MISC + 32));
    const int G = gridDim.x, cb = blockIdx.x;
    const int vcu = (G % 8 == 0) ? (cb % 8) * (G / 8) + cb / 8 : cb;
#ifdef TIMEK
    int phc = 0; if (blockIdx.x == 0 && threadIdx.x == 0) ((unsigned long long*)(p0.ws + WS_CTL + 32768))[0] = __builtin_amdgcn_s_memrealtime();
#endif
#ifdef DBL_PH
#define DBL_LOOP for (int rep_ = 0; rep_ < 1; ++rep_)
#define DBL_SYNC __syncthreads();
#else
#define DBL_LOOP
#define DBL_SYNC
#endif
#ifdef TIMEK
#define TS_REC { ++phc; if (blockIdx.x == 0 && wave0 == 0 && lane_opq() == 0) ((unsigned long long*)(p0.ws + WS_CTL + 32768))[phc] = __builtin_amdgcn_s_memrealtime(); }
#else
#define TS_REC
#endif
#define LAYER_PTRS bf16* H2 = (bf16*)(big + (l == 0 ? 0 : 128 * MiB)); float* LOG = (float*)(big + (l == 0 ? 128 * MiB : 256 * MiB)); bf16* ACT = (bf16*)(big + (l == 0 ? 144 * MiB : 272 * MiB)); \
        bf16* Y = (bf16*)(big + (l == 0 ? 224 * MiB : 352 * MiB)); bf16* HN = (bf16*)(big + 544 * MiB); const bf16* MIX = (const bf16*)(big + (l == 0 ? A0_MIX : 0)); \
        bf16* UT = (bf16*)big; bf16* UC = (bf16*)(big + 384 * MiB); bf16* ZT = (bf16*)big; bf16* Y2T = (bf16*)(big + 128 * MiB); bf16* Y2 = (bf16*)(big + 256 * MiB); \
        (void)H2; (void)LOG; (void)ACT; (void)Y; (void)HN; (void)MIX; (void)UT; (void)UC; (void)ZT; (void)Y2T; (void)Y2;
#define RUN(...) do { { { int tid_ = wave0 * 64 + lane_opq(); asm volatile("" : "+v"(tid_)); const int tid = tid_, lane = tid & 63, wave = __builtin_amdgcn_readfirstlane(tid >> 6); (void)lane; (void)wave; \
        Params p = p0; { size_t z_ = 0; asm volatile("" : "+s"(z_)); p.ws = p0.ws + z_; p.out = p0.out + z_; _Pragma("unroll") for (int i_ = 0; i_ < 31; ++i_) p.in[i_] = p0.in[i_] + z_; } unsigned char* ws = p.ws; unsigned char* big = ws + WS_BIG; (void)big; LAYER_PTRS DBL_LOOP { __VA_ARGS__; DBL_SYNC } } { XcdBarrier b2_ = bar; { size_t z_ = 0; asm volatile("" : "+s"(z_)); b2_.bar = bar.bar + z_; unsigned x_ = bar.x; asm volatile("" : "+s"(x_)); b2_.x = x_; } xcd_barrier(b2_, wave0 == 0 && lane_opq() == 0); } TS_REC } } while (0)

    { const int l = 0; RUN({ pro_mod(p, lds, tid, lane, wave); __syncthreads(); pro_filters(p, lds, tid, lane, wave); pro_rope(p, tid); pro_transposes(p, lds, lane, wave); }); }

    for (int l = 0; l < 2; ++l) {
        if (l == 0) {
            RUN({ ph_l0_norm(p, lane, wave); });
            RUN({ Gemm g{(const bf16*)(big + A0_H), (const bf16*)(ws + WS_WIN0), 1024, 2048u}; InprojSched S{G, vcu};
                  EpiInproj E{big, (const float*)(ws + WS_ROPE), (float*)(ws + WS_GATES), p.in[I_GATEB]};
                  gemm_phase<EpiInproj, InprojSched>(lds, g, S, E, tid); });
#ifdef DBG_INPROJ
            RUN({ dbg_inproj_check(p, big, lane, wave); });
#endif
            RUN({ ph_transpose_b((const bf16*)(big + A0_VA), (bf16*)(big + A0_VT), NB, SEQ + LC, 512, lds, lane, wave); });
            RUN({ ph_attn(p, big, lds, tid, lane, wave); });
#ifdef DBG_ATTN
            RUN({ dbg_attn_check(p, big, lds, lane, wave); });
#endif
            RUN({ ph_mlstm(p, big, lds, tid, lane, wave); });
#ifdef DBG_MLSTM
            RUN({ dbg_mlstm_check(p, big, lds, lane, wave); });
#endif
            RUN({ ph_outb(p, big, lane, wave); });
            RUN({ Gemm g{(const bf16*)(big + A0_MIXIN), (const bf16*)(ws + WS_WOUT0), 1024, 2048u}; DenseSched S{4, 1024, G, vcu, 0}; EpiBf16 E{(bf16*)(big + A0_MIX), 1024, 3};
                  gemm_phase<EpiBf16, DenseSched>(lds, g, S, E, tid); });
        }
        if (l == 1) {
            RUN({ Gemm g{(const bf16*)(ws + WS_WIN1), HN, 1024, 2048u}; DenseSched S{256, 12 * 256, G, vcu, 12}; EpiBf16 E{UT, (size_t)T, 0xffff};
                  gemm_phase<EpiBf16, DenseSched>(lds, g, S, E, tid); });
#ifdef DBG_HY
            if (DBG_MODE == 0) { RUN({ dbg_hyena_check(p, 0, HN, UT, UT, UT, UT, lds, lane, wave); }); }
#endif
            RUN({ ph_sconv(p, UT, UC, tid); });
#ifdef DBG_HY
            if (DBG_MODE == 5) { RUN({ dbg_hyena_check(p, 5, HN, UC, UT, UT, UT, lds, lane, wave); }); }
#endif
            RUN({ ph_lconv(p, 0, UC, UC, ZT, lds, tid, lane, wave); });
#ifdef DBG_HY
            if (DBG_MODE == 2) { RUN({ dbg_hyena_check(p, 2, HN, UC, ZT, Y2T, UT, lds, lane, wave); }); }
#endif
            RUN({ ph_lconv(p, 1, ZT, UC, Y2T, lds, tid, lane, wave); });
#ifdef DBG_HY
            if (DBG_MODE == 3) { RUN({ dbg_hyena_check(p, 3, HN, UC, ZT, Y2T, UT, lds, lane, wave); }); }
#endif
            RUN({ ph_transpose(Y2T, Y2, lds, lane, wave); });
            RUN({ Gemm g{Y2, (const bf16*)(ws + WS_WOUT1), 1024, 2048u}; DenseSched S{4, 1024, G, vcu, 0}; EpiBf16 E{(bf16*)big, 1024, 3};
                  gemm_phase<EpiBf16, DenseSched>(lds, g, S, E, tid); });
        }
#ifdef DBG_HY
        if (l == 1 && (DBG_MODE == 1 || DBG_MODE == 4)) { RUN({ dbg_hyena_check(p, DBG_MODE, HN, (const bf16*)(big + 384 * MiB), (const bf16*)big, (const bf16*)(big + 128 * MiB), (const bf16*)big, lds, lane, wave); }); }
#endif
        RUN({ ph_mid(p, l, MIX, H2, true, lane, wave); });
        RUN({ Gemm g{H2, (const bf16*)(ws + WS_WR) + (size_t)l * 256 * 1024, 1024, 2048u}; DenseSched S{1, 256, G, vcu, 0}; EpiRouter E{LOG};
              gemm_phase<EpiRouter, DenseSched>(lds, g, S, E, tid); });
        RUN({ ph_route_a(p, l, LOG, lds, tid); });
#ifdef DBG_ROUTE
        RUN({ if (l == DBG_L) dbg_route_check(p, l, H2, LOG, lds, tid); ph_route_b(p, lds, tid); });
#else
        RUN({ ph_route_b(p, lds, tid); });
#endif
#define DO_G1(chx) do { const int NT = moe_tables(p, chx, lds, tid); \
            Gemm g{H2, (const bf16*)(ws + WS_GU) + (size_t)l * (65 * 512) * 1024, 1024, 2048u}; \
            MoeSched S{(const LAS int*)(lds + LDS_TAB), (const int*)(ws + WS_SORT) + (size_t)(chx) * CHROWS, NT * 2, G, vcu, 1, 2}; EpiSwiglu E{ACT}; \
            gemm_phase<EpiSwiglu, MoeSched>(lds, g, S, E, tid); } while (0)
        RUN({ DO_G1(0); });
        for (int ch = 0; ch < NCH; ++ch) {
            RUN({ const int NT = moe_tables(p, ch, lds, tid);
                  Gemm g{ACT, (const bf16*)(ws + WS_DN) + (size_t)l * (65 * 1024) * 256, 256, 512u};
                  MoeSched S{(const LAS int*)(lds + LDS_TAB), nullptr, NT * 4, G, vcu, 2, 4}; EpiBf16 E{Y, 1024, 3};
                  gemm_phase<EpiBf16, MoeSched>(lds, g, S, E, tid); });
            RUN({ const int par = (cb >> 3) & 1;
                  _Pragma("unroll 1") for (int part = 0; part < 2; ++part) { int t2_ = tid; asm volatile("" : "+v"(t2_)); const int tid = t2_, lane = tid & 63; (void)lane; if ((part ^ par) == 0) { if (ch + 1 < NCH) DO_G1(ch + 1); } else { ph_combine(p, l, ch, Y, HN, lane, wave); } __syncthreads(); } });
        }
    }
#ifdef TIMEK
    if (blockIdx.x == 0) { const unsigned long long* ts = (const unsigned long long*)(p0.ws + WS_CTL + 32768); __syncthreads();
        const unsigned long long d = (__hip_atomic_load(ts + TIMEK, __ATOMIC_RELAXED, __HIP_MEMORY_SCOPE_AGENT) - __hip_atomic_load(ts + TIMEK0, __ATOMIC_RELAXED, __HIP_MEMORY_SCOPE_AGENT)) * 4ull, t0 = __builtin_amdgcn_s_memrealtime();
        while (__builtin_amdgcn_s_memrealtime() - t0 < d) __builtin_amdgcn_s_sleep(8); }
#endif
#ifdef DBG_ANY
    xcd_barrier(bar, threadIdx.x == 0);
    if (blockIdx.x == 0 && threadIdx.x == 0) p0.out[0] += 1.0e7f * __uint_as_float(((const unsigned*)(p0.ws + WS_CTL))[CW_DBG]);
#endif
#undef RUN
}
constexpr int NPHASES = 1 + 2 * (4 + 3 * NCH) + 6 + 64;
}

extern "C" void kernel_launch(void* const* d_in, const int* in_sizes, int n_in, void* d_out, int out_size, void* d_ws, size_t ws_size, hipStream_t stream) {
    using namespace mk;
    static int grid = 0;
    if (grid == 0) {
        if (n_in != 31 || out_size != T * D || ws_size < WS_END) { fprintf(stderr, "kernel_launch: unexpected shapes (n_in %d, out %d, ws %zu)\n", n_in, out_size, ws_size); grid = -1; return; }
        int dev = 0, cus = 0;
        if (hipGetDevice(&dev) != hipSuccess || hipDeviceGetAttribute(&cus, hipDeviceAttributeMultiprocessorCount, dev) != hipSuccess) { grid = -1; return; }
        if (hipFuncSetAttribute((const void*)mk_fwd, hipFuncAttributeMaxDynamicSharedMemorySize, LDS_BYTES) != hipSuccess) { fprintf(stderr, "kernel_launch: hipFuncSetAttribute failed\n"); grid = -1; return; }
        int per_cu = 0;
        if (hipOccupancyMaxActiveBlocksPerMultiprocessor(&per_cu, (const void*)mk_fwd, NTHR, LDS_BYTES) != hipSuccess || per_cu < 1) { fprintf(stderr, "kernel_launch: occupancy query says %d\n", per_cu); }
        (void)hipGetLastError();
        grid = cus;
        if (grid != 256) { fprintf(stderr, "kernel_launch: built for 256 CUs, found %d\n", grid); grid = -1; return; }
    }
    if (grid < 0) return;
    (void)hipMemsetAsync((char*)d_ws + WS_CTL, 0, CTL_ZERO_BYTES, stream);
    Params a{};
    for (int i = 0; i < 31; ++i) a.in[i] = (const float*)d_in[i];
    a.out = (float*)d_out; a.ws = (unsigned char*)d_ws; a.ph_lo = 0; a.ph_hi = NPHASES;
    hipLaunchKernelGGL(mk_fwd, dim3(grid), dim3(NTHR), LDS_BYTES, stream, a);
}
```

```cpp
#include <hip/hip_runtime.h>
#include <cstdio>
#include <cstdint>
namespace pg8 {
#define PG8_LAS __attribute__((address_space(3)))
typedef unsigned short bf16_t;
typedef short bf16x8 __attribute__((ext_vector_type(8)));
typedef float f32x4 __attribute__((ext_vector_type(4)));
typedef unsigned u32x4 __attribute__((ext_vector_type(4)));
typedef unsigned u32x2 __attribute__((ext_vector_type(2)));
constexpr int BM = 256, BK = 64, HALF = 128, HTB = HALF * BK * 2  , STAGE_BYTES = 8 * HTB;

__host__ __device__ __forceinline__ int lds_byte(int r, int c) { const int st = (r >> 4) * 2 + (c >> 5), rr = r & 15, cc = c & 31, ob = rr * 64 + cc * 2; return st * 1024 + (ob ^ (((ob >> 9) & 1) << 5)); }
__host__ __device__ __forceinline__ void stage_rc(int b, int& R, int& C) { const int st = b / 1024, sb = b % 1024, swz = sb ^ (((sb >> 9) & 1) << 5); R = (st >> 1) * 16 + swz / 64; C = (st & 1) * 32 + (swz % 64) / 2; }
__host__ __device__ __forceinline__ int perm32(int rho) { const int n = rho >> 4, i = rho & 15; return 8 * (i >> 2) + 4 * n + (i & 3); }

struct Unit { int pm, pn; };
__device__ __forceinline__ unsigned cvt_pk_bf16(float lo, float hi) { unsigned r; asm volatile("v_cvt_pk_bf16_f32 %0, %1, %2" : "=v"(r) : "v"(lo), "v"(hi)); return r; }
struct Gemm { const bf16_t* A; const bf16_t* Bt; int K; unsigned lda_bytes; };
template <class Epi, class Sched>
__device__ __forceinline__ void gemm_phase(PG8_LAS unsigned char* lds, const Gemm g, const Sched& S, const Epi& E, const int tid_in) {
    int tid_ = tid_in; asm volatile("" : "+v"(tid_));
    const int tid = tid_, wid = __builtin_amdgcn_readfirstlane(tid >> 6), lane = tid & 63, wr = wid >> 2, wc = wid & 3, fr = lane & 15, fq = lane >> 4;
    const int K = g.K, nt = K / BK;
    unsigned voffB[2];
#pragma unroll
    for (int i = 0; i < 2; ++i) { int R, C; stage_rc(tid * 16 + i * 8192, R, C); const int Rb = Epi::PERM ? ((R & ~31) + perm32(R & 31)) : R;
        voffB[i] = (unsigned)(Rb * K + C) * 2u; }
    const size_t kstep = (size_t)(BK * 2);
    const size_t hstep = (size_t)HALF * K * 2;
    const size_t tstep = 2 * hstep;
    const unsigned ldsw = (unsigned)wid * 1024u;
    const int aoff = lds_byte(wr * 64 + fr, fq * 8), boff = lds_byte(wc * 32 + fr, fq * 8);
    const char* Ab = (const char*)g.A;
#define PG8_SA(b, h) (((b) * 2 + (h)) * HTB)
#define PG8_SB(b, h) ((4 + (b) * 2 + (h)) * HTB)
#define PG8_STAGE(bufoff, gbase, voff) do { _Pragma("unroll") for (int _i = 0; _i < 2; ++_i) \
        __builtin_amdgcn_global_load_lds((const unsigned*)((const char*)(gbase) + (voff)[_i]), (PG8_LAS unsigned*)(lds + (bufoff) + ldsw + _i * 8192), 16, 0, 0); } while (0)
#define PG8_STAGEA(bufoff, o0, o1, kb) do { \
        __builtin_amdgcn_global_load_lds((const unsigned*)(Ab + (size_t)(o0) + (size_t)(kb)), (PG8_LAS unsigned*)(lds + (bufoff) + ldsw), 16, 0, 0); \
        __builtin_amdgcn_global_load_lds((const unsigned*)(Ab + (size_t)(o1) + (size_t)(kb)), (PG8_LAS unsigned*)(lds + (bufoff) + ldsw + 8192), 16, 0, 0); } while (0)
#define PG8_LDA(dst, b, h) do { _Pragma("unroll") for (int m = 0; m < 4; ++m) _Pragma("unroll") for (int k = 0; k < 2; ++k) dst[m][k] = *(const PG8_LAS bf16x8*)(lds + PG8_SA(b, h) + aoff + m * 2048 + k * 1024); } while (0)
#define PG8_LDB(dst, b, h) do { _Pragma("unroll") for (int n = 0; n < 2; ++n) _Pragma("unroll") for (int k = 0; k < 2; ++k) dst[n][k] = *(const PG8_LAS bf16x8*)(lds + PG8_SB(b, h) + boff + n * 2048 + k * 1024); } while (0)
#define PG8_MMA(ai, bj, At, Bt) do { __builtin_amdgcn_s_setprio(1); _Pragma("unroll") for (int m = 0; m < 4; ++m) _Pragma("unroll") for (int n = 0; n < 2; ++n) _Pragma("unroll") for (int k = 0; k < 2; ++k) \
        acc[ai][bj][m][n] = __builtin_amdgcn_mfma_f32_16x16x32_bf16(Bt[n][k], At[m][k], acc[ai][bj][m][n], 0, 0, 0); __builtin_amdgcn_s_setprio(0); } while (0)
#define PG8_WAIT_V(n) asm volatile("s_waitcnt vmcnt(" #n ")" ::: "memory")
#define PG8_WAIT_L(n) asm volatile("s_waitcnt lgkmcnt(" #n ")" ::: "memory")
#define PG8_BAR __builtin_amdgcn_s_barrier()
#define PG8_SCHED __builtin_amdgcn_sched_barrier(0)
#define PG8_OFFS(dst, u) do { _Pragma("unroll") for (int _i = 0; _i < 2; ++_i) { int _R, _C; stage_rc(tid * 16 + _i * 8192, _R, _C); _Pragma("unroll") for (int _h = 0; _h < 2; ++_h) \
        dst[_h][_i] = (unsigned)S.arow((u).pm * BM + _h * HALF + _R) * g.lda_bytes + (unsigned)(_C * 2); } } while (0)
    Unit cur, nxt; int ui = 0;
    if (!S.next(0, cur)) return;
    f32x4 acc[2][2][4][2];
#pragma unroll
    for (int a = 0; a < 2; ++a)
#pragma unroll
        for (int b = 0; b < 2; ++b)
#pragma unroll
            for (int m = 0; m < 4; ++m)
#pragma unroll
                for (int n = 0; n < 2; ++n) acc[a][b][m][n] = (f32x4){0.f, 0.f, 0.f, 0.f};
    bf16x8 At[4][2], B0[2][2], B1[2][2];
    unsigned oC[2][2], oN[2][2];
    PG8_OFFS(oC, cur);
    const char* cB = (const char*)g.Bt + (size_t)cur.pn * tstep;
    PG8_STAGE(PG8_SB(0, 0), cB, voffB); PG8_STAGE(PG8_SB(0, 1), cB + hstep, voffB); PG8_STAGEA(PG8_SA(0, 0), oC[0][0], oC[0][1], 0); PG8_STAGEA(PG8_SA(0, 1), oC[1][0], oC[1][1], 0);
    if (wr == 1) PG8_BAR;
    PG8_WAIT_V(2); PG8_BAR;
    PG8_STAGE(PG8_SB(1, 0), cB + kstep, voffB); PG8_STAGEA(PG8_SA(1, 0), oC[0][0], oC[0][1], kstep); PG8_STAGE(PG8_SB(1, 1), cB + hstep + kstep, voffB);
    PG8_WAIT_V(6); PG8_BAR;
    for (;;) {
        const bool has_next = S.next(ui + 1, nxt);
        if (has_next) { PG8_OFFS(oN, nxt); } else {
#pragma unroll
            for (int _h = 0; _h < 2; ++_h)
#pragma unroll
                for (int _i = 0; _i < 2; ++_i) oN[_h][_i] = oC[_h][_i]; }
        const char* nB = has_next ? (const char*)g.Bt + (size_t)nxt.pn * tstep : cB;
#pragma unroll 1
        for (int t = 0; t < nt; t += 2) {
            const bool last = (t == nt - 2);
            const size_t k1 = (size_t)(t + 1) * kstep;
            const size_t k2 = last ? 0 : (size_t)(t + 2) * kstep, k3 = k2 + kstep;
            const char* b2 = last ? nB : cB + (size_t)(t + 2) * kstep; const char* b3 = b2 + kstep;
            PG8_LDB(B0, 0, 0); PG8_LDB(B1, 0, 1); PG8_SCHED; PG8_LDA(At, 0, 0); PG8_STAGEA(PG8_SA(1, 1), oC[1][0], oC[1][1], k1);
            if (last) { oC[0][0] = oN[0][0]; oC[0][1] = oN[0][1]; oC[1][0] = oN[1][0]; oC[1][1] = oN[1][1]; }
            PG8_WAIT_V(8); PG8_WAIT_L(0); PG8_BAR; PG8_MMA(0, 0, At, B0); PG8_MMA(0, 1, At, B1); PG8_BAR; PG8_SCHED;
            PG8_LDA(At, 0, 1); PG8_STAGE(PG8_SB(0, 0), b2, voffB); PG8_STAGE(PG8_SB(0, 1), b2 + hstep, voffB); PG8_STAGEA(PG8_SA(0, 0), oC[0][0], oC[0][1], k2);
            PG8_WAIT_V(8); PG8_WAIT_L(0); PG8_BAR; PG8_MMA(1, 0, At, B0); PG8_MMA(1, 1, At, B1); PG8_BAR; PG8_SCHED;
            PG8_LDB(B0, 1, 0); PG8_LDB(B1, 1, 1); PG8_SCHED; PG8_LDA(At, 1, 0); PG8_STAGEA(PG8_SA(0, 1), oC[1][0], oC[1][1], k2);
            PG8_WAIT_V(8); PG8_WAIT_L(0); PG8_BAR; PG8_MMA(0, 0, At, B0); PG8_MMA(0, 1, At, B1); PG8_BAR; PG8_SCHED;
            PG8_LDA(At, 1, 1); PG8_STAGE(PG8_SB(1, 0), b3, voffB); PG8_STAGE(PG8_SB(1, 1), b3 + hstep, voffB); PG8_STAGEA(PG8_SA(1, 0), oC[0][0], oC[0][1], k3);
            PG8_WAIT_V(8); PG8_WAIT_L(0); PG8_BAR; PG8_MMA(1, 0, At, B0); PG8_MMA(1, 1, At, B1); PG8_BAR; PG8_SCHED;
        }
        if (wr == 0) PG8_BAR;
        E(acc, cur, wr, wc, fr, fq);
        if (!has_next) break;
#pragma unroll
        for (int a = 0; a < 2; ++a)
#pragma unroll
            for (int b = 0; b < 2; ++b)
#pragma unroll
                for (int m = 0; m < 4; ++m)
#pragma unroll
                    for (int n = 0; n < 2; ++n) acc[a][b][m][n] = (f32x4){0.f, 0.f, 0.f, 0.f};
        cur = nxt; cB = nB; ++ui;
#pragma unroll
        for (int _h = 0; _h < 2; ++_h)
#pragma unroll
            for (int _i = 0; _i < 2; ++_i) oC[_h][_i] = oN[_h][_i];
        if (wr == 1) PG8_BAR;
    }
    PG8_WAIT_V(0);
    PG8_BAR;
    if constexpr (Epi::AFTER_DRAIN) E.fused(acc, cur, wr, wc, fr, fq, lds);
#undef PG8_SA
#undef PG8_SB
#undef PG8_STAGE
#undef PG8_STAGEA
#undef PG8_LDA
#undef PG8_LDB
#undef PG8_MMA
#undef PG8_WAIT_V
#undef PG8_WAIT_L
#undef PG8_BAR
#undef PG8_SCHED
#undef PG8_OFFS
}

template <class Epi, class Sched>
__device__ __noinline__ void gemm_phase_ni(PG8_LAS unsigned char* lds, Gemm g, Sched S, Epi E) { gemm_phase<Epi, Sched>(lds, g, S, E, (int)threadIdx.x); }
}

namespace mk {
using namespace pg8;
constexpr int D = 1024, NB = 32, SEQ = 2048, T = NB * SEQ, LC = 256, TC = NB * LC, TT = T + TC;
constexpr int NMOD = 6 * D;
constexpr int NE = 64, NEX = 65, DE = 256;
constexpr int NCH = 4, CHT = T / NCH;
constexpr int MAXTILES = 640, CHROWS = MAXTILES * 256;
constexpr float RMS_EPS = 1e-6f;
constexpr int NWAVES = 8, NTHR = 512;

constexpr size_t MiB = 1u << 20;
constexpr size_t WS_CTL = 0, CTL_ZERO_BYTES = 64 * 1024;
constexpr size_t WS_MOD = 1 * MiB;
constexpr size_t WS_ROPE = 3 * MiB;
constexpr size_t WS_BC = 3 * MiB + 65536;
constexpr size_t WS_GATES = 4 * MiB;
constexpr size_t WS_FILT = 10 * MiB;
constexpr size_t WS_EIDX = 18 * MiB, WS_WTS = 20 * MiB, WS_PSLOT = 22 * MiB, WS_SORT = 26 * MiB;
constexpr size_t WS_WIN0 = 30 * MiB;
constexpr size_t WS_WOUT0 = 38 * MiB, WS_WIN1 = 40 * MiB, WS_WOUT1 = 46 * MiB, WS_WR = 48 * MiB;
constexpr size_t WS_GU = 50 * MiB;
constexpr size_t WS_DN = 180 * MiB;
constexpr size_t WS_BIG = 246 * MiB;
constexpr size_t WS_END = 1024 * MiB;
static_assert(WS_PSLOT + (size_t)T * 16 * 4 <= WS_SORT && WS_SORT + (size_t)4 * CHROWS * 4 <= WS_WIN0 && WS_WIN0 + (size_t)3840 * 2048 <= WS_WOUT0 && WS_WR + (size_t)2 * 256 * 2048 <= WS_GU && WS_GU + (size_t)2 * 65 * 512 * 2048 <= WS_DN && WS_DN + (size_t)2 * 65 * 1024 * 512 <= WS_BIG, "ws map");
constexpr size_t A0_H = 0, A0_QA = 144 * MiB, A0_KA = 208 * MiB, A0_VA = 280 * MiB, A0_BQ = 352 * MiB, A0_BK = 416 * MiB, A0_BV = 488 * MiB, A0_BO = 560 * MiB, A0_VT = 624 * MiB;
constexpr size_t A0_MIXIN = 0, A0_HB = 144 * MiB, A0_MIX = 352 * MiB;
constexpr int CW_BAR = 4096;

constexpr int LDS_BYTES = 160 * 1024;
constexpr int LDS_TAB = 131072;
constexpr int LDS_MISC = 131072 + 24 * 1024;

#define GAS __attribute__((address_space(1)))
#define LAS __attribute__((address_space(3)))
typedef unsigned short bf16;
typedef unsigned v4u __attribute__((ext_vector_type(4)));
typedef unsigned v2u __attribute__((ext_vector_type(2)));
#define LDS_WAIT() asm volatile("s_waitcnt lgkmcnt(0)" ::: "memory")
#define VM_WAIT() asm volatile("s_waitcnt vmcnt(0)" ::: "memory")
__device__ __forceinline__ unsigned f2bf(float f) { unsigned u = __builtin_bit_cast(unsigned, f); return (u + 0x7fffu + ((u >> 16) & 1u)) >> 16; }
__device__ __forceinline__ unsigned pk2(float lo, float hi) { return f2bf(lo) | (f2bf(hi) << 16); }
__device__ __forceinline__ float bf_lo(unsigned w) { return __builtin_bit_cast(float, w << 16); }
__device__ __forceinline__ float bf_hi(unsigned w) { return __builtin_bit_cast(float, w & 0xffff0000u); }
__device__ __forceinline__ float bf1(bf16 h) { return __builtin_bit_cast(float, (unsigned)h << 16); }
__device__ __forceinline__ int lane_opq() { int l = (int)__builtin_amdgcn_mbcnt_hi(~0u, __builtin_amdgcn_mbcnt_lo(~0u, 0u)); asm volatile("" : "+v"(l)); return l; }
__device__ __forceinline__ float shx(float v, int m) { return __builtin_bit_cast(float, __builtin_amdgcn_ds_bpermute((lane_opq() ^ m) << 2, __builtin_bit_cast(int, v))); }
__device__ __forceinline__ float shup(float v, int o) { const int l = lane_opq(); return __builtin_bit_cast(float, __builtin_amdgcn_ds_bpermute((l >= o ? l - o : l) << 2, __builtin_bit_cast(int, v))); }
__device__ __forceinline__ float shidx(float v, int idx) { return __builtin_bit_cast(float, __builtin_amdgcn_ds_bpermute(idx << 2, __builtin_bit_cast(int, v))); }
__device__ __forceinline__ float wave_sum(float v) {
#pragma unroll
    for (int o = 1; o < 64; o <<= 1) v += shx(v, o);
    return v;
}
__device__ __forceinline__ float wave_max(float v) {
#pragma unroll
    for (int o = 1; o < 64; o <<= 1) v = fmaxf(v, shx(v, o));
    return v;
}
__device__ __forceinline__ float sigmoidf_(float x) { return 1.f / (1.f + __expf(-x)); }
__device__ __forceinline__ float siluf_(float x) { return x / (1.f + __expf(-x)); }
#define XB_TMO      128
#define XB_XCNT(j)  (256  + 64 * (j))
#define XB_XSUB(j)  (1280 + 64 * (j))
#define XB_XGEN(j)  (2304 + 64 * (j))
#define XB_TOP      3328
#define XB_TOPGEN   3392
#define XCD_BAR_WORDS 3456
#define XB_SPIN_CAP (1u << 18)

__device__ __forceinline__ unsigned xb_ld(unsigned* p)              { return __hip_atomic_load(p, __ATOMIC_RELAXED, __HIP_MEMORY_SCOPE_AGENT); }
__device__ __forceinline__ unsigned xb_add(unsigned* p, unsigned v) { return __hip_atomic_fetch_add(p, v, __ATOMIC_RELAXED, __HIP_MEMORY_SCOPE_AGENT); }
__device__ __forceinline__ unsigned xb_xcc_id() { return (unsigned)__builtin_amdgcn_s_getreg((3 << 11) | 20) & 0xFu; }
#define XB_SPIN(cond, bar) do { unsigned _sp = 0; while (cond) { __builtin_amdgcn_s_sleep(1); \
    if ((++_sp & 255u) == 0u) { if (xb_ld(&(bar)[XB_TMO])) break; if (_sp > XB_SPIN_CAP) { atomicAdd(&(bar)[XB_TMO], 1u); break; } } } } while (0)

struct XcdBarrier {
    unsigned* bar; unsigned x;
    volatile LAS unsigned* st;
};

__device__ __forceinline__ XcdBarrier xcd_barrier_post(unsigned* bar, volatile LAS unsigned* st) {
    XcdBarrier b; b.bar = bar; b.x = xb_xcc_id(); b.st = st;
    if (threadIdx.x == 0) (void)xb_add(&bar[XB_XCNT(b.x)], 1u);
    return b;
}
__device__ __forceinline__ void xcd_barrier_complete(unsigned* bar, unsigned x, unsigned& nloc, unsigned& nx) {
    const unsigned G = gridDim.x * gridDim.y * gridDim.z;
    unsigned sum, cnt, mine, sp = 0u;
    for (;;) {
        sum = 0u; cnt = 0u; mine = 0u;
#pragma unroll
        for (unsigned j = 0; j < 16; ++j) { const unsigned c = xb_ld(&bar[XB_XCNT(j)]); sum += c; cnt += (c > 0u) ? 1u : 0u; mine = (j == x) ? c : mine; }
        if (sum == G) break;
        __builtin_amdgcn_s_sleep(1);
        if ((++sp & 255u) == 0u) { if (xb_ld(&bar[XB_TMO])) break; if (sp > XB_SPIN_CAP) { atomicAdd(&bar[XB_TMO], 1u); break; } }
    }
    nloc = mine > 0u ? mine : 1u; nx = cnt > 0u ? cnt : 1u;
}

__device__ __forceinline__ void xcd_barrier(const XcdBarrier& b, const bool t0  ) {
    asm volatile("s_waitcnt vmcnt(0)" ::: "memory");
    __syncthreads();
    if (t0) {
        unsigned* bar = b.bar;
        __builtin_amdgcn_s_waitcnt(0);
        unsigned nloc = b.st[0], nx = b.st[1];
        if (nloc == 0u) { xcd_barrier_complete(bar, b.x, nloc, nx); b.st[0] = nloc; b.st[1] = nx; }
        const unsigned old = xb_add(&bar[XB_XSUB(b.x)], 1u);
        const unsigned gen = old / nloc;
        if (old + 1u == (gen + 1u) * nloc) {
            __builtin_amdgcn_fence(__ATOMIC_RELEASE, "agent");
            asm volatile("s_waitcnt vmcnt(0)" ::: "memory");
            const unsigned og = xb_add(&bar[XB_TOP], 1u);
            const unsigned tg = og / nx;
            if (og + 1u == (tg + 1u) * nx) xb_add(&bar[XB_TOPGEN], 1u);
            else XB_SPIN(xb_ld(&bar[XB_TOPGEN]) == tg, bar);
            __builtin_amdgcn_fence(__ATOMIC_ACQUIRE, "agent");
            xb_add(&bar[XB_XGEN(b.x)], 1u);
            asm volatile("s_waitcnt vmcnt(0)" ::: "memory");
        } else {
            XB_SPIN(xb_ld(&bar[XB_XGEN(b.x)]) == gen, bar);
            __builtin_amdgcn_fence(__ATOMIC_ACQUIRE, "agent");
            asm volatile("s_waitcnt vmcnt(0)" ::: "memory");
        }
    }
    __syncthreads();
}

constexpr float Y8_SCALE = 16.f, Y8_INV = 1.f / 16.f;
struct Params { const float* in[31]; float* out; unsigned char* ws; int ph_lo, ph_hi; };
enum { I_X = 0, I_C, I_CTX, I_CCTX, I_WMOD, I_BMOD, I_NORMG, I_WINAB, I_CONVABW, I_CONVABB, I_GATEB, I_DLAM, I_HGA, I_HGB, I_WOUTAB, I_WINHY, I_CONVHYW, I_CONVHYB,
       I_FW1, I_FB1, I_FW2, I_FB2, I_FW3, I_FBIAS, I_WOUTHY, I_RW, I_RB, I_EGU, I_EDN, I_SGU, I_SDN };

__device__ __forceinline__ void row_ld_f32(const float* row, int lane, f32x4 (&v)[4]) { const f32x4* r = (const f32x4*)row + lane;
#pragma unroll
    for (int j = 0; j < 4; ++j) v[j] = r[64 * j]; }
__device__ __forceinline__ void row_st_f32(float* row, int lane, const f32x4 (&v)[4]) { f32x4* r = (f32x4*)row + lane;
#pragma unroll
    for (int j = 0; j < 4; ++j) r[64 * j] = v[j]; }
__device__ __forceinline__ void row_ld_bf16(const bf16* row, int lane, f32x4 (&v)[4]) { const v2u* r = (const v2u*)row + lane;
#pragma unroll
    for (int j = 0; j < 4; ++j) { const v2u w = r[64 * j]; v[j] = (f32x4){bf_lo(w.x), bf_hi(w.x), bf_lo(w.y), bf_hi(w.y)}; } }
__device__ __forceinline__ void row_st_bf16(bf16* row, int lane, const f32x4 (&v)[4]) { v2u* r = (v2u*)row + lane;
#pragma unroll
    for (int j = 0; j < 4; ++j) { v2u w; w.x = pk2(v[j].x, v[j].y); w.y = pk2(v[j].z, v[j].w); r[64 * j] = w; } }
__device__ __forceinline__ float row_ss(const f32x4 (&v)[4]) { float s = 0.f;
#pragma unroll
    for (int j = 0; j < 4; ++j) s += (v[j].x * v[j].x + v[j].y * v[j].y) + (v[j].z * v[j].z + v[j].w * v[j].w);
    return wave_sum(s); }
__device__ __forceinline__ void row_modulate(const f32x4 (&x)[4], float rstd, const float* g, const float* shift, const float* scale, int lane, f32x4 (&h)[4]) {
    const f32x4* gp = (const f32x4*)g + lane; const f32x4* sh = (const f32x4*)shift + lane; const f32x4* sc = (const f32x4*)scale + lane;
#pragma unroll
    for (int j = 0; j < 4; ++j) { const f32x4 gg = gp[64 * j], s1 = sc[64 * j], s0 = sh[64 * j]; h[j] = x[j] * rstd * gg * (1.f + s1) + s0; } }

__device__ __forceinline__ void pro_mod(const Params& p, LAS unsigned char* lds, int tid, int lane, int wave) {
    const int u = blockIdx.x; if (u >= 192) return;
    LAS float* S = (LAS float*)lds;
    const float* c = p.in[I_C]; const float* cc = p.in[I_CCTX];
#pragma unroll 1
    for (int i = tid; i < 33 * 1024; i += NTHR) { const int b = i >> 10, k = i & 1023; const float v = b < 32 ? c[b * 1024 + k] : cc[k]; S[i] = siluf_(v); }
    __syncthreads();
    const int l = u / 96, cg = (u % 96) * 64, col = cg + lane;
    const float* W = p.in[I_WMOD] + (size_t)l * 1024 * NMOD;
    float acc[33];
#pragma unroll
    for (int b = 0; b < 33; ++b) acc[b] = 0.f;
    const int k0 = wave * 128;
#pragma unroll 1
    for (int kk = 0; kk < 128; kk += 4) { const int k = k0 + kk;
        const float w0 = W[(size_t)k * NMOD + col], w1 = W[(size_t)(k + 1) * NMOD + col], w2 = W[(size_t)(k + 2) * NMOD + col], w3 = W[(size_t)(k + 3) * NMOD + col];
#pragma unroll
        for (int b = 0; b < 33; ++b) { const f32x4 s = *(const LAS f32x4*)(S + b * 1024 + k); acc[b] += (s.x * w0 + s.y * w1) + (s.z * w2 + s.w * w3); } }
    __syncthreads();
    LAS float* P = (LAS float*)lds;
#pragma unroll
    for (int b = 0; b < 33; ++b) P[(wave * 33 + b) * 64 + lane] = acc[b];
    __syncthreads();
    float* MOD = (float*)(p.ws + WS_MOD);
#pragma unroll 1
    for (int i = tid; i < 33 * 64; i += NTHR) { const int b = i >> 6, ln = i & 63; float s = 0.f;
#pragma unroll
        for (int w = 0; w < 8; ++w) s += P[(w * 33 + b) * 64 + ln];
        MOD[(size_t)(l * 33 + b) * NMOD + cg + ln] = s + p.in[I_BMOD][l * NMOD + cg + ln]; }
    __syncthreads();
}
__device__ __forceinline__ int rowmap(int kind, int n) {
    if (kind == 1) { const int o = n & 31; return (n & ~31) + (((o & 15) >> 2) * 8 + (o >> 4) * 4 + (o & 3)); }
    if (kind == 2) { return n < 256 ? ((n >> 7) * 256 + (n & 127)) : ((((n - 256) >> 7) * 256) + 128 + ((n - 256) & 127)); }
    if (kind == 3) { const int a = n & 255; return (n & ~255) + 128 * ((a >> 3) & 1) + 32 * (a >> 6) + 8 * ((a >> 4) & 3) + (a & 7); }
    return n;
}
__device__ __forceinline__ void tr_item(const float* W, int ldn, int k0, int n0, int nvalid, bf16* WT, int dK, int kind, int row_base, LAS float* scr, int lane) {
    const int nn = n0 + (lane & 31);
#pragma unroll 8
    for (int i = 0; i < 32; ++i) { const int kk = 2 * i + (lane >> 5); scr[kk * 33 + (lane & 31)] = nn < nvalid ? W[(size_t)(k0 + kk) * ldn + nn] : 0.f; }
    LDS_WAIT(); asm volatile("" ::: "memory");
    const int c = lane & 7;
#pragma unroll
    for (int j = 0; j < 4; ++j) { const int n = (lane >> 3) + 8 * j; const LAS float* s = scr + (8 * c) * 33 + n;
        v4u o; o.x = pk2(s[0 * 33], s[1 * 33]); o.y = pk2(s[2 * 33], s[3 * 33]); o.z = pk2(s[4 * 33], s[5 * 33]); o.w = pk2(s[6 * 33], s[7 * 33]);
        const int row = row_base + rowmap(kind, n0 + n);
        *(v4u*)(WT + (size_t)row * dK + k0 + 8 * c) = o; }
    LDS_WAIT(); asm volatile("" ::: "memory");
}
__device__ __forceinline__ void pro_transposes(const Params& p, LAS unsigned char* lds, int lane, int wave) {
    LAS float* scr = (LAS float*)(lds + wave * 16384);
    const int gw = blockIdx.x * NWAVES + wave, NGW = gridDim.x * NWAVES;
    constexpr int I_A = 16 * 113, I_B = 512, I_C2 = 1536, I_D = 512, I_E = 64, I_F = 130 * 256, I_G = 130 * 128;
    constexpr int NITEMS = I_A + I_B + I_C2 + I_D + I_E + I_F + I_G;
    unsigned char* ws = p.ws;
    for (int it = gw; it < NITEMS; it += NGW) {
        int r = it;
        if (r < I_A) { const int kb = r / 113, nb = r % 113, n0 = nb * 32; const int kind = (n0 < 512 || (n0 >= 1536 && n0 < 2048)) ? 1 : 0;
            tr_item(p.in[I_WINAB], 3600, kb * 64, n0, 3600, (bf16*)(ws + WS_WIN0), 1024, kind, 0, scr, lane); continue; } r -= I_A;
        if (r < I_B) { tr_item(p.in[I_WOUTAB], 1024, (r / 32) * 64, (r % 32) * 32, 1024, (bf16*)(ws + WS_WOUT0), 1024, 0, 0, scr, lane); continue; } r -= I_B;
        if (r < I_C2) { tr_item(p.in[I_WINHY], 3072, (r / 96) * 64, (r % 96) * 32, 3072, (bf16*)(ws + WS_WIN1), 1024, 0, 0, scr, lane); continue; } r -= I_C2;
        if (r < I_D) { tr_item(p.in[I_WOUTHY], 1024, (r / 32) * 64, (r % 32) * 32, 1024, (bf16*)(ws + WS_WOUT1), 1024, 0, 0, scr, lane); continue; } r -= I_D;
        if (r < I_E) { const int l = r / 32, q = r % 32;
            tr_item(p.in[I_RW] + (size_t)l * 1024 * 64, 64, (q / 2) * 64, (q % 2) * 32, 64, (bf16*)(ws + WS_WR) + (size_t)l * 256 * 1024, 1024, 0, 0, scr, lane); continue; } r -= I_E;
        if (r < I_F) { const int mat = r / 256, q = r % 256, l = mat / 65, e = mat % 65;
            const float* src = e < 64 ? p.in[I_EGU] + (size_t)(l * 64 + e) * 1024 * 512 : p.in[I_SGU] + (size_t)l * 1024 * 512;
            tr_item(src, 512, (q / 16) * 64, (q % 16) * 32, 512, (bf16*)(ws + WS_GU) + (size_t)l * (65 * 512) * 1024, 1024, 2, e * 512, scr, lane); continue; } r -= I_F;
        { const int mat = r / 128, q = r % 128, l = mat / 65, e = mat % 65;
            const float* src = e < 64 ? p.in[I_EDN] + (size_t)(l * 64 + e) * 256 * 1024 : p.in[I_SDN] + (size_t)l * 256 * 1024;
            tr_item(src, 1024, (q / 32) * 64, (q % 32) * 32, 1024, (bf16*)(ws + WS_DN) + (size_t)l * (65 * 1024) * 256, 256, 3, e * 1024, scr, lane); }
    }
}
__device__ __forceinline__ void pro_rope(const Params& p, int tid) {
    if (blockIdx.x != 255) return;
    float* R = (float*)(p.ws + WS_ROPE);
    for (int i = tid; i < 64 * 16; i += NTHR) { const int pos = i >> 4, f = i & 15; const float inv = exp2f(-(float)f * (13.287712379549449f / 16.f)); const float ang = (float)pos * inv;
        float sn, cs; sincosf(ang, &sn, &cs); R[2 * i] = cs; R[2 * i + 1] = sn; }
}
__device__ __forceinline__ void pro_filters(const Params& p, LAS unsigned char* lds, int tid, int lane, int wave) {
    LAS float* Z = (LAS float*)lds;
    LAS float* H1 = Z + 512;
    LAS float* H2 = H1 + 512;
    const int j0 = 8 * blockIdx.x, j = j0 + wave;
    const float* fw1 = p.in[I_FW1]; const float* fb1 = p.in[I_FB1]; const float* fw2 = p.in[I_FW2]; const float* fb2 = p.in[I_FB2]; const float* fw3 = p.in[I_FW3];
    {   float z = 0.f;
        if (lane == 0) z = (float)j / 2047.f;
        else if (lane < 33) { const int k = (lane - 1) & 15; const float fr = 1e-4f + (float)k * ((15.f - 1e-4f) / 15.f); const float ang = (6.283185307179586f / 2048.f) * (float)j * fr;
            float sn, cs; sincosf(ang, &sn, &cs); z = lane < 17 ? cs : -sn; }
        Z[wave * 64 + lane] = z; }
    LDS_WAIT(); asm volatile("" ::: "memory");
    {   float a = fb1[lane];
#pragma unroll 1
        for (int k = 0; k < 33; ++k) a += Z[wave * 64 + k] * fw1[k * 64 + lane];
        H1[wave * 64 + lane] = sinf(a); }
    LDS_WAIT(); asm volatile("" ::: "memory");
    {   float a = fb2[lane];
#pragma unroll 1
        for (int k = 0; k < 64; ++k) a += H1[wave * 64 + k] * fw2[k * 64 + lane];
        H2[wave * 64 + lane] = sinf(a); }
    __syncthreads();
    bf16* F = (bf16*)(p.ws + WS_FILT);
    const float mind = -4.605170185988091f / 1.5f, maxd = -4.605170185988091f / 0.3f;
#pragma unroll 1
    for (int i = 0; i < 4; ++i) { const int n = tid + NTHR * i, c = n & 1023;
        float acc[8];
#pragma unroll
        for (int q = 0; q < 8; ++q) acc[q] = 0.f;
#pragma unroll 2
        for (int k = 0; k < 64; ++k) { const float w = fw3[k * 2048 + n];
#pragma unroll
            for (int q = 0; q < 8; ++q) acc[q] += H2[q * 64 + k] * w; }
        const float delta = fabsf(mind + (float)c * ((maxd - mind) / 1023.f));
        float o[8];
#pragma unroll
        for (int q = 0; q < 8; ++q) { const float dist = fabsf((float)(j0 + q) - 1024.f) * (1.f / 1024.f); o[q] = acc[q] * expf(-dist * delta); }
        v4u w; w.x = pk2(o[0], o[1]); w.y = pk2(o[2], o[3]); w.z = pk2(o[4], o[5]); w.w = pk2(o[6], o[7]);
        *(v4u*)(F + (size_t)n * 2048 + j0) = w; }
    __syncthreads();
}

__device__ __forceinline__ void ph_l0_norm(const Params& p, int lane, int wave) {
    const int gw = blockIdx.x * NWAVES + wave, NGW = gridDim.x * NWAVES;
    const float* MOD = (const float*)(p.ws + WS_MOD); bf16* H = (bf16*)(p.ws + WS_BIG + A0_H);
    const float* g = p.in[I_NORMG];
    for (int m = gw; m < TT; m += NGW) {
        const float* src; int bi;
        if (m < T) { src = p.in[I_X] + (size_t)m * D; bi = m >> 11; } else { src = p.in[I_CTX] + (size_t)(m - T) * D; bi = 32; }
        f32x4 x[4], h[4]; row_ld_f32(src, lane, x);
        const float rstd = rsqrtf(row_ss(x) * (1.f / D) + RMS_EPS);
        const float* md = MOD + (size_t)bi * NMOD;
        row_modulate(x, rstd, g, md, md + D, lane, h);
        row_st_bf16(H + (size_t)m * D, lane, h);
    }
}
__device__ __forceinline__ void ph_mid(const Params& p, int l, const bf16* MIX, bf16* H2, bool has_mix, int lane, int wave) {
    const int gw = blockIdx.x * NWAVES + wave, NGW = gridDim.x * NWAVES;
    const float* MOD = (const float*)(p.ws + WS_MOD) + (size_t)l * 33 * NMOD;
    const float* g1 = p.in[I_NORMG] + (size_t)(l * 4 + 1) * D; const float* g2 = p.in[I_NORMG] + (size_t)(l * 4 + 2) * D;
    const float* xin = l == 0 ? p.in[I_X] : p.out;
    for (int m = gw; m < T; m += NGW) {
        const float* md = MOD + (size_t)(m >> 11) * NMOD;
        f32x4 x[4], h[4]; row_ld_f32(xin + (size_t)m * D, lane, x);
        if (has_mix) { f32x4 mx[4]; row_ld_bf16(MIX + (size_t)m * D, lane, mx);
            const float r = rsqrtf(row_ss(mx) * (1.f / D) + RMS_EPS);
            const f32x4* gp = (const f32x4*)g1 + lane; const f32x4* gm = (const f32x4*)(md + 2 * D) + lane;
#pragma unroll
            for (int j = 0; j < 4; ++j) x[j] = x[j] + gm[64 * j] * (mx[j] * r * gp[64 * j]); }
        row_st_f32(p.out + (size_t)m * D, lane, x);
        const float rstd = rsqrtf(row_ss(x) * (1.f / D) + RMS_EPS);
        row_modulate(x, rstd, g2, md + 3 * D, md + 4 * D, lane, h);
        row_st_bf16(H2 + (size_t)m * D, lane, h);
    }
}
__device__ __forceinline__ void ph_combine(const Params& p, int l, int ch, const unsigned char* Y8, bf16* Hn, int lane, int wave) {
    const int gw = blockIdx.x * NWAVES + wave, NGW = gridDim.x * NWAVES;
    const float* MOD = (const float*)(p.ws + WS_MOD) + (size_t)l * 33 * NMOD;
    const float* g3 = p.in[I_NORMG] + (size_t)(l * 4 + 3) * D;
    const int* PSLOT = (const int*)(p.ws + WS_PSLOT); const float* WTS = (const float*)(p.ws + WS_WTS);
#pragma unroll 1
    for (int mm = gw; mm < CHT; mm += NGW) { const int m = ch * CHT + mm;
        const float* md = MOD + (size_t)(m >> 11) * NMOD;
        float a[16];
#pragma unroll
        for (int j = 0; j < 16; ++j) a[j] = 0.f;
        u32x4 yr[9]; float wk[9];
#pragma unroll
        for (int k = 0; k < 9; ++k) { const int slot = PSLOT[(size_t)m * 16 + k]; wk[k] = k < 8 ? WTS[(size_t)m * 8 + k] : 1.f; yr[k] = *(const u32x4*)(Y8 + (size_t)slot * 1024 + lane * 16); }
#pragma unroll
        for (int k = 0; k < 9; ++k) { const float w = wk[k] * Y8_INV; const unsigned ww[4] = {yr[k].x, yr[k].y, yr[k].z, yr[k].w};
#pragma unroll
            for (int q = 0; q < 4; ++q) { a[4 * q + 0] += w * __builtin_amdgcn_cvt_f32_fp8((int)ww[q], 0); a[4 * q + 1] += w * __builtin_amdgcn_cvt_f32_fp8((int)ww[q], 1);
                                          a[4 * q + 2] += w * __builtin_amdgcn_cvt_f32_fp8((int)ww[q], 2); a[4 * q + 3] += w * __builtin_amdgcn_cvt_f32_fp8((int)ww[q], 3); } }
        float ss = 0.f;
#pragma unroll
        for (int j = 0; j < 16; ++j) ss += a[j] * a[j];
        const float r = rsqrtf(wave_sum(ss) * (1.f / D) + RMS_EPS);
        float* orow = p.out + (size_t)m * D + lane * 16; float x[16]; float s2 = 0.f;
#pragma unroll
        for (int q = 0; q < 4; ++q) { const f32x4 xv = *(const f32x4*)(orow + 4 * q), gp = *(const f32x4*)(g3 + lane * 16 + 4 * q), gf = *(const f32x4*)(md + 5 * D + lane * 16 + 4 * q);
#pragma unroll
            for (int j = 0; j < 4; ++j) { const float v = xv[j] + gf[j] * (a[4 * q + j] * r * gp[j]); x[4 * q + j] = v; s2 += v * v; }
            *(f32x4*)(orow + 4 * q) = (f32x4){x[4 * q], x[4 * q + 1], x[4 * q + 2], x[4 * q + 3]}; }
        if (l == 0) { const float* md1 = MOD + (size_t)(33 + (m >> 11)) * NMOD; const float* g10 = p.in[I_NORMG] + (size_t)4 * D;
            const float rstd = rsqrtf(wave_sum(s2) * (1.f / D) + RMS_EPS); float h[16];
#pragma unroll
            for (int q = 0; q < 4; ++q) { const f32x4 gg = *(const f32x4*)(g10 + lane * 16 + 4 * q), sh = *(const f32x4*)(md1 + lane * 16 + 4 * q), sc = *(const f32x4*)(md1 + D + lane * 16 + 4 * q);
#pragma unroll
                for (int j = 0; j < 4; ++j) h[4 * q + j] = x[4 * q + j] * rstd * gg[j] * (1.f + sc[j]) + sh[j]; }
            v4u w0, w1; w0.x = pk2(h[0], h[1]); w0.y = pk2(h[2], h[3]); w0.z = pk2(h[4], h[5]); w0.w = pk2(h[6], h[7]); w1.x = pk2(h[8], h[9]); w1.y = pk2(h[10], h[11]); w1.z = pk2(h[12], h[13]); w1.w = pk2(h[14], h[15]);
            *(v4u*)(Hn + (size_t)m * D + lane * 16) = w0; *(v4u*)(Hn + (size_t)m * D + lane * 16 + 8) = w1; }
    }
}

struct DenseSched { int NN, NU, G, c, NMs;
    __device__ __forceinline__ bool next(int i, Unit& u) const { const int L = i * G + c; if (L >= NU) return false; if (NMs > 0) { u.pm = L % NMs; u.pn = L / NMs; } else { u.pm = L / NN; u.pn = L % NN; } return true; }
    __device__ __forceinline__ int arow(int r) const { return r; } };
struct EpiBf16 { static constexpr bool PERM = true, AFTER_DRAIN = false; bf16* O; size_t ldc; int cmask;
    __device__ __forceinline__ void operator()(const f32x4 (&acc)[2][2][4][2], const Unit& u, int wr, int wc, int fr, int fq) const {
        const int row0 = u.pm * BM + wr * 64 + fr, col0 = (u.pn & cmask) * BM + wc * 32 + 8 * fq;
#pragma unroll
        for (int ai = 0; ai < 2; ++ai)
#pragma unroll
            for (int m = 0; m < 4; ++m) { bf16* rowp = O + (size_t)(row0 + ai * HALF + m * 16) * ldc + col0;
#pragma unroll
                for (int bj = 0; bj < 2; ++bj) { const f32x4 v0 = acc[ai][bj][m][0], v1 = acc[ai][bj][m][1];
                    u32x4 w; w.x = cvt_pk_bf16(v0[0], v0[1]); w.y = cvt_pk_bf16(v0[2], v0[3]); w.z = cvt_pk_bf16(v1[0], v1[1]); w.w = cvt_pk_bf16(v1[2], v1[3]);
                    *(u32x4*)(rowp + bj * HALF) = w; } }
    } };
struct EpiRouter { static constexpr bool PERM = false, AFTER_DRAIN = false; float* LOG;
    __device__ __forceinline__ void operator()(const f32x4 (&acc)[2][2][4][2], const Unit& u, int wr, int wc, int fr, int fq) const {
        if (wc >= 2) return;
        const int row0 = u.pm * BM + wr * 64 + fr, col0 = wc * 32 + 4 * fq;
#pragma unroll
        for (int ai = 0; ai < 2; ++ai)
#pragma unroll
            for (int m = 0; m < 4; ++m) { float* rowp = LOG + (size_t)(row0 + ai * HALF + m * 16) * 64 + col0;
#pragma unroll
                for (int n = 0; n < 2; ++n) *(f32x4*)(rowp + n * 16) = acc[ai][0][m][n]; }
    } };
struct EpiFp8 { static constexpr bool PERM = true, AFTER_DRAIN = false; unsigned char* O;
    __device__ __forceinline__ void operator()(const f32x4 (&acc)[2][2][4][2], const Unit& u, int wr, int wc, int fr, int fq) const {
        const int row0 = u.pm * BM + wr * 64 + fr, col0 = (u.pn & 3) * BM + wc * 64 + 16 * fq;
#pragma unroll
        for (int ai = 0; ai < 2; ++ai)
#pragma unroll
            for (int m = 0; m < 4; ++m) { unsigned char* rowp = O + (size_t)(row0 + ai * HALF + m * 16) * 1024 + col0; u32x4 w;
#pragma unroll
                for (int bj = 0; bj < 2; ++bj) { const f32x4 v0 = acc[ai][bj][m][0] * Y8_SCALE, v1 = acc[ai][bj][m][1] * Y8_SCALE; int lo = 0, hi = 0;
                    lo = __builtin_amdgcn_cvt_pk_fp8_f32(v0[0], v0[1], lo, false); lo = __builtin_amdgcn_cvt_pk_fp8_f32(v0[2], v0[3], lo, true);
                    hi = __builtin_amdgcn_cvt_pk_fp8_f32(v1[0], v1[1], hi, false); hi = __builtin_amdgcn_cvt_pk_fp8_f32(v1[2], v1[3], hi, true);
                    if (bj == 0) { w.x = (unsigned)lo; w.y = (unsigned)hi; } else { w.z = (unsigned)lo; w.w = (unsigned)hi; } }
                *(u32x4*)rowp = w; }
    } };
struct EpiRouterLds { static constexpr bool PERM = false, AFTER_DRAIN = true;
    __device__ __forceinline__ void operator()(const f32x4 (&)[2][2][4][2], const Unit&, int, int, int, int) const {}
    __device__ __forceinline__ void fused(const f32x4 (&acc)[2][2][4][2], const Unit&, int wr, int wc, int fr, int fq, LAS unsigned char* lds) const {
        if (wc >= 2) return;
        LAS float* SC = (LAS float*)lds;
#pragma unroll
        for (int ai = 0; ai < 2; ++ai)
#pragma unroll
            for (int m = 0; m < 4; ++m) { const int row = ai * HALF + wr * 64 + m * 16 + fr;
#pragma unroll
                for (int n = 0; n < 2; ++n)
#pragma unroll
                    for (int j = 0; j < 4; ++j) SC[row * 65 + wc * 32 + n * 16 + 4 * fq + j] = sigmoidf_(acc[ai][0][m][n][j]); }
    } };
struct MoeSched { const LAS int* te; const int* sort; int NU, G, c, sh, per;
    __device__ __forceinline__ bool next(int i, Unit& u) const { const int L = i * G + c; if (L >= NU) return false; const int tile = L >> sh; u.pm = tile; u.pn = te[tile] * per + (L & (per - 1)); return true; }
    __device__ __forceinline__ int arow(int r) const { return sort ? sort[r] : r; } };
struct EpiSwiglu { static constexpr bool PERM = true, AFTER_DRAIN = false; bf16* ACT;
    __device__ __forceinline__ void operator()(const f32x4 (&acc)[2][2][4][2], const Unit& u, int wr, int wc, int fr, int fq) const {
        const int row0 = u.pm * BM + wr * 64 + fr, col0 = (u.pn & 1) * 128 + wc * 32 + 8 * fq;
#pragma unroll
        for (int ai = 0; ai < 2; ++ai)
#pragma unroll
            for (int m = 0; m < 4; ++m) { bf16* rowp = ACT + (size_t)(row0 + ai * HALF + m * 16) * DE + col0;
                const f32x4 g0 = acc[ai][0][m][0], g1 = acc[ai][0][m][1], u0 = acc[ai][1][m][0], u1 = acc[ai][1][m][1];
                float o[8];
#pragma unroll
                for (int q = 0; q < 4; ++q) { o[q] = siluf_(g0[q]) * u0[q]; o[4 + q] = siluf_(g1[q]) * u1[q]; }
                u32x4 w; w.x = cvt_pk_bf16(o[0], o[1]); w.y = cvt_pk_bf16(o[2], o[3]); w.z = cvt_pk_bf16(o[4], o[5]); w.w = cvt_pk_bf16(o[6], o[7]);
                *(u32x4*)rowp = w; }
    } };
__device__ __forceinline__ int moe_tables(const Params& p, int ch, LAS unsigned char* lds, int tid) {
    LAS int* TE = (LAS int*)(lds + LDS_TAB);
    LAS int* TB = TE + 640;
    LAS int* CN = TB + 80;
    const int* BC = (const int*)(p.ws + WS_BC) + (size_t)ch * 64 * 64;
    __syncthreads();
    if (tid < 64) CN[tid] = 0;
    __syncthreads();
#pragma unroll 1
    for (int i = tid; i < 4096; i += NTHR) __hip_atomic_fetch_add(&CN[i & 63], BC[i], __ATOMIC_RELAXED, __HIP_MEMORY_SCOPE_WORKGROUP);
    __syncthreads();
    if (tid == 0) { int b = 0;
#pragma unroll 1
        for (int e = 0; e < 64; ++e) { TB[e] = b; b += (CN[e] + 255) >> 8; } TB[64] = b; TB[65] = b + 64; }
    __syncthreads();
    const int NT = TB[65];
#pragma unroll 1
    for (int i = tid; i < NT; i += NTHR) { int e = 0;
#pragma unroll 1
        while (e < 64 && i >= TB[e + 1]) ++e;
        TE[i] = e; }
    __syncthreads();
    return NT;
}

__device__ __forceinline__ void ph_route_a(const Params& p, int l, const float* LOG, int tile, LAS unsigned char* lds, int tid) {
    LAS float* SC = (LAS float*)lds;
    LAS float* RBs = (LAS float*)(lds + 68 * 1024);
    LAS unsigned* MASK = (LAS unsigned*)(lds + 69 * 1024);
    const int b = tile, tok0 = 256 * b;
    if (LOG)
#pragma unroll 1
    for (int i = tid; i < 256 * 64; i += NTHR) { const int t = i >> 6, e = i & 63; SC[t * 65 + e] = sigmoidf_(LOG[(size_t)(tok0 + t) * 64 + e]); }
    if (tid < 64) RBs[tid] = p.in[I_RB][l * 64 + tid];
    MASK[tid] = 0u;
    __syncthreads();
    int eidx[8]; float wts[8];
    if (tid < 256) { const int t = tid; const LAS float* sc = SC + t * 65;
        float gs[8];
#pragma unroll
        for (int g = 0; g < 8; ++g) { float m1 = -3.0e38f, m2 = -3.0e38f;
#pragma unroll
            for (int j = 0; j < 8; ++j) { const float v = sc[8 * g + j] + RBs[8 * g + j]; if (v > m1) { m2 = m1; m1 = v; } else if (v > m2) m2 = v; }
            gs[g] = m1 + m2; }
        unsigned gmask = 0u;
#pragma unroll
        for (int r = 0; r < 4; ++r) { float best = -3.0e38f; int bi = 0; bool found = false;
#pragma unroll
            for (int g = 0; g < 8; ++g) { const bool free_ = ((gmask >> g) & 1u) == 0u; if (free_ && (!found || gs[g] > best)) { best = gs[g]; bi = g; found = true; } }
            gmask |= 1u << bi; }
        unsigned long long taken = 0ull; float ssum = 0.f;
#pragma unroll
        for (int k = 0; k < 8; ++k) { float best = -3.0e38f; int be = -1;
#pragma unroll 1
            for (int e = 0; e < 64; ++e) { const bool ok = ((gmask >> (e >> 3)) & 1u) && !((taken >> e) & 1ull); const float v = sc[e] + RBs[e]; if (ok && (be < 0 || v > best)) { best = v; be = e; } }
            taken |= 1ull << be; eidx[k] = be; wts[k] = sc[be]; ssum += wts[k]; }
        const float inv = 2.5f / ssum;
#pragma unroll
        for (int k = 0; k < 8; ++k) { wts[k] *= inv; __hip_atomic_fetch_or(&MASK[eidx[k] * 8 + (t >> 5)], 1u << (t & 31), __ATOMIC_RELAXED, __HIP_MEMORY_SCOPE_WORKGROUP); }
    }
    __syncthreads();
    if (tid < 256) { const int t = tid; int* EIDX = (int*)(p.ws + WS_EIDX); float* WTS = (float*)(p.ws + WS_WTS);
#pragma unroll
        for (int k = 0; k < 8; ++k) { const int e = eidx[k]; int r = 0;
#pragma unroll 1
            for (int w = 0; w < (t >> 5); ++w) r += __popc(MASK[e * 8 + w]);
            r += __popc(MASK[e * 8 + (t >> 5)] & ((1u << (t & 31)) - 1u));
            EIDX[(size_t)(tok0 + t) * 8 + k] = e | (r << 8); WTS[(size_t)(tok0 + t) * 8 + k] = wts[k]; } }
    if (tid < 64) { int c = 0;
#pragma unroll
        for (int w = 0; w < 8; ++w) c += __popc(MASK[tid * 8 + w]);
        ((int*)(p.ws + WS_BC))[b * 64 + tid] = c; }
    __syncthreads();
}
__device__ __forceinline__ void ph_route_b(const Params& p, LAS unsigned char* lds, int tid) {
    LAS int* BCS = (LAS int*)lds;
    LAS int* CNT = BCS + 4096; LAS int* PRE = CNT + 64; LAS int* SEG = PRE + 64;
    const int b = blockIdx.x, ch = b >> 6, bl = b & 63;
    const int* BC = (const int*)(p.ws + WS_BC) + (size_t)ch * 64 * 64;
#pragma unroll 1
    for (int i = tid; i < 4096; i += NTHR) BCS[i] = BC[i];
    __syncthreads();
    if (tid < 64) { int c = 0, pr = 0;
#pragma unroll 1
        for (int i = 0; i < 64; ++i) { const int v = BCS[i * 64 + tid]; c += v; if (i < bl) pr += v; } CNT[tid] = c; PRE[tid] = pr; }
    __syncthreads();
    if (tid == 0) { int base = 0;
#pragma unroll 1
        for (int e = 0; e < 64; ++e) { SEG[e] = base; base += ((CNT[e] + 255) >> 8) << 8; } SEG[64] = base; }
    __syncthreads();
    int* SORT = (int*)(p.ws + WS_SORT) + (size_t)ch * CHROWS; int* PSLOT = (int*)(p.ws + WS_PSLOT); const int* EIDX = (const int*)(p.ws + WS_EIDX);
    if (tid < 256) { const int tok = 256 * b + tid;
#pragma unroll
        for (int k = 0; k < 8; ++k) { const int w = EIDX[(size_t)tok * 8 + k], e = w & 255, r = w >> 8; const int slot = SEG[e] + PRE[e] + r; SORT[slot] = tok; PSLOT[(size_t)tok * 16 + k] = slot; }
        const int s8 = SEG[64] + (tok - ch * CHT); SORT[s8] = tok; PSLOT[(size_t)tok * 16 + 8] = s8; }
    { const int e = bl, lo = SEG[e] + CNT[e], hi = SEG[e] + (((CNT[e] + 255) >> 8) << 8); for (int s = lo + tid; s < hi; s += NTHR) SORT[s] = ch * CHT; }
    __syncthreads();
}

typedef float f32x16 __attribute__((ext_vector_type(16)));
__device__ __forceinline__ void ph_sconv(const Params& p, const bf16* UT, bf16* UC, int tid) {
    const float* cw = p.in[I_CONVHYW]; const float* cbias = p.in[I_CONVHYB];
    const unsigned NIT = 3072u * 32u * 256u; const unsigned gt = blockIdx.x * NTHR + tid, NG = gridDim.x * NTHR;
#pragma unroll 1
    for (unsigned it = gt; it < NIT; it += NG) {
        const unsigned c = it >> 13, k = it & 255u; const size_t base = (size_t)it * 8;
        const v4u w = *(const v4u*)(UT + base);
        const float w0 = cw[c], w1 = cw[3072 + c], w2 = cw[6144 + c], bb = cbias[c];
        float x[10];
        x[0] = k > 0 ? bf1(UT[base - 1]) : 0.f; x[9] = k < 255 ? bf1(UT[base + 8]) : 0.f;
        x[1] = bf_lo(w.x); x[2] = bf_hi(w.x); x[3] = bf_lo(w.y); x[4] = bf_hi(w.y); x[5] = bf_lo(w.z); x[6] = bf_hi(w.z); x[7] = bf_lo(w.w); x[8] = bf_hi(w.w);
        float o[8];
#pragma unroll
        for (int j = 0; j < 8; ++j) o[j] = bb + w0 * x[j] + w1 * x[j + 1] + w2 * x[j + 2];
        v4u r; r.x = pk2(o[0], o[1]); r.y = pk2(o[2], o[3]); r.z = pk2(o[4], o[5]); r.w = pk2(o[6], o[7]);
        *(v4u*)(UC + base) = r;
    }
}
constexpr int LC_CPB = 8224, LC_RAW = 8 * LC_CPB, LC_RAWSZ = 32 * 512, LC_HALO = LC_RAW + 2 * LC_RAWSZ, LC_VBP = 528, LC_VB0 = LC_HALO + 2 * 8192, LC_VBSZ = 32 * LC_VBP;
static_assert(LC_VB0 + 2 * LC_VBSZ <= LDS_MISC && 8 * 32 * 528 <= LDS_MISC, "lconv LDS map");
struct Taps { float w0, w1, w2, b; };
__device__ __forceinline__ float bfh(unsigned w, int hi) { return hi ? bf_hi(w) : bf_lo(w); }
template <bool CONVIN>
__device__ __forceinline__ void lconv_unit(const bf16* vin, const Taps ti, const bf16* F, const bf16* graw, const Taps tg, float fb, bf16* out, LAS unsigned char* lds, int tid, int lane, int wave) {
    __syncthreads();
#define LC_DMA(ch, rb) do { _Pragma("unroll") for (int q = 0; q < 2; ++q) { const int row = wave * 4 + 2 * q + (ln >> 5); \
        __builtin_amdgcn_global_load_lds((const unsigned*)(vin + (size_t)row * 2048 + (ch) * 256 + (ln & 31) * 8), (LAS unsigned*)(lds + LC_RAW + (rb) * LC_RAWSZ + (wave * 4 + 2 * q) * 512), 16, 0, 0); } \
        { const int hrow = wave * 4 + ((ln & 7) >> 1); int hs = (ln & 1) ? (ch) * 256 + 256 : (ch) * 256 - 8; hs = hs < 0 ? 0 : (hs > 2040 ? 2040 : hs); \
          __builtin_amdgcn_global_load_lds((const unsigned*)(vin + (size_t)hrow * 2048 + hs), (LAS unsigned*)(lds + LC_HALO + (rb) * 8192 + wave * 1024), 16, 0, 0); } } while (0)
    LAS bf16* Fl = (LAS bf16*)(lds + LC_VB0 + LC_VBSZ);
    { int ln = lane; asm volatile("" : "+v"(ln)); LC_DMA(0, 0); LC_DMA(1, 1); }
    if (tid < 256) *(LAS v4u*)(Fl + tid * 8) = *(const v4u*)(F + tid * 8);
    __syncthreads();
    if (tid == 0) Fl[1024] = (bf16)f2bf(bf1(Fl[1024]) + fb);
    __syncthreads();
#pragma unroll 1
    for (int a = 0; a < 8; ++a)
#pragma unroll 1
        for (int mi = tid; mi < 2056; mi += NTHR) { const int m = mi * 2; const int x0 = 3079 - m - a, x1 = x0 - 1;
            const unsigned lo = (x0 >= 0 && x0 <= 2047) ? (unsigned)Fl[x0] : 0u, hi = (x1 >= 0 && x1 <= 2047) ? (unsigned)Fl[x1] : 0u;
            *(LAS unsigned*)(lds + a * LC_CPB + m * 2) = lo | (hi << 16); }
    const int r = lane & 31, h = lane >> 5, a = (7 - r) & 7;
    const LAS unsigned char* cpA = lds + a * LC_CPB + 2 * (1023 - r + 8 * h - a + 1032) - 512 * wave;
    const int laneB = r * LC_VBP + 16 * h;
#define LC_CONVERT(ch, rb, buf) do { _Pragma("unroll") for (int q = 0; q < 2; ++q) { const int pid = ln + 64 * q, row = wave * 4 + (pid >> 5), pp = pid & 31; const LAS unsigned char* rp = lds + LC_RAW + (rb) * LC_RAWSZ + row * 512 + pp * 16; \
        const v4u w = *(const LAS v4u*)rp; v4u o = w; \
        if (CONVIN) { const LAS unsigned char* hp_ = lds + LC_HALO + (rb) * 8192 + wave * 1024 + (pid >> 5) * 32; float x[10]; \
            x[0] = pp > 0 ? bf1(*(const LAS bf16*)(rp - 2)) : ((ch) > 0 ? bf1(*(const LAS bf16*)(hp_ + 14)) : 0.f); x[9] = pp < 31 ? bf1(*(const LAS bf16*)(rp + 16)) : ((ch) < 7 ? bf1(*(const LAS bf16*)(hp_ + 16)) : 0.f); \
            x[1] = bf_lo(w.x); x[2] = bf_hi(w.x); x[3] = bf_lo(w.y); x[4] = bf_hi(w.y); x[5] = bf_lo(w.z); x[6] = bf_hi(w.z); x[7] = bf_lo(w.w); x[8] = bf_hi(w.w); \
            float y[8]; _Pragma("unroll") for (int j = 0; j < 8; ++j) y[j] = ti.b + ti.w0 * x[j] + ti.w1 * x[j + 1] + ti.w2 * x[j + 2]; \
            o.x = pk2(y[0], y[1]); o.y = pk2(y[2], y[3]); o.z = pk2(y[4], y[5]); o.w = pk2(y[6], y[7]); } \
        *(LAS v4u*)(lds + LC_VB0 + (buf) * LC_VBSZ + row * LC_VBP + pp * 16) = o; } } while (0)
    { int ln = lane; asm volatile("" : "+v"(ln));
    asm volatile("s_waitcnt vmcnt(3)" ::: "memory");
    LC_CONVERT(0, 0, 0); }
    asm volatile("s_waitcnt lgkmcnt(0)" ::: "memory"); __builtin_amdgcn_s_barrier(); asm volatile("" ::: "memory");
    f32x16 acc[8];
#pragma unroll
    for (int i = 0; i < 8; ++i)
#pragma unroll
        for (int q = 0; q < 16; ++q) acc[i][q] = 0.f;
    bf16x8 E[8], O[8];
    bool primed = false;
#pragma unroll 1
    for (int ch = 0; ch < 8; ++ch) {
        int ln = lane; asm volatile("" : "+v"(ln));
        if (ch < 6) LC_DMA(ch + 2, ch & 1);
        const int du = wave - ch;
        if (du >= -4 && du <= 4) {
            const LAS unsigned char* ca = cpA + 64 * (ch * 8); const LAS unsigned char* vbh = lds + LC_VB0 + (ch & 1) * LC_VBSZ + laneB;
            if (!primed) { primed = true;
#pragma unroll
                for (int i = 1; i < 8; ++i) { E[(8 - i) & 7] = *(const LAS bf16x8*)(ca + 32 * (-2 * i)); O[(8 - i) & 7] = *(const LAS bf16x8*)(ca + 32 * (-2 * i + 1)); }
                E[0] = *(const LAS bf16x8*)ca; O[0] = *(const LAS bf16x8*)(ca + 32); }
            bf16x8 bc0 = *(const LAS bf16x8*)vbh, bc1 = *(const LAS bf16x8*)(vbh + 32);
#pragma unroll
            for (int mm = 0; mm < 8; ++mm) {
                bf16x8 bn0 = bc0, bn1 = bc1;
                if (mm < 7) { bn0 = *(const LAS bf16x8*)(vbh + 64 * (mm + 1)); bn1 = *(const LAS bf16x8*)(vbh + 64 * (mm + 1) + 32); }
                acc[7] = __builtin_amdgcn_mfma_f32_32x32x16_bf16(E[(mm + 1) & 7], bc0, acc[7], 0, 0, 0);
                E[(mm + 1) & 7] = *(const LAS bf16x8*)(ca + 64 * (mm + 1));
#pragma unroll
                for (int i = 0; i < 7; ++i) acc[i] = __builtin_amdgcn_mfma_f32_32x32x16_bf16(E[(mm - i) & 7], bc0, acc[i], 0, 0, 0);
                acc[7] = __builtin_amdgcn_mfma_f32_32x32x16_bf16(O[(mm + 1) & 7], bc1, acc[7], 0, 0, 0);
                O[(mm + 1) & 7] = *(const LAS bf16x8*)(ca + 64 * (mm + 1) + 32);
#pragma unroll
                for (int i = 0; i < 7; ++i) acc[i] = __builtin_amdgcn_mfma_f32_32x32x16_bf16(O[(mm - i) & 7], bc1, acc[i], 0, 0, 0);
                bc0 = bn0; bc1 = bn1;
            }
        }
        if (ch < 7) { if (ch < 6) asm volatile("s_waitcnt vmcnt(3)" ::: "memory"); else asm volatile("s_waitcnt vmcnt(0)" ::: "memory"); LC_CONVERT(ch + 1, (ch + 1) & 1, (ch + 1) & 1); }
        asm volatile("s_waitcnt lgkmcnt(0)" ::: "memory"); __builtin_amdgcn_s_barrier(); asm volatile("" ::: "memory");
    }
#undef LC_DMA
#undef LC_CONVERT
    { int le = lane; asm volatile("" : "+v"(le)); const int re = le & 31, he = le >> 5;
      LAS unsigned char* tw = lds + wave * (32 * 528);
#pragma unroll
      for (int i = 0; i < 8; ++i)
#pragma unroll
          for (int g = 0; g < 4; ++g) { v2u w; w.x = pk2(acc[i][4 * g + 0], acc[i][4 * g + 1]); w.y = pk2(acc[i][4 * g + 2], acc[i][4 * g + 3]); *(LAS v2u*)(tw + re * 528 + (32 * i + 8 * g + 4 * he) * 2) = w; }
      LDS_WAIT(); asm volatile("" ::: "memory");
      const int pp = le & 31;
      v4u gwa[16];
#pragma unroll
      for (int it = 0; it < 16; ++it) gwa[it] = *(const v4u*)(graw + (size_t)(2 * it + (le >> 5)) * 2048 + 256 * wave + pp * 8);
#pragma unroll
      for (int it = 0; it < 16; ++it) { const int row = 2 * it + (le >> 5); const size_t off = (size_t)row * 2048 + 256 * wave + pp * 8;
          const v4u gw = gwa[it]; const v4u aw = *(const LAS v4u*)(tw + row * 528 + pp * 16);
          float hp = 0.f, hn = 0.f;
          if (pp == 0 && wave > 0) hp = bf1(graw[off - 1]); if (pp == 31 && wave < 7) hn = bf1(graw[off + 8]);
          float gx[10]; gx[1] = bf_lo(gw.x); gx[2] = bf_hi(gw.x); gx[3] = bf_lo(gw.y); gx[4] = bf_hi(gw.y); gx[5] = bf_lo(gw.z); gx[6] = bf_hi(gw.z); gx[7] = bf_lo(gw.w); gx[8] = bf_hi(gw.w);
          const float fromprev = shidx(gx[8], le - 1), fromnext = shidx(gx[1], le + 1);
          gx[0] = pp > 0 ? fromprev : hp; gx[9] = pp < 31 ? fromnext : hn;
          const float av[8] = {bf_lo(aw.x), bf_hi(aw.x), bf_lo(aw.y), bf_hi(aw.y), bf_lo(aw.z), bf_hi(aw.z), bf_lo(aw.w), bf_hi(aw.w)};
          float o[8];
#pragma unroll
          for (int j = 0; j < 8; ++j) o[j] = (tg.b + tg.w0 * gx[j] + tg.w1 * gx[j + 1] + tg.w2 * gx[j + 2]) * av[j];
          v4u w; w.x = pk2(o[0], o[1]); w.y = pk2(o[2], o[3]); w.z = pk2(o[4], o[5]); w.w = pk2(o[6], o[7]);
          *(v4u*)(out + off) = w; }
    }
}
template <bool CONVIN>
__device__ __forceinline__ void ph_lconv(const Params& p, int o, const bf16* IN, const bf16* UT, bf16* OUT, LAS unsigned char* lds, int tid, int lane, int wave) {
    const bf16* FILT = (const bf16*)(p.ws + WS_FILT); const float* cw = p.in[I_CONVHYW]; const float* cbias = p.in[I_CONVHYB];
#pragma unroll 1
    for (int c = blockIdx.x; c < 1024; c += gridDim.x) { const int gc = (1 + o) * 1024 + c;
        const Taps ti{cw[c], cw[3072 + c], cw[6144 + c], cbias[c]}, tg{cw[gc], cw[3072 + gc], cw[6144 + gc], cbias[gc]};
        lconv_unit<CONVIN>(IN + (size_t)c * T, ti, FILT + (size_t)(o * 1024 + c) * 2048, UT + (size_t)gc * T, tg, p.in[I_FBIAS][o * 1024 + c], OUT + (size_t)c * T, lds, tid, lane, wave); }
}
__device__ __forceinline__ void ph_transpose(const bf16* Y2T, bf16* Y2, LAS unsigned char* lds, int lane, int wave) {
    LAS unsigned char* tl = lds + wave * 16384;
    const int gw = blockIdx.x * NWAVES + wave, NGW = gridDim.x * NWAVES;
#pragma unroll 1
    for (int tile = gw; tile < 16 * 1024; tile += NGW) { const int c0 = (tile & 15) * 64, t0 = (tile >> 4) * 64;
#pragma unroll
        for (int rr = 0; rr < 8; ++rr) { const int row = rr * 8 + (lane >> 3), pc = lane & 7;
            *(LAS v4u*)(tl + row * 144 + pc * 16) = *(const v4u*)(Y2T + (size_t)(c0 + row) * T + t0 + pc * 8); }
        LDS_WAIT(); asm volatile("" ::: "memory");
#pragma unroll
        for (int rr = 0; rr < 8; ++rr) { const int tk = rr * 8 + (lane >> 3), cp = (lane & 7) * 8;
            unsigned short e[8];
#pragma unroll
            for (int j = 0; j < 8; ++j) e[j] = *(const LAS unsigned short*)(tl + (cp + j) * 144 + tk * 2);
            v4u w; w.x = e[0] | ((unsigned)e[1] << 16); w.y = e[2] | ((unsigned)e[3] << 16); w.z = e[4] | ((unsigned)e[5] << 16); w.w = e[6] | ((unsigned)e[7] << 16);
            *(v4u*)(Y2 + (size_t)(t0 + tk) * D + c0 + cp) = w; }
        LDS_WAIT(); asm volatile("" ::: "memory");
    }
}

constexpr float QSCALE = 0.125f * 1.4426950408889634f;
struct InprojSched { int G, c;
    __device__ __forceinline__ bool next(int i, Unit& u) const { const int L = i * G + c; if (L >= 3840 + 288) return false;
        if (L < 3840) { u.pm = L / 15; u.pn = L % 15; } else { const int q = L - 3840; u.pm = 256 + q / 9; u.pn = 6 + q % 9; } return true; }
    __device__ __forceinline__ int arow(int r) const { return r; } };
struct EpiInproj { static constexpr bool PERM = true, AFTER_DRAIN = false; unsigned char* big; const float* rope; float* gates; const float* gate_b;
    __device__ __forceinline__ void operator()(const f32x4 (&acc)[2][2][4][2], const Unit& u, int wr, int wc, int fr, int fq) const {
        const bool ctx = u.pm >= 256; const int b = ctx ? u.pm - 256 : (u.pm >> 3), r0 = ctx ? 0 : (u.pm & 7) * 256;
        if (u.pn == 14) {
            if (wc != 0 || fq >= 2) return;
            const f32x4 gb0 = *(const f32x4*)(gate_b + 8 * fq), gb1 = *(const f32x4*)(gate_b + 8 * fq + 4);
#pragma unroll
            for (int ai = 0; ai < 2; ++ai)
#pragma unroll
                for (int m = 0; m < 4; ++m) { const int rr = r0 + wr * 64 + fr + ai * HALF + m * 16; const size_t grow = ctx ? (size_t)T + b * LC + rr : (size_t)b * SEQ + rr;
                    float* gp = gates + grow * 16 + 8 * fq; *(f32x4*)gp = acc[ai][0][m][0] + gb0; *(f32x4*)(gp + 4) = acc[ai][0][m][1] + gb1; }
            return; }
        const int t = u.pn >> 1;
        constexpr size_t offs[7] = {A0_QA, A0_BQ, A0_BO, A0_KA, A0_VA, A0_BK, A0_BV};
        const bool kv = t >= 3;
        size_t toff = A0_QA;
#pragma unroll
        for (int q = 0; q < 7; ++q) if (t == q) toff = offs[q];
        bf16* O = (bf16*)(big + toff) + (size_t)b * (kv ? (SEQ + LC) : SEQ) * 512 + (size_t)((kv && !ctx) ? LC : 0) * 512;
        const bool rope_on = (t == 0 || t == 3) && !ctx; const float qs = t == 0 ? QSCALE : 1.f;
        const int col0 = (u.pn & 1) * 256 + wc * 32 + 8 * fq;
#pragma unroll
        for (int ai = 0; ai < 2; ++ai)
#pragma unroll
            for (int m = 0; m < 4; ++m) { const int rr = r0 + wr * 64 + fr + ai * HALF + m * 16; bf16* rowp = O + (size_t)rr * 512 + col0;
                f32x4 cs0 = (f32x4){1.f, 0.f, 1.f, 0.f}, cs1 = cs0;
                if (rope_on) { const int pos = (wc & 1) ? (rr & 63) : (rr >> 6); const float* rp = rope + (size_t)(pos * 16 + 4 * fq) * 2; cs0 = *(const f32x4*)rp; cs1 = *(const f32x4*)(rp + 4); }
#pragma unroll
                for (int bj = 0; bj < 2; ++bj) { const f32x4 x0 = acc[ai][bj][m][0], x1 = acc[ai][bj][m][1];
                    f32x4 o0, o1;
                    o0[0] = x0[0] * cs0[0] - x1[0] * cs0[1]; o1[0] = x1[0] * cs0[0] + x0[0] * cs0[1];
                    o0[1] = x0[1] * cs0[2] - x1[1] * cs0[3]; o1[1] = x1[1] * cs0[2] + x0[1] * cs0[3];
                    o0[2] = x0[2] * cs1[0] - x1[2] * cs1[1]; o1[2] = x1[2] * cs1[0] + x0[2] * cs1[1];
                    o0[3] = x0[3] * cs1[2] - x1[3] * cs1[3]; o1[3] = x1[3] * cs1[2] + x0[3] * cs1[3];
                    o0 = o0 * qs; o1 = o1 * qs;
                    u32x4 w; w.x = cvt_pk_bf16(o0[0], o0[1]); w.y = cvt_pk_bf16(o0[2], o0[3]); w.z = cvt_pk_bf16(o1[0], o1[1]); w.w = cvt_pk_bf16(o1[2], o1[3]);
                    *(u32x4*)(rowp + bj * HALF) = w; } }
    } };
__device__ __forceinline__ void ph_transpose_b(const bf16* src, bf16* dst, int NBt, int R, int C, LAS unsigned char* lds, int lane, int wave) {
    LAS unsigned char* tl = lds + wave * 16384;
    const int gw = blockIdx.x * NWAVES + wave, NGW = gridDim.x * NWAVES; const int tr = R / 64, tc = C / 64, per = tr * tc;
#pragma unroll 1
    for (int tile = gw; tile < NBt * per; tile += NGW) { const int bt = tile / per, q = tile % per, c0 = (q % tc) * 64, r0 = (q / tc) * 64;
        const bf16* s = src + (size_t)bt * R * C; bf16* d = dst + (size_t)bt * R * C;
#pragma unroll
        for (int rr = 0; rr < 8; ++rr) { const int row = rr * 8 + (lane >> 3), pc = lane & 7;
            *(LAS v4u*)(tl + row * 144 + pc * 16) = *(const v4u*)(s + (size_t)(r0 + row) * C + c0 + pc * 8); }
        LDS_WAIT(); asm volatile("" ::: "memory");
#pragma unroll
        for (int rr = 0; rr < 8; ++rr) { const int cc = rr * 8 + (lane >> 3), rp = (lane & 7) * 8;
            unsigned short e[8];
#pragma unroll
            for (int j = 0; j < 8; ++j) e[j] = *(const LAS unsigned short*)(tl + (rp + j) * 144 + cc * 2);
            v4u w; w.x = e[0] | ((unsigned)e[1] << 16); w.y = e[2] | ((unsigned)e[3] << 16); w.z = e[4] | ((unsigned)e[5] << 16); w.w = e[6] | ((unsigned)e[7] << 16);
            *(v4u*)(d + (size_t)(c0 + cc) * R + r0 + rp) = w; }
        LDS_WAIT(); asm volatile("" ::: "memory");
    }
}

constexpr int AT_KP = 272, AT_VP = 144, AT_KB = 64 * AT_KP, AT_VB = 128 * AT_VP, AT_STAGE = AT_KB + AT_VB;
__device__ __forceinline__ void ph_attn(const Params& p, unsigned char* big, LAS unsigned char* lds, int tid, int lane, int wave) {
    const bf16* QA = (const bf16*)(big + A0_QA); const bf16* KA = (const bf16*)(big + A0_KA); const bf16* VT = (const bf16*)(big + A0_VT); bf16* MIXIN = (bf16*)(big + A0_MIXIN);
    const int comp = wave >> 2, qw = wave & 3, r = lane & 31, hh = lane >> 5;
    float lam; { const float* lv = p.in[I_DLAM]; const float a = wave_sum(lv[lane] * lv[64 + lane]), b2 = wave_sum(lv[128 + lane] * lv[192 + lane]); lam = expf(a) - expf(b2) + 0.2f; }
#pragma unroll 1
    for (int unit = blockIdx.x; unit < 2048; unit += gridDim.x) {
        const int b = unit >> 6, h = (unit >> 4) & 3, qblk = unit & 15, q0 = qblk * 128 + qw * 32;
        const bf16* Kg = KA + (size_t)b * (SEQ + LC) * 512 + h * 128; const bf16* Vg = VT + ((size_t)b * 512 + h * 128) * (SEQ + LC);
        bf16x8 qf[4];
#pragma unroll
        for (int ds = 0; ds < 4; ++ds) qf[ds] = *(const bf16x8*)(QA + ((size_t)b * SEQ + q0 + r) * 512 + h * 128 + comp * 64 + ds * 16 + hh * 8);
        f32x16 oacc[4];
#pragma unroll
        for (int i = 0; i < 4; ++i)
#pragma unroll
            for (int q = 0; q < 16; ++q) oacc[i][q] = 0.f;
        float m_run = -1.0e30f, l_run = 0.f;
        v4u pre[4];
#define AT_LOADG(kt) do { _Pragma("unroll") for (int q = 0; q < 2; ++q) { const int idx = tid + NTHR * q; \
            pre[q] = *(const v4u*)(Kg + (size_t)((kt) * 64 + (idx >> 4)) * 512 + (idx & 15) * 8); \
            pre[2 + q] = *(const v4u*)(Vg + (size_t)(idx >> 3) * (SEQ + LC) + (kt) * 64 + (idx & 7) * 8); } } while (0)
#define AT_STORES(buf) do { _Pragma("unroll") for (int q = 0; q < 2; ++q) { const int idx = tid + NTHR * q; \
            *(LAS v4u*)(lds + (buf) * AT_STAGE + (idx >> 4) * AT_KP + (idx & 15) * 16) = pre[q]; \
            *(LAS v4u*)(lds + (buf) * AT_STAGE + AT_KB + (idx >> 3) * AT_VP + (idx & 7) * 16) = pre[2 + q]; } } while (0)
        __syncthreads();
        AT_LOADG(0); AT_STORES(0);
        __syncthreads();
#pragma unroll 1
        for (int kt = 0; kt < 36; ++kt) {
            if (kt < 35) AT_LOADG(kt + 1);
            const LAS unsigned char* Kt = lds + (kt & 1) * AT_STAGE; const LAS unsigned char* Vt = Kt + AT_KB;
            f32x16 sacc[2];
#pragma unroll
            for (int kb = 0; kb < 2; ++kb)
#pragma unroll
                for (int q = 0; q < 16; ++q) sacc[kb][q] = 0.f;
#pragma unroll
            for (int ds = 0; ds < 4; ++ds)
#pragma unroll
                for (int kb = 0; kb < 2; ++kb) { const bf16x8 kf = *(const LAS bf16x8*)(Kt + (32 * kb + r) * AT_KP + comp * 128 + ds * 32 + hh * 16);
                    sacc[kb] = __builtin_amdgcn_mfma_f32_32x32x16_bf16(kf, qf[ds], sacc[kb], 0, 0, 0); }
            float mx = sacc[0][0];
#pragma unroll
            for (int kb = 0; kb < 2; ++kb)
#pragma unroll
                for (int q = 0; q < 16; ++q) mx = fmaxf(mx, sacc[kb][q]);
            mx = fmaxf(mx, shx(mx, 32));
            const float m_new = fmaxf(m_run, mx), alpha = exp2f(m_run - m_new); m_run = m_new;
            float ps = 0.f;
#pragma unroll
            for (int kb = 0; kb < 2; ++kb)
#pragma unroll
                for (int q = 0; q < 16; ++q) { const float e = exp2f(sacc[kb][q] - m_new); sacc[kb][q] = e; ps += e; }
            l_run = l_run * alpha + ps;
#pragma unroll
            for (int i = 0; i < 4; ++i) oacc[i] = oacc[i] * alpha;
#pragma unroll
            for (int kb = 0; kb < 2; ++kb)
#pragma unroll
                for (int s = 0; s < 2; ++s) {
                    u32x4 pw; pw.x = cvt_pk_bf16(sacc[kb][8 * s + 0], sacc[kb][8 * s + 1]); pw.y = cvt_pk_bf16(sacc[kb][8 * s + 2], sacc[kb][8 * s + 3]);
                    pw.z = cvt_pk_bf16(sacc[kb][8 * s + 4], sacc[kb][8 * s + 5]); pw.w = cvt_pk_bf16(sacc[kb][8 * s + 6], sacc[kb][8 * s + 7]);
                    const bf16x8 pf = __builtin_bit_cast(bf16x8, pw);
#pragma unroll
                    for (int dvb = 0; dvb < 4; ++dvb) { const LAS unsigned char* vp = Vt + (32 * dvb + r) * AT_VP + (32 * kb + 16 * s + 4 * hh) * 2;
                        const u32x2 lo = *(const LAS u32x2*)vp, hi = *(const LAS u32x2*)(vp + 16);
                        u32x4 vw; vw.x = lo.x; vw.y = lo.y; vw.z = hi.x; vw.w = hi.y;
                        oacc[dvb] = __builtin_amdgcn_mfma_f32_32x32x16_bf16(__builtin_bit_cast(bf16x8, vw), pf, oacc[dvb], 0, 0, 0); } }
            if (kt < 35) AT_STORES((kt + 1) & 1);
            __syncthreads();
        }
#undef AT_LOADG
#undef AT_STORES
        const float lsum = l_run + shx(l_run, 32), inv = 1.f / lsum;
        LAS float* X = (LAS float*)lds;
        if (comp == 1) {
#pragma unroll
            for (int dvb = 0; dvb < 4; ++dvb)
#pragma unroll
                for (int q = 0; q < 16; ++q) X[(qw * 64 + dvb * 16 + q) * 64 + lane] = oacc[dvb][q] * inv; }
        __syncthreads();
        if (comp == 0) {
            float ss = 0.f;
#pragma unroll
            for (int dvb = 0; dvb < 4; ++dvb)
#pragma unroll
                for (int q = 0; q < 16; ++q) { const float o = oacc[dvb][q] * inv - lam * X[(qw * 64 + dvb * 16 + q) * 64 + lane]; oacc[dvb][q] = o; ss += o * o; }
            ss += shx(ss, 32);
            const float rn = rsqrtf(ss * (1.f / 128.f) + RMS_EPS) * 0.8f;
            const float* ga = p.in[I_HGA] + h * 128; bf16* orow = MIXIN + ((size_t)b * SEQ + q0 + r) * D + h * 128;
#pragma unroll
            for (int dvb = 0; dvb < 4; ++dvb)
#pragma unroll
                for (int g = 0; g < 4; ++g) { const int dv = 32 * dvb + 8 * g + 4 * hh; const f32x4 gg = *(const f32x4*)(ga + dv);
                    v2u w; w.x = pk2(oacc[dvb][4 * g + 0] * rn * gg[0], oacc[dvb][4 * g + 1] * rn * gg[1]); w.y = pk2(oacc[dvb][4 * g + 2] * rn * gg[2], oacc[dvb][4 * g + 3] * rn * gg[3]);
                    *(v2u*)(orow + dv) = w; }
        }
    }
    __syncthreads();
}

constexpr int ML_P = 272, ML_TILE = 64 * ML_P;
constexpr int ML_VOFF = 3 * ML_TILE, ML_VSZ = 64 * 256;
constexpr int ML_RQ = ML_VOFF + 2 * ML_VSZ, ML_RSZ = 68 * 256, ML_RK = ML_RQ + ML_RSZ;
constexpr int ML_NOFF = ML_RK + ML_RSZ, ML_AOFF = ML_NOFF + 2 * 512;
constexpr int ML_CW = ML_AOFF + 8 * 256;
static_assert(ML_CW + 8 * 512 <= LDS_TAB, "mLSTM LDS map");
typedef short s16x4 __attribute__((ext_vector_type(4)));
__device__ __forceinline__ u32x2 tr16(const LAS unsigned char* p) { return __builtin_bit_cast(u32x2, __builtin_amdgcn_ds_read_tr16_b64_v4i16((LAS s16x4*)p)); }
__device__ __forceinline__ float logsigmoidf_(float x) { return x >= 0.f ? -__logf(1.f + __expf(-x)) : x - __logf(1.f + __expf(x)); }
__device__ __forceinline__ bf16x8 pack8(const f32x16& v, int s) { u32x4 w; w.x = cvt_pk_bf16(v[8 * s + 0], v[8 * s + 1]); w.y = cvt_pk_bf16(v[8 * s + 2], v[8 * s + 3]); w.z = cvt_pk_bf16(v[8 * s + 4], v[8 * s + 5]); w.w = cvt_pk_bf16(v[8 * s + 6], v[8 * s + 7]); return __builtin_bit_cast(bf16x8, w); }
__device__ __forceinline__ void ph_mlstm(const Params& p, unsigned char* big, LAS unsigned char* lds, int tid, int lane, int wave) {
    const int bid = blockIdx.x; if (bid >= 256) return;
    const int b = bid >> 3, h = (bid >> 1) & 3, dir = bid & 1;
    const bf16* BQ = (const bf16*)(big + A0_BQ) + (size_t)b * SEQ * 512 + h * 128;
    const bf16* BK = (const bf16*)(big + A0_BK) + (size_t)b * (SEQ + LC) * 512 + h * 128;
    const bf16* BV = (const bf16*)(big + A0_BV) + (size_t)b * (SEQ + LC) * 512 + h * 128;
    bf16* HB = (bf16*)(big + A0_HB) + (size_t)dir * T * 512 + (size_t)b * SEQ * 512 + h * 128;
    const float* GT = (const float*)(p.ws + WS_GATES);
    const float* cw = p.in[I_CONVABW]; const float* cb = p.in[I_CONVABB];
    const int eb = wave & 3, tb = wave >> 2, r = lane & 31, hh = lane >> 5;
    const int blk = (lane >> 4) & 1, tq = (lane & 15) >> 2, tp = lane & 3;
    LAS float* nbuf = (LAS float*)(lds + ML_NOFF); LAS float* aw = (LAS float*)(lds + ML_AOFF) + wave * 64;
    if (tid < 256) nbuf[tid] = 0.f;
    LAS float* cwl = (LAS float*)(lds + ML_CW);
    for (int i = tid; i < 1024; i += NTHR) { const int ten = i >> 9, j = (i >> 7) & 3, d = i & 127, ch = ten * 512 + h * 128 + d; cwl[i] = j < 3 ? cw[j * 1024 + ch] : cb[ch]; }
    f32x16 cacc[4];
#pragma unroll
    for (int i = 0; i < 4; ++i)
#pragma unroll
        for (int q = 0; q < 16; ++q) cacc[i][q] = 0.f;
    float m_state = 0.f;
    float a_c = 0.f, M_c = 0.f, b_c = 0.f, decay_c = 1.f, m_after = 0.f;
    float a_n = 0.f, M_n = 0.f, b_n = 0.f, w_n = 0.f, decay_n = 1.f, m_next = 0.f;
#define ML_POS(cc, t) ((cc) < 4 ? (dir ? 255 - ((cc) * 64 + (t)) : (cc) * 64 + (t)) : (dir ? 2047 - (((cc) - 4) * 64 + (t)) : ((cc) - 4) * 64 + (t)))
#define ML_GLOAD(cc, li_, fp_) do { const int pos_ = ML_POS(cc, lane); const size_t grow_ = (cc) < 4 ? (size_t)T + b * LC + pos_ : (size_t)b * SEQ + pos_; \
        li_ = GT[grow_ * 16 + dir * 8 + h]; fp_ = GT[grow_ * 16 + dir * 8 + 4 + h]; } while (0)
#define ML_SCAN(li_, fp_, m_in) do { const float lf_ = logsigmoidf_(fp_); \
        float bs_ = lf_; _Pragma("unroll") for (int o_ = 1; o_ < 64; o_ <<= 1) { const float v_ = shup(bs_, o_); if (lane >= o_) bs_ += v_; } \
        const float aa_ = (li_) - bs_; float pm_ = aa_; _Pragma("unroll") for (int o_ = 1; o_ < 64; o_ <<= 1) { const float v_ = shup(pm_, o_); if (lane >= o_) pm_ = fmaxf(pm_, v_); } \
        const float MM_ = fmaxf(m_in, pm_); const float M63_ = shidx(MM_, 63), b63_ = shidx(bs_, 63); \
        a_n = aa_; M_n = MM_; b_n = bs_; w_n = __expf(aa_ - M63_); decay_n = __expf((m_in) - M63_); m_next = b63_ + M63_; } while (0)
#define ML_DMA(cc, vbuf) do { const int lim_ = (cc) < 4 ? LC : SEQ, kvb_ = (cc) < 4 ? 0 : LC; \
        _Pragma("unroll 1") for (int ins_ = wave; ins_ < 17; ins_ += NWAVES) { const int rr_ = ins_ * 4 + (lane >> 4), pc_ = lane & 15; int pos_ = ML_POS(cc, rr_ - 1); pos_ = pos_ < 0 ? 0 : (pos_ >= lim_ ? lim_ - 1 : pos_); \
            __builtin_amdgcn_global_load_lds((const unsigned*)(BK + (size_t)(kvb_ + pos_) * 512 + pc_ * 8), (LAS unsigned*)(lds + ML_RK + ins_ * 1024), 16, 0, 0); \
            if ((cc) >= 4) __builtin_amdgcn_global_load_lds((const unsigned*)(BQ + (size_t)pos_ * 512 + pc_ * 8), (LAS unsigned*)(lds + ML_RQ + ins_ * 1024), 16, 0, 0); } \
        _Pragma("unroll") for (int q_ = 0; q_ < 2; ++q_) { const int ins_ = wave * 2 + q_, t_ = ins_ * 4 + (lane >> 4), pc_ = lane & 15; const int pos_ = ML_POS(cc, t_); \
            __builtin_amdgcn_global_load_lds((const unsigned*)(BV + (size_t)(kvb_ + pos_) * 512 + pc_ * 8), (LAS unsigned*)(lds + ML_VOFF + (vbuf) * ML_VSZ + ins_ * 1024), 16, 0, 0); } } while (0)
#define ML_CONV8(dst, rawoff, cc, t_, d8_, ten, scl) do { const int pos_ = ML_POS(cc, t_), lim_ = (cc) < 4 ? LC : SEQ; const int rm_ = dir ? (t_) + 2 : (t_), rp_ = dir ? (t_) : (t_) + 2; \
        v4u x_[3]; x_[0] = *(const LAS v4u*)(lds + (rawoff) + rm_ * 256 + (d8_) * 16); x_[1] = *(const LAS v4u*)(lds + (rawoff) + ((t_) + 1) * 256 + (d8_) * 16); x_[2] = *(const LAS v4u*)(lds + (rawoff) + rp_ * 256 + (d8_) * 16); \
        if (pos_ - 1 < 0) x_[0] = (v4u){0u, 0u, 0u, 0u}; if (pos_ + 1 >= lim_) x_[2] = (v4u){0u, 0u, 0u, 0u}; \
        const LAS float* wl_ = cwl + (ten) * 512 + (d8_) * 8; \
        _Pragma("unroll") for (int e_ = 0; e_ < 8; ++e_) { float s_ = wl_[3 * 128 + e_]; \
            _Pragma("unroll") for (int j_ = 0; j_ < 3; ++j_) { const unsigned w_ = e_ < 2 ? x_[j_].x : e_ < 4 ? x_[j_].y : e_ < 6 ? x_[j_].z : x_[j_].w; s_ += wl_[j_ * 128 + e_] * ((e_ & 1) ? bf_hi(w_) : bf_lo(w_)); } \
            dst[e_] = __fdividef(s_, 1.f + __expf(-s_)) * (scl); } } while (0)
#define ML_BUILD(cc) do { _Pragma("unroll 1") for (int q_ = 0; q_ < 2; ++q_) { const int idx_ = tid + NTHR * q_, t_ = idx_ >> 4, d8_ = idx_ & 15; \
        float kk_[8]; ML_CONV8(kk_, ML_RK, cc, t_, d8_, 1, 1.f); const float wt_ = shidx(w_n, t_); \
        v4u o_; o_.x = pk2(kk_[0], kk_[1]); o_.y = pk2(kk_[2], kk_[3]); o_.z = pk2(kk_[4], kk_[5]); o_.w = pk2(kk_[6], kk_[7]); *(LAS v4u*)(lds + ML_TILE + t_ * ML_P + d8_ * 16) = o_; \
        o_.x = pk2(kk_[0] * wt_, kk_[1] * wt_); o_.y = pk2(kk_[2] * wt_, kk_[3] * wt_); o_.z = pk2(kk_[4] * wt_, kk_[5] * wt_); o_.w = pk2(kk_[6] * wt_, kk_[7] * wt_); *(LAS v4u*)(lds + 2 * ML_TILE + t_ * ML_P + d8_ * 16) = o_; \
        if ((cc) >= 4) { float qq_[8]; ML_CONV8(qq_, ML_RQ, cc, t_, d8_, 0, 0.08838834764831845f); \
            o_.x = pk2(qq_[0], qq_[1]); o_.y = pk2(qq_[2], qq_[3]); o_.z = pk2(qq_[4], qq_[5]); o_.w = pk2(qq_[6], qq_[7]); *(LAS v4u*)(lds + t_ * ML_P + d8_ * 16) = o_; } } } while (0)
    __syncthreads();
    { float li0, fp0; ML_GLOAD(0, li0, fp0); ML_DMA(0, 0); ML_SCAN(li0, fp0, m_state); }
    asm volatile("s_waitcnt vmcnt(0)" ::: "memory");
    __syncthreads();
    ML_BUILD(0);
    a_c = a_n; M_c = M_n; b_c = b_n; decay_c = decay_n; m_after = m_next;
    __syncthreads();
#pragma unroll 1
    for (int cc = 0; cc < 36; ++cc) {
        const LAS unsigned char* Qs = lds; const LAS unsigned char* Ks = lds + ML_TILE; const LAS unsigned char* Kw = lds + 2 * ML_TILE; const LAS unsigned char* Vs = lds + ML_VOFF + (cc & 1) * ML_VSZ;
        const LAS float* ncur = nbuf + (cc & 1) * 128; LAS float* nnew = nbuf + ((cc + 1) & 1) * 128;
        float li1 = 0.f, fp1 = 0.f;
        if (cc < 35) { ML_GLOAD(cc + 1, li1, fp1); ML_DMA(cc + 1, (cc + 1) & 1); }
        if (cc >= 4) {
            aw[lane] = a_c;
            const int tcol = 32 * tb + r; const float Mt = shidx(M_c, tcol), bt = shidx(b_c, tcol);
            f32x16 nacc;
#pragma unroll
            for (int q = 0; q < 16; ++q) nacc[q] = 0.f;
#pragma unroll
            for (int db = 0; db < 4; ++db)
#pragma unroll
                for (int s2 = 0; s2 < 2; ++s2) { const LAS unsigned char* qp = Qs + tcol * ML_P + (32 * db + 16 * s2 + 4 * hh) * 2; const u32x2 lo = *(const LAS u32x2*)qp, hi = *(const LAS u32x2*)(qp + 16);
                    u32x4 qw; qw.x = lo.x; qw.y = lo.y; qw.z = hi.x; qw.w = hi.y;
                    nacc = __builtin_amdgcn_mfma_f32_32x32x16_bf16(pack8(cacc[db], s2), __builtin_bit_cast(bf16x8, qw), nacc, 0, 0, 0); }
            const float sc = __expf(m_state - Mt);
            nacc = nacc * sc;
            float rs = 0.f;
#pragma unroll
            for (int sb = 0; sb < 2; ++sb) if (sb <= tb) {
                f32x16 sacc;
#pragma unroll
                for (int q = 0; q < 16; ++q) sacc[q] = 0.f;
#pragma unroll
                for (int ds = 0; ds < 8; ++ds) { const bf16x8 kf = *(const LAS bf16x8*)(Ks + (32 * sb + r) * ML_P + (16 * ds + 8 * hh) * 2), qf = *(const LAS bf16x8*)(Qs + tcol * ML_P + (16 * ds + 8 * hh) * 2);
                    sacc = __builtin_amdgcn_mfma_f32_32x32x16_bf16(kf, qf, sacc, 0, 0, 0); }
#pragma unroll
                for (int g = 0; g < 4; ++g) { const int s0 = 32 * sb + 8 * g + 4 * hh; const f32x4 av = *(const LAS f32x4*)(aw + s0);
#pragma unroll
                    for (int j = 0; j < 4; ++j) { const bool keep = (s0 + j) <= tcol; const float v = keep ? sacc[4 * g + j] * __expf(av[j] - Mt) : 0.f; sacc[4 * g + j] = v; rs += v; } }
#pragma unroll
                for (int s2 = 0; s2 < 2; ++s2) { u32x4 vw;
                    { const u32x2 t0 = tr16(Vs + (32 * sb + 16 * s2 + 4 * hh + tq) * 256 + (32 * eb + 16 * blk + 4 * tp) * 2), t1 = tr16(Vs + (32 * sb + 16 * s2 + 8 + 4 * hh + tq) * 256 + (32 * eb + 16 * blk + 4 * tp) * 2);
                      vw.x = t0.x; vw.y = t0.y; vw.z = t1.x; vw.w = t1.y; }
                    nacc = __builtin_amdgcn_mfma_f32_32x32x16_bf16(__builtin_bit_cast(bf16x8, vw), pack8(sacc, s2), nacc, 0, 0, 0); } }
            rs += shx(rs, 32);
            float qn = 0.f;
            { const LAS unsigned char* qp = Qs + tcol * ML_P + (64 * hh) * 2;
#pragma unroll
              for (int c8 = 0; c8 < 8; ++c8) { const v4u w = *(const LAS v4u*)(qp + c8 * 16); const f32x4 n0 = *(const LAS f32x4*)(ncur + 64 * hh + 8 * c8), n1 = *(const LAS f32x4*)(ncur + 64 * hh + 8 * c8 + 4);
                  qn += bf_lo(w.x) * n0[0] + bf_hi(w.x) * n0[1] + bf_lo(w.y) * n0[2] + bf_hi(w.y) * n0[3] + bf_lo(w.z) * n1[0] + bf_hi(w.z) * n1[1] + bf_lo(w.w) * n1[2] + bf_hi(w.w) * n1[3]; } }
            qn += shx(qn, 32);
            const float den = sc * qn + rs; const float dd = __frcp_rn(fmaxf(fabsf(den), __expf(-(bt + Mt))));
            { const int pos = ML_POS(cc, tcol); bf16* hrow = HB + (size_t)pos * 512 + 32 * eb;
#pragma unroll
              for (int g = 0; g < 4; ++g) { v2u w; w.x = pk2(nacc[4 * g + 0] * dd, nacc[4 * g + 1] * dd); w.y = pk2(nacc[4 * g + 2] * dd, nacc[4 * g + 3] * dd); *(v2u*)(hrow + 8 * g + 4 * hh) = w; } }
        }
#pragma unroll
        for (int db = 0; db < 4; ++db) { cacc[db] = cacc[db] * decay_c;
#pragma unroll
            for (int s4 = 0; s4 < 4; ++s4) { u32x4 ka, vb;
                { const u32x2 t0 = tr16(Kw + (16 * s4 + 8 * hh + tq) * ML_P + (32 * db + 16 * blk + 4 * tp) * 2), t1 = tr16(Kw + (16 * s4 + 8 * hh + 4 + tq) * ML_P + (32 * db + 16 * blk + 4 * tp) * 2);
                  ka.x = t0.x; ka.y = t0.y; ka.z = t1.x; ka.w = t1.y; }
                { const u32x2 t0 = tr16(Vs + (16 * s4 + 8 * hh + tq) * 256 + (32 * eb + 16 * blk + 4 * tp) * 2), t1 = tr16(Vs + (16 * s4 + 8 * hh + 4 + tq) * 256 + (32 * eb + 16 * blk + 4 * tp) * 2);
                  vb.x = t0.x; vb.y = t0.y; vb.z = t1.x; vb.w = t1.y; }
                cacc[db] = __builtin_amdgcn_mfma_f32_32x32x16_bf16(__builtin_bit_cast(bf16x8, ka), __builtin_bit_cast(bf16x8, vb), cacc[db], 0, 0, 0); } }
        { const int d = tid >> 2, part = tid & 3; float s = 0.f;
#pragma unroll
            for (int t = 0; t < 16; ++t) s += bf1(*(const LAS bf16*)(Kw + (part * 16 + t) * ML_P + d * 2));
            s += shx(s, 1); s += shx(s, 2);
            if (part == 0) nnew[d] = decay_c * ncur[d] + s; }
        m_state = m_after;
        asm volatile("s_waitcnt vmcnt(0)" ::: "memory");
        __syncthreads();
        if (cc < 35) { ML_SCAN(li1, fp1, m_state); ML_BUILD(cc + 1); a_c = a_n; M_c = M_n; b_c = b_n; decay_c = decay_n; m_after = m_next; }
        __syncthreads();
    }
#undef ML_POS
#undef ML_GLOAD
#undef ML_SCAN
#undef ML_DMA
#undef ML_CONV8
#undef ML_BUILD
}
__device__ __forceinline__ void ph_outb(const Params& p, unsigned char* big, int lane, int wave) {
    const int gw = blockIdx.x * NWAVES + wave, NGW = gridDim.x * NWAVES;
    const bf16* HBf = (const bf16*)(big + A0_HB); const bf16* HBb = HBf + (size_t)T * 512; const bf16* BO = (const bf16*)(big + A0_BO); bf16* MIXIN = (bf16*)(big + A0_MIXIN);
    const float* gb = p.in[I_HGB];
#pragma unroll 1
    for (int m = gw; m < T; m += NGW) {
        const v4u f = *(const v4u*)(HBf + (size_t)m * 512 + lane * 8), bw = *(const v4u*)(HBb + (size_t)m * 512 + lane * 8), go = *(const v4u*)(BO + (size_t)m * 512 + lane * 8);
        float x[8], o[8]; x[0] = bf_lo(f.x) + bf_lo(bw.x); x[1] = bf_hi(f.x) + bf_hi(bw.x); x[2] = bf_lo(f.y) + bf_lo(bw.y); x[3] = bf_hi(f.y) + bf_hi(bw.y);
        x[4] = bf_lo(f.z) + bf_lo(bw.z); x[5] = bf_hi(f.z) + bf_hi(bw.z); x[6] = bf_lo(f.w) + bf_lo(bw.w); x[7] = bf_hi(f.w) + bf_hi(bw.w);
        o[0] = bf_lo(go.x); o[1] = bf_hi(go.x); o[2] = bf_lo(go.y); o[3] = bf_hi(go.y); o[4] = bf_lo(go.z); o[5] = bf_hi(go.z); o[6] = bf_lo(go.w); o[7] = bf_hi(go.w);
        float ss = 0.f;
#pragma unroll
        for (int j = 0; j < 8; ++j) ss += x[j] * x[j];
        ss += shx(ss, 1); ss += shx(ss, 2); ss += shx(ss, 4); ss += shx(ss, 8);
        const float rn = rsqrtf(ss * (1.f / 128.f) + RMS_EPS);
        const f32x4 g0 = *(const f32x4*)(gb + lane * 8), g1 = *(const f32x4*)(gb + lane * 8 + 4);
        float y[8];
#pragma unroll
        for (int j = 0; j < 8; ++j) y[j] = x[j] * rn * (j < 4 ? g0[j] : g1[j - 4]) * sigmoidf_(o[j]);
        v4u w; w.x = pk2(y[0], y[1]); w.y = pk2(y[2], y[3]); w.z = pk2(y[4], y[5]); w.w = pk2(y[6], y[7]);
        *(v4u*)(MIXIN + (size_t)m * D + 512 + lane * 8) = w;
    }
}

constexpr int CW_DBG = 16;
#ifndef DBG_MODE
#define DBG_MODE 0
#endif
#ifndef DBG_L
#define DBG_L 0
#endif
#ifndef DBG_CH
#define DBG_CH 0
#endif
__device__ __forceinline__ void dbg_report(const Params& p, float d) {
    if (!(d >= 0.f)) d = 1.0e6f;
    atomicMax((unsigned*)(p.ws + WS_CTL) + CW_DBG, __float_as_uint(d));
}
__device__ __forceinline__ float block_max(float v, LAS float* red, int tid) { v = wave_max(v); __syncthreads(); if ((tid & 63) == 0) red[tid >> 6] = v; __syncthreads(); float r = red[0];
#pragma unroll
    for (int w = 1; w < 8; ++w) r = fmaxf(r, red[w]); __syncthreads(); return r; }
__device__ __forceinline__ float block_sum(float v, LAS float* red, int tid) { v = wave_sum(v); __syncthreads(); if ((tid & 63) == 0) red[tid >> 6] = v; __syncthreads(); float r = 0.f;
#pragma unroll
    for (int w = 0; w < 8; ++w) r += red[w]; __syncthreads(); return r; }
__device__ __forceinline__ void dbg_moe_check(const Params& p, int l, int ch, const bf16* H2, const bf16* Y, LAS unsigned char* lds, int tid) {
    LAS float* hrow = (LAS float*)lds; LAS float* gu = hrow + 1024; LAS float* a = gu + 512; LAS float* red = a + 256;
    const int t = ch * CHT + blockIdx.x * 64 + 5;
    __syncthreads();
    for (int i = tid; i < 1024; i += NTHR) hrow[i] = bf1(H2[(size_t)t * D + i]);
    __syncthreads();
    const int* EIDX = (const int*)(p.ws + WS_EIDX); const float* WTS = (const float*)(p.ws + WS_WTS); const int* PSLOT = (const int*)(p.ws + WS_PSLOT);
    float yacc[2] = {0.f, 0.f};
#pragma unroll 1
    for (int k = 0; k < 9; ++k) {
        const int e = k < 8 ? (EIDX[(size_t)t * 8 + k] & 255) : 64; const float w = k < 8 ? WTS[(size_t)t * 8 + k] : 1.f;
        const float* Wgu = e < 64 ? p.in[I_EGU] + (size_t)(l * 64 + e) * 1024 * 512 : p.in[I_SGU] + (size_t)l * 1024 * 512;
        const float* Wdn = e < 64 ? p.in[I_EDN] + (size_t)(l * 64 + e) * 256 * 1024 : p.in[I_SDN] + (size_t)l * 256 * 1024;
        float s = 0.f;
#pragma unroll 4
        for (int kk = 0; kk < 1024; ++kk) s += hrow[kk] * Wgu[(size_t)kk * 512 + tid];
        gu[tid] = s;
        __syncthreads();
        if (tid < 256) a[tid] = siluf_(gu[tid]) * gu[256 + tid];
        __syncthreads();
#pragma unroll
        for (int q = 0; q < 2; ++q) { const int n = tid + 512 * q; float s2 = 0.f;
#pragma unroll 4
            for (int j = 0; j < 256; ++j) s2 += a[j] * Wdn[(size_t)j * 1024 + n];
            yacc[q] += w * s2; }
        __syncthreads();
    }
    float err = 0.f, ss = 0.f;
#pragma unroll
    for (int q = 0; q < 2; ++q) { const int n = tid + 512 * q; float f = 0.f;
#pragma unroll 1
        for (int k = 0; k < 9; ++k) { const int slot = PSLOT[(size_t)t * 16 + k]; const float w = k < 8 ? WTS[(size_t)t * 8 + k] : 1.f; f += w * bf1(Y[(size_t)slot * D + n]); }
        err = fmaxf(err, fabsf(f - yacc[q])); ss += yacc[q] * yacc[q]; }
    const float me = block_max(err, red, tid), sq = block_sum(ss, red, tid);
    if (tid == 0) dbg_report(p, me / sqrtf(sq * (1.f / 1024.f) + 1e-30f));
}
__device__ __forceinline__ void dbg_route_check(const Params& p, int l, const bf16* H2, const float* LOG, LAS unsigned char* lds, int tid) {
    LAS float* hrow = (LAS float*)lds; LAS float* lg = hrow + 1024; LAS float* bi = lg + 64; LAS float* sc = bi + 64; LAS float* red = sc + 64;
    const int t = blockIdx.x * 256 + 77;
    __syncthreads();
    for (int i = tid; i < 1024; i += NTHR) hrow[i] = bf1(H2[(size_t)t * D + i]);
    __syncthreads();
    if (tid < 64) { float s = 0.f; const float* W = p.in[I_RW] + (size_t)l * 1024 * 64;
#pragma unroll 4
        for (int k = 0; k < 1024; ++k) s += hrow[k] * W[k * 64 + tid];
        lg[tid] = s; sc[tid] = 1.f / (1.f + expf(-s)); bi[tid] = sc[tid] + p.in[I_RB][l * 64 + tid]; }
    __syncthreads();
    if (tid == 0) {
        float lerr = 0.f;
#pragma unroll 1
        for (int e = 0; e < 64; ++e) lerr = fmaxf(lerr, fabsf(lg[e] - LOG[(size_t)t * 64 + e]));
        float grp[8];
#pragma unroll
        for (int g = 0; g < 8; ++g) { float a = -1e30f, b = -1e30f;
#pragma unroll 1
            for (int j = 0; j < 8; ++j) { const float v = bi[g * 8 + j]; if (v > a) { b = a; a = v; } else if (v > b) b = v; } grp[g] = a + b; }
        unsigned gm = 0;
#pragma unroll 1
        for (int r = 0; r < 4; ++r) { int best = -1; float bv = 0.f;
#pragma unroll
            for (int g = 0; g < 8; ++g) if (!((gm >> g) & 1u) && (best < 0 || grp[g] > bv)) { best = g; bv = grp[g]; }
            gm |= 1u << best; }
        unsigned long long set_ref = 0ull; float ssum = 0.f;
#pragma unroll 1
        for (int r = 0; r < 8; ++r) { int best = -1; float bv = 0.f;
#pragma unroll 1
            for (int e = 0; e < 64; ++e) if (((gm >> (e >> 3)) & 1u) && !((set_ref >> e) & 1ull) && (best < 0 || bi[e] > bv)) { best = e; bv = bi[e]; }
            set_ref |= 1ull << best; ssum += sc[best]; }
        const int* EIDX = (const int*)(p.ws + WS_EIDX); const float* WTS = (const float*)(p.ws + WS_WTS);
        unsigned long long set_f = 0ull; float werr = 0.f, wsum = 0.f;
#pragma unroll 1
        for (int k = 0; k < 8; ++k) { const int e = EIDX[(size_t)t * 8 + k] & 255; set_f |= 1ull << e; const float wr = 2.5f * sc[e] / ssum; werr = fmaxf(werr, fabsf(wr - WTS[(size_t)t * 8 + k])); wsum += WTS[(size_t)t * 8 + k]; }
        float d = 0.f;
        if (DBG_MODE == 0) d = (set_f != set_ref) ? (1.f / 256.f) : 0.f;
        if (DBG_MODE == 1) d = (set_f != set_ref) ? 0.f : werr + fabsf(wsum - 2.5f);
        if (DBG_MODE == 2) d = lerr * (1.f / 256.f);
        atomicAdd((float*)((unsigned*)(p.ws + WS_CTL) + CW_DBG), d);
    }
    __syncthreads();
}
__device__ __forceinline__ unsigned dbg_hash(unsigned x) { x ^= x >> 16; x *= 0x7feb352du; x ^= x >> 15; x *= 0x846ca68bu; x ^= x >> 16; return x; }
__device__ __forceinline__ void dbg_report_wave(const Params& p, float d, int lane) { if (lane == 0) dbg_report(p, d); }
__device__ __forceinline__ void dbg_hyena_check(const Params& p, int mode, const bf16* HN, const bf16* UC, const bf16* ZT, const bf16* Y2T, const bf16* MIX, LAS unsigned char* lds, int lane, int wave) {
    const unsigned hsh = dbg_hash(blockIdx.x * 8u + wave + 12345u), h2 = dbg_hash(hsh), h3 = dbg_hash(h2);
    const bf16* FILT = (const bf16*)(p.ws + WS_FILT);
    float d = 0.f;
    if (mode == 0) {
        const int c = hsh % 3072u, b = h2 % 32u, s = h3 % 2048u; float acc = 0.f;
#pragma unroll 1
        for (int k = lane; k < 1024; k += 64) acc += bf1(HN[(size_t)(b * 2048 + s) * D + k]) * p.in[I_WINHY][(size_t)k * 3072 + c];
        acc = wave_sum(acc);
        const float got = bf1(UC[(size_t)c * T + b * 2048 + s]); d = fabsf(got - acc) / (fabsf(acc) + 0.1f);
    } else if (mode == 5) {
        const int c = hsh % 3072u, b = h2 % 32u; int s = h3 % 2048u; if ((h3 >> 20) % 8u == 0u) s = 0; if ((h3 >> 20) % 8u == 1u) s = 2047;
        float val = p.in[I_CONVHYB][c];
#pragma unroll 1
        for (int j = 0; j < 3; ++j) { const int sj = s + j - 1; if (sj < 0 || sj > 2047) continue; val += p.in[I_CONVHYW][j * 3072 + c] * bf1(ZT[(size_t)c * T + b * 2048 + sj]); }
        const float got = bf1(UC[(size_t)c * T + b * 2048 + s]); d = fabsf(got - val) / (fabsf(val) + 0.1f);
    } else if (mode == 1) {
        LAS float* Z = (LAS float*)(lds + wave * 1024); LAS float* A1 = Z + 64; LAS float* A2 = A1 + 64;
        const int o = hsh & 1u, c = h2 % 1024u, j = h3 % 2048u;
        float z = 0.f; if (lane == 0) z = (float)j / 2047.f; else if (lane < 33) { const int k = (lane - 1) & 15; const float fr = 1e-4f + (float)k * ((15.f - 1e-4f) / 15.f); const float ang = (6.283185307179586f / 2048.f) * (float)j * fr; z = lane < 17 ? cosf(ang) : -sinf(ang); }
        Z[lane] = z; LDS_WAIT(); asm volatile("" ::: "memory");
        float a = p.in[I_FB1][lane];
#pragma unroll 1
        for (int k = 0; k < 33; ++k) a += Z[k] * p.in[I_FW1][k * 64 + lane];
        A1[lane] = sinf(a); LDS_WAIT(); asm volatile("" ::: "memory");
        a = p.in[I_FB2][lane];
#pragma unroll 1
        for (int k = 0; k < 64; ++k) a += A1[k] * p.in[I_FW2][k * 64 + lane];
        A2[lane] = sinf(a); LDS_WAIT(); asm volatile("" ::: "memory");
        float v = wave_sum(A2[lane] * p.in[I_FW3][lane * 2048 + o * 1024 + c]);
        const float mind = -4.605170185988091f / 1.5f, maxd = -4.605170185988091f / 0.3f; const float delta = fabsf(mind + (float)c * ((maxd - mind) / 1023.f));
        v *= expf(-fabsf((float)j - 1024.f) / 1024.f * delta);
        const float got = bf1(FILT[(size_t)(o * 1024 + c) * 2048 + j]); d = fabsf(got - v) / (fabsf(v) + 1e-4f);
    } else if (mode == 2 || mode == 3) {
        const int o = mode - 2, c = hsh % 1024u, b = h2 % 32u; int t = h3 % 2048u; if ((h3 >> 20) % 8u == 0u) t = 0; if ((h3 >> 20) % 8u == 1u) t = 2047;
        const bf16* in = (o == 0 ? UC : ZT) + (size_t)c * T + b * 2048; const bf16* f = FILT + (size_t)(o * 1024 + c) * 2048; float acc = 0.f;
#pragma unroll 1
        for (int s = lane; s < 2048; s += 64) { const int x = 1024 + t - s; if (x >= 0 && x <= 2047) acc += bf1(f[x]) * bf1(in[s]); }
        acc = wave_sum(acc);
        const float gate = bf1(UC[(size_t)((1 + o) * 1024 + c) * T + b * 2048 + t]);
        const float val = gate * (acc + bf1(in[t]) * p.in[I_FBIAS][o * 1024 + c]);
        const float got = bf1((o == 0 ? ZT : Y2T)[(size_t)c * T + b * 2048 + t]); d = fabsf(got - val) / (fabsf(val) + 0.1f);
    } else if (mode == 4) {
        const int tok = hsh % 65536u, n = h2 % 1024u; float acc = 0.f;
#pragma unroll 1
        for (int c = lane; c < 1024; c += 64) acc += bf1(Y2T[(size_t)c * T + tok]) * p.in[I_WOUTHY][(size_t)c * 1024 + n];
        acc = wave_sum(acc);
        const float got = bf1(MIX[(size_t)tok * D + n]); d = fabsf(got - acc) / (fabsf(acc) + 0.1f);
    }
    dbg_report_wave(p, d, lane);
}
__device__ __forceinline__ void dbg_inproj_check(const Params& p, unsigned char* big, int lane, int wave) {
    const unsigned hsh = dbg_hash(blockIdx.x * 8u + wave + 777u), h2 = dbg_hash(hsh);
    const bf16* H0 = (const bf16*)(big + A0_H); const float* W = p.in[I_WINAB];
    int m = hsh % (unsigned)TT; int n = h2 % 3600u;
    const bool ctx = m >= T; if (ctx && n < 1536) n += 1536;
    const int b = ctx ? (m - T) / LC : m / SEQ, s = ctx ? (m - T) % LC : m % SEQ;
    float x = 0.f, xp = 0.f; const bool rope_col = (n < 512) || (n >= 1536 && n < 2048); const int np = rope_col ? (n ^ 16) : n;
#pragma unroll 1
    for (int k = lane; k < 1024; k += 64) { const float hv = bf1(H0[(size_t)m * D + k]); x += hv * W[(size_t)k * 3600 + n]; xp += hv * W[(size_t)k * 3600 + np]; }
    x = wave_sum(x); xp = wave_sum(xp);
    float val = x, got = 0.f;
    if (n >= 3584) { val = x + p.in[I_GATEB][n - 3584]; got = ((const float*)(p.ws + WS_GATES))[(size_t)m * 16 + (n - 3584)]; }
    else { const int t = n / 512, cn = n % 512; int pc = cn;
        if (rope_col) { const int o = cn & 31; pc = (cn & ~31) + (((o & 15) >> 2) * 8 + (o >> 4) * 4 + (o & 3));
            if (!ctx) { const int d = cn & 63, axis = d >> 5, half = (d >> 4) & 1, i = d & 15; const float pos = (float)(axis == 0 ? (s >> 6) : (s & 63)); const float ang = pos * powf(10000.f, -(float)i / 16.f);
                val = half == 0 ? x * cosf(ang) - xp * sinf(ang) : x * cosf(ang) + xp * sinf(ang); } }
        if (t == 0) val *= QSCALE;
        const size_t offs[7] = {A0_QA, A0_BQ, A0_BO, A0_KA, A0_VA, A0_BK, A0_BV}; const bool kv = t >= 3;
        const bf16* O = (const bf16*)(big + offs[t]) + (size_t)b * (kv ? (SEQ + LC) : SEQ) * 512 + (size_t)((kv && !ctx) ? LC : 0) * 512;
        got = bf1(O[(size_t)s * 512 + pc]); }
    dbg_report_wave(p, fabsf(got - val) / (fabsf(val) + 0.1f), lane);
}
__device__ __forceinline__ void dbg_attn_check(const Params& p, unsigned char* big, LAS unsigned char* lds, int lane, int wave) {
    const unsigned hsh = dbg_hash(blockIdx.x * 8u + wave + 4242u), h2 = dbg_hash(hsh);
    const int b = hsh % 32u, h = (hsh >> 8) % 4u, q = h2 % 2048u;
    const bf16* QA = (const bf16*)(big + A0_QA) + ((size_t)b * SEQ + q) * 512 + h * 128; const bf16* KA = (const bf16*)(big + A0_KA) + (size_t)b * 2304 * 512 + h * 128;
    const bf16* VA = (const bf16*)(big + A0_VA) + (size_t)b * 2304 * 512 + h * 128; const bf16* MIXIN = (const bf16*)(big + A0_MIXIN) + ((size_t)b * SEQ + q) * D + h * 128;
    LAS float* Aw = (LAS float*)(lds + wave * 18432);
    const float* lv = p.in[I_DLAM]; const float lam = expf(wave_sum(lv[lane] * lv[64 + lane])) - expf(wave_sum(lv[128 + lane] * lv[192 + lane])) + 0.2f;
    float mx0 = -1e30f, mx1 = -1e30f;
#pragma unroll 1
    for (int key = lane; key < 2304; key += 64) { float s0 = 0.f, s1 = 0.f;
#pragma unroll 1
        for (int d = 0; d < 64; ++d) { s0 += bf1(QA[d]) * bf1(KA[(size_t)key * 512 + d]); s1 += bf1(QA[64 + d]) * bf1(KA[(size_t)key * 512 + 64 + d]); }
        Aw[key] = s0; Aw[2304 + key] = s1; mx0 = fmaxf(mx0, s0); mx1 = fmaxf(mx1, s1); }
    mx0 = wave_max(mx0); mx1 = wave_max(mx1);
    float l0 = 0.f, l1 = 0.f;
#pragma unroll 1
    for (int key = lane; key < 2304; key += 64) { const float e0 = exp2f(Aw[key] - mx0), e1 = exp2f(Aw[2304 + key] - mx1); Aw[key] = e0; Aw[2304 + key] = e1; l0 += e0; l1 += e1; }
    l0 = wave_sum(l0); l1 = wave_sum(l1);
    LDS_WAIT(); asm volatile("" ::: "memory");
    float o[2] = {0.f, 0.f};
#pragma unroll 1
    for (int key = 0; key < 2304; ++key) { const float a = Aw[key] / l0 - lam * Aw[2304 + key] / l1; o[0] += a * bf1(VA[(size_t)key * 512 + lane]); o[1] += a * bf1(VA[(size_t)key * 512 + 64 + lane]); }
    const float ms = wave_sum(o[0] * o[0] + o[1] * o[1]) * (1.f / 128.f); const float rn = rsqrtf(ms + RMS_EPS) * 0.8f;
    float err = 0.f, sc = 0.f;
#pragma unroll
    for (int j = 0; j < 2; ++j) { const float val = o[j] * rn * p.in[I_HGA][h * 128 + 64 * j + lane]; err = fmaxf(err, fabsf(val - bf1(MIXIN[64 * j + lane]))); sc += val * val; }
    err = wave_max(err); sc = sqrtf(wave_sum(sc) * (1.f / 128.f));
    dbg_report_wave(p, err / (sc + 1e-3f), lane);
}
__device__ __forceinline__ float dbg_convsilu(const bf16* base, int pos, int lim, int ch, int d, const float* cw, const float* cb) {
    float s = cb[ch];
#pragma unroll
    for (int j = 0; j < 3; ++j) { const int pj = pos + j - 1; if (pj >= 0 && pj < lim) s += cw[j * 1024 + ch] * bf1(base[(size_t)pj * 512 + d]); }
    return s / (1.f + expf(-s));
}
__device__ __forceinline__ void dbg_mlstm_check(const Params& p, unsigned char* big, LAS unsigned char* lds, int lane, int wave) {
    const unsigned hsh = dbg_hash(blockIdx.x * 8u + wave + 991u), h2 = dbg_hash(hsh);
    const int b = hsh % 32u, h = (hsh >> 8) % 4u, dir = (hsh >> 12) & 1; int tau = h2 % 2048u; if ((h2 >> 16) % 4u == 0u) tau = (h2 >> 20) % 130u;
    const bf16* BQ = (const bf16*)(big + A0_BQ) + (size_t)b * SEQ * 512 + h * 128; const bf16* BK = (const bf16*)(big + A0_BK) + (size_t)b * (SEQ + LC) * 512 + h * 128;
    const bf16* BV = (const bf16*)(big + A0_BV) + (size_t)b * (SEQ + LC) * 512 + h * 128;
    const float* GT = (const float*)(p.ws + WS_GATES); const float* cw = p.in[I_CONVABW]; const float* cb = p.in[I_CONVABB];
    LAS float* F = (LAS float*)(lds + wave * 18432); LAS float* qv = F + 2304 + 64;
    const int N = 256 + tau + 1;
#define DBG_POS(u) ((u) < 256 ? (dir ? 255 - (u) : (u)) : (dir ? 2047 - ((u) - 256) : (u) - 256))
#define DBG_GROW(u) ((u) < 256 ? (size_t)T + b * LC + DBG_POS(u) : (size_t)b * SEQ + DBG_POS(u))
    float carry = 0.f;
#pragma unroll 1
    for (int u0 = 0; u0 < N; u0 += 64) { const int u = u0 + lane; float lf = 0.f;
        if (u < N) { const float x = GT[DBG_GROW(u) * 16 + dir * 8 + 4 + h]; lf = x >= 0.f ? -__logf(1.f + __expf(-x)) : x - __logf(1.f + __expf(x)); }
        float s = lf;
#pragma unroll
        for (int o = 1; o < 64; o <<= 1) { const float v = shup(s, o); if (lane >= o) s += v; }
        if (u < N) F[u] = carry + s; carry += shidx(s, 63); }
    LDS_WAIT(); asm volatile("" ::: "memory");
    const float Ft = F[N - 1];
    float mm = Ft;
#pragma unroll 1
    for (int u = lane; u < N; u += 64) mm = fmaxf(mm, Ft - F[u] + GT[DBG_GROW(u) * 16 + dir * 8 + h]);
    mm = wave_max(mm);
    { const int pos = DBG_POS(N - 1);
      for (int d = lane; d < 128; d += 64) qv[d] = dbg_convsilu(BQ, pos, SEQ, h * 128 + d, d, cw, cb) * 0.08838834764831845f; }
    LDS_WAIT(); asm volatile("" ::: "memory");
    float den = 0.f;
#pragma unroll 1
    for (int u = lane; u < N; u += 64) { const bool ctx = u < 256; const int pos = DBG_POS(u); const bf16* kb = ctx ? BK : BK + (size_t)LC * 512; float qk = 0.f;
#pragma unroll 1
        for (int d = 0; d < 128; ++d) qk += qv[d] * dbg_convsilu(kb, pos, ctx ? LC : SEQ, 512 + h * 128 + d, d, cw, cb);
        const float om = qk * expf(Ft - F[u] + GT[DBG_GROW(u) * 16 + dir * 8 + h] - mm); F[u] = om; den += om; }
    den = wave_sum(den);
    LDS_WAIT(); asm volatile("" ::: "memory");
    float num[2] = {0.f, 0.f};
#pragma unroll 1
    for (int u = 0; u < N; ++u) { const bool ctx = u < 256; const int pos = DBG_POS(u); const bf16* vb = BV + (size_t)((ctx ? 0 : LC) + pos) * 512; num[0] += F[u] * bf1(vb[lane]); num[1] += F[u] * bf1(vb[64 + lane]); }
    const float dd = 1.f / fmaxf(fabsf(den), expf(-mm));
    const bf16* HB = (const bf16*)(big + A0_HB) + (size_t)dir * T * 512 + ((size_t)b * SEQ + DBG_POS(N - 1)) * 512 + h * 128;
    float err = 0.f, sc = 0.f;
#pragma unroll
    for (int j = 0; j < 2; ++j) { const float val = num[j] * dd; err = fmaxf(err, fabsf(val - bf1(HB[64 * j + lane]))); sc += val * val; }
    err = wave_max(err); sc = sqrtf(wave_sum(sc) * (1.f / 128.f));
    dbg_report_wave(p, err / (sc + 1e-3f), lane);
#undef DBG_POS
#undef DBG_GROW
}

__global__ void __launch_bounds__(NTHR, 2) mk_fwd(Params p0) {
    extern __shared__ __attribute__((aligned(16))) unsigned char lds_raw[];
    LAS unsigned char* lds = (LAS unsigned char*)lds_raw;
    const int wave0 = __builtin_amdgcn_readfirstlane((int)threadIdx.x >> 6);
    if (threadIdx.x < 64) ((LAS unsigned*)(lds + LDS_MISC))[threadIdx.x] = 0u;
    __syncthreads();
    XcdBarrier bar = xcd_barrier_post((unsigned*)(p0.ws + WS_CTL) + CW_BAR, (volatile LAS unsigned*)(lds + LDS_MISC + 32));
    const int G = gridDim.x, cb = blockIdx.x;
    const int vcu = (G % 8 == 0) ? (cb % 8) * (G / 8) + cb / 8 : cb;
#ifdef TIMEK
    int phc = 0; if (blockIdx.x == 0 && threadIdx.x == 0) ((unsigned long long*)(p0.ws + WS_CTL + 32768))[0] = __builtin_amdgcn_s_memrealtime();
#endif
#ifdef DBL_PH
#define DBL_LOOP for (int rep_ = 0; rep_ < 1; ++rep_)
#define DBL_SYNC __syncthreads();
#else
#define DBL_LOOP
#define DBL_SYNC
#endif
#ifdef TIMEK
#define TS_REC { ++phc; if (blockIdx.x == 0 && wave0 == 0 && lane_opq() == 0) ((unsigned long long*)(p0.ws + WS_CTL + 32768))[phc] = __builtin_amdgcn_s_memrealtime(); }
#else
#define TS_REC
#endif
#define LAYER_PTRS bf16* H2 = (bf16*)(big + (l == 0 ? 0 : 128 * MiB)); float* LOG = (float*)(big + (l == 0 ? 128 * MiB : 256 * MiB)); bf16* ACT = (bf16*)(big + (l == 0 ? 144 * MiB : 272 * MiB)); \
        bf16* Y = (bf16*)(big + (l == 0 ? 224 * MiB : 352 * MiB)); bf16* HN = (bf16*)(big + 544 * MiB); const bf16* MIX = (const bf16*)(big + (l == 0 ? A0_MIX : 0)); \
        bf16* UT = (bf16*)big; bf16* UC = (bf16*)(big + 384 * MiB); bf16* ZT = (bf16*)(big + 384 * MiB); bf16* Y2T = (bf16*)(big + 512 * MiB); bf16* Y2 = (bf16*)(big + 640 * MiB); \
        (void)H2; (void)LOG; (void)ACT; (void)Y; (void)HN; (void)MIX; (void)UT; (void)UC; (void)ZT; (void)Y2T; (void)Y2;
#define RUN(...) do { { { int tid_ = wave0 * 64 + lane_opq(); asm volatile("" : "+v"(tid_)); const int tid = tid_, lane = tid & 63, wave = __builtin_amdgcn_readfirstlane(tid >> 6); (void)lane; (void)wave; \
        Params p = p0; { size_t z_ = 0; asm volatile("" : "+s"(z_)); p.ws = p0.ws + z_; p.out = p0.out + z_; _Pragma("unroll") for (int i_ = 0; i_ < 31; ++i_) p.in[i_] = p0.in[i_] + z_; } unsigned char* ws = p.ws; unsigned char* big = ws + WS_BIG; (void)big; LAYER_PTRS DBL_LOOP { __VA_ARGS__; DBL_SYNC } } { XcdBarrier b2_ = bar; { size_t z_ = 0; asm volatile("" : "+s"(z_)); b2_.bar = bar.bar + z_; unsigned x_ = bar.x; asm volatile("" : "+s"(x_)); b2_.x = x_; } xcd_barrier(b2_, wave0 == 0 && lane_opq() == 0); } TS_REC } } while (0)

    { const int l = 0; RUN({ pro_mod(p, lds, tid, lane, wave); __syncthreads(); pro_filters(p, lds, tid, lane, wave); pro_rope(p, tid); pro_transposes(p, lds, lane, wave); }); }

    for (int l = 0; l < 2; ++l) {
        if (l == 0) {
            RUN({ ph_l0_norm(p, lane, wave); });
            RUN({ Gemm g{(const bf16*)(big + A0_H), (const bf16*)(ws + WS_WIN0), 1024, 2048u}; InprojSched S{G, vcu};
                  EpiInproj E{big, (const float*)(ws + WS_ROPE), (float*)(ws + WS_GATES), p.in[I_GATEB]};
                  gemm_phase<EpiInproj, InprojSched>(lds, g, S, E, tid); });
#ifdef DBG_INPROJ
            RUN({ dbg_inproj_check(p, big, lane, wave); });
#endif
            RUN({ ph_transpose_b((const bf16*)(big + A0_VA), (bf16*)(big + A0_VT), NB, SEQ + LC, 512, lds, lane, wave); });
            RUN({ ph_attn(p, big, lds, tid, lane, wave); });
#ifdef DBG_ATTN
            RUN({ dbg_attn_check(p, big, lds, lane, wave); });
#endif
            RUN({ ph_mlstm(p, big, lds, tid, lane, wave); });
#ifdef DBG_MLSTM
            RUN({ dbg_mlstm_check(p, big, lds, lane, wave); });
#endif
            RUN({ ph_outb(p, big, lane, wave); });
            RUN({ Gemm g{(const bf16*)(big + A0_MIXIN), (const bf16*)(ws + WS_WOUT0), 1024, 2048u}; DenseSched S{4, 1024, G, vcu, 0}; EpiBf16 E{(bf16*)(big + A0_MIX), 1024, 3};
                  gemm_phase<EpiBf16, DenseSched>(lds, g, S, E, tid); });
        }
        if (l == 1) {
            RUN({ Gemm g{(const bf16*)(ws + WS_WIN1), HN, 1024, 2048u}; DenseSched S{256, 12 * 256, G, vcu, 12}; EpiBf16 E{UT, (size_t)T, 0xffff};
                  gemm_phase<EpiBf16, DenseSched>(lds, g, S, E, tid); });
#ifdef DBG_HY
            if (DBG_MODE == 0) { RUN({ dbg_hyena_check(p, 0, HN, UT, UT, UT, UT, lds, lane, wave); }); }
#endif
#ifdef DBG_HY
            if (DBG_MODE == 5) { RUN({ dbg_hyena_check(p, 5, HN, UC, UT, UT, UT, lds, lane, wave); }); }
#endif
            RUN({ ph_lconv<true>(p, 0, UT, UT, ZT, lds, tid, lane, wave); });
#ifdef DBG_HY
            if (DBG_MODE == 2) { RUN({ dbg_hyena_check(p, 2, HN, UC, ZT, Y2T, UT, lds, lane, wave); }); }
#endif
            RUN({ ph_lconv<false>(p, 1, ZT, UT, Y2T, lds, tid, lane, wave); });
#ifdef DBG_HY
            if (DBG_MODE == 3) { RUN({ dbg_hyena_check(p, 3, HN, UC, ZT, Y2T, UT, lds, lane, wave); }); }
#endif
            RUN({ ph_transpose(Y2T, Y2, lds, lane, wave); });
            RUN({ Gemm g{Y2, (const bf16*)(ws + WS_WOUT1), 1024, 2048u}; DenseSched S{4, 1024, G, vcu, 0}; EpiBf16 E{(bf16*)big, 1024, 3};
                  gemm_phase<EpiBf16, DenseSched>(lds, g, S, E, tid); });
        }
#ifdef DBG_HY
        if (l == 1 && (DBG_MODE == 1 || DBG_MODE == 4)) { RUN({ dbg_hyena_check(p, DBG_MODE, HN, (const bf16*)(big + 384 * MiB), (const bf16*)big, (const bf16*)(big + 128 * MiB), (const bf16*)big, lds, lane, wave); }); }
#endif
        RUN({ ph_mid(p, l, MIX, H2, true, lane, wave); });
        RUN({ Gemm g{H2, (const bf16*)(ws + WS_WR) + (size_t)l * 256 * 1024, 1024, 2048u}; DenseSched S{1, 256, G, vcu, 0}; EpiRouterLds E{};
              gemm_phase<EpiRouterLds, DenseSched>(lds, g, S, E, tid); __syncthreads(); ph_route_a(p, l, nullptr, vcu, lds, tid); });
#ifdef DBG_ROUTE
        RUN({ if (l == DBG_L) dbg_route_check(p, l, H2, LOG, lds, tid); ph_route_b(p, lds, tid); });
#else
        RUN({ ph_route_b(p, lds, tid); });
#endif
#define DO_G1(chx) do { const int NT = moe_tables(p, chx, lds, tid); \
            Gemm g{H2, (const bf16*)(ws + WS_GU) + (size_t)l * (65 * 512) * 1024, 1024, 2048u}; \
            MoeSched S{(const LAS int*)(lds + LDS_TAB), (const int*)(ws + WS_SORT) + (size_t)(chx) * CHROWS, NT * 2, G, vcu, 1, 2}; EpiSwiglu E{ACT}; \
            gemm_phase<EpiSwiglu, MoeSched>(lds, g, S, E, tid); } while (0)
        RUN({ DO_G1(0); });
        for (int ch = 0; ch < NCH; ++ch) {
            RUN({ const int NT = moe_tables(p, ch, lds, tid);
                  Gemm g{ACT, (const bf16*)(ws + WS_DN) + (size_t)l * (65 * 1024) * 256, 256, 512u};
                  MoeSched S{(const LAS int*)(lds + LDS_TAB), nullptr, NT * 4, G, vcu, 2, 4}; EpiFp8 E{(unsigned char*)Y};
                  gemm_phase<EpiFp8, MoeSched>(lds, g, S, E, tid); });
            RUN({ const int par = (cb >> 3) & 1;
                  _Pragma("unroll 1") for (int part = 0; part < 2; ++part) { int t2_ = tid; asm volatile("" : "+v"(t2_)); const int tid = t2_, lane = tid & 63; (void)lane; if ((part ^ par) == 0) { if (ch + 1 < NCH) DO_G1(ch + 1); } else { ph_combine(p, l, ch, (const unsigned char*)Y, HN, lane, wave); } __syncthreads(); } });
        }
    }
#ifdef TIMEK
    if (blockIdx.x == 0) { const unsigned long long* ts = (const unsigned long long*)(p0.ws + WS_CTL + 32768); __syncthreads();
        const unsigned long long d = (__hip_atomic_load(ts + TIMEK, __ATOMIC_RELAXED, __HIP_MEMORY_SCOPE_AGENT) - __hip_atomic_load(ts + TIMEK0, __ATOMIC_RELAXED, __HIP_MEMORY_SCOPE_AGENT)) * 4ull, t0 = __builtin_amdgcn_s_memrealtime();
        while (__builtin_amdgcn_s_memrealtime() - t0 < d) __builtin_amdgcn_s_sleep(8); }
#endif
#ifdef DBG_ANY
    xcd_barrier(bar, threadIdx.x == 0);
    if (blockIdx.x == 0 && threadIdx.x == 0) p0.out[0] += 1.0e7f * __uint_as_float(((const unsigned*)(p0.ws + WS_CTL))[CW_DBG]);
#endif
#undef RUN
}
constexpr int NPHASES = 1 + 2 * (4 + 3 * NCH) + 6 + 64;
}

extern "C" void kernel_launch(void* const* d_in, const int* in_sizes, int n_in, void* d_out, int out_size, void* d_ws, size_t ws_size, hipStream_t stream) {
    using namespace mk;
    static int grid = 0;
    if (grid == 0) {
        if (n_in != 31 || out_size != T * D || ws_size < WS_END) { fprintf(stderr, "kernel_launch: unexpected shapes (n_in %d, out %d, ws %zu)\n", n_in, out_size, ws_size); grid = -1; return; }
        int dev = 0, cus = 0;
        if (hipGetDevice(&dev) != hipSuccess || hipDeviceGetAttribute(&cus, hipDeviceAttributeMultiprocessorCount, dev) != hipSuccess) { grid = -1; return; }
        if (hipFuncSetAttribute((const void*)mk_fwd, hipFuncAttributeMaxDynamicSharedMemorySize, LDS_BYTES) != hipSuccess) { fprintf(stderr, "kernel_launch: hipFuncSetAttribute failed\n"); grid = -1; return; }
        int per_cu = 0;
        if (hipOccupancyMaxActiveBlocksPerMultiprocessor(&per_cu, (const void*)mk_fwd, NTHR, LDS_BYTES) != hipSuccess || per_cu < 1) { fprintf(stderr, "kernel_launch: occupancy query says %d\n", per_cu); }
        (void)hipGetLastError();
        grid = cus;
        if (grid != 256) { fprintf(stderr, "kernel_launch: built for 256 CUs, found %d\n", grid); grid = -1; return; }
    }
    if (grid < 0) return;
    (void)hipMemsetAsync((char*)d_ws + WS_CTL, 0, CTL_ZERO_BYTES, stream);
    Params a{};
    for (int i = 0; i < 31; ++i) a.in[i] = (const float*)d_in[i];
    a.out = (float*)d_out; a.ws = (unsigned char*)d_ws; a.ph_lo = 0; a.ph_hi = NPHASES;
    hipLaunchKernelGGL(mk_fwd, dim3(grid), dim3(NTHR), LDS_BYTES, stream, a);
}
```

```cpp
#include <hip/hip_runtime.h>
#include <cstdio>
#include <cstdint>
namespace pg8 {
#define PG8_LAS __attribute__((address_space(3)))
typedef unsigned short bf16_t;
typedef short bf16x8 __attribute__((ext_vector_type(8)));
typedef float f32x4 __attribute__((ext_vector_type(4)));
typedef unsigned u32x4 __attribute__((ext_vector_type(4)));
typedef unsigned u32x2 __attribute__((ext_vector_type(2)));
constexpr int BM = 256, BK = 64, HALF = 128, HTB = HALF * BK * 2  , STAGE_BYTES = 8 * HTB;

__host__ __device__ __forceinline__ int lds_byte(int r, int c) { const int st = (r >> 4) * 2 + (c >> 5), rr = r & 15, cc = c & 31, ob = rr * 64 + cc * 2; return st * 1024 + (ob ^ (((ob >> 9) & 1) << 5)); }
__host__ __device__ __forceinline__ void stage_rc(int b, int& R, int& C) { const int st = b / 1024, sb = b % 1024, swz = sb ^ (((sb >> 9) & 1) << 5); R = (st >> 1) * 16 + swz / 64; C = (st & 1) * 32 + (swz % 64) / 2; }
__host__ __device__ __forceinline__ int perm32(int rho) { const int n = rho >> 4, i = rho & 15; return 8 * (i >> 2) + 4 * n + (i & 3); }

struct Unit { int pm, pn; };
__device__ __forceinline__ unsigned cvt_pk_bf16(float lo, float hi) { unsigned r; asm volatile("v_cvt_pk_bf16_f32 %0, %1, %2" : "=v"(r) : "v"(lo), "v"(hi)); return r; }
struct Gemm { const bf16_t* A; const bf16_t* Bt; int K; unsigned lda_bytes; };
template <class Epi, class Sched, bool ALIGN_EPI = true>
__device__ __forceinline__ void gemm_phase(PG8_LAS unsigned char* lds, const Gemm g, const Sched& S, const Epi& E, const int tid_in) {
    int tid_ = tid_in; asm volatile("" : "+v"(tid_));
    const int tid = tid_, wid = __builtin_amdgcn_readfirstlane(tid >> 6), lane = tid & 63, wr = wid >> 2, wc = wid & 3, fr = lane & 15, fq = lane >> 4;
    const int K = g.K, nt = K / BK;
    unsigned voffB[2];
#pragma unroll
    for (int i = 0; i < 2; ++i) { int R, C; stage_rc(tid * 16 + i * 8192, R, C); const int Rb = Epi::PERM ? ((R & ~31) + perm32(R & 31)) : R;
        voffB[i] = (unsigned)(Rb * K + C) * 2u; }
    const size_t kstep = (size_t)(BK * 2);
    const size_t hstep = (size_t)HALF * K * 2;
    const size_t tstep = 2 * hstep;
    const unsigned ldsw = (unsigned)wid * 1024u;
    const int aoff = lds_byte(wr * 64 + fr, fq * 8), boff = lds_byte(wc * 32 + fr, fq * 8);
    const char* Ab = (const char*)g.A;
#define PG8_SA(b, h) (((b) * 2 + (h)) * HTB)
#define PG8_SB(b, h) ((4 + (b) * 2 + (h)) * HTB)
#define PG8_STAGE(bufoff, gbase, voff) do { _Pragma("unroll") for (int _i = 0; _i < 2; ++_i) \
        __builtin_amdgcn_global_load_lds((const unsigned*)((const char*)(gbase) + (voff)[_i]), (PG8_LAS unsigned*)(lds + (bufoff) + ldsw + _i * 8192), 16, 0, 0); } while (0)
#define PG8_STAGEA(bufoff, o0, o1, kb) do { \
        __builtin_amdgcn_global_load_lds((const unsigned*)(Ab + (size_t)(o0) + (size_t)(kb)), (PG8_LAS unsigned*)(lds + (bufoff) + ldsw), 16, 0, 0); \
        __builtin_amdgcn_global_load_lds((const unsigned*)(Ab + (size_t)(o1) + (size_t)(kb)), (PG8_LAS unsigned*)(lds + (bufoff) + ldsw + 8192), 16, 0, 0); } while (0)
#define PG8_LDA(dst, b, h) do { _Pragma("unroll") for (int m = 0; m < 4; ++m) _Pragma("unroll") for (int k = 0; k < 2; ++k) dst[m][k] = *(const PG8_LAS bf16x8*)(lds + PG8_SA(b, h) + aoff + m * 2048 + k * 1024); } while (0)
#define PG8_LDB(dst, b, h) do { _Pragma("unroll") for (int n = 0; n < 2; ++n) _Pragma("unroll") for (int k = 0; k < 2; ++k) dst[n][k] = *(const PG8_LAS bf16x8*)(lds + PG8_SB(b, h) + boff + n * 2048 + k * 1024); } while (0)
#define PG8_MMA(ai, bj, At, Bt) do { __builtin_amdgcn_s_setprio(1); _Pragma("unroll") for (int m = 0; m < 4; ++m) _Pragma("unroll") for (int n = 0; n < 2; ++n) _Pragma("unroll") for (int k = 0; k < 2; ++k) \
        acc[ai][bj][m][n] = __builtin_amdgcn_mfma_f32_16x16x32_bf16(Bt[n][k], At[m][k], acc[ai][bj][m][n], 0, 0, 0); __builtin_amdgcn_s_setprio(0); } while (0)
#define PG8_WAIT_V(n) asm volatile("s_waitcnt vmcnt(" #n ")" ::: "memory")
#define PG8_WAIT_L(n) asm volatile("s_waitcnt lgkmcnt(" #n ")" ::: "memory")
#define PG8_BAR __builtin_amdgcn_s_barrier()
#define PG8_SCHED __builtin_amdgcn_sched_barrier(0)
#define PG8_OFFS(dst, u) do { _Pragma("unroll") for (int _i = 0; _i < 2; ++_i) { int _R, _C; stage_rc(tid * 16 + _i * 8192, _R, _C); _Pragma("unroll") for (int _h = 0; _h < 2; ++_h) \
        dst[_h][_i] = (unsigned)S.arow((u).pm * BM + _h * HALF + _R) * g.lda_bytes + (unsigned)(_C * 2); } } while (0)
    Unit cur, nxt; int ui = 0;
    if (!S.next(0, cur)) return;
    f32x4 acc[2][2][4][2];
#pragma unroll
    for (int a = 0; a < 2; ++a)
#pragma unroll
        for (int b = 0; b < 2; ++b)
#pragma unroll
            for (int m = 0; m < 4; ++m)
#pragma unroll
                for (int n = 0; n < 2; ++n) acc[a][b][m][n] = (f32x4){0.f, 0.f, 0.f, 0.f};
    bf16x8 At[4][2], B0[2][2], B1[2][2];
    unsigned oC[2][2], oN[2][2];
    PG8_OFFS(oC, cur);
    const char* cB = (const char*)g.Bt + (size_t)cur.pn * tstep;
    PG8_STAGE(PG8_SB(0, 0), cB, voffB); PG8_STAGE(PG8_SB(0, 1), cB + hstep, voffB); PG8_STAGEA(PG8_SA(0, 0), oC[0][0], oC[0][1], 0); PG8_STAGEA(PG8_SA(0, 1), oC[1][0], oC[1][1], 0);
    if (wr == 1) PG8_BAR;
    PG8_WAIT_V(2); PG8_BAR;
    PG8_STAGE(PG8_SB(1, 0), cB + kstep, voffB); PG8_STAGEA(PG8_SA(1, 0), oC[0][0], oC[0][1], kstep); PG8_STAGE(PG8_SB(1, 1), cB + hstep + kstep, voffB);
    PG8_WAIT_V(6); PG8_BAR;
    for (;;) {
        const bool has_next = S.next(ui + 1, nxt);
        if (has_next) { PG8_OFFS(oN, nxt); } else {
#pragma unroll
            for (int _h = 0; _h < 2; ++_h)
#pragma unroll
                for (int _i = 0; _i < 2; ++_i) oN[_h][_i] = oC[_h][_i]; }
        const char* nB = has_next ? (const char*)g.Bt + (size_t)nxt.pn * tstep : cB;
#pragma unroll 1
        for (int t = 0; t < nt; t += 2) {
            const bool last = (t == nt - 2);
            const size_t k1 = (size_t)(t + 1) * kstep;
            const size_t k2 = last ? 0 : (size_t)(t + 2) * kstep, k3 = k2 + kstep;
            const char* b2 = last ? nB : cB + (size_t)(t + 2) * kstep; const char* b3 = b2 + kstep;
            PG8_LDB(B0, 0, 0); PG8_LDB(B1, 0, 1); PG8_SCHED; PG8_LDA(At, 0, 0); PG8_STAGEA(PG8_SA(1, 1), oC[1][0], oC[1][1], k1);
            if (last) { oC[0][0] = oN[0][0]; oC[0][1] = oN[0][1]; oC[1][0] = oN[1][0]; oC[1][1] = oN[1][1]; }
            PG8_WAIT_V(8); PG8_WAIT_L(0); PG8_BAR; PG8_MMA(0, 0, At, B0); PG8_MMA(0, 1, At, B1); PG8_BAR; PG8_SCHED;
            PG8_LDA(At, 0, 1); PG8_STAGE(PG8_SB(0, 0), b2, voffB); PG8_STAGE(PG8_SB(0, 1), b2 + hstep, voffB); PG8_STAGEA(PG8_SA(0, 0), oC[0][0], oC[0][1], k2);
            PG8_WAIT_V(8); PG8_WAIT_L(0); PG8_BAR; PG8_MMA(1, 0, At, B0); PG8_MMA(1, 1, At, B1); PG8_BAR; PG8_SCHED;
            PG8_LDB(B0, 1, 0); PG8_LDB(B1, 1, 1); PG8_SCHED; PG8_LDA(At, 1, 0); PG8_STAGEA(PG8_SA(0, 1), oC[1][0], oC[1][1], k2);
            PG8_WAIT_V(8); PG8_WAIT_L(0); PG8_BAR; PG8_MMA(0, 0, At, B0); PG8_MMA(0, 1, At, B1); PG8_BAR; PG8_SCHED;
            PG8_LDA(At, 1, 1); PG8_STAGE(PG8_SB(1, 0), b3, voffB); PG8_STAGE(PG8_SB(1, 1), b3 + hstep, voffB); PG8_STAGEA(PG8_SA(1, 0), oC[0][0], oC[0][1], k3);
            PG8_WAIT_V(8); PG8_WAIT_L(0); PG8_BAR; PG8_MMA(1, 0, At, B0); PG8_MMA(1, 1, At, B1); PG8_BAR; PG8_SCHED;
        }
        if constexpr (ALIGN_EPI) { if (wr == 0) PG8_BAR; }
        E(acc, cur, wr, wc, fr, fq);
        if (!has_next) break;
#pragma unroll
        for (int a = 0; a < 2; ++a)
#pragma unroll
            for (int b = 0; b < 2; ++b)
#pragma unroll
                for (int m = 0; m < 4; ++m)
#pragma unroll
                    for (int n = 0; n < 2; ++n) acc[a][b][m][n] = (f32x4){0.f, 0.f, 0.f, 0.f};
        cur = nxt; cB = nB; ++ui;
#pragma unroll
        for (int _h = 0; _h < 2; ++_h)
#pragma unroll
            for (int _i = 0; _i < 2; ++_i) oC[_h][_i] = oN[_h][_i];
        if constexpr (ALIGN_EPI) { if (wr == 1) PG8_BAR; }
    }
    PG8_WAIT_V(0);
    if constexpr (!ALIGN_EPI) { if (wr == 0) PG8_BAR; }
    PG8_BAR;
    if constexpr (Epi::AFTER_DRAIN) E.fused(acc, cur, wr, wc, fr, fq, lds);
#undef PG8_SA
#undef PG8_SB
#undef PG8_STAGE
#undef PG8_STAGEA
#undef PG8_LDA
#undef PG8_LDB
#undef PG8_MMA
#undef PG8_WAIT_V
#undef PG8_WAIT_L
#undef PG8_BAR
#undef PG8_SCHED
#undef PG8_OFFS
}

template <class Epi, class Sched>
__device__ __noinline__ void gemm_phase_ni(PG8_LAS unsigned char* lds, Gemm g, Sched S, Epi E) { gemm_phase<Epi, Sched>(lds, g, S, E, (int)threadIdx.x); }
}

namespace mk {
using namespace pg8;
constexpr int D = 1024, NB = 32, SEQ = 2048, T = NB * SEQ, LC = 256, TC = NB * LC, TT = T + TC;
constexpr int NMOD = 6 * D;
constexpr int NE = 64, NEX = 65, DE = 256;
constexpr int NCH = 2, CHT = T / NCH, BPC = 256 / NCH;
constexpr int MAXTILES = (CHT * 8 + 64 * 255) / 256 + CHT / 256 + 1, CHROWS = MAXTILES * 256;
constexpr float RMS_EPS = 1e-6f;
constexpr int NWAVES = 8, NTHR = 512;

constexpr size_t MiB = 1u << 20;
constexpr size_t WS_CTL = 0, CTL_ZERO_BYTES = 64 * 1024;
constexpr size_t WS_MOD = 1 * MiB;
constexpr size_t WS_ROPE = 3 * MiB;
constexpr size_t WS_BC = 3 * MiB + 65536;
constexpr size_t WS_GATES = 4 * MiB;
constexpr size_t WS_FILT = 10 * MiB;
constexpr size_t WS_EIDX = 18 * MiB, WS_WTS = 20 * MiB, WS_PSLOT = 22 * MiB, WS_SORT = 26 * MiB;
constexpr size_t WS_WIN0 = 30 * MiB;
constexpr size_t WS_WOUT0 = 38 * MiB, WS_WIN1 = 40 * MiB, WS_WOUT1 = 46 * MiB, WS_WR = 48 * MiB;
constexpr size_t WS_GU = 50 * MiB;
constexpr size_t WS_DN = 180 * MiB;
constexpr size_t WS_BIG = 246 * MiB;
constexpr size_t WS_END = 1024 * MiB;
static_assert(WS_PSLOT + (size_t)T * 16 * 4 <= WS_SORT && WS_SORT + (size_t)NCH * CHROWS * 4 <= WS_WIN0 && WS_WIN0 + (size_t)3840 * 2048 <= WS_WOUT0 && WS_WR + (size_t)2 * 256 * 2048 <= WS_GU && WS_GU + (size_t)2 * 65 * 512 * 2048 <= WS_DN && WS_DN + (size_t)2 * 65 * 1024 * 512 <= WS_BIG, "ws map");
constexpr size_t A0_H = 0, A0_QA = 144 * MiB, A0_KA = 208 * MiB, A0_VA = 280 * MiB, A0_BQ = 352 * MiB, A0_BK = 416 * MiB, A0_BV = 488 * MiB, A0_BO = 560 * MiB, A0_VT = 624 * MiB;
constexpr size_t A0_MIXIN = 0, A0_HB = 144 * MiB, A0_MIX = 352 * MiB;
constexpr int CW_BAR = 4096;

constexpr int LDS_BYTES = 160 * 1024;
constexpr int LDS_TAB = 131072;
constexpr int LDS_MISC = 131072 + 24 * 1024;

#define GAS __attribute__((address_space(1)))
#define LAS __attribute__((address_space(3)))
typedef unsigned short bf16;
typedef unsigned v4u __attribute__((ext_vector_type(4)));
typedef unsigned v2u __attribute__((ext_vector_type(2)));
#define LDS_WAIT() asm volatile("s_waitcnt lgkmcnt(0)" ::: "memory")
#define VM_WAIT() asm volatile("s_waitcnt vmcnt(0)" ::: "memory")
__device__ __forceinline__ unsigned f2bf(float f) { unsigned u = __builtin_bit_cast(unsigned, f); return (u + 0x7fffu + ((u >> 16) & 1u)) >> 16; }
__device__ __forceinline__ unsigned pk2(float lo, float hi) { return f2bf(lo) | (f2bf(hi) << 16); }
__device__ __forceinline__ float bf_lo(unsigned w) { return __builtin_bit_cast(float, w << 16); }
__device__ __forceinline__ float bf_hi(unsigned w) { return __builtin_bit_cast(float, w & 0xffff0000u); }
__device__ __forceinline__ float bf1(bf16 h) { return __builtin_bit_cast(float, (unsigned)h << 16); }
__device__ __forceinline__ int lane_opq() { int l = (int)__builtin_amdgcn_mbcnt_hi(~0u, __builtin_amdgcn_mbcnt_lo(~0u, 0u)); asm volatile("" : "+v"(l)); return l; }
__device__ __forceinline__ float shx(float v, int m) { return __builtin_bit_cast(float, __builtin_amdgcn_ds_bpermute((lane_opq() ^ m) << 2, __builtin_bit_cast(int, v))); }
__device__ __forceinline__ float shup(float v, int o) { const int l = lane_opq(); return __builtin_bit_cast(float, __builtin_amdgcn_ds_bpermute((l >= o ? l - o : l) << 2, __builtin_bit_cast(int, v))); }
__device__ __forceinline__ float shidx(float v, int idx) { return __builtin_bit_cast(float, __builtin_amdgcn_ds_bpermute(idx << 2, __builtin_bit_cast(int, v))); }
__device__ __forceinline__ float wave_sum(float v) {
#pragma unroll
    for (int o = 1; o < 64; o <<= 1) v += shx(v, o);
    return v;
}
__device__ __forceinline__ float wave_max(float v) {
#pragma unroll
    for (int o = 1; o < 64; o <<= 1) v = fmaxf(v, shx(v, o));
    return v;
}
__device__ __forceinline__ float sigmoidf_(float x) { return 1.f / (1.f + __expf(-x)); }
__device__ __forceinline__ float siluf_(float x) { return x / (1.f + __expf(-x)); }
#define XB_TMO      128
#define XB_XCNT(j)  (256  + 64 * (j))
#define XB_XSUB(j)  (1280 + 64 * (j))
#define XB_XGEN(j)  (2304 + 64 * (j))
#define XB_TOP      3328
#define XB_TOPGEN   3392
#define XCD_BAR_WORDS 3456
#define XB_SPIN_CAP (1u << 18)

__device__ __forceinline__ unsigned xb_ld(unsigned* p)              { return __hip_atomic_load(p, __ATOMIC_RELAXED, __HIP_MEMORY_SCOPE_AGENT); }
__device__ __forceinline__ unsigned xb_add(unsigned* p, unsigned v) { return __hip_atomic_fetch_add(p, v, __ATOMIC_RELAXED, __HIP_MEMORY_SCOPE_AGENT); }
__device__ __forceinline__ unsigned xb_xcc_id() { return (unsigned)__builtin_amdgcn_s_getreg((3 << 11) | 20) & 0xFu; }
#define XB_SPIN(cond, bar) do { unsigned _sp = 0; while (cond) { __builtin_amdgcn_s_sleep(1); \
    if ((++_sp & 255u) == 0u) { if (xb_ld(&(bar)[XB_TMO])) break; if (_sp > XB_SPIN_CAP) { atomicAdd(&(bar)[XB_TMO], 1u); break; } } } } while (0)

struct XcdBarrier {
    unsigned* bar; unsigned x;
    volatile LAS unsigned* st;
};

__device__ __forceinline__ XcdBarrier xcd_barrier_post(unsigned* bar, volatile LAS unsigned* st) {
    XcdBarrier b; b.bar = bar; b.x = xb_xcc_id(); b.st = st;
    if (threadIdx.x == 0) (void)xb_add(&bar[XB_XCNT(b.x)], 1u);
    return b;
}
__device__ __forceinline__ void xcd_barrier_complete(unsigned* bar, unsigned x, unsigned& nloc, unsigned& nx) {
    const unsigned G = gridDim.x * gridDim.y * gridDim.z;
    unsigned sum, cnt, mine, sp = 0u;
    for (;;) {
        sum = 0u; cnt = 0u; mine = 0u;
#pragma unroll
        for (unsigned j = 0; j < 16; ++j) { const unsigned c = xb_ld(&bar[XB_XCNT(j)]); sum += c; cnt += (c > 0u) ? 1u : 0u; mine = (j == x) ? c : mine; }
        if (sum == G) break;
        __builtin_amdgcn_s_sleep(1);
        if ((++sp & 255u) == 0u) { if (xb_ld(&bar[XB_TMO])) break; if (sp > XB_SPIN_CAP) { atomicAdd(&bar[XB_TMO], 1u); break; } }
    }
    nloc = mine > 0u ? mine : 1u; nx = cnt > 0u ? cnt : 1u;
}

__device__ __forceinline__ void xcd_barrier(const XcdBarrier& b, const bool t0  ) {
    asm volatile("s_waitcnt vmcnt(0)" ::: "memory");
    __syncthreads();
    if (t0) {
        unsigned* bar = b.bar;
        __builtin_amdgcn_s_waitcnt(0);
        unsigned nloc = b.st[0], nx = b.st[1];
        if (nloc == 0u) { xcd_barrier_complete(bar, b.x, nloc, nx); b.st[0] = nloc; b.st[1] = nx; }
        const unsigned old = xb_add(&bar[XB_XSUB(b.x)], 1u);
        const unsigned gen = old / nloc;
        if (old + 1u == (gen + 1u) * nloc) {
            __builtin_amdgcn_fence(__ATOMIC_RELEASE, "agent");
            asm volatile("s_waitcnt vmcnt(0)" ::: "memory");
            const unsigned og = xb_add(&bar[XB_TOP], 1u);
            const unsigned tg = og / nx;
            if (og + 1u == (tg + 1u) * nx) xb_add(&bar[XB_TOPGEN], 1u);
            else XB_SPIN(xb_ld(&bar[XB_TOPGEN]) == tg, bar);
            __builtin_amdgcn_fence(__ATOMIC_ACQUIRE, "agent");
            xb_add(&bar[XB_XGEN(b.x)], 1u);
            asm volatile("s_waitcnt vmcnt(0)" ::: "memory");
        } else {
            XB_SPIN(xb_ld(&bar[XB_XGEN(b.x)]) == gen, bar);
            __builtin_amdgcn_fence(__ATOMIC_ACQUIRE, "agent");
            asm volatile("s_waitcnt vmcnt(0)" ::: "memory");
        }
    }
    __syncthreads();
}

constexpr float Y8_SCALE = 16.f, Y8_INV = 1.f / 16.f;
struct Params { const float* in[31]; float* out; unsigned char* ws; int ph_lo, ph_hi; };
enum { I_X = 0, I_C, I_CTX, I_CCTX, I_WMOD, I_BMOD, I_NORMG, I_WINAB, I_CONVABW, I_CONVABB, I_GATEB, I_DLAM, I_HGA, I_HGB, I_WOUTAB, I_WINHY, I_CONVHYW, I_CONVHYB,
       I_FW1, I_FB1, I_FW2, I_FB2, I_FW3, I_FBIAS, I_WOUTHY, I_RW, I_RB, I_EGU, I_EDN, I_SGU, I_SDN };

__device__ __forceinline__ void row_ld_f32(const float* row, int lane, f32x4 (&v)[4]) { const f32x4* r = (const f32x4*)row + lane;
#pragma unroll
    for (int j = 0; j < 4; ++j) v[j] = r[64 * j]; }
__device__ __forceinline__ void row_st_f32(float* row, int lane, const f32x4 (&v)[4]) { f32x4* r = (f32x4*)row + lane;
#pragma unroll
    for (int j = 0; j < 4; ++j) r[64 * j] = v[j]; }
__device__ __forceinline__ void row_ld_bf16(const bf16* row, int lane, f32x4 (&v)[4]) { const v2u* r = (const v2u*)row + lane;
#pragma unroll
    for (int j = 0; j < 4; ++j) { const v2u w = r[64 * j]; v[j] = (f32x4){bf_lo(w.x), bf_hi(w.x), bf_lo(w.y), bf_hi(w.y)}; } }
__device__ __forceinline__ void row_st_bf16(bf16* row, int lane, const f32x4 (&v)[4]) { v2u* r = (v2u*)row + lane;
#pragma unroll
    for (int j = 0; j < 4; ++j) { v2u w; w.x = pk2(v[j].x, v[j].y); w.y = pk2(v[j].z, v[j].w); r[64 * j] = w; } }
__device__ __forceinline__ float row_ss(const f32x4 (&v)[4]) { float s = 0.f;
#pragma unroll
    for (int j = 0; j < 4; ++j) s += (v[j].x * v[j].x + v[j].y * v[j].y) + (v[j].z * v[j].z + v[j].w * v[j].w);
    return wave_sum(s); }
__device__ __forceinline__ void row_modulate(const f32x4 (&x)[4], float rstd, const float* g, const float* shift, const float* scale, int lane, f32x4 (&h)[4]) {
    const f32x4* gp = (const f32x4*)g + lane; const f32x4* sh = (const f32x4*)shift + lane; const f32x4* sc = (const f32x4*)scale + lane;
#pragma unroll
    for (int j = 0; j < 4; ++j) { const f32x4 gg = gp[64 * j], s1 = sc[64 * j], s0 = sh[64 * j]; h[j] = x[j] * rstd * gg * (1.f + s1) + s0; } }

__device__ __forceinline__ void pro_mod(const Params& p, LAS unsigned char* lds, int tid, int lane, int wave) {
    const int u = blockIdx.x; if (u >= 192) return;
    LAS float* S = (LAS float*)lds;
    const float* c = p.in[I_C]; const float* cc = p.in[I_CCTX];
#pragma unroll 1
    for (int i = tid; i < 33 * 1024; i += NTHR) { const int b = i >> 10, k = i & 1023; const float v = b < 32 ? c[b * 1024 + k] : cc[k]; S[i] = siluf_(v); }
    __syncthreads();
    const int l = u / 96, cg = (u % 96) * 64, col = cg + lane;
    const float* W = p.in[I_WMOD] + (size_t)l * 1024 * NMOD;
    float acc[33];
#pragma unroll
    for (int b = 0; b < 33; ++b) acc[b] = 0.f;
    const int k0 = wave * 128;
#pragma unroll 1
    for (int kk = 0; kk < 128; kk += 4) { const int k = k0 + kk;
        const float w0 = W[(size_t)k * NMOD + col], w1 = W[(size_t)(k + 1) * NMOD + col], w2 = W[(size_t)(k + 2) * NMOD + col], w3 = W[(size_t)(k + 3) * NMOD + col];
#pragma unroll
        for (int b = 0; b < 33; ++b) { const f32x4 s = *(const LAS f32x4*)(S + b * 1024 + k); acc[b] += (s.x * w0 + s.y * w1) + (s.z * w2 + s.w * w3); } }
    __syncthreads();
    LAS float* P = (LAS float*)lds;
#pragma unroll
    for (int b = 0; b < 33; ++b) P[(wave * 33 + b) * 64 + lane] = acc[b];
    __syncthreads();
    float* MOD = (float*)(p.ws + WS_MOD);
#pragma unroll 1
    for (int i = tid; i < 33 * 64; i += NTHR) { const int b = i >> 6, ln = i & 63; float s = 0.f;
#pragma unroll
        for (int w = 0; w < 8; ++w) s += P[(w * 33 + b) * 64 + ln];
        MOD[(size_t)(l * 33 + b) * NMOD + cg + ln] = s + p.in[I_BMOD][l * NMOD + cg + ln]; }
    __syncthreads();
}
__device__ __forceinline__ int rowmap(int kind, int n) {
    if (kind == 1) { const int o = n & 31; return (n & ~31) + (((o & 15) >> 2) * 8 + (o >> 4) * 4 + (o & 3)); }
    if (kind == 2) { return n < 256 ? ((n >> 7) * 256 + (n & 127)) : ((((n - 256) >> 7) * 256) + 128 + ((n - 256) & 127)); }
    if (kind == 3) { const int a = n & 255; return (n & ~255) + 128 * ((a >> 3) & 1) + 32 * (a >> 6) + 8 * ((a >> 4) & 3) + (a & 7); }
    return n;
}
struct TrDesc { const float* W; bf16* WT; int ldn, k0, n0, nvalid, dK, kind, row_base; };
__device__ __forceinline__ TrDesc tr_decode(const Params& p, int it) {
    constexpr int I_A = 16 * 113, I_B = 512, I_C2 = 1536, I_D = 512, I_E = 64, I_F = 130 * 256;
    unsigned char* ws = p.ws; int r = it;
    if (r < I_A) { const int kb = r / 113, nb = r % 113, n0 = nb * 32; const int kind = (n0 < 512 || (n0 >= 1536 && n0 < 2048)) ? 1 : 0;
        return TrDesc{p.in[I_WINAB], (bf16*)(ws + WS_WIN0), 3600, kb * 64, n0, 3600, 1024, kind, 0}; } r -= I_A;
    if (r < I_B) return TrDesc{p.in[I_WOUTAB], (bf16*)(ws + WS_WOUT0), 1024, (r / 32) * 64, (r % 32) * 32, 1024, 1024, 0, 0}; r -= I_B;
    if (r < I_C2) return TrDesc{p.in[I_WINHY], (bf16*)(ws + WS_WIN1), 3072, (r / 96) * 64, (r % 96) * 32, 3072, 1024, 0, 0}; r -= I_C2;
    if (r < I_D) return TrDesc{p.in[I_WOUTHY], (bf16*)(ws + WS_WOUT1), 1024, (r / 32) * 64, (r % 32) * 32, 1024, 1024, 0, 0}; r -= I_D;
    if (r < I_E) { const int l = r / 32, q = r % 32; return TrDesc{p.in[I_RW] + (size_t)l * 1024 * 64, (bf16*)(ws + WS_WR) + (size_t)l * 256 * 1024, 64, (q / 2) * 64, (q % 2) * 32, 64, 1024, 0, 0}; } r -= I_E;
    if (r < I_F) { const int mat = r / 256, q = r % 256, l = mat / 65, e = mat % 65;
        const float* src = e < 64 ? p.in[I_EGU] + (size_t)(l * 64 + e) * 1024 * 512 : p.in[I_SGU] + (size_t)l * 1024 * 512;
        return TrDesc{src, (bf16*)(ws + WS_GU) + (size_t)l * (65 * 512) * 1024, 512, (q / 16) * 64, (q % 16) * 32, 512, 1024, 2, e * 512}; } r -= I_F;
    { const int mat = r / 128, q = r % 128, l = mat / 65, e = mat % 65;
        const float* src = e < 64 ? p.in[I_EDN] + (size_t)(l * 64 + e) * 256 * 1024 : p.in[I_SDN] + (size_t)l * 256 * 1024;
        return TrDesc{src, (bf16*)(ws + WS_DN) + (size_t)l * (65 * 1024) * 256, 1024, (q / 32) * 64, (q % 32) * 32, 1024, 256, 3, e * 1024}; }
}
__device__ __forceinline__ void tr_load(const TrDesc& d, int lane, float (&v)[32]) {
    const int nn = d.n0 + (lane & 31); const bool ok = nn < d.nvalid; const float* src = d.W + (size_t)(d.k0 + (lane >> 5)) * d.ldn + (ok ? nn : 0);
#pragma unroll
    for (int i = 0; i < 32; ++i) v[i] = src[(size_t)(2 * i) * d.ldn];
    if (!ok) {
#pragma unroll
        for (int i = 0; i < 32; ++i) v[i] = 0.f; }
}
__device__ __forceinline__ void tr_finish(const TrDesc& d, const float (&v)[32], LAS float* scr, int lane) {
#pragma unroll
    for (int i = 0; i < 32; ++i) scr[(2 * i + (lane >> 5)) * 33 + (lane & 31)] = v[i];
    LDS_WAIT(); asm volatile("" ::: "memory");
    const int c = lane & 7;
#pragma unroll
    for (int j = 0; j < 4; ++j) { const int n = (lane >> 3) + 8 * j; const LAS float* s = scr + (8 * c) * 33 + n;
        v4u o; o.x = pk2(s[0 * 33], s[1 * 33]); o.y = pk2(s[2 * 33], s[3 * 33]); o.z = pk2(s[4 * 33], s[5 * 33]); o.w = pk2(s[6 * 33], s[7 * 33]);
        const int row = d.row_base + rowmap(d.kind, d.n0 + n);
        *(v4u*)(d.WT + (size_t)row * d.dK + d.k0 + 8 * c) = o; }
    LDS_WAIT(); asm volatile("" ::: "memory");
}
__device__ __forceinline__ void pro_transposes(const Params& p, LAS unsigned char* lds, int lane, int wave) {
    LAS float* scr = (LAS float*)(lds + wave * 16384);
    const int gw = blockIdx.x * NWAVES + wave, NGW = gridDim.x * NWAVES;
    constexpr int NITEMS = 16 * 113 + 512 + 1536 + 512 + 64 + 130 * 256 + 130 * 128;
    if (gw >= NITEMS) return;
    TrDesc dc = tr_decode(p, gw); float vc[32]; tr_load(dc, lane, vc);
#pragma unroll 1
    for (int it = gw; it < NITEMS; it += NGW) {
        const bool more = it + NGW < NITEMS; TrDesc dn = dc; float vn[32];
        if (more) { dn = tr_decode(p, it + NGW); tr_load(dn, lane, vn); }
        tr_finish(dc, vc, scr, lane);
        if (more) { dc = dn;
#pragma unroll
            for (int i = 0; i < 32; ++i) vc[i] = vn[i]; }
    }
}
__device__ __forceinline__ void pro_rope(const Params& p, int tid) {
    if (blockIdx.x != 255) return;
    float* R = (float*)(p.ws + WS_ROPE);
    for (int i = tid; i < 64 * 16; i += NTHR) { const int pos = i >> 4, f = i & 15; const float inv = exp2f(-(float)f * (13.287712379549449f / 16.f)); const float ang = (float)pos * inv;
        float sn, cs; sincosf(ang, &sn, &cs); R[2 * i] = cs; R[2 * i + 1] = sn; }
}
__device__ __forceinline__ void pro_filters(const Params& p, LAS unsigned char* lds, int tid, int lane, int wave) {
    LAS float* Z = (LAS float*)lds;
    LAS float* H1 = Z + 512;
    LAS float* H2 = H1 + 512;
    const int j0 = 8 * blockIdx.x, j = j0 + wave;
    const float* fw1 = p.in[I_FW1]; const float* fb1 = p.in[I_FB1]; const float* fw2 = p.in[I_FW2]; const float* fb2 = p.in[I_FB2]; const float* fw3 = p.in[I_FW3];
    {   float z = 0.f;
        if (lane == 0) z = (float)j / 2047.f;
        else if (lane < 33) { const int k = (lane - 1) & 15; const float fr = 1e-4f + (float)k * ((15.f - 1e-4f) / 15.f); const float ang = (6.283185307179586f / 2048.f) * (float)j * fr;
            float sn, cs; sincosf(ang, &sn, &cs); z = lane < 17 ? cs : -sn; }
        Z[wave * 64 + lane] = z; }
    LDS_WAIT(); asm volatile("" ::: "memory");
    {   float a = fb1[lane];
#pragma unroll 1
        for (int k = 0; k < 33; ++k) a += Z[wave * 64 + k] * fw1[k * 64 + lane];
        H1[wave * 64 + lane] = sinf(a); }
    LDS_WAIT(); asm volatile("" ::: "memory");
    {   float a = fb2[lane];
#pragma unroll 1
        for (int k = 0; k < 64; ++k) a += H1[wave * 64 + k] * fw2[k * 64 + lane];
        H2[wave * 64 + lane] = sinf(a); }
    __syncthreads();
    bf16* F = (bf16*)(p.ws + WS_FILT);
    const float mind = -4.605170185988091f / 1.5f, maxd = -4.605170185988091f / 0.3f;
#pragma unroll 1
    for (int i = 0; i < 4; ++i) { const int n = tid + NTHR * i, c = n & 1023;
        float acc[8];
#pragma unroll
        for (int q = 0; q < 8; ++q) acc[q] = 0.f;
#pragma unroll 2
        for (int k = 0; k < 64; ++k) { const float w = fw3[k * 2048 + n];
#pragma unroll
            for (int q = 0; q < 8; ++q) acc[q] += H2[q * 64 + k] * w; }
        const float delta = fabsf(mind + (float)c * ((maxd - mind) / 1023.f));
        float o[8];
#pragma unroll
        for (int q = 0; q < 8; ++q) { const float dist = fabsf((float)(j0 + q) - 1024.f) * (1.f / 1024.f); o[q] = acc[q] * expf(-dist * delta); }
        v4u w; w.x = pk2(o[0], o[1]); w.y = pk2(o[2], o[3]); w.z = pk2(o[4], o[5]); w.w = pk2(o[6], o[7]);
        *(v4u*)(F + (size_t)n * 2048 + j0) = w; }
    __syncthreads();
}

__device__ __forceinline__ void ph_l0_norm(const Params& p, int lane, int wave) {
    const int gw = blockIdx.x * NWAVES + wave, NGW = gridDim.x * NWAVES;
    const float* MOD = (const float*)(p.ws + WS_MOD); bf16* H = (bf16*)(p.ws + WS_BIG + A0_H);
    const float* g = p.in[I_NORMG];
    for (int m = gw; m < TT; m += NGW) {
        const float* src; int bi;
        if (m < T) { src = p.in[I_X] + (size_t)m * D; bi = m >> 11; } else { src = p.in[I_CTX] + (size_t)(m - T) * D; bi = 32; }
        f32x4 x[4], h[4]; row_ld_f32(src, lane, x);
        const float rstd = rsqrtf(row_ss(x) * (1.f / D) + RMS_EPS);
        const float* md = MOD + (size_t)bi * NMOD;
        row_modulate(x, rstd, g, md, md + D, lane, h);
        row_st_bf16(H + (size_t)m * D, lane, h);
    }
}
__device__ __forceinline__ void ph_mid(const Params& p, int l, const bf16* MIX, bf16* H2, bool has_mix, int lane, int wave) {
    const int gw = blockIdx.x * NWAVES + wave, NGW = gridDim.x * NWAVES;
    const float* MOD = (const float*)(p.ws + WS_MOD) + (size_t)l * 33 * NMOD;
    const float* g1 = p.in[I_NORMG] + (size_t)(l * 4 + 1) * D; const float* g2 = p.in[I_NORMG] + (size_t)(l * 4 + 2) * D;
    const float* xin = l == 0 ? p.in[I_X] : p.out;
    f32x4 xn[4], mn[4];
    if (gw < T) { row_ld_f32(xin + (size_t)gw * D, lane, xn); if (has_mix) row_ld_bf16(MIX + (size_t)gw * D, lane, mn); }
#pragma unroll 1
    for (int m = gw; m < T; m += NGW) {
        const float* md = MOD + (size_t)(m >> 11) * NMOD;
        f32x4 x[4], h[4];
#pragma unroll
        for (int j = 0; j < 4; ++j) x[j] = xn[j];
        f32x4 mx[4];
#pragma unroll
        for (int j = 0; j < 4; ++j) mx[j] = mn[j];
        if (m + NGW < T) { row_ld_f32(xin + (size_t)(m + NGW) * D, lane, xn); if (has_mix) row_ld_bf16(MIX + (size_t)(m + NGW) * D, lane, mn); }
        if (has_mix) {
            const float r = rsqrtf(row_ss(mx) * (1.f / D) + RMS_EPS);
            const f32x4* gp = (const f32x4*)g1 + lane; const f32x4* gm = (const f32x4*)(md + 2 * D) + lane;
#pragma unroll
            for (int j = 0; j < 4; ++j) x[j] = x[j] + gm[64 * j] * (mx[j] * r * gp[64 * j]); }
        row_st_f32(p.out + (size_t)m * D, lane, x);
        const float rstd = rsqrtf(row_ss(x) * (1.f / D) + RMS_EPS);
        row_modulate(x, rstd, g2, md + 3 * D, md + 4 * D, lane, h);
        row_st_bf16(H2 + (size_t)m * D, lane, h);
    }
}
__device__ __forceinline__ void ph_combine(const Params& p, int l, int ch, const unsigned char* Y8, bf16* Hn, int lane, int wave) {
    const int gw = blockIdx.x * NWAVES + wave, NGW = gridDim.x * NWAVES;
    const float* MOD = (const float*)(p.ws + WS_MOD) + (size_t)l * 33 * NMOD;
    const float* g3 = p.in[I_NORMG] + (size_t)(l * 4 + 3) * D;
    const int* PSLOT = (const int*)(p.ws + WS_PSLOT); const float* WTS = (const float*)(p.ws + WS_WTS);
    int sl[9]; float wk[9];
#define CMB_SLOTS(mt) do { _Pragma("unroll") for (int k = 0; k < 9; ++k) { sl[k] = PSLOT[(size_t)(mt) * 16 + k]; wk[k] = k < 8 ? WTS[(size_t)(mt) * 8 + k] : 1.f; } } while (0)
    if (gw < CHT) CMB_SLOTS(ch * CHT + gw);
#pragma unroll 1
    for (int mm = gw; mm < CHT; mm += NGW) { const int m = ch * CHT + mm;
        const float* md = MOD + (size_t)(m >> 11) * NMOD;
        float a[16];
#pragma unroll
        for (int j = 0; j < 16; ++j) a[j] = 0.f;
        u32x4 yr[9]; float wc[9];
#pragma unroll
        for (int k = 0; k < 9; ++k) { yr[k] = *(const u32x4*)(Y8 + (size_t)sl[k] * 1024 + lane * 16); wc[k] = wk[k]; }
        float* orow = p.out + (size_t)m * D + lane * 16; f32x4 xv4[4];
#pragma unroll
        for (int q = 0; q < 4; ++q) xv4[q] = *(const f32x4*)(orow + 4 * q);
        if (mm + NGW < CHT) CMB_SLOTS(m + NGW);
#pragma unroll
        for (int k = 0; k < 9; ++k) { const float w = wc[k] * Y8_INV; const unsigned ww[4] = {yr[k].x, yr[k].y, yr[k].z, yr[k].w};
#pragma unroll
            for (int q = 0; q < 4; ++q) { a[4 * q + 0] += w * __builtin_amdgcn_cvt_f32_fp8((int)ww[q], 0); a[4 * q + 1] += w * __builtin_amdgcn_cvt_f32_fp8((int)ww[q], 1);
                                          a[4 * q + 2] += w * __builtin_amdgcn_cvt_f32_fp8((int)ww[q], 2); a[4 * q + 3] += w * __builtin_amdgcn_cvt_f32_fp8((int)ww[q], 3); } }
        float ss = 0.f;
#pragma unroll
        for (int j = 0; j < 16; ++j) ss += a[j] * a[j];
        const float r = rsqrtf(wave_sum(ss) * (1.f / D) + RMS_EPS);
        float x[16]; float s2 = 0.f;
#pragma unroll
        for (int q = 0; q < 4; ++q) { const f32x4 xv = xv4[q], gp = *(const f32x4*)(g3 + lane * 16 + 4 * q), gf = *(const f32x4*)(md + 5 * D + lane * 16 + 4 * q);
#pragma unroll
            for (int j = 0; j < 4; ++j) { const float v = xv[j] + gf[j] * (a[4 * q + j] * r * gp[j]); x[4 * q + j] = v; s2 += v * v; }
            *(f32x4*)(orow + 4 * q) = (f32x4){x[4 * q], x[4 * q + 1], x[4 * q + 2], x[4 * q + 3]}; }
        if (l == 0) { const float* md1 = MOD + (size_t)(33 + (m >> 11)) * NMOD; const float* g10 = p.in[I_NORMG] + (size_t)4 * D;
            const float rstd = rsqrtf(wave_sum(s2) * (1.f / D) + RMS_EPS); float h[16];
#pragma unroll
            for (int q = 0; q < 4; ++q) { const f32x4 gg = *(const f32x4*)(g10 + lane * 16 + 4 * q), sh = *(const f32x4*)(md1 + lane * 16 + 4 * q), sc = *(const f32x4*)(md1 + D + lane * 16 + 4 * q);
#pragma unroll
                for (int j = 0; j < 4; ++j) h[4 * q + j] = x[4 * q + j] * rstd * gg[j] * (1.f + sc[j]) + sh[j]; }
            v4u w0, w1; w0.x = pk2(h[0], h[1]); w0.y = pk2(h[2], h[3]); w0.z = pk2(h[4], h[5]); w0.w = pk2(h[6], h[7]); w1.x = pk2(h[8], h[9]); w1.y = pk2(h[10], h[11]); w1.z = pk2(h[12], h[13]); w1.w = pk2(h[14], h[15]);
            *(v4u*)(Hn + (size_t)m * D + lane * 16) = w0; *(v4u*)(Hn + (size_t)m * D + lane * 16 + 8) = w1; }
    }
#undef CMB_SLOTS
}

struct DenseSched { int NN, NU, G, c, NMs;
    __device__ __forceinline__ bool next(int i, Unit& u) const { const int L = i * G + c; if (L >= NU) return false; if (NMs > 0) { u.pm = L % NMs; u.pn = L / NMs; } else { u.pm = L / NN; u.pn = L % NN; } return true; }
    __device__ __forceinline__ int arow(int r) const { return r; } };
struct EpiBf16 { static constexpr bool PERM = true, AFTER_DRAIN = false; bf16* O; size_t ldc; int cmask;
    __device__ __forceinline__ void operator()(const f32x4 (&acc)[2][2][4][2], const Unit& u, int wr, int wc, int fr, int fq) const {
        const int row0 = u.pm * BM + wr * 64 + fr, col0 = (u.pn & cmask) * BM + wc * 32 + 8 * fq;
#pragma unroll
        for (int ai = 0; ai < 2; ++ai)
#pragma unroll
            for (int m = 0; m < 4; ++m) { bf16* rowp = O + (size_t)(row0 + ai * HALF + m * 16) * ldc + col0;
#pragma unroll
                for (int bj = 0; bj < 2; ++bj) { const f32x4 v0 = acc[ai][bj][m][0], v1 = acc[ai][bj][m][1];
                    u32x4 w; w.x = cvt_pk_bf16(v0[0], v0[1]); w.y = cvt_pk_bf16(v0[2], v0[3]); w.z = cvt_pk_bf16(v1[0], v1[1]); w.w = cvt_pk_bf16(v1[2], v1[3]);
                    *(u32x4*)(rowp + bj * HALF) = w; } }
    } };
struct EpiRouter { static constexpr bool PERM = false, AFTER_DRAIN = false; float* LOG;
    __device__ __forceinline__ void operator()(const f32x4 (&acc)[2][2][4][2], const Unit& u, int wr, int wc, int fr, int fq) const {
        if (wc >= 2) return;
        const int row0 = u.pm * BM + wr * 64 + fr, col0 = wc * 32 + 4 * fq;
#pragma unroll
        for (int ai = 0; ai < 2; ++ai)
#pragma unroll
            for (int m = 0; m < 4; ++m) { float* rowp = LOG + (size_t)(row0 + ai * HALF + m * 16) * 64 + col0;
#pragma unroll
                for (int n = 0; n < 2; ++n) *(f32x4*)(rowp + n * 16) = acc[ai][0][m][n]; }
    } };
struct EpiFp8 { static constexpr bool PERM = true, AFTER_DRAIN = false; unsigned char* O;
    __device__ __forceinline__ void operator()(const f32x4 (&acc)[2][2][4][2], const Unit& u, int wr, int wc, int fr, int fq) const {
        const int row0 = u.pm * BM + wr * 64 + fr, col0 = (u.pn & 3) * BM + wc * 64 + 16 * fq;
#pragma unroll
        for (int ai = 0; ai < 2; ++ai)
#pragma unroll
            for (int m = 0; m < 4; ++m) { unsigned char* rowp = O + (size_t)(row0 + ai * HALF + m * 16) * 1024 + col0; u32x4 w;
#pragma unroll
                for (int bj = 0; bj < 2; ++bj) { const f32x4 v0 = acc[ai][bj][m][0] * Y8_SCALE, v1 = acc[ai][bj][m][1] * Y8_SCALE; int lo = 0, hi = 0;
                    lo = __builtin_amdgcn_cvt_pk_fp8_f32(v0[0], v0[1], lo, false); lo = __builtin_amdgcn_cvt_pk_fp8_f32(v0[2], v0[3], lo, true);
                    hi = __builtin_amdgcn_cvt_pk_fp8_f32(v1[0], v1[1], hi, false); hi = __builtin_amdgcn_cvt_pk_fp8_f32(v1[2], v1[3], hi, true);
                    if (bj == 0) { w.x = (unsigned)lo; w.y = (unsigned)hi; } else { w.z = (unsigned)lo; w.w = (unsigned)hi; } }
                *(u32x4*)rowp = w; }
    } };
struct EpiRouterLds { static constexpr bool PERM = false, AFTER_DRAIN = true;
    __device__ __forceinline__ void operator()(const f32x4 (&)[2][2][4][2], const Unit&, int, int, int, int) const {}
    __device__ __forceinline__ void fused(const f32x4 (&acc)[2][2][4][2], const Unit&, int wr, int wc, int fr, int fq, LAS unsigned char* lds) const {
        if (wc >= 2) return;
        LAS float* SC = (LAS float*)lds;
#pragma unroll
        for (int ai = 0; ai < 2; ++ai)
#pragma unroll
            for (int m = 0; m < 4; ++m) { const int row = ai * HALF + wr * 64 + m * 16 + fr;
#pragma unroll
                for (int n = 0; n < 2; ++n)
#pragma unroll
                    for (int j = 0; j < 4; ++j) SC[row * 65 + wc * 32 + n * 16 + 4 * fq + j] = sigmoidf_(acc[ai][0][m][n][j]); }
    } };
struct MoeSched { const LAS int* te; const int* sort; int NU, G, c, sh, per;
    __device__ __forceinline__ bool next(int i, Unit& u) const { const int L = i * G + c; if (L >= NU) return false; const int tile = L >> sh; u.pm = tile; u.pn = te[tile] * per + (L & (per - 1)); return true; }
    __device__ __forceinline__ int arow(int r) const { return sort ? sort[r] : r; } };
struct EpiSwiglu { static constexpr bool PERM = true, AFTER_DRAIN = false; bf16* ACT;
    __device__ __forceinline__ void operator()(const f32x4 (&acc)[2][2][4][2], const Unit& u, int wr, int wc, int fr, int fq) const {
        const int row0 = u.pm * BM + wr * 64 + fr, col0 = (u.pn & 1) * 128 + wc * 32 + 8 * fq;
#pragma unroll
        for (int ai = 0; ai < 2; ++ai)
#pragma unroll
            for (int m = 0; m < 4; ++m) { bf16* rowp = ACT + (size_t)(row0 + ai * HALF + m * 16) * DE + col0;
                const f32x4 g0 = acc[ai][0][m][0], g1 = acc[ai][0][m][1], u0 = acc[ai][1][m][0], u1 = acc[ai][1][m][1];
                float o[8];
#pragma unroll
                for (int q = 0; q < 4; ++q) { o[q] = siluf_(g0[q]) * u0[q]; o[4 + q] = siluf_(g1[q]) * u1[q]; }
                u32x4 w; w.x = cvt_pk_bf16(o[0], o[1]); w.y = cvt_pk_bf16(o[2], o[3]); w.z = cvt_pk_bf16(o[4], o[5]); w.w = cvt_pk_bf16(o[6], o[7]);
                *(u32x4*)rowp = w; }
    } };
__device__ __forceinline__ int moe_tables(const Params& p, int ch, LAS unsigned char* lds, int tid) {
    LAS int* TE = (LAS int*)(lds + LDS_TAB);
    LAS int* TB = TE + MAXTILES;
    LAS int* CN = TB + 80;
    const int* BC = (const int*)(p.ws + WS_BC) + (size_t)ch * BPC * 64;
    __syncthreads();
    if (tid < 64) CN[tid] = 0;
    __syncthreads();
#pragma unroll 1
    for (int i = tid; i < BPC * 64; i += NTHR) __hip_atomic_fetch_add(&CN[i & 63], BC[i], __ATOMIC_RELAXED, __HIP_MEMORY_SCOPE_WORKGROUP);
    __syncthreads();
    if (tid == 0) { int b = 0;
#pragma unroll 1
        for (int e = 0; e < 64; ++e) { TB[e] = b; b += (CN[e] + 255) >> 8; } TB[64] = b; TB[65] = b + CHT / 256; }
    __syncthreads();
    const int NT = TB[65];
#pragma unroll 1
    for (int i = tid; i < NT; i += NTHR) { int e = 0;
#pragma unroll 1
        while (e < 64 && i >= TB[e + 1]) ++e;
        TE[i] = e; }
    __syncthreads();
    return NT;
}

__device__ __forceinline__ void ph_route_a(const Params& p, int l, const float* LOG, int tile, LAS unsigned char* lds, int tid) {
    LAS float* SC = (LAS float*)lds;
    LAS float* RBs = (LAS float*)(lds + 68 * 1024);
    LAS unsigned* MASK = (LAS unsigned*)(lds + 69 * 1024);
    const int b = tile, tok0 = 256 * b;
    if (LOG)
#pragma unroll 1
    for (int i = tid; i < 256 * 64; i += NTHR) { const int t = i >> 6, e = i & 63; SC[t * 65 + e] = sigmoidf_(LOG[(size_t)(tok0 + t) * 64 + e]); }
    if (tid < 64) RBs[tid] = p.in[I_RB][l * 64 + tid];
    MASK[tid] = 0u;
    __syncthreads();
    int eidx[8]; float wts[8];
    if (tid < 256) { const int t = tid; const LAS float* sc = SC + t * 65;
        float gs[8];
#pragma unroll
        for (int g = 0; g < 8; ++g) { float m1 = -3.0e38f, m2 = -3.0e38f;
#pragma unroll
            for (int j = 0; j < 8; ++j) { const float v = sc[8 * g + j] + RBs[8 * g + j]; if (v > m1) { m2 = m1; m1 = v; } else if (v > m2) m2 = v; }
            gs[g] = m1 + m2; }
        unsigned gmask = 0u;
#pragma unroll
        for (int r = 0; r < 4; ++r) { float best = -3.0e38f; int bi = 0; bool found = false;
#pragma unroll
            for (int g = 0; g < 8; ++g) { const bool free_ = ((gmask >> g) & 1u) == 0u; if (free_ && (!found || gs[g] > best)) { best = gs[g]; bi = g; found = true; } }
            gmask |= 1u << bi; }
        unsigned long long taken = 0ull; float ssum = 0.f;
#pragma unroll
        for (int k = 0; k < 8; ++k) { float best = -3.0e38f; int be = -1;
#pragma unroll 1
            for (int e = 0; e < 64; ++e) { const bool ok = ((gmask >> (e >> 3)) & 1u) && !((taken >> e) & 1ull); const float v = sc[e] + RBs[e]; if (ok && (be < 0 || v > best)) { best = v; be = e; } }
            taken |= 1ull << be; eidx[k] = be; wts[k] = sc[be]; ssum += wts[k]; }
        const float inv = 2.5f / ssum;
#pragma unroll
        for (int k = 0; k < 8; ++k) { wts[k] *= inv; __hip_atomic_fetch_or(&MASK[eidx[k] * 8 + (t >> 5)], 1u << (t & 31), __ATOMIC_RELAXED, __HIP_MEMORY_SCOPE_WORKGROUP); }
    }
    __syncthreads();
    if (tid < 256) { const int t = tid; int* EIDX = (int*)(p.ws + WS_EIDX); float* WTS = (float*)(p.ws + WS_WTS);
#pragma unroll
        for (int k = 0; k < 8; ++k) { const int e = eidx[k]; int r = 0;
#pragma unroll 1
            for (int w = 0; w < (t >> 5); ++w) r += __popc(MASK[e * 8 + w]);
            r += __popc(MASK[e * 8 + (t >> 5)] & ((1u << (t & 31)) - 1u));
            EIDX[(size_t)(tok0 + t) * 8 + k] = e | (r << 8); WTS[(size_t)(tok0 + t) * 8 + k] = wts[k]; } }
    if (tid < 64) { int c = 0;
#pragma unroll
        for (int w = 0; w < 8; ++w) c += __popc(MASK[tid * 8 + w]);
        ((int*)(p.ws + WS_BC))[b * 64 + tid] = c; }
    __syncthreads();
}
__device__ __forceinline__ void ph_route_b(const Params& p, LAS unsigned char* lds, int tid) {
    LAS int* BCS = (LAS int*)lds;
    LAS int* CNT = BCS + BPC * 64; LAS int* PRE = CNT + 64; LAS int* SEG = PRE + 64;
    const int b = blockIdx.x, ch = b / BPC, bl = b % BPC;
    const int* BC = (const int*)(p.ws + WS_BC) + (size_t)ch * BPC * 64;
#pragma unroll 1
    for (int i = tid; i < BPC * 64; i += NTHR) BCS[i] = BC[i];
    __syncthreads();
    if (tid < 64) { int c = 0, pr = 0;
#pragma unroll 1
        for (int i = 0; i < BPC; ++i) { const int v = BCS[i * 64 + tid]; c += v; if (i < bl) pr += v; } CNT[tid] = c; PRE[tid] = pr; }
    __syncthreads();
    if (tid == 0) { int base = 0;
#pragma unroll 1
        for (int e = 0; e < 64; ++e) { SEG[e] = base; base += ((CNT[e] + 255) >> 8) << 8; } SEG[64] = base; }
    __syncthreads();
    int* SORT = (int*)(p.ws + WS_SORT) + (size_t)ch * CHROWS; int* PSLOT = (int*)(p.ws + WS_PSLOT); const int* EIDX = (const int*)(p.ws + WS_EIDX);
    if (tid < 256) { const int tok = 256 * b + tid;
#pragma unroll
        for (int k = 0; k < 8; ++k) { const int w = EIDX[(size_t)tok * 8 + k], e = w & 255, r = w >> 8; const int slot = SEG[e] + PRE[e] + r; SORT[slot] = tok; PSLOT[(size_t)tok * 16 + k] = slot; }
        const int s8 = SEG[64] + (tok - ch * CHT); SORT[s8] = tok; PSLOT[(size_t)tok * 16 + 8] = s8; }
    if (bl < 64) { const int e = bl, lo = SEG[e] + CNT[e], hi = SEG[e] + (((CNT[e] + 255) >> 8) << 8); for (int s = lo + tid; s < hi; s += NTHR) SORT[s] = ch * CHT; }
    __syncthreads();
}

typedef float f32x16 __attribute__((ext_vector_type(16)));
__device__ __forceinline__ void ph_sconv(const Params& p, const bf16* UT, bf16* UC, int tid) {
    const float* cw = p.in[I_CONVHYW]; const float* cbias = p.in[I_CONVHYB];
    const unsigned NIT = 3072u * 32u * 256u; const unsigned gt = blockIdx.x * NTHR + tid, NG = gridDim.x * NTHR;
#pragma unroll 1
    for (unsigned it = gt; it < NIT; it += NG) {
        const unsigned c = it >> 13, k = it & 255u; const size_t base = (size_t)it * 8;
        const v4u w = *(const v4u*)(UT + base);
        const float w0 = cw[c], w1 = cw[3072 + c], w2 = cw[6144 + c], bb = cbias[c];
        float x[10];
        x[0] = k > 0 ? bf1(UT[base - 1]) : 0.f; x[9] = k < 255 ? bf1(UT[base + 8]) : 0.f;
        x[1] = bf_lo(w.x); x[2] = bf_hi(w.x); x[3] = bf_lo(w.y); x[4] = bf_hi(w.y); x[5] = bf_lo(w.z); x[6] = bf_hi(w.z); x[7] = bf_lo(w.w); x[8] = bf_hi(w.w);
        float o[8];
#pragma unroll
        for (int j = 0; j < 8; ++j) o[j] = bb + w0 * x[j] + w1 * x[j + 1] + w2 * x[j + 2];
        v4u r; r.x = pk2(o[0], o[1]); r.y = pk2(o[2], o[3]); r.z = pk2(o[4], o[5]); r.w = pk2(o[6], o[7]);
        *(v4u*)(UC + base) = r;
    }
}
constexpr int LC_CPB = 8224, LC_RAW = 8 * LC_CPB, LC_RAWSZ = 32 * 512, LC_HALO = LC_RAW + 2 * LC_RAWSZ, LC_VBP = 528, LC_VB0 = LC_HALO + 2 * 8192, LC_VBSZ = 32 * LC_VBP;
static_assert(LC_VB0 + 2 * LC_VBSZ <= LDS_MISC && 8 * 32 * 528 <= LDS_MISC, "lconv LDS map");
struct Taps { float w0, w1, w2, b; };
__device__ __forceinline__ float bfh(unsigned w, int hi) { return hi ? bf_hi(w) : bf_lo(w); }
template <bool CONVIN>
__device__ __forceinline__ void lconv_unit(const bf16* vin, const Taps ti, const bf16* F, const bf16* graw, const Taps tg, float fb, bf16* out, LAS unsigned char* lds, int tid, int lane, int wave) {
    __syncthreads();
#define LC_DMA(ch, rb) do { _Pragma("unroll") for (int q = 0; q < 2; ++q) { const int row = wave * 4 + 2 * q + (ln >> 5); \
        __builtin_amdgcn_global_load_lds((const unsigned*)(vin + (size_t)row * 2048 + (ch) * 256 + (ln & 31) * 8), (LAS unsigned*)(lds + LC_RAW + (rb) * LC_RAWSZ + (wave * 4 + 2 * q) * 512), 16, 0, 0); } \
        { const int hrow = wave * 4 + ((ln & 7) >> 1); int hs = (ln & 1) ? (ch) * 256 + 256 : (ch) * 256 - 8; hs = hs < 0 ? 0 : (hs > 2040 ? 2040 : hs); \
          __builtin_amdgcn_global_load_lds((const unsigned*)(vin + (size_t)hrow * 2048 + hs), (LAS unsigned*)(lds + LC_HALO + (rb) * 8192 + wave * 1024), 16, 0, 0); } } while (0)
    LAS bf16* Fl = (LAS bf16*)(lds + LC_VB0 + LC_VBSZ);
    { int ln = lane; asm volatile("" : "+v"(ln)); LC_DMA(0, 0); LC_DMA(1, 1); }
    if (tid < 256) *(LAS v4u*)(Fl + tid * 8) = *(const v4u*)(F + tid * 8);
    __syncthreads();
    if (tid == 0) Fl[1024] = (bf16)f2bf(bf1(Fl[1024]) + fb);
    __syncthreads();
#pragma unroll 1
    for (int a = 0; a < 8; ++a)
#pragma unroll 1
        for (int mi = tid; mi < 2056; mi += NTHR) { const int m = mi * 2; const int x0 = 3079 - m - a, x1 = x0 - 1;
            const unsigned lo = (x0 >= 0 && x0 <= 2047) ? (unsigned)Fl[x0] : 0u, hi = (x1 >= 0 && x1 <= 2047) ? (unsigned)Fl[x1] : 0u;
            *(LAS unsigned*)(lds + a * LC_CPB + m * 2) = lo | (hi << 16); }
    const int r = lane & 31, h = lane >> 5, a = (7 - r) & 7;
    const LAS unsigned char* cpA = lds + a * LC_CPB + 2 * (1023 - r + 8 * h - a + 1032) - 512 * wave;
    const int laneB = r * LC_VBP + 16 * h;
#define LC_CONVERT(ch, rb, buf) do { _Pragma("unroll") for (int q = 0; q < 2; ++q) { const int pid = ln + 64 * q, row = wave * 4 + (pid >> 5), pp = pid & 31; const LAS unsigned char* rp = lds + LC_RAW + (rb) * LC_RAWSZ + row * 512 + pp * 16; \
        const v4u w = *(const LAS v4u*)rp; v4u o = w; \
        if (CONVIN) { const LAS unsigned char* hp_ = lds + LC_HALO + (rb) * 8192 + wave * 1024 + (pid >> 5) * 32; float x[10]; \
            x[0] = pp > 0 ? bf1(*(const LAS bf16*)(rp - 2)) : ((ch) > 0 ? bf1(*(const LAS bf16*)(hp_ + 14)) : 0.f); x[9] = pp < 31 ? bf1(*(const LAS bf16*)(rp + 16)) : ((ch) < 7 ? bf1(*(const LAS bf16*)(hp_ + 16)) : 0.f); \
            x[1] = bf_lo(w.x); x[2] = bf_hi(w.x); x[3] = bf_lo(w.y); x[4] = bf_hi(w.y); x[5] = bf_lo(w.z); x[6] = bf_hi(w.z); x[7] = bf_lo(w.w); x[8] = bf_hi(w.w); \
            float y[8]; _Pragma("unroll") for (int j = 0; j < 8; ++j) y[j] = ti.b + ti.w0 * x[j] + ti.w1 * x[j + 1] + ti.w2 * x[j + 2]; \
            o.x = pk2(y[0], y[1]); o.y = pk2(y[2], y[3]); o.z = pk2(y[4], y[5]); o.w = pk2(y[6], y[7]); } \
        *(LAS v4u*)(lds + LC_VB0 + (buf) * LC_VBSZ + row * LC_VBP + pp * 16) = o; } } while (0)
    { int ln = lane; asm volatile("" : "+v"(ln));
    asm volatile("s_waitcnt vmcnt(3)" ::: "memory");
    LC_CONVERT(0, 0, 0); }
    asm volatile("s_waitcnt lgkmcnt(0)" ::: "memory"); __builtin_amdgcn_s_barrier(); asm volatile("" ::: "memory");
    f32x16 acc[8];
#pragma unroll
    for (int i = 0; i < 8; ++i)
#pragma unroll
        for (int q = 0; q < 16; ++q) acc[i][q] = 0.f;
    bf16x8 E[8], O[8];
    bool primed = false;
#pragma unroll 1
    for (int ch = 0; ch < 8; ++ch) {
        int ln = lane; asm volatile("" : "+v"(ln));
        if (ch < 6) LC_DMA(ch + 2, ch & 1);
        const int du = wave - ch;
        if (du >= -4 && du <= 4) {
            const LAS unsigned char* ca = cpA + 64 * (ch * 8); const LAS unsigned char* vbh = lds + LC_VB0 + (ch & 1) * LC_VBSZ + laneB;
            if (!primed) { primed = true;
#pragma unroll
                for (int i = 1; i < 8; ++i) { E[(8 - i) & 7] = *(const LAS bf16x8*)(ca + 32 * (-2 * i)); O[(8 - i) & 7] = *(const LAS bf16x8*)(ca + 32 * (-2 * i + 1)); }
                E[0] = *(const LAS bf16x8*)ca; O[0] = *(const LAS bf16x8*)(ca + 32); }
            bf16x8 bc0 = *(const LAS bf16x8*)vbh, bc1 = *(const LAS bf16x8*)(vbh + 32);
#pragma unroll
            for (int mm = 0; mm < 8; ++mm) {
                bf16x8 bn0 = bc0, bn1 = bc1;
                if (mm < 7) { bn0 = *(const LAS bf16x8*)(vbh + 64 * (mm + 1)); bn1 = *(const LAS bf16x8*)(vbh + 64 * (mm + 1) + 32); }
                acc[7] = __builtin_amdgcn_mfma_f32_32x32x16_bf16(E[(mm + 1) & 7], bc0, acc[7], 0, 0, 0);
                E[(mm + 1) & 7] = *(const LAS bf16x8*)(ca + 64 * (mm + 1));
#pragma unroll
                for (int i = 0; i < 7; ++i) acc[i] = __builtin_amdgcn_mfma_f32_32x32x16_bf16(E[(mm - i) & 7], bc0, acc[i], 0, 0, 0);
                acc[7] = __builtin_amdgcn_mfma_f32_32x32x16_bf16(O[(mm + 1) & 7], bc1, acc[7], 0, 0, 0);
                O[(mm + 1) & 7] = *(const LAS bf16x8*)(ca + 64 * (mm + 1) + 32);
#pragma unroll
                for (int i = 0; i < 7; ++i) acc[i] = __builtin_amdgcn_mfma_f32_32x32x16_bf16(O[(mm - i) & 7], bc1, acc[i], 0, 0, 0);
                bc0 = bn0; bc1 = bn1;
            }
        }
        if (ch < 7) { if (ch < 6) asm volatile("s_waitcnt vmcnt(3)" ::: "memory"); else asm volatile("s_waitcnt vmcnt(0)" ::: "memory"); LC_CONVERT(ch + 1, (ch + 1) & 1, (ch + 1) & 1); }
        asm volatile("s_waitcnt lgkmcnt(0)" ::: "memory"); __builtin_amdgcn_s_barrier(); asm volatile("" ::: "memory");
    }
#undef LC_DMA
#undef LC_CONVERT
    { int le = lane; asm volatile("" : "+v"(le)); const int re = le & 31, he = le >> 5;
      LAS unsigned char* tw = lds + wave * (32 * 528);
#pragma unroll
      for (int i = 0; i < 8; ++i)
#pragma unroll
          for (int g = 0; g < 4; ++g) { v2u w; w.x = pk2(acc[i][4 * g + 0], acc[i][4 * g + 1]); w.y = pk2(acc[i][4 * g + 2], acc[i][4 * g + 3]); *(LAS v2u*)(tw + re * 528 + (32 * i + 8 * g + 4 * he) * 2) = w; }
      LDS_WAIT(); asm volatile("" ::: "memory");
      const int pp = le & 31;
      v4u gwa[16];
#pragma unroll
      for (int it = 0; it < 16; ++it) gwa[it] = *(const v4u*)(graw + (size_t)(2 * it + (le >> 5)) * 2048 + 256 * wave + pp * 8);
#pragma unroll
      for (int it = 0; it < 16; ++it) { const int row = 2 * it + (le >> 5); const size_t off = (size_t)row * 2048 + 256 * wave + pp * 8;
          const v4u gw = gwa[it]; const v4u aw = *(const LAS v4u*)(tw + row * 528 + pp * 16);
          float hp = 0.f, hn = 0.f;
          if (pp == 0 && wave > 0) hp = bf1(graw[off - 1]); if (pp == 31 && wave < 7) hn = bf1(graw[off + 8]);
          float gx[10]; gx[1] = bf_lo(gw.x); gx[2] = bf_hi(gw.x); gx[3] = bf_lo(gw.y); gx[4] = bf_hi(gw.y); gx[5] = bf_lo(gw.z); gx[6] = bf_hi(gw.z); gx[7] = bf_lo(gw.w); gx[8] = bf_hi(gw.w);
          const float fromprev = shidx(gx[8], le - 1), fromnext = shidx(gx[1], le + 1);
          gx[0] = pp > 0 ? fromprev : hp; gx[9] = pp < 31 ? fromnext : hn;
          const float av[8] = {bf_lo(aw.x), bf_hi(aw.x), bf_lo(aw.y), bf_hi(aw.y), bf_lo(aw.z), bf_hi(aw.z), bf_lo(aw.w), bf_hi(aw.w)};
          float o[8];
#pragma unroll
          for (int j = 0; j < 8; ++j) o[j] = (tg.b + tg.w0 * gx[j] + tg.w1 * gx[j + 1] + tg.w2 * gx[j + 2]) * av[j];
          v4u w; w.x = pk2(o[0], o[1]); w.y = pk2(o[2], o[3]); w.z = pk2(o[4], o[5]); w.w = pk2(o[6], o[7]);
          *(v4u*)(out + off) = w; }
    }
}
template <bool CONVIN>
__device__ __forceinline__ void ph_lconv(const Params& p, int o, const bf16* IN, const bf16* UT, bf16* OUT, LAS unsigned char* lds, int tid, int lane, int wave) {
    const bf16* FILT = (const bf16*)(p.ws + WS_FILT); const float* cw = p.in[I_CONVHYW]; const float* cbias = p.in[I_CONVHYB];
#pragma unroll 1
    for (int c = blockIdx.x; c < 1024; c += gridDim.x) { const int gc = (1 + o) * 1024 + c;
        const Taps ti{cw[c], cw[3072 + c], cw[6144 + c], cbias[c]}, tg{cw[gc], cw[3072 + gc], cw[6144 + gc], cbias[gc]};
        lconv_unit<CONVIN>(IN + (size_t)c * T, ti, FILT + (size_t)(o * 1024 + c) * 2048, UT + (size_t)gc * T, tg, p.in[I_FBIAS][o * 1024 + c], OUT + (size_t)c * T, lds, tid, lane, wave); }
}
__device__ __forceinline__ void ph_transpose(const bf16* Y2T, bf16* Y2, LAS unsigned char* lds, int lane, int wave) {
    LAS unsigned char* tl = lds + wave * 16384;
    const int gw = blockIdx.x * NWAVES + wave, NGW = gridDim.x * NWAVES;
#pragma unroll 1
    for (int tile = gw; tile < 16 * 1024; tile += NGW) { const int c0 = (tile & 15) * 64, t0 = (tile >> 4) * 64;
#pragma unroll
        for (int rr = 0; rr < 8; ++rr) { const int row = rr * 8 + (lane >> 3), pc = lane & 7;
            *(LAS v4u*)(tl + row * 144 + pc * 16) = *(const v4u*)(Y2T + (size_t)(c0 + row) * T + t0 + pc * 8); }
        LDS_WAIT(); asm volatile("" ::: "memory");
#pragma unroll
        for (int rr = 0; rr < 8; ++rr) { const int tk = rr * 8 + (lane >> 3), cp = (lane & 7) * 8;
            unsigned short e[8];
#pragma unroll
            for (int j = 0; j < 8; ++j) e[j] = *(const LAS unsigned short*)(tl + (cp + j) * 144 + tk * 2);
            v4u w; w.x = e[0] | ((unsigned)e[1] << 16); w.y = e[2] | ((unsigned)e[3] << 16); w.z = e[4] | ((unsigned)e[5] << 16); w.w = e[6] | ((unsigned)e[7] << 16);
            *(v4u*)(Y2 + (size_t)(t0 + tk) * D + c0 + cp) = w; }
        LDS_WAIT(); asm volatile("" ::: "memory");
    }
}

constexpr float QSCALE = 0.125f * 1.4426950408889634f;
struct InprojSched { int G, c;
    __device__ __forceinline__ bool next(int i, Unit& u) const { const int L = i * G + c; if (L >= 3840 + 288) return false;
        if (L < 3840) { u.pm = L / 15; u.pn = L % 15; } else { const int q = L - 3840; u.pm = 256 + q / 9; u.pn = 6 + q % 9; } return true; }
    __device__ __forceinline__ int arow(int r) const { return r; } };
struct EpiInproj { static constexpr bool PERM = true, AFTER_DRAIN = false; unsigned char* big; const float* rope; float* gates; const float* gate_b;
    __device__ __forceinline__ void operator()(const f32x4 (&acc)[2][2][4][2], const Unit& u, int wr, int wc, int fr, int fq) const {
        const bool ctx = u.pm >= 256; const int b = ctx ? u.pm - 256 : (u.pm >> 3), r0 = ctx ? 0 : (u.pm & 7) * 256;
        if (u.pn == 14) {
            if (wc != 0 || fq >= 2) return;
            const f32x4 gb0 = *(const f32x4*)(gate_b + 8 * fq), gb1 = *(const f32x4*)(gate_b + 8 * fq + 4);
#pragma unroll
            for (int ai = 0; ai < 2; ++ai)
#pragma unroll
                for (int m = 0; m < 4; ++m) { const int rr = r0 + wr * 64 + fr + ai * HALF + m * 16; const size_t grow = ctx ? (size_t)T + b * LC + rr : (size_t)b * SEQ + rr;
                    float* gp = gates + grow * 16 + 8 * fq; *(f32x4*)gp = acc[ai][0][m][0] + gb0; *(f32x4*)(gp + 4) = acc[ai][0][m][1] + gb1; }
            return; }
        const int t = u.pn >> 1;
        constexpr size_t offs[7] = {A0_QA, A0_BQ, A0_BO, A0_KA, A0_VA, A0_BK, A0_BV};
        const bool kv = t >= 3;
        size_t toff = A0_QA;
#pragma unroll
        for (int q = 0; q < 7; ++q) if (t == q) toff = offs[q];
        bf16* O = (bf16*)(big + toff) + (size_t)b * (kv ? (SEQ + LC) : SEQ) * 512 + (size_t)((kv && !ctx) ? LC : 0) * 512;
        const bool rope_on = (t == 0 || t == 3) && !ctx; const float qs = t == 0 ? QSCALE : 1.f;
        const int col0 = (u.pn & 1) * 256 + wc * 32 + 8 * fq;
#pragma unroll
        for (int ai = 0; ai < 2; ++ai)
#pragma unroll
            for (int m = 0; m < 4; ++m) { const int rr = r0 + wr * 64 + fr + ai * HALF + m * 16; bf16* rowp = O + (size_t)rr * 512 + col0;
                f32x4 cs0 = (f32x4){1.f, 0.f, 1.f, 0.f}, cs1 = cs0;
                if (rope_on) { const int pos = (wc & 1) ? (rr & 63) : (rr >> 6); const float* rp = rope + (size_t)(pos * 16 + 4 * fq) * 2; cs0 = *(const f32x4*)rp; cs1 = *(const f32x4*)(rp + 4); }
#pragma unroll
                for (int bj = 0; bj < 2; ++bj) { const f32x4 x0 = acc[ai][bj][m][0], x1 = acc[ai][bj][m][1];
                    f32x4 o0, o1;
                    o0[0] = x0[0] * cs0[0] - x1[0] * cs0[1]; o1[0] = x1[0] * cs0[0] + x0[0] * cs0[1];
                    o0[1] = x0[1] * cs0[2] - x1[1] * cs0[3]; o1[1] = x1[1] * cs0[2] + x0[1] * cs0[3];
                    o0[2] = x0[2] * cs1[0] - x1[2] * cs1[1]; o1[2] = x1[2] * cs1[0] + x0[2] * cs1[1];
                    o0[3] = x0[3] * cs1[2] - x1[3] * cs1[3]; o1[3] = x1[3] * cs1[2] + x0[3] * cs1[3];
                    o0 = o0 * qs; o1 = o1 * qs;
                    u32x4 w; w.x = cvt_pk_bf16(o0[0], o0[1]); w.y = cvt_pk_bf16(o0[2], o0[3]); w.z = cvt_pk_bf16(o1[0], o1[1]); w.w = cvt_pk_bf16(o1[2], o1[3]);
                    *(u32x4*)(rowp + bj * HALF) = w; } }
    } };
__device__ __forceinline__ void ph_transpose_b(const bf16* src, bf16* dst, int NBt, int R, int C, LAS unsigned char* lds, int lane, int wave) {
    LAS unsigned char* tl = lds + wave * 16384;
    const int gw = blockIdx.x * NWAVES + wave, NGW = gridDim.x * NWAVES; const int tr = R / 64, tc = C / 64, per = tr * tc;
#pragma unroll 1
    for (int tile = gw; tile < NBt * per; tile += NGW) { const int bt = tile / per, q = tile % per, c0 = (q % tc) * 64, r0 = (q / tc) * 64;
        const bf16* s = src + (size_t)bt * R * C; bf16* d = dst + (size_t)bt * R * C;
#pragma unroll
        for (int rr = 0; rr < 8; ++rr) { const int row = rr * 8 + (lane >> 3), pc = lane & 7;
            *(LAS v4u*)(tl + row * 144 + pc * 16) = *(const v4u*)(s + (size_t)(r0 + row) * C + c0 + pc * 8); }
        LDS_WAIT(); asm volatile("" ::: "memory");
#pragma unroll
        for (int rr = 0; rr < 8; ++rr) { const int cc = rr * 8 + (lane >> 3), rp = (lane & 7) * 8;
            unsigned short e[8];
#pragma unroll
            for (int j = 0; j < 8; ++j) e[j] = *(const LAS unsigned short*)(tl + (rp + j) * 144 + cc * 2);
            v4u w; w.x = e[0] | ((unsigned)e[1] << 16); w.y = e[2] | ((unsigned)e[3] << 16); w.z = e[4] | ((unsigned)e[5] << 16); w.w = e[6] | ((unsigned)e[7] << 16);
            *(v4u*)(d + (size_t)(c0 + cc) * R + r0 + rp) = w; }
        LDS_WAIT(); asm volatile("" ::: "memory");
    }
}

typedef float f32x2 __attribute__((ext_vector_type(2)));
constexpr int AT_KP = 272, AT_VP = 136  , AT_KB = 64 * AT_KP, AT_VB = 128 * AT_VP, AT_V0 = 2 * AT_KB;
__device__ __forceinline__ void ph_attn(const Params& p, unsigned char* big, LAS unsigned char* lds, int tid, int lane, int wave, int vcu) {
    const bf16* QA = (const bf16*)(big + A0_QA); const bf16* KA = (const bf16*)(big + A0_KA); const bf16* VT = (const bf16*)(big + A0_VT); bf16* MIXIN = (bf16*)(big + A0_MIXIN);
    const int comp = wave >> 2, qw = wave & 3, r = lane & 31, hh = lane >> 5;
    float lam; { const float* lv = p.in[I_DLAM]; const float a = wave_sum(lv[lane] * lv[64 + lane]), b2 = wave_sum(lv[128 + lane] * lv[192 + lane]); lam = expf(a) - expf(b2) + 0.2f; }
#pragma unroll 1
    for (int unit = vcu; unit < 2048; unit += gridDim.x) {
        const int b = unit >> 6, h = (unit >> 4) & 3, qblk = unit & 15, q0 = qblk * 128 + qw * 32;
        const bf16* Kg = KA + (size_t)b * (SEQ + LC) * 512 + h * 128; const bf16* Vg = VT + ((size_t)b * 512 + h * 128) * (SEQ + LC);
        bf16x8 qf[4];
#pragma unroll
        for (int ds = 0; ds < 4; ++ds) qf[ds] = *(const bf16x8*)(QA + ((size_t)b * SEQ + q0 + r) * 512 + h * 128 + comp * 64 + ds * 16 + hh * 8);
        f32x16 oacc[4];
#pragma unroll
        for (int i = 0; i < 4; ++i)
#pragma unroll
            for (int q = 0; q < 16; ++q) oacc[i][q] = 0.f;
        float m_run = 0.f, l_run = 0.f;
        v4u pre[4];
#define AT_LOADG(kt) do { _Pragma("unroll") for (int q = 0; q < 2; ++q) { const int idx = tid + NTHR * q; \
            pre[q] = *(const v4u*)(Kg + (size_t)((kt) * 64 + (idx >> 4)) * 512 + (idx & 15) * 8); \
            pre[2 + q] = *(const v4u*)(Vg + (size_t)(idx >> 3) * (SEQ + LC) + (kt) * 64 + (idx & 7) * 8); } } while (0)
#define AT_STORES(kn) do { _Pragma("unroll") for (int q = 0; q < 2; ++q) { const int idx = tid + NTHR * q; \
            *(LAS v4u*)(lds + ((kn) & 1) * AT_KB + (idx >> 4) * AT_KP + (idx & 15) * 16) = pre[q]; \
            { LAS unsigned char* vd_ = lds + AT_V0 + ((kn) % 3) * AT_VB + (idx >> 3) * AT_VP + (idx & 7) * 16; v2u h0_, h1_; h0_.x = pre[2 + q].x; h0_.y = pre[2 + q].y; h1_.x = pre[2 + q].z; h1_.y = pre[2 + q].w; \
              *(LAS v2u*)vd_ = h0_; *(LAS v2u*)(vd_ + 8) = h1_; } } } while (0)
#define AT_PV(PF, VT_) do { const LAS unsigned char* Vt_ = (VT_); _Pragma("unroll") for (int kb = 0; kb < 2; ++kb) _Pragma("unroll") for (int s = 0; s < 2; ++s) _Pragma("unroll") for (int dvb = 0; dvb < 4; ++dvb) { \
            const LAS unsigned char* vp = Vt_ + (32 * dvb + r) * AT_VP + (32 * kb + 16 * s + 4 * hh) * 2; const u32x2 lo = *(const LAS u32x2*)vp, hi = *(const LAS u32x2*)(vp + 16); \
            u32x4 vw; vw.x = lo.x; vw.y = lo.y; vw.z = hi.x; vw.w = hi.y; oacc[dvb] = __builtin_amdgcn_mfma_f32_32x32x16_bf16(__builtin_bit_cast(bf16x8, vw), PF[kb][s], oacc[dvb], 0, 0, 0); } } while (0)
        bf16x8 phold[2][2];
        __syncthreads();
        AT_LOADG(0); AT_STORES(0);
        __syncthreads();
#pragma unroll 1
        for (int kt = 0; kt < 36; ++kt) {
            if (kt < 35) AT_LOADG(kt + 1);
            const LAS unsigned char* Kt = lds + (kt & 1) * AT_KB;
            if (comp == 1 && kt > 0) { AT_PV(phold, lds + AT_V0 + ((kt - 1) % 3) * AT_VB); }
            f32x16 sacc[2];
#pragma unroll
            for (int kb = 0; kb < 2; ++kb)
#pragma unroll
                for (int q = 0; q < 16; ++q) sacc[kb][q] = -m_run;
#pragma unroll
            for (int ds = 0; ds < 4; ++ds)
#pragma unroll
                for (int kb = 0; kb < 2; ++kb) { const bf16x8 kf = *(const LAS bf16x8*)(Kt + (32 * kb + r) * AT_KP + comp * 128 + ds * 32 + hh * 16);
                    sacc[kb] = __builtin_amdgcn_mfma_f32_32x32x16_bf16(kf, qf[ds], sacc[kb], 0, 0, 0); }
            float mx = sacc[0][0];
#pragma unroll
            for (int kb = 0; kb < 2; ++kb)
#pragma unroll
                for (int q = 0; q < 16; ++q) mx = fmaxf(mx, sacc[kb][q]);
            mx = fmaxf(mx, shx(mx, 32));
            if (kt == 0 || __builtin_amdgcn_ballot_w64(mx > 0.f) != 0ull) {
                const float dm = kt == 0 ? mx : fmaxf(mx, 0.f), alpha = __builtin_amdgcn_exp2f(-dm); m_run += dm; l_run *= alpha;
#pragma unroll
                for (int kb = 0; kb < 2; ++kb) sacc[kb] = sacc[kb] - dm;
#pragma unroll
                for (int i = 0; i < 4; ++i) oacc[i] = oacc[i] * alpha; }
            f32x2 ps2 = (f32x2){0.f, 0.f};
#pragma unroll
            for (int kb = 0; kb < 2; ++kb)
#pragma unroll
                for (int q = 0; q < 8; ++q) { f32x2 e; e.x = __builtin_amdgcn_exp2f(sacc[kb][2 * q]); e.y = __builtin_amdgcn_exp2f(sacc[kb][2 * q + 1]); sacc[kb][2 * q] = e.x; sacc[kb][2 * q + 1] = e.y; ps2 += e; }
            l_run += ps2.x + ps2.y;
#pragma unroll
            for (int kb = 0; kb < 2; ++kb)
#pragma unroll
                for (int s = 0; s < 2; ++s) {
                    u32x4 pw; pw.x = cvt_pk_bf16(sacc[kb][8 * s + 0], sacc[kb][8 * s + 1]); pw.y = cvt_pk_bf16(sacc[kb][8 * s + 2], sacc[kb][8 * s + 3]);
                    pw.z = cvt_pk_bf16(sacc[kb][8 * s + 4], sacc[kb][8 * s + 5]); pw.w = cvt_pk_bf16(sacc[kb][8 * s + 6], sacc[kb][8 * s + 7]);
                    phold[kb][s] = __builtin_bit_cast(bf16x8, pw); }
            if (comp == 0) { AT_PV(phold, lds + AT_V0 + (kt % 3) * AT_VB); }
            if (kt < 35) AT_STORES(kt + 1);
            __syncthreads();
        }
        if (comp == 1) { AT_PV(phold, lds + AT_V0 + (35 % 3) * AT_VB); }
        __syncthreads();
#undef AT_LOADG
#undef AT_STORES
#undef AT_PV
        const float lsum = l_run + shx(l_run, 32), inv = 1.f / lsum;
        LAS float* X = (LAS float*)lds;
        if (comp == 1) {
#pragma unroll
            for (int dvb = 0; dvb < 4; ++dvb)
#pragma unroll
                for (int q = 0; q < 16; ++q) X[(qw * 64 + dvb * 16 + q) * 64 + lane] = oacc[dvb][q] * inv; }
        __syncthreads();
        if (comp == 0) {
            float ss = 0.f;
#pragma unroll
            for (int dvb = 0; dvb < 4; ++dvb)
#pragma unroll
                for (int q = 0; q < 16; ++q) { const float o = oacc[dvb][q] * inv - lam * X[(qw * 64 + dvb * 16 + q) * 64 + lane]; oacc[dvb][q] = o; ss += o * o; }
            ss += shx(ss, 32);
            const float rn = rsqrtf(ss * (1.f / 128.f) + RMS_EPS) * 0.8f;
            const float* ga = p.in[I_HGA] + h * 128; bf16* orow = MIXIN + ((size_t)b * SEQ + q0 + r) * D + h * 128;
#pragma unroll
            for (int dvb = 0; dvb < 4; ++dvb)
#pragma unroll
                for (int g = 0; g < 4; ++g) { const int dv = 32 * dvb + 8 * g + 4 * hh; const f32x4 gg = *(const f32x4*)(ga + dv);
                    v2u w; w.x = pk2(oacc[dvb][4 * g + 0] * rn * gg[0], oacc[dvb][4 * g + 1] * rn * gg[1]); w.y = pk2(oacc[dvb][4 * g + 2] * rn * gg[2], oacc[dvb][4 * g + 3] * rn * gg[3]);
                    *(v2u*)(orow + dv) = w; }
        }
    }
    __syncthreads();
}

constexpr int ML_P = 272, ML_TILE = 64 * ML_P;
constexpr int ML_VOFF = 3 * ML_TILE, ML_VSZ = 64 * 256;
constexpr int ML_RQ = ML_VOFF + 2 * ML_VSZ, ML_RSZ = 68 * 256, ML_RK = ML_RQ + ML_RSZ;
constexpr int ML_NOFF = ML_RK + ML_RSZ, ML_AOFF = ML_NOFF + 2 * 512;
constexpr int ML_CW = ML_AOFF + 8 * 256;
static_assert(ML_CW + 8 * 512 <= LDS_TAB, "mLSTM LDS map");
typedef short s16x4 __attribute__((ext_vector_type(4)));
__device__ __forceinline__ u32x2 tr16(const LAS unsigned char* p) { return __builtin_bit_cast(u32x2, __builtin_amdgcn_ds_read_tr16_b64_v4i16((LAS s16x4*)p)); }
__device__ __forceinline__ float logsigmoidf_(float x) { return x >= 0.f ? -__logf(1.f + __expf(-x)) : x - __logf(1.f + __expf(x)); }
__device__ __forceinline__ bf16x8 pack8(const f32x16& v, int s) { u32x4 w; w.x = cvt_pk_bf16(v[8 * s + 0], v[8 * s + 1]); w.y = cvt_pk_bf16(v[8 * s + 2], v[8 * s + 3]); w.z = cvt_pk_bf16(v[8 * s + 4], v[8 * s + 5]); w.w = cvt_pk_bf16(v[8 * s + 6], v[8 * s + 7]); return __builtin_bit_cast(bf16x8, w); }
__device__ __forceinline__ void ph_mlstm(const Params& p, unsigned char* big, LAS unsigned char* lds, int tid, int lane, int wave) {
    const int bid = blockIdx.x; if (bid >= 256) return;
    const int b = bid >> 3, h = (bid >> 1) & 3, dir = bid & 1;
    const bf16* BQ = (const bf16*)(big + A0_BQ) + (size_t)b * SEQ * 512 + h * 128;
    const bf16* BK = (const bf16*)(big + A0_BK) + (size_t)b * (SEQ + LC) * 512 + h * 128;
    const bf16* BV = (const bf16*)(big + A0_BV) + (size_t)b * (SEQ + LC) * 512 + h * 128;
    bf16* HB = (bf16*)(big + A0_HB) + (size_t)dir * T * 512 + (size_t)b * SEQ * 512 + h * 128;
    const float* GT = (const float*)(p.ws + WS_GATES);
    const float* cw = p.in[I_CONVABW]; const float* cb = p.in[I_CONVABB];
    const int eb = wave & 3, tb = wave >> 2, r = lane & 31, hh = lane >> 5;
    const int blk = (lane >> 4) & 1, tq = (lane & 15) >> 2, tp = lane & 3;
    LAS float* nbuf = (LAS float*)(lds + ML_NOFF); LAS float* aw = (LAS float*)(lds + ML_AOFF) + wave * 64;
    if (tid < 256) nbuf[tid] = 0.f;
    LAS float* cwl = (LAS float*)(lds + ML_CW);
    for (int i = tid; i < 1024; i += NTHR) { const int ten = i >> 9, j = (i >> 7) & 3, d = i & 127, ch = ten * 512 + h * 128 + d; cwl[i] = j < 3 ? cw[j * 1024 + ch] : cb[ch]; }
    f32x16 cacc[4];
#pragma unroll
    for (int i = 0; i < 4; ++i)
#pragma unroll
        for (int q = 0; q < 16; ++q) cacc[i][q] = 0.f;
    float m_state = 0.f;
#ifdef ML_PROBE
    unsigned long long accs[6] = {0, 0, 0, 0, 0, 0}; unsigned long long tp0 = __builtin_amdgcn_s_memrealtime();
#define ML_T(i) do { const unsigned long long t1_ = __builtin_amdgcn_s_memrealtime(); accs[i] += t1_ - tp0; tp0 = t1_; } while (0)
#else
#define ML_T(i)
#endif
    float a_c = 0.f, M_c = 0.f, b_c = 0.f, decay_c = 1.f, m_after = 0.f;
    float a_n = 0.f, M_n = 0.f, b_n = 0.f, w_n = 0.f, decay_n = 1.f, m_next = 0.f;
#define ML_POS(cc, t) ((cc) < 4 ? (dir ? 255 - ((cc) * 64 + (t)) : (cc) * 64 + (t)) : (dir ? 2047 - (((cc) - 4) * 64 + (t)) : ((cc) - 4) * 64 + (t)))
#define ML_GLOAD(cc, li_, fp_) do { const int pos_ = ML_POS(cc, lane); const size_t grow_ = (cc) < 4 ? (size_t)T + b * LC + pos_ : (size_t)b * SEQ + pos_; \
        li_ = GT[grow_ * 16 + dir * 8 + h]; fp_ = GT[grow_ * 16 + dir * 8 + 4 + h]; } while (0)
#define ML_SCAN(li_, fp_, m_in) do { const float lf_ = logsigmoidf_(fp_); \
        float bs_ = lf_; _Pragma("unroll") for (int o_ = 1; o_ < 64; o_ <<= 1) { const float v_ = shup(bs_, o_); if (lane >= o_) bs_ += v_; } \
        const float aa_ = (li_) - bs_; float pm_ = aa_; _Pragma("unroll") for (int o_ = 1; o_ < 64; o_ <<= 1) { const float v_ = shup(pm_, o_); if (lane >= o_) pm_ = fmaxf(pm_, v_); } \
        const float MM_ = fmaxf(m_in, pm_); const float M63_ = shidx(MM_, 63), b63_ = shidx(bs_, 63); \
        a_n = aa_; M_n = MM_; b_n = bs_; w_n = __expf(aa_ - M63_); decay_n = __expf((m_in) - M63_); m_next = b63_ + M63_; } while (0)
#define ML_DMA(cc, vbuf) do { const int lim_ = (cc) < 4 ? LC : SEQ, kvb_ = (cc) < 4 ? 0 : LC; \
        _Pragma("unroll 1") for (int ins_ = wave; ins_ < 17; ins_ += NWAVES) { const int rr_ = ins_ * 4 + (lane >> 4), pc_ = lane & 15; int pos_ = ML_POS(cc, rr_ - 1); pos_ = pos_ < 0 ? 0 : (pos_ >= lim_ ? lim_ - 1 : pos_); \
            __builtin_amdgcn_global_load_lds((const unsigned*)(BK + (size_t)(kvb_ + pos_) * 512 + pc_ * 8), (LAS unsigned*)(lds + ML_RK + ins_ * 1024), 16, 0, 0); \
            if ((cc) >= 4) __builtin_amdgcn_global_load_lds((const unsigned*)(BQ + (size_t)pos_ * 512 + pc_ * 8), (LAS unsigned*)(lds + ML_RQ + ins_ * 1024), 16, 0, 0); } \
        _Pragma("unroll") for (int q_ = 0; q_ < 2; ++q_) { const int ins_ = wave * 2 + q_, t_ = ins_ * 4 + (lane >> 4), pc_ = lane & 15; const int pos_ = ML_POS(cc, t_); \
            __builtin_amdgcn_global_load_lds((const unsigned*)(BV + (size_t)(kvb_ + pos_) * 512 + pc_ * 8), (LAS unsigned*)(lds + ML_VOFF + (vbuf) * ML_VSZ + ins_ * 1024), 16, 0, 0); } } while (0)
#define ML_CONV8(dst, rawoff, cc, t_, d8_, ten, scl) do { const int pos_ = ML_POS(cc, t_), lim_ = (cc) < 4 ? LC : SEQ; const int rm_ = dir ? (t_) + 2 : (t_), rp_ = dir ? (t_) : (t_) + 2; \
        v4u x_[3]; x_[0] = *(const LAS v4u*)(lds + (rawoff) + rm_ * 256 + (d8_) * 16); x_[1] = *(const LAS v4u*)(lds + (rawoff) + ((t_) + 1) * 256 + (d8_) * 16); x_[2] = *(const LAS v4u*)(lds + (rawoff) + rp_ * 256 + (d8_) * 16); \
        if (pos_ - 1 < 0) x_[0] = (v4u){0u, 0u, 0u, 0u}; if (pos_ + 1 >= lim_) x_[2] = (v4u){0u, 0u, 0u, 0u}; \
        const LAS float* wl_ = cwl + (ten) * 512 + (d8_) * 8; f32x4 wv_[4][2]; \
        _Pragma("unroll") for (int j_ = 0; j_ < 4; ++j_) { wv_[j_][0] = *(const LAS f32x4*)(wl_ + j_ * 128); wv_[j_][1] = *(const LAS f32x4*)(wl_ + j_ * 128 + 4); } \
        _Pragma("unroll") for (int e_ = 0; e_ < 8; ++e_) { float s_ = wv_[3][e_ >> 2][e_ & 3]; \
            _Pragma("unroll") for (int j_ = 0; j_ < 3; ++j_) { const unsigned w_ = e_ < 2 ? x_[j_].x : e_ < 4 ? x_[j_].y : e_ < 6 ? x_[j_].z : x_[j_].w; s_ += wv_[j_][e_ >> 2][e_ & 3] * ((e_ & 1) ? bf_hi(w_) : bf_lo(w_)); } \
            dst[e_] = __fdividef(s_, 1.f + __expf(-s_)) * (scl); } } while (0)
#define ML_BUILD(cc) do { _Pragma("unroll 1") for (int q_ = 0; q_ < 2; ++q_) { const int idx_ = tid + NTHR * q_, t_ = idx_ >> 4, d8_ = idx_ & 15; \
        float kk_[8]; ML_CONV8(kk_, ML_RK, cc, t_, d8_, 1, 1.f); const float wt_ = shidx(w_n, t_); \
        v4u o_; o_.x = pk2(kk_[0], kk_[1]); o_.y = pk2(kk_[2], kk_[3]); o_.z = pk2(kk_[4], kk_[5]); o_.w = pk2(kk_[6], kk_[7]); *(LAS v4u*)(lds + ML_TILE + t_ * ML_P + d8_ * 16) = o_; \
        o_.x = pk2(kk_[0] * wt_, kk_[1] * wt_); o_.y = pk2(kk_[2] * wt_, kk_[3] * wt_); o_.z = pk2(kk_[4] * wt_, kk_[5] * wt_); o_.w = pk2(kk_[6] * wt_, kk_[7] * wt_); *(LAS v4u*)(lds + 2 * ML_TILE + t_ * ML_P + d8_ * 16) = o_; \
        if ((cc) >= 4) { float qq_[8]; ML_CONV8(qq_, ML_RQ, cc, t_, d8_, 0, 0.08838834764831845f); \
            o_.x = pk2(qq_[0], qq_[1]); o_.y = pk2(qq_[2], qq_[3]); o_.z = pk2(qq_[4], qq_[5]); o_.w = pk2(qq_[6], qq_[7]); *(LAS v4u*)(lds + t_ * ML_P + d8_ * 16) = o_; } } } while (0)
    __syncthreads();
    { float li0, fp0; ML_GLOAD(0, li0, fp0); ML_DMA(0, 0); ML_SCAN(li0, fp0, m_state); }
    asm volatile("s_waitcnt vmcnt(0)" ::: "memory");
    __syncthreads();
    ML_BUILD(0);
    a_c = a_n; M_c = M_n; b_c = b_n; decay_c = decay_n; m_after = m_next;
    __syncthreads();
#pragma unroll 1
    for (int cc = 0; cc < 36; ++cc) {
        const LAS unsigned char* Qs = lds; const LAS unsigned char* Ks = lds + ML_TILE; const LAS unsigned char* Kw = lds + 2 * ML_TILE; const LAS unsigned char* Vs = lds + ML_VOFF + (cc & 1) * ML_VSZ;
        const LAS float* ncur = nbuf + (cc & 1) * 128; LAS float* nnew = nbuf + ((cc + 1) & 1) * 128;
        float li1 = 0.f, fp1 = 0.f;
        ML_T(5);
        if (cc < 35) { ML_GLOAD(cc + 1, li1, fp1); ML_DMA(cc + 1, (cc + 1) & 1); }
        ML_T(0);
        if (cc >= 4) {
            aw[lane] = a_c;
            const int tcol = 32 * tb + r; const float Mt = shidx(M_c, tcol), bt = shidx(b_c, tcol);
            f32x16 nacc;
#pragma unroll
            for (int q = 0; q < 16; ++q) nacc[q] = 0.f;
#pragma unroll
            for (int db = 0; db < 4; ++db)
#pragma unroll
                for (int s2 = 0; s2 < 2; ++s2) { const LAS unsigned char* qp = Qs + tcol * ML_P + (32 * db + 16 * s2 + 4 * hh) * 2; const u32x2 lo = *(const LAS u32x2*)qp, hi = *(const LAS u32x2*)(qp + 16);
                    u32x4 qw; qw.x = lo.x; qw.y = lo.y; qw.z = hi.x; qw.w = hi.y;
                    nacc = __builtin_amdgcn_mfma_f32_32x32x16_bf16(pack8(cacc[db], s2), __builtin_bit_cast(bf16x8, qw), nacc, 0, 0, 0); }
            const float sc = __expf(m_state - Mt);
            nacc = nacc * sc;
            float rs = 0.f;
#pragma unroll
            for (int sb = 0; sb < 2; ++sb) if (sb <= tb) {
                f32x16 sacc;
#pragma unroll
                for (int q = 0; q < 16; ++q) sacc[q] = 0.f;
#pragma unroll
                for (int ds = 0; ds < 8; ++ds) { const bf16x8 kf = *(const LAS bf16x8*)(Ks + (32 * sb + r) * ML_P + (16 * ds + 8 * hh) * 2), qf = *(const LAS bf16x8*)(Qs + tcol * ML_P + (16 * ds + 8 * hh) * 2);
                    sacc = __builtin_amdgcn_mfma_f32_32x32x16_bf16(kf, qf, sacc, 0, 0, 0); }
#pragma unroll
                for (int g = 0; g < 4; ++g) { const int s0 = 32 * sb + 8 * g + 4 * hh; const f32x4 av = *(const LAS f32x4*)(aw + s0);
#pragma unroll
                    for (int j = 0; j < 4; ++j) { const bool keep = (s0 + j) <= tcol; const float v = keep ? sacc[4 * g + j] * __expf(av[j] - Mt) : 0.f; sacc[4 * g + j] = v; rs += v; } }
#pragma unroll
                for (int s2 = 0; s2 < 2; ++s2) { u32x4 vw;
                    { const u32x2 t0 = tr16(Vs + (32 * sb + 16 * s2 + 4 * hh + tq) * 256 + (32 * eb + 16 * blk + 4 * tp) * 2), t1 = tr16(Vs + (32 * sb + 16 * s2 + 8 + 4 * hh + tq) * 256 + (32 * eb + 16 * blk + 4 * tp) * 2);
                      vw.x = t0.x; vw.y = t0.y; vw.z = t1.x; vw.w = t1.y; }
                    nacc = __builtin_amdgcn_mfma_f32_32x32x16_bf16(__builtin_bit_cast(bf16x8, vw), pack8(sacc, s2), nacc, 0, 0, 0); } }
            rs += shx(rs, 32);
            float qn = 0.f;
            { const LAS unsigned char* qp = Qs + tcol * ML_P + (64 * hh) * 2;
#pragma unroll
              for (int c8 = 0; c8 < 8; ++c8) { const v4u w = *(const LAS v4u*)(qp + c8 * 16); const f32x4 n0 = *(const LAS f32x4*)(ncur + 64 * hh + 8 * c8), n1 = *(const LAS f32x4*)(ncur + 64 * hh + 8 * c8 + 4);
                  qn += bf_lo(w.x) * n0[0] + bf_hi(w.x) * n0[1] + bf_lo(w.y) * n0[2] + bf_hi(w.y) * n0[3] + bf_lo(w.z) * n1[0] + bf_hi(w.z) * n1[1] + bf_lo(w.w) * n1[2] + bf_hi(w.w) * n1[3]; } }
            qn += shx(qn, 32);
            const float den = sc * qn + rs; const float dd = __frcp_rn(fmaxf(fabsf(den), __expf(-(bt + Mt))));
            { const int pos = ML_POS(cc, tcol); bf16* hrow = HB + (size_t)pos * 512 + 32 * eb;
#pragma unroll
              for (int g = 0; g < 4; ++g) { v2u w; w.x = pk2(nacc[4 * g + 0] * dd, nacc[4 * g + 1] * dd); w.y = pk2(nacc[4 * g + 2] * dd, nacc[4 * g + 3] * dd); *(v2u*)(hrow + 8 * g + 4 * hh) = w; } }
        }
        ML_T(1);
#pragma unroll
        for (int db = 0; db < 4; ++db) { cacc[db] = cacc[db] * decay_c;
#pragma unroll
            for (int s4 = 0; s4 < 4; ++s4) { u32x4 ka, vb;
                { const u32x2 t0 = tr16(Kw + (16 * s4 + 8 * hh + tq) * ML_P + (32 * db + 16 * blk + 4 * tp) * 2), t1 = tr16(Kw + (16 * s4 + 8 * hh + 4 + tq) * ML_P + (32 * db + 16 * blk + 4 * tp) * 2);
                  ka.x = t0.x; ka.y = t0.y; ka.z = t1.x; ka.w = t1.y; }
                { const u32x2 t0 = tr16(Vs + (16 * s4 + 8 * hh + tq) * 256 + (32 * eb + 16 * blk + 4 * tp) * 2), t1 = tr16(Vs + (16 * s4 + 8 * hh + 4 + tq) * 256 + (32 * eb + 16 * blk + 4 * tp) * 2);
                  vb.x = t0.x; vb.y = t0.y; vb.z = t1.x; vb.w = t1.y; }
                cacc[db] = __builtin_amdgcn_mfma_f32_32x32x16_bf16(__builtin_bit_cast(bf16x8, ka), __builtin_bit_cast(bf16x8, vb), cacc[db], 0, 0, 0); } }
        { const int d = tid >> 2, part = tid & 3; float s = 0.f;
#pragma unroll
            for (int t = 0; t < 16; ++t) s += bf1(*(const LAS bf16*)(Kw + (part * 16 + t) * ML_P + d * 2));
            s += shx(s, 1); s += shx(s, 2);
            if (part == 0) nnew[d] = decay_c * ncur[d] + s; }
        m_state = m_after;
        ML_T(2);
        asm volatile("s_waitcnt vmcnt(0)" ::: "memory");
        __syncthreads();
        ML_T(3);
        if (cc < 35) { ML_SCAN(li1, fp1, m_state); ML_BUILD(cc + 1); a_c = a_n; M_c = M_n; b_c = b_n; decay_c = decay_n; m_after = m_next; }
        ML_T(4);
        __syncthreads();
    }
#ifdef ML_PROBE
    if (blockIdx.x == 0 && tid == 0) { unsigned long long* ts = (unsigned long long*)(p.ws + WS_CTL + 32768); ts[50] = 0; unsigned long long c_ = 0; for (int i = 0; i < 6; ++i) { c_ += accs[i]; ts[51 + i] = c_; } }
#endif
#undef ML_T
#undef ML_POS
#undef ML_GLOAD
#undef ML_SCAN
#undef ML_DMA
#undef ML_CONV8
#undef ML_BUILD
}
__device__ __forceinline__ void ph_outb(const Params& p, unsigned char* big, int lane, int wave) {
    const int gw = blockIdx.x * NWAVES + wave, NGW = gridDim.x * NWAVES;
    const bf16* HBf = (const bf16*)(big + A0_HB); const bf16* HBb = HBf + (size_t)T * 512; const bf16* BO = (const bf16*)(big + A0_BO); bf16* MIXIN = (bf16*)(big + A0_MIXIN);
    const float* gb = p.in[I_HGB];
#pragma unroll 1
    for (int m = gw; m < T; m += NGW) {
        const v4u f = *(const v4u*)(HBf + (size_t)m * 512 + lane * 8), bw = *(const v4u*)(HBb + (size_t)m * 512 + lane * 8), go = *(const v4u*)(BO + (size_t)m * 512 + lane * 8);
        float x[8], o[8]; x[0] = bf_lo(f.x) + bf_lo(bw.x); x[1] = bf_hi(f.x) + bf_hi(bw.x); x[2] = bf_lo(f.y) + bf_lo(bw.y); x[3] = bf_hi(f.y) + bf_hi(bw.y);
        x[4] = bf_lo(f.z) + bf_lo(bw.z); x[5] = bf_hi(f.z) + bf_hi(bw.z); x[6] = bf_lo(f.w) + bf_lo(bw.w); x[7] = bf_hi(f.w) + bf_hi(bw.w);
        o[0] = bf_lo(go.x); o[1] = bf_hi(go.x); o[2] = bf_lo(go.y); o[3] = bf_hi(go.y); o[4] = bf_lo(go.z); o[5] = bf_hi(go.z); o[6] = bf_lo(go.w); o[7] = bf_hi(go.w);
        float ss = 0.f;
#pragma unroll
        for (int j = 0; j < 8; ++j) ss += x[j] * x[j];
        ss += shx(ss, 1); ss += shx(ss, 2); ss += shx(ss, 4); ss += shx(ss, 8);
        const float rn = rsqrtf(ss * (1.f / 128.f) + RMS_EPS);
        const f32x4 g0 = *(const f32x4*)(gb + lane * 8), g1 = *(const f32x4*)(gb + lane * 8 + 4);
        float y[8];
#pragma unroll
        for (int j = 0; j < 8; ++j) y[j] = x[j] * rn * (j < 4 ? g0[j] : g1[j - 4]) * sigmoidf_(o[j]);
        v4u w; w.x = pk2(y[0], y[1]); w.y = pk2(y[2], y[3]); w.z = pk2(y[4], y[5]); w.w = pk2(y[6], y[7]);
        *(v4u*)(MIXIN + (size_t)m * D + 512 + lane * 8) = w;
    }
}

constexpr int CW_DBG = 16;
#ifndef DBG_MODE
#define DBG_MODE 0
#endif
#ifndef DBG_L
#define DBG_L 0
#endif
#ifndef DBG_CH
#define DBG_CH 0
#endif
__device__ __forceinline__ void dbg_report(const Params& p, float d) {
    if (!(d >= 0.f)) d = 1.0e6f;
    atomicMax((unsigned*)(p.ws + WS_CTL) + CW_DBG, __float_as_uint(d));
}
__device__ __forceinline__ float block_max(float v, LAS float* red, int tid) { v = wave_max(v); __syncthreads(); if ((tid & 63) == 0) red[tid >> 6] = v; __syncthreads(); float r = red[0];
#pragma unroll
    for (int w = 1; w < 8; ++w) r = fmaxf(r, red[w]); __syncthreads(); return r; }
__device__ __forceinline__ float block_sum(float v, LAS float* red, int tid) { v = wave_sum(v); __syncthreads(); if ((tid & 63) == 0) red[tid >> 6] = v; __syncthreads(); float r = 0.f;
#pragma unroll
    for (int w = 0; w < 8; ++w) r += red[w]; __syncthreads(); return r; }
__device__ __forceinline__ void dbg_moe_check(const Params& p, int l, int ch, const bf16* H2, const bf16* Y, LAS unsigned char* lds, int tid) {
    LAS float* hrow = (LAS float*)lds; LAS float* gu = hrow + 1024; LAS float* a = gu + 512; LAS float* red = a + 256;
    const int t = ch * CHT + blockIdx.x * 64 + 5;
    __syncthreads();
    for (int i = tid; i < 1024; i += NTHR) hrow[i] = bf1(H2[(size_t)t * D + i]);
    __syncthreads();
    const int* EIDX = (const int*)(p.ws + WS_EIDX); const float* WTS = (const float*)(p.ws + WS_WTS); const int* PSLOT = (const int*)(p.ws + WS_PSLOT);
    float yacc[2] = {0.f, 0.f};
#pragma unroll 1
    for (int k = 0; k < 9; ++k) {
        const int e = k < 8 ? (EIDX[(size_t)t * 8 + k] & 255) : 64; const float w = k < 8 ? WTS[(size_t)t * 8 + k] : 1.f;
        const float* Wgu = e < 64 ? p.in[I_EGU] + (size_t)(l * 64 + e) * 1024 * 512 : p.in[I_SGU] + (size_t)l * 1024 * 512;
        const float* Wdn = e < 64 ? p.in[I_EDN] + (size_t)(l * 64 + e) * 256 * 1024 : p.in[I_SDN] + (size_t)l * 256 * 1024;
        float s = 0.f;
#pragma unroll 4
        for (int kk = 0; kk < 1024; ++kk) s += hrow[kk] * Wgu[(size_t)kk * 512 + tid];
        gu[tid] = s;
        __syncthreads();
        if (tid < 256) a[tid] = siluf_(gu[tid]) * gu[256 + tid];
        __syncthreads();
#pragma unroll
        for (int q = 0; q < 2; ++q) { const int n = tid + 512 * q; float s2 = 0.f;
#pragma unroll 4
            for (int j = 0; j < 256; ++j) s2 += a[j] * Wdn[(size_t)j * 1024 + n];
            yacc[q] += w * s2; }
        __syncthreads();
    }
    float err = 0.f, ss = 0.f;
#pragma unroll
    for (int q = 0; q < 2; ++q) { const int n = tid + 512 * q; float f = 0.f;
#pragma unroll 1
        for (int k = 0; k < 9; ++k) { const int slot = PSLOT[(size_t)t * 16 + k]; const float w = k < 8 ? WTS[(size_t)t * 8 + k] : 1.f; f += w * bf1(Y[(size_t)slot * D + n]); }
        err = fmaxf(err, fabsf(f - yacc[q])); ss += yacc[q] * yacc[q]; }
    const float me = block_max(err, red, tid), sq = block_sum(ss, red, tid);
    if (tid == 0) dbg_report(p, me / sqrtf(sq * (1.f / 1024.f) + 1e-30f));
}
__device__ __forceinline__ void dbg_route_check(const Params& p, int l, const bf16* H2, const float* LOG, LAS unsigned char* lds, int tid) {
    LAS float* hrow = (LAS float*)lds; LAS float* lg = hrow + 1024; LAS float* bi = lg + 64; LAS float* sc = bi + 64; LAS float* red = sc + 64;
    const int t = blockIdx.x * 256 + 77;
    __syncthreads();
    for (int i = tid; i < 1024; i += NTHR) hrow[i] = bf1(H2[(size_t)t * D + i]);
    __syncthreads();
    if (tid < 64) { float s = 0.f; const float* W = p.in[I_RW] + (size_t)l * 1024 * 64;
#pragma unroll 4
        for (int k = 0; k < 1024; ++k) s += hrow[k] * W[k * 64 + tid];
        lg[tid] = s; sc[tid] = 1.f / (1.f + expf(-s)); bi[tid] = sc[tid] + p.in[I_RB][l * 64 + tid]; }
    __syncthreads();
    if (tid == 0) {
        float lerr = 0.f;
#pragma unroll 1
        for (int e = 0; e < 64; ++e) lerr = fmaxf(lerr, fabsf(lg[e] - LOG[(size_t)t * 64 + e]));
        float grp[8];
#pragma unroll
        for (int g = 0; g < 8; ++g) { float a = -1e30f, b = -1e30f;
#pragma unroll 1
            for (int j = 0; j < 8; ++j) { const float v = bi[g * 8 + j]; if (v > a) { b = a; a = v; } else if (v > b) b = v; } grp[g] = a + b; }
        unsigned gm = 0;
#pragma unroll 1
        for (int r = 0; r < 4; ++r) { int best = -1; float bv = 0.f;
#pragma unroll
            for (int g = 0; g < 8; ++g) if (!((gm >> g) & 1u) && (best < 0 || grp[g] > bv)) { best = g; bv = grp[g]; }
            gm |= 1u << best; }
        unsigned long long set_ref = 0ull; float ssum = 0.f;
#pragma unroll 1
        for (int r = 0; r < 8; ++r) { int best = -1; float bv = 0.f;
#pragma unroll 1
            for (int e = 0; e < 64; ++e) if (((gm >> (e >> 3)) & 1u) && !((set_ref >> e) & 1ull) && (best < 0 || bi[e] > bv)) { best = e; bv = bi[e]; }
            set_ref |= 1ull << best; ssum += sc[best]; }
        const int* EIDX = (const int*)(p.ws + WS_EIDX); const float* WTS = (const float*)(p.ws + WS_WTS);
        unsigned long long set_f = 0ull; float werr = 0.f, wsum = 0.f;
#pragma unroll 1
        for (int k = 0; k < 8; ++k) { const int e = EIDX[(size_t)t * 8 + k] & 255; set_f |= 1ull << e; const float wr = 2.5f * sc[e] / ssum; werr = fmaxf(werr, fabsf(wr - WTS[(size_t)t * 8 + k])); wsum += WTS[(size_t)t * 8 + k]; }
        float d = 0.f;
        if (DBG_MODE == 0) d = (set_f != set_ref) ? (1.f / 256.f) : 0.f;
        if (DBG_MODE == 1) d = (set_f != set_ref) ? 0.f : werr + fabsf(wsum - 2.5f);
        if (DBG_MODE == 2) d = lerr * (1.f / 256.f);
        atomicAdd((float*)((unsigned*)(p.ws + WS_CTL) + CW_DBG), d);
    }
    __syncthreads();
}
__device__ __forceinline__ unsigned dbg_hash(unsigned x) { x ^= x >> 16; x *= 0x7feb352du; x ^= x >> 15; x *= 0x846ca68bu; x ^= x >> 16; return x; }
__device__ __forceinline__ void dbg_report_wave(const Params& p, float d, int lane) { if (lane == 0) dbg_report(p, d); }
__device__ __forceinline__ void dbg_hyena_check(const Params& p, int mode, const bf16* HN, const bf16* UC, const bf16* ZT, const bf16* Y2T, const bf16* MIX, LAS unsigned char* lds, int lane, int wave) {
    const unsigned hsh = dbg_hash(blockIdx.x * 8u + wave + 12345u), h2 = dbg_hash(hsh), h3 = dbg_hash(h2);
    const bf16* FILT = (const bf16*)(p.ws + WS_FILT);
    float d = 0.f;
    if (mode == 0) {
        const int c = hsh % 3072u, b = h2 % 32u, s = h3 % 2048u; float acc = 0.f;
#pragma unroll 1
        for (int k = lane; k < 1024; k += 64) acc += bf1(HN[(size_t)(b * 2048 + s) * D + k]) * p.in[I_WINHY][(size_t)k * 3072 + c];
        acc = wave_sum(acc);
        const float got = bf1(UC[(size_t)c * T + b * 2048 + s]); d = fabsf(got - acc) / (fabsf(acc) + 0.1f);
    } else if (mode == 5) {
        const int c = hsh % 3072u, b = h2 % 32u; int s = h3 % 2048u; if ((h3 >> 20) % 8u == 0u) s = 0; if ((h3 >> 20) % 8u == 1u) s = 2047;
        float val = p.in[I_CONVHYB][c];
#pragma unroll 1
        for (int j = 0; j < 3; ++j) { const int sj = s + j - 1; if (sj < 0 || sj > 2047) continue; val += p.in[I_CONVHYW][j * 3072 + c] * bf1(ZT[(size_t)c * T + b * 2048 + sj]); }
        const float got = bf1(UC[(size_t)c * T + b * 2048 + s]); d = fabsf(got - val) / (fabsf(val) + 0.1f);
    } else if (mode == 1) {
        LAS float* Z = (LAS float*)(lds + wave * 1024); LAS float* A1 = Z + 64; LAS float* A2 = A1 + 64;
        const int o = hsh & 1u, c = h2 % 1024u, j = h3 % 2048u;
        float z = 0.f; if (lane == 0) z = (float)j / 2047.f; else if (lane < 33) { const int k = (lane - 1) & 15; const float fr = 1e-4f + (float)k * ((15.f - 1e-4f) / 15.f); const float ang = (6.283185307179586f / 2048.f) * (float)j * fr; z = lane < 17 ? cosf(ang) : -sinf(ang); }
        Z[lane] = z; LDS_WAIT(); asm volatile("" ::: "memory");
        float a = p.in[I_FB1][lane];
#pragma unroll 1
        for (int k = 0; k < 33; ++k) a += Z[k] * p.in[I_FW1][k * 64 + lane];
        A1[lane] = sinf(a); LDS_WAIT(); asm volatile("" ::: "memory");
        a = p.in[I_FB2][lane];
#pragma unroll 1
        for (int k = 0; k < 64; ++k) a += A1[k] * p.in[I_FW2][k * 64 + lane];
        A2[lane] = sinf(a); LDS_WAIT(); asm volatile("" ::: "memory");
        float v = wave_sum(A2[lane] * p.in[I_FW3][lane * 2048 + o * 1024 + c]);
        const float mind = -4.605170185988091f / 1.5f, maxd = -4.605170185988091f / 0.3f; const float delta = fabsf(mind + (float)c * ((maxd - mind) / 1023.f));
        v *= expf(-fabsf((float)j - 1024.f) / 1024.f * delta);
        const float got = bf1(FILT[(size_t)(o * 1024 + c) * 2048 + j]); d = fabsf(got - v) / (fabsf(v) + 1e-4f);
    } else if (mode == 2 || mode == 3) {
        const int o = mode - 2, c = hsh % 1024u, b = h2 % 32u; int t = h3 % 2048u; if ((h3 >> 20) % 8u == 0u) t = 0; if ((h3 >> 20) % 8u == 1u) t = 2047;
        const bf16* in = (o == 0 ? UC : ZT) + (size_t)c * T + b * 2048; const bf16* f = FILT + (size_t)(o * 1024 + c) * 2048; float acc = 0.f;
#pragma unroll 1
        for (int s = lane; s < 2048; s += 64) { const int x = 1024 + t - s; if (x >= 0 && x <= 2047) acc += bf1(f[x]) * bf1(in[s]); }
        acc = wave_sum(acc);
        const float gate = bf1(UC[(size_t)((1 + o) * 1024 + c) * T + b * 2048 + t]);
        const float val = gate * (acc + bf1(in[t]) * p.in[I_FBIAS][o * 1024 + c]);
        const float got = bf1((o == 0 ? ZT : Y2T)[(size_t)c * T + b * 2048 + t]); d = fabsf(got - val) / (fabsf(val) + 0.1f);
    } else if (mode == 4) {
        const int tok = hsh % 65536u, n = h2 % 1024u; float acc = 0.f;
#pragma unroll 1
        for (int c = lane; c < 1024; c += 64) acc += bf1(Y2T[(size_t)c * T + tok]) * p.in[I_WOUTHY][(size_t)c * 1024 + n];
        acc = wave_sum(acc);
        const float got = bf1(MIX[(size_t)tok * D + n]); d = fabsf(got - acc) / (fabsf(acc) + 0.1f);
    }
    dbg_report_wave(p, d, lane);
}
__device__ __forceinline__ void dbg_inproj_check(const Params& p, unsigned char* big, int lane, int wave) {
    const unsigned hsh = dbg_hash(blockIdx.x * 8u + wave + 777u), h2 = dbg_hash(hsh);
    const bf16* H0 = (const bf16*)(big + A0_H); const float* W = p.in[I_WINAB];
    int m = hsh % (unsigned)TT; int n = h2 % 3600u;
    const bool ctx = m >= T; if (ctx && n < 1536) n += 1536;
    const int b = ctx ? (m - T) / LC : m / SEQ, s = ctx ? (m - T) % LC : m % SEQ;
    float x = 0.f, xp = 0.f; const bool rope_col = (n < 512) || (n >= 1536 && n < 2048); const int np = rope_col ? (n ^ 16) : n;
#pragma unroll 1
    for (int k = lane; k < 1024; k += 64) { const float hv = bf1(H0[(size_t)m * D + k]); x += hv * W[(size_t)k * 3600 + n]; xp += hv * W[(size_t)k * 3600 + np]; }
    x = wave_sum(x); xp = wave_sum(xp);
    float val = x, got = 0.f;
    if (n >= 3584) { val = x + p.in[I_GATEB][n - 3584]; got = ((const float*)(p.ws + WS_GATES))[(size_t)m * 16 + (n - 3584)]; }
    else { const int t = n / 512, cn = n % 512; int pc = cn;
        if (rope_col) { const int o = cn & 31; pc = (cn & ~31) + (((o & 15) >> 2) * 8 + (o >> 4) * 4 + (o & 3));
            if (!ctx) { const int d = cn & 63, axis = d >> 5, half = (d >> 4) & 1, i = d & 15; const float pos = (float)(axis == 0 ? (s >> 6) : (s & 63)); const float ang = pos * powf(10000.f, -(float)i / 16.f);
                val = half == 0 ? x * cosf(ang) - xp * sinf(ang) : x * cosf(ang) + xp * sinf(ang); } }
        if (t == 0) val *= QSCALE;
        const size_t offs[7] = {A0_QA, A0_BQ, A0_BO, A0_KA, A0_VA, A0_BK, A0_BV}; const bool kv = t >= 3;
        const bf16* O = (const bf16*)(big + offs[t]) + (size_t)b * (kv ? (SEQ + LC) : SEQ) * 512 + (size_t)((kv && !ctx) ? LC : 0) * 512;
        got = bf1(O[(size_t)s * 512 + pc]); }
    dbg_report_wave(p, fabsf(got - val) / (fabsf(val) + 0.1f), lane);
}
__device__ __forceinline__ void dbg_attn_check(const Params& p, unsigned char* big, LAS unsigned char* lds, int lane, int wave) {
    const unsigned hsh = dbg_hash(blockIdx.x * 8u + wave + 4242u), h2 = dbg_hash(hsh);
    const int b = hsh % 32u, h = (hsh >> 8) % 4u, q = h2 % 2048u;
    const bf16* QA = (const bf16*)(big + A0_QA) + ((size_t)b * SEQ + q) * 512 + h * 128; const bf16* KA = (const bf16*)(big + A0_KA) + (size_t)b * 2304 * 512 + h * 128;
    const bf16* VA = (const bf16*)(big + A0_VA) + (size_t)b * 2304 * 512 + h * 128; const bf16* MIXIN = (const bf16*)(big + A0_MIXIN) + ((size_t)b * SEQ + q) * D + h * 128;
    LAS float* Aw = (LAS float*)(lds + wave * 18432);
    const float* lv = p.in[I_DLAM]; const float lam = expf(wave_sum(lv[lane] * lv[64 + lane])) - expf(wave_sum(lv[128 + lane] * lv[192 + lane])) + 0.2f;
    float mx0 = -1e30f, mx1 = -1e30f;
#pragma unroll 1
    for (int key = lane; key < 2304; key += 64) { float s0 = 0.f, s1 = 0.f;
#pragma unroll 1
        for (int d = 0; d < 64; ++d) { s0 += bf1(QA[d]) * bf1(KA[(size_t)key * 512 + d]); s1 += bf1(QA[64 + d]) * bf1(KA[(size_t)key * 512 + 64 + d]); }
        Aw[key] = s0; Aw[2304 + key] = s1; mx0 = fmaxf(mx0, s0); mx1 = fmaxf(mx1, s1); }
    mx0 = wave_max(mx0); mx1 = wave_max(mx1);
    float l0 = 0.f, l1 = 0.f;
#pragma unroll 1
    for (int key = lane; key < 2304; key += 64) { const float e0 = exp2f(Aw[key] - mx0), e1 = exp2f(Aw[2304 + key] - mx1); Aw[key] = e0; Aw[2304 + key] = e1; l0 += e0; l1 += e1; }
    l0 = wave_sum(l0); l1 = wave_sum(l1);
    LDS_WAIT(); asm volatile("" ::: "memory");
    float o[2] = {0.f, 0.f};
#pragma unroll 1
    for (int key = 0; key < 2304; ++key) { const float a = Aw[key] / l0 - lam * Aw[2304 + key] / l1; o[0] += a * bf1(VA[(size_t)key * 512 + lane]); o[1] += a * bf1(VA[(size_t)key * 512 + 64 + lane]); }
    const float ms = wave_sum(o[0] * o[0] + o[1] * o[1]) * (1.f / 128.f); const float rn = rsqrtf(ms + RMS_EPS) * 0.8f;
    float err = 0.f, sc = 0.f;
#pragma unroll
    for (int j = 0; j < 2; ++j) { const float val = o[j] * rn * p.in[I_HGA][h * 128 + 64 * j + lane]; err = fmaxf(err, fabsf(val - bf1(MIXIN[64 * j + lane]))); sc += val * val; }
    err = wave_max(err); sc = sqrtf(wave_sum(sc) * (1.f / 128.f));
    dbg_report_wave(p, err / (sc + 1e-3f), lane);
}
__device__ __forceinline__ float dbg_convsilu(const bf16* base, int pos, int lim, int ch, int d, const float* cw, const float* cb) {
    float s = cb[ch];
#pragma unroll
    for (int j = 0; j < 3; ++j) { const int pj = pos + j - 1; if (pj >= 0 && pj < lim) s += cw[j * 1024 + ch] * bf1(base[(size_t)pj * 512 + d]); }
    return s / (1.f + expf(-s));
}
__device__ __forceinline__ void dbg_mlstm_check(const Params& p, unsigned char* big, LAS unsigned char* lds, int lane, int wave) {
    const unsigned hsh = dbg_hash(blockIdx.x * 8u + wave + 991u), h2 = dbg_hash(hsh);
    const int b = hsh % 32u, h = (hsh >> 8) % 4u, dir = (hsh >> 12) & 1; int tau = h2 % 2048u; if ((h2 >> 16) % 4u == 0u) tau = (h2 >> 20) % 130u;
    const bf16* BQ = (const bf16*)(big + A0_BQ) + (size_t)b * SEQ * 512 + h * 128; const bf16* BK = (const bf16*)(big + A0_BK) + (size_t)b * (SEQ + LC) * 512 + h * 128;
    const bf16* BV = (const bf16*)(big + A0_BV) + (size_t)b * (SEQ + LC) * 512 + h * 128;
    const float* GT = (const float*)(p.ws + WS_GATES); const float* cw = p.in[I_CONVABW]; const float* cb = p.in[I_CONVABB];
    LAS float* F = (LAS float*)(lds + wave * 18432); LAS float* qv = F + 2304 + 64;
    const int N = 256 + tau + 1;
#define DBG_POS(u) ((u) < 256 ? (dir ? 255 - (u) : (u)) : (dir ? 2047 - ((u) - 256) : (u) - 256))
#define DBG_GROW(u) ((u) < 256 ? (size_t)T + b * LC + DBG_POS(u) : (size_t)b * SEQ + DBG_POS(u))
    float carry = 0.f;
#pragma unroll 1
    for (int u0 = 0; u0 < N; u0 += 64) { const int u = u0 + lane; float lf = 0.f;
        if (u < N) { const float x = GT[DBG_GROW(u) * 16 + dir * 8 + 4 + h]; lf = x >= 0.f ? -__logf(1.f + __expf(-x)) : x - __logf(1.f + __expf(x)); }
        float s = lf;
#pragma unroll
        for (int o = 1; o < 64; o <<= 1) { const float v = shup(s, o); if (lane >= o) s += v; }
        if (u < N) F[u] = carry + s; carry += shidx(s, 63); }
    LDS_WAIT(); asm volatile("" ::: "memory");
    const float Ft = F[N - 1];
    float mm = Ft;
#pragma unroll 1
    for (int u = lane; u < N; u += 64) mm = fmaxf(mm, Ft - F[u] + GT[DBG_GROW(u) * 16 + dir * 8 + h]);
    mm = wave_max(mm);
    { const int pos = DBG_POS(N - 1);
      for (int d = lane; d < 128; d += 64) qv[d] = dbg_convsilu(BQ, pos, SEQ, h * 128 + d, d, cw, cb) * 0.08838834764831845f; }
    LDS_WAIT(); asm volatile("" ::: "memory");
    float den = 0.f;
#pragma unroll 1
    for (int u = lane; u < N; u += 64) { const bool ctx = u < 256; const int pos = DBG_POS(u); const bf16* kb = ctx ? BK : BK + (size_t)LC * 512; float qk = 0.f;
#pragma unroll 1
        for (int d = 0; d < 128; ++d) qk += qv[d] * dbg_convsilu(kb, pos, ctx ? LC : SEQ, 512 + h * 128 + d, d, cw, cb);
        const float om = qk * expf(Ft - F[u] + GT[DBG_GROW(u) * 16 + dir * 8 + h] - mm); F[u] = om; den += om; }
    den = wave_sum(den);
    LDS_WAIT(); asm volatile("" ::: "memory");
    float num[2] = {0.f, 0.f};
#pragma unroll 1
    for (int u = 0; u < N; ++u) { const bool ctx = u < 256; const int pos = DBG_POS(u); const bf16* vb = BV + (size_t)((ctx ? 0 : LC) + pos) * 512; num[0] += F[u] * bf1(vb[lane]); num[1] += F[u] * bf1(vb[64 + lane]); }
    const float dd = 1.f / fmaxf(fabsf(den), expf(-mm));
    const bf16* HB = (const bf16*)(big + A0_HB) + (size_t)dir * T * 512 + ((size_t)b * SEQ + DBG_POS(N - 1)) * 512 + h * 128;
    float err = 0.f, sc = 0.f;
#pragma unroll
    for (int j = 0; j < 2; ++j) { const float val = num[j] * dd; err = fmaxf(err, fabsf(val - bf1(HB[64 * j + lane]))); sc += val * val; }
    err = wave_max(err); sc = sqrtf(wave_sum(sc) * (1.f / 128.f));
    dbg_report_wave(p, err / (sc + 1e-3f), lane);
#undef DBG_POS
#undef DBG_GROW
}

__global__ void __launch_bounds__(NTHR, 2) mk_fwd(Params p0) {
    extern __shared__ __attribute__((aligned(16))) unsigned char lds_raw[];
    LAS unsigned char* lds = (LAS unsigned char*)lds_raw;
    const int wave0 = __builtin_amdgcn_readfirstlane((int)threadIdx.x >> 6);
    if (threadIdx.x < 64) ((LAS unsigned*)(lds + LDS_MISC))[threadIdx.x] = 0u;
    __syncthreads();
    XcdBarrier bar = xcd_barrier_post((unsigned*)(p0.ws + WS_CTL) + CW_BAR, (volatile LAS unsigned*)(lds + LDS_MISC + 32));
    const int G = gridDim.x, cb = blockIdx.x;
    const int vcu = (G % 8 == 0) ? (cb % 8) * (G / 8) + cb / 8 : cb;
#ifdef TIMEK
    int phc = 0; if (blockIdx.x == 0 && threadIdx.x == 0) ((unsigned long long*)(p0.ws + WS_CTL + 32768))[0] = __builtin_amdgcn_s_memrealtime();
#endif
#ifdef DBL_PH
#define DBL_LOOP for (int rep_ = 0; rep_ < 1; ++rep_)
#define DBL_SYNC __syncthreads();
#else
#define DBL_LOOP
#define DBL_SYNC
#endif
#ifdef TIMEK
#define TS_REC { ++phc; if (blockIdx.x == 0 && wave0 == 0 && lane_opq() == 0) ((unsigned long long*)(p0.ws + WS_CTL + 32768))[phc] = __builtin_amdgcn_s_memrealtime(); }
#else
#define TS_REC
#endif
#define LAYER_PTRS bf16* H2 = (bf16*)(big + (l == 0 ? 0 : 128 * MiB)); float* LOG = nullptr; bf16* ACT = (bf16*)(big + (l == 0 ? 144 * MiB : 272 * MiB)); \
        bf16* Y = (bf16*)(big + (l == 0 ? 304 * MiB : 432 * MiB)); bf16* HN = (bf16*)(big + 640 * MiB); const bf16* MIX = (const bf16*)(big + (l == 0 ? A0_MIX : 0)); \
        bf16* UT = (bf16*)big; bf16* UC = (bf16*)(big + 384 * MiB); bf16* ZT = (bf16*)(big + 384 * MiB); bf16* Y2T = (bf16*)(big + 512 * MiB); bf16* Y2 = (bf16*)(big + 640 * MiB); \
        (void)H2; (void)LOG; (void)ACT; (void)Y; (void)HN; (void)MIX; (void)UT; (void)UC; (void)ZT; (void)Y2T; (void)Y2;
#define RUN(...) do { { { int tid_ = wave0 * 64 + lane_opq(); asm volatile("" : "+v"(tid_)); const int tid = tid_, lane = tid & 63, wave = __builtin_amdgcn_readfirstlane(tid >> 6); (void)lane; (void)wave; \
        Params p = p0; { size_t z_ = 0; asm volatile("" : "+s"(z_)); p.ws = p0.ws + z_; p.out = p0.out + z_; _Pragma("unroll") for (int i_ = 0; i_ < 31; ++i_) p.in[i_] = p0.in[i_] + z_; } unsigned char* ws = p.ws; unsigned char* big = ws + WS_BIG; (void)big; LAYER_PTRS DBL_LOOP { __VA_ARGS__; DBL_SYNC } } { XcdBarrier b2_ = bar; { size_t z_ = 0; asm volatile("" : "+s"(z_)); b2_.bar = bar.bar + z_; unsigned x_ = bar.x; asm volatile("" : "+s"(x_)); b2_.x = x_; } xcd_barrier(b2_, wave0 == 0 && lane_opq() == 0); } TS_REC } } while (0)

    { const int l = 0; RUN({ pro_mod(p, lds, tid, lane, wave); __syncthreads(); pro_filters(p, lds, tid, lane, wave); pro_rope(p, tid); pro_transposes(p, lds, lane, wave); }); }

    for (int l = 0; l < 2; ++l) {
        if (l == 0) {
            RUN({ ph_l0_norm(p, lane, wave); });
            RUN({ Gemm g{(const bf16*)(big + A0_H), (const bf16*)(ws + WS_WIN0), 1024, 2048u}; InprojSched S{G, vcu};
                  EpiInproj E{big, (const float*)(ws + WS_ROPE), (float*)(ws + WS_GATES), p.in[I_GATEB]};
                  gemm_phase<EpiInproj, InprojSched>(lds, g, S, E, tid); });
#ifdef DBG_INPROJ
            RUN({ dbg_inproj_check(p, big, lane, wave); });
#endif
            RUN({ ph_transpose_b((const bf16*)(big + A0_VA), (bf16*)(big + A0_VT), NB, SEQ + LC, 512, lds, lane, wave); });
            RUN({ ph_attn(p, big, lds, tid, lane, wave, vcu); });
#ifdef DBG_ATTN
            RUN({ dbg_attn_check(p, big, lds, lane, wave); });
#endif
            RUN({ ph_mlstm(p, big, lds, tid, lane, wave); });
#ifdef DBG_MLSTM
            RUN({ dbg_mlstm_check(p, big, lds, lane, wave); });
#endif
            RUN({ ph_outb(p, big, lane, wave); });
            RUN({ Gemm g{(const bf16*)(big + A0_MIXIN), (const bf16*)(ws + WS_WOUT0), 1024, 2048u}; DenseSched S{4, 1024, G, vcu, 0}; EpiBf16 E{(bf16*)(big + A0_MIX), 1024, 3};
                  gemm_phase<EpiBf16, DenseSched>(lds, g, S, E, tid); });
        }
        if (l == 1) {
            RUN({ Gemm g{(const bf16*)(ws + WS_WIN1), HN, 1024, 2048u}; DenseSched S{256, 12 * 256, G, vcu, 12}; EpiBf16 E{UT, (size_t)T, 0xffff};
                  gemm_phase<EpiBf16, DenseSched>(lds, g, S, E, tid); });
#ifdef DBG_HY
            if (DBG_MODE == 0) { RUN({ dbg_hyena_check(p, 0, HN, UT, UT, UT, UT, lds, lane, wave); }); }
#endif
#ifdef DBG_HY
            if (DBG_MODE == 5) { RUN({ dbg_hyena_check(p, 5, HN, UC, UT, UT, UT, lds, lane, wave); }); }
#endif
            RUN({ ph_lconv<true>(p, 0, UT, UT, ZT, lds, tid, lane, wave); });
#ifdef DBG_HY
            if (DBG_MODE == 2) { RUN({ dbg_hyena_check(p, 2, HN, UC, ZT, Y2T, UT, lds, lane, wave); }); }
#endif
            RUN({ ph_lconv<false>(p, 1, ZT, UT, Y2T, lds, tid, lane, wave); });
#ifdef DBG_HY
            if (DBG_MODE == 3) { RUN({ dbg_hyena_check(p, 3, HN, UC, ZT, Y2T, UT, lds, lane, wave); }); }
#endif
            RUN({ ph_transpose(Y2T, Y2, lds, lane, wave); });
            RUN({ Gemm g{Y2, (const bf16*)(ws + WS_WOUT1), 1024, 2048u}; DenseSched S{4, 1024, G, vcu, 0}; EpiBf16 E{(bf16*)big, 1024, 3};
                  gemm_phase<EpiBf16, DenseSched>(lds, g, S, E, tid); });
        }
#ifdef DBG_HY
        if (l == 1 && (DBG_MODE == 1 || DBG_MODE == 4)) { RUN({ dbg_hyena_check(p, DBG_MODE, HN, (const bf16*)(big + 384 * MiB), (const bf16*)big, (const bf16*)(big + 128 * MiB), (const bf16*)big, lds, lane, wave); }); }
#endif
        RUN({ ph_mid(p, l, MIX, H2, true, lane, wave); });
        RUN({ Gemm g{H2, (const bf16*)(ws + WS_WR) + (size_t)l * 256 * 1024, 1024, 2048u}; DenseSched S{1, 256, G, vcu, 0}; EpiRouterLds E{};
              gemm_phase<EpiRouterLds, DenseSched>(lds, g, S, E, tid); __syncthreads(); ph_route_a(p, l, nullptr, vcu, lds, tid); });
#ifdef DBG_ROUTE
        RUN({ if (l == DBG_L) dbg_route_check(p, l, H2, LOG, lds, tid); ph_route_b(p, lds, tid); });
#else
        RUN({ ph_route_b(p, lds, tid); });
#endif
#define DO_G1(chx) do { const int NT = moe_tables(p, chx, lds, tid); \
            Gemm g{H2, (const bf16*)(ws + WS_GU) + (size_t)l * (65 * 512) * 1024, 1024, 2048u}; \
            MoeSched S{(const LAS int*)(lds + LDS_TAB), (const int*)(ws + WS_SORT) + (size_t)(chx) * CHROWS, NT * 2, G, vcu, 1, 2}; EpiSwiglu E{ACT}; \
            gemm_phase<EpiSwiglu, MoeSched>(lds, g, S, E, tid); } while (0)
        RUN({ DO_G1(0); });
        for (int ch = 0; ch < NCH; ++ch) {
            RUN({ const int NT = moe_tables(p, ch, lds, tid);
                  Gemm g{ACT, (const bf16*)(ws + WS_DN) + (size_t)l * (65 * 1024) * 256, 256, 512u};
                  MoeSched S{(const LAS int*)(lds + LDS_TAB), nullptr, NT * 4, G, vcu, 2, 4}; EpiFp8 E{(unsigned char*)Y};
                  gemm_phase<EpiFp8, MoeSched>(lds, g, S, E, tid); });
            RUN({ const int par = (cb >> 3) & 1;
                  _Pragma("unroll 1") for (int part = 0; part < 2; ++part) { int t2_ = tid; asm volatile("" : "+v"(t2_)); const int tid = t2_, lane = tid & 63; (void)lane; if ((part ^ par) == 0) { if (ch + 1 < NCH) DO_G1(ch + 1); } else { ph_combine(p, l, ch, (const unsigned char*)Y, HN, lane, wave); } __syncthreads(); } });
        }
    }
#ifdef TIMEK
    if (blockIdx.x == 0) { const unsigned long long* ts = (const unsigned long long*)(p0.ws + WS_CTL + 32768); __syncthreads();
        const unsigned long long d = (__hip_atomic_load(ts + TIMEK, __ATOMIC_RELAXED, __HIP_MEMORY_SCOPE_AGENT) - __hip_atomic_load(ts + TIMEK0, __ATOMIC_RELAXED, __HIP_MEMORY_SCOPE_AGENT)) * 4ull, t0 = __builtin_amdgcn_s_memrealtime();
        while (__builtin_amdgcn_s_memrealtime() - t0 < d) __builtin_amdgcn_s_sleep(8); }
#endif
#ifdef DBG_ANY
    xcd_barrier(bar, threadIdx.x == 0);
    if (blockIdx.x == 0 && threadIdx.x == 0) p0.out[0] += 1.0e7f * __uint_as_float(((const unsigned*)(p0.ws + WS_CTL))[CW_DBG]);
#endif
#undef RUN
}
constexpr int NPHASES = 1 + 2 * (4 + 3 * NCH) + 6 + 64;
}

extern "C" void kernel_launch(void* const* d_in, const int* in_sizes, int n_in, void* d_out, int out_size, void* d_ws, size_t ws_size, hipStream_t stream) {
    using namespace mk;
    static int grid = 0;
    if (grid == 0) {
        if (n_in != 31 || out_size != T * D || ws_size < WS_END) { fprintf(stderr, "kernel_launch: unexpected shapes (n_in %d, out %d, ws %zu)\n", n_in, out_size, ws_size); grid = -1; return; }
        int dev = 0, cus = 0;
        if (hipGetDevice(&dev) != hipSuccess || hipDeviceGetAttribute(&cus, hipDeviceAttributeMultiprocessorCount, dev) != hipSuccess) { grid = -1; return; }
        if (hipFuncSetAttribute((const void*)mk_fwd, hipFuncAttributeMaxDynamicSharedMemorySize, LDS_BYTES) != hipSuccess) { fprintf(stderr, "kernel_launch: hipFuncSetAttribute failed\n"); grid = -1; return; }
        int per_cu = 0;
        if (hipOccupancyMaxActiveBlocksPerMultiprocessor(&per_cu, (const void*)mk_fwd, NTHR, LDS_BYTES) != hipSuccess || per_cu < 1) { fprintf(stderr, "kernel_launch: occupancy query says %d\n", per_cu); }
        (void)hipGetLastError();
        grid = cus;
        if (grid != 256) { fprintf(stderr, "kernel_launch: built for 256 CUs, found %d\n", grid); grid = -1; return; }
    }
    if (grid < 0) return;
    (void)hipMemsetAsync((char*)d_ws + WS_CTL, 0, CTL_ZERO_BYTES, stream);
    Params a{};
    for (int i = 0; i < 31; ++i) a.in[i] = (const float*)d_in[i];
    a.out = (float*)d_out; a.ws = (unsigned char*)d_ws; a.ph_lo = 0; a.ph_hi = NPHASES;
    hipLaunchKernelGGL(mk_fwd, dim3(grid), dim3(NTHR), LDS_BYTES, stream, a);
}
```

```cpp
#include <hip/hip_runtime.h>
#include <cstdio>
#include <cstdint>
namespace pg8 {
#define PG8_LAS __attribute__((address_space(3)))
typedef unsigned short bf16_t;
typedef short bf16x8 __attribute__((ext_vector_type(8)));
typedef float f32x4 __attribute__((ext_vector_type(4)));
typedef unsigned u32x4 __attribute__((ext_vector_type(4)));
typedef unsigned u32x2 __attribute__((ext_vector_type(2)));
constexpr int BM = 256, BK = 64, HALF = 128, HTB = HALF * BK * 2  , STAGE_BYTES = 8 * HTB;

__host__ __device__ __forceinline__ int lds_byte(int r, int c) { const int st = (r >> 4) * 2 + (c >> 5), rr = r & 15, cc = c & 31, ob = rr * 64 + cc * 2; return st * 1024 + (ob ^ (((ob >> 9) & 1) << 5)); }
__host__ __device__ __forceinline__ void stage_rc(int b, int& R, int& C) { const int st = b / 1024, sb = b % 1024, swz = sb ^ (((sb >> 9) & 1) << 5); R = (st >> 1) * 16 + swz / 64; C = (st & 1) * 32 + (swz % 64) / 2; }
__host__ __device__ __forceinline__ int perm32(int rho) { const int n = rho >> 4, i = rho & 15; return 8 * (i >> 2) + 4 * n + (i & 3); }

struct Unit { int pm, pn; };
__device__ __forceinline__ unsigned cvt_pk_bf16(float lo, float hi) { unsigned r; asm volatile("v_cvt_pk_bf16_f32 %0, %1, %2" : "=v"(r) : "v"(lo), "v"(hi)); return r; }
struct Gemm { const bf16_t* A; const bf16_t* Bt; int K; unsigned lda_bytes; };
template <class Epi, class Sched, bool ALIGN_EPI = true>
__device__ __forceinline__ void gemm_phase(PG8_LAS unsigned char* lds, const Gemm g, const Sched& S, const Epi& E, const int tid_in) {
    int tid_ = tid_in; asm volatile("" : "+v"(tid_));
    const int tid = tid_, wid = __builtin_amdgcn_readfirstlane(tid >> 6), lane = tid & 63, wr = wid >> 2, wc = wid & 3, fr = lane & 15, fq = lane >> 4;
    const int K = g.K, nt = K / BK;
    unsigned voffB[2];
#pragma unroll
    for (int i = 0; i < 2; ++i) { int R, C; stage_rc(tid * 16 + i * 8192, R, C); const int Rb = Epi::PERM ? ((R & ~31) + perm32(R & 31)) : R;
        voffB[i] = (unsigned)(Rb * K + C) * 2u; }
    const size_t kstep = (size_t)(BK * 2);
    const size_t hstep = (size_t)HALF * K * 2;
    const size_t tstep = 2 * hstep;
    const unsigned ldsw = (unsigned)wid * 1024u;
    const int aoff = lds_byte(wr * 64 + fr, fq * 8), boff = lds_byte(wc * 32 + fr, fq * 8);
    const char* Ab = (const char*)g.A;
#define PG8_SA(b, h) (((b) * 2 + (h)) * HTB)
#define PG8_SB(b, h) ((4 + (b) * 2 + (h)) * HTB)
#define PG8_STAGE(bufoff, gbase, voff) do { _Pragma("unroll") for (int _i = 0; _i < 2; ++_i) \
        __builtin_amdgcn_global_load_lds((const unsigned*)((const char*)(gbase) + (voff)[_i]), (PG8_LAS unsigned*)(lds + (bufoff) + ldsw + _i * 8192), 16, 0, 0); } while (0)
#define PG8_STAGEA(bufoff, o0, o1, kb) do { \
        __builtin_amdgcn_global_load_lds((const unsigned*)(Ab + (size_t)(o0) + (size_t)(kb)), (PG8_LAS unsigned*)(lds + (bufoff) + ldsw), 16, 0, 0); \
        __builtin_amdgcn_global_load_lds((const unsigned*)(Ab + (size_t)(o1) + (size_t)(kb)), (PG8_LAS unsigned*)(lds + (bufoff) + ldsw + 8192), 16, 0, 0); } while (0)
#define PG8_LDA(dst, b, h) do { _Pragma("unroll") for (int m = 0; m < 4; ++m) _Pragma("unroll") for (int k = 0; k < 2; ++k) dst[m][k] = *(const PG8_LAS bf16x8*)(lds + PG8_SA(b, h) + aoff + m * 2048 + k * 1024); } while (0)
#define PG8_LDB(dst, b, h) do { _Pragma("unroll") for (int n = 0; n < 2; ++n) _Pragma("unroll") for (int k = 0; k < 2; ++k) dst[n][k] = *(const PG8_LAS bf16x8*)(lds + PG8_SB(b, h) + boff + n * 2048 + k * 1024); } while (0)
#define PG8_MMA(ai, bj, At, Bt) do { __builtin_amdgcn_s_setprio(1); _Pragma("unroll") for (int m = 0; m < 4; ++m) _Pragma("unroll") for (int n = 0; n < 2; ++n) _Pragma("unroll") for (int k = 0; k < 2; ++k) \
        acc[ai][bj][m][n] = __builtin_amdgcn_mfma_f32_16x16x32_bf16(Bt[n][k], At[m][k], acc[ai][bj][m][n], 0, 0, 0); __builtin_amdgcn_s_setprio(0); } while (0)
#define PG8_WAIT_V(n) asm volatile("s_waitcnt vmcnt(" #n ")" ::: "memory")
#define PG8_WAIT_L(n) asm volatile("s_waitcnt lgkmcnt(" #n ")" ::: "memory")
#define PG8_BAR __builtin_amdgcn_s_barrier()
#define PG8_SCHED __builtin_amdgcn_sched_barrier(0)
#define PG8_OFFS(dst, u) do { _Pragma("unroll") for (int _i = 0; _i < 2; ++_i) { int _R, _C; stage_rc(tid * 16 + _i * 8192, _R, _C); _Pragma("unroll") for (int _h = 0; _h < 2; ++_h) \
        dst[_h][_i] = (unsigned)S.arow((u).pm * BM + _h * HALF + _R) * g.lda_bytes + (unsigned)(_C * 2); } } while (0)
    Unit cur, nxt; int ui = 0;
    if (!S.next(0, cur)) return;
    f32x4 acc[2][2][4][2];
#pragma unroll
    for (int a = 0; a < 2; ++a)
#pragma unroll
        for (int b = 0; b < 2; ++b)
#pragma unroll
            for (int m = 0; m < 4; ++m)
#pragma unroll
                for (int n = 0; n < 2; ++n) acc[a][b][m][n] = (f32x4){0.f, 0.f, 0.f, 0.f};
    bf16x8 At[4][2], B0[2][2], B1[2][2];
    unsigned oC[2][2], oN[2][2];
    PG8_OFFS(oC, cur);
    const char* cB = (const char*)g.Bt + (size_t)cur.pn * tstep;
    PG8_STAGE(PG8_SB(0, 0), cB, voffB); PG8_STAGE(PG8_SB(0, 1), cB + hstep, voffB); PG8_STAGEA(PG8_SA(0, 0), oC[0][0], oC[0][1], 0); PG8_STAGEA(PG8_SA(0, 1), oC[1][0], oC[1][1], 0);
    if (wr == 1) PG8_BAR;
    PG8_WAIT_V(2); PG8_BAR;
    PG8_STAGE(PG8_SB(1, 0), cB + kstep, voffB); PG8_STAGEA(PG8_SA(1, 0), oC[0][0], oC[0][1], kstep); PG8_STAGE(PG8_SB(1, 1), cB + hstep + kstep, voffB);
    PG8_WAIT_V(6); PG8_BAR;
#ifdef GM_PROBE
    unsigned long long gaccs[3] = {0, 0, 0}; unsigned long long gtp = __builtin_amdgcn_s_memrealtime();
#define GM_T(i) do { if (Epi::PROBE) { const unsigned long long t1_ = __builtin_amdgcn_s_memrealtime(); gaccs[i] += t1_ - gtp; gtp = t1_; } } while (0)
#else
#define GM_T(i)
#endif
    for (;;) {
        const bool has_next = S.next(ui + 1, nxt);
        if (has_next) { PG8_OFFS(oN, nxt); } else {
#pragma unroll
            for (int _h = 0; _h < 2; ++_h)
#pragma unroll
                for (int _i = 0; _i < 2; ++_i) oN[_h][_i] = oC[_h][_i]; }
        const char* nB = has_next ? (const char*)g.Bt + (size_t)nxt.pn * tstep : cB;
#pragma unroll 1
        for (int t = 0; t < nt; t += 2) {
            const bool last = (t == nt - 2);
            const size_t k1 = (size_t)(t + 1) * kstep;
            const size_t k2 = last ? 0 : (size_t)(t + 2) * kstep, k3 = k2 + kstep;
            const char* b2 = last ? nB : cB + (size_t)(t + 2) * kstep; const char* b3 = b2 + kstep;
            PG8_LDB(B0, 0, 0); PG8_LDB(B1, 0, 1); PG8_SCHED; PG8_LDA(At, 0, 0); PG8_STAGEA(PG8_SA(1, 1), oC[1][0], oC[1][1], k1);
            if (last) { oC[0][0] = oN[0][0]; oC[0][1] = oN[0][1]; oC[1][0] = oN[1][0]; oC[1][1] = oN[1][1]; }
            PG8_WAIT_V(8); PG8_WAIT_L(0); PG8_BAR; PG8_MMA(0, 0, At, B0); PG8_MMA(0, 1, At, B1); PG8_BAR; PG8_SCHED;
            PG8_LDA(At, 0, 1); PG8_STAGE(PG8_SB(0, 0), b2, voffB); PG8_STAGE(PG8_SB(0, 1), b2 + hstep, voffB); PG8_STAGEA(PG8_SA(0, 0), oC[0][0], oC[0][1], k2);
            PG8_WAIT_V(8); PG8_WAIT_L(0); PG8_BAR; PG8_MMA(1, 0, At, B0); PG8_MMA(1, 1, At, B1); PG8_BAR; PG8_SCHED;
            PG8_LDB(B0, 1, 0); PG8_LDB(B1, 1, 1); PG8_SCHED; PG8_LDA(At, 1, 0); PG8_STAGEA(PG8_SA(0, 1), oC[1][0], oC[1][1], k2);
            PG8_WAIT_V(8); PG8_WAIT_L(0); PG8_BAR; PG8_MMA(0, 0, At, B0); PG8_MMA(0, 1, At, B1); PG8_BAR; PG8_SCHED;
            PG8_LDA(At, 1, 1); PG8_STAGE(PG8_SB(1, 0), b3, voffB); PG8_STAGE(PG8_SB(1, 1), b3 + hstep, voffB); PG8_STAGEA(PG8_SA(1, 0), oC[0][0], oC[0][1], k3);
            PG8_WAIT_V(8); PG8_WAIT_L(0); PG8_BAR; PG8_MMA(1, 0, At, B0); PG8_MMA(1, 1, At, B1); PG8_BAR; PG8_SCHED;
        }
        GM_T(0);
        if constexpr (ALIGN_EPI) { if (wr == 0) PG8_BAR; }
        GM_T(1);
        E(acc, cur, wr, wc, fr, fq);
        GM_T(2);
        if (!has_next) break;
#pragma unroll
        for (int a = 0; a < 2; ++a)
#pragma unroll
            for (int b = 0; b < 2; ++b)
#pragma unroll
                for (int m = 0; m < 4; ++m)
#pragma unroll
                    for (int n = 0; n < 2; ++n) acc[a][b][m][n] = (f32x4){0.f, 0.f, 0.f, 0.f};
        cur = nxt; cB = nB; ++ui;
#pragma unroll
        for (int _h = 0; _h < 2; ++_h)
#pragma unroll
            for (int _i = 0; _i < 2; ++_i) oC[_h][_i] = oN[_h][_i];
        if constexpr (ALIGN_EPI) { if (wr == 1) PG8_BAR; }
    }
#ifdef GM_PROBE
    if (Epi::PROBE && blockIdx.x == 0 && tid == 0) { unsigned long long* ts = (unsigned long long*)(S.probe_ts()); if (ts) { ts[50] = 0; ts[51] = gaccs[0]; ts[52] = gaccs[0] + gaccs[1]; ts[53] = gaccs[0] + gaccs[1] + gaccs[2]; } }
#endif
    PG8_WAIT_V(0);
    if constexpr (!ALIGN_EPI) { if (wr == 0) PG8_BAR; }
    PG8_BAR;
    if constexpr (Epi::AFTER_DRAIN) E.fused(acc, cur, wr, wc, fr, fq, lds);
#undef PG8_SA
#undef PG8_SB
#undef PG8_STAGE
#undef PG8_STAGEA
#undef PG8_LDA
#undef PG8_LDB
#undef PG8_MMA
#undef PG8_WAIT_V
#undef PG8_WAIT_L
#undef PG8_BAR
#undef PG8_SCHED
#undef PG8_OFFS
#undef GM_T
}

template <class Epi, class Sched>
__device__ __noinline__ void gemm_phase_ni(PG8_LAS unsigned char* lds, Gemm g, Sched S, Epi E) { gemm_phase<Epi, Sched>(lds, g, S, E, (int)threadIdx.x); }
}

namespace mk {
using namespace pg8;
constexpr int D = 1024, NB = 32, SEQ = 2048, T = NB * SEQ, LC = 256, TC = NB * LC, TT = T + TC;
constexpr int NMOD = 6 * D;
constexpr int NE = 64, NEX = 65, DE = 256;
constexpr int NCH = 2, CHT = T / NCH, BPC = 256 / NCH;
constexpr int MAXTILES = (CHT * 8 + 64 * 255) / 256 + CHT / 256 + 1, CHROWS = MAXTILES * 256;
constexpr float RMS_EPS = 1e-6f;
constexpr int NWAVES = 8, NTHR = 512;

constexpr size_t MiB = 1u << 20;
constexpr size_t WS_CTL = 0, CTL_ZERO_BYTES = 64 * 1024;
constexpr size_t WS_MOD = 1 * MiB;
constexpr size_t WS_ROPE = 3 * MiB;
constexpr size_t WS_BC = 3 * MiB + 65536;
constexpr size_t WS_TEG = 3 * MiB + 2 * 65536;
constexpr size_t WS_GATES = 4 * MiB;
constexpr size_t WS_FILT = 10 * MiB;
constexpr size_t WS_EIDX = 18 * MiB, WS_WTS = 20 * MiB, WS_PSLOT = 22 * MiB, WS_SORT = 26 * MiB;
constexpr size_t WS_WIN0 = 30 * MiB;
constexpr size_t WS_WOUT0 = 38 * MiB, WS_WIN1 = 40 * MiB, WS_WOUT1 = 46 * MiB, WS_WR = 48 * MiB;
constexpr size_t WS_GU = 50 * MiB;
constexpr size_t WS_DN = 180 * MiB;
constexpr size_t WS_BIG = 246 * MiB;
constexpr size_t WS_END = 1024 * MiB;
static_assert(WS_PSLOT + (size_t)T * 16 * 4 <= WS_SORT && WS_SORT + (size_t)NCH * CHROWS * 4 <= WS_WIN0 && WS_WIN0 + (size_t)3840 * 2048 <= WS_WOUT0 && WS_WR + (size_t)2 * 256 * 2048 <= WS_GU && WS_GU + (size_t)2 * 65 * 512 * 2048 <= WS_DN && WS_DN + (size_t)2 * 65 * 1024 * 512 <= WS_BIG, "ws map");
constexpr size_t A0_H = 0, A0_QA = 144 * MiB, A0_KA = 208 * MiB, A0_VA = 280 * MiB, A0_BQ = 352 * MiB, A0_BK = 416 * MiB, A0_BV = 488 * MiB, A0_BO = 560 * MiB, A0_VT = 624 * MiB;
constexpr size_t A0_MIXIN = 0, A0_HB = 144 * MiB, A0_MIX = 352 * MiB;
constexpr int CW_BAR = 4096;

constexpr int LDS_BYTES = 160 * 1024;
constexpr int LDS_TAB = 131072;
constexpr int LDS_MISC = 131072 + 24 * 1024;

#define GAS __attribute__((address_space(1)))
#define LAS __attribute__((address_space(3)))
typedef unsigned short bf16;
typedef unsigned v4u __attribute__((ext_vector_type(4)));
typedef unsigned v2u __attribute__((ext_vector_type(2)));
#define LDS_WAIT() asm volatile("s_waitcnt lgkmcnt(0)" ::: "memory")
#define VM_WAIT() asm volatile("s_waitcnt vmcnt(0)" ::: "memory")
__device__ __forceinline__ unsigned f2bf(float f) { unsigned u = __builtin_bit_cast(unsigned, f); return (u + 0x7fffu + ((u >> 16) & 1u)) >> 16; }
__device__ __forceinline__ unsigned pk2(float lo, float hi) { return f2bf(lo) | (f2bf(hi) << 16); }
__device__ __forceinline__ float bf_lo(unsigned w) { return __builtin_bit_cast(float, w << 16); }
__device__ __forceinline__ float bf_hi(unsigned w) { return __builtin_bit_cast(float, w & 0xffff0000u); }
__device__ __forceinline__ float bf1(bf16 h) { return __builtin_bit_cast(float, (unsigned)h << 16); }
__device__ __forceinline__ int lane_opq() { int l = (int)__builtin_amdgcn_mbcnt_hi(~0u, __builtin_amdgcn_mbcnt_lo(~0u, 0u)); asm volatile("" : "+v"(l)); return l; }
__device__ __forceinline__ float shx(float v, int m) { return __builtin_bit_cast(float, __builtin_amdgcn_ds_bpermute((lane_opq() ^ m) << 2, __builtin_bit_cast(int, v))); }
__device__ __forceinline__ float shup(float v, int o) { const int l = lane_opq(); return __builtin_bit_cast(float, __builtin_amdgcn_ds_bpermute((l >= o ? l - o : l) << 2, __builtin_bit_cast(int, v))); }
__device__ __forceinline__ float shidx(float v, int idx) { return __builtin_bit_cast(float, __builtin_amdgcn_ds_bpermute(idx << 2, __builtin_bit_cast(int, v))); }
__device__ __forceinline__ float wave_sum(float v) {
#pragma unroll
    for (int o = 1; o < 64; o <<= 1) v += shx(v, o);
    return v;
}
__device__ __forceinline__ float wave_max(float v) {
#pragma unroll
    for (int o = 1; o < 64; o <<= 1) v = fmaxf(v, shx(v, o));
    return v;
}
__device__ __forceinline__ float sigmoidf_(float x) { return 1.f / (1.f + __expf(-x)); }
__device__ __forceinline__ float siluf_(float x) { return x / (1.f + __expf(-x)); }
#define XB_TMO      128
#define XB_XCNT(j)  (256  + 64 * (j))
#define XB_XSUB(j)  (1280 + 64 * (j))
#define XB_XGEN(j)  (2304 + 64 * (j))
#define XB_TOP      3328
#define XB_TOPGEN   3392
#define XCD_BAR_WORDS 3456
#define XB_SPIN_CAP (1u << 18)

__device__ __forceinline__ unsigned xb_ld(unsigned* p)              { return __hip_atomic_load(p, __ATOMIC_RELAXED, __HIP_MEMORY_SCOPE_AGENT); }
__device__ __forceinline__ unsigned xb_add(unsigned* p, unsigned v) { return __hip_atomic_fetch_add(p, v, __ATOMIC_RELAXED, __HIP_MEMORY_SCOPE_AGENT); }
__device__ __forceinline__ unsigned xb_xcc_id() { return (unsigned)__builtin_amdgcn_s_getreg((3 << 11) | 20) & 0xFu; }
#define XB_SPIN(cond, bar) do { unsigned _sp = 0; while (cond) { __builtin_amdgcn_s_sleep(1); \
    if ((++_sp & 255u) == 0u) { if (xb_ld(&(bar)[XB_TMO])) break; if (_sp > XB_SPIN_CAP) { atomicAdd(&(bar)[XB_TMO], 1u); break; } } } } while (0)

struct XcdBarrier {
    unsigned* bar; unsigned x;
    volatile LAS unsigned* st;
};

__device__ __forceinline__ XcdBarrier xcd_barrier_post(unsigned* bar, volatile LAS unsigned* st) {
    XcdBarrier b; b.bar = bar; b.x = xb_xcc_id(); b.st = st;
    if (threadIdx.x == 0) (void)xb_add(&bar[XB_XCNT(b.x)], 1u);
    return b;
}
__device__ __forceinline__ void xcd_barrier_complete(unsigned* bar, unsigned x, unsigned& nloc, unsigned& nx) {
    const unsigned G = gridDim.x * gridDim.y * gridDim.z;
    unsigned sum, cnt, mine, sp = 0u;
    for (;;) {
        sum = 0u; cnt = 0u; mine = 0u;
#pragma unroll
        for (unsigned j = 0; j < 16; ++j) { const unsigned c = xb_ld(&bar[XB_XCNT(j)]); sum += c; cnt += (c > 0u) ? 1u : 0u; mine = (j == x) ? c : mine; }
        if (sum == G) break;
        __builtin_amdgcn_s_sleep(1);
        if ((++sp & 255u) == 0u) { if (xb_ld(&bar[XB_TMO])) break; if (sp > XB_SPIN_CAP) { atomicAdd(&bar[XB_TMO], 1u); break; } }
    }
    nloc = mine > 0u ? mine : 1u; nx = cnt > 0u ? cnt : 1u;
}

__device__ __forceinline__ void xcd_barrier(const XcdBarrier& b, const bool t0  ) {
    asm volatile("s_waitcnt vmcnt(0)" ::: "memory");
    __syncthreads();
    if (t0) {
        unsigned* bar = b.bar;
        __builtin_amdgcn_s_waitcnt(0);
        unsigned nloc = b.st[0], nx = b.st[1];
        if (nloc == 0u) { xcd_barrier_complete(bar, b.x, nloc, nx); b.st[0] = nloc; b.st[1] = nx; }
        const unsigned old = xb_add(&bar[XB_XSUB(b.x)], 1u);
        const unsigned gen = old / nloc;
        if (old + 1u == (gen + 1u) * nloc) {
            __builtin_amdgcn_fence(__ATOMIC_RELEASE, "agent");
            asm volatile("s_waitcnt vmcnt(0)" ::: "memory");
            const unsigned og = xb_add(&bar[XB_TOP], 1u);
            const unsigned tg = og / nx;
            if (og + 1u == (tg + 1u) * nx) xb_add(&bar[XB_TOPGEN], 1u);
            else XB_SPIN(xb_ld(&bar[XB_TOPGEN]) == tg, bar);
            __builtin_amdgcn_fence(__ATOMIC_ACQUIRE, "agent");
            xb_add(&bar[XB_XGEN(b.x)], 1u);
            asm volatile("s_waitcnt vmcnt(0)" ::: "memory");
        } else {
            XB_SPIN(xb_ld(&bar[XB_XGEN(b.x)]) == gen, bar);
            __builtin_amdgcn_fence(__ATOMIC_ACQUIRE, "agent");
            asm volatile("s_waitcnt vmcnt(0)" ::: "memory");
        }
    }
    __syncthreads();
}

constexpr float Y8_SCALE = 16.f, Y8_INV = 1.f / 16.f;
struct Params { const float* in[31]; float* out; unsigned char* ws; int ph_lo, ph_hi; };
enum { I_X = 0, I_C, I_CTX, I_CCTX, I_WMOD, I_BMOD, I_NORMG, I_WINAB, I_CONVABW, I_CONVABB, I_GATEB, I_DLAM, I_HGA, I_HGB, I_WOUTAB, I_WINHY, I_CONVHYW, I_CONVHYB,
       I_FW1, I_FB1, I_FW2, I_FB2, I_FW3, I_FBIAS, I_WOUTHY, I_RW, I_RB, I_EGU, I_EDN, I_SGU, I_SDN };

__device__ __forceinline__ void row_ld_f32(const float* row, int lane, f32x4 (&v)[4]) { const f32x4* r = (const f32x4*)row + lane;
#pragma unroll
    for (int j = 0; j < 4; ++j) v[j] = r[64 * j]; }
__device__ __forceinline__ void row_st_f32(float* row, int lane, const f32x4 (&v)[4]) { f32x4* r = (f32x4*)row + lane;
#pragma unroll
    for (int j = 0; j < 4; ++j) r[64 * j] = v[j]; }
__device__ __forceinline__ void row_ld_bf16(const bf16* row, int lane, f32x4 (&v)[4]) { const v2u* r = (const v2u*)row + lane;
#pragma unroll
    for (int j = 0; j < 4; ++j) { const v2u w = r[64 * j]; v[j] = (f32x4){bf_lo(w.x), bf_hi(w.x), bf_lo(w.y), bf_hi(w.y)}; } }
__device__ __forceinline__ void row_st_bf16(bf16* row, int lane, const f32x4 (&v)[4]) { v2u* r = (v2u*)row + lane;
#pragma unroll
    for (int j = 0; j < 4; ++j) { v2u w; w.x = pk2(v[j].x, v[j].y); w.y = pk2(v[j].z, v[j].w); r[64 * j] = w; } }
__device__ __forceinline__ float row_ss(const f32x4 (&v)[4]) { float s = 0.f;
#pragma unroll
    for (int j = 0; j < 4; ++j) s += (v[j].x * v[j].x + v[j].y * v[j].y) + (v[j].z * v[j].z + v[j].w * v[j].w);
    return wave_sum(s); }
__device__ __forceinline__ void row_modulate(const f32x4 (&x)[4], float rstd, const float* g, const float* shift, const float* scale, int lane, f32x4 (&h)[4]) {
    const f32x4* gp = (const f32x4*)g + lane; const f32x4* sh = (const f32x4*)shift + lane; const f32x4* sc = (const f32x4*)scale + lane;
#pragma unroll
    for (int j = 0; j < 4; ++j) { const f32x4 gg = gp[64 * j], s1 = sc[64 * j], s0 = sh[64 * j]; h[j] = x[j] * rstd * gg * (1.f + s1) + s0; } }

__device__ __forceinline__ void pro_mod(const Params& p, LAS unsigned char* lds, int tid, int lane, int wave) {
    const int u = blockIdx.x; if (u >= 192) return;
    LAS float* S = (LAS float*)lds;
    const float* c = p.in[I_C]; const float* cc = p.in[I_CCTX];
#pragma unroll 1
    for (int i = tid; i < 33 * 1024; i += NTHR) { const int b = i >> 10, k = i & 1023; const float v = b < 32 ? c[b * 1024 + k] : cc[k]; S[i] = siluf_(v); }
    __syncthreads();
    const int l = u / 96, cg = (u % 96) * 64, col = cg + lane;
    const float* W = p.in[I_WMOD] + (size_t)l * 1024 * NMOD;
    float acc[33];
#pragma unroll
    for (int b = 0; b < 33; ++b) acc[b] = 0.f;
    const int k0 = wave * 128;
#pragma unroll 1
    for (int kk = 0; kk < 128; kk += 4) { const int k = k0 + kk;
        const float w0 = W[(size_t)k * NMOD + col], w1 = W[(size_t)(k + 1) * NMOD + col], w2 = W[(size_t)(k + 2) * NMOD + col], w3 = W[(size_t)(k + 3) * NMOD + col];
#pragma unroll
        for (int b = 0; b < 33; ++b) { const f32x4 s = *(const LAS f32x4*)(S + b * 1024 + k); acc[b] += (s.x * w0 + s.y * w1) + (s.z * w2 + s.w * w3); } }
    __syncthreads();
    LAS float* P = (LAS float*)lds;
#pragma unroll
    for (int b = 0; b < 33; ++b) P[(wave * 33 + b) * 64 + lane] = acc[b];
    __syncthreads();
    float* MOD = (float*)(p.ws + WS_MOD);
#pragma unroll 1
    for (int i = tid; i < 33 * 64; i += NTHR) { const int b = i >> 6, ln = i & 63; float s = 0.f;
#pragma unroll
        for (int w = 0; w < 8; ++w) s += P[(w * 33 + b) * 64 + ln];
        MOD[(size_t)(l * 33 + b) * NMOD + cg + ln] = s + p.in[I_BMOD][l * NMOD + cg + ln]; }
    __syncthreads();
}
__device__ __forceinline__ int rowmap(int kind, int n) {
    if (kind == 1) { const int o = n & 31; return (n & ~31) + (((o & 15) >> 2) * 8 + (o >> 4) * 4 + (o & 3)); }
    if (kind == 2) { return n < 256 ? ((n >> 7) * 256 + (n & 127)) : ((((n - 256) >> 7) * 256) + 128 + ((n - 256) & 127)); }
    if (kind == 3) { const int a = n & 255; return (n & ~255) + 128 * ((a >> 3) & 1) + 32 * (a >> 6) + 8 * ((a >> 4) & 3) + (a & 7); }
    return n;
}
struct TrDesc { const float* W; bf16* WT; int ldn, k0, n0, nvalid, dK, kind, row_base; };
__device__ __forceinline__ TrDesc tr_decode(const Params& p, int it) {
    constexpr int I_A = 16 * 113, I_B = 512, I_C2 = 1536, I_D = 512, I_E = 64, I_F = 130 * 256;
    unsigned char* ws = p.ws; int r = it;
    if (r < I_A) { const int kb = r / 113, nb = r % 113, n0 = nb * 32; const int kind = (n0 < 512 || (n0 >= 1536 && n0 < 2048)) ? 1 : 0;
        return TrDesc{p.in[I_WINAB], (bf16*)(ws + WS_WIN0), 3600, kb * 64, n0, 3600, 1024, kind, 0}; } r -= I_A;
    if (r < I_B) return TrDesc{p.in[I_WOUTAB], (bf16*)(ws + WS_WOUT0), 1024, (r / 32) * 64, (r % 32) * 32, 1024, 1024, 0, 0}; r -= I_B;
    if (r < I_C2) return TrDesc{p.in[I_WINHY], (bf16*)(ws + WS_WIN1), 3072, (r / 96) * 64, (r % 96) * 32, 3072, 1024, 0, 0}; r -= I_C2;
    if (r < I_D) return TrDesc{p.in[I_WOUTHY], (bf16*)(ws + WS_WOUT1), 1024, (r / 32) * 64, (r % 32) * 32, 1024, 1024, 0, 0}; r -= I_D;
    if (r < I_E) { const int l = r / 32, q = r % 32; return TrDesc{p.in[I_RW] + (size_t)l * 1024 * 64, (bf16*)(ws + WS_WR) + (size_t)l * 256 * 1024, 64, (q / 2) * 64, (q % 2) * 32, 64, 1024, 0, 0}; } r -= I_E;
    if (r < I_F) { const int mat = r / 256, q = r % 256, l = mat / 65, e = mat % 65;
        const float* src = e < 64 ? p.in[I_EGU] + (size_t)(l * 64 + e) * 1024 * 512 : p.in[I_SGU] + (size_t)l * 1024 * 512;
        return TrDesc{src, (bf16*)(ws + WS_GU) + (size_t)l * (65 * 512) * 1024, 512, (q / 16) * 64, (q % 16) * 32, 512, 1024, 2, e * 512}; } r -= I_F;
    { const int mat = r / 128, q = r % 128, l = mat / 65, e = mat % 65;
        const float* src = e < 64 ? p.in[I_EDN] + (size_t)(l * 64 + e) * 256 * 1024 : p.in[I_SDN] + (size_t)l * 256 * 1024;
        return TrDesc{src, (bf16*)(ws + WS_DN) + (size_t)l * (65 * 1024) * 256, 1024, (q / 32) * 64, (q % 32) * 32, 1024, 256, 3, e * 1024}; }
}
__device__ __forceinline__ void tr_load(const TrDesc& d, int lane, float (&v)[32]) {
    const int nn = d.n0 + (lane & 31); const bool ok = nn < d.nvalid; const float* src = d.W + (size_t)(d.k0 + (lane >> 5)) * d.ldn + (ok ? nn : 0);
#pragma unroll
    for (int i = 0; i < 32; ++i) v[i] = src[(size_t)(2 * i) * d.ldn];
    if (!ok) {
#pragma unroll
        for (int i = 0; i < 32; ++i) v[i] = 0.f; }
}
__device__ __forceinline__ void tr_finish(const TrDesc& d, const float (&v)[32], LAS float* scr, int lane) {
#pragma unroll
    for (int i = 0; i < 32; ++i) scr[(2 * i + (lane >> 5)) * 33 + (lane & 31)] = v[i];
    LDS_WAIT(); asm volatile("" ::: "memory");
    const int c = lane & 7;
#pragma unroll
    for (int j = 0; j < 4; ++j) { const int n = (lane >> 3) + 8 * j; const LAS float* s = scr + (8 * c) * 33 + n;
        v4u o; o.x = pk2(s[0 * 33], s[1 * 33]); o.y = pk2(s[2 * 33], s[3 * 33]); o.z = pk2(s[4 * 33], s[5 * 33]); o.w = pk2(s[6 * 33], s[7 * 33]);
        const int row = d.row_base + rowmap(d.kind, d.n0 + n);
        *(v4u*)(d.WT + (size_t)row * d.dK + d.k0 + 8 * c) = o; }
    LDS_WAIT(); asm volatile("" ::: "memory");
}
__device__ __forceinline__ void pro_transposes(const Params& p, LAS unsigned char* lds, int lane, int wave) {
    LAS float* scr = (LAS float*)(lds + wave * 16384);
    const int gw = blockIdx.x * NWAVES + wave, NGW = gridDim.x * NWAVES;
    constexpr int NITEMS = 16 * 113 + 512 + 1536 + 512 + 64 + 130 * 256 + 130 * 128;
    if (gw >= NITEMS) return;
    TrDesc dc = tr_decode(p, gw); float vc[32]; tr_load(dc, lane, vc);
#pragma unroll 1
    for (int it = gw; it < NITEMS; it += NGW) {
        const bool more = it + NGW < NITEMS; TrDesc dn = dc; float vn[32];
        if (more) { dn = tr_decode(p, it + NGW); tr_load(dn, lane, vn); }
        tr_finish(dc, vc, scr, lane);
        if (more) { dc = dn;
#pragma unroll
            for (int i = 0; i < 32; ++i) vc[i] = vn[i]; }
    }
}
__device__ __forceinline__ void pro_rope(const Params& p, int tid) {
    if (blockIdx.x != 255) return;
    float* R = (float*)(p.ws + WS_ROPE);
    for (int i = tid; i < 64 * 16; i += NTHR) { const int pos = i >> 4, f = i & 15; const float inv = exp2f(-(float)f * (13.287712379549449f / 16.f)); const float ang = (float)pos * inv;
        float sn, cs; sincosf(ang, &sn, &cs); R[2 * i] = cs; R[2 * i + 1] = sn; }
}
__device__ __forceinline__ void pro_filters(const Params& p, LAS unsigned char* lds, int tid, int lane, int wave) {
    LAS float* Z = (LAS float*)lds;
    LAS float* H1 = Z + 512;
    LAS float* H2 = H1 + 512;
    const int j0 = 8 * blockIdx.x, j = j0 + wave;
    const float* fw1 = p.in[I_FW1]; const float* fb1 = p.in[I_FB1]; const float* fw2 = p.in[I_FW2]; const float* fb2 = p.in[I_FB2]; const float* fw3 = p.in[I_FW3];
    {   float z = 0.f;
        if (lane == 0) z = (float)j / 2047.f;
        else if (lane < 33) { const int k = (lane - 1) & 15; const float fr = 1e-4f + (float)k * ((15.f - 1e-4f) / 15.f); const float ang = (6.283185307179586f / 2048.f) * (float)j * fr;
            float sn, cs; sincosf(ang, &sn, &cs); z = lane < 17 ? cs : -sn; }
        Z[wave * 64 + lane] = z; }
    LDS_WAIT(); asm volatile("" ::: "memory");
    {   float a = fb1[lane];
#pragma unroll 1
        for (int k = 0; k < 33; ++k) a += Z[wave * 64 + k] * fw1[k * 64 + lane];
        H1[wave * 64 + lane] = sinf(a); }
    LDS_WAIT(); asm volatile("" ::: "memory");
    {   float a = fb2[lane];
#pragma unroll 1
        for (int k = 0; k < 64; ++k) a += H1[wave * 64 + k] * fw2[k * 64 + lane];
        H2[wave * 64 + lane] = sinf(a); }
    __syncthreads();
    bf16* F = (bf16*)(p.ws + WS_FILT);
    const float mind = -4.605170185988091f / 1.5f, maxd = -4.605170185988091f / 0.3f;
#pragma unroll 1
    for (int i = 0; i < 4; ++i) { const int n = tid + NTHR * i, c = n & 1023;
        float acc[8];
#pragma unroll
        for (int q = 0; q < 8; ++q) acc[q] = 0.f;
#pragma unroll 2
        for (int k = 0; k < 64; ++k) { const float w = fw3[k * 2048 + n];
#pragma unroll
            for (int q = 0; q < 8; ++q) acc[q] += H2[q * 64 + k] * w; }
        const float delta = fabsf(mind + (float)c * ((maxd - mind) / 1023.f));
        float o[8];
#pragma unroll
        for (int q = 0; q < 8; ++q) { const float dist = fabsf((float)(j0 + q) - 1024.f) * (1.f / 1024.f); o[q] = acc[q] * expf(-dist * delta); }
        v4u w; w.x = pk2(o[0], o[1]); w.y = pk2(o[2], o[3]); w.z = pk2(o[4], o[5]); w.w = pk2(o[6], o[7]);
        *(v4u*)(F + (size_t)n * 2048 + j0) = w; }
    __syncthreads();
}

__device__ __forceinline__ void l0_norm_rows(const float* src, bf16* dst, int nrows, const float* g, const float* md, int lane) {
    f32x4 vb[4], vc[4];
#pragma unroll
    for (int j = 0; j < 4; ++j) { const int o = 4 * lane + 256 * j; vb[j] = *(const f32x4*)(g + o) * (1.f + *(const f32x4*)(md + D + o)); vc[j] = *(const f32x4*)(md + o); }
    f32x4 xn[4]; row_ld_f32(src, lane, xn);
#pragma unroll 1
    for (int i = 0; i < nrows; ++i) { f32x4 x[4], h[4];
#pragma unroll
        for (int j = 0; j < 4; ++j) x[j] = xn[j];
        if (i + 1 < nrows) row_ld_f32(src + (size_t)(i + 1) * D, lane, xn);
        const float rstd = rsqrtf(row_ss(x) * (1.f / D) + RMS_EPS);
#pragma unroll
        for (int j = 0; j < 4; ++j) h[j] = x[j] * rstd * vb[j] + vc[j];
        row_st_bf16(dst + (size_t)i * D, lane, h); }
}
__device__ __forceinline__ void ph_l0_norm(const Params& p, int lane, int wave) {
    const int gw = blockIdx.x * NWAVES + wave;
    const float* MOD = (const float*)(p.ws + WS_MOD); bf16* H = (bf16*)(p.ws + WS_BIG + A0_H);
    const float* g = p.in[I_NORMG];
    { const int m0 = gw * 32; l0_norm_rows(p.in[I_X] + (size_t)m0 * D, H + (size_t)m0 * D, 32, g, MOD + (size_t)(m0 >> 11) * NMOD, lane); }
    { const int m0 = gw * 4; l0_norm_rows(p.in[I_CTX] + (size_t)m0 * D, H + (size_t)(T + m0) * D, 4, g, MOD + (size_t)32 * NMOD, lane); }
}
__device__ __forceinline__ void ph_mid(const Params& p, int l, const bf16* MIX, bf16* H2, bool has_mix, int lane, int wave) {
    const int gw = blockIdx.x * NWAVES + wave;
    const float* MOD = (const float*)(p.ws + WS_MOD) + (size_t)l * 33 * NMOD;
    const float* g1 = p.in[I_NORMG] + (size_t)(l * 4 + 1) * D; const float* g2 = p.in[I_NORMG] + (size_t)(l * 4 + 2) * D;
    const float* xin = l == 0 ? p.in[I_X] : p.out;
    const int m0 = gw * 32; const float* md = MOD + (size_t)(m0 >> 11) * NMOD;
    f32x4 va[4], vb[4], vc[4];
#pragma unroll
    for (int j = 0; j < 4; ++j) { const int o = 4 * lane + 256 * j; va[j] = *(const f32x4*)(md + 2 * D + o) * *(const f32x4*)(g1 + o); vb[j] = *(const f32x4*)(g2 + o) * (1.f + *(const f32x4*)(md + 4 * D + o)); vc[j] = *(const f32x4*)(md + 3 * D + o); }
    f32x4 xn[4], mn[4];
    row_ld_f32(xin + (size_t)m0 * D, lane, xn); if (has_mix) row_ld_bf16(MIX + (size_t)m0 * D, lane, mn);
#pragma unroll 1
    for (int m = m0; m < m0 + 32; ++m) {
        f32x4 x[4], h[4], mx[4];
#pragma unroll
        for (int j = 0; j < 4; ++j) { x[j] = xn[j]; mx[j] = mn[j]; }
        if (m + 1 < m0 + 32) { row_ld_f32(xin + (size_t)(m + 1) * D, lane, xn); if (has_mix) row_ld_bf16(MIX + (size_t)(m + 1) * D, lane, mn); }
        if (has_mix) { const float r = rsqrtf(row_ss(mx) * (1.f / D) + RMS_EPS);
#pragma unroll
            for (int j = 0; j < 4; ++j) x[j] = x[j] + va[j] * (mx[j] * r); }
        row_st_f32(p.out + (size_t)m * D, lane, x);
        const float rstd = rsqrtf(row_ss(x) * (1.f / D) + RMS_EPS);
#pragma unroll
        for (int j = 0; j < 4; ++j) h[j] = x[j] * rstd * vb[j] + vc[j];
        row_st_bf16(H2 + (size_t)m * D, lane, h);
    }
}
__device__ __forceinline__ void ph_combine(const Params& p, int l, int ch, const unsigned char* Y8, bf16* Hn, int lane, int wave) {
    const int gw = blockIdx.x * NWAVES + wave;
    const float* MOD = (const float*)(p.ws + WS_MOD) + (size_t)l * 33 * NMOD;
    const float* g3 = p.in[I_NORMG] + (size_t)(l * 4 + 3) * D;
    const int* PSLOT = (const int*)(p.ws + WS_PSLOT); const float* WTS = (const float*)(p.ws + WS_WTS);
    constexpr int RPW = CHT / 2048;
    const int mbase = ch * CHT + gw * RPW; const float* md = MOD + (size_t)(mbase >> 11) * NMOD;
    float va[16], vb[16], vc[16];
    { const float* md1 = MOD + (size_t)(33 + (mbase >> 11)) * NMOD; const float* g10 = p.in[I_NORMG] + (size_t)4 * D;
#pragma unroll
      for (int q = 0; q < 4; ++q) { const int o = lane * 16 + 4 * q; const f32x4 gp = *(const f32x4*)(g3 + o), gf = *(const f32x4*)(md + 5 * D + o); f32x4 gg = gp, sh = gp, sc = gp;
          if (l == 0) { gg = *(const f32x4*)(g10 + o); sh = *(const f32x4*)(md1 + o); sc = *(const f32x4*)(md1 + D + o); }
#pragma unroll
          for (int j = 0; j < 4; ++j) { va[4 * q + j] = gp[j] * gf[j]; vb[4 * q + j] = gg[j] * (1.f + sc[j]); vc[4 * q + j] = sh[j]; } } }
    int sl[9]; float wk[9];
#define CMB_SLOTS(mt) do { _Pragma("unroll") for (int k = 0; k < 9; ++k) { sl[k] = PSLOT[(size_t)(mt) * 16 + k]; wk[k] = k < 8 ? WTS[(size_t)(mt) * 8 + k] : 1.f; } } while (0)
    CMB_SLOTS(mbase);
#pragma unroll 1
    for (int m = mbase; m < mbase + RPW; ++m) {
        float a[16];
#pragma unroll
        for (int j = 0; j < 16; ++j) a[j] = 0.f;
        u32x4 yr[9]; float wc[9];
#pragma unroll
        for (int k = 0; k < 9; ++k) { yr[k] = *(const u32x4*)(Y8 + (size_t)sl[k] * 1024 + lane * 16); wc[k] = wk[k]; }
        float* orow = p.out + (size_t)m * D + lane * 16; f32x4 xv4[4];
#pragma unroll
        for (int q = 0; q < 4; ++q) xv4[q] = *(const f32x4*)(orow + 4 * q);
        if (m + 1 < mbase + RPW) CMB_SLOTS(m + 1);
#pragma unroll
        for (int k = 0; k < 9; ++k) { const float w = wc[k] * Y8_INV; const unsigned ww[4] = {yr[k].x, yr[k].y, yr[k].z, yr[k].w};
#pragma unroll
            for (int q = 0; q < 4; ++q) { a[4 * q + 0] += w * __builtin_amdgcn_cvt_f32_fp8((int)ww[q], 0); a[4 * q + 1] += w * __builtin_amdgcn_cvt_f32_fp8((int)ww[q], 1);
                                          a[4 * q + 2] += w * __builtin_amdgcn_cvt_f32_fp8((int)ww[q], 2); a[4 * q + 3] += w * __builtin_amdgcn_cvt_f32_fp8((int)ww[q], 3); } }
        float ss = 0.f;
#pragma unroll
        for (int j = 0; j < 16; ++j) ss += a[j] * a[j];
        const float r = rsqrtf(wave_sum(ss) * (1.f / D) + RMS_EPS);
        float x[16]; float s2 = 0.f;
#pragma unroll
        for (int q = 0; q < 4; ++q) {
#pragma unroll
            for (int j = 0; j < 4; ++j) { const float v = xv4[q][j] + va[4 * q + j] * (a[4 * q + j] * r); x[4 * q + j] = v; s2 += v * v; }
            *(f32x4*)(orow + 4 * q) = (f32x4){x[4 * q], x[4 * q + 1], x[4 * q + 2], x[4 * q + 3]}; }
        if (l == 0) { const float rstd = rsqrtf(wave_sum(s2) * (1.f / D) + RMS_EPS); float h[16];
#pragma unroll
            for (int j = 0; j < 16; ++j) h[j] = x[j] * rstd * vb[j] + vc[j];
            v4u w0, w1; w0.x = pk2(h[0], h[1]); w0.y = pk2(h[2], h[3]); w0.z = pk2(h[4], h[5]); w0.w = pk2(h[6], h[7]); w1.x = pk2(h[8], h[9]); w1.y = pk2(h[10], h[11]); w1.z = pk2(h[12], h[13]); w1.w = pk2(h[14], h[15]);
            *(v4u*)(Hn + (size_t)m * D + lane * 16) = w0; *(v4u*)(Hn + (size_t)m * D + lane * 16 + 8) = w1; }
    }
#undef CMB_SLOTS
}

struct DenseSched { int NN, NU, G, c, NMs;
    __device__ __forceinline__ bool next(int i, Unit& u) const { const int L = i * G + c; if (L >= NU) return false; if (NMs > 0) { u.pm = L % NMs; u.pn = L / NMs; } else { u.pm = L / NN; u.pn = L % NN; } return true; }
    __device__ __forceinline__ int arow(int r) const { return r; }
    __device__ __forceinline__ void* probe_ts() const { return nullptr; } };
struct EpiBf16 { static constexpr bool PERM = true, AFTER_DRAIN = false, PROBE = false; bf16* O; size_t ldc; int cmask;
    __device__ __forceinline__ void operator()(const f32x4 (&acc)[2][2][4][2], const Unit& u, int wr, int wc, int fr, int fq) const {
        const int row0 = u.pm * BM + wr * 64 + fr, col0 = (u.pn & cmask) * BM + wc * 32 + 8 * fq;
#pragma unroll
        for (int ai = 0; ai < 2; ++ai)
#pragma unroll
            for (int m = 0; m < 4; ++m) { bf16* rowp = O + (size_t)(row0 + ai * HALF + m * 16) * ldc + col0;
#pragma unroll
                for (int bj = 0; bj < 2; ++bj) { const f32x4 v0 = acc[ai][bj][m][0], v1 = acc[ai][bj][m][1];
                    u32x4 w; w.x = cvt_pk_bf16(v0[0], v0[1]); w.y = cvt_pk_bf16(v0[2], v0[3]); w.z = cvt_pk_bf16(v1[0], v1[1]); w.w = cvt_pk_bf16(v1[2], v1[3]);
                    *(u32x4*)(rowp + bj * HALF) = w; } }
    } };
struct EpiRouter { static constexpr bool PERM = false, AFTER_DRAIN = false, PROBE = false; float* LOG;
    __device__ __forceinline__ void operator()(const f32x4 (&acc)[2][2][4][2], const Unit& u, int wr, int wc, int fr, int fq) const {
        if (wc >= 2) return;
        const int row0 = u.pm * BM + wr * 64 + fr, col0 = wc * 32 + 4 * fq;
#pragma unroll
        for (int ai = 0; ai < 2; ++ai)
#pragma unroll
            for (int m = 0; m < 4; ++m) { float* rowp = LOG + (size_t)(row0 + ai * HALF + m * 16) * 64 + col0;
#pragma unroll
                for (int n = 0; n < 2; ++n) *(f32x4*)(rowp + n * 16) = acc[ai][0][m][n]; }
    } };
struct EpiFp8 { static constexpr bool PERM = true, AFTER_DRAIN = false, PROBE = true; unsigned char* O;
    __device__ __forceinline__ void operator()(const f32x4 (&acc)[2][2][4][2], const Unit& u, int wr, int wc, int fr, int fq) const {
        const int row0 = u.pm * BM + wr * 64 + fr, col0 = (u.pn & 3) * BM + wc * 64 + 16 * fq;
#pragma unroll
        for (int ai = 0; ai < 2; ++ai)
#pragma unroll
            for (int m = 0; m < 4; ++m) { unsigned char* rowp = O + (size_t)(row0 + ai * HALF + m * 16) * 1024 + col0; u32x4 w;
#pragma unroll
                for (int bj = 0; bj < 2; ++bj) { const f32x4 v0 = acc[ai][bj][m][0] * Y8_SCALE, v1 = acc[ai][bj][m][1] * Y8_SCALE; int lo = 0, hi = 0;
                    lo = __builtin_amdgcn_cvt_pk_fp8_f32(v0[0], v0[1], lo, false); lo = __builtin_amdgcn_cvt_pk_fp8_f32(v0[2], v0[3], lo, true);
                    hi = __builtin_amdgcn_cvt_pk_fp8_f32(v1[0], v1[1], hi, false); hi = __builtin_amdgcn_cvt_pk_fp8_f32(v1[2], v1[3], hi, true);
                    if (bj == 0) { w.x = (unsigned)lo; w.y = (unsigned)hi; } else { w.z = (unsigned)lo; w.w = (unsigned)hi; } }
                *(u32x4*)rowp = w; }
    } };
struct EpiRouterLds { static constexpr bool PERM = false, AFTER_DRAIN = true, PROBE = false;
    __device__ __forceinline__ void operator()(const f32x4 (&)[2][2][4][2], const Unit&, int, int, int, int) const {}
    __device__ __forceinline__ void fused(const f32x4 (&acc)[2][2][4][2], const Unit&, int wr, int wc, int fr, int fq, LAS unsigned char* lds) const {
        if (wc >= 2) return;
        LAS float* SC = (LAS float*)lds;
#pragma unroll
        for (int ai = 0; ai < 2; ++ai)
#pragma unroll
            for (int m = 0; m < 4; ++m) { const int row = ai * HALF + wr * 64 + m * 16 + fr;
#pragma unroll
                for (int n = 0; n < 2; ++n)
#pragma unroll
                    for (int j = 0; j < 4; ++j) SC[row * 65 + wc * 32 + n * 16 + 4 * fq + j] = sigmoidf_(acc[ai][0][m][n][j]); }
    } };
struct MoeSched { const LAS int* te; const int* sort; int NU, G, c, sh, per;
    __device__ __forceinline__ bool next(int i, Unit& u) const { const int L = i * G + c; if (L >= NU) return false; const int tile = L >> sh; u.pm = tile; u.pn = te[tile] * per + (L & (per - 1)); return true; }
    __device__ __forceinline__ int arow(int r) const { return sort ? sort[r] : r; }
    void* pts; __device__ __forceinline__ void* probe_ts() const { return pts; } };
struct EpiSwiglu { static constexpr bool PERM = true, AFTER_DRAIN = false, PROBE = false; bf16* ACT;
    __device__ __forceinline__ void operator()(const f32x4 (&acc)[2][2][4][2], const Unit& u, int wr, int wc, int fr, int fq) const {
        const int row0 = u.pm * BM + wr * 64 + fr, col0 = (u.pn & 1) * 128 + wc * 32 + 8 * fq;
#pragma unroll
        for (int ai = 0; ai < 2; ++ai)
#pragma unroll
            for (int m = 0; m < 4; ++m) { bf16* rowp = ACT + (size_t)(row0 + ai * HALF + m * 16) * DE + col0;
                const f32x4 g0 = acc[ai][0][m][0], g1 = acc[ai][0][m][1], u0 = acc[ai][1][m][0], u1 = acc[ai][1][m][1];
                float o[8];
#pragma unroll
                for (int q = 0; q < 4; ++q) { o[q] = siluf_(g0[q]) * u0[q]; o[4 + q] = siluf_(g1[q]) * u1[q]; }
                u32x4 w; w.x = cvt_pk_bf16(o[0], o[1]); w.y = cvt_pk_bf16(o[2], o[3]); w.z = cvt_pk_bf16(o[4], o[5]); w.w = cvt_pk_bf16(o[6], o[7]);
                *(u32x4*)rowp = w; }
    } };
__device__ __forceinline__ int moe_tables(const Params& p, int ch, LAS unsigned char* lds, int tid) {
    LAS int* TE = (LAS int*)(lds + LDS_TAB);
    const int* TEG = (const int*)(p.ws + WS_TEG) + (size_t)ch * (MAXTILES + 64);
    __syncthreads();
#pragma unroll 1
    for (int i = tid; i <= MAXTILES; i += NTHR) TE[i] = TEG[i];
    __syncthreads();
    return TE[MAXTILES];
}

__device__ __forceinline__ void ph_route_a(const Params& p, int l, const float* LOG, int tile, LAS unsigned char* lds, int tid) {
    LAS float* SC = (LAS float*)lds;
    LAS float* RBs = (LAS float*)(lds + 68 * 1024);
    LAS unsigned* MASK = (LAS unsigned*)(lds + 69 * 1024);
    const int b = tile, tok0 = 256 * b;
    if (LOG)
#pragma unroll 1
    for (int i = tid; i < 256 * 64; i += NTHR) { const int t = i >> 6, e = i & 63; SC[t * 65 + e] = sigmoidf_(LOG[(size_t)(tok0 + t) * 64 + e]); }
    if (tid < 64) RBs[tid] = p.in[I_RB][l * 64 + tid];
    MASK[tid] = 0u;
    __syncthreads();
    int eidx[8]; float wts[8];
    if (tid < 256) { const int t = tid; const LAS float* sc = SC + t * 65;
        float gs[8], bv[64];
#pragma unroll
        for (int g = 0; g < 8; ++g) { float m1 = -3.0e38f, m2 = -3.0e38f;
#pragma unroll
            for (int j = 0; j < 8; ++j) { const float v = sc[8 * g + j] + RBs[8 * g + j]; bv[8 * g + j] = v; if (v > m1) { m2 = m1; m1 = v; } else if (v > m2) m2 = v; }
            gs[g] = m1 + m2; }
        unsigned gmask = 0u;
#pragma unroll
        for (int r = 0; r < 4; ++r) { float best = -3.0e38f; int bi = 0; bool found = false;
#pragma unroll
            for (int g = 0; g < 8; ++g) { const bool free_ = ((gmask >> g) & 1u) == 0u; if (free_ && (!found || gs[g] > best)) { best = gs[g]; bi = g; found = true; } }
            gmask |= 1u << bi; }
#pragma unroll
        for (int e = 0; e < 64; ++e) if (((gmask >> (e >> 3)) & 1u) == 0u) bv[e] = -3.0e38f;
        unsigned long long taken = 0ull; float ssum = 0.f;
#pragma unroll
        for (int k = 0; k < 8; ++k) { float best = -3.0e38f; int be = 0; bool found = false;
#pragma unroll
            for (int e = 0; e < 64; ++e) { const bool ok = ((taken >> e) & 1ull) == 0ull; if (ok && (!found || bv[e] > best)) { best = bv[e]; be = e; found = true; } }
            taken |= 1ull << be; eidx[k] = be; wts[k] = sc[be]; ssum += wts[k]; }
        const float inv = 2.5f / ssum;
#pragma unroll
        for (int k = 0; k < 8; ++k) { wts[k] *= inv; __hip_atomic_fetch_or(&MASK[eidx[k] * 8 + (t >> 5)], 1u << (t & 31), __ATOMIC_RELAXED, __HIP_MEMORY_SCOPE_WORKGROUP); }
    }
    __syncthreads();
    if (tid < 256) { const int t = tid; int* EIDX = (int*)(p.ws + WS_EIDX); float* WTS = (float*)(p.ws + WS_WTS);
#pragma unroll
        for (int k = 0; k < 8; ++k) { const int e = eidx[k]; int r = 0;
#pragma unroll 1
            for (int w = 0; w < (t >> 5); ++w) r += __popc(MASK[e * 8 + w]);
            r += __popc(MASK[e * 8 + (t >> 5)] & ((1u << (t & 31)) - 1u));
            EIDX[(size_t)(tok0 + t) * 8 + k] = e | (r << 8); WTS[(size_t)(tok0 + t) * 8 + k] = wts[k]; } }
    if (tid < 64) { int c = 0;
#pragma unroll
        for (int w = 0; w < 8; ++w) c += __popc(MASK[tid * 8 + w]);
        ((int*)(p.ws + WS_BC))[b * 64 + tid] = c; }
    __syncthreads();
}
__device__ __forceinline__ void ph_route_b(const Params& p, LAS unsigned char* lds, int tid) {
    LAS int* BCS = (LAS int*)lds;
    LAS int* CNT = BCS + BPC * 64; LAS int* PRE = CNT + 64; LAS int* SEG = PRE + 64;
    const int b = blockIdx.x, ch = b / BPC, bl = b % BPC;
    const int* BC = (const int*)(p.ws + WS_BC) + (size_t)ch * BPC * 64;
#pragma unroll 1
    for (int i = tid; i < BPC * 64; i += NTHR) BCS[i] = BC[i];
    __syncthreads();
    if (tid < 64) { int c = 0, pr = 0;
#pragma unroll 1
        for (int i = 0; i < BPC; ++i) { const int v = BCS[i * 64 + tid]; c += v; if (i < bl) pr += v; } CNT[tid] = c; PRE[tid] = pr; }
    __syncthreads();
    if (tid == 0) { int base = 0;
#pragma unroll 1
        for (int e = 0; e < 64; ++e) { SEG[e] = base; base += ((CNT[e] + 255) >> 8) << 8; } SEG[64] = base; }
    __syncthreads();
    int* SORT = (int*)(p.ws + WS_SORT) + (size_t)ch * CHROWS; int* PSLOT = (int*)(p.ws + WS_PSLOT); const int* EIDX = (const int*)(p.ws + WS_EIDX);
    if (tid < 256) { const int tok = 256 * b + tid;
#pragma unroll
        for (int k = 0; k < 8; ++k) { const int w = EIDX[(size_t)tok * 8 + k], e = w & 255, r = w >> 8; const int slot = SEG[e] + PRE[e] + r; SORT[slot] = tok; PSLOT[(size_t)tok * 16 + k] = slot; }
        const int s8 = SEG[64] + (tok - ch * CHT); SORT[s8] = tok; PSLOT[(size_t)tok * 16 + 8] = s8; }
    if (bl == 0) {
        int* TEG = (int*)(p.ws + WS_TEG) + (size_t)ch * (MAXTILES + 64); const int NT = (SEG[64] >> 8) + CHT / 256;
#pragma unroll 1
        for (int i = tid; i < NT; i += NTHR) { int e = 0;
#pragma unroll 1
            while (e < 64 && (i << 8) >= SEG[e + 1]) ++e;
            TEG[i] = e; }
        if (tid == 0) TEG[MAXTILES] = NT; }
    if (bl < 64) { const int e = bl, lo = SEG[e] + CNT[e], hi = SEG[e] + (((CNT[e] + 255) >> 8) << 8); for (int s = lo + tid; s < hi; s += NTHR) SORT[s] = ch * CHT; }
    __syncthreads();
}

typedef float f32x16 __attribute__((ext_vector_type(16)));
__device__ __forceinline__ void ph_sconv(const Params& p, const bf16* UT, bf16* UC, int tid) {
    const float* cw = p.in[I_CONVHYW]; const float* cbias = p.in[I_CONVHYB];
    const unsigned NIT = 3072u * 32u * 256u; const unsigned gt = blockIdx.x * NTHR + tid, NG = gridDim.x * NTHR;
#pragma unroll 1
    for (unsigned it = gt; it < NIT; it += NG) {
        const unsigned c = it >> 13, k = it & 255u; const size_t base = (size_t)it * 8;
        const v4u w = *(const v4u*)(UT + base);
        const float w0 = cw[c], w1 = cw[3072 + c], w2 = cw[6144 + c], bb = cbias[c];
        float x[10];
        x[0] = k > 0 ? bf1(UT[base - 1]) : 0.f; x[9] = k < 255 ? bf1(UT[base + 8]) : 0.f;
        x[1] = bf_lo(w.x); x[2] = bf_hi(w.x); x[3] = bf_lo(w.y); x[4] = bf_hi(w.y); x[5] = bf_lo(w.z); x[6] = bf_hi(w.z); x[7] = bf_lo(w.w); x[8] = bf_hi(w.w);
        float o[8];
#pragma unroll
        for (int j = 0; j < 8; ++j) o[j] = bb + w0 * x[j] + w1 * x[j + 1] + w2 * x[j + 2];
        v4u r; r.x = pk2(o[0], o[1]); r.y = pk2(o[2], o[3]); r.z = pk2(o[4], o[5]); r.w = pk2(o[6], o[7]);
        *(v4u*)(UC + base) = r;
    }
}
constexpr int LC_CPB = 8224, LC_RAW = 8 * LC_CPB, LC_RAWSZ = 32 * 512, LC_HALO = LC_RAW + 2 * LC_RAWSZ, LC_VBP = 528, LC_VB0 = LC_HALO + 2 * 8192, LC_VBSZ = 32 * LC_VBP;
static_assert(LC_VB0 + 2 * LC_VBSZ <= LDS_MISC && 8 * 32 * 528 <= LDS_MISC, "lconv LDS map");
struct Taps { float w0, w1, w2, b; };
__device__ __forceinline__ float bfh(unsigned w, int hi) { return hi ? bf_hi(w) : bf_lo(w); }
template <bool CONVIN>
__device__ __forceinline__ void lconv_unit(const bf16* vin, const Taps ti, const bf16* F, const bf16* graw, const Taps tg, float fb, bf16* out, LAS unsigned char* lds, int tid, int lane, int wave) {
    __syncthreads();
#define LC_DMA(ch, rb) do { _Pragma("unroll") for (int q = 0; q < 2; ++q) { const int row = wave * 4 + 2 * q + (ln >> 5); \
        __builtin_amdgcn_global_load_lds((const unsigned*)(vin + (size_t)row * 2048 + (ch) * 256 + (ln & 31) * 8), (LAS unsigned*)(lds + LC_RAW + (rb) * LC_RAWSZ + (wave * 4 + 2 * q) * 512), 16, 0, 0); } \
        { const int hrow = wave * 4 + ((ln & 7) >> 1); int hs = (ln & 1) ? (ch) * 256 + 256 : (ch) * 256 - 8; hs = hs < 0 ? 0 : (hs > 2040 ? 2040 : hs); \
          __builtin_amdgcn_global_load_lds((const unsigned*)(vin + (size_t)hrow * 2048 + hs), (LAS unsigned*)(lds + LC_HALO + (rb) * 8192 + wave * 1024), 16, 0, 0); } } while (0)
    LAS bf16* Fl = (LAS bf16*)(lds + LC_VB0 + LC_VBSZ);
    { int ln = lane; asm volatile("" : "+v"(ln)); LC_DMA(0, 0); LC_DMA(1, 1); }
    if (tid < 256) *(LAS v4u*)(Fl + tid * 8) = *(const v4u*)(F + tid * 8);
    __syncthreads();
    if (tid == 0) Fl[1024] = (bf16)f2bf(bf1(Fl[1024]) + fb);
    __syncthreads();
#pragma unroll 1
    for (int a = 0; a < 8; ++a)
#pragma unroll 1
        for (int mi = tid; mi < 2056; mi += NTHR) { const int m = mi * 2; const int x0 = 3079 - m - a, x1 = x0 - 1;
            const unsigned lo = (x0 >= 0 && x0 <= 2047) ? (unsigned)Fl[x0] : 0u, hi = (x1 >= 0 && x1 <= 2047) ? (unsigned)Fl[x1] : 0u;
            *(LAS unsigned*)(lds + a * LC_CPB + m * 2) = lo | (hi << 16); }
    const int r = lane & 31, h = lane >> 5, a = (7 - r) & 7;
    const LAS unsigned char* cpA = lds + a * LC_CPB + 2 * (1023 - r + 8 * h - a + 1032) - 512 * wave;
    const int laneB = r * LC_VBP + 16 * h;
#define LC_CONVERT(ch, rb, buf) do { _Pragma("unroll") for (int q = 0; q < 2; ++q) { const int pid = ln + 64 * q, row = wave * 4 + (pid >> 5), pp = pid & 31; const LAS unsigned char* rp = lds + LC_RAW + (rb) * LC_RAWSZ + row * 512 + pp * 16; \
        const v4u w = *(const LAS v4u*)rp; v4u o = w; \
        if (CONVIN) { const LAS unsigned char* hp_ = lds + LC_HALO + (rb) * 8192 + wave * 1024 + (pid >> 5) * 32; float x[10]; \
            x[0] = pp > 0 ? bf1(*(const LAS bf16*)(rp - 2)) : ((ch) > 0 ? bf1(*(const LAS bf16*)(hp_ + 14)) : 0.f); x[9] = pp < 31 ? bf1(*(const LAS bf16*)(rp + 16)) : ((ch) < 7 ? bf1(*(const LAS bf16*)(hp_ + 16)) : 0.f); \
            x[1] = bf_lo(w.x); x[2] = bf_hi(w.x); x[3] = bf_lo(w.y); x[4] = bf_hi(w.y); x[5] = bf_lo(w.z); x[6] = bf_hi(w.z); x[7] = bf_lo(w.w); x[8] = bf_hi(w.w); \
            float y[8]; _Pragma("unroll") for (int j = 0; j < 8; ++j) y[j] = ti.b + ti.w0 * x[j] + ti.w1 * x[j + 1] + ti.w2 * x[j + 2]; \
            o.x = pk2(y[0], y[1]); o.y = pk2(y[2], y[3]); o.z = pk2(y[4], y[5]); o.w = pk2(y[6], y[7]); } \
        *(LAS v4u*)(lds + LC_VB0 + (buf) * LC_VBSZ + row * LC_VBP + pp * 16) = o; } } while (0)
    { int ln = lane; asm volatile("" : "+v"(ln));
    asm volatile("s_waitcnt vmcnt(3)" ::: "memory");
    LC_CONVERT(0, 0, 0); }
    asm volatile("s_waitcnt lgkmcnt(0)" ::: "memory"); __builtin_amdgcn_s_barrier(); asm volatile("" ::: "memory");
    f32x16 acc[8];
#pragma unroll
    for (int i = 0; i < 8; ++i)
#pragma unroll
        for (int q = 0; q < 16; ++q) acc[i][q] = 0.f;
    bf16x8 E[8], O[8];
    bool primed = false;
#pragma unroll 1
    for (int ch = 0; ch < 8; ++ch) {
        int ln = lane; asm volatile("" : "+v"(ln));
        if (ch < 6) LC_DMA(ch + 2, ch & 1);
        const int du = wave - ch;
        if (du >= -4 && du <= 4) {
            const LAS unsigned char* ca = cpA + 64 * (ch * 8); const LAS unsigned char* vbh = lds + LC_VB0 + (ch & 1) * LC_VBSZ + laneB;
            if (!primed) { primed = true;
#pragma unroll
                for (int i = 1; i < 8; ++i) { E[(8 - i) & 7] = *(const LAS bf16x8*)(ca + 32 * (-2 * i)); O[(8 - i) & 7] = *(const LAS bf16x8*)(ca + 32 * (-2 * i + 1)); }
                E[0] = *(const LAS bf16x8*)ca; O[0] = *(const LAS bf16x8*)(ca + 32); }
            bf16x8 bc0 = *(const LAS bf16x8*)vbh, bc1 = *(const LAS bf16x8*)(vbh + 32);
#pragma unroll
            for (int mm = 0; mm < 8; ++mm) {
                bf16x8 bn0 = bc0, bn1 = bc1;
                if (mm < 7) { bn0 = *(const LAS bf16x8*)(vbh + 64 * (mm + 1)); bn1 = *(const LAS bf16x8*)(vbh + 64 * (mm + 1) + 32); }
                acc[7] = __builtin_amdgcn_mfma_f32_32x32x16_bf16(E[(mm + 1) & 7], bc0, acc[7], 0, 0, 0);
                E[(mm + 1) & 7] = *(const LAS bf16x8*)(ca + 64 * (mm + 1));
#pragma unroll
                for (int i = 0; i < 7; ++i) acc[i] = __builtin_amdgcn_mfma_f32_32x32x16_bf16(E[(mm - i) & 7], bc0, acc[i], 0, 0, 0);
                acc[7] = __builtin_amdgcn_mfma_f32_32x32x16_bf16(O[(mm + 1) & 7], bc1, acc[7], 0, 0, 0);
                O[(mm + 1) & 7] = *(const LAS bf16x8*)(ca + 64 * (mm + 1) + 32);
#pragma unroll
                for (int i = 0; i < 7; ++i) acc[i] = __builtin_amdgcn_mfma_f32_32x32x16_bf16(O[(mm - i) & 7], bc1, acc[i], 0, 0, 0);
                bc0 = bn0; bc1 = bn1;
            }
        }
        if (ch < 7) { if (ch < 6) asm volatile("s_waitcnt vmcnt(3)" ::: "memory"); else asm volatile("s_waitcnt vmcnt(0)" ::: "memory"); LC_CONVERT(ch + 1, (ch + 1) & 1, (ch + 1) & 1); }
        asm volatile("s_waitcnt lgkmcnt(0)" ::: "memory"); __builtin_amdgcn_s_barrier(); asm volatile("" ::: "memory");
    }
#undef LC_DMA
#undef LC_CONVERT
    { int le = lane; asm volatile("" : "+v"(le)); const int re = le & 31, he = le >> 5;
      LAS unsigned char* tw = lds + wave * (32 * 528);
#pragma unroll
      for (int i = 0; i < 8; ++i)
#pragma unroll
          for (int g = 0; g < 4; ++g) { v2u w; w.x = pk2(acc[i][4 * g + 0], acc[i][4 * g + 1]); w.y = pk2(acc[i][4 * g + 2], acc[i][4 * g + 3]); *(LAS v2u*)(tw + re * 528 + (32 * i + 8 * g + 4 * he) * 2) = w; }
      LDS_WAIT(); asm volatile("" ::: "memory");
      const int pp = le & 31;
      v4u gwa[16];
#pragma unroll
      for (int it = 0; it < 16; ++it) gwa[it] = *(const v4u*)(graw + (size_t)(2 * it + (le >> 5)) * 2048 + 256 * wave + pp * 8);
#pragma unroll
      for (int it = 0; it < 16; ++it) { const int row = 2 * it + (le >> 5); const size_t off = (size_t)row * 2048 + 256 * wave + pp * 8;
          const v4u gw = gwa[it]; const v4u aw = *(const LAS v4u*)(tw + row * 528 + pp * 16);
          float hp = 0.f, hn = 0.f;
          if (pp == 0 && wave > 0) hp = bf1(graw[off - 1]); if (pp == 31 && wave < 7) hn = bf1(graw[off + 8]);
          float gx[10]; gx[1] = bf_lo(gw.x); gx[2] = bf_hi(gw.x); gx[3] = bf_lo(gw.y); gx[4] = bf_hi(gw.y); gx[5] = bf_lo(gw.z); gx[6] = bf_hi(gw.z); gx[7] = bf_lo(gw.w); gx[8] = bf_hi(gw.w);
          const float fromprev = shidx(gx[8], le - 1), fromnext = shidx(gx[1], le + 1);
          gx[0] = pp > 0 ? fromprev : hp; gx[9] = pp < 31 ? fromnext : hn;
          const float av[8] = {bf_lo(aw.x), bf_hi(aw.x), bf_lo(aw.y), bf_hi(aw.y), bf_lo(aw.z), bf_hi(aw.z), bf_lo(aw.w), bf_hi(aw.w)};
          float o[8];
#pragma unroll
          for (int j = 0; j < 8; ++j) o[j] = (tg.b + tg.w0 * gx[j] + tg.w1 * gx[j + 1] + tg.w2 * gx[j + 2]) * av[j];
          v4u w; w.x = pk2(o[0], o[1]); w.y = pk2(o[2], o[3]); w.z = pk2(o[4], o[5]); w.w = pk2(o[6], o[7]);
          *(v4u*)(out + off) = w; }
    }
}
template <bool CONVIN>
__device__ __forceinline__ void ph_lconv(const Params& p, int o, const bf16* IN, const bf16* UT, bf16* OUT, LAS unsigned char* lds, int tid, int lane, int wave) {
    const bf16* FILT = (const bf16*)(p.ws + WS_FILT); const float* cw = p.in[I_CONVHYW]; const float* cbias = p.in[I_CONVHYB];
#pragma unroll 1
    for (int c = blockIdx.x; c < 1024; c += gridDim.x) { const int gc = (1 + o) * 1024 + c;
        const Taps ti{cw[c], cw[3072 + c], cw[6144 + c], cbias[c]}, tg{cw[gc], cw[3072 + gc], cw[6144 + gc], cbias[gc]};
        lconv_unit<CONVIN>(IN + (size_t)c * T, ti, FILT + (size_t)(o * 1024 + c) * 2048, UT + (size_t)gc * T, tg, p.in[I_FBIAS][o * 1024 + c], OUT + (size_t)c * T, lds, tid, lane, wave); }
}
__device__ __forceinline__ void ph_transpose(const bf16* Y2T, bf16* Y2, LAS unsigned char* lds, int lane, int wave) {
    LAS unsigned char* tl = lds + wave * 16384;
    const int gw = blockIdx.x * NWAVES + wave, NGW = gridDim.x * NWAVES;
#pragma unroll 1
    for (int tile = gw; tile < 16 * 1024; tile += NGW) { const int c0 = (tile & 15) * 64, t0 = (tile >> 4) * 64;
#pragma unroll
        for (int rr = 0; rr < 8; ++rr) { const int row = rr * 8 + (lane >> 3), pc = lane & 7;
            *(LAS v4u*)(tl + row * 144 + pc * 16) = *(const v4u*)(Y2T + (size_t)(c0 + row) * T + t0 + pc * 8); }
        LDS_WAIT(); asm volatile("" ::: "memory");
#pragma unroll
        for (int rr = 0; rr < 8; ++rr) { const int tk = rr * 8 + (lane >> 3), cp = (lane & 7) * 8;
            unsigned short e[8];
#pragma unroll
            for (int j = 0; j < 8; ++j) e[j] = *(const LAS unsigned short*)(tl + (cp + j) * 144 + tk * 2);
            v4u w; w.x = e[0] | ((unsigned)e[1] << 16); w.y = e[2] | ((unsigned)e[3] << 16); w.z = e[4] | ((unsigned)e[5] << 16); w.w = e[6] | ((unsigned)e[7] << 16);
            *(v4u*)(Y2 + (size_t)(t0 + tk) * D + c0 + cp) = w; }
        LDS_WAIT(); asm volatile("" ::: "memory");
    }
}

constexpr float QSCALE = 0.125f * 1.4426950408889634f;
struct InprojSched { int G, c;
    __device__ __forceinline__ bool next(int i, Unit& u) const { const int L = i * G + c; if (L >= 3840 + 288) return false;
        if (L < 3840) { u.pm = L / 15; u.pn = L % 15; } else { const int q = L - 3840; u.pm = 256 + q / 9; u.pn = 6 + q % 9; } return true; }
    __device__ __forceinline__ int arow(int r) const { return r; }
    __device__ __forceinline__ void* probe_ts() const { return nullptr; } };
struct EpiInproj { static constexpr bool PERM = true, AFTER_DRAIN = false, PROBE = false; unsigned char* big; const float* rope; float* gates; const float* gate_b;
    __device__ __forceinline__ void operator()(const f32x4 (&acc)[2][2][4][2], const Unit& u, int wr, int wc, int fr, int fq) const {
        const bool ctx = u.pm >= 256; const int b = ctx ? u.pm - 256 : (u.pm >> 3), r0 = ctx ? 0 : (u.pm & 7) * 256;
        if (u.pn == 14) {
            if (wc != 0 || fq >= 2) return;
            const f32x4 gb0 = *(const f32x4*)(gate_b + 8 * fq), gb1 = *(const f32x4*)(gate_b + 8 * fq + 4);
#pragma unroll
            for (int ai = 0; ai < 2; ++ai)
#pragma unroll
                for (int m = 0; m < 4; ++m) { const int rr = r0 + wr * 64 + fr + ai * HALF + m * 16; const size_t grow = ctx ? (size_t)T + b * LC + rr : (size_t)b * SEQ + rr;
                    float* gp = gates + grow * 16 + 8 * fq; *(f32x4*)gp = acc[ai][0][m][0] + gb0; *(f32x4*)(gp + 4) = acc[ai][0][m][1] + gb1; }
            return; }
        const int t = u.pn >> 1;
        constexpr size_t offs[7] = {A0_QA, A0_BQ, A0_BO, A0_KA, A0_VA, A0_BK, A0_BV};
        const bool kv = t >= 3;
        size_t toff = A0_QA;
#pragma unroll
        for (int q = 0; q < 7; ++q) if (t == q) toff = offs[q];
        bf16* O = (bf16*)(big + toff) + (size_t)b * (kv ? (SEQ + LC) : SEQ) * 512 + (size_t)((kv && !ctx) ? LC : 0) * 512;
        const bool rope_on = (t == 0 || t == 3) && !ctx; const float qs = t == 0 ? QSCALE : 1.f;
        const int col0 = (u.pn & 1) * 256 + wc * 32 + 8 * fq;
#pragma unroll
        for (int ai = 0; ai < 2; ++ai)
#pragma unroll
            for (int m = 0; m < 4; ++m) { const int rr = r0 + wr * 64 + fr + ai * HALF + m * 16; bf16* rowp = O + (size_t)rr * 512 + col0;
                f32x4 cs0 = (f32x4){1.f, 0.f, 1.f, 0.f}, cs1 = cs0;
                if (rope_on) { const int pos = (wc & 1) ? (rr & 63) : (rr >> 6); const float* rp = rope + (size_t)(pos * 16 + 4 * fq) * 2; cs0 = *(const f32x4*)rp; cs1 = *(const f32x4*)(rp + 4); }
#pragma unroll
                for (int bj = 0; bj < 2; ++bj) { const f32x4 x0 = acc[ai][bj][m][0], x1 = acc[ai][bj][m][1];
                    f32x4 o0, o1;
                    o0[0] = x0[0] * cs0[0] - x1[0] * cs0[1]; o1[0] = x1[0] * cs0[0] + x0[0] * cs0[1];
                    o0[1] = x0[1] * cs0[2] - x1[1] * cs0[3]; o1[1] = x1[1] * cs0[2] + x0[1] * cs0[3];
                    o0[2] = x0[2] * cs1[0] - x1[2] * cs1[1]; o1[2] = x1[2] * cs1[0] + x0[2] * cs1[1];
                    o0[3] = x0[3] * cs1[2] - x1[3] * cs1[3]; o1[3] = x1[3] * cs1[2] + x0[3] * cs1[3];
                    o0 = o0 * qs; o1 = o1 * qs;
                    u32x4 w; w.x = cvt_pk_bf16(o0[0], o0[1]); w.y = cvt_pk_bf16(o0[2], o0[3]); w.z = cvt_pk_bf16(o1[0], o1[1]); w.w = cvt_pk_bf16(o1[2], o1[3]);
                    *(u32x4*)(rowp + bj * HALF) = w; } }
    } };
__device__ __forceinline__ void ph_transpose_b(const bf16* src, bf16* dst, int NBt, int R, int C, LAS unsigned char* lds, int lane, int wave) {
    LAS unsigned char* tl = lds + wave * 16384;
    const int gw = blockIdx.x * NWAVES + wave, NGW = gridDim.x * NWAVES; const int tr = R / 64, tc = C / 64, per = tr * tc;
#pragma unroll 1
    for (int tile = gw; tile < NBt * per; tile += NGW) { const int bt = tile / per, q = tile % per, c0 = (q % tc) * 64, r0 = (q / tc) * 64;
        const bf16* s = src + (size_t)bt * R * C; bf16* d = dst + (size_t)bt * R * C;
#pragma unroll
        for (int rr = 0; rr < 8; ++rr) { const int row = rr * 8 + (lane >> 3), pc = lane & 7;
            *(LAS v4u*)(tl + row * 144 + pc * 16) = *(const v4u*)(s + (size_t)(r0 + row) * C + c0 + pc * 8); }
        LDS_WAIT(); asm volatile("" ::: "memory");
#pragma unroll
        for (int rr = 0; rr < 8; ++rr) { const int cc = rr * 8 + (lane >> 3), rp = (lane & 7) * 8;
            unsigned short e[8];
#pragma unroll
            for (int j = 0; j < 8; ++j) e[j] = *(const LAS unsigned short*)(tl + (rp + j) * 144 + cc * 2);
            v4u w; w.x = e[0] | ((unsigned)e[1] << 16); w.y = e[2] | ((unsigned)e[3] << 16); w.z = e[4] | ((unsigned)e[5] << 16); w.w = e[6] | ((unsigned)e[7] << 16);
            *(v4u*)(d + (size_t)(c0 + cc) * R + r0 + rp) = w; }
        LDS_WAIT(); asm volatile("" ::: "memory");
    }
}

typedef float f32x2 __attribute__((ext_vector_type(2)));
constexpr int AT_KP = 272, AT_VP = 136  , AT_KB = 64 * AT_KP, AT_VB = 128 * AT_VP, AT_V0 = 2 * AT_KB;
__device__ __forceinline__ void ph_attn(const Params& p, unsigned char* big, LAS unsigned char* lds, int tid, int lane, int wave, int vcu) {
    const bf16* QA = (const bf16*)(big + A0_QA); const bf16* KA = (const bf16*)(big + A0_KA); const bf16* VT = (const bf16*)(big + A0_VT); bf16* MIXIN = (bf16*)(big + A0_MIXIN);
    const int comp = wave >> 2, qw = wave & 3, r = lane & 31, hh = lane >> 5;
    float lam; { const float* lv = p.in[I_DLAM]; const float a = wave_sum(lv[lane] * lv[64 + lane]), b2 = wave_sum(lv[128 + lane] * lv[192 + lane]); lam = expf(a) - expf(b2) + 0.2f; }
#pragma unroll 1
    for (int unit = vcu; unit < 2048; unit += gridDim.x) {
        const int b = unit >> 6, h = (unit >> 4) & 3, qblk = unit & 15, q0 = qblk * 128 + qw * 32;
        const bf16* Kg = KA + (size_t)b * (SEQ + LC) * 512 + h * 128; const bf16* Vg = VT + ((size_t)b * 512 + h * 128) * (SEQ + LC);
        bf16x8 qf[4];
#pragma unroll
        for (int ds = 0; ds < 4; ++ds) qf[ds] = *(const bf16x8*)(QA + ((size_t)b * SEQ + q0 + r) * 512 + h * 128 + comp * 64 + ds * 16 + hh * 8);
        f32x16 oacc[4];
#pragma unroll
        for (int i = 0; i < 4; ++i)
#pragma unroll
            for (int q = 0; q < 16; ++q) oacc[i][q] = 0.f;
        float m_run = 0.f, l_run = 0.f;
        v4u pre[4];
#define AT_LOADG(kt) do { _Pragma("unroll") for (int q = 0; q < 2; ++q) { const int idx = tid + NTHR * q; \
            pre[q] = *(const v4u*)(Kg + (size_t)((kt) * 64 + (idx >> 4)) * 512 + (idx & 15) * 8); \
            pre[2 + q] = *(const v4u*)(Vg + (size_t)(idx >> 3) * (SEQ + LC) + (kt) * 64 + (idx & 7) * 8); } } while (0)
#define AT_STORES(kn) do { _Pragma("unroll") for (int q = 0; q < 2; ++q) { const int idx = tid + NTHR * q; \
            *(LAS v4u*)(lds + ((kn) & 1) * AT_KB + (idx >> 4) * AT_KP + (idx & 15) * 16) = pre[q]; \
            { LAS unsigned char* vd_ = lds + AT_V0 + ((kn) % 3) * AT_VB + (idx >> 3) * AT_VP + (idx & 7) * 16; v2u h0_, h1_; h0_.x = pre[2 + q].x; h0_.y = pre[2 + q].y; h1_.x = pre[2 + q].z; h1_.y = pre[2 + q].w; \
              *(LAS v2u*)vd_ = h0_; *(LAS v2u*)(vd_ + 8) = h1_; } } } while (0)
#define AT_PV(PF, VT_) do { const LAS unsigned char* Vt_ = (VT_); _Pragma("unroll") for (int kb = 0; kb < 2; ++kb) _Pragma("unroll") for (int s = 0; s < 2; ++s) _Pragma("unroll") for (int dvb = 0; dvb < 4; ++dvb) { \
            const LAS unsigned char* vp = Vt_ + (32 * dvb + r) * AT_VP + (32 * kb + 16 * s + 4 * hh) * 2; const u32x2 lo = *(const LAS u32x2*)vp, hi = *(const LAS u32x2*)(vp + 16); \
            u32x4 vw; vw.x = lo.x; vw.y = lo.y; vw.z = hi.x; vw.w = hi.y; oacc[dvb] = __builtin_amdgcn_mfma_f32_32x32x16_bf16(__builtin_bit_cast(bf16x8, vw), PF[kb][s], oacc[dvb], 0, 0, 0); } } while (0)
        bf16x8 phold[2][2];
        __syncthreads();
        AT_LOADG(0); AT_STORES(0);
        __syncthreads();
#pragma unroll 1
        for (int kt = 0; kt < 36; ++kt) {
            if (kt < 35) AT_LOADG(kt + 1);
            const LAS unsigned char* Kt = lds + (kt & 1) * AT_KB;
            if (comp == 1 && kt > 0) { AT_PV(phold, lds + AT_V0 + ((kt - 1) % 3) * AT_VB); }
            f32x16 sacc[2];
#pragma unroll
            for (int kb = 0; kb < 2; ++kb)
#pragma unroll
                for (int q = 0; q < 16; ++q) sacc[kb][q] = -m_run;
#pragma unroll
            for (int ds = 0; ds < 4; ++ds)
#pragma unroll
                for (int kb = 0; kb < 2; ++kb) { const bf16x8 kf = *(const LAS bf16x8*)(Kt + (32 * kb + r) * AT_KP + comp * 128 + ds * 32 + hh * 16);
                    sacc[kb] = __builtin_amdgcn_mfma_f32_32x32x16_bf16(kf, qf[ds], sacc[kb], 0, 0, 0); }
            float mx = sacc[0][0];
#pragma unroll
            for (int kb = 0; kb < 2; ++kb)
#pragma unroll
                for (int q = 0; q < 16; ++q) mx = fmaxf(mx, sacc[kb][q]);
            mx = fmaxf(mx, shx(mx, 32));
            if (kt == 0 || __builtin_amdgcn_ballot_w64(mx > 0.f) != 0ull) {
                const float dm = kt == 0 ? mx : fmaxf(mx, 0.f), alpha = __builtin_amdgcn_exp2f(-dm); m_run += dm; l_run *= alpha;
#pragma unroll
                for (int kb = 0; kb < 2; ++kb) sacc[kb] = sacc[kb] - dm;
#pragma unroll
                for (int i = 0; i < 4; ++i) oacc[i] = oacc[i] * alpha; }
            f32x2 ps2 = (f32x2){0.f, 0.f};
#pragma unroll
            for (int kb = 0; kb < 2; ++kb)
#pragma unroll
                for (int q = 0; q < 8; ++q) { f32x2 e; e.x = __builtin_amdgcn_exp2f(sacc[kb][2 * q]); e.y = __builtin_amdgcn_exp2f(sacc[kb][2 * q + 1]); sacc[kb][2 * q] = e.x; sacc[kb][2 * q + 1] = e.y; ps2 += e; }
            l_run += ps2.x + ps2.y;
#pragma unroll
            for (int kb = 0; kb < 2; ++kb)
#pragma unroll
                for (int s = 0; s < 2; ++s) {
                    u32x4 pw; pw.x = cvt_pk_bf16(sacc[kb][8 * s + 0], sacc[kb][8 * s + 1]); pw.y = cvt_pk_bf16(sacc[kb][8 * s + 2], sacc[kb][8 * s + 3]);
                    pw.z = cvt_pk_bf16(sacc[kb][8 * s + 4], sacc[kb][8 * s + 5]); pw.w = cvt_pk_bf16(sacc[kb][8 * s + 6], sacc[kb][8 * s + 7]);
                    phold[kb][s] = __builtin_bit_cast(bf16x8, pw); }
            if (comp == 0) { AT_PV(phold, lds + AT_V0 + (kt % 3) * AT_VB); }
            if (kt < 35) AT_STORES(kt + 1);
            __syncthreads();
        }
        if (comp == 1) { AT_PV(phold, lds + AT_V0 + (35 % 3) * AT_VB); }
        __syncthreads();
#undef AT_LOADG
#undef AT_STORES
#undef AT_PV
        const float lsum = l_run + shx(l_run, 32), inv = 1.f / lsum;
        LAS float* X = (LAS float*)lds;
        if (comp == 1) {
#pragma unroll
            for (int dvb = 0; dvb < 4; ++dvb)
#pragma unroll
                for (int q = 0; q < 16; ++q) X[(qw * 64 + dvb * 16 + q) * 64 + lane] = oacc[dvb][q] * inv; }
        __syncthreads();
        if (comp == 0) {
            float ss = 0.f;
#pragma unroll
            for (int dvb = 0; dvb < 4; ++dvb)
#pragma unroll
                for (int q = 0; q < 16; ++q) { const float o = oacc[dvb][q] * inv - lam * X[(qw * 64 + dvb * 16 + q) * 64 + lane]; oacc[dvb][q] = o; ss += o * o; }
            ss += shx(ss, 32);
            const float rn = rsqrtf(ss * (1.f / 128.f) + RMS_EPS) * 0.8f;
            const float* ga = p.in[I_HGA] + h * 128; bf16* orow = MIXIN + ((size_t)b * SEQ + q0 + r) * D + h * 128;
#pragma unroll
            for (int dvb = 0; dvb < 4; ++dvb)
#pragma unroll
                for (int g = 0; g < 4; ++g) { const int dv = 32 * dvb + 8 * g + 4 * hh; const f32x4 gg = *(const f32x4*)(ga + dv);
                    v2u w; w.x = pk2(oacc[dvb][4 * g + 0] * rn * gg[0], oacc[dvb][4 * g + 1] * rn * gg[1]); w.y = pk2(oacc[dvb][4 * g + 2] * rn * gg[2], oacc[dvb][4 * g + 3] * rn * gg[3]);
                    *(v2u*)(orow + dv) = w; }
        }
    }
    __syncthreads();
}

constexpr int ML_P = 272, ML_TILE = 64 * ML_P;
constexpr int ML_VOFF = 3 * ML_TILE, ML_VSZ = 64 * 256;
constexpr int ML_RQ = ML_VOFF + 2 * ML_VSZ, ML_RSZ = 68 * 256, ML_RK = ML_RQ + ML_RSZ;
constexpr int ML_NOFF = ML_RK + ML_RSZ, ML_AOFF = ML_NOFF + 2 * 512;
constexpr int ML_CW = ML_AOFF + 8 * 256;
static_assert(ML_CW + 8 * 512 <= LDS_TAB, "mLSTM LDS map");
typedef short s16x4 __attribute__((ext_vector_type(4)));
__device__ __forceinline__ u32x2 tr16(const LAS unsigned char* p) { return __builtin_bit_cast(u32x2, __builtin_amdgcn_ds_read_tr16_b64_v4i16((LAS s16x4*)p)); }
__device__ __forceinline__ float logsigmoidf_(float x) { return x >= 0.f ? -__logf(1.f + __expf(-x)) : x - __logf(1.f + __expf(x)); }
__device__ __forceinline__ bf16x8 pack8(const f32x16& v, int s) { u32x4 w; w.x = cvt_pk_bf16(v[8 * s + 0], v[8 * s + 1]); w.y = cvt_pk_bf16(v[8 * s + 2], v[8 * s + 3]); w.z = cvt_pk_bf16(v[8 * s + 4], v[8 * s + 5]); w.w = cvt_pk_bf16(v[8 * s + 6], v[8 * s + 7]); return __builtin_bit_cast(bf16x8, w); }
__device__ __forceinline__ void ph_mlstm(const Params& p, unsigned char* big, LAS unsigned char* lds, int tid, int lane, int wave) {
    const int bid = blockIdx.x; if (bid >= 256) return;
    const int b = bid >> 3, h = (bid >> 1) & 3, dir = bid & 1;
    const bf16* BQ = (const bf16*)(big + A0_BQ) + (size_t)b * SEQ * 512 + h * 128;
    const bf16* BK = (const bf16*)(big + A0_BK) + (size_t)b * (SEQ + LC) * 512 + h * 128;
    const bf16* BV = (const bf16*)(big + A0_BV) + (size_t)b * (SEQ + LC) * 512 + h * 128;
    bf16* HB = (bf16*)(big + A0_HB) + (size_t)dir * T * 512 + (size_t)b * SEQ * 512 + h * 128;
    const float* GT = (const float*)(p.ws + WS_GATES);
    const float* cw = p.in[I_CONVABW]; const float* cb = p.in[I_CONVABB];
    const int eb = wave & 3, tb = wave >> 2, r = lane & 31, hh = lane >> 5;
    const int blk = (lane >> 4) & 1, tq = (lane & 15) >> 2, tp = lane & 3;
    LAS float* nbuf = (LAS float*)(lds + ML_NOFF); LAS float* aw = (LAS float*)(lds + ML_AOFF) + wave * 64;
    if (tid < 256) nbuf[tid] = 0.f;
    LAS float* cwl = (LAS float*)(lds + ML_CW);
    for (int i = tid; i < 1024; i += NTHR) { const int ten = i >> 9, j = (i >> 7) & 3, d = i & 127, ch = ten * 512 + h * 128 + d; cwl[i] = j < 3 ? cw[j * 1024 + ch] : cb[ch]; }
    f32x16 cacc[4];
#pragma unroll
    for (int i = 0; i < 4; ++i)
#pragma unroll
        for (int q = 0; q < 16; ++q) cacc[i][q] = 0.f;
    float m_state = 0.f;
#ifdef ML_PROBE
    unsigned long long accs[6] = {0, 0, 0, 0, 0, 0}; unsigned long long tp0 = __builtin_amdgcn_s_memrealtime();
#define ML_T(i) do { const unsigned long long t1_ = __builtin_amdgcn_s_memrealtime(); accs[i] += t1_ - tp0; tp0 = t1_; } while (0)
#else
#define ML_T(i)
#endif
    float a_c = 0.f, M_c = 0.f, b_c = 0.f, decay_c = 1.f, m_after = 0.f;
    float a_n = 0.f, M_n = 0.f, b_n = 0.f, w_n = 0.f, decay_n = 1.f, m_next = 0.f;
#define ML_POS(cc, t) ((cc) < 4 ? (dir ? 255 - ((cc) * 64 + (t)) : (cc) * 64 + (t)) : (dir ? 2047 - (((cc) - 4) * 64 + (t)) : ((cc) - 4) * 64 + (t)))
#define ML_GLOAD(cc, li_, fp_) do { const int pos_ = ML_POS(cc, lane); const size_t grow_ = (cc) < 4 ? (size_t)T + b * LC + pos_ : (size_t)b * SEQ + pos_; \
        li_ = GT[grow_ * 16 + dir * 8 + h]; fp_ = GT[grow_ * 16 + dir * 8 + 4 + h]; } while (0)
#define ML_SCAN(li_, fp_, m_in) do { const float lf_ = logsigmoidf_(fp_); \
        float bs_ = lf_; _Pragma("unroll") for (int o_ = 1; o_ < 64; o_ <<= 1) { const float v_ = shup(bs_, o_); if (lane >= o_) bs_ += v_; } \
        const float aa_ = (li_) - bs_; float pm_ = aa_; _Pragma("unroll") for (int o_ = 1; o_ < 64; o_ <<= 1) { const float v_ = shup(pm_, o_); if (lane >= o_) pm_ = fmaxf(pm_, v_); } \
        const float MM_ = fmaxf(m_in, pm_); const float M63_ = shidx(MM_, 63), b63_ = shidx(bs_, 63); \
        a_n = aa_; M_n = MM_; b_n = bs_; w_n = __expf(aa_ - M63_); decay_n = __expf((m_in) - M63_); m_next = b63_ + M63_; } while (0)
#define ML_DMA(cc, vbuf) do { const int lim_ = (cc) < 4 ? LC : SEQ, kvb_ = (cc) < 4 ? 0 : LC; \
        _Pragma("unroll 1") for (int ins_ = wave; ins_ < 17; ins_ += NWAVES) { const int rr_ = ins_ * 4 + (lane >> 4), pc_ = lane & 15; int pos_ = ML_POS(cc, rr_ - 1); pos_ = pos_ < 0 ? 0 : (pos_ >= lim_ ? lim_ - 1 : pos_); \
            __builtin_amdgcn_global_load_lds((const unsigned*)(BK + (size_t)(kvb_ + pos_) * 512 + pc_ * 8), (LAS unsigned*)(lds + ML_RK + ins_ * 1024), 16, 0, 0); \
            if ((cc) >= 4) __builtin_amdgcn_global_load_lds((const unsigned*)(BQ + (size_t)pos_ * 512 + pc_ * 8), (LAS unsigned*)(lds + ML_RQ + ins_ * 1024), 16, 0, 0); } \
        _Pragma("unroll") for (int q_ = 0; q_ < 2; ++q_) { const int ins_ = wave * 2 + q_, t_ = ins_ * 4 + (lane >> 4), pc_ = lane & 15; const int pos_ = ML_POS(cc, t_); \
            __builtin_amdgcn_global_load_lds((const unsigned*)(BV + (size_t)(kvb_ + pos_) * 512 + pc_ * 8), (LAS unsigned*)(lds + ML_VOFF + (vbuf) * ML_VSZ + ins_ * 1024), 16, 0, 0); } } while (0)
#define ML_CONV8(dst, rawoff, cc, t_, d8_, ten, scl) do { const int pos_ = ML_POS(cc, t_), lim_ = (cc) < 4 ? LC : SEQ; const int rm_ = dir ? (t_) + 2 : (t_), rp_ = dir ? (t_) : (t_) + 2; \
        v4u x_[3]; x_[0] = *(const LAS v4u*)(lds + (rawoff) + rm_ * 256 + (d8_) * 16); x_[1] = *(const LAS v4u*)(lds + (rawoff) + ((t_) + 1) * 256 + (d8_) * 16); x_[2] = *(const LAS v4u*)(lds + (rawoff) + rp_ * 256 + (d8_) * 16); \
        if (pos_ - 1 < 0) x_[0] = (v4u){0u, 0u, 0u, 0u}; if (pos_ + 1 >= lim_) x_[2] = (v4u){0u, 0u, 0u, 0u}; \
        const LAS float* wl_ = cwl + (ten) * 512 + (d8_) * 8; f32x4 wv_[4][2]; \
        _Pragma("unroll") for (int j_ = 0; j_ < 4; ++j_) { wv_[j_][0] = *(const LAS f32x4*)(wl_ + j_ * 128); wv_[j_][1] = *(const LAS f32x4*)(wl_ + j_ * 128 + 4); } \
        _Pragma("unroll") for (int e_ = 0; e_ < 8; ++e_) { float s_ = wv_[3][e_ >> 2][e_ & 3]; \
            _Pragma("unroll") for (int j_ = 0; j_ < 3; ++j_) { const unsigned w_ = e_ < 2 ? x_[j_].x : e_ < 4 ? x_[j_].y : e_ < 6 ? x_[j_].z : x_[j_].w; s_ += wv_[j_][e_ >> 2][e_ & 3] * ((e_ & 1) ? bf_hi(w_) : bf_lo(w_)); } \
            dst[e_] = __fdividef(s_, 1.f + __expf(-s_)) * (scl); } } while (0)
#define ML_BUILD(cc) do { _Pragma("unroll 1") for (int q_ = 0; q_ < 2; ++q_) { const int idx_ = tid + NTHR * q_, t_ = idx_ >> 4, d8_ = idx_ & 15; \
        float kk_[8]; ML_CONV8(kk_, ML_RK, cc, t_, d8_, 1, 1.f); const float wt_ = shidx(w_n, t_); \
        v4u o_; o_.x = pk2(kk_[0], kk_[1]); o_.y = pk2(kk_[2], kk_[3]); o_.z = pk2(kk_[4], kk_[5]); o_.w = pk2(kk_[6], kk_[7]); *(LAS v4u*)(lds + ML_TILE + t_ * ML_P + d8_ * 16) = o_; \
        o_.x = pk2(kk_[0] * wt_, kk_[1] * wt_); o_.y = pk2(kk_[2] * wt_, kk_[3] * wt_); o_.z = pk2(kk_[4] * wt_, kk_[5] * wt_); o_.w = pk2(kk_[6] * wt_, kk_[7] * wt_); *(LAS v4u*)(lds + 2 * ML_TILE + t_ * ML_P + d8_ * 16) = o_; \
        if ((cc) >= 4) { float qq_[8]; ML_CONV8(qq_, ML_RQ, cc, t_, d8_, 0, 0.08838834764831845f); \
            o_.x = pk2(qq_[0], qq_[1]); o_.y = pk2(qq_[2], qq_[3]); o_.z = pk2(qq_[4], qq_[5]); o_.w = pk2(qq_[6], qq_[7]); *(LAS v4u*)(lds + t_ * ML_P + d8_ * 16) = o_; } } } while (0)
    __syncthreads();
    { float li0, fp0; ML_GLOAD(0, li0, fp0); ML_DMA(0, 0); ML_SCAN(li0, fp0, m_state); }
    asm volatile("s_waitcnt vmcnt(0)" ::: "memory");
    __syncthreads();
    ML_BUILD(0);
    a_c = a_n; M_c = M_n; b_c = b_n; decay_c = decay_n; m_after = m_next;
    __syncthreads();
#pragma unroll 1
    for (int cc = 0; cc < 36; ++cc) {
        const LAS unsigned char* Qs = lds; const LAS unsigned char* Ks = lds + ML_TILE; const LAS unsigned char* Kw = lds + 2 * ML_TILE; const LAS unsigned char* Vs = lds + ML_VOFF + (cc & 1) * ML_VSZ;
        const LAS float* ncur = nbuf + (cc & 1) * 128; LAS float* nnew = nbuf + ((cc + 1) & 1) * 128;
        float li1 = 0.f, fp1 = 0.f;
        ML_T(5);
        if (cc < 35) { ML_GLOAD(cc + 1, li1, fp1); ML_DMA(cc + 1, (cc + 1) & 1); }
        ML_T(0);
        if (cc >= 4) {
            aw[lane] = a_c;
            const int tcol = 32 * tb + r; const float Mt = shidx(M_c, tcol), bt = shidx(b_c, tcol);
            f32x16 nacc;
#pragma unroll
            for (int q = 0; q < 16; ++q) nacc[q] = 0.f;
#pragma unroll
            for (int db = 0; db < 4; ++db)
#pragma unroll
                for (int s2 = 0; s2 < 2; ++s2) { const LAS unsigned char* qp = Qs + tcol * ML_P + (32 * db + 16 * s2 + 4 * hh) * 2; const u32x2 lo = *(const LAS u32x2*)qp, hi = *(const LAS u32x2*)(qp + 16);
                    u32x4 qw; qw.x = lo.x; qw.y = lo.y; qw.z = hi.x; qw.w = hi.y;
                    nacc = __builtin_amdgcn_mfma_f32_32x32x16_bf16(pack8(cacc[db], s2), __builtin_bit_cast(bf16x8, qw), nacc, 0, 0, 0); }
            const float sc = __expf(m_state - Mt);
            nacc = nacc * sc;
            float rs = 0.f;
#pragma unroll
            for (int sb = 0; sb < 2; ++sb) if (sb <= tb) {
                f32x16 sacc;
#pragma unroll
                for (int q = 0; q < 16; ++q) sacc[q] = 0.f;
#pragma unroll
                for (int ds = 0; ds < 8; ++ds) { const bf16x8 kf = *(const LAS bf16x8*)(Ks + (32 * sb + r) * ML_P + (16 * ds + 8 * hh) * 2), qf = *(const LAS bf16x8*)(Qs + tcol * ML_P + (16 * ds + 8 * hh) * 2);
                    sacc = __builtin_amdgcn_mfma_f32_32x32x16_bf16(kf, qf, sacc, 0, 0, 0); }
#pragma unroll
                for (int g = 0; g < 4; ++g) { const int s0 = 32 * sb + 8 * g + 4 * hh; const f32x4 av = *(const LAS f32x4*)(aw + s0);
#pragma unroll
                    for (int j = 0; j < 4; ++j) { const bool keep = (s0 + j) <= tcol; const float v = keep ? sacc[4 * g + j] * __expf(av[j] - Mt) : 0.f; sacc[4 * g + j] = v; rs += v; } }
#pragma unroll
                for (int s2 = 0; s2 < 2; ++s2) { u32x4 vw;
                    { const u32x2 t0 = tr16(Vs + (32 * sb + 16 * s2 + 4 * hh + tq) * 256 + (32 * eb + 16 * blk + 4 * tp) * 2), t1 = tr16(Vs + (32 * sb + 16 * s2 + 8 + 4 * hh + tq) * 256 + (32 * eb + 16 * blk + 4 * tp) * 2);
                      vw.x = t0.x; vw.y = t0.y; vw.z = t1.x; vw.w = t1.y; }
                    nacc = __builtin_amdgcn_mfma_f32_32x32x16_bf16(__builtin_bit_cast(bf16x8, vw), pack8(sacc, s2), nacc, 0, 0, 0); } }
            rs += shx(rs, 32);
            float qn = 0.f;
            { const LAS unsigned char* qp = Qs + tcol * ML_P + (64 * hh) * 2;
#pragma unroll
              for (int c8 = 0; c8 < 8; ++c8) { const v4u w = *(const LAS v4u*)(qp + c8 * 16); const f32x4 n0 = *(const LAS f32x4*)(ncur + 64 * hh + 8 * c8), n1 = *(const LAS f32x4*)(ncur + 64 * hh + 8 * c8 + 4);
                  qn += bf_lo(w.x) * n0[0] + bf_hi(w.x) * n0[1] + bf_lo(w.y) * n0[2] + bf_hi(w.y) * n0[3] + bf_lo(w.z) * n1[0] + bf_hi(w.z) * n1[1] + bf_lo(w.w) * n1[2] + bf_hi(w.w) * n1[3]; } }
            qn += shx(qn, 32);
            const float den = sc * qn + rs; const float dd = __frcp_rn(fmaxf(fabsf(den), __expf(-(bt + Mt))));
            { const int pos = ML_POS(cc, tcol); bf16* hrow = HB + (size_t)pos * 512 + 32 * eb;
#pragma unroll
              for (int g = 0; g < 4; ++g) { v2u w; w.x = pk2(nacc[4 * g + 0] * dd, nacc[4 * g + 1] * dd); w.y = pk2(nacc[4 * g + 2] * dd, nacc[4 * g + 3] * dd); *(v2u*)(hrow + 8 * g + 4 * hh) = w; } }
        }
        ML_T(1);
#pragma unroll
        for (int db = 0; db < 4; ++db) { cacc[db] = cacc[db] * decay_c;
#pragma unroll
            for (int s4 = 0; s4 < 4; ++s4) { u32x4 ka, vb;
                { const u32x2 t0 = tr16(Kw + (16 * s4 + 8 * hh + tq) * ML_P + (32 * db + 16 * blk + 4 * tp) * 2), t1 = tr16(Kw + (16 * s4 + 8 * hh + 4 + tq) * ML_P + (32 * db + 16 * blk + 4 * tp) * 2);
                  ka.x = t0.x; ka.y = t0.y; ka.z = t1.x; ka.w = t1.y; }
                { const u32x2 t0 = tr16(Vs + (16 * s4 + 8 * hh + tq) * 256 + (32 * eb + 16 * blk + 4 * tp) * 2), t1 = tr16(Vs + (16 * s4 + 8 * hh + 4 + tq) * 256 + (32 * eb + 16 * blk + 4 * tp) * 2);
                  vb.x = t0.x; vb.y = t0.y; vb.z = t1.x; vb.w = t1.y; }
                cacc[db] = __builtin_amdgcn_mfma_f32_32x32x16_bf16(__builtin_bit_cast(bf16x8, ka), __builtin_bit_cast(bf16x8, vb), cacc[db], 0, 0, 0); } }
        { const int d = tid >> 2, part = tid & 3; float s = 0.f;
#pragma unroll
            for (int t = 0; t < 16; ++t) s += bf1(*(const LAS bf16*)(Kw + (part * 16 + t) * ML_P + d * 2));
            s += shx(s, 1); s += shx(s, 2);
            if (part == 0) nnew[d] = decay_c * ncur[d] + s; }
        m_state = m_after;
        ML_T(2);
        asm volatile("s_waitcnt vmcnt(0)" ::: "memory");
        __syncthreads();
        ML_T(3);
        if (cc < 35) { ML_SCAN(li1, fp1, m_state); ML_BUILD(cc + 1); a_c = a_n; M_c = M_n; b_c = b_n; decay_c = decay_n; m_after = m_next; }
        ML_T(4);
        __syncthreads();
    }
#ifdef ML_PROBE
    if (blockIdx.x == 0 && tid == 0) { unsigned long long* ts = (unsigned long long*)(p.ws + WS_CTL + 32768); ts[50] = 0; unsigned long long c_ = 0; for (int i = 0; i < 6; ++i) { c_ += accs[i]; ts[51 + i] = c_; } }
#endif
#undef ML_T
#undef ML_POS
#undef ML_GLOAD
#undef ML_SCAN
#undef ML_DMA
#undef ML_CONV8
#undef ML_BUILD
}
__device__ __forceinline__ void ph_outb(const Params& p, unsigned char* big, int lane, int wave) {
    const int gw = blockIdx.x * NWAVES + wave;
    const bf16* HBf = (const bf16*)(big + A0_HB); const bf16* HBb = HBf + (size_t)T * 512; const bf16* BO = (const bf16*)(big + A0_BO); bf16* MIXIN = (bf16*)(big + A0_MIXIN);
    const float* gb = p.in[I_HGB];
    const f32x4 g0 = *(const f32x4*)(gb + lane * 8), g1 = *(const f32x4*)(gb + lane * 8 + 4);
#pragma unroll 2
    for (int m = gw * 32; m < gw * 32 + 32; ++m) {
        const v4u f = *(const v4u*)(HBf + (size_t)m * 512 + lane * 8), bw = *(const v4u*)(HBb + (size_t)m * 512 + lane * 8), go = *(const v4u*)(BO + (size_t)m * 512 + lane * 8);
        float x[8], o[8]; x[0] = bf_lo(f.x) + bf_lo(bw.x); x[1] = bf_hi(f.x) + bf_hi(bw.x); x[2] = bf_lo(f.y) + bf_lo(bw.y); x[3] = bf_hi(f.y) + bf_hi(bw.y);
        x[4] = bf_lo(f.z) + bf_lo(bw.z); x[5] = bf_hi(f.z) + bf_hi(bw.z); x[6] = bf_lo(f.w) + bf_lo(bw.w); x[7] = bf_hi(f.w) + bf_hi(bw.w);
        o[0] = bf_lo(go.x); o[1] = bf_hi(go.x); o[2] = bf_lo(go.y); o[3] = bf_hi(go.y); o[4] = bf_lo(go.z); o[5] = bf_hi(go.z); o[6] = bf_lo(go.w); o[7] = bf_hi(go.w);
        float ss = 0.f;
#pragma unroll
        for (int j = 0; j < 8; ++j) ss += x[j] * x[j];
        ss += shx(ss, 1); ss += shx(ss, 2); ss += shx(ss, 4); ss += shx(ss, 8);
        const float rn = rsqrtf(ss * (1.f / 128.f) + RMS_EPS);
        float y[8];
#pragma unroll
        for (int j = 0; j < 8; ++j) y[j] = x[j] * rn * (j < 4 ? g0[j] : g1[j - 4]) * sigmoidf_(o[j]);
        v4u w; w.x = pk2(y[0], y[1]); w.y = pk2(y[2], y[3]); w.z = pk2(y[4], y[5]); w.w = pk2(y[6], y[7]);
        *(v4u*)(MIXIN + (size_t)m * D + 512 + lane * 8) = w;
    }
}

constexpr int CW_DBG = 16;
#ifndef DBG_MODE
#define DBG_MODE 0
#endif
#ifndef DBG_L
#define DBG_L 0
#endif
#ifndef DBG_CH
#define DBG_CH 0
#endif
__device__ __forceinline__ void dbg_report(const Params& p, float d) {
    if (!(d >= 0.f)) d = 1.0e6f;
    atomicMax((unsigned*)(p.ws + WS_CTL) + CW_DBG, __float_as_uint(d));
}
__device__ __forceinline__ float block_max(float v, LAS float* red, int tid) { v = wave_max(v); __syncthreads(); if ((tid & 63) == 0) red[tid >> 6] = v; __syncthreads(); float r = red[0];
#pragma unroll
    for (int w = 1; w < 8; ++w) r = fmaxf(r, red[w]); __syncthreads(); return r; }
__device__ __forceinline__ float block_sum(float v, LAS float* red, int tid) { v = wave_sum(v); __syncthreads(); if ((tid & 63) == 0) red[tid >> 6] = v; __syncthreads(); float r = 0.f;
#pragma unroll
    for (int w = 0; w < 8; ++w) r += red[w]; __syncthreads(); return r; }
__device__ __forceinline__ void dbg_moe_check(const Params& p, int l, int ch, const bf16* H2, const bf16* Y, LAS unsigned char* lds, int tid) {
    LAS float* hrow = (LAS float*)lds; LAS float* gu = hrow + 1024; LAS float* a = gu + 512; LAS float* red = a + 256;
    const int t = ch * CHT + blockIdx.x * 64 + 5;
    __syncthreads();
    for (int i = tid; i < 1024; i += NTHR) hrow[i] = bf1(H2[(size_t)t * D + i]);
    __syncthreads();
    const int* EIDX = (const int*)(p.ws + WS_EIDX); const float* WTS = (const float*)(p.ws + WS_WTS); const int* PSLOT = (const int*)(p.ws + WS_PSLOT);
    float yacc[2] = {0.f, 0.f};
#pragma unroll 1
    for (int k = 0; k < 9; ++k) {
        const int e = k < 8 ? (EIDX[(size_t)t * 8 + k] & 255) : 64; const float w = k < 8 ? WTS[(size_t)t * 8 + k] : 1.f;
        const float* Wgu = e < 64 ? p.in[I_EGU] + (size_t)(l * 64 + e) * 1024 * 512 : p.in[I_SGU] + (size_t)l * 1024 * 512;
        const float* Wdn = e < 64 ? p.in[I_EDN] + (size_t)(l * 64 + e) * 256 * 1024 : p.in[I_SDN] + (size_t)l * 256 * 1024;
        float s = 0.f;
#pragma unroll 4
        for (int kk = 0; kk < 1024; ++kk) s += hrow[kk] * Wgu[(size_t)kk * 512 + tid];
        gu[tid] = s;
        __syncthreads();
        if (tid < 256) a[tid] = siluf_(gu[tid]) * gu[256 + tid];
        __syncthreads();
#pragma unroll
        for (int q = 0; q < 2; ++q) { const int n = tid + 512 * q; float s2 = 0.f;
#pragma unroll 4
            for (int j = 0; j < 256; ++j) s2 += a[j] * Wdn[(size_t)j * 1024 + n];
            yacc[q] += w * s2; }
        __syncthreads();
    }
    float err = 0.f, ss = 0.f;
#pragma unroll
    for (int q = 0; q < 2; ++q) { const int n = tid + 512 * q; float f = 0.f;
#pragma unroll 1
        for (int k = 0; k < 9; ++k) { const int slot = PSLOT[(size_t)t * 16 + k]; const float w = k < 8 ? WTS[(size_t)t * 8 + k] : 1.f; f += w * bf1(Y[(size_t)slot * D + n]); }
        err = fmaxf(err, fabsf(f - yacc[q])); ss += yacc[q] * yacc[q]; }
    const float me = block_max(err, red, tid), sq = block_sum(ss, red, tid);
    if (tid == 0) dbg_report(p, me / sqrtf(sq * (1.f / 1024.f) + 1e-30f));
}
__device__ __forceinline__ void dbg_route_check(const Params& p, int l, const bf16* H2, const float* LOG, LAS unsigned char* lds, int tid) {
    LAS float* hrow = (LAS float*)lds; LAS float* lg = hrow + 1024; LAS float* bi = lg + 64; LAS float* sc = bi + 64; LAS float* red = sc + 64;
    const int t = blockIdx.x * 256 + 77;
    __syncthreads();
    for (int i = tid; i < 1024; i += NTHR) hrow[i] = bf1(H2[(size_t)t * D + i]);
    __syncthreads();
    if (tid < 64) { float s = 0.f; const float* W = p.in[I_RW] + (size_t)l * 1024 * 64;
#pragma unroll 4
        for (int k = 0; k < 1024; ++k) s += hrow[k] * W[k * 64 + tid];
        lg[tid] = s; sc[tid] = 1.f / (1.f + expf(-s)); bi[tid] = sc[tid] + p.in[I_RB][l * 64 + tid]; }
    __syncthreads();
    if (tid == 0) {
        float lerr = 0.f;
#pragma unroll 1
        for (int e = 0; e < 64; ++e) lerr = fmaxf(lerr, fabsf(lg[e] - LOG[(size_t)t * 64 + e]));
        float grp[8];
#pragma unroll
        for (int g = 0; g < 8; ++g) { float a = -1e30f, b = -1e30f;
#pragma unroll 1
            for (int j = 0; j < 8; ++j) { const float v = bi[g * 8 + j]; if (v > a) { b = a; a = v; } else if (v > b) b = v; } grp[g] = a + b; }
        unsigned gm = 0;
#pragma unroll 1
        for (int r = 0; r < 4; ++r) { int best = -1; float bv = 0.f;
#pragma unroll
            for (int g = 0; g < 8; ++g) if (!((gm >> g) & 1u) && (best < 0 || grp[g] > bv)) { best = g; bv = grp[g]; }
            gm |= 1u << best; }
        unsigned long long set_ref = 0ull; float ssum = 0.f;
#pragma unroll 1
        for (int r = 0; r < 8; ++r) { int best = -1; float bv = 0.f;
#pragma unroll 1
            for (int e = 0; e < 64; ++e) if (((gm >> (e >> 3)) & 1u) && !((set_ref >> e) & 1ull) && (best < 0 || bi[e] > bv)) { best = e; bv = bi[e]; }
            set_ref |= 1ull << best; ssum += sc[best]; }
        const int* EIDX = (const int*)(p.ws + WS_EIDX); const float* WTS = (const float*)(p.ws + WS_WTS);
        unsigned long long set_f = 0ull; float werr = 0.f, wsum = 0.f;
#pragma unroll 1
        for (int k = 0; k < 8; ++k) { const int e = EIDX[(size_t)t * 8 + k] & 255; set_f |= 1ull << e; const float wr = 2.5f * sc[e] / ssum; werr = fmaxf(werr, fabsf(wr - WTS[(size_t)t * 8 + k])); wsum += WTS[(size_t)t * 8 + k]; }
        float d = 0.f;
        if (DBG_MODE == 0) d = (set_f != set_ref) ? (1.f / 256.f) : 0.f;
        if (DBG_MODE == 1) d = (set_f != set_ref) ? 0.f : werr + fabsf(wsum - 2.5f);
        if (DBG_MODE == 2) d = lerr * (1.f / 256.f);
        atomicAdd((float*)((unsigned*)(p.ws + WS_CTL) + CW_DBG), d);
    }
    __syncthreads();
}
__device__ __forceinline__ unsigned dbg_hash(unsigned x) { x ^= x >> 16; x *= 0x7feb352du; x ^= x >> 15; x *= 0x846ca68bu; x ^= x >> 16; return x; }
__device__ __forceinline__ void dbg_report_wave(const Params& p, float d, int lane) { if (lane == 0) dbg_report(p, d); }
__device__ __forceinline__ void dbg_hyena_check(const Params& p, int mode, const bf16* HN, const bf16* UC, const bf16* ZT, const bf16* Y2T, const bf16* MIX, LAS unsigned char* lds, int lane, int wave) {
    const unsigned hsh = dbg_hash(blockIdx.x * 8u + wave + 12345u), h2 = dbg_hash(hsh), h3 = dbg_hash(h2);
    const bf16* FILT = (const bf16*)(p.ws + WS_FILT);
    float d = 0.f;
    if (mode == 0) {
        const int c = hsh % 3072u, b = h2 % 32u, s = h3 % 2048u; float acc = 0.f;
#pragma unroll 1
        for (int k = lane; k < 1024; k += 64) acc += bf1(HN[(size_t)(b * 2048 + s) * D + k]) * p.in[I_WINHY][(size_t)k * 3072 + c];
        acc = wave_sum(acc);
        const float got = bf1(UC[(size_t)c * T + b * 2048 + s]); d = fabsf(got - acc) / (fabsf(acc) + 0.1f);
    } else if (mode == 5) {
        const int c = hsh % 3072u, b = h2 % 32u; int s = h3 % 2048u; if ((h3 >> 20) % 8u == 0u) s = 0; if ((h3 >> 20) % 8u == 1u) s = 2047;
        float val = p.in[I_CONVHYB][c];
#pragma unroll 1
        for (int j = 0; j < 3; ++j) { const int sj = s + j - 1; if (sj < 0 || sj > 2047) continue; val += p.in[I_CONVHYW][j * 3072 + c] * bf1(ZT[(size_t)c * T + b * 2048 + sj]); }
        const float got = bf1(UC[(size_t)c * T + b * 2048 + s]); d = fabsf(got - val) / (fabsf(val) + 0.1f);
    } else if (mode == 1) {
        LAS float* Z = (LAS float*)(lds + wave * 1024); LAS float* A1 = Z + 64; LAS float* A2 = A1 + 64;
        const int o = hsh & 1u, c = h2 % 1024u, j = h3 % 2048u;
        float z = 0.f; if (lane == 0) z = (float)j / 2047.f; else if (lane < 33) { const int k = (lane - 1) & 15; const float fr = 1e-4f + (float)k * ((15.f - 1e-4f) / 15.f); const float ang = (6.283185307179586f / 2048.f) * (float)j * fr; z = lane < 17 ? cosf(ang) : -sinf(ang); }
        Z[lane] = z; LDS_WAIT(); asm volatile("" ::: "memory");
        float a = p.in[I_FB1][lane];
#pragma unroll 1
        for (int k = 0; k < 33; ++k) a += Z[k] * p.in[I_FW1][k * 64 + lane];
        A1[lane] = sinf(a); LDS_WAIT(); asm volatile("" ::: "memory");
        a = p.in[I_FB2][lane];
#pragma unroll 1
        for (int k = 0; k < 64; ++k) a += A1[k] * p.in[I_FW2][k * 64 + lane];
        A2[lane] = sinf(a); LDS_WAIT(); asm volatile("" ::: "memory");
        float v = wave_sum(A2[lane] * p.in[I_FW3][lane * 2048 + o * 1024 + c]);
        const float mind = -4.605170185988091f / 1.5f, maxd = -4.605170185988091f / 0.3f; const float delta = fabsf(mind + (float)c * ((maxd - mind) / 1023.f));
        v *= expf(-fabsf((float)j - 1024.f) / 1024.f * delta);
        const float got = bf1(FILT[(size_t)(o * 1024 + c) * 2048 + j]); d = fabsf(got - v) / (fabsf(v) + 1e-4f);
    } else if (mode == 2 || mode == 3) {
        const int o = mode - 2, c = hsh % 1024u, b = h2 % 32u; int t = h3 % 2048u; if ((h3 >> 20) % 8u == 0u) t = 0; if ((h3 >> 20) % 8u == 1u) t = 2047;
        const bf16* in = (o == 0 ? UC : ZT) + (size_t)c * T + b * 2048; const bf16* f = FILT + (size_t)(o * 1024 + c) * 2048; float acc = 0.f;
#pragma unroll 1
        for (int s = lane; s < 2048; s += 64) { const int x = 1024 + t - s; if (x >= 0 && x <= 2047) acc += bf1(f[x]) * bf1(in[s]); }
        acc = wave_sum(acc);
        const float gate = bf1(UC[(size_t)((1 + o) * 1024 + c) * T + b * 2048 + t]);
        const float val = gate * (acc + bf1(in[t]) * p.in[I_FBIAS][o * 1024 + c]);
        const float got = bf1((o == 0 ? ZT : Y2T)[(size_t)c * T + b * 2048 + t]); d = fabsf(got - val) / (fabsf(val) + 0.1f);
    } else if (mode == 4) {
        const int tok = hsh % 65536u, n = h2 % 1024u; float acc = 0.f;
#pragma unroll 1
        for (int c = lane; c < 1024; c += 64) acc += bf1(Y2T[(size_t)c * T + tok]) * p.in[I_WOUTHY][(size_t)c * 1024 + n];
        acc = wave_sum(acc);
        const float got = bf1(MIX[(size_t)tok * D + n]); d = fabsf(got - acc) / (fabsf(acc) + 0.1f);
    }
    dbg_report_wave(p, d, lane);
}
__device__ __forceinline__ void dbg_inproj_check(const Params& p, unsigned char* big, int lane, int wave) {
    const unsigned hsh = dbg_hash(blockIdx.x * 8u + wave + 777u), h2 = dbg_hash(hsh);
    const bf16* H0 = (const bf16*)(big + A0_H); const float* W = p.in[I_WINAB];
    int m = hsh % (unsigned)TT; int n = h2 % 3600u;
    const bool ctx = m >= T; if (ctx && n < 1536) n += 1536;
    const int b = ctx ? (m - T) / LC : m / SEQ, s = ctx ? (m - T) % LC : m % SEQ;
    float x = 0.f, xp = 0.f; const bool rope_col = (n < 512) || (n >= 1536 && n < 2048); const int np = rope_col ? (n ^ 16) : n;
#pragma unroll 1
    for (int k = lane; k < 1024; k += 64) { const float hv = bf1(H0[(size_t)m * D + k]); x += hv * W[(size_t)k * 3600 + n]; xp += hv * W[(size_t)k * 3600 + np]; }
    x = wave_sum(x); xp = wave_sum(xp);
    float val = x, got = 0.f;
    if (n >= 3584) { val = x + p.in[I_GATEB][n - 3584]; got = ((const float*)(p.ws + WS_GATES))[(size_t)m * 16 + (n - 3584)]; }
    else { const int t = n / 512, cn = n % 512; int pc = cn;
        if (rope_col) { const int o = cn & 31; pc = (cn & ~31) + (((o & 15) >> 2) * 8 + (o >> 4) * 4 + (o & 3));
            if (!ctx) { const int d = cn & 63, axis = d >> 5, half = (d >> 4) & 1, i = d & 15; const float pos = (float)(axis == 0 ? (s >> 6) : (s & 63)); const float ang = pos * powf(10000.f, -(float)i / 16.f);
                val = half == 0 ? x * cosf(ang) - xp * sinf(ang) : x * cosf(ang) + xp * sinf(ang); } }
        if (t == 0) val *= QSCALE;
        const size_t offs[7] = {A0_QA, A0_BQ, A0_BO, A0_KA, A0_VA, A0_BK, A0_BV}; const bool kv = t >= 3;
        const bf16* O = (const bf16*)(big + offs[t]) + (size_t)b * (kv ? (SEQ + LC) : SEQ) * 512 + (size_t)((kv && !ctx) ? LC : 0) * 512;
        got = bf1(O[(size_t)s * 512 + pc]); }
    dbg_report_wave(p, fabsf(got - val) / (fabsf(val) + 0.1f), lane);
}
__device__ __forceinline__ void dbg_attn_check(const Params& p, unsigned char* big, LAS unsigned char* lds, int lane, int wave) {
    const unsigned hsh = dbg_hash(blockIdx.x * 8u + wave + 4242u), h2 = dbg_hash(hsh);
    const int b = hsh % 32u, h = (hsh >> 8) % 4u, q = h2 % 2048u;
    const bf16* QA = (const bf16*)(big + A0_QA) + ((size_t)b * SEQ + q) * 512 + h * 128; const bf16* KA = (const bf16*)(big + A0_KA) + (size_t)b * 2304 * 512 + h * 128;
    const bf16* VA = (const bf16*)(big + A0_VA) + (size_t)b * 2304 * 512 + h * 128; const bf16* MIXIN = (const bf16*)(big + A0_MIXIN) + ((size_t)b * SEQ + q) * D + h * 128;
    LAS float* Aw = (LAS float*)(lds + wave * 18432);
    const float* lv = p.in[I_DLAM]; const float lam = expf(wave_sum(lv[lane] * lv[64 + lane])) - expf(wave_sum(lv[128 + lane] * lv[192 + lane])) + 0.2f;
    float mx0 = -1e30f, mx1 = -1e30f;
#pragma unroll 1
    for (int key = lane; key < 2304; key += 64) { float s0 = 0.f, s1 = 0.f;
#pragma unroll 1
        for (int d = 0; d < 64; ++d) { s0 += bf1(QA[d]) * bf1(KA[(size_t)key * 512 + d]); s1 += bf1(QA[64 + d]) * bf1(KA[(size_t)key * 512 + 64 + d]); }
        Aw[key] = s0; Aw[2304 + key] = s1; mx0 = fmaxf(mx0, s0); mx1 = fmaxf(mx1, s1); }
    mx0 = wave_max(mx0); mx1 = wave_max(mx1);
    float l0 = 0.f, l1 = 0.f;
#pragma unroll 1
    for (int key = lane; key < 2304; key += 64) { const float e0 = exp2f(Aw[key] - mx0), e1 = exp2f(Aw[2304 + key] - mx1); Aw[key] = e0; Aw[2304 + key] = e1; l0 += e0; l1 += e1; }
    l0 = wave_sum(l0); l1 = wave_sum(l1);
    LDS_WAIT(); asm volatile("" ::: "memory");
    float o[2] = {0.f, 0.f};
#pragma unroll 1
    for (int key = 0; key < 2304; ++key) { const float a = Aw[key] / l0 - lam * Aw[2304 + key] / l1; o[0] += a * bf1(VA[(size_t)key * 512 + lane]); o[1] += a * bf1(VA[(size_t)key * 512 + 64 + lane]); }
    const float ms = wave_sum(o[0] * o[0] + o[1] * o[1]) * (1.f / 128.f); const float rn = rsqrtf(ms + RMS_EPS) * 0.8f;
    float err = 0.f, sc = 0.f;
#pragma unroll
    for (int j = 0; j < 2; ++j) { const float val = o[j] * rn * p.in[I_HGA][h * 128 + 64 * j + lane]; err = fmaxf(err, fabsf(val - bf1(MIXIN[64 * j + lane]))); sc += val * val; }
    err = wave_max(err); sc = sqrtf(wave_sum(sc) * (1.f / 128.f));
    dbg_report_wave(p, err / (sc + 1e-3f), lane);
}
__device__ __forceinline__ float dbg_convsilu(const bf16* base, int pos, int lim, int ch, int d, const float* cw, const float* cb) {
    float s = cb[ch];
#pragma unroll
    for (int j = 0; j < 3; ++j) { const int pj = pos + j - 1; if (pj >= 0 && pj < lim) s += cw[j * 1024 + ch] * bf1(base[(size_t)pj * 512 + d]); }
    return s / (1.f + expf(-s));
}
__device__ __forceinline__ void dbg_mlstm_check(const Params& p, unsigned char* big, LAS unsigned char* lds, int lane, int wave) {
    const unsigned hsh = dbg_hash(blockIdx.x * 8u + wave + 991u), h2 = dbg_hash(hsh);
    const int b = hsh % 32u, h = (hsh >> 8) % 4u, dir = (hsh >> 12) & 1; int tau = h2 % 2048u; if ((h2 >> 16) % 4u == 0u) tau = (h2 >> 20) % 130u;
    const bf16* BQ = (const bf16*)(big + A0_BQ) + (size_t)b * SEQ * 512 + h * 128; const bf16* BK = (const bf16*)(big + A0_BK) + (size_t)b * (SEQ + LC) * 512 + h * 128;
    const bf16* BV = (const bf16*)(big + A0_BV) + (size_t)b * (SEQ + LC) * 512 + h * 128;
    const float* GT = (const float*)(p.ws + WS_GATES); const float* cw = p.in[I_CONVABW]; const float* cb = p.in[I_CONVABB];
    LAS float* F = (LAS float*)(lds + wave * 18432); LAS float* qv = F + 2304 + 64;
    const int N = 256 + tau + 1;
#define DBG_POS(u) ((u) < 256 ? (dir ? 255 - (u) : (u)) : (dir ? 2047 - ((u) - 256) : (u) - 256))
#define DBG_GROW(u) ((u) < 256 ? (size_t)T + b * LC + DBG_POS(u) : (size_t)b * SEQ + DBG_POS(u))
    float carry = 0.f;
#pragma unroll 1
    for (int u0 = 0; u0 < N; u0 += 64) { const int u = u0 + lane; float lf = 0.f;
        if (u < N) { const float x = GT[DBG_GROW(u) * 16 + dir * 8 + 4 + h]; lf = x >= 0.f ? -__logf(1.f + __expf(-x)) : x - __logf(1.f + __expf(x)); }
        float s = lf;
#pragma unroll
        for (int o = 1; o < 64; o <<= 1) { const float v = shup(s, o); if (lane >= o) s += v; }
        if (u < N) F[u] = carry + s; carry += shidx(s, 63); }
    LDS_WAIT(); asm volatile("" ::: "memory");
    const float Ft = F[N - 1];
    float mm = Ft;
#pragma unroll 1
    for (int u = lane; u < N; u += 64) mm = fmaxf(mm, Ft - F[u] + GT[DBG_GROW(u) * 16 + dir * 8 + h]);
    mm = wave_max(mm);
    { const int pos = DBG_POS(N - 1);
      for (int d = lane; d < 128; d += 64) qv[d] = dbg_convsilu(BQ, pos, SEQ, h * 128 + d, d, cw, cb) * 0.08838834764831845f; }
    LDS_WAIT(); asm volatile("" ::: "memory");
    float den = 0.f;
#pragma unroll 1
    for (int u = lane; u < N; u += 64) { const bool ctx = u < 256; const int pos = DBG_POS(u); const bf16* kb = ctx ? BK : BK + (size_t)LC * 512; float qk = 0.f;
#pragma unroll 1
        for (int d = 0; d < 128; ++d) qk += qv[d] * dbg_convsilu(kb, pos, ctx ? LC : SEQ, 512 + h * 128 + d, d, cw, cb);
        const float om = qk * expf(Ft - F[u] + GT[DBG_GROW(u) * 16 + dir * 8 + h] - mm); F[u] = om; den += om; }
    den = wave_sum(den);
    LDS_WAIT(); asm volatile("" ::: "memory");
    float num[2] = {0.f, 0.f};
#pragma unroll 1
    for (int u = 0; u < N; ++u) { const bool ctx = u < 256; const int pos = DBG_POS(u); const bf16* vb = BV + (size_t)((ctx ? 0 : LC) + pos) * 512; num[0] += F[u] * bf1(vb[lane]); num[1] += F[u] * bf1(vb[64 + lane]); }
    const float dd = 1.f / fmaxf(fabsf(den), expf(-mm));
    const bf16* HB = (const bf16*)(big + A0_HB) + (size_t)dir * T * 512 + ((size_t)b * SEQ + DBG_POS(N - 1)) * 512 + h * 128;
    float err = 0.f, sc = 0.f;
#pragma unroll
    for (int j = 0; j < 2; ++j) { const float val = num[j] * dd; err = fmaxf(err, fabsf(val - bf1(HB[64 * j + lane]))); sc += val * val; }
    err = wave_max(err); sc = sqrtf(wave_sum(sc) * (1.f / 128.f));
    dbg_report_wave(p, err / (sc + 1e-3f), lane);
#undef DBG_POS
#undef DBG_GROW
}

__global__ void __launch_bounds__(NTHR, 2) mk_fwd(Params p0) {
    extern __shared__ __attribute__((aligned(16))) unsigned char lds_raw[];
    LAS unsigned char* lds = (LAS unsigned char*)lds_raw;
    const int wave0 = __builtin_amdgcn_readfirstlane((int)threadIdx.x >> 6);
    if (threadIdx.x < 64) ((LAS unsigned*)(lds + LDS_MISC))[threadIdx.x] = 0u;
    __syncthreads();
    XcdBarrier bar = xcd_barrier_post((unsigned*)(p0.ws + WS_CTL) + CW_BAR, (volatile LAS unsigned*)(lds + LDS_MISC + 32));
    const int G = gridDim.x, cb = blockIdx.x;
    const int vcu = (G % 8 == 0) ? (cb % 8) * (G / 8) + cb / 8 : cb;
#ifdef TIMEK
    int phc = 0; if (blockIdx.x == 0 && threadIdx.x == 0) ((unsigned long long*)(p0.ws + WS_CTL + 32768))[0] = __builtin_amdgcn_s_memrealtime();
#endif
#ifdef DBL_PH
#define DBL_LOOP for (int rep_ = 0; rep_ < 1; ++rep_)
#define DBL_SYNC __syncthreads();
#else
#define DBL_LOOP
#define DBL_SYNC
#endif
#ifdef TIMEK
#define TS_REC { ++phc; if (blockIdx.x == 0 && wave0 == 0 && lane_opq() == 0) ((unsigned long long*)(p0.ws + WS_CTL + 32768))[phc] = __builtin_amdgcn_s_memrealtime(); }
#else
#define TS_REC
#endif
#define LAYER_PTRS bf16* H2 = (bf16*)(big + (l == 0 ? 0 : 128 * MiB)); float* LOG = nullptr; bf16* ACT = (bf16*)(big + (l == 0 ? 144 * MiB : 272 * MiB)); \
        bf16* Y = (bf16*)(big + (l == 0 ? 304 * MiB : 432 * MiB)); bf16* HN = (bf16*)(big + 640 * MiB); const bf16* MIX = (const bf16*)(big + (l == 0 ? A0_MIX : 0)); \
        bf16* UT = (bf16*)big; bf16* UC = (bf16*)(big + 384 * MiB); bf16* ZT = (bf16*)(big + 384 * MiB); bf16* Y2T = (bf16*)(big + 512 * MiB); bf16* Y2 = (bf16*)(big + 640 * MiB); \
        (void)H2; (void)LOG; (void)ACT; (void)Y; (void)HN; (void)MIX; (void)UT; (void)UC; (void)ZT; (void)Y2T; (void)Y2;
#define RUN(...) do { { { int tid_ = wave0 * 64 + lane_opq(); asm volatile("" : "+v"(tid_)); const int tid = tid_, lane = tid & 63, wave = __builtin_amdgcn_readfirstlane(tid >> 6); (void)lane; (void)wave; \
        Params p = p0; { size_t z_ = 0; asm volatile("" : "+s"(z_)); p.ws = p0.ws + z_; p.out = p0.out + z_; _Pragma("unroll") for (int i_ = 0; i_ < 31; ++i_) p.in[i_] = p0.in[i_] + z_; } unsigned char* ws = p.ws; unsigned char* big = ws + WS_BIG; (void)big; LAYER_PTRS DBL_LOOP { __VA_ARGS__; DBL_SYNC } } { XcdBarrier b2_ = bar; { size_t z_ = 0; asm volatile("" : "+s"(z_)); b2_.bar = bar.bar + z_; unsigned x_ = bar.x; asm volatile("" : "+s"(x_)); b2_.x = x_; } xcd_barrier(b2_, wave0 == 0 && lane_opq() == 0); } TS_REC } } while (0)

    { const int l = 0; RUN({ pro_mod(p, lds, tid, lane, wave); __syncthreads(); pro_filters(p, lds, tid, lane, wave); pro_rope(p, tid); pro_transposes(p, lds, lane, wave); }); }

    for (int l = 0; l < 2; ++l) {
        if (l == 0) {
            RUN({ ph_l0_norm(p, lane, wave); });
            RUN({ Gemm g{(const bf16*)(big + A0_H), (const bf16*)(ws + WS_WIN0), 1024, 2048u}; InprojSched S{G, vcu};
                  EpiInproj E{big, (const float*)(ws + WS_ROPE), (float*)(ws + WS_GATES), p.in[I_GATEB]};
                  gemm_phase<EpiInproj, InprojSched>(lds, g, S, E, tid); });
#ifdef DBG_INPROJ
            RUN({ dbg_inproj_check(p, big, lane, wave); });
#endif
            RUN({ ph_transpose_b((const bf16*)(big + A0_VA), (bf16*)(big + A0_VT), NB, SEQ + LC, 512, lds, lane, wave); });
            RUN({ ph_attn(p, big, lds, tid, lane, wave, vcu); });
#ifdef DBG_ATTN
            RUN({ dbg_attn_check(p, big, lds, lane, wave); });
#endif
            RUN({ ph_mlstm(p, big, lds, tid, lane, wave); });
#ifdef DBG_MLSTM
            RUN({ dbg_mlstm_check(p, big, lds, lane, wave); });
#endif
            RUN({ ph_outb(p, big, lane, wave); });
            RUN({ Gemm g{(const bf16*)(big + A0_MIXIN), (const bf16*)(ws + WS_WOUT0), 1024, 2048u}; DenseSched S{4, 1024, G, vcu, 0}; EpiBf16 E{(bf16*)(big + A0_MIX), 1024, 3};
                  gemm_phase<EpiBf16, DenseSched>(lds, g, S, E, tid); });
        }
        if (l == 1) {
            RUN({ Gemm g{(const bf16*)(ws + WS_WIN1), HN, 1024, 2048u}; DenseSched S{256, 12 * 256, G, vcu, 12}; EpiBf16 E{UT, (size_t)T, 0xffff};
                  gemm_phase<EpiBf16, DenseSched>(lds, g, S, E, tid); });
#ifdef DBG_HY
            if (DBG_MODE == 0) { RUN({ dbg_hyena_check(p, 0, HN, UT, UT, UT, UT, lds, lane, wave); }); }
#endif
#ifdef DBG_HY
            if (DBG_MODE == 5) { RUN({ dbg_hyena_check(p, 5, HN, UC, UT, UT, UT, lds, lane, wave); }); }
#endif
            RUN({ ph_lconv<true>(p, 0, UT, UT, ZT, lds, tid, lane, wave); });
#ifdef DBG_HY
            if (DBG_MODE == 2) { RUN({ dbg_hyena_check(p, 2, HN, UC, ZT, Y2T, UT, lds, lane, wave); }); }
#endif
            RUN({ ph_lconv<false>(p, 1, ZT, UT, Y2T, lds, tid, lane, wave); });
#ifdef DBG_HY
            if (DBG_MODE == 3) { RUN({ dbg_hyena_check(p, 3, HN, UC, ZT, Y2T, UT, lds, lane, wave); }); }
#endif
            RUN({ ph_transpose(Y2T, Y2, lds, lane, wave); });
            RUN({ Gemm g{Y2, (const bf16*)(ws + WS_WOUT1), 1024, 2048u}; DenseSched S{4, 1024, G, vcu, 0}; EpiBf16 E{(bf16*)big, 1024, 3};
                  gemm_phase<EpiBf16, DenseSched>(lds, g, S, E, tid); });
        }
#ifdef DBG_HY
        if (l == 1 && (DBG_MODE == 1 || DBG_MODE == 4)) { RUN({ dbg_hyena_check(p, DBG_MODE, HN, (const bf16*)(big + 384 * MiB), (const bf16*)big, (const bf16*)(big + 128 * MiB), (const bf16*)big, lds, lane, wave); }); }
#endif
        RUN({ ph_mid(p, l, MIX, H2, true, lane, wave); });
        RUN({ Gemm g{H2, (const bf16*)(ws + WS_WR) + (size_t)l * 256 * 1024, 1024, 2048u}; DenseSched S{1, 256, G, vcu, 0}; EpiRouterLds E{};
              gemm_phase<EpiRouterLds, DenseSched>(lds, g, S, E, tid); __syncthreads(); ph_route_a(p, l, nullptr, vcu, lds, tid); });
#ifdef DBG_ROUTE
        RUN({ if (l == DBG_L) dbg_route_check(p, l, H2, LOG, lds, tid); ph_route_b(p, lds, tid); });
#else
        RUN({ ph_route_b(p, lds, tid); });
#endif
#define DO_G1(chx) do { const int NT = moe_tables(p, chx, lds, tid); \
            Gemm g{H2, (const bf16*)(ws + WS_GU) + (size_t)l * (65 * 512) * 1024, 1024, 2048u}; \
            MoeSched S{(const LAS int*)(lds + LDS_TAB), (const int*)(ws + WS_SORT) + (size_t)(chx) * CHROWS, NT * 2, G, vcu, 1, 2, nullptr}; EpiSwiglu E{ACT}; \
            gemm_phase<EpiSwiglu, MoeSched>(lds, g, S, E, tid); } while (0)
        RUN({ DO_G1(0); });
        for (int ch = 0; ch < NCH; ++ch) {
            RUN({ const int NT = moe_tables(p, ch, lds, tid);
                  Gemm g{ACT, (const bf16*)(ws + WS_DN) + (size_t)l * (65 * 1024) * 256, 256, 512u};
                  MoeSched S{(const LAS int*)(lds + LDS_TAB), nullptr, NT * 4, G, vcu, 2, 4, (l == 0 && ch == 0) ? (void*)(ws + WS_CTL + 32768) : nullptr}; EpiFp8 E{(unsigned char*)Y};
                  gemm_phase<EpiFp8, MoeSched>(lds, g, S, E, tid); });
            RUN({ const int par = (cb >> 3) & 1;
                  _Pragma("unroll 1") for (int part = 0; part < 2; ++part) { int t2_ = tid; asm volatile("" : "+v"(t2_)); const int tid = t2_, lane = tid & 63; (void)lane; if ((part ^ par) == 0) { if (ch + 1 < NCH) DO_G1(ch + 1); } else { ph_combine(p, l, ch, (const unsigned char*)Y, HN, lane, wave); } __syncthreads(); } });
        }
    }
#ifdef TIMEK
    if (blockIdx.x == 0) { const unsigned long long* ts = (const unsigned long long*)(p0.ws + WS_CTL + 32768); __syncthreads();
        const unsigned long long d = (__hip_atomic_load(ts + TIMEK, __ATOMIC_RELAXED, __HIP_MEMORY_SCOPE_AGENT) - __hip_atomic_load(ts + TIMEK0, __ATOMIC_RELAXED, __HIP_MEMORY_SCOPE_AGENT)) * 4ull, t0 = __builtin_amdgcn_s_memrealtime();
        while (__builtin_amdgcn_s_memrealtime() - t0 < d) __builtin_amdgcn_s_sleep(8); }
#endif
#ifdef DBG_ANY
    xcd_barrier(bar, threadIdx.x == 0);
    if (blockIdx.x == 0 && threadIdx.x == 0) p0.out[0] += 1.0e7f * __uint_as_float(((const unsigned*)(p0.ws + WS_CTL))[CW_DBG]);
#endif
#undef RUN
}
constexpr int NPHASES = 1 + 2 * (4 + 3 * NCH) + 6 + 64;
}

extern "C" void kernel_launch(void* const* d_in, const int* in_sizes, int n_in, void* d_out, int out_size, void* d_ws, size_t ws_size, hipStream_t stream) {
    using namespace mk;
    static int grid = 0;
    if (grid == 0) {
        if (n_in != 31 || out_size != T * D || ws_size < WS_END) { fprintf(stderr, "kernel_launch: unexpected shapes (n_in %d, out %d, ws %zu)\n", n_in, out_size, ws_size); grid = -1; return; }
        int dev = 0, cus = 0;
        if (hipGetDevice(&dev) != hipSuccess || hipDeviceGetAttribute(&cus, hipDeviceAttributeMultiprocessorCount, dev) != hipSuccess) { grid = -1; return; }
        if (hipFuncSetAttribute((const void*)mk_fwd, hipFuncAttributeMaxDynamicSharedMemorySize, LDS_BYTES) != hipSuccess) { fprintf(stderr, "kernel_launch: hipFuncSetAttribute failed\n"); grid = -1; return; }
        int per_cu = 0;
        if (hipOccupancyMaxActiveBlocksPerMultiprocessor(&per_cu, (const void*)mk_fwd, NTHR, LDS_BYTES) != hipSuccess || per_cu < 1) { fprintf(stderr, "kernel_launch: occupancy query says %d\n", per_cu); }
        (void)hipGetLastError();
        grid = cus;
        if (grid != 256) { fprintf(stderr, "kernel_launch: built for 256 CUs, found %d\n", grid); grid = -1; return; }
    }
    if (grid < 0) return;
    (void)hipMemsetAsync((char*)d_ws + WS_CTL, 0, CTL_ZERO_BYTES, stream);
    Params a{};
    for (int i = 0; i < 31; ++i) a.in[i] = (const float*)d_in[i];
    a.out = (float*)d_out; a.ws = (unsigned char*)d_ws; a.ph_lo = 0; a.ph_hi = NPHASES;
    hipLaunchKernelGGL(mk_fwd, dim3(grid), dim3(NTHR), LDS_BYTES, stream, a);
}
```

```cpp
#include <hip/hip_runtime.h>
#include <cstdio>
#include <cstdint>
namespace pg8 {
#define PG8_LAS __attribute__((address_space(3)))
typedef unsigned short bf16_t;
typedef short bf16x8 __attribute__((ext_vector_type(8)));
typedef float f32x4 __attribute__((ext_vector_type(4)));
typedef unsigned u32x4 __attribute__((ext_vector_type(4)));
typedef unsigned u32x2 __attribute__((ext_vector_type(2)));
constexpr int BM = 256, BK = 64, HALF = 128, HTB = HALF * BK * 2  , STAGE_BYTES = 8 * HTB;

__host__ __device__ __forceinline__ int lds_byte(int r, int c) { const int st = (r >> 4) * 2 + (c >> 5), rr = r & 15, cc = c & 31, ob = rr * 64 + cc * 2; return st * 1024 + (ob ^ (((ob >> 9) & 1) << 5)); }
__host__ __device__ __forceinline__ void stage_rc(int b, int& R, int& C) { const int st = b / 1024, sb = b % 1024, swz = sb ^ (((sb >> 9) & 1) << 5); R = (st >> 1) * 16 + swz / 64; C = (st & 1) * 32 + (swz % 64) / 2; }
__host__ __device__ __forceinline__ int perm32(int rho) { const int n = rho >> 4, i = rho & 15; return 8 * (i >> 2) + 4 * n + (i & 3); }

struct Unit { int pm, pn; };
__device__ __forceinline__ unsigned cvt_pk_bf16(float lo, float hi) { unsigned r; asm volatile("v_cvt_pk_bf16_f32 %0, %1, %2" : "=v"(r) : "v"(lo), "v"(hi)); return r; }
struct Gemm { const bf16_t* A; const bf16_t* Bt; int K; unsigned lda_bytes; };
template <class Epi, class Sched, bool ALIGN_EPI = true>
__device__ __forceinline__ void gemm_phase(PG8_LAS unsigned char* lds, const Gemm g, const Sched& S, const Epi& E, const int tid_in) {
    int tid_ = tid_in; asm volatile("" : "+v"(tid_));
    const int tid = tid_, wid = __builtin_amdgcn_readfirstlane(tid >> 6), lane = tid & 63, wr = wid >> 2, wc = wid & 3, fr = lane & 15, fq = lane >> 4;
    const int K = g.K, nt = K / BK;
    unsigned voffB[2];
#pragma unroll
    for (int i = 0; i < 2; ++i) { int R, C; stage_rc(tid * 16 + i * 8192, R, C); const int Rb = Epi::PERM ? ((R & ~31) + perm32(R & 31)) : R;
        voffB[i] = (unsigned)(Rb * K + C) * 2u; }
    const size_t kstep = (size_t)(BK * 2);
    const size_t hstep = (size_t)HALF * K * 2;
    const size_t tstep = 2 * hstep;
    const unsigned ldsw = (unsigned)wid * 1024u;
    const int aoff = lds_byte(wr * 64 + fr, fq * 8), boff = lds_byte(wc * 32 + fr, fq * 8);
    const char* Ab = (const char*)g.A;
#define PG8_SA(b, h) (((b) * 2 + (h)) * HTB)
#define PG8_SB(b, h) ((4 + (b) * 2 + (h)) * HTB)
#define PG8_STAGE(bufoff, gbase, voff) do { _Pragma("unroll") for (int _i = 0; _i < 2; ++_i) \
        __builtin_amdgcn_global_load_lds((const unsigned*)((const char*)(gbase) + (voff)[_i]), (PG8_LAS unsigned*)(lds + (bufoff) + ldsw + _i * 8192), 16, 0, 0); } while (0)
#define PG8_STAGEA(bufoff, o0, o1, kb) do { \
        __builtin_amdgcn_global_load_lds((const unsigned*)(Ab + (size_t)(o0) + (size_t)(kb)), (PG8_LAS unsigned*)(lds + (bufoff) + ldsw), 16, 0, 0); \
        __builtin_amdgcn_global_load_lds((const unsigned*)(Ab + (size_t)(o1) + (size_t)(kb)), (PG8_LAS unsigned*)(lds + (bufoff) + ldsw + 8192), 16, 0, 0); } while (0)
#define PG8_LDA(dst, b, h) do { _Pragma("unroll") for (int m = 0; m < 4; ++m) _Pragma("unroll") for (int k = 0; k < 2; ++k) dst[m][k] = *(const PG8_LAS bf16x8*)(lds + PG8_SA(b, h) + aoff + m * 2048 + k * 1024); } while (0)
#define PG8_LDB(dst, b, h) do { _Pragma("unroll") for (int n = 0; n < 2; ++n) _Pragma("unroll") for (int k = 0; k < 2; ++k) dst[n][k] = *(const PG8_LAS bf16x8*)(lds + PG8_SB(b, h) + boff + n * 2048 + k * 1024); } while (0)
#define PG8_MMA(ai, bj, At, Bt) do { __builtin_amdgcn_s_setprio(1); _Pragma("unroll") for (int m = 0; m < 4; ++m) _Pragma("unroll") for (int n = 0; n < 2; ++n) _Pragma("unroll") for (int k = 0; k < 2; ++k) \
        acc[ai][bj][m][n] = __builtin_amdgcn_mfma_f32_16x16x32_bf16(Bt[n][k], At[m][k], acc[ai][bj][m][n], 0, 0, 0); __builtin_amdgcn_s_setprio(0); } while (0)
#define PG8_WAIT_V(n) asm volatile("s_waitcnt vmcnt(" #n ")" ::: "memory")
#define PG8_WAIT_L(n) asm volatile("s_waitcnt lgkmcnt(" #n ")" ::: "memory")
#define PG8_BAR __builtin_amdgcn_s_barrier()
#define PG8_SCHED __builtin_amdgcn_sched_barrier(0)
#define PG8_OFFS(dst, u) do { _Pragma("unroll") for (int _i = 0; _i < 2; ++_i) { int _R, _C; stage_rc(tid * 16 + _i * 8192, _R, _C); _Pragma("unroll") for (int _h = 0; _h < 2; ++_h) \
        dst[_h][_i] = (unsigned)S.arow((u).pm * BM + _h * HALF + _R) * g.lda_bytes + (unsigned)(_C * 2); } } while (0)
    Unit cur, nxt; int ui = 0;
    if (!S.next(0, cur)) return;
    f32x4 acc[2][2][4][2];
#pragma unroll
    for (int a = 0; a < 2; ++a)
#pragma unroll
        for (int b = 0; b < 2; ++b)
#pragma unroll
            for (int m = 0; m < 4; ++m)
#pragma unroll
                for (int n = 0; n < 2; ++n) acc[a][b][m][n] = (f32x4){0.f, 0.f, 0.f, 0.f};
    bf16x8 At[4][2], B0[2][2], B1[2][2];
    unsigned oC[2][2], oN[2][2];
    PG8_OFFS(oC, cur);
    const char* cB = (const char*)g.Bt + (size_t)cur.pn * tstep;
    PG8_STAGE(PG8_SB(0, 0), cB, voffB); PG8_STAGE(PG8_SB(0, 1), cB + hstep, voffB); PG8_STAGEA(PG8_SA(0, 0), oC[0][0], oC[0][1], 0); PG8_STAGEA(PG8_SA(0, 1), oC[1][0], oC[1][1], 0);
    if (wr == 1) PG8_BAR;
    PG8_WAIT_V(2); PG8_BAR;
    PG8_STAGE(PG8_SB(1, 0), cB + kstep, voffB); PG8_STAGEA(PG8_SA(1, 0), oC[0][0], oC[0][1], kstep); PG8_STAGE(PG8_SB(1, 1), cB + hstep + kstep, voffB);
    PG8_WAIT_V(6); PG8_BAR;
#ifdef GM_PROBE
    unsigned long long gaccs[3] = {0, 0, 0}; unsigned long long gtp = __builtin_amdgcn_s_memrealtime();
#define GM_T(i) do { if (Epi::PROBE) { const unsigned long long t1_ = __builtin_amdgcn_s_memrealtime(); gaccs[i] += t1_ - gtp; gtp = t1_; } } while (0)
#else
#define GM_T(i)
#endif
    for (;;) {
        const bool has_next = S.next(ui + 1, nxt);
        if (has_next) { PG8_OFFS(oN, nxt); } else {
#pragma unroll
            for (int _h = 0; _h < 2; ++_h)
#pragma unroll
                for (int _i = 0; _i < 2; ++_i) oN[_h][_i] = oC[_h][_i]; }
        const char* nB = has_next ? (const char*)g.Bt + (size_t)nxt.pn * tstep : cB;
#pragma unroll 1
        for (int t = 0; t < nt; t += 2) {
            const bool last = (t == nt - 2);
            const size_t k1 = (size_t)(t + 1) * kstep;
            const size_t k2 = last ? 0 : (size_t)(t + 2) * kstep, k3 = k2 + kstep;
            const char* b2 = last ? nB : cB + (size_t)(t + 2) * kstep; const char* b3 = b2 + kstep;
            PG8_LDB(B0, 0, 0); PG8_LDB(B1, 0, 1); PG8_SCHED; PG8_LDA(At, 0, 0); PG8_STAGEA(PG8_SA(1, 1), oC[1][0], oC[1][1], k1);
            if (last) { oC[0][0] = oN[0][0]; oC[0][1] = oN[0][1]; oC[1][0] = oN[1][0]; oC[1][1] = oN[1][1]; }
            PG8_WAIT_V(8); PG8_WAIT_L(0); PG8_BAR; PG8_MMA(0, 0, At, B0); PG8_MMA(0, 1, At, B1); PG8_BAR; PG8_SCHED;
            PG8_LDA(At, 0, 1); PG8_STAGE(PG8_SB(0, 0), b2, voffB); PG8_STAGE(PG8_SB(0, 1), b2 + hstep, voffB); PG8_STAGEA(PG8_SA(0, 0), oC[0][0], oC[0][1], k2);
            PG8_WAIT_V(8); PG8_WAIT_L(0); PG8_BAR; PG8_MMA(1, 0, At, B0); PG8_MMA(1, 1, At, B1); PG8_BAR; PG8_SCHED;
            PG8_LDB(B0, 1, 0); PG8_LDB(B1, 1, 1); PG8_SCHED; PG8_LDA(At, 1, 0); PG8_STAGEA(PG8_SA(0, 1), oC[1][0], oC[1][1], k2);
            PG8_WAIT_V(8); PG8_WAIT_L(0); PG8_BAR; PG8_MMA(0, 0, At, B0); PG8_MMA(0, 1, At, B1); PG8_BAR; PG8_SCHED;
            PG8_LDA(At, 1, 1); PG8_STAGE(PG8_SB(1, 0), b3, voffB); PG8_STAGE(PG8_SB(1, 1), b3 + hstep, voffB); PG8_STAGEA(PG8_SA(1, 0), oC[0][0], oC[0][1], k3);
            PG8_WAIT_V(8); PG8_WAIT_L(0); PG8_BAR; PG8_MMA(1, 0, At, B0); PG8_MMA(1, 1, At, B1); PG8_BAR; PG8_SCHED;
        }
        GM_T(0);
        if constexpr (ALIGN_EPI) { if (wr == 0) PG8_BAR; }
        GM_T(1);
        E(acc, cur, wr, wc, fr, fq);
        GM_T(2);
        if (!has_next) break;
#pragma unroll
        for (int a = 0; a < 2; ++a)
#pragma unroll
            for (int b = 0; b < 2; ++b)
#pragma unroll
                for (int m = 0; m < 4; ++m)
#pragma unroll
                    for (int n = 0; n < 2; ++n) acc[a][b][m][n] = (f32x4){0.f, 0.f, 0.f, 0.f};
        cur = nxt; cB = nB; ++ui;
#pragma unroll
        for (int _h = 0; _h < 2; ++_h)
#pragma unroll
            for (int _i = 0; _i < 2; ++_i) oC[_h][_i] = oN[_h][_i];
        if constexpr (ALIGN_EPI) { if (wr == 1) PG8_BAR; }
    }
#ifdef GM_PROBE
    if (Epi::PROBE && blockIdx.x == 0 && tid == 0) { unsigned long long* ts = (unsigned long long*)(S.probe_ts()); if (ts) { ts[50] = 0; ts[51] = gaccs[0]; ts[52] = gaccs[0] + gaccs[1]; ts[53] = gaccs[0] + gaccs[1] + gaccs[2]; } }
#endif
    PG8_WAIT_V(0);
    if constexpr (!ALIGN_EPI) { if (wr == 0) PG8_BAR; }
    PG8_BAR;
    if constexpr (Epi::AFTER_DRAIN) E.fused(acc, cur, wr, wc, fr, fq, lds);
#undef PG8_SA
#undef PG8_SB
#undef PG8_STAGE
#undef PG8_STAGEA
#undef PG8_LDA
#undef PG8_LDB
#undef PG8_MMA
#undef PG8_WAIT_V
#undef PG8_WAIT_L
#undef PG8_BAR
#undef PG8_SCHED
#undef PG8_OFFS
#undef GM_T
}

template <class Epi, class Sched>
__device__ __noinline__ void gemm_phase_ni(PG8_LAS unsigned char* lds, Gemm g, Sched S, Epi E) { gemm_phase<Epi, Sched>(lds, g, S, E, (int)threadIdx.x); }
}

namespace mk {
using namespace pg8;
constexpr int D = 1024, NB = 32, SEQ = 2048, T = NB * SEQ, LC = 256, TC = NB * LC, TT = T + TC;
constexpr int NMOD = 6 * D;
constexpr int NE = 64, NEX = 65, DE = 256;
constexpr int NCH = 2, CHT = T / NCH, BPC = 256 / NCH;
constexpr int MAXTILES = (CHT * 8 + 64 * 255) / 256 + CHT / 256 + 1, CHROWS = MAXTILES * 256;
constexpr float RMS_EPS = 1e-6f;
constexpr int NWAVES = 8, NTHR = 512;

constexpr size_t MiB = 1u << 20;
constexpr size_t WS_CTL = 0, CTL_ZERO_BYTES = 64 * 1024;
constexpr size_t WS_MOD = 1 * MiB;
constexpr size_t WS_ROPE = 3 * MiB;
constexpr size_t WS_BC = 3 * MiB + 65536;
constexpr size_t WS_TEG = 3 * MiB + 2 * 65536;
constexpr size_t WS_GATES = 4 * MiB;
constexpr size_t WS_FILT = 10 * MiB;
constexpr size_t WS_EIDX = 18 * MiB, WS_WTS = 20 * MiB, WS_PSLOT = 22 * MiB, WS_SORT = 26 * MiB;
constexpr size_t WS_WIN0 = 30 * MiB;
constexpr size_t WS_WOUT0 = 38 * MiB, WS_WIN1 = 40 * MiB, WS_WOUT1 = 46 * MiB, WS_WR = 48 * MiB;
constexpr size_t WS_GU = 50 * MiB;
constexpr size_t WS_DN = 180 * MiB;
constexpr size_t WS_BIG = 246 * MiB;
constexpr size_t WS_END = 1024 * MiB;
static_assert(WS_PSLOT + (size_t)T * 16 * 4 <= WS_SORT && WS_SORT + (size_t)NCH * CHROWS * 4 <= WS_WIN0 && WS_WIN0 + (size_t)3840 * 2048 <= WS_WOUT0 && WS_WR + (size_t)2 * 256 * 2048 <= WS_GU && WS_GU + (size_t)2 * 65 * 512 * 2048 <= WS_DN && WS_DN + (size_t)2 * 65 * 1024 * 512 <= WS_BIG, "ws map");
constexpr size_t A0_H = 0, A0_QA = 144 * MiB, A0_KA = 208 * MiB, A0_VA = 280 * MiB, A0_BQ = 352 * MiB, A0_BK = 416 * MiB, A0_BV = 488 * MiB, A0_BO = 560 * MiB, A0_VT = 624 * MiB;
constexpr size_t A0_MIXIN = 0, A0_HB = 144 * MiB, A0_MIX = 352 * MiB;
constexpr int CW_BAR = 4096;

constexpr int LDS_BYTES = 160 * 1024;
constexpr int LDS_TAB = 131072;
constexpr int LDS_MISC = 131072 + 24 * 1024;

#define GAS __attribute__((address_space(1)))
#define LAS __attribute__((address_space(3)))
typedef unsigned short bf16;
typedef unsigned v4u __attribute__((ext_vector_type(4)));
typedef unsigned v2u __attribute__((ext_vector_type(2)));
#define LDS_WAIT() asm volatile("s_waitcnt lgkmcnt(0)" ::: "memory")
#define VM_WAIT() asm volatile("s_waitcnt vmcnt(0)" ::: "memory")
__device__ __forceinline__ unsigned f2bf(float f) { unsigned u = __builtin_bit_cast(unsigned, f); return (u + 0x7fffu + ((u >> 16) & 1u)) >> 16; }
__device__ __forceinline__ unsigned pk2(float lo, float hi) { return f2bf(lo) | (f2bf(hi) << 16); }
__device__ __forceinline__ float bf_lo(unsigned w) { return __builtin_bit_cast(float, w << 16); }
__device__ __forceinline__ float bf_hi(unsigned w) { return __builtin_bit_cast(float, w & 0xffff0000u); }
__device__ __forceinline__ float bf1(bf16 h) { return __builtin_bit_cast(float, (unsigned)h << 16); }
__device__ __forceinline__ int lane_opq() { int l = (int)__builtin_amdgcn_mbcnt_hi(~0u, __builtin_amdgcn_mbcnt_lo(~0u, 0u)); asm volatile("" : "+v"(l)); return l; }
__device__ __forceinline__ float shx(float v, int m) { return __builtin_bit_cast(float, __builtin_amdgcn_ds_bpermute((lane_opq() ^ m) << 2, __builtin_bit_cast(int, v))); }
__device__ __forceinline__ float shup(float v, int o) { const int l = lane_opq(); return __builtin_bit_cast(float, __builtin_amdgcn_ds_bpermute((l >= o ? l - o : l) << 2, __builtin_bit_cast(int, v))); }
__device__ __forceinline__ float shidx(float v, int idx) { return __builtin_bit_cast(float, __builtin_amdgcn_ds_bpermute(idx << 2, __builtin_bit_cast(int, v))); }
__device__ __forceinline__ float wave_sum(float v) {
#pragma unroll
    for (int o = 1; o < 64; o <<= 1) v += shx(v, o);
    return v;
}
__device__ __forceinline__ float wave_max(float v) {
#pragma unroll
    for (int o = 1; o < 64; o <<= 1) v = fmaxf(v, shx(v, o));
    return v;
}
__device__ __forceinline__ float sigmoidf_(float x) { return 1.f / (1.f + __expf(-x)); }
__device__ __forceinline__ float siluf_(float x) { return x / (1.f + __expf(-x)); }
#define XB_TMO      128
#define XB_XCNT(j)  (256  + 64 * (j))
#define XB_XSUB(j)  (1280 + 64 * (j))
#define XB_XGEN(j)  (2304 + 64 * (j))
#define XB_TOP      3328
#define XB_TOPGEN   3392
#define XCD_BAR_WORDS 3456
#define XB_SPIN_CAP (1u << 18)

__device__ __forceinline__ unsigned xb_ld(unsigned* p)              { return __hip_atomic_load(p, __ATOMIC_RELAXED, __HIP_MEMORY_SCOPE_AGENT); }
__device__ __forceinline__ unsigned xb_add(unsigned* p, unsigned v) { return __hip_atomic_fetch_add(p, v, __ATOMIC_RELAXED, __HIP_MEMORY_SCOPE_AGENT); }
__device__ __forceinline__ unsigned xb_xcc_id() { return (unsigned)__builtin_amdgcn_s_getreg((3 << 11) | 20) & 0xFu; }
#define XB_SPIN(cond, bar) do { unsigned _sp = 0; while (cond) { __builtin_amdgcn_s_sleep(1); \
    if ((++_sp & 255u) == 0u) { if (xb_ld(&(bar)[XB_TMO])) break; if (_sp > XB_SPIN_CAP) { atomicAdd(&(bar)[XB_TMO], 1u); break; } } } } while (0)

struct XcdBarrier {
    unsigned* bar; unsigned x;
    volatile LAS unsigned* st;
};

__device__ __forceinline__ XcdBarrier xcd_barrier_post(unsigned* bar, volatile LAS unsigned* st) {
    XcdBarrier b; b.bar = bar; b.x = xb_xcc_id(); b.st = st;
    if (threadIdx.x == 0) (void)xb_add(&bar[XB_XCNT(b.x)], 1u);
    return b;
}
__device__ __forceinline__ void xcd_barrier_complete(unsigned* bar, unsigned x, unsigned& nloc, unsigned& nx) {
    const unsigned G = gridDim.x * gridDim.y * gridDim.z;
    unsigned sum, cnt, mine, sp = 0u;
    for (;;) {
        sum = 0u; cnt = 0u; mine = 0u;
#pragma unroll
        for (unsigned j = 0; j < 16; ++j) { const unsigned c = xb_ld(&bar[XB_XCNT(j)]); sum += c; cnt += (c > 0u) ? 1u : 0u; mine = (j == x) ? c : mine; }
        if (sum == G) break;
        __builtin_amdgcn_s_sleep(1);
        if ((++sp & 255u) == 0u) { if (xb_ld(&bar[XB_TMO])) break; if (sp > XB_SPIN_CAP) { atomicAdd(&bar[XB_TMO], 1u); break; } }
    }
    nloc = mine > 0u ? mine : 1u; nx = cnt > 0u ? cnt : 1u;
}

__device__ __forceinline__ void xcd_barrier(const XcdBarrier& b, const bool t0  ) {
    asm volatile("s_waitcnt vmcnt(0)" ::: "memory");
    __syncthreads();
    if (t0) {
        unsigned* bar = b.bar;
        __builtin_amdgcn_s_waitcnt(0);
        unsigned nloc = b.st[0], nx = b.st[1];
        if (nloc == 0u) { xcd_barrier_complete(bar, b.x, nloc, nx); b.st[0] = nloc; b.st[1] = nx; }
        const unsigned old = xb_add(&bar[XB_XSUB(b.x)], 1u);
        const unsigned gen = old / nloc;
        if (old + 1u == (gen + 1u) * nloc) {
            __builtin_amdgcn_fence(__ATOMIC_RELEASE, "agent");
            asm volatile("s_waitcnt vmcnt(0)" ::: "memory");
            const unsigned og = xb_add(&bar[XB_TOP], 1u);
            const unsigned tg = og / nx;
            if (og + 1u == (tg + 1u) * nx) xb_add(&bar[XB_TOPGEN], 1u);
            else XB_SPIN(xb_ld(&bar[XB_TOPGEN]) == tg, bar);
            __builtin_amdgcn_fence(__ATOMIC_ACQUIRE, "agent");
            xb_add(&bar[XB_XGEN(b.x)], 1u);
            asm volatile("s_waitcnt vmcnt(0)" ::: "memory");
        } else {
            XB_SPIN(xb_ld(&bar[XB_XGEN(b.x)]) == gen, bar);
            __builtin_amdgcn_fence(__ATOMIC_ACQUIRE, "agent");
            asm volatile("s_waitcnt vmcnt(0)" ::: "memory");
        }
    }
    __syncthreads();
}

constexpr float Y8_SCALE = 16.f, Y8_INV = 1.f / 16.f;
struct Params { const float* in[31]; float* out; unsigned char* ws; int ph_lo, ph_hi; };
enum { I_X = 0, I_C, I_CTX, I_CCTX, I_WMOD, I_BMOD, I_NORMG, I_WINAB, I_CONVABW, I_CONVABB, I_GATEB, I_DLAM, I_HGA, I_HGB, I_WOUTAB, I_WINHY, I_CONVHYW, I_CONVHYB,
       I_FW1, I_FB1, I_FW2, I_FB2, I_FW3, I_FBIAS, I_WOUTHY, I_RW, I_RB, I_EGU, I_EDN, I_SGU, I_SDN };

__device__ __forceinline__ void row_ld_f32(const float* row, int lane, f32x4 (&v)[4]) { const f32x4* r = (const f32x4*)row + lane;
#pragma unroll
    for (int j = 0; j < 4; ++j) v[j] = r[64 * j]; }
__device__ __forceinline__ void row_st_f32(float* row, int lane, const f32x4 (&v)[4]) { f32x4* r = (f32x4*)row + lane;
#pragma unroll
    for (int j = 0; j < 4; ++j) r[64 * j] = v[j]; }
__device__ __forceinline__ void row_ld_bf16(const bf16* row, int lane, f32x4 (&v)[4]) { const v2u* r = (const v2u*)row + lane;
#pragma unroll
    for (int j = 0; j < 4; ++j) { const v2u w = r[64 * j]; v[j] = (f32x4){bf_lo(w.x), bf_hi(w.x), bf_lo(w.y), bf_hi(w.y)}; } }
__device__ __forceinline__ void row_st_bf16(bf16* row, int lane, const f32x4 (&v)[4]) { v2u* r = (v2u*)row + lane;
#pragma unroll
    for (int j = 0; j < 4; ++j) { v2u w; w.x = pk2(v[j].x, v[j].y); w.y = pk2(v[j].z, v[j].w); r[64 * j] = w; } }
__device__ __forceinline__ float row_ss(const f32x4 (&v)[4]) { float s = 0.f;
#pragma unroll
    for (int j = 0; j < 4; ++j) s += (v[j].x * v[j].x + v[j].y * v[j].y) + (v[j].z * v[j].z + v[j].w * v[j].w);
    return wave_sum(s); }
__device__ __forceinline__ void row_modulate(const f32x4 (&x)[4], float rstd, const float* g, const float* shift, const float* scale, int lane, f32x4 (&h)[4]) {
    const f32x4* gp = (const f32x4*)g + lane; const f32x4* sh = (const f32x4*)shift + lane; const f32x4* sc = (const f32x4*)scale + lane;
#pragma unroll
    for (int j = 0; j < 4; ++j) { const f32x4 gg = gp[64 * j], s1 = sc[64 * j], s0 = sh[64 * j]; h[j] = x[j] * rstd * gg * (1.f + s1) + s0; } }

__device__ __forceinline__ void pro_mod(const Params& p, LAS unsigned char* lds, int tid, int lane, int wave) {
    const int u = blockIdx.x; if (u >= 192) return;
    LAS float* S = (LAS float*)lds;
    const float* c = p.in[I_C]; const float* cc = p.in[I_CCTX];
#pragma unroll 4
    for (int i = tid; i < 33 * 256; i += NTHR) { const int b = i >> 8, k4 = (i & 255) * 4; const f32x4 v = b < 32 ? *(const f32x4*)(c + b * 1024 + k4) : *(const f32x4*)(cc + k4);
        *(LAS f32x4*)(S + b * 1024 + k4) = (f32x4){siluf_(v[0]), siluf_(v[1]), siluf_(v[2]), siluf_(v[3])}; }
    __syncthreads();
    const int l = u / 96, cg = (u % 96) * 64, col = cg + lane;
    const float* W = p.in[I_WMOD] + (size_t)l * 1024 * NMOD;
    float acc[33];
#pragma unroll
    for (int b = 0; b < 33; ++b) acc[b] = 0.f;
    const int k0 = wave * 128;
#pragma unroll 4
    for (int kk = 0; kk < 128; kk += 4) { const int k = k0 + kk;
        const float w0 = W[(size_t)k * NMOD + col], w1 = W[(size_t)(k + 1) * NMOD + col], w2 = W[(size_t)(k + 2) * NMOD + col], w3 = W[(size_t)(k + 3) * NMOD + col];
#pragma unroll
        for (int b = 0; b < 33; ++b) { const f32x4 s = *(const LAS f32x4*)(S + b * 1024 + k); acc[b] += (s.x * w0 + s.y * w1) + (s.z * w2 + s.w * w3); } }
    __syncthreads();
    LAS float* P = (LAS float*)lds;
#pragma unroll
    for (int b = 0; b < 33; ++b) P[(wave * 33 + b) * 64 + lane] = acc[b];
    __syncthreads();
    float* MOD = (float*)(p.ws + WS_MOD);
#pragma unroll 1
    for (int i = tid; i < 33 * 64; i += NTHR) { const int b = i >> 6, ln = i & 63; float s = 0.f;
#pragma unroll
        for (int w = 0; w < 8; ++w) s += P[(w * 33 + b) * 64 + ln];
        MOD[(size_t)(l * 33 + b) * NMOD + cg + ln] = s + p.in[I_BMOD][l * NMOD + cg + ln]; }
    __syncthreads();
}
__device__ __forceinline__ int rowmap(int kind, int n) {
    if (kind == 1) { const int o = n & 31; return (n & ~31) + (((o & 15) >> 2) * 8 + (o >> 4) * 4 + (o & 3)); }
    if (kind == 2) { return n < 256 ? ((n >> 7) * 256 + (n & 127)) : ((((n - 256) >> 7) * 256) + 128 + ((n - 256) & 127)); }
    if (kind == 3) { const int a = n & 255; return (n & ~255) + 128 * ((a >> 3) & 1) + 32 * (a >> 6) + 8 * ((a >> 4) & 3) + (a & 7); }
    return n;
}
struct TrDesc { const float* W; bf16* WT; int ldn, k0, n0, nvalid, dK, kind, row_base; };
__device__ __forceinline__ TrDesc tr_decode(const Params& p, int it) {
    constexpr int I_A = 16 * 113, I_B = 512, I_C2 = 1536, I_D = 512, I_E = 64, I_F = 130 * 256;
    unsigned char* ws = p.ws; int r = it;
    if (r < I_A) { const int kb = r / 113, nb = r % 113, n0 = nb * 32; const int kind = (n0 < 512 || (n0 >= 1536 && n0 < 2048)) ? 1 : 0;
        return TrDesc{p.in[I_WINAB], (bf16*)(ws + WS_WIN0), 3600, kb * 64, n0, 3600, 1024, kind, 0}; } r -= I_A;
    if (r < I_B) return TrDesc{p.in[I_WOUTAB], (bf16*)(ws + WS_WOUT0), 1024, (r / 32) * 64, (r % 32) * 32, 1024, 1024, 0, 0}; r -= I_B;
    if (r < I_C2) return TrDesc{p.in[I_WINHY], (bf16*)(ws + WS_WIN1), 3072, (r / 96) * 64, (r % 96) * 32, 3072, 1024, 0, 0}; r -= I_C2;
    if (r < I_D) return TrDesc{p.in[I_WOUTHY], (bf16*)(ws + WS_WOUT1), 1024, (r / 32) * 64, (r % 32) * 32, 1024, 1024, 0, 0}; r -= I_D;
    if (r < I_E) { const int l = r / 32, q = r % 32; return TrDesc{p.in[I_RW] + (size_t)l * 1024 * 64, (bf16*)(ws + WS_WR) + (size_t)l * 256 * 1024, 64, (q / 2) * 64, (q % 2) * 32, 64, 1024, 0, 0}; } r -= I_E;
    if (r < I_F) { const int mat = r / 256, q = r % 256, l = mat / 65, e = mat % 65;
        const float* src = e < 64 ? p.in[I_EGU] + (size_t)(l * 64 + e) * 1024 * 512 : p.in[I_SGU] + (size_t)l * 1024 * 512;
        return TrDesc{src, (bf16*)(ws + WS_GU) + (size_t)l * (65 * 512) * 1024, 512, (q / 16) * 64, (q % 16) * 32, 512, 1024, 2, e * 512}; } r -= I_F;
    { const int mat = r / 128, q = r % 128, l = mat / 65, e = mat % 65;
        const float* src = e < 64 ? p.in[I_EDN] + (size_t)(l * 64 + e) * 256 * 1024 : p.in[I_SDN] + (size_t)l * 256 * 1024;
        return TrDesc{src, (bf16*)(ws + WS_DN) + (size_t)l * (65 * 1024) * 256, 1024, (q / 32) * 64, (q % 32) * 32, 1024, 256, 3, e * 1024}; }
}
__device__ __forceinline__ void tr_load(const TrDesc& d, int lane, float (&v)[32]) {
    const int nn = d.n0 + (lane & 31); const bool ok = nn < d.nvalid; const float* src = d.W + (size_t)(d.k0 + (lane >> 5)) * d.ldn + (ok ? nn : 0);
#pragma unroll
    for (int i = 0; i < 32; ++i) v[i] = src[(size_t)(2 * i) * d.ldn];
    if (!ok) {
#pragma unroll
        for (int i = 0; i < 32; ++i) v[i] = 0.f; }
}
__device__ __forceinline__ void tr_finish(const TrDesc& d, const float (&v)[32], LAS float* scr, int lane) {
#pragma unroll
    for (int i = 0; i < 32; ++i) scr[(2 * i + (lane >> 5)) * 33 + (lane & 31)] = v[i];
    LDS_WAIT(); asm volatile("" ::: "memory");
    const int c = lane & 7;
#pragma unroll
    for (int j = 0; j < 4; ++j) { const int n = (lane >> 3) + 8 * j; const LAS float* s = scr + (8 * c) * 33 + n;
        v4u o; o.x = pk2(s[0 * 33], s[1 * 33]); o.y = pk2(s[2 * 33], s[3 * 33]); o.z = pk2(s[4 * 33], s[5 * 33]); o.w = pk2(s[6 * 33], s[7 * 33]);
        const int row = d.row_base + rowmap(d.kind, d.n0 + n);
        *(v4u*)(d.WT + (size_t)row * d.dK + d.k0 + 8 * c) = o; }
    LDS_WAIT(); asm volatile("" ::: "memory");
}
__device__ __forceinline__ void pro_transposes(const Params& p, LAS unsigned char* lds, int lane, int wave) {
    LAS float* scr = (LAS float*)(lds + wave * 16384);
    const int gw = blockIdx.x * NWAVES + wave, NGW = gridDim.x * NWAVES;
    constexpr int NITEMS = 16 * 113 + 512 + 1536 + 512 + 64 + 130 * 256 + 130 * 128;
    if (gw >= NITEMS) return;
    TrDesc dc = tr_decode(p, gw); float vc[32]; tr_load(dc, lane, vc);
#pragma unroll 1
    for (int it = gw; it < NITEMS; it += NGW) {
        const bool more = it + NGW < NITEMS; TrDesc dn = dc; float vn[32];
        if (more) { dn = tr_decode(p, it + NGW); tr_load(dn, lane, vn); }
        tr_finish(dc, vc, scr, lane);
        if (more) { dc = dn;
#pragma unroll
            for (int i = 0; i < 32; ++i) vc[i] = vn[i]; }
    }
}
__device__ __forceinline__ void pro_rope(const Params& p, int tid) {
    if (blockIdx.x != 255) return;
    float* R = (float*)(p.ws + WS_ROPE);
    for (int i = tid; i < 64 * 16; i += NTHR) { const int pos = i >> 4, f = i & 15; const float inv = exp2f(-(float)f * (13.287712379549449f / 16.f)); const float ang = (float)pos * inv;
        float sn, cs; sincosf(ang, &sn, &cs); R[2 * i] = cs; R[2 * i + 1] = sn; }
}
__device__ __forceinline__ void pro_filters(const Params& p, LAS unsigned char* lds, int tid, int lane, int wave) {
    LAS float* Z = (LAS float*)lds;
    LAS float* H1 = Z + 512;
    LAS float* H2 = H1 + 512;
    const int j0 = 8 * blockIdx.x, j = j0 + wave;
    const float* fw1 = p.in[I_FW1]; const float* fb1 = p.in[I_FB1]; const float* fw2 = p.in[I_FW2]; const float* fb2 = p.in[I_FB2]; const float* fw3 = p.in[I_FW3];
    {   float z = 0.f;
        if (lane == 0) z = (float)j / 2047.f;
        else if (lane < 33) { const int k = (lane - 1) & 15; const float fr = 1e-4f + (float)k * ((15.f - 1e-4f) / 15.f); const float ang = (6.283185307179586f / 2048.f) * (float)j * fr;
            float sn, cs; sincosf(ang, &sn, &cs); z = lane < 17 ? cs : -sn; }
        Z[wave * 64 + lane] = z; }
    LDS_WAIT(); asm volatile("" ::: "memory");
    {   float a = fb1[lane];
#pragma unroll 11
        for (int k = 0; k < 33; ++k) a += Z[wave * 64 + k] * fw1[k * 64 + lane];
        H1[wave * 64 + lane] = sinf(a); }
    LDS_WAIT(); asm volatile("" ::: "memory");
    {   float a = fb2[lane];
#pragma unroll 16
        for (int k = 0; k < 64; ++k) a += H1[wave * 64 + k] * fw2[k * 64 + lane];
        H2[wave * 64 + lane] = sinf(a); }
    __syncthreads();
    bf16* F = (bf16*)(p.ws + WS_FILT);
    const float mind = -4.605170185988091f / 1.5f, maxd = -4.605170185988091f / 0.3f;
#pragma unroll 1
    for (int i = 0; i < 4; ++i) { const int n = tid + NTHR * i, c = n & 1023;
        float acc[8];
#pragma unroll
        for (int q = 0; q < 8; ++q) acc[q] = 0.f;
#pragma unroll 16
        for (int k = 0; k < 64; ++k) { const float w = fw3[k * 2048 + n];
#pragma unroll
            for (int q = 0; q < 8; ++q) acc[q] += H2[q * 64 + k] * w; }
        const float delta = fabsf(mind + (float)c * ((maxd - mind) / 1023.f));
        float o[8];
#pragma unroll
        for (int q = 0; q < 8; ++q) { const float dist = fabsf((float)(j0 + q) - 1024.f) * (1.f / 1024.f); o[q] = acc[q] * expf(-dist * delta); }
        v4u w; w.x = pk2(o[0], o[1]); w.y = pk2(o[2], o[3]); w.z = pk2(o[4], o[5]); w.w = pk2(o[6], o[7]);
        *(v4u*)(F + (size_t)n * 2048 + j0) = w; }
    __syncthreads();
}

__device__ __forceinline__ void l0_norm_rows(const float* src, bf16* dst, int nrows, const float* g, const float* md, int lane) {
    f32x4 vb[4], vc[4];
#pragma unroll
    for (int j = 0; j < 4; ++j) { const int o = 4 * lane + 256 * j; vb[j] = *(const f32x4*)(g + o) * (1.f + *(const f32x4*)(md + D + o)); vc[j] = *(const f32x4*)(md + o); }
    f32x4 xn[4]; row_ld_f32(src, lane, xn);
#pragma unroll 1
    for (int i = 0; i < nrows; ++i) { f32x4 x[4], h[4];
#pragma unroll
        for (int j = 0; j < 4; ++j) x[j] = xn[j];
        if (i + 1 < nrows) row_ld_f32(src + (size_t)(i + 1) * D, lane, xn);
        const float rstd = rsqrtf(row_ss(x) * (1.f / D) + RMS_EPS);
#pragma unroll
        for (int j = 0; j < 4; ++j) h[j] = x[j] * rstd * vb[j] + vc[j];
        row_st_bf16(dst + (size_t)i * D, lane, h); }
}
__device__ __forceinline__ void ph_l0_norm(const Params& p, int lane, int wave) {
    const int gw = blockIdx.x * NWAVES + wave;
    const float* MOD = (const float*)(p.ws + WS_MOD); bf16* H = (bf16*)(p.ws + WS_BIG + A0_H);
    const float* g = p.in[I_NORMG];
    { const int m0 = gw * 32; l0_norm_rows(p.in[I_X] + (size_t)m0 * D, H + (size_t)m0 * D, 32, g, MOD + (size_t)(m0 >> 11) * NMOD, lane); }
    { const int m0 = gw * 4; l0_norm_rows(p.in[I_CTX] + (size_t)m0 * D, H + (size_t)(T + m0) * D, 4, g, MOD + (size_t)32 * NMOD, lane); }
}
__device__ __forceinline__ void ph_mid(const Params& p, int l, const bf16* MIX, bf16* H2, bool has_mix, int lane, int wave, int tile) {
    const int gw = tile * NWAVES + wave;
    const float* MOD = (const float*)(p.ws + WS_MOD) + (size_t)l * 33 * NMOD;
    const float* g1 = p.in[I_NORMG] + (size_t)(l * 4 + 1) * D; const float* g2 = p.in[I_NORMG] + (size_t)(l * 4 + 2) * D;
    const float* xin = l == 0 ? p.in[I_X] : p.out;
    const int m0 = gw * 32; const float* md = MOD + (size_t)(m0 >> 11) * NMOD;
    f32x4 va[4], vb[4], vc[4];
#pragma unroll
    for (int j = 0; j < 4; ++j) { const int o = 4 * lane + 256 * j; va[j] = *(const f32x4*)(md + 2 * D + o) * *(const f32x4*)(g1 + o); vb[j] = *(const f32x4*)(g2 + o) * (1.f + *(const f32x4*)(md + 4 * D + o)); vc[j] = *(const f32x4*)(md + 3 * D + o); }
    f32x4 xn[4], mn[4];
    row_ld_f32(xin + (size_t)m0 * D, lane, xn); if (has_mix) row_ld_bf16(MIX + (size_t)m0 * D, lane, mn);
#pragma unroll 1
    for (int m = m0; m < m0 + 32; ++m) {
        f32x4 x[4], h[4], mx[4];
#pragma unroll
        for (int j = 0; j < 4; ++j) { x[j] = xn[j]; mx[j] = mn[j]; }
        if (m + 1 < m0 + 32) { row_ld_f32(xin + (size_t)(m + 1) * D, lane, xn); if (has_mix) row_ld_bf16(MIX + (size_t)(m + 1) * D, lane, mn); }
        if (has_mix) { const float r = rsqrtf(row_ss(mx) * (1.f / D) + RMS_EPS);
#pragma unroll
            for (int j = 0; j < 4; ++j) x[j] = x[j] + va[j] * (mx[j] * r); }
        row_st_f32(p.out + (size_t)m * D, lane, x);
        const float rstd = rsqrtf(row_ss(x) * (1.f / D) + RMS_EPS);
#pragma unroll
        for (int j = 0; j < 4; ++j) h[j] = x[j] * rstd * vb[j] + vc[j];
        row_st_bf16(H2 + (size_t)m * D, lane, h);
    }
}
__device__ __forceinline__ void ph_combine(const Params& p, int l, int ch, const unsigned char* Y8, bf16* Hn, int lane, int wave) {
    const int gw = blockIdx.x * NWAVES + wave;
    const float* MOD = (const float*)(p.ws + WS_MOD) + (size_t)l * 33 * NMOD;
    const float* g3 = p.in[I_NORMG] + (size_t)(l * 4 + 3) * D;
    const int* PSLOT = (const int*)(p.ws + WS_PSLOT); const float* WTS = (const float*)(p.ws + WS_WTS);
    constexpr int RPW = CHT / 2048;
    const int mbase = ch * CHT + gw * RPW; const float* md = MOD + (size_t)(mbase >> 11) * NMOD;
    float va[16], vb[16], vc[16];
    { const float* md1 = MOD + (size_t)(33 + (mbase >> 11)) * NMOD; const float* g10 = p.in[I_NORMG] + (size_t)4 * D;
#pragma unroll
      for (int q = 0; q < 4; ++q) { const int o = lane * 16 + 4 * q; const f32x4 gp = *(const f32x4*)(g3 + o), gf = *(const f32x4*)(md + 5 * D + o); f32x4 gg = gp, sh = gp, sc = gp;
          if (l == 0) { gg = *(const f32x4*)(g10 + o); sh = *(const f32x4*)(md1 + o); sc = *(const f32x4*)(md1 + D + o); }
#pragma unroll
          for (int j = 0; j < 4; ++j) { va[4 * q + j] = gp[j] * gf[j]; vb[4 * q + j] = gg[j] * (1.f + sc[j]); vc[4 * q + j] = sh[j]; } } }
    int sl[9]; float wk[9];
#define CMB_SLOTS(mt) do { _Pragma("unroll") for (int k = 0; k < 9; ++k) { sl[k] = PSLOT[(size_t)(mt) * 16 + k]; wk[k] = k < 8 ? WTS[(size_t)(mt) * 8 + k] : 1.f; } } while (0)
    CMB_SLOTS(mbase);
#pragma unroll 1
    for (int m = mbase; m < mbase + RPW; ++m) {
        float a[16];
#pragma unroll
        for (int j = 0; j < 16; ++j) a[j] = 0.f;
        u32x4 yr[9]; float wc[9];
#pragma unroll
        for (int k = 0; k < 9; ++k) { yr[k] = *(const u32x4*)(Y8 + (size_t)sl[k] * 1024 + lane * 16); wc[k] = wk[k]; }
        float* orow = p.out + (size_t)m * D + lane * 16; f32x4 xv4[4];
#pragma unroll
        for (int q = 0; q < 4; ++q) xv4[q] = *(const f32x4*)(orow + 4 * q);
        if (m + 1 < mbase + RPW) CMB_SLOTS(m + 1);
#pragma unroll
        for (int k = 0; k < 9; ++k) { const float w = wc[k] * Y8_INV; const unsigned ww[4] = {yr[k].x, yr[k].y, yr[k].z, yr[k].w};
#pragma unroll
            for (int q = 0; q < 4; ++q) { a[4 * q + 0] += w * __builtin_amdgcn_cvt_f32_fp8((int)ww[q], 0); a[4 * q + 1] += w * __builtin_amdgcn_cvt_f32_fp8((int)ww[q], 1);
                                          a[4 * q + 2] += w * __builtin_amdgcn_cvt_f32_fp8((int)ww[q], 2); a[4 * q + 3] += w * __builtin_amdgcn_cvt_f32_fp8((int)ww[q], 3); } }
        float ss = 0.f;
#pragma unroll
        for (int j = 0; j < 16; ++j) ss += a[j] * a[j];
        const float r = rsqrtf(wave_sum(ss) * (1.f / D) + RMS_EPS);
        float x[16]; float s2 = 0.f;
#pragma unroll
        for (int q = 0; q < 4; ++q) {
#pragma unroll
            for (int j = 0; j < 4; ++j) { const float v = xv4[q][j] + va[4 * q + j] * (a[4 * q + j] * r); x[4 * q + j] = v; s2 += v * v; }
            *(f32x4*)(orow + 4 * q) = (f32x4){x[4 * q], x[4 * q + 1], x[4 * q + 2], x[4 * q + 3]}; }
        if (l == 0) { const float rstd = rsqrtf(wave_sum(s2) * (1.f / D) + RMS_EPS); float h[16];
#pragma unroll
            for (int j = 0; j < 16; ++j) h[j] = x[j] * rstd * vb[j] + vc[j];
            v4u w0, w1; w0.x = pk2(h[0], h[1]); w0.y = pk2(h[2], h[3]); w0.z = pk2(h[4], h[5]); w0.w = pk2(h[6], h[7]); w1.x = pk2(h[8], h[9]); w1.y = pk2(h[10], h[11]); w1.z = pk2(h[12], h[13]); w1.w = pk2(h[14], h[15]);
            *(v4u*)(Hn + (size_t)m * D + lane * 16) = w0; *(v4u*)(Hn + (size_t)m * D + lane * 16 + 8) = w1; }
    }
#undef CMB_SLOTS
}

struct DenseSched { int NN, NU, G, c, NMs;
    __device__ __forceinline__ bool next(int i, Unit& u) const { const int L = i * G + c; if (L >= NU) return false; if (NMs > 0) { u.pm = L % NMs; u.pn = L / NMs; } else { u.pm = L / NN; u.pn = L % NN; } return true; }
    __device__ __forceinline__ int arow(int r) const { return r; }
    __device__ __forceinline__ void* probe_ts() const { return nullptr; } };
struct PanelSched { int NN, pm;
    __device__ __forceinline__ bool next(int i, Unit& u) const { if (i >= NN) return false; u.pm = pm; u.pn = i; return true; }
    __device__ __forceinline__ int arow(int r) const { return r; }
    __device__ __forceinline__ void* probe_ts() const { return nullptr; } };
struct EpiBf16 { static constexpr bool PERM = true, AFTER_DRAIN = false, PROBE = false; bf16* O; size_t ldc; int cmask;
    __device__ __forceinline__ void operator()(const f32x4 (&acc)[2][2][4][2], const Unit& u, int wr, int wc, int fr, int fq) const {
        const int row0 = u.pm * BM + wr * 64 + fr, col0 = (u.pn & cmask) * BM + wc * 32 + 8 * fq;
#pragma unroll
        for (int ai = 0; ai < 2; ++ai)
#pragma unroll
            for (int m = 0; m < 4; ++m) { bf16* rowp = O + (size_t)(row0 + ai * HALF + m * 16) * ldc + col0;
#pragma unroll
                for (int bj = 0; bj < 2; ++bj) { const f32x4 v0 = acc[ai][bj][m][0], v1 = acc[ai][bj][m][1];
                    u32x4 w; w.x = cvt_pk_bf16(v0[0], v0[1]); w.y = cvt_pk_bf16(v0[2], v0[3]); w.z = cvt_pk_bf16(v1[0], v1[1]); w.w = cvt_pk_bf16(v1[2], v1[3]);
                    *(u32x4*)(rowp + bj * HALF) = w; } }
    } };
struct EpiRouter { static constexpr bool PERM = false, AFTER_DRAIN = false, PROBE = false; float* LOG;
    __device__ __forceinline__ void operator()(const f32x4 (&acc)[2][2][4][2], const Unit& u, int wr, int wc, int fr, int fq) const {
        if (wc >= 2) return;
        const int row0 = u.pm * BM + wr * 64 + fr, col0 = wc * 32 + 4 * fq;
#pragma unroll
        for (int ai = 0; ai < 2; ++ai)
#pragma unroll
            for (int m = 0; m < 4; ++m) { float* rowp = LOG + (size_t)(row0 + ai * HALF + m * 16) * 64 + col0;
#pragma unroll
                for (int n = 0; n < 2; ++n) *(f32x4*)(rowp + n * 16) = acc[ai][0][m][n]; }
    } };
struct EpiFp8 { static constexpr bool PERM = true, AFTER_DRAIN = false, PROBE = true; unsigned char* O;
    __device__ __forceinline__ void operator()(const f32x4 (&acc)[2][2][4][2], const Unit& u, int wr, int wc, int fr, int fq) const {
        const int row0 = u.pm * BM + wr * 64 + fr, col0 = (u.pn & 3) * BM + wc * 64 + 16 * fq;
#pragma unroll
        for (int ai = 0; ai < 2; ++ai)
#pragma unroll
            for (int m = 0; m < 4; ++m) { unsigned char* rowp = O + (size_t)(row0 + ai * HALF + m * 16) * 1024 + col0; u32x4 w;
#pragma unroll
                for (int bj = 0; bj < 2; ++bj) { f32x4 v0 = acc[ai][bj][m][0] * Y8_SCALE, v1 = acc[ai][bj][m][1] * Y8_SCALE; int lo = 0, hi = 0;
#pragma unroll
                    for (int j = 0; j < 4; ++j) { v0[j] = __builtin_amdgcn_fmed3f(v0[j], -440.f, 440.f); v1[j] = __builtin_amdgcn_fmed3f(v1[j], -440.f, 440.f); }
                    lo = __builtin_amdgcn_cvt_pk_fp8_f32(v0[0], v0[1], lo, false); lo = __builtin_amdgcn_cvt_pk_fp8_f32(v0[2], v0[3], lo, true);
                    hi = __builtin_amdgcn_cvt_pk_fp8_f32(v1[0], v1[1], hi, false); hi = __builtin_amdgcn_cvt_pk_fp8_f32(v1[2], v1[3], hi, true);
                    if (bj == 0) { w.x = (unsigned)lo; w.y = (unsigned)hi; } else { w.z = (unsigned)lo; w.w = (unsigned)hi; } }
                *(u32x4*)rowp = w; }
    } };
struct EpiRouterLds { static constexpr bool PERM = false, AFTER_DRAIN = true, PROBE = false;
    __device__ __forceinline__ void operator()(const f32x4 (&)[2][2][4][2], const Unit&, int, int, int, int) const {}
    __device__ __forceinline__ void fused(const f32x4 (&acc)[2][2][4][2], const Unit&, int wr, int wc, int fr, int fq, LAS unsigned char* lds) const {
        if (wc >= 2) return;
        LAS float* SC = (LAS float*)lds;
#pragma unroll
        for (int ai = 0; ai < 2; ++ai)
#pragma unroll
            for (int m = 0; m < 4; ++m) { const int row = ai * HALF + wr * 64 + m * 16 + fr;
#pragma unroll
                for (int n = 0; n < 2; ++n)
#pragma unroll
                    for (int j = 0; j < 4; ++j) SC[row * 65 + wc * 32 + n * 16 + 4 * fq + j] = sigmoidf_(acc[ai][0][m][n][j]); }
    } };
struct MoeSched { const LAS int* te; const int* sort; int NU, G, c, sh, per;
    __device__ __forceinline__ bool next(int i, Unit& u) const { const int L = i * G + c; if (L >= NU) return false; const int tile = L >> sh; u.pm = tile; u.pn = te[tile] * per + (L & (per - 1)); return true; }
    __device__ __forceinline__ int arow(int r) const { return sort ? sort[r] : r; }
    void* pts; __device__ __forceinline__ void* probe_ts() const { return pts; } };
struct EpiSwiglu { static constexpr bool PERM = true, AFTER_DRAIN = false, PROBE = false; bf16* ACT;
    __device__ __forceinline__ void operator()(const f32x4 (&acc)[2][2][4][2], const Unit& u, int wr, int wc, int fr, int fq) const {
        const int row0 = u.pm * BM + wr * 64 + fr, col0 = (u.pn & 1) * 128 + wc * 32 + 8 * fq;
#pragma unroll
        for (int ai = 0; ai < 2; ++ai)
#pragma unroll
            for (int m = 0; m < 4; ++m) { bf16* rowp = ACT + (size_t)(row0 + ai * HALF + m * 16) * DE + col0;
                const f32x4 g0 = acc[ai][0][m][0], g1 = acc[ai][0][m][1], u0 = acc[ai][1][m][0], u1 = acc[ai][1][m][1];
                float o[8];
#pragma unroll
                for (int q = 0; q < 4; ++q) { o[q] = siluf_(g0[q]) * u0[q]; o[4 + q] = siluf_(g1[q]) * u1[q]; }
                u32x4 w; w.x = cvt_pk_bf16(o[0], o[1]); w.y = cvt_pk_bf16(o[2], o[3]); w.z = cvt_pk_bf16(o[4], o[5]); w.w = cvt_pk_bf16(o[6], o[7]);
                *(u32x4*)rowp = w; }
    } };
__device__ __forceinline__ int moe_tables(const Params& p, int ch, LAS unsigned char* lds, int tid) {
    LAS int* TE = (LAS int*)(lds + LDS_TAB);
    const int* TEG = (const int*)(p.ws + WS_TEG) + (size_t)ch * (MAXTILES + 64);
    __syncthreads();
#pragma unroll 1
    for (int i = tid; i <= MAXTILES; i += NTHR) TE[i] = TEG[i];
    __syncthreads();
    return TE[MAXTILES];
}

__device__ __forceinline__ void ph_route_a(const Params& p, int l, const float* LOG, int tile, LAS unsigned char* lds, int tid) {
    LAS float* SC = (LAS float*)lds;
    LAS float* RBs = (LAS float*)(lds + 68 * 1024);
    LAS unsigned* MASK = (LAS unsigned*)(lds + 69 * 1024);
    const int b = tile, tok0 = 256 * b;
    if (LOG)
#pragma unroll 1
    for (int i = tid; i < 256 * 64; i += NTHR) { const int t = i >> 6, e = i & 63; SC[t * 65 + e] = sigmoidf_(LOG[(size_t)(tok0 + t) * 64 + e]); }
    if (tid < 64) RBs[tid] = p.in[I_RB][l * 64 + tid];
    MASK[tid] = 0u;
    __syncthreads();
    int eidx[8]; float wts[8];
    if (tid < 256) { const int t = tid; const LAS float* sc = SC + t * 65;
        float gs[8], bv[64];
#pragma unroll
        for (int g = 0; g < 8; ++g) { float m1 = -3.0e38f, m2 = -3.0e38f;
#pragma unroll
            for (int j = 0; j < 8; ++j) { const float v = sc[8 * g + j] + RBs[8 * g + j]; bv[8 * g + j] = v; if (v > m1) { m2 = m1; m1 = v; } else if (v > m2) m2 = v; }
            gs[g] = m1 + m2; }
        unsigned gmask = 0u;
#pragma unroll
        for (int r = 0; r < 4; ++r) { float best = -3.0e38f; int bi = 0; bool found = false;
#pragma unroll
            for (int g = 0; g < 8; ++g) { const bool free_ = ((gmask >> g) & 1u) == 0u; if (free_ && (!found || gs[g] > best)) { best = gs[g]; bi = g; found = true; } }
            gmask |= 1u << bi; }
#pragma unroll
        for (int e = 0; e < 64; ++e) if (((gmask >> (e >> 3)) & 1u) == 0u) bv[e] = -3.0e38f;
        unsigned long long taken = 0ull; float ssum = 0.f;
#pragma unroll
        for (int k = 0; k < 8; ++k) { float best = -3.0e38f; int be = 0; bool found = false;
#pragma unroll
            for (int e = 0; e < 64; ++e) { const bool ok = ((taken >> e) & 1ull) == 0ull; if (ok && (!found || bv[e] > best)) { best = bv[e]; be = e; found = true; } }
            taken |= 1ull << be; eidx[k] = be; wts[k] = sc[be]; ssum += wts[k]; }
        const float inv = 2.5f / ssum;
#pragma unroll
        for (int k = 0; k < 8; ++k) { wts[k] *= inv; __hip_atomic_fetch_or(&MASK[eidx[k] * 8 + (t >> 5)], 1u << (t & 31), __ATOMIC_RELAXED, __HIP_MEMORY_SCOPE_WORKGROUP); }
    }
    __syncthreads();
    if (tid < 256) { const int t = tid; int* EIDX = (int*)(p.ws + WS_EIDX); float* WTS = (float*)(p.ws + WS_WTS);
#pragma unroll
        for (int k = 0; k < 8; ++k) { const int e = eidx[k]; int r = 0;
#pragma unroll 1
            for (int w = 0; w < (t >> 5); ++w) r += __popc(MASK[e * 8 + w]);
            r += __popc(MASK[e * 8 + (t >> 5)] & ((1u << (t & 31)) - 1u));
            EIDX[(size_t)(tok0 + t) * 8 + k] = e | (r << 8); WTS[(size_t)(tok0 + t) * 8 + k] = wts[k]; } }
    if (tid < 64) { int c = 0;
#pragma unroll
        for (int w = 0; w < 8; ++w) c += __popc(MASK[tid * 8 + w]);
        ((int*)(p.ws + WS_BC))[b * 64 + tid] = c; }
    __syncthreads();
}
__device__ __forceinline__ void ph_route_b(const Params& p, LAS unsigned char* lds, int tid) {
    LAS int* BCS = (LAS int*)lds;
    LAS int* CNT = BCS + BPC * 64; LAS int* PRE = CNT + 64; LAS int* SEG = PRE + 64;
    const int b = blockIdx.x, ch = b / BPC, bl = b % BPC;
    const int* BC = (const int*)(p.ws + WS_BC) + (size_t)ch * BPC * 64;
#pragma unroll 1
    for (int i = tid; i < BPC * 64; i += NTHR) BCS[i] = BC[i];
    __syncthreads();
    if (tid < 64) { int c = 0, pr = 0;
#pragma unroll 1
        for (int i = 0; i < BPC; ++i) { const int v = BCS[i * 64 + tid]; c += v; if (i < bl) pr += v; } CNT[tid] = c; PRE[tid] = pr; }
    __syncthreads();
    if (tid == 0) { int base = 0;
#pragma unroll 1
        for (int e = 0; e < 64; ++e) { SEG[e] = base; base += ((CNT[e] + 255) >> 8) << 8; } SEG[64] = base; }
    __syncthreads();
    int* SORT = (int*)(p.ws + WS_SORT) + (size_t)ch * CHROWS; int* PSLOT = (int*)(p.ws + WS_PSLOT); const int* EIDX = (const int*)(p.ws + WS_EIDX);
    if (tid < 256) { const int tok = 256 * b + tid;
#pragma unroll
        for (int k = 0; k < 8; ++k) { const int w = EIDX[(size_t)tok * 8 + k], e = w & 255, r = w >> 8; const int slot = SEG[e] + PRE[e] + r; SORT[slot] = tok; PSLOT[(size_t)tok * 16 + k] = slot; }
        const int s8 = SEG[64] + (tok - ch * CHT); SORT[s8] = tok; PSLOT[(size_t)tok * 16 + 8] = s8; }
    if (bl == 0) {
        int* TEG = (int*)(p.ws + WS_TEG) + (size_t)ch * (MAXTILES + 64); const int NT = (SEG[64] >> 8) + CHT / 256;
#pragma unroll 1
        for (int i = tid; i < NT; i += NTHR) { int e = 0;
#pragma unroll 1
            while (e < 64 && (i << 8) >= SEG[e + 1]) ++e;
            TEG[i] = e; }
        if (tid == 0) TEG[MAXTILES] = NT; }
    if (bl < 64) { const int e = bl, lo = SEG[e] + CNT[e], hi = SEG[e] + (((CNT[e] + 255) >> 8) << 8); for (int s = lo + tid; s < hi; s += NTHR) SORT[s] = ch * CHT; }
    __syncthreads();
}

typedef float f32x16 __attribute__((ext_vector_type(16)));
__device__ __forceinline__ void ph_sconv(const Params& p, const bf16* UT, bf16* UC, int tid) {
    const float* cw = p.in[I_CONVHYW]; const float* cbias = p.in[I_CONVHYB];
    const unsigned NIT = 3072u * 32u * 256u; const unsigned gt = blockIdx.x * NTHR + tid, NG = gridDim.x * NTHR;
#pragma unroll 1
    for (unsigned it = gt; it < NIT; it += NG) {
        const unsigned c = it >> 13, k = it & 255u; const size_t base = (size_t)it * 8;
        const v4u w = *(const v4u*)(UT + base);
        const float w0 = cw[c], w1 = cw[3072 + c], w2 = cw[6144 + c], bb = cbias[c];
        float x[10];
        x[0] = k > 0 ? bf1(UT[base - 1]) : 0.f; x[9] = k < 255 ? bf1(UT[base + 8]) : 0.f;
        x[1] = bf_lo(w.x); x[2] = bf_hi(w.x); x[3] = bf_lo(w.y); x[4] = bf_hi(w.y); x[5] = bf_lo(w.z); x[6] = bf_hi(w.z); x[7] = bf_lo(w.w); x[8] = bf_hi(w.w);
        float o[8];
#pragma unroll
        for (int j = 0; j < 8; ++j) o[j] = bb + w0 * x[j] + w1 * x[j + 1] + w2 * x[j + 2];
        v4u r; r.x = pk2(o[0], o[1]); r.y = pk2(o[2], o[3]); r.z = pk2(o[4], o[5]); r.w = pk2(o[6], o[7]);
        *(v4u*)(UC + base) = r;
    }
}
constexpr int LC_CPB = 8224, LC_RAW = 8 * LC_CPB, LC_RAWSZ = 32 * 512, LC_HALO = LC_RAW + 2 * LC_RAWSZ, LC_VBP = 528, LC_VB0 = LC_HALO + 2 * 8192, LC_VBSZ = 32 * LC_VBP;
static_assert(LC_VB0 + 2 * LC_VBSZ <= LDS_MISC && 8 * 32 * 528 <= LDS_MISC, "lconv LDS map");
struct Taps { float w0, w1, w2, b; };
__device__ __forceinline__ float bfh(unsigned w, int hi) { return hi ? bf_hi(w) : bf_lo(w); }
template <bool CONVIN>
__device__ __forceinline__ void lconv_unit(const bf16* vin, const Taps ti, const bf16* F, const bf16* graw, const Taps tg, float fb, bf16* out, LAS unsigned char* lds, int tid, int lane, int wave) {
    __syncthreads();
#define LC_DMA(ch, rb) do { _Pragma("unroll") for (int q = 0; q < 2; ++q) { const int row = wave * 4 + 2 * q + (ln >> 5); \
        __builtin_amdgcn_global_load_lds((const unsigned*)(vin + (size_t)row * 2048 + (ch) * 256 + (ln & 31) * 8), (LAS unsigned*)(lds + LC_RAW + (rb) * LC_RAWSZ + (wave * 4 + 2 * q) * 512), 16, 0, 0); } \
        { const int hrow = wave * 4 + ((ln & 7) >> 1); int hs = (ln & 1) ? (ch) * 256 + 256 : (ch) * 256 - 8; hs = hs < 0 ? 0 : (hs > 2040 ? 2040 : hs); \
          __builtin_amdgcn_global_load_lds((const unsigned*)(vin + (size_t)hrow * 2048 + hs), (LAS unsigned*)(lds + LC_HALO + (rb) * 8192 + wave * 1024), 16, 0, 0); } } while (0)
    LAS bf16* Fl = (LAS bf16*)(lds + LC_VB0 + LC_VBSZ);
    { int ln = lane; asm volatile("" : "+v"(ln)); LC_DMA(0, 0); LC_DMA(1, 1); }
    if (tid < 256) *(LAS v4u*)(Fl + tid * 8) = *(const v4u*)(F + tid * 8);
    __syncthreads();
    if (tid == 0) Fl[1024] = (bf16)f2bf(bf1(Fl[1024]) + fb);
    __syncthreads();
#pragma unroll 1
    for (int a = 0; a < 8; ++a)
#pragma unroll 1
        for (int mi = tid; mi < 2056; mi += NTHR) { const int m = mi * 2; const int x0 = 3079 - m - a, x1 = x0 - 1;
            const unsigned lo = (x0 >= 0 && x0 <= 2047) ? (unsigned)Fl[x0] : 0u, hi = (x1 >= 0 && x1 <= 2047) ? (unsigned)Fl[x1] : 0u;
            *(LAS unsigned*)(lds + a * LC_CPB + m * 2) = lo | (hi << 16); }
    const int r = lane & 31, h = lane >> 5, a = (7 - r) & 7;
    const LAS unsigned char* cpA = lds + a * LC_CPB + 2 * (1023 - r + 8 * h - a + 1032) - 512 * wave;
    const int laneB = r * LC_VBP + 16 * h;
#define LC_CONVERT(ch, rb, buf) do { _Pragma("unroll") for (int q = 0; q < 2; ++q) { const int pid = ln + 64 * q, row = wave * 4 + (pid >> 5), pp = pid & 31; const LAS unsigned char* rp = lds + LC_RAW + (rb) * LC_RAWSZ + row * 512 + pp * 16; \
        const v4u w = *(const LAS v4u*)rp; v4u o = w; \
        if (CONVIN) { const LAS unsigned char* hp_ = lds + LC_HALO + (rb) * 8192 + wave * 1024 + (pid >> 5) * 32; float x[10]; \
            x[0] = pp > 0 ? bf1(*(const LAS bf16*)(rp - 2)) : ((ch) > 0 ? bf1(*(const LAS bf16*)(hp_ + 14)) : 0.f); x[9] = pp < 31 ? bf1(*(const LAS bf16*)(rp + 16)) : ((ch) < 7 ? bf1(*(const LAS bf16*)(hp_ + 16)) : 0.f); \
            x[1] = bf_lo(w.x); x[2] = bf_hi(w.x); x[3] = bf_lo(w.y); x[4] = bf_hi(w.y); x[5] = bf_lo(w.z); x[6] = bf_hi(w.z); x[7] = bf_lo(w.w); x[8] = bf_hi(w.w); \
            float y[8]; _Pragma("unroll") for (int j = 0; j < 8; ++j) y[j] = ti.b + ti.w0 * x[j] + ti.w1 * x[j + 1] + ti.w2 * x[j + 2]; \
            o.x = pk2(y[0], y[1]); o.y = pk2(y[2], y[3]); o.z = pk2(y[4], y[5]); o.w = pk2(y[6], y[7]); } \
        *(LAS v4u*)(lds + LC_VB0 + (buf) * LC_VBSZ + row * LC_VBP + pp * 16) = o; } } while (0)
    { int ln = lane; asm volatile("" : "+v"(ln));
    asm volatile("s_waitcnt vmcnt(3)" ::: "memory");
    LC_CONVERT(0, 0, 0); }
    asm volatile("s_waitcnt lgkmcnt(0)" ::: "memory"); __builtin_amdgcn_s_barrier(); asm volatile("" ::: "memory");
    f32x16 acc[8];
#pragma unroll
    for (int i = 0; i < 8; ++i)
#pragma unroll
        for (int q = 0; q < 16; ++q) acc[i][q] = 0.f;
    bf16x8 E[8], O[8];
    bool primed = false;
#pragma unroll 1
    for (int ch = 0; ch < 8; ++ch) {
        int ln = lane; asm volatile("" : "+v"(ln));
        if (ch < 6) LC_DMA(ch + 2, ch & 1);
        const int du = wave - ch;
        if (du >= -4 && du <= 4) {
            const LAS unsigned char* ca = cpA + 64 * (ch * 8); const LAS unsigned char* vbh = lds + LC_VB0 + (ch & 1) * LC_VBSZ + laneB;
            if (!primed) { primed = true;
#pragma unroll
                for (int i = 1; i < 8; ++i) { E[(8 - i) & 7] = *(const LAS bf16x8*)(ca + 32 * (-2 * i)); O[(8 - i) & 7] = *(const LAS bf16x8*)(ca + 32 * (-2 * i + 1)); }
                E[0] = *(const LAS bf16x8*)ca; O[0] = *(const LAS bf16x8*)(ca + 32); }
            bf16x8 bc0 = *(const LAS bf16x8*)vbh, bc1 = *(const LAS bf16x8*)(vbh + 32);
#pragma unroll
            for (int mm = 0; mm < 8; ++mm) {
                bf16x8 bn0 = bc0, bn1 = bc1;
                if (mm < 7) { bn0 = *(const LAS bf16x8*)(vbh + 64 * (mm + 1)); bn1 = *(const LAS bf16x8*)(vbh + 64 * (mm + 1) + 32); }
                acc[7] = __builtin_amdgcn_mfma_f32_32x32x16_bf16(E[(mm + 1) & 7], bc0, acc[7], 0, 0, 0);
                E[(mm + 1) & 7] = *(const LAS bf16x8*)(ca + 64 * (mm + 1));
#pragma unroll
                for (int i = 0; i < 7; ++i) acc[i] = __builtin_amdgcn_mfma_f32_32x32x16_bf16(E[(mm - i) & 7], bc0, acc[i], 0, 0, 0);
                acc[7] = __builtin_amdgcn_mfma_f32_32x32x16_bf16(O[(mm + 1) & 7], bc1, acc[7], 0, 0, 0);
                O[(mm + 1) & 7] = *(const LAS bf16x8*)(ca + 64 * (mm + 1) + 32);
#pragma unroll
                for (int i = 0; i < 7; ++i) acc[i] = __builtin_amdgcn_mfma_f32_32x32x16_bf16(O[(mm - i) & 7], bc1, acc[i], 0, 0, 0);
                bc0 = bn0; bc1 = bn1;
            }
        }
        if (ch < 7) { if (ch < 6) asm volatile("s_waitcnt vmcnt(3)" ::: "memory"); else asm volatile("s_waitcnt vmcnt(0)" ::: "memory"); LC_CONVERT(ch + 1, (ch + 1) & 1, (ch + 1) & 1); }
        asm volatile("s_waitcnt lgkmcnt(0)" ::: "memory"); __builtin_amdgcn_s_barrier(); asm volatile("" ::: "memory");
    }
#undef LC_DMA
#undef LC_CONVERT
    { int le = lane; asm volatile("" : "+v"(le)); const int re = le & 31, he = le >> 5;
      LAS unsigned char* tw = lds + wave * (32 * 528);
#pragma unroll
      for (int i = 0; i < 8; ++i)
#pragma unroll
          for (int g = 0; g < 4; ++g) { v2u w; w.x = pk2(acc[i][4 * g + 0], acc[i][4 * g + 1]); w.y = pk2(acc[i][4 * g + 2], acc[i][4 * g + 3]); *(LAS v2u*)(tw + re * 528 + (32 * i + 8 * g + 4 * he) * 2) = w; }
      LDS_WAIT(); asm volatile("" ::: "memory");
      const int pp = le & 31;
      v4u gwa[16]; float hal[16];
      const bool hprev = pp == 0 && wave > 0, hnext = pp == 31 && wave < 7;
#pragma unroll
      for (int it = 0; it < 16; ++it) { const size_t off = (size_t)(2 * it + (le >> 5)) * 2048 + 256 * wave + pp * 8; gwa[it] = *(const v4u*)(graw + off);
          hal[it] = (hprev || hnext) ? bf1(graw[hprev ? off - 1 : off + 8]) : 0.f; }
#pragma unroll
      for (int it = 0; it < 16; ++it) { const int row = 2 * it + (le >> 5); const size_t off = (size_t)row * 2048 + 256 * wave + pp * 8;
          const v4u gw = gwa[it]; const v4u aw = *(const LAS v4u*)(tw + row * 528 + pp * 16);
          const float hp = hal[it], hn = hal[it];
          float gx[10]; gx[1] = bf_lo(gw.x); gx[2] = bf_hi(gw.x); gx[3] = bf_lo(gw.y); gx[4] = bf_hi(gw.y); gx[5] = bf_lo(gw.z); gx[6] = bf_hi(gw.z); gx[7] = bf_lo(gw.w); gx[8] = bf_hi(gw.w);
          const float fromprev = shidx(gx[8], le - 1), fromnext = shidx(gx[1], le + 1);
          gx[0] = pp > 0 ? fromprev : hp; gx[9] = pp < 31 ? fromnext : hn;
          const float av[8] = {bf_lo(aw.x), bf_hi(aw.x), bf_lo(aw.y), bf_hi(aw.y), bf_lo(aw.z), bf_hi(aw.z), bf_lo(aw.w), bf_hi(aw.w)};
          float o[8];
#pragma unroll
          for (int j = 0; j < 8; ++j) o[j] = (tg.b + tg.w0 * gx[j] + tg.w1 * gx[j + 1] + tg.w2 * gx[j + 2]) * av[j];
          v4u w; w.x = pk2(o[0], o[1]); w.y = pk2(o[2], o[3]); w.z = pk2(o[4], o[5]); w.w = pk2(o[6], o[7]);
          *(v4u*)(out + off) = w; }
    }
}
template <bool CONVIN>
__device__ __forceinline__ void ph_lconv(const Params& p, int o, const bf16* IN, const bf16* UT, bf16* OUT, LAS unsigned char* lds, int tid, int lane, int wave) {
    const bf16* FILT = (const bf16*)(p.ws + WS_FILT); const float* cw = p.in[I_CONVHYW]; const float* cbias = p.in[I_CONVHYB];
#pragma unroll 1
    for (int c = blockIdx.x; c < 1024; c += gridDim.x) { const int gc = (1 + o) * 1024 + c;
        const Taps ti{cw[c], cw[3072 + c], cw[6144 + c], cbias[c]}, tg{cw[gc], cw[3072 + gc], cw[6144 + gc], cbias[gc]};
        lconv_unit<CONVIN>(IN + (size_t)c * T, ti, FILT + (size_t)(o * 1024 + c) * 2048, UT + (size_t)gc * T, tg, p.in[I_FBIAS][o * 1024 + c], OUT + (size_t)c * T, lds, tid, lane, wave); }
}
__device__ __forceinline__ void ph_transpose(const bf16* Y2T, bf16* Y2, LAS unsigned char* lds, int lane, int wave, int panel) {
    LAS unsigned char* tl = lds + wave * 16384;
#pragma unroll 1
    for (int tile = wave; tile < 64; tile += NWAVES) { const int c0 = (tile & 15) * 64, t0 = panel * 256 + (tile >> 4) * 64;
#pragma unroll
        for (int rr = 0; rr < 8; ++rr) { const int row = rr * 8 + (lane >> 3), pc = lane & 7;
            *(LAS v4u*)(tl + row * 144 + pc * 16) = *(const v4u*)(Y2T + (size_t)(c0 + row) * T + t0 + pc * 8); }
        LDS_WAIT(); asm volatile("" ::: "memory");
#pragma unroll
        for (int rr = 0; rr < 8; ++rr) { const int tk = rr * 8 + (lane >> 3), cp = (lane & 7) * 8;
            unsigned short e[8];
#pragma unroll
            for (int j = 0; j < 8; ++j) e[j] = *(const LAS unsigned short*)(tl + (cp + j) * 144 + tk * 2);
            v4u w; w.x = e[0] | ((unsigned)e[1] << 16); w.y = e[2] | ((unsigned)e[3] << 16); w.z = e[4] | ((unsigned)e[5] << 16); w.w = e[6] | ((unsigned)e[7] << 16);
            *(v4u*)(Y2 + (size_t)(t0 + tk) * D + c0 + cp) = w; }
        LDS_WAIT(); asm volatile("" ::: "memory");
    }
}

constexpr float QSCALE = 0.125f * 1.4426950408889634f;
struct InprojSched { int G, c;
    __device__ __forceinline__ bool next(int i, Unit& u) const { const int L = i * G + c; if (L >= 3840 + 288) return false;
        if (L < 3840) { u.pm = L / 15; u.pn = L % 15; } else { const int q = L - 3840; u.pm = 256 + q / 9; u.pn = 6 + q % 9; } return true; }
    __device__ __forceinline__ int arow(int r) const { return r; }
    __device__ __forceinline__ void* probe_ts() const { return nullptr; } };
struct EpiInproj { static constexpr bool PERM = true, AFTER_DRAIN = false, PROBE = false; unsigned char* big; const float* rope; float* gates; const float* gate_b;
    __device__ __forceinline__ void operator()(const f32x4 (&acc)[2][2][4][2], const Unit& u, int wr, int wc, int fr, int fq) const {
        const bool ctx = u.pm >= 256; const int b = ctx ? u.pm - 256 : (u.pm >> 3), r0 = ctx ? 0 : (u.pm & 7) * 256;
        if (u.pn == 14) {
            if (wc != 0 || fq >= 2) return;
            const f32x4 gb0 = *(const f32x4*)(gate_b + 8 * fq), gb1 = *(const f32x4*)(gate_b + 8 * fq + 4);
#pragma unroll
            for (int ai = 0; ai < 2; ++ai)
#pragma unroll
                for (int m = 0; m < 4; ++m) { const int rr = r0 + wr * 64 + fr + ai * HALF + m * 16; const size_t grow = ctx ? (size_t)T + b * LC + rr : (size_t)b * SEQ + rr;
                    float* gp = gates + grow * 16 + 8 * fq; *(f32x4*)gp = acc[ai][0][m][0] + gb0; *(f32x4*)(gp + 4) = acc[ai][0][m][1] + gb1; }
            return; }
        const int t = u.pn >> 1;
        constexpr size_t offs[7] = {A0_QA, A0_BQ, A0_BO, A0_KA, A0_VA, A0_BK, A0_BV};
        const bool kv = t >= 3;
        size_t toff = A0_QA;
#pragma unroll
        for (int q = 0; q < 7; ++q) if (t == q) toff = offs[q];
        bf16* O = (bf16*)(big + toff) + (size_t)b * (kv ? (SEQ + LC) : SEQ) * 512 + (size_t)((kv && !ctx) ? LC : 0) * 512;
        const bool rope_on = (t == 0 || t == 3) && !ctx; const float qs = t == 0 ? QSCALE : 1.f;
        const int col0 = (u.pn & 1) * 256 + wc * 32 + 8 * fq;
#pragma unroll
        for (int ai = 0; ai < 2; ++ai)
#pragma unroll
            for (int m = 0; m < 4; ++m) { const int rr = r0 + wr * 64 + fr + ai * HALF + m * 16; bf16* rowp = O + (size_t)rr * 512 + col0;
                f32x4 cs0 = (f32x4){1.f, 0.f, 1.f, 0.f}, cs1 = cs0;
                if (rope_on) { const int pos = (wc & 1) ? (rr & 63) : (rr >> 6); const float* rp = rope + (size_t)(pos * 16 + 4 * fq) * 2; cs0 = *(const f32x4*)rp; cs1 = *(const f32x4*)(rp + 4); }
#pragma unroll
                for (int bj = 0; bj < 2; ++bj) { const f32x4 x0 = acc[ai][bj][m][0], x1 = acc[ai][bj][m][1];
                    f32x4 o0, o1;
                    o0[0] = x0[0] * cs0[0] - x1[0] * cs0[1]; o1[0] = x1[0] * cs0[0] + x0[0] * cs0[1];
                    o0[1] = x0[1] * cs0[2] - x1[1] * cs0[3]; o1[1] = x1[1] * cs0[2] + x0[1] * cs0[3];
                    o0[2] = x0[2] * cs1[0] - x1[2] * cs1[1]; o1[2] = x1[2] * cs1[0] + x0[2] * cs1[1];
                    o0[3] = x0[3] * cs1[2] - x1[3] * cs1[3]; o1[3] = x1[3] * cs1[2] + x0[3] * cs1[3];
                    o0 = o0 * qs; o1 = o1 * qs;
                    u32x4 w; w.x = cvt_pk_bf16(o0[0], o0[1]); w.y = cvt_pk_bf16(o0[2], o0[3]); w.z = cvt_pk_bf16(o1[0], o1[1]); w.w = cvt_pk_bf16(o1[2], o1[3]);
                    *(u32x4*)(rowp + bj * HALF) = w; } }
    } };
__device__ __forceinline__ void ph_transpose_b(const bf16* src, bf16* dst, int NBt, int R, int C, LAS unsigned char* lds, int lane, int wave) {
    LAS unsigned char* tl = lds + wave * 16384;
    const int gw = blockIdx.x * NWAVES + wave, NGW = gridDim.x * NWAVES; const int tr = R / 64, tc = C / 64, per = tr * tc;
#pragma unroll 1
    for (int tile = gw; tile < NBt * per; tile += NGW) { const int bt = tile / per, q = tile % per, c0 = (q % tc) * 64, r0 = (q / tc) * 64;
        const bf16* s = src + (size_t)bt * R * C; bf16* d = dst + (size_t)bt * R * C;
#pragma unroll
        for (int rr = 0; rr < 8; ++rr) { const int row = rr * 8 + (lane >> 3), pc = lane & 7;
            *(LAS v4u*)(tl + row * 144 + pc * 16) = *(const v4u*)(s + (size_t)(r0 + row) * C + c0 + pc * 8); }
        LDS_WAIT(); asm volatile("" ::: "memory");
#pragma unroll
        for (int rr = 0; rr < 8; ++rr) { const int cc = rr * 8 + (lane >> 3), rp = (lane & 7) * 8;
            unsigned short e[8];
#pragma unroll
            for (int j = 0; j < 8; ++j) e[j] = *(const LAS unsigned short*)(tl + (rp + j) * 144 + cc * 2);
            v4u w; w.x = e[0] | ((unsigned)e[1] << 16); w.y = e[2] | ((unsigned)e[3] << 16); w.z = e[4] | ((unsigned)e[5] << 16); w.w = e[6] | ((unsigned)e[7] << 16);
            *(v4u*)(d + (size_t)(c0 + cc) * R + r0 + rp) = w; }
        LDS_WAIT(); asm volatile("" ::: "memory");
    }
}

typedef float f32x2 __attribute__((ext_vector_type(2)));
constexpr int AT_KP = 272, AT_VP = 136  , AT_KB = 64 * AT_KP, AT_VB = 128 * AT_VP, AT_V0 = 2 * AT_KB;
__device__ __forceinline__ void ph_attn(const Params& p, unsigned char* big, LAS unsigned char* lds, int tid, int lane, int wave, int vcu) {
    const bf16* QA = (const bf16*)(big + A0_QA); const bf16* KA = (const bf16*)(big + A0_KA); const bf16* VT = (const bf16*)(big + A0_VT); bf16* MIXIN = (bf16*)(big + A0_MIXIN);
    const int comp = wave >> 2, qw = wave & 3, r = lane & 31, hh = lane >> 5;
    float lam; { const float* lv = p.in[I_DLAM]; const float a = wave_sum(lv[lane] * lv[64 + lane]), b2 = wave_sum(lv[128 + lane] * lv[192 + lane]); lam = expf(a) - expf(b2) + 0.2f; }
#pragma unroll 1
    for (int unit = vcu; unit < 2048; unit += gridDim.x) {
        const int b = unit >> 6, h = (unit >> 4) & 3, qblk = unit & 15, q0 = qblk * 128 + qw * 32;
        const bf16* Kg = KA + (size_t)b * (SEQ + LC) * 512 + h * 128; const bf16* Vg = VT + ((size_t)b * 512 + h * 128) * (SEQ + LC);
        bf16x8 qf[4];
#pragma unroll
        for (int ds = 0; ds < 4; ++ds) qf[ds] = *(const bf16x8*)(QA + ((size_t)b * SEQ + q0 + r) * 512 + h * 128 + comp * 64 + ds * 16 + hh * 8);
        f32x16 oacc[4];
#pragma unroll
        for (int i = 0; i < 4; ++i)
#pragma unroll
            for (int q = 0; q < 16; ++q) oacc[i][q] = 0.f;
        float m_run = 0.f, l_run = 0.f;
        v4u pre[4];
#define AT_LOADG(kt) do { _Pragma("unroll") for (int q = 0; q < 2; ++q) { const int idx = tid + NTHR * q; \
            pre[q] = *(const v4u*)(Kg + (size_t)((kt) * 64 + (idx >> 4)) * 512 + (idx & 15) * 8); \
            pre[2 + q] = *(const v4u*)(Vg + (size_t)(idx >> 3) * (SEQ + LC) + (kt) * 64 + (idx & 7) * 8); } } while (0)
#define AT_STORES(kn) do { _Pragma("unroll") for (int q = 0; q < 2; ++q) { const int idx = tid + NTHR * q; \
            *(LAS v4u*)(lds + ((kn) & 1) * AT_KB + (idx >> 4) * AT_KP + (idx & 15) * 16) = pre[q]; \
            { LAS unsigned char* vd_ = lds + AT_V0 + ((kn) % 3) * AT_VB + (idx >> 3) * AT_VP + (idx & 7) * 16; v2u h0_, h1_; h0_.x = pre[2 + q].x; h0_.y = pre[2 + q].y; h1_.x = pre[2 + q].z; h1_.y = pre[2 + q].w; \
              *(LAS v2u*)vd_ = h0_; *(LAS v2u*)(vd_ + 8) = h1_; } } } while (0)
#define AT_PV(PF, VT_) do { const LAS unsigned char* Vt_ = (VT_); _Pragma("unroll") for (int kb = 0; kb < 2; ++kb) _Pragma("unroll") for (int s = 0; s < 2; ++s) _Pragma("unroll") for (int dvb = 0; dvb < 4; ++dvb) { \
            const LAS unsigned char* vp = Vt_ + (32 * dvb + r) * AT_VP + (32 * kb + 16 * s + 4 * hh) * 2; const u32x2 lo = *(const LAS u32x2*)vp, hi = *(const LAS u32x2*)(vp + 16); \
            u32x4 vw; vw.x = lo.x; vw.y = lo.y; vw.z = hi.x; vw.w = hi.y; oacc[dvb] = __builtin_amdgcn_mfma_f32_32x32x16_bf16(__builtin_bit_cast(bf16x8, vw), PF[kb][s], oacc[dvb], 0, 0, 0); } } while (0)
        bf16x8 phold[2][2];
        __syncthreads();
        AT_LOADG(0); AT_STORES(0);
        __syncthreads();
#pragma unroll 1
        for (int kt = 0; kt < 36; ++kt) {
            if (kt < 35) AT_LOADG(kt + 1);
            const LAS unsigned char* Kt = lds + (kt & 1) * AT_KB;
            if (comp == 1 && kt > 0) { AT_PV(phold, lds + AT_V0 + ((kt - 1) % 3) * AT_VB); }
            f32x16 sacc[2];
#pragma unroll
            for (int kb = 0; kb < 2; ++kb)
#pragma unroll
                for (int q = 0; q < 16; ++q) sacc[kb][q] = -m_run;
#pragma unroll
            for (int ds = 0; ds < 4; ++ds)
#pragma unroll
                for (int kb = 0; kb < 2; ++kb) { const bf16x8 kf = *(const LAS bf16x8*)(Kt + (32 * kb + r) * AT_KP + comp * 128 + ds * 32 + hh * 16);
                    sacc[kb] = __builtin_amdgcn_mfma_f32_32x32x16_bf16(kf, qf[ds], sacc[kb], 0, 0, 0); }
            float mx = sacc[0][0];
#pragma unroll
            for (int kb = 0; kb < 2; ++kb)
#pragma unroll
                for (int q = 0; q < 16; ++q) mx = fmaxf(mx, sacc[kb][q]);
            mx = fmaxf(mx, shx(mx, 32));
            if (kt == 0 || __builtin_amdgcn_ballot_w64(mx > 0.f) != 0ull) {
                const float dm = kt == 0 ? mx : fmaxf(mx, 0.f), alpha = __builtin_amdgcn_exp2f(-dm); m_run += dm; l_run *= alpha;
#pragma unroll
                for (int kb = 0; kb < 2; ++kb) sacc[kb] = sacc[kb] - dm;
#pragma unroll
                for (int i = 0; i < 4; ++i) oacc[i] = oacc[i] * alpha; }
            f32x2 ps2 = (f32x2){0.f, 0.f};
#pragma unroll
            for (int kb = 0; kb < 2; ++kb)
#pragma unroll
                for (int q = 0; q < 8; ++q) { f32x2 e; e.x = __builtin_amdgcn_exp2f(sacc[kb][2 * q]); e.y = __builtin_amdgcn_exp2f(sacc[kb][2 * q + 1]); sacc[kb][2 * q] = e.x; sacc[kb][2 * q + 1] = e.y; ps2 += e; }
            l_run += ps2.x + ps2.y;
#pragma unroll
            for (int kb = 0; kb < 2; ++kb)
#pragma unroll
                for (int s = 0; s < 2; ++s) {
                    u32x4 pw; pw.x = cvt_pk_bf16(sacc[kb][8 * s + 0], sacc[kb][8 * s + 1]); pw.y = cvt_pk_bf16(sacc[kb][8 * s + 2], sacc[kb][8 * s + 3]);
                    pw.z = cvt_pk_bf16(sacc[kb][8 * s + 4], sacc[kb][8 * s + 5]); pw.w = cvt_pk_bf16(sacc[kb][8 * s + 6], sacc[kb][8 * s + 7]);
                    phold[kb][s] = __builtin_bit_cast(bf16x8, pw); }
            if (comp == 0) { AT_PV(phold, lds + AT_V0 + (kt % 3) * AT_VB); }
            if (kt < 35) AT_STORES(kt + 1);
            __syncthreads();
        }
        if (comp == 1) { AT_PV(phold, lds + AT_V0 + (35 % 3) * AT_VB); }
        __syncthreads();
#undef AT_LOADG
#undef AT_STORES
#undef AT_PV
        const float lsum = l_run + shx(l_run, 32), inv = 1.f / lsum;
        LAS float* X = (LAS float*)lds;
        if (comp == 1) {
#pragma unroll
            for (int dvb = 0; dvb < 4; ++dvb)
#pragma unroll
                for (int q = 0; q < 16; ++q) X[(qw * 64 + dvb * 16 + q) * 64 + lane] = oacc[dvb][q] * inv; }
        __syncthreads();
        if (comp == 0) {
            float ss = 0.f;
#pragma unroll
            for (int dvb = 0; dvb < 4; ++dvb)
#pragma unroll
                for (int q = 0; q < 16; ++q) { const float o = oacc[dvb][q] * inv - lam * X[(qw * 64 + dvb * 16 + q) * 64 + lane]; oacc[dvb][q] = o; ss += o * o; }
            ss += shx(ss, 32);
            const float rn = rsqrtf(ss * (1.f / 128.f) + RMS_EPS) * 0.8f;
            const float* ga = p.in[I_HGA] + h * 128; bf16* orow = MIXIN + ((size_t)b * SEQ + q0 + r) * D + h * 128;
#pragma unroll
            for (int dvb = 0; dvb < 4; ++dvb)
#pragma unroll
                for (int g = 0; g < 4; ++g) { const int dv = 32 * dvb + 8 * g + 4 * hh; const f32x4 gg = *(const f32x4*)(ga + dv);
                    v2u w; w.x = pk2(oacc[dvb][4 * g + 0] * rn * gg[0], oacc[dvb][4 * g + 1] * rn * gg[1]); w.y = pk2(oacc[dvb][4 * g + 2] * rn * gg[2], oacc[dvb][4 * g + 3] * rn * gg[3]);
                    *(v2u*)(orow + dv) = w; }
        }
    }
    __syncthreads();
}

constexpr int ML_P = 272, ML_TILE = 64 * ML_P;
constexpr int ML_VOFF = 3 * ML_TILE, ML_VSZ = 64 * 256;
constexpr int ML_RQ = ML_VOFF + 2 * ML_VSZ, ML_RSZ = 68 * 256, ML_RK = ML_RQ + ML_RSZ;
constexpr int ML_NOFF = ML_RK + ML_RSZ, ML_AOFF = ML_NOFF + 2 * 512;
constexpr int ML_CW = ML_AOFF + 8 * 256;
static_assert(ML_CW + 8 * 512 <= LDS_TAB, "mLSTM LDS map");
typedef short s16x4 __attribute__((ext_vector_type(4)));
__device__ __forceinline__ u32x2 tr16(const LAS unsigned char* p) { return __builtin_bit_cast(u32x2, __builtin_amdgcn_ds_read_tr16_b64_v4i16((LAS s16x4*)p)); }
__device__ __forceinline__ float logsigmoidf_(float x) { return x >= 0.f ? -__logf(1.f + __expf(-x)) : x - __logf(1.f + __expf(x)); }
__device__ __forceinline__ bf16x8 pack8(const f32x16& v, int s) { u32x4 w; w.x = cvt_pk_bf16(v[8 * s + 0], v[8 * s + 1]); w.y = cvt_pk_bf16(v[8 * s + 2], v[8 * s + 3]); w.z = cvt_pk_bf16(v[8 * s + 4], v[8 * s + 5]); w.w = cvt_pk_bf16(v[8 * s + 6], v[8 * s + 7]); return __builtin_bit_cast(bf16x8, w); }
__device__ __forceinline__ void ph_mlstm(const Params& p, unsigned char* big, LAS unsigned char* lds, int tid, int lane, int wave) {
    const int bid = blockIdx.x; if (bid >= 256) return;
    const int b = bid >> 3, h = (bid >> 1) & 3, dir = bid & 1;
    const bf16* BQ = (const bf16*)(big + A0_BQ) + (size_t)b * SEQ * 512 + h * 128;
    const bf16* BK = (const bf16*)(big + A0_BK) + (size_t)b * (SEQ + LC) * 512 + h * 128;
    const bf16* BV = (const bf16*)(big + A0_BV) + (size_t)b * (SEQ + LC) * 512 + h * 128;
    bf16* HB = (bf16*)(big + A0_HB) + (size_t)dir * T * 512 + (size_t)b * SEQ * 512 + h * 128;
    const float* GT = (const float*)(p.ws + WS_GATES);
    const float* cw = p.in[I_CONVABW]; const float* cb = p.in[I_CONVABB];
    const int eb = wave & 3, tb = wave >> 2, r = lane & 31, hh = lane >> 5;
    const int blk = (lane >> 4) & 1, tq = (lane & 15) >> 2, tp = lane & 3;
    LAS float* nbuf = (LAS float*)(lds + ML_NOFF); LAS float* aw = (LAS float*)(lds + ML_AOFF) + wave * 64;
    if (tid < 256) nbuf[tid] = 0.f;
    LAS float* cwl = (LAS float*)(lds + ML_CW);
    for (int i = tid; i < 1024; i += NTHR) { const int ten = i >> 9, j = (i >> 7) & 3, d = i & 127, ch = ten * 512 + h * 128 + d; cwl[i] = j < 3 ? cw[j * 1024 + ch] : cb[ch]; }
    f32x16 cacc[4];
#pragma unroll
    for (int i = 0; i < 4; ++i)
#pragma unroll
        for (int q = 0; q < 16; ++q) cacc[i][q] = 0.f;
    float m_state = 0.f;
#ifdef ML_PROBE
    unsigned long long accs[6] = {0, 0, 0, 0, 0, 0}; unsigned long long tp0 = __builtin_amdgcn_s_memrealtime();
#define ML_T(i) do { const unsigned long long t1_ = __builtin_amdgcn_s_memrealtime(); accs[i] += t1_ - tp0; tp0 = t1_; } while (0)
#else
#define ML_T(i)
#endif
    float a_c = 0.f, M_c = 0.f, b_c = 0.f, decay_c = 1.f, m_after = 0.f;
    float a_n = 0.f, M_n = 0.f, b_n = 0.f, w_n = 0.f, decay_n = 1.f, m_next = 0.f;
#define ML_POS(cc, t) ((cc) < 4 ? (dir ? 255 - ((cc) * 64 + (t)) : (cc) * 64 + (t)) : (dir ? 2047 - (((cc) - 4) * 64 + (t)) : ((cc) - 4) * 64 + (t)))
#define ML_GLOAD(cc, li_, fp_) do { const int pos_ = ML_POS(cc, lane); const size_t grow_ = (cc) < 4 ? (size_t)T + b * LC + pos_ : (size_t)b * SEQ + pos_; \
        li_ = GT[grow_ * 16 + dir * 8 + h]; fp_ = GT[grow_ * 16 + dir * 8 + 4 + h]; } while (0)
#define ML_SCAN(li_, fp_, m_in) do { const float lf_ = logsigmoidf_(fp_); \
        float bs_ = lf_; _Pragma("unroll") for (int o_ = 1; o_ < 64; o_ <<= 1) { const float v_ = shup(bs_, o_); if (lane >= o_) bs_ += v_; } \
        const float aa_ = (li_) - bs_; float pm_ = aa_; _Pragma("unroll") for (int o_ = 1; o_ < 64; o_ <<= 1) { const float v_ = shup(pm_, o_); if (lane >= o_) pm_ = fmaxf(pm_, v_); } \
        const float MM_ = fmaxf(m_in, pm_); const float M63_ = shidx(MM_, 63), b63_ = shidx(bs_, 63); \
        a_n = aa_; M_n = MM_; b_n = bs_; w_n = __expf(aa_ - M63_); decay_n = __expf((m_in) - M63_); m_next = b63_ + M63_; } while (0)
#define ML_DMA(cc, vbuf) do { const int lim_ = (cc) < 4 ? LC : SEQ, kvb_ = (cc) < 4 ? 0 : LC; \
        _Pragma("unroll 1") for (int ins_ = wave; ins_ < 17; ins_ += NWAVES) { const int rr_ = ins_ * 4 + (lane >> 4), pc_ = lane & 15; int pos_ = ML_POS(cc, rr_ - 1); pos_ = pos_ < 0 ? 0 : (pos_ >= lim_ ? lim_ - 1 : pos_); \
            __builtin_amdgcn_global_load_lds((const unsigned*)(BK + (size_t)(kvb_ + pos_) * 512 + pc_ * 8), (LAS unsigned*)(lds + ML_RK + ins_ * 1024), 16, 0, 0); \
            if ((cc) >= 4) __builtin_amdgcn_global_load_lds((const unsigned*)(BQ + (size_t)pos_ * 512 + pc_ * 8), (LAS unsigned*)(lds + ML_RQ + ins_ * 1024), 16, 0, 0); } \
        _Pragma("unroll") for (int q_ = 0; q_ < 2; ++q_) { const int ins_ = wave * 2 + q_, t_ = ins_ * 4 + (lane >> 4), pc_ = lane & 15; const int pos_ = ML_POS(cc, t_); \
            __builtin_amdgcn_global_load_lds((const unsigned*)(BV + (size_t)(kvb_ + pos_) * 512 + pc_ * 8), (LAS unsigned*)(lds + ML_VOFF + (vbuf) * ML_VSZ + ins_ * 1024), 16, 0, 0); } } while (0)
#define ML_CONV8(dst, rawoff, cc, t_, d8_, ten, scl) do { const int pos_ = ML_POS(cc, t_), lim_ = (cc) < 4 ? LC : SEQ; const int rm_ = dir ? (t_) + 2 : (t_), rp_ = dir ? (t_) : (t_) + 2; \
        v4u x_[3]; x_[0] = *(const LAS v4u*)(lds + (rawoff) + rm_ * 256 + (d8_) * 16); x_[1] = *(const LAS v4u*)(lds + (rawoff) + ((t_) + 1) * 256 + (d8_) * 16); x_[2] = *(const LAS v4u*)(lds + (rawoff) + rp_ * 256 + (d8_) * 16); \
        if (pos_ - 1 < 0) x_[0] = (v4u){0u, 0u, 0u, 0u}; if (pos_ + 1 >= lim_) x_[2] = (v4u){0u, 0u, 0u, 0u}; \
        const LAS float* wl_ = cwl + (ten) * 512 + (d8_) * 8; f32x4 wv_[4][2]; \
        _Pragma("unroll") for (int j_ = 0; j_ < 4; ++j_) { wv_[j_][0] = *(const LAS f32x4*)(wl_ + j_ * 128); wv_[j_][1] = *(const LAS f32x4*)(wl_ + j_ * 128 + 4); } \
        _Pragma("unroll") for (int e_ = 0; e_ < 8; ++e_) { float s_ = wv_[3][e_ >> 2][e_ & 3]; \
            _Pragma("unroll") for (int j_ = 0; j_ < 3; ++j_) { const unsigned w_ = e_ < 2 ? x_[j_].x : e_ < 4 ? x_[j_].y : e_ < 6 ? x_[j_].z : x_[j_].w; s_ += wv_[j_][e_ >> 2][e_ & 3] * ((e_ & 1) ? bf_hi(w_) : bf_lo(w_)); } \
            dst[e_] = __fdividef(s_, 1.f + __expf(-s_)) * (scl); } } while (0)
#define ML_BUILD(cc) do { _Pragma("unroll 1") for (int q_ = 0; q_ < 2; ++q_) { const int idx_ = tid + NTHR * q_, t_ = idx_ >> 4, d8_ = idx_ & 15; \
        float kk_[8]; ML_CONV8(kk_, ML_RK, cc, t_, d8_, 1, 1.f); const float wt_ = shidx(w_n, t_); \
        v4u o_; o_.x = pk2(kk_[0], kk_[1]); o_.y = pk2(kk_[2], kk_[3]); o_.z = pk2(kk_[4], kk_[5]); o_.w = pk2(kk_[6], kk_[7]); *(LAS v4u*)(lds + ML_TILE + t_ * ML_P + d8_ * 16) = o_; \
        o_.x = pk2(kk_[0] * wt_, kk_[1] * wt_); o_.y = pk2(kk_[2] * wt_, kk_[3] * wt_); o_.z = pk2(kk_[4] * wt_, kk_[5] * wt_); o_.w = pk2(kk_[6] * wt_, kk_[7] * wt_); *(LAS v4u*)(lds + 2 * ML_TILE + t_ * ML_P + d8_ * 16) = o_; \
        if ((cc) >= 4) { float qq_[8]; ML_CONV8(qq_, ML_RQ, cc, t_, d8_, 0, 0.08838834764831845f); \
            o_.x = pk2(qq_[0], qq_[1]); o_.y = pk2(qq_[2], qq_[3]); o_.z = pk2(qq_[4], qq_[5]); o_.w = pk2(qq_[6], qq_[7]); *(LAS v4u*)(lds + t_ * ML_P + d8_ * 16) = o_; } } } while (0)
    __syncthreads();
    { float li0, fp0; ML_GLOAD(0, li0, fp0); ML_DMA(0, 0); ML_SCAN(li0, fp0, m_state); }
    asm volatile("s_waitcnt vmcnt(0)" ::: "memory");
    __syncthreads();
    ML_BUILD(0);
    a_c = a_n; M_c = M_n; b_c = b_n; decay_c = decay_n; m_after = m_next;
    __syncthreads();
#pragma unroll 1
    for (int cc = 0; cc < 36; ++cc) {
        const LAS unsigned char* Qs = lds; const LAS unsigned char* Ks = lds + ML_TILE; const LAS unsigned char* Kw = lds + 2 * ML_TILE; const LAS unsigned char* Vs = lds + ML_VOFF + (cc & 1) * ML_VSZ;
        const LAS float* ncur = nbuf + (cc & 1) * 128; LAS float* nnew = nbuf + ((cc + 1) & 1) * 128;
        float li1 = 0.f, fp1 = 0.f;
        ML_T(5);
        if (cc < 35) { ML_GLOAD(cc + 1, li1, fp1); ML_DMA(cc + 1, (cc + 1) & 1); }
        ML_T(0);
        if (cc >= 4) {
            aw[lane] = a_c;
            const int tcol = 32 * tb + r; const float Mt = shidx(M_c, tcol), bt = shidx(b_c, tcol);
            f32x16 nacc;
#pragma unroll
            for (int q = 0; q < 16; ++q) nacc[q] = 0.f;
#pragma unroll
            for (int db = 0; db < 4; ++db)
#pragma unroll
                for (int s2 = 0; s2 < 2; ++s2) { const LAS unsigned char* qp = Qs + tcol * ML_P + (32 * db + 16 * s2 + 4 * hh) * 2; const u32x2 lo = *(const LAS u32x2*)qp, hi = *(const LAS u32x2*)(qp + 16);
                    u32x4 qw; qw.x = lo.x; qw.y = lo.y; qw.z = hi.x; qw.w = hi.y;
                    nacc = __builtin_amdgcn_mfma_f32_32x32x16_bf16(pack8(cacc[db], s2), __builtin_bit_cast(bf16x8, qw), nacc, 0, 0, 0); }
            const float sc = __expf(m_state - Mt);
            nacc = nacc * sc;
            float rs = 0.f;
#pragma unroll
            for (int sb = 0; sb < 2; ++sb) if (sb <= tb) {
                f32x16 sacc;
#pragma unroll
                for (int q = 0; q < 16; ++q) sacc[q] = 0.f;
#pragma unroll
                for (int ds = 0; ds < 8; ++ds) { const bf16x8 kf = *(const LAS bf16x8*)(Ks + (32 * sb + r) * ML_P + (16 * ds + 8 * hh) * 2), qf = *(const LAS bf16x8*)(Qs + tcol * ML_P + (16 * ds + 8 * hh) * 2);
                    sacc = __builtin_amdgcn_mfma_f32_32x32x16_bf16(kf, qf, sacc, 0, 0, 0); }
#pragma unroll
                for (int g = 0; g < 4; ++g) { const int s0 = 32 * sb + 8 * g + 4 * hh; const f32x4 av = *(const LAS f32x4*)(aw + s0);
#pragma unroll
                    for (int j = 0; j < 4; ++j) { const bool keep = (s0 + j) <= tcol; const float v = keep ? sacc[4 * g + j] * __expf(av[j] - Mt) : 0.f; sacc[4 * g + j] = v; rs += v; } }
#pragma unroll
                for (int s2 = 0; s2 < 2; ++s2) { u32x4 vw;
                    { const u32x2 t0 = tr16(Vs + (32 * sb + 16 * s2 + 4 * hh + tq) * 256 + (32 * eb + 16 * blk + 4 * tp) * 2), t1 = tr16(Vs + (32 * sb + 16 * s2 + 8 + 4 * hh + tq) * 256 + (32 * eb + 16 * blk + 4 * tp) * 2);
                      vw.x = t0.x; vw.y = t0.y; vw.z = t1.x; vw.w = t1.y; }
                    nacc = __builtin_amdgcn_mfma_f32_32x32x16_bf16(__builtin_bit_cast(bf16x8, vw), pack8(sacc, s2), nacc, 0, 0, 0); } }
            rs += shx(rs, 32);
            float qn = 0.f;
            { const LAS unsigned char* qp = Qs + tcol * ML_P + (64 * hh) * 2;
#pragma unroll
              for (int c8 = 0; c8 < 8; ++c8) { const v4u w = *(const LAS v4u*)(qp + c8 * 16); const f32x4 n0 = *(const LAS f32x4*)(ncur + 64 * hh + 8 * c8), n1 = *(const LAS f32x4*)(ncur + 64 * hh + 8 * c8 + 4);
                  qn += bf_lo(w.x) * n0[0] + bf_hi(w.x) * n0[1] + bf_lo(w.y) * n0[2] + bf_hi(w.y) * n0[3] + bf_lo(w.z) * n1[0] + bf_hi(w.z) * n1[1] + bf_lo(w.w) * n1[2] + bf_hi(w.w) * n1[3]; } }
            qn += shx(qn, 32);
            const float den = sc * qn + rs; const float dd = __frcp_rn(fmaxf(fabsf(den), __expf(-(bt + Mt))));
            { const int pos = ML_POS(cc, tcol); bf16* hrow = HB + (size_t)pos * 512 + 32 * eb;
#pragma unroll
              for (int g = 0; g < 4; ++g) { v2u w; w.x = pk2(nacc[4 * g + 0] * dd, nacc[4 * g + 1] * dd); w.y = pk2(nacc[4 * g + 2] * dd, nacc[4 * g + 3] * dd); *(v2u*)(hrow + 8 * g + 4 * hh) = w; } }
        }
        ML_T(1);
#pragma unroll
        for (int db = 0; db < 4; ++db) { cacc[db] = cacc[db] * decay_c;
#pragma unroll
            for (int s4 = 0; s4 < 4; ++s4) { u32x4 ka, vb;
                { const u32x2 t0 = tr16(Kw + (16 * s4 + 8 * hh + tq) * ML_P + (32 * db + 16 * blk + 4 * tp) * 2), t1 = tr16(Kw + (16 * s4 + 8 * hh + 4 + tq) * ML_P + (32 * db + 16 * blk + 4 * tp) * 2);
                  ka.x = t0.x; ka.y = t0.y; ka.z = t1.x; ka.w = t1.y; }
                { const u32x2 t0 = tr16(Vs + (16 * s4 + 8 * hh + tq) * 256 + (32 * eb + 16 * blk + 4 * tp) * 2), t1 = tr16(Vs + (16 * s4 + 8 * hh + 4 + tq) * 256 + (32 * eb + 16 * blk + 4 * tp) * 2);
                  vb.x = t0.x; vb.y = t0.y; vb.z = t1.x; vb.w = t1.y; }
                cacc[db] = __builtin_amdgcn_mfma_f32_32x32x16_bf16(__builtin_bit_cast(bf16x8, ka), __builtin_bit_cast(bf16x8, vb), cacc[db], 0, 0, 0); } }
        { const int d = tid >> 2, part = tid & 3; float s = 0.f;
#pragma unroll
            for (int t = 0; t < 16; ++t) s += bf1(*(const LAS bf16*)(Kw + (part * 16 + t) * ML_P + d * 2));
            s += shx(s, 1); s += shx(s, 2);
            if (part == 0) nnew[d] = decay_c * ncur[d] + s; }
        m_state = m_after;
        ML_T(2);
        asm volatile("s_waitcnt vmcnt(0)" ::: "memory");
        __syncthreads();
        ML_T(3);
        if (cc < 35) { ML_SCAN(li1, fp1, m_state); ML_BUILD(cc + 1); a_c = a_n; M_c = M_n; b_c = b_n; decay_c = decay_n; m_after = m_next; }
        ML_T(4);
        __syncthreads();
    }
#ifdef ML_PROBE
    if (blockIdx.x == 0 && tid == 0) { unsigned long long* ts = (unsigned long long*)(p.ws + WS_CTL + 32768); ts[50] = 0; unsigned long long c_ = 0; for (int i = 0; i < 6; ++i) { c_ += accs[i]; ts[51 + i] = c_; } }
#endif
#undef ML_T
#undef ML_POS
#undef ML_GLOAD
#undef ML_SCAN
#undef ML_DMA
#undef ML_CONV8
#undef ML_BUILD
}
__device__ __forceinline__ void ph_outb(const Params& p, unsigned char* big, int lane, int wave, int tile) {
    const int gw = tile * NWAVES + wave;
    const bf16* HBf = (const bf16*)(big + A0_HB); const bf16* HBb = HBf + (size_t)T * 512; const bf16* BO = (const bf16*)(big + A0_BO); bf16* MIXIN = (bf16*)(big + A0_MIXIN);
    const float* gb = p.in[I_HGB];
    const f32x4 g0 = *(const f32x4*)(gb + lane * 8), g1 = *(const f32x4*)(gb + lane * 8 + 4);
#pragma unroll 2
    for (int m = gw * 32; m < gw * 32 + 32; ++m) {
        const v4u f = *(const v4u*)(HBf + (size_t)m * 512 + lane * 8), bw = *(const v4u*)(HBb + (size_t)m * 512 + lane * 8), go = *(const v4u*)(BO + (size_t)m * 512 + lane * 8);
        float x[8], o[8]; x[0] = bf_lo(f.x) + bf_lo(bw.x); x[1] = bf_hi(f.x) + bf_hi(bw.x); x[2] = bf_lo(f.y) + bf_lo(bw.y); x[3] = bf_hi(f.y) + bf_hi(bw.y);
        x[4] = bf_lo(f.z) + bf_lo(bw.z); x[5] = bf_hi(f.z) + bf_hi(bw.z); x[6] = bf_lo(f.w) + bf_lo(bw.w); x[7] = bf_hi(f.w) + bf_hi(bw.w);
        o[0] = bf_lo(go.x); o[1] = bf_hi(go.x); o[2] = bf_lo(go.y); o[3] = bf_hi(go.y); o[4] = bf_lo(go.z); o[5] = bf_hi(go.z); o[6] = bf_lo(go.w); o[7] = bf_hi(go.w);
        float ss = 0.f;
#pragma unroll
        for (int j = 0; j < 8; ++j) ss += x[j] * x[j];
        ss += shx(ss, 1); ss += shx(ss, 2); ss += shx(ss, 4); ss += shx(ss, 8);
        const float rn = rsqrtf(ss * (1.f / 128.f) + RMS_EPS);
        float y[8];
#pragma unroll
        for (int j = 0; j < 8; ++j) y[j] = x[j] * rn * (j < 4 ? g0[j] : g1[j - 4]) * sigmoidf_(o[j]);
        v4u w; w.x = pk2(y[0], y[1]); w.y = pk2(y[2], y[3]); w.z = pk2(y[4], y[5]); w.w = pk2(y[6], y[7]);
        *(v4u*)(MIXIN + (size_t)m * D + 512 + lane * 8) = w;
    }
}

constexpr int CW_DBG = 16;
#ifndef DBG_MODE
#define DBG_MODE 0
#endif
#ifndef DBG_L
#define DBG_L 0
#endif
#ifndef DBG_CH
#define DBG_CH 0
#endif
__device__ __forceinline__ void dbg_report(const Params& p, float d) {
    if (!(d >= 0.f)) d = 1.0e6f;
    atomicMax((unsigned*)(p.ws + WS_CTL) + CW_DBG, __float_as_uint(d));
}
__device__ __forceinline__ float block_max(float v, LAS float* red, int tid) { v = wave_max(v); __syncthreads(); if ((tid & 63) == 0) red[tid >> 6] = v; __syncthreads(); float r = red[0];
#pragma unroll
    for (int w = 1; w < 8; ++w) r = fmaxf(r, red[w]); __syncthreads(); return r; }
__device__ __forceinline__ float block_sum(float v, LAS float* red, int tid) { v = wave_sum(v); __syncthreads(); if ((tid & 63) == 0) red[tid >> 6] = v; __syncthreads(); float r = 0.f;
#pragma unroll
    for (int w = 0; w < 8; ++w) r += red[w]; __syncthreads(); return r; }
__device__ __forceinline__ void dbg_moe_check(const Params& p, int l, int ch, const bf16* H2, const bf16* Y, LAS unsigned char* lds, int tid) {
    LAS float* hrow = (LAS float*)lds; LAS float* gu = hrow + 1024; LAS float* a = gu + 512; LAS float* red = a + 256;
    const int t = ch * CHT + blockIdx.x * 64 + 5;
    __syncthreads();
    for (int i = tid; i < 1024; i += NTHR) hrow[i] = bf1(H2[(size_t)t * D + i]);
    __syncthreads();
    const int* EIDX = (const int*)(p.ws + WS_EIDX); const float* WTS = (const float*)(p.ws + WS_WTS); const int* PSLOT = (const int*)(p.ws + WS_PSLOT);
    float yacc[2] = {0.f, 0.f};
#pragma unroll 1
    for (int k = 0; k < 9; ++k) {
        const int e = k < 8 ? (EIDX[(size_t)t * 8 + k] & 255) : 64; const float w = k < 8 ? WTS[(size_t)t * 8 + k] : 1.f;
        const float* Wgu = e < 64 ? p.in[I_EGU] + (size_t)(l * 64 + e) * 1024 * 512 : p.in[I_SGU] + (size_t)l * 1024 * 512;
        const float* Wdn = e < 64 ? p.in[I_EDN] + (size_t)(l * 64 + e) * 256 * 1024 : p.in[I_SDN] + (size_t)l * 256 * 1024;
        float s = 0.f;
#pragma unroll 4
        for (int kk = 0; kk < 1024; ++kk) s += hrow[kk] * Wgu[(size_t)kk * 512 + tid];
        gu[tid] = s;
        __syncthreads();
        if (tid < 256) a[tid] = siluf_(gu[tid]) * gu[256 + tid];
        __syncthreads();
#pragma unroll
        for (int q = 0; q < 2; ++q) { const int n = tid + 512 * q; float s2 = 0.f;
#pragma unroll 4
            for (int j = 0; j < 256; ++j) s2 += a[j] * Wdn[(size_t)j * 1024 + n];
            yacc[q] += w * s2; }
        __syncthreads();
    }
    float err = 0.f, ss = 0.f;
#pragma unroll
    for (int q = 0; q < 2; ++q) { const int n = tid + 512 * q; float f = 0.f;
#pragma unroll 1
        for (int k = 0; k < 9; ++k) { const int slot = PSLOT[(size_t)t * 16 + k]; const float w = k < 8 ? WTS[(size_t)t * 8 + k] : 1.f; f += w * bf1(Y[(size_t)slot * D + n]); }
        err = fmaxf(err, fabsf(f - yacc[q])); ss += yacc[q] * yacc[q]; }
    const float me = block_max(err, red, tid), sq = block_sum(ss, red, tid);
    if (tid == 0) dbg_report(p, me / sqrtf(sq * (1.f / 1024.f) + 1e-30f));
}
__device__ __forceinline__ void dbg_route_check(const Params& p, int l, const bf16* H2, const float* LOG, LAS unsigned char* lds, int tid) {
    LAS float* hrow = (LAS float*)lds; LAS float* lg = hrow + 1024; LAS float* bi = lg + 64; LAS float* sc = bi + 64; LAS float* red = sc + 64;
    const int t = blockIdx.x * 256 + 77;
    __syncthreads();
    for (int i = tid; i < 1024; i += NTHR) hrow[i] = bf1(H2[(size_t)t * D + i]);
    __syncthreads();
    if (tid < 64) { float s = 0.f; const float* W = p.in[I_RW] + (size_t)l * 1024 * 64;
#pragma unroll 4
        for (int k = 0; k < 1024; ++k) s += hrow[k] * W[k * 64 + tid];
        lg[tid] = s; sc[tid] = 1.f / (1.f + expf(-s)); bi[tid] = sc[tid] + p.in[I_RB][l * 64 + tid]; }
    __syncthreads();
    if (tid == 0) {
        float lerr = 0.f;
#pragma unroll 1
        for (int e = 0; e < 64; ++e) lerr = fmaxf(lerr, fabsf(lg[e] - LOG[(size_t)t * 64 + e]));
        float grp[8];
#pragma unroll
        for (int g = 0; g < 8; ++g) { float a = -1e30f, b = -1e30f;
#pragma unroll 1
            for (int j = 0; j < 8; ++j) { const float v = bi[g * 8 + j]; if (v > a) { b = a; a = v; } else if (v > b) b = v; } grp[g] = a + b; }
        unsigned gm = 0;
#pragma unroll 1
        for (int r = 0; r < 4; ++r) { int best = -1; float bv = 0.f;
#pragma unroll
            for (int g = 0; g < 8; ++g) if (!((gm >> g) & 1u) && (best < 0 || grp[g] > bv)) { best = g; bv = grp[g]; }
            gm |= 1u << best; }
        unsigned long long set_ref = 0ull; float ssum = 0.f;
#pragma unroll 1
        for (int r = 0; r < 8; ++r) { int best = -1; float bv = 0.f;
#pragma unroll 1
            for (int e = 0; e < 64; ++e) if (((gm >> (e >> 3)) & 1u) && !((set_ref >> e) & 1ull) && (best < 0 || bi[e] > bv)) { best = e; bv = bi[e]; }
            set_ref |= 1ull << best; ssum += sc[best]; }
        const int* EIDX = (const int*)(p.ws + WS_EIDX); const float* WTS = (const float*)(p.ws + WS_WTS);
        unsigned long long set_f = 0ull; float werr = 0.f, wsum = 0.f;
#pragma unroll 1
        for (int k = 0; k < 8; ++k) { const int e = EIDX[(size_t)t * 8 + k] & 255; set_f |= 1ull << e; const float wr = 2.5f * sc[e] / ssum; werr = fmaxf(werr, fabsf(wr - WTS[(size_t)t * 8 + k])); wsum += WTS[(size_t)t * 8 + k]; }
        float d = 0.f;
        if (DBG_MODE == 0) d = (set_f != set_ref) ? (1.f / 256.f) : 0.f;
        if (DBG_MODE == 1) d = (set_f != set_ref) ? 0.f : werr + fabsf(wsum - 2.5f);
        if (DBG_MODE == 2) d = lerr * (1.f / 256.f);
        atomicAdd((float*)((unsigned*)(p.ws + WS_CTL) + CW_DBG), d);
    }
    __syncthreads();
}
__device__ __forceinline__ unsigned dbg_hash(unsigned x) { x ^= x >> 16; x *= 0x7feb352du; x ^= x >> 15; x *= 0x846ca68bu; x ^= x >> 16; return x; }
__device__ __forceinline__ void dbg_report_wave(const Params& p, float d, int lane) { if (lane == 0) dbg_report(p, d); }
__device__ __forceinline__ void dbg_hyena_check(const Params& p, int mode, const bf16* HN, const bf16* UC, const bf16* ZT, const bf16* Y2T, const bf16* MIX, LAS unsigned char* lds, int lane, int wave) {
    const unsigned hsh = dbg_hash(blockIdx.x * 8u + wave + 12345u), h2 = dbg_hash(hsh), h3 = dbg_hash(h2);
    const bf16* FILT = (const bf16*)(p.ws + WS_FILT);
    float d = 0.f;
    if (mode == 0) {
        const int c = hsh % 3072u, b = h2 % 32u, s = h3 % 2048u; float acc = 0.f;
#pragma unroll 1
        for (int k = lane; k < 1024; k += 64) acc += bf1(HN[(size_t)(b * 2048 + s) * D + k]) * p.in[I_WINHY][(size_t)k * 3072 + c];
        acc = wave_sum(acc);
        const float got = bf1(UC[(size_t)c * T + b * 2048 + s]); d = fabsf(got - acc) / (fabsf(acc) + 0.1f);
    } else if (mode == 5) {
        const int c = hsh % 3072u, b = h2 % 32u; int s = h3 % 2048u; if ((h3 >> 20) % 8u == 0u) s = 0; if ((h3 >> 20) % 8u == 1u) s = 2047;
        float val = p.in[I_CONVHYB][c];
#pragma unroll 1
        for (int j = 0; j < 3; ++j) { const int sj = s + j - 1; if (sj < 0 || sj > 2047) continue; val += p.in[I_CONVHYW][j * 3072 + c] * bf1(ZT[(size_t)c * T + b * 2048 + sj]); }
        const float got = bf1(UC[(size_t)c * T + b * 2048 + s]); d = fabsf(got - val) / (fabsf(val) + 0.1f);
    } else if (mode == 1) {
        LAS float* Z = (LAS float*)(lds + wave * 1024); LAS float* A1 = Z + 64; LAS float* A2 = A1 + 64;
        const int o = hsh & 1u, c = h2 % 1024u, j = h3 % 2048u;
        float z = 0.f; if (lane == 0) z = (float)j / 2047.f; else if (lane < 33) { const int k = (lane - 1) & 15; const float fr = 1e-4f + (float)k * ((15.f - 1e-4f) / 15.f); const float ang = (6.283185307179586f / 2048.f) * (float)j * fr; z = lane < 17 ? cosf(ang) : -sinf(ang); }
        Z[lane] = z; LDS_WAIT(); asm volatile("" ::: "memory");
        float a = p.in[I_FB1][lane];
#pragma unroll 1
        for (int k = 0; k < 33; ++k) a += Z[k] * p.in[I_FW1][k * 64 + lane];
        A1[lane] = sinf(a); LDS_WAIT(); asm volatile("" ::: "memory");
        a = p.in[I_FB2][lane];
#pragma unroll 1
        for (int k = 0; k < 64; ++k) a += A1[k] * p.in[I_FW2][k * 64 + lane];
        A2[lane] = sinf(a); LDS_WAIT(); asm volatile("" ::: "memory");
        float v = wave_sum(A2[lane] * p.in[I_FW3][lane * 2048 + o * 1024 + c]);
        const float mind = -4.605170185988091f / 1.5f, maxd = -4.605170185988091f / 0.3f; const float delta = fabsf(mind + (float)c * ((maxd - mind) / 1023.f));
        v *= expf(-fabsf((float)j - 1024.f) / 1024.f * delta);
        const float got = bf1(FILT[(size_t)(o * 1024 + c) * 2048 + j]); d = fabsf(got - v) / (fabsf(v) + 1e-4f);
    } else if (mode == 2 || mode == 3) {
        const int o = mode - 2, c = hsh % 1024u, b = h2 % 32u; int t = h3 % 2048u; if ((h3 >> 20) % 8u == 0u) t = 0; if ((h3 >> 20) % 8u == 1u) t = 2047;
        const bf16* in = (o == 0 ? UC : ZT) + (size_t)c * T + b * 2048; const bf16* f = FILT + (size_t)(o * 1024 + c) * 2048; float acc = 0.f;
#pragma unroll 1
        for (int s = lane; s < 2048; s += 64) { const int x = 1024 + t - s; if (x >= 0 && x <= 2047) acc += bf1(f[x]) * bf1(in[s]); }
        acc = wave_sum(acc);
        const float gate = bf1(UC[(size_t)((1 + o) * 1024 + c) * T + b * 2048 + t]);
        const float val = gate * (acc + bf1(in[t]) * p.in[I_FBIAS][o * 1024 + c]);
        const float got = bf1((o == 0 ? ZT : Y2T)[(size_t)c * T + b * 2048 + t]); d = fabsf(got - val) / (fabsf(val) + 0.1f);
    } else if (mode == 4) {
        const int tok = hsh % 65536u, n = h2 % 1024u; float acc = 0.f;
#pragma unroll 1
        for (int c = lane; c < 1024; c += 64) acc += bf1(Y2T[(size_t)c * T + tok]) * p.in[I_WOUTHY][(size_t)c * 1024 + n];
        acc = wave_sum(acc);
        const float got = bf1(MIX[(size_t)tok * D + n]); d = fabsf(got - acc) / (fabsf(acc) + 0.1f);
    }
    dbg_report_wave(p, d, lane);
}
__device__ __forceinline__ void dbg_inproj_check(const Params& p, unsigned char* big, int lane, int wave) {
    const unsigned hsh = dbg_hash(blockIdx.x * 8u + wave + 777u), h2 = dbg_hash(hsh);
    const bf16* H0 = (const bf16*)(big + A0_H); const float* W = p.in[I_WINAB];
    int m = hsh % (unsigned)TT; int n = h2 % 3600u;
    const bool ctx = m >= T; if (ctx && n < 1536) n += 1536;
    const int b = ctx ? (m - T) / LC : m / SEQ, s = ctx ? (m - T) % LC : m % SEQ;
    float x = 0.f, xp = 0.f; const bool rope_col = (n < 512) || (n >= 1536 && n < 2048); const int np = rope_col ? (n ^ 16) : n;
#pragma unroll 1
    for (int k = lane; k < 1024; k += 64) { const float hv = bf1(H0[(size_t)m * D + k]); x += hv * W[(size_t)k * 3600 + n]; xp += hv * W[(size_t)k * 3600 + np]; }
    x = wave_sum(x); xp = wave_sum(xp);
    float val = x, got = 0.f;
    if (n >= 3584) { val = x + p.in[I_GATEB][n - 3584]; got = ((const float*)(p.ws + WS_GATES))[(size_t)m * 16 + (n - 3584)]; }
    else { const int t = n / 512, cn = n % 512; int pc = cn;
        if (rope_col) { const int o = cn & 31; pc = (cn & ~31) + (((o & 15) >> 2) * 8 + (o >> 4) * 4 + (o & 3));
            if (!ctx) { const int d = cn & 63, axis = d >> 5, half = (d >> 4) & 1, i = d & 15; const float pos = (float)(axis == 0 ? (s >> 6) : (s & 63)); const float ang = pos * powf(10000.f, -(float)i / 16.f);
                val = half == 0 ? x * cosf(ang) - xp * sinf(ang) : x * cosf(ang) + xp * sinf(ang); } }
        if (t == 0) val *= QSCALE;
        const size_t offs[7] = {A0_QA, A0_BQ, A0_BO, A0_KA, A0_VA, A0_BK, A0_BV}; const bool kv = t >= 3;
        const bf16* O = (const bf16*)(big + offs[t]) + (size_t)b * (kv ? (SEQ + LC) : SEQ) * 512 + (size_t)((kv && !ctx) ? LC : 0) * 512;
        got = bf1(O[(size_t)s * 512 + pc]); }
    dbg_report_wave(p, fabsf(got - val) / (fabsf(val) + 0.1f), lane);
}
__device__ __forceinline__ void dbg_attn_check(const Params& p, unsigned char* big, LAS unsigned char* lds, int lane, int wave) {
    const unsigned hsh = dbg_hash(blockIdx.x * 8u + wave + 4242u), h2 = dbg_hash(hsh);
    const int b = hsh % 32u, h = (hsh >> 8) % 4u, q = h2 % 2048u;
    const bf16* QA = (const bf16*)(big + A0_QA) + ((size_t)b * SEQ + q) * 512 + h * 128; const bf16* KA = (const bf16*)(big + A0_KA) + (size_t)b * 2304 * 512 + h * 128;
    const bf16* VA = (const bf16*)(big + A0_VA) + (size_t)b * 2304 * 512 + h * 128; const bf16* MIXIN = (const bf16*)(big + A0_MIXIN) + ((size_t)b * SEQ + q) * D + h * 128;
    LAS float* Aw = (LAS float*)(lds + wave * 18432);
    const float* lv = p.in[I_DLAM]; const float lam = expf(wave_sum(lv[lane] * lv[64 + lane])) - expf(wave_sum(lv[128 + lane] * lv[192 + lane])) + 0.2f;
    float mx0 = -1e30f, mx1 = -1e30f;
#pragma unroll 1
    for (int key = lane; key < 2304; key += 64) { float s0 = 0.f, s1 = 0.f;
#pragma unroll 1
        for (int d = 0; d < 64; ++d) { s0 += bf1(QA[d]) * bf1(KA[(size_t)key * 512 + d]); s1 += bf1(QA[64 + d]) * bf1(KA[(size_t)key * 512 + 64 + d]); }
        Aw[key] = s0; Aw[2304 + key] = s1; mx0 = fmaxf(mx0, s0); mx1 = fmaxf(mx1, s1); }
    mx0 = wave_max(mx0); mx1 = wave_max(mx1);
    float l0 = 0.f, l1 = 0.f;
#pragma unroll 1
    for (int key = lane; key < 2304; key += 64) { const float e0 = exp2f(Aw[key] - mx0), e1 = exp2f(Aw[2304 + key] - mx1); Aw[key] = e0; Aw[2304 + key] = e1; l0 += e0; l1 += e1; }
    l0 = wave_sum(l0); l1 = wave_sum(l1);
    LDS_WAIT(); asm volatile("" ::: "memory");
    float o[2] = {0.f, 0.f};
#pragma unroll 1
    for (int key = 0; key < 2304; ++key) { const float a = Aw[key] / l0 - lam * Aw[2304 + key] / l1; o[0] += a * bf1(VA[(size_t)key * 512 + lane]); o[1] += a * bf1(VA[(size_t)key * 512 + 64 + lane]); }
    const float ms = wave_sum(o[0] * o[0] + o[1] * o[1]) * (1.f / 128.f); const float rn = rsqrtf(ms + RMS_EPS) * 0.8f;
    float err = 0.f, sc = 0.f;
#pragma unroll
    for (int j = 0; j < 2; ++j) { const float val = o[j] * rn * p.in[I_HGA][h * 128 + 64 * j + lane]; err = fmaxf(err, fabsf(val - bf1(MIXIN[64 * j + lane]))); sc += val * val; }
    err = wave_max(err); sc = sqrtf(wave_sum(sc) * (1.f / 128.f));
    dbg_report_wave(p, err / (sc + 1e-3f), lane);
}
__device__ __forceinline__ float dbg_convsilu(const bf16* base, int pos, int lim, int ch, int d, const float* cw, const float* cb) {
    float s = cb[ch];
#pragma unroll
    for (int j = 0; j < 3; ++j) { const int pj = pos + j - 1; if (pj >= 0 && pj < lim) s += cw[j * 1024 + ch] * bf1(base[(size_t)pj * 512 + d]); }
    return s / (1.f + expf(-s));
}
__device__ __forceinline__ void dbg_mlstm_check(const Params& p, unsigned char* big, LAS unsigned char* lds, int lane, int wave) {
    const unsigned hsh = dbg_hash(blockIdx.x * 8u + wave + 991u), h2 = dbg_hash(hsh);
    const int b = hsh % 32u, h = (hsh >> 8) % 4u, dir = (hsh >> 12) & 1; int tau = h2 % 2048u; if ((h2 >> 16) % 4u == 0u) tau = (h2 >> 20) % 130u;
    const bf16* BQ = (const bf16*)(big + A0_BQ) + (size_t)b * SEQ * 512 + h * 128; const bf16* BK = (const bf16*)(big + A0_BK) + (size_t)b * (SEQ + LC) * 512 + h * 128;
    const bf16* BV = (const bf16*)(big + A0_BV) + (size_t)b * (SEQ + LC) * 512 + h * 128;
    const float* GT = (const float*)(p.ws + WS_GATES); const float* cw = p.in[I_CONVABW]; const float* cb = p.in[I_CONVABB];
    LAS float* F = (LAS float*)(lds + wave * 18432); LAS float* qv = F + 2304 + 64;
    const int N = 256 + tau + 1;
#define DBG_POS(u) ((u) < 256 ? (dir ? 255 - (u) : (u)) : (dir ? 2047 - ((u) - 256) : (u) - 256))
#define DBG_GROW(u) ((u) < 256 ? (size_t)T + b * LC + DBG_POS(u) : (size_t)b * SEQ + DBG_POS(u))
    float carry = 0.f;
#pragma unroll 1
    for (int u0 = 0; u0 < N; u0 += 64) { const int u = u0 + lane; float lf = 0.f;
        if (u < N) { const float x = GT[DBG_GROW(u) * 16 + dir * 8 + 4 + h]; lf = x >= 0.f ? -__logf(1.f + __expf(-x)) : x - __logf(1.f + __expf(x)); }
        float s = lf;
#pragma unroll
        for (int o = 1; o < 64; o <<= 1) { const float v = shup(s, o); if (lane >= o) s += v; }
        if (u < N) F[u] = carry + s; carry += shidx(s, 63); }
    LDS_WAIT(); asm volatile("" ::: "memory");
    const float Ft = F[N - 1];
    float mm = Ft;
#pragma unroll 1
    for (int u = lane; u < N; u += 64) mm = fmaxf(mm, Ft - F[u] + GT[DBG_GROW(u) * 16 + dir * 8 + h]);
    mm = wave_max(mm);
    { const int pos = DBG_POS(N - 1);
      for (int d = lane; d < 128; d += 64) qv[d] = dbg_convsilu(BQ, pos, SEQ, h * 128 + d, d, cw, cb) * 0.08838834764831845f; }
    LDS_WAIT(); asm volatile("" ::: "memory");
    float den = 0.f;
#pragma unroll 1
    for (int u = lane; u < N; u += 64) { const bool ctx = u < 256; const int pos = DBG_POS(u); const bf16* kb = ctx ? BK : BK + (size_t)LC * 512; float qk = 0.f;
#pragma unroll 1
        for (int d = 0; d < 128; ++d) qk += qv[d] * dbg_convsilu(kb, pos, ctx ? LC : SEQ, 512 + h * 128 + d, d, cw, cb);
        const float om = qk * expf(Ft - F[u] + GT[DBG_GROW(u) * 16 + dir * 8 + h] - mm); F[u] = om; den += om; }
    den = wave_sum(den);
    LDS_WAIT(); asm volatile("" ::: "memory");
    float num[2] = {0.f, 0.f};
#pragma unroll 1
    for (int u = 0; u < N; ++u) { const bool ctx = u < 256; const int pos = DBG_POS(u); const bf16* vb = BV + (size_t)((ctx ? 0 : LC) + pos) * 512; num[0] += F[u] * bf1(vb[lane]); num[1] += F[u] * bf1(vb[64 + lane]); }
    const float dd = 1.f / fmaxf(fabsf(den), expf(-mm));
    const bf16* HB = (const bf16*)(big + A0_HB) + (size_t)dir * T * 512 + ((size_t)b * SEQ + DBG_POS(N - 1)) * 512 + h * 128;
    float err = 0.f, sc = 0.f;
#pragma unroll
    for (int j = 0; j < 2; ++j) { const float val = num[j] * dd; err = fmaxf(err, fabsf(val - bf1(HB[64 * j + lane]))); sc += val * val; }
    err = wave_max(err); sc = sqrtf(wave_sum(sc) * (1.f / 128.f));
    dbg_report_wave(p, err / (sc + 1e-3f), lane);
#undef DBG_POS
#undef DBG_GROW
}

__global__ void __launch_bounds__(NTHR, 2) mk_fwd(Params p0) {
    extern __shared__ __attribute__((aligned(16))) unsigned char lds_raw[];
    LAS unsigned char* lds = (LAS unsigned char*)lds_raw;
    const int wave0 = __builtin_amdgcn_readfirstlane((int)threadIdx.x >> 6);
    if (threadIdx.x < 64) ((LAS unsigned*)(lds + LDS_MISC))[threadIdx.x] = 0u;
    __syncthreads();
    XcdBarrier bar = xcd_barrier_post((unsigned*)(p0.ws + WS_CTL) + CW_BAR, (volatile LAS unsigned*)(lds + LDS_MISC + 32));
    const int G = gridDim.x, cb = blockIdx.x;
    const int vcu = (G % 8 == 0) ? (cb % 8) * (G / 8) + cb / 8 : cb;
#ifdef TIMEK
    int phc = 0; if (blockIdx.x == 0 && threadIdx.x == 0) ((unsigned long long*)(p0.ws + WS_CTL + 32768))[0] = __builtin_amdgcn_s_memrealtime();
#endif
#ifdef DBL_PH
#define DBL_LOOP for (int rep_ = 0; rep_ < 1; ++rep_)
#define DBL_SYNC __syncthreads();
#else
#define DBL_LOOP
#define DBL_SYNC
#endif
#ifdef TIMEK
#define TS_REC { ++phc; if (blockIdx.x == 0 && wave0 == 0 && lane_opq() == 0) ((unsigned long long*)(p0.ws + WS_CTL + 32768))[phc] = __builtin_amdgcn_s_memrealtime(); }
#else
#define TS_REC
#endif
#define LAYER_PTRS bf16* H2 = (bf16*)(big + (l == 0 ? 0 : 128 * MiB)); float* LOG = nullptr; bf16* ACT = (bf16*)(big + (l == 0 ? 144 * MiB : 272 * MiB)); \
        bf16* Y = (bf16*)(big + (l == 0 ? 304 * MiB : 432 * MiB)); bf16* HN = (bf16*)(big + 640 * MiB); const bf16* MIX = (const bf16*)(big + (l == 0 ? A0_MIX : 0)); \
        bf16* UT = (bf16*)big; bf16* UC = (bf16*)(big + 384 * MiB); bf16* ZT = (bf16*)(big + 384 * MiB); bf16* Y2T = (bf16*)(big + 512 * MiB); bf16* Y2 = (bf16*)(big + 640 * MiB); \
        (void)H2; (void)LOG; (void)ACT; (void)Y; (void)HN; (void)MIX; (void)UT; (void)UC; (void)ZT; (void)Y2T; (void)Y2;
#define RUN(...) do { { { int tid_ = wave0 * 64 + lane_opq(); asm volatile("" : "+v"(tid_)); const int tid = tid_, lane = tid & 63, wave = __builtin_amdgcn_readfirstlane(tid >> 6); (void)lane; (void)wave; \
        Params p = p0; { size_t z_ = 0; asm volatile("" : "+s"(z_)); p.ws = p0.ws + z_; p.out = p0.out + z_; _Pragma("unroll") for (int i_ = 0; i_ < 31; ++i_) p.in[i_] = p0.in[i_] + z_; } unsigned char* ws = p.ws; unsigned char* big = ws + WS_BIG; (void)big; LAYER_PTRS DBL_LOOP { __VA_ARGS__; DBL_SYNC } } { XcdBarrier b2_ = bar; { size_t z_ = 0; asm volatile("" : "+s"(z_)); b2_.bar = bar.bar + z_; unsigned x_ = bar.x; asm volatile("" : "+s"(x_)); b2_.x = x_; } xcd_barrier(b2_, wave0 == 0 && lane_opq() == 0); } TS_REC } } while (0)

#ifdef PRO_PROBE
#define PP(i) do { if (blockIdx.x == 0 && tid == 0) ((unsigned long long*)(p0.ws + WS_CTL + 32768))[50 + (i)] = __builtin_amdgcn_s_memrealtime(); } while (0)
#else
#define PP(i)
#endif
    { const int l = 0; RUN({ PP(0); pro_mod(p, lds, tid, lane, wave); __syncthreads(); PP(1); pro_filters(p, lds, tid, lane, wave); PP(2); pro_rope(p, tid); pro_transposes(p, lds, lane, wave); PP(3); }); }

    for (int l = 0; l < 2; ++l) {
        if (l == 0) {
            RUN({ ph_l0_norm(p, lane, wave); });
            RUN({ Gemm g{(const bf16*)(big + A0_H), (const bf16*)(ws + WS_WIN0), 1024, 2048u}; InprojSched S{G, vcu};
                  EpiInproj E{big, (const float*)(ws + WS_ROPE), (float*)(ws + WS_GATES), p.in[I_GATEB]};
                  gemm_phase<EpiInproj, InprojSched>(lds, g, S, E, tid); });
#ifdef DBG_INPROJ
            RUN({ dbg_inproj_check(p, big, lane, wave); });
#endif
            RUN({ ph_transpose_b((const bf16*)(big + A0_VA), (bf16*)(big + A0_VT), NB, SEQ + LC, 512, lds, lane, wave); });
            RUN({ ph_attn(p, big, lds, tid, lane, wave, vcu); });
#ifdef DBG_ATTN
            RUN({ dbg_attn_check(p, big, lds, lane, wave); });
#endif
            RUN({ ph_mlstm(p, big, lds, tid, lane, wave); });
#ifdef DBG_MLSTM
            RUN({ dbg_mlstm_check(p, big, lds, lane, wave); });
#endif
            RUN({ ph_outb(p, big, lane, wave, vcu); asm volatile("s_waitcnt vmcnt(0)" ::: "memory"); __syncthreads();
                  Gemm g{(const bf16*)(big + A0_MIXIN), (const bf16*)(ws + WS_WOUT0), 1024, 2048u}; PanelSched S{4, vcu}; EpiBf16 E{(bf16*)(big + A0_MIX), 1024, 3};
                  gemm_phase<EpiBf16, PanelSched>(lds, g, S, E, tid); });
        }
        if (l == 1) {
            RUN({ Gemm g{(const bf16*)(ws + WS_WIN1), HN, 1024, 2048u}; DenseSched S{256, 12 * 256, G, vcu, 12}; EpiBf16 E{UT, (size_t)T, 0xffff};
                  gemm_phase<EpiBf16, DenseSched>(lds, g, S, E, tid); });
#ifdef DBG_HY
            if (DBG_MODE == 0) { RUN({ dbg_hyena_check(p, 0, HN, UT, UT, UT, UT, lds, lane, wave); }); }
#endif
#ifdef DBG_HY
            if (DBG_MODE == 5) { RUN({ dbg_hyena_check(p, 5, HN, UC, UT, UT, UT, lds, lane, wave); }); }
#endif
            RUN({ ph_lconv<true>(p, 0, UT, UT, ZT, lds, tid, lane, wave); });
#ifdef DBG_HY
            if (DBG_MODE == 2) { RUN({ dbg_hyena_check(p, 2, HN, UC, ZT, Y2T, UT, lds, lane, wave); }); }
#endif
            RUN({ ph_lconv<false>(p, 1, ZT, UT, Y2T, lds, tid, lane, wave); });
#ifdef DBG_HY
            if (DBG_MODE == 3) { RUN({ dbg_hyena_check(p, 3, HN, UC, ZT, Y2T, UT, lds, lane, wave); }); }
#endif
            RUN({ ph_transpose(Y2T, Y2, lds, lane, wave, vcu); asm volatile("s_waitcnt vmcnt(0)" ::: "memory"); __syncthreads();
                  Gemm g{Y2, (const bf16*)(ws + WS_WOUT1), 1024, 2048u}; PanelSched S{4, vcu}; EpiBf16 E{(bf16*)big, 1024, 3};
                  gemm_phase<EpiBf16, PanelSched>(lds, g, S, E, tid); });
        }
#ifdef DBG_HY
        if (l == 1 && (DBG_MODE == 1 || DBG_MODE == 4)) { RUN({ dbg_hyena_check(p, DBG_MODE, HN, (const bf16*)(big + 384 * MiB), (const bf16*)big, (const bf16*)(big + 128 * MiB), (const bf16*)big, lds, lane, wave); }); }
#endif
        RUN({ ph_mid(p, l, MIX, H2, true, lane, wave, vcu); asm volatile("s_waitcnt vmcnt(0)" ::: "memory"); __syncthreads();
              Gemm g{H2, (const bf16*)(ws + WS_WR) + (size_t)l * 256 * 1024, 1024, 2048u}; DenseSched S{1, 256, G, vcu, 0}; EpiRouterLds E{};
              gemm_phase<EpiRouterLds, DenseSched>(lds, g, S, E, tid); __syncthreads(); ph_route_a(p, l, nullptr, vcu, lds, tid); });
#ifdef DBG_ROUTE
        RUN({ if (l == DBG_L) dbg_route_check(p, l, H2, LOG, lds, tid); ph_route_b(p, lds, tid); });
#else
        RUN({ ph_route_b(p, lds, tid); });
#endif
#define DO_G1(chx) do { const int NT = moe_tables(p, chx, lds, tid); \
            Gemm g{H2, (const bf16*)(ws + WS_GU) + (size_t)l * (65 * 512) * 1024, 1024, 2048u}; \
            MoeSched S{(const LAS int*)(lds + LDS_TAB), (const int*)(ws + WS_SORT) + (size_t)(chx) * CHROWS, NT * 2, G, vcu, 1, 2, nullptr}; EpiSwiglu E{ACT}; \
            gemm_phase<EpiSwiglu, MoeSched>(lds, g, S, E, tid); } while (0)
        RUN({ DO_G1(0); });
        for (int ch = 0; ch < NCH; ++ch) {
            RUN({ const int NT = moe_tables(p, ch, lds, tid);
                  Gemm g{ACT, (const bf16*)(ws + WS_DN) + (size_t)l * (65 * 1024) * 256, 256, 512u};
                  MoeSched S{(const LAS int*)(lds + LDS_TAB), nullptr, NT * 4, G, vcu, 2, 4, (l == 0 && ch == 0) ? (void*)(ws + WS_CTL + 32768) : nullptr}; EpiFp8 E{(unsigned char*)Y};
                  gemm_phase<EpiFp8, MoeSched>(lds, g, S, E, tid); });
            RUN({ const int par = (cb >> 3) & 1;
                  _Pragma("unroll 1") for (int part = 0; part < 2; ++part) { int t2_ = tid; asm volatile("" : "+v"(t2_)); const int tid = t2_, lane = tid & 63; (void)lane; if ((part ^ par) == 0) { if (ch + 1 < NCH) DO_G1(ch + 1); } else { ph_combine(p, l, ch, (const unsigned char*)Y, HN, lane, wave); } __syncthreads(); } });
        }
    }
#ifdef TIMEK
    if (blockIdx.x == 0) { const unsigned long long* ts = (const unsigned long long*)(p0.ws + WS_CTL + 32768); __syncthreads();
        const unsigned long long d = (__hip_atomic_load(ts + TIMEK, __ATOMIC_RELAXED, __HIP_MEMORY_SCOPE_AGENT) - __hip_atomic_load(ts + TIMEK0, __ATOMIC_RELAXED, __HIP_MEMORY_SCOPE_AGENT)) * 4ull, t0 = __builtin_amdgcn_s_memrealtime();
        while (__builtin_amdgcn_s_memrealtime() - t0 < d) __builtin_amdgcn_s_sleep(8); }
#endif
#ifdef DBG_ANY
    xcd_barrier(bar, threadIdx.x == 0);
    if (blockIdx.x == 0 && threadIdx.x == 0) p0.out[0] += 1.0e7f * __uint_as_float(((const unsigned*)(p0.ws + WS_CTL))[CW_DBG]);
#endif
#undef RUN
}
constexpr int NPHASES = 1 + 2 * (4 + 3 * NCH) + 6 + 64;
}

extern "C" void kernel_launch(void* const* d_in, const int* in_sizes, int n_in, void* d_out, int out_size, void* d_ws, size_t ws_size, hipStream_t stream) {
    using namespace mk;
    static int grid = 0;
    if (grid == 0) {
        if (n_in != 31 || out_size != T * D || ws_size < WS_END) { fprintf(stderr, "kernel_launch: unexpected shapes (n_in %d, out %d, ws %zu)\n", n_in, out_size, ws_size); grid = -1; return; }
        int dev = 0, cus = 0;
        if (hipGetDevice(&dev) != hipSuccess || hipDeviceGetAttribute(&cus, hipDeviceAttributeMultiprocessorCount, dev) != hipSuccess) { grid = -1; return; }
        if (hipFuncSetAttribute((const void*)mk_fwd, hipFuncAttributeMaxDynamicSharedMemorySize, LDS_BYTES) != hipSuccess) { fprintf(stderr, "kernel_launch: hipFuncSetAttribute failed\n"); grid = -1; return; }
        int per_cu = 0;
        if (hipOccupancyMaxActiveBlocksPerMultiprocessor(&per_cu, (const void*)mk_fwd, NTHR, LDS_BYTES) != hipSuccess || per_cu < 1) { fprintf(stderr, "kernel_launch: occupancy query says %d\n", per_cu); }
        (void)hipGetLastError();
        grid = cus;
        if (grid != 256) { fprintf(stderr, "kernel_launch: built for 256 CUs, found %d\n", grid); grid = -1; return; }
    }
    if (grid < 0) return;
    (void)hipMemsetAsync((char*)d_ws + WS_CTL, 0, CTL_ZERO_BYTES, stream);
    Params a{};
    for (int i = 0; i < 31; ++i) a.in[i] = (const float*)d_in[i];
    a.out = (float*)d_out; a.ws = (unsigned char*)d_ws; a.ph_lo = 0; a.ph_hi = NPHASES;
    hipLaunchKernelGGL(mk_fwd, dim3(grid), dim3(NTHR), LDS_BYTES, stream, a);
}
```

```cpp
#include <hip/hip_runtime.h>
#include <cstdio>
#include <cstdint>
namespace pg8 {
#define PG8_LAS __attribute__((address_space(3)))
typedef unsigned short bf16_t;
typedef short bf16x8 __attribute__((ext_vector_type(8)));
typedef float f32x4 __attribute__((ext_vector_type(4)));
typedef unsigned u32x4 __attribute__((ext_vector_type(4)));
typedef unsigned u32x2 __attribute__((ext_vector_type(2)));
constexpr int BM = 256, BK = 64, HALF = 128, HTB = HALF * BK * 2  , STAGE_BYTES = 8 * HTB;

__host__ __device__ __forceinline__ int lds_byte(int r, int c) { const int st = (r >> 4) * 2 + (c >> 5), rr = r & 15, cc = c & 31, ob = rr * 64 + cc * 2; return st * 1024 + (ob ^ (((ob >> 9) & 1) << 5)); }
__host__ __device__ __forceinline__ void stage_rc(int b, int& R, int& C) { const int st = b / 1024, sb = b % 1024, swz = sb ^ (((sb >> 9) & 1) << 5); R = (st >> 1) * 16 + swz / 64; C = (st & 1) * 32 + (swz % 64) / 2; }
__host__ __device__ __forceinline__ int perm32(int rho) { const int n = rho >> 4, i = rho & 15; return 8 * (i >> 2) + 4 * n + (i & 3); }

struct Unit { int pm, pn; };
__device__ __forceinline__ unsigned cvt_pk_bf16(float lo, float hi) { unsigned r; asm volatile("v_cvt_pk_bf16_f32 %0, %1, %2" : "=v"(r) : "v"(lo), "v"(hi)); return r; }
struct Gemm { const bf16_t* A; const bf16_t* Bt; int K; unsigned lda_bytes; };
template <class Epi, class Sched, bool ALIGN_EPI = true>
__device__ __forceinline__ void gemm_phase(PG8_LAS unsigned char* lds, const Gemm g, const Sched& S, const Epi& E, const int tid_in) {
    int tid_ = tid_in; asm volatile("" : "+v"(tid_));
    const int tid = tid_, wid = __builtin_amdgcn_readfirstlane(tid >> 6), lane = tid & 63, wr = wid >> 2, wc = wid & 3, fr = lane & 15, fq = lane >> 4;
    const int K = g.K, nt = K / BK;
    unsigned voffB[2];
#pragma unroll
    for (int i = 0; i < 2; ++i) { int R, C; stage_rc(tid * 16 + i * 8192, R, C); const int Rb = Epi::PERM ? ((R & ~31) + perm32(R & 31)) : R;
        voffB[i] = (unsigned)(Rb * K + C) * 2u; }
    const size_t kstep = (size_t)(BK * 2);
    const size_t hstep = (size_t)HALF * K * 2;
    const size_t tstep = 2 * hstep;
    const unsigned ldsw = (unsigned)wid * 1024u;
    const int aoff = lds_byte(wr * 64 + fr, fq * 8), boff = lds_byte(wc * 32 + fr, fq * 8);
    const char* Ab = (const char*)g.A;
#define PG8_SA(b, h) (((b) * 2 + (h)) * HTB)
#define PG8_SB(b, h) ((4 + (b) * 2 + (h)) * HTB)
#define PG8_STAGE(bufoff, gbase, voff) do { _Pragma("unroll") for (int _i = 0; _i < 2; ++_i) \
        __builtin_amdgcn_global_load_lds((const unsigned*)((const char*)(gbase) + (voff)[_i]), (PG8_LAS unsigned*)(lds + (bufoff) + ldsw + _i * 8192), 16, 0, 0); } while (0)
#define PG8_STAGEA(bufoff, o0, o1, kb) do { \
        __builtin_amdgcn_global_load_lds((const unsigned*)(Ab + (size_t)(o0) + (size_t)(kb)), (PG8_LAS unsigned*)(lds + (bufoff) + ldsw), 16, 0, 0); \
        __builtin_amdgcn_global_load_lds((const unsigned*)(Ab + (size_t)(o1) + (size_t)(kb)), (PG8_LAS unsigned*)(lds + (bufoff) + ldsw + 8192), 16, 0, 0); } while (0)
#define PG8_LDA(dst, b, h) do { _Pragma("unroll") for (int m = 0; m < 4; ++m) _Pragma("unroll") for (int k = 0; k < 2; ++k) dst[m][k] = *(const PG8_LAS bf16x8*)(lds + PG8_SA(b, h) + aoff + m * 2048 + k * 1024); } while (0)
#define PG8_LDB(dst, b, h) do { _Pragma("unroll") for (int n = 0; n < 2; ++n) _Pragma("unroll") for (int k = 0; k < 2; ++k) dst[n][k] = *(const PG8_LAS bf16x8*)(lds + PG8_SB(b, h) + boff + n * 2048 + k * 1024); } while (0)
#define PG8_MMA(ai, bj, At, Bt) do { __builtin_amdgcn_s_setprio(1); _Pragma("unroll") for (int m = 0; m < 4; ++m) _Pragma("unroll") for (int n = 0; n < 2; ++n) _Pragma("unroll") for (int k = 0; k < 2; ++k) \
        acc[ai][bj][m][n] = __builtin_amdgcn_mfma_f32_16x16x32_bf16(Bt[n][k], At[m][k], acc[ai][bj][m][n], 0, 0, 0); __builtin_amdgcn_s_setprio(0); } while (0)
#define PG8_WAIT_V(n) asm volatile("s_waitcnt vmcnt(" #n ")" ::: "memory")
#define PG8_WAIT_L(n) asm volatile("s_waitcnt lgkmcnt(" #n ")" ::: "memory")
#define PG8_BAR __builtin_amdgcn_s_barrier()
#define PG8_SCHED __builtin_amdgcn_sched_barrier(0)
#define PG8_OFFS(dst, u) do { _Pragma("unroll") for (int _i = 0; _i < 2; ++_i) { int _R, _C; stage_rc(tid * 16 + _i * 8192, _R, _C); _Pragma("unroll") for (int _h = 0; _h < 2; ++_h) \
        dst[_h][_i] = (unsigned)S.arow((u).pm * BM + _h * HALF + _R) * g.lda_bytes + (unsigned)(_C * 2); } } while (0)
    Unit cur, nxt; int ui = 0;
    if (!S.next(0, cur)) return;
    f32x4 acc[2][2][4][2];
#pragma unroll
    for (int a = 0; a < 2; ++a)
#pragma unroll
        for (int b = 0; b < 2; ++b)
#pragma unroll
            for (int m = 0; m < 4; ++m)
#pragma unroll
                for (int n = 0; n < 2; ++n) acc[a][b][m][n] = (f32x4){0.f, 0.f, 0.f, 0.f};
    bf16x8 At[4][2], B0[2][2], B1[2][2];
    unsigned oC[2][2], oN[2][2];
    PG8_OFFS(oC, cur);
    const char* cB = (const char*)g.Bt + (size_t)cur.pn * tstep;
    PG8_STAGE(PG8_SB(0, 0), cB, voffB); PG8_STAGE(PG8_SB(0, 1), cB + hstep, voffB); PG8_STAGEA(PG8_SA(0, 0), oC[0][0], oC[0][1], 0); PG8_STAGEA(PG8_SA(0, 1), oC[1][0], oC[1][1], 0);
    if (wr == 1) PG8_BAR;
    PG8_WAIT_V(2); PG8_BAR;
    PG8_STAGE(PG8_SB(1, 0), cB + kstep, voffB); PG8_STAGEA(PG8_SA(1, 0), oC[0][0], oC[0][1], kstep); PG8_STAGE(PG8_SB(1, 1), cB + hstep + kstep, voffB);
    PG8_WAIT_V(6); PG8_BAR;
#ifdef GM_PROBE
    unsigned long long gaccs[3] = {0, 0, 0}; unsigned long long gtp = __builtin_amdgcn_s_memrealtime();
#define GM_T(i) do { if (Epi::PROBE) { const unsigned long long t1_ = __builtin_amdgcn_s_memrealtime(); gaccs[i] += t1_ - gtp; gtp = t1_; } } while (0)
#else
#define GM_T(i)
#endif
    for (;;) {
        const bool has_next = S.next(ui + 1, nxt);
        if (has_next) { PG8_OFFS(oN, nxt); } else {
#pragma unroll
            for (int _h = 0; _h < 2; ++_h)
#pragma unroll
                for (int _i = 0; _i < 2; ++_i) oN[_h][_i] = oC[_h][_i]; }
        const char* nB = has_next ? (const char*)g.Bt + (size_t)nxt.pn * tstep : cB;
#pragma unroll 1
        for (int t = 0; t < nt; t += 2) {
            const bool last = (t == nt - 2);
            const size_t k1 = (size_t)(t + 1) * kstep;
            const size_t k2 = last ? 0 : (size_t)(t + 2) * kstep, k3 = k2 + kstep;
            const char* b2 = last ? nB : cB + (size_t)(t + 2) * kstep; const char* b3 = b2 + kstep;
            PG8_LDB(B0, 0, 0); PG8_LDB(B1, 0, 1); PG8_SCHED; PG8_LDA(At, 0, 0); PG8_STAGEA(PG8_SA(1, 1), oC[1][0], oC[1][1], k1);
            if (last) { oC[0][0] = oN[0][0]; oC[0][1] = oN[0][1]; oC[1][0] = oN[1][0]; oC[1][1] = oN[1][1]; }
            PG8_WAIT_V(8); PG8_WAIT_L(0); PG8_BAR; PG8_MMA(0, 0, At, B0); PG8_MMA(0, 1, At, B1); PG8_BAR; PG8_SCHED;
            PG8_LDA(At, 0, 1); PG8_STAGE(PG8_SB(0, 0), b2, voffB); PG8_STAGE(PG8_SB(0, 1), b2 + hstep, voffB); PG8_STAGEA(PG8_SA(0, 0), oC[0][0], oC[0][1], k2);
            PG8_WAIT_V(8); PG8_WAIT_L(0); PG8_BAR; PG8_MMA(1, 0, At, B0); PG8_MMA(1, 1, At, B1); PG8_BAR; PG8_SCHED;
            PG8_LDB(B0, 1, 0); PG8_LDB(B1, 1, 1); PG8_SCHED; PG8_LDA(At, 1, 0); PG8_STAGEA(PG8_SA(0, 1), oC[1][0], oC[1][1], k2);
            PG8_WAIT_V(8); PG8_WAIT_L(0); PG8_BAR; PG8_MMA(0, 0, At, B0); PG8_MMA(0, 1, At, B1); PG8_BAR; PG8_SCHED;
            PG8_LDA(At, 1, 1); PG8_STAGE(PG8_SB(1, 0), b3, voffB); PG8_STAGE(PG8_SB(1, 1), b3 + hstep, voffB); PG8_STAGEA(PG8_SA(1, 0), oC[0][0], oC[0][1], k3);
            PG8_WAIT_V(8); PG8_WAIT_L(0); PG8_BAR; PG8_MMA(1, 0, At, B0); PG8_MMA(1, 1, At, B1); PG8_BAR; PG8_SCHED;
        }
        GM_T(0);
        if constexpr (ALIGN_EPI) { if (wr == 0) PG8_BAR; }
        GM_T(1);
        E(acc, cur, wr, wc, fr, fq);
        GM_T(2);
        if (!has_next) break;
#pragma unroll
        for (int a = 0; a < 2; ++a)
#pragma unroll
            for (int b = 0; b < 2; ++b)
#pragma unroll
                for (int m = 0; m < 4; ++m)
#pragma unroll
                    for (int n = 0; n < 2; ++n) acc[a][b][m][n] = (f32x4){0.f, 0.f, 0.f, 0.f};
        cur = nxt; cB = nB; ++ui;
#pragma unroll
        for (int _h = 0; _h < 2; ++_h)
#pragma unroll
            for (int _i = 0; _i < 2; ++_i) oC[_h][_i] = oN[_h][_i];
        if constexpr (ALIGN_EPI) { if (wr == 1) PG8_BAR; }
    }
#ifdef GM_PROBE
    if (Epi::PROBE && blockIdx.x == 0 && tid == 0) { unsigned long long* ts = (unsigned long long*)(S.probe_ts()); if (ts) { ts[50] = 0; ts[51] = gaccs[0]; ts[52] = gaccs[0] + gaccs[1]; ts[53] = gaccs[0] + gaccs[1] + gaccs[2]; } }
#endif
    PG8_WAIT_V(0);
    if constexpr (!ALIGN_EPI) { if (wr == 0) PG8_BAR; }
    PG8_BAR;
    if constexpr (Epi::AFTER_DRAIN) E.fused(acc, cur, wr, wc, fr, fq, lds);
#undef PG8_SA
#undef PG8_SB
#undef PG8_STAGE
#undef PG8_STAGEA
#undef PG8_LDA
#undef PG8_LDB
#undef PG8_MMA
#undef PG8_WAIT_V
#undef PG8_WAIT_L
#undef PG8_BAR
#undef PG8_SCHED
#undef PG8_OFFS
#undef GM_T
}

template <class Epi, class Sched>
__device__ __noinline__ void gemm_phase_ni(PG8_LAS unsigned char* lds, Gemm g, Sched S, Epi E) { gemm_phase<Epi, Sched>(lds, g, S, E, (int)threadIdx.x); }
}

namespace mk {
using namespace pg8;
constexpr int D = 1024, NB = 32, SEQ = 2048, T = NB * SEQ, LC = 256, TC = NB * LC, TT = T + TC;
constexpr int NMOD = 6 * D;
constexpr int NE = 64, NEX = 65, DE = 256;
constexpr int NCH = 2, CHT = T / NCH, BPC = 256 / NCH;
constexpr int MAXTILES = (CHT * 8 + 64 * 255) / 256 + CHT / 256 + 1, CHROWS = MAXTILES * 256;
constexpr float RMS_EPS = 1e-6f;
constexpr int NWAVES = 8, NTHR = 512;

constexpr size_t MiB = 1u << 20;
constexpr size_t WS_CTL = 0, CTL_ZERO_BYTES = 64 * 1024;
constexpr size_t WS_MOD = 1 * MiB;
constexpr size_t WS_ROPE = 3 * MiB;
constexpr size_t WS_BC = 3 * MiB + 65536;
constexpr size_t WS_TEG = 3 * MiB + 2 * 65536;
constexpr size_t WS_GATES = 4 * MiB;
constexpr size_t WS_FILT = 10 * MiB;
constexpr size_t WS_EIDX = 18 * MiB, WS_WTS = 20 * MiB, WS_PSLOT = 22 * MiB, WS_SORT = 26 * MiB;
constexpr size_t WS_WIN0 = 30 * MiB;
constexpr size_t WS_WOUT0 = 38 * MiB, WS_WIN1 = 40 * MiB, WS_WOUT1 = 46 * MiB, WS_WR = 48 * MiB;
constexpr size_t WS_GU = 50 * MiB;
constexpr size_t WS_DN = 180 * MiB;
constexpr size_t WS_BIG = 246 * MiB;
constexpr size_t WS_END = 1024 * MiB;
static_assert(WS_PSLOT + (size_t)T * 16 * 4 <= WS_SORT && WS_SORT + (size_t)NCH * CHROWS * 4 <= WS_WIN0 && WS_WIN0 + (size_t)3840 * 2048 <= WS_WOUT0 && WS_WR + (size_t)2 * 256 * 2048 <= WS_GU && WS_GU + (size_t)2 * 65 * 512 * 2048 <= WS_DN && WS_DN + (size_t)2 * 65 * 1024 * 512 <= WS_BIG, "ws map");
constexpr size_t A0_H = 0, A0_QA = 144 * MiB, A0_KA = 208 * MiB, A0_VA = 280 * MiB, A0_BQ = 352 * MiB, A0_BK = 416 * MiB, A0_BV = 488 * MiB, A0_BO = 560 * MiB, A0_VT = 624 * MiB;
constexpr size_t A0_MIXIN = 0, A0_HB = 144 * MiB, A0_MIX = 352 * MiB;
constexpr int CW_BAR = 4096;

constexpr int LDS_BYTES = 160 * 1024;
constexpr int LDS_TAB = 131072;
constexpr int LDS_MISC = 131072 + 24 * 1024;

#define GAS __attribute__((address_space(1)))
#define LAS __attribute__((address_space(3)))
typedef unsigned short bf16;
typedef unsigned v4u __attribute__((ext_vector_type(4)));
typedef unsigned v2u __attribute__((ext_vector_type(2)));
#define LDS_WAIT() asm volatile("s_waitcnt lgkmcnt(0)" ::: "memory")
#define VM_WAIT() asm volatile("s_waitcnt vmcnt(0)" ::: "memory")
__device__ __forceinline__ unsigned f2bf(float f) { unsigned u = __builtin_bit_cast(unsigned, f); return (u + 0x7fffu + ((u >> 16) & 1u)) >> 16; }
__device__ __forceinline__ unsigned pk2(float lo, float hi) { return f2bf(lo) | (f2bf(hi) << 16); }
__device__ __forceinline__ float bf_lo(unsigned w) { return __builtin_bit_cast(float, w << 16); }
__device__ __forceinline__ float bf_hi(unsigned w) { return __builtin_bit_cast(float, w & 0xffff0000u); }
__device__ __forceinline__ float bf1(bf16 h) { return __builtin_bit_cast(float, (unsigned)h << 16); }
__device__ __forceinline__ int lane_opq() { int l = (int)__builtin_amdgcn_mbcnt_hi(~0u, __builtin_amdgcn_mbcnt_lo(~0u, 0u)); asm volatile("" : "+v"(l)); return l; }
__device__ __forceinline__ float shx(float v, int m) { return __builtin_bit_cast(float, __builtin_amdgcn_ds_bpermute((lane_opq() ^ m) << 2, __builtin_bit_cast(int, v))); }
__device__ __forceinline__ float shup(float v, int o) { const int l = lane_opq(); return __builtin_bit_cast(float, __builtin_amdgcn_ds_bpermute((l >= o ? l - o : l) << 2, __builtin_bit_cast(int, v))); }
__device__ __forceinline__ float shidx(float v, int idx) { return __builtin_bit_cast(float, __builtin_amdgcn_ds_bpermute(idx << 2, __builtin_bit_cast(int, v))); }
__device__ __forceinline__ float wave_sum(float v) {
#pragma unroll
    for (int o = 1; o < 64; o <<= 1) v += shx(v, o);
    return v;
}
__device__ __forceinline__ float wave_max(float v) {
#pragma unroll
    for (int o = 1; o < 64; o <<= 1) v = fmaxf(v, shx(v, o));
    return v;
}
__device__ __forceinline__ float sigmoidf_(float x) { return 1.f / (1.f + __expf(-x)); }
__device__ __forceinline__ float siluf_(float x) { return x / (1.f + __expf(-x)); }
#define XB_TMO      128
#define XB_XCNT(j)  (256  + 64 * (j))
#define XB_XSUB(j)  (1280 + 64 * (j))
#define XB_XGEN(j)  (2304 + 64 * (j))
#define XB_TOP      3328
#define XB_TOPGEN   3392
#define XCD_BAR_WORDS 3456
#define XB_SPIN_CAP (1u << 18)

__device__ __forceinline__ unsigned xb_ld(unsigned* p)              { return __hip_atomic_load(p, __ATOMIC_RELAXED, __HIP_MEMORY_SCOPE_AGENT); }
__device__ __forceinline__ unsigned xb_add(unsigned* p, unsigned v) { return __hip_atomic_fetch_add(p, v, __ATOMIC_RELAXED, __HIP_MEMORY_SCOPE_AGENT); }
__device__ __forceinline__ unsigned xb_xcc_id() { return (unsigned)__builtin_amdgcn_s_getreg((3 << 11) | 20) & 0xFu; }
#define XB_SPIN(cond, bar) do { unsigned _sp = 0; while (cond) { __builtin_amdgcn_s_sleep(1); \
    if ((++_sp & 255u) == 0u) { if (xb_ld(&(bar)[XB_TMO])) break; if (_sp > XB_SPIN_CAP) { atomicAdd(&(bar)[XB_TMO], 1u); break; } } } } while (0)

struct XcdBarrier {
    unsigned* bar; unsigned x;
    volatile LAS unsigned* st;
};

__device__ __forceinline__ XcdBarrier xcd_barrier_post(unsigned* bar, volatile LAS unsigned* st) {
    XcdBarrier b; b.bar = bar; b.x = xb_xcc_id(); b.st = st;
    if (threadIdx.x == 0) (void)xb_add(&bar[XB_XCNT(b.x)], 1u);
    return b;
}
__device__ __forceinline__ void xcd_barrier_complete(unsigned* bar, unsigned x, unsigned& nloc, unsigned& nx) {
    const unsigned G = gridDim.x * gridDim.y * gridDim.z;
    unsigned sum, cnt, mine, sp = 0u;
    for (;;) {
        sum = 0u; cnt = 0u; mine = 0u;
#pragma unroll
        for (unsigned j = 0; j < 16; ++j) { const unsigned c = xb_ld(&bar[XB_XCNT(j)]); sum += c; cnt += (c > 0u) ? 1u : 0u; mine = (j == x) ? c : mine; }
        if (sum == G) break;
        __builtin_amdgcn_s_sleep(1);
        if ((++sp & 255u) == 0u) { if (xb_ld(&bar[XB_TMO])) break; if (sp > XB_SPIN_CAP) { atomicAdd(&bar[XB_TMO], 1u); break; } }
    }
    nloc = mine > 0u ? mine : 1u; nx = cnt > 0u ? cnt : 1u;
}

__device__ __forceinline__ void xcd_barrier(const XcdBarrier& b, const bool t0  ) {
    asm volatile("s_waitcnt vmcnt(0)" ::: "memory");
    __syncthreads();
    if (t0) {
        unsigned* bar = b.bar;
        __builtin_amdgcn_s_waitcnt(0);
        unsigned nloc = b.st[0], nx = b.st[1];
        if (nloc == 0u) { xcd_barrier_complete(bar, b.x, nloc, nx); b.st[0] = nloc; b.st[1] = nx; }
        const unsigned old = xb_add(&bar[XB_XSUB(b.x)], 1u);
        const unsigned gen = old / nloc;
        if (old + 1u == (gen + 1u) * nloc) {
            __builtin_amdgcn_fence(__ATOMIC_RELEASE, "agent");
            asm volatile("s_waitcnt vmcnt(0)" ::: "memory");
            const unsigned og = xb_add(&bar[XB_TOP], 1u);
            const unsigned tg = og / nx;
            if (og + 1u == (tg + 1u) * nx) xb_add(&bar[XB_TOPGEN], 1u);
            else XB_SPIN(xb_ld(&bar[XB_TOPGEN]) == tg, bar);
            __builtin_amdgcn_fence(__ATOMIC_ACQUIRE, "agent");
            xb_add(&bar[XB_XGEN(b.x)], 1u);
            asm volatile("s_waitcnt vmcnt(0)" ::: "memory");
        } else {
            XB_SPIN(xb_ld(&bar[XB_XGEN(b.x)]) == gen, bar);
            __builtin_amdgcn_fence(__ATOMIC_ACQUIRE, "agent");
            asm volatile("s_waitcnt vmcnt(0)" ::: "memory");
        }
    }
    __syncthreads();
}

constexpr float Y8_SCALE = 16.f, Y8_INV = 1.f / 16.f;
struct Params { const float* in[31]; float* out; unsigned char* ws; int ph_lo, ph_hi; };
enum { I_X = 0, I_C, I_CTX, I_CCTX, I_WMOD, I_BMOD, I_NORMG, I_WINAB, I_CONVABW, I_CONVABB, I_GATEB, I_DLAM, I_HGA, I_HGB, I_WOUTAB, I_WINHY, I_CONVHYW, I_CONVHYB,
       I_FW1, I_FB1, I_FW2, I_FB2, I_FW3, I_FBIAS, I_WOUTHY, I_RW, I_RB, I_EGU, I_EDN, I_SGU, I_SDN };

__device__ __forceinline__ void row_ld_f32(const float* row, int lane, f32x4 (&v)[4]) { const f32x4* r = (const f32x4*)row + lane;
#pragma unroll
    for (int j = 0; j < 4; ++j) v[j] = r[64 * j]; }
__device__ __forceinline__ void row_st_f32(float* row, int lane, const f32x4 (&v)[4]) { f32x4* r = (f32x4*)row + lane;
#pragma unroll
    for (int j = 0; j < 4; ++j) r[64 * j] = v[j]; }
__device__ __forceinline__ void row_ld_bf16(const bf16* row, int lane, f32x4 (&v)[4]) { const v2u* r = (const v2u*)row + lane;
#pragma unroll
    for (int j = 0; j < 4; ++j) { const v2u w = r[64 * j]; v[j] = (f32x4){bf_lo(w.x), bf_hi(w.x), bf_lo(w.y), bf_hi(w.y)}; } }
__device__ __forceinline__ void row_st_bf16(bf16* row, int lane, const f32x4 (&v)[4]) { v2u* r = (v2u*)row + lane;
#pragma unroll
    for (int j = 0; j < 4; ++j) { v2u w; w.x = pk2(v[j].x, v[j].y); w.y = pk2(v[j].z, v[j].w); r[64 * j] = w; } }
__device__ __forceinline__ float row_ss(const f32x4 (&v)[4]) { float s = 0.f;
#pragma unroll
    for (int j = 0; j < 4; ++j) s += (v[j].x * v[j].x + v[j].y * v[j].y) + (v[j].z * v[j].z + v[j].w * v[j].w);
    return wave_sum(s); }
__device__ __forceinline__ void row_modulate(const f32x4 (&x)[4], float rstd, const float* g, const float* shift, const float* scale, int lane, f32x4 (&h)[4]) {
    const f32x4* gp = (const f32x4*)g + lane; const f32x4* sh = (const f32x4*)shift + lane; const f32x4* sc = (const f32x4*)scale + lane;
#pragma unroll
    for (int j = 0; j < 4; ++j) { const f32x4 gg = gp[64 * j], s1 = sc[64 * j], s0 = sh[64 * j]; h[j] = x[j] * rstd * gg * (1.f + s1) + s0; } }

__device__ __forceinline__ void pro_mod(const Params& p, LAS unsigned char* lds, int tid, int lane, int wave) {
    const int u = blockIdx.x; if (u >= 192) return;
    LAS float* S = (LAS float*)lds;
    const float* c = p.in[I_C]; const float* cc = p.in[I_CCTX];
#pragma unroll 4
    for (int i = tid; i < 33 * 256; i += NTHR) { const int b = i >> 8, k4 = (i & 255) * 4; const f32x4 v = b < 32 ? *(const f32x4*)(c + b * 1024 + k4) : *(const f32x4*)(cc + k4);
        *(LAS f32x4*)(S + b * 1024 + k4) = (f32x4){siluf_(v[0]), siluf_(v[1]), siluf_(v[2]), siluf_(v[3])}; }
    __syncthreads();
    const int l = u / 96, cg = (u % 96) * 64, col = cg + lane;
    const float* W = p.in[I_WMOD] + (size_t)l * 1024 * NMOD;
    float acc[33];
#pragma unroll
    for (int b = 0; b < 33; ++b) acc[b] = 0.f;
    const int k0 = wave * 128;
#pragma unroll 4
    for (int kk = 0; kk < 128; kk += 4) { const int k = k0 + kk;
        const float w0 = W[(size_t)k * NMOD + col], w1 = W[(size_t)(k + 1) * NMOD + col], w2 = W[(size_t)(k + 2) * NMOD + col], w3 = W[(size_t)(k + 3) * NMOD + col];
#pragma unroll
        for (int b = 0; b < 33; ++b) { const f32x4 s = *(const LAS f32x4*)(S + b * 1024 + k); acc[b] += (s.x * w0 + s.y * w1) + (s.z * w2 + s.w * w3); } }
    __syncthreads();
    LAS float* P = (LAS float*)lds;
#pragma unroll
    for (int b = 0; b < 33; ++b) P[(wave * 33 + b) * 64 + lane] = acc[b];
    __syncthreads();
    float* MOD = (float*)(p.ws + WS_MOD);
#pragma unroll 1
    for (int i = tid; i < 33 * 64; i += NTHR) { const int b = i >> 6, ln = i & 63; float s = 0.f;
#pragma unroll
        for (int w = 0; w < 8; ++w) s += P[(w * 33 + b) * 64 + ln];
        MOD[(size_t)(l * 33 + b) * NMOD + cg + ln] = s + p.in[I_BMOD][l * NMOD + cg + ln]; }
    __syncthreads();
}
__device__ __forceinline__ int rowmap(int kind, int n) {
    if (kind == 1) { const int o = n & 31; return (n & ~31) + (((o & 15) >> 2) * 8 + (o >> 4) * 4 + (o & 3)); }
    if (kind == 2) { return n < 256 ? ((n >> 7) * 256 + (n & 127)) : ((((n - 256) >> 7) * 256) + 128 + ((n - 256) & 127)); }
    if (kind == 3) { const int a = n & 255; return (n & ~255) + 128 * ((a >> 3) & 1) + 32 * (a >> 6) + 8 * ((a >> 4) & 3) + (a & 7); }
    return n;
}
struct TrDesc { const float* W; bf16* WT; int ldn, k0, n0, nvalid, dK, kind, row_base; };
__device__ __forceinline__ TrDesc tr_decode(const Params& p, int it) {
    constexpr int I_A = 16 * 113, I_B = 512, I_C2 = 1536, I_D = 512, I_E = 64, I_F = 130 * 256;
    unsigned char* ws = p.ws; int r = it;
    if (r < I_A) { const int kb = r / 113, nb = r % 113, n0 = nb * 32; const int kind = (n0 < 512 || (n0 >= 1536 && n0 < 2048)) ? 1 : 0;
        return TrDesc{p.in[I_WINAB], (bf16*)(ws + WS_WIN0), 3600, kb * 64, n0, 3600, 1024, kind, 0}; } r -= I_A;
    if (r < I_B) return TrDesc{p.in[I_WOUTAB], (bf16*)(ws + WS_WOUT0), 1024, (r / 32) * 64, (r % 32) * 32, 1024, 1024, 0, 0}; r -= I_B;
    if (r < I_C2) return TrDesc{p.in[I_WINHY], (bf16*)(ws + WS_WIN1), 3072, (r / 96) * 64, (r % 96) * 32, 3072, 1024, 0, 0}; r -= I_C2;
    if (r < I_D) return TrDesc{p.in[I_WOUTHY], (bf16*)(ws + WS_WOUT1), 1024, (r / 32) * 64, (r % 32) * 32, 1024, 1024, 0, 0}; r -= I_D;
    if (r < I_E) { const int l = r / 32, q = r % 32; return TrDesc{p.in[I_RW] + (size_t)l * 1024 * 64, (bf16*)(ws + WS_WR) + (size_t)l * 256 * 1024, 64, (q / 2) * 64, (q % 2) * 32, 64, 1024, 0, 0}; } r -= I_E;
    if (r < I_F) { const int mat = r / 256, q = r % 256, l = mat / 65, e = mat % 65;
        const float* src = e < 64 ? p.in[I_EGU] + (size_t)(l * 64 + e) * 1024 * 512 : p.in[I_SGU] + (size_t)l * 1024 * 512;
        return TrDesc{src, (bf16*)(ws + WS_GU) + (size_t)l * (65 * 512) * 1024, 512, (q / 16) * 64, (q % 16) * 32, 512, 1024, 2, e * 512}; } r -= I_F;
    { const int mat = r / 128, q = r % 128, l = mat / 65, e = mat % 65;
        const float* src = e < 64 ? p.in[I_EDN] + (size_t)(l * 64 + e) * 256 * 1024 : p.in[I_SDN] + (size_t)l * 256 * 1024;
        return TrDesc{src, (bf16*)(ws + WS_DN) + (size_t)l * (65 * 1024) * 256, 1024, (q / 32) * 64, (q % 32) * 32, 1024, 256, 3, e * 1024}; }
}
__device__ __forceinline__ void tr_load(const TrDesc& d, int lane, float (&v)[32]) {
    const int nn = d.n0 + (lane & 31); const bool ok = nn < d.nvalid; const float* src = d.W + (size_t)(d.k0 + (lane >> 5)) * d.ldn + (ok ? nn : 0);
#pragma unroll
    for (int i = 0; i < 32; ++i) v[i] = src[(size_t)(2 * i) * d.ldn];
    if (!ok) {
#pragma unroll
        for (int i = 0; i < 32; ++i) v[i] = 0.f; }
}
__device__ __forceinline__ void tr_finish(const TrDesc& d, const float (&v)[32], LAS float* scr, int lane) {
#pragma unroll
    for (int i = 0; i < 32; ++i) scr[(2 * i + (lane >> 5)) * 33 + (lane & 31)] = v[i];
    LDS_WAIT(); asm volatile("" ::: "memory");
    const int c = lane & 7;
#pragma unroll
    for (int j = 0; j < 4; ++j) { const int n = (lane >> 3) + 8 * j; const LAS float* s = scr + (8 * c) * 33 + n;
        v4u o; o.x = pk2(s[0 * 33], s[1 * 33]); o.y = pk2(s[2 * 33], s[3 * 33]); o.z = pk2(s[4 * 33], s[5 * 33]); o.w = pk2(s[6 * 33], s[7 * 33]);
        const int row = d.row_base + rowmap(d.kind, d.n0 + n);
        *(v4u*)(d.WT + (size_t)row * d.dK + d.k0 + 8 * c) = o; }
    LDS_WAIT(); asm volatile("" ::: "memory");
}
__device__ __forceinline__ void pro_transposes(const Params& p, LAS unsigned char* lds, int lane, int wave) {
    LAS float* scr = (LAS float*)(lds + wave * 16384);
    const int gw = blockIdx.x * NWAVES + wave, NGW = gridDim.x * NWAVES;
    constexpr int NITEMS = 16 * 113 + 512 + 1536 + 512 + 64 + 130 * 256 + 130 * 128;
    if (gw >= NITEMS) return;
    TrDesc dc = tr_decode(p, gw); float vc[32]; tr_load(dc, lane, vc);
#pragma unroll 1
    for (int it = gw; it < NITEMS; it += NGW) {
        const bool more = it + NGW < NITEMS; TrDesc dn = dc; float vn[32];
        if (more) { dn = tr_decode(p, it + NGW); tr_load(dn, lane, vn); }
        tr_finish(dc, vc, scr, lane);
        if (more) { dc = dn;
#pragma unroll
            for (int i = 0; i < 32; ++i) vc[i] = vn[i]; }
    }
}
__device__ __forceinline__ void pro_rope(const Params& p, int tid) {
    if (blockIdx.x != 255) return;
    float* R = (float*)(p.ws + WS_ROPE);
    for (int i = tid; i < 64 * 16; i += NTHR) { const int pos = i >> 4, f = i & 15; const float inv = exp2f(-(float)f * (13.287712379549449f / 16.f)); const float ang = (float)pos * inv;
        float sn, cs; sincosf(ang, &sn, &cs); R[2 * i] = cs; R[2 * i + 1] = sn; }
}
__device__ __forceinline__ void pro_filters(const Params& p, LAS unsigned char* lds, int tid, int lane, int wave) {
    LAS float* Z = (LAS float*)lds;
    LAS float* H1 = Z + 512;
    LAS float* H2 = H1 + 512;
    const int j0 = 8 * blockIdx.x, j = j0 + wave;
    const float* fw1 = p.in[I_FW1]; const float* fb1 = p.in[I_FB1]; const float* fw2 = p.in[I_FW2]; const float* fb2 = p.in[I_FB2]; const float* fw3 = p.in[I_FW3];
    {   float z = 0.f;
        if (lane == 0) z = (float)j / 2047.f;
        else if (lane < 33) { const int k = (lane - 1) & 15; const float fr = 1e-4f + (float)k * ((15.f - 1e-4f) / 15.f); const float ang = (6.283185307179586f / 2048.f) * (float)j * fr;
            float sn, cs; sincosf(ang, &sn, &cs); z = lane < 17 ? cs : -sn; }
        Z[wave * 64 + lane] = z; }
    LDS_WAIT(); asm volatile("" ::: "memory");
    {   float a = fb1[lane];
#pragma unroll 11
        for (int k = 0; k < 33; ++k) a += Z[wave * 64 + k] * fw1[k * 64 + lane];
        H1[wave * 64 + lane] = sinf(a); }
    LDS_WAIT(); asm volatile("" ::: "memory");
    {   float a = fb2[lane];
#pragma unroll 16
        for (int k = 0; k < 64; ++k) a += H1[wave * 64 + k] * fw2[k * 64 + lane];
        H2[wave * 64 + lane] = sinf(a); }
    __syncthreads();
    bf16* F = (bf16*)(p.ws + WS_FILT);
    const float mind = -4.605170185988091f / 1.5f, maxd = -4.605170185988091f / 0.3f;
#pragma unroll 1
    for (int i = 0; i < 4; ++i) { const int n = tid + NTHR * i, c = n & 1023;
        float acc[8];
#pragma unroll
        for (int q = 0; q < 8; ++q) acc[q] = 0.f;
#pragma unroll 16
        for (int k = 0; k < 64; ++k) { const float w = fw3[k * 2048 + n];
#pragma unroll
            for (int q = 0; q < 8; ++q) acc[q] += H2[q * 64 + k] * w; }
        const float delta = fabsf(mind + (float)c * ((maxd - mind) / 1023.f));
        float o[8];
#pragma unroll
        for (int q = 0; q < 8; ++q) { const float dist = fabsf((float)(j0 + q) - 1024.f) * (1.f / 1024.f); o[q] = acc[q] * expf(-dist * delta); }
        v4u w; w.x = pk2(o[0], o[1]); w.y = pk2(o[2], o[3]); w.z = pk2(o[4], o[5]); w.w = pk2(o[6], o[7]);
        *(v4u*)(F + (size_t)n * 2048 + j0) = w; }
    __syncthreads();
}

__device__ __forceinline__ void l0_norm_rows(const float* src, bf16* dst, int nrows, const float* g, const float* md, int lane) {
    f32x4 vb[4], vc[4];
#pragma unroll
    for (int j = 0; j < 4; ++j) { const int o = 4 * lane + 256 * j; vb[j] = *(const f32x4*)(g + o) * (1.f + *(const f32x4*)(md + D + o)); vc[j] = *(const f32x4*)(md + o); }
    f32x4 xn[4]; row_ld_f32(src, lane, xn);
#pragma unroll 1
    for (int i = 0; i < nrows; ++i) { f32x4 x[4], h[4];
#pragma unroll
        for (int j = 0; j < 4; ++j) x[j] = xn[j];
        if (i + 1 < nrows) row_ld_f32(src + (size_t)(i + 1) * D, lane, xn);
        const float rstd = rsqrtf(row_ss(x) * (1.f / D) + RMS_EPS);
#pragma unroll
        for (int j = 0; j < 4; ++j) h[j] = x[j] * rstd * vb[j] + vc[j];
        row_st_bf16(dst + (size_t)i * D, lane, h); }
}
__device__ __forceinline__ void ph_l0_norm(const Params& p, int lane, int wave) {
    const int gw = blockIdx.x * NWAVES + wave;
    const float* MOD = (const float*)(p.ws + WS_MOD); bf16* H = (bf16*)(p.ws + WS_BIG + A0_H);
    const float* g = p.in[I_NORMG];
    { const int m0 = gw * 32; l0_norm_rows(p.in[I_X] + (size_t)m0 * D, H + (size_t)m0 * D, 32, g, MOD + (size_t)(m0 >> 11) * NMOD, lane); }
    { const int m0 = gw * 4; l0_norm_rows(p.in[I_CTX] + (size_t)m0 * D, H + (size_t)(T + m0) * D, 4, g, MOD + (size_t)32 * NMOD, lane); }
}
__device__ __forceinline__ void ph_mid(const Params& p, int l, const bf16* MIX, bf16* H2, bool has_mix, int lane, int wave, int tile) {
    const int gw = tile * NWAVES + wave;
    const float* MOD = (const float*)(p.ws + WS_MOD) + (size_t)l * 33 * NMOD;
    const float* g1 = p.in[I_NORMG] + (size_t)(l * 4 + 1) * D; const float* g2 = p.in[I_NORMG] + (size_t)(l * 4 + 2) * D;
    const float* xin = l == 0 ? p.in[I_X] : p.out;
    const int m0 = gw * 32; const float* md = MOD + (size_t)(m0 >> 11) * NMOD;
    f32x4 va[4], vb[4], vc[4];
#pragma unroll
    for (int j = 0; j < 4; ++j) { const int o = 4 * lane + 256 * j; va[j] = *(const f32x4*)(md + 2 * D + o) * *(const f32x4*)(g1 + o); vb[j] = *(const f32x4*)(g2 + o) * (1.f + *(const f32x4*)(md + 4 * D + o)); vc[j] = *(const f32x4*)(md + 3 * D + o); }
    f32x4 xn[4], mn[4];
    row_ld_f32(xin + (size_t)m0 * D, lane, xn); if (has_mix) row_ld_bf16(MIX + (size_t)m0 * D, lane, mn);
#pragma unroll 1
    for (int m = m0; m < m0 + 32; ++m) {
        f32x4 x[4], h[4], mx[4];
#pragma unroll
        for (int j = 0; j < 4; ++j) { x[j] = xn[j]; mx[j] = mn[j]; }
        if (m + 1 < m0 + 32) { row_ld_f32(xin + (size_t)(m + 1) * D, lane, xn); if (has_mix) row_ld_bf16(MIX + (size_t)(m + 1) * D, lane, mn); }
        if (has_mix) { const float r = rsqrtf(row_ss(mx) * (1.f / D) + RMS_EPS);
#pragma unroll
            for (int j = 0; j < 4; ++j) x[j] = x[j] + va[j] * (mx[j] * r); }
        row_st_f32(p.out + (size_t)m * D, lane, x);
        const float rstd = rsqrtf(row_ss(x) * (1.f / D) + RMS_EPS);
#pragma unroll
        for (int j = 0; j < 4; ++j) h[j] = x[j] * rstd * vb[j] + vc[j];
        row_st_bf16(H2 + (size_t)m * D, lane, h);
    }
}
__device__ __forceinline__ void ph_combine(const Params& p, int l, int ch, const unsigned char* Y8, bf16* Hn, int lane, int wave) {
    const int gw = blockIdx.x * NWAVES + wave;
    const float* MOD = (const float*)(p.ws + WS_MOD) + (size_t)l * 33 * NMOD;
    const float* g3 = p.in[I_NORMG] + (size_t)(l * 4 + 3) * D;
    const int* PSLOT = (const int*)(p.ws + WS_PSLOT); const float* WTS = (const float*)(p.ws + WS_WTS);
    constexpr int RPW = CHT / 2048;
    const int mbase = ch * CHT + gw * RPW; const float* md = MOD + (size_t)(mbase >> 11) * NMOD;
    float va[16], vb[16], vc[16];
    { const float* md1 = MOD + (size_t)(33 + (mbase >> 11)) * NMOD; const float* g10 = p.in[I_NORMG] + (size_t)4 * D;
#pragma unroll
      for (int q = 0; q < 4; ++q) { const int o = lane * 16 + 4 * q; const f32x4 gp = *(const f32x4*)(g3 + o), gf = *(const f32x4*)(md + 5 * D + o); f32x4 gg = gp, sh = gp, sc = gp;
          if (l == 0) { gg = *(const f32x4*)(g10 + o); sh = *(const f32x4*)(md1 + o); sc = *(const f32x4*)(md1 + D + o); }
#pragma unroll
          for (int j = 0; j < 4; ++j) { va[4 * q + j] = gp[j] * gf[j]; vb[4 * q + j] = gg[j] * (1.f + sc[j]); vc[4 * q + j] = sh[j]; } } }
    int sl[9]; float wk[9];
#define CMB_SLOTS(mt) do { _Pragma("unroll") for (int k = 0; k < 9; ++k) { sl[k] = PSLOT[(size_t)(mt) * 16 + k]; wk[k] = k < 8 ? WTS[(size_t)(mt) * 8 + k] : 1.f; } } while (0)
    CMB_SLOTS(mbase);
#pragma unroll 1
    for (int m = mbase; m < mbase + RPW; ++m) {
        float a[16];
#pragma unroll
        for (int j = 0; j < 16; ++j) a[j] = 0.f;
        u32x4 yr[9]; float wc[9];
#pragma unroll
        for (int k = 0; k < 9; ++k) { yr[k] = *(const u32x4*)(Y8 + (size_t)sl[k] * 1024 + lane * 16); wc[k] = wk[k]; }
        float* orow = p.out + (size_t)m * D + lane * 16; f32x4 xv4[4];
#pragma unroll
        for (int q = 0; q < 4; ++q) xv4[q] = *(const f32x4*)(orow + 4 * q);
        if (m + 1 < mbase + RPW) CMB_SLOTS(m + 1);
#pragma unroll
        for (int k = 0; k < 9; ++k) { const float w = wc[k] * Y8_INV; const unsigned ww[4] = {yr[k].x, yr[k].y, yr[k].z, yr[k].w};
#pragma unroll
            for (int q = 0; q < 4; ++q) { a[4 * q + 0] += w * __builtin_amdgcn_cvt_f32_fp8((int)ww[q], 0); a[4 * q + 1] += w * __builtin_amdgcn_cvt_f32_fp8((int)ww[q], 1);
                                          a[4 * q + 2] += w * __builtin_amdgcn_cvt_f32_fp8((int)ww[q], 2); a[4 * q + 3] += w * __builtin_amdgcn_cvt_f32_fp8((int)ww[q], 3); } }
        float ss = 0.f;
#pragma unroll
        for (int j = 0; j < 16; ++j) ss += a[j] * a[j];
        const float r = rsqrtf(wave_sum(ss) * (1.f / D) + RMS_EPS);
        float x[16]; float s2 = 0.f;
#pragma unroll
        for (int q = 0; q < 4; ++q) {
#pragma unroll
            for (int j = 0; j < 4; ++j) { const float v = xv4[q][j] + va[4 * q + j] * (a[4 * q + j] * r); x[4 * q + j] = v; s2 += v * v; }
            *(f32x4*)(orow + 4 * q) = (f32x4){x[4 * q], x[4 * q + 1], x[4 * q + 2], x[4 * q + 3]}; }
        if (l == 0) { const float rstd = rsqrtf(wave_sum(s2) * (1.f / D) + RMS_EPS); float h[16];
#pragma unroll
            for (int j = 0; j < 16; ++j) h[j] = x[j] * rstd * vb[j] + vc[j];
            v4u w0, w1; w0.x = pk2(h[0], h[1]); w0.y = pk2(h[2], h[3]); w0.z = pk2(h[4], h[5]); w0.w = pk2(h[6], h[7]); w1.x = pk2(h[8], h[9]); w1.y = pk2(h[10], h[11]); w1.z = pk2(h[12], h[13]); w1.w = pk2(h[14], h[15]);
            *(v4u*)(Hn + (size_t)m * D + lane * 16) = w0; *(v4u*)(Hn + (size_t)m * D + lane * 16 + 8) = w1; }
    }
#undef CMB_SLOTS
}

struct DenseSched { int NN, NU, G, c, NMs;
    __device__ __forceinline__ bool next(int i, Unit& u) const { const int L = i * G + c; if (L >= NU) return false; if (NMs > 0) { u.pm = L % NMs; u.pn = L / NMs; } else { u.pm = L / NN; u.pn = L % NN; } return true; }
    __device__ __forceinline__ int arow(int r) const { return r; }
    __device__ __forceinline__ void* probe_ts() const { return nullptr; } };
struct PanelSched { int NN, pm;
    __device__ __forceinline__ bool next(int i, Unit& u) const { if (i >= NN) return false; u.pm = pm; u.pn = i; return true; }
    __device__ __forceinline__ int arow(int r) const { return r; }
    __device__ __forceinline__ void* probe_ts() const { return nullptr; } };
struct EpiBf16 { static constexpr bool PERM = true, AFTER_DRAIN = false, PROBE = false; bf16* O; size_t ldc; int cmask;
    __device__ __forceinline__ void operator()(const f32x4 (&acc)[2][2][4][2], const Unit& u, int wr, int wc, int fr, int fq) const {
        const int row0 = u.pm * BM + wr * 64 + fr, col0 = (u.pn & cmask) * BM + wc * 32 + 8 * fq;
#pragma unroll
        for (int ai = 0; ai < 2; ++ai)
#pragma unroll
            for (int m = 0; m < 4; ++m) { bf16* rowp = O + (size_t)(row0 + ai * HALF + m * 16) * ldc + col0;
#pragma unroll
                for (int bj = 0; bj < 2; ++bj) { const f32x4 v0 = acc[ai][bj][m][0], v1 = acc[ai][bj][m][1];
                    u32x4 w; w.x = cvt_pk_bf16(v0[0], v0[1]); w.y = cvt_pk_bf16(v0[2], v0[3]); w.z = cvt_pk_bf16(v1[0], v1[1]); w.w = cvt_pk_bf16(v1[2], v1[3]);
                    *(u32x4*)(rowp + bj * HALF) = w; } }
    } };
struct EpiRouter { static constexpr bool PERM = false, AFTER_DRAIN = false, PROBE = false; float* LOG;
    __device__ __forceinline__ void operator()(const f32x4 (&acc)[2][2][4][2], const Unit& u, int wr, int wc, int fr, int fq) const {
        if (wc >= 2) return;
        const int row0 = u.pm * BM + wr * 64 + fr, col0 = wc * 32 + 4 * fq;
#pragma unroll
        for (int ai = 0; ai < 2; ++ai)
#pragma unroll
            for (int m = 0; m < 4; ++m) { float* rowp = LOG + (size_t)(row0 + ai * HALF + m * 16) * 64 + col0;
#pragma unroll
                for (int n = 0; n < 2; ++n) *(f32x4*)(rowp + n * 16) = acc[ai][0][m][n]; }
    } };
struct EpiFp8 { static constexpr bool PERM = true, AFTER_DRAIN = false, PROBE = true; unsigned char* O;
    __device__ __forceinline__ void operator()(const f32x4 (&acc)[2][2][4][2], const Unit& u, int wr, int wc, int fr, int fq) const {
        const int row0 = u.pm * BM + wr * 64 + fr, col0 = (u.pn & 3) * BM + wc * 64 + 16 * fq;
#pragma unroll
        for (int ai = 0; ai < 2; ++ai)
#pragma unroll
            for (int m = 0; m < 4; ++m) { unsigned char* rowp = O + (size_t)(row0 + ai * HALF + m * 16) * 1024 + col0; u32x4 w;
#pragma unroll
                for (int bj = 0; bj < 2; ++bj) { f32x4 v0 = acc[ai][bj][m][0] * Y8_SCALE, v1 = acc[ai][bj][m][1] * Y8_SCALE; int lo = 0, hi = 0;
#pragma unroll
                    for (int j = 0; j < 4; ++j) { v0[j] = __builtin_amdgcn_fmed3f(v0[j], -440.f, 440.f); v1[j] = __builtin_amdgcn_fmed3f(v1[j], -440.f, 440.f); }
                    lo = __builtin_amdgcn_cvt_pk_fp8_f32(v0[0], v0[1], lo, false); lo = __builtin_amdgcn_cvt_pk_fp8_f32(v0[2], v0[3], lo, true);
                    hi = __builtin_amdgcn_cvt_pk_fp8_f32(v1[0], v1[1], hi, false); hi = __builtin_amdgcn_cvt_pk_fp8_f32(v1[2], v1[3], hi, true);
                    if (bj == 0) { w.x = (unsigned)lo; w.y = (unsigned)hi; } else { w.z = (unsigned)lo; w.w = (unsigned)hi; } }
                *(u32x4*)rowp = w; }
    } };
struct EpiRouterLds { static constexpr bool PERM = false, AFTER_DRAIN = true, PROBE = false;
    __device__ __forceinline__ void operator()(const f32x4 (&)[2][2][4][2], const Unit&, int, int, int, int) const {}
    __device__ __forceinline__ void fused(const f32x4 (&acc)[2][2][4][2], const Unit&, int wr, int wc, int fr, int fq, LAS unsigned char* lds) const {
        if (wc >= 2) return;
        LAS float* SC = (LAS float*)lds;
#pragma unroll
        for (int ai = 0; ai < 2; ++ai)
#pragma unroll
            for (int m = 0; m < 4; ++m) { const int row = ai * HALF + wr * 64 + m * 16 + fr;
#pragma unroll
                for (int n = 0; n < 2; ++n)
#pragma unroll
                    for (int j = 0; j < 4; ++j) SC[row * 65 + wc * 32 + n * 16 + 4 * fq + j] = sigmoidf_(acc[ai][0][m][n][j]); }
    } };
struct MoeSched { const LAS int* te; const int* sort; int NU, G, c, sh, per;
    __device__ __forceinline__ bool next(int i, Unit& u) const { const int L = i * G + c; if (L >= NU) return false; const int tile = L >> sh; u.pm = tile; u.pn = te[tile] * per + (L & (per - 1)); return true; }
    __device__ __forceinline__ int arow(int r) const { return sort ? sort[r] : r; }
    void* pts; __device__ __forceinline__ void* probe_ts() const { return pts; } };
struct EpiSwiglu { static constexpr bool PERM = true, AFTER_DRAIN = false, PROBE = false; bf16* ACT;
    __device__ __forceinline__ void operator()(const f32x4 (&acc)[2][2][4][2], const Unit& u, int wr, int wc, int fr, int fq) const {
        const int row0 = u.pm * BM + wr * 64 + fr, col0 = (u.pn & 1) * 128 + wc * 32 + 8 * fq;
#pragma unroll
        for (int ai = 0; ai < 2; ++ai)
#pragma unroll
            for (int m = 0; m < 4; ++m) { bf16* rowp = ACT + (size_t)(row0 + ai * HALF + m * 16) * DE + col0;
                const f32x4 g0 = acc[ai][0][m][0], g1 = acc[ai][0][m][1], u0 = acc[ai][1][m][0], u1 = acc[ai][1][m][1];
                float o[8];
#pragma unroll
                for (int q = 0; q < 4; ++q) { o[q] = siluf_(g0[q]) * u0[q]; o[4 + q] = siluf_(g1[q]) * u1[q]; }
                u32x4 w; w.x = cvt_pk_bf16(o[0], o[1]); w.y = cvt_pk_bf16(o[2], o[3]); w.z = cvt_pk_bf16(o[4], o[5]); w.w = cvt_pk_bf16(o[6], o[7]);
                *(u32x4*)rowp = w; }
    } };
__device__ __forceinline__ int moe_tables(const Params& p, int ch, LAS unsigned char* lds, int tid) {
    LAS int* TE = (LAS int*)(lds + LDS_TAB);
    const int* TEG = (const int*)(p.ws + WS_TEG) + (size_t)ch * (MAXTILES + 64);
    __syncthreads();
#pragma unroll 1
    for (int i = tid; i <= MAXTILES; i += NTHR) TE[i] = TEG[i];
    __syncthreads();
    return TE[MAXTILES];
}

__device__ __forceinline__ void ph_route_a(const Params& p, int l, const float* LOG, int tile, LAS unsigned char* lds, int tid) {
    LAS float* SC = (LAS float*)lds;
    LAS float* RBs = (LAS float*)(lds + 68 * 1024);
    LAS unsigned* MASK = (LAS unsigned*)(lds + 69 * 1024);
    const int b = tile, tok0 = 256 * b;
    if (LOG)
#pragma unroll 1
    for (int i = tid; i < 256 * 64; i += NTHR) { const int t = i >> 6, e = i & 63; SC[t * 65 + e] = sigmoidf_(LOG[(size_t)(tok0 + t) * 64 + e]); }
    if (tid < 64) RBs[tid] = p.in[I_RB][l * 64 + tid];
    MASK[tid] = 0u;
    __syncthreads();
    int eidx[8]; float wts[8];
    if (tid < 256) { const int t = tid; const LAS float* sc = SC + t * 65;
        float gs[8], bv[64];
#pragma unroll
        for (int g = 0; g < 8; ++g) { float m1 = -3.0e38f, m2 = -3.0e38f;
#pragma unroll
            for (int j = 0; j < 8; ++j) { const float v = sc[8 * g + j] + RBs[8 * g + j]; bv[8 * g + j] = v; if (v > m1) { m2 = m1; m1 = v; } else if (v > m2) m2 = v; }
            gs[g] = m1 + m2; }
        unsigned gmask = 0u;
#pragma unroll
        for (int r = 0; r < 4; ++r) { float best = -3.0e38f; int bi = 0; bool found = false;
#pragma unroll
            for (int g = 0; g < 8; ++g) { const bool free_ = ((gmask >> g) & 1u) == 0u; if (free_ && (!found || gs[g] > best)) { best = gs[g]; bi = g; found = true; } }
            gmask |= 1u << bi; }
#pragma unroll
        for (int e = 0; e < 64; ++e) if (((gmask >> (e >> 3)) & 1u) == 0u) bv[e] = -3.0e38f;
        unsigned long long taken = 0ull; float ssum = 0.f;
#pragma unroll
        for (int k = 0; k < 8; ++k) { float best = -3.0e38f; int be = 0; bool found = false;
#pragma unroll
            for (int e = 0; e < 64; ++e) { const bool ok = ((taken >> e) & 1ull) == 0ull; if (ok && (!found || bv[e] > best)) { best = bv[e]; be = e; found = true; } }
            taken |= 1ull << be; eidx[k] = be; wts[k] = sc[be]; ssum += wts[k]; }
        const float inv = 2.5f / ssum;
#pragma unroll
        for (int k = 0; k < 8; ++k) { wts[k] *= inv; __hip_atomic_fetch_or(&MASK[eidx[k] * 8 + (t >> 5)], 1u << (t & 31), __ATOMIC_RELAXED, __HIP_MEMORY_SCOPE_WORKGROUP); }
    }
    __syncthreads();
    if (tid < 256) { const int t = tid; int* EIDX = (int*)(p.ws + WS_EIDX); float* WTS = (float*)(p.ws + WS_WTS);
#pragma unroll
        for (int k = 0; k < 8; ++k) { const int e = eidx[k]; int r = 0;
#pragma unroll 1
            for (int w = 0; w < (t >> 5); ++w) r += __popc(MASK[e * 8 + w]);
            r += __popc(MASK[e * 8 + (t >> 5)] & ((1u << (t & 31)) - 1u));
            EIDX[(size_t)(tok0 + t) * 8 + k] = e | (r << 8); WTS[(size_t)(tok0 + t) * 8 + k] = wts[k]; } }
    if (tid < 64) { int c = 0;
#pragma unroll
        for (int w = 0; w < 8; ++w) c += __popc(MASK[tid * 8 + w]);
        ((int*)(p.ws + WS_BC))[b * 64 + tid] = c; }
    __syncthreads();
}
__device__ __forceinline__ void ph_route_b(const Params& p, LAS unsigned char* lds, int tid) {
    LAS int* BCS = (LAS int*)lds;
    LAS int* CNT = BCS + BPC * 64; LAS int* PRE = CNT + 64; LAS int* SEG = PRE + 64;
    const int b = blockIdx.x, ch = b / BPC, bl = b % BPC;
    const int* BC = (const int*)(p.ws + WS_BC) + (size_t)ch * BPC * 64;
#pragma unroll 1
    for (int i = tid; i < BPC * 64; i += NTHR) BCS[i] = BC[i];
    __syncthreads();
    if (tid < 64) { int c = 0, pr = 0;
#pragma unroll 1
        for (int i = 0; i < BPC; ++i) { const int v = BCS[i * 64 + tid]; c += v; if (i < bl) pr += v; } CNT[tid] = c; PRE[tid] = pr; }
    __syncthreads();
    if (tid == 0) { int base = 0;
#pragma unroll 1
        for (int e = 0; e < 64; ++e) { SEG[e] = base; base += ((CNT[e] + 255) >> 8) << 8; } SEG[64] = base; }
    __syncthreads();
    int* SORT = (int*)(p.ws + WS_SORT) + (size_t)ch * CHROWS; int* PSLOT = (int*)(p.ws + WS_PSLOT); const int* EIDX = (const int*)(p.ws + WS_EIDX);
    if (tid < 256) { const int tok = 256 * b + tid;
#pragma unroll
        for (int k = 0; k < 8; ++k) { const int w = EIDX[(size_t)tok * 8 + k], e = w & 255, r = w >> 8; const int slot = SEG[e] + PRE[e] + r; SORT[slot] = tok; PSLOT[(size_t)tok * 16 + k] = slot; }
        const int s8 = SEG[64] + (tok - ch * CHT); SORT[s8] = tok; PSLOT[(size_t)tok * 16 + 8] = s8; }
    if (bl == 0) {
        int* TEG = (int*)(p.ws + WS_TEG) + (size_t)ch * (MAXTILES + 64); const int NT = (SEG[64] >> 8) + CHT / 256;
#pragma unroll 1
        for (int i = tid; i < NT; i += NTHR) { int e = 0;
#pragma unroll 1
            while (e < 64 && (i << 8) >= SEG[e + 1]) ++e;
            TEG[i] = e; }
        if (tid == 0) TEG[MAXTILES] = NT; }
    if (bl < 64) { const int e = bl, lo = SEG[e] + CNT[e], hi = SEG[e] + (((CNT[e] + 255) >> 8) << 8); for (int s = lo + tid; s < hi; s += NTHR) SORT[s] = ch * CHT; }
    __syncthreads();
}

typedef float f32x16 __attribute__((ext_vector_type(16)));
__device__ __forceinline__ void ph_sconv(const Params& p, const bf16* UT, bf16* UC, int tid) {
    const float* cw = p.in[I_CONVHYW]; const float* cbias = p.in[I_CONVHYB];
    const unsigned NIT = 3072u * 32u * 256u; const unsigned gt = blockIdx.x * NTHR + tid, NG = gridDim.x * NTHR;
#pragma unroll 1
    for (unsigned it = gt; it < NIT; it += NG) {
        const unsigned c = it >> 13, k = it & 255u; const size_t base = (size_t)it * 8;
        const v4u w = *(const v4u*)(UT + base);
        const float w0 = cw[c], w1 = cw[3072 + c], w2 = cw[6144 + c], bb = cbias[c];
        float x[10];
        x[0] = k > 0 ? bf1(UT[base - 1]) : 0.f; x[9] = k < 255 ? bf1(UT[base + 8]) : 0.f;
        x[1] = bf_lo(w.x); x[2] = bf_hi(w.x); x[3] = bf_lo(w.y); x[4] = bf_hi(w.y); x[5] = bf_lo(w.z); x[6] = bf_hi(w.z); x[7] = bf_lo(w.w); x[8] = bf_hi(w.w);
        float o[8];
#pragma unroll
        for (int j = 0; j < 8; ++j) o[j] = bb + w0 * x[j] + w1 * x[j + 1] + w2 * x[j + 2];
        v4u r; r.x = pk2(o[0], o[1]); r.y = pk2(o[2], o[3]); r.z = pk2(o[4], o[5]); r.w = pk2(o[6], o[7]);
        *(v4u*)(UC + base) = r;
    }
}
constexpr int LC_CPB = 8224, LC_RAW = 8 * LC_CPB, LC_RAWSZ = 32 * 512, LC_HALO = LC_RAW + 2 * LC_RAWSZ, LC_VBP = 528, LC_VB0 = LC_HALO + 2 * 8192, LC_VBSZ = 32 * LC_VBP;
static_assert(LC_VB0 + 2 * LC_VBSZ <= LDS_MISC && 8 * 32 * 528 <= LDS_MISC, "lconv LDS map");
struct Taps { float w0, w1, w2, b; };
__device__ __forceinline__ float bfh(unsigned w, int hi) { return hi ? bf_hi(w) : bf_lo(w); }
template <bool CONVIN>
__device__ __forceinline__ void lconv_unit(const bf16* vin, const Taps ti, const bf16* F, const bf16* graw, const Taps tg, float fb, bf16* out, LAS unsigned char* lds, int tid, int lane, int wave) {
    __syncthreads();
#define LC_DMA(ch, rb) do { _Pragma("unroll") for (int q = 0; q < 2; ++q) { const int row = wave * 4 + 2 * q + (ln >> 5); \
        __builtin_amdgcn_global_load_lds((const unsigned*)(vin + (size_t)row * 2048 + (ch) * 256 + (ln & 31) * 8), (LAS unsigned*)(lds + LC_RAW + (rb) * LC_RAWSZ + (wave * 4 + 2 * q) * 512), 16, 0, 0); } \
        { const int hrow = wave * 4 + ((ln & 7) >> 1); int hs = (ln & 1) ? (ch) * 256 + 256 : (ch) * 256 - 8; hs = hs < 0 ? 0 : (hs > 2040 ? 2040 : hs); \
          __builtin_amdgcn_global_load_lds((const unsigned*)(vin + (size_t)hrow * 2048 + hs), (LAS unsigned*)(lds + LC_HALO + (rb) * 8192 + wave * 1024), 16, 0, 0); } } while (0)
    LAS bf16* Fl = (LAS bf16*)(lds + LC_VB0 + LC_VBSZ);
    { int ln = lane; asm volatile("" : "+v"(ln)); LC_DMA(0, 0); LC_DMA(1, 1); }
    if (tid < 256) *(LAS v4u*)(Fl + tid * 8) = *(const v4u*)(F + tid * 8);
    __syncthreads();
    if (tid == 0) Fl[1024] = (bf16)f2bf(bf1(Fl[1024]) + fb);
    __syncthreads();
#pragma unroll 1
    for (int a = 0; a < 8; ++a)
#pragma unroll 1
        for (int mi = tid; mi < 2056; mi += NTHR) { const int m = mi * 2; const int x0 = 3079 - m - a, x1 = x0 - 1;
            const unsigned lo = (x0 >= 0 && x0 <= 2047) ? (unsigned)Fl[x0] : 0u, hi = (x1 >= 0 && x1 <= 2047) ? (unsigned)Fl[x1] : 0u;
            *(LAS unsigned*)(lds + a * LC_CPB + m * 2) = lo | (hi << 16); }
    const int r = lane & 31, h = lane >> 5, a = (7 - r) & 7;
    const LAS unsigned char* cpA = lds + a * LC_CPB + 2 * (1023 - r + 8 * h - a + 1032) - 512 * wave;
    const int laneB = r * LC_VBP + 16 * h;
#define LC_CONVERT(ch, rb, buf) do { _Pragma("unroll") for (int q = 0; q < 2; ++q) { const int pid = ln + 64 * q, row = wave * 4 + (pid >> 5), pp = pid & 31; const LAS unsigned char* rp = lds + LC_RAW + (rb) * LC_RAWSZ + row * 512 + pp * 16; \
        const v4u w = *(const LAS v4u*)rp; v4u o = w; \
        if (CONVIN) { const LAS unsigned char* hp_ = lds + LC_HALO + (rb) * 8192 + wave * 1024 + (pid >> 5) * 32; float x[10]; \
            x[0] = pp > 0 ? bf1(*(const LAS bf16*)(rp - 2)) : ((ch) > 0 ? bf1(*(const LAS bf16*)(hp_ + 14)) : 0.f); x[9] = pp < 31 ? bf1(*(const LAS bf16*)(rp + 16)) : ((ch) < 7 ? bf1(*(const LAS bf16*)(hp_ + 16)) : 0.f); \
            x[1] = bf_lo(w.x); x[2] = bf_hi(w.x); x[3] = bf_lo(w.y); x[4] = bf_hi(w.y); x[5] = bf_lo(w.z); x[6] = bf_hi(w.z); x[7] = bf_lo(w.w); x[8] = bf_hi(w.w); \
            float y[8]; _Pragma("unroll") for (int j = 0; j < 8; ++j) y[j] = ti.b + ti.w0 * x[j] + ti.w1 * x[j + 1] + ti.w2 * x[j + 2]; \
            o.x = pk2(y[0], y[1]); o.y = pk2(y[2], y[3]); o.z = pk2(y[4], y[5]); o.w = pk2(y[6], y[7]); } \
        *(LAS v4u*)(lds + LC_VB0 + (buf) * LC_VBSZ + row * LC_VBP + pp * 16) = o; } } while (0)
    { int ln = lane; asm volatile("" : "+v"(ln));
    asm volatile("s_waitcnt vmcnt(3)" ::: "memory");
    LC_CONVERT(0, 0, 0); }
    asm volatile("s_waitcnt lgkmcnt(0)" ::: "memory"); __builtin_amdgcn_s_barrier(); asm volatile("" ::: "memory");
    f32x16 acc[8];
#pragma unroll
    for (int i = 0; i < 8; ++i)
#pragma unroll
        for (int q = 0; q < 16; ++q) acc[i][q] = 0.f;
    bf16x8 E[8], O[8];
    bool primed = false;
#pragma unroll 1
    for (int ch = 0; ch < 8; ++ch) {
        int ln = lane; asm volatile("" : "+v"(ln));
        if (ch < 6) LC_DMA(ch + 2, ch & 1);
        const int du = wave - ch;
        if (du >= -4 && du <= 4) {
            const LAS unsigned char* ca = cpA + 64 * (ch * 8); const LAS unsigned char* vbh = lds + LC_VB0 + (ch & 1) * LC_VBSZ + laneB;
            if (!primed) { primed = true;
#pragma unroll
                for (int i = 1; i < 8; ++i) { E[(8 - i) & 7] = *(const LAS bf16x8*)(ca + 32 * (-2 * i)); O[(8 - i) & 7] = *(const LAS bf16x8*)(ca + 32 * (-2 * i + 1)); }
                E[0] = *(const LAS bf16x8*)ca; O[0] = *(const LAS bf16x8*)(ca + 32); }
            bf16x8 bc0 = *(const LAS bf16x8*)vbh, bc1 = *(const LAS bf16x8*)(vbh + 32);
#pragma unroll
            for (int mm = 0; mm < 8; ++mm) {
                bf16x8 bn0 = bc0, bn1 = bc1;
                if (mm < 7) { bn0 = *(const LAS bf16x8*)(vbh + 64 * (mm + 1)); bn1 = *(const LAS bf16x8*)(vbh + 64 * (mm + 1) + 32); }
                acc[7] = __builtin_amdgcn_mfma_f32_32x32x16_bf16(E[(mm + 1) & 7], bc0, acc[7], 0, 0, 0);
                E[(mm + 1) & 7] = *(const LAS bf16x8*)(ca + 64 * (mm + 1));
#pragma unroll
                for (int i = 0; i < 7; ++i) acc[i] = __builtin_amdgcn_mfma_f32_32x32x16_bf16(E[(mm - i) & 7], bc0, acc[i], 0, 0, 0);
                acc[7] = __builtin_amdgcn_mfma_f32_32x32x16_bf16(O[(mm + 1) & 7], bc1, acc[7], 0, 0, 0);
                O[(mm + 1) & 7] = *(const LAS bf16x8*)(ca + 64 * (mm + 1) + 32);
#pragma unroll
                for (int i = 0; i < 7; ++i) acc[i] = __builtin_amdgcn_mfma_f32_32x32x16_bf16(O[(mm - i) & 7], bc1, acc[i], 0, 0, 0);
                bc0 = bn0; bc1 = bn1;
            }
        }
        if (ch < 7) { if (ch < 6) asm volatile("s_waitcnt vmcnt(3)" ::: "memory"); else asm volatile("s_waitcnt vmcnt(0)" ::: "memory"); LC_CONVERT(ch + 1, (ch + 1) & 1, (ch + 1) & 1); }
        asm volatile("s_waitcnt lgkmcnt(0)" ::: "memory"); __builtin_amdgcn_s_barrier(); asm volatile("" ::: "memory");
    }
#undef LC_DMA
#undef LC_CONVERT
    { int le = lane; asm volatile("" : "+v"(le)); const int re = le & 31, he = le >> 5;
      LAS unsigned char* tw = lds + wave * (32 * 528);
#pragma unroll
      for (int i = 0; i < 8; ++i)
#pragma unroll
          for (int g = 0; g < 4; ++g) { v2u w; w.x = pk2(acc[i][4 * g + 0], acc[i][4 * g + 1]); w.y = pk2(acc[i][4 * g + 2], acc[i][4 * g + 3]); *(LAS v2u*)(tw + re * 528 + (32 * i + 8 * g + 4 * he) * 2) = w; }
      LDS_WAIT(); asm volatile("" ::: "memory");
      const int pp = le & 31;
      v4u gwa[16]; float hal[16];
      const bool hprev = pp == 0 && wave > 0, hnext = pp == 31 && wave < 7;
#pragma unroll
      for (int it = 0; it < 16; ++it) { const size_t off = (size_t)(2 * it + (le >> 5)) * 2048 + 256 * wave + pp * 8; gwa[it] = *(const v4u*)(graw + off);
          hal[it] = (hprev || hnext) ? bf1(graw[hprev ? off - 1 : off + 8]) : 0.f; }
#pragma unroll
      for (int it = 0; it < 16; ++it) { const int row = 2 * it + (le >> 5); const size_t off = (size_t)row * 2048 + 256 * wave + pp * 8;
          const v4u gw = gwa[it]; const v4u aw = *(const LAS v4u*)(tw + row * 528 + pp * 16);
          const float hp = hal[it], hn = hal[it];
          float gx[10]; gx[1] = bf_lo(gw.x); gx[2] = bf_hi(gw.x); gx[3] = bf_lo(gw.y); gx[4] = bf_hi(gw.y); gx[5] = bf_lo(gw.z); gx[6] = bf_hi(gw.z); gx[7] = bf_lo(gw.w); gx[8] = bf_hi(gw.w);
          const float fromprev = shidx(gx[8], le - 1), fromnext = shidx(gx[1], le + 1);
          gx[0] = pp > 0 ? fromprev : hp; gx[9] = pp < 31 ? fromnext : hn;
          const float av[8] = {bf_lo(aw.x), bf_hi(aw.x), bf_lo(aw.y), bf_hi(aw.y), bf_lo(aw.z), bf_hi(aw.z), bf_lo(aw.w), bf_hi(aw.w)};
          float o[8];
#pragma unroll
          for (int j = 0; j < 8; ++j) o[j] = (tg.b + tg.w0 * gx[j] + tg.w1 * gx[j + 1] + tg.w2 * gx[j + 2]) * av[j];
          v4u w; w.x = pk2(o[0], o[1]); w.y = pk2(o[2], o[3]); w.z = pk2(o[4], o[5]); w.w = pk2(o[6], o[7]);
          *(v4u*)(out + off) = w; }
    }
}
template <bool CONVIN>
__device__ __forceinline__ void ph_lconv(const Params& p, int o, const bf16* IN, const bf16* UT, bf16* OUT, LAS unsigned char* lds, int tid, int lane, int wave) {
    const bf16* FILT = (const bf16*)(p.ws + WS_FILT); const float* cw = p.in[I_CONVHYW]; const float* cbias = p.in[I_CONVHYB];
#pragma unroll 1
    for (int c = blockIdx.x; c < 1024; c += gridDim.x) { const int gc = (1 + o) * 1024 + c;
        const Taps ti{cw[c], cw[3072 + c], cw[6144 + c], cbias[c]}, tg{cw[gc], cw[3072 + gc], cw[6144 + gc], cbias[gc]};
        lconv_unit<CONVIN>(IN + (size_t)c * T, ti, FILT + (size_t)(o * 1024 + c) * 2048, UT + (size_t)gc * T, tg, p.in[I_FBIAS][o * 1024 + c], OUT + (size_t)c * T, lds, tid, lane, wave); }
}
__device__ __forceinline__ void ph_transpose(const bf16* Y2T, bf16* Y2, LAS unsigned char* lds, int lane, int wave, int panel) {
    LAS unsigned char* tl = lds + wave * 16384;
#pragma unroll 1
    for (int tile = wave; tile < 64; tile += NWAVES) { const int c0 = (tile & 15) * 64, t0 = panel * 256 + (tile >> 4) * 64;
#pragma unroll
        for (int rr = 0; rr < 8; ++rr) { const int row = rr * 8 + (lane >> 3), pc = lane & 7;
            *(LAS v4u*)(tl + row * 144 + pc * 16) = *(const v4u*)(Y2T + (size_t)(c0 + row) * T + t0 + pc * 8); }
        LDS_WAIT(); asm volatile("" ::: "memory");
#pragma unroll
        for (int rr = 0; rr < 8; ++rr) { const int tk = rr * 8 + (lane >> 3), cp = (lane & 7) * 8;
            unsigned short e[8];
#pragma unroll
            for (int j = 0; j < 8; ++j) e[j] = *(const LAS unsigned short*)(tl + (cp + j) * 144 + tk * 2);
            v4u w; w.x = e[0] | ((unsigned)e[1] << 16); w.y = e[2] | ((unsigned)e[3] << 16); w.z = e[4] | ((unsigned)e[5] << 16); w.w = e[6] | ((unsigned)e[7] << 16);
            *(v4u*)(Y2 + (size_t)(t0 + tk) * D + c0 + cp) = w; }
        LDS_WAIT(); asm volatile("" ::: "memory");
    }
}

constexpr float QSCALE = 0.125f * 1.4426950408889634f;
struct InprojSched { int G, c;
    __device__ __forceinline__ bool next(int i, Unit& u) const { const int L = i * G + c; if (L >= 3840 + 288) return false;
        if (L < 3840) { u.pm = L / 15; u.pn = L % 15; } else { const int q = L - 3840; u.pm = 256 + q / 9; u.pn = 6 + q % 9; } return true; }
    __device__ __forceinline__ int arow(int r) const { return r; }
    __device__ __forceinline__ void* probe_ts() const { return nullptr; } };
struct EpiInproj { static constexpr bool PERM = true, AFTER_DRAIN = false, PROBE = false; unsigned char* big; const float* rope; float* gates; const float* gate_b;
    __device__ __forceinline__ void operator()(const f32x4 (&acc)[2][2][4][2], const Unit& u, int wr, int wc, int fr, int fq) const {
        const bool ctx = u.pm >= 256; const int b = ctx ? u.pm - 256 : (u.pm >> 3), r0 = ctx ? 0 : (u.pm & 7) * 256;
        if (u.pn == 14) {
            if (wc != 0 || fq >= 2) return;
            const f32x4 gb0 = *(const f32x4*)(gate_b + 8 * fq), gb1 = *(const f32x4*)(gate_b + 8 * fq + 4);
#pragma unroll
            for (int ai = 0; ai < 2; ++ai)
#pragma unroll
                for (int m = 0; m < 4; ++m) { const int rr = r0 + wr * 64 + fr + ai * HALF + m * 16; const size_t grow = ctx ? (size_t)T + b * LC + rr : (size_t)b * SEQ + rr;
                    float* gp = gates + grow * 16 + 8 * fq; *(f32x4*)gp = acc[ai][0][m][0] + gb0; *(f32x4*)(gp + 4) = acc[ai][0][m][1] + gb1; }
            return; }
        const int t = u.pn >> 1;
        constexpr size_t offs[7] = {A0_QA, A0_BQ, A0_BO, A0_KA, A0_VA, A0_BK, A0_BV};
        const bool kv = t >= 3;
        size_t toff = A0_QA;
#pragma unroll
        for (int q = 0; q < 7; ++q) if (t == q) toff = offs[q];
        bf16* O = (bf16*)(big + toff) + (size_t)b * (kv ? (SEQ + LC) : SEQ) * 512 + (size_t)((kv && !ctx) ? LC : 0) * 512;
        const bool rope_on = (t == 0 || t == 3) && !ctx; const float qs = t == 0 ? QSCALE : 1.f;
        const int col0 = (u.pn & 1) * 256 + wc * 32 + 8 * fq;
#pragma unroll
        for (int ai = 0; ai < 2; ++ai)
#pragma unroll
            for (int m = 0; m < 4; ++m) { const int rr = r0 + wr * 64 + fr + ai * HALF + m * 16; bf16* rowp = O + (size_t)rr * 512 + col0;
                f32x4 cs0 = (f32x4){1.f, 0.f, 1.f, 0.f}, cs1 = cs0;
                if (rope_on) { const int pos = (wc & 1) ? (rr & 63) : (rr >> 6); const float* rp = rope + (size_t)(pos * 16 + 4 * fq) * 2; cs0 = *(const f32x4*)rp; cs1 = *(const f32x4*)(rp + 4); }
#pragma unroll
                for (int bj = 0; bj < 2; ++bj) { const f32x4 x0 = acc[ai][bj][m][0], x1 = acc[ai][bj][m][1];
                    f32x4 o0, o1;
                    o0[0] = x0[0] * cs0[0] - x1[0] * cs0[1]; o1[0] = x1[0] * cs0[0] + x0[0] * cs0[1];
                    o0[1] = x0[1] * cs0[2] - x1[1] * cs0[3]; o1[1] = x1[1] * cs0[2] + x0[1] * cs0[3];
                    o0[2] = x0[2] * cs1[0] - x1[2] * cs1[1]; o1[2] = x1[2] * cs1[0] + x0[2] * cs1[1];
                    o0[3] = x0[3] * cs1[2] - x1[3] * cs1[3]; o1[3] = x1[3] * cs1[2] + x0[3] * cs1[3];
                    o0 = o0 * qs; o1 = o1 * qs;
                    u32x4 w; w.x = cvt_pk_bf16(o0[0], o0[1]); w.y = cvt_pk_bf16(o0[2], o0[3]); w.z = cvt_pk_bf16(o1[0], o1[1]); w.w = cvt_pk_bf16(o1[2], o1[3]);
                    *(u32x4*)(rowp + bj * HALF) = w; } }
    } };
__device__ __forceinline__ void ph_transpose_b(const bf16* src, bf16* dst, int NBt, int R, int C, LAS unsigned char* lds, int lane, int wave) {
    LAS unsigned char* tl = lds + wave * 16384;
    const int gw = blockIdx.x * NWAVES + wave, NGW = gridDim.x * NWAVES; const int tr = R / 64, tc = C / 64, per = tr * tc;
#pragma unroll 1
    for (int tile = gw; tile < NBt * per; tile += NGW) { const int bt = tile / per, q = tile % per, c0 = (q % tc) * 64, r0 = (q / tc) * 64;
        const bf16* s = src + (size_t)bt * R * C; bf16* d = dst + (size_t)bt * R * C;
#pragma unroll
        for (int rr = 0; rr < 8; ++rr) { const int row = rr * 8 + (lane >> 3), pc = lane & 7;
            *(LAS v4u*)(tl + row * 144 + pc * 16) = *(const v4u*)(s + (size_t)(r0 + row) * C + c0 + pc * 8); }
        LDS_WAIT(); asm volatile("" ::: "memory");
#pragma unroll
        for (int rr = 0; rr < 8; ++rr) { const int cc = rr * 8 + (lane >> 3), rp = (lane & 7) * 8;
            unsigned short e[8];
#pragma unroll
            for (int j = 0; j < 8; ++j) e[j] = *(const LAS unsigned short*)(tl + (rp + j) * 144 + cc * 2);
            v4u w; w.x = e[0] | ((unsigned)e[1] << 16); w.y = e[2] | ((unsigned)e[3] << 16); w.z = e[4] | ((unsigned)e[5] << 16); w.w = e[6] | ((unsigned)e[7] << 16);
            *(v4u*)(d + (size_t)(c0 + cc) * R + r0 + rp) = w; }
        LDS_WAIT(); asm volatile("" ::: "memory");
    }
}

typedef short s16x4 __attribute__((ext_vector_type(4)));
__device__ __forceinline__ u32x2 tr16(const LAS unsigned char* p) { return __builtin_bit_cast(u32x2, __builtin_amdgcn_ds_read_tr16_b64_v4i16((LAS s16x4*)p)); }
typedef float f32x2 __attribute__((ext_vector_type(2)));
constexpr int AT_KP = 272, AT_VP = 320  , AT_KB = 64 * AT_KP, AT_VB = 64 * AT_VP, AT_V0 = 2 * AT_KB;
__device__ __forceinline__ void ph_attn(const Params& p, unsigned char* big, LAS unsigned char* lds, int tid, int lane, int wave, int vcu) {
    const bf16* QA = (const bf16*)(big + A0_QA); const bf16* KA = (const bf16*)(big + A0_KA); const bf16* VA = (const bf16*)(big + A0_VA); bf16* MIXIN = (bf16*)(big + A0_MIXIN);
    const int blk = (lane >> 4) & 1, tq = (lane & 15) >> 2, tp = lane & 3;
    const int comp = wave >> 2, qw = wave & 3, r = lane & 31, hh = lane >> 5;
    float lam; { const float* lv = p.in[I_DLAM]; const float a = wave_sum(lv[lane] * lv[64 + lane]), b2 = wave_sum(lv[128 + lane] * lv[192 + lane]); lam = expf(a) - expf(b2) + 0.2f; }
#pragma unroll 1
    for (int unit = vcu; unit < 2048; unit += gridDim.x) {
        const int b = unit >> 6, h = (unit >> 4) & 3, qblk = unit & 15, q0 = qblk * 128 + qw * 32;
        const bf16* Kg = KA + (size_t)b * (SEQ + LC) * 512 + h * 128; const bf16* Vg = VA + (size_t)b * (SEQ + LC) * 512 + h * 128;
        bf16x8 qf[4];
#pragma unroll
        for (int ds = 0; ds < 4; ++ds) qf[ds] = *(const bf16x8*)(QA + ((size_t)b * SEQ + q0 + r) * 512 + h * 128 + comp * 64 + ds * 16 + hh * 8);
        f32x16 oacc[4];
#pragma unroll
        for (int i = 0; i < 4; ++i)
#pragma unroll
            for (int q = 0; q < 16; ++q) oacc[i][q] = 0.f;
        float m_run = 0.f, l_run = 0.f;
        v4u pre[4];
#define AT_LOADG(kt) do { _Pragma("unroll") for (int q = 0; q < 2; ++q) { const int idx = tid + NTHR * q; \
            pre[q] = *(const v4u*)(Kg + (size_t)((kt) * 64 + (idx >> 4)) * 512 + (idx & 15) * 8); \
            pre[2 + q] = *(const v4u*)(Vg + (size_t)((kt) * 64 + (idx >> 4)) * 512 + (idx & 15) * 8); } } while (0)
#define AT_STORES(kn) do { _Pragma("unroll") for (int q = 0; q < 2; ++q) { const int idx = tid + NTHR * q; \
            *(LAS v4u*)(lds + ((kn) & 1) * AT_KB + (idx >> 4) * AT_KP + (idx & 15) * 16) = pre[q]; \
            *(LAS v4u*)(lds + AT_V0 + ((kn) % 3) * AT_VB + (idx >> 4) * AT_VP + (idx & 15) * 16) = pre[2 + q]; } } while (0)
#define AT_PV(PF, VT_) do { const LAS unsigned char* Vt_ = (VT_); _Pragma("unroll") for (int kb = 0; kb < 2; ++kb) _Pragma("unroll") for (int s = 0; s < 2; ++s) _Pragma("unroll") for (int dvb = 0; dvb < 4; ++dvb) { \
            const LAS unsigned char* vp = Vt_ + (32 * kb + 16 * s + 4 * hh + tq) * AT_VP + (32 * dvb + 16 * blk + 4 * tp) * 2; const u32x2 lo = tr16(vp), hi = tr16(vp + 8 * AT_VP); \
            u32x4 vw; vw.x = lo.x; vw.y = lo.y; vw.z = hi.x; vw.w = hi.y; oacc[dvb] = __builtin_amdgcn_mfma_f32_32x32x16_bf16(__builtin_bit_cast(bf16x8, vw), PF[kb][s], oacc[dvb], 0, 0, 0); } } while (0)
        bf16x8 phold[2][2];
        __syncthreads();
        AT_LOADG(0); AT_STORES(0);
        __syncthreads();
#pragma unroll 1
        for (int kt = 0; kt < 36; ++kt) {
            if (kt < 35) AT_LOADG(kt + 1);
            const LAS unsigned char* Kt = lds + (kt & 1) * AT_KB;
            if (comp == 1 && kt > 0) { AT_PV(phold, lds + AT_V0 + ((kt - 1) % 3) * AT_VB); }
            f32x16 sacc[2];
#pragma unroll
            for (int kb = 0; kb < 2; ++kb)
#pragma unroll
                for (int q = 0; q < 16; ++q) sacc[kb][q] = -m_run;
#pragma unroll
            for (int ds = 0; ds < 4; ++ds)
#pragma unroll
                for (int kb = 0; kb < 2; ++kb) { const bf16x8 kf = *(const LAS bf16x8*)(Kt + (32 * kb + r) * AT_KP + comp * 128 + ds * 32 + hh * 16);
                    sacc[kb] = __builtin_amdgcn_mfma_f32_32x32x16_bf16(kf, qf[ds], sacc[kb], 0, 0, 0); }
            float mx = sacc[0][0];
#pragma unroll
            for (int kb = 0; kb < 2; ++kb)
#pragma unroll
                for (int q = 0; q < 16; ++q) mx = fmaxf(mx, sacc[kb][q]);
            mx = fmaxf(mx, shx(mx, 32));
            if (kt == 0 || __builtin_amdgcn_ballot_w64(mx > 0.f) != 0ull) {
                const float dm = kt == 0 ? mx : fmaxf(mx, 0.f), alpha = __builtin_amdgcn_exp2f(-dm); m_run += dm; l_run *= alpha;
#pragma unroll
                for (int kb = 0; kb < 2; ++kb) sacc[kb] = sacc[kb] - dm;
#pragma unroll
                for (int i = 0; i < 4; ++i) oacc[i] = oacc[i] * alpha; }
            f32x2 ps2 = (f32x2){0.f, 0.f};
#pragma unroll
            for (int kb = 0; kb < 2; ++kb)
#pragma unroll
                for (int q = 0; q < 8; ++q) { f32x2 e; e.x = __builtin_amdgcn_exp2f(sacc[kb][2 * q]); e.y = __builtin_amdgcn_exp2f(sacc[kb][2 * q + 1]); sacc[kb][2 * q] = e.x; sacc[kb][2 * q + 1] = e.y; ps2 += e; }
            l_run += ps2.x + ps2.y;
#pragma unroll
            for (int kb = 0; kb < 2; ++kb)
#pragma unroll
                for (int s = 0; s < 2; ++s) {
                    u32x4 pw; pw.x = cvt_pk_bf16(sacc[kb][8 * s + 0], sacc[kb][8 * s + 1]); pw.y = cvt_pk_bf16(sacc[kb][8 * s + 2], sacc[kb][8 * s + 3]);
                    pw.z = cvt_pk_bf16(sacc[kb][8 * s + 4], sacc[kb][8 * s + 5]); pw.w = cvt_pk_bf16(sacc[kb][8 * s + 6], sacc[kb][8 * s + 7]);
                    phold[kb][s] = __builtin_bit_cast(bf16x8, pw); }
            if (comp == 0) { AT_PV(phold, lds + AT_V0 + (kt % 3) * AT_VB); }
            if (kt < 35) AT_STORES(kt + 1);
            __syncthreads();
        }
        if (comp == 1) { AT_PV(phold, lds + AT_V0 + (35 % 3) * AT_VB); }
        __syncthreads();
#undef AT_LOADG
#undef AT_STORES
#undef AT_PV
        const float lsum = l_run + shx(l_run, 32), inv = 1.f / lsum;
        LAS float* X = (LAS float*)lds;
        if (comp == 1) {
#pragma unroll
            for (int dvb = 0; dvb < 4; ++dvb)
#pragma unroll
                for (int q = 0; q < 16; ++q) X[(qw * 64 + dvb * 16 + q) * 64 + lane] = oacc[dvb][q] * inv; }
        __syncthreads();
        if (comp == 0) {
            float ss = 0.f;
#pragma unroll
            for (int dvb = 0; dvb < 4; ++dvb)
#pragma unroll
                for (int q = 0; q < 16; ++q) { const float o = oacc[dvb][q] * inv - lam * X[(qw * 64 + dvb * 16 + q) * 64 + lane]; oacc[dvb][q] = o; ss += o * o; }
            ss += shx(ss, 32);
            const float rn = rsqrtf(ss * (1.f / 128.f) + RMS_EPS) * 0.8f;
            const float* ga = p.in[I_HGA] + h * 128; bf16* orow = MIXIN + ((size_t)b * SEQ + q0 + r) * D + h * 128;
#pragma unroll
            for (int dvb = 0; dvb < 4; ++dvb)
#pragma unroll
                for (int g = 0; g < 4; ++g) { const int dv = 32 * dvb + 8 * g + 4 * hh; const f32x4 gg = *(const f32x4*)(ga + dv);
                    v2u w; w.x = pk2(oacc[dvb][4 * g + 0] * rn * gg[0], oacc[dvb][4 * g + 1] * rn * gg[1]); w.y = pk2(oacc[dvb][4 * g + 2] * rn * gg[2], oacc[dvb][4 * g + 3] * rn * gg[3]);
                    *(v2u*)(orow + dv) = w; }
        }
    }
    __syncthreads();
}

constexpr int ML_P = 272, ML_TILE = 64 * ML_P;
constexpr int ML_VOFF = 3 * ML_TILE, ML_VSZ = 64 * 256;
constexpr int ML_RQ = ML_VOFF + 2 * ML_VSZ, ML_RSZ = 68 * 256, ML_RK = ML_RQ + ML_RSZ;
constexpr int ML_NOFF = ML_RK + ML_RSZ, ML_AOFF = ML_NOFF + 2 * 512;
constexpr int ML_CW = ML_AOFF + 8 * 256;
static_assert(ML_CW + 8 * 512 <= LDS_TAB, "mLSTM LDS map");
__device__ __forceinline__ float logsigmoidf_(float x) { return x >= 0.f ? -__logf(1.f + __expf(-x)) : x - __logf(1.f + __expf(x)); }
__device__ __forceinline__ bf16x8 pack8(const f32x16& v, int s) { u32x4 w; w.x = cvt_pk_bf16(v[8 * s + 0], v[8 * s + 1]); w.y = cvt_pk_bf16(v[8 * s + 2], v[8 * s + 3]); w.z = cvt_pk_bf16(v[8 * s + 4], v[8 * s + 5]); w.w = cvt_pk_bf16(v[8 * s + 6], v[8 * s + 7]); return __builtin_bit_cast(bf16x8, w); }
__device__ __forceinline__ void ph_mlstm(const Params& p, unsigned char* big, LAS unsigned char* lds, int tid, int lane, int wave) {
    const int bid = blockIdx.x; if (bid >= 256) return;
    const int b = bid >> 3, h = (bid >> 1) & 3, dir = bid & 1;
    const bf16* BQ = (const bf16*)(big + A0_BQ) + (size_t)b * SEQ * 512 + h * 128;
    const bf16* BK = (const bf16*)(big + A0_BK) + (size_t)b * (SEQ + LC) * 512 + h * 128;
    const bf16* BV = (const bf16*)(big + A0_BV) + (size_t)b * (SEQ + LC) * 512 + h * 128;
    bf16* HB = (bf16*)(big + A0_HB) + (size_t)dir * T * 512 + (size_t)b * SEQ * 512 + h * 128;
    const float* GT = (const float*)(p.ws + WS_GATES);
    const float* cw = p.in[I_CONVABW]; const float* cb = p.in[I_CONVABB];
    const int eb = wave & 3, tb = wave >> 2, r = lane & 31, hh = lane >> 5;
    const int blk = (lane >> 4) & 1, tq = (lane & 15) >> 2, tp = lane & 3;
    LAS float* nbuf = (LAS float*)(lds + ML_NOFF); LAS float* aw = (LAS float*)(lds + ML_AOFF) + wave * 64;
    if (tid < 256) nbuf[tid] = 0.f;
    LAS float* cwl = (LAS float*)(lds + ML_CW);
    for (int i = tid; i < 1024; i += NTHR) { const int ten = i >> 9, j = (i >> 7) & 3, d = i & 127, ch = ten * 512 + h * 128 + d; cwl[i] = j < 3 ? cw[j * 1024 + ch] : cb[ch]; }
    f32x16 cacc[4];
#pragma unroll
    for (int i = 0; i < 4; ++i)
#pragma unroll
        for (int q = 0; q < 16; ++q) cacc[i][q] = 0.f;
    float m_state = 0.f;
#ifdef ML_PROBE
    unsigned long long accs[6] = {0, 0, 0, 0, 0, 0}; unsigned long long tp0 = __builtin_amdgcn_s_memrealtime();
#define ML_T(i) do { const unsigned long long t1_ = __builtin_amdgcn_s_memrealtime(); accs[i] += t1_ - tp0; tp0 = t1_; } while (0)
#else
#define ML_T(i)
#endif
    float a_c = 0.f, M_c = 0.f, b_c = 0.f, decay_c = 1.f, m_after = 0.f;
    float a_n = 0.f, M_n = 0.f, b_n = 0.f, w_n = 0.f, decay_n = 1.f, m_next = 0.f;
#define ML_POS(cc, t) ((cc) < 4 ? (dir ? 255 - ((cc) * 64 + (t)) : (cc) * 64 + (t)) : (dir ? 2047 - (((cc) - 4) * 64 + (t)) : ((cc) - 4) * 64 + (t)))
#define ML_GLOAD(cc, li_, fp_) do { const int pos_ = ML_POS(cc, lane); const size_t grow_ = (cc) < 4 ? (size_t)T + b * LC + pos_ : (size_t)b * SEQ + pos_; \
        li_ = GT[grow_ * 16 + dir * 8 + h]; fp_ = GT[grow_ * 16 + dir * 8 + 4 + h]; } while (0)
#define ML_SCAN(li_, fp_, m_in) do { const float lf_ = logsigmoidf_(fp_); \
        float bs_ = lf_; _Pragma("unroll") for (int o_ = 1; o_ < 64; o_ <<= 1) { const float v_ = shup(bs_, o_); if (lane >= o_) bs_ += v_; } \
        const float aa_ = (li_) - bs_; float pm_ = aa_; _Pragma("unroll") for (int o_ = 1; o_ < 64; o_ <<= 1) { const float v_ = shup(pm_, o_); if (lane >= o_) pm_ = fmaxf(pm_, v_); } \
        const float MM_ = fmaxf(m_in, pm_); const float M63_ = shidx(MM_, 63), b63_ = shidx(bs_, 63); \
        a_n = aa_; M_n = MM_; b_n = bs_; w_n = __expf(aa_ - M63_); decay_n = __expf((m_in) - M63_); m_next = b63_ + M63_; } while (0)
#define ML_DMA(cc, vbuf) do { const int lim_ = (cc) < 4 ? LC : SEQ, kvb_ = (cc) < 4 ? 0 : LC; \
        _Pragma("unroll 1") for (int ins_ = wave; ins_ < 17; ins_ += NWAVES) { const int rr_ = ins_ * 4 + (lane >> 4), pc_ = lane & 15; int pos_ = ML_POS(cc, rr_ - 1); pos_ = pos_ < 0 ? 0 : (pos_ >= lim_ ? lim_ - 1 : pos_); \
            __builtin_amdgcn_global_load_lds((const unsigned*)(BK + (size_t)(kvb_ + pos_) * 512 + pc_ * 8), (LAS unsigned*)(lds + ML_RK + ins_ * 1024), 16, 0, 0); \
            if ((cc) >= 4) __builtin_amdgcn_global_load_lds((const unsigned*)(BQ + (size_t)pos_ * 512 + pc_ * 8), (LAS unsigned*)(lds + ML_RQ + ins_ * 1024), 16, 0, 0); } \
        _Pragma("unroll") for (int q_ = 0; q_ < 2; ++q_) { const int ins_ = wave * 2 + q_, t_ = ins_ * 4 + (lane >> 4), pc_ = lane & 15; const int pos_ = ML_POS(cc, t_); \
            __builtin_amdgcn_global_load_lds((const unsigned*)(BV + (size_t)(kvb_ + pos_) * 512 + pc_ * 8), (LAS unsigned*)(lds + ML_VOFF + (vbuf) * ML_VSZ + ins_ * 1024), 16, 0, 0); } } while (0)
#define ML_CONV8(dst, rawoff, cc, t_, d8_, ten, scl) do { const int pos_ = ML_POS(cc, t_), lim_ = (cc) < 4 ? LC : SEQ; const int rm_ = dir ? (t_) + 2 : (t_), rp_ = dir ? (t_) : (t_) + 2; \
        v4u x_[3]; x_[0] = *(const LAS v4u*)(lds + (rawoff) + rm_ * 256 + (d8_) * 16); x_[1] = *(const LAS v4u*)(lds + (rawoff) + ((t_) + 1) * 256 + (d8_) * 16); x_[2] = *(const LAS v4u*)(lds + (rawoff) + rp_ * 256 + (d8_) * 16); \
        if (pos_ - 1 < 0) x_[0] = (v4u){0u, 0u, 0u, 0u}; if (pos_ + 1 >= lim_) x_[2] = (v4u){0u, 0u, 0u, 0u}; \
        const LAS float* wl_ = cwl + (ten) * 512 + (d8_) * 8; f32x4 wv_[4][2]; \
        _Pragma("unroll") for (int j_ = 0; j_ < 4; ++j_) { wv_[j_][0] = *(const LAS f32x4*)(wl_ + j_ * 128); wv_[j_][1] = *(const LAS f32x4*)(wl_ + j_ * 128 + 4); } \
        _Pragma("unroll") for (int e_ = 0; e_ < 8; ++e_) { float s_ = wv_[3][e_ >> 2][e_ & 3]; \
            _Pragma("unroll") for (int j_ = 0; j_ < 3; ++j_) { const unsigned w_ = e_ < 2 ? x_[j_].x : e_ < 4 ? x_[j_].y : e_ < 6 ? x_[j_].z : x_[j_].w; s_ += wv_[j_][e_ >> 2][e_ & 3] * ((e_ & 1) ? bf_hi(w_) : bf_lo(w_)); } \
            dst[e_] = __fdividef(s_, 1.f + __expf(-s_)) * (scl); } } while (0)
#define ML_BUILD(cc) do { _Pragma("unroll 1") for (int q_ = 0; q_ < 2; ++q_) { const int idx_ = tid + NTHR * q_, t_ = idx_ >> 4, d8_ = idx_ & 15; \
        float kk_[8]; ML_CONV8(kk_, ML_RK, cc, t_, d8_, 1, 1.f); const float wt_ = shidx(w_n, t_); \
        v4u o_; o_.x = pk2(kk_[0], kk_[1]); o_.y = pk2(kk_[2], kk_[3]); o_.z = pk2(kk_[4], kk_[5]); o_.w = pk2(kk_[6], kk_[7]); *(LAS v4u*)(lds + ML_TILE + t_ * ML_P + d8_ * 16) = o_; \
        o_.x = pk2(kk_[0] * wt_, kk_[1] * wt_); o_.y = pk2(kk_[2] * wt_, kk_[3] * wt_); o_.z = pk2(kk_[4] * wt_, kk_[5] * wt_); o_.w = pk2(kk_[6] * wt_, kk_[7] * wt_); *(LAS v4u*)(lds + 2 * ML_TILE + t_ * ML_P + d8_ * 16) = o_; \
        if ((cc) >= 4) { float qq_[8]; ML_CONV8(qq_, ML_RQ, cc, t_, d8_, 0, 0.08838834764831845f); \
            o_.x = pk2(qq_[0], qq_[1]); o_.y = pk2(qq_[2], qq_[3]); o_.z = pk2(qq_[4], qq_[5]); o_.w = pk2(qq_[6], qq_[7]); *(LAS v4u*)(lds + t_ * ML_P + d8_ * 16) = o_; } } } while (0)
    __syncthreads();
    { float li0, fp0; ML_GLOAD(0, li0, fp0); ML_DMA(0, 0); ML_SCAN(li0, fp0, m_state); }
    asm volatile("s_waitcnt vmcnt(0)" ::: "memory");
    __syncthreads();
    ML_BUILD(0);
    a_c = a_n; M_c = M_n; b_c = b_n; decay_c = decay_n; m_after = m_next;
    __syncthreads();
#pragma unroll 1
    for (int cc = 0; cc < 36; ++cc) {
        const LAS unsigned char* Qs = lds; const LAS unsigned char* Ks = lds + ML_TILE; const LAS unsigned char* Kw = lds + 2 * ML_TILE; const LAS unsigned char* Vs = lds + ML_VOFF + (cc & 1) * ML_VSZ;
        const LAS float* ncur = nbuf + (cc & 1) * 128; LAS float* nnew = nbuf + ((cc + 1) & 1) * 128;
        float li1 = 0.f, fp1 = 0.f;
        ML_T(5);
        if (cc < 35) { ML_GLOAD(cc + 1, li1, fp1); ML_DMA(cc + 1, (cc + 1) & 1); }
        ML_T(0);
        if (cc >= 4) {
            aw[lane] = a_c;
            const int tcol = 32 * tb + r; const float Mt = shidx(M_c, tcol), bt = shidx(b_c, tcol);
            f32x16 nacc;
#pragma unroll
            for (int q = 0; q < 16; ++q) nacc[q] = 0.f;
#pragma unroll
            for (int db = 0; db < 4; ++db)
#pragma unroll
                for (int s2 = 0; s2 < 2; ++s2) { const LAS unsigned char* qp = Qs + tcol * ML_P + (32 * db + 16 * s2 + 4 * hh) * 2; const u32x2 lo = *(const LAS u32x2*)qp, hi = *(const LAS u32x2*)(qp + 16);
                    u32x4 qw; qw.x = lo.x; qw.y = lo.y; qw.z = hi.x; qw.w = hi.y;
                    nacc = __builtin_amdgcn_mfma_f32_32x32x16_bf16(pack8(cacc[db], s2), __builtin_bit_cast(bf16x8, qw), nacc, 0, 0, 0); }
            const float sc = __expf(m_state - Mt);
            nacc = nacc * sc;
            float rs = 0.f;
#pragma unroll
            for (int sb = 0; sb < 2; ++sb) if (sb <= tb) {
                f32x16 sacc;
#pragma unroll
                for (int q = 0; q < 16; ++q) sacc[q] = 0.f;
#pragma unroll
                for (int ds = 0; ds < 8; ++ds) { const bf16x8 kf = *(const LAS bf16x8*)(Ks + (32 * sb + r) * ML_P + (16 * ds + 8 * hh) * 2), qf = *(const LAS bf16x8*)(Qs + tcol * ML_P + (16 * ds + 8 * hh) * 2);
                    sacc = __builtin_amdgcn_mfma_f32_32x32x16_bf16(kf, qf, sacc, 0, 0, 0); }
#pragma unroll
                for (int g = 0; g < 4; ++g) { const int s0 = 32 * sb + 8 * g + 4 * hh; const f32x4 av = *(const LAS f32x4*)(aw + s0);
#pragma unroll
                    for (int j = 0; j < 4; ++j) { const bool keep = (s0 + j) <= tcol; const float v = keep ? sacc[4 * g + j] * __expf(av[j] - Mt) : 0.f; sacc[4 * g + j] = v; rs += v; } }
#pragma unroll
                for (int s2 = 0; s2 < 2; ++s2) { u32x4 vw;
                    { const u32x2 t0 = tr16(Vs + (32 * sb + 16 * s2 + 4 * hh + tq) * 256 + (32 * eb + 16 * blk + 4 * tp) * 2), t1 = tr16(Vs + (32 * sb + 16 * s2 + 8 + 4 * hh + tq) * 256 + (32 * eb + 16 * blk + 4 * tp) * 2);
                      vw.x = t0.x; vw.y = t0.y; vw.z = t1.x; vw.w = t1.y; }
                    nacc = __builtin_amdgcn_mfma_f32_32x32x16_bf16(__builtin_bit_cast(bf16x8, vw), pack8(sacc, s2), nacc, 0, 0, 0); } }
            rs += shx(rs, 32);
            float qn = 0.f;
            { const LAS unsigned char* qp = Qs + tcol * ML_P + (64 * hh) * 2;
#pragma unroll
              for (int c8 = 0; c8 < 8; ++c8) { const v4u w = *(const LAS v4u*)(qp + c8 * 16); const f32x4 n0 = *(const LAS f32x4*)(ncur + 64 * hh + 8 * c8), n1 = *(const LAS f32x4*)(ncur + 64 * hh + 8 * c8 + 4);
                  qn += bf_lo(w.x) * n0[0] + bf_hi(w.x) * n0[1] + bf_lo(w.y) * n0[2] + bf_hi(w.y) * n0[3] + bf_lo(w.z) * n1[0] + bf_hi(w.z) * n1[1] + bf_lo(w.w) * n1[2] + bf_hi(w.w) * n1[3]; } }
            qn += shx(qn, 32);
            const float den = sc * qn + rs; const float dd = __frcp_rn(fmaxf(fabsf(den), __expf(-(bt + Mt))));
            { const int pos = ML_POS(cc, tcol); bf16* hrow = HB + (size_t)pos * 512 + 32 * eb;
#pragma unroll
              for (int g = 0; g < 4; ++g) { v2u w; w.x = pk2(nacc[4 * g + 0] * dd, nacc[4 * g + 1] * dd); w.y = pk2(nacc[4 * g + 2] * dd, nacc[4 * g + 3] * dd); *(v2u*)(hrow + 8 * g + 4 * hh) = w; } }
        }
        ML_T(1);
#pragma unroll
        for (int db = 0; db < 4; ++db) { cacc[db] = cacc[db] * decay_c;
#pragma unroll
            for (int s4 = 0; s4 < 4; ++s4) { u32x4 ka, vb;
                { const u32x2 t0 = tr16(Kw + (16 * s4 + 8 * hh + tq) * ML_P + (32 * db + 16 * blk + 4 * tp) * 2), t1 = tr16(Kw + (16 * s4 + 8 * hh + 4 + tq) * ML_P + (32 * db + 16 * blk + 4 * tp) * 2);
                  ka.x = t0.x; ka.y = t0.y; ka.z = t1.x; ka.w = t1.y; }
                { const u32x2 t0 = tr16(Vs + (16 * s4 + 8 * hh + tq) * 256 + (32 * eb + 16 * blk + 4 * tp) * 2), t1 = tr16(Vs + (16 * s4 + 8 * hh + 4 + tq) * 256 + (32 * eb + 16 * blk + 4 * tp) * 2);
                  vb.x = t0.x; vb.y = t0.y; vb.z = t1.x; vb.w = t1.y; }
                cacc[db] = __builtin_amdgcn_mfma_f32_32x32x16_bf16(__builtin_bit_cast(bf16x8, ka), __builtin_bit_cast(bf16x8, vb), cacc[db], 0, 0, 0); } }
        { const int d = tid >> 2, part = tid & 3; float s = 0.f;
#pragma unroll
            for (int t = 0; t < 16; ++t) s += bf1(*(const LAS bf16*)(Kw + (part * 16 + t) * ML_P + d * 2));
            s += shx(s, 1); s += shx(s, 2);
            if (part == 0) nnew[d] = decay_c * ncur[d] + s; }
        m_state = m_after;
        ML_T(2);
        asm volatile("s_waitcnt vmcnt(0)" ::: "memory");
        __syncthreads();
        ML_T(3);
        if (cc < 35) { ML_SCAN(li1, fp1, m_state); ML_BUILD(cc + 1); a_c = a_n; M_c = M_n; b_c = b_n; decay_c = decay_n; m_after = m_next; }
        ML_T(4);
        __syncthreads();
    }
#ifdef ML_PROBE
    if (blockIdx.x == 0 && tid == 0) { unsigned long long* ts = (unsigned long long*)(p.ws + WS_CTL + 32768); ts[50] = 0; unsigned long long c_ = 0; for (int i = 0; i < 6; ++i) { c_ += accs[i]; ts[51 + i] = c_; } }
#endif
#undef ML_T
#undef ML_POS
#undef ML_GLOAD
#undef ML_SCAN
#undef ML_DMA
#undef ML_CONV8
#undef ML_BUILD
}
__device__ __forceinline__ void ph_outb(const Params& p, unsigned char* big, int lane, int wave, int tile) {
    const int gw = tile * NWAVES + wave;
    const bf16* HBf = (const bf16*)(big + A0_HB); const bf16* HBb = HBf + (size_t)T * 512; const bf16* BO = (const bf16*)(big + A0_BO); bf16* MIXIN = (bf16*)(big + A0_MIXIN);
    const float* gb = p.in[I_HGB];
    const f32x4 g0 = *(const f32x4*)(gb + lane * 8), g1 = *(const f32x4*)(gb + lane * 8 + 4);
#pragma unroll 2
    for (int m = gw * 32; m < gw * 32 + 32; ++m) {
        const v4u f = *(const v4u*)(HBf + (size_t)m * 512 + lane * 8), bw = *(const v4u*)(HBb + (size_t)m * 512 + lane * 8), go = *(const v4u*)(BO + (size_t)m * 512 + lane * 8);
        float x[8], o[8]; x[0] = bf_lo(f.x) + bf_lo(bw.x); x[1] = bf_hi(f.x) + bf_hi(bw.x); x[2] = bf_lo(f.y) + bf_lo(bw.y); x[3] = bf_hi(f.y) + bf_hi(bw.y);
        x[4] = bf_lo(f.z) + bf_lo(bw.z); x[5] = bf_hi(f.z) + bf_hi(bw.z); x[6] = bf_lo(f.w) + bf_lo(bw.w); x[7] = bf_hi(f.w) + bf_hi(bw.w);
        o[0] = bf_lo(go.x); o[1] = bf_hi(go.x); o[2] = bf_lo(go.y); o[3] = bf_hi(go.y); o[4] = bf_lo(go.z); o[5] = bf_hi(go.z); o[6] = bf_lo(go.w); o[7] = bf_hi(go.w);
        float ss = 0.f;
#pragma unroll
        for (int j = 0; j < 8; ++j) ss += x[j] * x[j];
        ss += shx(ss, 1); ss += shx(ss, 2); ss += shx(ss, 4); ss += shx(ss, 8);
        const float rn = rsqrtf(ss * (1.f / 128.f) + RMS_EPS);
        float y[8];
#pragma unroll
        for (int j = 0; j < 8; ++j) y[j] = x[j] * rn * (j < 4 ? g0[j] : g1[j - 4]) * sigmoidf_(o[j]);
        v4u w; w.x = pk2(y[0], y[1]); w.y = pk2(y[2], y[3]); w.z = pk2(y[4], y[5]); w.w = pk2(y[6], y[7]);
        *(v4u*)(MIXIN + (size_t)m * D + 512 + lane * 8) = w;
    }
}

constexpr int CW_DBG = 16;
#ifndef DBG_MODE
#define DBG_MODE 0
#endif
#ifndef DBG_L
#define DBG_L 0
#endif
#ifndef DBG_CH
#define DBG_CH 0
#endif
__device__ __forceinline__ void dbg_report(const Params& p, float d) {
    if (!(d >= 0.f)) d = 1.0e6f;
    atomicMax((unsigned*)(p.ws + WS_CTL) + CW_DBG, __float_as_uint(d));
}
__device__ __forceinline__ float block_max(float v, LAS float* red, int tid) { v = wave_max(v); __syncthreads(); if ((tid & 63) == 0) red[tid >> 6] = v; __syncthreads(); float r = red[0];
#pragma unroll
    for (int w = 1; w < 8; ++w) r = fmaxf(r, red[w]); __syncthreads(); return r; }
__device__ __forceinline__ float block_sum(float v, LAS float* red, int tid) { v = wave_sum(v); __syncthreads(); if ((tid & 63) == 0) red[tid >> 6] = v; __syncthreads(); float r = 0.f;
#pragma unroll
    for (int w = 0; w < 8; ++w) r += red[w]; __syncthreads(); return r; }
__device__ __forceinline__ void dbg_moe_check(const Params& p, int l, int ch, const bf16* H2, const bf16* Y, LAS unsigned char* lds, int tid) {
    LAS float* hrow = (LAS float*)lds; LAS float* gu = hrow + 1024; LAS float* a = gu + 512; LAS float* red = a + 256;
    const int t = ch * CHT + blockIdx.x * 64 + 5;
    __syncthreads();
    for (int i = tid; i < 1024; i += NTHR) hrow[i] = bf1(H2[(size_t)t * D + i]);
    __syncthreads();
    const int* EIDX = (const int*)(p.ws + WS_EIDX); const float* WTS = (const float*)(p.ws + WS_WTS); const int* PSLOT = (const int*)(p.ws + WS_PSLOT);
    float yacc[2] = {0.f, 0.f};
#pragma unroll 1
    for (int k = 0; k < 9; ++k) {
        const int e = k < 8 ? (EIDX[(size_t)t * 8 + k] & 255) : 64; const float w = k < 8 ? WTS[(size_t)t * 8 + k] : 1.f;
        const float* Wgu = e < 64 ? p.in[I_EGU] + (size_t)(l * 64 + e) * 1024 * 512 : p.in[I_SGU] + (size_t)l * 1024 * 512;
        const float* Wdn = e < 64 ? p.in[I_EDN] + (size_t)(l * 64 + e) * 256 * 1024 : p.in[I_SDN] + (size_t)l * 256 * 1024;
        float s = 0.f;
#pragma unroll 4
        for (int kk = 0; kk < 1024; ++kk) s += hrow[kk] * Wgu[(size_t)kk * 512 + tid];
        gu[tid] = s;
        __syncthreads();
        if (tid < 256) a[tid] = siluf_(gu[tid]) * gu[256 + tid];
        __syncthreads();
#pragma unroll
        for (int q = 0; q < 2; ++q) { const int n = tid + 512 * q; float s2 = 0.f;
#pragma unroll 4
            for (int j = 0; j < 256; ++j) s2 += a[j] * Wdn[(size_t)j * 1024 + n];
            yacc[q] += w * s2; }
        __syncthreads();
    }
    float err = 0.f, ss = 0.f;
#pragma unroll
    for (int q = 0; q < 2; ++q) { const int n = tid + 512 * q; float f = 0.f;
#pragma unroll 1
        for (int k = 0; k < 9; ++k) { const int slot = PSLOT[(size_t)t * 16 + k]; const float w = k < 8 ? WTS[(size_t)t * 8 + k] : 1.f; f += w * bf1(Y[(size_t)slot * D + n]); }
        err = fmaxf(err, fabsf(f - yacc[q])); ss += yacc[q] * yacc[q]; }
    const float me = block_max(err, red, tid), sq = block_sum(ss, red, tid);
    if (tid == 0) dbg_report(p, me / sqrtf(sq * (1.f / 1024.f) + 1e-30f));
}
__device__ __forceinline__ void dbg_route_check(const Params& p, int l, const bf16* H2, const float* LOG, LAS unsigned char* lds, int tid) {
    LAS float* hrow = (LAS float*)lds; LAS float* lg = hrow + 1024; LAS float* bi = lg + 64; LAS float* sc = bi + 64; LAS float* red = sc + 64;
    const int t = blockIdx.x * 256 + 77;
    __syncthreads();
    for (int i = tid; i < 1024; i += NTHR) hrow[i] = bf1(H2[(size_t)t * D + i]);
    __syncthreads();
    if (tid < 64) { float s = 0.f; const float* W = p.in[I_RW] + (size_t)l * 1024 * 64;
#pragma unroll 4
        for (int k = 0; k < 1024; ++k) s += hrow[k] * W[k * 64 + tid];
        lg[tid] = s; sc[tid] = 1.f / (1.f + expf(-s)); bi[tid] = sc[tid] + p.in[I_RB][l * 64 + tid]; }
    __syncthreads();
    if (tid == 0) {
        float lerr = 0.f;
#pragma unroll 1
        for (int e = 0; e < 64; ++e) lerr = fmaxf(lerr, fabsf(lg[e] - LOG[(size_t)t * 64 + e]));
        float grp[8];
#pragma unroll
        for (int g = 0; g < 8; ++g) { float a = -1e30f, b = -1e30f;
#pragma unroll 1
            for (int j = 0; j < 8; ++j) { const float v = bi[g * 8 + j]; if (v > a) { b = a; a = v; } else if (v > b) b = v; } grp[g] = a + b; }
        unsigned gm = 0;
#pragma unroll 1
        for (int r = 0; r < 4; ++r) { int best = -1; float bv = 0.f;
#pragma unroll
            for (int g = 0; g < 8; ++g) if (!((gm >> g) & 1u) && (best < 0 || grp[g] > bv)) { best = g; bv = grp[g]; }
            gm |= 1u << best; }
        unsigned long long set_ref = 0ull; float ssum = 0.f;
#pragma unroll 1
        for (int r = 0; r < 8; ++r) { int best = -1; float bv = 0.f;
#pragma unroll 1
            for (int e = 0; e < 64; ++e) if (((gm >> (e >> 3)) & 1u) && !((set_ref >> e) & 1ull) && (best < 0 || bi[e] > bv)) { best = e; bv = bi[e]; }
            set_ref |= 1ull << best; ssum += sc[best]; }
        const int* EIDX = (const int*)(p.ws + WS_EIDX); const float* WTS = (const float*)(p.ws + WS_WTS);
        unsigned long long set_f = 0ull; float werr = 0.f, wsum = 0.f;
#pragma unroll 1
        for (int k = 0; k < 8; ++k) { const int e = EIDX[(size_t)t * 8 + k] & 255; set_f |= 1ull << e; const float wr = 2.5f * sc[e] / ssum; werr = fmaxf(werr, fabsf(wr - WTS[(size_t)t * 8 + k])); wsum += WTS[(size_t)t * 8 + k]; }
        float d = 0.f;
        if (DBG_MODE == 0) d = (set_f != set_ref) ? (1.f / 256.f) : 0.f;
        if (DBG_MODE == 1) d = (set_f != set_ref) ? 0.f : werr + fabsf(wsum - 2.5f);
        if (DBG_MODE == 2) d = lerr * (1.f / 256.f);
        atomicAdd((float*)((unsigned*)(p.ws + WS_CTL) + CW_DBG), d);
    }
    __syncthreads();
}
__device__ __forceinline__ unsigned dbg_hash(unsigned x) { x ^= x >> 16; x *= 0x7feb352du; x ^= x >> 15; x *= 0x846ca68bu; x ^= x >> 16; return x; }
__device__ __forceinline__ void dbg_report_wave(const Params& p, float d, int lane) { if (lane == 0) dbg_report(p, d); }
__device__ __forceinline__ void dbg_hyena_check(const Params& p, int mode, const bf16* HN, const bf16* UC, const bf16* ZT, const bf16* Y2T, const bf16* MIX, LAS unsigned char* lds, int lane, int wave) {
    const unsigned hsh = dbg_hash(blockIdx.x * 8u + wave + 12345u), h2 = dbg_hash(hsh), h3 = dbg_hash(h2);
    const bf16* FILT = (const bf16*)(p.ws + WS_FILT);
    float d = 0.f;
    if (mode == 0) {
        const int c = hsh % 3072u, b = h2 % 32u, s = h3 % 2048u; float acc = 0.f;
#pragma unroll 1
        for (int k = lane; k < 1024; k += 64) acc += bf1(HN[(size_t)(b * 2048 + s) * D + k]) * p.in[I_WINHY][(size_t)k * 3072 + c];
        acc = wave_sum(acc);
        const float got = bf1(UC[(size_t)c * T + b * 2048 + s]); d = fabsf(got - acc) / (fabsf(acc) + 0.1f);
    } else if (mode == 5) {
        const int c = hsh % 3072u, b = h2 % 32u; int s = h3 % 2048u; if ((h3 >> 20) % 8u == 0u) s = 0; if ((h3 >> 20) % 8u == 1u) s = 2047;
        float val = p.in[I_CONVHYB][c];
#pragma unroll 1
        for (int j = 0; j < 3; ++j) { const int sj = s + j - 1; if (sj < 0 || sj > 2047) continue; val += p.in[I_CONVHYW][j * 3072 + c] * bf1(ZT[(size_t)c * T + b * 2048 + sj]); }
        const float got = bf1(UC[(size_t)c * T + b * 2048 + s]); d = fabsf(got - val) / (fabsf(val) + 0.1f);
    } else if (mode == 1) {
        LAS float* Z = (LAS float*)(lds + wave * 1024); LAS float* A1 = Z + 64; LAS float* A2 = A1 + 64;
        const int o = hsh & 1u, c = h2 % 1024u, j = h3 % 2048u;
        float z = 0.f; if (lane == 0) z = (float)j / 2047.f; else if (lane < 33) { const int k = (lane - 1) & 15; const float fr = 1e-4f + (float)k * ((15.f - 1e-4f) / 15.f); const float ang = (6.283185307179586f / 2048.f) * (float)j * fr; z = lane < 17 ? cosf(ang) : -sinf(ang); }
        Z[lane] = z; LDS_WAIT(); asm volatile("" ::: "memory");
        float a = p.in[I_FB1][lane];
#pragma unroll 1
        for (int k = 0; k < 33; ++k) a += Z[k] * p.in[I_FW1][k * 64 + lane];
        A1[lane] = sinf(a); LDS_WAIT(); asm volatile("" ::: "memory");
        a = p.in[I_FB2][lane];
#pragma unroll 1
        for (int k = 0; k < 64; ++k) a += A1[k] * p.in[I_FW2][k * 64 + lane];
        A2[lane] = sinf(a); LDS_WAIT(); asm volatile("" ::: "memory");
        float v = wave_sum(A2[lane] * p.in[I_FW3][lane * 2048 + o * 1024 + c]);
        const float mind = -4.605170185988091f / 1.5f, maxd = -4.605170185988091f / 0.3f; const float delta = fabsf(mind + (float)c * ((maxd - mind) / 1023.f));
        v *= expf(-fabsf((float)j - 1024.f) / 1024.f * delta);
        const float got = bf1(FILT[(size_t)(o * 1024 + c) * 2048 + j]); d = fabsf(got - v) / (fabsf(v) + 1e-4f);
    } else if (mode == 2 || mode == 3) {
        const int o = mode - 2, c = hsh % 1024u, b = h2 % 32u; int t = h3 % 2048u; if ((h3 >> 20) % 8u == 0u) t = 0; if ((h3 >> 20) % 8u == 1u) t = 2047;
        const bf16* in = (o == 0 ? UC : ZT) + (size_t)c * T + b * 2048; const bf16* f = FILT + (size_t)(o * 1024 + c) * 2048; float acc = 0.f;
#pragma unroll 1
        for (int s = lane; s < 2048; s += 64) { const int x = 1024 + t - s; if (x >= 0 && x <= 2047) acc += bf1(f[x]) * bf1(in[s]); }
        acc = wave_sum(acc);
        const float gate = bf1(UC[(size_t)((1 + o) * 1024 + c) * T + b * 2048 + t]);
        const float val = gate * (acc + bf1(in[t]) * p.in[I_FBIAS][o * 1024 + c]);
        const float got = bf1((o == 0 ? ZT : Y2T)[(size_t)c * T + b * 2048 + t]); d = fabsf(got - val) / (fabsf(val) + 0.1f);
    } else if (mode == 4) {
        const int tok = hsh % 65536u, n = h2 % 1024u; float acc = 0.f;
#pragma unroll 1
        for (int c = lane; c < 1024; c += 64) acc += bf1(Y2T[(size_t)c * T + tok]) * p.in[I_WOUTHY][(size_t)c * 1024 + n];
        acc = wave_sum(acc);
        const float got = bf1(MIX[(size_t)tok * D + n]); d = fabsf(got - acc) / (fabsf(acc) + 0.1f);
    }
    dbg_report_wave(p, d, lane);
}
__device__ __forceinline__ void dbg_inproj_check(const Params& p, unsigned char* big, int lane, int wave) {
    const unsigned hsh = dbg_hash(blockIdx.x * 8u + wave + 777u), h2 = dbg_hash(hsh);
    const bf16* H0 = (const bf16*)(big + A0_H); const float* W = p.in[I_WINAB];
    int m = hsh % (unsigned)TT; int n = h2 % 3600u;
    const bool ctx = m >= T; if (ctx && n < 1536) n += 1536;
    const int b = ctx ? (m - T) / LC : m / SEQ, s = ctx ? (m - T) % LC : m % SEQ;
    float x = 0.f, xp = 0.f; const bool rope_col = (n < 512) || (n >= 1536 && n < 2048); const int np = rope_col ? (n ^ 16) : n;
#pragma unroll 1
    for (int k = lane; k < 1024; k += 64) { const float hv = bf1(H0[(size_t)m * D + k]); x += hv * W[(size_t)k * 3600 + n]; xp += hv * W[(size_t)k * 3600 + np]; }
    x = wave_sum(x); xp = wave_sum(xp);
    float val = x, got = 0.f;
    if (n >= 3584) { val = x + p.in[I_GATEB][n - 3584]; got = ((const float*)(p.ws + WS_GATES))[(size_t)m * 16 + (n - 3584)]; }
    else { const int t = n / 512, cn = n % 512; int pc = cn;
        if (rope_col) { const int o = cn & 31; pc = (cn & ~31) + (((o & 15) >> 2) * 8 + (o >> 4) * 4 + (o & 3));
            if (!ctx) { const int d = cn & 63, axis = d >> 5, half = (d >> 4) & 1, i = d & 15; const float pos = (float)(axis == 0 ? (s >> 6) : (s & 63)); const float ang = pos * powf(10000.f, -(float)i / 16.f);
                val = half == 0 ? x * cosf(ang) - xp * sinf(ang) : x * cosf(ang) + xp * sinf(ang); } }
        if (t == 0) val *= QSCALE;
        const size_t offs[7] = {A0_QA, A0_BQ, A0_BO, A0_KA, A0_VA, A0_BK, A0_BV}; const bool kv = t >= 3;
        const bf16* O = (const bf16*)(big + offs[t]) + (size_t)b * (kv ? (SEQ + LC) : SEQ) * 512 + (size_t)((kv && !ctx) ? LC : 0) * 512;
        got = bf1(O[(size_t)s * 512 + pc]); }
    dbg_report_wave(p, fabsf(got - val) / (fabsf(val) + 0.1f), lane);
}
__device__ __forceinline__ void dbg_attn_check(const Params& p, unsigned char* big, LAS unsigned char* lds, int lane, int wave) {
    const unsigned hsh = dbg_hash(blockIdx.x * 8u + wave + 4242u), h2 = dbg_hash(hsh);
    const int b = hsh % 32u, h = (hsh >> 8) % 4u, q = h2 % 2048u;
    const bf16* QA = (const bf16*)(big + A0_QA) + ((size_t)b * SEQ + q) * 512 + h * 128; const bf16* KA = (const bf16*)(big + A0_KA) + (size_t)b * 2304 * 512 + h * 128;
    const bf16* VA = (const bf16*)(big + A0_VA) + (size_t)b * 2304 * 512 + h * 128; const bf16* MIXIN = (const bf16*)(big + A0_MIXIN) + ((size_t)b * SEQ + q) * D + h * 128;
    LAS float* Aw = (LAS float*)(lds + wave * 18432);
    const float* lv = p.in[I_DLAM]; const float lam = expf(wave_sum(lv[lane] * lv[64 + lane])) - expf(wave_sum(lv[128 + lane] * lv[192 + lane])) + 0.2f;
    float mx0 = -1e30f, mx1 = -1e30f;
#pragma unroll 1
    for (int key = lane; key < 2304; key += 64) { float s0 = 0.f, s1 = 0.f;
#pragma unroll 1
        for (int d = 0; d < 64; ++d) { s0 += bf1(QA[d]) * bf1(KA[(size_t)key * 512 + d]); s1 += bf1(QA[64 + d]) * bf1(KA[(size_t)key * 512 + 64 + d]); }
        Aw[key] = s0; Aw[2304 + key] = s1; mx0 = fmaxf(mx0, s0); mx1 = fmaxf(mx1, s1); }
    mx0 = wave_max(mx0); mx1 = wave_max(mx1);
    float l0 = 0.f, l1 = 0.f;
#pragma unroll 1
    for (int key = lane; key < 2304; key += 64) { const float e0 = exp2f(Aw[key] - mx0), e1 = exp2f(Aw[2304 + key] - mx1); Aw[key] = e0; Aw[2304 + key] = e1; l0 += e0; l1 += e1; }
    l0 = wave_sum(l0); l1 = wave_sum(l1);
    LDS_WAIT(); asm volatile("" ::: "memory");
    float o[2] = {0.f, 0.f};
#pragma unroll 1
    for (int key = 0; key < 2304; ++key) { const float a = Aw[key] / l0 - lam * Aw[2304 + key] / l1; o[0] += a * bf1(VA[(size_t)key * 512 + lane]); o[1] += a * bf1(VA[(size_t)key * 512 + 64 + lane]); }
    const float ms = wave_sum(o[0] * o[0] + o[1] * o[1]) * (1.f / 128.f); const float rn = rsqrtf(ms + RMS_EPS) * 0.8f;
    float err = 0.f, sc = 0.f;
#pragma unroll
    for (int j = 0; j < 2; ++j) { const float val = o[j] * rn * p.in[I_HGA][h * 128 + 64 * j + lane]; err = fmaxf(err, fabsf(val - bf1(MIXIN[64 * j + lane]))); sc += val * val; }
    err = wave_max(err); sc = sqrtf(wave_sum(sc) * (1.f / 128.f));
    dbg_report_wave(p, err / (sc + 1e-3f), lane);
}
__device__ __forceinline__ float dbg_convsilu(const bf16* base, int pos, int lim, int ch, int d, const float* cw, const float* cb) {
    float s = cb[ch];
#pragma unroll
    for (int j = 0; j < 3; ++j) { const int pj = pos + j - 1; if (pj >= 0 && pj < lim) s += cw[j * 1024 + ch] * bf1(base[(size_t)pj * 512 + d]); }
    return s / (1.f + expf(-s));
}
__device__ __forceinline__ void dbg_mlstm_check(const Params& p, unsigned char* big, LAS unsigned char* lds, int lane, int wave) {
    const unsigned hsh = dbg_hash(blockIdx.x * 8u + wave + 991u), h2 = dbg_hash(hsh);
    const int b = hsh % 32u, h = (hsh >> 8) % 4u, dir = (hsh >> 12) & 1; int tau = h2 % 2048u; if ((h2 >> 16) % 4u == 0u) tau = (h2 >> 20) % 130u;
    const bf16* BQ = (const bf16*)(big + A0_BQ) + (size_t)b * SEQ * 512 + h * 128; const bf16* BK = (const bf16*)(big + A0_BK) + (size_t)b * (SEQ + LC) * 512 + h * 128;
    const bf16* BV = (const bf16*)(big + A0_BV) + (size_t)b * (SEQ + LC) * 512 + h * 128;
    const float* GT = (const float*)(p.ws + WS_GATES); const float* cw = p.in[I_CONVABW]; const float* cb = p.in[I_CONVABB];
    LAS float* F = (LAS float*)(lds + wave * 18432); LAS float* qv = F + 2304 + 64;
    const int N = 256 + tau + 1;
#define DBG_POS(u) ((u) < 256 ? (dir ? 255 - (u) : (u)) : (dir ? 2047 - ((u) - 256) : (u) - 256))
#define DBG_GROW(u) ((u) < 256 ? (size_t)T + b * LC + DBG_POS(u) : (size_t)b * SEQ + DBG_POS(u))
    float carry = 0.f;
#pragma unroll 1
    for (int u0 = 0; u0 < N; u0 += 64) { const int u = u0 + lane; float lf = 0.f;
        if (u < N) { const float x = GT[DBG_GROW(u) * 16 + dir * 8 + 4 + h]; lf = x >= 0.f ? -__logf(1.f + __expf(-x)) : x - __logf(1.f + __expf(x)); }
        float s = lf;
#pragma unroll
        for (int o = 1; o < 64; o <<= 1) { const float v = shup(s, o); if (lane >= o) s += v; }
        if (u < N) F[u] = carry + s; carry += shidx(s, 63); }
    LDS_WAIT(); asm volatile("" ::: "memory");
    const float Ft = F[N - 1];
    float mm = Ft;
#pragma unroll 1
    for (int u = lane; u < N; u += 64) mm = fmaxf(mm, Ft - F[u] + GT[DBG_GROW(u) * 16 + dir * 8 + h]);
    mm = wave_max(mm);
    { const int pos = DBG_POS(N - 1);
      for (int d = lane; d < 128; d += 64) qv[d] = dbg_convsilu(BQ, pos, SEQ, h * 128 + d, d, cw, cb) * 0.08838834764831845f; }
    LDS_WAIT(); asm volatile("" ::: "memory");
    float den = 0.f;
#pragma unroll 1
    for (int u = lane; u < N; u += 64) { const bool ctx = u < 256; const int pos = DBG_POS(u); const bf16* kb = ctx ? BK : BK + (size_t)LC * 512; float qk = 0.f;
#pragma unroll 1
        for (int d = 0; d < 128; ++d) qk += qv[d] * dbg_convsilu(kb, pos, ctx ? LC : SEQ, 512 + h * 128 + d, d, cw, cb);
        const float om = qk * expf(Ft - F[u] + GT[DBG_GROW(u) * 16 + dir * 8 + h] - mm); F[u] = om; den += om; }
    den = wave_sum(den);
    LDS_WAIT(); asm volatile("" ::: "memory");
    float num[2] = {0.f, 0.f};
#pragma unroll 1
    for (int u = 0; u < N; ++u) { const bool ctx = u < 256; const int pos = DBG_POS(u); const bf16* vb = BV + (size_t)((ctx ? 0 : LC) + pos) * 512; num[0] += F[u] * bf1(vb[lane]); num[1] += F[u] * bf1(vb[64 + lane]); }
    const float dd = 1.f / fmaxf(fabsf(den), expf(-mm));
    const bf16* HB = (const bf16*)(big + A0_HB) + (size_t)dir * T * 512 + ((size_t)b * SEQ + DBG_POS(N - 1)) * 512 + h * 128;
    float err = 0.f, sc = 0.f;
#pragma unroll
    for (int j = 0; j < 2; ++j) { const float val = num[j] * dd; err = fmaxf(err, fabsf(val - bf1(HB[64 * j + lane]))); sc += val * val; }
    err = wave_max(err); sc = sqrtf(wave_sum(sc) * (1.f / 128.f));
    dbg_report_wave(p, err / (sc + 1e-3f), lane);
#undef DBG_POS
#undef DBG_GROW
}

__global__ void __launch_bounds__(NTHR, 2) mk_fwd(Params p0) {
    extern __shared__ __attribute__((aligned(16))) unsigned char lds_raw[];
    LAS unsigned char* lds = (LAS unsigned char*)lds_raw;
    const int wave0 = __builtin_amdgcn_readfirstlane((int)threadIdx.x >> 6);
    if (threadIdx.x < 64) ((LAS unsigned*)(lds + LDS_MISC))[threadIdx.x] = 0u;
    __syncthreads();
    XcdBarrier bar = xcd_barrier_post((unsigned*)(p0.ws + WS_CTL) + CW_BAR, (volatile LAS unsigned*)(lds + LDS_MISC + 32));
    const int G = gridDim.x, cb = blockIdx.x;
    const int vcu = (G % 8 == 0) ? (cb % 8) * (G / 8) + cb / 8 : cb;
#ifdef TIMEK
    int phc = 0; if (blockIdx.x == 0 && threadIdx.x == 0) ((unsigned long long*)(p0.ws + WS_CTL + 32768))[0] = __builtin_amdgcn_s_memrealtime();
#endif
#ifdef DBL_PH
#define DBL_LOOP for (int rep_ = 0; rep_ < 1; ++rep_)
#define DBL_SYNC __syncthreads();
#else
#define DBL_LOOP
#define DBL_SYNC
#endif
#ifdef TIMEK
#define TS_REC { ++phc; if (blockIdx.x == 0 && wave0 == 0 && lane_opq() == 0) ((unsigned long long*)(p0.ws + WS_CTL + 32768))[phc] = __builtin_amdgcn_s_memrealtime(); }
#else
#define TS_REC
#endif
#define LAYER_PTRS bf16* H2 = (bf16*)(big + (l == 0 ? 0 : 128 * MiB)); float* LOG = nullptr; bf16* ACT = (bf16*)(big + (l == 0 ? 144 * MiB : 272 * MiB)); \
        bf16* Y = (bf16*)(big + (l == 0 ? 304 * MiB : 432 * MiB)); bf16* HN = (bf16*)(big + 640 * MiB); const bf16* MIX = (const bf16*)(big + (l == 0 ? A0_MIX : 0)); \
        bf16* UT = (bf16*)big; bf16* UC = (bf16*)(big + 384 * MiB); bf16* ZT = (bf16*)(big + 384 * MiB); bf16* Y2T = (bf16*)(big + 512 * MiB); bf16* Y2 = (bf16*)(big + 640 * MiB); \
        (void)H2; (void)LOG; (void)ACT; (void)Y; (void)HN; (void)MIX; (void)UT; (void)UC; (void)ZT; (void)Y2T; (void)Y2;
#define RUN(...) do { { { int tid_ = wave0 * 64 + lane_opq(); asm volatile("" : "+v"(tid_)); const int tid = tid_, lane = tid & 63, wave = __builtin_amdgcn_readfirstlane(tid >> 6); (void)lane; (void)wave; \
        Params p = p0; { size_t z_ = 0; asm volatile("" : "+s"(z_)); p.ws = p0.ws + z_; p.out = p0.out + z_; _Pragma("unroll") for (int i_ = 0; i_ < 31; ++i_) p.in[i_] = p0.in[i_] + z_; } unsigned char* ws = p.ws; unsigned char* big = ws + WS_BIG; (void)big; LAYER_PTRS DBL_LOOP { __VA_ARGS__; DBL_SYNC } } { XcdBarrier b2_ = bar; { size_t z_ = 0; asm volatile("" : "+s"(z_)); b2_.bar = bar.bar + z_; unsigned x_ = bar.x; asm volatile("" : "+s"(x_)); b2_.x = x_; } xcd_barrier(b2_, wave0 == 0 && lane_opq() == 0); } TS_REC } } while (0)

#ifdef PRO_PROBE
#define PP(i) do { if (blockIdx.x == 0 && tid == 0) ((unsigned long long*)(p0.ws + WS_CTL + 32768))[50 + (i)] = __builtin_amdgcn_s_memrealtime(); } while (0)
#else
#define PP(i)
#endif
    { const int l = 0; RUN({ PP(0); pro_mod(p, lds, tid, lane, wave); __syncthreads(); PP(1); pro_filters(p, lds, tid, lane, wave); PP(2); pro_rope(p, tid); pro_transposes(p, lds, lane, wave); PP(3); }); }

    for (int l = 0; l < 2; ++l) {
        if (l == 0) {
            RUN({ ph_l0_norm(p, lane, wave); });
            RUN({ Gemm g{(const bf16*)(big + A0_H), (const bf16*)(ws + WS_WIN0), 1024, 2048u}; InprojSched S{G, vcu};
                  EpiInproj E{big, (const float*)(ws + WS_ROPE), (float*)(ws + WS_GATES), p.in[I_GATEB]};
                  gemm_phase<EpiInproj, InprojSched>(lds, g, S, E, tid); });
#ifdef DBG_INPROJ
            RUN({ dbg_inproj_check(p, big, lane, wave); });
#endif
            RUN({ ph_attn(p, big, lds, tid, lane, wave, vcu); });
#ifdef DBG_ATTN
            RUN({ dbg_attn_check(p, big, lds, lane, wave); });
#endif
            RUN({ ph_mlstm(p, big, lds, tid, lane, wave); });
#ifdef DBG_MLSTM
            RUN({ dbg_mlstm_check(p, big, lds, lane, wave); });
#endif
            RUN({ ph_outb(p, big, lane, wave, vcu); asm volatile("s_waitcnt vmcnt(0)" ::: "memory"); __syncthreads();
                  Gemm g{(const bf16*)(big + A0_MIXIN), (const bf16*)(ws + WS_WOUT0), 1024, 2048u}; PanelSched S{4, vcu}; EpiBf16 E{(bf16*)(big + A0_MIX), 1024, 3};
                  gemm_phase<EpiBf16, PanelSched>(lds, g, S, E, tid); });
        }
        if (l == 1) {
            RUN({ Gemm g{(const bf16*)(ws + WS_WIN1), HN, 1024, 2048u}; DenseSched S{256, 12 * 256, G, vcu, 12}; EpiBf16 E{UT, (size_t)T, 0xffff};
                  gemm_phase<EpiBf16, DenseSched>(lds, g, S, E, tid); });
#ifdef DBG_HY
            if (DBG_MODE == 0) { RUN({ dbg_hyena_check(p, 0, HN, UT, UT, UT, UT, lds, lane, wave); }); }
#endif
#ifdef DBG_HY
            if (DBG_MODE == 5) { RUN({ dbg_hyena_check(p, 5, HN, UC, UT, UT, UT, lds, lane, wave); }); }
#endif
            RUN({ ph_lconv<true>(p, 0, UT, UT, ZT, lds, tid, lane, wave); });
#ifdef DBG_HY
            if (DBG_MODE == 2) { RUN({ dbg_hyena_check(p, 2, HN, UC, ZT, Y2T, UT, lds, lane, wave); }); }
#endif
            RUN({ ph_lconv<false>(p, 1, ZT, UT, Y2T, lds, tid, lane, wave); });
#ifdef DBG_HY
            if (DBG_MODE == 3) { RUN({ dbg_hyena_check(p, 3, HN, UC, ZT, Y2T, UT, lds, lane, wave); }); }
#endif
            RUN({ ph_transpose(Y2T, Y2, lds, lane, wave, vcu); asm volatile("s_waitcnt vmcnt(0)" ::: "memory"); __syncthreads();
                  Gemm g{Y2, (const bf16*)(ws + WS_WOUT1), 1024, 2048u}; PanelSched S{4, vcu}; EpiBf16 E{(bf16*)big, 1024, 3};
                  gemm_phase<EpiBf16, PanelSched>(lds, g, S, E, tid); });
        }
#ifdef DBG_HY
        if (l == 1 && (DBG_MODE == 1 || DBG_MODE == 4)) { RUN({ dbg_hyena_check(p, DBG_MODE, HN, (const bf16*)(big + 384 * MiB), (const bf16*)big, (const bf16*)(big + 128 * MiB), (const bf16*)big, lds, lane, wave); }); }
#endif
        RUN({ ph_mid(p, l, MIX, H2, true, lane, wave, vcu); asm volatile("s_waitcnt vmcnt(0)" ::: "memory"); __syncthreads();
              Gemm g{H2, (const bf16*)(ws + WS_WR) + (size_t)l * 256 * 1024, 1024, 2048u}; DenseSched S{1, 256, G, vcu, 0}; EpiRouterLds E{};
              gemm_phase<EpiRouterLds, DenseSched>(lds, g, S, E, tid); __syncthreads(); ph_route_a(p, l, nullptr, vcu, lds, tid); });
#ifdef DBG_ROUTE
        RUN({ if (l == DBG_L) dbg_route_check(p, l, H2, LOG, lds, tid); ph_route_b(p, lds, tid); });
#else
        RUN({ ph_route_b(p, lds, tid); });
#endif
#define DO_G1(chx) do { const int NT = moe_tables(p, chx, lds, tid); \
            Gemm g{H2, (const bf16*)(ws + WS_GU) + (size_t)l * (65 * 512) * 1024, 1024, 2048u}; \
            MoeSched S{(const LAS int*)(lds + LDS_TAB), (const int*)(ws + WS_SORT) + (size_t)(chx) * CHROWS, NT * 2, G, vcu, 1, 2, nullptr}; EpiSwiglu E{ACT}; \
            gemm_phase<EpiSwiglu, MoeSched>(lds, g, S, E, tid); } while (0)
        RUN({ DO_G1(0); });
        for (int ch = 0; ch < NCH; ++ch) {
            RUN({ const int NT = moe_tables(p, ch, lds, tid);
                  Gemm g{ACT, (const bf16*)(ws + WS_DN) + (size_t)l * (65 * 1024) * 256, 256, 512u};
                  MoeSched S{(const LAS int*)(lds + LDS_TAB), nullptr, NT * 4, G, vcu, 2, 4, (l == 0 && ch == 0) ? (void*)(ws + WS_CTL + 32768) : nullptr}; EpiFp8 E{(unsigned char*)Y};
                  gemm_phase<EpiFp8, MoeSched>(lds, g, S, E, tid); });
            RUN({ const int par = (cb >> 3) & 1;
                  _Pragma("unroll 1") for (int part = 0; part < 2; ++part) { int t2_ = tid; asm volatile("" : "+v"(t2_)); const int tid = t2_, lane = tid & 63; (void)lane; if ((part ^ par) == 0) { if (ch + 1 < NCH) DO_G1(ch + 1); } else { ph_combine(p, l, ch, (const unsigned char*)Y, HN, lane, wave); } __syncthreads(); } });
        }
    }
#ifdef TIMEK
    if (blockIdx.x == 0) { const unsigned long long* ts = (const unsigned long long*)(p0.ws + WS_CTL + 32768); __syncthreads();
        const unsigned long long d = (__hip_atomic_load(ts + TIMEK, __ATOMIC_RELAXED, __HIP_MEMORY_SCOPE_AGENT) - __hip_atomic_load(ts + TIMEK0, __ATOMIC_RELAXED, __HIP_MEMORY_SCOPE_AGENT)) * 4ull, t0 = __builtin_amdgcn_s_memrealtime();
        while (__builtin_amdgcn_s_memrealtime() - t0 < d) __builtin_amdgcn_s_sleep(8); }
#endif
#ifdef DBG_ANY
    xcd_barrier(bar, threadIdx.x == 0);
    if (blockIdx.x == 0 && threadIdx.x == 0) p0.out[0] += 1.0e7f * __uint_as_float(((const unsigned*)(p0.ws + WS_CTL))[CW_DBG]);
#endif
#undef RUN
}
constexpr int NPHASES = 1 + 2 * (4 + 3 * NCH) + 6 + 64;
}

extern "C" void kernel_launch(void* const* d_in, const int* in_sizes, int n_in, void* d_out, int out_size, void* d_ws, size_t ws_size, hipStream_t stream) {
    using namespace mk;
    static int grid = 0;
    if (grid == 0) {
        if (n_in != 31 || out_size != T * D || ws_size < WS_END) { fprintf(stderr, "kernel_launch: unexpected shapes (n_in %d, out %d, ws %zu)\n", n_in, out_size, ws_size); grid = -1; return; }
        int dev = 0, cus = 0;
        if (hipGetDevice(&dev) != hipSuccess || hipDeviceGetAttribute(&cus, hipDeviceAttributeMultiprocessorCount, dev) != hipSuccess) { grid = -1; return; }
        if (hipFuncSetAttribute((const void*)mk_fwd, hipFuncAttributeMaxDynamicSharedMemorySize, LDS_BYTES) != hipSuccess) { fprintf(stderr, "kernel_launch: hipFuncSetAttribute failed\n"); grid = -1; return; }
        int per_cu = 0;
        if (hipOccupancyMaxActiveBlocksPerMultiprocessor(&per_cu, (const void*)mk_fwd, NTHR, LDS_BYTES) != hipSuccess || per_cu < 1) { fprintf(stderr, "kernel_launch: occupancy query says %d\n", per_cu); }
        (void)hipGetLastError();
        grid = cus;
        if (grid != 256) { fprintf(stderr, "kernel_launch: built for 256 CUs, found %d\n", grid); grid = -1; return; }
    }
    if (grid < 0) return;
    (void)hipMemsetAsync((char*)d_ws + WS_CTL, 0, CTL_ZERO_BYTES, stream);
    Params a{};
    for (int i = 0; i < 31; ++i) a.in[i] = (const float*)d_in[i];
    a.out = (float*)d_out; a.ws = (unsigned char*)d_ws; a.ph_lo = 0; a.ph_hi = NPHASES;
    hipLaunchKernelGGL(mk_fwd, dim3(grid), dim3(NTHR), LDS_BYTES, stream, a);
}
```

```cpp
#include <hip/hip_runtime.h>
#include <cstdio>
#include <cstdint>
namespace pg8 {
#define PG8_LAS __attribute__((address_space(3)))
typedef unsigned short bf16_t;
typedef short bf16x8 __attribute__((ext_vector_type(8)));
typedef float f32x4 __attribute__((ext_vector_type(4)));
typedef unsigned u32x4 __attribute__((ext_vector_type(4)));
typedef unsigned u32x2 __attribute__((ext_vector_type(2)));
constexpr int BM = 256, BK = 64, HALF = 128, HTB = HALF * BK * 2  , STAGE_BYTES = 8 * HTB;

__host__ __device__ __forceinline__ int lds_byte(int r, int c) { const int st = (r >> 4) * 2 + (c >> 5), rr = r & 15, cc = c & 31, ob = rr * 64 + cc * 2; return st * 1024 + (ob ^ (((ob >> 9) & 1) << 5)); }
__host__ __device__ __forceinline__ void stage_rc(int b, int& R, int& C) { const int st = b / 1024, sb = b % 1024, swz = sb ^ (((sb >> 9) & 1) << 5); R = (st >> 1) * 16 + swz / 64; C = (st & 1) * 32 + (swz % 64) / 2; }
__host__ __device__ __forceinline__ int perm32(int rho) { const int n = rho >> 4, i = rho & 15; return 8 * (i >> 2) + 4 * n + (i & 3); }

struct Unit { int pm, pn; };
__device__ __forceinline__ unsigned cvt_pk_bf16(float lo, float hi) { unsigned r; asm volatile("v_cvt_pk_bf16_f32 %0, %1, %2" : "=v"(r) : "v"(lo), "v"(hi)); return r; }
struct Gemm { const bf16_t* A; const bf16_t* Bt; int K; unsigned lda_bytes; };
template <class Epi, class Sched, bool ALIGN_EPI = true>
__device__ __forceinline__ void gemm_phase(PG8_LAS unsigned char* lds, const Gemm g, const Sched& S, const Epi& E, const int tid_in) {
    int tid_ = tid_in; asm volatile("" : "+v"(tid_));
    const int tid = tid_, wid = __builtin_amdgcn_readfirstlane(tid >> 6), lane = tid & 63, wr = wid >> 2, wc = wid & 3, fr = lane & 15, fq = lane >> 4;
    const int K = g.K, nt = K / BK;
    unsigned voffB[2];
#pragma unroll
    for (int i = 0; i < 2; ++i) { int R, C; stage_rc(tid * 16 + i * 8192, R, C); const int Rb = Epi::PERM ? ((R & ~31) + perm32(R & 31)) : R;
        voffB[i] = (unsigned)(Rb * K + C) * 2u; }
    const size_t kstep = (size_t)(BK * 2);
    const size_t hstep = (size_t)HALF * K * 2;
    const size_t tstep = 2 * hstep;
    const unsigned ldsw = (unsigned)wid * 1024u;
    const int aoff = lds_byte(wr * 64 + fr, fq * 8), boff = lds_byte(wc * 32 + fr, fq * 8);
    const char* Ab = (const char*)g.A;
#define PG8_SA(b, h) (((b) * 2 + (h)) * HTB)
#define PG8_SB(b, h) ((4 + (b) * 2 + (h)) * HTB)
#define PG8_STAGE(bufoff, gbase, voff) do { _Pragma("unroll") for (int _i = 0; _i < 2; ++_i) \
        __builtin_amdgcn_global_load_lds((const unsigned*)((const char*)(gbase) + (voff)[_i]), (PG8_LAS unsigned*)(lds + (bufoff) + ldsw + _i * 8192), 16, 0, 0); } while (0)
#define PG8_STAGEA(bufoff, o0, o1, kb) do { \
        __builtin_amdgcn_global_load_lds((const unsigned*)(Ab + (size_t)(o0) + (size_t)(kb)), (PG8_LAS unsigned*)(lds + (bufoff) + ldsw), 16, 0, 0); \
        __builtin_amdgcn_global_load_lds((const unsigned*)(Ab + (size_t)(o1) + (size_t)(kb)), (PG8_LAS unsigned*)(lds + (bufoff) + ldsw + 8192), 16, 0, 0); } while (0)
#define PG8_LDA(dst, b, h) do { _Pragma("unroll") for (int m = 0; m < 4; ++m) _Pragma("unroll") for (int k = 0; k < 2; ++k) dst[m][k] = *(const PG8_LAS bf16x8*)(lds + PG8_SA(b, h) + aoff + m * 2048 + k * 1024); } while (0)
#define PG8_LDB(dst, b, h) do { _Pragma("unroll") for (int n = 0; n < 2; ++n) _Pragma("unroll") for (int k = 0; k < 2; ++k) dst[n][k] = *(const PG8_LAS bf16x8*)(lds + PG8_SB(b, h) + boff + n * 2048 + k * 1024); } while (0)
#define PG8_MMA(ai, bj, At, Bt) do { __builtin_amdgcn_s_setprio(1); _Pragma("unroll") for (int m = 0; m < 4; ++m) _Pragma("unroll") for (int n = 0; n < 2; ++n) _Pragma("unroll") for (int k = 0; k < 2; ++k) \
        acc[ai][bj][m][n] = __builtin_amdgcn_mfma_f32_16x16x32_bf16(Bt[n][k], At[m][k], acc[ai][bj][m][n], 0, 0, 0); __builtin_amdgcn_s_setprio(0); } while (0)
#define PG8_WAIT_V(n) asm volatile("s_waitcnt vmcnt(" #n ")" ::: "memory")
#define PG8_WAIT_L(n) asm volatile("s_waitcnt lgkmcnt(" #n ")" ::: "memory")
#define PG8_BAR __builtin_amdgcn_s_barrier()
#define PG8_SCHED __builtin_amdgcn_sched_barrier(0)
#define PG8_OFFS(dst, u) do { _Pragma("unroll") for (int _i = 0; _i < 2; ++_i) { int _R, _C; stage_rc(tid * 16 + _i * 8192, _R, _C); _Pragma("unroll") for (int _h = 0; _h < 2; ++_h) \
        dst[_h][_i] = (unsigned)S.arow((u).pm * BM + _h * HALF + _R) * g.lda_bytes + (unsigned)(_C * 2); } } while (0)
    Unit cur, nxt; int ui = 0;
    if (!S.next(0, cur)) return;
    f32x4 acc[2][2][4][2];
#pragma unroll
    for (int a = 0; a < 2; ++a)
#pragma unroll
        for (int b = 0; b < 2; ++b)
#pragma unroll
            for (int m = 0; m < 4; ++m)
#pragma unroll
                for (int n = 0; n < 2; ++n) acc[a][b][m][n] = (f32x4){0.f, 0.f, 0.f, 0.f};
    bf16x8 At[4][2], B0[2][2], B1[2][2];
    unsigned oC[2][2], oN[2][2];
    PG8_OFFS(oC, cur);
    const char* cB = (const char*)g.Bt + (size_t)cur.pn * tstep;
    PG8_STAGE(PG8_SB(0, 0), cB, voffB); PG8_STAGE(PG8_SB(0, 1), cB + hstep, voffB); PG8_STAGEA(PG8_SA(0, 0), oC[0][0], oC[0][1], 0); PG8_STAGEA(PG8_SA(0, 1), oC[1][0], oC[1][1], 0);
    if (wr == 1) PG8_BAR;
    PG8_WAIT_V(2); PG8_BAR;
    PG8_STAGE(PG8_SB(1, 0), cB + kstep, voffB); PG8_STAGEA(PG8_SA(1, 0), oC[0][0], oC[0][1], kstep); PG8_STAGE(PG8_SB(1, 1), cB + hstep + kstep, voffB);
    PG8_WAIT_V(6); PG8_BAR;
#ifdef GM_PROBE
    unsigned long long gaccs[3] = {0, 0, 0}; unsigned long long gtp = __builtin_amdgcn_s_memrealtime();
#define GM_T(i) do { if (Epi::PROBE) { const unsigned long long t1_ = __builtin_amdgcn_s_memrealtime(); gaccs[i] += t1_ - gtp; gtp = t1_; } } while (0)
#else
#define GM_T(i)
#endif
    for (;;) {
        const bool has_next = S.next(ui + 1, nxt);
        if (has_next) { PG8_OFFS(oN, nxt); } else {
#pragma unroll
            for (int _h = 0; _h < 2; ++_h)
#pragma unroll
                for (int _i = 0; _i < 2; ++_i) oN[_h][_i] = oC[_h][_i]; }
        const char* nB = has_next ? (const char*)g.Bt + (size_t)nxt.pn * tstep : cB;
#pragma unroll 1
        for (int t = 0; t < nt; t += 2) {
            const bool last = (t == nt - 2);
            const size_t k1 = (size_t)(t + 1) * kstep;
            const size_t k2 = last ? 0 : (size_t)(t + 2) * kstep, k3 = k2 + kstep;
            const char* b2 = last ? nB : cB + (size_t)(t + 2) * kstep; const char* b3 = b2 + kstep;
            PG8_LDB(B0, 0, 0); PG8_LDB(B1, 0, 1); PG8_SCHED; PG8_LDA(At, 0, 0); PG8_STAGEA(PG8_SA(1, 1), oC[1][0], oC[1][1], k1);
            if (last) { oC[0][0] = oN[0][0]; oC[0][1] = oN[0][1]; oC[1][0] = oN[1][0]; oC[1][1] = oN[1][1]; }
            PG8_WAIT_V(8); PG8_WAIT_L(0); PG8_BAR; PG8_MMA(0, 0, At, B0); PG8_MMA(0, 1, At, B1); PG8_BAR; PG8_SCHED;
            PG8_LDA(At, 0, 1); PG8_STAGE(PG8_SB(0, 0), b2, voffB); PG8_STAGE(PG8_SB(0, 1), b2 + hstep, voffB); PG8_STAGEA(PG8_SA(0, 0), oC[0][0], oC[0][1], k2);
            PG8_WAIT_V(8); PG8_WAIT_L(0); PG8_BAR; PG8_MMA(1, 0, At, B0); PG8_MMA(1, 1, At, B1); PG8_BAR; PG8_SCHED;
            PG8_LDB(B0, 1, 0); PG8_LDB(B1, 1, 1); PG8_SCHED; PG8_LDA(At, 1, 0); PG8_STAGEA(PG8_SA(0, 1), oC[1][0], oC[1][1], k2);
            PG8_WAIT_V(8); PG8_WAIT_L(0); PG8_BAR; PG8_MMA(0, 0, At, B0); PG8_MMA(0, 1, At, B1); PG8_BAR; PG8_SCHED;
            PG8_LDA(At, 1, 1); PG8_STAGE(PG8_SB(1, 0), b3, voffB); PG8_STAGE(PG8_SB(1, 1), b3 + hstep, voffB); PG8_STAGEA(PG8_SA(1, 0), oC[0][0], oC[0][1], k3);
            PG8_WAIT_V(8); PG8_WAIT_L(0); PG8_BAR; PG8_MMA(1, 0, At, B0); PG8_MMA(1, 1, At, B1); PG8_BAR; PG8_SCHED;
        }
        GM_T(0);
        if constexpr (ALIGN_EPI) { if (wr == 0) PG8_BAR; }
        GM_T(1);
        E(acc, cur, wr, wc, fr, fq);
        GM_T(2);
        if (!has_next) break;
#pragma unroll
        for (int a = 0; a < 2; ++a)
#pragma unroll
            for (int b = 0; b < 2; ++b)
#pragma unroll
                for (int m = 0; m < 4; ++m)
#pragma unroll
                    for (int n = 0; n < 2; ++n) acc[a][b][m][n] = (f32x4){0.f, 0.f, 0.f, 0.f};
        cur = nxt; cB = nB; ++ui;
#pragma unroll
        for (int _h = 0; _h < 2; ++_h)
#pragma unroll
            for (int _i = 0; _i < 2; ++_i) oC[_h][_i] = oN[_h][_i];
        if constexpr (ALIGN_EPI) { if (wr == 1) PG8_BAR; }
    }
#ifdef GM_PROBE
    if (Epi::PROBE && blockIdx.x == 0 && tid == 0) { unsigned long long* ts = (unsigned long long*)(S.probe_ts()); if (ts) { ts[50] = 0; ts[51] = gaccs[0]; ts[52] = gaccs[0] + gaccs[1]; ts[53] = gaccs[0] + gaccs[1] + gaccs[2]; } }
#endif
    PG8_WAIT_V(0);
    if constexpr (!ALIGN_EPI) { if (wr == 0) PG8_BAR; }
    PG8_BAR;
    if constexpr (Epi::AFTER_DRAIN) E.fused(acc, cur, wr, wc, fr, fq, lds);
#undef PG8_SA
#undef PG8_SB
#undef PG8_STAGE
#undef PG8_STAGEA
#undef PG8_LDA
#undef PG8_LDB
#undef PG8_MMA
#undef PG8_WAIT_V
#undef PG8_WAIT_L
#undef PG8_BAR
#undef PG8_SCHED
#undef PG8_OFFS
#undef GM_T
}

template <class Epi, class Sched>
__device__ __noinline__ void gemm_phase_ni(PG8_LAS unsigned char* lds, Gemm g, Sched S, Epi E) { gemm_phase<Epi, Sched>(lds, g, S, E, (int)threadIdx.x); }
}

namespace mk {
using namespace pg8;
constexpr int D = 1024, NB = 32, SEQ = 2048, T = NB * SEQ, LC = 256, TC = NB * LC, TT = T + TC;
constexpr int NMOD = 6 * D;
constexpr int NE = 64, NEX = 65, DE = 256;
constexpr int NCH = 2, CHT = T / NCH, BPC = 256 / NCH;
constexpr int MAXTILES = (CHT * 8 + 64 * 255) / 256 + CHT / 256 + 1, CHROWS = MAXTILES * 256;
constexpr float RMS_EPS = 1e-6f;
constexpr int NWAVES = 8, NTHR = 512;

constexpr size_t MiB = 1u << 20;
constexpr size_t WS_CTL = 0, CTL_ZERO_BYTES = 64 * 1024;
constexpr size_t WS_MOD = 1 * MiB;
constexpr size_t WS_ROPE = 3 * MiB;
constexpr size_t WS_BC = 3 * MiB + 65536;
constexpr size_t WS_TEG = 3 * MiB + 2 * 65536;
constexpr size_t WS_GATES = 4 * MiB;
constexpr size_t WS_FILT = 10 * MiB;
constexpr size_t WS_EIDX = 18 * MiB, WS_WTS = 20 * MiB, WS_PSLOT = 22 * MiB, WS_SORT = 26 * MiB;
constexpr size_t WS_WIN0 = 30 * MiB;
constexpr size_t WS_WOUT0 = 38 * MiB, WS_WIN1 = 40 * MiB, WS_WOUT1 = 46 * MiB, WS_WR = 48 * MiB;
constexpr size_t WS_GU = 50 * MiB;
constexpr size_t WS_DN = 180 * MiB;
constexpr size_t WS_BIG = 246 * MiB;
constexpr size_t WS_END = 1024 * MiB;
static_assert(WS_PSLOT + (size_t)T * 16 * 4 <= WS_SORT && WS_SORT + (size_t)NCH * CHROWS * 4 <= WS_WIN0 && WS_WIN0 + (size_t)3840 * 2048 <= WS_WOUT0 && WS_WR + (size_t)2 * 256 * 2048 <= WS_GU && WS_GU + (size_t)2 * 65 * 512 * 2048 <= WS_DN && WS_DN + (size_t)2 * 65 * 1024 * 512 <= WS_BIG, "ws map");
constexpr size_t A0_H = 0, A0_QA = 144 * MiB, A0_KA = 208 * MiB, A0_VA = 280 * MiB, A0_BQ = 352 * MiB, A0_BK = 416 * MiB, A0_BV = 488 * MiB, A0_BO = 560 * MiB, A0_VT = 624 * MiB;
constexpr size_t A0_MIXIN = 0, A0_HB = 144 * MiB, A0_MIX = 352 * MiB;
constexpr int CW_BAR = 4096;

constexpr int LDS_BYTES = 160 * 1024;
constexpr int LDS_TAB = 131072;
constexpr int LDS_MISC = 131072 + 24 * 1024;

#define GAS __attribute__((address_space(1)))
#define LAS __attribute__((address_space(3)))
typedef unsigned short bf16;
typedef unsigned v4u __attribute__((ext_vector_type(4)));
typedef unsigned v2u __attribute__((ext_vector_type(2)));
#define LDS_WAIT() asm volatile("s_waitcnt lgkmcnt(0)" ::: "memory")
#define VM_WAIT() asm volatile("s_waitcnt vmcnt(0)" ::: "memory")
__device__ __forceinline__ unsigned f2bf(float f) { unsigned u = __builtin_bit_cast(unsigned, f); return (u + 0x7fffu + ((u >> 16) & 1u)) >> 16; }
typedef float f32x2_t __attribute__((ext_vector_type(2))); typedef __bf16 bf16x2_t __attribute__((ext_vector_type(2)));
__device__ __forceinline__ unsigned pk2(float lo, float hi) { const f32x2_t v = {lo, hi}; return __builtin_bit_cast(unsigned, __builtin_convertvector(v, bf16x2_t)); }
__device__ __forceinline__ float bf_lo(unsigned w) { return __builtin_bit_cast(float, w << 16); }
__device__ __forceinline__ float bf_hi(unsigned w) { return __builtin_bit_cast(float, w & 0xffff0000u); }
__device__ __forceinline__ float bf1(bf16 h) { return __builtin_bit_cast(float, (unsigned)h << 16); }
__device__ __forceinline__ int lane_opq() { int l = (int)__builtin_amdgcn_mbcnt_hi(~0u, __builtin_amdgcn_mbcnt_lo(~0u, 0u)); asm volatile("" : "+v"(l)); return l; }
__device__ __forceinline__ float shx(float v, int m) { return __builtin_bit_cast(float, __builtin_amdgcn_ds_bpermute((lane_opq() ^ m) << 2, __builtin_bit_cast(int, v))); }
__device__ __forceinline__ float shup(float v, int o) { const int l = lane_opq(); return __builtin_bit_cast(float, __builtin_amdgcn_ds_bpermute((l >= o ? l - o : l) << 2, __builtin_bit_cast(int, v))); }
__device__ __forceinline__ float shidx(float v, int idx) { return __builtin_bit_cast(float, __builtin_amdgcn_ds_bpermute(idx << 2, __builtin_bit_cast(int, v))); }
__device__ __forceinline__ float wave_sum(float v) {
#pragma unroll
    for (int o = 1; o < 64; o <<= 1) v += shx(v, o);
    return v;
}
__device__ __forceinline__ float wave_max(float v) {
#pragma unroll
    for (int o = 1; o < 64; o <<= 1) v = fmaxf(v, shx(v, o));
    return v;
}
__device__ __forceinline__ float sigmoidf_(float x) { return __builtin_amdgcn_rcpf(1.f + __expf(-x)); }
__device__ __forceinline__ float siluf_(float x) { return x * __builtin_amdgcn_rcpf(1.f + __expf(-x)); }
#define XB_TMO      128
#define XB_XCNT(j)  (256  + 64 * (j))
#define XB_XSUB(j)  (1280 + 64 * (j))
#define XB_XGEN(j)  (2304 + 64 * (j))
#define XB_TOP      3328
#define XB_TOPGEN   3392
#define XCD_BAR_WORDS 3456
#define XB_SPIN_CAP (1u << 18)

__device__ __forceinline__ unsigned xb_ld(unsigned* p)              { return __hip_atomic_load(p, __ATOMIC_RELAXED, __HIP_MEMORY_SCOPE_AGENT); }
__device__ __forceinline__ unsigned xb_add(unsigned* p, unsigned v) { return __hip_atomic_fetch_add(p, v, __ATOMIC_RELAXED, __HIP_MEMORY_SCOPE_AGENT); }
__device__ __forceinline__ unsigned xb_xcc_id() { return (unsigned)__builtin_amdgcn_s_getreg((3 << 11) | 20) & 0xFu; }
#define XB_SPIN(cond, bar) do { unsigned _sp = 0; while (cond) { __builtin_amdgcn_s_sleep(1); \
    if ((++_sp & 255u) == 0u) { if (xb_ld(&(bar)[XB_TMO])) break; if (_sp > XB_SPIN_CAP) { atomicAdd(&(bar)[XB_TMO], 1u); break; } } } } while (0)

struct XcdBarrier {
    unsigned* bar; unsigned x;
    volatile LAS unsigned* st;
};

__device__ __forceinline__ XcdBarrier xcd_barrier_post(unsigned* bar, volatile LAS unsigned* st) {
    XcdBarrier b; b.bar = bar; b.x = xb_xcc_id(); b.st = st;
    if (threadIdx.x == 0) (void)xb_add(&bar[XB_XCNT(b.x)], 1u);
    return b;
}
__device__ __forceinline__ void xcd_barrier_complete(unsigned* bar, unsigned x, unsigned& nloc, unsigned& nx) {
    const unsigned G = gridDim.x * gridDim.y * gridDim.z;
    unsigned sum, cnt, mine, sp = 0u;
    for (;;) {
        sum = 0u; cnt = 0u; mine = 0u;
#pragma unroll
        for (unsigned j = 0; j < 16; ++j) { const unsigned c = xb_ld(&bar[XB_XCNT(j)]); sum += c; cnt += (c > 0u) ? 1u : 0u; mine = (j == x) ? c : mine; }
        if (sum == G) break;
        __builtin_amdgcn_s_sleep(1);
        if ((++sp & 255u) == 0u) { if (xb_ld(&bar[XB_TMO])) break; if (sp > XB_SPIN_CAP) { atomicAdd(&bar[XB_TMO], 1u); break; } }
    }
    nloc = mine > 0u ? mine : 1u; nx = cnt > 0u ? cnt : 1u;
}

__device__ __forceinline__ void xcd_barrier(const XcdBarrier& b, const bool t0  ) {
    asm volatile("s_waitcnt vmcnt(0)" ::: "memory");
    __syncthreads();
    if (t0) {
        unsigned* bar = b.bar;
        __builtin_amdgcn_s_waitcnt(0);
        unsigned nloc = b.st[0], nx = b.st[1];
        if (nloc == 0u) { xcd_barrier_complete(bar, b.x, nloc, nx); b.st[0] = nloc; b.st[1] = nx; }
        const unsigned old = xb_add(&bar[XB_XSUB(b.x)], 1u);
        const unsigned gen = old / nloc;
        if (old + 1u == (gen + 1u) * nloc) {
            __builtin_amdgcn_fence(__ATOMIC_RELEASE, "agent");
            asm volatile("s_waitcnt vmcnt(0)" ::: "memory");
            const unsigned og = xb_add(&bar[XB_TOP], 1u);
            const unsigned tg = og / nx;
            if (og + 1u == (tg + 1u) * nx) xb_add(&bar[XB_TOPGEN], 1u);
            else XB_SPIN(xb_ld(&bar[XB_TOPGEN]) == tg, bar);
            __builtin_amdgcn_fence(__ATOMIC_ACQUIRE, "agent");
            xb_add(&bar[XB_XGEN(b.x)], 1u);
            asm volatile("s_waitcnt vmcnt(0)" ::: "memory");
        } else {
            XB_SPIN(xb_ld(&bar[XB_XGEN(b.x)]) == gen, bar);
            __builtin_amdgcn_fence(__ATOMIC_ACQUIRE, "agent");
            asm volatile("s_waitcnt vmcnt(0)" ::: "memory");
        }
    }
    __syncthreads();
}

constexpr float Y8_SCALE = 16.f, Y8_INV = 1.f / 16.f;
struct Params { const float* in[31]; float* out; unsigned char* ws; int ph_lo, ph_hi; };
enum { I_X = 0, I_C, I_CTX, I_CCTX, I_WMOD, I_BMOD, I_NORMG, I_WINAB, I_CONVABW, I_CONVABB, I_GATEB, I_DLAM, I_HGA, I_HGB, I_WOUTAB, I_WINHY, I_CONVHYW, I_CONVHYB,
       I_FW1, I_FB1, I_FW2, I_FB2, I_FW3, I_FBIAS, I_WOUTHY, I_RW, I_RB, I_EGU, I_EDN, I_SGU, I_SDN };

__device__ __forceinline__ void row_ld_f32(const float* row, int lane, f32x4 (&v)[4]) { const f32x4* r = (const f32x4*)row + lane;
#pragma unroll
    for (int j = 0; j < 4; ++j) v[j] = r[64 * j]; }
__device__ __forceinline__ void row_st_f32(float* row, int lane, const f32x4 (&v)[4]) { f32x4* r = (f32x4*)row + lane;
#pragma unroll
    for (int j = 0; j < 4; ++j) r[64 * j] = v[j]; }
__device__ __forceinline__ void row_ld_bf16(const bf16* row, int lane, f32x4 (&v)[4]) { const v2u* r = (const v2u*)row + lane;
#pragma unroll
    for (int j = 0; j < 4; ++j) { const v2u w = r[64 * j]; v[j] = (f32x4){bf_lo(w.x), bf_hi(w.x), bf_lo(w.y), bf_hi(w.y)}; } }
__device__ __forceinline__ void row_st_bf16(bf16* row, int lane, const f32x4 (&v)[4]) { v2u* r = (v2u*)row + lane;
#pragma unroll
    for (int j = 0; j < 4; ++j) { v2u w; w.x = pk2(v[j].x, v[j].y); w.y = pk2(v[j].z, v[j].w); r[64 * j] = w; } }
__device__ __forceinline__ float row_ss(const f32x4 (&v)[4]) { float s = 0.f;
#pragma unroll
    for (int j = 0; j < 4; ++j) s += (v[j].x * v[j].x + v[j].y * v[j].y) + (v[j].z * v[j].z + v[j].w * v[j].w);
    return wave_sum(s); }
__device__ __forceinline__ void row_modulate(const f32x4 (&x)[4], float rstd, const float* g, const float* shift, const float* scale, int lane, f32x4 (&h)[4]) {
    const f32x4* gp = (const f32x4*)g + lane; const f32x4* sh = (const f32x4*)shift + lane; const f32x4* sc = (const f32x4*)scale + lane;
#pragma unroll
    for (int j = 0; j < 4; ++j) { const f32x4 gg = gp[64 * j], s1 = sc[64 * j], s0 = sh[64 * j]; h[j] = x[j] * rstd * gg * (1.f + s1) + s0; } }

__device__ __forceinline__ void pro_mod(const Params& p, LAS unsigned char* lds, int tid, int lane, int wave) {
    const int u = blockIdx.x; if (u >= 192) return;
    LAS float* S = (LAS float*)lds;
    const float* c = p.in[I_C]; const float* cc = p.in[I_CCTX];
#pragma unroll 4
    for (int i = tid; i < 33 * 256; i += NTHR) { const int b = i >> 8, k4 = (i & 255) * 4; const f32x4 v = b < 32 ? *(const f32x4*)(c + b * 1024 + k4) : *(const f32x4*)(cc + k4);
        *(LAS f32x4*)(S + b * 1024 + k4) = (f32x4){siluf_(v[0]), siluf_(v[1]), siluf_(v[2]), siluf_(v[3])}; }
    __syncthreads();
    const int l = u / 96, cg = (u % 96) * 64, col = cg + lane;
    const float* W = p.in[I_WMOD] + (size_t)l * 1024 * NMOD;
    float acc[33];
#pragma unroll
    for (int b = 0; b < 33; ++b) acc[b] = 0.f;
    const int k0 = wave * 128;
#pragma unroll 4
    for (int kk = 0; kk < 128; kk += 4) { const int k = k0 + kk;
        const float w0 = W[(size_t)k * NMOD + col], w1 = W[(size_t)(k + 1) * NMOD + col], w2 = W[(size_t)(k + 2) * NMOD + col], w3 = W[(size_t)(k + 3) * NMOD + col];
#pragma unroll
        for (int b = 0; b < 33; ++b) { const f32x4 s = *(const LAS f32x4*)(S + b * 1024 + k); acc[b] += (s.x * w0 + s.y * w1) + (s.z * w2 + s.w * w3); } }
    __syncthreads();
    LAS float* P = (LAS float*)lds;
#pragma unroll
    for (int b = 0; b < 33; ++b) P[(wave * 33 + b) * 64 + lane] = acc[b];
    __syncthreads();
    float* MOD = (float*)(p.ws + WS_MOD);
#pragma unroll 1
    for (int i = tid; i < 33 * 64; i += NTHR) { const int b = i >> 6, ln = i & 63; float s = 0.f;
#pragma unroll
        for (int w = 0; w < 8; ++w) s += P[(w * 33 + b) * 64 + ln];
        MOD[(size_t)(l * 33 + b) * NMOD + cg + ln] = s + p.in[I_BMOD][l * NMOD + cg + ln]; }
    __syncthreads();
}
__device__ __forceinline__ int rowmap(int kind, int n) {
    if (kind == 1) { const int o = n & 31; return (n & ~31) + (((o & 15) >> 2) * 8 + (o >> 4) * 4 + (o & 3)); }
    if (kind == 2) { return n < 256 ? ((n >> 7) * 256 + (n & 127)) : ((((n - 256) >> 7) * 256) + 128 + ((n - 256) & 127)); }
    if (kind == 3) { const int a = n & 255; return (n & ~255) + 128 * ((a >> 3) & 1) + 32 * (a >> 6) + 8 * ((a >> 4) & 3) + (a & 7); }
    return n;
}
struct TrDesc { const float* W; bf16* WT; int ldn, k0, n0, nvalid, dK, kind, row_base; };
__device__ __forceinline__ TrDesc tr_decode(const Params& p, int it) {
    constexpr int I_A = 16 * 113, I_B = 512, I_C2 = 1536, I_D = 512, I_E = 64, I_F = 130 * 256;
    unsigned char* ws = p.ws; int r = it;
    if (r < I_A) { const int kb = r / 113, nb = r % 113, n0 = nb * 32; const int kind = (n0 < 512 || (n0 >= 1536 && n0 < 2048)) ? 1 : 0;
        return TrDesc{p.in[I_WINAB], (bf16*)(ws + WS_WIN0), 3600, kb * 64, n0, 3600, 1024, kind, 0}; } r -= I_A;
    if (r < I_B) return TrDesc{p.in[I_WOUTAB], (bf16*)(ws + WS_WOUT0), 1024, (r / 32) * 64, (r % 32) * 32, 1024, 1024, 0, 0}; r -= I_B;
    if (r < I_C2) return TrDesc{p.in[I_WINHY], (bf16*)(ws + WS_WIN1), 3072, (r / 96) * 64, (r % 96) * 32, 3072, 1024, 0, 0}; r -= I_C2;
    if (r < I_D) return TrDesc{p.in[I_WOUTHY], (bf16*)(ws + WS_WOUT1), 1024, (r / 32) * 64, (r % 32) * 32, 1024, 1024, 0, 0}; r -= I_D;
    if (r < I_E) { const int l = r / 32, q = r % 32; return TrDesc{p.in[I_RW] + (size_t)l * 1024 * 64, (bf16*)(ws + WS_WR) + (size_t)l * 256 * 1024, 64, (q / 2) * 64, (q % 2) * 32, 64, 1024, 0, 0}; } r -= I_E;
    if (r < I_F) { const int mat = r / 256, q = r % 256, l = mat / 65, e = mat % 65;
        const float* src = e < 64 ? p.in[I_EGU] + (size_t)(l * 64 + e) * 1024 * 512 : p.in[I_SGU] + (size_t)l * 1024 * 512;
        return TrDesc{src, (bf16*)(ws + WS_GU) + (size_t)l * (65 * 512) * 1024, 512, (q / 16) * 64, (q % 16) * 32, 512, 1024, 2, e * 512}; } r -= I_F;
    { const int mat = r / 128, q = r % 128, l = mat / 65, e = mat % 65;
        const float* src = e < 64 ? p.in[I_EDN] + (size_t)(l * 64 + e) * 256 * 1024 : p.in[I_SDN] + (size_t)l * 256 * 1024;
        return TrDesc{src, (bf16*)(ws + WS_DN) + (size_t)l * (65 * 1024) * 256, 1024, (q / 32) * 64, (q % 32) * 32, 1024, 256, 3, e * 1024}; }
}
__device__ __forceinline__ void tr_load(const TrDesc& d, int lane, float (&v)[32]) {
    const int nn = d.n0 + (lane & 31); const bool ok = nn < d.nvalid; const float* src = d.W + (size_t)(d.k0 + (lane >> 5)) * d.ldn + (ok ? nn : 0);
#pragma unroll
    for (int i = 0; i < 32; ++i) v[i] = src[(size_t)(2 * i) * d.ldn];
    if (!ok) {
#pragma unroll
        for (int i = 0; i < 32; ++i) v[i] = 0.f; }
}
__device__ __forceinline__ void tr_finish(const TrDesc& d, const float (&v)[32], LAS float* scr, int lane) {
#pragma unroll
    for (int i = 0; i < 32; ++i) scr[(2 * i + (lane >> 5)) * 33 + (lane & 31)] = v[i];
    LDS_WAIT(); asm volatile("" ::: "memory");
    const int c = lane & 7;
#pragma unroll
    for (int j = 0; j < 4; ++j) { const int n = (lane >> 3) + 8 * j; const LAS float* s = scr + (8 * c) * 33 + n;
        v4u o; o.x = pk2(s[0 * 33], s[1 * 33]); o.y = pk2(s[2 * 33], s[3 * 33]); o.z = pk2(s[4 * 33], s[5 * 33]); o.w = pk2(s[6 * 33], s[7 * 33]);
        const int row = d.row_base + rowmap(d.kind, d.n0 + n);
        *(v4u*)(d.WT + (size_t)row * d.dK + d.k0 + 8 * c) = o; }
    LDS_WAIT(); asm volatile("" ::: "memory");
}
__device__ __forceinline__ void pro_transposes(const Params& p, LAS unsigned char* lds, int lane, int wave) {
    LAS float* scr = (LAS float*)(lds + wave * 16384);
    const int gw = blockIdx.x * NWAVES + wave, NGW = gridDim.x * NWAVES;
    constexpr int NITEMS = 16 * 113 + 512 + 1536 + 512 + 64 + 130 * 256 + 130 * 128;
    if (gw >= NITEMS) return;
    TrDesc dc = tr_decode(p, gw); float vc[32]; tr_load(dc, lane, vc);
#pragma unroll 1
    for (int it = gw; it < NITEMS; it += NGW) {
        const bool more = it + NGW < NITEMS; TrDesc dn = dc; float vn[32];
        if (more) { dn = tr_decode(p, it + NGW); tr_load(dn, lane, vn); }
        tr_finish(dc, vc, scr, lane);
        if (more) { dc = dn;
#pragma unroll
            for (int i = 0; i < 32; ++i) vc[i] = vn[i]; }
    }
}
__device__ __forceinline__ void pro_rope(const Params& p, int tid) {
    if (blockIdx.x != 255) return;
    float* R = (float*)(p.ws + WS_ROPE);
    for (int i = tid; i < 64 * 16; i += NTHR) { const int pos = i >> 4, f = i & 15; const float inv = exp2f(-(float)f * (13.287712379549449f / 16.f)); const float ang = (float)pos * inv;
        float sn, cs; sincosf(ang, &sn, &cs); R[2 * i] = cs; R[2 * i + 1] = sn; }
}
__device__ __forceinline__ void pro_filters(const Params& p, LAS unsigned char* lds, int tid, int lane, int wave) {
    LAS float* Z = (LAS float*)lds;
    LAS float* H1 = Z + 512;
    LAS float* H2 = H1 + 512;
    const int j0 = 8 * blockIdx.x, j = j0 + wave;
    const float* fw1 = p.in[I_FW1]; const float* fb1 = p.in[I_FB1]; const float* fw2 = p.in[I_FW2]; const float* fb2 = p.in[I_FB2]; const float* fw3 = p.in[I_FW3];
    {   float z = 0.f;
        if (lane == 0) z = (float)j / 2047.f;
        else if (lane < 33) { const int k = (lane - 1) & 15; const float fr = 1e-4f + (float)k * ((15.f - 1e-4f) / 15.f); const float ang = (6.283185307179586f / 2048.f) * (float)j * fr;
            float sn, cs; sincosf(ang, &sn, &cs); z = lane < 17 ? cs : -sn; }
        Z[wave * 64 + lane] = z; }
    LDS_WAIT(); asm volatile("" ::: "memory");
    {   float a = fb1[lane];
#pragma unroll 11
        for (int k = 0; k < 33; ++k) a += Z[wave * 64 + k] * fw1[k * 64 + lane];
        H1[wave * 64 + lane] = sinf(a); }
    LDS_WAIT(); asm volatile("" ::: "memory");
    {   float a = fb2[lane];
#pragma unroll 16
        for (int k = 0; k < 64; ++k) a += H1[wave * 64 + k] * fw2[k * 64 + lane];
        H2[wave * 64 + lane] = sinf(a); }
    __syncthreads();
    bf16* F = (bf16*)(p.ws + WS_FILT);
    const float mind = -4.605170185988091f / 1.5f, maxd = -4.605170185988091f / 0.3f;
#pragma unroll 1
    for (int i = 0; i < 4; ++i) { const int n = tid + NTHR * i, c = n & 1023;
        float acc[8];
#pragma unroll
        for (int q = 0; q < 8; ++q) acc[q] = 0.f;
#pragma unroll 16
        for (int k = 0; k < 64; ++k) { const float w = fw3[k * 2048 + n];
#pragma unroll
            for (int q = 0; q < 8; ++q) acc[q] += H2[q * 64 + k] * w; }
        const float delta = fabsf(mind + (float)c * ((maxd - mind) / 1023.f));
        float o[8];
#pragma unroll
        for (int q = 0; q < 8; ++q) { const float dist = fabsf((float)(j0 + q) - 1024.f) * (1.f / 1024.f); o[q] = acc[q] * expf(-dist * delta); }
        v4u w; w.x = pk2(o[0], o[1]); w.y = pk2(o[2], o[3]); w.z = pk2(o[4], o[5]); w.w = pk2(o[6], o[7]);
        *(v4u*)(F + (size_t)n * 2048 + j0) = w; }
    __syncthreads();
}

__device__ __forceinline__ void l0_norm_rows(const float* src, bf16* dst, int nrows, const float* g, const float* md, int lane) {
    f32x4 vb[4], vc[4];
#pragma unroll
    for (int j = 0; j < 4; ++j) { const int o = 4 * lane + 256 * j; vb[j] = *(const f32x4*)(g + o) * (1.f + *(const f32x4*)(md + D + o)); vc[j] = *(const f32x4*)(md + o); }
    f32x4 xn[4]; row_ld_f32(src, lane, xn);
#pragma unroll 1
    for (int i = 0; i < nrows; ++i) { f32x4 x[4], h[4];
#pragma unroll
        for (int j = 0; j < 4; ++j) x[j] = xn[j];
        if (i + 1 < nrows) row_ld_f32(src + (size_t)(i + 1) * D, lane, xn);
        const float rstd = rsqrtf(row_ss(x) * (1.f / D) + RMS_EPS);
#pragma unroll
        for (int j = 0; j < 4; ++j) h[j] = x[j] * rstd * vb[j] + vc[j];
        row_st_bf16(dst + (size_t)i * D, lane, h); }
}
__device__ __forceinline__ void ph_l0_norm(const Params& p, int lane, int wave) {
    const int gw = blockIdx.x * NWAVES + wave;
    const float* MOD = (const float*)(p.ws + WS_MOD); bf16* H = (bf16*)(p.ws + WS_BIG + A0_H);
    const float* g = p.in[I_NORMG];
    { const int m0 = gw * 32; l0_norm_rows(p.in[I_X] + (size_t)m0 * D, H + (size_t)m0 * D, 32, g, MOD + (size_t)(m0 >> 11) * NMOD, lane); }
    { const int m0 = gw * 4; l0_norm_rows(p.in[I_CTX] + (size_t)m0 * D, H + (size_t)(T + m0) * D, 4, g, MOD + (size_t)32 * NMOD, lane); }
}
__device__ __forceinline__ void ph_mid(const Params& p, int l, const bf16* MIX, bf16* H2, bool has_mix, int lane, int wave, int tile) {
    const int gw = tile * NWAVES + wave;
    const float* MOD = (const float*)(p.ws + WS_MOD) + (size_t)l * 33 * NMOD;
    const float* g1 = p.in[I_NORMG] + (size_t)(l * 4 + 1) * D; const float* g2 = p.in[I_NORMG] + (size_t)(l * 4 + 2) * D;
    const float* xin = l == 0 ? p.in[I_X] : p.out;
    const int m0 = gw * 32; const float* md = MOD + (size_t)(m0 >> 11) * NMOD;
    f32x4 va[4], vb[4], vc[4];
#pragma unroll
    for (int j = 0; j < 4; ++j) { const int o = 4 * lane + 256 * j; va[j] = *(const f32x4*)(md + 2 * D + o) * *(const f32x4*)(g1 + o); vb[j] = *(const f32x4*)(g2 + o) * (1.f + *(const f32x4*)(md + 4 * D + o)); vc[j] = *(const f32x4*)(md + 3 * D + o); }
    f32x4 xn[4], mn[4];
    row_ld_f32(xin + (size_t)m0 * D, lane, xn); if (has_mix) row_ld_bf16(MIX + (size_t)m0 * D, lane, mn);
#pragma unroll 1
    for (int m = m0; m < m0 + 32; ++m) {
        f32x4 x[4], h[4], mx[4];
#pragma unroll
        for (int j = 0; j < 4; ++j) { x[j] = xn[j]; mx[j] = mn[j]; }
        if (m + 1 < m0 + 32) { row_ld_f32(xin + (size_t)(m + 1) * D, lane, xn); if (has_mix) row_ld_bf16(MIX + (size_t)(m + 1) * D, lane, mn); }
        if (has_mix) { const float r = rsqrtf(row_ss(mx) * (1.f / D) + RMS_EPS);
#pragma unroll
            for (int j = 0; j < 4; ++j) x[j] = x[j] + va[j] * (mx[j] * r); }
        row_st_f32(p.out + (size_t)m * D, lane, x);
        const float rstd = rsqrtf(row_ss(x) * (1.f / D) + RMS_EPS);
#pragma unroll
        for (int j = 0; j < 4; ++j) h[j] = x[j] * rstd * vb[j] + vc[j];
        row_st_bf16(H2 + (size_t)m * D, lane, h);
    }
}
__device__ __forceinline__ void ph_combine(const Params& p, int l, int ch, const unsigned char* Y8, bf16* Hn, int lane, int wave) {
    const int gw = blockIdx.x * NWAVES + wave;
    const float* MOD = (const float*)(p.ws + WS_MOD) + (size_t)l * 33 * NMOD;
    const float* g3 = p.in[I_NORMG] + (size_t)(l * 4 + 3) * D;
    const int* PSLOT = (const int*)(p.ws + WS_PSLOT); const float* WTS = (const float*)(p.ws + WS_WTS);
    constexpr int RPW = CHT / 2048;
    const int mbase = ch * CHT + gw * RPW; const float* md = MOD + (size_t)(mbase >> 11) * NMOD;
    float va[16], vb[16], vc[16];
    { const float* md1 = MOD + (size_t)(33 + (mbase >> 11)) * NMOD; const float* g10 = p.in[I_NORMG] + (size_t)4 * D;
#pragma unroll
      for (int q = 0; q < 4; ++q) { const int o = lane * 16 + 4 * q; const f32x4 gp = *(const f32x4*)(g3 + o), gf = *(const f32x4*)(md + 5 * D + o); f32x4 gg = gp, sh = gp, sc = gp;
          if (l == 0) { gg = *(const f32x4*)(g10 + o); sh = *(const f32x4*)(md1 + o); sc = *(const f32x4*)(md1 + D + o); }
#pragma unroll
          for (int j = 0; j < 4; ++j) { va[4 * q + j] = gp[j] * gf[j]; vb[4 * q + j] = gg[j] * (1.f + sc[j]); vc[4 * q + j] = sh[j]; } } }
    int sl[9]; float wk[9];
#define CMB_SLOTS(mt) do { _Pragma("unroll") for (int k = 0; k < 9; ++k) { sl[k] = PSLOT[(size_t)(mt) * 16 + k]; wk[k] = k < 8 ? WTS[(size_t)(mt) * 8 + k] : 1.f; } } while (0)
    CMB_SLOTS(mbase);
#pragma unroll 1
    for (int m = mbase; m < mbase + RPW; ++m) {
        float a[16];
#pragma unroll
        for (int j = 0; j < 16; ++j) a[j] = 0.f;
        u32x4 yr[9]; float wc[9];
#pragma unroll
        for (int k = 0; k < 9; ++k) { yr[k] = *(const u32x4*)(Y8 + (size_t)sl[k] * 1024 + lane * 16); wc[k] = wk[k]; }
        float* orow = p.out + (size_t)m * D + lane * 16; f32x4 xv4[4];
#pragma unroll
        for (int q = 0; q < 4; ++q) xv4[q] = *(const f32x4*)(orow + 4 * q);
        if (m + 1 < mbase + RPW) CMB_SLOTS(m + 1);
#pragma unroll
        for (int k = 0; k < 9; ++k) { const float w = wc[k] * Y8_INV; const unsigned ww[4] = {yr[k].x, yr[k].y, yr[k].z, yr[k].w};
#pragma unroll
            for (int q = 0; q < 4; ++q) { a[4 * q + 0] += w * __builtin_amdgcn_cvt_f32_fp8((int)ww[q], 0); a[4 * q + 1] += w * __builtin_amdgcn_cvt_f32_fp8((int)ww[q], 1);
                                          a[4 * q + 2] += w * __builtin_amdgcn_cvt_f32_fp8((int)ww[q], 2); a[4 * q + 3] += w * __builtin_amdgcn_cvt_f32_fp8((int)ww[q], 3); } }
        float ss = 0.f;
#pragma unroll
        for (int j = 0; j < 16; ++j) ss += a[j] * a[j];
        const float r = rsqrtf(wave_sum(ss) * (1.f / D) + RMS_EPS);
        float x[16]; float s2 = 0.f;
#pragma unroll
        for (int q = 0; q < 4; ++q) {
#pragma unroll
            for (int j = 0; j < 4; ++j) { const float v = xv4[q][j] + va[4 * q + j] * (a[4 * q + j] * r); x[4 * q + j] = v; s2 += v * v; }
            *(f32x4*)(orow + 4 * q) = (f32x4){x[4 * q], x[4 * q + 1], x[4 * q + 2], x[4 * q + 3]}; }
        if (l == 0) { const float rstd = rsqrtf(wave_sum(s2) * (1.f / D) + RMS_EPS); float h[16];
#pragma unroll
            for (int j = 0; j < 16; ++j) h[j] = x[j] * rstd * vb[j] + vc[j];
            v4u w0, w1; w0.x = pk2(h[0], h[1]); w0.y = pk2(h[2], h[3]); w0.z = pk2(h[4], h[5]); w0.w = pk2(h[6], h[7]); w1.x = pk2(h[8], h[9]); w1.y = pk2(h[10], h[11]); w1.z = pk2(h[12], h[13]); w1.w = pk2(h[14], h[15]);
            *(v4u*)(Hn + (size_t)m * D + lane * 16) = w0; *(v4u*)(Hn + (size_t)m * D + lane * 16 + 8) = w1; }
    }
#undef CMB_SLOTS
}

struct DenseSched { int NN, NU, G, c, NMs;
    __device__ __forceinline__ bool next(int i, Unit& u) const { const int L = i * G + c; if (L >= NU) return false; if (NMs > 0) { u.pm = L % NMs; u.pn = L / NMs; } else { u.pm = L / NN; u.pn = L % NN; } return true; }
    __device__ __forceinline__ int arow(int r) const { return r; }
    __device__ __forceinline__ void* probe_ts() const { return nullptr; } };
struct PanelSched { int NN, pm;
    __device__ __forceinline__ bool next(int i, Unit& u) const { if (i >= NN) return false; u.pm = pm; u.pn = i; return true; }
    __device__ __forceinline__ int arow(int r) const { return r; }
    __device__ __forceinline__ void* probe_ts() const { return nullptr; } };
struct EpiBf16 { static constexpr bool PERM = true, AFTER_DRAIN = false, PROBE = false; bf16* O; size_t ldc; int cmask;
    __device__ __forceinline__ void operator()(const f32x4 (&acc)[2][2][4][2], const Unit& u, int wr, int wc, int fr, int fq) const {
        const int row0 = u.pm * BM + wr * 64 + fr, col0 = (u.pn & cmask) * BM + wc * 32 + 8 * fq;
#pragma unroll
        for (int ai = 0; ai < 2; ++ai)
#pragma unroll
            for (int m = 0; m < 4; ++m) { bf16* rowp = O + (size_t)(row0 + ai * HALF + m * 16) * ldc + col0;
#pragma unroll
                for (int bj = 0; bj < 2; ++bj) { const f32x4 v0 = acc[ai][bj][m][0], v1 = acc[ai][bj][m][1];
                    u32x4 w; w.x = cvt_pk_bf16(v0[0], v0[1]); w.y = cvt_pk_bf16(v0[2], v0[3]); w.z = cvt_pk_bf16(v1[0], v1[1]); w.w = cvt_pk_bf16(v1[2], v1[3]);
                    *(u32x4*)(rowp + bj * HALF) = w; } }
    } };
struct EpiRouter { static constexpr bool PERM = false, AFTER_DRAIN = false, PROBE = false; float* LOG;
    __device__ __forceinline__ void operator()(const f32x4 (&acc)[2][2][4][2], const Unit& u, int wr, int wc, int fr, int fq) const {
        if (wc >= 2) return;
        const int row0 = u.pm * BM + wr * 64 + fr, col0 = wc * 32 + 4 * fq;
#pragma unroll
        for (int ai = 0; ai < 2; ++ai)
#pragma unroll
            for (int m = 0; m < 4; ++m) { float* rowp = LOG + (size_t)(row0 + ai * HALF + m * 16) * 64 + col0;
#pragma unroll
                for (int n = 0; n < 2; ++n) *(f32x4*)(rowp + n * 16) = acc[ai][0][m][n]; }
    } };
struct EpiFp8 { static constexpr bool PERM = true, AFTER_DRAIN = false, PROBE = true; unsigned char* O;
    __device__ __forceinline__ void operator()(const f32x4 (&acc)[2][2][4][2], const Unit& u, int wr, int wc, int fr, int fq) const {
        const int row0 = u.pm * BM + wr * 64 + fr, col0 = (u.pn & 3) * BM + wc * 64 + 16 * fq;
#pragma unroll
        for (int ai = 0; ai < 2; ++ai)
#pragma unroll
            for (int m = 0; m < 4; ++m) { unsigned char* rowp = O + (size_t)(row0 + ai * HALF + m * 16) * 1024 + col0; u32x4 w;
#pragma unroll
                for (int bj = 0; bj < 2; ++bj) { f32x4 v0 = acc[ai][bj][m][0] * Y8_SCALE, v1 = acc[ai][bj][m][1] * Y8_SCALE; int lo = 0, hi = 0;
#pragma unroll
                    for (int j = 0; j < 4; ++j) { v0[j] = __builtin_amdgcn_fmed3f(v0[j], -440.f, 440.f); v1[j] = __builtin_amdgcn_fmed3f(v1[j], -440.f, 440.f); }
                    lo = __builtin_amdgcn_cvt_pk_fp8_f32(v0[0], v0[1], lo, false); lo = __builtin_amdgcn_cvt_pk_fp8_f32(v0[2], v0[3], lo, true);
                    hi = __builtin_amdgcn_cvt_pk_fp8_f32(v1[0], v1[1], hi, false); hi = __builtin_amdgcn_cvt_pk_fp8_f32(v1[2], v1[3], hi, true);
                    if (bj == 0) { w.x = (unsigned)lo; w.y = (unsigned)hi; } else { w.z = (unsigned)lo; w.w = (unsigned)hi; } }
                *(u32x4*)rowp = w; }
    } };
struct EpiRouterLds { static constexpr bool PERM = false, AFTER_DRAIN = true, PROBE = false;
    __device__ __forceinline__ void operator()(const f32x4 (&)[2][2][4][2], const Unit&, int, int, int, int) const {}
    __device__ __forceinline__ void fused(const f32x4 (&acc)[2][2][4][2], const Unit&, int wr, int wc, int fr, int fq, LAS unsigned char* lds) const {
        if (wc >= 2) return;
        LAS float* SC = (LAS float*)lds;
#pragma unroll
        for (int ai = 0; ai < 2; ++ai)
#pragma unroll
            for (int m = 0; m < 4; ++m) { const int row = ai * HALF + wr * 64 + m * 16 + fr;
#pragma unroll
                for (int n = 0; n < 2; ++n)
#pragma unroll
                    for (int j = 0; j < 4; ++j) SC[row * 65 + wc * 32 + n * 16 + 4 * fq + j] = sigmoidf_(acc[ai][0][m][n][j]); }
    } };
struct MoeSched { const LAS int* te; const int* sort; int NU, G, c, sh, per;
    __device__ __forceinline__ bool next(int i, Unit& u) const { const int L = i * G + c; if (L >= NU) return false; const int tile = L >> sh; u.pm = tile; u.pn = te[tile] * per + (L & (per - 1)); return true; }
    __device__ __forceinline__ int arow(int r) const { return sort ? sort[r] : r; }
    void* pts; __device__ __forceinline__ void* probe_ts() const { return pts; } };
struct EpiSwiglu { static constexpr bool PERM = true, AFTER_DRAIN = false, PROBE = false; bf16* ACT;
    __device__ __forceinline__ void operator()(const f32x4 (&acc)[2][2][4][2], const Unit& u, int wr, int wc, int fr, int fq) const {
        const int row0 = u.pm * BM + wr * 64 + fr, col0 = (u.pn & 1) * 128 + wc * 32 + 8 * fq;
#pragma unroll
        for (int ai = 0; ai < 2; ++ai)
#pragma unroll
            for (int m = 0; m < 4; ++m) { bf16* rowp = ACT + (size_t)(row0 + ai * HALF + m * 16) * DE + col0;
                const f32x4 g0 = acc[ai][0][m][0], g1 = acc[ai][0][m][1], u0 = acc[ai][1][m][0], u1 = acc[ai][1][m][1];
                float o[8];
#pragma unroll
                for (int q = 0; q < 4; ++q) { o[q] = siluf_(g0[q]) * u0[q]; o[4 + q] = siluf_(g1[q]) * u1[q]; }
                u32x4 w; w.x = cvt_pk_bf16(o[0], o[1]); w.y = cvt_pk_bf16(o[2], o[3]); w.z = cvt_pk_bf16(o[4], o[5]); w.w = cvt_pk_bf16(o[6], o[7]);
                *(u32x4*)rowp = w; }
    } };
__device__ __forceinline__ int moe_tables(const Params& p, int ch, LAS unsigned char* lds, int tid) {
    LAS int* TE = (LAS int*)(lds + LDS_TAB);
    const int* TEG = (const int*)(p.ws + WS_TEG) + (size_t)ch * (MAXTILES + 64);
    __syncthreads();
#pragma unroll 1
    for (int i = tid; i <= MAXTILES; i += NTHR) TE[i] = TEG[i];
    __syncthreads();
    return TE[MAXTILES];
}

__device__ __forceinline__ void ph_route_a(const Params& p, int l, const float* LOG, int tile, LAS unsigned char* lds, int tid) {
    LAS float* SC = (LAS float*)lds;
    LAS float* RBs = (LAS float*)(lds + 68 * 1024);
    LAS unsigned* MASK = (LAS unsigned*)(lds + 69 * 1024);
    const int b = tile, tok0 = 256 * b;
    if (LOG)
#pragma unroll 1
    for (int i = tid; i < 256 * 64; i += NTHR) { const int t = i >> 6, e = i & 63; SC[t * 65 + e] = sigmoidf_(LOG[(size_t)(tok0 + t) * 64 + e]); }
    if (tid < 64) RBs[tid] = p.in[I_RB][l * 64 + tid];
    MASK[tid] = 0u;
    __syncthreads();
    int eidx[8]; float wts[8];
    if (tid < 256) { const int t = tid; const LAS float* sc = SC + t * 65;
        float gs[8], bv[64];
#pragma unroll
        for (int g = 0; g < 8; ++g) { float m1 = -3.0e38f, m2 = -3.0e38f;
#pragma unroll
            for (int j = 0; j < 8; ++j) { const float v = sc[8 * g + j] + RBs[8 * g + j]; bv[8 * g + j] = v; if (v > m1) { m2 = m1; m1 = v; } else if (v > m2) m2 = v; }
            gs[g] = m1 + m2; }
        unsigned gmask = 0u;
#pragma unroll
        for (int r = 0; r < 4; ++r) { float best = -3.0e38f; int bi = 0; bool found = false;
#pragma unroll
            for (int g = 0; g < 8; ++g) { const bool free_ = ((gmask >> g) & 1u) == 0u; if (free_ && (!found || gs[g] > best)) { best = gs[g]; bi = g; found = true; } }
            gmask |= 1u << bi; }
#pragma unroll
        for (int e = 0; e < 64; ++e) if (((gmask >> (e >> 3)) & 1u) == 0u) bv[e] = -3.0e38f;
        unsigned long long taken = 0ull; float ssum = 0.f;
#pragma unroll
        for (int k = 0; k < 8; ++k) { float best = -3.0e38f; int be = 0; bool found = false;
#pragma unroll
            for (int e = 0; e < 64; ++e) { const bool ok = ((taken >> e) & 1ull) == 0ull; if (ok && (!found || bv[e] > best)) { best = bv[e]; be = e; found = true; } }
            taken |= 1ull << be; eidx[k] = be; wts[k] = sc[be]; ssum += wts[k]; }
        const float inv = 2.5f / ssum;
#pragma unroll
        for (int k = 0; k < 8; ++k) { wts[k] *= inv; __hip_atomic_fetch_or(&MASK[eidx[k] * 8 + (t >> 5)], 1u << (t & 31), __ATOMIC_RELAXED, __HIP_MEMORY_SCOPE_WORKGROUP); }
    }
    __syncthreads();
    if (tid < 256) { const int t = tid; int* EIDX = (int*)(p.ws + WS_EIDX); float* WTS = (float*)(p.ws + WS_WTS);
#pragma unroll
        for (int k = 0; k < 8; ++k) { const int e = eidx[k]; int r = 0;
#pragma unroll 1
            for (int w = 0; w < (t >> 5); ++w) r += __popc(MASK[e * 8 + w]);
            r += __popc(MASK[e * 8 + (t >> 5)] & ((1u << (t & 31)) - 1u));
            EIDX[(size_t)(tok0 + t) * 8 + k] = e | (r << 8); WTS[(size_t)(tok0 + t) * 8 + k] = wts[k]; } }
    if (tid < 64) { int c = 0;
#pragma unroll
        for (int w = 0; w < 8; ++w) c += __popc(MASK[tid * 8 + w]);
        ((int*)(p.ws + WS_BC))[b * 64 + tid] = c; }
    __syncthreads();
}
__device__ __forceinline__ void ph_route_b(const Params& p, LAS unsigned char* lds, int tid) {
    LAS int* BCS = (LAS int*)lds;
    LAS int* CNT = BCS + BPC * 64; LAS int* PRE = CNT + 64; LAS int* SEG = PRE + 64;
    const int b = blockIdx.x, ch = b / BPC, bl = b % BPC;
    const int* BC = (const int*)(p.ws + WS_BC) + (size_t)ch * BPC * 64;
#pragma unroll 1
    for (int i = tid; i < BPC * 64; i += NTHR) BCS[i] = BC[i];
    __syncthreads();
    if (tid < 64) { int c = 0, pr = 0;
#pragma unroll 1
        for (int i = 0; i < BPC; ++i) { const int v = BCS[i * 64 + tid]; c += v; if (i < bl) pr += v; } CNT[tid] = c; PRE[tid] = pr; }
    __syncthreads();
    if (tid == 0) { int base = 0;
#pragma unroll 1
        for (int e = 0; e < 64; ++e) { SEG[e] = base; base += ((CNT[e] + 255) >> 8) << 8; } SEG[64] = base; }
    __syncthreads();
    int* SORT = (int*)(p.ws + WS_SORT) + (size_t)ch * CHROWS; int* PSLOT = (int*)(p.ws + WS_PSLOT); const int* EIDX = (const int*)(p.ws + WS_EIDX);
    if (tid < 256) { const int tok = 256 * b + tid;
#pragma unroll
        for (int k = 0; k < 8; ++k) { const int w = EIDX[(size_t)tok * 8 + k], e = w & 255, r = w >> 8; const int slot = SEG[e] + PRE[e] + r; SORT[slot] = tok; PSLOT[(size_t)tok * 16 + k] = slot; }
        const int s8 = SEG[64] + (tok - ch * CHT); SORT[s8] = tok; PSLOT[(size_t)tok * 16 + 8] = s8; }
    if (bl == 0) {
        int* TEG = (int*)(p.ws + WS_TEG) + (size_t)ch * (MAXTILES + 64); const int NT = (SEG[64] >> 8) + CHT / 256;
#pragma unroll 1
        for (int i = tid; i < NT; i += NTHR) { int e = 0;
#pragma unroll 1
            while (e < 64 && (i << 8) >= SEG[e + 1]) ++e;
            TEG[i] = e; }
        if (tid == 0) TEG[MAXTILES] = NT; }
    if (bl < 64) { const int e = bl, lo = SEG[e] + CNT[e], hi = SEG[e] + (((CNT[e] + 255) >> 8) << 8); for (int s = lo + tid; s < hi; s += NTHR) SORT[s] = ch * CHT; }
    __syncthreads();
}

typedef float f32x16 __attribute__((ext_vector_type(16)));
__device__ __forceinline__ void ph_sconv(const Params& p, const bf16* UT, bf16* UC, int tid) {
    const float* cw = p.in[I_CONVHYW]; const float* cbias = p.in[I_CONVHYB];
    const unsigned NIT = 3072u * 32u * 256u; const unsigned gt = blockIdx.x * NTHR + tid, NG = gridDim.x * NTHR;
#pragma unroll 1
    for (unsigned it = gt; it < NIT; it += NG) {
        const unsigned c = it >> 13, k = it & 255u; const size_t base = (size_t)it * 8;
        const v4u w = *(const v4u*)(UT + base);
        const float w0 = cw[c], w1 = cw[3072 + c], w2 = cw[6144 + c], bb = cbias[c];
        float x[10];
        x[0] = k > 0 ? bf1(UT[base - 1]) : 0.f; x[9] = k < 255 ? bf1(UT[base + 8]) : 0.f;
        x[1] = bf_lo(w.x); x[2] = bf_hi(w.x); x[3] = bf_lo(w.y); x[4] = bf_hi(w.y); x[5] = bf_lo(w.z); x[6] = bf_hi(w.z); x[7] = bf_lo(w.w); x[8] = bf_hi(w.w);
        float o[8];
#pragma unroll
        for (int j = 0; j < 8; ++j) o[j] = bb + w0 * x[j] + w1 * x[j + 1] + w2 * x[j + 2];
        v4u r; r.x = pk2(o[0], o[1]); r.y = pk2(o[2], o[3]); r.z = pk2(o[4], o[5]); r.w = pk2(o[6], o[7]);
        *(v4u*)(UC + base) = r;
    }
}
constexpr int LC_CPB = 8224, LC_RAW = 8 * LC_CPB, LC_RAWSZ = 32 * 512, LC_HALO = LC_RAW + 2 * LC_RAWSZ, LC_VBP = 528, LC_VB0 = LC_HALO + 2 * 8192, LC_VBSZ = 32 * LC_VBP;
static_assert(LC_VB0 + 2 * LC_VBSZ <= LDS_MISC && 8 * 32 * 528 <= LDS_MISC, "lconv LDS map");
struct Taps { float w0, w1, w2, b; };
__device__ __forceinline__ float bfh(unsigned w, int hi) { return hi ? bf_hi(w) : bf_lo(w); }
template <bool CONVIN>
__device__ __forceinline__ void lconv_unit(const bf16* vin, const Taps ti, const bf16* F, const bf16* graw, const Taps tg, float fb, bf16* out, LAS unsigned char* lds, int tid, int lane, int wave) {
    __syncthreads();
#define LC_DMA(ch, rb) do { _Pragma("unroll") for (int q = 0; q < 2; ++q) { const int row = wave * 4 + 2 * q + (ln >> 5); \
        __builtin_amdgcn_global_load_lds((const unsigned*)(vin + (size_t)row * 2048 + (ch) * 256 + (ln & 31) * 8), (LAS unsigned*)(lds + LC_RAW + (rb) * LC_RAWSZ + (wave * 4 + 2 * q) * 512), 16, 0, 0); } \
        { const int hrow = wave * 4 + ((ln & 7) >> 1); int hs = (ln & 1) ? (ch) * 256 + 256 : (ch) * 256 - 8; hs = hs < 0 ? 0 : (hs > 2040 ? 2040 : hs); \
          __builtin_amdgcn_global_load_lds((const unsigned*)(vin + (size_t)hrow * 2048 + hs), (LAS unsigned*)(lds + LC_HALO + (rb) * 8192 + wave * 1024), 16, 0, 0); } } while (0)
    LAS bf16* Fl = (LAS bf16*)(lds + LC_VB0 + LC_VBSZ);
    { int ln = lane; asm volatile("" : "+v"(ln)); LC_DMA(0, 0); LC_DMA(1, 1); }
    if (tid < 256) *(LAS v4u*)(Fl + tid * 8) = *(const v4u*)(F + tid * 8);
    __syncthreads();
    if (tid == 0) Fl[1024] = (bf16)f2bf(bf1(Fl[1024]) + fb);
    __syncthreads();
#pragma unroll 1
    for (int a = 0; a < 8; ++a)
#pragma unroll 1
        for (int mi = tid; mi < 2056; mi += NTHR) { const int m = mi * 2; const int x0 = 3079 - m - a, x1 = x0 - 1;
            const unsigned lo = (x0 >= 0 && x0 <= 2047) ? (unsigned)Fl[x0] : 0u, hi = (x1 >= 0 && x1 <= 2047) ? (unsigned)Fl[x1] : 0u;
            *(LAS unsigned*)(lds + a * LC_CPB + m * 2) = lo | (hi << 16); }
    const int r = lane & 31, h = lane >> 5, a = (7 - r) & 7;
    const LAS unsigned char* cpA = lds + a * LC_CPB + 2 * (1023 - r + 8 * h - a + 1032) - 512 * wave;
    const int laneB = r * LC_VBP + 16 * h;
#define LC_CONVERT(ch, rb, buf) do { _Pragma("unroll") for (int q = 0; q < 2; ++q) { const int pid = ln + 64 * q, row = wave * 4 + (pid >> 5), pp = pid & 31; const LAS unsigned char* rp = lds + LC_RAW + (rb) * LC_RAWSZ + row * 512 + pp * 16; \
        const v4u w = *(const LAS v4u*)rp; v4u o = w; \
        if (CONVIN) { const LAS unsigned char* hp_ = lds + LC_HALO + (rb) * 8192 + wave * 1024 + (pid >> 5) * 32; float x[10]; \
            x[0] = pp > 0 ? bf1(*(const LAS bf16*)(rp - 2)) : ((ch) > 0 ? bf1(*(const LAS bf16*)(hp_ + 14)) : 0.f); x[9] = pp < 31 ? bf1(*(const LAS bf16*)(rp + 16)) : ((ch) < 7 ? bf1(*(const LAS bf16*)(hp_ + 16)) : 0.f); \
            x[1] = bf_lo(w.x); x[2] = bf_hi(w.x); x[3] = bf_lo(w.y); x[4] = bf_hi(w.y); x[5] = bf_lo(w.z); x[6] = bf_hi(w.z); x[7] = bf_lo(w.w); x[8] = bf_hi(w.w); \
            float y[8]; _Pragma("unroll") for (int j = 0; j < 8; ++j) y[j] = ti.b + ti.w0 * x[j] + ti.w1 * x[j + 1] + ti.w2 * x[j + 2]; \
            o.x = pk2(y[0], y[1]); o.y = pk2(y[2], y[3]); o.z = pk2(y[4], y[5]); o.w = pk2(y[6], y[7]); } \
        *(LAS v4u*)(lds + LC_VB0 + (buf) * LC_VBSZ + row * LC_VBP + pp * 16) = o; } } while (0)
    { int ln = lane; asm volatile("" : "+v"(ln));
    asm volatile("s_waitcnt vmcnt(3)" ::: "memory");
    LC_CONVERT(0, 0, 0); }
    asm volatile("s_waitcnt lgkmcnt(0)" ::: "memory"); __builtin_amdgcn_s_barrier(); asm volatile("" ::: "memory");
    f32x16 acc[8];
#pragma unroll
    for (int i = 0; i < 8; ++i)
#pragma unroll
        for (int q = 0; q < 16; ++q) acc[i][q] = 0.f;
    bf16x8 E[8], O[8];
    bool primed = false;
#pragma unroll 1
    for (int ch = 0; ch < 8; ++ch) {
        int ln = lane; asm volatile("" : "+v"(ln));
        if (ch < 6) LC_DMA(ch + 2, ch & 1);
        const int du = wave - ch;
        if (du >= -4 && du <= 4) {
            const LAS unsigned char* ca = cpA + 64 * (ch * 8); const LAS unsigned char* vbh = lds + LC_VB0 + (ch & 1) * LC_VBSZ + laneB;
            if (!primed) { primed = true;
#pragma unroll
                for (int i = 1; i < 8; ++i) { E[(8 - i) & 7] = *(const LAS bf16x8*)(ca + 32 * (-2 * i)); O[(8 - i) & 7] = *(const LAS bf16x8*)(ca + 32 * (-2 * i + 1)); }
                E[0] = *(const LAS bf16x8*)ca; O[0] = *(const LAS bf16x8*)(ca + 32); }
            bf16x8 bc0 = *(const LAS bf16x8*)vbh, bc1 = *(const LAS bf16x8*)(vbh + 32);
#pragma unroll
            for (int mm = 0; mm < 8; ++mm) {
                bf16x8 bn0 = bc0, bn1 = bc1;
                if (mm < 7) { bn0 = *(const LAS bf16x8*)(vbh + 64 * (mm + 1)); bn1 = *(const LAS bf16x8*)(vbh + 64 * (mm + 1) + 32); }
                acc[7] = __builtin_amdgcn_mfma_f32_32x32x16_bf16(E[(mm + 1) & 7], bc0, acc[7], 0, 0, 0);
                E[(mm + 1) & 7] = *(const LAS bf16x8*)(ca + 64 * (mm + 1));
#pragma unroll
                for (int i = 0; i < 7; ++i) acc[i] = __builtin_amdgcn_mfma_f32_32x32x16_bf16(E[(mm - i) & 7], bc0, acc[i], 0, 0, 0);
                acc[7] = __builtin_amdgcn_mfma_f32_32x32x16_bf16(O[(mm + 1) & 7], bc1, acc[7], 0, 0, 0);
                O[(mm + 1) & 7] = *(const LAS bf16x8*)(ca + 64 * (mm + 1) + 32);
#pragma unroll
                for (int i = 0; i < 7; ++i) acc[i] = __builtin_amdgcn_mfma_f32_32x32x16_bf16(O[(mm - i) & 7], bc1, acc[i], 0, 0, 0);
                bc0 = bn0; bc1 = bn1;
            }
        }
        if (ch < 7) { if (ch < 6) asm volatile("s_waitcnt vmcnt(3)" ::: "memory"); else asm volatile("s_waitcnt vmcnt(0)" ::: "memory"); LC_CONVERT(ch + 1, (ch + 1) & 1, (ch + 1) & 1); }
        asm volatile("s_waitcnt lgkmcnt(0)" ::: "memory"); __builtin_amdgcn_s_barrier(); asm volatile("" ::: "memory");
    }
#undef LC_DMA
#undef LC_CONVERT
    { int le = lane; asm volatile("" : "+v"(le)); const int re = le & 31, he = le >> 5;
      LAS unsigned char* tw = lds + wave * (32 * 528);
#pragma unroll
      for (int i = 0; i < 8; ++i)
#pragma unroll
          for (int g = 0; g < 4; ++g) { v2u w; w.x = pk2(acc[i][4 * g + 0], acc[i][4 * g + 1]); w.y = pk2(acc[i][4 * g + 2], acc[i][4 * g + 3]); *(LAS v2u*)(tw + re * 528 + (32 * i + 8 * g + 4 * he) * 2) = w; }
      LDS_WAIT(); asm volatile("" ::: "memory");
      const int pp = le & 31;
      v4u gwa[16]; float hal[16];
      const bool hprev = pp == 0 && wave > 0, hnext = pp == 31 && wave < 7;
#pragma unroll
      for (int it = 0; it < 16; ++it) { const size_t off = (size_t)(2 * it + (le >> 5)) * 2048 + 256 * wave + pp * 8; gwa[it] = *(const v4u*)(graw + off);
          hal[it] = (hprev || hnext) ? bf1(graw[hprev ? off - 1 : off + 8]) : 0.f; }
#pragma unroll
      for (int it = 0; it < 16; ++it) { const int row = 2 * it + (le >> 5); const size_t off = (size_t)row * 2048 + 256 * wave + pp * 8;
          const v4u gw = gwa[it]; const v4u aw = *(const LAS v4u*)(tw + row * 528 + pp * 16);
          const float hp = hal[it], hn = hal[it];
          float gx[10]; gx[1] = bf_lo(gw.x); gx[2] = bf_hi(gw.x); gx[3] = bf_lo(gw.y); gx[4] = bf_hi(gw.y); gx[5] = bf_lo(gw.z); gx[6] = bf_hi(gw.z); gx[7] = bf_lo(gw.w); gx[8] = bf_hi(gw.w);
          const float fromprev = shidx(gx[8], le - 1), fromnext = shidx(gx[1], le + 1);
          gx[0] = pp > 0 ? fromprev : hp; gx[9] = pp < 31 ? fromnext : hn;
          const float av[8] = {bf_lo(aw.x), bf_hi(aw.x), bf_lo(aw.y), bf_hi(aw.y), bf_lo(aw.z), bf_hi(aw.z), bf_lo(aw.w), bf_hi(aw.w)};
          float o[8];
#pragma unroll
          for (int j = 0; j < 8; ++j) o[j] = (tg.b + tg.w0 * gx[j] + tg.w1 * gx[j + 1] + tg.w2 * gx[j + 2]) * av[j];
          v4u w; w.x = pk2(o[0], o[1]); w.y = pk2(o[2], o[3]); w.z = pk2(o[4], o[5]); w.w = pk2(o[6], o[7]);
          *(v4u*)(out + off) = w; }
    }
}
template <bool CONVIN>
__device__ __forceinline__ void ph_lconv(const Params& p, int o, const bf16* IN, const bf16* UT, bf16* OUT, LAS unsigned char* lds, int tid, int lane, int wave) {
    const bf16* FILT = (const bf16*)(p.ws + WS_FILT); const float* cw = p.in[I_CONVHYW]; const float* cbias = p.in[I_CONVHYB];
#pragma unroll 1
    for (int c = blockIdx.x; c < 1024; c += gridDim.x) { const int gc = (1 + o) * 1024 + c;
        const Taps ti{cw[c], cw[3072 + c], cw[6144 + c], cbias[c]}, tg{cw[gc], cw[3072 + gc], cw[6144 + gc], cbias[gc]};
        lconv_unit<CONVIN>(IN + (size_t)c * T, ti, FILT + (size_t)(o * 1024 + c) * 2048, UT + (size_t)gc * T, tg, p.in[I_FBIAS][o * 1024 + c], OUT + (size_t)c * T, lds, tid, lane, wave); }
}
__device__ __forceinline__ void ph_transpose(const bf16* Y2T, bf16* Y2, LAS unsigned char* lds, int lane, int wave, int panel) {
    LAS unsigned char* tl = lds + wave * 16384;
#pragma unroll 1
    for (int tile = wave; tile < 64; tile += NWAVES) { const int c0 = (tile & 15) * 64, t0 = panel * 256 + (tile >> 4) * 64;
#pragma unroll
        for (int rr = 0; rr < 8; ++rr) { const int row = rr * 8 + (lane >> 3), pc = lane & 7;
            *(LAS v4u*)(tl + row * 144 + pc * 16) = *(const v4u*)(Y2T + (size_t)(c0 + row) * T + t0 + pc * 8); }
        LDS_WAIT(); asm volatile("" ::: "memory");
#pragma unroll
        for (int rr = 0; rr < 8; ++rr) { const int tk = rr * 8 + (lane >> 3), cp = (lane & 7) * 8;
            unsigned short e[8];
#pragma unroll
            for (int j = 0; j < 8; ++j) e[j] = *(const LAS unsigned short*)(tl + (cp + j) * 144 + tk * 2);
            v4u w; w.x = e[0] | ((unsigned)e[1] << 16); w.y = e[2] | ((unsigned)e[3] << 16); w.z = e[4] | ((unsigned)e[5] << 16); w.w = e[6] | ((unsigned)e[7] << 16);
            *(v4u*)(Y2 + (size_t)(t0 + tk) * D + c0 + cp) = w; }
        LDS_WAIT(); asm volatile("" ::: "memory");
    }
}

constexpr float QSCALE = 0.125f * 1.4426950408889634f;
struct InprojSched { int G, c;
    __device__ __forceinline__ bool next(int i, Unit& u) const { const int L = i * G + c; if (L >= 3840 + 288) return false;
        if (L < 3840) { u.pm = L / 15; u.pn = L % 15; } else { const int q = L - 3840; u.pm = 256 + q / 9; u.pn = 6 + q % 9; } return true; }
    __device__ __forceinline__ int arow(int r) const { return r; }
    __device__ __forceinline__ void* probe_ts() const { return nullptr; } };
struct EpiInproj { static constexpr bool PERM = true, AFTER_DRAIN = false, PROBE = false; unsigned char* big; const float* rope; float* gates; const float* gate_b;
    __device__ __forceinline__ void operator()(const f32x4 (&acc)[2][2][4][2], const Unit& u, int wr, int wc, int fr, int fq) const {
        const bool ctx = u.pm >= 256; const int b = ctx ? u.pm - 256 : (u.pm >> 3), r0 = ctx ? 0 : (u.pm & 7) * 256;
        if (u.pn == 14) {
            if (wc != 0 || fq >= 2) return;
            const f32x4 gb0 = *(const f32x4*)(gate_b + 8 * fq), gb1 = *(const f32x4*)(gate_b + 8 * fq + 4);
#pragma unroll
            for (int ai = 0; ai < 2; ++ai)
#pragma unroll
                for (int m = 0; m < 4; ++m) { const int rr = r0 + wr * 64 + fr + ai * HALF + m * 16; const size_t grow = ctx ? (size_t)T + b * LC + rr : (size_t)b * SEQ + rr;
                    float* gp = gates + grow * 16 + 8 * fq; *(f32x4*)gp = acc[ai][0][m][0] + gb0; *(f32x4*)(gp + 4) = acc[ai][0][m][1] + gb1; }
            return; }
        const int t = u.pn >> 1;
        constexpr size_t offs[7] = {A0_QA, A0_BQ, A0_BO, A0_KA, A0_VA, A0_BK, A0_BV};
        const bool kv = t >= 3;
        size_t toff = A0_QA;
#pragma unroll
        for (int q = 0; q < 7; ++q) if (t == q) toff = offs[q];
        bf16* O = (bf16*)(big + toff) + (size_t)b * (kv ? (SEQ + LC) : SEQ) * 512 + (size_t)((kv && !ctx) ? LC : 0) * 512;
        const bool rope_on = (t == 0 || t == 3) && !ctx; const float qs = t == 0 ? QSCALE : 1.f;
        const int col0 = (u.pn & 1) * 256 + wc * 32 + 8 * fq;
#pragma unroll
        for (int ai = 0; ai < 2; ++ai)
#pragma unroll
            for (int m = 0; m < 4; ++m) { const int rr = r0 + wr * 64 + fr + ai * HALF + m * 16; bf16* rowp = O + (size_t)rr * 512 + col0;
                f32x4 cs0 = (f32x4){1.f, 0.f, 1.f, 0.f}, cs1 = cs0;
                if (rope_on) { const int pos = (wc & 1) ? (rr & 63) : (rr >> 6); const float* rp = rope + (size_t)(pos * 16 + 4 * fq) * 2; cs0 = *(const f32x4*)rp; cs1 = *(const f32x4*)(rp + 4); }
#pragma unroll
                for (int bj = 0; bj < 2; ++bj) { const f32x4 x0 = acc[ai][bj][m][0], x1 = acc[ai][bj][m][1];
                    f32x4 o0, o1;
                    o0[0] = x0[0] * cs0[0] - x1[0] * cs0[1]; o1[0] = x1[0] * cs0[0] + x0[0] * cs0[1];
                    o0[1] = x0[1] * cs0[2] - x1[1] * cs0[3]; o1[1] = x1[1] * cs0[2] + x0[1] * cs0[3];
                    o0[2] = x0[2] * cs1[0] - x1[2] * cs1[1]; o1[2] = x1[2] * cs1[0] + x0[2] * cs1[1];
                    o0[3] = x0[3] * cs1[2] - x1[3] * cs1[3]; o1[3] = x1[3] * cs1[2] + x0[3] * cs1[3];
                    o0 = o0 * qs; o1 = o1 * qs;
                    u32x4 w; w.x = cvt_pk_bf16(o0[0], o0[1]); w.y = cvt_pk_bf16(o0[2], o0[3]); w.z = cvt_pk_bf16(o1[0], o1[1]); w.w = cvt_pk_bf16(o1[2], o1[3]);
                    *(u32x4*)(rowp + bj * HALF) = w; } }
    } };
__device__ __forceinline__ void ph_transpose_b(const bf16* src, bf16* dst, int NBt, int R, int C, LAS unsigned char* lds, int lane, int wave) {
    LAS unsigned char* tl = lds + wave * 16384;
    const int gw = blockIdx.x * NWAVES + wave, NGW = gridDim.x * NWAVES; const int tr = R / 64, tc = C / 64, per = tr * tc;
#pragma unroll 1
    for (int tile = gw; tile < NBt * per; tile += NGW) { const int bt = tile / per, q = tile % per, c0 = (q % tc) * 64, r0 = (q / tc) * 64;
        const bf16* s = src + (size_t)bt * R * C; bf16* d = dst + (size_t)bt * R * C;
#pragma unroll
        for (int rr = 0; rr < 8; ++rr) { const int row = rr * 8 + (lane >> 3), pc = lane & 7;
            *(LAS v4u*)(tl + row * 144 + pc * 16) = *(const v4u*)(s + (size_t)(r0 + row) * C + c0 + pc * 8); }
        LDS_WAIT(); asm volatile("" ::: "memory");
#pragma unroll
        for (int rr = 0; rr < 8; ++rr) { const int cc = rr * 8 + (lane >> 3), rp = (lane & 7) * 8;
            unsigned short e[8];
#pragma unroll
            for (int j = 0; j < 8; ++j) e[j] = *(const LAS unsigned short*)(tl + (rp + j) * 144 + cc * 2);
            v4u w; w.x = e[0] | ((unsigned)e[1] << 16); w.y = e[2] | ((unsigned)e[3] << 16); w.z = e[4] | ((unsigned)e[5] << 16); w.w = e[6] | ((unsigned)e[7] << 16);
            *(v4u*)(d + (size_t)(c0 + cc) * R + r0 + rp) = w; }
        LDS_WAIT(); asm volatile("" ::: "memory");
    }
}

typedef short s16x4 __attribute__((ext_vector_type(4)));
__device__ __forceinline__ u32x2 tr16(const LAS unsigned char* p) { return __builtin_bit_cast(u32x2, __builtin_amdgcn_ds_read_tr16_b64_v4i16((LAS s16x4*)p)); }
typedef float f32x2 __attribute__((ext_vector_type(2)));
constexpr int AT_KP = 272, AT_VP = 320  , AT_KB = 64 * AT_KP, AT_VB = 64 * AT_VP, AT_V0 = 2 * AT_KB;
__device__ __forceinline__ void ph_attn(const Params& p, unsigned char* big, LAS unsigned char* lds, int tid, int lane, int wave, int vcu) {
    const bf16* QA = (const bf16*)(big + A0_QA); const bf16* KA = (const bf16*)(big + A0_KA); const bf16* VA = (const bf16*)(big + A0_VA); bf16* MIXIN = (bf16*)(big + A0_MIXIN);
    const int blk = (lane >> 4) & 1, tq = (lane & 15) >> 2, tp = lane & 3;
    const int comp = wave >> 2, qw = wave & 3, r = lane & 31, hh = lane >> 5;
    float lam; { const float* lv = p.in[I_DLAM]; const float a = wave_sum(lv[lane] * lv[64 + lane]), b2 = wave_sum(lv[128 + lane] * lv[192 + lane]); lam = expf(a) - expf(b2) + 0.2f; }
#pragma unroll 1
    for (int unit = vcu; unit < 2048; unit += gridDim.x) {
        const int b = unit >> 6, h = (unit >> 4) & 3, qblk = unit & 15, q0 = qblk * 128 + qw * 32;
        const bf16* Kg = KA + (size_t)b * (SEQ + LC) * 512 + h * 128; const bf16* Vg = VA + (size_t)b * (SEQ + LC) * 512 + h * 128;
        bf16x8 qf[4];
#pragma unroll
        for (int ds = 0; ds < 4; ++ds) qf[ds] = *(const bf16x8*)(QA + ((size_t)b * SEQ + q0 + r) * 512 + h * 128 + comp * 64 + ds * 16 + hh * 8);
        f32x16 oacc[4];
#pragma unroll
        for (int i = 0; i < 4; ++i)
#pragma unroll
            for (int q = 0; q < 16; ++q) oacc[i][q] = 0.f;
        float m_run = 0.f, l_run = 0.f;
        v4u pre[4];
#define AT_LOADG(kt) do { _Pragma("unroll") for (int q = 0; q < 2; ++q) { const int idx = tid + NTHR * q; \
            pre[q] = *(const v4u*)(Kg + (size_t)((kt) * 64 + (idx >> 4)) * 512 + (idx & 15) * 8); \
            pre[2 + q] = *(const v4u*)(Vg + (size_t)((kt) * 64 + (idx >> 4)) * 512 + (idx & 15) * 8); } } while (0)
#define AT_STORES(kn) do { _Pragma("unroll") for (int q = 0; q < 2; ++q) { const int idx = tid + NTHR * q; \
            *(LAS v4u*)(lds + ((kn) & 1) * AT_KB + (idx >> 4) * AT_KP + (idx & 15) * 16) = pre[q]; \
            *(LAS v4u*)(lds + AT_V0 + ((kn) % 3) * AT_VB + (idx >> 4) * AT_VP + (idx & 15) * 16) = pre[2 + q]; } } while (0)
#define AT_PV(PF, VT_) do { const LAS unsigned char* Vt_ = (VT_); _Pragma("unroll") for (int kb = 0; kb < 2; ++kb) _Pragma("unroll") for (int s = 0; s < 2; ++s) _Pragma("unroll") for (int dvb = 0; dvb < 4; ++dvb) { \
            const LAS unsigned char* vp = Vt_ + (32 * kb + 16 * s + 4 * hh + tq) * AT_VP + (32 * dvb + 16 * blk + 4 * tp) * 2; const u32x2 lo = tr16(vp), hi = tr16(vp + 8 * AT_VP); \
            u32x4 vw; vw.x = lo.x; vw.y = lo.y; vw.z = hi.x; vw.w = hi.y; oacc[dvb] = __builtin_amdgcn_mfma_f32_32x32x16_bf16(__builtin_bit_cast(bf16x8, vw), PF[kb][s], oacc[dvb], 0, 0, 0); } } while (0)
        bf16x8 phold[2][2];
        __syncthreads();
        AT_LOADG(0); AT_STORES(0);
        __syncthreads();
#pragma unroll 1
        for (int kt = 0; kt < 36; ++kt) {
            if (kt < 35) AT_LOADG(kt + 1);
            const LAS unsigned char* Kt = lds + (kt & 1) * AT_KB;
            if (comp == 1 && kt > 0) { AT_PV(phold, lds + AT_V0 + ((kt - 1) % 3) * AT_VB); }
            f32x16 sacc[2];
#pragma unroll
            for (int kb = 0; kb < 2; ++kb)
#pragma unroll
                for (int q = 0; q < 16; ++q) sacc[kb][q] = -m_run;
#pragma unroll
            for (int ds = 0; ds < 4; ++ds)
#pragma unroll
                for (int kb = 0; kb < 2; ++kb) { const bf16x8 kf = *(const LAS bf16x8*)(Kt + (32 * kb + r) * AT_KP + comp * 128 + ds * 32 + hh * 16);
                    sacc[kb] = __builtin_amdgcn_mfma_f32_32x32x16_bf16(kf, qf[ds], sacc[kb], 0, 0, 0); }
            float mx = sacc[0][0];
#pragma unroll
            for (int kb = 0; kb < 2; ++kb)
#pragma unroll
                for (int q = 0; q < 16; ++q) mx = fmaxf(mx, sacc[kb][q]);
            mx = fmaxf(mx, shx(mx, 32));
            if (kt == 0 || __builtin_amdgcn_ballot_w64(mx > 0.f) != 0ull) {
                const float dm = kt == 0 ? mx : fmaxf(mx, 0.f), alpha = __builtin_amdgcn_exp2f(-dm); m_run += dm; l_run *= alpha;
#pragma unroll
                for (int kb = 0; kb < 2; ++kb) sacc[kb] = sacc[kb] - dm;
#pragma unroll
                for (int i = 0; i < 4; ++i) oacc[i] = oacc[i] * alpha; }
            f32x2 ps2 = (f32x2){0.f, 0.f};
#pragma unroll
            for (int kb = 0; kb < 2; ++kb)
#pragma unroll
                for (int q = 0; q < 8; ++q) { f32x2 e; e.x = __builtin_amdgcn_exp2f(sacc[kb][2 * q]); e.y = __builtin_amdgcn_exp2f(sacc[kb][2 * q + 1]); sacc[kb][2 * q] = e.x; sacc[kb][2 * q + 1] = e.y; ps2 += e; }
            l_run += ps2.x + ps2.y;
#pragma unroll
            for (int kb = 0; kb < 2; ++kb)
#pragma unroll
                for (int s = 0; s < 2; ++s) {
                    u32x4 pw; pw.x = cvt_pk_bf16(sacc[kb][8 * s + 0], sacc[kb][8 * s + 1]); pw.y = cvt_pk_bf16(sacc[kb][8 * s + 2], sacc[kb][8 * s + 3]);
                    pw.z = cvt_pk_bf16(sacc[kb][8 * s + 4], sacc[kb][8 * s + 5]); pw.w = cvt_pk_bf16(sacc[kb][8 * s + 6], sacc[kb][8 * s + 7]);
                    phold[kb][s] = __builtin_bit_cast(bf16x8, pw); }
            if (comp == 0) { AT_PV(phold, lds + AT_V0 + (kt % 3) * AT_VB); }
            if (kt < 35) AT_STORES(kt + 1);
            __syncthreads();
        }
        if (comp == 1) { AT_PV(phold, lds + AT_V0 + (35 % 3) * AT_VB); }
        __syncthreads();
#undef AT_LOADG
#undef AT_STORES
#undef AT_PV
        const float lsum = l_run + shx(l_run, 32), inv = __builtin_amdgcn_rcpf(lsum);
        LAS float* X = (LAS float*)lds;
        if (comp == 1) {
#pragma unroll
            for (int dvb = 0; dvb < 4; ++dvb)
#pragma unroll
                for (int q = 0; q < 16; ++q) X[(qw * 64 + dvb * 16 + q) * 64 + lane] = oacc[dvb][q] * inv; }
        __syncthreads();
        if (comp == 0) {
            float ss = 0.f;
#pragma unroll
            for (int dvb = 0; dvb < 4; ++dvb)
#pragma unroll
                for (int q = 0; q < 16; ++q) { const float o = oacc[dvb][q] * inv - lam * X[(qw * 64 + dvb * 16 + q) * 64 + lane]; oacc[dvb][q] = o; ss += o * o; }
            ss += shx(ss, 32);
            const float rn = rsqrtf(ss * (1.f / 128.f) + RMS_EPS) * 0.8f;
            const float* ga = p.in[I_HGA] + h * 128; bf16* orow = MIXIN + ((size_t)b * SEQ + q0 + r) * D + h * 128;
#pragma unroll
            for (int dvb = 0; dvb < 4; ++dvb)
#pragma unroll
                for (int g = 0; g < 4; ++g) { const int dv = 32 * dvb + 8 * g + 4 * hh; const f32x4 gg = *(const f32x4*)(ga + dv);
                    v2u w; w.x = pk2(oacc[dvb][4 * g + 0] * rn * gg[0], oacc[dvb][4 * g + 1] * rn * gg[1]); w.y = pk2(oacc[dvb][4 * g + 2] * rn * gg[2], oacc[dvb][4 * g + 3] * rn * gg[3]);
                    *(v2u*)(orow + dv) = w; }
        }
    }
    __syncthreads();
}

constexpr int ML_P = 272, ML_TILE = 64 * ML_P;
constexpr int ML_VOFF = 3 * ML_TILE, ML_VSZ = 64 * 256;
constexpr int ML_RQ = ML_VOFF + 2 * ML_VSZ, ML_RSZ = 68 * 256, ML_RK = ML_RQ + ML_RSZ;
constexpr int ML_NOFF = ML_RK + ML_RSZ, ML_AOFF = ML_NOFF + 2 * 512;
constexpr int ML_CW = ML_AOFF + 8 * 256;
static_assert(ML_CW + 8 * 512 <= LDS_TAB, "mLSTM LDS map");
__device__ __forceinline__ float logsigmoidf_(float x) { return x >= 0.f ? -__logf(1.f + __expf(-x)) : x - __logf(1.f + __expf(x)); }
__device__ __forceinline__ bf16x8 pack8(const f32x16& v, int s) { u32x4 w; w.x = cvt_pk_bf16(v[8 * s + 0], v[8 * s + 1]); w.y = cvt_pk_bf16(v[8 * s + 2], v[8 * s + 3]); w.z = cvt_pk_bf16(v[8 * s + 4], v[8 * s + 5]); w.w = cvt_pk_bf16(v[8 * s + 6], v[8 * s + 7]); return __builtin_bit_cast(bf16x8, w); }
__device__ __forceinline__ void ph_mlstm(const Params& p, unsigned char* big, LAS unsigned char* lds, int tid, int lane, int wave) {
    const int bid = blockIdx.x; if (bid >= 256) return;
    const int b = bid >> 3, h = (bid >> 1) & 3, dir = bid & 1;
    const bf16* BQ = (const bf16*)(big + A0_BQ) + (size_t)b * SEQ * 512 + h * 128;
    const bf16* BK = (const bf16*)(big + A0_BK) + (size_t)b * (SEQ + LC) * 512 + h * 128;
    const bf16* BV = (const bf16*)(big + A0_BV) + (size_t)b * (SEQ + LC) * 512 + h * 128;
    bf16* HB = (bf16*)(big + A0_HB) + (size_t)dir * T * 512 + (size_t)b * SEQ * 512 + h * 128;
    const float* GT = (const float*)(p.ws + WS_GATES);
    const float* cw = p.in[I_CONVABW]; const float* cb = p.in[I_CONVABB];
    const int eb = wave & 3, tb = wave >> 2, r = lane & 31, hh = lane >> 5;
    const int blk = (lane >> 4) & 1, tq = (lane & 15) >> 2, tp = lane & 3;
    LAS float* nbuf = (LAS float*)(lds + ML_NOFF); LAS float* aw = (LAS float*)(lds + ML_AOFF) + wave * 64;
    if (tid < 256) nbuf[tid] = 0.f;
    LAS float* cwl = (LAS float*)(lds + ML_CW);
    for (int i = tid; i < 1024; i += NTHR) { const int ten = i >> 9, j = (i >> 7) & 3, d = i & 127, ch = ten * 512 + h * 128 + d; cwl[i] = j < 3 ? cw[j * 1024 + ch] : cb[ch]; }
    f32x16 cacc[4];
#pragma unroll
    for (int i = 0; i < 4; ++i)
#pragma unroll
        for (int q = 0; q < 16; ++q) cacc[i][q] = 0.f;
    float m_state = 0.f;
#ifdef ML_PROBE
    unsigned long long accs[7] = {0, 0, 0, 0, 0, 0, 0}; unsigned long long tp0 = __builtin_amdgcn_s_memrealtime();
#define ML_T(i) do { const unsigned long long t1_ = __builtin_amdgcn_s_memrealtime(); accs[i] += t1_ - tp0; tp0 = t1_; } while (0)
#else
#define ML_T(i)
#endif
    float a_c = 0.f, M_c = 0.f, b_c = 0.f, decay_c = 1.f, m_after = 0.f;
    float a_n = 0.f, M_n = 0.f, b_n = 0.f, w_n = 0.f, decay_n = 1.f, m_next = 0.f;
#define ML_POS(cc, t) ((cc) < 4 ? (dir ? 255 - ((cc) * 64 + (t)) : (cc) * 64 + (t)) : (dir ? 2047 - (((cc) - 4) * 64 + (t)) : ((cc) - 4) * 64 + (t)))
#define ML_GLOAD(cc, li_, fp_) do { const int pos_ = ML_POS(cc, lane); const size_t grow_ = (cc) < 4 ? (size_t)T + b * LC + pos_ : (size_t)b * SEQ + pos_; \
        li_ = GT[grow_ * 16 + dir * 8 + h]; fp_ = GT[grow_ * 16 + dir * 8 + 4 + h]; } while (0)
#define ML_SCAN(li_, fp_, m_in) do { const float lf_ = logsigmoidf_(fp_); \
        float bs_ = lf_; _Pragma("unroll") for (int o_ = 1; o_ < 64; o_ <<= 1) { const float v_ = shup(bs_, o_); if (lane >= o_) bs_ += v_; } \
        const float aa_ = (li_) - bs_; float pm_ = aa_; _Pragma("unroll") for (int o_ = 1; o_ < 64; o_ <<= 1) { const float v_ = shup(pm_, o_); if (lane >= o_) pm_ = fmaxf(pm_, v_); } \
        const float MM_ = fmaxf(m_in, pm_); const float M63_ = shidx(MM_, 63), b63_ = shidx(bs_, 63); \
        a_n = aa_; M_n = MM_; b_n = bs_; w_n = __expf(aa_ - M63_); decay_n = __expf((m_in) - M63_); m_next = b63_ + M63_; } while (0)
#define ML_DMA(cc, vbuf) do { const int lim_ = (cc) < 4 ? LC : SEQ, kvb_ = (cc) < 4 ? 0 : LC; \
        _Pragma("unroll 1") for (int ins_ = wave; ins_ < 17; ins_ += NWAVES) { const int rr_ = ins_ * 4 + (lane >> 4), pc_ = lane & 15; int pos_ = ML_POS(cc, rr_ - 1); pos_ = pos_ < 0 ? 0 : (pos_ >= lim_ ? lim_ - 1 : pos_); \
            __builtin_amdgcn_global_load_lds((const unsigned*)(BK + (size_t)(kvb_ + pos_) * 512 + pc_ * 8), (LAS unsigned*)(lds + ML_RK + ins_ * 1024), 16, 0, 0); \
            if ((cc) >= 4) __builtin_amdgcn_global_load_lds((const unsigned*)(BQ + (size_t)pos_ * 512 + pc_ * 8), (LAS unsigned*)(lds + ML_RQ + ins_ * 1024), 16, 0, 0); } \
        _Pragma("unroll") for (int q_ = 0; q_ < 2; ++q_) { const int ins_ = wave * 2 + q_, t_ = ins_ * 4 + (lane >> 4), pc_ = lane & 15; const int pos_ = ML_POS(cc, t_); \
            __builtin_amdgcn_global_load_lds((const unsigned*)(BV + (size_t)(kvb_ + pos_) * 512 + pc_ * 8), (LAS unsigned*)(lds + ML_VOFF + (vbuf) * ML_VSZ + ins_ * 1024), 16, 0, 0); } } while (0)
#define ML_CONV8(dst, rawoff, cc, t_, d8_, ten, scl) do { const int pos_ = ML_POS(cc, t_), lim_ = (cc) < 4 ? LC : SEQ; const int rm_ = dir ? (t_) + 2 : (t_), rp_ = dir ? (t_) : (t_) + 2; \
        v4u x_[3]; x_[0] = *(const LAS v4u*)(lds + (rawoff) + rm_ * 256 + (d8_) * 16); x_[1] = *(const LAS v4u*)(lds + (rawoff) + ((t_) + 1) * 256 + (d8_) * 16); x_[2] = *(const LAS v4u*)(lds + (rawoff) + rp_ * 256 + (d8_) * 16); \
        if (pos_ - 1 < 0) x_[0] = (v4u){0u, 0u, 0u, 0u}; if (pos_ + 1 >= lim_) x_[2] = (v4u){0u, 0u, 0u, 0u}; \
        const LAS float* wl_ = cwl + (ten) * 512 + (d8_) * 8; f32x4 wv_[4][2]; \
        _Pragma("unroll") for (int j_ = 0; j_ < 4; ++j_) { wv_[j_][0] = *(const LAS f32x4*)(wl_ + j_ * 128); wv_[j_][1] = *(const LAS f32x4*)(wl_ + j_ * 128 + 4); } \
        _Pragma("unroll") for (int e_ = 0; e_ < 8; ++e_) { float s_ = wv_[3][e_ >> 2][e_ & 3]; \
            _Pragma("unroll") for (int j_ = 0; j_ < 3; ++j_) { const unsigned w_ = e_ < 2 ? x_[j_].x : e_ < 4 ? x_[j_].y : e_ < 6 ? x_[j_].z : x_[j_].w; s_ += wv_[j_][e_ >> 2][e_ & 3] * ((e_ & 1) ? bf_hi(w_) : bf_lo(w_)); } \
            dst[e_] = s_ * __builtin_amdgcn_rcpf(1.f + __expf(-s_)) * (scl); } } while (0)
#define ML_BUILD(cc) do { _Pragma("unroll 1") for (int q_ = 0; q_ < 2; ++q_) { const int idx_ = tid + NTHR * q_, t_ = idx_ >> 4, d8_ = idx_ & 15; \
        float kk_[8]; ML_CONV8(kk_, ML_RK, cc, t_, d8_, 1, 1.f); const float wt_ = shidx(w_n, t_); \
        v4u o_; o_.x = pk2(kk_[0], kk_[1]); o_.y = pk2(kk_[2], kk_[3]); o_.z = pk2(kk_[4], kk_[5]); o_.w = pk2(kk_[6], kk_[7]); *(LAS v4u*)(lds + ML_TILE + t_ * ML_P + d8_ * 16) = o_; \
        o_.x = pk2(kk_[0] * wt_, kk_[1] * wt_); o_.y = pk2(kk_[2] * wt_, kk_[3] * wt_); o_.z = pk2(kk_[4] * wt_, kk_[5] * wt_); o_.w = pk2(kk_[6] * wt_, kk_[7] * wt_); *(LAS v4u*)(lds + 2 * ML_TILE + t_ * ML_P + d8_ * 16) = o_; \
        if ((cc) >= 4) { float qq_[8]; ML_CONV8(qq_, ML_RQ, cc, t_, d8_, 0, 0.08838834764831845f); \
            o_.x = pk2(qq_[0], qq_[1]); o_.y = pk2(qq_[2], qq_[3]); o_.z = pk2(qq_[4], qq_[5]); o_.w = pk2(qq_[6], qq_[7]); *(LAS v4u*)(lds + t_ * ML_P + d8_ * 16) = o_; } } } while (0)
    __syncthreads();
    { float li0, fp0; ML_GLOAD(0, li0, fp0); ML_DMA(0, 0); ML_SCAN(li0, fp0, m_state); }
    asm volatile("s_waitcnt vmcnt(0)" ::: "memory");
    __syncthreads();
    ML_BUILD(0);
    a_c = a_n; M_c = M_n; b_c = b_n; decay_c = decay_n; m_after = m_next;
    __syncthreads();
#pragma unroll 1
    for (int cc = 0; cc < 36; ++cc) {
        const LAS unsigned char* Qs = lds; const LAS unsigned char* Ks = lds + ML_TILE; const LAS unsigned char* Kw = lds + 2 * ML_TILE; const LAS unsigned char* Vs = lds + ML_VOFF + (cc & 1) * ML_VSZ;
        const LAS float* ncur = nbuf + (cc & 1) * 128; LAS float* nnew = nbuf + ((cc + 1) & 1) * 128;
        float li1 = 0.f, fp1 = 0.f;
        ML_T(5);
        if (cc < 35) { ML_GLOAD(cc + 1, li1, fp1); ML_DMA(cc + 1, (cc + 1) & 1); }
        ML_T(0);
        if (cc >= 4) {
            aw[lane] = a_c;
            const int tcol = 32 * tb + r; const float Mt = shidx(M_c, tcol), bt = shidx(b_c, tcol);
            f32x16 nacc;
#pragma unroll
            for (int q = 0; q < 16; ++q) nacc[q] = 0.f;
#pragma unroll
            for (int db = 0; db < 4; ++db)
#pragma unroll
                for (int s2 = 0; s2 < 2; ++s2) { const LAS unsigned char* qp = Qs + tcol * ML_P + (32 * db + 16 * s2 + 4 * hh) * 2; const u32x2 lo = *(const LAS u32x2*)qp, hi = *(const LAS u32x2*)(qp + 16);
                    u32x4 qw; qw.x = lo.x; qw.y = lo.y; qw.z = hi.x; qw.w = hi.y;
                    nacc = __builtin_amdgcn_mfma_f32_32x32x16_bf16(pack8(cacc[db], s2), __builtin_bit_cast(bf16x8, qw), nacc, 0, 0, 0); }
            const float sc = __expf(m_state - Mt);
            nacc = nacc * sc;
            float rs = 0.f;
#pragma unroll
            for (int sb = 0; sb < 2; ++sb) if (sb <= tb) {
                f32x16 sacc;
#pragma unroll
                for (int q = 0; q < 16; ++q) sacc[q] = 0.f;
#pragma unroll
                for (int ds = 0; ds < 8; ++ds) { const bf16x8 kf = *(const LAS bf16x8*)(Ks + (32 * sb + r) * ML_P + (16 * ds + 8 * hh) * 2), qf = *(const LAS bf16x8*)(Qs + tcol * ML_P + (16 * ds + 8 * hh) * 2);
                    sacc = __builtin_amdgcn_mfma_f32_32x32x16_bf16(kf, qf, sacc, 0, 0, 0); }
#pragma unroll
                for (int g = 0; g < 4; ++g) { const int s0 = 32 * sb + 8 * g + 4 * hh; const f32x4 av = *(const LAS f32x4*)(aw + s0);
#pragma unroll
                    for (int j = 0; j < 4; ++j) { const bool keep = (s0 + j) <= tcol; const float v = keep ? sacc[4 * g + j] * __expf(av[j] - Mt) : 0.f; sacc[4 * g + j] = v; rs += v; } }
#pragma unroll
                for (int s2 = 0; s2 < 2; ++s2) { u32x4 vw;
                    { const u32x2 t0 = tr16(Vs + (32 * sb + 16 * s2 + 4 * hh + tq) * 256 + (32 * eb + 16 * blk + 4 * tp) * 2), t1 = tr16(Vs + (32 * sb + 16 * s2 + 8 + 4 * hh + tq) * 256 + (32 * eb + 16 * blk + 4 * tp) * 2);
                      vw.x = t0.x; vw.y = t0.y; vw.z = t1.x; vw.w = t1.y; }
                    nacc = __builtin_amdgcn_mfma_f32_32x32x16_bf16(__builtin_bit_cast(bf16x8, vw), pack8(sacc, s2), nacc, 0, 0, 0); } }
            rs += shx(rs, 32);
            float qn = 0.f;
            { const LAS unsigned char* qp = Qs + tcol * ML_P + (64 * hh) * 2;
#pragma unroll
              for (int c8 = 0; c8 < 8; ++c8) { const v4u w = *(const LAS v4u*)(qp + c8 * 16); const f32x4 n0 = *(const LAS f32x4*)(ncur + 64 * hh + 8 * c8), n1 = *(const LAS f32x4*)(ncur + 64 * hh + 8 * c8 + 4);
                  qn += bf_lo(w.x) * n0[0] + bf_hi(w.x) * n0[1] + bf_lo(w.y) * n0[2] + bf_hi(w.y) * n0[3] + bf_lo(w.z) * n1[0] + bf_hi(w.z) * n1[1] + bf_lo(w.w) * n1[2] + bf_hi(w.w) * n1[3]; } }
            qn += shx(qn, 32);
            const float den = sc * qn + rs; const float dd = __frcp_rn(fmaxf(fabsf(den), __expf(-(bt + Mt))));
            { const int pos = ML_POS(cc, tcol); bf16* hrow = HB + (size_t)pos * 512 + 32 * eb;
#pragma unroll
              for (int g = 0; g < 4; ++g) { v2u w; w.x = pk2(nacc[4 * g + 0] * dd, nacc[4 * g + 1] * dd); w.y = pk2(nacc[4 * g + 2] * dd, nacc[4 * g + 3] * dd); *(v2u*)(hrow + 8 * g + 4 * hh) = w; } }
        }
        ML_T(1);
#pragma unroll
        for (int db = 0; db < 4; ++db) { cacc[db] = cacc[db] * decay_c;
#pragma unroll
            for (int s4 = 0; s4 < 4; ++s4) { u32x4 ka, vb;
                { const u32x2 t0 = tr16(Kw + (16 * s4 + 8 * hh + tq) * ML_P + (32 * db + 16 * blk + 4 * tp) * 2), t1 = tr16(Kw + (16 * s4 + 8 * hh + 4 + tq) * ML_P + (32 * db + 16 * blk + 4 * tp) * 2);
                  ka.x = t0.x; ka.y = t0.y; ka.z = t1.x; ka.w = t1.y; }
                { const u32x2 t0 = tr16(Vs + (16 * s4 + 8 * hh + tq) * 256 + (32 * eb + 16 * blk + 4 * tp) * 2), t1 = tr16(Vs + (16 * s4 + 8 * hh + 4 + tq) * 256 + (32 * eb + 16 * blk + 4 * tp) * 2);
                  vb.x = t0.x; vb.y = t0.y; vb.z = t1.x; vb.w = t1.y; }
                cacc[db] = __builtin_amdgcn_mfma_f32_32x32x16_bf16(__builtin_bit_cast(bf16x8, ka), __builtin_bit_cast(bf16x8, vb), cacc[db], 0, 0, 0); } }
        { const int d = tid >> 2, part = tid & 3; float s = 0.f;
#pragma unroll
            for (int t = 0; t < 16; ++t) s += bf1(*(const LAS bf16*)(Kw + (part * 16 + t) * ML_P + d * 2));
            s += shx(s, 1); s += shx(s, 2);
            if (part == 0) nnew[d] = decay_c * ncur[d] + s; }
        m_state = m_after;
        ML_T(2);
        asm volatile("s_waitcnt vmcnt(0)" ::: "memory");
        __syncthreads();
        ML_T(3);
        if (cc < 35) { ML_SCAN(li1, fp1, m_state); ML_T(6); ML_BUILD(cc + 1); a_c = a_n; M_c = M_n; b_c = b_n; decay_c = decay_n; m_after = m_next; }
        ML_T(4);
        __syncthreads();
    }
#ifdef ML_PROBE
    if (blockIdx.x == 0 && tid == 256) { unsigned long long* ts = (unsigned long long*)(p.ws + WS_CTL + 32768); ts[50] = 0; unsigned long long c_ = 0; for (int i = 0; i < 7; ++i) { c_ += accs[i]; ts[51 + i] = c_; } }
#endif
#undef ML_T
#undef ML_POS
#undef ML_GLOAD
#undef ML_SCAN
#undef ML_DMA
#undef ML_CONV8
#undef ML_BUILD
}
__device__ __forceinline__ void ph_outb(const Params& p, unsigned char* big, int lane, int wave, int tile) {
    const int gw = tile * NWAVES + wave;
    const bf16* HBf = (const bf16*)(big + A0_HB); const bf16* HBb = HBf + (size_t)T * 512; const bf16* BO = (const bf16*)(big + A0_BO); bf16* MIXIN = (bf16*)(big + A0_MIXIN);
    const float* gb = p.in[I_HGB];
    const f32x4 g0 = *(const f32x4*)(gb + lane * 8), g1 = *(const f32x4*)(gb + lane * 8 + 4);
#pragma unroll 2
    for (int m = gw * 32; m < gw * 32 + 32; ++m) {
        const v4u f = *(const v4u*)(HBf + (size_t)m * 512 + lane * 8), bw = *(const v4u*)(HBb + (size_t)m * 512 + lane * 8), go = *(const v4u*)(BO + (size_t)m * 512 + lane * 8);
        float x[8], o[8]; x[0] = bf_lo(f.x) + bf_lo(bw.x); x[1] = bf_hi(f.x) + bf_hi(bw.x); x[2] = bf_lo(f.y) + bf_lo(bw.y); x[3] = bf_hi(f.y) + bf_hi(bw.y);
        x[4] = bf_lo(f.z) + bf_lo(bw.z); x[5] = bf_hi(f.z) + bf_hi(bw.z); x[6] = bf_lo(f.w) + bf_lo(bw.w); x[7] = bf_hi(f.w) + bf_hi(bw.w);
        o[0] = bf_lo(go.x); o[1] = bf_hi(go.x); o[2] = bf_lo(go.y); o[3] = bf_hi(go.y); o[4] = bf_lo(go.z); o[5] = bf_hi(go.z); o[6] = bf_lo(go.w); o[7] = bf_hi(go.w);
        float ss = 0.f;
#pragma unroll
        for (int j = 0; j < 8; ++j) ss += x[j] * x[j];
        ss += shx(ss, 1); ss += shx(ss, 2); ss += shx(ss, 4); ss += shx(ss, 8);
        const float rn = rsqrtf(ss * (1.f / 128.f) + RMS_EPS);
        float y[8];
#pragma unroll
        for (int j = 0; j < 8; ++j) y[j] = x[j] * rn * (j < 4 ? g0[j] : g1[j - 4]) * sigmoidf_(o[j]);
        v4u w; w.x = pk2(y[0], y[1]); w.y = pk2(y[2], y[3]); w.z = pk2(y[4], y[5]); w.w = pk2(y[6], y[7]);
        *(v4u*)(MIXIN + (size_t)m * D + 512 + lane * 8) = w;
    }
}

constexpr int CW_DBG = 16;
#ifndef DBG_MODE
#define DBG_MODE 0
#endif
#ifndef DBG_L
#define DBG_L 0
#endif
#ifndef DBG_CH
#define DBG_CH 0
#endif
__device__ __forceinline__ void dbg_report(const Params& p, float d) {
    if (!(d >= 0.f)) d = 1.0e6f;
    atomicMax((unsigned*)(p.ws + WS_CTL) + CW_DBG, __float_as_uint(d));
}
__device__ __forceinline__ float block_max(float v, LAS float* red, int tid) { v = wave_max(v); __syncthreads(); if ((tid & 63) == 0) red[tid >> 6] = v; __syncthreads(); float r = red[0];
#pragma unroll
    for (int w = 1; w < 8; ++w) r = fmaxf(r, red[w]); __syncthreads(); return r; }
__device__ __forceinline__ float block_sum(float v, LAS float* red, int tid) { v = wave_sum(v); __syncthreads(); if ((tid & 63) == 0) red[tid >> 6] = v; __syncthreads(); float r = 0.f;
#pragma unroll
    for (int w = 0; w < 8; ++w) r += red[w]; __syncthreads(); return r; }
__device__ __forceinline__ void dbg_moe_check(const Params& p, int l, int ch, const bf16* H2, const bf16* Y, LAS unsigned char* lds, int tid) {
    LAS float* hrow = (LAS float*)lds; LAS float* gu = hrow + 1024; LAS float* a = gu + 512; LAS float* red = a + 256;
    const int t = ch * CHT + blockIdx.x * 64 + 5;
    __syncthreads();
    for (int i = tid; i < 1024; i += NTHR) hrow[i] = bf1(H2[(size_t)t * D + i]);
    __syncthreads();
    const int* EIDX = (const int*)(p.ws + WS_EIDX); const float* WTS = (const float*)(p.ws + WS_WTS); const int* PSLOT = (const int*)(p.ws + WS_PSLOT);
    float yacc[2] = {0.f, 0.f};
#pragma unroll 1
    for (int k = 0; k < 9; ++k) {
        const int e = k < 8 ? (EIDX[(size_t)t * 8 + k] & 255) : 64; const float w = k < 8 ? WTS[(size_t)t * 8 + k] : 1.f;
        const float* Wgu = e < 64 ? p.in[I_EGU] + (size_t)(l * 64 + e) * 1024 * 512 : p.in[I_SGU] + (size_t)l * 1024 * 512;
        const float* Wdn = e < 64 ? p.in[I_EDN] + (size_t)(l * 64 + e) * 256 * 1024 : p.in[I_SDN] + (size_t)l * 256 * 1024;
        float s = 0.f;
#pragma unroll 4
        for (int kk = 0; kk < 1024; ++kk) s += hrow[kk] * Wgu[(size_t)kk * 512 + tid];
        gu[tid] = s;
        __syncthreads();
        if (tid < 256) a[tid] = siluf_(gu[tid]) * gu[256 + tid];
        __syncthreads();
#pragma unroll
        for (int q = 0; q < 2; ++q) { const int n = tid + 512 * q; float s2 = 0.f;
#pragma unroll 4
            for (int j = 0; j < 256; ++j) s2 += a[j] * Wdn[(size_t)j * 1024 + n];
            yacc[q] += w * s2; }
        __syncthreads();
    }
    float err = 0.f, ss = 0.f;
#pragma unroll
    for (int q = 0; q < 2; ++q) { const int n = tid + 512 * q; float f = 0.f;
#pragma unroll 1
        for (int k = 0; k < 9; ++k) { const int slot = PSLOT[(size_t)t * 16 + k]; const float w = k < 8 ? WTS[(size_t)t * 8 + k] : 1.f; f += w * bf1(Y[(size_t)slot * D + n]); }
        err = fmaxf(err, fabsf(f - yacc[q])); ss += yacc[q] * yacc[q]; }
    const float me = block_max(err, red, tid), sq = block_sum(ss, red, tid);
    if (tid == 0) dbg_report(p, me / sqrtf(sq * (1.f / 1024.f) + 1e-30f));
}
__device__ __forceinline__ void dbg_route_check(const Params& p, int l, const bf16* H2, const float* LOG, LAS unsigned char* lds, int tid) {
    LAS float* hrow = (LAS float*)lds; LAS float* lg = hrow + 1024; LAS float* bi = lg + 64; LAS float* sc = bi + 64; LAS float* red = sc + 64;
    const int t = blockIdx.x * 256 + 77;
    __syncthreads();
    for (int i = tid; i < 1024; i += NTHR) hrow[i] = bf1(H2[(size_t)t * D + i]);
    __syncthreads();
    if (tid < 64) { float s = 0.f; const float* W = p.in[I_RW] + (size_t)l * 1024 * 64;
#pragma unroll 4
        for (int k = 0; k < 1024; ++k) s += hrow[k] * W[k * 64 + tid];
        lg[tid] = s; sc[tid] = 1.f / (1.f + expf(-s)); bi[tid] = sc[tid] + p.in[I_RB][l * 64 + tid]; }
    __syncthreads();
    if (tid == 0) {
        float lerr = 0.f;
#pragma unroll 1
        for (int e = 0; e < 64; ++e) lerr = fmaxf(lerr, fabsf(lg[e] - LOG[(size_t)t * 64 + e]));
        float grp[8];
#pragma unroll
        for (int g = 0; g < 8; ++g) { float a = -1e30f, b = -1e30f;
#pragma unroll 1
            for (int j = 0; j < 8; ++j) { const float v = bi[g * 8 + j]; if (v > a) { b = a; a = v; } else if (v > b) b = v; } grp[g] = a + b; }
        unsigned gm = 0;
#pragma unroll 1
        for (int r = 0; r < 4; ++r) { int best = -1; float bv = 0.f;
#pragma unroll
            for (int g = 0; g < 8; ++g) if (!((gm >> g) & 1u) && (best < 0 || grp[g] > bv)) { best = g; bv = grp[g]; }
            gm |= 1u << best; }
        unsigned long long set_ref = 0ull; float ssum = 0.f;
#pragma unroll 1
        for (int r = 0; r < 8; ++r) { int best = -1; float bv = 0.f;
#pragma unroll 1
            for (int e = 0; e < 64; ++e) if (((gm >> (e >> 3)) & 1u) && !((set_ref >> e) & 1ull) && (best < 0 || bi[e] > bv)) { best = e; bv = bi[e]; }
            set_ref |= 1ull << best; ssum += sc[best]; }
        const int* EIDX = (const int*)(p.ws + WS_EIDX); const float* WTS = (const float*)(p.ws + WS_WTS);
        unsigned long long set_f = 0ull; float werr = 0.f, wsum = 0.f;
#pragma unroll 1
        for (int k = 0; k < 8; ++k) { const int e = EIDX[(size_t)t * 8 + k] & 255; set_f |= 1ull << e; const float wr = 2.5f * sc[e] / ssum; werr = fmaxf(werr, fabsf(wr - WTS[(size_t)t * 8 + k])); wsum += WTS[(size_t)t * 8 + k]; }
        float d = 0.f;
        if (DBG_MODE == 0) d = (set_f != set_ref) ? (1.f / 256.f) : 0.f;
        if (DBG_MODE == 1) d = (set_f != set_ref) ? 0.f : werr + fabsf(wsum - 2.5f);
        if (DBG_MODE == 2) d = lerr * (1.f / 256.f);
        atomicAdd((float*)((unsigned*)(p.ws + WS_CTL) + CW_DBG), d);
    }
    __syncthreads();
}
__device__ __forceinline__ unsigned dbg_hash(unsigned x) { x ^= x >> 16; x *= 0x7feb352du; x ^= x >> 15; x *= 0x846ca68bu; x ^= x >> 16; return x; }
__device__ __forceinline__ void dbg_report_wave(const Params& p, float d, int lane) { if (lane == 0) dbg_report(p, d); }
__device__ __forceinline__ void dbg_hyena_check(const Params& p, int mode, const bf16* HN, const bf16* UC, const bf16* ZT, const bf16* Y2T, const bf16* MIX, LAS unsigned char* lds, int lane, int wave) {
    const unsigned hsh = dbg_hash(blockIdx.x * 8u + wave + 12345u), h2 = dbg_hash(hsh), h3 = dbg_hash(h2);
    const bf16* FILT = (const bf16*)(p.ws + WS_FILT);
    float d = 0.f;
    if (mode == 0) {
        const int c = hsh % 3072u, b = h2 % 32u, s = h3 % 2048u; float acc = 0.f;
#pragma unroll 1
        for (int k = lane; k < 1024; k += 64) acc += bf1(HN[(size_t)(b * 2048 + s) * D + k]) * p.in[I_WINHY][(size_t)k * 3072 + c];
        acc = wave_sum(acc);
        const float got = bf1(UC[(size_t)c * T + b * 2048 + s]); d = fabsf(got - acc) / (fabsf(acc) + 0.1f);
    } else if (mode == 5) {
        const int c = hsh % 3072u, b = h2 % 32u; int s = h3 % 2048u; if ((h3 >> 20) % 8u == 0u) s = 0; if ((h3 >> 20) % 8u == 1u) s = 2047;
        float val = p.in[I_CONVHYB][c];
#pragma unroll 1
        for (int j = 0; j < 3; ++j) { const int sj = s + j - 1; if (sj < 0 || sj > 2047) continue; val += p.in[I_CONVHYW][j * 3072 + c] * bf1(ZT[(size_t)c * T + b * 2048 + sj]); }
        const float got = bf1(UC[(size_t)c * T + b * 2048 + s]); d = fabsf(got - val) / (fabsf(val) + 0.1f);
    } else if (mode == 1) {
        LAS float* Z = (LAS float*)(lds + wave * 1024); LAS float* A1 = Z + 64; LAS float* A2 = A1 + 64;
        const int o = hsh & 1u, c = h2 % 1024u, j = h3 % 2048u;
        float z = 0.f; if (lane == 0) z = (float)j / 2047.f; else if (lane < 33) { const int k = (lane - 1) & 15; const float fr = 1e-4f + (float)k * ((15.f - 1e-4f) / 15.f); const float ang = (6.283185307179586f / 2048.f) * (float)j * fr; z = lane < 17 ? cosf(ang) : -sinf(ang); }
        Z[lane] = z; LDS_WAIT(); asm volatile("" ::: "memory");
        float a = p.in[I_FB1][lane];
#pragma unroll 1
        for (int k = 0; k < 33; ++k) a += Z[k] * p.in[I_FW1][k * 64 + lane];
        A1[lane] = sinf(a); LDS_WAIT(); asm volatile("" ::: "memory");
        a = p.in[I_FB2][lane];
#pragma unroll 1
        for (int k = 0; k < 64; ++k) a += A1[k] * p.in[I_FW2][k * 64 + lane];
        A2[lane] = sinf(a); LDS_WAIT(); asm volatile("" ::: "memory");
        float v = wave_sum(A2[lane] * p.in[I_FW3][lane * 2048 + o * 1024 + c]);
        const float mind = -4.605170185988091f / 1.5f, maxd = -4.605170185988091f / 0.3f; const float delta = fabsf(mind + (float)c * ((maxd - mind) / 1023.f));
        v *= expf(-fabsf((float)j - 1024.f) / 1024.f * delta);
        const float got = bf1(FILT[(size_t)(o * 1024 + c) * 2048 + j]); d = fabsf(got - v) / (fabsf(v) + 1e-4f);
    } else if (mode == 2 || mode == 3) {
        const int o = mode - 2, c = hsh % 1024u, b = h2 % 32u; int t = h3 % 2048u; if ((h3 >> 20) % 8u == 0u) t = 0; if ((h3 >> 20) % 8u == 1u) t = 2047;
        const bf16* in = (o == 0 ? UC : ZT) + (size_t)c * T + b * 2048; const bf16* f = FILT + (size_t)(o * 1024 + c) * 2048; float acc = 0.f;
#pragma unroll 1
        for (int s = lane; s < 2048; s += 64) { const int x = 1024 + t - s; if (x >= 0 && x <= 2047) acc += bf1(f[x]) * bf1(in[s]); }
        acc = wave_sum(acc);
        const float gate = bf1(UC[(size_t)((1 + o) * 1024 + c) * T + b * 2048 + t]);
        const float val = gate * (acc + bf1(in[t]) * p.in[I_FBIAS][o * 1024 + c]);
        const float got = bf1((o == 0 ? ZT : Y2T)[(size_t)c * T + b * 2048 + t]); d = fabsf(got - val) / (fabsf(val) + 0.1f);
    } else if (mode == 4) {
        const int tok = hsh % 65536u, n = h2 % 1024u; float acc = 0.f;
#pragma unroll 1
        for (int c = lane; c < 1024; c += 64) acc += bf1(Y2T[(size_t)c * T + tok]) * p.in[I_WOUTHY][(size_t)c * 1024 + n];
        acc = wave_sum(acc);
        const float got = bf1(MIX[(size_t)tok * D + n]); d = fabsf(got - acc) / (fabsf(acc) + 0.1f);
    }
    dbg_report_wave(p, d, lane);
}
__device__ __forceinline__ void dbg_inproj_check(const Params& p, unsigned char* big, int lane, int wave) {
    const unsigned hsh = dbg_hash(blockIdx.x * 8u + wave + 777u), h2 = dbg_hash(hsh);
    const bf16* H0 = (const bf16*)(big + A0_H); const float* W = p.in[I_WINAB];
    int m = hsh % (unsigned)TT; int n = h2 % 3600u;
    const bool ctx = m >= T; if (ctx && n < 1536) n += 1536;
    const int b = ctx ? (m - T) / LC : m / SEQ, s = ctx ? (m - T) % LC : m % SEQ;
    float x = 0.f, xp = 0.f; const bool rope_col = (n < 512) || (n >= 1536 && n < 2048); const int np = rope_col ? (n ^ 16) : n;
#pragma unroll 1
    for (int k = lane; k < 1024; k += 64) { const float hv = bf1(H0[(size_t)m * D + k]); x += hv * W[(size_t)k * 3600 + n]; xp += hv * W[(size_t)k * 3600 + np]; }
    x = wave_sum(x); xp = wave_sum(xp);
    float val = x, got = 0.f;
    if (n >= 3584) { val = x + p.in[I_GATEB][n - 3584]; got = ((const float*)(p.ws + WS_GATES))[(size_t)m * 16 + (n - 3584)]; }
    else { const int t = n / 512, cn = n % 512; int pc = cn;
        if (rope_col) { const int o = cn & 31; pc = (cn & ~31) + (((o & 15) >> 2) * 8 + (o >> 4) * 4 + (o & 3));
            if (!ctx) { const int d = cn & 63, axis = d >> 5, half = (d >> 4) & 1, i = d & 15; const float pos = (float)(axis == 0 ? (s >> 6) : (s & 63)); const float ang = pos * powf(10000.f, -(float)i / 16.f);
                val = half == 0 ? x * cosf(ang) - xp * sinf(ang) : x * cosf(ang) + xp * sinf(ang); } }
        if (t == 0) val *= QSCALE;
        const size_t offs[7] = {A0_QA, A0_BQ, A0_BO, A0_KA, A0_VA, A0_BK, A0_BV}; const bool kv = t >= 3;
        const bf16* O = (const bf16*)(big + offs[t]) + (size_t)b * (kv ? (SEQ + LC) : SEQ) * 512 + (size_t)((kv && !ctx) ? LC : 0) * 512;
        got = bf1(O[(size_t)s * 512 + pc]); }
    dbg_report_wave(p, fabsf(got - val) / (fabsf(val) + 0.1f), lane);
}
__device__ __forceinline__ void dbg_attn_check(const Params& p, unsigned char* big, LAS unsigned char* lds, int lane, int wave) {
    const unsigned hsh = dbg_hash(blockIdx.x * 8u + wave + 4242u), h2 = dbg_hash(hsh);
    const int b = hsh % 32u, h = (hsh >> 8) % 4u, q = h2 % 2048u;
    const bf16* QA = (const bf16*)(big + A0_QA) + ((size_t)b * SEQ + q) * 512 + h * 128; const bf16* KA = (const bf16*)(big + A0_KA) + (size_t)b * 2304 * 512 + h * 128;
    const bf16* VA = (const bf16*)(big + A0_VA) + (size_t)b * 2304 * 512 + h * 128; const bf16* MIXIN = (const bf16*)(big + A0_MIXIN) + ((size_t)b * SEQ + q) * D + h * 128;
    LAS float* Aw = (LAS float*)(lds + wave * 18432);
    const float* lv = p.in[I_DLAM]; const float lam = expf(wave_sum(lv[lane] * lv[64 + lane])) - expf(wave_sum(lv[128 + lane] * lv[192 + lane])) + 0.2f;
    float mx0 = -1e30f, mx1 = -1e30f;
#pragma unroll 1
    for (int key = lane; key < 2304; key += 64) { float s0 = 0.f, s1 = 0.f;
#pragma unroll 1
        for (int d = 0; d < 64; ++d) { s0 += bf1(QA[d]) * bf1(KA[(size_t)key * 512 + d]); s1 += bf1(QA[64 + d]) * bf1(KA[(size_t)key * 512 + 64 + d]); }
        Aw[key] = s0; Aw[2304 + key] = s1; mx0 = fmaxf(mx0, s0); mx1 = fmaxf(mx1, s1); }
    mx0 = wave_max(mx0); mx1 = wave_max(mx1);
    float l0 = 0.f, l1 = 0.f;
#pragma unroll 1
    for (int key = lane; key < 2304; key += 64) { const float e0 = exp2f(Aw[key] - mx0), e1 = exp2f(Aw[2304 + key] - mx1); Aw[key] = e0; Aw[2304 + key] = e1; l0 += e0; l1 += e1; }
    l0 = wave_sum(l0); l1 = wave_sum(l1);
    LDS_WAIT(); asm volatile("" ::: "memory");
    float o[2] = {0.f, 0.f};
#pragma unroll 1
    for (int key = 0; key < 2304; ++key) { const float a = Aw[key] / l0 - lam * Aw[2304 + key] / l1; o[0] += a * bf1(VA[(size_t)key * 512 + lane]); o[1] += a * bf1(VA[(size_t)key * 512 + 64 + lane]); }
    const float ms = wave_sum(o[0] * o[0] + o[1] * o[1]) * (1.f / 128.f); const float rn = rsqrtf(ms + RMS_EPS) * 0.8f;
    float err = 0.f, sc = 0.f;
#pragma unroll
    for (int j = 0; j < 2; ++j) { const float val = o[j] * rn * p.in[I_HGA][h * 128 + 64 * j + lane]; err = fmaxf(err, fabsf(val - bf1(MIXIN[64 * j + lane]))); sc += val * val; }
    err = wave_max(err); sc = sqrtf(wave_sum(sc) * (1.f / 128.f));
    dbg_report_wave(p, err / (sc + 1e-3f), lane);
}
__device__ __forceinline__ float dbg_convsilu(const bf16* base, int pos, int lim, int ch, int d, const float* cw, const float* cb) {
    float s = cb[ch];
#pragma unroll
    for (int j = 0; j < 3; ++j) { const int pj = pos + j - 1; if (pj >= 0 && pj < lim) s += cw[j * 1024 + ch] * bf1(base[(size_t)pj * 512 + d]); }
    return s / (1.f + expf(-s));
}
__device__ __forceinline__ void dbg_mlstm_check(const Params& p, unsigned char* big, LAS unsigned char* lds, int lane, int wave) {
    const unsigned hsh = dbg_hash(blockIdx.x * 8u + wave + 991u), h2 = dbg_hash(hsh);
    const int b = hsh % 32u, h = (hsh >> 8) % 4u, dir = (hsh >> 12) & 1; int tau = h2 % 2048u; if ((h2 >> 16) % 4u == 0u) tau = (h2 >> 20) % 130u;
    const bf16* BQ = (const bf16*)(big + A0_BQ) + (size_t)b * SEQ * 512 + h * 128; const bf16* BK = (const bf16*)(big + A0_BK) + (size_t)b * (SEQ + LC) * 512 + h * 128;
    const bf16* BV = (const bf16*)(big + A0_BV) + (size_t)b * (SEQ + LC) * 512 + h * 128;
    const float* GT = (const float*)(p.ws + WS_GATES); const float* cw = p.in[I_CONVABW]; const float* cb = p.in[I_CONVABB];
    LAS float* F = (LAS float*)(lds + wave * 18432); LAS float* qv = F + 2304 + 64;
    const int N = 256 + tau + 1;
#define DBG_POS(u) ((u) < 256 ? (dir ? 255 - (u) : (u)) : (dir ? 2047 - ((u) - 256) : (u) - 256))
#define DBG_GROW(u) ((u) < 256 ? (size_t)T + b * LC + DBG_POS(u) : (size_t)b * SEQ + DBG_POS(u))
    float carry = 0.f;
#pragma unroll 1
    for (int u0 = 0; u0 < N; u0 += 64) { const int u = u0 + lane; float lf = 0.f;
        if (u < N) { const float x = GT[DBG_GROW(u) * 16 + dir * 8 + 4 + h]; lf = x >= 0.f ? -__logf(1.f + __expf(-x)) : x - __logf(1.f + __expf(x)); }
        float s = lf;
#pragma unroll
        for (int o = 1; o < 64; o <<= 1) { const float v = shup(s, o); if (lane >= o) s += v; }
        if (u < N) F[u] = carry + s; carry += shidx(s, 63); }
    LDS_WAIT(); asm volatile("" ::: "memory");
    const float Ft = F[N - 1];
    float mm = Ft;
#pragma unroll 1
    for (int u = lane; u < N; u += 64) mm = fmaxf(mm, Ft - F[u] + GT[DBG_GROW(u) * 16 + dir * 8 + h]);
    mm = wave_max(mm);
    { const int pos = DBG_POS(N - 1);
      for (int d = lane; d < 128; d += 64) qv[d] = dbg_convsilu(BQ, pos, SEQ, h * 128 + d, d, cw, cb) * 0.08838834764831845f; }
    LDS_WAIT(); asm volatile("" ::: "memory");
    float den = 0.f;
#pragma unroll 1
    for (int u = lane; u < N; u += 64) { const bool ctx = u < 256; const int pos = DBG_POS(u); const bf16* kb = ctx ? BK : BK + (size_t)LC * 512; float qk = 0.f;
#pragma unroll 1
        for (int d = 0; d < 128; ++d) qk += qv[d] * dbg_convsilu(kb, pos, ctx ? LC : SEQ, 512 + h * 128 + d, d, cw, cb);
        const float om = qk * expf(Ft - F[u] + GT[DBG_GROW(u) * 16 + dir * 8 + h] - mm); F[u] = om; den += om; }
    den = wave_sum(den);
    LDS_WAIT(); asm volatile("" ::: "memory");
    float num[2] = {0.f, 0.f};
#pragma unroll 1
    for (int u = 0; u < N; ++u) { const bool ctx = u < 256; const int pos = DBG_POS(u); const bf16* vb = BV + (size_t)((ctx ? 0 : LC) + pos) * 512; num[0] += F[u] * bf1(vb[lane]); num[1] += F[u] * bf1(vb[64 + lane]); }
    const float dd = 1.f / fmaxf(fabsf(den), expf(-mm));
    const bf16* HB = (const bf16*)(big + A0_HB) + (size_t)dir * T * 512 + ((size_t)b * SEQ + DBG_POS(N - 1)) * 512 + h * 128;
    float err = 0.f, sc = 0.f;
#pragma unroll
    for (int j = 0; j < 2; ++j) { const float val = num[j] * dd; err = fmaxf(err, fabsf(val - bf1(HB[64 * j + lane]))); sc += val * val; }
    err = wave_max(err); sc = sqrtf(wave_sum(sc) * (1.f / 128.f));
    dbg_report_wave(p, err / (sc + 1e-3f), lane);
#undef DBG_POS
#undef DBG_GROW
}

__global__ void __launch_bounds__(NTHR, 2) mk_fwd(Params p0) {
    extern __shared__ __attribute__((aligned(16))) unsigned char lds_raw[];
    LAS unsigned char* lds = (LAS unsigned char*)lds_raw;
    const int wave0 = __builtin_amdgcn_readfirstlane((int)threadIdx.x >> 6);
    if (threadIdx.x < 64) ((LAS unsigned*)(lds + LDS_MISC))[threadIdx.x] = 0u;
    __syncthreads();
    XcdBarrier bar = xcd_barrier_post((unsigned*)(p0.ws + WS_CTL) + CW_BAR, (volatile LAS unsigned*)(lds + LDS_MISC + 32));
    const int G = gridDim.x, cb = blockIdx.x;
    const int vcu = (G % 8 == 0) ? (cb % 8) * (G / 8) + cb / 8 : cb;
#ifdef TIMEK
    int phc = 0; if (blockIdx.x == 0 && threadIdx.x == 0) ((unsigned long long*)(p0.ws + WS_CTL + 32768))[0] = __builtin_amdgcn_s_memrealtime();
#endif
#ifdef DBL_PH
#define DBL_LOOP for (int rep_ = 0; rep_ < 1; ++rep_)
#define DBL_SYNC __syncthreads();
#else
#define DBL_LOOP
#define DBL_SYNC
#endif
#ifdef TIMEK
#define TS_REC { ++phc; if (blockIdx.x == 0 && wave0 == 0 && lane_opq() == 0) ((unsigned long long*)(p0.ws + WS_CTL + 32768))[phc] = __builtin_amdgcn_s_memrealtime(); }
#else
#define TS_REC
#endif
#define LAYER_PTRS bf16* H2 = (bf16*)(big + (l == 0 ? 0 : 128 * MiB)); float* LOG = nullptr; bf16* ACT = (bf16*)(big + (l == 0 ? 144 * MiB : 272 * MiB)); \
        bf16* Y = (bf16*)(big + (l == 0 ? 304 * MiB : 432 * MiB)); bf16* HN = (bf16*)(big + 640 * MiB); const bf16* MIX = (const bf16*)(big + (l == 0 ? A0_MIX : 0)); \
        bf16* UT = (bf16*)big; bf16* UC = (bf16*)(big + 384 * MiB); bf16* ZT = (bf16*)(big + 384 * MiB); bf16* Y2T = (bf16*)(big + 512 * MiB); bf16* Y2 = (bf16*)(big + 640 * MiB); \
        (void)H2; (void)LOG; (void)ACT; (void)Y; (void)HN; (void)MIX; (void)UT; (void)UC; (void)ZT; (void)Y2T; (void)Y2;
#define RUN(...) do { { { int tid_ = wave0 * 64 + lane_opq(); asm volatile("" : "+v"(tid_)); const int tid = tid_, lane = tid & 63, wave = __builtin_amdgcn_readfirstlane(tid >> 6); (void)lane; (void)wave; \
        Params p = p0; { size_t z_ = 0; asm volatile("" : "+s"(z_)); p.ws = p0.ws + z_; p.out = p0.out + z_; _Pragma("unroll") for (int i_ = 0; i_ < 31; ++i_) p.in[i_] = p0.in[i_] + z_; } unsigned char* ws = p.ws; unsigned char* big = ws + WS_BIG; (void)big; LAYER_PTRS DBL_LOOP { __VA_ARGS__; DBL_SYNC } } { XcdBarrier b2_ = bar; { size_t z_ = 0; asm volatile("" : "+s"(z_)); b2_.bar = bar.bar + z_; unsigned x_ = bar.x; asm volatile("" : "+s"(x_)); b2_.x = x_; } xcd_barrier(b2_, wave0 == 0 && lane_opq() == 0); } TS_REC } } while (0)

#ifdef PRO_PROBE
#define PP(i) do { if (blockIdx.x == 0 && tid == 0) ((unsigned long long*)(p0.ws + WS_CTL + 32768))[50 + (i)] = __builtin_amdgcn_s_memrealtime(); } while (0)
#else
#define PP(i)
#endif
    { const int l = 0; RUN({ PP(0); pro_mod(p, lds, tid, lane, wave); __syncthreads(); PP(1); pro_filters(p, lds, tid, lane, wave); PP(2); pro_rope(p, tid); pro_transposes(p, lds, lane, wave); PP(3); }); }

    for (int l = 0; l < 2; ++l) {
        if (l == 0) {
            RUN({ ph_l0_norm(p, lane, wave); });
            RUN({ Gemm g{(const bf16*)(big + A0_H), (const bf16*)(ws + WS_WIN0), 1024, 2048u}; InprojSched S{G, vcu};
                  EpiInproj E{big, (const float*)(ws + WS_ROPE), (float*)(ws + WS_GATES), p.in[I_GATEB]};
                  gemm_phase<EpiInproj, InprojSched>(lds, g, S, E, tid); });
#ifdef DBG_INPROJ
            RUN({ dbg_inproj_check(p, big, lane, wave); });
#endif
            RUN({ ph_attn(p, big, lds, tid, lane, wave, vcu); });
#ifdef DBG_ATTN
            RUN({ dbg_attn_check(p, big, lds, lane, wave); });
#endif
            RUN({ ph_mlstm(p, big, lds, tid, lane, wave); });
#ifdef DBG_MLSTM
            RUN({ dbg_mlstm_check(p, big, lds, lane, wave); });
#endif
            RUN({ ph_outb(p, big, lane, wave, vcu); asm volatile("s_waitcnt vmcnt(0)" ::: "memory"); __syncthreads();
                  Gemm g{(const bf16*)(big + A0_MIXIN), (const bf16*)(ws + WS_WOUT0), 1024, 2048u}; PanelSched S{4, vcu}; EpiBf16 E{(bf16*)(big + A0_MIX), 1024, 3};
                  gemm_phase<EpiBf16, PanelSched>(lds, g, S, E, tid); });
        }
        if (l == 1) {
            RUN({ Gemm g{(const bf16*)(ws + WS_WIN1), HN, 1024, 2048u}; DenseSched S{256, 12 * 256, G, vcu, 12}; EpiBf16 E{UT, (size_t)T, 0xffff};
                  gemm_phase<EpiBf16, DenseSched>(lds, g, S, E, tid); });
#ifdef DBG_HY
            if (DBG_MODE == 0) { RUN({ dbg_hyena_check(p, 0, HN, UT, UT, UT, UT, lds, lane, wave); }); }
#endif
#ifdef DBG_HY
            if (DBG_MODE == 5) { RUN({ dbg_hyena_check(p, 5, HN, UC, UT, UT, UT, lds, lane, wave); }); }
#endif
            RUN({ ph_lconv<true>(p, 0, UT, UT, ZT, lds, tid, lane, wave); });
#ifdef DBG_HY
            if (DBG_MODE == 2) { RUN({ dbg_hyena_check(p, 2, HN, UC, ZT, Y2T, UT, lds, lane, wave); }); }
#endif
            RUN({ ph_lconv<false>(p, 1, ZT, UT, Y2T, lds, tid, lane, wave); });
#ifdef DBG_HY
            if (DBG_MODE == 3) { RUN({ dbg_hyena_check(p, 3, HN, UC, ZT, Y2T, UT, lds, lane, wave); }); }
#endif
            RUN({ ph_transpose(Y2T, Y2, lds, lane, wave, vcu); asm volatile("s_waitcnt vmcnt(0)" ::: "memory"); __syncthreads();
                  Gemm g{Y2, (const bf16*)(ws + WS_WOUT1), 1024, 2048u}; PanelSched S{4, vcu}; EpiBf16 E{(bf16*)big, 1024, 3};
                  gemm_phase<EpiBf16, PanelSched>(lds, g, S, E, tid); });
        }
#ifdef DBG_HY
        if (l == 1 && (DBG_MODE == 1 || DBG_MODE == 4)) { RUN({ dbg_hyena_check(p, DBG_MODE, HN, (const bf16*)(big + 384 * MiB), (const bf16*)big, (const bf16*)(big + 128 * MiB), (const bf16*)big, lds, lane, wave); }); }
#endif
        RUN({ ph_mid(p, l, MIX, H2, true, lane, wave, vcu); asm volatile("s_waitcnt vmcnt(0)" ::: "memory"); __syncthreads();
              Gemm g{H2, (const bf16*)(ws + WS_WR) + (size_t)l * 256 * 1024, 1024, 2048u}; DenseSched S{1, 256, G, vcu, 0}; EpiRouterLds E{};
              gemm_phase<EpiRouterLds, DenseSched>(lds, g, S, E, tid); __syncthreads(); ph_route_a(p, l, nullptr, vcu, lds, tid); });
#ifdef DBG_ROUTE
        RUN({ if (l == DBG_L) dbg_route_check(p, l, H2, LOG, lds, tid); ph_route_b(p, lds, tid); });
#else
        RUN({ ph_route_b(p, lds, tid); });
#endif
#define DO_G1(chx) do { const int NT = moe_tables(p, chx, lds, tid); \
            Gemm g{H2, (const bf16*)(ws + WS_GU) + (size_t)l * (65 * 512) * 1024, 1024, 2048u}; \
            MoeSched S{(const LAS int*)(lds + LDS_TAB), (const int*)(ws + WS_SORT) + (size_t)(chx) * CHROWS, NT * 2, G, vcu, 1, 2, nullptr}; EpiSwiglu E{ACT}; \
            gemm_phase<EpiSwiglu, MoeSched>(lds, g, S, E, tid); } while (0)
        RUN({ DO_G1(0); });
        for (int ch = 0; ch < NCH; ++ch) {
            RUN({ const int NT = moe_tables(p, ch, lds, tid);
                  Gemm g{ACT, (const bf16*)(ws + WS_DN) + (size_t)l * (65 * 1024) * 256, 256, 512u};
                  MoeSched S{(const LAS int*)(lds + LDS_TAB), nullptr, NT * 4, G, vcu, 2, 4, (l == 0 && ch == 0) ? (void*)(ws + WS_CTL + 32768) : nullptr}; EpiFp8 E{(unsigned char*)Y};
                  gemm_phase<EpiFp8, MoeSched>(lds, g, S, E, tid); });
            RUN({ const int par = (cb >> 3) & 1;
                  _Pragma("unroll 1") for (int part = 0; part < 2; ++part) { int t2_ = tid; asm volatile("" : "+v"(t2_)); const int tid = t2_, lane = tid & 63; (void)lane; if ((part ^ par) == 0) { if (ch + 1 < NCH) DO_G1(ch + 1); } else { ph_combine(p, l, ch, (const unsigned char*)Y, HN, lane, wave); } __syncthreads(); } });
        }
    }
#ifdef TIMEK
    if (blockIdx.x == 0) { const unsigned long long* ts = (const unsigned long long*)(p0.ws + WS_CTL + 32768); __syncthreads();
        const unsigned long long d = (__hip_atomic_load(ts + TIMEK, __ATOMIC_RELAXED, __HIP_MEMORY_SCOPE_AGENT) - __hip_atomic_load(ts + TIMEK0, __ATOMIC_RELAXED, __HIP_MEMORY_SCOPE_AGENT)) * 4ull, t0 = __builtin_amdgcn_s_memrealtime();
        while (__builtin_amdgcn_s_memrealtime() - t0 < d) __builtin_amdgcn_s_sleep(8); }
#endif
#ifdef DBG_ANY
    xcd_barrier(bar, threadIdx.x == 0);
    if (blockIdx.x == 0 && threadIdx.x == 0) p0.out[0] += 1.0e7f * __uint_as_float(((const unsigned*)(p0.ws + WS_CTL))[CW_DBG]);
#endif
#undef RUN
}
constexpr int NPHASES = 1 + 2 * (4 + 3 * NCH) + 6 + 64;
}

extern "C" void kernel_launch(void* const* d_in, const int* in_sizes, int n_in, void* d_out, int out_size, void* d_ws, size_t ws_size, hipStream_t stream) {
    using namespace mk;
    static int grid = 0;
    if (grid == 0) {
        if (n_in != 31 || out_size != T * D || ws_size < WS_END) { fprintf(stderr, "kernel_launch: unexpected shapes (n_in %d, out %d, ws %zu)\n", n_in, out_size, ws_size); grid = -1; return; }
        int dev = 0, cus = 0;
        if (hipGetDevice(&dev) != hipSuccess || hipDeviceGetAttribute(&cus, hipDeviceAttributeMultiprocessorCount, dev) != hipSuccess) { grid = -1; return; }
        if (hipFuncSetAttribute((const void*)mk_fwd, hipFuncAttributeMaxDynamicSharedMemorySize, LDS_BYTES) != hipSuccess) { fprintf(stderr, "kernel_launch: hipFuncSetAttribute failed\n"); grid = -1; return; }
        int per_cu = 0;
        if (hipOccupancyMaxActiveBlocksPerMultiprocessor(&per_cu, (const void*)mk_fwd, NTHR, LDS_BYTES) != hipSuccess || per_cu < 1) { fprintf(stderr, "kernel_launch: occupancy query says %d\n", per_cu); }
        (void)hipGetLastError();
        grid = cus;
        if (grid != 256) { fprintf(stderr, "kernel_launch: built for 256 CUs, found %d\n", grid); grid = -1; return; }
    }
    if (grid < 0) return;
    (void)hipMemsetAsync((char*)d_ws + WS_CTL, 0, CTL_ZERO_BYTES, stream);
    Params a{};
    for (int i = 0; i < 31; ++i) a.in[i] = (const float*)d_in[i];
    a.out = (float*)d_out; a.ws = (unsigned char*)d_ws; a.ph_lo = 0; a.ph_hi = NPHASES;
    hipLaunchKernelGGL(mk_fwd, dim3(grid), dim3(NTHR), LDS_BYTES, stream, a);
}
```

```cpp
#include <hip/hip_runtime.h>
#include <cstdio>
#include <cstdint>
namespace pg8 {
#define PG8_LAS __attribute__((address_space(3)))
typedef unsigned short bf16_t;
typedef short bf16x8 __attribute__((ext_vector_type(8)));
typedef float f32x4 __attribute__((ext_vector_type(4)));
typedef unsigned u32x4 __attribute__((ext_vector_type(4)));
typedef unsigned u32x2 __attribute__((ext_vector_type(2)));
typedef int i32x4 __attribute__((ext_vector_type(4)));
typedef int i32x8 __attribute__((ext_vector_type(8)));
constexpr int BM = 256, BK = 64, HALF = 128, HTB = HALF * BK * 2  , STAGE_BYTES = 8 * HTB;

__host__ __device__ __forceinline__ int lds_byte(int r, int c) { const int st = (r >> 4) * 2 + (c >> 5), rr = r & 15, cc = c & 31, ob = rr * 64 + cc * 2; return st * 1024 + (ob ^ (((ob >> 9) & 1) << 5)); }
__host__ __device__ __forceinline__ void stage_rc(int b, int& R, int& C) { const int st = b / 1024, sb = b % 1024, swz = sb ^ (((sb >> 9) & 1) << 5); R = (st >> 1) * 16 + swz / 64; C = (st & 1) * 32 + (swz % 64) / 2; }
__host__ __device__ __forceinline__ int perm32(int rho) { const int n = rho >> 4, i = rho & 15; return 8 * (i >> 2) + 4 * n + (i & 3); }

struct Unit { int pm, pn; };
__device__ __forceinline__ unsigned cvt_pk_bf16(float lo, float hi) { unsigned r; asm volatile("v_cvt_pk_bf16_f32 %0, %1, %2" : "=v"(r) : "v"(lo), "v"(hi)); return r; }
struct Gemm { const bf16_t* A; const bf16_t* Bt; int K; unsigned lda_bytes; };
template <class Epi, class Sched, bool ALIGN_EPI = true, bool F8 = false>
__device__ __forceinline__ void gemm_phase(PG8_LAS unsigned char* lds, const Gemm g, const Sched& S, const Epi& E, const int tid_in) {
    int tid_ = tid_in; asm volatile("" : "+v"(tid_));
    const int tid = tid_, wid = __builtin_amdgcn_readfirstlane(tid >> 6), lane = tid & 63, wr = wid >> 2, wc = wid & 3, fr = lane & 15, fq = lane >> 4;
    const int K = g.K, nt = K / BK;
    unsigned voffB[2];
#pragma unroll
    for (int i = 0; i < 2; ++i) { int R, C; stage_rc(tid * 16 + i * 8192, R, C); const int Rb = Epi::PERM ? ((R & ~31) + perm32(R & 31)) : R;
        voffB[i] = (unsigned)(Rb * K + C) * 2u; }
    const size_t kstep = (size_t)(BK * 2);
    const size_t hstep = (size_t)HALF * K * 2;
    const size_t tstep = 2 * hstep;
    const unsigned ldsw = (unsigned)wid * 1024u;
    const int aoff = lds_byte(wr * 64 + fr, fq * 8), boff = lds_byte(wc * 32 + fr, fq * 8);
    const char* Ab = (const char*)g.A;
#define PG8_SA(b, h) (((b) * 2 + (h)) * HTB)
#define PG8_SB(b, h) ((4 + (b) * 2 + (h)) * HTB)
#define PG8_STAGE(bufoff, gbase, voff) do { _Pragma("unroll") for (int _i = 0; _i < 2; ++_i) \
        __builtin_amdgcn_global_load_lds((const unsigned*)((const char*)(gbase) + (voff)[_i]), (PG8_LAS unsigned*)(lds + (bufoff) + ldsw + _i * 8192), 16, 0, 0); } while (0)
#define PG8_STAGEA(bufoff, o0, o1, kb) do { \
        __builtin_amdgcn_global_load_lds((const unsigned*)(Ab + (size_t)(o0) + (size_t)(kb)), (PG8_LAS unsigned*)(lds + (bufoff) + ldsw), 16, 0, 0); \
        __builtin_amdgcn_global_load_lds((const unsigned*)(Ab + (size_t)(o1) + (size_t)(kb)), (PG8_LAS unsigned*)(lds + (bufoff) + ldsw + 8192), 16, 0, 0); } while (0)
#define PG8_LDA(dst, b, h) do { _Pragma("unroll") for (int m = 0; m < 4; ++m) _Pragma("unroll") for (int k = 0; k < 2; ++k) dst[m][k] = *(const PG8_LAS bf16x8*)(lds + PG8_SA(b, h) + aoff + m * 2048 + k * 1024); } while (0)
#define PG8_LDB(dst, b, h) do { _Pragma("unroll") for (int n = 0; n < 2; ++n) _Pragma("unroll") for (int k = 0; k < 2; ++k) dst[n][k] = *(const PG8_LAS bf16x8*)(lds + PG8_SB(b, h) + boff + n * 2048 + k * 1024); } while (0)
#define PG8_CAT(x0, x1) __builtin_shufflevector(__builtin_bit_cast(i32x4, x0), __builtin_bit_cast(i32x4, x1), 0, 1, 2, 3, 4, 5, 6, 7)
#define PG8_MMA(ai, bj, At, Bt) do { __builtin_amdgcn_s_setprio(1); _Pragma("unroll") for (int m = 0; m < 4; ++m) _Pragma("unroll") for (int n = 0; n < 2; ++n) { \
        if constexpr (F8) acc[ai][bj][m][n] = __builtin_amdgcn_mfma_scale_f32_16x16x128_f8f6f4(PG8_CAT(Bt[n][0], Bt[n][1]), PG8_CAT(At[m][0], At[m][1]), acc[ai][bj][m][n], 0, 0, 0, 0, 0, 0); \
        else { _Pragma("unroll") for (int k = 0; k < 2; ++k) acc[ai][bj][m][n] = __builtin_amdgcn_mfma_f32_16x16x32_bf16(Bt[n][k], At[m][k], acc[ai][bj][m][n], 0, 0, 0); } } __builtin_amdgcn_s_setprio(0); } while (0)
#define PG8_WAIT_V(n) asm volatile("s_waitcnt vmcnt(" #n ")" ::: "memory")
#define PG8_WAIT_L(n) asm volatile("s_waitcnt lgkmcnt(" #n ")" ::: "memory")
#define PG8_BAR __builtin_amdgcn_s_barrier()
#define PG8_SCHED __builtin_amdgcn_sched_barrier(0)
#define PG8_OFFS(dst, u) do { _Pragma("unroll") for (int _i = 0; _i < 2; ++_i) { int _R, _C; stage_rc(tid * 16 + _i * 8192, _R, _C); _Pragma("unroll") for (int _h = 0; _h < 2; ++_h) \
        dst[_h][_i] = (unsigned)S.arow((u).pm * BM + _h * HALF + _R) * g.lda_bytes + (unsigned)(_C * 2); } } while (0)
    Unit cur, nxt; int ui = 0;
    if (!S.next(0, cur)) return;
    f32x4 acc[2][2][4][2];
#pragma unroll
    for (int a = 0; a < 2; ++a)
#pragma unroll
        for (int b = 0; b < 2; ++b)
#pragma unroll
            for (int m = 0; m < 4; ++m)
#pragma unroll
                for (int n = 0; n < 2; ++n) acc[a][b][m][n] = (f32x4){0.f, 0.f, 0.f, 0.f};
    bf16x8 At[4][2], B0[2][2], B1[2][2];
    unsigned oC[2][2], oN[2][2];
    PG8_OFFS(oC, cur);
    const char* cB = (const char*)g.Bt + (size_t)cur.pn * tstep;
    PG8_STAGE(PG8_SB(0, 0), cB, voffB); PG8_STAGE(PG8_SB(0, 1), cB + hstep, voffB); PG8_STAGEA(PG8_SA(0, 0), oC[0][0], oC[0][1], 0); PG8_STAGEA(PG8_SA(0, 1), oC[1][0], oC[1][1], 0);
    if (wr == 1) PG8_BAR;
    PG8_WAIT_V(2); PG8_BAR;
    PG8_STAGE(PG8_SB(1, 0), cB + kstep, voffB); PG8_STAGEA(PG8_SA(1, 0), oC[0][0], oC[0][1], kstep); PG8_STAGE(PG8_SB(1, 1), cB + hstep + kstep, voffB);
    PG8_WAIT_V(6); PG8_BAR;
#ifdef GM_PROBE
    unsigned long long gaccs[3] = {0, 0, 0}; unsigned long long gtp = __builtin_amdgcn_s_memrealtime();
#define GM_T(i) do { if (Epi::PROBE) { const unsigned long long t1_ = __builtin_amdgcn_s_memrealtime(); gaccs[i] += t1_ - gtp; gtp = t1_; } } while (0)
#else
#define GM_T(i)
#endif
    for (;;) {
        const bool has_next = S.next(ui + 1, nxt);
        if (has_next) { PG8_OFFS(oN, nxt); } else {
#pragma unroll
            for (int _h = 0; _h < 2; ++_h)
#pragma unroll
                for (int _i = 0; _i < 2; ++_i) oN[_h][_i] = oC[_h][_i]; }
        const char* nB = has_next ? (const char*)g.Bt + (size_t)nxt.pn * tstep : cB;
#pragma unroll 1
        for (int t = 0; t < nt; t += 2) {
            const bool last = (t == nt - 2);
            const size_t k1 = (size_t)(t + 1) * kstep;
            const size_t k2 = last ? 0 : (size_t)(t + 2) * kstep, k3 = k2 + kstep;
            const char* b2 = last ? nB : cB + (size_t)(t + 2) * kstep; const char* b3 = b2 + kstep;
            PG8_LDB(B0, 0, 0); PG8_LDB(B1, 0, 1); PG8_SCHED; PG8_LDA(At, 0, 0); PG8_STAGEA(PG8_SA(1, 1), oC[1][0], oC[1][1], k1);
            if (last) { oC[0][0] = oN[0][0]; oC[0][1] = oN[0][1]; oC[1][0] = oN[1][0]; oC[1][1] = oN[1][1]; }
            PG8_WAIT_V(8); PG8_WAIT_L(0); PG8_BAR; PG8_MMA(0, 0, At, B0); PG8_MMA(0, 1, At, B1); PG8_BAR; PG8_SCHED;
            PG8_LDA(At, 0, 1); PG8_STAGE(PG8_SB(0, 0), b2, voffB); PG8_STAGE(PG8_SB(0, 1), b2 + hstep, voffB); PG8_STAGEA(PG8_SA(0, 0), oC[0][0], oC[0][1], k2);
            PG8_WAIT_V(8); PG8_WAIT_L(0); PG8_BAR; PG8_MMA(1, 0, At, B0); PG8_MMA(1, 1, At, B1); PG8_BAR; PG8_SCHED;
            PG8_LDB(B0, 1, 0); PG8_LDB(B1, 1, 1); PG8_SCHED; PG8_LDA(At, 1, 0); PG8_STAGEA(PG8_SA(0, 1), oC[1][0], oC[1][1], k2);
            PG8_WAIT_V(8); PG8_WAIT_L(0); PG8_BAR; PG8_MMA(0, 0, At, B0); PG8_MMA(0, 1, At, B1); PG8_BAR; PG8_SCHED;
            PG8_LDA(At, 1, 1); PG8_STAGE(PG8_SB(1, 0), b3, voffB); PG8_STAGE(PG8_SB(1, 1), b3 + hstep, voffB); PG8_STAGEA(PG8_SA(1, 0), oC[0][0], oC[0][1], k3);
            PG8_WAIT_V(8); PG8_WAIT_L(0); PG8_BAR; PG8_MMA(1, 0, At, B0); PG8_MMA(1, 1, At, B1); PG8_BAR; PG8_SCHED;
        }
        GM_T(0);
        if constexpr (ALIGN_EPI) { if (wr == 0) PG8_BAR; }
        GM_T(1);
        E(acc, cur, wr, wc, fr, fq);
        GM_T(2);
        if (!has_next) break;
#pragma unroll
        for (int a = 0; a < 2; ++a)
#pragma unroll
            for (int b = 0; b < 2; ++b)
#pragma unroll
                for (int m = 0; m < 4; ++m)
#pragma unroll
                    for (int n = 0; n < 2; ++n) acc[a][b][m][n] = (f32x4){0.f, 0.f, 0.f, 0.f};
        cur = nxt; cB = nB; ++ui;
#pragma unroll
        for (int _h = 0; _h < 2; ++_h)
#pragma unroll
            for (int _i = 0; _i < 2; ++_i) oC[_h][_i] = oN[_h][_i];
        if constexpr (ALIGN_EPI) { if (wr == 1) PG8_BAR; }
    }
#ifdef GM_PROBE
    if (Epi::PROBE && blockIdx.x == 0 && tid == 0) { unsigned long long* ts = (unsigned long long*)(S.probe_ts()); if (ts) { ts[50] = 0; ts[51] = gaccs[0]; ts[52] = gaccs[0] + gaccs[1]; ts[53] = gaccs[0] + gaccs[1] + gaccs[2]; } }
#endif
    PG8_WAIT_V(0);
    if constexpr (!ALIGN_EPI) { if (wr == 0) PG8_BAR; }
    PG8_BAR;
    if constexpr (Epi::AFTER_DRAIN) E.fused(acc, cur, wr, wc, fr, fq, lds);
#undef PG8_SA
#undef PG8_SB
#undef PG8_STAGE
#undef PG8_STAGEA
#undef PG8_LDA
#undef PG8_LDB
#undef PG8_MMA
#undef PG8_CAT
#undef PG8_WAIT_V
#undef PG8_WAIT_L
#undef PG8_BAR
#undef PG8_SCHED
#undef PG8_OFFS
#undef GM_T
}

template <class Epi, class Sched>
__device__ __noinline__ void gemm_phase_ni(PG8_LAS unsigned char* lds, Gemm g, Sched S, Epi E) { gemm_phase<Epi, Sched>(lds, g, S, E, (int)threadIdx.x); }
}

namespace mk {
using namespace pg8;
constexpr int D = 1024, NB = 32, SEQ = 2048, T = NB * SEQ, LC = 256, TC = NB * LC, TT = T + TC;
constexpr int NMOD = 6 * D;
constexpr int NE = 64, NEX = 65, DE = 256;
constexpr int NCH = 2, CHT = T / NCH, BPC = 256 / NCH;
constexpr int MAXTILES = (CHT * 8 + 64 * 255) / 256 + CHT / 256 + 1, CHROWS = MAXTILES * 256;
constexpr float RMS_EPS = 1e-6f;
constexpr int NWAVES = 8, NTHR = 512;

constexpr size_t MiB = 1u << 20;
constexpr size_t WS_CTL = 0, CTL_ZERO_BYTES = 64 * 1024;
constexpr size_t WS_MOD = 1 * MiB;
constexpr size_t WS_ROPE = 3 * MiB;
constexpr size_t WS_BC = 3 * MiB + 65536;
constexpr size_t WS_TEG = 3 * MiB + 2 * 65536;
constexpr size_t WS_GATES = 4 * MiB;
constexpr size_t WS_FILT = 10 * MiB;
constexpr size_t WS_EIDX = 18 * MiB, WS_WTS = 20 * MiB, WS_PSLOT = 22 * MiB, WS_SORT = 26 * MiB;
constexpr size_t WS_WIN0 = 30 * MiB;
constexpr size_t WS_WOUT0 = 38 * MiB, WS_WIN1 = 40 * MiB, WS_WOUT1 = 46 * MiB, WS_WR = 48 * MiB;
constexpr size_t WS_GU = 50 * MiB;
constexpr size_t WS_X8 = 116 * MiB;
constexpr size_t WS_DN = 180 * MiB;
constexpr size_t WS_BIG = 246 * MiB;
constexpr size_t WS_END = 1024 * MiB;
static_assert(WS_PSLOT + (size_t)T * 16 * 4 <= WS_SORT && WS_SORT + (size_t)NCH * CHROWS * 4 <= WS_WIN0 && WS_WIN0 + (size_t)3840 * 2048 <= WS_WOUT0 && WS_WR + (size_t)2 * 256 * 2048 <= WS_GU && WS_GU + (size_t)2 * 65 * 512 * 1024 <= WS_X8 && WS_X8 + (size_t)T * D <= WS_DN && WS_DN + (size_t)2 * 65 * 1024 * 512 <= WS_BIG, "ws map");
constexpr size_t A0_H = 0, A0_QA = 144 * MiB, A0_KA = 208 * MiB, A0_VA = 280 * MiB, A0_BQ = 352 * MiB, A0_BK = 416 * MiB, A0_BV = 488 * MiB, A0_BO = 560 * MiB, A0_VT = 624 * MiB;
constexpr size_t A0_MIXIN = 0, A0_HB = 144 * MiB, A0_MIX = 352 * MiB;
constexpr int CW_BAR = 4096;

constexpr int LDS_BYTES = 160 * 1024;
constexpr int LDS_TAB = 131072;
constexpr int LDS_MISC = 131072 + 24 * 1024;

#define GAS __attribute__((address_space(1)))
#define LAS __attribute__((address_space(3)))
typedef unsigned short bf16;
typedef unsigned v4u __attribute__((ext_vector_type(4)));
typedef unsigned v2u __attribute__((ext_vector_type(2)));
#define LDS_WAIT() asm volatile("s_waitcnt lgkmcnt(0)" ::: "memory")
#define VM_WAIT() asm volatile("s_waitcnt vmcnt(0)" ::: "memory")
__device__ __forceinline__ unsigned f2bf(float f) { unsigned u = __builtin_bit_cast(unsigned, f); return (u + 0x7fffu + ((u >> 16) & 1u)) >> 16; }
typedef float f32x2_t __attribute__((ext_vector_type(2))); typedef __bf16 bf16x2_t __attribute__((ext_vector_type(2)));
__device__ __forceinline__ unsigned pk2(float lo, float hi) { const f32x2_t v = {lo, hi}; return __builtin_bit_cast(unsigned, __builtin_convertvector(v, bf16x2_t)); }
__device__ __forceinline__ float bf_lo(unsigned w) { return __builtin_bit_cast(float, w << 16); }
__device__ __forceinline__ float bf_hi(unsigned w) { return __builtin_bit_cast(float, w & 0xffff0000u); }
__device__ __forceinline__ float bf1(bf16 h) { return __builtin_bit_cast(float, (unsigned)h << 16); }
__device__ __forceinline__ int lane_opq() { int l = (int)__builtin_amdgcn_mbcnt_hi(~0u, __builtin_amdgcn_mbcnt_lo(~0u, 0u)); asm volatile("" : "+v"(l)); return l; }
__device__ __forceinline__ float shx(float v, int m) { return __builtin_bit_cast(float, __builtin_amdgcn_ds_bpermute((lane_opq() ^ m) << 2, __builtin_bit_cast(int, v))); }
__device__ __forceinline__ float shup(float v, int o) { const int l = lane_opq(); return __builtin_bit_cast(float, __builtin_amdgcn_ds_bpermute((l >= o ? l - o : l) << 2, __builtin_bit_cast(int, v))); }
__device__ __forceinline__ float shidx(float v, int idx) { return __builtin_bit_cast(float, __builtin_amdgcn_ds_bpermute(idx << 2, __builtin_bit_cast(int, v))); }
__device__ __forceinline__ float wave_sum(float v) {
#pragma unroll
    for (int o = 1; o < 64; o <<= 1) v += shx(v, o);
    return v;
}
__device__ __forceinline__ float wave_max(float v) {
#pragma unroll
    for (int o = 1; o < 64; o <<= 1) v = fmaxf(v, shx(v, o));
    return v;
}
__device__ __forceinline__ float sigmoidf_(float x) { return __builtin_amdgcn_rcpf(1.f + __expf(-x)); }
__device__ __forceinline__ float siluf_(float x) { return x * __builtin_amdgcn_rcpf(1.f + __expf(-x)); }
#define XB_TMO      128
#define XB_XCNT(j)  (256  + 64 * (j))
#define XB_XSUB(j)  (1280 + 64 * (j))
#define XB_XGEN(j)  (2304 + 64 * (j))
#define XB_TOP      3328
#define XB_TOPGEN   3392
#define XCD_BAR_WORDS 3456
#define XB_SPIN_CAP (1u << 18)

__device__ __forceinline__ unsigned xb_ld(unsigned* p)              { return __hip_atomic_load(p, __ATOMIC_RELAXED, __HIP_MEMORY_SCOPE_AGENT); }
__device__ __forceinline__ unsigned xb_add(unsigned* p, unsigned v) { return __hip_atomic_fetch_add(p, v, __ATOMIC_RELAXED, __HIP_MEMORY_SCOPE_AGENT); }
__device__ __forceinline__ unsigned xb_xcc_id() { return (unsigned)__builtin_amdgcn_s_getreg((3 << 11) | 20) & 0xFu; }
#define XB_SPIN(cond, bar) do { unsigned _sp = 0; while (cond) { __builtin_amdgcn_s_sleep(1); \
    if ((++_sp & 255u) == 0u) { if (xb_ld(&(bar)[XB_TMO])) break; if (_sp > XB_SPIN_CAP) { atomicAdd(&(bar)[XB_TMO], 1u); break; } } } } while (0)

struct XcdBarrier {
    unsigned* bar; unsigned x;
    volatile LAS unsigned* st;
};

__device__ __forceinline__ XcdBarrier xcd_barrier_post(unsigned* bar, volatile LAS unsigned* st) {
    XcdBarrier b; b.bar = bar; b.x = xb_xcc_id(); b.st = st;
    if (threadIdx.x == 0) (void)xb_add(&bar[XB_XCNT(b.x)], 1u);
    return b;
}
__device__ __forceinline__ void xcd_barrier_complete(unsigned* bar, unsigned x, unsigned& nloc, unsigned& nx) {
    const unsigned G = gridDim.x * gridDim.y * gridDim.z;
    unsigned sum, cnt, mine, sp = 0u;
    for (;;) {
        sum = 0u; cnt = 0u; mine = 0u;
#pragma unroll
        for (unsigned j = 0; j < 16; ++j) { const unsigned c = xb_ld(&bar[XB_XCNT(j)]); sum += c; cnt += (c > 0u) ? 1u : 0u; mine = (j == x) ? c : mine; }
        if (sum == G) break;
        __builtin_amdgcn_s_sleep(1);
        if ((++sp & 255u) == 0u) { if (xb_ld(&bar[XB_TMO])) break; if (sp > XB_SPIN_CAP) { atomicAdd(&bar[XB_TMO], 1u); break; } }
    }
    nloc = mine > 0u ? mine : 1u; nx = cnt > 0u ? cnt : 1u;
}

__device__ __forceinline__ void xcd_barrier(const XcdBarrier& b, const bool t0  ) {
    asm volatile("s_waitcnt vmcnt(0)" ::: "memory");
    __syncthreads();
    if (t0) {
        unsigned* bar = b.bar;
        __builtin_amdgcn_s_waitcnt(0);
        unsigned nloc = b.st[0], nx = b.st[1];
        if (nloc == 0u) { xcd_barrier_complete(bar, b.x, nloc, nx); b.st[0] = nloc; b.st[1] = nx; }
        const unsigned old = xb_add(&bar[XB_XSUB(b.x)], 1u);
        const unsigned gen = old / nloc;
        if (old + 1u == (gen + 1u) * nloc) {
            __builtin_amdgcn_fence(__ATOMIC_RELEASE, "agent");
            asm volatile("s_waitcnt vmcnt(0)" ::: "memory");
            const unsigned og = xb_add(&bar[XB_TOP], 1u);
            const unsigned tg = og / nx;
            if (og + 1u == (tg + 1u) * nx) xb_add(&bar[XB_TOPGEN], 1u);
            else XB_SPIN(xb_ld(&bar[XB_TOPGEN]) == tg, bar);
            __builtin_amdgcn_fence(__ATOMIC_ACQUIRE, "agent");
            xb_add(&bar[XB_XGEN(b.x)], 1u);
            asm volatile("s_waitcnt vmcnt(0)" ::: "memory");
        } else {
            XB_SPIN(xb_ld(&bar[XB_XGEN(b.x)]) == gen, bar);
            __builtin_amdgcn_fence(__ATOMIC_ACQUIRE, "agent");
            asm volatile("s_waitcnt vmcnt(0)" ::: "memory");
        }
    }
    __syncthreads();
}

constexpr float Y8_SCALE = 16.f, Y8_INV = 1.f / 16.f;
constexpr float X8_SCALE = 16.f, GU8_SCALE = 256.f, G1_INV = 1.f / (X8_SCALE * GU8_SCALE);
struct Params { const float* in[31]; float* out; unsigned char* ws; int ph_lo, ph_hi; };
enum { I_X = 0, I_C, I_CTX, I_CCTX, I_WMOD, I_BMOD, I_NORMG, I_WINAB, I_CONVABW, I_CONVABB, I_GATEB, I_DLAM, I_HGA, I_HGB, I_WOUTAB, I_WINHY, I_CONVHYW, I_CONVHYB,
       I_FW1, I_FB1, I_FW2, I_FB2, I_FW3, I_FBIAS, I_WOUTHY, I_RW, I_RB, I_EGU, I_EDN, I_SGU, I_SDN };

__device__ __forceinline__ void row_ld_f32(const float* row, int lane, f32x4 (&v)[4]) { const f32x4* r = (const f32x4*)row + lane;
#pragma unroll
    for (int j = 0; j < 4; ++j) v[j] = r[64 * j]; }
__device__ __forceinline__ void row_st_f32(float* row, int lane, const f32x4 (&v)[4]) { f32x4* r = (f32x4*)row + lane;
#pragma unroll
    for (int j = 0; j < 4; ++j) r[64 * j] = v[j]; }
__device__ __forceinline__ void row_ld_bf16(const bf16* row, int lane, f32x4 (&v)[4]) { const v2u* r = (const v2u*)row + lane;
#pragma unroll
    for (int j = 0; j < 4; ++j) { const v2u w = r[64 * j]; v[j] = (f32x4){bf_lo(w.x), bf_hi(w.x), bf_lo(w.y), bf_hi(w.y)}; } }
__device__ __forceinline__ void row_st_bf16(bf16* row, int lane, const f32x4 (&v)[4]) { v2u* r = (v2u*)row + lane;
#pragma unroll
    for (int j = 0; j < 4; ++j) { v2u w; w.x = pk2(v[j].x, v[j].y); w.y = pk2(v[j].z, v[j].w); r[64 * j] = w; } }
__device__ __forceinline__ unsigned fp8x4(float a, float b, float c, float d, float sc) {
    a = __builtin_amdgcn_fmed3f(a * sc, -440.f, 440.f); b = __builtin_amdgcn_fmed3f(b * sc, -440.f, 440.f); c = __builtin_amdgcn_fmed3f(c * sc, -440.f, 440.f); d = __builtin_amdgcn_fmed3f(d * sc, -440.f, 440.f);
    int w = 0; w = __builtin_amdgcn_cvt_pk_fp8_f32(a, b, w, false); w = __builtin_amdgcn_cvt_pk_fp8_f32(c, d, w, true); return (unsigned)w; }
__device__ __forceinline__ void row_st_fp8(unsigned char* row, int lane, const f32x4 (&v)[4], float sc) { unsigned* r = (unsigned*)row + lane;
#pragma unroll
    for (int j = 0; j < 4; ++j) r[64 * j] = fp8x4(v[j].x, v[j].y, v[j].z, v[j].w, sc); }
__device__ __forceinline__ float row_ss(const f32x4 (&v)[4]) { float s = 0.f;
#pragma unroll
    for (int j = 0; j < 4; ++j) s += (v[j].x * v[j].x + v[j].y * v[j].y) + (v[j].z * v[j].z + v[j].w * v[j].w);
    return wave_sum(s); }
__device__ __forceinline__ void row_modulate(const f32x4 (&x)[4], float rstd, const float* g, const float* shift, const float* scale, int lane, f32x4 (&h)[4]) {
    const f32x4* gp = (const f32x4*)g + lane; const f32x4* sh = (const f32x4*)shift + lane; const f32x4* sc = (const f32x4*)scale + lane;
#pragma unroll
    for (int j = 0; j < 4; ++j) { const f32x4 gg = gp[64 * j], s1 = sc[64 * j], s0 = sh[64 * j]; h[j] = x[j] * rstd * gg * (1.f + s1) + s0; } }

__device__ __forceinline__ void pro_mod(const Params& p, LAS unsigned char* lds, int tid, int lane, int wave) {
    const int u = blockIdx.x; if (u >= 192) return;
    LAS float* S = (LAS float*)lds;
    const float* c = p.in[I_C]; const float* cc = p.in[I_CCTX];
#pragma unroll 4
    for (int i = tid; i < 33 * 256; i += NTHR) { const int b = i >> 8, k4 = (i & 255) * 4; const f32x4 v = b < 32 ? *(const f32x4*)(c + b * 1024 + k4) : *(const f32x4*)(cc + k4);
        *(LAS f32x4*)(S + b * 1024 + k4) = (f32x4){siluf_(v[0]), siluf_(v[1]), siluf_(v[2]), siluf_(v[3])}; }
    __syncthreads();
    const int l = u / 96, cg = (u % 96) * 64, col = cg + lane;
    const float* W = p.in[I_WMOD] + (size_t)l * 1024 * NMOD;
    float acc[33];
#pragma unroll
    for (int b = 0; b < 33; ++b) acc[b] = 0.f;
    const int k0 = wave * 128;
#pragma unroll 4
    for (int kk = 0; kk < 128; kk += 4) { const int k = k0 + kk;
        const float w0 = W[(size_t)k * NMOD + col], w1 = W[(size_t)(k + 1) * NMOD + col], w2 = W[(size_t)(k + 2) * NMOD + col], w3 = W[(size_t)(k + 3) * NMOD + col];
#pragma unroll
        for (int b = 0; b < 33; ++b) { const f32x4 s = *(const LAS f32x4*)(S + b * 1024 + k); acc[b] += (s.x * w0 + s.y * w1) + (s.z * w2 + s.w * w3); } }
    __syncthreads();
    LAS float* P = (LAS float*)lds;
#pragma unroll
    for (int b = 0; b < 33; ++b) P[(wave * 33 + b) * 64 + lane] = acc[b];
    __syncthreads();
    float* MOD = (float*)(p.ws + WS_MOD);
#pragma unroll 1
    for (int i = tid; i < 33 * 64; i += NTHR) { const int b = i >> 6, ln = i & 63; float s = 0.f;
#pragma unroll
        for (int w = 0; w < 8; ++w) s += P[(w * 33 + b) * 64 + ln];
        MOD[(size_t)(l * 33 + b) * NMOD + cg + ln] = s + p.in[I_BMOD][l * NMOD + cg + ln]; }
    __syncthreads();
}
__device__ __forceinline__ int rowmap(int kind, int n) {
    if (kind == 1) { const int o = n & 31; return (n & ~31) + (((o & 15) >> 2) * 8 + (o >> 4) * 4 + (o & 3)); }
    if (kind == 2) { return n < 256 ? ((n >> 7) * 256 + (n & 127)) : ((((n - 256) >> 7) * 256) + 128 + ((n - 256) & 127)); }
    if (kind == 3) { const int a = n & 255; return (n & ~255) + 128 * ((a >> 3) & 1) + 32 * (a >> 6) + 8 * ((a >> 4) & 3) + (a & 7); }
    return n;
}
struct TrDesc { const float* W; bf16* WT; int ldn, k0, n0, nvalid, dK, kind, row_base; };
__device__ __forceinline__ TrDesc tr_decode(const Params& p, int it) {
    constexpr int I_A = 16 * 113, I_B = 512, I_C2 = 1536, I_D = 512, I_E = 64, I_F = 130 * 256;
    unsigned char* ws = p.ws; int r = it;
    if (r < I_A) { const int kb = r / 113, nb = r % 113, n0 = nb * 32; const int kind = (n0 < 512 || (n0 >= 1536 && n0 < 2048)) ? 1 : 0;
        return TrDesc{p.in[I_WINAB], (bf16*)(ws + WS_WIN0), 3600, kb * 64, n0, 3600, 1024, kind, 0}; } r -= I_A;
    if (r < I_B) return TrDesc{p.in[I_WOUTAB], (bf16*)(ws + WS_WOUT0), 1024, (r / 32) * 64, (r % 32) * 32, 1024, 1024, 0, 0}; r -= I_B;
    if (r < I_C2) return TrDesc{p.in[I_WINHY], (bf16*)(ws + WS_WIN1), 3072, (r / 96) * 64, (r % 96) * 32, 3072, 1024, 0, 0}; r -= I_C2;
    if (r < I_D) return TrDesc{p.in[I_WOUTHY], (bf16*)(ws + WS_WOUT1), 1024, (r / 32) * 64, (r % 32) * 32, 1024, 1024, 0, 0}; r -= I_D;
    if (r < I_E) { const int l = r / 32, q = r % 32; return TrDesc{p.in[I_RW] + (size_t)l * 1024 * 64, (bf16*)(ws + WS_WR) + (size_t)l * 256 * 1024, 64, (q / 2) * 64, (q % 2) * 32, 64, 1024, 0, 0}; } r -= I_E;
    if (r < I_F) { const int mat = r / 256, q = r % 256, l = mat / 65, e = mat % 65;
        const float* src = e < 64 ? p.in[I_EGU] + (size_t)(l * 64 + e) * 1024 * 512 : p.in[I_SGU] + (size_t)l * 1024 * 512;
        return TrDesc{src, (bf16*)(ws + WS_GU + (size_t)l * (65 * 512) * 1024), 512, (q / 16) * 64, (q % 16) * 32, 512, 1024, 2, e * 512}; } r -= I_F;
    { const int mat = r / 128, q = r % 128, l = mat / 65, e = mat % 65;
        const float* src = e < 64 ? p.in[I_EDN] + (size_t)(l * 64 + e) * 256 * 1024 : p.in[I_SDN] + (size_t)l * 256 * 1024;
        return TrDesc{src, (bf16*)(ws + WS_DN) + (size_t)l * (65 * 1024) * 256, 1024, (q / 32) * 64, (q % 32) * 32, 1024, 256, 3, e * 1024}; }
}
__device__ __forceinline__ void tr_load(const TrDesc& d, int lane, float (&v)[32]) {
    const int nn = d.n0 + (lane & 31); const bool ok = nn < d.nvalid; const float* src = d.W + (size_t)(d.k0 + (lane >> 5)) * d.ldn + (ok ? nn : 0);
#pragma unroll
    for (int i = 0; i < 32; ++i) v[i] = src[(size_t)(2 * i) * d.ldn];
    if (!ok) {
#pragma unroll
        for (int i = 0; i < 32; ++i) v[i] = 0.f; }
}
__device__ __forceinline__ void tr_finish(const TrDesc& d, const float (&v)[32], LAS float* scr, int lane) {
#pragma unroll
    for (int i = 0; i < 32; ++i) scr[(2 * i + (lane >> 5)) * 33 + (lane & 31)] = v[i];
    LDS_WAIT(); asm volatile("" ::: "memory");
    const int c = lane & 7;
#pragma unroll
    for (int j = 0; j < 4; ++j) { const int n = (lane >> 3) + 8 * j; const LAS float* s = scr + (8 * c) * 33 + n;
        const int row = d.row_base + rowmap(d.kind, d.n0 + n);
        if (d.kind == 2) { v2u o; o.x = fp8x4(s[0 * 33], s[1 * 33], s[2 * 33], s[3 * 33], GU8_SCALE); o.y = fp8x4(s[4 * 33], s[5 * 33], s[6 * 33], s[7 * 33], GU8_SCALE);
            *(v2u*)((unsigned char*)d.WT + (size_t)row * d.dK + d.k0 + 8 * c) = o; }
        else { v4u o; o.x = pk2(s[0 * 33], s[1 * 33]); o.y = pk2(s[2 * 33], s[3 * 33]); o.z = pk2(s[4 * 33], s[5 * 33]); o.w = pk2(s[6 * 33], s[7 * 33]);
            *(v4u*)(d.WT + (size_t)row * d.dK + d.k0 + 8 * c) = o; } }
    LDS_WAIT(); asm volatile("" ::: "memory");
}
__device__ __forceinline__ void pro_transposes(const Params& p, LAS unsigned char* lds, int lane, int wave) {
    LAS float* scr = (LAS float*)(lds + wave * 16384);
    const int gw = blockIdx.x * NWAVES + wave, NGW = gridDim.x * NWAVES;
    constexpr int NITEMS = 16 * 113 + 512 + 1536 + 512 + 64 + 130 * 256 + 130 * 128;
    if (gw >= NITEMS) return;
    TrDesc dc = tr_decode(p, gw); float vc[32]; tr_load(dc, lane, vc);
#pragma unroll 1
    for (int it = gw; it < NITEMS; it += NGW) {
        const bool more = it + NGW < NITEMS; TrDesc dn = dc; float vn[32];
        if (more) { dn = tr_decode(p, it + NGW); tr_load(dn, lane, vn); }
        tr_finish(dc, vc, scr, lane);
        if (more) { dc = dn;
#pragma unroll
            for (int i = 0; i < 32; ++i) vc[i] = vn[i]; }
    }
}
__device__ __forceinline__ void pro_rope(const Params& p, int tid) {
    if (blockIdx.x != 255) return;
    float* R = (float*)(p.ws + WS_ROPE);
    for (int i = tid; i < 64 * 16; i += NTHR) { const int pos = i >> 4, f = i & 15; const float inv = exp2f(-(float)f * (13.287712379549449f / 16.f)); const float ang = (float)pos * inv;
        float sn, cs; sincosf(ang, &sn, &cs); R[2 * i] = cs; R[2 * i + 1] = sn; }
}
__device__ __forceinline__ void pro_filters(const Params& p, LAS unsigned char* lds, int tid, int lane, int wave) {
    LAS float* Z = (LAS float*)lds;
    LAS float* H1 = Z + 512;
    LAS float* H2 = H1 + 512;
    const int j0 = 8 * blockIdx.x, j = j0 + wave;
    const float* fw1 = p.in[I_FW1]; const float* fb1 = p.in[I_FB1]; const float* fw2 = p.in[I_FW2]; const float* fb2 = p.in[I_FB2]; const float* fw3 = p.in[I_FW3];
    {   float z = 0.f;
        if (lane == 0) z = (float)j / 2047.f;
        else if (lane < 33) { const int k = (lane - 1) & 15; const float fr = 1e-4f + (float)k * ((15.f - 1e-4f) / 15.f); const float ang = (6.283185307179586f / 2048.f) * (float)j * fr;
            float sn, cs; sincosf(ang, &sn, &cs); z = lane < 17 ? cs : -sn; }
        Z[wave * 64 + lane] = z; }
    LDS_WAIT(); asm volatile("" ::: "memory");
    {   float a = fb1[lane];
#pragma unroll 11
        for (int k = 0; k < 33; ++k) a += Z[wave * 64 + k] * fw1[k * 64 + lane];
        H1[wave * 64 + lane] = sinf(a); }
    LDS_WAIT(); asm volatile("" ::: "memory");
    {   float a = fb2[lane];
#pragma unroll 16
        for (int k = 0; k < 64; ++k) a += H1[wave * 64 + k] * fw2[k * 64 + lane];
        H2[wave * 64 + lane] = sinf(a); }
    __syncthreads();
    bf16* F = (bf16*)(p.ws + WS_FILT);
    const float mind = -4.605170185988091f / 1.5f, maxd = -4.605170185988091f / 0.3f;
#pragma unroll 1
    for (int i = 0; i < 4; ++i) { const int n = tid + NTHR * i, c = n & 1023;
        float acc[8];
#pragma unroll
        for (int q = 0; q < 8; ++q) acc[q] = 0.f;
#pragma unroll 16
        for (int k = 0; k < 64; ++k) { const float w = fw3[k * 2048 + n];
#pragma unroll
            for (int q = 0; q < 8; ++q) acc[q] += H2[q * 64 + k] * w; }
        const float delta = fabsf(mind + (float)c * ((maxd - mind) / 1023.f));
        float o[8];
#pragma unroll
        for (int q = 0; q < 8; ++q) { const float dist = fabsf((float)(j0 + q) - 1024.f) * (1.f / 1024.f); o[q] = acc[q] * expf(-dist * delta); }
        v4u w; w.x = pk2(o[0], o[1]); w.y = pk2(o[2], o[3]); w.z = pk2(o[4], o[5]); w.w = pk2(o[6], o[7]);
        *(v4u*)(F + (size_t)n * 2048 + j0) = w; }
    __syncthreads();
}

__device__ __forceinline__ void l0_norm_rows(const float* src, bf16* dst, int nrows, const float* g, const float* md, int lane) {
    f32x4 vb[4], vc[4];
#pragma unroll
    for (int j = 0; j < 4; ++j) { const int o = 4 * lane + 256 * j; vb[j] = *(const f32x4*)(g + o) * (1.f + *(const f32x4*)(md + D + o)); vc[j] = *(const f32x4*)(md + o); }
    f32x4 xn[4]; row_ld_f32(src, lane, xn);
#pragma unroll 1
    for (int i = 0; i < nrows; ++i) { f32x4 x[4], h[4];
#pragma unroll
        for (int j = 0; j < 4; ++j) x[j] = xn[j];
        if (i + 1 < nrows) row_ld_f32(src + (size_t)(i + 1) * D, lane, xn);
        const float rstd = rsqrtf(row_ss(x) * (1.f / D) + RMS_EPS);
#pragma unroll
        for (int j = 0; j < 4; ++j) h[j] = x[j] * rstd * vb[j] + vc[j];
        row_st_bf16(dst + (size_t)i * D, lane, h); }
}
__device__ __forceinline__ void ph_l0_norm(const Params& p, int lane, int wave) {
    const int gw = blockIdx.x * NWAVES + wave;
    const float* MOD = (const float*)(p.ws + WS_MOD); bf16* H = (bf16*)(p.ws + WS_BIG + A0_H);
    const float* g = p.in[I_NORMG];
    { const int m0 = gw * 32; l0_norm_rows(p.in[I_X] + (size_t)m0 * D, H + (size_t)m0 * D, 32, g, MOD + (size_t)(m0 >> 11) * NMOD, lane); }
    { const int m0 = gw * 4; l0_norm_rows(p.in[I_CTX] + (size_t)m0 * D, H + (size_t)(T + m0) * D, 4, g, MOD + (size_t)32 * NMOD, lane); }
}
__device__ __forceinline__ void ph_mid(const Params& p, int l, const bf16* MIX, bf16* H2, unsigned char* X8, bool has_mix, int lane, int wave, int tile) {
    const int gw = tile * NWAVES + wave;
    const float* MOD = (const float*)(p.ws + WS_MOD) + (size_t)l * 33 * NMOD;
    const float* g1 = p.in[I_NORMG] + (size_t)(l * 4 + 1) * D; const float* g2 = p.in[I_NORMG] + (size_t)(l * 4 + 2) * D;
    const float* xin = l == 0 ? p.in[I_X] : p.out;
    const int m0 = gw * 32; const float* md = MOD + (size_t)(m0 >> 11) * NMOD;
    f32x4 va[4], vb[4], vc[4];
#pragma unroll
    for (int j = 0; j < 4; ++j) { const int o = 4 * lane + 256 * j; va[j] = *(const f32x4*)(md + 2 * D + o) * *(const f32x4*)(g1 + o); vb[j] = *(const f32x4*)(g2 + o) * (1.f + *(const f32x4*)(md + 4 * D + o)); vc[j] = *(const f32x4*)(md + 3 * D + o); }
    f32x4 xn[4], mn[4];
    row_ld_f32(xin + (size_t)m0 * D, lane, xn); if (has_mix) row_ld_bf16(MIX + (size_t)m0 * D, lane, mn);
#pragma unroll 1
    for (int m = m0; m < m0 + 32; ++m) {
        f32x4 x[4], h[4], mx[4];
#pragma unroll
        for (int j = 0; j < 4; ++j) { x[j] = xn[j]; mx[j] = mn[j]; }
        if (m + 1 < m0 + 32) { row_ld_f32(xin + (size_t)(m + 1) * D, lane, xn); if (has_mix) row_ld_bf16(MIX + (size_t)(m + 1) * D, lane, mn); }
        if (has_mix) { const float r = rsqrtf(row_ss(mx) * (1.f / D) + RMS_EPS);
#pragma unroll
            for (int j = 0; j < 4; ++j) x[j] = x[j] + va[j] * (mx[j] * r); }
        row_st_f32(p.out + (size_t)m * D, lane, x);
        const float rstd = rsqrtf(row_ss(x) * (1.f / D) + RMS_EPS);
#pragma unroll
        for (int j = 0; j < 4; ++j) h[j] = x[j] * rstd * vb[j] + vc[j];
        row_st_bf16(H2 + (size_t)m * D, lane, h);
        row_st_fp8(X8 + (size_t)m * D, lane, h, X8_SCALE);
    }
}
__device__ __forceinline__ void ph_combine(const Params& p, int l, int ch, const unsigned char* Y8, bf16* Hn, int lane, int wave) {
    const int gw = blockIdx.x * NWAVES + wave;
    const float* MOD = (const float*)(p.ws + WS_MOD) + (size_t)l * 33 * NMOD;
    const float* g3 = p.in[I_NORMG] + (size_t)(l * 4 + 3) * D;
    const int* PSLOT = (const int*)(p.ws + WS_PSLOT); const float* WTS = (const float*)(p.ws + WS_WTS);
    constexpr int RPW = CHT / 2048;
    const int mbase = ch * CHT + gw * RPW; const float* md = MOD + (size_t)(mbase >> 11) * NMOD;
    float va[16], vb[16], vc[16];
    { const float* md1 = MOD + (size_t)(33 + (mbase >> 11)) * NMOD; const float* g10 = p.in[I_NORMG] + (size_t)4 * D;
#pragma unroll
      for (int q = 0; q < 4; ++q) { const int o = lane * 16 + 4 * q; const f32x4 gp = *(const f32x4*)(g3 + o), gf = *(const f32x4*)(md + 5 * D + o); f32x4 gg = gp, sh = gp, sc = gp;
          if (l == 0) { gg = *(const f32x4*)(g10 + o); sh = *(const f32x4*)(md1 + o); sc = *(const f32x4*)(md1 + D + o); }
#pragma unroll
          for (int j = 0; j < 4; ++j) { va[4 * q + j] = gp[j] * gf[j]; vb[4 * q + j] = gg[j] * (1.f + sc[j]); vc[4 * q + j] = sh[j]; } } }
    int sl[9]; float wk[9];
#define CMB_SLOTS(mt) do { _Pragma("unroll") for (int k = 0; k < 9; ++k) { sl[k] = PSLOT[(size_t)(mt) * 16 + k]; wk[k] = k < 8 ? WTS[(size_t)(mt) * 8 + k] : 1.f; } } while (0)
    CMB_SLOTS(mbase);
#pragma unroll 1
    for (int m = mbase; m < mbase + RPW; ++m) {
        float a[16];
#pragma unroll
        for (int j = 0; j < 16; ++j) a[j] = 0.f;
        u32x4 yr[9]; float wc[9];
#pragma unroll
        for (int k = 0; k < 9; ++k) { yr[k] = *(const u32x4*)(Y8 + (size_t)sl[k] * 1024 + lane * 16); wc[k] = wk[k]; }
        float* orow = p.out + (size_t)m * D + lane * 16; f32x4 xv4[4];
#pragma unroll
        for (int q = 0; q < 4; ++q) xv4[q] = *(const f32x4*)(orow + 4 * q);
        if (m + 1 < mbase + RPW) CMB_SLOTS(m + 1);
#pragma unroll
        for (int k = 0; k < 9; ++k) { const float w = wc[k] * Y8_INV; const unsigned ww[4] = {yr[k].x, yr[k].y, yr[k].z, yr[k].w};
#pragma unroll
            for (int q = 0; q < 4; ++q) { a[4 * q + 0] += w * __builtin_amdgcn_cvt_f32_fp8((int)ww[q], 0); a[4 * q + 1] += w * __builtin_amdgcn_cvt_f32_fp8((int)ww[q], 1);
                                          a[4 * q + 2] += w * __builtin_amdgcn_cvt_f32_fp8((int)ww[q], 2); a[4 * q + 3] += w * __builtin_amdgcn_cvt_f32_fp8((int)ww[q], 3); } }
        float ss = 0.f;
#pragma unroll
        for (int j = 0; j < 16; ++j) ss += a[j] * a[j];
        const float r = rsqrtf(wave_sum(ss) * (1.f / D) + RMS_EPS);
        float x[16]; float s2 = 0.f;
#pragma unroll
        for (int q = 0; q < 4; ++q) {
#pragma unroll
            for (int j = 0; j < 4; ++j) { const float v = xv4[q][j] + va[4 * q + j] * (a[4 * q + j] * r); x[4 * q + j] = v; s2 += v * v; }
            *(f32x4*)(orow + 4 * q) = (f32x4){x[4 * q], x[4 * q + 1], x[4 * q + 2], x[4 * q + 3]}; }
        if (l == 0) { const float rstd = rsqrtf(wave_sum(s2) * (1.f / D) + RMS_EPS); float h[16];
#pragma unroll
            for (int j = 0; j < 16; ++j) h[j] = x[j] * rstd * vb[j] + vc[j];
            v4u w0, w1; w0.x = pk2(h[0], h[1]); w0.y = pk2(h[2], h[3]); w0.z = pk2(h[4], h[5]); w0.w = pk2(h[6], h[7]); w1.x = pk2(h[8], h[9]); w1.y = pk2(h[10], h[11]); w1.z = pk2(h[12], h[13]); w1.w = pk2(h[14], h[15]);
            *(v4u*)(Hn + (size_t)m * D + lane * 16) = w0; *(v4u*)(Hn + (size_t)m * D + lane * 16 + 8) = w1; }
    }
#undef CMB_SLOTS
}

struct DenseSched { int NN, NU, G, c, NMs;
    __device__ __forceinline__ bool next(int i, Unit& u) const { const int L = i * G + c; if (L >= NU) return false; if (NMs > 0) { u.pm = L % NMs; u.pn = L / NMs; } else { u.pm = L / NN; u.pn = L % NN; } return true; }
    __device__ __forceinline__ int arow(int r) const { return r; }
    __device__ __forceinline__ void* probe_ts() const { return nullptr; } };
struct PanelSched { int NN, pm;
    __device__ __forceinline__ bool next(int i, Unit& u) const { if (i >= NN) return false; u.pm = pm; u.pn = i; return true; }
    __device__ __forceinline__ int arow(int r) const { return r; }
    __device__ __forceinline__ void* probe_ts() const { return nullptr; } };
struct EpiBf16 { static constexpr bool PERM = true, AFTER_DRAIN = false, PROBE = false; bf16* O; size_t ldc; int cmask;
    __device__ __forceinline__ void operator()(const f32x4 (&acc)[2][2][4][2], const Unit& u, int wr, int wc, int fr, int fq) const {
        const int row0 = u.pm * BM + wr * 64 + fr, col0 = (u.pn & cmask) * BM + wc * 32 + 8 * fq;
#pragma unroll
        for (int ai = 0; ai < 2; ++ai)
#pragma unroll
            for (int m = 0; m < 4; ++m) { bf16* rowp = O + (size_t)(row0 + ai * HALF + m * 16) * ldc + col0;
#pragma unroll
                for (int bj = 0; bj < 2; ++bj) { const f32x4 v0 = acc[ai][bj][m][0], v1 = acc[ai][bj][m][1];
                    u32x4 w; w.x = cvt_pk_bf16(v0[0], v0[1]); w.y = cvt_pk_bf16(v0[2], v0[3]); w.z = cvt_pk_bf16(v1[0], v1[1]); w.w = cvt_pk_bf16(v1[2], v1[3]);
                    *(u32x4*)(rowp + bj * HALF) = w; } }
    } };
struct EpiRouter { static constexpr bool PERM = false, AFTER_DRAIN = false, PROBE = false; float* LOG;
    __device__ __forceinline__ void operator()(const f32x4 (&acc)[2][2][4][2], const Unit& u, int wr, int wc, int fr, int fq) const {
        if (wc >= 2) return;
        const int row0 = u.pm * BM + wr * 64 + fr, col0 = wc * 32 + 4 * fq;
#pragma unroll
        for (int ai = 0; ai < 2; ++ai)
#pragma unroll
            for (int m = 0; m < 4; ++m) { float* rowp = LOG + (size_t)(row0 + ai * HALF + m * 16) * 64 + col0;
#pragma unroll
                for (int n = 0; n < 2; ++n) *(f32x4*)(rowp + n * 16) = acc[ai][0][m][n]; }
    } };
struct EpiFp8 { static constexpr bool PERM = true, AFTER_DRAIN = false, PROBE = true; unsigned char* O;
    __device__ __forceinline__ void operator()(const f32x4 (&acc)[2][2][4][2], const Unit& u, int wr, int wc, int fr, int fq) const {
        const int row0 = u.pm * BM + wr * 64 + fr, col0 = (u.pn & 3) * BM + wc * 64 + 16 * fq;
#pragma unroll
        for (int ai = 0; ai < 2; ++ai)
#pragma unroll
            for (int m = 0; m < 4; ++m) { unsigned char* rowp = O + (size_t)(row0 + ai * HALF + m * 16) * 1024 + col0; u32x4 w;
#pragma unroll
                for (int bj = 0; bj < 2; ++bj) { f32x4 v0 = acc[ai][bj][m][0] * Y8_SCALE, v1 = acc[ai][bj][m][1] * Y8_SCALE; int lo = 0, hi = 0;
#pragma unroll
                    for (int j = 0; j < 4; ++j) { v0[j] = __builtin_amdgcn_fmed3f(v0[j], -440.f, 440.f); v1[j] = __builtin_amdgcn_fmed3f(v1[j], -440.f, 440.f); }
                    lo = __builtin_amdgcn_cvt_pk_fp8_f32(v0[0], v0[1], lo, false); lo = __builtin_amdgcn_cvt_pk_fp8_f32(v0[2], v0[3], lo, true);
                    hi = __builtin_amdgcn_cvt_pk_fp8_f32(v1[0], v1[1], hi, false); hi = __builtin_amdgcn_cvt_pk_fp8_f32(v1[2], v1[3], hi, true);
                    if (bj == 0) { w.x = (unsigned)lo; w.y = (unsigned)hi; } else { w.z = (unsigned)lo; w.w = (unsigned)hi; } }
                *(u32x4*)rowp = w; }
    } };
struct EpiRouterLds { static constexpr bool PERM = false, AFTER_DRAIN = true, PROBE = false;
    __device__ __forceinline__ void operator()(const f32x4 (&)[2][2][4][2], const Unit&, int, int, int, int) const {}
    __device__ __forceinline__ void fused(const f32x4 (&acc)[2][2][4][2], const Unit&, int wr, int wc, int fr, int fq, LAS unsigned char* lds) const {
        if (wc >= 2) return;
        LAS float* SC = (LAS float*)lds;
#pragma unroll
        for (int ai = 0; ai < 2; ++ai)
#pragma unroll
            for (int m = 0; m < 4; ++m) { const int row = ai * HALF + wr * 64 + m * 16 + fr;
#pragma unroll
                for (int n = 0; n < 2; ++n)
#pragma unroll
                    for (int j = 0; j < 4; ++j) SC[row * 65 + wc * 32 + n * 16 + 4 * fq + j] = sigmoidf_(acc[ai][0][m][n][j]); }
    } };
struct MoeSched { const LAS int* te; const int* sort; int NU, G, c, sh, per;
    __device__ __forceinline__ bool next(int i, Unit& u) const { const int L = i * G + c; if (L >= NU) return false; const int tile = L >> sh; u.pm = tile; u.pn = te[tile] * per + (L & (per - 1)); return true; }
    __device__ __forceinline__ int arow(int r) const { return sort ? sort[r] : r; }
    void* pts; __device__ __forceinline__ void* probe_ts() const { return pts; } };
struct EpiSwiglu { static constexpr bool PERM = true, AFTER_DRAIN = false, PROBE = false; bf16* ACT;
    __device__ __forceinline__ void operator()(const f32x4 (&acc)[2][2][4][2], const Unit& u, int wr, int wc, int fr, int fq) const {
        const int row0 = u.pm * BM + wr * 64 + fr, col0 = (u.pn & 1) * 128 + wc * 32 + 8 * fq;
#pragma unroll
        for (int ai = 0; ai < 2; ++ai)
#pragma unroll
            for (int m = 0; m < 4; ++m) { bf16* rowp = ACT + (size_t)(row0 + ai * HALF + m * 16) * DE + col0;
                const f32x4 g0 = acc[ai][0][m][0], g1 = acc[ai][0][m][1], u0 = acc[ai][1][m][0], u1 = acc[ai][1][m][1];
                float o[8];
#pragma unroll
                for (int q = 0; q < 4; ++q) { o[q] = siluf_(g0[q] * G1_INV) * (u0[q] * G1_INV); o[4 + q] = siluf_(g1[q] * G1_INV) * (u1[q] * G1_INV); }
                u32x4 w; w.x = cvt_pk_bf16(o[0], o[1]); w.y = cvt_pk_bf16(o[2], o[3]); w.z = cvt_pk_bf16(o[4], o[5]); w.w = cvt_pk_bf16(o[6], o[7]);
                *(u32x4*)rowp = w; }
    } };
__device__ __forceinline__ int moe_tables(const Params& p, int ch, LAS unsigned char* lds, int tid) {
    LAS int* TE = (LAS int*)(lds + LDS_TAB);
    const int* TEG = (const int*)(p.ws + WS_TEG) + (size_t)ch * (MAXTILES + 64);
    __syncthreads();
#pragma unroll 1
    for (int i = tid; i <= MAXTILES; i += NTHR) TE[i] = TEG[i];
    __syncthreads();
    return TE[MAXTILES];
}

__device__ __forceinline__ void ph_route_a(const Params& p, int l, const float* LOG, int tile, LAS unsigned char* lds, int tid) {
    LAS float* SC = (LAS float*)lds;
    LAS float* RBs = (LAS float*)(lds + 68 * 1024);
    LAS unsigned* MASK = (LAS unsigned*)(lds + 69 * 1024);
    const int b = tile, tok0 = 256 * b;
    if (LOG)
#pragma unroll 1
    for (int i = tid; i < 256 * 64; i += NTHR) { const int t = i >> 6, e = i & 63; SC[t * 65 + e] = sigmoidf_(LOG[(size_t)(tok0 + t) * 64 + e]); }
    if (tid < 64) RBs[tid] = p.in[I_RB][l * 64 + tid];
    MASK[tid] = 0u;
    __syncthreads();
    int eidx[8]; float wts[8];
    if (tid < 256) { const int t = tid; const LAS float* sc = SC + t * 65;
        float gs[8], bv[64];
#pragma unroll
        for (int g = 0; g < 8; ++g) { float m1 = -3.0e38f, m2 = -3.0e38f;
#pragma unroll
            for (int j = 0; j < 8; ++j) { const float v = sc[8 * g + j] + RBs[8 * g + j]; bv[8 * g + j] = v; if (v > m1) { m2 = m1; m1 = v; } else if (v > m2) m2 = v; }
            gs[g] = m1 + m2; }
        unsigned gmask = 0u;
#pragma unroll
        for (int r = 0; r < 4; ++r) { float best = -3.0e38f; int bi = 0; bool found = false;
#pragma unroll
            for (int g = 0; g < 8; ++g) { const bool free_ = ((gmask >> g) & 1u) == 0u; if (free_ && (!found || gs[g] > best)) { best = gs[g]; bi = g; found = true; } }
            gmask |= 1u << bi; }
#pragma unroll
        for (int e = 0; e < 64; ++e) if (((gmask >> (e >> 3)) & 1u) == 0u) bv[e] = -3.0e38f;
        unsigned long long taken = 0ull; float ssum = 0.f;
#pragma unroll
        for (int k = 0; k < 8; ++k) { float best = -3.0e38f; int be = 0; bool found = false;
#pragma unroll
            for (int e = 0; e < 64; ++e) { const bool ok = ((taken >> e) & 1ull) == 0ull; if (ok && (!found || bv[e] > best)) { best = bv[e]; be = e; found = true; } }
            taken |= 1ull << be; eidx[k] = be; wts[k] = sc[be]; ssum += wts[k]; }
        const float inv = 2.5f / ssum;
#pragma unroll
        for (int k = 0; k < 8; ++k) { wts[k] *= inv; __hip_atomic_fetch_or(&MASK[eidx[k] * 8 + (t >> 5)], 1u << (t & 31), __ATOMIC_RELAXED, __HIP_MEMORY_SCOPE_WORKGROUP); }
    }
    __syncthreads();
    if (tid < 256) { const int t = tid; int* EIDX = (int*)(p.ws + WS_EIDX); float* WTS = (float*)(p.ws + WS_WTS);
#pragma unroll
        for (int k = 0; k < 8; ++k) { const int e = eidx[k]; int r = 0;
#pragma unroll 1
            for (int w = 0; w < (t >> 5); ++w) r += __popc(MASK[e * 8 + w]);
            r += __popc(MASK[e * 8 + (t >> 5)] & ((1u << (t & 31)) - 1u));
            EIDX[(size_t)(tok0 + t) * 8 + k] = e | (r << 8); WTS[(size_t)(tok0 + t) * 8 + k] = wts[k]; } }
    if (tid < 64) { int c = 0;
#pragma unroll
        for (int w = 0; w < 8; ++w) c += __popc(MASK[tid * 8 + w]);
        ((int*)(p.ws + WS_BC))[b * 64 + tid] = c; }
    __syncthreads();
}
__device__ __forceinline__ void ph_route_b(const Params& p, LAS unsigned char* lds, int tid) {
    LAS int* BCS = (LAS int*)lds;
    LAS int* CNT = BCS + BPC * 64; LAS int* PRE = CNT + 64; LAS int* SEG = PRE + 64;
    const int b = blockIdx.x, ch = b / BPC, bl = b % BPC;
    const int* BC = (const int*)(p.ws + WS_BC) + (size_t)ch * BPC * 64;
#pragma unroll 16
    for (int i = tid; i < BPC * 64; i += NTHR) BCS[i] = BC[i];
    __syncthreads();
    if (tid < 64) { int c = 0, pr = 0;
#pragma unroll 16
        for (int i = 0; i < BPC; ++i) { const int v = BCS[i * 64 + tid]; c += v; if (i < bl) pr += v; } CNT[tid] = c; PRE[tid] = pr; }
    __syncthreads();
    if (tid == 0) { int base = 0;
#pragma unroll 1
        for (int e = 0; e < 64; ++e) { SEG[e] = base; base += ((CNT[e] + 255) >> 8) << 8; } SEG[64] = base; }
    __syncthreads();
    int* SORT = (int*)(p.ws + WS_SORT) + (size_t)ch * CHROWS; int* PSLOT = (int*)(p.ws + WS_PSLOT); const int* EIDX = (const int*)(p.ws + WS_EIDX);
    if (tid < 256) { const int tok = 256 * b + tid;
#pragma unroll
        for (int k = 0; k < 8; ++k) { const int w = EIDX[(size_t)tok * 8 + k], e = w & 255, r = w >> 8; const int slot = SEG[e] + PRE[e] + r; SORT[slot] = tok; PSLOT[(size_t)tok * 16 + k] = slot; }
        const int s8 = SEG[64] + (tok - ch * CHT); SORT[s8] = tok; PSLOT[(size_t)tok * 16 + 8] = s8; }
    if (bl == 0) {
        int* TEG = (int*)(p.ws + WS_TEG) + (size_t)ch * (MAXTILES + 64); const int NT = (SEG[64] >> 8) + CHT / 256;
#pragma unroll 1
        for (int i = tid; i < NT; i += NTHR) { int e = 0;
#pragma unroll 1
            while (e < 64 && (i << 8) >= SEG[e + 1]) ++e;
            TEG[i] = e; }
        if (tid == 0) TEG[MAXTILES] = NT; }
    if (bl < 64) { const int e = bl, lo = SEG[e] + CNT[e], hi = SEG[e] + (((CNT[e] + 255) >> 8) << 8); for (int s = lo + tid; s < hi; s += NTHR) SORT[s] = ch * CHT; }
    __syncthreads();
}

typedef float f32x16 __attribute__((ext_vector_type(16)));
__device__ __forceinline__ void ph_sconv(const Params& p, const bf16* UT, bf16* UC, int tid) {
    const float* cw = p.in[I_CONVHYW]; const float* cbias = p.in[I_CONVHYB];
    const unsigned NIT = 3072u * 32u * 256u; const unsigned gt = blockIdx.x * NTHR + tid, NG = gridDim.x * NTHR;
#pragma unroll 1
    for (unsigned it = gt; it < NIT; it += NG) {
        const unsigned c = it >> 13, k = it & 255u; const size_t base = (size_t)it * 8;
        const v4u w = *(const v4u*)(UT + base);
        const float w0 = cw[c], w1 = cw[3072 + c], w2 = cw[6144 + c], bb = cbias[c];
        float x[10];
        x[0] = k > 0 ? bf1(UT[base - 1]) : 0.f; x[9] = k < 255 ? bf1(UT[base + 8]) : 0.f;
        x[1] = bf_lo(w.x); x[2] = bf_hi(w.x); x[3] = bf_lo(w.y); x[4] = bf_hi(w.y); x[5] = bf_lo(w.z); x[6] = bf_hi(w.z); x[7] = bf_lo(w.w); x[8] = bf_hi(w.w);
        float o[8];
#pragma unroll
        for (int j = 0; j < 8; ++j) o[j] = bb + w0 * x[j] + w1 * x[j + 1] + w2 * x[j + 2];
        v4u r; r.x = pk2(o[0], o[1]); r.y = pk2(o[2], o[3]); r.z = pk2(o[4], o[5]); r.w = pk2(o[6], o[7]);
        *(v4u*)(UC + base) = r;
    }
}
constexpr int LC_CPB = 8224, LC_RAW = 8 * LC_CPB, LC_RAWSZ = 32 * 512, LC_HALO = LC_RAW + 2 * LC_RAWSZ, LC_VBP = 528, LC_VB0 = LC_HALO + 2 * 8192, LC_VBSZ = 32 * LC_VBP;
static_assert(LC_VB0 + 2 * LC_VBSZ <= LDS_MISC && 8 * 32 * 528 <= LDS_MISC, "lconv LDS map");
struct Taps { float w0, w1, w2, b; };
__device__ __forceinline__ float bfh(unsigned w, int hi) { return hi ? bf_hi(w) : bf_lo(w); }
template <bool CONVIN>
__device__ __forceinline__ void lconv_unit(const bf16* vin, const Taps ti, const bf16* F, const bf16* graw, const Taps tg, float fb, bf16* out, LAS unsigned char* lds, int tid, int lane, int wave) {
    __syncthreads();
#define LC_DMA(ch, rb) do { _Pragma("unroll") for (int q = 0; q < 2; ++q) { const int row = wave * 4 + 2 * q + (ln >> 5); \
        __builtin_amdgcn_global_load_lds((const unsigned*)(vin + (size_t)row * 2048 + (ch) * 256 + (ln & 31) * 8), (LAS unsigned*)(lds + LC_RAW + (rb) * LC_RAWSZ + (wave * 4 + 2 * q) * 512), 16, 0, 0); } \
        { const int hrow = wave * 4 + ((ln & 7) >> 1); int hs = (ln & 1) ? (ch) * 256 + 256 : (ch) * 256 - 8; hs = hs < 0 ? 0 : (hs > 2040 ? 2040 : hs); \
          __builtin_amdgcn_global_load_lds((const unsigned*)(vin + (size_t)hrow * 2048 + hs), (LAS unsigned*)(lds + LC_HALO + (rb) * 8192 + wave * 1024), 16, 0, 0); } } while (0)
    LAS bf16* Fl = (LAS bf16*)(lds + LC_VB0 + LC_VBSZ);
    { int ln = lane; asm volatile("" : "+v"(ln)); LC_DMA(0, 0); LC_DMA(1, 1); }
    if (tid < 256) *(LAS v4u*)(Fl + tid * 8) = *(const v4u*)(F + tid * 8);
    __syncthreads();
    if (tid == 0) Fl[1024] = (bf16)f2bf(bf1(Fl[1024]) + fb);
    __syncthreads();
#pragma unroll 1
    for (int a = 0; a < 8; ++a)
#pragma unroll 1
        for (int mi = tid; mi < 2056; mi += NTHR) { const int m = mi * 2; const int x0 = 3079 - m - a, x1 = x0 - 1;
            const unsigned lo = (x0 >= 0 && x0 <= 2047) ? (unsigned)Fl[x0] : 0u, hi = (x1 >= 0 && x1 <= 2047) ? (unsigned)Fl[x1] : 0u;
            *(LAS unsigned*)(lds + a * LC_CPB + m * 2) = lo | (hi << 16); }
    const int r = lane & 31, h = lane >> 5, a = (7 - r) & 7;
    const LAS unsigned char* cpA = lds + a * LC_CPB + 2 * (1023 - r + 8 * h - a + 1032) - 512 * wave;
    const int laneB = r * LC_VBP + 16 * h;
#define LC_CONVERT(ch, rb, buf) do { _Pragma("unroll") for (int q = 0; q < 2; ++q) { const int pid = ln + 64 * q, row = wave * 4 + (pid >> 5), pp = pid & 31; const LAS unsigned char* rp = lds + LC_RAW + (rb) * LC_RAWSZ + row * 512 + pp * 16; \
        const v4u w = *(const LAS v4u*)rp; v4u o = w; \
        if (CONVIN) { const LAS unsigned char* hp_ = lds + LC_HALO + (rb) * 8192 + wave * 1024 + (pid >> 5) * 32; float x[10]; \
            x[0] = pp > 0 ? bf1(*(const LAS bf16*)(rp - 2)) : ((ch) > 0 ? bf1(*(const LAS bf16*)(hp_ + 14)) : 0.f); x[9] = pp < 31 ? bf1(*(const LAS bf16*)(rp + 16)) : ((ch) < 7 ? bf1(*(const LAS bf16*)(hp_ + 16)) : 0.f); \
            x[1] = bf_lo(w.x); x[2] = bf_hi(w.x); x[3] = bf_lo(w.y); x[4] = bf_hi(w.y); x[5] = bf_lo(w.z); x[6] = bf_hi(w.z); x[7] = bf_lo(w.w); x[8] = bf_hi(w.w); \
            float y[8]; _Pragma("unroll") for (int j = 0; j < 8; ++j) y[j] = ti.b + ti.w0 * x[j] + ti.w1 * x[j + 1] + ti.w2 * x[j + 2]; \
            o.x = pk2(y[0], y[1]); o.y = pk2(y[2], y[3]); o.z = pk2(y[4], y[5]); o.w = pk2(y[6], y[7]); } \
        *(LAS v4u*)(lds + LC_VB0 + (buf) * LC_VBSZ + row * LC_VBP + pp * 16) = o; } } while (0)
    { int ln = lane; asm volatile("" : "+v"(ln));
    asm volatile("s_waitcnt vmcnt(3)" ::: "memory");
    LC_CONVERT(0, 0, 0); }
    asm volatile("s_waitcnt lgkmcnt(0)" ::: "memory"); __builtin_amdgcn_s_barrier(); asm volatile("" ::: "memory");
    f32x16 acc[8];
#pragma unroll
    for (int i = 0; i < 8; ++i)
#pragma unroll
        for (int q = 0; q < 16; ++q) acc[i][q] = 0.f;
    bf16x8 E[8], O[8];
    bool primed = false;
#pragma unroll 1
    for (int ch = 0; ch < 8; ++ch) {
        int ln = lane; asm volatile("" : "+v"(ln));
        if (ch < 6) LC_DMA(ch + 2, ch & 1);
        const int du = wave - ch;
        if (du >= -4 && du <= 4) {
            const LAS unsigned char* ca = cpA + 64 * (ch * 8); const LAS unsigned char* vbh = lds + LC_VB0 + (ch & 1) * LC_VBSZ + laneB;
            if (!primed) { primed = true;
#pragma unroll
                for (int i = 1; i < 8; ++i) { E[(8 - i) & 7] = *(const LAS bf16x8*)(ca + 32 * (-2 * i)); O[(8 - i) & 7] = *(const LAS bf16x8*)(ca + 32 * (-2 * i + 1)); }
                E[0] = *(const LAS bf16x8*)ca; O[0] = *(const LAS bf16x8*)(ca + 32); }
            bf16x8 bc0 = *(const LAS bf16x8*)vbh, bc1 = *(const LAS bf16x8*)(vbh + 32);
#pragma unroll
            for (int mm = 0; mm < 8; ++mm) {
                bf16x8 bn0 = bc0, bn1 = bc1;
                if (mm < 7) { bn0 = *(const LAS bf16x8*)(vbh + 64 * (mm + 1)); bn1 = *(const LAS bf16x8*)(vbh + 64 * (mm + 1) + 32); }
                acc[7] = __builtin_amdgcn_mfma_f32_32x32x16_bf16(E[(mm + 1) & 7], bc0, acc[7], 0, 0, 0);
                E[(mm + 1) & 7] = *(const LAS bf16x8*)(ca + 64 * (mm + 1));
#pragma unroll
                for (int i = 0; i < 7; ++i) acc[i] = __builtin_amdgcn_mfma_f32_32x32x16_bf16(E[(mm - i) & 7], bc0, acc[i], 0, 0, 0);
                acc[7] = __builtin_amdgcn_mfma_f32_32x32x16_bf16(O[(mm + 1) & 7], bc1, acc[7], 0, 0, 0);
                O[(mm + 1) & 7] = *(const LAS bf16x8*)(ca + 64 * (mm + 1) + 32);
#pragma unroll
                for (int i = 0; i < 7; ++i) acc[i] = __builtin_amdgcn_mfma_f32_32x32x16_bf16(O[(mm - i) & 7], bc1, acc[i], 0, 0, 0);
                bc0 = bn0; bc1 = bn1;
            }
        }
        if (ch < 7) { if (ch < 6) asm volatile("s_waitcnt vmcnt(3)" ::: "memory"); else asm volatile("s_waitcnt vmcnt(0)" ::: "memory"); LC_CONVERT(ch + 1, (ch + 1) & 1, (ch + 1) & 1); }
        asm volatile("s_waitcnt lgkmcnt(0)" ::: "memory"); __builtin_amdgcn_s_barrier(); asm volatile("" ::: "memory");
    }
#undef LC_DMA
#undef LC_CONVERT
    { int le = lane; asm volatile("" : "+v"(le)); const int re = le & 31, he = le >> 5;
      LAS unsigned char* tw = lds + wave * (32 * 528);
#pragma unroll
      for (int i = 0; i < 8; ++i)
#pragma unroll
          for (int g = 0; g < 4; ++g) { v2u w; w.x = pk2(acc[i][4 * g + 0], acc[i][4 * g + 1]); w.y = pk2(acc[i][4 * g + 2], acc[i][4 * g + 3]); *(LAS v2u*)(tw + re * 528 + (32 * i + 8 * g + 4 * he) * 2) = w; }
      LDS_WAIT(); asm volatile("" ::: "memory");
      const int pp = le & 31;
      v4u gwa[16]; float hal[16];
      const bool hprev = pp == 0 && wave > 0, hnext = pp == 31 && wave < 7;
#pragma unroll
      for (int it = 0; it < 16; ++it) { const size_t off = (size_t)(2 * it + (le >> 5)) * 2048 + 256 * wave + pp * 8; gwa[it] = *(const v4u*)(graw + off);
          hal[it] = (hprev || hnext) ? bf1(graw[hprev ? off - 1 : off + 8]) : 0.f; }
#pragma unroll
      for (int it = 0; it < 16; ++it) { const int row = 2 * it + (le >> 5); const size_t off = (size_t)row * 2048 + 256 * wave + pp * 8;
          const v4u gw = gwa[it]; const v4u aw = *(const LAS v4u*)(tw + row * 528 + pp * 16);
          const float hp = hal[it], hn = hal[it];
          float gx[10]; gx[1] = bf_lo(gw.x); gx[2] = bf_hi(gw.x); gx[3] = bf_lo(gw.y); gx[4] = bf_hi(gw.y); gx[5] = bf_lo(gw.z); gx[6] = bf_hi(gw.z); gx[7] = bf_lo(gw.w); gx[8] = bf_hi(gw.w);
          const float fromprev = shidx(gx[8], le - 1), fromnext = shidx(gx[1], le + 1);
          gx[0] = pp > 0 ? fromprev : hp; gx[9] = pp < 31 ? fromnext : hn;
          const float av[8] = {bf_lo(aw.x), bf_hi(aw.x), bf_lo(aw.y), bf_hi(aw.y), bf_lo(aw.z), bf_hi(aw.z), bf_lo(aw.w), bf_hi(aw.w)};
          float o[8];
#pragma unroll
          for (int j = 0; j < 8; ++j) o[j] = (tg.b + tg.w0 * gx[j] + tg.w1 * gx[j + 1] + tg.w2 * gx[j + 2]) * av[j];
          v4u w; w.x = pk2(o[0], o[1]); w.y = pk2(o[2], o[3]); w.z = pk2(o[4], o[5]); w.w = pk2(o[6], o[7]);
          *(v4u*)(out + off) = w; }
    }
}
template <bool CONVIN>
__device__ __forceinline__ void ph_lconv(const Params& p, int o, const bf16* IN, const bf16* UT, bf16* OUT, LAS unsigned char* lds, int tid, int lane, int wave) {
    const bf16* FILT = (const bf16*)(p.ws + WS_FILT); const float* cw = p.in[I_CONVHYW]; const float* cbias = p.in[I_CONVHYB];
#pragma unroll 1
    for (int c = blockIdx.x; c < 1024; c += gridDim.x) { const int gc = (1 + o) * 1024 + c;
        const Taps ti{cw[c], cw[3072 + c], cw[6144 + c], cbias[c]}, tg{cw[gc], cw[3072 + gc], cw[6144 + gc], cbias[gc]};
        lconv_unit<CONVIN>(IN + (size_t)c * T, ti, FILT + (size_t)(o * 1024 + c) * 2048, UT + (size_t)gc * T, tg, p.in[I_FBIAS][o * 1024 + c], OUT + (size_t)c * T, lds, tid, lane, wave); }
}
__device__ __forceinline__ void ph_transpose(const bf16* Y2T, bf16* Y2, LAS unsigned char* lds, int lane, int wave, int panel) {
    LAS unsigned char* tl = lds + wave * 16384;
    v4u cur[8], nxt[8];
#define TP_LOAD(dst, tile_) do { const int c0_ = ((tile_) & 15) * 64, t0_ = panel * 256 + ((tile_) >> 4) * 64; _Pragma("unroll") for (int rr = 0; rr < 8; ++rr) \
        dst[rr] = *(const v4u*)(Y2T + (size_t)(c0_ + rr * 8 + (lane >> 3)) * T + t0_ + (lane & 7) * 8); } while (0)
    TP_LOAD(cur, wave);
#pragma unroll 1
    for (int tile = wave; tile < 64; tile += NWAVES) { const int c0 = (tile & 15) * 64, t0 = panel * 256 + (tile >> 4) * 64;
        if (tile + NWAVES < 64) TP_LOAD(nxt, tile + NWAVES);
#pragma unroll
        for (int rr = 0; rr < 8; ++rr) { LAS unsigned* d = (LAS unsigned*)(tl + (rr * 8 + (lane >> 3)) * 132 + (lane & 7) * 16); d[0] = cur[rr].x; d[1] = cur[rr].y; d[2] = cur[rr].z; d[3] = cur[rr].w; }
        LDS_WAIT(); asm volatile("" ::: "memory");
#pragma unroll
        for (int rr = 0; rr < 8; ++rr) { const int tk = rr * 8 + (lane >> 3), cp = (lane & 7) * 8;
            unsigned short e[8];
#pragma unroll
            for (int j = 0; j < 8; ++j) e[j] = *(const LAS unsigned short*)(tl + (cp + j) * 132 + tk * 2);
            v4u w; w.x = e[0] | ((unsigned)e[1] << 16); w.y = e[2] | ((unsigned)e[3] << 16); w.z = e[4] | ((unsigned)e[5] << 16); w.w = e[6] | ((unsigned)e[7] << 16);
            *(v4u*)(Y2 + (size_t)(t0 + tk) * D + c0 + cp) = w; }
        LDS_WAIT(); asm volatile("" ::: "memory");
#pragma unroll
        for (int rr = 0; rr < 8; ++rr) cur[rr] = nxt[rr];
    }
#undef TP_LOAD
}

constexpr float QSCALE = 0.125f * 1.4426950408889634f;
struct InprojSched { int G, c;
    __device__ __forceinline__ bool next(int i, Unit& u) const { const int L = i * G + c; if (L >= 3840 + 288) return false;
        if (L < 3840) { u.pm = L / 15; u.pn = L % 15; } else { const int q = L - 3840; u.pm = 256 + q / 9; u.pn = 6 + q % 9; } return true; }
    __device__ __forceinline__ int arow(int r) const { return r; }
    __device__ __forceinline__ void* probe_ts() const { return nullptr; } };
struct EpiInproj { static constexpr bool PERM = true, AFTER_DRAIN = false, PROBE = false; unsigned char* big; const float* rope; float* gates; const float* gate_b;
    __device__ __forceinline__ void operator()(const f32x4 (&acc)[2][2][4][2], const Unit& u, int wr, int wc, int fr, int fq) const {
        const bool ctx = u.pm >= 256; const int b = ctx ? u.pm - 256 : (u.pm >> 3), r0 = ctx ? 0 : (u.pm & 7) * 256;
        if (u.pn == 14) {
            if (wc != 0 || fq >= 2) return;
            const f32x4 gb0 = *(const f32x4*)(gate_b + 8 * fq), gb1 = *(const f32x4*)(gate_b + 8 * fq + 4);
#pragma unroll
            for (int ai = 0; ai < 2; ++ai)
#pragma unroll
                for (int m = 0; m < 4; ++m) { const int rr = r0 + wr * 64 + fr + ai * HALF + m * 16; const size_t grow = ctx ? (size_t)T + b * LC + rr : (size_t)b * SEQ + rr;
                    float* gp = gates + grow * 16 + 8 * fq; *(f32x4*)gp = acc[ai][0][m][0] + gb0; *(f32x4*)(gp + 4) = acc[ai][0][m][1] + gb1; }
            return; }
        const int t = u.pn >> 1;
        constexpr size_t offs[7] = {A0_QA, A0_BQ, A0_BO, A0_KA, A0_VA, A0_BK, A0_BV};
        const bool kv = t >= 3;
        size_t toff = A0_QA;
#pragma unroll
        for (int q = 0; q < 7; ++q) if (t == q) toff = offs[q];
        bf16* O = (bf16*)(big + toff) + (size_t)b * (kv ? (SEQ + LC) : SEQ) * 512 + (size_t)((kv && !ctx) ? LC : 0) * 512;
        const bool rope_on = (t == 0 || t == 3) && !ctx; const float qs = t == 0 ? QSCALE : 1.f;
        const int col0 = (u.pn & 1) * 256 + wc * 32 + 8 * fq;
#pragma unroll
        for (int ai = 0; ai < 2; ++ai)
#pragma unroll
            for (int m = 0; m < 4; ++m) { const int rr = r0 + wr * 64 + fr + ai * HALF + m * 16; bf16* rowp = O + (size_t)rr * 512 + col0;
                f32x4 cs0 = (f32x4){1.f, 0.f, 1.f, 0.f}, cs1 = cs0;
                if (rope_on) { const int pos = (wc & 1) ? (rr & 63) : (rr >> 6); const float* rp = rope + (size_t)(pos * 16 + 4 * fq) * 2; cs0 = *(const f32x4*)rp; cs1 = *(const f32x4*)(rp + 4); }
#pragma unroll
                for (int bj = 0; bj < 2; ++bj) { const f32x4 x0 = acc[ai][bj][m][0], x1 = acc[ai][bj][m][1];
                    f32x4 o0, o1;
                    o0[0] = x0[0] * cs0[0] - x1[0] * cs0[1]; o1[0] = x1[0] * cs0[0] + x0[0] * cs0[1];
                    o0[1] = x0[1] * cs0[2] - x1[1] * cs0[3]; o1[1] = x1[1] * cs0[2] + x0[1] * cs0[3];
                    o0[2] = x0[2] * cs1[0] - x1[2] * cs1[1]; o1[2] = x1[2] * cs1[0] + x0[2] * cs1[1];
                    o0[3] = x0[3] * cs1[2] - x1[3] * cs1[3]; o1[3] = x1[3] * cs1[2] + x0[3] * cs1[3];
                    o0 = o0 * qs; o1 = o1 * qs;
                    u32x4 w; w.x = cvt_pk_bf16(o0[0], o0[1]); w.y = cvt_pk_bf16(o0[2], o0[3]); w.z = cvt_pk_bf16(o1[0], o1[1]); w.w = cvt_pk_bf16(o1[2], o1[3]);
                    *(u32x4*)(rowp + bj * HALF) = w; } }
    } };
__device__ __forceinline__ void ph_transpose_b(const bf16* src, bf16* dst, int NBt, int R, int C, LAS unsigned char* lds, int lane, int wave) {
    LAS unsigned char* tl = lds + wave * 16384;
    const int gw = blockIdx.x * NWAVES + wave, NGW = gridDim.x * NWAVES; const int tr = R / 64, tc = C / 64, per = tr * tc;
#pragma unroll 1
    for (int tile = gw; tile < NBt * per; tile += NGW) { const int bt = tile / per, q = tile % per, c0 = (q % tc) * 64, r0 = (q / tc) * 64;
        const bf16* s = src + (size_t)bt * R * C; bf16* d = dst + (size_t)bt * R * C;
#pragma unroll
        for (int rr = 0; rr < 8; ++rr) { const int row = rr * 8 + (lane >> 3), pc = lane & 7;
            *(LAS v4u*)(tl + row * 144 + pc * 16) = *(const v4u*)(s + (size_t)(r0 + row) * C + c0 + pc * 8); }
        LDS_WAIT(); asm volatile("" ::: "memory");
#pragma unroll
        for (int rr = 0; rr < 8; ++rr) { const int cc = rr * 8 + (lane >> 3), rp = (lane & 7) * 8;
            unsigned short e[8];
#pragma unroll
            for (int j = 0; j < 8; ++j) e[j] = *(const LAS unsigned short*)(tl + (rp + j) * 144 + cc * 2);
            v4u w; w.x = e[0] | ((unsigned)e[1] << 16); w.y = e[2] | ((unsigned)e[3] << 16); w.z = e[4] | ((unsigned)e[5] << 16); w.w = e[6] | ((unsigned)e[7] << 16);
            *(v4u*)(d + (size_t)(c0 + cc) * R + r0 + rp) = w; }
        LDS_WAIT(); asm volatile("" ::: "memory");
    }
}

typedef short s16x4 __attribute__((ext_vector_type(4)));
__device__ __forceinline__ u32x2 tr16(const LAS unsigned char* p) { return __builtin_bit_cast(u32x2, __builtin_amdgcn_ds_read_tr16_b64_v4i16((LAS s16x4*)p)); }
typedef float f32x2 __attribute__((ext_vector_type(2)));
constexpr int AT_KP = 272, AT_VP = 320  , AT_KB = 64 * AT_KP, AT_VB = 64 * AT_VP, AT_V0 = 2 * AT_KB;
__device__ __forceinline__ void ph_attn(const Params& p, unsigned char* big, LAS unsigned char* lds, int tid, int lane, int wave, int vcu) {
    const bf16* QA = (const bf16*)(big + A0_QA); const bf16* KA = (const bf16*)(big + A0_KA); const bf16* VA = (const bf16*)(big + A0_VA); bf16* MIXIN = (bf16*)(big + A0_MIXIN);
    const int blk = (lane >> 4) & 1, tq = (lane & 15) >> 2, tp = lane & 3;
    const int comp = wave >> 2, qw = wave & 3, r = lane & 31, hh = lane >> 5;
    float lam; { const float* lv = p.in[I_DLAM]; const float a = wave_sum(lv[lane] * lv[64 + lane]), b2 = wave_sum(lv[128 + lane] * lv[192 + lane]); lam = expf(a) - expf(b2) + 0.2f; }
#pragma unroll 1
    for (int unit = vcu; unit < 2048; unit += gridDim.x) {
        const int b = unit >> 6, h = (unit >> 4) & 3, qblk = unit & 15, q0 = qblk * 128 + qw * 32;
        const bf16* Kg = KA + (size_t)b * (SEQ + LC) * 512 + h * 128; const bf16* Vg = VA + (size_t)b * (SEQ + LC) * 512 + h * 128;
        bf16x8 qf[4];
#pragma unroll
        for (int ds = 0; ds < 4; ++ds) qf[ds] = *(const bf16x8*)(QA + ((size_t)b * SEQ + q0 + r) * 512 + h * 128 + comp * 64 + ds * 16 + hh * 8);
        f32x16 oacc[4];
#pragma unroll
        for (int i = 0; i < 4; ++i)
#pragma unroll
            for (int q = 0; q < 16; ++q) oacc[i][q] = 0.f;
        float m_run = 0.f, l_run = 0.f;
        v4u pre[4];
#define AT_LOADG(kt) do { _Pragma("unroll") for (int q = 0; q < 2; ++q) { const int idx = tid + NTHR * q; \
            pre[q] = *(const v4u*)(Kg + (size_t)((kt) * 64 + (idx >> 4)) * 512 + (idx & 15) * 8); \
            pre[2 + q] = *(const v4u*)(Vg + (size_t)((kt) * 64 + (idx >> 4)) * 512 + (idx & 15) * 8); } } while (0)
#define AT_STORES(kn) do { _Pragma("unroll") for (int q = 0; q < 2; ++q) { const int idx = tid + NTHR * q; \
            *(LAS v4u*)(lds + ((kn) & 1) * AT_KB + (idx >> 4) * AT_KP + (idx & 15) * 16) = pre[q]; \
            *(LAS v4u*)(lds + AT_V0 + ((kn) % 3) * AT_VB + (idx >> 4) * AT_VP + (idx & 15) * 16) = pre[2 + q]; } } while (0)
#define AT_PV(PF, VT_) do { const LAS unsigned char* Vt_ = (VT_); _Pragma("unroll") for (int kb = 0; kb < 2; ++kb) _Pragma("unroll") for (int s = 0; s < 2; ++s) _Pragma("unroll") for (int dvb = 0; dvb < 4; ++dvb) { \
            const LAS unsigned char* vp = Vt_ + (32 * kb + 16 * s + 4 * hh + tq) * AT_VP + (32 * dvb + 16 * blk + 4 * tp) * 2; const u32x2 lo = tr16(vp), hi = tr16(vp + 8 * AT_VP); \
            u32x4 vw; vw.x = lo.x; vw.y = lo.y; vw.z = hi.x; vw.w = hi.y; oacc[dvb] = __builtin_amdgcn_mfma_f32_32x32x16_bf16(__builtin_bit_cast(bf16x8, vw), PF[kb][s], oacc[dvb], 0, 0, 0); } } while (0)
        bf16x8 phold[2][2];
        __syncthreads();
        AT_LOADG(0); AT_STORES(0);
        __syncthreads();
#pragma unroll 1
        for (int kt = 0; kt < 36; ++kt) {
            if (kt < 35) AT_LOADG(kt + 1);
            const LAS unsigned char* Kt = lds + (kt & 1) * AT_KB;
            if (comp == 1 && kt > 0) { AT_PV(phold, lds + AT_V0 + ((kt - 1) % 3) * AT_VB); }
            f32x16 sacc[2];
#pragma unroll
            for (int kb = 0; kb < 2; ++kb)
#pragma unroll
                for (int q = 0; q < 16; ++q) sacc[kb][q] = -m_run;
#pragma unroll
            for (int ds = 0; ds < 4; ++ds)
#pragma unroll
                for (int kb = 0; kb < 2; ++kb) { const bf16x8 kf = *(const LAS bf16x8*)(Kt + (32 * kb + r) * AT_KP + comp * 128 + ds * 32 + hh * 16);
                    sacc[kb] = __builtin_amdgcn_mfma_f32_32x32x16_bf16(kf, qf[ds], sacc[kb], 0, 0, 0); }
            float mx = sacc[0][0];
#pragma unroll
            for (int kb = 0; kb < 2; ++kb)
#pragma unroll
                for (int q = 0; q < 16; ++q) mx = fmaxf(mx, sacc[kb][q]);
            mx = fmaxf(mx, shx(mx, 32));
            if (kt == 0 || __builtin_amdgcn_ballot_w64(mx > 0.f) != 0ull) {
                const float dm = kt == 0 ? mx : fmaxf(mx, 0.f), alpha = __builtin_amdgcn_exp2f(-dm); m_run += dm; l_run *= alpha;
#pragma unroll
                for (int kb = 0; kb < 2; ++kb) sacc[kb] = sacc[kb] - dm;
#pragma unroll
                for (int i = 0; i < 4; ++i) oacc[i] = oacc[i] * alpha; }
            f32x2 ps2 = (f32x2){0.f, 0.f};
#pragma unroll
            for (int kb = 0; kb < 2; ++kb)
#pragma unroll
                for (int q = 0; q < 8; ++q) { f32x2 e; e.x = __builtin_amdgcn_exp2f(sacc[kb][2 * q]); e.y = __builtin_amdgcn_exp2f(sacc[kb][2 * q + 1]); sacc[kb][2 * q] = e.x; sacc[kb][2 * q + 1] = e.y; ps2 += e; }
            l_run += ps2.x + ps2.y;
#pragma unroll
            for (int kb = 0; kb < 2; ++kb)
#pragma unroll
                for (int s = 0; s < 2; ++s) {
                    u32x4 pw; pw.x = cvt_pk_bf16(sacc[kb][8 * s + 0], sacc[kb][8 * s + 1]); pw.y = cvt_pk_bf16(sacc[kb][8 * s + 2], sacc[kb][8 * s + 3]);
                    pw.z = cvt_pk_bf16(sacc[kb][8 * s + 4], sacc[kb][8 * s + 5]); pw.w = cvt_pk_bf16(sacc[kb][8 * s + 6], sacc[kb][8 * s + 7]);
                    phold[kb][s] = __builtin_bit_cast(bf16x8, pw); }
            if (comp == 0) { AT_PV(phold, lds + AT_V0 + (kt % 3) * AT_VB); }
            if (kt < 35) AT_STORES(kt + 1);
            __syncthreads();
        }
        if (comp == 1) { AT_PV(phold, lds + AT_V0 + (35 % 3) * AT_VB); }
        __syncthreads();
#undef AT_LOADG
#undef AT_STORES
#undef AT_PV
        const float lsum = l_run + shx(l_run, 32), inv = __builtin_amdgcn_rcpf(lsum);
        LAS float* X = (LAS float*)lds;
        if (comp == 1) {
#pragma unroll
            for (int dvb = 0; dvb < 4; ++dvb)
#pragma unroll
                for (int q = 0; q < 16; ++q) X[(qw * 64 + dvb * 16 + q) * 64 + lane] = oacc[dvb][q] * inv; }
        __syncthreads();
        if (comp == 0) {
            float ss = 0.f;
#pragma unroll
            for (int dvb = 0; dvb < 4; ++dvb)
#pragma unroll
                for (int q = 0; q < 16; ++q) { const float o = oacc[dvb][q] * inv - lam * X[(qw * 64 + dvb * 16 + q) * 64 + lane]; oacc[dvb][q] = o; ss += o * o; }
            ss += shx(ss, 32);
            const float rn = rsqrtf(ss * (1.f / 128.f) + RMS_EPS) * 0.8f;
            const float* ga = p.in[I_HGA] + h * 128; bf16* orow = MIXIN + ((size_t)b * SEQ + q0 + r) * D + h * 128;
#pragma unroll
            for (int dvb = 0; dvb < 4; ++dvb)
#pragma unroll
                for (int g = 0; g < 4; ++g) { const int dv = 32 * dvb + 8 * g + 4 * hh; const f32x4 gg = *(const f32x4*)(ga + dv);
                    v2u w; w.x = pk2(oacc[dvb][4 * g + 0] * rn * gg[0], oacc[dvb][4 * g + 1] * rn * gg[1]); w.y = pk2(oacc[dvb][4 * g + 2] * rn * gg[2], oacc[dvb][4 * g + 3] * rn * gg[3]);
                    *(v2u*)(orow + dv) = w; }
        }
    }
    __syncthreads();
}

constexpr int ML_P = 272, ML_TILE = 64 * ML_P;
constexpr int ML_VOFF = 3 * ML_TILE, ML_VSZ = 64 * 256;
constexpr int ML_RQ = ML_VOFF + 2 * ML_VSZ, ML_RSZ = 68 * 256, ML_RK = ML_RQ + ML_RSZ;
constexpr int ML_NOFF = ML_RK + ML_RSZ, ML_AOFF = ML_NOFF + 2 * 512;
constexpr int ML_CW = ML_AOFF + 8 * 256;
static_assert(ML_CW + 8 * 512 <= LDS_TAB, "mLSTM LDS map");
__device__ __forceinline__ float logsigmoidf_(float x) { return x >= 0.f ? -__logf(1.f + __expf(-x)) : x - __logf(1.f + __expf(x)); }
__device__ __forceinline__ bf16x8 pack8(const f32x16& v, int s) { u32x4 w; w.x = cvt_pk_bf16(v[8 * s + 0], v[8 * s + 1]); w.y = cvt_pk_bf16(v[8 * s + 2], v[8 * s + 3]); w.z = cvt_pk_bf16(v[8 * s + 4], v[8 * s + 5]); w.w = cvt_pk_bf16(v[8 * s + 6], v[8 * s + 7]); return __builtin_bit_cast(bf16x8, w); }
__device__ __forceinline__ void ph_mlstm(const Params& p, unsigned char* big, LAS unsigned char* lds, int tid, int lane, int wave) {
    const int bid = blockIdx.x; if (bid >= 256) return;
    const int b = bid >> 3, h = (bid >> 1) & 3, dir = bid & 1;
    const bf16* BQ = (const bf16*)(big + A0_BQ) + (size_t)b * SEQ * 512 + h * 128;
    const bf16* BK = (const bf16*)(big + A0_BK) + (size_t)b * (SEQ + LC) * 512 + h * 128;
    const bf16* BV = (const bf16*)(big + A0_BV) + (size_t)b * (SEQ + LC) * 512 + h * 128;
    bf16* HB = (bf16*)(big + A0_HB) + (size_t)dir * T * 512 + (size_t)b * SEQ * 512 + h * 128;
    const float* GT = (const float*)(p.ws + WS_GATES);
    const float* cw = p.in[I_CONVABW]; const float* cb = p.in[I_CONVABB];
    const int eb = wave & 3, tb = wave >> 2, r = lane & 31, hh = lane >> 5;
    const int blk = (lane >> 4) & 1, tq = (lane & 15) >> 2, tp = lane & 3;
    LAS float* nbuf = (LAS float*)(lds + ML_NOFF); LAS float* aw = (LAS float*)(lds + ML_AOFF) + wave * 64;
    if (tid < 256) nbuf[tid] = 0.f;
    LAS float* cwl = (LAS float*)(lds + ML_CW);
    for (int i = tid; i < 1024; i += NTHR) { const int ten = i >> 9, j = (i >> 7) & 3, d = i & 127, ch = ten * 512 + h * 128 + d; cwl[i] = j < 3 ? cw[j * 1024 + ch] : cb[ch]; }
    f32x16 cacc[4];
#pragma unroll
    for (int i = 0; i < 4; ++i)
#pragma unroll
        for (int q = 0; q < 16; ++q) cacc[i][q] = 0.f;
    float m_state = 0.f;
#ifdef ML_PROBE
    unsigned long long accs[7] = {0, 0, 0, 0, 0, 0, 0}; unsigned long long tp0 = __builtin_amdgcn_s_memrealtime();
#define ML_T(i) do { const unsigned long long t1_ = __builtin_amdgcn_s_memrealtime(); accs[i] += t1_ - tp0; tp0 = t1_; } while (0)
#else
#define ML_T(i)
#endif
    float a_c = 0.f, M_c = 0.f, b_c = 0.f, decay_c = 1.f, m_after = 0.f;
    float a_n = 0.f, M_n = 0.f, b_n = 0.f, w_n = 0.f, decay_n = 1.f, m_next = 0.f;
#define ML_POS(cc, t) ((cc) < 4 ? (dir ? 255 - ((cc) * 64 + (t)) : (cc) * 64 + (t)) : (dir ? 2047 - (((cc) - 4) * 64 + (t)) : ((cc) - 4) * 64 + (t)))
#define ML_GLOAD(cc, li_, fp_) do { const int pos_ = ML_POS(cc, lane); const size_t grow_ = (cc) < 4 ? (size_t)T + b * LC + pos_ : (size_t)b * SEQ + pos_; \
        li_ = GT[grow_ * 16 + dir * 8 + h]; fp_ = GT[grow_ * 16 + dir * 8 + 4 + h]; } while (0)
#define ML_SCAN(li_, fp_, m_in) do { const float lf_ = logsigmoidf_(fp_); \
        float bs_ = lf_; _Pragma("unroll") for (int o_ = 1; o_ < 64; o_ <<= 1) { const float v_ = shup(bs_, o_); if (lane >= o_) bs_ += v_; } \
        const float aa_ = (li_) - bs_; float pm_ = aa_; _Pragma("unroll") for (int o_ = 1; o_ < 64; o_ <<= 1) { const float v_ = shup(pm_, o_); if (lane >= o_) pm_ = fmaxf(pm_, v_); } \
        const float MM_ = fmaxf(m_in, pm_); const float M63_ = shidx(MM_, 63), b63_ = shidx(bs_, 63); \
        a_n = aa_; M_n = MM_; b_n = bs_; w_n = __expf(aa_ - M63_); decay_n = __expf((m_in) - M63_); m_next = b63_ + M63_; } while (0)
#define ML_DMA(cc, vbuf) do { const int lim_ = (cc) < 4 ? LC : SEQ, kvb_ = (cc) < 4 ? 0 : LC; \
        _Pragma("unroll 1") for (int ins_ = wave; ins_ < 17; ins_ += NWAVES) { const int rr_ = ins_ * 4 + (lane >> 4), pc_ = lane & 15; int pos_ = ML_POS(cc, rr_ - 1); pos_ = pos_ < 0 ? 0 : (pos_ >= lim_ ? lim_ - 1 : pos_); \
            __builtin_amdgcn_global_load_lds((const unsigned*)(BK + (size_t)(kvb_ + pos_) * 512 + pc_ * 8), (LAS unsigned*)(lds + ML_RK + ins_ * 1024), 16, 0, 0); \
            if ((cc) >= 4) __builtin_amdgcn_global_load_lds((const unsigned*)(BQ + (size_t)pos_ * 512 + pc_ * 8), (LAS unsigned*)(lds + ML_RQ + ins_ * 1024), 16, 0, 0); } \
        _Pragma("unroll") for (int q_ = 0; q_ < 2; ++q_) { const int ins_ = wave * 2 + q_, t_ = ins_ * 4 + (lane >> 4), pc_ = lane & 15; const int pos_ = ML_POS(cc, t_); \
            __builtin_amdgcn_global_load_lds((const unsigned*)(BV + (size_t)(kvb_ + pos_) * 512 + pc_ * 8), (LAS unsigned*)(lds + ML_VOFF + (vbuf) * ML_VSZ + ins_ * 1024), 16, 0, 0); } } while (0)
#define ML_CONV8(dst, rawoff, cc, t_, d8_, ten, scl) do { const int pos_ = ML_POS(cc, t_), lim_ = (cc) < 4 ? LC : SEQ; const int rm_ = dir ? (t_) + 2 : (t_), rp_ = dir ? (t_) : (t_) + 2; \
        v4u x_[3]; x_[0] = *(const LAS v4u*)(lds + (rawoff) + rm_ * 256 + (d8_) * 16); x_[1] = *(const LAS v4u*)(lds + (rawoff) + ((t_) + 1) * 256 + (d8_) * 16); x_[2] = *(const LAS v4u*)(lds + (rawoff) + rp_ * 256 + (d8_) * 16); \
        if (pos_ - 1 < 0) x_[0] = (v4u){0u, 0u, 0u, 0u}; if (pos_ + 1 >= lim_) x_[2] = (v4u){0u, 0u, 0u, 0u}; \
        const LAS float* wl_ = cwl + (ten) * 512 + (d8_) * 8; f32x4 wv_[4][2]; \
        _Pragma("unroll") for (int j_ = 0; j_ < 4; ++j_) { wv_[j_][0] = *(const LAS f32x4*)(wl_ + j_ * 128); wv_[j_][1] = *(const LAS f32x4*)(wl_ + j_ * 128 + 4); } \
        _Pragma("unroll") for (int e_ = 0; e_ < 8; ++e_) { float s_ = wv_[3][e_ >> 2][e_ & 3]; \
            _Pragma("unroll") for (int j_ = 0; j_ < 3; ++j_) { const unsigned w_ = e_ < 2 ? x_[j_].x : e_ < 4 ? x_[j_].y : e_ < 6 ? x_[j_].z : x_[j_].w; s_ += wv_[j_][e_ >> 2][e_ & 3] * ((e_ & 1) ? bf_hi(w_) : bf_lo(w_)); } \
            dst[e_] = s_ * __builtin_amdgcn_rcpf(1.f + __expf(-s_)) * (scl); } } while (0)
#define ML_BUILD(cc) do { _Pragma("unroll 1") for (int q_ = 0; q_ < 2; ++q_) { const int idx_ = tid + NTHR * q_, t_ = idx_ >> 4, d8_ = idx_ & 15; \
        float kk_[8]; ML_CONV8(kk_, ML_RK, cc, t_, d8_, 1, 1.f); const float wt_ = shidx(w_n, t_); \
        v4u o_; o_.x = pk2(kk_[0], kk_[1]); o_.y = pk2(kk_[2], kk_[3]); o_.z = pk2(kk_[4], kk_[5]); o_.w = pk2(kk_[6], kk_[7]); *(LAS v4u*)(lds + ML_TILE + t_ * ML_P + d8_ * 16) = o_; \
        o_.x = pk2(kk_[0] * wt_, kk_[1] * wt_); o_.y = pk2(kk_[2] * wt_, kk_[3] * wt_); o_.z = pk2(kk_[4] * wt_, kk_[5] * wt_); o_.w = pk2(kk_[6] * wt_, kk_[7] * wt_); *(LAS v4u*)(lds + 2 * ML_TILE + t_ * ML_P + d8_ * 16) = o_; \
        if ((cc) >= 4) { float qq_[8]; ML_CONV8(qq_, ML_RQ, cc, t_, d8_, 0, 0.08838834764831845f); \
            o_.x = pk2(qq_[0], qq_[1]); o_.y = pk2(qq_[2], qq_[3]); o_.z = pk2(qq_[4], qq_[5]); o_.w = pk2(qq_[6], qq_[7]); *(LAS v4u*)(lds + t_ * ML_P + d8_ * 16) = o_; } } } while (0)
    __syncthreads();
    { float li0, fp0; ML_GLOAD(0, li0, fp0); ML_DMA(0, 0); ML_SCAN(li0, fp0, m_state); }
    asm volatile("s_waitcnt vmcnt(0)" ::: "memory");
    __syncthreads();
    ML_BUILD(0);
    a_c = a_n; M_c = M_n; b_c = b_n; decay_c = decay_n; m_after = m_next;
    __syncthreads();
#pragma unroll 1
    for (int cc = 0; cc < 36; ++cc) {
        const LAS unsigned char* Qs = lds; const LAS unsigned char* Ks = lds + ML_TILE; const LAS unsigned char* Kw = lds + 2 * ML_TILE; const LAS unsigned char* Vs = lds + ML_VOFF + (cc & 1) * ML_VSZ;
        const LAS float* ncur = nbuf + (cc & 1) * 128; LAS float* nnew = nbuf + ((cc + 1) & 1) * 128;
        float li1 = 0.f, fp1 = 0.f;
        ML_T(5);
        if (cc < 35) { ML_GLOAD(cc + 1, li1, fp1); ML_DMA(cc + 1, (cc + 1) & 1); }
        ML_T(0);
        if (cc >= 4) {
            aw[lane] = a_c;
            const int tcol = 32 * tb + r; const float Mt = shidx(M_c, tcol), bt = shidx(b_c, tcol);
            f32x16 nacc;
#pragma unroll
            for (int q = 0; q < 16; ++q) nacc[q] = 0.f;
#pragma unroll
            for (int db = 0; db < 4; ++db)
#pragma unroll
                for (int s2 = 0; s2 < 2; ++s2) { const LAS unsigned char* qp = Qs + tcol * ML_P + (32 * db + 16 * s2 + 4 * hh) * 2; const u32x2 lo = *(const LAS u32x2*)qp, hi = *(const LAS u32x2*)(qp + 16);
                    u32x4 qw; qw.x = lo.x; qw.y = lo.y; qw.z = hi.x; qw.w = hi.y;
                    nacc = __builtin_amdgcn_mfma_f32_32x32x16_bf16(pack8(cacc[db], s2), __builtin_bit_cast(bf16x8, qw), nacc, 0, 0, 0); }
            const float sc = __expf(m_state - Mt);
            nacc = nacc * sc;
            float rs = 0.f;
#pragma unroll
            for (int sb = 0; sb < 2; ++sb) if (sb <= tb) {
                f32x16 sacc;
#pragma unroll
                for (int q = 0; q < 16; ++q) sacc[q] = 0.f;
#pragma unroll
                for (int ds = 0; ds < 8; ++ds) { const bf16x8 kf = *(const LAS bf16x8*)(Ks + (32 * sb + r) * ML_P + (16 * ds + 8 * hh) * 2), qf = *(const LAS bf16x8*)(Qs + tcol * ML_P + (16 * ds + 8 * hh) * 2);
                    sacc = __builtin_amdgcn_mfma_f32_32x32x16_bf16(kf, qf, sacc, 0, 0, 0); }
#pragma unroll
                for (int g = 0; g < 4; ++g) { const int s0 = 32 * sb + 8 * g + 4 * hh; const f32x4 av = *(const LAS f32x4*)(aw + s0);
#pragma unroll
                    for (int j = 0; j < 4; ++j) { const bool keep = (s0 + j) <= tcol; const float v = keep ? sacc[4 * g + j] * __expf(av[j] - Mt) : 0.f; sacc[4 * g + j] = v; rs += v; } }
#pragma unroll
                for (int s2 = 0; s2 < 2; ++s2) { u32x4 vw;
                    { const u32x2 t0 = tr16(Vs + (32 * sb + 16 * s2 + 4 * hh + tq) * 256 + (32 * eb + 16 * blk + 4 * tp) * 2), t1 = tr16(Vs + (32 * sb + 16 * s2 + 8 + 4 * hh + tq) * 256 + (32 * eb + 16 * blk + 4 * tp) * 2);
                      vw.x = t0.x; vw.y = t0.y; vw.z = t1.x; vw.w = t1.y; }
                    nacc = __builtin_amdgcn_mfma_f32_32x32x16_bf16(__builtin_bit_cast(bf16x8, vw), pack8(sacc, s2), nacc, 0, 0, 0); } }
            rs += shx(rs, 32);
            float qn = 0.f;
            { const LAS unsigned char* qp = Qs + tcol * ML_P + (64 * hh) * 2;
#pragma unroll
              for (int c8 = 0; c8 < 8; ++c8) { const v4u w = *(const LAS v4u*)(qp + c8 * 16); const f32x4 n0 = *(const LAS f32x4*)(ncur + 64 * hh + 8 * c8), n1 = *(const LAS f32x4*)(ncur + 64 * hh + 8 * c8 + 4);
                  qn += bf_lo(w.x) * n0[0] + bf_hi(w.x) * n0[1] + bf_lo(w.y) * n0[2] + bf_hi(w.y) * n0[3] + bf_lo(w.z) * n1[0] + bf_hi(w.z) * n1[1] + bf_lo(w.w) * n1[2] + bf_hi(w.w) * n1[3]; } }
            qn += shx(qn, 32);
            const float den = sc * qn + rs; const float dd = __frcp_rn(fmaxf(fabsf(den), __expf(-(bt + Mt))));
            { const int pos = ML_POS(cc, tcol); bf16* hrow = HB + (size_t)pos * 512 + 32 * eb;
#pragma unroll
              for (int g = 0; g < 4; ++g) { v2u w; w.x = pk2(nacc[4 * g + 0] * dd, nacc[4 * g + 1] * dd); w.y = pk2(nacc[4 * g + 2] * dd, nacc[4 * g + 3] * dd); *(v2u*)(hrow + 8 * g + 4 * hh) = w; } }
        }
        ML_T(1);
#pragma unroll
        for (int db = 0; db < 4; ++db) { cacc[db] = cacc[db] * decay_c;
#pragma unroll
            for (int s4 = 0; s4 < 4; ++s4) { u32x4 ka, vb;
                { const u32x2 t0 = tr16(Kw + (16 * s4 + 8 * hh + tq) * ML_P + (32 * db + 16 * blk + 4 * tp) * 2), t1 = tr16(Kw + (16 * s4 + 8 * hh + 4 + tq) * ML_P + (32 * db + 16 * blk + 4 * tp) * 2);
                  ka.x = t0.x; ka.y = t0.y; ka.z = t1.x; ka.w = t1.y; }
                { const u32x2 t0 = tr16(Vs + (16 * s4 + 8 * hh + tq) * 256 + (32 * eb + 16 * blk + 4 * tp) * 2), t1 = tr16(Vs + (16 * s4 + 8 * hh + 4 + tq) * 256 + (32 * eb + 16 * blk + 4 * tp) * 2);
                  vb.x = t0.x; vb.y = t0.y; vb.z = t1.x; vb.w = t1.y; }
                cacc[db] = __builtin_amdgcn_mfma_f32_32x32x16_bf16(__builtin_bit_cast(bf16x8, ka), __builtin_bit_cast(bf16x8, vb), cacc[db], 0, 0, 0); } }
        { const int d = tid >> 2, part = tid & 3; float s = 0.f;
#pragma unroll
            for (int t = 0; t < 16; ++t) s += bf1(*(const LAS bf16*)(Kw + (part * 16 + t) * ML_P + d * 2));
            s += shx(s, 1); s += shx(s, 2);
            if (part == 0) nnew[d] = decay_c * ncur[d] + s; }
        m_state = m_after;
        ML_T(2);
        asm volatile("s_waitcnt vmcnt(0)" ::: "memory");
        __syncthreads();
        ML_T(3);
        if (cc < 35) { ML_SCAN(li1, fp1, m_state); ML_T(6); ML_BUILD(cc + 1); a_c = a_n; M_c = M_n; b_c = b_n; decay_c = decay_n; m_after = m_next; }
        ML_T(4);
        __syncthreads();
    }
#ifdef ML_PROBE
    if (blockIdx.x == 0 && tid == 256) { unsigned long long* ts = (unsigned long long*)(p.ws + WS_CTL + 32768); ts[50] = 0; unsigned long long c_ = 0; for (int i = 0; i < 7; ++i) { c_ += accs[i]; ts[51 + i] = c_; } }
#endif
#undef ML_T
#undef ML_POS
#undef ML_GLOAD
#undef ML_SCAN
#undef ML_DMA
#undef ML_CONV8
#undef ML_BUILD
}
__device__ __forceinline__ void ph_outb(const Params& p, unsigned char* big, int lane, int wave, int tile) {
    const int gw = tile * NWAVES + wave;
    const bf16* HBf = (const bf16*)(big + A0_HB); const bf16* HBb = HBf + (size_t)T * 512; const bf16* BO = (const bf16*)(big + A0_BO); bf16* MIXIN = (bf16*)(big + A0_MIXIN);
    const float* gb = p.in[I_HGB];
    const f32x4 g0 = *(const f32x4*)(gb + lane * 8), g1 = *(const f32x4*)(gb + lane * 8 + 4);
#pragma unroll 2
    for (int m = gw * 32; m < gw * 32 + 32; ++m) {
        const v4u f = *(const v4u*)(HBf + (size_t)m * 512 + lane * 8), bw = *(const v4u*)(HBb + (size_t)m * 512 + lane * 8), go = *(const v4u*)(BO + (size_t)m * 512 + lane * 8);
        float x[8], o[8]; x[0] = bf_lo(f.x) + bf_lo(bw.x); x[1] = bf_hi(f.x) + bf_hi(bw.x); x[2] = bf_lo(f.y) + bf_lo(bw.y); x[3] = bf_hi(f.y) + bf_hi(bw.y);
        x[4] = bf_lo(f.z) + bf_lo(bw.z); x[5] = bf_hi(f.z) + bf_hi(bw.z); x[6] = bf_lo(f.w) + bf_lo(bw.w); x[7] = bf_hi(f.w) + bf_hi(bw.w);
        o[0] = bf_lo(go.x); o[1] = bf_hi(go.x); o[2] = bf_lo(go.y); o[3] = bf_hi(go.y); o[4] = bf_lo(go.z); o[5] = bf_hi(go.z); o[6] = bf_lo(go.w); o[7] = bf_hi(go.w);
        float ss = 0.f;
#pragma unroll
        for (int j = 0; j < 8; ++j) ss += x[j] * x[j];
        ss += shx(ss, 1); ss += shx(ss, 2); ss += shx(ss, 4); ss += shx(ss, 8);
        const float rn = rsqrtf(ss * (1.f / 128.f) + RMS_EPS);
        float y[8];
#pragma unroll
        for (int j = 0; j < 8; ++j) y[j] = x[j] * rn * (j < 4 ? g0[j] : g1[j - 4]) * sigmoidf_(o[j]);
        v4u w; w.x = pk2(y[0], y[1]); w.y = pk2(y[2], y[3]); w.z = pk2(y[4], y[5]); w.w = pk2(y[6], y[7]);
        *(v4u*)(MIXIN + (size_t)m * D + 512 + lane * 8) = w;
    }
}

constexpr int CW_DBG = 16;
#ifndef DBG_MODE
#define DBG_MODE 0
#endif
#ifndef DBG_L
#define DBG_L 0
#endif
#ifndef DBG_CH
#define DBG_CH 0
#endif
__device__ __forceinline__ void dbg_report(const Params& p, float d) {
    if (!(d >= 0.f)) d = 1.0e6f;
    atomicMax((unsigned*)(p.ws + WS_CTL) + CW_DBG, __float_as_uint(d));
}
__device__ __forceinline__ float block_max(float v, LAS float* red, int tid) { v = wave_max(v); __syncthreads(); if ((tid & 63) == 0) red[tid >> 6] = v; __syncthreads(); float r = red[0];
#pragma unroll
    for (int w = 1; w < 8; ++w) r = fmaxf(r, red[w]); __syncthreads(); return r; }
__device__ __forceinline__ float block_sum(float v, LAS float* red, int tid) { v = wave_sum(v); __syncthreads(); if ((tid & 63) == 0) red[tid >> 6] = v; __syncthreads(); float r = 0.f;
#pragma unroll
    for (int w = 0; w < 8; ++w) r += red[w]; __syncthreads(); return r; }
__device__ __forceinline__ void dbg_moe_check(const Params& p, int l, int ch, const bf16* H2, const bf16* Y, LAS unsigned char* lds, int tid) {
    LAS float* hrow = (LAS float*)lds; LAS float* gu = hrow + 1024; LAS float* a = gu + 512; LAS float* red = a + 256;
    const int t = ch * CHT + blockIdx.x * 64 + 5;
    __syncthreads();
    for (int i = tid; i < 1024; i += NTHR) hrow[i] = bf1(H2[(size_t)t * D + i]);
    __syncthreads();
    const int* EIDX = (const int*)(p.ws + WS_EIDX); const float* WTS = (const float*)(p.ws + WS_WTS); const int* PSLOT = (const int*)(p.ws + WS_PSLOT);
    float yacc[2] = {0.f, 0.f};
#pragma unroll 1
    for (int k = 0; k < 9; ++k) {
        const int e = k < 8 ? (EIDX[(size_t)t * 8 + k] & 255) : 64; const float w = k < 8 ? WTS[(size_t)t * 8 + k] : 1.f;
        const float* Wgu = e < 64 ? p.in[I_EGU] + (size_t)(l * 64 + e) * 1024 * 512 : p.in[I_SGU] + (size_t)l * 1024 * 512;
        const float* Wdn = e < 64 ? p.in[I_EDN] + (size_t)(l * 64 + e) * 256 * 1024 : p.in[I_SDN] + (size_t)l * 256 * 1024;
        float s = 0.f;
#pragma unroll 4
        for (int kk = 0; kk < 1024; ++kk) s += hrow[kk] * Wgu[(size_t)kk * 512 + tid];
        gu[tid] = s;
        __syncthreads();
        if (tid < 256) a[tid] = siluf_(gu[tid]) * gu[256 + tid];
        __syncthreads();
#pragma unroll
        for (int q = 0; q < 2; ++q) { const int n = tid + 512 * q; float s2 = 0.f;
#pragma unroll 4
            for (int j = 0; j < 256; ++j) s2 += a[j] * Wdn[(size_t)j * 1024 + n];
            yacc[q] += w * s2; }
        __syncthreads();
    }
    float err = 0.f, ss = 0.f;
#pragma unroll
    for (int q = 0; q < 2; ++q) { const int n = tid + 512 * q; float f = 0.f;
#pragma unroll 1
        for (int k = 0; k < 9; ++k) { const int slot = PSLOT[(size_t)t * 16 + k]; const float w = k < 8 ? WTS[(size_t)t * 8 + k] : 1.f; f += w * bf1(Y[(size_t)slot * D + n]); }
        err = fmaxf(err, fabsf(f - yacc[q])); ss += yacc[q] * yacc[q]; }
    const float me = block_max(err, red, tid), sq = block_sum(ss, red, tid);
    if (tid == 0) dbg_report(p, me / sqrtf(sq * (1.f / 1024.f) + 1e-30f));
}
__device__ __forceinline__ void dbg_route_check(const Params& p, int l, const bf16* H2, const float* LOG, LAS unsigned char* lds, int tid) {
    LAS float* hrow = (LAS float*)lds; LAS float* lg = hrow + 1024; LAS float* bi = lg + 64; LAS float* sc = bi + 64; LAS float* red = sc + 64;
    const int t = blockIdx.x * 256 + 77;
    __syncthreads();
    for (int i = tid; i < 1024; i += NTHR) hrow[i] = bf1(H2[(size_t)t * D + i]);
    __syncthreads();
    if (tid < 64) { float s = 0.f; const float* W = p.in[I_RW] + (size_t)l * 1024 * 64;
#pragma unroll 4
        for (int k = 0; k < 1024; ++k) s += hrow[k] * W[k * 64 + tid];
        lg[tid] = s; sc[tid] = 1.f / (1.f + expf(-s)); bi[tid] = sc[tid] + p.in[I_RB][l * 64 + tid]; }
    __syncthreads();
    if (tid == 0) {
        float lerr = 0.f;
#pragma unroll 1
        for (int e = 0; e < 64; ++e) lerr = fmaxf(lerr, fabsf(lg[e] - LOG[(size_t)t * 64 + e]));
        float grp[8];
#pragma unroll
        for (int g = 0; g < 8; ++g) { float a = -1e30f, b = -1e30f;
#pragma unroll 1
            for (int j = 0; j < 8; ++j) { const float v = bi[g * 8 + j]; if (v > a) { b = a; a = v; } else if (v > b) b = v; } grp[g] = a + b; }
        unsigned gm = 0;
#pragma unroll 1
        for (int r = 0; r < 4; ++r) { int best = -1; float bv = 0.f;
#pragma unroll
            for (int g = 0; g < 8; ++g) if (!((gm >> g) & 1u) && (best < 0 || grp[g] > bv)) { best = g; bv = grp[g]; }
            gm |= 1u << best; }
        unsigned long long set_ref = 0ull; float ssum = 0.f;
#pragma unroll 1
        for (int r = 0; r < 8; ++r) { int best = -1; float bv = 0.f;
#pragma unroll 1
            for (int e = 0; e < 64; ++e) if (((gm >> (e >> 3)) & 1u) && !((set_ref >> e) & 1ull) && (best < 0 || bi[e] > bv)) { best = e; bv = bi[e]; }
            set_ref |= 1ull << best; ssum += sc[best]; }
        const int* EIDX = (const int*)(p.ws + WS_EIDX); const float* WTS = (const float*)(p.ws + WS_WTS);
        unsigned long long set_f = 0ull; float werr = 0.f, wsum = 0.f;
#pragma unroll 1
        for (int k = 0; k < 8; ++k) { const int e = EIDX[(size_t)t * 8 + k] & 255; set_f |= 1ull << e; const float wr = 2.5f * sc[e] / ssum; werr = fmaxf(werr, fabsf(wr - WTS[(size_t)t * 8 + k])); wsum += WTS[(size_t)t * 8 + k]; }
        float d = 0.f;
        if (DBG_MODE == 0) d = (set_f != set_ref) ? (1.f / 256.f) : 0.f;
        if (DBG_MODE == 1) d = (set_f != set_ref) ? 0.f : werr + fabsf(wsum - 2.5f);
        if (DBG_MODE == 2) d = lerr * (1.f / 256.f);
        atomicAdd((float*)((unsigned*)(p.ws + WS_CTL) + CW_DBG), d);
    }
    __syncthreads();
}
__device__ __forceinline__ unsigned dbg_hash(unsigned x) { x ^= x >> 16; x *= 0x7feb352du; x ^= x >> 15; x *= 0x846ca68bu; x ^= x >> 16; return x; }
__device__ __forceinline__ void dbg_report_wave(const Params& p, float d, int lane) { if (lane == 0) dbg_report(p, d); }
__device__ __forceinline__ void dbg_hyena_check(const Params& p, int mode, const bf16* HN, const bf16* UC, const bf16* ZT, const bf16* Y2T, const bf16* MIX, LAS unsigned char* lds, int lane, int wave) {
    const unsigned hsh = dbg_hash(blockIdx.x * 8u + wave + 12345u), h2 = dbg_hash(hsh), h3 = dbg_hash(h2);
    const bf16* FILT = (const bf16*)(p.ws + WS_FILT);
    float d = 0.f;
    if (mode == 0) {
        const int c = hsh % 3072u, b = h2 % 32u, s = h3 % 2048u; float acc = 0.f;
#pragma unroll 1
        for (int k = lane; k < 1024; k += 64) acc += bf1(HN[(size_t)(b * 2048 + s) * D + k]) * p.in[I_WINHY][(size_t)k * 3072 + c];
        acc = wave_sum(acc);
        const float got = bf1(UC[(size_t)c * T + b * 2048 + s]); d = fabsf(got - acc) / (fabsf(acc) + 0.1f);
    } else if (mode == 5) {
        const int c = hsh % 3072u, b = h2 % 32u; int s = h3 % 2048u; if ((h3 >> 20) % 8u == 0u) s = 0; if ((h3 >> 20) % 8u == 1u) s = 2047;
        float val = p.in[I_CONVHYB][c];
#pragma unroll 1
        for (int j = 0; j < 3; ++j) { const int sj = s + j - 1; if (sj < 0 || sj > 2047) continue; val += p.in[I_CONVHYW][j * 3072 + c] * bf1(ZT[(size_t)c * T + b * 2048 + sj]); }
        const float got = bf1(UC[(size_t)c * T + b * 2048 + s]); d = fabsf(got - val) / (fabsf(val) + 0.1f);
    } else if (mode == 1) {
        LAS float* Z = (LAS float*)(lds + wave * 1024); LAS float* A1 = Z + 64; LAS float* A2 = A1 + 64;
        const int o = hsh & 1u, c = h2 % 1024u, j = h3 % 2048u;
        float z = 0.f; if (lane == 0) z = (float)j / 2047.f; else if (lane < 33) { const int k = (lane - 1) & 15; const float fr = 1e-4f + (float)k * ((15.f - 1e-4f) / 15.f); const float ang = (6.283185307179586f / 2048.f) * (float)j * fr; z = lane < 17 ? cosf(ang) : -sinf(ang); }
        Z[lane] = z; LDS_WAIT(); asm volatile("" ::: "memory");
        float a = p.in[I_FB1][lane];
#pragma unroll 1
        for (int k = 0; k < 33; ++k) a += Z[k] * p.in[I_FW1][k * 64 + lane];
        A1[lane] = sinf(a); LDS_WAIT(); asm volatile("" ::: "memory");
        a = p.in[I_FB2][lane];
#pragma unroll 1
        for (int k = 0; k < 64; ++k) a += A1[k] * p.in[I_FW2][k * 64 + lane];
        A2[lane] = sinf(a); LDS_WAIT(); asm volatile("" ::: "memory");
        float v = wave_sum(A2[lane] * p.in[I_FW3][lane * 2048 + o * 1024 + c]);
        const float mind = -4.605170185988091f / 1.5f, maxd = -4.605170185988091f / 0.3f; const float delta = fabsf(mind + (float)c * ((maxd - mind) / 1023.f));
        v *= expf(-fabsf((float)j - 1024.f) / 1024.f * delta);
        const float got = bf1(FILT[(size_t)(o * 1024 + c) * 2048 + j]); d = fabsf(got - v) / (fabsf(v) + 1e-4f);
    } else if (mode == 2 || mode == 3) {
        const int o = mode - 2, c = hsh % 1024u, b = h2 % 32u; int t = h3 % 2048u; if ((h3 >> 20) % 8u == 0u) t = 0; if ((h3 >> 20) % 8u == 1u) t = 2047;
        const bf16* in = (o == 0 ? UC : ZT) + (size_t)c * T + b * 2048; const bf16* f = FILT + (size_t)(o * 1024 + c) * 2048; float acc = 0.f;
#pragma unroll 1
        for (int s = lane; s < 2048; s += 64) { const int x = 1024 + t - s; if (x >= 0 && x <= 2047) acc += bf1(f[x]) * bf1(in[s]); }
        acc = wave_sum(acc);
        const float gate = bf1(UC[(size_t)((1 + o) * 1024 + c) * T + b * 2048 + t]);
        const float val = gate * (acc + bf1(in[t]) * p.in[I_FBIAS][o * 1024 + c]);
        const float got = bf1((o == 0 ? ZT : Y2T)[(size_t)c * T + b * 2048 + t]); d = fabsf(got - val) / (fabsf(val) + 0.1f);
    } else if (mode == 4) {
        const int tok = hsh % 65536u, n = h2 % 1024u; float acc = 0.f;
#pragma unroll 1
        for (int c = lane; c < 1024; c += 64) acc += bf1(Y2T[(size_t)c * T + tok]) * p.in[I_WOUTHY][(size_t)c * 1024 + n];
        acc = wave_sum(acc);
        const float got = bf1(MIX[(size_t)tok * D + n]); d = fabsf(got - acc) / (fabsf(acc) + 0.1f);
    }
    dbg_report_wave(p, d, lane);
}
__device__ __forceinline__ void dbg_inproj_check(const Params& p, unsigned char* big, int lane, int wave) {
    const unsigned hsh = dbg_hash(blockIdx.x * 8u + wave + 777u), h2 = dbg_hash(hsh);
    const bf16* H0 = (const bf16*)(big + A0_H); const float* W = p.in[I_WINAB];
    int m = hsh % (unsigned)TT; int n = h2 % 3600u;
    const bool ctx = m >= T; if (ctx && n < 1536) n += 1536;
    const int b = ctx ? (m - T) / LC : m / SEQ, s = ctx ? (m - T) % LC : m % SEQ;
    float x = 0.f, xp = 0.f; const bool rope_col = (n < 512) || (n >= 1536 && n < 2048); const int np = rope_col ? (n ^ 16) : n;
#pragma unroll 1
    for (int k = lane; k < 1024; k += 64) { const float hv = bf1(H0[(size_t)m * D + k]); x += hv * W[(size_t)k * 3600 + n]; xp += hv * W[(size_t)k * 3600 + np]; }
    x = wave_sum(x); xp = wave_sum(xp);
    float val = x, got = 0.f;
    if (n >= 3584) { val = x + p.in[I_GATEB][n - 3584]; got = ((const float*)(p.ws + WS_GATES))[(size_t)m * 16 + (n - 3584)]; }
    else { const int t = n / 512, cn = n % 512; int pc = cn;
        if (rope_col) { const int o = cn & 31; pc = (cn & ~31) + (((o & 15) >> 2) * 8 + (o >> 4) * 4 + (o & 3));
            if (!ctx) { const int d = cn & 63, axis = d >> 5, half = (d >> 4) & 1, i = d & 15; const float pos = (float)(axis == 0 ? (s >> 6) : (s & 63)); const float ang = pos * powf(10000.f, -(float)i / 16.f);
                val = half == 0 ? x * cosf(ang) - xp * sinf(ang) : x * cosf(ang) + xp * sinf(ang); } }
        if (t == 0) val *= QSCALE;
        const size_t offs[7] = {A0_QA, A0_BQ, A0_BO, A0_KA, A0_VA, A0_BK, A0_BV}; const bool kv = t >= 3;
        const bf16* O = (const bf16*)(big + offs[t]) + (size_t)b * (kv ? (SEQ + LC) : SEQ) * 512 + (size_t)((kv && !ctx) ? LC : 0) * 512;
        got = bf1(O[(size_t)s * 512 + pc]); }
    dbg_report_wave(p, fabsf(got - val) / (fabsf(val) + 0.1f), lane);
}
__device__ __forceinline__ void dbg_attn_check(const Params& p, unsigned char* big, LAS unsigned char* lds, int lane, int wave) {
    const unsigned hsh = dbg_hash(blockIdx.x * 8u + wave + 4242u), h2 = dbg_hash(hsh);
    const int b = hsh % 32u, h = (hsh >> 8) % 4u, q = h2 % 2048u;
    const bf16* QA = (const bf16*)(big + A0_QA) + ((size_t)b * SEQ + q) * 512 + h * 128; const bf16* KA = (const bf16*)(big + A0_KA) + (size_t)b * 2304 * 512 + h * 128;
    const bf16* VA = (const bf16*)(big + A0_VA) + (size_t)b * 2304 * 512 + h * 128; const bf16* MIXIN = (const bf16*)(big + A0_MIXIN) + ((size_t)b * SEQ + q) * D + h * 128;
    LAS float* Aw = (LAS float*)(lds + wave * 18432);
    const float* lv = p.in[I_DLAM]; const float lam = expf(wave_sum(lv[lane] * lv[64 + lane])) - expf(wave_sum(lv[128 + lane] * lv[192 + lane])) + 0.2f;
    float mx0 = -1e30f, mx1 = -1e30f;
#pragma unroll 1
    for (int key = lane; key < 2304; key += 64) { float s0 = 0.f, s1 = 0.f;
#pragma unroll 1
        for (int d = 0; d < 64; ++d) { s0 += bf1(QA[d]) * bf1(KA[(size_t)key * 512 + d]); s1 += bf1(QA[64 + d]) * bf1(KA[(size_t)key * 512 + 64 + d]); }
        Aw[key] = s0; Aw[2304 + key] = s1; mx0 = fmaxf(mx0, s0); mx1 = fmaxf(mx1, s1); }
    mx0 = wave_max(mx0); mx1 = wave_max(mx1);
    float l0 = 0.f, l1 = 0.f;
#pragma unroll 1
    for (int key = lane; key < 2304; key += 64) { const float e0 = exp2f(Aw[key] - mx0), e1 = exp2f(Aw[2304 + key] - mx1); Aw[key] = e0; Aw[2304 + key] = e1; l0 += e0; l1 += e1; }
    l0 = wave_sum(l0); l1 = wave_sum(l1);
    LDS_WAIT(); asm volatile("" ::: "memory");
    float o[2] = {0.f, 0.f};
#pragma unroll 1
    for (int key = 0; key < 2304; ++key) { const float a = Aw[key] / l0 - lam * Aw[2304 + key] / l1; o[0] += a * bf1(VA[(size_t)key * 512 + lane]); o[1] += a * bf1(VA[(size_t)key * 512 + 64 + lane]); }
    const float ms = wave_sum(o[0] * o[0] + o[1] * o[1]) * (1.f / 128.f); const float rn = rsqrtf(ms + RMS_EPS) * 0.8f;
    float err = 0.f, sc = 0.f;
#pragma unroll
    for (int j = 0; j < 2; ++j) { const float val = o[j] * rn * p.in[I_HGA][h * 128 + 64 * j + lane]; err = fmaxf(err, fabsf(val - bf1(MIXIN[64 * j + lane]))); sc += val * val; }
    err = wave_max(err); sc = sqrtf(wave_sum(sc) * (1.f / 128.f));
    dbg_report_wave(p, err / (sc + 1e-3f), lane);
}
__device__ __forceinline__ float dbg_convsilu(const bf16* base, int pos, int lim, int ch, int d, const float* cw, const float* cb) {
    float s = cb[ch];
#pragma unroll
    for (int j = 0; j < 3; ++j) { const int pj = pos + j - 1; if (pj >= 0 && pj < lim) s += cw[j * 1024 + ch] * bf1(base[(size_t)pj * 512 + d]); }
    return s / (1.f + expf(-s));
}
__device__ __forceinline__ void dbg_mlstm_check(const Params& p, unsigned char* big, LAS unsigned char* lds, int lane, int wave) {
    const unsigned hsh = dbg_hash(blockIdx.x * 8u + wave + 991u), h2 = dbg_hash(hsh);
    const int b = hsh % 32u, h = (hsh >> 8) % 4u, dir = (hsh >> 12) & 1; int tau = h2 % 2048u; if ((h2 >> 16) % 4u == 0u) tau = (h2 >> 20) % 130u;
    const bf16* BQ = (const bf16*)(big + A0_BQ) + (size_t)b * SEQ * 512 + h * 128; const bf16* BK = (const bf16*)(big + A0_BK) + (size_t)b * (SEQ + LC) * 512 + h * 128;
    const bf16* BV = (const bf16*)(big + A0_BV) + (size_t)b * (SEQ + LC) * 512 + h * 128;
    const float* GT = (const float*)(p.ws + WS_GATES); const float* cw = p.in[I_CONVABW]; const float* cb = p.in[I_CONVABB];
    LAS float* F = (LAS float*)(lds + wave * 18432); LAS float* qv = F + 2304 + 64;
    const int N = 256 + tau + 1;
#define DBG_POS(u) ((u) < 256 ? (dir ? 255 - (u) : (u)) : (dir ? 2047 - ((u) - 256) : (u) - 256))
#define DBG_GROW(u) ((u) < 256 ? (size_t)T + b * LC + DBG_POS(u) : (size_t)b * SEQ + DBG_POS(u))
    float carry = 0.f;
#pragma unroll 1
    for (int u0 = 0; u0 < N; u0 += 64) { const int u = u0 + lane; float lf = 0.f;
        if (u < N) { const float x = GT[DBG_GROW(u) * 16 + dir * 8 + 4 + h]; lf = x >= 0.f ? -__logf(1.f + __expf(-x)) : x - __logf(1.f + __expf(x)); }
        float s = lf;
#pragma unroll
        for (int o = 1; o < 64; o <<= 1) { const float v = shup(s, o); if (lane >= o) s += v; }
        if (u < N) F[u] = carry + s; carry += shidx(s, 63); }
    LDS_WAIT(); asm volatile("" ::: "memory");
    const float Ft = F[N - 1];
    float mm = Ft;
#pragma unroll 1
    for (int u = lane; u < N; u += 64) mm = fmaxf(mm, Ft - F[u] + GT[DBG_GROW(u) * 16 + dir * 8 + h]);
    mm = wave_max(mm);
    { const int pos = DBG_POS(N - 1);
      for (int d = lane; d < 128; d += 64) qv[d] = dbg_convsilu(BQ, pos, SEQ, h * 128 + d, d, cw, cb) * 0.08838834764831845f; }
    LDS_WAIT(); asm volatile("" ::: "memory");
    float den = 0.f;
#pragma unroll 1
    for (int u = lane; u < N; u += 64) { const bool ctx = u < 256; const int pos = DBG_POS(u); const bf16* kb = ctx ? BK : BK + (size_t)LC * 512; float qk = 0.f;
#pragma unroll 1
        for (int d = 0; d < 128; ++d) qk += qv[d] * dbg_convsilu(kb, pos, ctx ? LC : SEQ, 512 + h * 128 + d, d, cw, cb);
        const float om = qk * expf(Ft - F[u] + GT[DBG_GROW(u) * 16 + dir * 8 + h] - mm); F[u] = om; den += om; }
    den = wave_sum(den);
    LDS_WAIT(); asm volatile("" ::: "memory");
    float num[2] = {0.f, 0.f};
#pragma unroll 1
    for (int u = 0; u < N; ++u) { const bool ctx = u < 256; const int pos = DBG_POS(u); const bf16* vb = BV + (size_t)((ctx ? 0 : LC) + pos) * 512; num[0] += F[u] * bf1(vb[lane]); num[1] += F[u] * bf1(vb[64 + lane]); }
    const float dd = 1.f / fmaxf(fabsf(den), expf(-mm));
    const bf16* HB = (const bf16*)(big + A0_HB) + (size_t)dir * T * 512 + ((size_t)b * SEQ + DBG_POS(N - 1)) * 512 + h * 128;
    float err = 0.f, sc = 0.f;
#pragma unroll
    for (int j = 0; j < 2; ++j) { const float val = num[j] * dd; err = fmaxf(err, fabsf(val - bf1(HB[64 * j + lane]))); sc += val * val; }
    err = wave_max(err); sc = sqrtf(wave_sum(sc) * (1.f / 128.f));
    dbg_report_wave(p, err / (sc + 1e-3f), lane);
#undef DBG_POS
#undef DBG_GROW
}

__global__ void __launch_bounds__(NTHR, 2) mk_fwd(Params p0) {
    extern __shared__ __attribute__((aligned(16))) unsigned char lds_raw[];
    LAS unsigned char* lds = (LAS unsigned char*)lds_raw;
    const int wave0 = __builtin_amdgcn_readfirstlane((int)threadIdx.x >> 6);
    if (threadIdx.x < 64) ((LAS unsigned*)(lds + LDS_MISC))[threadIdx.x] = 0u;
    __syncthreads();
    XcdBarrier bar = xcd_barrier_post((unsigned*)(p0.ws + WS_CTL) + CW_BAR, (volatile LAS unsigned*)(lds + LDS_MISC + 32));
    const int G = gridDim.x, cb = blockIdx.x;
    const int vcu = (G % 8 == 0) ? (cb % 8) * (G / 8) + cb / 8 : cb;
#ifdef TIMEK
    int phc = 0; if (blockIdx.x == 0 && threadIdx.x == 0) ((unsigned long long*)(p0.ws + WS_CTL + 32768))[0] = __builtin_amdgcn_s_memrealtime();
#endif
#ifdef DBL_PH
#define DBL_LOOP for (int rep_ = 0; rep_ < 1; ++rep_)
#define DBL_SYNC __syncthreads();
#else
#define DBL_LOOP
#define DBL_SYNC
#endif
#ifdef TIMEK
#define TS_REC { ++phc; if (blockIdx.x == 0 && wave0 == 0 && lane_opq() == 0) ((unsigned long long*)(p0.ws + WS_CTL + 32768))[phc] = __builtin_amdgcn_s_memrealtime(); }
#else
#define TS_REC
#endif
#define LAYER_PTRS bf16* H2 = (bf16*)(big + (l == 0 ? 0 : 128 * MiB)); float* LOG = nullptr; bf16* ACT = (bf16*)(big + (l == 0 ? 144 * MiB : 272 * MiB)); \
        bf16* Y = (bf16*)(big + (l == 0 ? 304 * MiB : 432 * MiB)); bf16* HN = (bf16*)(big + 640 * MiB); const bf16* MIX = (const bf16*)(big + (l == 0 ? A0_MIX : 0)); \
        unsigned char* X8 = ws + WS_X8; bf16* UT = (bf16*)big; bf16* UC = (bf16*)(big + 384 * MiB); bf16* ZT = (bf16*)(big + 384 * MiB); bf16* Y2T = (bf16*)(big + 512 * MiB); bf16* Y2 = (bf16*)(big + 640 * MiB); \
        (void)X8; (void)H2; (void)LOG; (void)ACT; (void)Y; (void)HN; (void)MIX; (void)UT; (void)UC; (void)ZT; (void)Y2T; (void)Y2;
#define RUN(...) do { { { int tid_ = wave0 * 64 + lane_opq(); asm volatile("" : "+v"(tid_)); const int tid = tid_, lane = tid & 63, wave = __builtin_amdgcn_readfirstlane(tid >> 6); (void)lane; (void)wave; \
        Params p = p0; { size_t z_ = 0; asm volatile("" : "+s"(z_)); p.ws = p0.ws + z_; p.out = p0.out + z_; _Pragma("unroll") for (int i_ = 0; i_ < 31; ++i_) p.in[i_] = p0.in[i_] + z_; } unsigned char* ws = p.ws; unsigned char* big = ws + WS_BIG; (void)big; LAYER_PTRS DBL_LOOP { __VA_ARGS__; DBL_SYNC } } { XcdBarrier b2_ = bar; { size_t z_ = 0; asm volatile("" : "+s"(z_)); b2_.bar = bar.bar + z_; unsigned x_ = bar.x; asm volatile("" : "+s"(x_)); b2_.x = x_; } xcd_barrier(b2_, wave0 == 0 && lane_opq() == 0); } TS_REC } } while (0)

#ifdef PRO_PROBE
#define PP(i) do { if (blockIdx.x == 0 && tid == 0) ((unsigned long long*)(p0.ws + WS_CTL + 32768))[50 + (i)] = __builtin_amdgcn_s_memrealtime(); } while (0)
#else
#define PP(i)
#endif
    { const int l = 0; RUN({ PP(0); pro_mod(p, lds, tid, lane, wave); __syncthreads(); PP(1); pro_filters(p, lds, tid, lane, wave); PP(2); pro_rope(p, tid); pro_transposes(p, lds, lane, wave); PP(3); }); }

    for (int l = 0; l < 2; ++l) {
        if (l == 0) {
            RUN({ ph_l0_norm(p, lane, wave); });
            RUN({ Gemm g{(const bf16*)(big + A0_H), (const bf16*)(ws + WS_WIN0), 1024, 2048u}; InprojSched S{G, vcu};
                  EpiInproj E{big, (const float*)(ws + WS_ROPE), (float*)(ws + WS_GATES), p.in[I_GATEB]};
                  gemm_phase<EpiInproj, InprojSched>(lds, g, S, E, tid); });
#ifdef DBG_INPROJ
            RUN({ dbg_inproj_check(p, big, lane, wave); });
#endif
            RUN({ ph_attn(p, big, lds, tid, lane, wave, vcu); });
#ifdef DBG_ATTN
            RUN({ dbg_attn_check(p, big, lds, lane, wave); });
#endif
            RUN({ ph_mlstm(p, big, lds, tid, lane, wave); });
#ifdef DBG_MLSTM
            RUN({ dbg_mlstm_check(p, big, lds, lane, wave); });
#endif
            RUN({ ph_outb(p, big, lane, wave, vcu); asm volatile("s_waitcnt vmcnt(0)" ::: "memory"); __syncthreads();
                  Gemm g{(const bf16*)(big + A0_MIXIN), (const bf16*)(ws + WS_WOUT0), 1024, 2048u}; PanelSched S{4, vcu}; EpiBf16 E{(bf16*)(big + A0_MIX), 1024, 3};
                  gemm_phase<EpiBf16, PanelSched>(lds, g, S, E, tid); });
        }
        if (l == 1) {
            RUN({ Gemm g{(const bf16*)(ws + WS_WIN1), HN, 1024, 2048u}; DenseSched S{256, 12 * 256, G, vcu, 12}; EpiBf16 E{UT, (size_t)T, 0xffff};
                  gemm_phase<EpiBf16, DenseSched>(lds, g, S, E, tid); });
#ifdef DBG_HY
            if (DBG_MODE == 0) { RUN({ dbg_hyena_check(p, 0, HN, UT, UT, UT, UT, lds, lane, wave); }); }
#endif
#ifdef DBG_HY
            if (DBG_MODE == 5) { RUN({ dbg_hyena_check(p, 5, HN, UC, UT, UT, UT, lds, lane, wave); }); }
#endif
            RUN({ ph_lconv<true>(p, 0, UT, UT, ZT, lds, tid, lane, wave); });
#ifdef DBG_HY
            if (DBG_MODE == 2) { RUN({ dbg_hyena_check(p, 2, HN, UC, ZT, Y2T, UT, lds, lane, wave); }); }
#endif
            RUN({ ph_lconv<false>(p, 1, ZT, UT, Y2T, lds, tid, lane, wave); });
#ifdef DBG_HY
            if (DBG_MODE == 3) { RUN({ dbg_hyena_check(p, 3, HN, UC, ZT, Y2T, UT, lds, lane, wave); }); }
#endif
            RUN({ ph_transpose(Y2T, Y2, lds, lane, wave, vcu); asm volatile("s_waitcnt vmcnt(0)" ::: "memory"); __syncthreads();
                  Gemm g{Y2, (const bf16*)(ws + WS_WOUT1), 1024, 2048u}; PanelSched S{4, vcu}; EpiBf16 E{(bf16*)big, 1024, 3};
                  gemm_phase<EpiBf16, PanelSched>(lds, g, S, E, tid); });
        }
#ifdef DBG_HY
        if (l == 1 && (DBG_MODE == 1 || DBG_MODE == 4)) { RUN({ dbg_hyena_check(p, DBG_MODE, HN, (const bf16*)(big + 384 * MiB), (const bf16*)big, (const bf16*)(big + 128 * MiB), (const bf16*)big, lds, lane, wave); }); }
#endif
        RUN({ ph_mid(p, l, MIX, H2, X8, true, lane, wave, vcu); asm volatile("s_waitcnt vmcnt(0)" ::: "memory"); __syncthreads();
              Gemm g{H2, (const bf16*)(ws + WS_WR) + (size_t)l * 256 * 1024, 1024, 2048u}; DenseSched S{1, 256, G, vcu, 0}; EpiRouterLds E{};
              gemm_phase<EpiRouterLds, DenseSched>(lds, g, S, E, tid); __syncthreads(); ph_route_a(p, l, nullptr, vcu, lds, tid); });
#ifdef DBG_ROUTE
        RUN({ if (l == DBG_L) dbg_route_check(p, l, H2, LOG, lds, tid); ph_route_b(p, lds, tid); });
#else
        RUN({ ph_route_b(p, lds, tid); });
#endif
#define DO_G1(chx) do { const int NT = moe_tables(p, chx, lds, tid); \
            Gemm g{(const bf16*)X8, (const bf16*)(ws + WS_GU + (size_t)l * (65 * 512) * 1024), 512, 1024u};        \
            MoeSched S{(const LAS int*)(lds + LDS_TAB), (const int*)(ws + WS_SORT) + (size_t)(chx) * CHROWS, NT * 2, G, vcu, 1, 2, nullptr}; EpiSwiglu E{ACT}; \
            gemm_phase<EpiSwiglu, MoeSched, true, true>(lds, g, S, E, tid); } while (0)
        RUN({ DO_G1(0); });
        for (int ch = 0; ch < NCH; ++ch) {
            RUN({ const int NT = moe_tables(p, ch, lds, tid);
                  Gemm g{ACT, (const bf16*)(ws + WS_DN) + (size_t)l * (65 * 1024) * 256, 256, 512u};
                  MoeSched S{(const LAS int*)(lds + LDS_TAB), nullptr, NT * 4, G, vcu, 2, 4, (l == 0 && ch == 0) ? (void*)(ws + WS_CTL + 32768) : nullptr}; EpiFp8 E{(unsigned char*)Y};
                  gemm_phase<EpiFp8, MoeSched>(lds, g, S, E, tid); });
            RUN({ const int par = (cb >> 3) & 1;
                  _Pragma("unroll 1") for (int part = 0; part < 2; ++part) { int t2_ = tid; asm volatile("" : "+v"(t2_)); const int tid = t2_, lane = tid & 63; (void)lane; if ((part ^ par) == 0) { if (ch + 1 < NCH) DO_G1(ch + 1); } else { ph_combine(p, l, ch, (const unsigned char*)Y, HN, lane, wave); } __syncthreads(); } });
        }
    }
#ifdef TIMEK
    if (blockIdx.x == 0) { const unsigned long long* ts = (const unsigned long long*)(p0.ws + WS_CTL + 32768); __syncthreads();
        const unsigned long long d = (__hip_atomic_load(ts + TIMEK, __ATOMIC_RELAXED, __HIP_MEMORY_SCOPE_AGENT) - __hip_atomic_load(ts + TIMEK0, __ATOMIC_RELAXED, __HIP_MEMORY_SCOPE_AGENT)) * 4ull, t0 = __builtin_amdgcn_s_memrealtime();
        while (__builtin_amdgcn_s_memrealtime() - t0 < d) __builtin_amdgcn_s_sleep(8); }
#endif
#ifdef DBG_ANY
    xcd_barrier(bar, threadIdx.x == 0);
    if (blockIdx.x == 0 && threadIdx.x == 0) p0.out[0] += 1.0e7f * __uint_as_float(((const unsigned*)(p0.ws + WS_CTL))[CW_DBG]);
#endif
#undef RUN
}
constexpr int NPHASES = 1 + 2 * (4 + 3 * NCH) + 6 + 64;
}

extern "C" void kernel_launch(void* const* d_in, const int* in_sizes, int n_in, void* d_out, int out_size, void* d_ws, size_t ws_size, hipStream_t stream) {
    using namespace mk;
    static int grid = 0;
    if (grid == 0) {
        if (n_in != 31 || out_size != T * D || ws_size < WS_END) { fprintf(stderr, "kernel_launch: unexpected shapes (n_in %d, out %d, ws %zu)\n", n_in, out_size, ws_size); grid = -1; return; }
        int dev = 0, cus = 0;
        if (hipGetDevice(&dev) != hipSuccess || hipDeviceGetAttribute(&cus, hipDeviceAttributeMultiprocessorCount, dev) != hipSuccess) { grid = -1; return; }
        if (hipFuncSetAttribute((const void*)mk_fwd, hipFuncAttributeMaxDynamicSharedMemorySize, LDS_BYTES) != hipSuccess) { fprintf(stderr, "kernel_launch: hipFuncSetAttribute failed\n"); grid = -1; return; }
        int per_cu = 0;
        if (hipOccupancyMaxActiveBlocksPerMultiprocessor(&per_cu, (const void*)mk_fwd, NTHR, LDS_BYTES) != hipSuccess || per_cu < 1) { fprintf(stderr, "kernel_launch: occupancy query says %d\n", per_cu); }
        (void)hipGetLastError();
        grid = cus;
        if (grid != 256) { fprintf(stderr, "kernel_launch: built for 256 CUs, found %d\n", grid); grid = -1; return; }
    }
    if (grid < 0) return;
    (void)hipMemsetAsync((char*)d_ws + WS_CTL, 0, CTL_ZERO_BYTES, stream);
    Params a{};
    for (int i = 0; i < 31; ++i) a.in[i] = (const float*)d_in[i];
    a.out = (float*)d_out; a.ws = (unsigned char*)d_ws; a.ph_lo = 0; a.ph_hi = NPHASES;
    hipLaunchKernelGGL(mk_fwd, dim3(grid), dim3(NTHR), LDS_BYTES, stream, a);
}
```

```cpp
#include <hip/hip_runtime.h>
#include <cstdio>
#include <cstdint>
namespace pg8 {
#define PG8_LAS __attribute__((address_space(3)))
typedef unsigned short bf16_t;
typedef short bf16x8 __attribute__((ext_vector_type(8)));
typedef float f32x4 __attribute__((ext_vector_type(4)));
typedef unsigned u32x4 __attribute__((ext_vector_type(4)));
typedef unsigned u32x2 __attribute__((ext_vector_type(2)));
typedef int i32x4 __attribute__((ext_vector_type(4)));
typedef int i32x8 __attribute__((ext_vector_type(8)));
constexpr int BM = 256, BK = 64, HALF = 128, HTB = HALF * BK * 2  , STAGE_BYTES = 8 * HTB;

__host__ __device__ __forceinline__ int lds_byte(int r, int c) { const int st = (r >> 4) * 2 + (c >> 5), rr = r & 15, cc = c & 31, ob = rr * 64 + cc * 2; return st * 1024 + (ob ^ (((ob >> 9) & 1) << 5)); }
__host__ __device__ __forceinline__ void stage_rc(int b, int& R, int& C) { const int st = b / 1024, sb = b % 1024, swz = sb ^ (((sb >> 9) & 1) << 5); R = (st >> 1) * 16 + swz / 64; C = (st & 1) * 32 + (swz % 64) / 2; }
__host__ __device__ __forceinline__ int perm32(int rho) { const int n = rho >> 4, i = rho & 15; return 8 * (i >> 2) + 4 * n + (i & 3); }

struct Unit { int pm, pn; };
__device__ __forceinline__ unsigned cvt_pk_bf16(float lo, float hi) { unsigned r; asm volatile("v_cvt_pk_bf16_f32 %0, %1, %2" : "=v"(r) : "v"(lo), "v"(hi)); return r; }
struct Gemm { const bf16_t* A; const bf16_t* Bt; int K; unsigned lda_bytes; };
template <class Epi, class Sched, bool ALIGN_EPI = true, bool F8 = false>
__device__ __forceinline__ void gemm_phase(PG8_LAS unsigned char* lds, const Gemm g, const Sched& S, const Epi& E, const int tid_in) {
    int tid_ = tid_in; asm volatile("" : "+v"(tid_));
    const int tid = tid_, wid = __builtin_amdgcn_readfirstlane(tid >> 6), lane = tid & 63, wr = wid >> 2, wc = wid & 3, fr = lane & 15, fq = lane >> 4;
    const int K = g.K, nt = K / BK;
    unsigned voffB[2];
#pragma unroll
    for (int i = 0; i < 2; ++i) { int R, C; stage_rc(tid * 16 + i * 8192, R, C); const int Rb = Epi::PERM ? ((R & ~31) + perm32(R & 31)) : R;
        voffB[i] = (unsigned)(Rb * K + C) * 2u; }
    const size_t kstep = (size_t)(BK * 2);
    const size_t hstep = (size_t)HALF * K * 2;
    const size_t tstep = 2 * hstep;
    const unsigned ldsw = (unsigned)wid * 1024u;
    const int aoff = lds_byte(wr * 64 + fr, fq * 8), boff = lds_byte(wc * 32 + fr, fq * 8);
    const char* Ab = (const char*)g.A;
#define PG8_SA(b, h) (((b) * 2 + (h)) * HTB)
#define PG8_SB(b, h) ((4 + (b) * 2 + (h)) * HTB)
#define PG8_STAGE(bufoff, gbase, voff) do { _Pragma("unroll") for (int _i = 0; _i < 2; ++_i) \
        __builtin_amdgcn_global_load_lds((const unsigned*)((const char*)(gbase) + (voff)[_i]), (PG8_LAS unsigned*)(lds + (bufoff) + ldsw + _i * 8192), 16, 0, 0); } while (0)
#define PG8_STAGEA(bufoff, o0, o1, kb) do { \
        __builtin_amdgcn_global_load_lds((const unsigned*)(Ab + (size_t)(o0) + (size_t)(kb)), (PG8_LAS unsigned*)(lds + (bufoff) + ldsw), 16, 0, 0); \
        __builtin_amdgcn_global_load_lds((const unsigned*)(Ab + (size_t)(o1) + (size_t)(kb)), (PG8_LAS unsigned*)(lds + (bufoff) + ldsw + 8192), 16, 0, 0); } while (0)
#define PG8_LDA(dst, b, h) do { _Pragma("unroll") for (int m = 0; m < 4; ++m) _Pragma("unroll") for (int k = 0; k < 2; ++k) dst[m][k] = *(const PG8_LAS bf16x8*)(lds + PG8_SA(b, h) + aoff + m * 2048 + k * 1024); } while (0)
#define PG8_LDB(dst, b, h) do { _Pragma("unroll") for (int n = 0; n < 2; ++n) _Pragma("unroll") for (int k = 0; k < 2; ++k) dst[n][k] = *(const PG8_LAS bf16x8*)(lds + PG8_SB(b, h) + boff + n * 2048 + k * 1024); } while (0)
#define PG8_CAT(x0, x1) __builtin_shufflevector(__builtin_bit_cast(i32x4, x0), __builtin_bit_cast(i32x4, x1), 0, 1, 2, 3, 4, 5, 6, 7)
#define PG8_MMA(ai, bj, At, Bt) do { __builtin_amdgcn_s_setprio(1); _Pragma("unroll") for (int m = 0; m < 4; ++m) _Pragma("unroll") for (int n = 0; n < 2; ++n) { \
        if constexpr (F8) acc[ai][bj][m][n] = __builtin_amdgcn_mfma_scale_f32_16x16x128_f8f6f4(PG8_CAT(Bt[n][0], Bt[n][1]), PG8_CAT(At[m][0], At[m][1]), acc[ai][bj][m][n], 0, 0, 0, 0, 0, 0); \
        else { _Pragma("unroll") for (int k = 0; k < 2; ++k) acc[ai][bj][m][n] = __builtin_amdgcn_mfma_f32_16x16x32_bf16(Bt[n][k], At[m][k], acc[ai][bj][m][n], 0, 0, 0); } } __builtin_amdgcn_s_setprio(0); } while (0)
#define PG8_WAIT_V(n) asm volatile("s_waitcnt vmcnt(" #n ")" ::: "memory")
#define PG8_WAIT_L(n) asm volatile("s_waitcnt lgkmcnt(" #n ")" ::: "memory")
#define PG8_BAR __builtin_amdgcn_s_barrier()
#define PG8_SCHED __builtin_amdgcn_sched_barrier(0)
#define PG8_OFFS(dst, u) do { _Pragma("unroll") for (int _i = 0; _i < 2; ++_i) { int _R, _C; stage_rc(tid * 16 + _i * 8192, _R, _C); _Pragma("unroll") for (int _h = 0; _h < 2; ++_h) \
        dst[_h][_i] = (unsigned)S.arow((u).pm * BM + _h * HALF + _R) * g.lda_bytes + (unsigned)(_C * 2); } } while (0)
    Unit cur, nxt; int ui = 0;
    if (!S.next(0, cur)) return;
    f32x4 acc[2][2][4][2];
#pragma unroll
    for (int a = 0; a < 2; ++a)
#pragma unroll
        for (int b = 0; b < 2; ++b)
#pragma unroll
            for (int m = 0; m < 4; ++m)
#pragma unroll
                for (int n = 0; n < 2; ++n) acc[a][b][m][n] = (f32x4){0.f, 0.f, 0.f, 0.f};
    bf16x8 At[4][2], B0[2][2], B1[2][2];
    unsigned oC[2][2], oN[2][2];
    PG8_OFFS(oC, cur);
    const char* cB = (const char*)g.Bt + (size_t)cur.pn * tstep;
    PG8_STAGE(PG8_SB(0, 0), cB, voffB); PG8_STAGE(PG8_SB(0, 1), cB + hstep, voffB); PG8_STAGEA(PG8_SA(0, 0), oC[0][0], oC[0][1], 0); PG8_STAGEA(PG8_SA(0, 1), oC[1][0], oC[1][1], 0);
    if (wr == 1) PG8_BAR;
    PG8_WAIT_V(2); PG8_BAR;
    PG8_STAGE(PG8_SB(1, 0), cB + kstep, voffB); PG8_STAGEA(PG8_SA(1, 0), oC[0][0], oC[0][1], kstep); PG8_STAGE(PG8_SB(1, 1), cB + hstep + kstep, voffB);
    PG8_WAIT_V(6); PG8_BAR;
#ifdef GM_PROBE
    unsigned long long gaccs[3] = {0, 0, 0}; unsigned long long gtp = __builtin_amdgcn_s_memrealtime();
#define GM_T(i) do { if (Epi::PROBE) { const unsigned long long t1_ = __builtin_amdgcn_s_memrealtime(); gaccs[i] += t1_ - gtp; gtp = t1_; } } while (0)
#else
#define GM_T(i)
#endif
    for (;;) {
        const bool has_next = S.next(ui + 1, nxt);
        if (has_next) { PG8_OFFS(oN, nxt); } else {
#pragma unroll
            for (int _h = 0; _h < 2; ++_h)
#pragma unroll
                for (int _i = 0; _i < 2; ++_i) oN[_h][_i] = oC[_h][_i]; }
        const char* nB = has_next ? (const char*)g.Bt + (size_t)nxt.pn * tstep : cB;
#pragma unroll 1
        for (int t = 0; t < nt; t += 2) {
            const bool last = (t == nt - 2);
            const size_t k1 = (size_t)(t + 1) * kstep;
            const size_t k2 = last ? 0 : (size_t)(t + 2) * kstep, k3 = k2 + kstep;
            const char* b2 = last ? nB : cB + (size_t)(t + 2) * kstep; const char* b3 = b2 + kstep;
            PG8_LDB(B0, 0, 0); PG8_LDB(B1, 0, 1); PG8_SCHED; PG8_LDA(At, 0, 0); PG8_STAGEA(PG8_SA(1, 1), oC[1][0], oC[1][1], k1);
            if (last) { oC[0][0] = oN[0][0]; oC[0][1] = oN[0][1]; oC[1][0] = oN[1][0]; oC[1][1] = oN[1][1]; }
            PG8_WAIT_V(8); PG8_WAIT_L(0); PG8_BAR; PG8_MMA(0, 0, At, B0); PG8_MMA(0, 1, At, B1); PG8_BAR; PG8_SCHED;
            PG8_LDA(At, 0, 1); PG8_STAGE(PG8_SB(0, 0), b2, voffB); PG8_STAGE(PG8_SB(0, 1), b2 + hstep, voffB); PG8_STAGEA(PG8_SA(0, 0), oC[0][0], oC[0][1], k2);
            PG8_WAIT_V(8); PG8_WAIT_L(0); PG8_BAR; PG8_MMA(1, 0, At, B0); PG8_MMA(1, 1, At, B1); PG8_BAR; PG8_SCHED;
            PG8_LDB(B0, 1, 0); PG8_LDB(B1, 1, 1); PG8_SCHED; PG8_LDA(At, 1, 0); PG8_STAGEA(PG8_SA(0, 1), oC[1][0], oC[1][1], k2);
            PG8_WAIT_V(8); PG8_WAIT_L(0); PG8_BAR; PG8_MMA(0, 0, At, B0); PG8_MMA(0, 1, At, B1); PG8_BAR; PG8_SCHED;
            PG8_LDA(At, 1, 1); PG8_STAGE(PG8_SB(1, 0), b3, voffB); PG8_STAGE(PG8_SB(1, 1), b3 + hstep, voffB); PG8_STAGEA(PG8_SA(1, 0), oC[0][0], oC[0][1], k3);
            PG8_WAIT_V(8); PG8_WAIT_L(0); PG8_BAR; PG8_MMA(1, 0, At, B0); PG8_MMA(1, 1, At, B1); PG8_BAR; PG8_SCHED;
        }
        GM_T(0);
        if constexpr (ALIGN_EPI) { if (wr == 0) PG8_BAR; }
        GM_T(1);
        E(acc, cur, wr, wc, fr, fq);
        GM_T(2);
        if (!has_next) break;
#pragma unroll
        for (int a = 0; a < 2; ++a)
#pragma unroll
            for (int b = 0; b < 2; ++b)
#pragma unroll
                for (int m = 0; m < 4; ++m)
#pragma unroll
                    for (int n = 0; n < 2; ++n) acc[a][b][m][n] = (f32x4){0.f, 0.f, 0.f, 0.f};
        cur = nxt; cB = nB; ++ui;
#pragma unroll
        for (int _h = 0; _h < 2; ++_h)
#pragma unroll
            for (int _i = 0; _i < 2; ++_i) oC[_h][_i] = oN[_h][_i];
        if constexpr (ALIGN_EPI) { if (wr == 1) PG8_BAR; }
    }
#ifdef GM_PROBE
    if (Epi::PROBE && blockIdx.x == 0 && tid == 0) { unsigned long long* ts = (unsigned long long*)(S.probe_ts()); if (ts) { ts[50] = 0; ts[51] = gaccs[0]; ts[52] = gaccs[0] + gaccs[1]; ts[53] = gaccs[0] + gaccs[1] + gaccs[2]; } }
#endif
    PG8_WAIT_V(0);
    if constexpr (!ALIGN_EPI) { if (wr == 0) PG8_BAR; }
    PG8_BAR;
    if constexpr (Epi::AFTER_DRAIN) E.fused(acc, cur, wr, wc, fr, fq, lds);
#undef PG8_SA
#undef PG8_SB
#undef PG8_STAGE
#undef PG8_STAGEA
#undef PG8_LDA
#undef PG8_LDB
#undef PG8_MMA
#undef PG8_CAT
#undef PG8_WAIT_V
#undef PG8_WAIT_L
#undef PG8_BAR
#undef PG8_SCHED
#undef PG8_OFFS
#undef GM_T
}

template <class Epi, class Sched>
__device__ __noinline__ void gemm_phase_ni(PG8_LAS unsigned char* lds, Gemm g, Sched S, Epi E) { gemm_phase<Epi, Sched>(lds, g, S, E, (int)threadIdx.x); }
}

namespace mk {
using namespace pg8;
constexpr int D = 1024, NB = 32, SEQ = 2048, T = NB * SEQ, LC = 256, TC = NB * LC, TT = T + TC;
constexpr int NMOD = 6 * D;
constexpr int NE = 64, NEX = 65, DE = 256;
constexpr int NCH = 2, CHT = T / NCH, BPC = 256 / NCH;
constexpr int MAXTILES = (CHT * 8 + 64 * 255) / 256 + CHT / 256 + 1, CHROWS = MAXTILES * 256;
constexpr float RMS_EPS = 1e-6f;
constexpr int NWAVES = 8, NTHR = 512;

constexpr size_t MiB = 1u << 20;
constexpr size_t WS_CTL = 0, CTL_ZERO_BYTES = 64 * 1024;
constexpr size_t WS_MOD = 1 * MiB;
constexpr size_t WS_ROPE = 3 * MiB;
constexpr size_t WS_BC = 3 * MiB + 65536;
constexpr size_t WS_TEG = 3 * MiB + 2 * 65536;
constexpr size_t WS_GATES = 4 * MiB;
constexpr size_t WS_FILT = 10 * MiB;
constexpr size_t WS_EIDX = 18 * MiB, WS_WTS = 20 * MiB, WS_PSLOT = 22 * MiB, WS_SORT = 26 * MiB;
constexpr size_t WS_WIN0 = 30 * MiB;
constexpr size_t WS_WOUT0 = 38 * MiB, WS_WIN1 = 40 * MiB, WS_WOUT1 = 46 * MiB, WS_WR = 48 * MiB;
constexpr size_t WS_GU = 50 * MiB;
constexpr size_t WS_X8 = 116 * MiB;
constexpr size_t WS_DN = 180 * MiB;
constexpr size_t WS_BIG = 246 * MiB;
constexpr size_t WS_END = 1024 * MiB;
static_assert(WS_PSLOT + (size_t)T * 16 * 4 <= WS_SORT && WS_SORT + (size_t)NCH * CHROWS * 4 <= WS_WIN0 && WS_WIN0 + (size_t)3840 * 2048 <= WS_WOUT0 && WS_WR + (size_t)2 * 256 * 2048 <= WS_GU && WS_GU + (size_t)2 * 65 * 512 * 1024 <= WS_X8 && WS_X8 + (size_t)T * D <= WS_DN && WS_DN + (size_t)2 * 65 * 1024 * 512 <= WS_BIG, "ws map");
constexpr size_t A0_H = 0, A0_QA = 144 * MiB, A0_KA = 208 * MiB, A0_VA = 280 * MiB, A0_BQ = 352 * MiB, A0_BK = 416 * MiB, A0_BV = 488 * MiB, A0_BO = 560 * MiB, A0_VT = 624 * MiB;
constexpr size_t A0_MIXIN = 0, A0_HB = 144 * MiB, A0_MIX = 352 * MiB;
constexpr int CW_BAR = 4096;

constexpr int LDS_BYTES = 160 * 1024;
constexpr int LDS_TAB = 131072;
constexpr int LDS_MISC = 131072 + 24 * 1024;

#define GAS __attribute__((address_space(1)))
#define LAS __attribute__((address_space(3)))
typedef unsigned short bf16;
typedef unsigned v4u __attribute__((ext_vector_type(4)));
typedef unsigned v2u __attribute__((ext_vector_type(2)));
#define LDS_WAIT() asm volatile("s_waitcnt lgkmcnt(0)" ::: "memory")
#define VM_WAIT() asm volatile("s_waitcnt vmcnt(0)" ::: "memory")
__device__ __forceinline__ unsigned f2bf(float f) { unsigned u = __builtin_bit_cast(unsigned, f); return (u + 0x7fffu + ((u >> 16) & 1u)) >> 16; }
typedef float f32x2_t __attribute__((ext_vector_type(2))); typedef __bf16 bf16x2_t __attribute__((ext_vector_type(2)));
__device__ __forceinline__ unsigned pk2(float lo, float hi) { const f32x2_t v = {lo, hi}; return __builtin_bit_cast(unsigned, __builtin_convertvector(v, bf16x2_t)); }
__device__ __forceinline__ float bf_lo(unsigned w) { return __builtin_bit_cast(float, w << 16); }
__device__ __forceinline__ float bf_hi(unsigned w) { return __builtin_bit_cast(float, w & 0xffff0000u); }
__device__ __forceinline__ float bf1(bf16 h) { return __builtin_bit_cast(float, (unsigned)h << 16); }
__device__ __forceinline__ int lane_opq() { int l = (int)__builtin_amdgcn_mbcnt_hi(~0u, __builtin_amdgcn_mbcnt_lo(~0u, 0u)); asm volatile("" : "+v"(l)); return l; }
__device__ __forceinline__ float shx(float v, int m) { return __builtin_bit_cast(float, __builtin_amdgcn_ds_bpermute((lane_opq() ^ m) << 2, __builtin_bit_cast(int, v))); }
__device__ __forceinline__ float shup(float v, int o) { const int l = lane_opq(); return __builtin_bit_cast(float, __builtin_amdgcn_ds_bpermute((l >= o ? l - o : l) << 2, __builtin_bit_cast(int, v))); }
__device__ __forceinline__ float shidx(float v, int idx) { return __builtin_bit_cast(float, __builtin_amdgcn_ds_bpermute(idx << 2, __builtin_bit_cast(int, v))); }
__device__ __forceinline__ float wave_sum(float v) {
#pragma unroll
    for (int o = 1; o < 64; o <<= 1) v += shx(v, o);
    return v;
}
__device__ __forceinline__ float wave_max(float v) {
#pragma unroll
    for (int o = 1; o < 64; o <<= 1) v = fmaxf(v, shx(v, o));
    return v;
}
__device__ __forceinline__ float sigmoidf_(float x) { return __builtin_amdgcn_rcpf(1.f + __expf(-x)); }
__device__ __forceinline__ float siluf_(float x) { return x * __builtin_amdgcn_rcpf(1.f + __expf(-x)); }
#define XB_TMO      128
#define XB_XCNT(j)  (256  + 64 * (j))
#define XB_XSUB(j)  (1280 + 64 * (j))
#define XB_XGEN(j)  (2304 + 64 * (j))
#define XB_TOP      3328
#define XB_TOPGEN   3392
#define XCD_BAR_WORDS 3456
#define XB_SPIN_CAP (1u << 18)

__device__ __forceinline__ unsigned xb_ld(unsigned* p)              { return __hip_atomic_load(p, __ATOMIC_RELAXED, __HIP_MEMORY_SCOPE_AGENT); }
__device__ __forceinline__ unsigned xb_add(unsigned* p, unsigned v) { return __hip_atomic_fetch_add(p, v, __ATOMIC_RELAXED, __HIP_MEMORY_SCOPE_AGENT); }
__device__ __forceinline__ unsigned xb_xcc_id() { return (unsigned)__builtin_amdgcn_s_getreg((3 << 11) | 20) & 0xFu; }
#define XB_SPIN(cond, bar) do { unsigned _sp = 0; while (cond) { __builtin_amdgcn_s_sleep(1); \
    if ((++_sp & 255u) == 0u) { if (xb_ld(&(bar)[XB_TMO])) break; if (_sp > XB_SPIN_CAP) { atomicAdd(&(bar)[XB_TMO], 1u); break; } } } } while (0)

struct XcdBarrier {
    unsigned* bar; unsigned x;
    volatile LAS unsigned* st;
};

__device__ __forceinline__ XcdBarrier xcd_barrier_post(unsigned* bar, volatile LAS unsigned* st) {
    XcdBarrier b; b.bar = bar; b.x = xb_xcc_id(); b.st = st;
    if (threadIdx.x == 0) (void)xb_add(&bar[XB_XCNT(b.x)], 1u);
    return b;
}
__device__ __forceinline__ void xcd_barrier_complete(unsigned* bar, unsigned x, unsigned& nloc, unsigned& nx) {
    const unsigned G = gridDim.x * gridDim.y * gridDim.z;
    unsigned sum, cnt, mine, sp = 0u;
    for (;;) {
        sum = 0u; cnt = 0u; mine = 0u;
#pragma unroll
        for (unsigned j = 0; j < 16; ++j) { const unsigned c = xb_ld(&bar[XB_XCNT(j)]); sum += c; cnt += (c > 0u) ? 1u : 0u; mine = (j == x) ? c : mine; }
        if (sum == G) break;
        __builtin_amdgcn_s_sleep(1);
        if ((++sp & 255u) == 0u) { if (xb_ld(&bar[XB_TMO])) break; if (sp > XB_SPIN_CAP) { atomicAdd(&bar[XB_TMO], 1u); break; } }
    }
    nloc = mine > 0u ? mine : 1u; nx = cnt > 0u ? cnt : 1u;
}

__device__ __forceinline__ void xcd_barrier(const XcdBarrier& b, const bool t0  ) {
    asm volatile("s_waitcnt vmcnt(0)" ::: "memory");
    __syncthreads();
    if (t0) {
        unsigned* bar = b.bar;
        __builtin_amdgcn_s_waitcnt(0);
        unsigned nloc = b.st[0], nx = b.st[1];
        if (nloc == 0u) { xcd_barrier_complete(bar, b.x, nloc, nx); b.st[0] = nloc; b.st[1] = nx; }
        const unsigned old = xb_add(&bar[XB_XSUB(b.x)], 1u);
        const unsigned gen = old / nloc;
        if (old + 1u == (gen + 1u) * nloc) {
            __builtin_amdgcn_fence(__ATOMIC_RELEASE, "agent");
            asm volatile("s_waitcnt vmcnt(0)" ::: "memory");
            const unsigned og = xb_add(&bar[XB_TOP], 1u);
            const unsigned tg = og / nx;
            if (og + 1u == (tg + 1u) * nx) xb_add(&bar[XB_TOPGEN], 1u);
            else XB_SPIN(xb_ld(&bar[XB_TOPGEN]) == tg, bar);
            __builtin_amdgcn_fence(__ATOMIC_ACQUIRE, "agent");
            xb_add(&bar[XB_XGEN(b.x)], 1u);
            asm volatile("s_waitcnt vmcnt(0)" ::: "memory");
        } else {
            XB_SPIN(xb_ld(&bar[XB_XGEN(b.x)]) == gen, bar);
            __builtin_amdgcn_fence(__ATOMIC_ACQUIRE, "agent");
            asm volatile("s_waitcnt vmcnt(0)" ::: "memory");
        }
    }
    __syncthreads();
}

constexpr float Y8_SCALE = 16.f, Y8_INV = 1.f / 16.f;
constexpr float X8_SCALE = 16.f, GU8_SCALE = 256.f, G1_INV = 1.f / (X8_SCALE * GU8_SCALE), ACT8_SCALE = 8.f, DN8_SCALE = 128.f, G2_INV = 1.f / (ACT8_SCALE * DN8_SCALE);
struct Params { const float* in[31]; float* out; unsigned char* ws; int ph_lo, ph_hi; };
enum { I_X = 0, I_C, I_CTX, I_CCTX, I_WMOD, I_BMOD, I_NORMG, I_WINAB, I_CONVABW, I_CONVABB, I_GATEB, I_DLAM, I_HGA, I_HGB, I_WOUTAB, I_WINHY, I_CONVHYW, I_CONVHYB,
       I_FW1, I_FB1, I_FW2, I_FB2, I_FW3, I_FBIAS, I_WOUTHY, I_RW, I_RB, I_EGU, I_EDN, I_SGU, I_SDN };

__device__ __forceinline__ void row_ld_f32(const float* row, int lane, f32x4 (&v)[4]) { const f32x4* r = (const f32x4*)row + lane;
#pragma unroll
    for (int j = 0; j < 4; ++j) v[j] = r[64 * j]; }
__device__ __forceinline__ void row_st_f32(float* row, int lane, const f32x4 (&v)[4]) { f32x4* r = (f32x4*)row + lane;
#pragma unroll
    for (int j = 0; j < 4; ++j) r[64 * j] = v[j]; }
__device__ __forceinline__ void row_ld_bf16(const bf16* row, int lane, f32x4 (&v)[4]) { const v2u* r = (const v2u*)row + lane;
#pragma unroll
    for (int j = 0; j < 4; ++j) { const v2u w = r[64 * j]; v[j] = (f32x4){bf_lo(w.x), bf_hi(w.x), bf_lo(w.y), bf_hi(w.y)}; } }
__device__ __forceinline__ void row_st_bf16(bf16* row, int lane, const f32x4 (&v)[4]) { v2u* r = (v2u*)row + lane;
#pragma unroll
    for (int j = 0; j < 4; ++j) { v2u w; w.x = pk2(v[j].x, v[j].y); w.y = pk2(v[j].z, v[j].w); r[64 * j] = w; } }
__device__ __forceinline__ unsigned fp8x4(float a, float b, float c, float d, float sc) {
    a = __builtin_amdgcn_fmed3f(a * sc, -440.f, 440.f); b = __builtin_amdgcn_fmed3f(b * sc, -440.f, 440.f); c = __builtin_amdgcn_fmed3f(c * sc, -440.f, 440.f); d = __builtin_amdgcn_fmed3f(d * sc, -440.f, 440.f);
    int w = 0; w = __builtin_amdgcn_cvt_pk_fp8_f32(a, b, w, false); w = __builtin_amdgcn_cvt_pk_fp8_f32(c, d, w, true); return (unsigned)w; }
__device__ __forceinline__ void row_st_fp8(unsigned char* row, int lane, const f32x4 (&v)[4], float sc) { unsigned* r = (unsigned*)row + lane;
#pragma unroll
    for (int j = 0; j < 4; ++j) r[64 * j] = fp8x4(v[j].x, v[j].y, v[j].z, v[j].w, sc); }
__device__ __forceinline__ float row_ss(const f32x4 (&v)[4]) { float s = 0.f;
#pragma unroll
    for (int j = 0; j < 4; ++j) s += (v[j].x * v[j].x + v[j].y * v[j].y) + (v[j].z * v[j].z + v[j].w * v[j].w);
    return wave_sum(s); }
__device__ __forceinline__ void row_modulate(const f32x4 (&x)[4], float rstd, const float* g, const float* shift, const float* scale, int lane, f32x4 (&h)[4]) {
    const f32x4* gp = (const f32x4*)g + lane; const f32x4* sh = (const f32x4*)shift + lane; const f32x4* sc = (const f32x4*)scale + lane;
#pragma unroll
    for (int j = 0; j < 4; ++j) { const f32x4 gg = gp[64 * j], s1 = sc[64 * j], s0 = sh[64 * j]; h[j] = x[j] * rstd * gg * (1.f + s1) + s0; } }

__device__ __forceinline__ void pro_mod(const Params& p, LAS unsigned char* lds, int tid, int lane, int wave) {
    const int u = blockIdx.x; if (u >= 192) return;
    LAS float* S = (LAS float*)lds;
    const float* c = p.in[I_C]; const float* cc = p.in[I_CCTX];
#pragma unroll 4
    for (int i = tid; i < 33 * 256; i += NTHR) { const int b = i >> 8, k4 = (i & 255) * 4; const f32x4 v = b < 32 ? *(const f32x4*)(c + b * 1024 + k4) : *(const f32x4*)(cc + k4);
        *(LAS f32x4*)(S + b * 1024 + k4) = (f32x4){siluf_(v[0]), siluf_(v[1]), siluf_(v[2]), siluf_(v[3])}; }
    __syncthreads();
    const int l = u / 96, cg = (u % 96) * 64, col = cg + lane;
    const float* W = p.in[I_WMOD] + (size_t)l * 1024 * NMOD;
    float acc[33];
#pragma unroll
    for (int b = 0; b < 33; ++b) acc[b] = 0.f;
    const int k0 = wave * 128;
#pragma unroll 4
    for (int kk = 0; kk < 128; kk += 4) { const int k = k0 + kk;
        const float w0 = W[(size_t)k * NMOD + col], w1 = W[(size_t)(k + 1) * NMOD + col], w2 = W[(size_t)(k + 2) * NMOD + col], w3 = W[(size_t)(k + 3) * NMOD + col];
#pragma unroll
        for (int b = 0; b < 33; ++b) { const f32x4 s = *(const LAS f32x4*)(S + b * 1024 + k); acc[b] += (s.x * w0 + s.y * w1) + (s.z * w2 + s.w * w3); } }
    __syncthreads();
    LAS float* P = (LAS float*)lds;
#pragma unroll
    for (int b = 0; b < 33; ++b) P[(wave * 33 + b) * 64 + lane] = acc[b];
    __syncthreads();
    float* MOD = (float*)(p.ws + WS_MOD);
#pragma unroll 1
    for (int i = tid; i < 33 * 64; i += NTHR) { const int b = i >> 6, ln = i & 63; float s = 0.f;
#pragma unroll
        for (int w = 0; w < 8; ++w) s += P[(w * 33 + b) * 64 + ln];
        MOD[(size_t)(l * 33 + b) * NMOD + cg + ln] = s + p.in[I_BMOD][l * NMOD + cg + ln]; }
    __syncthreads();
}
__device__ __forceinline__ int rowmap(int kind, int n) {
    if (kind == 1) { const int o = n & 31; return (n & ~31) + (((o & 15) >> 2) * 8 + (o >> 4) * 4 + (o & 3)); }
    if (kind == 2) { return n < 256 ? ((n >> 7) * 256 + (n & 127)) : ((((n - 256) >> 7) * 256) + 128 + ((n - 256) & 127)); }
    if (kind == 3) { const int a = n & 255; return (n & ~255) + 128 * ((a >> 3) & 1) + 32 * (a >> 6) + 8 * ((a >> 4) & 3) + (a & 7); }
    return n;
}
struct TrDesc { const float* W; bf16* WT; int ldn, k0, n0, nvalid, dK, kind, row_base; };
__device__ __forceinline__ TrDesc tr_decode(const Params& p, int it) {
    constexpr int I_A = 16 * 113, I_B = 512, I_C2 = 1536, I_D = 512, I_E = 64, I_F = 130 * 256;
    unsigned char* ws = p.ws; int r = it;
    if (r < I_A) { const int kb = r / 113, nb = r % 113, n0 = nb * 32; const int kind = (n0 < 512 || (n0 >= 1536 && n0 < 2048)) ? 1 : 0;
        return TrDesc{p.in[I_WINAB], (bf16*)(ws + WS_WIN0), 3600, kb * 64, n0, 3600, 1024, kind, 0}; } r -= I_A;
    if (r < I_B) return TrDesc{p.in[I_WOUTAB], (bf16*)(ws + WS_WOUT0), 1024, (r / 32) * 64, (r % 32) * 32, 1024, 1024, 0, 0}; r -= I_B;
    if (r < I_C2) return TrDesc{p.in[I_WINHY], (bf16*)(ws + WS_WIN1), 3072, (r / 96) * 64, (r % 96) * 32, 3072, 1024, 0, 0}; r -= I_C2;
    if (r < I_D) return TrDesc{p.in[I_WOUTHY], (bf16*)(ws + WS_WOUT1), 1024, (r / 32) * 64, (r % 32) * 32, 1024, 1024, 0, 0}; r -= I_D;
    if (r < I_E) { const int l = r / 32, q = r % 32; return TrDesc{p.in[I_RW] + (size_t)l * 1024 * 64, (bf16*)(ws + WS_WR) + (size_t)l * 256 * 1024, 64, (q / 2) * 64, (q % 2) * 32, 64, 1024, 0, 0}; } r -= I_E;
    if (r < I_F) { const int mat = r / 256, q = r % 256, l = mat / 65, e = mat % 65;
        const float* src = e < 64 ? p.in[I_EGU] + (size_t)(l * 64 + e) * 1024 * 512 : p.in[I_SGU] + (size_t)l * 1024 * 512;
        return TrDesc{src, (bf16*)(ws + WS_GU + (size_t)l * (65 * 512) * 1024), 512, (q / 16) * 64, (q % 16) * 32, 512, 1024, 2, e * 512}; } r -= I_F;
    { const int mat = r / 128, q = r % 128, l = mat / 65, e = mat % 65;
        const float* src = e < 64 ? p.in[I_EDN] + (size_t)(l * 64 + e) * 256 * 1024 : p.in[I_SDN] + (size_t)l * 256 * 1024;
        return TrDesc{src, (bf16*)(ws + WS_DN + (size_t)l * (65 * 1024) * 256), 1024, (q / 32) * 64, (q % 32) * 32, 1024, 256, 3, e * 1024}; }
}
__device__ __forceinline__ void tr_load(const TrDesc& d, int lane, float (&v)[32]) {
    const int nn = d.n0 + (lane & 31); const bool ok = nn < d.nvalid; const float* src = d.W + (size_t)(d.k0 + (lane >> 5)) * d.ldn + (ok ? nn : 0);
#pragma unroll
    for (int i = 0; i < 32; ++i) v[i] = src[(size_t)(2 * i) * d.ldn];
    if (!ok) {
#pragma unroll
        for (int i = 0; i < 32; ++i) v[i] = 0.f; }
}
__device__ __forceinline__ void tr_finish(const TrDesc& d, const float (&v)[32], LAS float* scr, int lane) {
#pragma unroll
    for (int i = 0; i < 32; ++i) scr[(2 * i + (lane >> 5)) * 33 + (lane & 31)] = v[i];
    LDS_WAIT(); asm volatile("" ::: "memory");
    const int c = lane & 7;
#pragma unroll
    for (int j = 0; j < 4; ++j) { const int n = (lane >> 3) + 8 * j; const LAS float* s = scr + (8 * c) * 33 + n;
        const int row = d.row_base + rowmap(d.kind, d.n0 + n);
        if (d.kind >= 2) { const float ws_ = d.kind == 2 ? GU8_SCALE : DN8_SCALE; v2u o; o.x = fp8x4(s[0 * 33], s[1 * 33], s[2 * 33], s[3 * 33], ws_); o.y = fp8x4(s[4 * 33], s[5 * 33], s[6 * 33], s[7 * 33], ws_);
            *(v2u*)((unsigned char*)d.WT + (size_t)row * d.dK + d.k0 + 8 * c) = o; }
        else { v4u o; o.x = pk2(s[0 * 33], s[1 * 33]); o.y = pk2(s[2 * 33], s[3 * 33]); o.z = pk2(s[4 * 33], s[5 * 33]); o.w = pk2(s[6 * 33], s[7 * 33]);
            *(v4u*)(d.WT + (size_t)row * d.dK + d.k0 + 8 * c) = o; } }
    LDS_WAIT(); asm volatile("" ::: "memory");
}
__device__ __forceinline__ void pro_transposes(const Params& p, LAS unsigned char* lds, int lane, int wave) {
    LAS float* scr = (LAS float*)(lds + wave * 16384);
    const int gw = blockIdx.x * NWAVES + wave, NGW = gridDim.x * NWAVES;
    constexpr int NITEMS = 16 * 113 + 512 + 1536 + 512 + 64 + 130 * 256 + 130 * 128;
    if (gw >= NITEMS) return;
    TrDesc dc = tr_decode(p, gw); float vc[32]; tr_load(dc, lane, vc);
#pragma unroll 1
    for (int it = gw; it < NITEMS; it += NGW) {
        const bool more = it + NGW < NITEMS; TrDesc dn = dc; float vn[32];
        if (more) { dn = tr_decode(p, it + NGW); tr_load(dn, lane, vn); }
        tr_finish(dc, vc, scr, lane);
        if (more) { dc = dn;
#pragma unroll
            for (int i = 0; i < 32; ++i) vc[i] = vn[i]; }
    }
}
__device__ __forceinline__ void pro_rope(const Params& p, int tid) {
    if (blockIdx.x != 255) return;
    float* R = (float*)(p.ws + WS_ROPE);
    for (int i = tid; i < 64 * 16; i += NTHR) { const int pos = i >> 4, f = i & 15; const float inv = exp2f(-(float)f * (13.287712379549449f / 16.f)); const float ang = (float)pos * inv;
        float sn, cs; sincosf(ang, &sn, &cs); R[2 * i] = cs; R[2 * i + 1] = sn; }
}
__device__ __forceinline__ void pro_filters(const Params& p, LAS unsigned char* lds, int tid, int lane, int wave) {
    LAS float* Z = (LAS float*)lds;
    LAS float* H1 = Z + 512;
    LAS float* H2 = H1 + 512;
    const int j0 = 8 * blockIdx.x, j = j0 + wave;
    const float* fw1 = p.in[I_FW1]; const float* fb1 = p.in[I_FB1]; const float* fw2 = p.in[I_FW2]; const float* fb2 = p.in[I_FB2]; const float* fw3 = p.in[I_FW3];
    {   float z = 0.f;
        if (lane == 0) z = (float)j / 2047.f;
        else if (lane < 33) { const int k = (lane - 1) & 15; const float fr = 1e-4f + (float)k * ((15.f - 1e-4f) / 15.f); const float ang = (6.283185307179586f / 2048.f) * (float)j * fr;
            float sn, cs; sincosf(ang, &sn, &cs); z = lane < 17 ? cs : -sn; }
        Z[wave * 64 + lane] = z; }
    LDS_WAIT(); asm volatile("" ::: "memory");
    {   float a = fb1[lane];
#pragma unroll 11
        for (int k = 0; k < 33; ++k) a += Z[wave * 64 + k] * fw1[k * 64 + lane];
        H1[wave * 64 + lane] = sinf(a); }
    LDS_WAIT(); asm volatile("" ::: "memory");
    {   float a = fb2[lane];
#pragma unroll 16
        for (int k = 0; k < 64; ++k) a += H1[wave * 64 + k] * fw2[k * 64 + lane];
        H2[wave * 64 + lane] = sinf(a); }
    __syncthreads();
    bf16* F = (bf16*)(p.ws + WS_FILT);
    const float mind = -4.605170185988091f / 1.5f, maxd = -4.605170185988091f / 0.3f;
#pragma unroll 1
    for (int i = 0; i < 4; ++i) { const int n = tid + NTHR * i, c = n & 1023;
        float acc[8];
#pragma unroll
        for (int q = 0; q < 8; ++q) acc[q] = 0.f;
#pragma unroll 16
        for (int k = 0; k < 64; ++k) { const float w = fw3[k * 2048 + n];
#pragma unroll
            for (int q = 0; q < 8; ++q) acc[q] += H2[q * 64 + k] * w; }
        const float delta = fabsf(mind + (float)c * ((maxd - mind) / 1023.f));
        float o[8];
#pragma unroll
        for (int q = 0; q < 8; ++q) { const float dist = fabsf((float)(j0 + q) - 1024.f) * (1.f / 1024.f); o[q] = acc[q] * expf(-dist * delta); }
        v4u w; w.x = pk2(o[0], o[1]); w.y = pk2(o[2], o[3]); w.z = pk2(o[4], o[5]); w.w = pk2(o[6], o[7]);
        *(v4u*)(F + (size_t)n * 2048 + j0) = w; }
    __syncthreads();
}

__device__ __forceinline__ void l0_norm_rows(const float* src, bf16* dst, int nrows, const float* g, const float* md, int lane) {
    f32x4 vb[4], vc[4];
#pragma unroll
    for (int j = 0; j < 4; ++j) { const int o = 4 * lane + 256 * j; vb[j] = *(const f32x4*)(g + o) * (1.f + *(const f32x4*)(md + D + o)); vc[j] = *(const f32x4*)(md + o); }
    f32x4 xn[4]; row_ld_f32(src, lane, xn);
#pragma unroll 1
    for (int i = 0; i < nrows; ++i) { f32x4 x[4], h[4];
#pragma unroll
        for (int j = 0; j < 4; ++j) x[j] = xn[j];
        if (i + 1 < nrows) row_ld_f32(src + (size_t)(i + 1) * D, lane, xn);
        const float rstd = rsqrtf(row_ss(x) * (1.f / D) + RMS_EPS);
#pragma unroll
        for (int j = 0; j < 4; ++j) h[j] = x[j] * rstd * vb[j] + vc[j];
        row_st_bf16(dst + (size_t)i * D, lane, h); }
}
__device__ __forceinline__ void ph_l0_norm(const Params& p, int lane, int wave) {
    const int gw = blockIdx.x * NWAVES + wave;
    const float* MOD = (const float*)(p.ws + WS_MOD); bf16* H = (bf16*)(p.ws + WS_BIG + A0_H);
    const float* g = p.in[I_NORMG];
    { const int m0 = gw * 32; l0_norm_rows(p.in[I_X] + (size_t)m0 * D, H + (size_t)m0 * D, 32, g, MOD + (size_t)(m0 >> 11) * NMOD, lane); }
    { const int m0 = gw * 4; l0_norm_rows(p.in[I_CTX] + (size_t)m0 * D, H + (size_t)(T + m0) * D, 4, g, MOD + (size_t)32 * NMOD, lane); }
}
__device__ __forceinline__ void ph_mid(const Params& p, int l, const bf16* MIX, bf16* H2, unsigned char* X8, bool has_mix, int lane, int wave, int tile) {
    const int gw = tile * NWAVES + wave;
    const float* MOD = (const float*)(p.ws + WS_MOD) + (size_t)l * 33 * NMOD;
    const float* g1 = p.in[I_NORMG] + (size_t)(l * 4 + 1) * D; const float* g2 = p.in[I_NORMG] + (size_t)(l * 4 + 2) * D;
    const float* xin = l == 0 ? p.in[I_X] : p.out;
    const int m0 = gw * 32; const float* md = MOD + (size_t)(m0 >> 11) * NMOD;
    f32x4 va[4], vb[4], vc[4];
#pragma unroll
    for (int j = 0; j < 4; ++j) { const int o = 4 * lane + 256 * j; va[j] = *(const f32x4*)(md + 2 * D + o) * *(const f32x4*)(g1 + o); vb[j] = *(const f32x4*)(g2 + o) * (1.f + *(const f32x4*)(md + 4 * D + o)); vc[j] = *(const f32x4*)(md + 3 * D + o); }
    f32x4 xn[4], mn[4];
    row_ld_f32(xin + (size_t)m0 * D, lane, xn); if (has_mix) row_ld_bf16(MIX + (size_t)m0 * D, lane, mn);
#pragma unroll 1
    for (int m = m0; m < m0 + 32; ++m) {
        f32x4 x[4], h[4], mx[4];
#pragma unroll
        for (int j = 0; j < 4; ++j) { x[j] = xn[j]; mx[j] = mn[j]; }
        if (m + 1 < m0 + 32) { row_ld_f32(xin + (size_t)(m + 1) * D, lane, xn); if (has_mix) row_ld_bf16(MIX + (size_t)(m + 1) * D, lane, mn); }
        if (has_mix) { const float r = rsqrtf(row_ss(mx) * (1.f / D) + RMS_EPS);
#pragma unroll
            for (int j = 0; j < 4; ++j) x[j] = x[j] + va[j] * (mx[j] * r); }
        row_st_f32(p.out + (size_t)m * D, lane, x);
        const float rstd = rsqrtf(row_ss(x) * (1.f / D) + RMS_EPS);
#pragma unroll
        for (int j = 0; j < 4; ++j) h[j] = x[j] * rstd * vb[j] + vc[j];
        row_st_bf16(H2 + (size_t)m * D, lane, h);
        row_st_fp8(X8 + (size_t)m * D, lane, h, X8_SCALE);
    }
}
__device__ __forceinline__ void ph_combine(const Params& p, int l, int ch, const unsigned char* Y8, bf16* Hn, int lane, int wave) {
    const int gw = blockIdx.x * NWAVES + wave;
    const float* MOD = (const float*)(p.ws + WS_MOD) + (size_t)l * 33 * NMOD;
    const float* g3 = p.in[I_NORMG] + (size_t)(l * 4 + 3) * D;
    const int* PSLOT = (const int*)(p.ws + WS_PSLOT); const float* WTS = (const float*)(p.ws + WS_WTS);
    constexpr int RPW = CHT / 2048;
    const int mbase = ch * CHT + gw * RPW; const float* md = MOD + (size_t)(mbase >> 11) * NMOD;
    float va[16], vb[16], vc[16];
    { const float* md1 = MOD + (size_t)(33 + (mbase >> 11)) * NMOD; const float* g10 = p.in[I_NORMG] + (size_t)4 * D;
#pragma unroll
      for (int q = 0; q < 4; ++q) { const int o = lane * 16 + 4 * q; const f32x4 gp = *(const f32x4*)(g3 + o), gf = *(const f32x4*)(md + 5 * D + o); f32x4 gg = gp, sh = gp, sc = gp;
          if (l == 0) { gg = *(const f32x4*)(g10 + o); sh = *(const f32x4*)(md1 + o); sc = *(const f32x4*)(md1 + D + o); }
#pragma unroll
          for (int j = 0; j < 4; ++j) { va[4 * q + j] = gp[j] * gf[j]; vb[4 * q + j] = gg[j] * (1.f + sc[j]); vc[4 * q + j] = sh[j]; } } }
    int sl[9]; float wk[9];
#define CMB_SLOTS(mt) do { _Pragma("unroll") for (int k = 0; k < 9; ++k) { sl[k] = PSLOT[(size_t)(mt) * 16 + k]; wk[k] = k < 8 ? WTS[(size_t)(mt) * 8 + k] : 1.f; } } while (0)
    CMB_SLOTS(mbase);
#pragma unroll 1
    for (int m = mbase; m < mbase + RPW; ++m) {
        float a[16];
#pragma unroll
        for (int j = 0; j < 16; ++j) a[j] = 0.f;
        u32x4 yr[9]; float wc[9];
#pragma unroll
        for (int k = 0; k < 9; ++k) { yr[k] = *(const u32x4*)(Y8 + (size_t)sl[k] * 1024 + lane * 16); wc[k] = wk[k]; }
        float* orow = p.out + (size_t)m * D + lane * 16; f32x4 xv4[4];
#pragma unroll
        for (int q = 0; q < 4; ++q) xv4[q] = *(const f32x4*)(orow + 4 * q);
        if (m + 1 < mbase + RPW) CMB_SLOTS(m + 1);
#pragma unroll
        for (int k = 0; k < 9; ++k) { const float w = wc[k] * Y8_INV; const unsigned ww[4] = {yr[k].x, yr[k].y, yr[k].z, yr[k].w};
#pragma unroll
            for (int q = 0; q < 4; ++q) { a[4 * q + 0] += w * __builtin_amdgcn_cvt_f32_fp8((int)ww[q], 0); a[4 * q + 1] += w * __builtin_amdgcn_cvt_f32_fp8((int)ww[q], 1);
                                          a[4 * q + 2] += w * __builtin_amdgcn_cvt_f32_fp8((int)ww[q], 2); a[4 * q + 3] += w * __builtin_amdgcn_cvt_f32_fp8((int)ww[q], 3); } }
        float ss = 0.f;
#pragma unroll
        for (int j = 0; j < 16; ++j) ss += a[j] * a[j];
        const float r = rsqrtf(wave_sum(ss) * (1.f / D) + RMS_EPS);
        float x[16]; float s2 = 0.f;
#pragma unroll
        for (int q = 0; q < 4; ++q) {
#pragma unroll
            for (int j = 0; j < 4; ++j) { const float v = xv4[q][j] + va[4 * q + j] * (a[4 * q + j] * r); x[4 * q + j] = v; s2 += v * v; }
            *(f32x4*)(orow + 4 * q) = (f32x4){x[4 * q], x[4 * q + 1], x[4 * q + 2], x[4 * q + 3]}; }
        if (l == 0) { const float rstd = rsqrtf(wave_sum(s2) * (1.f / D) + RMS_EPS); float h[16];
#pragma unroll
            for (int j = 0; j < 16; ++j) h[j] = x[j] * rstd * vb[j] + vc[j];
            v4u w0, w1; w0.x = pk2(h[0], h[1]); w0.y = pk2(h[2], h[3]); w0.z = pk2(h[4], h[5]); w0.w = pk2(h[6], h[7]); w1.x = pk2(h[8], h[9]); w1.y = pk2(h[10], h[11]); w1.z = pk2(h[12], h[13]); w1.w = pk2(h[14], h[15]);
            *(v4u*)(Hn + (size_t)m * D + lane * 16) = w0; *(v4u*)(Hn + (size_t)m * D + lane * 16 + 8) = w1; }
    }
#undef CMB_SLOTS
}

struct DenseSched { int NN, NU, G, c, NMs;
    __device__ __forceinline__ bool next(int i, Unit& u) const { const int L = i * G + c; if (L >= NU) return false; if (NMs > 0) { u.pm = L % NMs; u.pn = L / NMs; } else { u.pm = L / NN; u.pn = L % NN; } return true; }
    __device__ __forceinline__ int arow(int r) const { return r; }
    __device__ __forceinline__ void* probe_ts() const { return nullptr; } };
struct PanelSched { int NN, pm;
    __device__ __forceinline__ bool next(int i, Unit& u) const { if (i >= NN) return false; u.pm = pm; u.pn = i; return true; }
    __device__ __forceinline__ int arow(int r) const { return r; }
    __device__ __forceinline__ void* probe_ts() const { return nullptr; } };
struct EpiBf16 { static constexpr bool PERM = true, AFTER_DRAIN = false, PROBE = false; bf16* O; size_t ldc; int cmask;
    __device__ __forceinline__ void operator()(const f32x4 (&acc)[2][2][4][2], const Unit& u, int wr, int wc, int fr, int fq) const {
        const int row0 = u.pm * BM + wr * 64 + fr, col0 = (u.pn & cmask) * BM + wc * 32 + 8 * fq;
#pragma unroll
        for (int ai = 0; ai < 2; ++ai)
#pragma unroll
            for (int m = 0; m < 4; ++m) { bf16* rowp = O + (size_t)(row0 + ai * HALF + m * 16) * ldc + col0;
#pragma unroll
                for (int bj = 0; bj < 2; ++bj) { const f32x4 v0 = acc[ai][bj][m][0], v1 = acc[ai][bj][m][1];
                    u32x4 w; w.x = cvt_pk_bf16(v0[0], v0[1]); w.y = cvt_pk_bf16(v0[2], v0[3]); w.z = cvt_pk_bf16(v1[0], v1[1]); w.w = cvt_pk_bf16(v1[2], v1[3]);
                    *(u32x4*)(rowp + bj * HALF) = w; } }
    } };
struct EpiRouter { static constexpr bool PERM = false, AFTER_DRAIN = false, PROBE = false; float* LOG;
    __device__ __forceinline__ void operator()(const f32x4 (&acc)[2][2][4][2], const Unit& u, int wr, int wc, int fr, int fq) const {
        if (wc >= 2) return;
        const int row0 = u.pm * BM + wr * 64 + fr, col0 = wc * 32 + 4 * fq;
#pragma unroll
        for (int ai = 0; ai < 2; ++ai)
#pragma unroll
            for (int m = 0; m < 4; ++m) { float* rowp = LOG + (size_t)(row0 + ai * HALF + m * 16) * 64 + col0;
#pragma unroll
                for (int n = 0; n < 2; ++n) *(f32x4*)(rowp + n * 16) = acc[ai][0][m][n]; }
    } };
struct EpiFp8 { static constexpr bool PERM = true, AFTER_DRAIN = false, PROBE = true; unsigned char* O;
    __device__ __forceinline__ void operator()(const f32x4 (&acc)[2][2][4][2], const Unit& u, int wr, int wc, int fr, int fq) const {
        const int row0 = u.pm * BM + wr * 64 + fr, col0 = (u.pn & 3) * BM + wc * 64 + 16 * fq;
#pragma unroll
        for (int ai = 0; ai < 2; ++ai)
#pragma unroll
            for (int m = 0; m < 4; ++m) { unsigned char* rowp = O + (size_t)(row0 + ai * HALF + m * 16) * 1024 + col0; u32x4 w;
#pragma unroll
                for (int bj = 0; bj < 2; ++bj) { f32x4 v0 = acc[ai][bj][m][0] * (Y8_SCALE * G2_INV), v1 = acc[ai][bj][m][1] * (Y8_SCALE * G2_INV); int lo = 0, hi = 0;
#pragma unroll
                    for (int j = 0; j < 4; ++j) { v0[j] = __builtin_amdgcn_fmed3f(v0[j], -440.f, 440.f); v1[j] = __builtin_amdgcn_fmed3f(v1[j], -440.f, 440.f); }
                    lo = __builtin_amdgcn_cvt_pk_fp8_f32(v0[0], v0[1], lo, false); lo = __builtin_amdgcn_cvt_pk_fp8_f32(v0[2], v0[3], lo, true);
                    hi = __builtin_amdgcn_cvt_pk_fp8_f32(v1[0], v1[1], hi, false); hi = __builtin_amdgcn_cvt_pk_fp8_f32(v1[2], v1[3], hi, true);
                    if (bj == 0) { w.x = (unsigned)lo; w.y = (unsigned)hi; } else { w.z = (unsigned)lo; w.w = (unsigned)hi; } }
                *(u32x4*)rowp = w; }
    } };
struct EpiRouterLds { static constexpr bool PERM = false, AFTER_DRAIN = true, PROBE = false;
    __device__ __forceinline__ void operator()(const f32x4 (&)[2][2][4][2], const Unit&, int, int, int, int) const {}
    __device__ __forceinline__ void fused(const f32x4 (&acc)[2][2][4][2], const Unit&, int wr, int wc, int fr, int fq, LAS unsigned char* lds) const {
        if (wc >= 2) return;
        LAS float* SC = (LAS float*)lds;
#pragma unroll
        for (int ai = 0; ai < 2; ++ai)
#pragma unroll
            for (int m = 0; m < 4; ++m) { const int row = ai * HALF + wr * 64 + m * 16 + fr;
#pragma unroll
                for (int n = 0; n < 2; ++n)
#pragma unroll
                    for (int j = 0; j < 4; ++j) SC[row * 65 + wc * 32 + n * 16 + 4 * fq + j] = sigmoidf_(acc[ai][0][m][n][j]); }
    } };
struct MoeSched { const LAS int* te; const int* sort; int NU, G, c, sh, per;
    __device__ __forceinline__ bool next(int i, Unit& u) const { const int L = i * G + c; if (L >= NU) return false; const int tile = L >> sh; u.pm = tile; u.pn = te[tile] * per + (L & (per - 1)); return true; }
    __device__ __forceinline__ int arow(int r) const { return sort ? sort[r] : r; }
    void* pts; __device__ __forceinline__ void* probe_ts() const { return pts; } };
struct EpiSwiglu { static constexpr bool PERM = true, AFTER_DRAIN = false, PROBE = false; unsigned char* ACT;
    __device__ __forceinline__ void operator()(const f32x4 (&acc)[2][2][4][2], const Unit& u, int wr, int wc, int fr, int fq) const {
        const int row0 = u.pm * BM + wr * 64 + fr, col0 = (u.pn & 1) * 128 + wc * 32 + 8 * fq;
#pragma unroll
        for (int ai = 0; ai < 2; ++ai)
#pragma unroll
            for (int m = 0; m < 4; ++m) { unsigned char* rowp = ACT + (size_t)(row0 + ai * HALF + m * 16) * DE + col0;
                const f32x4 g0 = acc[ai][0][m][0], g1 = acc[ai][0][m][1], u0 = acc[ai][1][m][0], u1 = acc[ai][1][m][1];
                float o[8];
#pragma unroll
                for (int q = 0; q < 4; ++q) { o[q] = siluf_(g0[q] * G1_INV) * (u0[q] * G1_INV); o[4 + q] = siluf_(g1[q] * G1_INV) * (u1[q] * G1_INV); }
                u32x2 w; w.x = fp8x4(o[0], o[1], o[2], o[3], ACT8_SCALE); w.y = fp8x4(o[4], o[5], o[6], o[7], ACT8_SCALE);
                *(u32x2*)rowp = w; }
    } };
__device__ __forceinline__ int moe_tables(const Params& p, int ch, LAS unsigned char* lds, int tid) {
    LAS int* TE = (LAS int*)(lds + LDS_TAB);
    const int* TEG = (const int*)(p.ws + WS_TEG) + (size_t)ch * (MAXTILES + 64);
    __syncthreads();
#pragma unroll 1
    for (int i = tid; i <= MAXTILES; i += NTHR) TE[i] = TEG[i];
    __syncthreads();
    return TE[MAXTILES];
}

__device__ __forceinline__ void ph_route_a(const Params& p, int l, const float* LOG, int tile, LAS unsigned char* lds, int tid) {
    LAS float* SC = (LAS float*)lds;
    LAS float* RBs = (LAS float*)(lds + 68 * 1024);
    LAS unsigned* MASK = (LAS unsigned*)(lds + 69 * 1024);
    const int b = tile, tok0 = 256 * b;
    if (LOG)
#pragma unroll 1
    for (int i = tid; i < 256 * 64; i += NTHR) { const int t = i >> 6, e = i & 63; SC[t * 65 + e] = sigmoidf_(LOG[(size_t)(tok0 + t) * 64 + e]); }
    if (tid < 64) RBs[tid] = p.in[I_RB][l * 64 + tid];
    MASK[tid] = 0u;
    __syncthreads();
    int eidx[8]; float wts[8];
    if (tid < 256) { const int t = tid; const LAS float* sc = SC + t * 65;
        float gs[8], bv[64];
#pragma unroll
        for (int g = 0; g < 8; ++g) { float m1 = -3.0e38f, m2 = -3.0e38f;
#pragma unroll
            for (int j = 0; j < 8; ++j) { const float v = sc[8 * g + j] + RBs[8 * g + j]; bv[8 * g + j] = v; if (v > m1) { m2 = m1; m1 = v; } else if (v > m2) m2 = v; }
            gs[g] = m1 + m2; }
        unsigned gmask = 0u;
#pragma unroll
        for (int r = 0; r < 4; ++r) { float best = -3.0e38f; int bi = 0; bool found = false;
#pragma unroll
            for (int g = 0; g < 8; ++g) { const bool free_ = ((gmask >> g) & 1u) == 0u; if (free_ && (!found || gs[g] > best)) { best = gs[g]; bi = g; found = true; } }
            gmask |= 1u << bi; }
#pragma unroll
        for (int e = 0; e < 64; ++e) if (((gmask >> (e >> 3)) & 1u) == 0u) bv[e] = -3.0e38f;
        unsigned long long taken = 0ull; float ssum = 0.f;
#pragma unroll
        for (int k = 0; k < 8; ++k) { float best = -3.0e38f; int be = 0; bool found = false;
#pragma unroll
            for (int e = 0; e < 64; ++e) { const bool ok = ((taken >> e) & 1ull) == 0ull; if (ok && (!found || bv[e] > best)) { best = bv[e]; be = e; found = true; } }
            taken |= 1ull << be; eidx[k] = be; wts[k] = sc[be]; ssum += wts[k]; }
        const float inv = 2.5f / ssum;
#pragma unroll
        for (int k = 0; k < 8; ++k) { wts[k] *= inv; __hip_atomic_fetch_or(&MASK[eidx[k] * 8 + (t >> 5)], 1u << (t & 31), __ATOMIC_RELAXED, __HIP_MEMORY_SCOPE_WORKGROUP); }
    }
    __syncthreads();
    if (tid < 256) { const int t = tid; int* EIDX = (int*)(p.ws + WS_EIDX); float* WTS = (float*)(p.ws + WS_WTS);
#pragma unroll
        for (int k = 0; k < 8; ++k) { const int e = eidx[k]; int r = 0;
#pragma unroll 1
            for (int w = 0; w < (t >> 5); ++w) r += __popc(MASK[e * 8 + w]);
            r += __popc(MASK[e * 8 + (t >> 5)] & ((1u << (t & 31)) - 1u));
            EIDX[(size_t)(tok0 + t) * 8 + k] = e | (r << 8); WTS[(size_t)(tok0 + t) * 8 + k] = wts[k]; } }
    if (tid < 64) { int c = 0;
#pragma unroll
        for (int w = 0; w < 8; ++w) c += __popc(MASK[tid * 8 + w]);
        ((int*)(p.ws + WS_BC))[b * 64 + tid] = c; }
    __syncthreads();
}
__device__ __forceinline__ void ph_route_b(const Params& p, LAS unsigned char* lds, int tid) {
    LAS int* BCS = (LAS int*)lds;
    LAS int* CNT = BCS + BPC * 64; LAS int* PRE = CNT + 64; LAS int* SEG = PRE + 64;
    const int b = blockIdx.x, ch = b / BPC, bl = b % BPC;
    const int* BC = (const int*)(p.ws + WS_BC) + (size_t)ch * BPC * 64;
#pragma unroll 16
    for (int i = tid; i < BPC * 64; i += NTHR) BCS[i] = BC[i];
    __syncthreads();
    if (tid < 64) { int c = 0, pr = 0;
#pragma unroll 16
        for (int i = 0; i < BPC; ++i) { const int v = BCS[i * 64 + tid]; c += v; if (i < bl) pr += v; } CNT[tid] = c; PRE[tid] = pr; }
    __syncthreads();
    if (tid == 0) { int base = 0;
#pragma unroll 1
        for (int e = 0; e < 64; ++e) { SEG[e] = base; base += ((CNT[e] + 255) >> 8) << 8; } SEG[64] = base; }
    __syncthreads();
    int* SORT = (int*)(p.ws + WS_SORT) + (size_t)ch * CHROWS; int* PSLOT = (int*)(p.ws + WS_PSLOT); const int* EIDX = (const int*)(p.ws + WS_EIDX);
    if (tid < 256) { const int tok = 256 * b + tid;
#pragma unroll
        for (int k = 0; k < 8; ++k) { const int w = EIDX[(size_t)tok * 8 + k], e = w & 255, r = w >> 8; const int slot = SEG[e] + PRE[e] + r; SORT[slot] = tok; PSLOT[(size_t)tok * 16 + k] = slot; }
        const int s8 = SEG[64] + (tok - ch * CHT); SORT[s8] = tok; PSLOT[(size_t)tok * 16 + 8] = s8; }
    if (bl == 0) {
        int* TEG = (int*)(p.ws + WS_TEG) + (size_t)ch * (MAXTILES + 64); const int NT = (SEG[64] >> 8) + CHT / 256;
#pragma unroll 1
        for (int i = tid; i < NT; i += NTHR) { int e = 0;
#pragma unroll 1
            while (e < 64 && (i << 8) >= SEG[e + 1]) ++e;
            TEG[i] = e; }
        if (tid == 0) TEG[MAXTILES] = NT; }
    if (bl < 64) { const int e = bl, lo = SEG[e] + CNT[e], hi = SEG[e] + (((CNT[e] + 255) >> 8) << 8); for (int s = lo + tid; s < hi; s += NTHR) SORT[s] = ch * CHT; }
    __syncthreads();
}

typedef float f32x16 __attribute__((ext_vector_type(16)));
__device__ __forceinline__ void ph_sconv(const Params& p, const bf16* UT, bf16* UC, int tid) {
    const float* cw = p.in[I_CONVHYW]; const float* cbias = p.in[I_CONVHYB];
    const unsigned NIT = 3072u * 32u * 256u; const unsigned gt = blockIdx.x * NTHR + tid, NG = gridDim.x * NTHR;
#pragma unroll 1
    for (unsigned it = gt; it < NIT; it += NG) {
        const unsigned c = it >> 13, k = it & 255u; const size_t base = (size_t)it * 8;
        const v4u w = *(const v4u*)(UT + base);
        const float w0 = cw[c], w1 = cw[3072 + c], w2 = cw[6144 + c], bb = cbias[c];
        float x[10];
        x[0] = k > 0 ? bf1(UT[base - 1]) : 0.f; x[9] = k < 255 ? bf1(UT[base + 8]) : 0.f;
        x[1] = bf_lo(w.x); x[2] = bf_hi(w.x); x[3] = bf_lo(w.y); x[4] = bf_hi(w.y); x[5] = bf_lo(w.z); x[6] = bf_hi(w.z); x[7] = bf_lo(w.w); x[8] = bf_hi(w.w);
        float o[8];
#pragma unroll
        for (int j = 0; j < 8; ++j) o[j] = bb + w0 * x[j] + w1 * x[j + 1] + w2 * x[j + 2];
        v4u r; r.x = pk2(o[0], o[1]); r.y = pk2(o[2], o[3]); r.z = pk2(o[4], o[5]); r.w = pk2(o[6], o[7]);
        *(v4u*)(UC + base) = r;
    }
}
constexpr int LC_CPB = 8224, LC_RAW = 8 * LC_CPB, LC_RAWSZ = 32 * 512, LC_HALO = LC_RAW + 2 * LC_RAWSZ, LC_VBP = 528, LC_VB0 = LC_HALO + 2 * 8192, LC_VBSZ = 32 * LC_VBP;
static_assert(LC_VB0 + 2 * LC_VBSZ <= LDS_MISC && 8 * 32 * 528 <= LDS_MISC, "lconv LDS map");
struct Taps { float w0, w1, w2, b; };
__device__ __forceinline__ float bfh(unsigned w, int hi) { return hi ? bf_hi(w) : bf_lo(w); }
template <bool CONVIN>
__device__ __forceinline__ void lconv_unit(const bf16* vin, const Taps ti, const bf16* F, const bf16* graw, const Taps tg, float fb, bf16* out, LAS unsigned char* lds, int tid, int lane, int wave) {
    __syncthreads();
#define LC_DMA(ch, rb) do { _Pragma("unroll") for (int q = 0; q < 2; ++q) { const int row = wave * 4 + 2 * q + (ln >> 5); \
        __builtin_amdgcn_global_load_lds((const unsigned*)(vin + (size_t)row * 2048 + (ch) * 256 + (ln & 31) * 8), (LAS unsigned*)(lds + LC_RAW + (rb) * LC_RAWSZ + (wave * 4 + 2 * q) * 512), 16, 0, 0); } \
        { const int hrow = wave * 4 + ((ln & 7) >> 1); int hs = (ln & 1) ? (ch) * 256 + 256 : (ch) * 256 - 8; hs = hs < 0 ? 0 : (hs > 2040 ? 2040 : hs); \
          __builtin_amdgcn_global_load_lds((const unsigned*)(vin + (size_t)hrow * 2048 + hs), (LAS unsigned*)(lds + LC_HALO + (rb) * 8192 + wave * 1024), 16, 0, 0); } } while (0)
    LAS bf16* Fl = (LAS bf16*)(lds + LC_VB0 + LC_VBSZ);
    { int ln = lane; asm volatile("" : "+v"(ln)); LC_DMA(0, 0); LC_DMA(1, 1); }
    if (tid < 256) *(LAS v4u*)(Fl + tid * 8) = *(const v4u*)(F + tid * 8);
    __syncthreads();
    if (tid == 0) Fl[1024] = (bf16)f2bf(bf1(Fl[1024]) + fb);
    __syncthreads();
#pragma unroll 1
    for (int a = 0; a < 8; ++a)
#pragma unroll 1
        for (int mi = tid; mi < 2056; mi += NTHR) { const int m = mi * 2; const int x0 = 3079 - m - a, x1 = x0 - 1;
            const unsigned lo = (x0 >= 0 && x0 <= 2047) ? (unsigned)Fl[x0] : 0u, hi = (x1 >= 0 && x1 <= 2047) ? (unsigned)Fl[x1] : 0u;
            *(LAS unsigned*)(lds + a * LC_CPB + m * 2) = lo | (hi << 16); }
    const int r = lane & 31, h = lane >> 5, a = (7 - r) & 7;
    const LAS unsigned char* cpA = lds + a * LC_CPB + 2 * (1023 - r + 8 * h - a + 1032) - 512 * wave;
    const int laneB = r * LC_VBP + 16 * h;
#define LC_CONVERT(ch, rb, buf) do { _Pragma("unroll") for (int q = 0; q < 2; ++q) { const int pid = ln + 64 * q, row = wave * 4 + (pid >> 5), pp = pid & 31; const LAS unsigned char* rp = lds + LC_RAW + (rb) * LC_RAWSZ + row * 512 + pp * 16; \
        const v4u w = *(const LAS v4u*)rp; v4u o = w; \
        if (CONVIN) { const LAS unsigned char* hp_ = lds + LC_HALO + (rb) * 8192 + wave * 1024 + (pid >> 5) * 32; float x[10]; \
            x[0] = pp > 0 ? bf1(*(const LAS bf16*)(rp - 2)) : ((ch) > 0 ? bf1(*(const LAS bf16*)(hp_ + 14)) : 0.f); x[9] = pp < 31 ? bf1(*(const LAS bf16*)(rp + 16)) : ((ch) < 7 ? bf1(*(const LAS bf16*)(hp_ + 16)) : 0.f); \
            x[1] = bf_lo(w.x); x[2] = bf_hi(w.x); x[3] = bf_lo(w.y); x[4] = bf_hi(w.y); x[5] = bf_lo(w.z); x[6] = bf_hi(w.z); x[7] = bf_lo(w.w); x[8] = bf_hi(w.w); \
            float y[8]; _Pragma("unroll") for (int j = 0; j < 8; ++j) y[j] = ti.b + ti.w0 * x[j] + ti.w1 * x[j + 1] + ti.w2 * x[j + 2]; \
            o.x = pk2(y[0], y[1]); o.y = pk2(y[2], y[3]); o.z = pk2(y[4], y[5]); o.w = pk2(y[6], y[7]); } \
        *(LAS v4u*)(lds + LC_VB0 + (buf) * LC_VBSZ + row * LC_VBP + pp * 16) = o; } } while (0)
    { int ln = lane; asm volatile("" : "+v"(ln));
    asm volatile("s_waitcnt vmcnt(3)" ::: "memory");
    LC_CONVERT(0, 0, 0); }
    asm volatile("s_waitcnt lgkmcnt(0)" ::: "memory"); __builtin_amdgcn_s_barrier(); asm volatile("" ::: "memory");
    f32x16 acc[8];
#pragma unroll
    for (int i = 0; i < 8; ++i)
#pragma unroll
        for (int q = 0; q < 16; ++q) acc[i][q] = 0.f;
    bf16x8 E[8], O[8];
    bool primed = false;
#pragma unroll 1
    for (int ch = 0; ch < 8; ++ch) {
        int ln = lane; asm volatile("" : "+v"(ln));
        if (ch < 6) LC_DMA(ch + 2, ch & 1);
        const int du = wave - ch;
        if (du >= -4 && du <= 4) {
            const LAS unsigned char* ca = cpA + 64 * (ch * 8); const LAS unsigned char* vbh = lds + LC_VB0 + (ch & 1) * LC_VBSZ + laneB;
            if (!primed) { primed = true;
#pragma unroll
                for (int i = 1; i < 8; ++i) { E[(8 - i) & 7] = *(const LAS bf16x8*)(ca + 32 * (-2 * i)); O[(8 - i) & 7] = *(const LAS bf16x8*)(ca + 32 * (-2 * i + 1)); }
                E[0] = *(const LAS bf16x8*)ca; O[0] = *(const LAS bf16x8*)(ca + 32); }
            bf16x8 bc0 = *(const LAS bf16x8*)vbh, bc1 = *(const LAS bf16x8*)(vbh + 32);
#pragma unroll
            for (int mm = 0; mm < 8; ++mm) {
                bf16x8 bn0 = bc0, bn1 = bc1;
                if (mm < 7) { bn0 = *(const LAS bf16x8*)(vbh + 64 * (mm + 1)); bn1 = *(const LAS bf16x8*)(vbh + 64 * (mm + 1) + 32); }
                acc[7] = __builtin_amdgcn_mfma_f32_32x32x16_bf16(E[(mm + 1) & 7], bc0, acc[7], 0, 0, 0);
                E[(mm + 1) & 7] = *(const LAS bf16x8*)(ca + 64 * (mm + 1));
#pragma unroll
                for (int i = 0; i < 7; ++i) acc[i] = __builtin_amdgcn_mfma_f32_32x32x16_bf16(E[(mm - i) & 7], bc0, acc[i], 0, 0, 0);
                acc[7] = __builtin_amdgcn_mfma_f32_32x32x16_bf16(O[(mm + 1) & 7], bc1, acc[7], 0, 0, 0);
                O[(mm + 1) & 7] = *(const LAS bf16x8*)(ca + 64 * (mm + 1) + 32);
#pragma unroll
                for (int i = 0; i < 7; ++i) acc[i] = __builtin_amdgcn_mfma_f32_32x32x16_bf16(O[(mm - i) & 7], bc1, acc[i], 0, 0, 0);
                bc0 = bn0; bc1 = bn1;
            }
        }
        if (ch < 7) { if (ch < 6) asm volatile("s_waitcnt vmcnt(3)" ::: "memory"); else asm volatile("s_waitcnt vmcnt(0)" ::: "memory"); LC_CONVERT(ch + 1, (ch + 1) & 1, (ch + 1) & 1); }
        asm volatile("s_waitcnt lgkmcnt(0)" ::: "memory"); __builtin_amdgcn_s_barrier(); asm volatile("" ::: "memory");
    }
#undef LC_DMA
#undef LC_CONVERT
    { int le = lane; asm volatile("" : "+v"(le)); const int re = le & 31, he = le >> 5;
      LAS unsigned char* tw = lds + wave * (32 * 528);
#pragma unroll
      for (int i = 0; i < 8; ++i)
#pragma unroll
          for (int g = 0; g < 4; ++g) { v2u w; w.x = pk2(acc[i][4 * g + 0], acc[i][4 * g + 1]); w.y = pk2(acc[i][4 * g + 2], acc[i][4 * g + 3]); *(LAS v2u*)(tw + re * 528 + (32 * i + 8 * g + 4 * he) * 2) = w; }
      LDS_WAIT(); asm volatile("" ::: "memory");
      const int pp = le & 31;
      v4u gwa[16]; float hal[16];
      const bool hprev = pp == 0 && wave > 0, hnext = pp == 31 && wave < 7;
#pragma unroll
      for (int it = 0; it < 16; ++it) { const size_t off = (size_t)(2 * it + (le >> 5)) * 2048 + 256 * wave + pp * 8; gwa[it] = *(const v4u*)(graw + off);
          hal[it] = (hprev || hnext) ? bf1(graw[hprev ? off - 1 : off + 8]) : 0.f; }
#pragma unroll
      for (int it = 0; it < 16; ++it) { const int row = 2 * it + (le >> 5); const size_t off = (size_t)row * 2048 + 256 * wave + pp * 8;
          const v4u gw = gwa[it]; const v4u aw = *(const LAS v4u*)(tw + row * 528 + pp * 16);
          const float hp = hal[it], hn = hal[it];
          float gx[10]; gx[1] = bf_lo(gw.x); gx[2] = bf_hi(gw.x); gx[3] = bf_lo(gw.y); gx[4] = bf_hi(gw.y); gx[5] = bf_lo(gw.z); gx[6] = bf_hi(gw.z); gx[7] = bf_lo(gw.w); gx[8] = bf_hi(gw.w);
          const float fromprev = shidx(gx[8], le - 1), fromnext = shidx(gx[1], le + 1);
          gx[0] = pp > 0 ? fromprev : hp; gx[9] = pp < 31 ? fromnext : hn;
          const float av[8] = {bf_lo(aw.x), bf_hi(aw.x), bf_lo(aw.y), bf_hi(aw.y), bf_lo(aw.z), bf_hi(aw.z), bf_lo(aw.w), bf_hi(aw.w)};
          float o[8];
#pragma unroll
          for (int j = 0; j < 8; ++j) o[j] = (tg.b + tg.w0 * gx[j] + tg.w1 * gx[j + 1] + tg.w2 * gx[j + 2]) * av[j];
          v4u w; w.x = pk2(o[0], o[1]); w.y = pk2(o[2], o[3]); w.z = pk2(o[4], o[5]); w.w = pk2(o[6], o[7]);
          *(v4u*)(out + off) = w; }
    }
}
template <bool CONVIN>
__device__ __forceinline__ void ph_lconv(const Params& p, int o, const bf16* IN, const bf16* UT, bf16* OUT, LAS unsigned char* lds, int tid, int lane, int wave) {
    const bf16* FILT = (const bf16*)(p.ws + WS_FILT); const float* cw = p.in[I_CONVHYW]; const float* cbias = p.in[I_CONVHYB];
#pragma unroll 1
    for (int c = blockIdx.x; c < 1024; c += gridDim.x) { const int gc = (1 + o) * 1024 + c;
        const Taps ti{cw[c], cw[3072 + c], cw[6144 + c], cbias[c]}, tg{cw[gc], cw[3072 + gc], cw[6144 + gc], cbias[gc]};
        lconv_unit<CONVIN>(IN + (size_t)c * T, ti, FILT + (size_t)(o * 1024 + c) * 2048, UT + (size_t)gc * T, tg, p.in[I_FBIAS][o * 1024 + c], OUT + (size_t)c * T, lds, tid, lane, wave); }
}
__device__ __forceinline__ void ph_transpose(const bf16* Y2T, bf16* Y2, LAS unsigned char* lds, int lane, int wave, int panel) {
    LAS unsigned char* tl = lds + wave * 16384;
    v4u cur[8], nxt[8];
#define TP_LOAD(dst, tile_) do { const int c0_ = ((tile_) & 15) * 64, t0_ = panel * 256 + ((tile_) >> 4) * 64; _Pragma("unroll") for (int rr = 0; rr < 8; ++rr) \
        dst[rr] = *(const v4u*)(Y2T + (size_t)(c0_ + rr * 8 + (lane >> 3)) * T + t0_ + (lane & 7) * 8); } while (0)
    TP_LOAD(cur, wave);
#pragma unroll 1
    for (int tile = wave; tile < 64; tile += NWAVES) { const int c0 = (tile & 15) * 64, t0 = panel * 256 + (tile >> 4) * 64;
        if (tile + NWAVES < 64) TP_LOAD(nxt, tile + NWAVES);
#pragma unroll
        for (int rr = 0; rr < 8; ++rr) { LAS unsigned* d = (LAS unsigned*)(tl + (rr * 8 + (lane >> 3)) * 132 + (lane & 7) * 16); d[0] = cur[rr].x; d[1] = cur[rr].y; d[2] = cur[rr].z; d[3] = cur[rr].w; }
        LDS_WAIT(); asm volatile("" ::: "memory");
#pragma unroll
        for (int rr = 0; rr < 8; ++rr) { const int tk = rr * 8 + (lane >> 3), cp = (lane & 7) * 8;
            unsigned short e[8];
#pragma unroll
            for (int j = 0; j < 8; ++j) e[j] = *(const LAS unsigned short*)(tl + (cp + j) * 132 + tk * 2);
            v4u w; w.x = e[0] | ((unsigned)e[1] << 16); w.y = e[2] | ((unsigned)e[3] << 16); w.z = e[4] | ((unsigned)e[5] << 16); w.w = e[6] | ((unsigned)e[7] << 16);
            *(v4u*)(Y2 + (size_t)(t0 + tk) * D + c0 + cp) = w; }
        LDS_WAIT(); asm volatile("" ::: "memory");
#pragma unroll
        for (int rr = 0; rr < 8; ++rr) cur[rr] = nxt[rr];
    }
#undef TP_LOAD
}

constexpr float QSCALE = 0.125f * 1.4426950408889634f;
struct InprojSched { int G, c;
    __device__ __forceinline__ bool next(int i, Unit& u) const { const int L = i * G + c; if (L >= 3840 + 288) return false;
        if (L < 3840) { u.pm = L / 15; u.pn = L % 15; } else { const int q = L - 3840; u.pm = 256 + q / 9; u.pn = 6 + q % 9; } return true; }
    __device__ __forceinline__ int arow(int r) const { return r; }
    __device__ __forceinline__ void* probe_ts() const { return nullptr; } };
struct EpiInproj { static constexpr bool PERM = true, AFTER_DRAIN = false, PROBE = false; unsigned char* big; const float* rope; float* gates; const float* gate_b;
    __device__ __forceinline__ void operator()(const f32x4 (&acc)[2][2][4][2], const Unit& u, int wr, int wc, int fr, int fq) const {
        const bool ctx = u.pm >= 256; const int b = ctx ? u.pm - 256 : (u.pm >> 3), r0 = ctx ? 0 : (u.pm & 7) * 256;
        if (u.pn == 14) {
            if (wc != 0 || fq >= 2) return;
            const f32x4 gb0 = *(const f32x4*)(gate_b + 8 * fq), gb1 = *(const f32x4*)(gate_b + 8 * fq + 4);
#pragma unroll
            for (int ai = 0; ai < 2; ++ai)
#pragma unroll
                for (int m = 0; m < 4; ++m) { const int rr = r0 + wr * 64 + fr + ai * HALF + m * 16; const size_t grow = ctx ? (size_t)T + b * LC + rr : (size_t)b * SEQ + rr;
                    float* gp = gates + grow * 16 + 8 * fq; *(f32x4*)gp = acc[ai][0][m][0] + gb0; *(f32x4*)(gp + 4) = acc[ai][0][m][1] + gb1; }
            return; }
        const int t = u.pn >> 1;
        constexpr size_t offs[7] = {A0_QA, A0_BQ, A0_BO, A0_KA, A0_VA, A0_BK, A0_BV};
        const bool kv = t >= 3;
        size_t toff = A0_QA;
#pragma unroll
        for (int q = 0; q < 7; ++q) if (t == q) toff = offs[q];
        bf16* O = (bf16*)(big + toff) + (size_t)b * (kv ? (SEQ + LC) : SEQ) * 512 + (size_t)((kv && !ctx) ? LC : 0) * 512;
        const bool rope_on = (t == 0 || t == 3) && !ctx; const float qs = t == 0 ? QSCALE : 1.f;
        const int col0 = (u.pn & 1) * 256 + wc * 32 + 8 * fq;
#pragma unroll
        for (int ai = 0; ai < 2; ++ai)
#pragma unroll
            for (int m = 0; m < 4; ++m) { const int rr = r0 + wr * 64 + fr + ai * HALF + m * 16; bf16* rowp = O + (size_t)rr * 512 + col0;
                f32x4 cs0 = (f32x4){1.f, 0.f, 1.f, 0.f}, cs1 = cs0;
                if (rope_on) { const int pos = (wc & 1) ? (rr & 63) : (rr >> 6); const float* rp = rope + (size_t)(pos * 16 + 4 * fq) * 2; cs0 = *(const f32x4*)rp; cs1 = *(const f32x4*)(rp + 4); }
#pragma unroll
                for (int bj = 0; bj < 2; ++bj) { const f32x4 x0 = acc[ai][bj][m][0], x1 = acc[ai][bj][m][1];
                    f32x4 o0, o1;
                    o0[0] = x0[0] * cs0[0] - x1[0] * cs0[1]; o1[0] = x1[0] * cs0[0] + x0[0] * cs0[1];
                    o0[1] = x0[1] * cs0[2] - x1[1] * cs0[3]; o1[1] = x1[1] * cs0[2] + x0[1] * cs0[3];
                    o0[2] = x0[2] * cs1[0] - x1[2] * cs1[1]; o1[2] = x1[2] * cs1[0] + x0[2] * cs1[1];
                    o0[3] = x0[3] * cs1[2] - x1[3] * cs1[3]; o1[3] = x1[3] * cs1[2] + x0[3] * cs1[3];
                    o0 = o0 * qs; o1 = o1 * qs;
                    u32x4 w; w.x = cvt_pk_bf16(o0[0], o0[1]); w.y = cvt_pk_bf16(o0[2], o0[3]); w.z = cvt_pk_bf16(o1[0], o1[1]); w.w = cvt_pk_bf16(o1[2], o1[3]);
                    *(u32x4*)(rowp + bj * HALF) = w; } }
    } };
__device__ __forceinline__ void ph_transpose_b(const bf16* src, bf16* dst, int NBt, int R, int C, LAS unsigned char* lds, int lane, int wave) {
    LAS unsigned char* tl = lds + wave * 16384;
    const int gw = blockIdx.x * NWAVES + wave, NGW = gridDim.x * NWAVES; const int tr = R / 64, tc = C / 64, per = tr * tc;
#pragma unroll 1
    for (int tile = gw; tile < NBt * per; tile += NGW) { const int bt = tile / per, q = tile % per, c0 = (q % tc) * 64, r0 = (q / tc) * 64;
        const bf16* s = src + (size_t)bt * R * C; bf16* d = dst + (size_t)bt * R * C;
#pragma unroll
        for (int rr = 0; rr < 8; ++rr) { const int row = rr * 8 + (lane >> 3), pc = lane & 7;
            *(LAS v4u*)(tl + row * 144 + pc * 16) = *(const v4u*)(s + (size_t)(r0 + row) * C + c0 + pc * 8); }
        LDS_WAIT(); asm volatile("" ::: "memory");
#pragma unroll
        for (int rr = 0; rr < 8; ++rr) { const int cc = rr * 8 + (lane >> 3), rp = (lane & 7) * 8;
            unsigned short e[8];
#pragma unroll
            for (int j = 0; j < 8; ++j) e[j] = *(const LAS unsigned short*)(tl + (rp + j) * 144 + cc * 2);
            v4u w; w.x = e[0] | ((unsigned)e[1] << 16); w.y = e[2] | ((unsigned)e[3] << 16); w.z = e[4] | ((unsigned)e[5] << 16); w.w = e[6] | ((unsigned)e[7] << 16);
            *(v4u*)(d + (size_t)(c0 + cc) * R + r0 + rp) = w; }
        LDS_WAIT(); asm volatile("" ::: "memory");
    }
}

typedef short s16x4 __attribute__((ext_vector_type(4)));
__device__ __forceinline__ u32x2 tr16(const LAS unsigned char* p) { return __builtin_bit_cast(u32x2, __builtin_amdgcn_ds_read_tr16_b64_v4i16((LAS s16x4*)p)); }
typedef float f32x2 __attribute__((ext_vector_type(2)));
constexpr int AT_KP = 272, AT_VP = 320  , AT_KB = 64 * AT_KP, AT_VB = 64 * AT_VP, AT_V0 = 2 * AT_KB;
__device__ __forceinline__ void ph_attn(const Params& p, unsigned char* big, LAS unsigned char* lds, int tid, int lane, int wave, int vcu) {
    const bf16* QA = (const bf16*)(big + A0_QA); const bf16* KA = (const bf16*)(big + A0_KA); const bf16* VA = (const bf16*)(big + A0_VA); bf16* MIXIN = (bf16*)(big + A0_MIXIN);
    const int blk = (lane >> 4) & 1, tq = (lane & 15) >> 2, tp = lane & 3;
    const int comp = wave >> 2, qw = wave & 3, r = lane & 31, hh = lane >> 5;
    float lam; { const float* lv = p.in[I_DLAM]; const float a = wave_sum(lv[lane] * lv[64 + lane]), b2 = wave_sum(lv[128 + lane] * lv[192 + lane]); lam = expf(a) - expf(b2) + 0.2f; }
#pragma unroll 1
    for (int unit = vcu; unit < 2048; unit += gridDim.x) {
        const int b = unit >> 6, h = (unit >> 4) & 3, qblk = unit & 15, q0 = qblk * 128 + qw * 32;
        const bf16* Kg = KA + (size_t)b * (SEQ + LC) * 512 + h * 128; const bf16* Vg = VA + (size_t)b * (SEQ + LC) * 512 + h * 128;
        bf16x8 qf[4];
#pragma unroll
        for (int ds = 0; ds < 4; ++ds) qf[ds] = *(const bf16x8*)(QA + ((size_t)b * SEQ + q0 + r) * 512 + h * 128 + comp * 64 + ds * 16 + hh * 8);
        f32x16 oacc[4];
#pragma unroll
        for (int i = 0; i < 4; ++i)
#pragma unroll
            for (int q = 0; q < 16; ++q) oacc[i][q] = 0.f;
        float m_run = 0.f, l_run = 0.f;
        v4u pre[4];
#define AT_LOADG(kt) do { _Pragma("unroll") for (int q = 0; q < 2; ++q) { const int idx = tid + NTHR * q; \
            pre[q] = *(const v4u*)(Kg + (size_t)((kt) * 64 + (idx >> 4)) * 512 + (idx & 15) * 8); \
            pre[2 + q] = *(const v4u*)(Vg + (size_t)((kt) * 64 + (idx >> 4)) * 512 + (idx & 15) * 8); } } while (0)
#define AT_STORES(kn) do { _Pragma("unroll") for (int q = 0; q < 2; ++q) { const int idx = tid + NTHR * q; \
            *(LAS v4u*)(lds + ((kn) & 1) * AT_KB + (idx >> 4) * AT_KP + (idx & 15) * 16) = pre[q]; \
            *(LAS v4u*)(lds + AT_V0 + ((kn) % 3) * AT_VB + (idx >> 4) * AT_VP + (idx & 15) * 16) = pre[2 + q]; } } while (0)
#define AT_PV(PF, VT_) do { const LAS unsigned char* Vt_ = (VT_); _Pragma("unroll") for (int kb = 0; kb < 2; ++kb) _Pragma("unroll") for (int s = 0; s < 2; ++s) _Pragma("unroll") for (int dvb = 0; dvb < 4; ++dvb) { \
            const LAS unsigned char* vp = Vt_ + (32 * kb + 16 * s + 4 * hh + tq) * AT_VP + (32 * dvb + 16 * blk + 4 * tp) * 2; const u32x2 lo = tr16(vp), hi = tr16(vp + 8 * AT_VP); \
            u32x4 vw; vw.x = lo.x; vw.y = lo.y; vw.z = hi.x; vw.w = hi.y; oacc[dvb] = __builtin_amdgcn_mfma_f32_32x32x16_bf16(__builtin_bit_cast(bf16x8, vw), PF[kb][s], oacc[dvb], 0, 0, 0); } } while (0)
        bf16x8 phold[2][2];
        __syncthreads();
        AT_LOADG(0); AT_STORES(0);
        __syncthreads();
#pragma unroll 1
        for (int kt = 0; kt < 36; ++kt) {
            if (kt < 35) AT_LOADG(kt + 1);
            const LAS unsigned char* Kt = lds + (kt & 1) * AT_KB;
            if (comp == 1 && kt > 0) { AT_PV(phold, lds + AT_V0 + ((kt - 1) % 3) * AT_VB); }
            f32x16 sacc[2];
#pragma unroll
            for (int kb = 0; kb < 2; ++kb)
#pragma unroll
                for (int q = 0; q < 16; ++q) sacc[kb][q] = -m_run;
#pragma unroll
            for (int ds = 0; ds < 4; ++ds)
#pragma unroll
                for (int kb = 0; kb < 2; ++kb) { const bf16x8 kf = *(const LAS bf16x8*)(Kt + (32 * kb + r) * AT_KP + comp * 128 + ds * 32 + hh * 16);
                    sacc[kb] = __builtin_amdgcn_mfma_f32_32x32x16_bf16(kf, qf[ds], sacc[kb], 0, 0, 0); }
            float mx = sacc[0][0];
#pragma unroll
            for (int kb = 0; kb < 2; ++kb)
#pragma unroll
                for (int q = 0; q < 16; ++q) mx = fmaxf(mx, sacc[kb][q]);
            mx = fmaxf(mx, shx(mx, 32));
            if (kt == 0 || __builtin_amdgcn_ballot_w64(mx > 0.f) != 0ull) {
                const float dm = kt == 0 ? mx : fmaxf(mx, 0.f), alpha = __builtin_amdgcn_exp2f(-dm); m_run += dm; l_run *= alpha;
#pragma unroll
                for (int kb = 0; kb < 2; ++kb) sacc[kb] = sacc[kb] - dm;
#pragma unroll
                for (int i = 0; i < 4; ++i) oacc[i] = oacc[i] * alpha; }
            f32x2 ps2 = (f32x2){0.f, 0.f};
#pragma unroll
            for (int kb = 0; kb < 2; ++kb)
#pragma unroll
                for (int q = 0; q < 8; ++q) { f32x2 e; e.x = __builtin_amdgcn_exp2f(sacc[kb][2 * q]); e.y = __builtin_amdgcn_exp2f(sacc[kb][2 * q + 1]); sacc[kb][2 * q] = e.x; sacc[kb][2 * q + 1] = e.y; ps2 += e; }
            l_run += ps2.x + ps2.y;
#pragma unroll
            for (int kb = 0; kb < 2; ++kb)
#pragma unroll
                for (int s = 0; s < 2; ++s) {
                    u32x4 pw; pw.x = cvt_pk_bf16(sacc[kb][8 * s + 0], sacc[kb][8 * s + 1]); pw.y = cvt_pk_bf16(sacc[kb][8 * s + 2], sacc[kb][8 * s + 3]);
                    pw.z = cvt_pk_bf16(sacc[kb][8 * s + 4], sacc[kb][8 * s + 5]); pw.w = cvt_pk_bf16(sacc[kb][8 * s + 6], sacc[kb][8 * s + 7]);
                    phold[kb][s] = __builtin_bit_cast(bf16x8, pw); }
            if (comp == 0) { AT_PV(phold, lds + AT_V0 + (kt % 3) * AT_VB); }
            if (kt < 35) AT_STORES(kt + 1);
            __syncthreads();
        }
        if (comp == 1) { AT_PV(phold, lds + AT_V0 + (35 % 3) * AT_VB); }
        __syncthreads();
#undef AT_LOADG
#undef AT_STORES
#undef AT_PV
        const float lsum = l_run + shx(l_run, 32), inv = __builtin_amdgcn_rcpf(lsum);
        LAS float* X = (LAS float*)lds;
        if (comp == 1) {
#pragma unroll
            for (int dvb = 0; dvb < 4; ++dvb)
#pragma unroll
                for (int q = 0; q < 16; ++q) X[(qw * 64 + dvb * 16 + q) * 64 + lane] = oacc[dvb][q] * inv; }
        __syncthreads();
        if (comp == 0) {
            float ss = 0.f;
#pragma unroll
            for (int dvb = 0; dvb < 4; ++dvb)
#pragma unroll
                for (int q = 0; q < 16; ++q) { const float o = oacc[dvb][q] * inv - lam * X[(qw * 64 + dvb * 16 + q) * 64 + lane]; oacc[dvb][q] = o; ss += o * o; }
            ss += shx(ss, 32);
            const float rn = rsqrtf(ss * (1.f / 128.f) + RMS_EPS) * 0.8f;
            const float* ga = p.in[I_HGA] + h * 128; bf16* orow = MIXIN + ((size_t)b * SEQ + q0 + r) * D + h * 128;
#pragma unroll
            for (int dvb = 0; dvb < 4; ++dvb)
#pragma unroll
                for (int g = 0; g < 4; ++g) { const int dv = 32 * dvb + 8 * g + 4 * hh; const f32x4 gg = *(const f32x4*)(ga + dv);
                    v2u w; w.x = pk2(oacc[dvb][4 * g + 0] * rn * gg[0], oacc[dvb][4 * g + 1] * rn * gg[1]); w.y = pk2(oacc[dvb][4 * g + 2] * rn * gg[2], oacc[dvb][4 * g + 3] * rn * gg[3]);
                    *(v2u*)(orow + dv) = w; }
        }
    }
    __syncthreads();
}

constexpr int ML_P = 272, ML_TILE = 64 * ML_P;
constexpr int ML_VOFF = 3 * ML_TILE, ML_VSZ = 64 * 256;
constexpr int ML_RQ = ML_VOFF + 2 * ML_VSZ, ML_RSZ = 68 * 256, ML_RK = ML_RQ + ML_RSZ;
constexpr int ML_NOFF = ML_RK + ML_RSZ, ML_AOFF = ML_NOFF + 2 * 512;
constexpr int ML_CW = ML_AOFF + 8 * 256;
static_assert(ML_CW + 8 * 512 <= LDS_TAB, "mLSTM LDS map");
__device__ __forceinline__ float logsigmoidf_(float x) { return x >= 0.f ? -__logf(1.f + __expf(-x)) : x - __logf(1.f + __expf(x)); }
__device__ __forceinline__ bf16x8 pack8(const f32x16& v, int s) { u32x4 w; w.x = cvt_pk_bf16(v[8 * s + 0], v[8 * s + 1]); w.y = cvt_pk_bf16(v[8 * s + 2], v[8 * s + 3]); w.z = cvt_pk_bf16(v[8 * s + 4], v[8 * s + 5]); w.w = cvt_pk_bf16(v[8 * s + 6], v[8 * s + 7]); return __builtin_bit_cast(bf16x8, w); }
__device__ __forceinline__ void ph_mlstm(const Params& p, unsigned char* big, LAS unsigned char* lds, int tid, int lane, int wave) {
    const int bid = blockIdx.x; if (bid >= 256) return;
    const int b = bid >> 3, h = (bid >> 1) & 3, dir = bid & 1;
    const bf16* BQ = (const bf16*)(big + A0_BQ) + (size_t)b * SEQ * 512 + h * 128;
    const bf16* BK = (const bf16*)(big + A0_BK) + (size_t)b * (SEQ + LC) * 512 + h * 128;
    const bf16* BV = (const bf16*)(big + A0_BV) + (size_t)b * (SEQ + LC) * 512 + h * 128;
    bf16* HB = (bf16*)(big + A0_HB) + (size_t)dir * T * 512 + (size_t)b * SEQ * 512 + h * 128;
    const float* GT = (const float*)(p.ws + WS_GATES);
    const float* cw = p.in[I_CONVABW]; const float* cb = p.in[I_CONVABB];
    const int eb = wave & 3, tb = wave >> 2, r = lane & 31, hh = lane >> 5;
    const int blk = (lane >> 4) & 1, tq = (lane & 15) >> 2, tp = lane & 3;
    LAS float* nbuf = (LAS float*)(lds + ML_NOFF); LAS float* aw = (LAS float*)(lds + ML_AOFF) + wave * 64;
    if (tid < 256) nbuf[tid] = 0.f;
    LAS float* cwl = (LAS float*)(lds + ML_CW);
    for (int i = tid; i < 1024; i += NTHR) { const int ten = i >> 9, j = (i >> 7) & 3, d = i & 127, ch = ten * 512 + h * 128 + d; cwl[i] = j < 3 ? cw[j * 1024 + ch] : cb[ch]; }
    f32x16 cacc[4];
#pragma unroll
    for (int i = 0; i < 4; ++i)
#pragma unroll
        for (int q = 0; q < 16; ++q) cacc[i][q] = 0.f;
    float m_state = 0.f;
#ifdef ML_PROBE
    unsigned long long accs[7] = {0, 0, 0, 0, 0, 0, 0}; unsigned long long tp0 = __builtin_amdgcn_s_memrealtime();
#define ML_T(i) do { const unsigned long long t1_ = __builtin_amdgcn_s_memrealtime(); accs[i] += t1_ - tp0; tp0 = t1_; } while (0)
#else
#define ML_T(i)
#endif
    float a_c = 0.f, M_c = 0.f, b_c = 0.f, decay_c = 1.f, m_after = 0.f;
    float a_n = 0.f, M_n = 0.f, b_n = 0.f, w_n = 0.f, decay_n = 1.f, m_next = 0.f;
#define ML_POS(cc, t) ((cc) < 4 ? (dir ? 255 - ((cc) * 64 + (t)) : (cc) * 64 + (t)) : (dir ? 2047 - (((cc) - 4) * 64 + (t)) : ((cc) - 4) * 64 + (t)))
#define ML_GLOAD(cc, li_, fp_) do { const int pos_ = ML_POS(cc, lane); const size_t grow_ = (cc) < 4 ? (size_t)T + b * LC + pos_ : (size_t)b * SEQ + pos_; \
        li_ = GT[grow_ * 16 + dir * 8 + h]; fp_ = GT[grow_ * 16 + dir * 8 + 4 + h]; } while (0)
#define ML_SCAN(li_, fp_, m_in) do { const float lf_ = logsigmoidf_(fp_); \
        float bs_ = lf_; _Pragma("unroll") for (int o_ = 1; o_ < 64; o_ <<= 1) { const float v_ = shup(bs_, o_); if (lane >= o_) bs_ += v_; } \
        const float aa_ = (li_) - bs_; float pm_ = aa_; _Pragma("unroll") for (int o_ = 1; o_ < 64; o_ <<= 1) { const float v_ = shup(pm_, o_); if (lane >= o_) pm_ = fmaxf(pm_, v_); } \
        const float MM_ = fmaxf(m_in, pm_); const float M63_ = shidx(MM_, 63), b63_ = shidx(bs_, 63); \
        a_n = aa_; M_n = MM_; b_n = bs_; w_n = __expf(aa_ - M63_); decay_n = __expf((m_in) - M63_); m_next = b63_ + M63_; } while (0)
#define ML_DMA(cc, vbuf) do { const int lim_ = (cc) < 4 ? LC : SEQ, kvb_ = (cc) < 4 ? 0 : LC; \
        _Pragma("unroll 1") for (int ins_ = wave; ins_ < 17; ins_ += NWAVES) { const int rr_ = ins_ * 4 + (lane >> 4), pc_ = lane & 15; int pos_ = ML_POS(cc, rr_ - 1); pos_ = pos_ < 0 ? 0 : (pos_ >= lim_ ? lim_ - 1 : pos_); \
            __builtin_amdgcn_global_load_lds((const unsigned*)(BK + (size_t)(kvb_ + pos_) * 512 + pc_ * 8), (LAS unsigned*)(lds + ML_RK + ins_ * 1024), 16, 0, 0); \
            if ((cc) >= 4) __builtin_amdgcn_global_load_lds((const unsigned*)(BQ + (size_t)pos_ * 512 + pc_ * 8), (LAS unsigned*)(lds + ML_RQ + ins_ * 1024), 16, 0, 0); } \
        _Pragma("unroll") for (int q_ = 0; q_ < 2; ++q_) { const int ins_ = wave * 2 + q_, t_ = ins_ * 4 + (lane >> 4), pc_ = lane & 15; const int pos_ = ML_POS(cc, t_); \
            __builtin_amdgcn_global_load_lds((const unsigned*)(BV + (size_t)(kvb_ + pos_) * 512 + pc_ * 8), (LAS unsigned*)(lds + ML_VOFF + (vbuf) * ML_VSZ + ins_ * 1024), 16, 0, 0); } } while (0)
#define ML_CONV8(dst, rawoff, cc, t_, d8_, ten, scl) do { const int pos_ = ML_POS(cc, t_), lim_ = (cc) < 4 ? LC : SEQ; const int rm_ = dir ? (t_) + 2 : (t_), rp_ = dir ? (t_) : (t_) + 2; \
        v4u x_[3]; x_[0] = *(const LAS v4u*)(lds + (rawoff) + rm_ * 256 + (d8_) * 16); x_[1] = *(const LAS v4u*)(lds + (rawoff) + ((t_) + 1) * 256 + (d8_) * 16); x_[2] = *(const LAS v4u*)(lds + (rawoff) + rp_ * 256 + (d8_) * 16); \
        if (pos_ - 1 < 0) x_[0] = (v4u){0u, 0u, 0u, 0u}; if (pos_ + 1 >= lim_) x_[2] = (v4u){0u, 0u, 0u, 0u}; \
        const LAS float* wl_ = cwl + (ten) * 512 + (d8_) * 8; f32x4 wv_[4][2]; \
        _Pragma("unroll") for (int j_ = 0; j_ < 4; ++j_) { wv_[j_][0] = *(const LAS f32x4*)(wl_ + j_ * 128); wv_[j_][1] = *(const LAS f32x4*)(wl_ + j_ * 128 + 4); } \
        _Pragma("unroll") for (int e_ = 0; e_ < 8; ++e_) { float s_ = wv_[3][e_ >> 2][e_ & 3]; \
            _Pragma("unroll") for (int j_ = 0; j_ < 3; ++j_) { const unsigned w_ = e_ < 2 ? x_[j_].x : e_ < 4 ? x_[j_].y : e_ < 6 ? x_[j_].z : x_[j_].w; s_ += wv_[j_][e_ >> 2][e_ & 3] * ((e_ & 1) ? bf_hi(w_) : bf_lo(w_)); } \
            dst[e_] = s_ * __builtin_amdgcn_rcpf(1.f + __expf(-s_)) * (scl); } } while (0)
#define ML_BUILD(cc) do { _Pragma("unroll 1") for (int q_ = 0; q_ < 2; ++q_) { const int idx_ = tid + NTHR * q_, t_ = idx_ >> 4, d8_ = idx_ & 15; \
        float kk_[8]; ML_CONV8(kk_, ML_RK, cc, t_, d8_, 1, 1.f); const float wt_ = shidx(w_n, t_); \
        v4u o_; o_.x = pk2(kk_[0], kk_[1]); o_.y = pk2(kk_[2], kk_[3]); o_.z = pk2(kk_[4], kk_[5]); o_.w = pk2(kk_[6], kk_[7]); *(LAS v4u*)(lds + ML_TILE + t_ * ML_P + d8_ * 16) = o_; \
        o_.x = pk2(kk_[0] * wt_, kk_[1] * wt_); o_.y = pk2(kk_[2] * wt_, kk_[3] * wt_); o_.z = pk2(kk_[4] * wt_, kk_[5] * wt_); o_.w = pk2(kk_[6] * wt_, kk_[7] * wt_); *(LAS v4u*)(lds + 2 * ML_TILE + t_ * ML_P + d8_ * 16) = o_; \
        if ((cc) >= 4) { float qq_[8]; ML_CONV8(qq_, ML_RQ, cc, t_, d8_, 0, 0.08838834764831845f); \
            o_.x = pk2(qq_[0], qq_[1]); o_.y = pk2(qq_[2], qq_[3]); o_.z = pk2(qq_[4], qq_[5]); o_.w = pk2(qq_[6], qq_[7]); *(LAS v4u*)(lds + t_ * ML_P + d8_ * 16) = o_; } } } while (0)
    __syncthreads();
    { float li0, fp0; ML_GLOAD(0, li0, fp0); ML_DMA(0, 0); ML_SCAN(li0, fp0, m_state); }
    asm volatile("s_waitcnt vmcnt(0)" ::: "memory");
    __syncthreads();
    ML_BUILD(0);
    a_c = a_n; M_c = M_n; b_c = b_n; decay_c = decay_n; m_after = m_next;
    __syncthreads();
#pragma unroll 1
    for (int cc = 0; cc < 36; ++cc) {
        const LAS unsigned char* Qs = lds; const LAS unsigned char* Ks = lds + ML_TILE; const LAS unsigned char* Kw = lds + 2 * ML_TILE; const LAS unsigned char* Vs = lds + ML_VOFF + (cc & 1) * ML_VSZ;
        const LAS float* ncur = nbuf + (cc & 1) * 128; LAS float* nnew = nbuf + ((cc + 1) & 1) * 128;
        float li1 = 0.f, fp1 = 0.f;
        ML_T(5);
        if (cc < 35) { ML_GLOAD(cc + 1, li1, fp1); ML_DMA(cc + 1, (cc + 1) & 1); }
        ML_T(0);
        if (cc >= 4) {
            aw[lane] = a_c;
            const int tcol = 32 * tb + r; const float Mt = shidx(M_c, tcol), bt = shidx(b_c, tcol);
            f32x16 nacc;
#pragma unroll
            for (int q = 0; q < 16; ++q) nacc[q] = 0.f;
#pragma unroll
            for (int db = 0; db < 4; ++db)
#pragma unroll
                for (int s2 = 0; s2 < 2; ++s2) { const LAS unsigned char* qp = Qs + tcol * ML_P + (32 * db + 16 * s2 + 4 * hh) * 2; const u32x2 lo = *(const LAS u32x2*)qp, hi = *(const LAS u32x2*)(qp + 16);
                    u32x4 qw; qw.x = lo.x; qw.y = lo.y; qw.z = hi.x; qw.w = hi.y;
                    nacc = __builtin_amdgcn_mfma_f32_32x32x16_bf16(pack8(cacc[db], s2), __builtin_bit_cast(bf16x8, qw), nacc, 0, 0, 0); }
            const float sc = __expf(m_state - Mt);
            nacc = nacc * sc;
            float rs = 0.f;
#pragma unroll
            for (int sb = 0; sb < 2; ++sb) if (sb <= tb) {
                f32x16 sacc;
#pragma unroll
                for (int q = 0; q < 16; ++q) sacc[q] = 0.f;
#pragma unroll
                for (int ds = 0; ds < 8; ++ds) { const bf16x8 kf = *(const LAS bf16x8*)(Ks + (32 * sb + r) * ML_P + (16 * ds + 8 * hh) * 2), qf = *(const LAS bf16x8*)(Qs + tcol * ML_P + (16 * ds + 8 * hh) * 2);
                    sacc = __builtin_amdgcn_mfma_f32_32x32x16_bf16(kf, qf, sacc, 0, 0, 0); }
#pragma unroll
                for (int g = 0; g < 4; ++g) { const int s0 = 32 * sb + 8 * g + 4 * hh; const f32x4 av = *(const LAS f32x4*)(aw + s0);
#pragma unroll
                    for (int j = 0; j < 4; ++j) { const bool keep = (s0 + j) <= tcol; const float v = keep ? sacc[4 * g + j] * __expf(av[j] - Mt) : 0.f; sacc[4 * g + j] = v; rs += v; } }
#pragma unroll
                for (int s2 = 0; s2 < 2; ++s2) { u32x4 vw;
                    { const u32x2 t0 = tr16(Vs + (32 * sb + 16 * s2 + 4 * hh + tq) * 256 + (32 * eb + 16 * blk + 4 * tp) * 2), t1 = tr16(Vs + (32 * sb + 16 * s2 + 8 + 4 * hh + tq) * 256 + (32 * eb + 16 * blk + 4 * tp) * 2);
                      vw.x = t0.x; vw.y = t0.y; vw.z = t1.x; vw.w = t1.y; }
                    nacc = __builtin_amdgcn_mfma_f32_32x32x16_bf16(__builtin_bit_cast(bf16x8, vw), pack8(sacc, s2), nacc, 0, 0, 0); } }
            rs += shx(rs, 32);
            float qn = 0.f;
            { const LAS unsigned char* qp = Qs + tcol * ML_P + (64 * hh) * 2;
#pragma unroll
              for (int c8 = 0; c8 < 8; ++c8) { const v4u w = *(const LAS v4u*)(qp + c8 * 16); const f32x4 n0 = *(const LAS f32x4*)(ncur + 64 * hh + 8 * c8), n1 = *(const LAS f32x4*)(ncur + 64 * hh + 8 * c8 + 4);
                  qn += bf_lo(w.x) * n0[0] + bf_hi(w.x) * n0[1] + bf_lo(w.y) * n0[2] + bf_hi(w.y) * n0[3] + bf_lo(w.z) * n1[0] + bf_hi(w.z) * n1[1] + bf_lo(w.w) * n1[2] + bf_hi(w.w) * n1[3]; } }
            qn += shx(qn, 32);
            const float den = sc * qn + rs; const float dd = __frcp_rn(fmaxf(fabsf(den), __expf(-(bt + Mt))));
            { const int pos = ML_POS(cc, tcol); bf16* hrow = HB + (size_t)pos * 512 + 32 * eb;
#pragma unroll
              for (int g = 0; g < 4; ++g) { v2u w; w.x = pk2(nacc[4 * g + 0] * dd, nacc[4 * g + 1] * dd); w.y = pk2(nacc[4 * g + 2] * dd, nacc[4 * g + 3] * dd); *(v2u*)(hrow + 8 * g + 4 * hh) = w; } }
        }
        ML_T(1);
#pragma unroll
        for (int db = 0; db < 4; ++db) { cacc[db] = cacc[db] * decay_c;
#pragma unroll
            for (int s4 = 0; s4 < 4; ++s4) { u32x4 ka, vb;
                { const u32x2 t0 = tr16(Kw + (16 * s4 + 8 * hh + tq) * ML_P + (32 * db + 16 * blk + 4 * tp) * 2), t1 = tr16(Kw + (16 * s4 + 8 * hh + 4 + tq) * ML_P + (32 * db + 16 * blk + 4 * tp) * 2);
                  ka.x = t0.x; ka.y = t0.y; ka.z = t1.x; ka.w = t1.y; }
                { const u32x2 t0 = tr16(Vs + (16 * s4 + 8 * hh + tq) * 256 + (32 * eb + 16 * blk + 4 * tp) * 2), t1 = tr16(Vs + (16 * s4 + 8 * hh + 4 + tq) * 256 + (32 * eb + 16 * blk + 4 * tp) * 2);
                  vb.x = t0.x; vb.y = t0.y; vb.z = t1.x; vb.w = t1.y; }
                cacc[db] = __builtin_amdgcn_mfma_f32_32x32x16_bf16(__builtin_bit_cast(bf16x8, ka), __builtin_bit_cast(bf16x8, vb), cacc[db], 0, 0, 0); } }
        { const int d = tid >> 2, part = tid & 3; float s = 0.f;
#pragma unroll
            for (int t = 0; t < 16; ++t) s += bf1(*(const LAS bf16*)(Kw + (part * 16 + t) * ML_P + d * 2));
            s += shx(s, 1); s += shx(s, 2);
            if (part == 0) nnew[d] = decay_c * ncur[d] + s; }
        m_state = m_after;
        ML_T(2);
        asm volatile("s_waitcnt vmcnt(0)" ::: "memory");
        __syncthreads();
        ML_T(3);
        if (cc < 35) { ML_SCAN(li1, fp1, m_state); ML_T(6); ML_BUILD(cc + 1); a_c = a_n; M_c = M_n; b_c = b_n; decay_c = decay_n; m_after = m_next; }
        ML_T(4);
        __syncthreads();
    }
#ifdef ML_PROBE
    if (blockIdx.x == 0 && tid == 256) { unsigned long long* ts = (unsigned long long*)(p.ws + WS_CTL + 32768); ts[50] = 0; unsigned long long c_ = 0; for (int i = 0; i < 7; ++i) { c_ += accs[i]; ts[51 + i] = c_; } }
#endif
#undef ML_T
#undef ML_POS
#undef ML_GLOAD
#undef ML_SCAN
#undef ML_DMA
#undef ML_CONV8
#undef ML_BUILD
}
__device__ __forceinline__ void ph_outb(const Params& p, unsigned char* big, int lane, int wave, int tile) {
    const int gw = tile * NWAVES + wave;
    const bf16* HBf = (const bf16*)(big + A0_HB); const bf16* HBb = HBf + (size_t)T * 512; const bf16* BO = (const bf16*)(big + A0_BO); bf16* MIXIN = (bf16*)(big + A0_MIXIN);
    const float* gb = p.in[I_HGB];
    const f32x4 g0 = *(const f32x4*)(gb + lane * 8), g1 = *(const f32x4*)(gb + lane * 8 + 4);
#pragma unroll 2
    for (int m = gw * 32; m < gw * 32 + 32; ++m) {
        const v4u f = *(const v4u*)(HBf + (size_t)m * 512 + lane * 8), bw = *(const v4u*)(HBb + (size_t)m * 512 + lane * 8), go = *(const v4u*)(BO + (size_t)m * 512 + lane * 8);
        float x[8], o[8]; x[0] = bf_lo(f.x) + bf_lo(bw.x); x[1] = bf_hi(f.x) + bf_hi(bw.x); x[2] = bf_lo(f.y) + bf_lo(bw.y); x[3] = bf_hi(f.y) + bf_hi(bw.y);
        x[4] = bf_lo(f.z) + bf_lo(bw.z); x[5] = bf_hi(f.z) + bf_hi(bw.z); x[6] = bf_lo(f.w) + bf_lo(bw.w); x[7] = bf_hi(f.w) + bf_hi(bw.w);
        o[0] = bf_lo(go.x); o[1] = bf_hi(go.x); o[2] = bf_lo(go.y); o[3] = bf_hi(go.y); o[4] = bf_lo(go.z); o[5] = bf_hi(go.z); o[6] = bf_lo(go.w); o[7] = bf_hi(go.w);
        float ss = 0.f;
#pragma unroll
        for (int j = 0; j < 8; ++j) ss += x[j] * x[j];
        ss += shx(ss, 1); ss += shx(ss, 2); ss += shx(ss, 4); ss += shx(ss, 8);
        const float rn = rsqrtf(ss * (1.f / 128.f) + RMS_EPS);
        float y[8];
#pragma unroll
        for (int j = 0; j < 8; ++j) y[j] = x[j] * rn * (j < 4 ? g0[j] : g1[j - 4]) * sigmoidf_(o[j]);
        v4u w; w.x = pk2(y[0], y[1]); w.y = pk2(y[2], y[3]); w.z = pk2(y[4], y[5]); w.w = pk2(y[6], y[7]);
        *(v4u*)(MIXIN + (size_t)m * D + 512 + lane * 8) = w;
    }
}

constexpr int CW_DBG = 16;
#ifndef DBG_MODE
#define DBG_MODE 0
#endif
#ifndef DBG_L
#define DBG_L 0
#endif
#ifndef DBG_CH
#define DBG_CH 0
#endif
__device__ __forceinline__ void dbg_report(const Params& p, float d) {
    if (!(d >= 0.f)) d = 1.0e6f;
    atomicMax((unsigned*)(p.ws + WS_CTL) + CW_DBG, __float_as_uint(d));
}
__device__ __forceinline__ float block_max(float v, LAS float* red, int tid) { v = wave_max(v); __syncthreads(); if ((tid & 63) == 0) red[tid >> 6] = v; __syncthreads(); float r = red[0];
#pragma unroll
    for (int w = 1; w < 8; ++w) r = fmaxf(r, red[w]); __syncthreads(); return r; }
__device__ __forceinline__ float block_sum(float v, LAS float* red, int tid) { v = wave_sum(v); __syncthreads(); if ((tid & 63) == 0) red[tid >> 6] = v; __syncthreads(); float r = 0.f;
#pragma unroll
    for (int w = 0; w < 8; ++w) r += red[w]; __syncthreads(); return r; }
__device__ __forceinline__ void dbg_moe_check(const Params& p, int l, int ch, const bf16* H2, const bf16* Y, LAS unsigned char* lds, int tid) {
    LAS float* hrow = (LAS float*)lds; LAS float* gu = hrow + 1024; LAS float* a = gu + 512; LAS float* red = a + 256;
    const int t = ch * CHT + blockIdx.x * 64 + 5;
    __syncthreads();
    for (int i = tid; i < 1024; i += NTHR) hrow[i] = bf1(H2[(size_t)t * D + i]);
    __syncthreads();
    const int* EIDX = (const int*)(p.ws + WS_EIDX); const float* WTS = (const float*)(p.ws + WS_WTS); const int* PSLOT = (const int*)(p.ws + WS_PSLOT);
    float yacc[2] = {0.f, 0.f};
#pragma unroll 1
    for (int k = 0; k < 9; ++k) {
        const int e = k < 8 ? (EIDX[(size_t)t * 8 + k] & 255) : 64; const float w = k < 8 ? WTS[(size_t)t * 8 + k] : 1.f;
        const float* Wgu = e < 64 ? p.in[I_EGU] + (size_t)(l * 64 + e) * 1024 * 512 : p.in[I_SGU] + (size_t)l * 1024 * 512;
        const float* Wdn = e < 64 ? p.in[I_EDN] + (size_t)(l * 64 + e) * 256 * 1024 : p.in[I_SDN] + (size_t)l * 256 * 1024;
        float s = 0.f;
#pragma unroll 4
        for (int kk = 0; kk < 1024; ++kk) s += hrow[kk] * Wgu[(size_t)kk * 512 + tid];
        gu[tid] = s;
        __syncthreads();
        if (tid < 256) a[tid] = siluf_(gu[tid]) * gu[256 + tid];
        __syncthreads();
#pragma unroll
        for (int q = 0; q < 2; ++q) { const int n = tid + 512 * q; float s2 = 0.f;
#pragma unroll 4
            for (int j = 0; j < 256; ++j) s2 += a[j] * Wdn[(size_t)j * 1024 + n];
            yacc[q] += w * s2; }
        __syncthreads();
    }
    float err = 0.f, ss = 0.f;
#pragma unroll
    for (int q = 0; q < 2; ++q) { const int n = tid + 512 * q; float f = 0.f;
#pragma unroll 1
        for (int k = 0; k < 9; ++k) { const int slot = PSLOT[(size_t)t * 16 + k]; const float w = k < 8 ? WTS[(size_t)t * 8 + k] : 1.f; f += w * bf1(Y[(size_t)slot * D + n]); }
        err = fmaxf(err, fabsf(f - yacc[q])); ss += yacc[q] * yacc[q]; }
    const float me = block_max(err, red, tid), sq = block_sum(ss, red, tid);
    if (tid == 0) dbg_report(p, me / sqrtf(sq * (1.f / 1024.f) + 1e-30f));
}
__device__ __forceinline__ void dbg_route_check(const Params& p, int l, const bf16* H2, const float* LOG, LAS unsigned char* lds, int tid) {
    LAS float* hrow = (LAS float*)lds; LAS float* lg = hrow + 1024; LAS float* bi = lg + 64; LAS float* sc = bi + 64; LAS float* red = sc + 64;
    const int t = blockIdx.x * 256 + 77;
    __syncthreads();
    for (int i = tid; i < 1024; i += NTHR) hrow[i] = bf1(H2[(size_t)t * D + i]);
    __syncthreads();
    if (tid < 64) { float s = 0.f; const float* W = p.in[I_RW] + (size_t)l * 1024 * 64;
#pragma unroll 4
        for (int k = 0; k < 1024; ++k) s += hrow[k] * W[k * 64 + tid];
        lg[tid] = s; sc[tid] = 1.f / (1.f + expf(-s)); bi[tid] = sc[tid] + p.in[I_RB][l * 64 + tid]; }
    __syncthreads();
    if (tid == 0) {
        float lerr = 0.f;
#pragma unroll 1
        for (int e = 0; e < 64; ++e) lerr = fmaxf(lerr, fabsf(lg[e] - LOG[(size_t)t * 64 + e]));
        float grp[8];
#pragma unroll
        for (int g = 0; g < 8; ++g) { float a = -1e30f, b = -1e30f;
#pragma unroll 1
            for (int j = 0; j < 8; ++j) { const float v = bi[g * 8 + j]; if (v > a) { b = a; a = v; } else if (v > b) b = v; } grp[g] = a + b; }
        unsigned gm = 0;
#pragma unroll 1
        for (int r = 0; r < 4; ++r) { int best = -1; float bv = 0.f;
#pragma unroll
            for (int g = 0; g < 8; ++g) if (!((gm >> g) & 1u) && (best < 0 || grp[g] > bv)) { best = g; bv = grp[g]; }
            gm |= 1u << best; }
        unsigned long long set_ref = 0ull; float ssum = 0.f;
#pragma unroll 1
        for (int r = 0; r < 8; ++r) { int best = -1; float bv = 0.f;
#pragma unroll 1
            for (int e = 0; e < 64; ++e) if (((gm >> (e >> 3)) & 1u) && !((set_ref >> e) & 1ull) && (best < 0 || bi[e] > bv)) { best = e; bv = bi[e]; }
            set_ref |= 1ull << best; ssum += sc[best]; }
        const int* EIDX = (const int*)(p.ws + WS_EIDX); const float* WTS = (const float*)(p.ws + WS_WTS);
        unsigned long long set_f = 0ull; float werr = 0.f, wsum = 0.f;
#pragma unroll 1
        for (int k = 0; k < 8; ++k) { const int e = EIDX[(size_t)t * 8 + k] & 255; set_f |= 1ull << e; const float wr = 2.5f * sc[e] / ssum; werr = fmaxf(werr, fabsf(wr - WTS[(size_t)t * 8 + k])); wsum += WTS[(size_t)t * 8 + k]; }
        float d = 0.f;
        if (DBG_MODE == 0) d = (set_f != set_ref) ? (1.f / 256.f) : 0.f;
        if (DBG_MODE == 1) d = (set_f != set_ref) ? 0.f : werr + fabsf(wsum - 2.5f);
        if (DBG_MODE == 2) d = lerr * (1.f / 256.f);
        atomicAdd((float*)((unsigned*)(p.ws + WS_CTL) + CW_DBG), d);
    }
    __syncthreads();
}
__device__ __forceinline__ unsigned dbg_hash(unsigned x) { x ^= x >> 16; x *= 0x7feb352du; x ^= x >> 15; x *= 0x846ca68bu; x ^= x >> 16; return x; }
__device__ __forceinline__ void dbg_report_wave(const Params& p, float d, int lane) { if (lane == 0) dbg_report(p, d); }
__device__ __forceinline__ void dbg_hyena_check(const Params& p, int mode, const bf16* HN, const bf16* UC, const bf16* ZT, const bf16* Y2T, const bf16* MIX, LAS unsigned char* lds, int lane, int wave) {
    const unsigned hsh = dbg_hash(blockIdx.x * 8u + wave + 12345u), h2 = dbg_hash(hsh), h3 = dbg_hash(h2);
    const bf16* FILT = (const bf16*)(p.ws + WS_FILT);
    float d = 0.f;
    if (mode == 0) {
        const int c = hsh % 3072u, b = h2 % 32u, s = h3 % 2048u; float acc = 0.f;
#pragma unroll 1
        for (int k = lane; k < 1024; k += 64) acc += bf1(HN[(size_t)(b * 2048 + s) * D + k]) * p.in[I_WINHY][(size_t)k * 3072 + c];
        acc = wave_sum(acc);
        const float got = bf1(UC[(size_t)c * T + b * 2048 + s]); d = fabsf(got - acc) / (fabsf(acc) + 0.1f);
    } else if (mode == 5) {
        const int c = hsh % 3072u, b = h2 % 32u; int s = h3 % 2048u; if ((h3 >> 20) % 8u == 0u) s = 0; if ((h3 >> 20) % 8u == 1u) s = 2047;
        float val = p.in[I_CONVHYB][c];
#pragma unroll 1
        for (int j = 0; j < 3; ++j) { const int sj = s + j - 1; if (sj < 0 || sj > 2047) continue; val += p.in[I_CONVHYW][j * 3072 + c] * bf1(ZT[(size_t)c * T + b * 2048 + sj]); }
        const float got = bf1(UC[(size_t)c * T + b * 2048 + s]); d = fabsf(got - val) / (fabsf(val) + 0.1f);
    } else if (mode == 1) {
        LAS float* Z = (LAS float*)(lds + wave * 1024); LAS float* A1 = Z + 64; LAS float* A2 = A1 + 64;
        const int o = hsh & 1u, c = h2 % 1024u, j = h3 % 2048u;
        float z = 0.f; if (lane == 0) z = (float)j / 2047.f; else if (lane < 33) { const int k = (lane - 1) & 15; const float fr = 1e-4f + (float)k * ((15.f - 1e-4f) / 15.f); const float ang = (6.283185307179586f / 2048.f) * (float)j * fr; z = lane < 17 ? cosf(ang) : -sinf(ang); }
        Z[lane] = z; LDS_WAIT(); asm volatile("" ::: "memory");
        float a = p.in[I_FB1][lane];
#pragma unroll 1
        for (int k = 0; k < 33; ++k) a += Z[k] * p.in[I_FW1][k * 64 + lane];
        A1[lane] = sinf(a); LDS_WAIT(); asm volatile("" ::: "memory");
        a = p.in[I_FB2][lane];
#pragma unroll 1
        for (int k = 0; k < 64; ++k) a += A1[k] * p.in[I_FW2][k * 64 + lane];
        A2[lane] = sinf(a); LDS_WAIT(); asm volatile("" ::: "memory");
        float v = wave_sum(A2[lane] * p.in[I_FW3][lane * 2048 + o * 1024 + c]);
        const float mind = -4.605170185988091f / 1.5f, maxd = -4.605170185988091f / 0.3f; const float delta = fabsf(mind + (float)c * ((maxd - mind) / 1023.f));
        v *= expf(-fabsf((float)j - 1024.f) / 1024.f * delta);
        const float got = bf1(FILT[(size_t)(o * 1024 + c) * 2048 + j]); d = fabsf(got - v) / (fabsf(v) + 1e-4f);
    } else if (mode == 2 || mode == 3) {
        const int o = mode - 2, c = hsh % 1024u, b = h2 % 32u; int t = h3 % 2048u; if ((h3 >> 20) % 8u == 0u) t = 0; if ((h3 >> 20) % 8u == 1u) t = 2047;
        const bf16* in = (o == 0 ? UC : ZT) + (size_t)c * T + b * 2048; const bf16* f = FILT + (size_t)(o * 1024 + c) * 2048; float acc = 0.f;
#pragma unroll 1
        for (int s = lane; s < 2048; s += 64) { const int x = 1024 + t - s; if (x >= 0 && x <= 2047) acc += bf1(f[x]) * bf1(in[s]); }
        acc = wave_sum(acc);
        const float gate = bf1(UC[(size_t)((1 + o) * 1024 + c) * T + b * 2048 + t]);
        const float val = gate * (acc + bf1(in[t]) * p.in[I_FBIAS][o * 1024 + c]);
        const float got = bf1((o == 0 ? ZT : Y2T)[(size_t)c * T + b * 2048 + t]); d = fabsf(got - val) / (fabsf(val) + 0.1f);
    } else if (mode == 4) {
        const int tok = hsh % 65536u, n = h2 % 1024u; float acc = 0.f;
#pragma unroll 1
        for (int c = lane; c < 1024; c += 64) acc += bf1(Y2T[(size_t)c * T + tok]) * p.in[I_WOUTHY][(size_t)c * 1024 + n];
        acc = wave_sum(acc);
        const float got = bf1(MIX[(size_t)tok * D + n]); d = fabsf(got - acc) / (fabsf(acc) + 0.1f);
    }
    dbg_report_wave(p, d, lane);
}
__device__ __forceinline__ void dbg_inproj_check(const Params& p, unsigned char* big, int lane, int wave) {
    const unsigned hsh = dbg_hash(blockIdx.x * 8u + wave + 777u), h2 = dbg_hash(hsh);
    const bf16* H0 = (const bf16*)(big + A0_H); const float* W = p.in[I_WINAB];
    int m = hsh % (unsigned)TT; int n = h2 % 3600u;
    const bool ctx = m >= T; if (ctx && n < 1536) n += 1536;
    const int b = ctx ? (m - T) / LC : m / SEQ, s = ctx ? (m - T) % LC : m % SEQ;
    float x = 0.f, xp = 0.f; const bool rope_col = (n < 512) || (n >= 1536 && n < 2048); const int np = rope_col ? (n ^ 16) : n;
#pragma unroll 1
    for (int k = lane; k < 1024; k += 64) { const float hv = bf1(H0[(size_t)m * D + k]); x += hv * W[(size_t)k * 3600 + n]; xp += hv * W[(size_t)k * 3600 + np]; }
    x = wave_sum(x); xp = wave_sum(xp);
    float val = x, got = 0.f;
    if (n >= 3584) { val = x + p.in[I_GATEB][n - 3584]; got = ((const float*)(p.ws + WS_GATES))[(size_t)m * 16 + (n - 3584)]; }
    else { const int t = n / 512, cn = n % 512; int pc = cn;
        if (rope_col) { const int o = cn & 31; pc = (cn & ~31) + (((o & 15) >> 2) * 8 + (o >> 4) * 4 + (o & 3));
            if (!ctx) { const int d = cn & 63, axis = d >> 5, half = (d >> 4) & 1, i = d & 15; const float pos = (float)(axis == 0 ? (s >> 6) : (s & 63)); const float ang = pos * powf(10000.f, -(float)i / 16.f);
                val = half == 0 ? x * cosf(ang) - xp * sinf(ang) : x * cosf(ang) + xp * sinf(ang); } }
        if (t == 0) val *= QSCALE;
        const size_t offs[7] = {A0_QA, A0_BQ, A0_BO, A0_KA, A0_VA, A0_BK, A0_BV}; const bool kv = t >= 3;
        const bf16* O = (const bf16*)(big + offs[t]) + (size_t)b * (kv ? (SEQ + LC) : SEQ) * 512 + (size_t)((kv && !ctx) ? LC : 0) * 512;
        got = bf1(O[(size_t)s * 512 + pc]); }
    dbg_report_wave(p, fabsf(got - val) / (fabsf(val) + 0.1f), lane);
}
__device__ __forceinline__ void dbg_attn_check(const Params& p, unsigned char* big, LAS unsigned char* lds, int lane, int wave) {
    const unsigned hsh = dbg_hash(blockIdx.x * 8u + wave + 4242u), h2 = dbg_hash(hsh);
    const int b = hsh % 32u, h = (hsh >> 8) % 4u, q = h2 % 2048u;
    const bf16* QA = (const bf16*)(big + A0_QA) + ((size_t)b * SEQ + q) * 512 + h * 128; const bf16* KA = (const bf16*)(big + A0_KA) + (size_t)b * 2304 * 512 + h * 128;
    const bf16* VA = (const bf16*)(big + A0_VA) + (size_t)b * 2304 * 512 + h * 128; const bf16* MIXIN = (const bf16*)(big + A0_MIXIN) + ((size_t)b * SEQ + q) * D + h * 128;
    LAS float* Aw = (LAS float*)(lds + wave * 18432);
    const float* lv = p.in[I_DLAM]; const float lam = expf(wave_sum(lv[lane] * lv[64 + lane])) - expf(wave_sum(lv[128 + lane] * lv[192 + lane])) + 0.2f;
    float mx0 = -1e30f, mx1 = -1e30f;
#pragma unroll 1
    for (int key = lane; key < 2304; key += 64) { float s0 = 0.f, s1 = 0.f;
#pragma unroll 1
        for (int d = 0; d < 64; ++d) { s0 += bf1(QA[d]) * bf1(KA[(size_t)key * 512 + d]); s1 += bf1(QA[64 + d]) * bf1(KA[(size_t)key * 512 + 64 + d]); }
        Aw[key] = s0; Aw[2304 + key] = s1; mx0 = fmaxf(mx0, s0); mx1 = fmaxf(mx1, s1); }
    mx0 = wave_max(mx0); mx1 = wave_max(mx1);
    float l0 = 0.f, l1 = 0.f;
#pragma unroll 1
    for (int key = lane; key < 2304; key += 64) { const float e0 = exp2f(Aw[key] - mx0), e1 = exp2f(Aw[2304 + key] - mx1); Aw[key] = e0; Aw[2304 + key] = e1; l0 += e0; l1 += e1; }
    l0 = wave_sum(l0); l1 = wave_sum(l1);
    LDS_WAIT(); asm volatile("" ::: "memory");
    float o[2] = {0.f, 0.f};
#pragma unroll 1
    for (int key = 0; key < 2304; ++key) { const float a = Aw[key] / l0 - lam * Aw[2304 + key] / l1; o[0] += a * bf1(VA[(size_t)key * 512 + lane]); o[1] += a * bf1(VA[(size_t)key * 512 + 64 + lane]); }
    const float ms = wave_sum(o[0] * o[0] + o[1] * o[1]) * (1.f / 128.f); const float rn = rsqrtf(ms + RMS_EPS) * 0.8f;
    float err = 0.f, sc = 0.f;
#pragma unroll
    for (int j = 0; j < 2; ++j) { const float val = o[j] * rn * p.in[I_HGA][h * 128 + 64 * j + lane]; err = fmaxf(err, fabsf(val - bf1(MIXIN[64 * j + lane]))); sc += val * val; }
    err = wave_max(err); sc = sqrtf(wave_sum(sc) * (1.f / 128.f));
    dbg_report_wave(p, err / (sc + 1e-3f), lane);
}
__device__ __forceinline__ float dbg_convsilu(const bf16* base, int pos, int lim, int ch, int d, const float* cw, const float* cb) {
    float s = cb[ch];
#pragma unroll
    for (int j = 0; j < 3; ++j) { const int pj = pos + j - 1; if (pj >= 0 && pj < lim) s += cw[j * 1024 + ch] * bf1(base[(size_t)pj * 512 + d]); }
    return s / (1.f + expf(-s));
}
__device__ __forceinline__ void dbg_mlstm_check(const Params& p, unsigned char* big, LAS unsigned char* lds, int lane, int wave) {
    const unsigned hsh = dbg_hash(blockIdx.x * 8u + wave + 991u), h2 = dbg_hash(hsh);
    const int b = hsh % 32u, h = (hsh >> 8) % 4u, dir = (hsh >> 12) & 1; int tau = h2 % 2048u; if ((h2 >> 16) % 4u == 0u) tau = (h2 >> 20) % 130u;
    const bf16* BQ = (const bf16*)(big + A0_BQ) + (size_t)b * SEQ * 512 + h * 128; const bf16* BK = (const bf16*)(big + A0_BK) + (size_t)b * (SEQ + LC) * 512 + h * 128;
    const bf16* BV = (const bf16*)(big + A0_BV) + (size_t)b * (SEQ + LC) * 512 + h * 128;
    const float* GT = (const float*)(p.ws + WS_GATES); const float* cw = p.in[I_CONVABW]; const float* cb = p.in[I_CONVABB];
    LAS float* F = (LAS float*)(lds + wave * 18432); LAS float* qv = F + 2304 + 64;
    const int N = 256 + tau + 1;
#define DBG_POS(u) ((u) < 256 ? (dir ? 255 - (u) : (u)) : (dir ? 2047 - ((u) - 256) : (u) - 256))
#define DBG_GROW(u) ((u) < 256 ? (size_t)T + b * LC + DBG_POS(u) : (size_t)b * SEQ + DBG_POS(u))
    float carry = 0.f;
#pragma unroll 1
    for (int u0 = 0; u0 < N; u0 += 64) { const int u = u0 + lane; float lf = 0.f;
        if (u < N) { const float x = GT[DBG_GROW(u) * 16 + dir * 8 + 4 + h]; lf = x >= 0.f ? -__logf(1.f + __expf(-x)) : x - __logf(1.f + __expf(x)); }
        float s = lf;
#pragma unroll
        for (int o = 1; o < 64; o <<= 1) { const float v = shup(s, o); if (lane >= o) s += v; }
        if (u < N) F[u] = carry + s; carry += shidx(s, 63); }
    LDS_WAIT(); asm volatile("" ::: "memory");
    const float Ft = F[N - 1];
    float mm = Ft;
#pragma unroll 1
    for (int u = lane; u < N; u += 64) mm = fmaxf(mm, Ft - F[u] + GT[DBG_GROW(u) * 16 + dir * 8 + h]);
    mm = wave_max(mm);
    { const int pos = DBG_POS(N - 1);
      for (int d = lane; d < 128; d += 64) qv[d] = dbg_convsilu(BQ, pos, SEQ, h * 128 + d, d, cw, cb) * 0.08838834764831845f; }
    LDS_WAIT(); asm volatile("" ::: "memory");
    float den = 0.f;
#pragma unroll 1
    for (int u = lane; u < N; u += 64) { const bool ctx = u < 256; const int pos = DBG_POS(u); const bf16* kb = ctx ? BK : BK + (size_t)LC * 512; float qk = 0.f;
#pragma unroll 1
        for (int d = 0; d < 128; ++d) qk += qv[d] * dbg_convsilu(kb, pos, ctx ? LC : SEQ, 512 + h * 128 + d, d, cw, cb);
        const float om = qk * expf(Ft - F[u] + GT[DBG_GROW(u) * 16 + dir * 8 + h] - mm); F[u] = om; den += om; }
    den = wave_sum(den);
    LDS_WAIT(); asm volatile("" ::: "memory");
    float num[2] = {0.f, 0.f};
#pragma unroll 1
    for (int u = 0; u < N; ++u) { const bool ctx = u < 256; const int pos = DBG_POS(u); const bf16* vb = BV + (size_t)((ctx ? 0 : LC) + pos) * 512; num[0] += F[u] * bf1(vb[lane]); num[1] += F[u] * bf1(vb[64 + lane]); }
    const float dd = 1.f / fmaxf(fabsf(den), expf(-mm));
    const bf16* HB = (const bf16*)(big + A0_HB) + (size_t)dir * T * 512 + ((size_t)b * SEQ + DBG_POS(N - 1)) * 512 + h * 128;
    float err = 0.f, sc = 0.f;
#pragma unroll
    for (int j = 0; j < 2; ++j) { const float val = num[j] * dd; err = fmaxf(err, fabsf(val - bf1(HB[64 * j + lane]))); sc += val * val; }
    err = wave_max(err); sc = sqrtf(wave_sum(sc) * (1.f / 128.f));
    dbg_report_wave(p, err / (sc + 1e-3f), lane);
#undef DBG_POS
#undef DBG_GROW
}

__global__ void __launch_bounds__(NTHR, 2) mk_fwd(Params p0) {
    extern __shared__ __attribute__((aligned(16))) unsigned char lds_raw[];
    LAS unsigned char* lds = (LAS unsigned char*)lds_raw;
    const int wave0 = __builtin_amdgcn_readfirstlane((int)threadIdx.x >> 6);
    if (threadIdx.x < 64) ((LAS unsigned*)(lds + LDS_MISC))[threadIdx.x] = 0u;
    __syncthreads();
    XcdBarrier bar = xcd_barrier_post((unsigned*)(p0.ws + WS_CTL) + CW_BAR, (volatile LAS unsigned*)(lds + LDS_MISC + 32));
    const int G = gridDim.x, cb = blockIdx.x;
    const int vcu = (G % 8 == 0) ? (cb % 8) * (G / 8) + cb / 8 : cb;
#ifdef TIMEK
    int phc = 0; if (blockIdx.x == 0 && threadIdx.x == 0) ((unsigned long long*)(p0.ws + WS_CTL + 32768))[0] = __builtin_amdgcn_s_memrealtime();
#endif
#ifdef DBL_PH
#define DBL_LOOP for (int rep_ = 0; rep_ < 1; ++rep_)
#define DBL_SYNC __syncthreads();
#else
#define DBL_LOOP
#define DBL_SYNC
#endif
#ifdef TIMEK
#define TS_REC { ++phc; if (blockIdx.x == 0 && wave0 == 0 && lane_opq() == 0) ((unsigned long long*)(p0.ws + WS_CTL + 32768))[phc] = __builtin_amdgcn_s_memrealtime(); }
#else
#define TS_REC
#endif
#define LAYER_PTRS bf16* H2 = (bf16*)(big + (l == 0 ? 0 : 128 * MiB)); float* LOG = nullptr; bf16* ACT = (bf16*)(big + (l == 0 ? 144 * MiB : 272 * MiB)); \
        bf16* Y = (bf16*)(big + (l == 0 ? 304 * MiB : 432 * MiB)); bf16* HN = (bf16*)(big + 640 * MiB); const bf16* MIX = (const bf16*)(big + (l == 0 ? A0_MIX : 0)); \
        unsigned char* X8 = ws + WS_X8; bf16* UT = (bf16*)big; bf16* UC = (bf16*)(big + 384 * MiB); bf16* ZT = (bf16*)(big + 384 * MiB); bf16* Y2T = (bf16*)(big + 512 * MiB); bf16* Y2 = (bf16*)(big + 640 * MiB); \
        (void)X8; (void)H2; (void)LOG; (void)ACT; (void)Y; (void)HN; (void)MIX; (void)UT; (void)UC; (void)ZT; (void)Y2T; (void)Y2;
#define RUN(...) do { { { int tid_ = wave0 * 64 + lane_opq(); asm volatile("" : "+v"(tid_)); const int tid = tid_, lane = tid & 63, wave = __builtin_amdgcn_readfirstlane(tid >> 6); (void)lane; (void)wave; \
        Params p = p0; { size_t z_ = 0; asm volatile("" : "+s"(z_)); p.ws = p0.ws + z_; p.out = p0.out + z_; _Pragma("unroll") for (int i_ = 0; i_ < 31; ++i_) p.in[i_] = p0.in[i_] + z_; } unsigned char* ws = p.ws; unsigned char* big = ws + WS_BIG; (void)big; LAYER_PTRS DBL_LOOP { __VA_ARGS__; DBL_SYNC } } { XcdBarrier b2_ = bar; { size_t z_ = 0; asm volatile("" : "+s"(z_)); b2_.bar = bar.bar + z_; unsigned x_ = bar.x; asm volatile("" : "+s"(x_)); b2_.x = x_; } xcd_barrier(b2_, wave0 == 0 && lane_opq() == 0); } TS_REC } } while (0)

#ifdef PRO_PROBE
#define PP(i) do { if (blockIdx.x == 0 && tid == 0) ((unsigned long long*)(p0.ws + WS_CTL + 32768))[50 + (i)] = __builtin_amdgcn_s_memrealtime(); } while (0)
#else
#define PP(i)
#endif
    { const int l = 0; RUN({ PP(0); pro_mod(p, lds, tid, lane, wave); __syncthreads(); PP(1); pro_filters(p, lds, tid, lane, wave); PP(2); pro_rope(p, tid); pro_transposes(p, lds, lane, wave); PP(3); }); }

    for (int l = 0; l < 2; ++l) {
        if (l == 0) {
            RUN({ ph_l0_norm(p, lane, wave); });
            RUN({ Gemm g{(const bf16*)(big + A0_H), (const bf16*)(ws + WS_WIN0), 1024, 2048u}; InprojSched S{G, vcu};
                  EpiInproj E{big, (const float*)(ws + WS_ROPE), (float*)(ws + WS_GATES), p.in[I_GATEB]};
                  gemm_phase<EpiInproj, InprojSched>(lds, g, S, E, tid); });
#ifdef DBG_INPROJ
            RUN({ dbg_inproj_check(p, big, lane, wave); });
#endif
            RUN({ ph_attn(p, big, lds, tid, lane, wave, vcu); });
#ifdef DBG_ATTN
            RUN({ dbg_attn_check(p, big, lds, lane, wave); });
#endif
            RUN({ ph_mlstm(p, big, lds, tid, lane, wave); });
#ifdef DBG_MLSTM
            RUN({ dbg_mlstm_check(p, big, lds, lane, wave); });
#endif
            RUN({ ph_outb(p, big, lane, wave, vcu); asm volatile("s_waitcnt vmcnt(0)" ::: "memory"); __syncthreads();
                  Gemm g{(const bf16*)(big + A0_MIXIN), (const bf16*)(ws + WS_WOUT0), 1024, 2048u}; PanelSched S{4, vcu}; EpiBf16 E{(bf16*)(big + A0_MIX), 1024, 3};
                  gemm_phase<EpiBf16, PanelSched>(lds, g, S, E, tid); });
        }
        if (l == 1) {
            RUN({ Gemm g{(const bf16*)(ws + WS_WIN1), HN, 1024, 2048u}; DenseSched S{256, 12 * 256, G, vcu, 12}; EpiBf16 E{UT, (size_t)T, 0xffff};
                  gemm_phase<EpiBf16, DenseSched>(lds, g, S, E, tid); });
#ifdef DBG_HY
            if (DBG_MODE == 0) { RUN({ dbg_hyena_check(p, 0, HN, UT, UT, UT, UT, lds, lane, wave); }); }
#endif
#ifdef DBG_HY
            if (DBG_MODE == 5) { RUN({ dbg_hyena_check(p, 5, HN, UC, UT, UT, UT, lds, lane, wave); }); }
#endif
            RUN({ ph_lconv<true>(p, 0, UT, UT, ZT, lds, tid, lane, wave); });
#ifdef DBG_HY
            if (DBG_MODE == 2) { RUN({ dbg_hyena_check(p, 2, HN, UC, ZT, Y2T, UT, lds, lane, wave); }); }
#endif
            RUN({ ph_lconv<false>(p, 1, ZT, UT, Y2T, lds, tid, lane, wave); });
#ifdef DBG_HY
            if (DBG_MODE == 3) { RUN({ dbg_hyena_check(p, 3, HN, UC, ZT, Y2T, UT, lds, lane, wave); }); }
#endif
            RUN({ ph_transpose(Y2T, Y2, lds, lane, wave, vcu); asm volatile("s_waitcnt vmcnt(0)" ::: "memory"); __syncthreads();
                  Gemm g{Y2, (const bf16*)(ws + WS_WOUT1), 1024, 2048u}; PanelSched S{4, vcu}; EpiBf16 E{(bf16*)big, 1024, 3};
                  gemm_phase<EpiBf16, PanelSched>(lds, g, S, E, tid); });
        }
#ifdef DBG_HY
        if (l == 1 && (DBG_MODE == 1 || DBG_MODE == 4)) { RUN({ dbg_hyena_check(p, DBG_MODE, HN, (const bf16*)(big + 384 * MiB), (const bf16*)big, (const bf16*)(big + 128 * MiB), (const bf16*)big, lds, lane, wave); }); }
#endif
        RUN({ ph_mid(p, l, MIX, H2, X8, true, lane, wave, vcu); asm volatile("s_waitcnt vmcnt(0)" ::: "memory"); __syncthreads();
              Gemm g{H2, (const bf16*)(ws + WS_WR) + (size_t)l * 256 * 1024, 1024, 2048u}; DenseSched S{1, 256, G, vcu, 0}; EpiRouterLds E{};
              gemm_phase<EpiRouterLds, DenseSched>(lds, g, S, E, tid); __syncthreads(); ph_route_a(p, l, nullptr, vcu, lds, tid); });
#ifdef DBG_ROUTE
        RUN({ if (l == DBG_L) dbg_route_check(p, l, H2, LOG, lds, tid); ph_route_b(p, lds, tid); });
#else
        RUN({ ph_route_b(p, lds, tid); });
#endif
#define DO_G1(chx) do { const int NT = moe_tables(p, chx, lds, tid); \
            Gemm g{(const bf16*)X8, (const bf16*)(ws + WS_GU + (size_t)l * (65 * 512) * 1024), 512, 1024u};        \
            MoeSched S{(const LAS int*)(lds + LDS_TAB), (const int*)(ws + WS_SORT) + (size_t)(chx) * CHROWS, NT * 2, G, vcu, 1, 2, nullptr}; EpiSwiglu E{(unsigned char*)ACT}; \
            gemm_phase<EpiSwiglu, MoeSched, true, true>(lds, g, S, E, tid); } while (0)
        RUN({ DO_G1(0); });
        for (int ch = 0; ch < NCH; ++ch) {
            RUN({ const int NT = moe_tables(p, ch, lds, tid);
                  int k_ = 128; asm volatile("" : "+s"(k_));
                  Gemm g{ACT, (const bf16*)(ws + WS_DN + (size_t)l * (65 * 1024) * 256), k_, 256u};
                  MoeSched S{(const LAS int*)(lds + LDS_TAB), nullptr, NT * 4, G, vcu, 2, 4, (l == 0 && ch == 0) ? (void*)(ws + WS_CTL + 32768) : nullptr}; EpiFp8 E{(unsigned char*)Y};
                  gemm_phase<EpiFp8, MoeSched, true, true>(lds, g, S, E, tid); });
            RUN({ const int par = (cb >> 3) & 1;
                  _Pragma("unroll 1") for (int part = 0; part < 2; ++part) { int t2_ = tid; asm volatile("" : "+v"(t2_)); const int tid = t2_, lane = tid & 63; (void)lane; if ((part ^ par) == 0) { if (ch + 1 < NCH) DO_G1(ch + 1); } else { ph_combine(p, l, ch, (const unsigned char*)Y, HN, lane, wave); } __syncthreads(); } });
        }
    }
#ifdef TIMEK
    if (blockIdx.x == 0) { const unsigned long long* ts = (const unsigned long long*)(p0.ws + WS_CTL + 32768); __syncthreads();
        const unsigned long long d = (__hip_atomic_load(ts + TIMEK, __ATOMIC_RELAXED, __HIP_MEMORY_SCOPE_AGENT) - __hip_atomic_load(ts + TIMEK0, __ATOMIC_RELAXED, __HIP_MEMORY_SCOPE_AGENT)) * 4ull, t0 = __builtin_amdgcn_s_memrealtime();
        while (__builtin_amdgcn_s_memrealtime() - t0 < d) __builtin_amdgcn_s_sleep(8); }
#endif
#ifdef DBG_ANY
    xcd_barrier(bar, threadIdx.x == 0);
    if (blockIdx.x == 0 && threadIdx.x == 0) p0.out[0] += 1.0e7f * __uint_as_float(((const unsigned*)(p0.ws + WS_CTL))[CW_DBG]);
#endif
#undef RUN
}
constexpr int NPHASES = 1 + 2 * (4 + 3 * NCH) + 6 + 64;
}

extern "C" void kernel_launch(void* const* d_in, const int* in_sizes, int n_in, void* d_out, int out_size, void* d_ws, size_t ws_size, hipStream_t stream) {
    using namespace mk;
    static int grid = 0;
    if (grid == 0) {
        if (n_in != 31 || out_size != T * D || ws_size < WS_END) { fprintf(stderr, "kernel_launch: unexpected shapes (n_in %d, out %d, ws %zu)\n", n_in, out_size, ws_size); grid = -1; return; }
        int dev = 0, cus = 0;
        if (hipGetDevice(&dev) != hipSuccess || hipDeviceGetAttribute(&cus, hipDeviceAttributeMultiprocessorCount, dev) != hipSuccess) { grid = -1; return; }
        if (hipFuncSetAttribute((const void*)mk_fwd, hipFuncAttributeMaxDynamicSharedMemorySize, LDS_BYTES) != hipSuccess) { fprintf(stderr, "kernel_launch: hipFuncSetAttribute failed\n"); grid = -1; return; }
        int per_cu = 0;
        if (hipOccupancyMaxActiveBlocksPerMultiprocessor(&per_cu, (const void*)mk_fwd, NTHR, LDS_BYTES) != hipSuccess || per_cu < 1) { fprintf(stderr, "kernel_launch: occupancy query says %d\n", per_cu); }
        (void)hipGetLastError();
        grid = cus;
        if (grid != 256) { fprintf(stderr, "kernel_launch: built for 256 CUs, found %d\n", grid); grid = -1; return; }
    }
    if (grid < 0) return;
    (void)hipMemsetAsync((char*)d_ws + WS_CTL, 0, CTL_ZERO_BYTES, stream);
    Params a{};
    for (int i = 0; i < 31; ++i) a.in[i] = (const float*)d_in[i];
    a.out = (float*)d_out; a.ws = (unsigned char*)d_ws; a.ph_lo = 0; a.ph_hi = NPHASES;
    hipLaunchKernelGGL(mk_fwd, dim3(grid), dim3(NTHR), LDS_BYTES, stream, a);
}
```

```cpp
#include <hip/hip_runtime.h>
#include <cstdio>
#include <cstdint>
namespace pg8 {
#define PG8_LAS __attribute__((address_space(3)))
typedef unsigned short bf16_t;
typedef short bf16x8 __attribute__((ext_vector_type(8)));
typedef float f32x4 __attribute__((ext_vector_type(4)));
typedef unsigned u32x4 __attribute__((ext_vector_type(4)));
typedef unsigned u32x2 __attribute__((ext_vector_type(2)));
typedef int i32x4 __attribute__((ext_vector_type(4)));
typedef int i32x8 __attribute__((ext_vector_type(8)));
constexpr int BM = 256, BK = 64, HALF = 128, HTB = HALF * BK * 2  , STAGE_BYTES = 8 * HTB;

__host__ __device__ __forceinline__ int lds_byte(int r, int c) { const int st = (r >> 4) * 2 + (c >> 5), rr = r & 15, cc = c & 31, ob = rr * 64 + cc * 2; return st * 1024 + (ob ^ (((ob >> 9) & 1) << 5)); }
__host__ __device__ __forceinline__ void stage_rc(int b, int& R, int& C) { const int st = b / 1024, sb = b % 1024, swz = sb ^ (((sb >> 9) & 1) << 5); R = (st >> 1) * 16 + swz / 64; C = (st & 1) * 32 + (swz % 64) / 2; }
__host__ __device__ __forceinline__ int perm32(int rho) { const int n = rho >> 4, i = rho & 15; return 8 * (i >> 2) + 4 * n + (i & 3); }

struct Unit { int pm, pn; };
__device__ __forceinline__ unsigned cvt_pk_bf16(float lo, float hi) { unsigned r; asm volatile("v_cvt_pk_bf16_f32 %0, %1, %2" : "=v"(r) : "v"(lo), "v"(hi)); return r; }
struct Gemm { const bf16_t* A; const bf16_t* Bt; int K; unsigned lda_bytes; };
template <class Epi, class Sched, bool ALIGN_EPI = true, bool F8 = false>
__device__ __forceinline__ void gemm_phase(PG8_LAS unsigned char* lds, const Gemm g, const Sched& S, const Epi& E, const int tid_in) {
    int tid_ = tid_in; asm volatile("" : "+v"(tid_));
    const int tid = tid_, wid = __builtin_amdgcn_readfirstlane(tid >> 6), lane = tid & 63, wr = wid >> 2, wc = wid & 3, fr = lane & 15, fq = lane >> 4;
    const int K = g.K, nt = K / BK;
    unsigned voffB[2];
#pragma unroll
    for (int i = 0; i < 2; ++i) { int R, C; stage_rc(tid * 16 + i * 8192, R, C); const int Rb = Epi::PERM ? ((R & ~31) + perm32(R & 31)) : R;
        voffB[i] = (unsigned)(Rb * K + C) * 2u; }
    const size_t kstep = (size_t)(BK * 2);
    const size_t hstep = (size_t)HALF * K * 2;
    const size_t tstep = 2 * hstep;
    const unsigned ldsw = (unsigned)wid * 1024u;
    const int aoff = lds_byte(wr * 64 + fr, fq * 8), boff = lds_byte(wc * 32 + fr, fq * 8);
    const char* Ab = (const char*)g.A;
#define PG8_SA(b, h) (((b) * 2 + (h)) * HTB)
#define PG8_SB(b, h) ((4 + (b) * 2 + (h)) * HTB)
#define PG8_STAGE(bufoff, gbase, voff) do { _Pragma("unroll") for (int _i = 0; _i < 2; ++_i) \
        __builtin_amdgcn_global_load_lds((const unsigned*)((const char*)(gbase) + (voff)[_i]), (PG8_LAS unsigned*)(lds + (bufoff) + ldsw + _i * 8192), 16, 0, 0); } while (0)
#define PG8_STAGEA(bufoff, o0, o1, kb) do { \
        __builtin_amdgcn_global_load_lds((const unsigned*)(Ab + (size_t)(o0) + (size_t)(kb)), (PG8_LAS unsigned*)(lds + (bufoff) + ldsw), 16, 0, 0); \
        __builtin_amdgcn_global_load_lds((const unsigned*)(Ab + (size_t)(o1) + (size_t)(kb)), (PG8_LAS unsigned*)(lds + (bufoff) + ldsw + 8192), 16, 0, 0); } while (0)
#define PG8_LDA(dst, b, h) do { _Pragma("unroll") for (int m = 0; m < 4; ++m) _Pragma("unroll") for (int k = 0; k < 2; ++k) dst[m][k] = *(const PG8_LAS bf16x8*)(lds + PG8_SA(b, h) + aoff + m * 2048 + k * 1024); } while (0)
#define PG8_LDB(dst, b, h) do { _Pragma("unroll") for (int n = 0; n < 2; ++n) _Pragma("unroll") for (int k = 0; k < 2; ++k) dst[n][k] = *(const PG8_LAS bf16x8*)(lds + PG8_SB(b, h) + boff + n * 2048 + k * 1024); } while (0)
#define PG8_CAT(x0, x1) __builtin_shufflevector(__builtin_bit_cast(i32x4, x0), __builtin_bit_cast(i32x4, x1), 0, 1, 2, 3, 4, 5, 6, 7)
#define PG8_MMA(ai, bj, At, Bt) do { __builtin_amdgcn_s_setprio(1); _Pragma("unroll") for (int m = 0; m < 4; ++m) _Pragma("unroll") for (int n = 0; n < 2; ++n) { \
        if constexpr (F8) acc[ai][bj][m][n] = __builtin_amdgcn_mfma_scale_f32_16x16x128_f8f6f4(PG8_CAT(Bt[n][0], Bt[n][1]), PG8_CAT(At[m][0], At[m][1]), acc[ai][bj][m][n], 0, 0, 0, 0, 0, 0); \
        else { _Pragma("unroll") for (int k = 0; k < 2; ++k) acc[ai][bj][m][n] = __builtin_amdgcn_mfma_f32_16x16x32_bf16(Bt[n][k], At[m][k], acc[ai][bj][m][n], 0, 0, 0); } } __builtin_amdgcn_s_setprio(0); } while (0)
#define PG8_WAIT_V(n) asm volatile("s_waitcnt vmcnt(" #n ")" ::: "memory")
#define PG8_WAIT_L(n) asm volatile("s_waitcnt lgkmcnt(" #n ")" ::: "memory")
#define PG8_BAR __builtin_amdgcn_s_barrier()
#define PG8_SCHED __builtin_amdgcn_sched_barrier(0)
#define PG8_OFFS(dst, u) do { _Pragma("unroll") for (int _i = 0; _i < 2; ++_i) { int _R, _C; stage_rc(tid * 16 + _i * 8192, _R, _C); _Pragma("unroll") for (int _h = 0; _h < 2; ++_h) \
        dst[_h][_i] = (unsigned)S.arow((u).pm * BM + _h * HALF + _R) * g.lda_bytes + (unsigned)(_C * 2); } } while (0)
    Unit cur, nxt; int ui = 0;
    if (!S.next(0, cur)) return;
    f32x4 acc[2][2][4][2];
#pragma unroll
    for (int a = 0; a < 2; ++a)
#pragma unroll
        for (int b = 0; b < 2; ++b)
#pragma unroll
            for (int m = 0; m < 4; ++m)
#pragma unroll
                for (int n = 0; n < 2; ++n) acc[a][b][m][n] = (f32x4){0.f, 0.f, 0.f, 0.f};
    bf16x8 At[4][2], B0[2][2], B1[2][2];
    unsigned oC[2][2], oN[2][2];
    PG8_OFFS(oC, cur);
    const char* cB = (const char*)g.Bt + (size_t)cur.pn * tstep;
    PG8_STAGE(PG8_SB(0, 0), cB, voffB); PG8_STAGE(PG8_SB(0, 1), cB + hstep, voffB); PG8_STAGEA(PG8_SA(0, 0), oC[0][0], oC[0][1], 0); PG8_STAGEA(PG8_SA(0, 1), oC[1][0], oC[1][1], 0);
    if (wr == 1) PG8_BAR;
    PG8_WAIT_V(2); PG8_BAR;
    PG8_STAGE(PG8_SB(1, 0), cB + kstep, voffB); PG8_STAGEA(PG8_SA(1, 0), oC[0][0], oC[0][1], kstep); PG8_STAGE(PG8_SB(1, 1), cB + hstep + kstep, voffB);
    PG8_WAIT_V(6); PG8_BAR;
#ifdef GM_PROBE
    unsigned long long gaccs[3] = {0, 0, 0}; unsigned long long gtp = __builtin_amdgcn_s_memrealtime();
#define GM_T(i) do { if (Epi::PROBE) { const unsigned long long t1_ = __builtin_amdgcn_s_memrealtime(); gaccs[i] += t1_ - gtp; gtp = t1_; } } while (0)
#else
#define GM_T(i)
#endif
    for (;;) {
        const bool has_next = S.next(ui + 1, nxt);
        if (has_next) { PG8_OFFS(oN, nxt); } else {
#pragma unroll
            for (int _h = 0; _h < 2; ++_h)
#pragma unroll
                for (int _i = 0; _i < 2; ++_i) oN[_h][_i] = oC[_h][_i]; }
        const char* nB = has_next ? (const char*)g.Bt + (size_t)nxt.pn * tstep : cB;
#pragma unroll 1
        for (int t = 0; t < nt; t += 2) {
            const bool last = (t == nt - 2);
            const size_t k1 = (size_t)(t + 1) * kstep;
            const size_t k2 = last ? 0 : (size_t)(t + 2) * kstep, k3 = k2 + kstep;
            const char* b2 = last ? nB : cB + (size_t)(t + 2) * kstep; const char* b3 = b2 + kstep;
            PG8_LDB(B0, 0, 0); PG8_LDB(B1, 0, 1); PG8_SCHED; PG8_LDA(At, 0, 0); PG8_STAGEA(PG8_SA(1, 1), oC[1][0], oC[1][1], k1);
            if (last) { oC[0][0] = oN[0][0]; oC[0][1] = oN[0][1]; oC[1][0] = oN[1][0]; oC[1][1] = oN[1][1]; }
            PG8_WAIT_V(8); PG8_WAIT_L(0); PG8_BAR; PG8_MMA(0, 0, At, B0); PG8_MMA(0, 1, At, B1); PG8_BAR; PG8_SCHED;
            PG8_LDA(At, 0, 1); PG8_STAGE(PG8_SB(0, 0), b2, voffB); PG8_STAGE(PG8_SB(0, 1), b2 + hstep, voffB); PG8_STAGEA(PG8_SA(0, 0), oC[0][0], oC[0][1], k2);
            PG8_WAIT_V(8); PG8_WAIT_L(0); PG8_BAR; PG8_MMA(1, 0, At, B0); PG8_MMA(1, 1, At, B1); PG8_BAR; PG8_SCHED;
            PG8_LDB(B0, 1, 0); PG8_LDB(B1, 1, 1); PG8_SCHED; PG8_LDA(At, 1, 0); PG8_STAGEA(PG8_SA(0, 1), oC[1][0], oC[1][1], k2);
            PG8_WAIT_V(8); PG8_WAIT_L(0); PG8_BAR; PG8_MMA(0, 0, At, B0); PG8_MMA(0, 1, At, B1); PG8_BAR; PG8_SCHED;
            PG8_LDA(At, 1, 1); PG8_STAGE(PG8_SB(1, 0), b3, voffB); PG8_STAGE(PG8_SB(1, 1), b3 + hstep, voffB); PG8_STAGEA(PG8_SA(1, 0), oC[0][0], oC[0][1], k3);
            PG8_WAIT_V(8); PG8_WAIT_L(0); PG8_BAR; PG8_MMA(1, 0, At, B0); PG8_MMA(1, 1, At, B1); PG8_BAR; PG8_SCHED;
        }
        GM_T(0);
        if constexpr (ALIGN_EPI) { if (wr == 0) PG8_BAR; }
        GM_T(1);
        E(acc, cur, wr, wc, fr, fq);
        GM_T(2);
        if (!has_next) break;
#pragma unroll
        for (int a = 0; a < 2; ++a)
#pragma unroll
            for (int b = 0; b < 2; ++b)
#pragma unroll
                for (int m = 0; m < 4; ++m)
#pragma unroll
                    for (int n = 0; n < 2; ++n) acc[a][b][m][n] = (f32x4){0.f, 0.f, 0.f, 0.f};
        cur = nxt; cB = nB; ++ui;
#pragma unroll
        for (int _h = 0; _h < 2; ++_h)
#pragma unroll
            for (int _i = 0; _i < 2; ++_i) oC[_h][_i] = oN[_h][_i];
        if constexpr (ALIGN_EPI) { if (wr == 1) PG8_BAR; }
    }
#ifdef GM_PROBE
    if (Epi::PROBE && blockIdx.x == 0 && tid == 0) { unsigned long long* ts = (unsigned long long*)(S.probe_ts()); if (ts) { ts[50] = 0; ts[51] = gaccs[0]; ts[52] = gaccs[0] + gaccs[1]; ts[53] = gaccs[0] + gaccs[1] + gaccs[2]; } }
#endif
    PG8_WAIT_V(0);
    if constexpr (!ALIGN_EPI) { if (wr == 0) PG8_BAR; }
    PG8_BAR;
    if constexpr (Epi::AFTER_DRAIN) E.fused(acc, cur, wr, wc, fr, fq, lds);
#undef PG8_SA
#undef PG8_SB
#undef PG8_STAGE
#undef PG8_STAGEA
#undef PG8_LDA
#undef PG8_LDB
#undef PG8_MMA
#undef PG8_CAT
#undef PG8_WAIT_V
#undef PG8_WAIT_L
#undef PG8_BAR
#undef PG8_SCHED
#undef PG8_OFFS
#undef GM_T
}

template <class Epi, class Sched>
__device__ __noinline__ void gemm_phase_ni(PG8_LAS unsigned char* lds, Gemm g, Sched S, Epi E) { gemm_phase<Epi, Sched>(lds, g, S, E, (int)threadIdx.x); }
}

namespace mk {
using namespace pg8;
constexpr int D = 1024, NB = 32, SEQ = 2048, T = NB * SEQ, LC = 256, TC = NB * LC, TT = T + TC;
constexpr int NMOD = 6 * D;
constexpr int NE = 64, NEX = 65, DE = 256;
constexpr int NCH = 2, CHT = T / NCH, BPC = 256 / NCH;
constexpr int MAXTILES = (CHT * 8 + 64 * 255) / 256 + CHT / 256 + 1, CHROWS = MAXTILES * 256;
constexpr float RMS_EPS = 1e-6f;
constexpr int NWAVES = 8, NTHR = 512;

constexpr size_t MiB = 1u << 20;
constexpr size_t WS_CTL = 0, CTL_ZERO_BYTES = 64 * 1024;
constexpr size_t WS_MOD = 1 * MiB;
constexpr size_t WS_ROPE = 3 * MiB;
constexpr size_t WS_BC = 3 * MiB + 65536;
constexpr size_t WS_TEG = 3 * MiB + 2 * 65536;
constexpr size_t WS_GATES = 4 * MiB;
constexpr size_t WS_FILT = 10 * MiB;
constexpr size_t WS_EIDX = 18 * MiB, WS_WTS = 20 * MiB, WS_PSLOT = 22 * MiB, WS_SORT = 26 * MiB;
constexpr size_t WS_WIN0 = 30 * MiB;
constexpr size_t WS_WOUT0 = 38 * MiB, WS_WIN1 = 40 * MiB, WS_WOUT1 = 46 * MiB, WS_WR = 48 * MiB;
constexpr size_t WS_GU = 50 * MiB;
constexpr size_t WS_X8 = 116 * MiB;
constexpr size_t WS_DN = 180 * MiB;
constexpr size_t WS_BIG = 246 * MiB;
constexpr size_t WS_END = 1024 * MiB;
static_assert(WS_PSLOT + (size_t)T * 16 * 4 <= WS_SORT && WS_SORT + (size_t)NCH * CHROWS * 4 <= WS_WIN0 && WS_WIN0 + (size_t)3840 * 2048 <= WS_WOUT0 && WS_WR + (size_t)2 * 256 * 2048 <= WS_GU && WS_GU + (size_t)2 * 65 * 512 * 1024 <= WS_X8 && WS_X8 + (size_t)T * D <= WS_DN && WS_DN + (size_t)2 * 65 * 1024 * 512 <= WS_BIG, "ws map");
constexpr size_t A0_H = 0, A0_QA = 144 * MiB, A0_KA = 208 * MiB, A0_VA = 280 * MiB, A0_BQ = 352 * MiB, A0_BK = 416 * MiB, A0_BV = 488 * MiB, A0_BO = 560 * MiB, A0_VT = 624 * MiB;
constexpr size_t A0_MIXIN = 0, A0_HB = 144 * MiB, A0_MIX = 352 * MiB;
constexpr int CW_BAR = 4096;

constexpr int LDS_BYTES = 160 * 1024;
constexpr int LDS_TAB = 131072;
constexpr int LDS_MISC = 131072 + 24 * 1024;

#define GAS __attribute__((address_space(1)))
#define LAS __attribute__((address_space(3)))
typedef unsigned short bf16;
typedef unsigned v4u __attribute__((ext_vector_type(4)));
typedef unsigned v2u __attribute__((ext_vector_type(2)));
#define LDS_WAIT() asm volatile("s_waitcnt lgkmcnt(0)" ::: "memory")
#define VM_WAIT() asm volatile("s_waitcnt vmcnt(0)" ::: "memory")
__device__ __forceinline__ unsigned f2bf(float f) { unsigned u = __builtin_bit_cast(unsigned, f); return (u + 0x7fffu + ((u >> 16) & 1u)) >> 16; }
typedef float f32x2_t __attribute__((ext_vector_type(2))); typedef __bf16 bf16x2_t __attribute__((ext_vector_type(2)));
__device__ __forceinline__ unsigned pk2(float lo, float hi) { const f32x2_t v = {lo, hi}; return __builtin_bit_cast(unsigned, __builtin_convertvector(v, bf16x2_t)); }
__device__ __forceinline__ float bf_lo(unsigned w) { return __builtin_bit_cast(float, w << 16); }
__device__ __forceinline__ float bf_hi(unsigned w) { return __builtin_bit_cast(float, w & 0xffff0000u); }
__device__ __forceinline__ float bf1(bf16 h) { return __builtin_bit_cast(float, (unsigned)h << 16); }
__device__ __forceinline__ int lane_opq() { int l = (int)__builtin_amdgcn_mbcnt_hi(~0u, __builtin_amdgcn_mbcnt_lo(~0u, 0u)); asm volatile("" : "+v"(l)); return l; }
__device__ __forceinline__ float shx(float v, int m) { return __builtin_bit_cast(float, __builtin_amdgcn_ds_bpermute((lane_opq() ^ m) << 2, __builtin_bit_cast(int, v))); }
__device__ __forceinline__ float shup(float v, int o) { const int l = lane_opq(); return __builtin_bit_cast(float, __builtin_amdgcn_ds_bpermute((l >= o ? l - o : l) << 2, __builtin_bit_cast(int, v))); }
__device__ __forceinline__ float shidx(float v, int idx) { return __builtin_bit_cast(float, __builtin_amdgcn_ds_bpermute(idx << 2, __builtin_bit_cast(int, v))); }
__device__ __forceinline__ float wave_sum(float v) {
#pragma unroll
    for (int o = 1; o < 64; o <<= 1) v += shx(v, o);
    return v;
}
__device__ __forceinline__ float wave_max(float v) {
#pragma unroll
    for (int o = 1; o < 64; o <<= 1) v = fmaxf(v, shx(v, o));
    return v;
}
__device__ __forceinline__ float sigmoidf_(float x) { return __builtin_amdgcn_rcpf(1.f + __expf(-x)); }
__device__ __forceinline__ float siluf_(float x) { return x * __builtin_amdgcn_rcpf(1.f + __expf(-x)); }
#define XB_TMO      128
#define XB_XCNT(j)  (256  + 64 * (j))
#define XB_XSUB(j)  (1280 + 64 * (j))
#define XB_XGEN(j)  (2304 + 64 * (j))
#define XB_TOP      3328
#define XB_TOPGEN   3392
#define XCD_BAR_WORDS 3456
#define XB_SPIN_CAP (1u << 18)

__device__ __forceinline__ unsigned xb_ld(unsigned* p)              { return __hip_atomic_load(p, __ATOMIC_RELAXED, __HIP_MEMORY_SCOPE_AGENT); }
__device__ __forceinline__ unsigned xb_add(unsigned* p, unsigned v) { return __hip_atomic_fetch_add(p, v, __ATOMIC_RELAXED, __HIP_MEMORY_SCOPE_AGENT); }
__device__ __forceinline__ unsigned xb_xcc_id() { return (unsigned)__builtin_amdgcn_s_getreg((3 << 11) | 20) & 0xFu; }
#define XB_SPIN(cond, bar) do { unsigned _sp = 0; while (cond) { __builtin_amdgcn_s_sleep(1); \
    if ((++_sp & 255u) == 0u) { if (xb_ld(&(bar)[XB_TMO])) break; if (_sp > XB_SPIN_CAP) { atomicAdd(&(bar)[XB_TMO], 1u); break; } } } } while (0)

struct XcdBarrier {
    unsigned* bar; unsigned x;
    volatile LAS unsigned* st;
};

__device__ __forceinline__ XcdBarrier xcd_barrier_post(unsigned* bar, volatile LAS unsigned* st) {
    XcdBarrier b; b.bar = bar; b.x = xb_xcc_id(); b.st = st;
    if (threadIdx.x == 0) (void)xb_add(&bar[XB_XCNT(b.x)], 1u);
    return b;
}
__device__ __forceinline__ void xcd_barrier_complete(unsigned* bar, unsigned x, unsigned& nloc, unsigned& nx) {
    const unsigned G = gridDim.x * gridDim.y * gridDim.z;
    unsigned sum, cnt, mine, sp = 0u;
    for (;;) {
        sum = 0u; cnt = 0u; mine = 0u;
#pragma unroll
        for (unsigned j = 0; j < 16; ++j) { const unsigned c = xb_ld(&bar[XB_XCNT(j)]); sum += c; cnt += (c > 0u) ? 1u : 0u; mine = (j == x) ? c : mine; }
        if (sum == G) break;
        __builtin_amdgcn_s_sleep(1);
        if ((++sp & 255u) == 0u) { if (xb_ld(&bar[XB_TMO])) break; if (sp > XB_SPIN_CAP) { atomicAdd(&bar[XB_TMO], 1u); break; } }
    }
    nloc = mine > 0u ? mine : 1u; nx = cnt > 0u ? cnt : 1u;
}

__device__ __forceinline__ void xcd_barrier(const XcdBarrier& b, const bool t0  ) {
    asm volatile("s_waitcnt vmcnt(0)" ::: "memory");
    __syncthreads();
    if (t0) {
        unsigned* bar = b.bar;
        __builtin_amdgcn_s_waitcnt(0);
        unsigned nloc = b.st[0], nx = b.st[1];
        if (nloc == 0u) { xcd_barrier_complete(bar, b.x, nloc, nx); b.st[0] = nloc; b.st[1] = nx; }
        const unsigned old = xb_add(&bar[XB_XSUB(b.x)], 1u);
        const unsigned gen = old / nloc;
        if (old + 1u == (gen + 1u) * nloc) {
            __builtin_amdgcn_fence(__ATOMIC_RELEASE, "agent");
            asm volatile("s_waitcnt vmcnt(0)" ::: "memory");
            const unsigned og = xb_add(&bar[XB_TOP], 1u);
            const unsigned tg = og / nx;
            if (og + 1u == (tg + 1u) * nx) xb_add(&bar[XB_TOPGEN], 1u);
            else XB_SPIN(xb_ld(&bar[XB_TOPGEN]) == tg, bar);
            __builtin_amdgcn_fence(__ATOMIC_ACQUIRE, "agent");
            xb_add(&bar[XB_XGEN(b.x)], 1u);
            asm volatile("s_waitcnt vmcnt(0)" ::: "memory");
        } else {
            XB_SPIN(xb_ld(&bar[XB_XGEN(b.x)]) == gen, bar);
            __builtin_amdgcn_fence(__ATOMIC_ACQUIRE, "agent");
            asm volatile("s_waitcnt vmcnt(0)" ::: "memory");
        }
    }
    __syncthreads();
}

constexpr float Y8_SCALE = 16.f, Y8_INV = 1.f / 16.f;
constexpr float X8_SCALE = 16.f, GU8_SCALE = 256.f, G1_INV = 1.f / (X8_SCALE * GU8_SCALE), ACT8_SCALE = 8.f, DN8_SCALE = 128.f, G2_INV = 1.f / (ACT8_SCALE * DN8_SCALE);
struct Params { const float* in[31]; float* out; unsigned char* ws; int ph_lo, ph_hi; };
enum { I_X = 0, I_C, I_CTX, I_CCTX, I_WMOD, I_BMOD, I_NORMG, I_WINAB, I_CONVABW, I_CONVABB, I_GATEB, I_DLAM, I_HGA, I_HGB, I_WOUTAB, I_WINHY, I_CONVHYW, I_CONVHYB,
       I_FW1, I_FB1, I_FW2, I_FB2, I_FW3, I_FBIAS, I_WOUTHY, I_RW, I_RB, I_EGU, I_EDN, I_SGU, I_SDN };

__device__ __forceinline__ void row_ld_f32(const float* row, int lane, f32x4 (&v)[4]) { const f32x4* r = (const f32x4*)row + lane;
#pragma unroll
    for (int j = 0; j < 4; ++j) v[j] = r[64 * j]; }
__device__ __forceinline__ void row_st_f32(float* row, int lane, const f32x4 (&v)[4]) { f32x4* r = (f32x4*)row + lane;
#pragma unroll
    for (int j = 0; j < 4; ++j) r[64 * j] = v[j]; }
__device__ __forceinline__ void row_ld_bf16(const bf16* row, int lane, f32x4 (&v)[4]) { const v2u* r = (const v2u*)row + lane;
#pragma unroll
    for (int j = 0; j < 4; ++j) { const v2u w = r[64 * j]; v[j] = (f32x4){bf_lo(w.x), bf_hi(w.x), bf_lo(w.y), bf_hi(w.y)}; } }
__device__ __forceinline__ void row_st_bf16(bf16* row, int lane, const f32x4 (&v)[4]) { v2u* r = (v2u*)row + lane;
#pragma unroll
    for (int j = 0; j < 4; ++j) { v2u w; w.x = pk2(v[j].x, v[j].y); w.y = pk2(v[j].z, v[j].w); r[64 * j] = w; } }
__device__ __forceinline__ unsigned fp8x4(float a, float b, float c, float d, float sc) {
    a = __builtin_amdgcn_fmed3f(a * sc, -440.f, 440.f); b = __builtin_amdgcn_fmed3f(b * sc, -440.f, 440.f); c = __builtin_amdgcn_fmed3f(c * sc, -440.f, 440.f); d = __builtin_amdgcn_fmed3f(d * sc, -440.f, 440.f);
    int w = 0; w = __builtin_amdgcn_cvt_pk_fp8_f32(a, b, w, false); w = __builtin_amdgcn_cvt_pk_fp8_f32(c, d, w, true); return (unsigned)w; }
__device__ __forceinline__ void row_st_fp8(unsigned char* row, int lane, const f32x4 (&v)[4], float sc) { unsigned* r = (unsigned*)row + lane;
#pragma unroll
    for (int j = 0; j < 4; ++j) r[64 * j] = fp8x4(v[j].x, v[j].y, v[j].z, v[j].w, sc); }
__device__ __forceinline__ float row_ss(const f32x4 (&v)[4]) { float s = 0.f;
#pragma unroll
    for (int j = 0; j < 4; ++j) s += (v[j].x * v[j].x + v[j].y * v[j].y) + (v[j].z * v[j].z + v[j].w * v[j].w);
    return wave_sum(s); }
__device__ __forceinline__ void row_modulate(const f32x4 (&x)[4], float rstd, const float* g, const float* shift, const float* scale, int lane, f32x4 (&h)[4]) {
    const f32x4* gp = (const f32x4*)g + lane; const f32x4* sh = (const f32x4*)shift + lane; const f32x4* sc = (const f32x4*)scale + lane;
#pragma unroll
    for (int j = 0; j < 4; ++j) { const f32x4 gg = gp[64 * j], s1 = sc[64 * j], s0 = sh[64 * j]; h[j] = x[j] * rstd * gg * (1.f + s1) + s0; } }

__device__ __forceinline__ void pro_mod(const Params& p, LAS unsigned char* lds, int tid, int lane, int wave) {
    const int u = blockIdx.x; if (u >= 192) return;
    LAS float* S = (LAS float*)lds;
    const float* c = p.in[I_C]; const float* cc = p.in[I_CCTX];
#pragma unroll 4
    for (int i = tid; i < 33 * 256; i += NTHR) { const int b = i >> 8, k4 = (i & 255) * 4; const f32x4 v = b < 32 ? *(const f32x4*)(c + b * 1024 + k4) : *(const f32x4*)(cc + k4);
        *(LAS f32x4*)(S + b * 1024 + k4) = (f32x4){siluf_(v[0]), siluf_(v[1]), siluf_(v[2]), siluf_(v[3])}; }
    __syncthreads();
    const int l = u / 96, cg = (u % 96) * 64, col = cg + lane;
    const float* W = p.in[I_WMOD] + (size_t)l * 1024 * NMOD;
    float acc[33];
#pragma unroll
    for (int b = 0; b < 33; ++b) acc[b] = 0.f;
    const int k0 = wave * 128;
#pragma unroll 4
    for (int kk = 0; kk < 128; kk += 4) { const int k = k0 + kk;
        const float w0 = W[(size_t)k * NMOD + col], w1 = W[(size_t)(k + 1) * NMOD + col], w2 = W[(size_t)(k + 2) * NMOD + col], w3 = W[(size_t)(k + 3) * NMOD + col];
#pragma unroll
        for (int b = 0; b < 33; ++b) { const f32x4 s = *(const LAS f32x4*)(S + b * 1024 + k); acc[b] += (s.x * w0 + s.y * w1) + (s.z * w2 + s.w * w3); } }
    __syncthreads();
    LAS float* P = (LAS float*)lds;
#pragma unroll
    for (int b = 0; b < 33; ++b) P[(wave * 33 + b) * 64 + lane] = acc[b];
    __syncthreads();
    float* MOD = (float*)(p.ws + WS_MOD);
#pragma unroll 1
    for (int i = tid; i < 33 * 64; i += NTHR) { const int b = i >> 6, ln = i & 63; float s = 0.f;
#pragma unroll
        for (int w = 0; w < 8; ++w) s += P[(w * 33 + b) * 64 + ln];
        MOD[(size_t)(l * 33 + b) * NMOD + cg + ln] = s + p.in[I_BMOD][l * NMOD + cg + ln]; }
    __syncthreads();
}
__device__ __forceinline__ int rowmap(int kind, int n) {
    if (kind == 1) { const int o = n & 31; return (n & ~31) + (((o & 15) >> 2) * 8 + (o >> 4) * 4 + (o & 3)); }
    if (kind == 2) { return n < 256 ? ((n >> 7) * 256 + (n & 127)) : ((((n - 256) >> 7) * 256) + 128 + ((n - 256) & 127)); }
    if (kind == 3) { const int a = n & 255; return (n & ~255) + 128 * ((a >> 3) & 1) + 32 * (a >> 6) + 8 * ((a >> 4) & 3) + (a & 7); }
    return n;
}
struct TrDesc { const float* W; bf16* WT; int ldn, k0, n0, nvalid, dK, kind, row_base; };
__device__ __forceinline__ TrDesc tr_decode(const Params& p, int it) {
    constexpr int I_A = 16 * 113, I_B = 512, I_C2 = 1536, I_D = 512, I_E = 64, I_F = 130 * 256;
    unsigned char* ws = p.ws; int r = it;
    if (r < I_A) { const int kb = r / 113, nb = r % 113, n0 = nb * 32; const int kind = (n0 < 512 || (n0 >= 1536 && n0 < 2048)) ? 1 : 0;
        return TrDesc{p.in[I_WINAB], (bf16*)(ws + WS_WIN0), 3600, kb * 64, n0, 3600, 1024, kind, 0}; } r -= I_A;
    if (r < I_B) return TrDesc{p.in[I_WOUTAB], (bf16*)(ws + WS_WOUT0), 1024, (r / 32) * 64, (r % 32) * 32, 1024, 1024, 0, 0}; r -= I_B;
    if (r < I_C2) return TrDesc{p.in[I_WINHY], (bf16*)(ws + WS_WIN1), 3072, (r / 96) * 64, (r % 96) * 32, 3072, 1024, 0, 0}; r -= I_C2;
    if (r < I_D) return TrDesc{p.in[I_WOUTHY], (bf16*)(ws + WS_WOUT1), 1024, (r / 32) * 64, (r % 32) * 32, 1024, 1024, 0, 0}; r -= I_D;
    if (r < I_E) { const int l = r / 32, q = r % 32; return TrDesc{p.in[I_RW] + (size_t)l * 1024 * 64, (bf16*)(ws + WS_WR) + (size_t)l * 256 * 1024, 64, (q / 2) * 64, (q % 2) * 32, 64, 1024, 0, 0}; } r -= I_E;
    if (r < I_F) { const int mat = r / 256, q = r % 256, l = mat / 65, e = mat % 65;
        const float* src = e < 64 ? p.in[I_EGU] + (size_t)(l * 64 + e) * 1024 * 512 : p.in[I_SGU] + (size_t)l * 1024 * 512;
        return TrDesc{src, (bf16*)(ws + WS_GU + (size_t)l * (65 * 512) * 1024), 512, (q / 16) * 64, (q % 16) * 32, 512, 1024, 2, e * 512}; } r -= I_F;
    { const int mat = r / 128, q = r % 128, l = mat / 65, e = mat % 65;
        const float* src = e < 64 ? p.in[I_EDN] + (size_t)(l * 64 + e) * 256 * 1024 : p.in[I_SDN] + (size_t)l * 256 * 1024;
        return TrDesc{src, (bf16*)(ws + WS_DN + (size_t)l * (65 * 1024) * 256), 1024, (q / 32) * 64, (q % 32) * 32, 1024, 256, 3, e * 1024}; }
}
__device__ __forceinline__ void tr_load(const TrDesc& d, int lane, float (&v)[32]) {
    const int nn = d.n0 + (lane & 31); const bool ok = nn < d.nvalid; const float* src = d.W + (size_t)(d.k0 + (lane >> 5)) * d.ldn + (ok ? nn : 0);
#pragma unroll
    for (int i = 0; i < 32; ++i) v[i] = src[(size_t)(2 * i) * d.ldn];
    if (!ok) {
#pragma unroll
        for (int i = 0; i < 32; ++i) v[i] = 0.f; }
}
__device__ __forceinline__ void tr_finish(const TrDesc& d, const float (&v)[32], LAS float* scr, int lane) {
#pragma unroll
    for (int i = 0; i < 32; ++i) scr[(2 * i + (lane >> 5)) * 33 + (lane & 31)] = v[i];
    LDS_WAIT(); asm volatile("" ::: "memory");
    const int c = lane & 7;
#pragma unroll
    for (int j = 0; j < 4; ++j) { const int n = (lane >> 3) + 8 * j; const LAS float* s = scr + (8 * c) * 33 + n;
        const int row = d.row_base + rowmap(d.kind, d.n0 + n);
        if (d.kind >= 2) { const float ws_ = d.kind == 2 ? GU8_SCALE : DN8_SCALE; v2u o; o.x = fp8x4(s[0 * 33], s[1 * 33], s[2 * 33], s[3 * 33], ws_); o.y = fp8x4(s[4 * 33], s[5 * 33], s[6 * 33], s[7 * 33], ws_);
            *(v2u*)((unsigned char*)d.WT + (size_t)row * d.dK + d.k0 + 8 * c) = o; }
        else { v4u o; o.x = pk2(s[0 * 33], s[1 * 33]); o.y = pk2(s[2 * 33], s[3 * 33]); o.z = pk2(s[4 * 33], s[5 * 33]); o.w = pk2(s[6 * 33], s[7 * 33]);
            *(v4u*)(d.WT + (size_t)row * d.dK + d.k0 + 8 * c) = o; } }
    LDS_WAIT(); asm volatile("" ::: "memory");
}
__device__ __forceinline__ void pro_transposes(const Params& p, LAS unsigned char* lds, int lane, int wave) {
    LAS float* scr = (LAS float*)(lds + wave * 16384);
    const int gw = blockIdx.x * NWAVES + wave, NGW = gridDim.x * NWAVES;
    constexpr int NITEMS = 16 * 113 + 512 + 1536 + 512 + 64 + 130 * 256 + 130 * 128;
    if (gw >= NITEMS) return;
    TrDesc dc = tr_decode(p, gw); float vc[32]; tr_load(dc, lane, vc);
#pragma unroll 1
    for (int it = gw; it < NITEMS; it += NGW) {
        const bool more = it + NGW < NITEMS; TrDesc dn = dc; float vn[32];
        if (more) { dn = tr_decode(p, it + NGW); tr_load(dn, lane, vn); }
        tr_finish(dc, vc, scr, lane);
        if (more) { dc = dn;
#pragma unroll
            for (int i = 0; i < 32; ++i) vc[i] = vn[i]; }
    }
}
__device__ __forceinline__ void pro_rope(const Params& p, int tid) {
    if (blockIdx.x != 255) return;
    float* R = (float*)(p.ws + WS_ROPE);
    for (int i = tid; i < 64 * 16; i += NTHR) { const int pos = i >> 4, f = i & 15; const float inv = exp2f(-(float)f * (13.287712379549449f / 16.f)); const float ang = (float)pos * inv;
        float sn, cs; sincosf(ang, &sn, &cs); R[2 * i] = cs; R[2 * i + 1] = sn; }
}
__device__ __forceinline__ void pro_filters(const Params& p, LAS unsigned char* lds, int tid, int lane, int wave) {
    LAS float* Z = (LAS float*)lds;
    LAS float* H1 = Z + 512;
    LAS float* H2 = H1 + 512;
    const int j0 = 8 * blockIdx.x, j = j0 + wave;
    const float* fw1 = p.in[I_FW1]; const float* fb1 = p.in[I_FB1]; const float* fw2 = p.in[I_FW2]; const float* fb2 = p.in[I_FB2]; const float* fw3 = p.in[I_FW3];
    {   float z = 0.f;
        if (lane == 0) z = (float)j / 2047.f;
        else if (lane < 33) { const int k = (lane - 1) & 15; const float fr = 1e-4f + (float)k * ((15.f - 1e-4f) / 15.f); const float ang = (6.283185307179586f / 2048.f) * (float)j * fr;
            float sn, cs; sincosf(ang, &sn, &cs); z = lane < 17 ? cs : -sn; }
        Z[wave * 64 + lane] = z; }
    LDS_WAIT(); asm volatile("" ::: "memory");
    {   float a = fb1[lane];
#pragma unroll 11
        for (int k = 0; k < 33; ++k) a += Z[wave * 64 + k] * fw1[k * 64 + lane];
        H1[wave * 64 + lane] = sinf(a); }
    LDS_WAIT(); asm volatile("" ::: "memory");
    {   float a = fb2[lane];
#pragma unroll 16
        for (int k = 0; k < 64; ++k) a += H1[wave * 64 + k] * fw2[k * 64 + lane];
        H2[wave * 64 + lane] = sinf(a); }
    __syncthreads();
    bf16* F = (bf16*)(p.ws + WS_FILT);
    const float mind = -4.605170185988091f / 1.5f, maxd = -4.605170185988091f / 0.3f;
#pragma unroll 1
    for (int i = 0; i < 4; ++i) { const int n = tid + NTHR * i, c = n & 1023;
        float acc[8];
#pragma unroll
        for (int q = 0; q < 8; ++q) acc[q] = 0.f;
#pragma unroll 16
        for (int k = 0; k < 64; ++k) { const float w = fw3[k * 2048 + n];
#pragma unroll
            for (int q = 0; q < 8; ++q) acc[q] += H2[q * 64 + k] * w; }
        const float delta = fabsf(mind + (float)c * ((maxd - mind) / 1023.f));
        float o[8];
#pragma unroll
        for (int q = 0; q < 8; ++q) { const float dist = fabsf((float)(j0 + q) - 1024.f) * (1.f / 1024.f); o[q] = acc[q] * expf(-dist * delta); }
        v4u w; w.x = pk2(o[0], o[1]); w.y = pk2(o[2], o[3]); w.z = pk2(o[4], o[5]); w.w = pk2(o[6], o[7]);
        *(v4u*)(F + (size_t)n * 2048 + j0) = w; }
    __syncthreads();
}

__device__ __forceinline__ void l0_norm_rows(const float* src, bf16* dst, int nrows, const float* g, const float* md, int lane) {
    f32x4 vb[4], vc[4];
#pragma unroll
    for (int j = 0; j < 4; ++j) { const int o = 4 * lane + 256 * j; vb[j] = *(const f32x4*)(g + o) * (1.f + *(const f32x4*)(md + D + o)); vc[j] = *(const f32x4*)(md + o); }
    f32x4 xn[4]; row_ld_f32(src, lane, xn);
#pragma unroll 1
    for (int i = 0; i < nrows; ++i) { f32x4 x[4], h[4];
#pragma unroll
        for (int j = 0; j < 4; ++j) x[j] = xn[j];
        if (i + 1 < nrows) row_ld_f32(src + (size_t)(i + 1) * D, lane, xn);
        const float rstd = rsqrtf(row_ss(x) * (1.f / D) + RMS_EPS);
#pragma unroll
        for (int j = 0; j < 4; ++j) h[j] = x[j] * rstd * vb[j] + vc[j];
        row_st_bf16(dst + (size_t)i * D, lane, h); }
}
__device__ __forceinline__ void ph_l0_norm(const Params& p, int lane, int wave) {
    const int gw = blockIdx.x * NWAVES + wave;
    const float* MOD = (const float*)(p.ws + WS_MOD); bf16* H = (bf16*)(p.ws + WS_BIG + A0_H);
    const float* g = p.in[I_NORMG];
    { const int m0 = gw * 32; l0_norm_rows(p.in[I_X] + (size_t)m0 * D, H + (size_t)m0 * D, 32, g, MOD + (size_t)(m0 >> 11) * NMOD, lane); }
    { const int m0 = gw * 4; l0_norm_rows(p.in[I_CTX] + (size_t)m0 * D, H + (size_t)(T + m0) * D, 4, g, MOD + (size_t)32 * NMOD, lane); }
}
__device__ __forceinline__ void ph_mid(const Params& p, int l, const bf16* MIX, bf16* H2, unsigned char* X8, bool has_mix, int lane, int wave, int tile) {
    const int gw = tile * NWAVES + wave;
    const float* MOD = (const float*)(p.ws + WS_MOD) + (size_t)l * 33 * NMOD;
    const float* g1 = p.in[I_NORMG] + (size_t)(l * 4 + 1) * D; const float* g2 = p.in[I_NORMG] + (size_t)(l * 4 + 2) * D;
    const float* xin = p.in[I_X]; bf16* XR = (bf16*)p.out;
    const int m0 = gw * 32; const float* md = MOD + (size_t)(m0 >> 11) * NMOD;
    f32x4 va[4], vb[4], vc[4];
#pragma unroll
    for (int j = 0; j < 4; ++j) { const int o = 4 * lane + 256 * j; va[j] = *(const f32x4*)(md + 2 * D + o) * *(const f32x4*)(g1 + o); vb[j] = *(const f32x4*)(g2 + o) * (1.f + *(const f32x4*)(md + 4 * D + o)); vc[j] = *(const f32x4*)(md + 3 * D + o); }
    f32x4 xn[4], mn[4];
    if (l == 0) row_ld_f32(xin + (size_t)m0 * D, lane, xn); else row_ld_bf16(XR + (size_t)m0 * (2 * D), lane, xn);
    if (has_mix) row_ld_bf16(MIX + (size_t)m0 * D, lane, mn);
#pragma unroll 1
    for (int m = m0; m < m0 + 32; ++m) {
        f32x4 x[4], h[4], mx[4];
#pragma unroll
        for (int j = 0; j < 4; ++j) { x[j] = xn[j]; mx[j] = mn[j]; }
        if (m + 1 < m0 + 32) { if (l == 0) row_ld_f32(xin + (size_t)(m + 1) * D, lane, xn); else row_ld_bf16(XR + (size_t)(m + 1) * (2 * D), lane, xn);
                               if (has_mix) row_ld_bf16(MIX + (size_t)(m + 1) * D, lane, mn); }
        if (has_mix) { const float r = rsqrtf(row_ss(mx) * (1.f / D) + RMS_EPS);
#pragma unroll
            for (int j = 0; j < 4; ++j) x[j] = x[j] + va[j] * (mx[j] * r); }
        row_st_bf16(XR + (size_t)m * (2 * D), lane, x);
        const float rstd = rsqrtf(row_ss(x) * (1.f / D) + RMS_EPS);
#pragma unroll
        for (int j = 0; j < 4; ++j) h[j] = x[j] * rstd * vb[j] + vc[j];
        row_st_bf16(H2 + (size_t)m * D, lane, h);
        row_st_fp8(X8 + (size_t)m * D, lane, h, X8_SCALE);
    }
}
__device__ __forceinline__ void ph_combine(const Params& p, int l, int ch, const unsigned char* Y8, bf16* Hn, int lane, int wave) {
    const int gw = blockIdx.x * NWAVES + wave;
    const float* MOD = (const float*)(p.ws + WS_MOD) + (size_t)l * 33 * NMOD;
    const float* g3 = p.in[I_NORMG] + (size_t)(l * 4 + 3) * D;
    const int* PSLOT = (const int*)(p.ws + WS_PSLOT); const float* WTS = (const float*)(p.ws + WS_WTS);
    constexpr int RPW = CHT / 2048;
    const int mbase = ch * CHT + gw * RPW; const float* md = MOD + (size_t)(mbase >> 11) * NMOD;
    float va[16], vb[16], vc[16];
    { const float* md1 = MOD + (size_t)(33 + (mbase >> 11)) * NMOD; const float* g10 = p.in[I_NORMG] + (size_t)4 * D;
#pragma unroll
      for (int q = 0; q < 4; ++q) { const int o = lane * 16 + 4 * q; const f32x4 gp = *(const f32x4*)(g3 + o), gf = *(const f32x4*)(md + 5 * D + o); f32x4 gg = gp, sh = gp, sc = gp;
          if (l == 0) { gg = *(const f32x4*)(g10 + o); sh = *(const f32x4*)(md1 + o); sc = *(const f32x4*)(md1 + D + o); }
#pragma unroll
          for (int j = 0; j < 4; ++j) { va[4 * q + j] = gp[j] * gf[j]; vb[4 * q + j] = gg[j] * (1.f + sc[j]); vc[4 * q + j] = sh[j]; } } }
    int sl[9]; float wk[9];
#define CMB_SLOTS(mt) do { _Pragma("unroll") for (int k = 0; k < 9; ++k) { sl[k] = PSLOT[(size_t)(mt) * 16 + k]; wk[k] = k < 8 ? WTS[(size_t)(mt) * 8 + k] : 1.f; } } while (0)
    CMB_SLOTS(mbase);
#pragma unroll 1
    for (int m = mbase; m < mbase + RPW; ++m) {
        float a[16];
#pragma unroll
        for (int j = 0; j < 16; ++j) a[j] = 0.f;
        u32x4 yr[9]; float wc[9];
#pragma unroll
        for (int k = 0; k < 9; ++k) { yr[k] = *(const u32x4*)(Y8 + (size_t)sl[k] * 1024 + lane * 16); wc[k] = wk[k]; }
        float* orow = p.out + (size_t)m * D + lane * 16; bf16* xrow = (bf16*)p.out + (size_t)m * (2 * D) + lane * 16; f32x4 xv4[4];
        { const v4u x0 = *(const v4u*)xrow, x1 = *(const v4u*)(xrow + 8);
          xv4[0] = (f32x4){bf_lo(x0.x), bf_hi(x0.x), bf_lo(x0.y), bf_hi(x0.y)}; xv4[1] = (f32x4){bf_lo(x0.z), bf_hi(x0.z), bf_lo(x0.w), bf_hi(x0.w)};
          xv4[2] = (f32x4){bf_lo(x1.x), bf_hi(x1.x), bf_lo(x1.y), bf_hi(x1.y)}; xv4[3] = (f32x4){bf_lo(x1.z), bf_hi(x1.z), bf_lo(x1.w), bf_hi(x1.w)}; }
        if (m + 1 < mbase + RPW) CMB_SLOTS(m + 1);
#pragma unroll
        for (int k = 0; k < 9; ++k) { const float w = wc[k] * Y8_INV; const unsigned ww[4] = {yr[k].x, yr[k].y, yr[k].z, yr[k].w};
#pragma unroll
            for (int q = 0; q < 4; ++q) { a[4 * q + 0] += w * __builtin_amdgcn_cvt_f32_fp8((int)ww[q], 0); a[4 * q + 1] += w * __builtin_amdgcn_cvt_f32_fp8((int)ww[q], 1);
                                          a[4 * q + 2] += w * __builtin_amdgcn_cvt_f32_fp8((int)ww[q], 2); a[4 * q + 3] += w * __builtin_amdgcn_cvt_f32_fp8((int)ww[q], 3); } }
        float ss = 0.f;
#pragma unroll
        for (int j = 0; j < 16; ++j) ss += a[j] * a[j];
        const float r = rsqrtf(wave_sum(ss) * (1.f / D) + RMS_EPS);
        float x[16]; float s2 = 0.f;
#pragma unroll
        for (int q = 0; q < 4; ++q) {
#pragma unroll
            for (int j = 0; j < 4; ++j) { const float v = xv4[q][j] + va[4 * q + j] * (a[4 * q + j] * r); x[4 * q + j] = v; s2 += v * v; }
            if (l == 1) *(f32x4*)(orow + 4 * q) = (f32x4){x[4 * q], x[4 * q + 1], x[4 * q + 2], x[4 * q + 3]}; }
        if (l == 0) { v4u w0, w1; w0.x = pk2(x[0], x[1]); w0.y = pk2(x[2], x[3]); w0.z = pk2(x[4], x[5]); w0.w = pk2(x[6], x[7]); w1.x = pk2(x[8], x[9]); w1.y = pk2(x[10], x[11]); w1.z = pk2(x[12], x[13]); w1.w = pk2(x[14], x[15]);
            *(v4u*)xrow = w0; *(v4u*)(xrow + 8) = w1; }
        if (l == 0) { const float rstd = rsqrtf(wave_sum(s2) * (1.f / D) + RMS_EPS); float h[16];
#pragma unroll
            for (int j = 0; j < 16; ++j) h[j] = x[j] * rstd * vb[j] + vc[j];
            v4u w0, w1; w0.x = pk2(h[0], h[1]); w0.y = pk2(h[2], h[3]); w0.z = pk2(h[4], h[5]); w0.w = pk2(h[6], h[7]); w1.x = pk2(h[8], h[9]); w1.y = pk2(h[10], h[11]); w1.z = pk2(h[12], h[13]); w1.w = pk2(h[14], h[15]);
            *(v4u*)(Hn + (size_t)m * D + lane * 16) = w0; *(v4u*)(Hn + (size_t)m * D + lane * 16 + 8) = w1; }
    }
#undef CMB_SLOTS
}

struct DenseSched { int NN, NU, G, c, NMs;
    __device__ __forceinline__ bool next(int i, Unit& u) const { const int L = i * G + c; if (L >= NU) return false; if (NMs > 0) { u.pm = L % NMs; u.pn = L / NMs; } else { u.pm = L / NN; u.pn = L % NN; } return true; }
    __device__ __forceinline__ int arow(int r) const { return r; }
    __device__ __forceinline__ void* probe_ts() const { return nullptr; } };
struct PanelSched { int NN, pm;
    __device__ __forceinline__ bool next(int i, Unit& u) const { if (i >= NN) return false; u.pm = pm; u.pn = i; return true; }
    __device__ __forceinline__ int arow(int r) const { return r; }
    __device__ __forceinline__ void* probe_ts() const { return nullptr; } };
struct EpiBf16 { static constexpr bool PERM = true, AFTER_DRAIN = false, PROBE = false; bf16* O; size_t ldc; int cmask;
    __device__ __forceinline__ void operator()(const f32x4 (&acc)[2][2][4][2], const Unit& u, int wr, int wc, int fr, int fq) const {
        const int row0 = u.pm * BM + wr * 64 + fr, col0 = (u.pn & cmask) * BM + wc * 32 + 8 * fq;
#pragma unroll
        for (int ai = 0; ai < 2; ++ai)
#pragma unroll
            for (int m = 0; m < 4; ++m) { bf16* rowp = O + (size_t)(row0 + ai * HALF + m * 16) * ldc + col0;
#pragma unroll
                for (int bj = 0; bj < 2; ++bj) { const f32x4 v0 = acc[ai][bj][m][0], v1 = acc[ai][bj][m][1];
                    u32x4 w; w.x = cvt_pk_bf16(v0[0], v0[1]); w.y = cvt_pk_bf16(v0[2], v0[3]); w.z = cvt_pk_bf16(v1[0], v1[1]); w.w = cvt_pk_bf16(v1[2], v1[3]);
                    *(u32x4*)(rowp + bj * HALF) = w; } }
    } };
struct EpiRouter { static constexpr bool PERM = false, AFTER_DRAIN = false, PROBE = false; float* LOG;
    __device__ __forceinline__ void operator()(const f32x4 (&acc)[2][2][4][2], const Unit& u, int wr, int wc, int fr, int fq) const {
        if (wc >= 2) return;
        const int row0 = u.pm * BM + wr * 64 + fr, col0 = wc * 32 + 4 * fq;
#pragma unroll
        for (int ai = 0; ai < 2; ++ai)
#pragma unroll
            for (int m = 0; m < 4; ++m) { float* rowp = LOG + (size_t)(row0 + ai * HALF + m * 16) * 64 + col0;
#pragma unroll
                for (int n = 0; n < 2; ++n) *(f32x4*)(rowp + n * 16) = acc[ai][0][m][n]; }
    } };
struct EpiFp8 { static constexpr bool PERM = true, AFTER_DRAIN = false, PROBE = true; unsigned char* O;
    __device__ __forceinline__ void operator()(const f32x4 (&acc)[2][2][4][2], const Unit& u, int wr, int wc, int fr, int fq) const {
        const int row0 = u.pm * BM + wr * 64 + fr, col0 = (u.pn & 3) * BM + wc * 64 + 16 * fq;
#pragma unroll
        for (int ai = 0; ai < 2; ++ai)
#pragma unroll
            for (int m = 0; m < 4; ++m) { unsigned char* rowp = O + (size_t)(row0 + ai * HALF + m * 16) * 1024 + col0; u32x4 w;
#pragma unroll
                for (int bj = 0; bj < 2; ++bj) { f32x4 v0 = acc[ai][bj][m][0] * (Y8_SCALE * G2_INV), v1 = acc[ai][bj][m][1] * (Y8_SCALE * G2_INV); int lo = 0, hi = 0;
#pragma unroll
                    for (int j = 0; j < 4; ++j) { v0[j] = __builtin_amdgcn_fmed3f(v0[j], -440.f, 440.f); v1[j] = __builtin_amdgcn_fmed3f(v1[j], -440.f, 440.f); }
                    lo = __builtin_amdgcn_cvt_pk_fp8_f32(v0[0], v0[1], lo, false); lo = __builtin_amdgcn_cvt_pk_fp8_f32(v0[2], v0[3], lo, true);
                    hi = __builtin_amdgcn_cvt_pk_fp8_f32(v1[0], v1[1], hi, false); hi = __builtin_amdgcn_cvt_pk_fp8_f32(v1[2], v1[3], hi, true);
                    if (bj == 0) { w.x = (unsigned)lo; w.y = (unsigned)hi; } else { w.z = (unsigned)lo; w.w = (unsigned)hi; } }
                *(u32x4*)rowp = w; }
    } };
struct EpiRouterLds { static constexpr bool PERM = false, AFTER_DRAIN = true, PROBE = false;
    __device__ __forceinline__ void operator()(const f32x4 (&)[2][2][4][2], const Unit&, int, int, int, int) const {}
    __device__ __forceinline__ void fused(const f32x4 (&acc)[2][2][4][2], const Unit&, int wr, int wc, int fr, int fq, LAS unsigned char* lds) const {
        if (wc >= 2) return;
        LAS float* SC = (LAS float*)lds;
#pragma unroll
        for (int ai = 0; ai < 2; ++ai)
#pragma unroll
            for (int m = 0; m < 4; ++m) { const int row = ai * HALF + wr * 64 + m * 16 + fr;
#pragma unroll
                for (int n = 0; n < 2; ++n)
#pragma unroll
                    for (int j = 0; j < 4; ++j) SC[row * 65 + wc * 32 + n * 16 + 4 * fq + j] = sigmoidf_(acc[ai][0][m][n][j]); }
    } };
struct MoeSched { const LAS int* te; const int* sort; int NU, G, c, sh, per;
    __device__ __forceinline__ bool next(int i, Unit& u) const { const int L = i * G + c; if (L >= NU) return false; const int tile = L >> sh; u.pm = tile; u.pn = te[tile] * per + (L & (per - 1)); return true; }
    __device__ __forceinline__ int arow(int r) const { return sort ? sort[r] : r; }
    void* pts; __device__ __forceinline__ void* probe_ts() const { return pts; } };
struct EpiSwiglu { static constexpr bool PERM = true, AFTER_DRAIN = false, PROBE = false; unsigned char* ACT;
    __device__ __forceinline__ void operator()(const f32x4 (&acc)[2][2][4][2], const Unit& u, int wr, int wc, int fr, int fq) const {
        const int row0 = u.pm * BM + wr * 64 + fr, col0 = (u.pn & 1) * 128 + wc * 32 + 8 * fq;
#pragma unroll
        for (int ai = 0; ai < 2; ++ai)
#pragma unroll
            for (int m = 0; m < 4; ++m) { unsigned char* rowp = ACT + (size_t)(row0 + ai * HALF + m * 16) * DE + col0;
                const f32x4 g0 = acc[ai][0][m][0], g1 = acc[ai][0][m][1], u0 = acc[ai][1][m][0], u1 = acc[ai][1][m][1];
                float o[8];
#pragma unroll
                for (int q = 0; q < 4; ++q) { o[q] = siluf_(g0[q] * G1_INV) * (u0[q] * G1_INV); o[4 + q] = siluf_(g1[q] * G1_INV) * (u1[q] * G1_INV); }
                u32x2 w; w.x = fp8x4(o[0], o[1], o[2], o[3], ACT8_SCALE); w.y = fp8x4(o[4], o[5], o[6], o[7], ACT8_SCALE);
                *(u32x2*)rowp = w; }
    } };
__device__ __forceinline__ int moe_tables(const Params& p, int ch, LAS unsigned char* lds, int tid) {
    LAS int* TE = (LAS int*)(lds + LDS_TAB);
    const int* TEG = (const int*)(p.ws + WS_TEG) + (size_t)ch * (MAXTILES + 64);
    __syncthreads();
#pragma unroll 1
    for (int i = tid; i <= MAXTILES; i += NTHR) TE[i] = TEG[i];
    __syncthreads();
    return TE[MAXTILES];
}

__device__ __forceinline__ void ph_route_a(const Params& p, int l, const float* LOG, int tile, LAS unsigned char* lds, int tid) {
    LAS float* SC = (LAS float*)lds;
    LAS float* RBs = (LAS float*)(lds + 68 * 1024);
    LAS unsigned* MASK = (LAS unsigned*)(lds + 69 * 1024);
    const int b = tile, tok0 = 256 * b;
    if (LOG)
#pragma unroll 1
    for (int i = tid; i < 256 * 64; i += NTHR) { const int t = i >> 6, e = i & 63; SC[t * 65 + e] = sigmoidf_(LOG[(size_t)(tok0 + t) * 64 + e]); }
    if (tid < 64) RBs[tid] = p.in[I_RB][l * 64 + tid];
    MASK[tid] = 0u;
    __syncthreads();
    int eidx[8]; float wts[8];
    if (tid < 256) { const int t = tid; const LAS float* sc = SC + t * 65;
        float gs[8], bv[64];
#pragma unroll
        for (int g = 0; g < 8; ++g) { float m1 = -3.0e38f, m2 = -3.0e38f;
#pragma unroll
            for (int j = 0; j < 8; ++j) { const float v = sc[8 * g + j] + RBs[8 * g + j]; bv[8 * g + j] = v; if (v > m1) { m2 = m1; m1 = v; } else if (v > m2) m2 = v; }
            gs[g] = m1 + m2; }
        unsigned gmask = 0u;
#pragma unroll
        for (int r = 0; r < 4; ++r) { float best = -3.0e38f; int bi = 0; bool found = false;
#pragma unroll
            for (int g = 0; g < 8; ++g) { const bool free_ = ((gmask >> g) & 1u) == 0u; if (free_ && (!found || gs[g] > best)) { best = gs[g]; bi = g; found = true; } }
            gmask |= 1u << bi; }
#pragma unroll
        for (int e = 0; e < 64; ++e) if (((gmask >> (e >> 3)) & 1u) == 0u) bv[e] = -3.0e38f;
        unsigned long long taken = 0ull; float ssum = 0.f;
#pragma unroll
        for (int k = 0; k < 8; ++k) { float best = -3.0e38f; int be = 0; bool found = false;
#pragma unroll
            for (int e = 0; e < 64; ++e) { const bool ok = ((taken >> e) & 1ull) == 0ull; if (ok && (!found || bv[e] > best)) { best = bv[e]; be = e; found = true; } }
            taken |= 1ull << be; eidx[k] = be; wts[k] = sc[be]; ssum += wts[k]; }
        const float inv = 2.5f / ssum;
#pragma unroll
        for (int k = 0; k < 8; ++k) { wts[k] *= inv; __hip_atomic_fetch_or(&MASK[eidx[k] * 8 + (t >> 5)], 1u << (t & 31), __ATOMIC_RELAXED, __HIP_MEMORY_SCOPE_WORKGROUP); }
    }
    __syncthreads();
    if (tid < 256) { const int t = tid; int* EIDX = (int*)(p.ws + WS_EIDX); float* WTS = (float*)(p.ws + WS_WTS);
#pragma unroll
        for (int k = 0; k < 8; ++k) { const int e = eidx[k]; int r = 0;
#pragma unroll 1
            for (int w = 0; w < (t >> 5); ++w) r += __popc(MASK[e * 8 + w]);
            r += __popc(MASK[e * 8 + (t >> 5)] & ((1u << (t & 31)) - 1u));
            EIDX[(size_t)(tok0 + t) * 8 + k] = e | (r << 8); WTS[(size_t)(tok0 + t) * 8 + k] = wts[k]; } }
    if (tid < 64) { int c = 0;
#pragma unroll
        for (int w = 0; w < 8; ++w) c += __popc(MASK[tid * 8 + w]);
        ((int*)(p.ws + WS_BC))[b * 64 + tid] = c; }
    __syncthreads();
}
__device__ __forceinline__ void ph_route_b(const Params& p, LAS unsigned char* lds, int tid) {
    LAS int* BCS = (LAS int*)lds;
    LAS int* CNT = BCS + BPC * 64; LAS int* PRE = CNT + 64; LAS int* SEG = PRE + 64;
    const int b = blockIdx.x, ch = b / BPC, bl = b % BPC;
    const int* BC = (const int*)(p.ws + WS_BC) + (size_t)ch * BPC * 64;
#pragma unroll 16
    for (int i = tid; i < BPC * 64; i += NTHR) BCS[i] = BC[i];
    __syncthreads();
    if (tid < 64) { int c = 0, pr = 0;
#pragma unroll 16
        for (int i = 0; i < BPC; ++i) { const int v = BCS[i * 64 + tid]; c += v; if (i < bl) pr += v; } CNT[tid] = c; PRE[tid] = pr; }
    __syncthreads();
    if (tid == 0) { int base = 0;
#pragma unroll 1
        for (int e = 0; e < 64; ++e) { SEG[e] = base; base += ((CNT[e] + 255) >> 8) << 8; } SEG[64] = base; }
    __syncthreads();
    int* SORT = (int*)(p.ws + WS_SORT) + (size_t)ch * CHROWS; int* PSLOT = (int*)(p.ws + WS_PSLOT); const int* EIDX = (const int*)(p.ws + WS_EIDX);
    if (tid < 256) { const int tok = 256 * b + tid;
#pragma unroll
        for (int k = 0; k < 8; ++k) { const int w = EIDX[(size_t)tok * 8 + k], e = w & 255, r = w >> 8; const int slot = SEG[e] + PRE[e] + r; SORT[slot] = tok; PSLOT[(size_t)tok * 16 + k] = slot; }
        const int s8 = SEG[64] + (tok - ch * CHT); SORT[s8] = tok; PSLOT[(size_t)tok * 16 + 8] = s8; }
    if (bl == 0) {
        int* TEG = (int*)(p.ws + WS_TEG) + (size_t)ch * (MAXTILES + 64); const int NT = (SEG[64] >> 8) + CHT / 256;
#pragma unroll 1
        for (int i = tid; i < NT; i += NTHR) { int e = 0;
#pragma unroll 1
            while (e < 64 && (i << 8) >= SEG[e + 1]) ++e;
            TEG[i] = e; }
        if (tid == 0) TEG[MAXTILES] = NT; }
    if (bl < 64) { const int e = bl, lo = SEG[e] + CNT[e], hi = SEG[e] + (((CNT[e] + 255) >> 8) << 8); for (int s = lo + tid; s < hi; s += NTHR) SORT[s] = ch * CHT; }
    __syncthreads();
}

typedef float f32x16 __attribute__((ext_vector_type(16)));
__device__ __forceinline__ void ph_sconv(const Params& p, const bf16* UT, bf16* UC, int tid) {
    const float* cw = p.in[I_CONVHYW]; const float* cbias = p.in[I_CONVHYB];
    const unsigned NIT = 3072u * 32u * 256u; const unsigned gt = blockIdx.x * NTHR + tid, NG = gridDim.x * NTHR;
#pragma unroll 1
    for (unsigned it = gt; it < NIT; it += NG) {
        const unsigned c = it >> 13, k = it & 255u; const size_t base = (size_t)it * 8;
        const v4u w = *(const v4u*)(UT + base);
        const float w0 = cw[c], w1 = cw[3072 + c], w2 = cw[6144 + c], bb = cbias[c];
        float x[10];
        x[0] = k > 0 ? bf1(UT[base - 1]) : 0.f; x[9] = k < 255 ? bf1(UT[base + 8]) : 0.f;
        x[1] = bf_lo(w.x); x[2] = bf_hi(w.x); x[3] = bf_lo(w.y); x[4] = bf_hi(w.y); x[5] = bf_lo(w.z); x[6] = bf_hi(w.z); x[7] = bf_lo(w.w); x[8] = bf_hi(w.w);
        float o[8];
#pragma unroll
        for (int j = 0; j < 8; ++j) o[j] = bb + w0 * x[j] + w1 * x[j + 1] + w2 * x[j + 2];
        v4u r; r.x = pk2(o[0], o[1]); r.y = pk2(o[2], o[3]); r.z = pk2(o[4], o[5]); r.w = pk2(o[6], o[7]);
        *(v4u*)(UC + base) = r;
    }
}
constexpr int LC_CPB = 8224, LC_RAW = 8 * LC_CPB, LC_RAWSZ = 32 * 512, LC_HALO = LC_RAW + 2 * LC_RAWSZ, LC_VBP = 528, LC_VB0 = LC_HALO + 2 * 8192, LC_VBSZ = 32 * LC_VBP;
static_assert(LC_VB0 + 2 * LC_VBSZ <= LDS_MISC && 8 * 32 * 528 <= LDS_MISC, "lconv LDS map");
struct Taps { float w0, w1, w2, b; };
__device__ __forceinline__ float bfh(unsigned w, int hi) { return hi ? bf_hi(w) : bf_lo(w); }
template <bool CONVIN>
__device__ __forceinline__ void lconv_unit(const bf16* vin, const Taps ti, const bf16* F, const bf16* graw, const Taps tg, float fb, bf16* out, LAS unsigned char* lds, int tid, int lane, int wave) {
    __syncthreads();
#define LC_DMA(ch, rb) do { _Pragma("unroll") for (int q = 0; q < 2; ++q) { const int row = wave * 4 + 2 * q + (ln >> 5); \
        __builtin_amdgcn_global_load_lds((const unsigned*)(vin + (size_t)row * 2048 + (ch) * 256 + (ln & 31) * 8), (LAS unsigned*)(lds + LC_RAW + (rb) * LC_RAWSZ + (wave * 4 + 2 * q) * 512), 16, 0, 0); } \
        { const int hrow = wave * 4 + ((ln & 7) >> 1); int hs = (ln & 1) ? (ch) * 256 + 256 : (ch) * 256 - 8; hs = hs < 0 ? 0 : (hs > 2040 ? 2040 : hs); \
          __builtin_amdgcn_global_load_lds((const unsigned*)(vin + (size_t)hrow * 2048 + hs), (LAS unsigned*)(lds + LC_HALO + (rb) * 8192 + wave * 1024), 16, 0, 0); } } while (0)
    LAS bf16* Fl = (LAS bf16*)(lds + LC_VB0 + LC_VBSZ);
    { int ln = lane; asm volatile("" : "+v"(ln)); LC_DMA(0, 0); LC_DMA(1, 1); }
    if (tid < 256) *(LAS v4u*)(Fl + tid * 8) = *(const v4u*)(F + tid * 8);
    __syncthreads();
    if (tid == 0) Fl[1024] = (bf16)f2bf(bf1(Fl[1024]) + fb);
    __syncthreads();
#pragma unroll 1
    for (int a = 0; a < 8; ++a)
#pragma unroll 1
        for (int mi = tid; mi < 2056; mi += NTHR) { const int m = mi * 2; const int x0 = 3079 - m - a, x1 = x0 - 1;
            const unsigned lo = (x0 >= 0 && x0 <= 2047) ? (unsigned)Fl[x0] : 0u, hi = (x1 >= 0 && x1 <= 2047) ? (unsigned)Fl[x1] : 0u;
            *(LAS unsigned*)(lds + a * LC_CPB + m * 2) = lo | (hi << 16); }
    const int r = lane & 31, h = lane >> 5, a = (7 - r) & 7;
    const LAS unsigned char* cpA = lds + a * LC_CPB + 2 * (1023 - r + 8 * h - a + 1032) - 512 * wave;
    const int laneB = r * LC_VBP + 16 * h;
#define LC_CONVERT(ch, rb, buf) do { _Pragma("unroll") for (int q = 0; q < 2; ++q) { const int pid = ln + 64 * q, row = wave * 4 + (pid >> 5), pp = pid & 31; const LAS unsigned char* rp = lds + LC_RAW + (rb) * LC_RAWSZ + row * 512 + pp * 16; \
        const v4u w = *(const LAS v4u*)rp; v4u o = w; \
        if (CONVIN) { const LAS unsigned char* hp_ = lds + LC_HALO + (rb) * 8192 + wave * 1024 + (pid >> 5) * 32; float x[10]; \
            x[0] = pp > 0 ? bf1(*(const LAS bf16*)(rp - 2)) : ((ch) > 0 ? bf1(*(const LAS bf16*)(hp_ + 14)) : 0.f); x[9] = pp < 31 ? bf1(*(const LAS bf16*)(rp + 16)) : ((ch) < 7 ? bf1(*(const LAS bf16*)(hp_ + 16)) : 0.f); \
            x[1] = bf_lo(w.x); x[2] = bf_hi(w.x); x[3] = bf_lo(w.y); x[4] = bf_hi(w.y); x[5] = bf_lo(w.z); x[6] = bf_hi(w.z); x[7] = bf_lo(w.w); x[8] = bf_hi(w.w); \
            float y[8]; _Pragma("unroll") for (int j = 0; j < 8; ++j) y[j] = ti.b + ti.w0 * x[j] + ti.w1 * x[j + 1] + ti.w2 * x[j + 2]; \
            o.x = pk2(y[0], y[1]); o.y = pk2(y[2], y[3]); o.z = pk2(y[4], y[5]); o.w = pk2(y[6], y[7]); } \
        *(LAS v4u*)(lds + LC_VB0 + (buf) * LC_VBSZ + row * LC_VBP + pp * 16) = o; } } while (0)
    { int ln = lane; asm volatile("" : "+v"(ln));
    asm volatile("s_waitcnt vmcnt(3)" ::: "memory");
    LC_CONVERT(0, 0, 0); }
    asm volatile("s_waitcnt lgkmcnt(0)" ::: "memory"); __builtin_amdgcn_s_barrier(); asm volatile("" ::: "memory");
    f32x16 acc[8];
#pragma unroll
    for (int i = 0; i < 8; ++i)
#pragma unroll
        for (int q = 0; q < 16; ++q) acc[i][q] = 0.f;
    bf16x8 E[8], O[8];
    bool primed = false;
#pragma unroll 1
    for (int ch = 0; ch < 8; ++ch) {
        int ln = lane; asm volatile("" : "+v"(ln));
        if (ch < 6) LC_DMA(ch + 2, ch & 1);
        const int du = wave - ch;
        if (du >= -4 && du <= 4) {
            const LAS unsigned char* ca = cpA + 64 * (ch * 8); const LAS unsigned char* vbh = lds + LC_VB0 + (ch & 1) * LC_VBSZ + laneB;
            if (!primed) { primed = true;
#pragma unroll
                for (int i = 1; i < 8; ++i) { E[(8 - i) & 7] = *(const LAS bf16x8*)(ca + 32 * (-2 * i)); O[(8 - i) & 7] = *(const LAS bf16x8*)(ca + 32 * (-2 * i + 1)); }
                E[0] = *(const LAS bf16x8*)ca; O[0] = *(const LAS bf16x8*)(ca + 32); }
            bf16x8 bc0 = *(const LAS bf16x8*)vbh, bc1 = *(const LAS bf16x8*)(vbh + 32);
#pragma unroll
            for (int mm = 0; mm < 8; ++mm) {
                bf16x8 bn0 = bc0, bn1 = bc1;
                if (mm < 7) { bn0 = *(const LAS bf16x8*)(vbh + 64 * (mm + 1)); bn1 = *(const LAS bf16x8*)(vbh + 64 * (mm + 1) + 32); }
                acc[7] = __builtin_amdgcn_mfma_f32_32x32x16_bf16(E[(mm + 1) & 7], bc0, acc[7], 0, 0, 0);
                E[(mm + 1) & 7] = *(const LAS bf16x8*)(ca + 64 * (mm + 1));
#pragma unroll
                for (int i = 0; i < 7; ++i) acc[i] = __builtin_amdgcn_mfma_f32_32x32x16_bf16(E[(mm - i) & 7], bc0, acc[i], 0, 0, 0);
                acc[7] = __builtin_amdgcn_mfma_f32_32x32x16_bf16(O[(mm + 1) & 7], bc1, acc[7], 0, 0, 0);
                O[(mm + 1) & 7] = *(const LAS bf16x8*)(ca + 64 * (mm + 1) + 32);
#pragma unroll
                for (int i = 0; i < 7; ++i) acc[i] = __builtin_amdgcn_mfma_f32_32x32x16_bf16(O[(mm - i) & 7], bc1, acc[i], 0, 0, 0);
                bc0 = bn0; bc1 = bn1;
            }
        }
        if (ch < 7) { if (ch < 6) asm volatile("s_waitcnt vmcnt(3)" ::: "memory"); else asm volatile("s_waitcnt vmcnt(0)" ::: "memory"); LC_CONVERT(ch + 1, (ch + 1) & 1, (ch + 1) & 1); }
        asm volatile("s_waitcnt lgkmcnt(0)" ::: "memory"); __builtin_amdgcn_s_barrier(); asm volatile("" ::: "memory");
    }
#undef LC_DMA
#undef LC_CONVERT
    { int le = lane; asm volatile("" : "+v"(le)); const int re = le & 31, he = le >> 5;
      LAS unsigned char* tw = lds + wave * (32 * 528);
#pragma unroll
      for (int i = 0; i < 8; ++i)
#pragma unroll
          for (int g = 0; g < 4; ++g) { v2u w; w.x = pk2(acc[i][4 * g + 0], acc[i][4 * g + 1]); w.y = pk2(acc[i][4 * g + 2], acc[i][4 * g + 3]); *(LAS v2u*)(tw + re * 528 + (32 * i + 8 * g + 4 * he) * 2) = w; }
      LDS_WAIT(); asm volatile("" ::: "memory");
      const int pp = le & 31;
      v4u gwa[16]; float hal[16];
      const bool hprev = pp == 0 && wave > 0, hnext = pp == 31 && wave < 7;
#pragma unroll
      for (int it = 0; it < 16; ++it) { const size_t off = (size_t)(2 * it + (le >> 5)) * 2048 + 256 * wave + pp * 8; gwa[it] = *(const v4u*)(graw + off);
          hal[it] = (hprev || hnext) ? bf1(graw[hprev ? off - 1 : off + 8]) : 0.f; }
#pragma unroll
      for (int it = 0; it < 16; ++it) { const int row = 2 * it + (le >> 5); const size_t off = (size_t)row * 2048 + 256 * wave + pp * 8;
          const v4u gw = gwa[it]; const v4u aw = *(const LAS v4u*)(tw + row * 528 + pp * 16);
          const float hp = hal[it], hn = hal[it];
          float gx[10]; gx[1] = bf_lo(gw.x); gx[2] = bf_hi(gw.x); gx[3] = bf_lo(gw.y); gx[4] = bf_hi(gw.y); gx[5] = bf_lo(gw.z); gx[6] = bf_hi(gw.z); gx[7] = bf_lo(gw.w); gx[8] = bf_hi(gw.w);
          const float fromprev = shidx(gx[8], le - 1), fromnext = shidx(gx[1], le + 1);
          gx[0] = pp > 0 ? fromprev : hp; gx[9] = pp < 31 ? fromnext : hn;
          const float av[8] = {bf_lo(aw.x), bf_hi(aw.x), bf_lo(aw.y), bf_hi(aw.y), bf_lo(aw.z), bf_hi(aw.z), bf_lo(aw.w), bf_hi(aw.w)};
          float o[8];
#pragma unroll
          for (int j = 0; j < 8; ++j) o[j] = (tg.b + tg.w0 * gx[j] + tg.w1 * gx[j + 1] + tg.w2 * gx[j + 2]) * av[j];
          v4u w; w.x = pk2(o[0], o[1]); w.y = pk2(o[2], o[3]); w.z = pk2(o[4], o[5]); w.w = pk2(o[6], o[7]);
          *(v4u*)(out + off) = w; }
    }
}
template <bool CONVIN>
__device__ __forceinline__ void ph_lconv(const Params& p, int o, const bf16* IN, const bf16* UT, bf16* OUT, LAS unsigned char* lds, int tid, int lane, int wave) {
    const bf16* FILT = (const bf16*)(p.ws + WS_FILT); const float* cw = p.in[I_CONVHYW]; const float* cbias = p.in[I_CONVHYB];
#pragma unroll 1
    for (int c = blockIdx.x; c < 1024; c += gridDim.x) { const int gc = (1 + o) * 1024 + c;
        const Taps ti{cw[c], cw[3072 + c], cw[6144 + c], cbias[c]}, tg{cw[gc], cw[3072 + gc], cw[6144 + gc], cbias[gc]};
        lconv_unit<CONVIN>(IN + (size_t)c * T, ti, FILT + (size_t)(o * 1024 + c) * 2048, UT + (size_t)gc * T, tg, p.in[I_FBIAS][o * 1024 + c], OUT + (size_t)c * T, lds, tid, lane, wave); }
}
__device__ __forceinline__ void ph_transpose(const bf16* Y2T, bf16* Y2, LAS unsigned char* lds, int lane, int wave, int panel) {
    LAS unsigned char* tl = lds + wave * 16384;
    v4u cur[8], nxt[8];
#define TP_LOAD(dst, tile_) do { const int c0_ = ((tile_) & 15) * 64, t0_ = panel * 256 + ((tile_) >> 4) * 64; _Pragma("unroll") for (int rr = 0; rr < 8; ++rr) \
        dst[rr] = *(const v4u*)(Y2T + (size_t)(c0_ + rr * 8 + (lane >> 3)) * T + t0_ + (lane & 7) * 8); } while (0)
    TP_LOAD(cur, wave);
#pragma unroll 1
    for (int tile = wave; tile < 64; tile += NWAVES) { const int c0 = (tile & 15) * 64, t0 = panel * 256 + (tile >> 4) * 64;
        if (tile + NWAVES < 64) TP_LOAD(nxt, tile + NWAVES);
#pragma unroll
        for (int rr = 0; rr < 8; ++rr) { LAS unsigned* d = (LAS unsigned*)(tl + (rr * 8 + (lane >> 3)) * 132 + (lane & 7) * 16); d[0] = cur[rr].x; d[1] = cur[rr].y; d[2] = cur[rr].z; d[3] = cur[rr].w; }
        LDS_WAIT(); asm volatile("" ::: "memory");
#pragma unroll
        for (int rr = 0; rr < 8; ++rr) { const int tk = rr * 8 + (lane >> 3), cp = (lane & 7) * 8;
            unsigned short e[8];
#pragma unroll
            for (int j = 0; j < 8; ++j) e[j] = *(const LAS unsigned short*)(tl + (cp + j) * 132 + tk * 2);
            v4u w; w.x = e[0] | ((unsigned)e[1] << 16); w.y = e[2] | ((unsigned)e[3] << 16); w.z = e[4] | ((unsigned)e[5] << 16); w.w = e[6] | ((unsigned)e[7] << 16);
            *(v4u*)(Y2 + (size_t)(t0 + tk) * D + c0 + cp) = w; }
        LDS_WAIT(); asm volatile("" ::: "memory");
#pragma unroll
        for (int rr = 0; rr < 8; ++rr) cur[rr] = nxt[rr];
    }
#undef TP_LOAD
}

constexpr float QSCALE = 0.125f * 1.4426950408889634f;
struct InprojSched { int G, c;
    __device__ __forceinline__ bool next(int i, Unit& u) const { const int L = i * G + c; if (L >= 3840 + 288) return false;
        if (L < 3840) { u.pm = L / 15; u.pn = L % 15; } else { const int q = L - 3840; u.pm = 256 + q / 9; u.pn = 6 + q % 9; } return true; }
    __device__ __forceinline__ int arow(int r) const { return r; }
    __device__ __forceinline__ void* probe_ts() const { return nullptr; } };
struct EpiInproj { static constexpr bool PERM = true, AFTER_DRAIN = false, PROBE = false; unsigned char* big; const float* rope; float* gates; const float* gate_b;
    __device__ __forceinline__ void operator()(const f32x4 (&acc)[2][2][4][2], const Unit& u, int wr, int wc, int fr, int fq) const {
        const bool ctx = u.pm >= 256; const int b = ctx ? u.pm - 256 : (u.pm >> 3), r0 = ctx ? 0 : (u.pm & 7) * 256;
        if (u.pn == 14) {
            if (wc != 0 || fq >= 2) return;
            const f32x4 gb0 = *(const f32x4*)(gate_b + 8 * fq), gb1 = *(const f32x4*)(gate_b + 8 * fq + 4);
#pragma unroll
            for (int ai = 0; ai < 2; ++ai)
#pragma unroll
                for (int m = 0; m < 4; ++m) { const int rr = r0 + wr * 64 + fr + ai * HALF + m * 16; const size_t grow = ctx ? (size_t)T + b * LC + rr : (size_t)b * SEQ + rr;
                    float* gp = gates + grow * 16 + 8 * fq; *(f32x4*)gp = acc[ai][0][m][0] + gb0; *(f32x4*)(gp + 4) = acc[ai][0][m][1] + gb1; }
            return; }
        const int t = u.pn >> 1;
        constexpr size_t offs[7] = {A0_QA, A0_BQ, A0_BO, A0_KA, A0_VA, A0_BK, A0_BV};
        const bool kv = t >= 3;
        size_t toff = A0_QA;
#pragma unroll
        for (int q = 0; q < 7; ++q) if (t == q) toff = offs[q];
        bf16* O = (bf16*)(big + toff) + (size_t)b * (kv ? (SEQ + LC) : SEQ) * 512 + (size_t)((kv && !ctx) ? LC : 0) * 512;
        const bool rope_on = (t == 0 || t == 3) && !ctx; const float qs = t == 0 ? QSCALE : 1.f;
        const int col0 = (u.pn & 1) * 256 + wc * 32 + 8 * fq;
#pragma unroll
        for (int ai = 0; ai < 2; ++ai)
#pragma unroll
            for (int m = 0; m < 4; ++m) { const int rr = r0 + wr * 64 + fr + ai * HALF + m * 16; bf16* rowp = O + (size_t)rr * 512 + col0;
                f32x4 cs0 = (f32x4){1.f, 0.f, 1.f, 0.f}, cs1 = cs0;
                if (rope_on) { const int pos = (wc & 1) ? (rr & 63) : (rr >> 6); const float* rp = rope + (size_t)(pos * 16 + 4 * fq) * 2; cs0 = *(const f32x4*)rp; cs1 = *(const f32x4*)(rp + 4); }
#pragma unroll
                for (int bj = 0; bj < 2; ++bj) { const f32x4 x0 = acc[ai][bj][m][0], x1 = acc[ai][bj][m][1];
                    f32x4 o0, o1;
                    o0[0] = x0[0] * cs0[0] - x1[0] * cs0[1]; o1[0] = x1[0] * cs0[0] + x0[0] * cs0[1];
                    o0[1] = x0[1] * cs0[2] - x1[1] * cs0[3]; o1[1] = x1[1] * cs0[2] + x0[1] * cs0[3];
                    o0[2] = x0[2] * cs1[0] - x1[2] * cs1[1]; o1[2] = x1[2] * cs1[0] + x0[2] * cs1[1];
                    o0[3] = x0[3] * cs1[2] - x1[3] * cs1[3]; o1[3] = x1[3] * cs1[2] + x0[3] * cs1[3];
                    o0 = o0 * qs; o1 = o1 * qs;
                    u32x4 w; w.x = cvt_pk_bf16(o0[0], o0[1]); w.y = cvt_pk_bf16(o0[2], o0[3]); w.z = cvt_pk_bf16(o1[0], o1[1]); w.w = cvt_pk_bf16(o1[2], o1[3]);
                    *(u32x4*)(rowp + bj * HALF) = w; } }
    } };
__device__ __forceinline__ void ph_transpose_b(const bf16* src, bf16* dst, int NBt, int R, int C, LAS unsigned char* lds, int lane, int wave) {
    LAS unsigned char* tl = lds + wave * 16384;
    const int gw = blockIdx.x * NWAVES + wave, NGW = gridDim.x * NWAVES; const int tr = R / 64, tc = C / 64, per = tr * tc;
#pragma unroll 1
    for (int tile = gw; tile < NBt * per; tile += NGW) { const int bt = tile / per, q = tile % per, c0 = (q % tc) * 64, r0 = (q / tc) * 64;
        const bf16* s = src + (size_t)bt * R * C; bf16* d = dst + (size_t)bt * R * C;
#pragma unroll
        for (int rr = 0; rr < 8; ++rr) { const int row = rr * 8 + (lane >> 3), pc = lane & 7;
            *(LAS v4u*)(tl + row * 144 + pc * 16) = *(const v4u*)(s + (size_t)(r0 + row) * C + c0 + pc * 8); }
        LDS_WAIT(); asm volatile("" ::: "memory");
#pragma unroll
        for (int rr = 0; rr < 8; ++rr) { const int cc = rr * 8 + (lane >> 3), rp = (lane & 7) * 8;
            unsigned short e[8];
#pragma unroll
            for (int j = 0; j < 8; ++j) e[j] = *(const LAS unsigned short*)(tl + (rp + j) * 144 + cc * 2);
            v4u w; w.x = e[0] | ((unsigned)e[1] << 16); w.y = e[2] | ((unsigned)e[3] << 16); w.z = e[4] | ((unsigned)e[5] << 16); w.w = e[6] | ((unsigned)e[7] << 16);
            *(v4u*)(d + (size_t)(c0 + cc) * R + r0 + rp) = w; }
        LDS_WAIT(); asm volatile("" ::: "memory");
    }
}

typedef short s16x4 __attribute__((ext_vector_type(4)));
__device__ __forceinline__ u32x2 tr16(const LAS unsigned char* p) { return __builtin_bit_cast(u32x2, __builtin_amdgcn_ds_read_tr16_b64_v4i16((LAS s16x4*)p)); }
typedef float f32x2 __attribute__((ext_vector_type(2)));
constexpr int AT_KP = 272, AT_VP = 320  , AT_KB = 64 * AT_KP, AT_VB = 64 * AT_VP, AT_V0 = 2 * AT_KB;
__device__ __forceinline__ void ph_attn(const Params& p, unsigned char* big, LAS unsigned char* lds, int tid, int lane, int wave, int vcu) {
    const bf16* QA = (const bf16*)(big + A0_QA); const bf16* KA = (const bf16*)(big + A0_KA); const bf16* VA = (const bf16*)(big + A0_VA); bf16* MIXIN = (bf16*)(big + A0_MIXIN);
    const int blk = (lane >> 4) & 1, tq = (lane & 15) >> 2, tp = lane & 3;
    const int comp = wave >> 2, qw = wave & 3, r = lane & 31, hh = lane >> 5;
    float lam; { const float* lv = p.in[I_DLAM]; const float a = wave_sum(lv[lane] * lv[64 + lane]), b2 = wave_sum(lv[128 + lane] * lv[192 + lane]); lam = expf(a) - expf(b2) + 0.2f; }
#pragma unroll 1
    for (int unit = vcu; unit < 2048; unit += gridDim.x) {
        const int b = unit >> 6, h = (unit >> 4) & 3, qblk = unit & 15, q0 = qblk * 128 + qw * 32;
        const bf16* Kg = KA + (size_t)b * (SEQ + LC) * 512 + h * 128; const bf16* Vg = VA + (size_t)b * (SEQ + LC) * 512 + h * 128;
        bf16x8 qf[4];
#pragma unroll
        for (int ds = 0; ds < 4; ++ds) qf[ds] = *(const bf16x8*)(QA + ((size_t)b * SEQ + q0 + r) * 512 + h * 128 + comp * 64 + ds * 16 + hh * 8);
        f32x16 oacc[4];
#pragma unroll
        for (int i = 0; i < 4; ++i)
#pragma unroll
            for (int q = 0; q < 16; ++q) oacc[i][q] = 0.f;
        float m_run = 0.f, l_run = 0.f;
        v4u pre[4];
#define AT_LOADG(kt) do { _Pragma("unroll") for (int q = 0; q < 2; ++q) { const int idx = tid + NTHR * q; \
            pre[q] = *(const v4u*)(Kg + (size_t)((kt) * 64 + (idx >> 4)) * 512 + (idx & 15) * 8); \
            pre[2 + q] = *(const v4u*)(Vg + (size_t)((kt) * 64 + (idx >> 4)) * 512 + (idx & 15) * 8); } } while (0)
#define AT_STORES(kn) do { _Pragma("unroll") for (int q = 0; q < 2; ++q) { const int idx = tid + NTHR * q; \
            *(LAS v4u*)(lds + ((kn) & 1) * AT_KB + (idx >> 4) * AT_KP + (idx & 15) * 16) = pre[q]; \
            *(LAS v4u*)(lds + AT_V0 + ((kn) % 3) * AT_VB + (idx >> 4) * AT_VP + (idx & 15) * 16) = pre[2 + q]; } } while (0)
#define AT_PV(PF, VT_) do { const LAS unsigned char* Vt_ = (VT_); _Pragma("unroll") for (int kb = 0; kb < 2; ++kb) _Pragma("unroll") for (int s = 0; s < 2; ++s) _Pragma("unroll") for (int dvb = 0; dvb < 4; ++dvb) { \
            const LAS unsigned char* vp = Vt_ + (32 * kb + 16 * s + 4 * hh + tq) * AT_VP + (32 * dvb + 16 * blk + 4 * tp) * 2; const u32x2 lo = tr16(vp), hi = tr16(vp + 8 * AT_VP); \
            u32x4 vw; vw.x = lo.x; vw.y = lo.y; vw.z = hi.x; vw.w = hi.y; oacc[dvb] = __builtin_amdgcn_mfma_f32_32x32x16_bf16(__builtin_bit_cast(bf16x8, vw), PF[kb][s], oacc[dvb], 0, 0, 0); } } while (0)
        bf16x8 phold[2][2];
        __syncthreads();
        AT_LOADG(0); AT_STORES(0);
        __syncthreads();
#pragma unroll 1
        for (int kt = 0; kt < 36; ++kt) {
            if (kt < 35) AT_LOADG(kt + 1);
            const LAS unsigned char* Kt = lds + (kt & 1) * AT_KB;
            if (comp == 1 && kt > 0) { AT_PV(phold, lds + AT_V0 + ((kt - 1) % 3) * AT_VB); }
            f32x16 sacc[2];
#pragma unroll
            for (int kb = 0; kb < 2; ++kb)
#pragma unroll
                for (int q = 0; q < 16; ++q) sacc[kb][q] = -m_run;
#pragma unroll
            for (int ds = 0; ds < 4; ++ds)
#pragma unroll
                for (int kb = 0; kb < 2; ++kb) { const bf16x8 kf = *(const LAS bf16x8*)(Kt + (32 * kb + r) * AT_KP + comp * 128 + ds * 32 + hh * 16);
                    sacc[kb] = __builtin_amdgcn_mfma_f32_32x32x16_bf16(kf, qf[ds], sacc[kb], 0, 0, 0); }
            float mx = sacc[0][0];
#pragma unroll
            for (int kb = 0; kb < 2; ++kb)
#pragma unroll
                for (int q = 0; q < 16; ++q) mx = fmaxf(mx, sacc[kb][q]);
            mx = fmaxf(mx, shx(mx, 32));
            if (kt == 0 || __builtin_amdgcn_ballot_w64(mx > 0.f) != 0ull) {
                const float dm = kt == 0 ? mx : fmaxf(mx, 0.f), alpha = __builtin_amdgcn_exp2f(-dm); m_run += dm; l_run *= alpha;
#pragma unroll
                for (int kb = 0; kb < 2; ++kb) sacc[kb] = sacc[kb] - dm;
#pragma unroll
                for (int i = 0; i < 4; ++i) oacc[i] = oacc[i] * alpha; }
            f32x2 ps2 = (f32x2){0.f, 0.f};
#pragma unroll
            for (int kb = 0; kb < 2; ++kb)
#pragma unroll
                for (int q = 0; q < 8; ++q) { f32x2 e; e.x = __builtin_amdgcn_exp2f(sacc[kb][2 * q]); e.y = __builtin_amdgcn_exp2f(sacc[kb][2 * q + 1]); sacc[kb][2 * q] = e.x; sacc[kb][2 * q + 1] = e.y; ps2 += e; }
            l_run += ps2.x + ps2.y;
#pragma unroll
            for (int kb = 0; kb < 2; ++kb)
#pragma unroll
                for (int s = 0; s < 2; ++s) {
                    u32x4 pw; pw.x = cvt_pk_bf16(sacc[kb][8 * s + 0], sacc[kb][8 * s + 1]); pw.y = cvt_pk_bf16(sacc[kb][8 * s + 2], sacc[kb][8 * s + 3]);
                    pw.z = cvt_pk_bf16(sacc[kb][8 * s + 4], sacc[kb][8 * s + 5]); pw.w = cvt_pk_bf16(sacc[kb][8 * s + 6], sacc[kb][8 * s + 7]);
                    phold[kb][s] = __builtin_bit_cast(bf16x8, pw); }
            if (comp == 0) { AT_PV(phold, lds + AT_V0 + (kt % 3) * AT_VB); }
            if (kt < 35) AT_STORES(kt + 1);
            __syncthreads();
        }
        if (comp == 1) { AT_PV(phold, lds + AT_V0 + (35 % 3) * AT_VB); }
        __syncthreads();
#undef AT_LOADG
#undef AT_STORES
#undef AT_PV
        const float lsum = l_run + shx(l_run, 32), inv = __builtin_amdgcn_rcpf(lsum);
        LAS float* X = (LAS float*)lds;
        if (comp == 1) {
#pragma unroll
            for (int dvb = 0; dvb < 4; ++dvb)
#pragma unroll
                for (int q = 0; q < 16; ++q) X[(qw * 64 + dvb * 16 + q) * 64 + lane] = oacc[dvb][q] * inv; }
        __syncthreads();
        if (comp == 0) {
            float ss = 0.f;
#pragma unroll
            for (int dvb = 0; dvb < 4; ++dvb)
#pragma unroll
                for (int q = 0; q < 16; ++q) { const float o = oacc[dvb][q] * inv - lam * X[(qw * 64 + dvb * 16 + q) * 64 + lane]; oacc[dvb][q] = o; ss += o * o; }
            ss += shx(ss, 32);
            const float rn = rsqrtf(ss * (1.f / 128.f) + RMS_EPS) * 0.8f;
            const float* ga = p.in[I_HGA] + h * 128; bf16* orow = MIXIN + ((size_t)b * SEQ + q0 + r) * D + h * 128;
#pragma unroll
            for (int dvb = 0; dvb < 4; ++dvb)
#pragma unroll
                for (int g = 0; g < 4; ++g) { const int dv = 32 * dvb + 8 * g + 4 * hh; const f32x4 gg = *(const f32x4*)(ga + dv);
                    v2u w; w.x = pk2(oacc[dvb][4 * g + 0] * rn * gg[0], oacc[dvb][4 * g + 1] * rn * gg[1]); w.y = pk2(oacc[dvb][4 * g + 2] * rn * gg[2], oacc[dvb][4 * g + 3] * rn * gg[3]);
                    *(v2u*)(orow + dv) = w; }
        }
    }
    __syncthreads();
}

constexpr int ML_P = 272, ML_TILE = 64 * ML_P;
constexpr int ML_VOFF = 3 * ML_TILE, ML_VSZ = 64 * 256;
constexpr int ML_RQ = ML_VOFF + 2 * ML_VSZ, ML_RSZ = 68 * 256, ML_RK = ML_RQ + ML_RSZ;
constexpr int ML_NOFF = ML_RK + ML_RSZ, ML_AOFF = ML_NOFF + 2 * 512;
constexpr int ML_CW = ML_AOFF + 8 * 256;
static_assert(ML_CW + 8 * 512 <= LDS_TAB, "mLSTM LDS map");
__device__ __forceinline__ float logsigmoidf_(float x) { return x >= 0.f ? -__logf(1.f + __expf(-x)) : x - __logf(1.f + __expf(x)); }
__device__ __forceinline__ bf16x8 pack8(const f32x16& v, int s) { u32x4 w; w.x = cvt_pk_bf16(v[8 * s + 0], v[8 * s + 1]); w.y = cvt_pk_bf16(v[8 * s + 2], v[8 * s + 3]); w.z = cvt_pk_bf16(v[8 * s + 4], v[8 * s + 5]); w.w = cvt_pk_bf16(v[8 * s + 6], v[8 * s + 7]); return __builtin_bit_cast(bf16x8, w); }
__device__ __forceinline__ void ph_mlstm(const Params& p, unsigned char* big, LAS unsigned char* lds, int tid, int lane, int wave) {
    const int bid = blockIdx.x; if (bid >= 256) return;
    const int b = bid >> 3, h = (bid >> 1) & 3, dir = bid & 1;
    const bf16* BQ = (const bf16*)(big + A0_BQ) + (size_t)b * SEQ * 512 + h * 128;
    const bf16* BK = (const bf16*)(big + A0_BK) + (size_t)b * (SEQ + LC) * 512 + h * 128;
    const bf16* BV = (const bf16*)(big + A0_BV) + (size_t)b * (SEQ + LC) * 512 + h * 128;
    bf16* HB = (bf16*)(big + A0_HB) + (size_t)dir * T * 512 + (size_t)b * SEQ * 512 + h * 128;
    const float* GT = (const float*)(p.ws + WS_GATES);
    const float* cw = p.in[I_CONVABW]; const float* cb = p.in[I_CONVABB];
    const int eb = wave & 3, tb = wave >> 2, r = lane & 31, hh = lane >> 5;
    const int blk = (lane >> 4) & 1, tq = (lane & 15) >> 2, tp = lane & 3;
    LAS float* nbuf = (LAS float*)(lds + ML_NOFF); LAS float* aw = (LAS float*)(lds + ML_AOFF) + wave * 64;
    if (tid < 256) nbuf[tid] = 0.f;
    LAS float* cwl = (LAS float*)(lds + ML_CW);
    for (int i = tid; i < 1024; i += NTHR) { const int ten = i >> 9, j = (i >> 7) & 3, d = i & 127, ch = ten * 512 + h * 128 + d; cwl[i] = j < 3 ? cw[j * 1024 + ch] : cb[ch]; }
    f32x16 cacc[4];
#pragma unroll
    for (int i = 0; i < 4; ++i)
#pragma unroll
        for (int q = 0; q < 16; ++q) cacc[i][q] = 0.f;
    float m_state = 0.f;
#ifdef ML_PROBE
    unsigned long long accs[7] = {0, 0, 0, 0, 0, 0, 0}; unsigned long long tp0 = __builtin_amdgcn_s_memrealtime();
#define ML_T(i) do { const unsigned long long t1_ = __builtin_amdgcn_s_memrealtime(); accs[i] += t1_ - tp0; tp0 = t1_; } while (0)
#else
#define ML_T(i)
#endif
    float a_c = 0.f, M_c = 0.f, b_c = 0.f, decay_c = 1.f, m_after = 0.f;
    float a_n = 0.f, M_n = 0.f, b_n = 0.f, w_n = 0.f, decay_n = 1.f, m_next = 0.f;
#define ML_POS(cc, t) ((cc) < 4 ? (dir ? 255 - ((cc) * 64 + (t)) : (cc) * 64 + (t)) : (dir ? 2047 - (((cc) - 4) * 64 + (t)) : ((cc) - 4) * 64 + (t)))
#define ML_GLOAD(cc, li_, fp_) do { const int pos_ = ML_POS(cc, lane); const size_t grow_ = (cc) < 4 ? (size_t)T + b * LC + pos_ : (size_t)b * SEQ + pos_; \
        li_ = GT[grow_ * 16 + dir * 8 + h]; fp_ = GT[grow_ * 16 + dir * 8 + 4 + h]; } while (0)
#define ML_SCAN(li_, fp_, m_in) do { const float lf_ = logsigmoidf_(fp_); \
        float bs_ = lf_; _Pragma("unroll") for (int o_ = 1; o_ < 64; o_ <<= 1) { const float v_ = shup(bs_, o_); if (lane >= o_) bs_ += v_; } \
        const float aa_ = (li_) - bs_; float pm_ = aa_; _Pragma("unroll") for (int o_ = 1; o_ < 64; o_ <<= 1) { const float v_ = shup(pm_, o_); if (lane >= o_) pm_ = fmaxf(pm_, v_); } \
        const float MM_ = fmaxf(m_in, pm_); const float M63_ = shidx(MM_, 63), b63_ = shidx(bs_, 63); \
        a_n = aa_; M_n = MM_; b_n = bs_; w_n = __expf(aa_ - M63_); decay_n = __expf((m_in) - M63_); m_next = b63_ + M63_; } while (0)
#define ML_DMA(cc, vbuf) do { const int lim_ = (cc) < 4 ? LC : SEQ, kvb_ = (cc) < 4 ? 0 : LC; \
        _Pragma("unroll 1") for (int ins_ = wave; ins_ < 17; ins_ += NWAVES) { const int rr_ = ins_ * 4 + (lane >> 4), pc_ = lane & 15; int pos_ = ML_POS(cc, rr_ - 1); pos_ = pos_ < 0 ? 0 : (pos_ >= lim_ ? lim_ - 1 : pos_); \
            __builtin_amdgcn_global_load_lds((const unsigned*)(BK + (size_t)(kvb_ + pos_) * 512 + pc_ * 8), (LAS unsigned*)(lds + ML_RK + ins_ * 1024), 16, 0, 0); \
            if ((cc) >= 4) __builtin_amdgcn_global_load_lds((const unsigned*)(BQ + (size_t)pos_ * 512 + pc_ * 8), (LAS unsigned*)(lds + ML_RQ + ins_ * 1024), 16, 0, 0); } \
        _Pragma("unroll") for (int q_ = 0; q_ < 2; ++q_) { const int ins_ = wave * 2 + q_, t_ = ins_ * 4 + (lane >> 4), pc_ = lane & 15; const int pos_ = ML_POS(cc, t_); \
            __builtin_amdgcn_global_load_lds((const unsigned*)(BV + (size_t)(kvb_ + pos_) * 512 + pc_ * 8), (LAS unsigned*)(lds + ML_VOFF + (vbuf) * ML_VSZ + ins_ * 1024), 16, 0, 0); } } while (0)
#define ML_CONV8(dst, rawoff, cc, t_, d8_, ten, scl) do { const int pos_ = ML_POS(cc, t_), lim_ = (cc) < 4 ? LC : SEQ; const int rm_ = dir ? (t_) + 2 : (t_), rp_ = dir ? (t_) : (t_) + 2; \
        v4u x_[3]; x_[0] = *(const LAS v4u*)(lds + (rawoff) + rm_ * 256 + (d8_) * 16); x_[1] = *(const LAS v4u*)(lds + (rawoff) + ((t_) + 1) * 256 + (d8_) * 16); x_[2] = *(const LAS v4u*)(lds + (rawoff) + rp_ * 256 + (d8_) * 16); \
        if (pos_ - 1 < 0) x_[0] = (v4u){0u, 0u, 0u, 0u}; if (pos_ + 1 >= lim_) x_[2] = (v4u){0u, 0u, 0u, 0u}; \
        const LAS float* wl_ = cwl + (ten) * 512 + (d8_) * 8; f32x4 wv_[4][2]; \
        _Pragma("unroll") for (int j_ = 0; j_ < 4; ++j_) { wv_[j_][0] = *(const LAS f32x4*)(wl_ + j_ * 128); wv_[j_][1] = *(const LAS f32x4*)(wl_ + j_ * 128 + 4); } \
        _Pragma("unroll") for (int e_ = 0; e_ < 8; ++e_) { float s_ = wv_[3][e_ >> 2][e_ & 3]; \
            _Pragma("unroll") for (int j_ = 0; j_ < 3; ++j_) { const unsigned w_ = e_ < 2 ? x_[j_].x : e_ < 4 ? x_[j_].y : e_ < 6 ? x_[j_].z : x_[j_].w; s_ += wv_[j_][e_ >> 2][e_ & 3] * ((e_ & 1) ? bf_hi(w_) : bf_lo(w_)); } \
            dst[e_] = s_ * __builtin_amdgcn_rcpf(1.f + __expf(-s_)) * (scl); } } while (0)
#define ML_BUILD(cc) do { _Pragma("unroll 1") for (int q_ = 0; q_ < 2; ++q_) { const int idx_ = tid + NTHR * q_, t_ = idx_ >> 4, d8_ = idx_ & 15; \
        float kk_[8]; ML_CONV8(kk_, ML_RK, cc, t_, d8_, 1, 1.f); const float wt_ = shidx(w_n, t_); \
        v4u o_; o_.x = pk2(kk_[0], kk_[1]); o_.y = pk2(kk_[2], kk_[3]); o_.z = pk2(kk_[4], kk_[5]); o_.w = pk2(kk_[6], kk_[7]); *(LAS v4u*)(lds + ML_TILE + t_ * ML_P + d8_ * 16) = o_; \
        o_.x = pk2(kk_[0] * wt_, kk_[1] * wt_); o_.y = pk2(kk_[2] * wt_, kk_[3] * wt_); o_.z = pk2(kk_[4] * wt_, kk_[5] * wt_); o_.w = pk2(kk_[6] * wt_, kk_[7] * wt_); *(LAS v4u*)(lds + 2 * ML_TILE + t_ * ML_P + d8_ * 16) = o_; \
        if ((cc) >= 4) { float qq_[8]; ML_CONV8(qq_, ML_RQ, cc, t_, d8_, 0, 0.08838834764831845f); \
            o_.x = pk2(qq_[0], qq_[1]); o_.y = pk2(qq_[2], qq_[3]); o_.z = pk2(qq_[4], qq_[5]); o_.w = pk2(qq_[6], qq_[7]); *(LAS v4u*)(lds + t_ * ML_P + d8_ * 16) = o_; } } } while (0)
    __syncthreads();
    { float li0, fp0; ML_GLOAD(0, li0, fp0); ML_DMA(0, 0); ML_SCAN(li0, fp0, m_state); }
    asm volatile("s_waitcnt vmcnt(0)" ::: "memory");
    __syncthreads();
    ML_BUILD(0);
    a_c = a_n; M_c = M_n; b_c = b_n; decay_c = decay_n; m_after = m_next;
    __syncthreads();
#pragma unroll 1
    for (int cc = 0; cc < 36; ++cc) {
        const LAS unsigned char* Qs = lds; const LAS unsigned char* Ks = lds + ML_TILE; const LAS unsigned char* Kw = lds + 2 * ML_TILE; const LAS unsigned char* Vs = lds + ML_VOFF + (cc & 1) * ML_VSZ;
        const LAS float* ncur = nbuf + (cc & 1) * 128; LAS float* nnew = nbuf + ((cc + 1) & 1) * 128;
        float li1 = 0.f, fp1 = 0.f;
        ML_T(5);
        if (cc < 35) { ML_GLOAD(cc + 1, li1, fp1); ML_DMA(cc + 1, (cc + 1) & 1); }
        ML_T(0);
        if (cc >= 4) {
            aw[lane] = a_c;
            const int tcol = 32 * tb + r; const float Mt = shidx(M_c, tcol), bt = shidx(b_c, tcol);
            f32x16 nacc;
#pragma unroll
            for (int q = 0; q < 16; ++q) nacc[q] = 0.f;
#pragma unroll
            for (int db = 0; db < 4; ++db)
#pragma unroll
                for (int s2 = 0; s2 < 2; ++s2) { const LAS unsigned char* qp = Qs + tcol * ML_P + (32 * db + 16 * s2 + 4 * hh) * 2; const u32x2 lo = *(const LAS u32x2*)qp, hi = *(const LAS u32x2*)(qp + 16);
                    u32x4 qw; qw.x = lo.x; qw.y = lo.y; qw.z = hi.x; qw.w = hi.y;
                    nacc = __builtin_amdgcn_mfma_f32_32x32x16_bf16(pack8(cacc[db], s2), __builtin_bit_cast(bf16x8, qw), nacc, 0, 0, 0); }
            const float sc = __expf(m_state - Mt);
            nacc = nacc * sc;
            float rs = 0.f;
#pragma unroll
            for (int sb = 0; sb < 2; ++sb) if (sb <= tb) {
                f32x16 sacc;
#pragma unroll
                for (int q = 0; q < 16; ++q) sacc[q] = 0.f;
#pragma unroll
                for (int ds = 0; ds < 8; ++ds) { const bf16x8 kf = *(const LAS bf16x8*)(Ks + (32 * sb + r) * ML_P + (16 * ds + 8 * hh) * 2), qf = *(const LAS bf16x8*)(Qs + tcol * ML_P + (16 * ds + 8 * hh) * 2);
                    sacc = __builtin_amdgcn_mfma_f32_32x32x16_bf16(kf, qf, sacc, 0, 0, 0); }
#pragma unroll
                for (int g = 0; g < 4; ++g) { const int s0 = 32 * sb + 8 * g + 4 * hh; const f32x4 av = *(const LAS f32x4*)(aw + s0);
#pragma unroll
                    for (int j = 0; j < 4; ++j) { const bool keep = (s0 + j) <= tcol; const float v = keep ? sacc[4 * g + j] * __expf(av[j] - Mt) : 0.f; sacc[4 * g + j] = v; rs += v; } }
#pragma unroll
                for (int s2 = 0; s2 < 2; ++s2) { u32x4 vw;
                    { const u32x2 t0 = tr16(Vs + (32 * sb + 16 * s2 + 4 * hh + tq) * 256 + (32 * eb + 16 * blk + 4 * tp) * 2), t1 = tr16(Vs + (32 * sb + 16 * s2 + 8 + 4 * hh + tq) * 256 + (32 * eb + 16 * blk + 4 * tp) * 2);
                      vw.x = t0.x; vw.y = t0.y; vw.z = t1.x; vw.w = t1.y; }
                    nacc = __builtin_amdgcn_mfma_f32_32x32x16_bf16(__builtin_bit_cast(bf16x8, vw), pack8(sacc, s2), nacc, 0, 0, 0); } }
            rs += shx(rs, 32);
            float qn = 0.f;
            { const LAS unsigned char* qp = Qs + tcol * ML_P + (64 * hh) * 2;
#pragma unroll
              for (int c8 = 0; c8 < 8; ++c8) { const v4u w = *(const LAS v4u*)(qp + c8 * 16); const f32x4 n0 = *(const LAS f32x4*)(ncur + 64 * hh + 8 * c8), n1 = *(const LAS f32x4*)(ncur + 64 * hh + 8 * c8 + 4);
                  qn += bf_lo(w.x) * n0[0] + bf_hi(w.x) * n0[1] + bf_lo(w.y) * n0[2] + bf_hi(w.y) * n0[3] + bf_lo(w.z) * n1[0] + bf_hi(w.z) * n1[1] + bf_lo(w.w) * n1[2] + bf_hi(w.w) * n1[3]; } }
            qn += shx(qn, 32);
            const float den = sc * qn + rs; const float dd = __frcp_rn(fmaxf(fabsf(den), __expf(-(bt + Mt))));
            { const int pos = ML_POS(cc, tcol); bf16* hrow = HB + (size_t)pos * 512 + 32 * eb;
#pragma unroll
              for (int g = 0; g < 4; ++g) { v2u w; w.x = pk2(nacc[4 * g + 0] * dd, nacc[4 * g + 1] * dd); w.y = pk2(nacc[4 * g + 2] * dd, nacc[4 * g + 3] * dd); *(v2u*)(hrow + 8 * g + 4 * hh) = w; } }
        }
        ML_T(1);
#pragma unroll
        for (int db = 0; db < 4; ++db) { cacc[db] = cacc[db] * decay_c;
#pragma unroll
            for (int s4 = 0; s4 < 4; ++s4) { u32x4 ka, vb;
                { const u32x2 t0 = tr16(Kw + (16 * s4 + 8 * hh + tq) * ML_P + (32 * db + 16 * blk + 4 * tp) * 2), t1 = tr16(Kw + (16 * s4 + 8 * hh + 4 + tq) * ML_P + (32 * db + 16 * blk + 4 * tp) * 2);
                  ka.x = t0.x; ka.y = t0.y; ka.z = t1.x; ka.w = t1.y; }
                { const u32x2 t0 = tr16(Vs + (16 * s4 + 8 * hh + tq) * 256 + (32 * eb + 16 * blk + 4 * tp) * 2), t1 = tr16(Vs + (16 * s4 + 8 * hh + 4 + tq) * 256 + (32 * eb + 16 * blk + 4 * tp) * 2);
                  vb.x = t0.x; vb.y = t0.y; vb.z = t1.x; vb.w = t1.y; }
                cacc[db] = __builtin_amdgcn_mfma_f32_32x32x16_bf16(__builtin_bit_cast(bf16x8, ka), __builtin_bit_cast(bf16x8, vb), cacc[db], 0, 0, 0); } }
        { const int d = tid >> 2, part = tid & 3; float s = 0.f;
#pragma unroll
            for (int t = 0; t < 16; ++t) s += bf1(*(const LAS bf16*)(Kw + (part * 16 + t) * ML_P + d * 2));
            s += shx(s, 1); s += shx(s, 2);
            if (part == 0) nnew[d] = decay_c * ncur[d] + s; }
        m_state = m_after;
        ML_T(2);
        asm volatile("s_waitcnt vmcnt(0)" ::: "memory");
        __syncthreads();
        ML_T(3);
        if (cc < 35) { ML_SCAN(li1, fp1, m_state); ML_T(6); ML_BUILD(cc + 1); a_c = a_n; M_c = M_n; b_c = b_n; decay_c = decay_n; m_after = m_next; }
        ML_T(4);
        __syncthreads();
    }
#ifdef ML_PROBE
    if (blockIdx.x == 0 && tid == 256) { unsigned long long* ts = (unsigned long long*)(p.ws + WS_CTL + 32768); ts[50] = 0; unsigned long long c_ = 0; for (int i = 0; i < 7; ++i) { c_ += accs[i]; ts[51 + i] = c_; } }
#endif
#undef ML_T
#undef ML_POS
#undef ML_GLOAD
#undef ML_SCAN
#undef ML_DMA
#undef ML_CONV8
#undef ML_BUILD
}
__device__ __forceinline__ void ph_outb(const Params& p, unsigned char* big, int lane, int wave, int tile) {
    const int gw = tile * NWAVES + wave;
    const bf16* HBf = (const bf16*)(big + A0_HB); const bf16* HBb = HBf + (size_t)T * 512; const bf16* BO = (const bf16*)(big + A0_BO); bf16* MIXIN = (bf16*)(big + A0_MIXIN);
    const float* gb = p.in[I_HGB];
    const f32x4 g0 = *(const f32x4*)(gb + lane * 8), g1 = *(const f32x4*)(gb + lane * 8 + 4);
#pragma unroll 2
    for (int m = gw * 32; m < gw * 32 + 32; ++m) {
        const v4u f = *(const v4u*)(HBf + (size_t)m * 512 + lane * 8), bw = *(const v4u*)(HBb + (size_t)m * 512 + lane * 8), go = *(const v4u*)(BO + (size_t)m * 512 + lane * 8);
        float x[8], o[8]; x[0] = bf_lo(f.x) + bf_lo(bw.x); x[1] = bf_hi(f.x) + bf_hi(bw.x); x[2] = bf_lo(f.y) + bf_lo(bw.y); x[3] = bf_hi(f.y) + bf_hi(bw.y);
        x[4] = bf_lo(f.z) + bf_lo(bw.z); x[5] = bf_hi(f.z) + bf_hi(bw.z); x[6] = bf_lo(f.w) + bf_lo(bw.w); x[7] = bf_hi(f.w) + bf_hi(bw.w);
        o[0] = bf_lo(go.x); o[1] = bf_hi(go.x); o[2] = bf_lo(go.y); o[3] = bf_hi(go.y); o[4] = bf_lo(go.z); o[5] = bf_hi(go.z); o[6] = bf_lo(go.w); o[7] = bf_hi(go.w);
        float ss = 0.f;
#pragma unroll
        for (int j = 0; j < 8; ++j) ss += x[j] * x[j];
        ss += shx(ss, 1); ss += shx(ss, 2); ss += shx(ss, 4); ss += shx(ss, 8);
        const float rn = rsqrtf(ss * (1.f / 128.f) + RMS_EPS);
        float y[8];
#pragma unroll
        for (int j = 0; j < 8; ++j) y[j] = x[j] * rn * (j < 4 ? g0[j] : g1[j - 4]) * sigmoidf_(o[j]);
        v4u w; w.x = pk2(y[0], y[1]); w.y = pk2(y[2], y[3]); w.z = pk2(y[4], y[5]); w.w = pk2(y[6], y[7]);
        *(v4u*)(MIXIN + (size_t)m * D + 512 + lane * 8) = w;
    }
}

constexpr int CW_DBG = 16;
#ifndef DBG_MODE
#define DBG_MODE 0
#endif
#ifndef DBG_L
#define DBG_L 0
#endif
#ifndef DBG_CH
#define DBG_CH 0
#endif
__device__ __forceinline__ void dbg_report(const Params& p, float d) {
    if (!(d >= 0.f)) d = 1.0e6f;
    atomicMax((unsigned*)(p.ws + WS_CTL) + CW_DBG, __float_as_uint(d));
}
__device__ __forceinline__ float block_max(float v, LAS float* red, int tid) { v = wave_max(v); __syncthreads(); if ((tid & 63) == 0) red[tid >> 6] = v; __syncthreads(); float r = red[0];
#pragma unroll
    for (int w = 1; w < 8; ++w) r = fmaxf(r, red[w]); __syncthreads(); return r; }
__device__ __forceinline__ float block_sum(float v, LAS float* red, int tid) { v = wave_sum(v); __syncthreads(); if ((tid & 63) == 0) red[tid >> 6] = v; __syncthreads(); float r = 0.f;
#pragma unroll
    for (int w = 0; w < 8; ++w) r += red[w]; __syncthreads(); return r; }
__device__ __forceinline__ void dbg_moe_check(const Params& p, int l, int ch, const bf16* H2, const bf16* Y, LAS unsigned char* lds, int tid) {
    LAS float* hrow = (LAS float*)lds; LAS float* gu = hrow + 1024; LAS float* a = gu + 512; LAS float* red = a + 256;
    const int t = ch * CHT + blockIdx.x * 64 + 5;
    __syncthreads();
    for (int i = tid; i < 1024; i += NTHR) hrow[i] = bf1(H2[(size_t)t * D + i]);
    __syncthreads();
    const int* EIDX = (const int*)(p.ws + WS_EIDX); const float* WTS = (const float*)(p.ws + WS_WTS); const int* PSLOT = (const int*)(p.ws + WS_PSLOT);
    float yacc[2] = {0.f, 0.f};
#pragma unroll 1
    for (int k = 0; k < 9; ++k) {
        const int e = k < 8 ? (EIDX[(size_t)t * 8 + k] & 255) : 64; const float w = k < 8 ? WTS[(size_t)t * 8 + k] : 1.f;
        const float* Wgu = e < 64 ? p.in[I_EGU] + (size_t)(l * 64 + e) * 1024 * 512 : p.in[I_SGU] + (size_t)l * 1024 * 512;
        const float* Wdn = e < 64 ? p.in[I_EDN] + (size_t)(l * 64 + e) * 256 * 1024 : p.in[I_SDN] + (size_t)l * 256 * 1024;
        float s = 0.f;
#pragma unroll 4
        for (int kk = 0; kk < 1024; ++kk) s += hrow[kk] * Wgu[(size_t)kk * 512 + tid];
        gu[tid] = s;
        __syncthreads();
        if (tid < 256) a[tid] = siluf_(gu[tid]) * gu[256 + tid];
        __syncthreads();
#pragma unroll
        for (int q = 0; q < 2; ++q) { const int n = tid + 512 * q; float s2 = 0.f;
#pragma unroll 4
            for (int j = 0; j < 256; ++j) s2 += a[j] * Wdn[(size_t)j * 1024 + n];
            yacc[q] += w * s2; }
        __syncthreads();
    }
    float err = 0.f, ss = 0.f;
#pragma unroll
    for (int q = 0; q < 2; ++q) { const int n = tid + 512 * q; float f = 0.f;
#pragma unroll 1
        for (int k = 0; k < 9; ++k) { const int slot = PSLOT[(size_t)t * 16 + k]; const float w = k < 8 ? WTS[(size_t)t * 8 + k] : 1.f; f += w * bf1(Y[(size_t)slot * D + n]); }
        err = fmaxf(err, fabsf(f - yacc[q])); ss += yacc[q] * yacc[q]; }
    const float me = block_max(err, red, tid), sq = block_sum(ss, red, tid);
    if (tid == 0) dbg_report(p, me / sqrtf(sq * (1.f / 1024.f) + 1e-30f));
}
__device__ __forceinline__ void dbg_route_check(const Params& p, int l, const bf16* H2, const float* LOG, LAS unsigned char* lds, int tid) {
    LAS float* hrow = (LAS float*)lds; LAS float* lg = hrow + 1024; LAS float* bi = lg + 64; LAS float* sc = bi + 64; LAS float* red = sc + 64;
    const int t = blockIdx.x * 256 + 77;
    __syncthreads();
    for (int i = tid; i < 1024; i += NTHR) hrow[i] = bf1(H2[(size_t)t * D + i]);
    __syncthreads();
    if (tid < 64) { float s = 0.f; const float* W = p.in[I_RW] + (size_t)l * 1024 * 64;
#pragma unroll 4
        for (int k = 0; k < 1024; ++k) s += hrow[k] * W[k * 64 + tid];
        lg[tid] = s; sc[tid] = 1.f / (1.f + expf(-s)); bi[tid] = sc[tid] + p.in[I_RB][l * 64 + tid]; }
    __syncthreads();
    if (tid == 0) {
        float lerr = 0.f;
#pragma unroll 1
        for (int e = 0; e < 64; ++e) lerr = fmaxf(lerr, fabsf(lg[e] - LOG[(size_t)t * 64 + e]));
        float grp[8];
#pragma unroll
        for (int g = 0; g < 8; ++g) { float a = -1e30f, b = -1e30f;
#pragma unroll 1
            for (int j = 0; j < 8; ++j) { const float v = bi[g * 8 + j]; if (v > a) { b = a; a = v; } else if (v > b) b = v; } grp[g] = a + b; }
        unsigned gm = 0;
#pragma unroll 1
        for (int r = 0; r < 4; ++r) { int best = -1; float bv = 0.f;
#pragma unroll
            for (int g = 0; g < 8; ++g) if (!((gm >> g) & 1u) && (best < 0 || grp[g] > bv)) { best = g; bv = grp[g]; }
            gm |= 1u << best; }
        unsigned long long set_ref = 0ull; float ssum = 0.f;
#pragma unroll 1
        for (int r = 0; r < 8; ++r) { int best = -1; float bv = 0.f;
#pragma unroll 1
            for (int e = 0; e < 64; ++e) if (((gm >> (e >> 3)) & 1u) && !((set_ref >> e) & 1ull) && (best < 0 || bi[e] > bv)) { best = e; bv = bi[e]; }
            set_ref |= 1ull << best; ssum += sc[best]; }
        const int* EIDX = (const int*)(p.ws + WS_EIDX); const float* WTS = (const float*)(p.ws + WS_WTS);
        unsigned long long set_f = 0ull; float werr = 0.f, wsum = 0.f;
#pragma unroll 1
        for (int k = 0; k < 8; ++k) { const int e = EIDX[(size_t)t * 8 + k] & 255; set_f |= 1ull << e; const float wr = 2.5f * sc[e] / ssum; werr = fmaxf(werr, fabsf(wr - WTS[(size_t)t * 8 + k])); wsum += WTS[(size_t)t * 8 + k]; }
        float d = 0.f;
        if (DBG_MODE == 0) d = (set_f != set_ref) ? (1.f / 256.f) : 0.f;
        if (DBG_MODE == 1) d = (set_f != set_ref) ? 0.f : werr + fabsf(wsum - 2.5f);
        if (DBG_MODE == 2) d = lerr * (1.f / 256.f);
        atomicAdd((float*)((unsigned*)(p.ws + WS_CTL) + CW_DBG), d);
    }
    __syncthreads();
}
__device__ __forceinline__ unsigned dbg_hash(unsigned x) { x ^= x >> 16; x *= 0x7feb352du; x ^= x >> 15; x *= 0x846ca68bu; x ^= x >> 16; return x; }
__device__ __forceinline__ void dbg_report_wave(const Params& p, float d, int lane) { if (lane == 0) dbg_report(p, d); }
__device__ __forceinline__ void dbg_hyena_check(const Params& p, int mode, const bf16* HN, const bf16* UC, const bf16* ZT, const bf16* Y2T, const bf16* MIX, LAS unsigned char* lds, int lane, int wave) {
    const unsigned hsh = dbg_hash(blockIdx.x * 8u + wave + 12345u), h2 = dbg_hash(hsh), h3 = dbg_hash(h2);
    const bf16* FILT = (const bf16*)(p.ws + WS_FILT);
    float d = 0.f;
    if (mode == 0) {
        const int c = hsh % 3072u, b = h2 % 32u, s = h3 % 2048u; float acc = 0.f;
#pragma unroll 1
        for (int k = lane; k < 1024; k += 64) acc += bf1(HN[(size_t)(b * 2048 + s) * D + k]) * p.in[I_WINHY][(size_t)k * 3072 + c];
        acc = wave_sum(acc);
        const float got = bf1(UC[(size_t)c * T + b * 2048 + s]); d = fabsf(got - acc) / (fabsf(acc) + 0.1f);
    } else if (mode == 5) {
        const int c = hsh % 3072u, b = h2 % 32u; int s = h3 % 2048u; if ((h3 >> 20) % 8u == 0u) s = 0; if ((h3 >> 20) % 8u == 1u) s = 2047;
        float val = p.in[I_CONVHYB][c];
#pragma unroll 1
        for (int j = 0; j < 3; ++j) { const int sj = s + j - 1; if (sj < 0 || sj > 2047) continue; val += p.in[I_CONVHYW][j * 3072 + c] * bf1(ZT[(size_t)c * T + b * 2048 + sj]); }
        const float got = bf1(UC[(size_t)c * T + b * 2048 + s]); d = fabsf(got - val) / (fabsf(val) + 0.1f);
    } else if (mode == 1) {
        LAS float* Z = (LAS float*)(lds + wave * 1024); LAS float* A1 = Z + 64; LAS float* A2 = A1 + 64;
        const int o = hsh & 1u, c = h2 % 1024u, j = h3 % 2048u;
        float z = 0.f; if (lane == 0) z = (float)j / 2047.f; else if (lane < 33) { const int k = (lane - 1) & 15; const float fr = 1e-4f + (float)k * ((15.f - 1e-4f) / 15.f); const float ang = (6.283185307179586f / 2048.f) * (float)j * fr; z = lane < 17 ? cosf(ang) : -sinf(ang); }
        Z[lane] = z; LDS_WAIT(); asm volatile("" ::: "memory");
        float a = p.in[I_FB1][lane];
#pragma unroll 1
        for (int k = 0; k < 33; ++k) a += Z[k] * p.in[I_FW1][k * 64 + lane];
        A1[lane] = sinf(a); LDS_WAIT(); asm volatile("" ::: "memory");
        a = p.in[I_FB2][lane];
#pragma unroll 1
        for (int k = 0; k < 64; ++k) a += A1[k] * p.in[I_FW2][k * 64 + lane];
        A2[lane] = sinf(a); LDS_WAIT(); asm volatile("" ::: "memory");
        float v = wave_sum(A2[lane] * p.in[I_FW3][lane * 2048 + o * 1024 + c]);
        const float mind = -4.605170185988091f / 1.5f, maxd = -4.605170185988091f / 0.3f; const float delta = fabsf(mind + (float)c * ((maxd - mind) / 1023.f));
        v *= expf(-fabsf((float)j - 1024.f) / 1024.f * delta);
        const float got = bf1(FILT[(size_t)(o * 1024 + c) * 2048 + j]); d = fabsf(got - v) / (fabsf(v) + 1e-4f);
    } else if (mode == 2 || mode == 3) {
        const int o = mode - 2, c = hsh % 1024u, b = h2 % 32u; int t = h3 % 2048u; if ((h3 >> 20) % 8u == 0u) t = 0; if ((h3 >> 20) % 8u == 1u) t = 2047;
        const bf16* in = (o == 0 ? UC : ZT) + (size_t)c * T + b * 2048; const bf16* f = FILT + (size_t)(o * 1024 + c) * 2048; float acc = 0.f;
#pragma unroll 1
        for (int s = lane; s < 2048; s += 64) { const int x = 1024 + t - s; if (x >= 0 && x <= 2047) acc += bf1(f[x]) * bf1(in[s]); }
        acc = wave_sum(acc);
        const float gate = bf1(UC[(size_t)((1 + o) * 1024 + c) * T + b * 2048 + t]);
        const float val = gate * (acc + bf1(in[t]) * p.in[I_FBIAS][o * 1024 + c]);
        const float got = bf1((o == 0 ? ZT : Y2T)[(size_t)c * T + b * 2048 + t]); d = fabsf(got - val) / (fabsf(val) + 0.1f);
    } else if (mode == 4) {
        const int tok = hsh % 65536u, n = h2 % 1024u; float acc = 0.f;
#pragma unroll 1
        for (int c = lane; c < 1024; c += 64) acc += bf1(Y2T[(size_t)c * T + tok]) * p.in[I_WOUTHY][(size_t)c * 1024 + n];
        acc = wave_sum(acc);
        const float got = bf1(MIX[(size_t)tok * D + n]); d = fabsf(got - acc) / (fabsf(acc) + 0.1f);
    }
    dbg_report_wave(p, d, lane);
}
__device__ __forceinline__ void dbg_inproj_check(const Params& p, unsigned char* big, int lane, int wave) {
    const unsigned hsh = dbg_hash(blockIdx.x * 8u + wave + 777u), h2 = dbg_hash(hsh);
    const bf16* H0 = (const bf16*)(big + A0_H); const float* W = p.in[I_WINAB];
    int m = hsh % (unsigned)TT; int n = h2 % 3600u;
    const bool ctx = m >= T; if (ctx && n < 1536) n += 1536;
    const int b = ctx ? (m - T) / LC : m / SEQ, s = ctx ? (m - T) % LC : m % SEQ;
    float x = 0.f, xp = 0.f; const bool rope_col = (n < 512) || (n >= 1536 && n < 2048); const int np = rope_col ? (n ^ 16) : n;
#pragma unroll 1
    for (int k = lane; k < 1024; k += 64) { const float hv = bf1(H0[(size_t)m * D + k]); x += hv * W[(size_t)k * 3600 + n]; xp += hv * W[(size_t)k * 3600 + np]; }
    x = wave_sum(x); xp = wave_sum(xp);
    float val = x, got = 0.f;
    if (n >= 3584) { val = x + p.in[I_GATEB][n - 3584]; got = ((const float*)(p.ws + WS_GATES))[(size_t)m * 16 + (n - 3584)]; }
    else { const int t = n / 512, cn = n % 512; int pc = cn;
        if (rope_col) { const int o = cn & 31; pc = (cn & ~31) + (((o & 15) >> 2) * 8 + (o >> 4) * 4 + (o & 3));
            if (!ctx) { const int d = cn & 63, axis = d >> 5, half = (d >> 4) & 1, i = d & 15; const float pos = (float)(axis == 0 ? (s >> 6) : (s & 63)); const float ang = pos * powf(10000.f, -(float)i / 16.f);
                val = half == 0 ? x * cosf(ang) - xp * sinf(ang) : x * cosf(ang) + xp * sinf(ang); } }
        if (t == 0) val *= QSCALE;
        const size_t offs[7] = {A0_QA, A0_BQ, A0_BO, A0_KA, A0_VA, A0_BK, A0_BV}; const bool kv = t >= 3;
        const bf16* O = (const bf16*)(big + offs[t]) + (size_t)b * (kv ? (SEQ + LC) : SEQ) * 512 + (size_t)((kv && !ctx) ? LC : 0) * 512;
        got = bf1(O[(size_t)s * 512 + pc]); }
    dbg_report_wave(p, fabsf(got - val) / (fabsf(val) + 0.1f), lane);
}
__device__ __forceinline__ void dbg_attn_check(const Params& p, unsigned char* big, LAS unsigned char* lds, int lane, int wave) {
    const unsigned hsh = dbg_hash(blockIdx.x * 8u + wave + 4242u), h2 = dbg_hash(hsh);
    const int b = hsh % 32u, h = (hsh >> 8) % 4u, q = h2 % 2048u;
    const bf16* QA = (const bf16*)(big + A0_QA) + ((size_t)b * SEQ + q) * 512 + h * 128; const bf16* KA = (const bf16*)(big + A0_KA) + (size_t)b * 2304 * 512 + h * 128;
    const bf16* VA = (const bf16*)(big + A0_VA) + (size_t)b * 2304 * 512 + h * 128; const bf16* MIXIN = (const bf16*)(big + A0_MIXIN) + ((size_t)b * SEQ + q) * D + h * 128;
    LAS float* Aw = (LAS float*)(lds + wave * 18432);
    const float* lv = p.in[I_DLAM]; const float lam = expf(wave_sum(lv[lane] * lv[64 + lane])) - expf(wave_sum(lv[128 + lane] * lv[192 + lane])) + 0.2f;
    float mx0 = -1e30f, mx1 = -1e30f;
#pragma unroll 1
    for (int key = lane; key < 2304; key += 64) { float s0 = 0.f, s1 = 0.f;
#pragma unroll 1
        for (int d = 0; d < 64; ++d) { s0 += bf1(QA[d]) * bf1(KA[(size_t)key * 512 + d]); s1 += bf1(QA[64 + d]) * bf1(KA[(size_t)key * 512 + 64 + d]); }
        Aw[key] = s0; Aw[2304 + key] = s1; mx0 = fmaxf(mx0, s0); mx1 = fmaxf(mx1, s1); }
    mx0 = wave_max(mx0); mx1 = wave_max(mx1);
    float l0 = 0.f, l1 = 0.f;
#pragma unroll 1
    for (int key = lane; key < 2304; key += 64) { const float e0 = exp2f(Aw[key] - mx0), e1 = exp2f(Aw[2304 + key] - mx1); Aw[key] = e0; Aw[2304 + key] = e1; l0 += e0; l1 += e1; }
    l0 = wave_sum(l0); l1 = wave_sum(l1);
    LDS_WAIT(); asm volatile("" ::: "memory");
    float o[2] = {0.f, 0.f};
#pragma unroll 1
    for (int key = 0; key < 2304; ++key) { const float a = Aw[key] / l0 - lam * Aw[2304 + key] / l1; o[0] += a * bf1(VA[(size_t)key * 512 + lane]); o[1] += a * bf1(VA[(size_t)key * 512 + 64 + lane]); }
    const float ms = wave_sum(o[0] * o[0] + o[1] * o[1]) * (1.f / 128.f); const float rn = rsqrtf(ms + RMS_EPS) * 0.8f;
    float err = 0.f, sc = 0.f;
#pragma unroll
    for (int j = 0; j < 2; ++j) { const float val = o[j] * rn * p.in[I_HGA][h * 128 + 64 * j + lane]; err = fmaxf(err, fabsf(val - bf1(MIXIN[64 * j + lane]))); sc += val * val; }
    err = wave_max(err); sc = sqrtf(wave_sum(sc) * (1.f / 128.f));
    dbg_report_wave(p, err / (sc + 1e-3f), lane);
}
__device__ __forceinline__ float dbg_convsilu(const bf16* base, int pos, int lim, int ch, int d, const float* cw, const float* cb) {
    float s = cb[ch];
#pragma unroll
    for (int j = 0; j < 3; ++j) { const int pj = pos + j - 1; if (pj >= 0 && pj < lim) s += cw[j * 1024 + ch] * bf1(base[(size_t)pj * 512 + d]); }
    return s / (1.f + expf(-s));
}
__device__ __forceinline__ void dbg_mlstm_check(const Params& p, unsigned char* big, LAS unsigned char* lds, int lane, int wave) {
    const unsigned hsh = dbg_hash(blockIdx.x * 8u + wave + 991u), h2 = dbg_hash(hsh);
    const int b = hsh % 32u, h = (hsh >> 8) % 4u, dir = (hsh >> 12) & 1; int tau = h2 % 2048u; if ((h2 >> 16) % 4u == 0u) tau = (h2 >> 20) % 130u;
    const bf16* BQ = (const bf16*)(big + A0_BQ) + (size_t)b * SEQ * 512 + h * 128; const bf16* BK = (const bf16*)(big + A0_BK) + (size_t)b * (SEQ + LC) * 512 + h * 128;
    const bf16* BV = (const bf16*)(big + A0_BV) + (size_t)b * (SEQ + LC) * 512 + h * 128;
    const float* GT = (const float*)(p.ws + WS_GATES); const float* cw = p.in[I_CONVABW]; const float* cb = p.in[I_CONVABB];
    LAS float* F = (LAS float*)(lds + wave * 18432); LAS float* qv = F + 2304 + 64;
    const int N = 256 + tau + 1;
#define DBG_POS(u) ((u) < 256 ? (dir ? 255 - (u) : (u)) : (dir ? 2047 - ((u) - 256) : (u) - 256))
#define DBG_GROW(u) ((u) < 256 ? (size_t)T + b * LC + DBG_POS(u) : (size_t)b * SEQ + DBG_POS(u))
    float carry = 0.f;
#pragma unroll 1
    for (int u0 = 0; u0 < N; u0 += 64) { const int u = u0 + lane; float lf = 0.f;
        if (u < N) { const float x = GT[DBG_GROW(u) * 16 + dir * 8 + 4 + h]; lf = x >= 0.f ? -__logf(1.f + __expf(-x)) : x - __logf(1.f + __expf(x)); }
        float s = lf;
#pragma unroll
        for (int o = 1; o < 64; o <<= 1) { const float v = shup(s, o); if (lane >= o) s += v; }
        if (u < N) F[u] = carry + s; carry += shidx(s, 63); }
    LDS_WAIT(); asm volatile("" ::: "memory");
    const float Ft = F[N - 1];
    float mm = Ft;
#pragma unroll 1
    for (int u = lane; u < N; u += 64) mm = fmaxf(mm, Ft - F[u] + GT[DBG_GROW(u) * 16 + dir * 8 + h]);
    mm = wave_max(mm);
    { const int pos = DBG_POS(N - 1);
      for (int d = lane; d < 128; d += 64) qv[d] = dbg_convsilu(BQ, pos, SEQ, h * 128 + d, d, cw, cb) * 0.08838834764831845f; }
    LDS_WAIT(); asm volatile("" ::: "memory");
    float den = 0.f;
#pragma unroll 1
    for (int u = lane; u < N; u += 64) { const bool ctx = u < 256; const int pos = DBG_POS(u); const bf16* kb = ctx ? BK : BK + (size_t)LC * 512; float qk = 0.f;
#pragma unroll 1
        for (int d = 0; d < 128; ++d) qk += qv[d] * dbg_convsilu(kb, pos, ctx ? LC : SEQ, 512 + h * 128 + d, d, cw, cb);
        const float om = qk * expf(Ft - F[u] + GT[DBG_GROW(u) * 16 + dir * 8 + h] - mm); F[u] = om; den += om; }
    den = wave_sum(den);
    LDS_WAIT(); asm volatile("" ::: "memory");
    float num[2] = {0.f, 0.f};
#pragma unroll 1
    for (int u = 0; u < N; ++u) { const bool ctx = u < 256; const int pos = DBG_POS(u); const bf16* vb = BV + (size_t)((ctx ? 0 : LC) + pos) * 512; num[0] += F[u] * bf1(vb[lane]); num[1] += F[u] * bf1(vb[64 + lane]); }
    const float dd = 1.f / fmaxf(fabsf(den), expf(-mm));
    const bf16* HB = (const bf16*)(big + A0_HB) + (size_t)dir * T * 512 + ((size_t)b * SEQ + DBG_POS(N - 1)) * 512 + h * 128;
    float err = 0.f, sc = 0.f;
#pragma unroll
    for (int j = 0; j < 2; ++j) { const float val = num[j] * dd; err = fmaxf(err, fabsf(val - bf1(HB[64 * j + lane]))); sc += val * val; }
    err = wave_max(err); sc = sqrtf(wave_sum(sc) * (1.f / 128.f));
    dbg_report_wave(p, err / (sc + 1e-3f), lane);
#undef DBG_POS
#undef DBG_GROW
}

__global__ void __launch_bounds__(NTHR, 2) mk_fwd(Params p0) {
    extern __shared__ __attribute__((aligned(16))) unsigned char lds_raw[];
    LAS unsigned char* lds = (LAS unsigned char*)lds_raw;
    const int wave0 = __builtin_amdgcn_readfirstlane((int)threadIdx.x >> 6);
    if (threadIdx.x < 64) ((LAS unsigned*)(lds + LDS_MISC))[threadIdx.x] = 0u;
    __syncthreads();
    XcdBarrier bar = xcd_barrier_post((unsigned*)(p0.ws + WS_CTL) + CW_BAR, (volatile LAS unsigned*)(lds + LDS_MISC + 32));
    const int G = gridDim.x, cb = blockIdx.x;
    const int vcu = (G % 8 == 0) ? (cb % 8) * (G / 8) + cb / 8 : cb;
#ifdef TIMEK
    int phc = 0; if (blockIdx.x == 0 && threadIdx.x == 0) ((unsigned long long*)(p0.ws + WS_CTL + 32768))[0] = __builtin_amdgcn_s_memrealtime();
#endif
#ifdef DBL_PH
#define DBL_LOOP for (int rep_ = 0; rep_ < 1; ++rep_)
#define DBL_SYNC __syncthreads();
#else
#define DBL_LOOP
#define DBL_SYNC
#endif
#ifdef TIMEK
#define TS_REC { ++phc; if (blockIdx.x == 0 && wave0 == 0 && lane_opq() == 0) ((unsigned long long*)(p0.ws + WS_CTL + 32768))[phc] = __builtin_amdgcn_s_memrealtime(); }
#else
#define TS_REC
#endif
#define LAYER_PTRS bf16* H2 = (bf16*)(big + (l == 0 ? 0 : 128 * MiB)); float* LOG = nullptr; bf16* ACT = (bf16*)(big + (l == 0 ? 144 * MiB : 272 * MiB)); \
        bf16* Y = (bf16*)(big + (l == 0 ? 304 * MiB : 432 * MiB)); bf16* HN = (bf16*)(big + 640 * MiB); const bf16* MIX = (const bf16*)(big + (l == 0 ? A0_MIX : 0)); \
        unsigned char* X8 = ws + WS_X8; bf16* UT = (bf16*)big; bf16* UC = (bf16*)(big + 384 * MiB); bf16* ZT = (bf16*)(big + 384 * MiB); bf16* Y2T = (bf16*)(big + 512 * MiB); bf16* Y2 = (bf16*)(big + 640 * MiB); \
        (void)X8; (void)H2; (void)LOG; (void)ACT; (void)Y; (void)HN; (void)MIX; (void)UT; (void)UC; (void)ZT; (void)Y2T; (void)Y2;
#define RUN(...) do { { { int tid_ = wave0 * 64 + lane_opq(); asm volatile("" : "+v"(tid_)); const int tid = tid_, lane = tid & 63, wave = __builtin_amdgcn_readfirstlane(tid >> 6); (void)lane; (void)wave; \
        Params p = p0; { size_t z_ = 0; asm volatile("" : "+s"(z_)); p.ws = p0.ws + z_; p.out = p0.out + z_; _Pragma("unroll") for (int i_ = 0; i_ < 31; ++i_) p.in[i_] = p0.in[i_] + z_; } unsigned char* ws = p.ws; unsigned char* big = ws + WS_BIG; (void)big; LAYER_PTRS DBL_LOOP { __VA_ARGS__; DBL_SYNC } } { XcdBarrier b2_ = bar; { size_t z_ = 0; asm volatile("" : "+s"(z_)); b2_.bar = bar.bar + z_; unsigned x_ = bar.x; asm volatile("" : "+s"(x_)); b2_.x = x_; } xcd_barrier(b2_, wave0 == 0 && lane_opq() == 0); } TS_REC } } while (0)

#ifdef PRO_PROBE
#define PP(i) do { if (blockIdx.x == 0 && tid == 0) ((unsigned long long*)(p0.ws + WS_CTL + 32768))[50 + (i)] = __builtin_amdgcn_s_memrealtime(); } while (0)
#else
#define PP(i)
#endif
    { const int l = 0; RUN({ PP(0); pro_mod(p, lds, tid, lane, wave); __syncthreads(); PP(1); pro_filters(p, lds, tid, lane, wave); PP(2); pro_rope(p, tid); pro_transposes(p, lds, lane, wave); PP(3); }); }

    for (int l = 0; l < 2; ++l) {
        if (l == 0) {
            RUN({ ph_l0_norm(p, lane, wave); });
            RUN({ Gemm g{(const bf16*)(big + A0_H), (const bf16*)(ws + WS_WIN0), 1024, 2048u}; InprojSched S{G, vcu};
                  EpiInproj E{big, (const float*)(ws + WS_ROPE), (float*)(ws + WS_GATES), p.in[I_GATEB]};
                  gemm_phase<EpiInproj, InprojSched>(lds, g, S, E, tid); });
#ifdef DBG_INPROJ
            RUN({ dbg_inproj_check(p, big, lane, wave); });
#endif
            RUN({ ph_attn(p, big, lds, tid, lane, wave, vcu); });
#ifdef DBG_ATTN
            RUN({ dbg_attn_check(p, big, lds, lane, wave); });
#endif
            RUN({ ph_mlstm(p, big, lds, tid, lane, wave); });
#ifdef DBG_MLSTM
            RUN({ dbg_mlstm_check(p, big, lds, lane, wave); });
#endif
            RUN({ ph_outb(p, big, lane, wave, vcu); asm volatile("s_waitcnt vmcnt(0)" ::: "memory"); __syncthreads();
                  Gemm g{(const bf16*)(big + A0_MIXIN), (const bf16*)(ws + WS_WOUT0), 1024, 2048u}; PanelSched S{4, vcu}; EpiBf16 E{(bf16*)(big + A0_MIX), 1024, 3};
                  gemm_phase<EpiBf16, PanelSched>(lds, g, S, E, tid); });
        }
        if (l == 1) {
            RUN({ Gemm g{(const bf16*)(ws + WS_WIN1), HN, 1024, 2048u}; DenseSched S{256, 12 * 256, G, vcu, 12}; EpiBf16 E{UT, (size_t)T, 0xffff};
                  gemm_phase<EpiBf16, DenseSched>(lds, g, S, E, tid); });
#ifdef DBG_HY
            if (DBG_MODE == 0) { RUN({ dbg_hyena_check(p, 0, HN, UT, UT, UT, UT, lds, lane, wave); }); }
#endif
#ifdef DBG_HY
            if (DBG_MODE == 5) { RUN({ dbg_hyena_check(p, 5, HN, UC, UT, UT, UT, lds, lane, wave); }); }
#endif
            RUN({ ph_lconv<true>(p, 0, UT, UT, ZT, lds, tid, lane, wave); });
#ifdef DBG_HY
            if (DBG_MODE == 2) { RUN({ dbg_hyena_check(p, 2, HN, UC, ZT, Y2T, UT, lds, lane, wave); }); }
#endif
            RUN({ ph_lconv<false>(p, 1, ZT, UT, Y2T, lds, tid, lane, wave); });
#ifdef DBG_HY
            if (DBG_MODE == 3) { RUN({ dbg_hyena_check(p, 3, HN, UC, ZT, Y2T, UT, lds, lane, wave); }); }
#endif
            RUN({ ph_transpose(Y2T, Y2, lds, lane, wave, vcu); asm volatile("s_waitcnt vmcnt(0)" ::: "memory"); __syncthreads();
                  Gemm g{Y2, (const bf16*)(ws + WS_WOUT1), 1024, 2048u}; PanelSched S{4, vcu}; EpiBf16 E{(bf16*)big, 1024, 3};
                  gemm_phase<EpiBf16, PanelSched>(lds, g, S, E, tid); });
        }
#ifdef DBG_HY
        if (l == 1 && (DBG_MODE == 1 || DBG_MODE == 4)) { RUN({ dbg_hyena_check(p, DBG_MODE, HN, (const bf16*)(big + 384 * MiB), (const bf16*)big, (const bf16*)(big + 128 * MiB), (const bf16*)big, lds, lane, wave); }); }
#endif
        RUN({ ph_mid(p, l, MIX, H2, X8, true, lane, wave, vcu); asm volatile("s_waitcnt vmcnt(0)" ::: "memory"); __syncthreads();
              Gemm g{H2, (const bf16*)(ws + WS_WR) + (size_t)l * 256 * 1024, 1024, 2048u}; DenseSched S{1, 256, G, vcu, 0}; EpiRouterLds E{};
              gemm_phase<EpiRouterLds, DenseSched>(lds, g, S, E, tid); __syncthreads(); ph_route_a(p, l, nullptr, vcu, lds, tid); });
#ifdef DBG_ROUTE
        RUN({ if (l == DBG_L) dbg_route_check(p, l, H2, LOG, lds, tid); ph_route_b(p, lds, tid); });
#else
        RUN({ ph_route_b(p, lds, tid); });
#endif
#define DO_G1(chx) do { const int NT = moe_tables(p, chx, lds, tid); \
            Gemm g{(const bf16*)X8, (const bf16*)(ws + WS_GU + (size_t)l * (65 * 512) * 1024), 512, 1024u};        \
            MoeSched S{(const LAS int*)(lds + LDS_TAB), (const int*)(ws + WS_SORT) + (size_t)(chx) * CHROWS, NT * 2, G, vcu, 1, 2, nullptr}; EpiSwiglu E{(unsigned char*)ACT}; \
            gemm_phase<EpiSwiglu, MoeSched, true, true>(lds, g, S, E, tid); } while (0)
        RUN({ DO_G1(0); });
        for (int ch = 0; ch < NCH; ++ch) {
            RUN({ const int NT = moe_tables(p, ch, lds, tid);
                  int k_ = 128; asm volatile("" : "+s"(k_));
                  Gemm g{ACT, (const bf16*)(ws + WS_DN + (size_t)l * (65 * 1024) * 256), k_, 256u};
                  MoeSched S{(const LAS int*)(lds + LDS_TAB), nullptr, NT * 4, G, vcu, 2, 4, (l == 0 && ch == 0) ? (void*)(ws + WS_CTL + 32768) : nullptr}; EpiFp8 E{(unsigned char*)Y};
                  gemm_phase<EpiFp8, MoeSched, true, true>(lds, g, S, E, tid); });
            RUN({ const int par = (cb >> 3) & 1;
                  _Pragma("unroll 1") for (int part = 0; part < 2; ++part) { int t2_ = tid; asm volatile("" : "+v"(t2_)); const int tid = t2_, lane = tid & 63; (void)lane; if ((part ^ par) == 0) { if (ch + 1 < NCH) DO_G1(ch + 1); } else { ph_combine(p, l, ch, (const unsigned char*)Y, HN, lane, wave); } __syncthreads(); } });
        }
    }
#ifdef TIMEK
    if (blockIdx.x == 0) { const unsigned long long* ts = (const unsigned long long*)(p0.ws + WS_CTL + 32768); __syncthreads();
        const unsigned long long d = (__hip_atomic_load(ts + TIMEK, __ATOMIC_RELAXED, __HIP_MEMORY_SCOPE_AGENT) - __hip_atomic_load(ts + TIMEK0, __ATOMIC_RELAXED, __HIP_MEMORY_SCOPE_AGENT)) * 4ull, t0 = __builtin_amdgcn_s_memrealtime();
        while (__builtin_amdgcn_s_memrealtime() - t0 < d) __builtin_amdgcn_s_sleep(8); }
#endif
#ifdef DBG_ANY
    xcd_barrier(bar, threadIdx.x == 0);
    if (blockIdx.x == 0 && threadIdx.x == 0) p0.out[0] += 1.0e7f * __uint_as_float(((const unsigned*)(p0.ws + WS_CTL))[CW_DBG]);
#endif
#undef RUN
}
constexpr int NPHASES = 1 + 2 * (4 + 3 * NCH) + 6 + 64;
}

extern "C" void kernel_launch(void* const* d_in, const int* in_sizes, int n_in, void* d_out, int out_size, void* d_ws, size_t ws_size, hipStream_t stream) {
    using namespace mk;
    static int grid = 0;
    if (grid == 0) {
        if (n_in != 31 || out_size != T * D || ws_size < WS_END) { fprintf(stderr, "kernel_launch: unexpected shapes (n_in %d, out %d, ws %zu)\n", n_in, out_size, ws_size); grid = -1; return; }
        int dev = 0, cus = 0;
        if (hipGetDevice(&dev) != hipSuccess || hipDeviceGetAttribute(&cus, hipDeviceAttributeMultiprocessorCount, dev) != hipSuccess) { grid = -1; return; }
        if (hipFuncSetAttribute((const void*)mk_fwd, hipFuncAttributeMaxDynamicSharedMemorySize, LDS_BYTES) != hipSuccess) { fprintf(stderr, "kernel_launch: hipFuncSetAttribute failed\n"); grid = -1; return; }
        int per_cu = 0;
        if (hipOccupancyMaxActiveBlocksPerMultiprocessor(&per_cu, (const void*)mk_fwd, NTHR, LDS_BYTES) != hipSuccess || per_cu < 1) { fprintf(stderr, "kernel_launch: occupancy query says %d\n", per_cu); }
        (void)hipGetLastError();
        grid = cus;
        if (grid != 256) { fprintf(stderr, "kernel_launch: built for 256 CUs, found %d\n", grid); grid = -1; return; }
    }
    if (grid < 0) return;
    (void)hipMemsetAsync((char*)d_ws + WS_CTL, 0, CTL_ZERO_BYTES, stream);
    Params a{};
    for (int i = 0; i < 31; ++i) a.in[i] = (const float*)d_in[i];
    a.out = (float*)d_out; a.ws = (unsigned char*)d_ws; a.ph_lo = 0; a.ph_hi = NPHASES;
    hipLaunchKernelGGL(mk_fwd, dim3(grid), dim3(NTHR), LDS_BYTES, stream, a);
}
```

```cpp
#include <hip/hip_runtime.h>
#include <cstdio>
#include <cstdint>
namespace pg8 {
#define PG8_LAS __attribute__((address_space(3)))
typedef unsigned short bf16_t;
typedef short bf16x8 __attribute__((ext_vector_type(8)));
typedef float f32x4 __attribute__((ext_vector_type(4)));
typedef unsigned u32x4 __attribute__((ext_vector_type(4)));
typedef unsigned u32x2 __attribute__((ext_vector_type(2)));
typedef int i32x4 __attribute__((ext_vector_type(4)));
typedef int i32x8 __attribute__((ext_vector_type(8)));
constexpr int BM = 256, BK = 64, HALF = 128, HTB = HALF * BK * 2  , STAGE_BYTES = 8 * HTB;

__host__ __device__ __forceinline__ int lds_byte(int r, int c) { const int st = (r >> 4) * 2 + (c >> 5), rr = r & 15, cc = c & 31, ob = rr * 64 + cc * 2; return st * 1024 + (ob ^ (((ob >> 9) & 1) << 5)); }
__host__ __device__ __forceinline__ void stage_rc(int b, int& R, int& C) { const int st = b / 1024, sb = b % 1024, swz = sb ^ (((sb >> 9) & 1) << 5); R = (st >> 1) * 16 + swz / 64; C = (st & 1) * 32 + (swz % 64) / 2; }
__host__ __device__ __forceinline__ int perm32(int rho) { const int n = rho >> 4, i = rho & 15; return 8 * (i >> 2) + 4 * n + (i & 3); }

struct Unit { int pm, pn; };
__device__ __forceinline__ unsigned cvt_pk_bf16(float lo, float hi) { unsigned r; asm volatile("v_cvt_pk_bf16_f32 %0, %1, %2" : "=v"(r) : "v"(lo), "v"(hi)); return r; }
struct Gemm { const bf16_t* A; const bf16_t* Bt; int K; unsigned lda_bytes; };
template <class Epi, class Sched, bool ALIGN_EPI = true, bool F8 = false>
__device__ __forceinline__ void gemm_phase(PG8_LAS unsigned char* lds, const Gemm g, const Sched& S, const Epi& E, const int tid_in) {
    int tid_ = tid_in; asm volatile("" : "+v"(tid_));
    const int tid = tid_, wid = __builtin_amdgcn_readfirstlane(tid >> 6), lane = tid & 63, wr = wid >> 2, wc = wid & 3, fr = lane & 15, fq = lane >> 4;
    const int K = g.K, nt = K / BK;
    unsigned voffB[2];
#pragma unroll
    for (int i = 0; i < 2; ++i) { int R, C; stage_rc(tid * 16 + i * 8192, R, C); int Rb = Epi::PERM ? ((R & ~31) + perm32(R & 31)) : R;
        if (Epi::TOKPERM) Rb = 64 * ((Rb >> 5) & 3) + 16 * ((Rb >> 3) & 3) + (Rb & 7);
        voffB[i] = (unsigned)(Rb * K + C) * 2u; }
    const size_t kstep = (size_t)(BK * 2);
    const size_t hstep = (size_t)(Epi::TOKPERM ? 8 : HALF) * K * 2;
    const size_t tstep = (size_t)2 * HALF * K * 2;
    const unsigned ldsw = (unsigned)wid * 1024u;
    const int aoff = lds_byte(wr * 64 + fr, fq * 8), boff = lds_byte(wc * 32 + fr, fq * 8);
    const char* Ab = (const char*)g.A;
#define PG8_SA(b, h) (((b) * 2 + (h)) * HTB)
#define PG8_SB(b, h) ((4 + (b) * 2 + (h)) * HTB)
#define PG8_STAGE(bufoff, gbase, voff) do { _Pragma("unroll") for (int _i = 0; _i < 2; ++_i) \
        __builtin_amdgcn_global_load_lds((const unsigned*)((const char*)(gbase) + (voff)[_i]), (PG8_LAS unsigned*)(lds + (bufoff) + ldsw + _i * 8192), 16, 0, 0); } while (0)
#define PG8_STAGEA(bufoff, o0, o1, kb) do { \
        __builtin_amdgcn_global_load_lds((const unsigned*)(Ab + (size_t)(o0) + (size_t)(kb)), (PG8_LAS unsigned*)(lds + (bufoff) + ldsw), 16, 0, 0); \
        __builtin_amdgcn_global_load_lds((const unsigned*)(Ab + (size_t)(o1) + (size_t)(kb)), (PG8_LAS unsigned*)(lds + (bufoff) + ldsw + 8192), 16, 0, 0); } while (0)
#define PG8_LDA(dst, b, h) do { _Pragma("unroll") for (int m = 0; m < 4; ++m) _Pragma("unroll") for (int k = 0; k < 2; ++k) dst[m][k] = *(const PG8_LAS bf16x8*)(lds + PG8_SA(b, h) + aoff + m * 2048 + k * 1024); } while (0)
#define PG8_LDB(dst, b, h) do { _Pragma("unroll") for (int n = 0; n < 2; ++n) _Pragma("unroll") for (int k = 0; k < 2; ++k) dst[n][k] = *(const PG8_LAS bf16x8*)(lds + PG8_SB(b, h) + boff + n * 2048 + k * 1024); } while (0)
#define PG8_CAT(x0, x1) __builtin_shufflevector(__builtin_bit_cast(i32x4, x0), __builtin_bit_cast(i32x4, x1), 0, 1, 2, 3, 4, 5, 6, 7)
#define PG8_MMA(ai, bj, At, Bt) do { __builtin_amdgcn_s_setprio(1); _Pragma("unroll") for (int m = 0; m < 4; ++m) _Pragma("unroll") for (int n = 0; n < 2; ++n) { \
        if constexpr (F8) acc[ai][bj][m][n] = __builtin_amdgcn_mfma_scale_f32_16x16x128_f8f6f4(PG8_CAT(Bt[n][0], Bt[n][1]), PG8_CAT(At[m][0], At[m][1]), acc[ai][bj][m][n], 0, 0, 0, 0, 0, 0); \
        else { _Pragma("unroll") for (int k = 0; k < 2; ++k) acc[ai][bj][m][n] = __builtin_amdgcn_mfma_f32_16x16x32_bf16(Bt[n][k], At[m][k], acc[ai][bj][m][n], 0, 0, 0); } } __builtin_amdgcn_s_setprio(0); } while (0)
#define PG8_WAIT_V(n) asm volatile("s_waitcnt vmcnt(" #n ")" ::: "memory")
#define PG8_WAIT_L(n) asm volatile("s_waitcnt lgkmcnt(" #n ")" ::: "memory")
#define PG8_BAR __builtin_amdgcn_s_barrier()
#define PG8_SCHED __builtin_amdgcn_sched_barrier(0)
#define PG8_OFFS(dst, u) do { _Pragma("unroll") for (int _i = 0; _i < 2; ++_i) { int _R, _C; stage_rc(tid * 16 + _i * 8192, _R, _C); _Pragma("unroll") for (int _h = 0; _h < 2; ++_h) \
        dst[_h][_i] = (unsigned)S.arow((u).pm * BM + _h * HALF + _R) * g.lda_bytes + (unsigned)(_C * 2); } } while (0)
    Unit cur, nxt; int ui = 0;
    if (!S.next(0, cur)) return;
    f32x4 acc[2][2][4][2];
#pragma unroll
    for (int a = 0; a < 2; ++a)
#pragma unroll
        for (int b = 0; b < 2; ++b)
#pragma unroll
            for (int m = 0; m < 4; ++m)
#pragma unroll
                for (int n = 0; n < 2; ++n) acc[a][b][m][n] = (f32x4){0.f, 0.f, 0.f, 0.f};
    bf16x8 At[4][2], B0[2][2], B1[2][2];
    unsigned oC[2][2], oN[2][2];
    PG8_OFFS(oC, cur);
    const char* cB = (const char*)g.Bt + (size_t)cur.pn * tstep;
    PG8_STAGE(PG8_SB(0, 0), cB, voffB); PG8_STAGE(PG8_SB(0, 1), cB + hstep, voffB); PG8_STAGEA(PG8_SA(0, 0), oC[0][0], oC[0][1], 0); PG8_STAGEA(PG8_SA(0, 1), oC[1][0], oC[1][1], 0);
    if (wr == 1) PG8_BAR;
    PG8_WAIT_V(2); PG8_BAR;
    PG8_STAGE(PG8_SB(1, 0), cB + kstep, voffB); PG8_STAGEA(PG8_SA(1, 0), oC[0][0], oC[0][1], kstep); PG8_STAGE(PG8_SB(1, 1), cB + hstep + kstep, voffB);
    PG8_WAIT_V(6); PG8_BAR;
#ifdef GM_PROBE
    unsigned long long gaccs[3] = {0, 0, 0}; unsigned long long gtp = __builtin_amdgcn_s_memrealtime();
#define GM_T(i) do { if (Epi::PROBE) { const unsigned long long t1_ = __builtin_amdgcn_s_memrealtime(); gaccs[i] += t1_ - gtp; gtp = t1_; } } while (0)
#else
#define GM_T(i)
#endif
    for (;;) {
        const bool has_next = S.next(ui + 1, nxt);
        if (has_next) { PG8_OFFS(oN, nxt); } else {
#pragma unroll
            for (int _h = 0; _h < 2; ++_h)
#pragma unroll
                for (int _i = 0; _i < 2; ++_i) oN[_h][_i] = oC[_h][_i]; }
        const char* nB = has_next ? (const char*)g.Bt + (size_t)nxt.pn * tstep : cB;
#pragma unroll 1
        for (int t = 0; t < nt; t += 2) {
            const bool last = (t == nt - 2);
            const size_t k1 = (size_t)(t + 1) * kstep;
            const size_t k2 = last ? 0 : (size_t)(t + 2) * kstep, k3 = k2 + kstep;
            const char* b2 = last ? nB : cB + (size_t)(t + 2) * kstep; const char* b3 = b2 + kstep;
            PG8_LDB(B0, 0, 0); PG8_LDB(B1, 0, 1); PG8_SCHED; PG8_LDA(At, 0, 0); PG8_STAGEA(PG8_SA(1, 1), oC[1][0], oC[1][1], k1);
            if (last) { oC[0][0] = oN[0][0]; oC[0][1] = oN[0][1]; oC[1][0] = oN[1][0]; oC[1][1] = oN[1][1]; }
            PG8_WAIT_V(8); PG8_WAIT_L(0); PG8_BAR; PG8_MMA(0, 0, At, B0); if constexpr (!Epi::NARROW) { if (!S.narrow(cur)) PG8_MMA(0, 1, At, B1); } PG8_BAR; PG8_SCHED;
            PG8_LDA(At, 0, 1); PG8_STAGE(PG8_SB(0, 0), b2, voffB); PG8_STAGE(PG8_SB(0, 1), b2 + hstep, voffB); PG8_STAGEA(PG8_SA(0, 0), oC[0][0], oC[0][1], k2);
            PG8_WAIT_V(8); PG8_WAIT_L(0); PG8_BAR; PG8_MMA(1, 0, At, B0); if constexpr (!Epi::NARROW) { if (!S.narrow(cur)) PG8_MMA(1, 1, At, B1); } PG8_BAR; PG8_SCHED;
            PG8_LDB(B0, 1, 0); PG8_LDB(B1, 1, 1); PG8_SCHED; PG8_LDA(At, 1, 0); PG8_STAGEA(PG8_SA(0, 1), oC[1][0], oC[1][1], k2);
            PG8_WAIT_V(8); PG8_WAIT_L(0); PG8_BAR; PG8_MMA(0, 0, At, B0); if constexpr (!Epi::NARROW) { if (!S.narrow(cur)) PG8_MMA(0, 1, At, B1); } PG8_BAR; PG8_SCHED;
            PG8_LDA(At, 1, 1); PG8_STAGE(PG8_SB(1, 0), b3, voffB); PG8_STAGE(PG8_SB(1, 1), b3 + hstep, voffB); PG8_STAGEA(PG8_SA(1, 0), oC[0][0], oC[0][1], k3);
            PG8_WAIT_V(8); PG8_WAIT_L(0); PG8_BAR; PG8_MMA(1, 0, At, B0); if constexpr (!Epi::NARROW) { if (!S.narrow(cur)) PG8_MMA(1, 1, At, B1); } PG8_BAR; PG8_SCHED;
        }
        GM_T(0);
        if constexpr (ALIGN_EPI) { if (wr == 0) PG8_BAR; }
        GM_T(1);
        E(acc, cur, wr, wc, fr, fq);
        GM_T(2);
        if (!has_next) break;
#pragma unroll
        for (int a = 0; a < 2; ++a)
#pragma unroll
            for (int b = 0; b < 2; ++b)
#pragma unroll
                for (int m = 0; m < 4; ++m)
#pragma unroll
                    for (int n = 0; n < 2; ++n) acc[a][b][m][n] = (f32x4){0.f, 0.f, 0.f, 0.f};
        cur = nxt; cB = nB; ++ui;
#pragma unroll
        for (int _h = 0; _h < 2; ++_h)
#pragma unroll
            for (int _i = 0; _i < 2; ++_i) oC[_h][_i] = oN[_h][_i];
        if constexpr (ALIGN_EPI) { if (wr == 1) PG8_BAR; }
    }
#ifdef GM_PROBE
    if (Epi::PROBE && blockIdx.x == 0 && tid == 0) { unsigned long long* ts = (unsigned long long*)(S.probe_ts()); if (ts) { ts[50] = 0; ts[51] = gaccs[0]; ts[52] = gaccs[0] + gaccs[1]; ts[53] = gaccs[0] + gaccs[1] + gaccs[2]; } }
#endif
    PG8_WAIT_V(0);
    if constexpr (!ALIGN_EPI) { if (wr == 0) PG8_BAR; }
    PG8_BAR;
    if constexpr (Epi::AFTER_DRAIN) E.fused(acc, cur, wr, wc, fr, fq, lds);
#undef PG8_SA
#undef PG8_SB
#undef PG8_STAGE
#undef PG8_STAGEA
#undef PG8_LDA
#undef PG8_LDB
#undef PG8_MMA
#undef PG8_CAT
#undef PG8_WAIT_V
#undef PG8_WAIT_L
#undef PG8_BAR
#undef PG8_SCHED
#undef PG8_OFFS
#undef GM_T
}

template <class Epi, class Sched>
__device__ __noinline__ void gemm_phase_ni(PG8_LAS unsigned char* lds, Gemm g, Sched S, Epi E) { gemm_phase<Epi, Sched>(lds, g, S, E, (int)threadIdx.x); }
}

namespace mk {
using namespace pg8;
constexpr int D = 1024, NB = 32, SEQ = 2048, T = NB * SEQ, LC = 256, TC = NB * LC, TT = T + TC;
constexpr int NMOD = 6 * D;
constexpr int NE = 64, NEX = 65, DE = 256;
constexpr int NCH = 1, CHT = T / NCH, BPC = 256 / NCH;
constexpr int MAXTILES = (CHT * 8 + 64 * 255) / 256 + CHT / 256 + 1, CHROWS = MAXTILES * 256;
constexpr float RMS_EPS = 1e-6f;
constexpr int NWAVES = 8, NTHR = 512;

constexpr size_t MiB = 1u << 20;
constexpr size_t WS_CTL = 0, CTL_ZERO_BYTES = 64 * 1024;
constexpr size_t WS_MOD = 1 * MiB;
constexpr size_t WS_ROPE = 3 * MiB;
constexpr size_t WS_BC = 3 * MiB + 65536;
constexpr size_t WS_TEG = 3 * MiB + 2 * 65536;
constexpr size_t WS_GATES = 4 * MiB;
constexpr size_t WS_FILT = 10 * MiB;
constexpr size_t WS_EIDX = 18 * MiB, WS_WTS = 20 * MiB, WS_PSLOT = 22 * MiB, WS_SORT = 26 * MiB;
constexpr size_t WS_WIN0 = 30 * MiB;
constexpr size_t WS_WOUT0 = 38 * MiB, WS_WIN1 = 40 * MiB, WS_WOUT1 = 46 * MiB, WS_WR = 48 * MiB;
constexpr size_t WS_GU = 50 * MiB;
constexpr size_t WS_X8 = 116 * MiB;
constexpr size_t WS_DN = 180 * MiB;
constexpr size_t WS_BIG = 246 * MiB;
constexpr size_t WS_END = 1024 * MiB;
static_assert(WS_PSLOT + (size_t)T * 16 * 4 <= WS_SORT && WS_SORT + (size_t)NCH * CHROWS * 4 <= WS_WIN0 && WS_WIN0 + (size_t)3840 * 2048 <= WS_WOUT0 && WS_WR + (size_t)2 * 256 * 2048 <= WS_GU && WS_GU + (size_t)2 * 65 * 512 * 1024 <= WS_X8 && WS_X8 + (size_t)T * D <= WS_DN && WS_DN + (size_t)2 * 65 * 1024 * 512 <= WS_BIG, "ws map");
static_assert((size_t)CHROWS * 256 <= 160 * MiB && WS_BIG + 160 * MiB + (size_t)CHROWS * 1024 <= WS_END && (MAXTILES + 1) * 4 <= 24 * 1024, "MoE activation map");
constexpr size_t A0_H = 0, A0_QA = 144 * MiB, A0_KA = 208 * MiB, A0_VA = 280 * MiB, A0_BQ = 352 * MiB, A0_BK = 416 * MiB, A0_BV = 488 * MiB, A0_BO = 560 * MiB, A0_VT = 624 * MiB;
constexpr size_t A0_MIXIN = 0, A0_HB = 144 * MiB, A0_MIX = 352 * MiB;
constexpr int CW_BAR = 4096;

constexpr int LDS_BYTES = 160 * 1024;
constexpr int LDS_TAB = 131072;
constexpr int LDS_MISC = 131072 + 24 * 1024;

#define GAS __attribute__((address_space(1)))
#define LAS __attribute__((address_space(3)))
typedef unsigned short bf16;
typedef unsigned v4u __attribute__((ext_vector_type(4)));
typedef unsigned v2u __attribute__((ext_vector_type(2)));
#define LDS_WAIT() asm volatile("s_waitcnt lgkmcnt(0)" ::: "memory")
#define VM_WAIT() asm volatile("s_waitcnt vmcnt(0)" ::: "memory")
__device__ __forceinline__ unsigned f2bf(float f) { unsigned u = __builtin_bit_cast(unsigned, f); return (u + 0x7fffu + ((u >> 16) & 1u)) >> 16; }
typedef float f32x2_t __attribute__((ext_vector_type(2))); typedef __bf16 bf16x2_t __attribute__((ext_vector_type(2)));
__device__ __forceinline__ unsigned pk2(float lo, float hi) { const f32x2_t v = {lo, hi}; return __builtin_bit_cast(unsigned, __builtin_convertvector(v, bf16x2_t)); }
__device__ __forceinline__ float bf_lo(unsigned w) { return __builtin_bit_cast(float, w << 16); }
__device__ __forceinline__ float bf_hi(unsigned w) { return __builtin_bit_cast(float, w & 0xffff0000u); }
__device__ __forceinline__ float bf1(bf16 h) { return __builtin_bit_cast(float, (unsigned)h << 16); }
__device__ __forceinline__ int lane_opq() { int l = (int)__builtin_amdgcn_mbcnt_hi(~0u, __builtin_amdgcn_mbcnt_lo(~0u, 0u)); asm volatile("" : "+v"(l)); return l; }
__device__ __forceinline__ float shx(float v, int m) { return __builtin_bit_cast(float, __builtin_amdgcn_ds_bpermute((lane_opq() ^ m) << 2, __builtin_bit_cast(int, v))); }
__device__ __forceinline__ float shup(float v, int o) { const int l = lane_opq(); return __builtin_bit_cast(float, __builtin_amdgcn_ds_bpermute((l >= o ? l - o : l) << 2, __builtin_bit_cast(int, v))); }
__device__ __forceinline__ float shidx(float v, int idx) { return __builtin_bit_cast(float, __builtin_amdgcn_ds_bpermute(idx << 2, __builtin_bit_cast(int, v))); }
__device__ __forceinline__ float wave_sum(float v) {
#pragma unroll
    for (int o = 1; o < 64; o <<= 1) v += shx(v, o);
    return v;
}
__device__ __forceinline__ float wave_max(float v) {
#pragma unroll
    for (int o = 1; o < 64; o <<= 1) v = fmaxf(v, shx(v, o));
    return v;
}
__device__ __forceinline__ float sigmoidf_(float x) { return __builtin_amdgcn_rcpf(1.f + __expf(-x)); }
__device__ __forceinline__ float siluf_(float x) { return x * __builtin_amdgcn_rcpf(1.f + __expf(-x)); }
#define XB_TMO      128
#define XB_XCNT(j)  (256  + 64 * (j))
#define XB_XSUB(j)  (1280 + 64 * (j))
#define XB_XGEN(j)  (2304 + 64 * (j))
#define XB_TOP      3328
#define XB_TOPGEN   3392
#define XCD_BAR_WORDS 3456
#define XB_SPIN_CAP (1u << 18)

__device__ __forceinline__ unsigned xb_ld(unsigned* p)              { return __hip_atomic_load(p, __ATOMIC_RELAXED, __HIP_MEMORY_SCOPE_AGENT); }
__device__ __forceinline__ unsigned xb_add(unsigned* p, unsigned v) { return __hip_atomic_fetch_add(p, v, __ATOMIC_RELAXED, __HIP_MEMORY_SCOPE_AGENT); }
__device__ __forceinline__ unsigned xb_xcc_id() { return (unsigned)__builtin_amdgcn_s_getreg((3 << 11) | 20) & 0xFu; }
#define XB_SPIN(cond, bar) do { unsigned _sp = 0; while (cond) { __builtin_amdgcn_s_sleep(1); \
    if ((++_sp & 255u) == 0u) { if (xb_ld(&(bar)[XB_TMO])) break; if (_sp > XB_SPIN_CAP) { atomicAdd(&(bar)[XB_TMO], 1u); break; } } } } while (0)

struct XcdBarrier {
    unsigned* bar; unsigned x;
    volatile LAS unsigned* st;
};

__device__ __forceinline__ XcdBarrier xcd_barrier_post(unsigned* bar, volatile LAS unsigned* st) {
    XcdBarrier b; b.bar = bar; b.x = xb_xcc_id(); b.st = st;
    if (threadIdx.x == 0) (void)xb_add(&bar[XB_XCNT(b.x)], 1u);
    return b;
}
__device__ __forceinline__ void xcd_barrier_complete(unsigned* bar, unsigned x, unsigned& nloc, unsigned& nx) {
    const unsigned G = gridDim.x * gridDim.y * gridDim.z;
    unsigned sum, cnt, mine, sp = 0u;
    for (;;) {
        sum = 0u; cnt = 0u; mine = 0u;
#pragma unroll
        for (unsigned j = 0; j < 16; ++j) { const unsigned c = xb_ld(&bar[XB_XCNT(j)]); sum += c; cnt += (c > 0u) ? 1u : 0u; mine = (j == x) ? c : mine; }
        if (sum == G) break;
        __builtin_amdgcn_s_sleep(1);
        if ((++sp & 255u) == 0u) { if (xb_ld(&bar[XB_TMO])) break; if (sp > XB_SPIN_CAP) { atomicAdd(&bar[XB_TMO], 1u); break; } }
    }
    nloc = mine > 0u ? mine : 1u; nx = cnt > 0u ? cnt : 1u;
}

__device__ __forceinline__ void xcd_barrier(const XcdBarrier& b, const bool t0  ) {
    asm volatile("s_waitcnt vmcnt(0)" ::: "memory");
    __syncthreads();
    if (t0) {
        unsigned* bar = b.bar;
        __builtin_amdgcn_s_waitcnt(0);
        unsigned nloc = b.st[0], nx = b.st[1];
        if (nloc == 0u) { xcd_barrier_complete(bar, b.x, nloc, nx); b.st[0] = nloc; b.st[1] = nx; }
        const unsigned old = xb_add(&bar[XB_XSUB(b.x)], 1u);
        const unsigned gen = old / nloc;
        if (old + 1u == (gen + 1u) * nloc) {
            __builtin_amdgcn_fence(__ATOMIC_RELEASE, "agent");
            asm volatile("s_waitcnt vmcnt(0)" ::: "memory");
            const unsigned og = xb_add(&bar[XB_TOP], 1u);
            const unsigned tg = og / nx;
            if (og + 1u == (tg + 1u) * nx) xb_add(&bar[XB_TOPGEN], 1u);
            else XB_SPIN(xb_ld(&bar[XB_TOPGEN]) == tg, bar);
            __builtin_amdgcn_fence(__ATOMIC_ACQUIRE, "agent");
            xb_add(&bar[XB_XGEN(b.x)], 1u);
            asm volatile("s_waitcnt vmcnt(0)" ::: "memory");
        } else {
            XB_SPIN(xb_ld(&bar[XB_XGEN(b.x)]) == gen, bar);
            __builtin_amdgcn_fence(__ATOMIC_ACQUIRE, "agent");
            asm volatile("s_waitcnt vmcnt(0)" ::: "memory");
        }
    }
    __syncthreads();
}

constexpr float Y8_SCALE = 16.f, Y8_INV = 1.f / 16.f;
constexpr float X8_SCALE = 16.f, GU8_SCALE = 256.f, G1_INV = 1.f / (X8_SCALE * GU8_SCALE), ACT8_SCALE = 8.f, DN8_SCALE = 2.f, G2_INV = 1.f / (ACT8_SCALE * DN8_SCALE);
struct Params { const float* in[31]; float* out; unsigned char* ws; int ph_lo, ph_hi; };
enum { I_X = 0, I_C, I_CTX, I_CCTX, I_WMOD, I_BMOD, I_NORMG, I_WINAB, I_CONVABW, I_CONVABB, I_GATEB, I_DLAM, I_HGA, I_HGB, I_WOUTAB, I_WINHY, I_CONVHYW, I_CONVHYB,
       I_FW1, I_FB1, I_FW2, I_FB2, I_FW3, I_FBIAS, I_WOUTHY, I_RW, I_RB, I_EGU, I_EDN, I_SGU, I_SDN };

__device__ __forceinline__ void row_ld_f32(const float* row, int lane, f32x4 (&v)[4]) { const f32x4* r = (const f32x4*)row + lane;
#pragma unroll
    for (int j = 0; j < 4; ++j) v[j] = r[64 * j]; }
__device__ __forceinline__ void row_st_f32(float* row, int lane, const f32x4 (&v)[4]) { f32x4* r = (f32x4*)row + lane;
#pragma unroll
    for (int j = 0; j < 4; ++j) r[64 * j] = v[j]; }
__device__ __forceinline__ void row_ld_bf16(const bf16* row, int lane, f32x4 (&v)[4]) { const v2u* r = (const v2u*)row + lane;
#pragma unroll
    for (int j = 0; j < 4; ++j) { const v2u w = r[64 * j]; v[j] = (f32x4){bf_lo(w.x), bf_hi(w.x), bf_lo(w.y), bf_hi(w.y)}; } }
__device__ __forceinline__ void row_st_bf16(bf16* row, int lane, const f32x4 (&v)[4]) { v2u* r = (v2u*)row + lane;
#pragma unroll
    for (int j = 0; j < 4; ++j) { v2u w; w.x = pk2(v[j].x, v[j].y); w.y = pk2(v[j].z, v[j].w); r[64 * j] = w; } }
__device__ __forceinline__ unsigned fp8x4(float a, float b, float c, float d, float sc) {
    a = __builtin_amdgcn_fmed3f(a * sc, -440.f, 440.f); b = __builtin_amdgcn_fmed3f(b * sc, -440.f, 440.f); c = __builtin_amdgcn_fmed3f(c * sc, -440.f, 440.f); d = __builtin_amdgcn_fmed3f(d * sc, -440.f, 440.f);
    int w = 0; w = __builtin_amdgcn_cvt_pk_fp8_f32(a, b, w, false); w = __builtin_amdgcn_cvt_pk_fp8_f32(c, d, w, true); return (unsigned)w; }
__device__ __forceinline__ void row_st_fp8(unsigned char* row, int lane, const f32x4 (&v)[4], float sc) { unsigned* r = (unsigned*)row + lane;
#pragma unroll
    for (int j = 0; j < 4; ++j) r[64 * j] = fp8x4(v[j].x, v[j].y, v[j].z, v[j].w, sc); }
__device__ __forceinline__ float row_ss(const f32x4 (&v)[4]) { float s = 0.f;
#pragma unroll
    for (int j = 0; j < 4; ++j) s += (v[j].x * v[j].x + v[j].y * v[j].y) + (v[j].z * v[j].z + v[j].w * v[j].w);
    return wave_sum(s); }
__device__ __forceinline__ void row_modulate(const f32x4 (&x)[4], float rstd, const float* g, const float* shift, const float* scale, int lane, f32x4 (&h)[4]) {
    const f32x4* gp = (const f32x4*)g + lane; const f32x4* sh = (const f32x4*)shift + lane; const f32x4* sc = (const f32x4*)scale + lane;
#pragma unroll
    for (int j = 0; j < 4; ++j) { const f32x4 gg = gp[64 * j], s1 = sc[64 * j], s0 = sh[64 * j]; h[j] = x[j] * rstd * gg * (1.f + s1) + s0; } }

__device__ __forceinline__ void pro_mod(const Params& p, LAS unsigned char* lds, int tid, int lane, int wave) {
    const int u = blockIdx.x; if (u >= 192) return;
    LAS float* S = (LAS float*)lds;
    const float* c = p.in[I_C]; const float* cc = p.in[I_CCTX];
#pragma unroll 4
    for (int i = tid; i < 33 * 256; i += NTHR) { const int b = i >> 8, k4 = (i & 255) * 4; const f32x4 v = b < 32 ? *(const f32x4*)(c + b * 1024 + k4) : *(const f32x4*)(cc + k4);
        *(LAS f32x4*)(S + b * 1024 + k4) = (f32x4){siluf_(v[0]), siluf_(v[1]), siluf_(v[2]), siluf_(v[3])}; }
    __syncthreads();
    const int l = u / 96, cg = (u % 96) * 64, col = cg + lane;
    const float* W = p.in[I_WMOD] + (size_t)l * 1024 * NMOD;
    float acc[33];
#pragma unroll
    for (int b = 0; b < 33; ++b) acc[b] = 0.f;
    const int k0 = wave * 128;
#pragma unroll 4
    for (int kk = 0; kk < 128; kk += 4) { const int k = k0 + kk;
        const float w0 = W[(size_t)k * NMOD + col], w1 = W[(size_t)(k + 1) * NMOD + col], w2 = W[(size_t)(k + 2) * NMOD + col], w3 = W[(size_t)(k + 3) * NMOD + col];
#pragma unroll
        for (int b = 0; b < 33; ++b) { const f32x4 s = *(const LAS f32x4*)(S + b * 1024 + k); acc[b] += (s.x * w0 + s.y * w1) + (s.z * w2 + s.w * w3); } }
    __syncthreads();
    LAS float* P = (LAS float*)lds;
#pragma unroll
    for (int b = 0; b < 33; ++b) P[(wave * 33 + b) * 64 + lane] = acc[b];
    __syncthreads();
    float* MOD = (float*)(p.ws + WS_MOD);
#pragma unroll 1
    for (int i = tid; i < 33 * 64; i += NTHR) { const int b = i >> 6, ln = i & 63; float s = 0.f;
#pragma unroll
        for (int w = 0; w < 8; ++w) s += P[(w * 33 + b) * 64 + ln];
        MOD[(size_t)(l * 33 + b) * NMOD + cg + ln] = s + p.in[I_BMOD][l * NMOD + cg + ln]; }
    __syncthreads();
}
__device__ __forceinline__ int rowmap(int kind, int n) {
    if (kind == 1) { const int o = n & 31; return (n & ~31) + (((o & 15) >> 2) * 8 + (o >> 4) * 4 + (o & 3)); }
    if (kind == 2) { return n < 256 ? ((n >> 7) * 256 + (n & 127)) : ((((n - 256) >> 7) * 256) + 128 + ((n - 256) & 127)); }
    if (kind == 3) { const int a = n & 255; return (n & ~255) + 128 * ((a >> 3) & 1) + 32 * (a >> 6) + 8 * ((a >> 4) & 3) + (a & 7); }
    return n;
}
struct TrDesc { const float* W; bf16* WT; int ldn, k0, n0, nvalid, dK, kind, row_base; };
__device__ __forceinline__ TrDesc tr_decode(const Params& p, int it) {
    constexpr int I_A = 16 * 57, I_B = 256, I_C2 = 768, I_D = 256, I_E = 32, I_F = 130 * 128;
    unsigned char* ws = p.ws; int r = it;
    if (r < I_A) { const int kb = r / 57, nb = r % 57, n0 = nb * 64; const int kind = (n0 < 512 || (n0 >= 1536 && n0 < 2048)) ? 1 : 0;
        return TrDesc{p.in[I_WINAB], (bf16*)(ws + WS_WIN0), 3600, kb * 64, n0, 3600, 1024, kind, 0}; } r -= I_A;
    if (r < I_B) return TrDesc{p.in[I_WOUTAB], (bf16*)(ws + WS_WOUT0), 1024, (r / 16) * 64, (r % 16) * 64, 1024, 1024, 0, 0}; r -= I_B;
    if (r < I_C2) return TrDesc{p.in[I_WINHY], (bf16*)(ws + WS_WIN1), 3072, (r / 48) * 64, (r % 48) * 64, 3072, 1024, 0, 0}; r -= I_C2;
    if (r < I_D) return TrDesc{p.in[I_WOUTHY], (bf16*)(ws + WS_WOUT1), 1024, (r / 16) * 64, (r % 16) * 64, 1024, 1024, 0, 0}; r -= I_D;
    if (r < I_E) { const int l = r / 16, q = r % 16; return TrDesc{p.in[I_RW] + (size_t)l * 1024 * 64, (bf16*)(ws + WS_WR) + (size_t)l * 256 * 1024, 64, q * 64, 0, 64, 1024, 0, 0}; } r -= I_E;
    if (r < I_F) { const int mat = r / 128, q = r % 128, l = mat / 65, e = mat % 65;
        const float* src = e < 64 ? p.in[I_EGU] + (size_t)(l * 64 + e) * 1024 * 512 : p.in[I_SGU] + (size_t)l * 1024 * 512;
        return TrDesc{src, (bf16*)(ws + WS_GU + (size_t)l * (65 * 512) * 1024), 512, (q / 8) * 64, (q % 8) * 64, 512, 1024, 2, e * 512}; } r -= I_F;
    { const int mat = r / 64, q = r % 64, l = mat / 65, e = mat % 65;
        const float* src = e < 64 ? p.in[I_EDN] + (size_t)(l * 64 + e) * 256 * 1024 : p.in[I_SDN] + (size_t)l * 256 * 1024;
        return TrDesc{src, (bf16*)(ws + WS_DN + (size_t)l * (65 * 1024) * 256), 1024, (q / 16) * 64, (q % 16) * 64, 1024, 256, 3, e * 1024}; }
}
__device__ __forceinline__ void tr_load(const TrDesc& d, int lane, float (&v)[64]) {
    const int nn = d.n0 + lane; const bool ok = nn < d.nvalid; const float* src = d.W + (size_t)d.k0 * d.ldn + (ok ? nn : 0);
#pragma unroll
    for (int i = 0; i < 64; ++i) v[i] = src[(size_t)i * d.ldn];
    if (!ok) {
#pragma unroll
        for (int i = 0; i < 64; ++i) v[i] = 0.f; }
}
__device__ __forceinline__ void tr_finish(const TrDesc& d, const float (&v)[64], LAS float* scr, int lane) {
#pragma unroll
    for (int i = 0; i < 64; ++i) scr[i * 65 + lane] = v[i];
    LDS_WAIT(); asm volatile("" ::: "memory");
    const int c = lane & 7;
#pragma unroll
    for (int j = 0; j < 8; ++j) { const int n = (lane >> 3) + 8 * j; const LAS float* s = scr + (8 * c) * 65 + n;
        const int row = d.row_base + rowmap(d.kind, d.n0 + n);
        if (d.kind >= 2) { const float ws_ = d.kind == 2 ? GU8_SCALE : DN8_SCALE; v2u o; o.x = fp8x4(s[0 * 65], s[1 * 65], s[2 * 65], s[3 * 65], ws_); o.y = fp8x4(s[4 * 65], s[5 * 65], s[6 * 65], s[7 * 65], ws_);
            *(v2u*)((unsigned char*)d.WT + (size_t)row * d.dK + d.k0 + 8 * c) = o; }
        else { v4u o; o.x = pk2(s[0 * 65], s[1 * 65]); o.y = pk2(s[2 * 65], s[3 * 65]); o.z = pk2(s[4 * 65], s[5 * 65]); o.w = pk2(s[6 * 65], s[7 * 65]);
            *(v4u*)(d.WT + (size_t)row * d.dK + d.k0 + 8 * c) = o; } }
    LDS_WAIT(); asm volatile("" ::: "memory");
}
__device__ __forceinline__ void pro_transposes(const Params& p, LAS unsigned char* lds, int lane, int wave) {
    LAS float* scr = (LAS float*)(lds + wave * 16640);
    const int gw = blockIdx.x * NWAVES + wave, NGW = gridDim.x * NWAVES;
    constexpr int NITEMS = 16 * 57 + 256 + 768 + 256 + 32 + 130 * 128 + 130 * 64;
    if (gw >= NITEMS) return;
    TrDesc dc = tr_decode(p, gw); float vc[64]; tr_load(dc, lane, vc);
#pragma unroll 1
    for (int it = gw; it < NITEMS; it += NGW) {
        const bool more = it + NGW < NITEMS; TrDesc dn = dc; float vn[64];
        if (more) { dn = tr_decode(p, it + NGW); tr_load(dn, lane, vn); }
        tr_finish(dc, vc, scr, lane);
        if (more) { dc = dn;
#pragma unroll
            for (int i = 0; i < 64; ++i) vc[i] = vn[i]; }
    }
}
__device__ __forceinline__ void pro_rope(const Params& p, int tid) {
    if (blockIdx.x != 255) return;
    float* R = (float*)(p.ws + WS_ROPE);
    for (int i = tid; i < 64 * 16; i += NTHR) { const int pos = i >> 4, f = i & 15; const float inv = exp2f(-(float)f * (13.287712379549449f / 16.f)); const float ang = (float)pos * inv;
        float sn, cs; sincosf(ang, &sn, &cs); R[2 * i] = cs; R[2 * i + 1] = sn; }
}
__device__ __forceinline__ void pro_filters(const Params& p, LAS unsigned char* lds, int tid, int lane, int wave) {
    LAS float* Z = (LAS float*)lds;
    LAS float* H1 = Z + 512;
    LAS float* H2 = H1 + 512;
    const int j0 = 8 * blockIdx.x, j = j0 + wave;
    const float* fw1 = p.in[I_FW1]; const float* fb1 = p.in[I_FB1]; const float* fw2 = p.in[I_FW2]; const float* fb2 = p.in[I_FB2]; const float* fw3 = p.in[I_FW3];
    {   float z = 0.f;
        if (lane == 0) z = (float)j / 2047.f;
        else if (lane < 33) { const int k = (lane - 1) & 15; const float fr = 1e-4f + (float)k * ((15.f - 1e-4f) / 15.f); const float ang = (6.283185307179586f / 2048.f) * (float)j * fr;
            float sn, cs; sincosf(ang, &sn, &cs); z = lane < 17 ? cs : -sn; }
        Z[wave * 64 + lane] = z; }
    LDS_WAIT(); asm volatile("" ::: "memory");
    {   float a = fb1[lane];
#pragma unroll 11
        for (int k = 0; k < 33; ++k) a += Z[wave * 64 + k] * fw1[k * 64 + lane];
        H1[wave * 64 + lane] = sinf(a); }
    LDS_WAIT(); asm volatile("" ::: "memory");
    {   float a = fb2[lane];
#pragma unroll 16
        for (int k = 0; k < 64; ++k) a += H1[wave * 64 + k] * fw2[k * 64 + lane];
        H2[wave * 64 + lane] = sinf(a); }
    __syncthreads();
    bf16* F = (bf16*)(p.ws + WS_FILT);
    const float mind = -4.605170185988091f / 1.5f, maxd = -4.605170185988091f / 0.3f;
#pragma unroll 1
    for (int i = 0; i < 4; ++i) { const int n = tid + NTHR * i, c = n & 1023;
        float acc[8];
#pragma unroll
        for (int q = 0; q < 8; ++q) acc[q] = 0.f;
#pragma unroll 16
        for (int k = 0; k < 64; ++k) { const float w = fw3[k * 2048 + n];
#pragma unroll
            for (int q = 0; q < 8; ++q) acc[q] += H2[q * 64 + k] * w; }
        const float delta = fabsf(mind + (float)c * ((maxd - mind) / 1023.f));
        float o[8];
#pragma unroll
        for (int q = 0; q < 8; ++q) { const float dist = fabsf((float)(j0 + q) - 1024.f) * (1.f / 1024.f); o[q] = acc[q] * expf(-dist * delta); }
        v4u w; w.x = pk2(o[0], o[1]); w.y = pk2(o[2], o[3]); w.z = pk2(o[4], o[5]); w.w = pk2(o[6], o[7]);
        *(v4u*)(F + (size_t)n * 2048 + j0) = w; }
    __syncthreads();
}

__device__ __forceinline__ void l0_norm_rows(const float* src, bf16* dst, int nrows, const float* g, const float* md, int lane) {
    f32x4 vb[4], vc[4];
#pragma unroll
    for (int j = 0; j < 4; ++j) { const int o = 4 * lane + 256 * j; vb[j] = *(const f32x4*)(g + o) * (1.f + *(const f32x4*)(md + D + o)); vc[j] = *(const f32x4*)(md + o); }
    f32x4 xn[4]; row_ld_f32(src, lane, xn);
#pragma unroll 1
    for (int i = 0; i < nrows; ++i) { f32x4 x[4], h[4];
#pragma unroll
        for (int j = 0; j < 4; ++j) x[j] = xn[j];
        if (i + 1 < nrows) row_ld_f32(src + (size_t)(i + 1) * D, lane, xn);
        const float rstd = rsqrtf(row_ss(x) * (1.f / D) + RMS_EPS);
#pragma unroll
        for (int j = 0; j < 4; ++j) h[j] = x[j] * rstd * vb[j] + vc[j];
        row_st_bf16(dst + (size_t)i * D, lane, h); }
}
__device__ __forceinline__ void ph_l0_norm(const Params& p, int lane, int wave) {
    const int gw = blockIdx.x * NWAVES + wave;
    const float* MOD = (const float*)(p.ws + WS_MOD); bf16* H = (bf16*)(p.ws + WS_BIG + A0_H);
    const float* g = p.in[I_NORMG];
    { const int m0 = gw * 32; l0_norm_rows(p.in[I_X] + (size_t)m0 * D, H + (size_t)m0 * D, 32, g, MOD + (size_t)(m0 >> 11) * NMOD, lane); }
    { const int m0 = gw * 4; l0_norm_rows(p.in[I_CTX] + (size_t)m0 * D, H + (size_t)(T + m0) * D, 4, g, MOD + (size_t)32 * NMOD, lane); }
}
__device__ __forceinline__ void ph_mid(const Params& p, int l, const bf16* MIX, bf16* H2, unsigned char* X8, bool has_mix, int lane, int wave, int tile) {
    const int gw = tile * NWAVES + wave;
    const float* MOD = (const float*)(p.ws + WS_MOD) + (size_t)l * 33 * NMOD;
    const float* g1 = p.in[I_NORMG] + (size_t)(l * 4 + 1) * D; const float* g2 = p.in[I_NORMG] + (size_t)(l * 4 + 2) * D;
    const float* xin = p.in[I_X]; bf16* XR = (bf16*)p.out;
    const int m0 = gw * 32; const float* md = MOD + (size_t)(m0 >> 11) * NMOD;
    f32x4 va[4], vb[4], vc[4];
#pragma unroll
    for (int j = 0; j < 4; ++j) { const int o = 4 * lane + 256 * j; va[j] = *(const f32x4*)(md + 2 * D + o) * *(const f32x4*)(g1 + o); vb[j] = *(const f32x4*)(g2 + o) * (1.f + *(const f32x4*)(md + 4 * D + o)); vc[j] = *(const f32x4*)(md + 3 * D + o); }
    f32x4 xn[4], mn[4];
    if (l == 0) row_ld_f32(xin + (size_t)m0 * D, lane, xn); else row_ld_bf16(XR + (size_t)m0 * (2 * D), lane, xn);
    if (has_mix) row_ld_bf16(MIX + (size_t)m0 * D, lane, mn);
#pragma unroll 1
    for (int m = m0; m < m0 + 32; ++m) {
        f32x4 x[4], h[4], mx[4];
#pragma unroll
        for (int j = 0; j < 4; ++j) { x[j] = xn[j]; mx[j] = mn[j]; }
        if (m + 1 < m0 + 32) { if (l == 0) row_ld_f32(xin + (size_t)(m + 1) * D, lane, xn); else row_ld_bf16(XR + (size_t)(m + 1) * (2 * D), lane, xn);
                               if (has_mix) row_ld_bf16(MIX + (size_t)(m + 1) * D, lane, mn); }
        if (has_mix) { const float r = rsqrtf(row_ss(mx) * (1.f / D) + RMS_EPS);
#pragma unroll
            for (int j = 0; j < 4; ++j) x[j] = x[j] + va[j] * (mx[j] * r); }
        row_st_bf16(XR + (size_t)m * (2 * D), lane, x);
        const float rstd = rsqrtf(row_ss(x) * (1.f / D) + RMS_EPS);
#pragma unroll
        for (int j = 0; j < 4; ++j) h[j] = x[j] * rstd * vb[j] + vc[j];
        row_st_bf16(H2 + (size_t)m * D, lane, h);
        row_st_fp8(X8 + (size_t)m * D, lane, h, X8_SCALE);
    }
}
__device__ __forceinline__ void ph_combine(const Params& p, int l, int ch, const unsigned char* Y8, bf16* Hn, int lane, int wave) {
    const int gw = blockIdx.x * NWAVES + wave;
    const float* MOD = (const float*)(p.ws + WS_MOD) + (size_t)l * 33 * NMOD;
    const float* g3 = p.in[I_NORMG] + (size_t)(l * 4 + 3) * D;
    const int* PSLOT = (const int*)(p.ws + WS_PSLOT); const float* WTS = (const float*)(p.ws + WS_WTS);
    constexpr int RPW = CHT / 2048;
    const int mbase = ch * CHT + gw * RPW; const float* md = MOD + (size_t)(mbase >> 11) * NMOD;
    float va[16], vb[16], vc[16];
    { const float* md1 = MOD + (size_t)(33 + (mbase >> 11)) * NMOD; const float* g10 = p.in[I_NORMG] + (size_t)4 * D;
#pragma unroll
      for (int q = 0; q < 4; ++q) { const int o = lane * 16 + 4 * q; const f32x4 gp = *(const f32x4*)(g3 + o), gf = *(const f32x4*)(md + 5 * D + o); f32x4 gg = gp, sh = gp, sc = gp;
          if (l == 0) { gg = *(const f32x4*)(g10 + o); sh = *(const f32x4*)(md1 + o); sc = *(const f32x4*)(md1 + D + o); }
#pragma unroll
          for (int j = 0; j < 4; ++j) { va[4 * q + j] = gp[j] * gf[j]; vb[4 * q + j] = gg[j] * (1.f + sc[j]); vc[4 * q + j] = sh[j]; } } }
    int sl[9]; float wk[9];
#define CMB_SLOTS(mt) do { _Pragma("unroll") for (int k = 0; k < 9; ++k) { sl[k] = PSLOT[(size_t)(mt) * 16 + k]; wk[k] = k < 8 ? WTS[(size_t)(mt) * 8 + k] : 1.f; } } while (0)
    CMB_SLOTS(mbase);
#pragma unroll 1
    for (int m = mbase; m < mbase + RPW; ++m) {
        float a[16];
#pragma unroll
        for (int j = 0; j < 16; ++j) a[j] = 0.f;
        u32x4 yr[9]; float wc[9];
#pragma unroll
        for (int k = 0; k < 9; ++k) { yr[k] = *(const u32x4*)(Y8 + (size_t)sl[k] * 1024 + lane * 16); wc[k] = wk[k]; }
        float* orow = p.out + (size_t)m * D + lane * 16; bf16* xrow = (bf16*)p.out + (size_t)m * (2 * D) + lane * 16; f32x4 xv4[4];
        { const v4u x0 = *(const v4u*)xrow, x1 = *(const v4u*)(xrow + 8);
          xv4[0] = (f32x4){bf_lo(x0.x), bf_hi(x0.x), bf_lo(x0.y), bf_hi(x0.y)}; xv4[1] = (f32x4){bf_lo(x0.z), bf_hi(x0.z), bf_lo(x0.w), bf_hi(x0.w)};
          xv4[2] = (f32x4){bf_lo(x1.x), bf_hi(x1.x), bf_lo(x1.y), bf_hi(x1.y)}; xv4[3] = (f32x4){bf_lo(x1.z), bf_hi(x1.z), bf_lo(x1.w), bf_hi(x1.w)}; }
        if (m + 1 < mbase + RPW) CMB_SLOTS(m + 1);
#pragma unroll
        for (int k = 0; k < 9; ++k) { const float w = wc[k] * Y8_INV; const unsigned ww[4] = {yr[k].x, yr[k].y, yr[k].z, yr[k].w};
#pragma unroll
            for (int q = 0; q < 4; ++q) { a[4 * q + 0] += w * __builtin_amdgcn_cvt_f32_fp8((int)ww[q], 0); a[4 * q + 1] += w * __builtin_amdgcn_cvt_f32_fp8((int)ww[q], 1);
                                          a[4 * q + 2] += w * __builtin_amdgcn_cvt_f32_fp8((int)ww[q], 2); a[4 * q + 3] += w * __builtin_amdgcn_cvt_f32_fp8((int)ww[q], 3); } }
        float ss = 0.f;
#pragma unroll
        for (int j = 0; j < 16; ++j) ss += a[j] * a[j];
        const float r = rsqrtf(wave_sum(ss) * (1.f / D) + RMS_EPS);
        float x[16]; float s2 = 0.f;
#pragma unroll
        for (int q = 0; q < 4; ++q) {
#pragma unroll
            for (int j = 0; j < 4; ++j) { const float v = xv4[q][j] + va[4 * q + j] * (a[4 * q + j] * r); x[4 * q + j] = v; s2 += v * v; }
            if (l == 1) *(f32x4*)(orow + 4 * q) = (f32x4){x[4 * q], x[4 * q + 1], x[4 * q + 2], x[4 * q + 3]}; }
        if (l == 0) { v4u w0, w1; w0.x = pk2(x[0], x[1]); w0.y = pk2(x[2], x[3]); w0.z = pk2(x[4], x[5]); w0.w = pk2(x[6], x[7]); w1.x = pk2(x[8], x[9]); w1.y = pk2(x[10], x[11]); w1.z = pk2(x[12], x[13]); w1.w = pk2(x[14], x[15]);
            *(v4u*)xrow = w0; *(v4u*)(xrow + 8) = w1; }
        if (l == 0) { const float rstd = rsqrtf(wave_sum(s2) * (1.f / D) + RMS_EPS); float h[16];
#pragma unroll
            for (int j = 0; j < 16; ++j) h[j] = x[j] * rstd * vb[j] + vc[j];
            v4u w0, w1; w0.x = pk2(h[0], h[1]); w0.y = pk2(h[2], h[3]); w0.z = pk2(h[4], h[5]); w0.w = pk2(h[6], h[7]); w1.x = pk2(h[8], h[9]); w1.y = pk2(h[10], h[11]); w1.z = pk2(h[12], h[13]); w1.w = pk2(h[14], h[15]);
            *(v4u*)(Hn + (size_t)m * D + lane * 16) = w0; *(v4u*)(Hn + (size_t)m * D + lane * 16 + 8) = w1; }
    }
#undef CMB_SLOTS
}

struct DenseSched { int NN, NU, G, c, NMs;
    __device__ __forceinline__ bool next(int i, Unit& u) const { const int L = i * G + c; if (L >= NU) return false; if (NMs > 0) { u.pm = L % NMs; u.pn = L / NMs; } else { u.pm = L / NN; u.pn = L % NN; } return true; }
    __device__ __forceinline__ int arow(int r) const { return r; }
    __device__ __forceinline__ bool narrow(const Unit&) const { return false; }
    __device__ __forceinline__ void* probe_ts() const { return nullptr; } };
struct Inproj1Sched { int c;
    __device__ __forceinline__ bool next(int i, Unit& u) const { if (i >= 12) return false; u.pm = 4 * (i % 3) + (c & 3); u.pn = 64 * (i / 3) + (c >> 2); return true; }
    __device__ __forceinline__ int arow(int r) const { return r; }
    __device__ __forceinline__ bool narrow(const Unit&) const { return false; }
    __device__ __forceinline__ void* probe_ts() const { return nullptr; } };
struct PanelSched { int NN, pm;
    __device__ __forceinline__ bool next(int i, Unit& u) const { if (i >= NN) return false; u.pm = pm; u.pn = i; return true; }
    __device__ __forceinline__ int arow(int r) const { return r; }
    __device__ __forceinline__ bool narrow(const Unit&) const { return false; }
    __device__ __forceinline__ void* probe_ts() const { return nullptr; } };
struct EpiBf16 { static constexpr bool PERM = true, AFTER_DRAIN = false, PROBE = false, NARROW = false, TOKPERM = false; bf16* O; size_t ldc; int cmask;
    __device__ __forceinline__ void operator()(const f32x4 (&acc)[2][2][4][2], const Unit& u, int wr, int wc, int fr, int fq) const {
        const int row0 = u.pm * BM + wr * 64 + fr, col0 = (u.pn & cmask) * BM + wc * 32 + 8 * fq;
#pragma unroll
        for (int ai = 0; ai < 2; ++ai)
#pragma unroll
            for (int m = 0; m < 4; ++m) { bf16* rowp = O + (size_t)(row0 + ai * HALF + m * 16) * ldc + col0;
#pragma unroll
                for (int bj = 0; bj < 2; ++bj) { const f32x4 v0 = acc[ai][bj][m][0], v1 = acc[ai][bj][m][1];
                    u32x4 w; w.x = cvt_pk_bf16(v0[0], v0[1]); w.y = cvt_pk_bf16(v0[2], v0[3]); w.z = cvt_pk_bf16(v1[0], v1[1]); w.w = cvt_pk_bf16(v1[2], v1[3]);
                    *(u32x4*)(rowp + bj * HALF) = w; } }
    } };
struct EpiBf16T { static constexpr bool PERM = true, AFTER_DRAIN = false, PROBE = false, NARROW = false, TOKPERM = true; bf16* O; size_t ldc;
    __device__ __forceinline__ void operator()(const f32x4 (&acc)[2][2][4][2], const Unit& u, int wr, int wc, int fr, int fq) const {
        const int odd = fr & 1, rowA = u.pm * BM + wr * 64 + (fr & ~1), col0 = u.pn * BM + wc * 64 + 16 * fq + 8 * odd;
#pragma unroll
        for (int ai = 0; ai < 2; ++ai)
#pragma unroll
            for (int m = 0; m < 4; ++m) { bf16* rowp = O + (size_t)(rowA + ai * HALF + m * 16) * ldc + col0;
                const f32x4 a0 = acc[ai][0][m][0], a1 = acc[ai][0][m][1], b0 = acc[ai][1][m][0], b1 = acc[ai][1][m][1];
                u32x4 w0, w1; w0.x = cvt_pk_bf16(a0[0], a0[1]); w0.y = cvt_pk_bf16(a0[2], a0[3]); w0.z = cvt_pk_bf16(a1[0], a1[1]); w0.w = cvt_pk_bf16(a1[2], a1[3]);
                w1.x = cvt_pk_bf16(b0[0], b0[1]); w1.y = cvt_pk_bf16(b0[2], b0[3]); w1.z = cvt_pk_bf16(b1[0], b1[1]); w1.w = cvt_pk_bf16(b1[2], b1[3]);
                const u32x4 snd = odd ? w0 : w1; u32x4 rcv;
                rcv.x = (unsigned)__builtin_amdgcn_mov_dpp((int)snd.x, 0xB1, 0xf, 0xf, true); rcv.y = (unsigned)__builtin_amdgcn_mov_dpp((int)snd.y, 0xB1, 0xf, 0xf, true);
                rcv.z = (unsigned)__builtin_amdgcn_mov_dpp((int)snd.z, 0xB1, 0xf, 0xf, true); rcv.w = (unsigned)__builtin_amdgcn_mov_dpp((int)snd.w, 0xB1, 0xf, 0xf, true);
                *(u32x4*)rowp = odd ? rcv : w0;
                *(u32x4*)(rowp + ldc) = odd ? w1 : rcv; }
    } };
struct EpiRouter { static constexpr bool PERM = false, AFTER_DRAIN = false, PROBE = false, NARROW = false, TOKPERM = false; float* LOG;
    __device__ __forceinline__ void operator()(const f32x4 (&acc)[2][2][4][2], const Unit& u, int wr, int wc, int fr, int fq) const {
        if (wc >= 2) return;
        const int row0 = u.pm * BM + wr * 64 + fr, col0 = wc * 32 + 4 * fq;
#pragma unroll
        for (int ai = 0; ai < 2; ++ai)
#pragma unroll
            for (int m = 0; m < 4; ++m) { float* rowp = LOG + (size_t)(row0 + ai * HALF + m * 16) * 64 + col0;
#pragma unroll
                for (int n = 0; n < 2; ++n) *(f32x4*)(rowp + n * 16) = acc[ai][0][m][n]; }
    } };
struct EpiFp8 { static constexpr bool PERM = true, AFTER_DRAIN = false, PROBE = true, NARROW = false, TOKPERM = false; unsigned char* O;
    __device__ __forceinline__ void operator()(const f32x4 (&acc)[2][2][4][2], const Unit& u, int wr, int wc, int fr, int fq) const {
        const int row0 = u.pm * BM + wr * 64 + fr, col0 = (u.pn & 3) * BM + wc * 64 + 16 * fq;
#pragma unroll
        for (int ai = 0; ai < 2; ++ai)
#pragma unroll
            for (int m = 0; m < 4; ++m) { unsigned char* rowp = O + (size_t)(row0 + ai * HALF + m * 16) * 1024 + col0; u32x4 w;
#pragma unroll
                for (int bj = 0; bj < 2; ++bj) { f32x4 v0 = acc[ai][bj][m][0], v1 = acc[ai][bj][m][1]; static_assert(Y8_SCALE * G2_INV == 1.f, "scales"); int lo = 0, hi = 0;
#pragma unroll
                    for (int j = 0; j < 4; ++j) { v0[j] = __builtin_amdgcn_fmed3f(v0[j], -440.f, 440.f); v1[j] = __builtin_amdgcn_fmed3f(v1[j], -440.f, 440.f); }
                    lo = __builtin_amdgcn_cvt_pk_fp8_f32(v0[0], v0[1], lo, false); lo = __builtin_amdgcn_cvt_pk_fp8_f32(v0[2], v0[3], lo, true);
                    hi = __builtin_amdgcn_cvt_pk_fp8_f32(v1[0], v1[1], hi, false); hi = __builtin_amdgcn_cvt_pk_fp8_f32(v1[2], v1[3], hi, true);
                    if (bj == 0) { w.x = (unsigned)lo; w.y = (unsigned)hi; } else { w.z = (unsigned)lo; w.w = (unsigned)hi; } }
                *(u32x4*)rowp = w; }
    } };
struct EpiRouterLds { static constexpr bool PERM = false, AFTER_DRAIN = true, PROBE = false, NARROW = true  , TOKPERM = false;
    __device__ __forceinline__ void operator()(const f32x4 (&)[2][2][4][2], const Unit&, int, int, int, int) const {}
    __device__ __forceinline__ void fused(const f32x4 (&acc)[2][2][4][2], const Unit&, int wr, int wc, int fr, int fq, LAS unsigned char* lds) const {
        if (wc >= 2) return;
        LAS float* SC = (LAS float*)lds;
#pragma unroll
        for (int ai = 0; ai < 2; ++ai)
#pragma unroll
            for (int m = 0; m < 4; ++m) { const int row = ai * HALF + wr * 64 + m * 16 + fr;
#pragma unroll
                for (int n = 0; n < 2; ++n)
#pragma unroll
                    for (int j = 0; j < 4; ++j) SC[row * 65 + wc * 32 + n * 16 + 4 * fq + j] = sigmoidf_(acc[ai][0][m][n][j]); }
    } };
struct MoeSched { const LAS int* te; const int* sort; int NU, G, c, sh, per;
    __device__ __forceinline__ bool next(int i, Unit& u) const { const int L = i * G + c; if (L >= NU) return false; const int tile = L >> sh; u.pm = tile; u.pn = te[tile] * per + (L & (per - 1)); return true; }
    __device__ __forceinline__ int arow(int r) const { return sort ? sort[r] : r; }
    __device__ __forceinline__ bool narrow(const Unit&) const { return false; }
    void* pts; __device__ __forceinline__ void* probe_ts() const { return pts; } };
struct EpiSwiglu { static constexpr bool PERM = true, AFTER_DRAIN = false, PROBE = false, NARROW = false, TOKPERM = false; unsigned char* ACT;
    __device__ __forceinline__ void operator()(const f32x4 (&acc)[2][2][4][2], const Unit& u, int wr, int wc, int fr, int fq) const {
        const int row0 = u.pm * BM + wr * 64 + fr, col0 = (u.pn & 1) * 128 + wc * 32 + 8 * fq;
#pragma unroll
        for (int ai = 0; ai < 2; ++ai)
#pragma unroll
            for (int m = 0; m < 4; ++m) { unsigned char* rowp = ACT + (size_t)(row0 + ai * HALF + m * 16) * DE + col0;
                const f32x4 g0 = acc[ai][0][m][0], g1 = acc[ai][0][m][1], u0 = acc[ai][1][m][0], u1 = acc[ai][1][m][1];
                float o[8];
#pragma unroll
                for (int q = 0; q < 4; ++q) {
                    o[q] = (g0[q] * u0[q]) * (G1_INV * G1_INV * ACT8_SCALE) * __builtin_amdgcn_rcpf(1.f + __builtin_amdgcn_exp2f(g0[q] * (-G1_INV * 1.44269504f)));
                    o[4 + q] = (g1[q] * u1[q]) * (G1_INV * G1_INV * ACT8_SCALE) * __builtin_amdgcn_rcpf(1.f + __builtin_amdgcn_exp2f(g1[q] * (-G1_INV * 1.44269504f))); }
                u32x2 w; w.x = fp8x4(o[0], o[1], o[2], o[3], 1.f); w.y = fp8x4(o[4], o[5], o[6], o[7], 1.f);
                *(u32x2*)rowp = w; }
    } };
__device__ __forceinline__ int moe_tables(const Params& p, int ch, LAS unsigned char* lds, int tid) {
    LAS int* TE = (LAS int*)(lds + LDS_TAB);
    const int* TEG = (const int*)(p.ws + WS_TEG) + (size_t)ch * (MAXTILES + 64);
    __syncthreads();
    constexpr int NIT = (MAXTILES + NTHR) / NTHR; int v[NIT];
#pragma unroll
    for (int k = 0; k < NIT; ++k) { const int i = tid + k * NTHR; v[k] = i <= MAXTILES ? TEG[i] : 0; }
#pragma unroll
    for (int k = 0; k < NIT; ++k) { const int i = tid + k * NTHR; if (i <= MAXTILES) TE[i] = v[k]; }
    __syncthreads();
    return TE[MAXTILES];
}

__device__ __forceinline__ void ph_route_a(const Params& p, int l, const float* LOG, int tile, LAS unsigned char* lds, int tid) {
    LAS float* SC = (LAS float*)lds;
    LAS float* RBs = (LAS float*)(lds + 68 * 1024);
    LAS unsigned* MASK = (LAS unsigned*)(lds + 69 * 1024);
    const int b = tile, tok0 = 256 * b;
    if (LOG)
#pragma unroll 1
    for (int i = tid; i < 256 * 64; i += NTHR) { const int t = i >> 6, e = i & 63; SC[t * 65 + e] = sigmoidf_(LOG[(size_t)(tok0 + t) * 64 + e]); }
    if (tid < 64) RBs[tid] = p.in[I_RB][l * 64 + tid];
    MASK[tid] = 0u;
    __syncthreads();
    int eidx[8]; float wts[8];
    if (tid < 256) { const int t = tid; const LAS float* sc = SC + t * 65;
        float gs[8], bv[64];
#pragma unroll
        for (int g = 0; g < 8; ++g) { float m1 = -3.0e38f, m2 = -3.0e38f;
#pragma unroll
            for (int j = 0; j < 8; ++j) { const float v = sc[8 * g + j] + RBs[8 * g + j]; bv[8 * g + j] = v; if (v > m1) { m2 = m1; m1 = v; } else if (v > m2) m2 = v; }
            gs[g] = m1 + m2; }
        unsigned gmask = 0u;
#pragma unroll
        for (int r = 0; r < 4; ++r) { float best = -3.0e38f; int bi = 0; bool found = false;
#pragma unroll
            for (int g = 0; g < 8; ++g) { const bool free_ = ((gmask >> g) & 1u) == 0u; if (free_ && (!found || gs[g] > best)) { best = gs[g]; bi = g; found = true; } }
            gmask |= 1u << bi; }
#pragma unroll
        for (int e = 0; e < 64; ++e) if (((gmask >> (e >> 3)) & 1u) == 0u) bv[e] = -3.0e38f;
        unsigned long long taken = 0ull; float ssum = 0.f;
#pragma unroll
        for (int k = 0; k < 8; ++k) { float best = -3.0e38f; int be = 0; bool found = false;
#pragma unroll
            for (int e = 0; e < 64; ++e) { const bool ok = ((taken >> e) & 1ull) == 0ull; if (ok && (!found || bv[e] > best)) { best = bv[e]; be = e; found = true; } }
            taken |= 1ull << be; eidx[k] = be; wts[k] = sc[be]; ssum += wts[k]; }
        const float inv = 2.5f / ssum;
#pragma unroll
        for (int k = 0; k < 8; ++k) { wts[k] *= inv; __hip_atomic_fetch_or(&MASK[eidx[k] * 8 + (t >> 5)], 1u << (t & 31), __ATOMIC_RELAXED, __HIP_MEMORY_SCOPE_WORKGROUP); }
    }
    __syncthreads();
    if (tid < 256) { const int t = tid; int* EIDX = (int*)(p.ws + WS_EIDX); float* WTS = (float*)(p.ws + WS_WTS);
#pragma unroll
        for (int k = 0; k < 8; ++k) { const int e = eidx[k]; int r = 0;
#pragma unroll 1
            for (int w = 0; w < (t >> 5); ++w) r += __popc(MASK[e * 8 + w]);
            r += __popc(MASK[e * 8 + (t >> 5)] & ((1u << (t & 31)) - 1u));
            EIDX[(size_t)(tok0 + t) * 8 + k] = e | (r << 8); WTS[(size_t)(tok0 + t) * 8 + k] = wts[k]; } }
    if (tid < 64) { int c = 0;
#pragma unroll
        for (int w = 0; w < 8; ++w) c += __popc(MASK[tid * 8 + w]);
        ((int*)(p.ws + WS_BC))[b * 64 + tid] = c; }
    __syncthreads();
}
__device__ __forceinline__ void ph_route_b(const Params& p, LAS unsigned char* lds, int tid) {
    LAS int* BCS = (LAS int*)lds;
    LAS int* CNT = BCS + BPC * 64; LAS int* PRE = CNT + 64; LAS int* SEG = PRE + 64;
    const int b = blockIdx.x, ch = b / BPC, bl = b % BPC;
    const int* BC = (const int*)(p.ws + WS_BC) + (size_t)ch * BPC * 64;
#pragma unroll 16
    for (int i = tid; i < BPC * 64; i += NTHR) BCS[i] = BC[i];
    __syncthreads();
    if (tid < 64) { int c = 0, pr = 0;
#pragma unroll 16
        for (int i = 0; i < BPC; ++i) { const int v = BCS[i * 64 + tid]; c += v; if (i < bl) pr += v; } CNT[tid] = c; PRE[tid] = pr; }
    __syncthreads();
    if (tid == 0) { int base = 0;
#pragma unroll 1
        for (int e = 0; e < 64; ++e) { SEG[e] = base; base += ((CNT[e] + 255) >> 8) << 8; } SEG[64] = base; }
    __syncthreads();
    int* SORT = (int*)(p.ws + WS_SORT) + (size_t)ch * CHROWS; int* PSLOT = (int*)(p.ws + WS_PSLOT); const int* EIDX = (const int*)(p.ws + WS_EIDX);
    if (tid < 256) { const int tok = 256 * b + tid;
#pragma unroll
        for (int k = 0; k < 8; ++k) { const int w = EIDX[(size_t)tok * 8 + k], e = w & 255, r = w >> 8; const int slot = SEG[e] + PRE[e] + r; SORT[slot] = tok; PSLOT[(size_t)tok * 16 + k] = slot; }
        const int s8 = SEG[64] + (tok - ch * CHT); SORT[s8] = tok; PSLOT[(size_t)tok * 16 + 8] = s8; }
    if (bl == 0) {
        int* TEG = (int*)(p.ws + WS_TEG) + (size_t)ch * (MAXTILES + 64); const int NT = (SEG[64] >> 8) + CHT / 256;
#pragma unroll 1
        for (int i = tid; i < NT; i += NTHR) { const int pos = i << 8; int lo = 0, hi = 64;
#pragma unroll
            for (int st = 0; st < 7; ++st) { const int mid = (lo + hi + 1) >> 1; if (SEG[mid] <= pos) lo = mid; else hi = mid - 1; }
            TEG[i] = lo; }
        if (tid == 0) TEG[MAXTILES] = NT; }
    if (bl < 64) { const int e = bl, lo = SEG[e] + CNT[e], hi = SEG[e] + (((CNT[e] + 255) >> 8) << 8); for (int s = lo + tid; s < hi; s += NTHR) SORT[s] = ch * CHT; }
    __syncthreads();
}

typedef float f32x16 __attribute__((ext_vector_type(16)));
__device__ __forceinline__ void ph_sconv(const Params& p, const bf16* UT, bf16* UC, int tid) {
    const float* cw = p.in[I_CONVHYW]; const float* cbias = p.in[I_CONVHYB];
    const unsigned NIT = 3072u * 32u * 256u; const unsigned gt = blockIdx.x * NTHR + tid, NG = gridDim.x * NTHR;
#pragma unroll 1
    for (unsigned it = gt; it < NIT; it += NG) {
        const unsigned c = it >> 13, k = it & 255u; const size_t base = (size_t)it * 8;
        const v4u w = *(const v4u*)(UT + base);
        const float w0 = cw[c], w1 = cw[3072 + c], w2 = cw[6144 + c], bb = cbias[c];
        float x[10];
        x[0] = k > 0 ? bf1(UT[base - 1]) : 0.f; x[9] = k < 255 ? bf1(UT[base + 8]) : 0.f;
        x[1] = bf_lo(w.x); x[2] = bf_hi(w.x); x[3] = bf_lo(w.y); x[4] = bf_hi(w.y); x[5] = bf_lo(w.z); x[6] = bf_hi(w.z); x[7] = bf_lo(w.w); x[8] = bf_hi(w.w);
        float o[8];
#pragma unroll
        for (int j = 0; j < 8; ++j) o[j] = bb + w0 * x[j] + w1 * x[j + 1] + w2 * x[j + 2];
        v4u r; r.x = pk2(o[0], o[1]); r.y = pk2(o[2], o[3]); r.z = pk2(o[4], o[5]); r.w = pk2(o[6], o[7]);
        *(v4u*)(UC + base) = r;
    }
}
constexpr int LC_CPB = 8336  , LC_RAW = 8 * LC_CPB, LC_RAWSZ = 32 * 512, LC_HALO = LC_RAW + 2 * LC_RAWSZ, LC_VBP = 528, LC_VB0 = LC_HALO + 2 * 8192, LC_VBSZ = 32 * LC_VBP;
static_assert(LC_VB0 + 2 * LC_VBSZ <= LDS_MISC && 8 * 32 * 528 <= LDS_MISC, "lconv LDS map");
struct Taps { float w0, w1, w2, b; };
#ifdef LC_PROBE
#define LC_PARG , unsigned long long* lcacc
#define LC_PPASS , lcacc
#define LC_PPASS0 , lcacc
#define LC_T0 unsigned long long lct_ = __builtin_amdgcn_s_memrealtime()
#define LC_T(i) do { const unsigned long long t1_ = __builtin_amdgcn_s_memrealtime(); lcacc[i] += t1_ - lct_; lct_ = t1_; } while (0)
#else
#define LC_PARG
#define LC_PPASS
#define LC_PPASS0
#define LC_T0
#define LC_T(i)
#endif
__device__ __forceinline__ float bfh(unsigned w, int hi) { return hi ? bf_hi(w) : bf_lo(w); }
template <bool CONVIN>
__device__ __forceinline__ void lconv_unit(const bf16* vin, const Taps ti, const bf16* F, const bf16* graw, const Taps tg, float fb, bf16* out, LAS unsigned char* lds, int tid, int lane, int wave LC_PARG) {
    __syncthreads();
    LC_T0;
#define LC_DMA(ch, rb) do { _Pragma("unroll") for (int q = 0; q < 2; ++q) { const int row = wave * 4 + 2 * q + (ln >> 5); \
        __builtin_amdgcn_global_load_lds((const unsigned*)(vin + (size_t)row * 2048 + (ch) * 256 + (ln & 31) * 8), (LAS unsigned*)(lds + LC_RAW + (rb) * LC_RAWSZ + (wave * 4 + 2 * q) * 512), 16, 0, 0); } \
        { const int hrow = wave * 4 + ((ln & 7) >> 1); int hs = (ln & 1) ? (ch) * 256 + 256 : (ch) * 256 - 8; hs = hs < 0 ? 0 : (hs > 2040 ? 2040 : hs); \
          __builtin_amdgcn_global_load_lds((const unsigned*)(vin + (size_t)hrow * 2048 + hs), (LAS unsigned*)(lds + LC_HALO + (rb) * 8192 + wave * 1024), 16, 0, 0); } } while (0)
    LAS bf16* Fl = (LAS bf16*)(lds + LC_VB0 + LC_VBSZ);
    { int ln = lane; asm volatile("" : "+v"(ln)); LC_DMA(0, 0); LC_DMA(1, 1); }
    if (tid < 256) *(LAS v4u*)(Fl + tid * 8) = *(const v4u*)(F + tid * 8);
    __syncthreads();
#pragma unroll 1
    for (int mi = tid; mi < 2056; mi += NTHR) { const int m = mi * 2, xb = 3071 - m; unsigned f[9];
#pragma unroll
        for (int j = 0; j < 9; ++j) { const int x = xb + j; const bool in = x >= 0 && x <= 2047; const unsigned v = (unsigned)Fl[in ? x : 0]; f[j] = in ? v : 0u; if (x == 1024) f[j] = f2bf(bf1((bf16)f[j]) + fb); }
#pragma unroll
        for (int a = 0; a < 8; ++a) *(LAS unsigned*)(lds + a * LC_CPB + m * 2) = f[8 - a] | (f[7 - a] << 16); }
    LC_T(0);
    const int r = lane & 31, h = lane >> 5, a = (7 - r) & 7;
    const LAS unsigned char* cpA = lds + a * LC_CPB + 2 * (1023 - r + 8 * h - a + 1032) - 512 * wave;
    const int laneB = r * LC_VBP + 16 * h;
#define LC_CONVERT(ch, rb, buf) do { _Pragma("unroll") for (int q = 0; q < 2; ++q) { const int pid = ln + 64 * q, row = wave * 4 + (pid >> 5), pp = pid & 31; const LAS unsigned char* rp = lds + LC_RAW + (rb) * LC_RAWSZ + row * 512 + pp * 16; \
        const v4u w = *(const LAS v4u*)rp; v4u o = w; \
        if (CONVIN) { const LAS unsigned char* hp_ = lds + LC_HALO + (rb) * 8192 + wave * 1024 + (pid >> 5) * 32; float x[10]; \
            x[0] = pp > 0 ? bf1(*(const LAS bf16*)(rp - 2)) : ((ch) > 0 ? bf1(*(const LAS bf16*)(hp_ + 14)) : 0.f); x[9] = pp < 31 ? bf1(*(const LAS bf16*)(rp + 16)) : ((ch) < 7 ? bf1(*(const LAS bf16*)(hp_ + 16)) : 0.f); \
            x[1] = bf_lo(w.x); x[2] = bf_hi(w.x); x[3] = bf_lo(w.y); x[4] = bf_hi(w.y); x[5] = bf_lo(w.z); x[6] = bf_hi(w.z); x[7] = bf_lo(w.w); x[8] = bf_hi(w.w); \
            float y[8]; _Pragma("unroll") for (int j = 0; j < 8; ++j) y[j] = ti.b + ti.w0 * x[j] + ti.w1 * x[j + 1] + ti.w2 * x[j + 2]; \
            o.x = pk2(y[0], y[1]); o.y = pk2(y[2], y[3]); o.z = pk2(y[4], y[5]); o.w = pk2(y[6], y[7]); } \
        *(LAS v4u*)(lds + LC_VB0 + (buf) * LC_VBSZ + row * LC_VBP + pp * 16) = o; } } while (0)
    { int ln = lane; asm volatile("" : "+v"(ln));
    asm volatile("s_waitcnt vmcnt(3)" ::: "memory");
    LC_CONVERT(0, 0, 0); }
    asm volatile("s_waitcnt lgkmcnt(0)" ::: "memory"); __builtin_amdgcn_s_barrier(); asm volatile("" ::: "memory");
    LC_T(1);
    f32x16 acc[8];
#pragma unroll
    for (int i = 0; i < 8; ++i)
#pragma unroll
        for (int q = 0; q < 16; ++q) acc[i][q] = 0.f;
    bf16x8 E[8], O[8];
    bool primed = false;
#pragma unroll 1
    for (int ch = 0; ch < 8; ++ch) {
        int ln = lane; asm volatile("" : "+v"(ln));
        if (ch < 6) LC_DMA(ch + 2, ch & 1);
        if (wave < 4 && ch < 7) { if (ch < 6) asm volatile("s_waitcnt vmcnt(3)" ::: "memory"); else asm volatile("s_waitcnt vmcnt(0)" ::: "memory"); LC_CONVERT(ch + 1, (ch + 1) & 1, (ch + 1) & 1); }
        const int du = wave - ch;
        if (du >= -4 && du <= 4) {
            const LAS unsigned char* ca = cpA + 64 * (ch * 8); const LAS unsigned char* vbh = lds + LC_VB0 + (ch & 1) * LC_VBSZ + laneB;
            if (!primed) { primed = true;
#pragma unroll
                for (int i = 1; i < 8; ++i) { E[(8 - i) & 7] = *(const LAS bf16x8*)(ca + 32 * (-2 * i)); O[(8 - i) & 7] = *(const LAS bf16x8*)(ca + 32 * (-2 * i + 1)); }
                E[0] = *(const LAS bf16x8*)ca; O[0] = *(const LAS bf16x8*)(ca + 32); }
            bf16x8 bc0 = *(const LAS bf16x8*)vbh, bc1 = *(const LAS bf16x8*)(vbh + 32);
#pragma unroll
            for (int mm = 0; mm < 8; ++mm) {
                bf16x8 bn0 = bc0, bn1 = bc1;
                if (mm < 7) { bn0 = *(const LAS bf16x8*)(vbh + 64 * (mm + 1)); bn1 = *(const LAS bf16x8*)(vbh + 64 * (mm + 1) + 32); }
                __builtin_amdgcn_sched_barrier(0);
                acc[7] = __builtin_amdgcn_mfma_f32_32x32x16_bf16(E[(mm + 1) & 7], bc0, acc[7], 0, 0, 0);
                E[(mm + 1) & 7] = *(const LAS bf16x8*)(ca + 64 * (mm + 1));
#pragma unroll
                for (int i = 0; i < 7; ++i) acc[i] = __builtin_amdgcn_mfma_f32_32x32x16_bf16(E[(mm - i) & 7], bc0, acc[i], 0, 0, 0);
                acc[7] = __builtin_amdgcn_mfma_f32_32x32x16_bf16(O[(mm + 1) & 7], bc1, acc[7], 0, 0, 0);
                O[(mm + 1) & 7] = *(const LAS bf16x8*)(ca + 64 * (mm + 1) + 32);
#pragma unroll
                for (int i = 0; i < 7; ++i) acc[i] = __builtin_amdgcn_mfma_f32_32x32x16_bf16(O[(mm - i) & 7], bc1, acc[i], 0, 0, 0);
                bc0 = bn0; bc1 = bn1;
            }
        }
        if (wave >= 4 && ch < 7) { if (ch < 6) asm volatile("s_waitcnt vmcnt(3)" ::: "memory"); else asm volatile("s_waitcnt vmcnt(0)" ::: "memory"); LC_CONVERT(ch + 1, (ch + 1) & 1, (ch + 1) & 1); }
        asm volatile("s_waitcnt lgkmcnt(0)" ::: "memory"); __builtin_amdgcn_s_barrier(); asm volatile("" ::: "memory");
    }
    LC_T(2);
#undef LC_DMA
#undef LC_CONVERT
    { int le = lane; asm volatile("" : "+v"(le)); const int re = le & 31, he = le >> 5;
      LAS unsigned char* tw = lds + wave * (32 * 528);
      const int pp = le & 31;
      v4u gwa[16]; float hal[16];
      const bool hprev = pp == 0 && wave > 0, hnext = pp == 31 && wave < 7;
#pragma unroll
      for (int it = 0; it < 6; ++it) { const size_t off = (size_t)(2 * it + (le >> 5)) * 2048 + 256 * wave + pp * 8; gwa[it] = *(const v4u*)(graw + off);
          hal[it] = (hprev || hnext) ? bf1(graw[hprev ? off - 1 : off + 8]) : 0.f; }
      __builtin_amdgcn_sched_barrier(0);
#pragma unroll
      for (int i = 0; i < 8; ++i)
#pragma unroll
          for (int g = 0; g < 4; ++g) { v2u w; w.x = pk2(acc[i][4 * g + 0], acc[i][4 * g + 1]); w.y = pk2(acc[i][4 * g + 2], acc[i][4 * g + 3]); *(LAS v2u*)(tw + re * 528 + (32 * i + 8 * g + 4 * he) * 2) = w; }
      LDS_WAIT(); asm volatile("" ::: "memory");
#pragma unroll
      for (int it = 6; it < 16; ++it) { const size_t off = (size_t)(2 * it + (le >> 5)) * 2048 + 256 * wave + pp * 8; gwa[it] = *(const v4u*)(graw + off);
          hal[it] = (hprev || hnext) ? bf1(graw[hprev ? off - 1 : off + 8]) : 0.f; }
#pragma unroll
      for (int it = 0; it < 16; ++it) { const int row = 2 * it + (le >> 5); const size_t off = (size_t)row * 2048 + 256 * wave + pp * 8;
          const v4u gw = gwa[it]; const v4u aw = *(const LAS v4u*)(tw + row * 528 + pp * 16);
          const float hp = hal[it], hn = hal[it];
          float gx[10]; gx[1] = bf_lo(gw.x); gx[2] = bf_hi(gw.x); gx[3] = bf_lo(gw.y); gx[4] = bf_hi(gw.y); gx[5] = bf_lo(gw.z); gx[6] = bf_hi(gw.z); gx[7] = bf_lo(gw.w); gx[8] = bf_hi(gw.w);
          const float fromprev = shidx(gx[8], le - 1), fromnext = shidx(gx[1], le + 1);
          gx[0] = pp > 0 ? fromprev : hp; gx[9] = pp < 31 ? fromnext : hn;
          const float av[8] = {bf_lo(aw.x), bf_hi(aw.x), bf_lo(aw.y), bf_hi(aw.y), bf_lo(aw.z), bf_hi(aw.z), bf_lo(aw.w), bf_hi(aw.w)};
          float o[8];
#pragma unroll
          for (int j = 0; j < 8; ++j) o[j] = (tg.b + tg.w0 * gx[j] + tg.w1 * gx[j + 1] + tg.w2 * gx[j + 2]) * av[j];
          v4u w; w.x = pk2(o[0], o[1]); w.y = pk2(o[2], o[3]); w.z = pk2(o[4], o[5]); w.w = pk2(o[6], o[7]);
          *(v4u*)(out + off) = w; }
    }
    LC_T(3);
}
template <bool CONVIN>
__device__ __forceinline__ void ph_lconv(const Params& p, int o, const bf16* IN, const bf16* UT, bf16* OUT, LAS unsigned char* lds, int tid, int lane, int wave) {
    const bf16* FILT = (const bf16*)(p.ws + WS_FILT); const float* cw = p.in[I_CONVHYW]; const float* cbias = p.in[I_CONVHYB];
#ifdef LC_PROBE
    unsigned long long lcacc[4] = {0, 0, 0, 0};
#endif
#pragma unroll 1
    for (int c = blockIdx.x; c < 1024; c += gridDim.x) { const int gc = (1 + o) * 1024 + c;
        const Taps ti{cw[c], cw[3072 + c], cw[6144 + c], cbias[c]}, tg{cw[gc], cw[3072 + gc], cw[6144 + gc], cbias[gc]};
        lconv_unit<CONVIN>(IN + (size_t)c * T, ti, FILT + (size_t)(o * 1024 + c) * 2048, UT + (size_t)gc * T, tg, p.in[I_FBIAS][o * 1024 + c], OUT + (size_t)c * T, lds, tid, lane, wave LC_PPASS); }
#ifdef LC_PROBE
    if (o == 0 && blockIdx.x == 0 && tid == 0) { unsigned long long* ts = (unsigned long long*)(p.ws + WS_CTL + 32768); ts[50] = 0; ts[51] = lcacc[0]; ts[52] = ts[51] + lcacc[1]; ts[53] = ts[52] + lcacc[2]; ts[54] = ts[53] + lcacc[3]; }
#endif
}
__device__ __forceinline__ void ph_lconv2(const Params& p, const bf16* UT, bf16* ZT, bf16* Y2T, LAS unsigned char* lds, int tid, int lane, int wave) {
    const bf16* FILT = (const bf16*)(p.ws + WS_FILT); const float* cw = p.in[I_CONVHYW]; const float* cbias = p.in[I_CONVHYB];
#pragma unroll 1
    for (int c = blockIdx.x; c < 1024; c += gridDim.x) {
        { const int gc = 1024 + c; const Taps ti{cw[c], cw[3072 + c], cw[6144 + c], cbias[c]}, tg{cw[gc], cw[3072 + gc], cw[6144 + gc], cbias[gc]};
          lconv_unit<true>(UT + (size_t)c * T, ti, FILT + (size_t)c * 2048, UT + (size_t)gc * T, tg, p.in[I_FBIAS][c], ZT + (size_t)c * T, lds, tid, lane, wave LC_PPASS0); }
        asm volatile("s_waitcnt vmcnt(0)" ::: "memory");
        { const int gc = 2048 + c; const Taps ti{0.f, 0.f, 0.f, 0.f}, tg{cw[gc], cw[3072 + gc], cw[6144 + gc], cbias[gc]};
          lconv_unit<false>(ZT + (size_t)c * T, ti, FILT + (size_t)(1024 + c) * 2048, UT + (size_t)gc * T, tg, p.in[I_FBIAS][1024 + c], Y2T + (size_t)c * T, lds, tid, lane, wave LC_PPASS0); }
        asm volatile("s_waitcnt vmcnt(0)" ::: "memory"); }
}
__device__ __forceinline__ void ph_transpose(const bf16* Y2T, bf16* Y2, LAS unsigned char* lds, int lane, int wave, int panel) {
    LAS unsigned char* tl = lds + wave * 16384;
    v4u cur[8], nxt[8];
#define TP_LOAD(dst, tile_) do { const int c0_ = ((tile_) & 15) * 64, t0_ = panel * 256 + ((tile_) >> 4) * 64; _Pragma("unroll") for (int rr = 0; rr < 8; ++rr) \
        dst[rr] = *(const v4u*)(Y2T + (size_t)(c0_ + rr * 8 + (lane >> 3)) * T + t0_ + (lane & 7) * 8); } while (0)
    TP_LOAD(cur, wave);
#pragma unroll 1
    for (int tile = wave; tile < 64; tile += NWAVES) { const int c0 = (tile & 15) * 64, t0 = panel * 256 + (tile >> 4) * 64;
        if (tile + NWAVES < 64) TP_LOAD(nxt, tile + NWAVES);
#pragma unroll
        for (int rr = 0; rr < 8; ++rr) { LAS unsigned* d = (LAS unsigned*)(tl + (rr * 8 + (lane >> 3)) * 132 + (lane & 7) * 16); d[0] = cur[rr].x; d[1] = cur[rr].y; d[2] = cur[rr].z; d[3] = cur[rr].w; }
        LDS_WAIT(); asm volatile("" ::: "memory");
#pragma unroll
        for (int rr = 0; rr < 8; ++rr) { const int tk = rr * 8 + (lane >> 3), cp = (lane & 7) * 8;
            unsigned short e[8];
#pragma unroll
            for (int j = 0; j < 8; ++j) e[j] = *(const LAS unsigned short*)(tl + (cp + j) * 132 + tk * 2);
            v4u w; w.x = e[0] | ((unsigned)e[1] << 16); w.y = e[2] | ((unsigned)e[3] << 16); w.z = e[4] | ((unsigned)e[5] << 16); w.w = e[6] | ((unsigned)e[7] << 16);
            *(v4u*)(Y2 + (size_t)(t0 + tk) * D + c0 + cp) = w; }
        LDS_WAIT(); asm volatile("" ::: "memory");
#pragma unroll
        for (int rr = 0; rr < 8; ++rr) cur[rr] = nxt[rr];
    }
#undef TP_LOAD
}

constexpr float QSCALE = 0.125f * 1.4426950408889634f;
struct InprojSched { int G, c;
    __device__ __forceinline__ bool next(int i, Unit& u) const { const int L = i * G + c; if (L >= 3840 + 288) return false;
        if (L < 3840) { u.pm = L / 15; u.pn = L % 15; } else { const int q = L - 3840; u.pm = 256 + q / 9; u.pn = 6 + q % 9; } return true; }
    __device__ __forceinline__ int arow(int r) const { return r; }
    __device__ __forceinline__ bool narrow(const Unit& u) const { return u.pn == 14; }
    __device__ __forceinline__ void* probe_ts() const { return nullptr; } };
struct EpiInproj { static constexpr bool PERM = true, AFTER_DRAIN = false, PROBE = false, NARROW = false, TOKPERM = false; unsigned char* big; const float* rope; float* gates; const float* gate_b;
    __device__ __forceinline__ void operator()(const f32x4 (&acc)[2][2][4][2], const Unit& u, int wr, int wc, int fr, int fq) const {
        const bool ctx = u.pm >= 256; const int b = ctx ? u.pm - 256 : (u.pm >> 3), r0 = ctx ? 0 : (u.pm & 7) * 256;
        if (u.pn == 14) {
            if (wc != 0 || fq >= 2) return;
            const f32x4 gb0 = *(const f32x4*)(gate_b + 8 * fq), gb1 = *(const f32x4*)(gate_b + 8 * fq + 4);
#pragma unroll
            for (int ai = 0; ai < 2; ++ai)
#pragma unroll
                for (int m = 0; m < 4; ++m) { const int rr = r0 + wr * 64 + fr + ai * HALF + m * 16; const size_t grow = ctx ? (size_t)T + b * LC + rr : (size_t)b * SEQ + rr;
                    float* gp = gates + grow * 16 + 8 * fq; *(f32x4*)gp = acc[ai][0][m][0] + gb0; *(f32x4*)(gp + 4) = acc[ai][0][m][1] + gb1; }
            return; }
        const int t = u.pn >> 1;
        constexpr size_t offs[7] = {A0_QA, A0_BQ, A0_BO, A0_KA, A0_VA, A0_BK, A0_BV};
        const bool kv = t >= 3;
        size_t toff = A0_QA;
#pragma unroll
        for (int q = 0; q < 7; ++q) if (t == q) toff = offs[q];
        bf16* O = (bf16*)(big + toff) + (size_t)b * (kv ? (SEQ + LC) : SEQ) * 512 + (size_t)((kv && !ctx) ? LC : 0) * 512;
        const bool rope_on = (t == 0 || t == 3) && !ctx; const float qs = t == 0 ? QSCALE : 1.f;
        const int col0 = (u.pn & 1) * 256 + wc * 32 + 8 * fq;
#pragma unroll
        for (int ai = 0; ai < 2; ++ai)
#pragma unroll
            for (int m = 0; m < 4; ++m) { const int rr = r0 + wr * 64 + fr + ai * HALF + m * 16; bf16* rowp = O + (size_t)rr * 512 + col0;
                f32x4 cs0 = (f32x4){1.f, 0.f, 1.f, 0.f}, cs1 = cs0;
                if (rope_on) { const int pos = (wc & 1) ? (rr & 63) : (rr >> 6); const float* rp = rope + (size_t)(pos * 16 + 4 * fq) * 2; cs0 = *(const f32x4*)rp; cs1 = *(const f32x4*)(rp + 4); }
#pragma unroll
                for (int bj = 0; bj < 2; ++bj) { const f32x4 x0 = acc[ai][bj][m][0], x1 = acc[ai][bj][m][1];
                    f32x4 o0, o1;
                    o0[0] = x0[0] * cs0[0] - x1[0] * cs0[1]; o1[0] = x1[0] * cs0[0] + x0[0] * cs0[1];
                    o0[1] = x0[1] * cs0[2] - x1[1] * cs0[3]; o1[1] = x1[1] * cs0[2] + x0[1] * cs0[3];
                    o0[2] = x0[2] * cs1[0] - x1[2] * cs1[1]; o1[2] = x1[2] * cs1[0] + x0[2] * cs1[1];
                    o0[3] = x0[3] * cs1[2] - x1[3] * cs1[3]; o1[3] = x1[3] * cs1[2] + x0[3] * cs1[3];
                    o0 = o0 * qs; o1 = o1 * qs;
                    u32x4 w; w.x = cvt_pk_bf16(o0[0], o0[1]); w.y = cvt_pk_bf16(o0[2], o0[3]); w.z = cvt_pk_bf16(o1[0], o1[1]); w.w = cvt_pk_bf16(o1[2], o1[3]);
                    *(u32x4*)(rowp + bj * HALF) = w; } }
    } };
__device__ __forceinline__ void ph_transpose_b(const bf16* src, bf16* dst, int NBt, int R, int C, LAS unsigned char* lds, int lane, int wave) {
    LAS unsigned char* tl = lds + wave * 16384;
    const int gw = blockIdx.x * NWAVES + wave, NGW = gridDim.x * NWAVES; const int tr = R / 64, tc = C / 64, per = tr * tc;
#pragma unroll 1
    for (int tile = gw; tile < NBt * per; tile += NGW) { const int bt = tile / per, q = tile % per, c0 = (q % tc) * 64, r0 = (q / tc) * 64;
        const bf16* s = src + (size_t)bt * R * C; bf16* d = dst + (size_t)bt * R * C;
#pragma unroll
        for (int rr = 0; rr < 8; ++rr) { const int row = rr * 8 + (lane >> 3), pc = lane & 7;
            *(LAS v4u*)(tl + row * 144 + pc * 16) = *(const v4u*)(s + (size_t)(r0 + row) * C + c0 + pc * 8); }
        LDS_WAIT(); asm volatile("" ::: "memory");
#pragma unroll
        for (int rr = 0; rr < 8; ++rr) { const int cc = rr * 8 + (lane >> 3), rp = (lane & 7) * 8;
            unsigned short e[8];
#pragma unroll
            for (int j = 0; j < 8; ++j) e[j] = *(const LAS unsigned short*)(tl + (rp + j) * 144 + cc * 2);
            v4u w; w.x = e[0] | ((unsigned)e[1] << 16); w.y = e[2] | ((unsigned)e[3] << 16); w.z = e[4] | ((unsigned)e[5] << 16); w.w = e[6] | ((unsigned)e[7] << 16);
            *(v4u*)(d + (size_t)(c0 + cc) * R + r0 + rp) = w; }
        LDS_WAIT(); asm volatile("" ::: "memory");
    }
}

typedef short s16x4 __attribute__((ext_vector_type(4)));
__device__ __forceinline__ u32x2 tr16(const LAS unsigned char* p) { return __builtin_bit_cast(u32x2, __builtin_amdgcn_ds_read_tr16_b64_v4i16((LAS s16x4*)p)); }
typedef float f32x2 __attribute__((ext_vector_type(2)));
constexpr int AT_KP = 272, AT_VP = 320  , AT_KB = 64 * AT_KP, AT_VB = 64 * AT_VP, AT_V0 = 2 * AT_KB;
__device__ __forceinline__ void ph_attn(const Params& p, unsigned char* big, LAS unsigned char* lds, int tid, int lane, int wave, int vcu) {
    const bf16* QA = (const bf16*)(big + A0_QA); const bf16* KA = (const bf16*)(big + A0_KA); const bf16* VA = (const bf16*)(big + A0_VA); bf16* MIXIN = (bf16*)(big + A0_MIXIN);
    const int blk = (lane >> 4) & 1, tq = (lane & 15) >> 2, tp = lane & 3;
    const int comp = wave >> 2, qw = wave & 3, r = lane & 31, hh = lane >> 5;
    float lam; { const float* lv = p.in[I_DLAM]; const float a = wave_sum(lv[lane] * lv[64 + lane]), b2 = wave_sum(lv[128 + lane] * lv[192 + lane]); lam = expf(a) - expf(b2) + 0.2f; }
#pragma unroll 1
    for (int unit = vcu; unit < 2048; unit += gridDim.x) {
        const int b = unit >> 6, h = (unit >> 4) & 3, qblk = unit & 15, q0 = qblk * 128 + qw * 32;
        const bf16* Kg = KA + (size_t)b * (SEQ + LC) * 512 + h * 128; const bf16* Vg = VA + (size_t)b * (SEQ + LC) * 512 + h * 128;
        bf16x8 qf[4];
#pragma unroll
        for (int ds = 0; ds < 4; ++ds) qf[ds] = *(const bf16x8*)(QA + ((size_t)b * SEQ + q0 + r) * 512 + h * 128 + comp * 64 + ds * 16 + hh * 8);
        f32x16 oacc[4];
#pragma unroll
        for (int i = 0; i < 4; ++i)
#pragma unroll
            for (int q = 0; q < 16; ++q) oacc[i][q] = 0.f;
        float m_run = 0.f, l_run = 0.f;
        v4u pre[4];
#define AT_LOADG(kt) do { _Pragma("unroll") for (int q = 0; q < 2; ++q) { const int idx = tid + NTHR * q; \
            pre[q] = *(const v4u*)(Kg + (size_t)((kt) * 64 + (idx >> 4)) * 512 + (idx & 15) * 8); \
            pre[2 + q] = *(const v4u*)(Vg + (size_t)((kt) * 64 + (idx >> 4)) * 512 + (idx & 15) * 8); } } while (0)
#define AT_STORES(kn) do { _Pragma("unroll") for (int q = 0; q < 2; ++q) { const int idx = tid + NTHR * q; \
            *(LAS v4u*)(lds + ((kn) & 1) * AT_KB + (idx >> 4) * AT_KP + (idx & 15) * 16) = pre[q]; \
            *(LAS v4u*)(lds + AT_V0 + ((kn) % 3) * AT_VB + (idx >> 4) * AT_VP + (idx & 15) * 16) = pre[2 + q]; } } while (0)
#define AT_VFRAG(dst, i_) do { const int kb_ = (i_) >> 3, s_ = ((i_) >> 2) & 1, dvb_ = (i_) & 3; const LAS unsigned char* vp = Vt_ + (32 * kb_ + 16 * s_ + 4 * hh + tq) * AT_VP + (32 * dvb_ + 16 * blk + 4 * tp) * 2; \
            const u32x2 lo = tr16(vp), hi = tr16(vp + 8 * AT_VP); dst.x = lo.x; dst.y = lo.y; dst.z = hi.x; dst.w = hi.y; } while (0)
#define AT_PV(PF, VT_) do { const LAS unsigned char* Vt_ = (VT_); u32x4 vf0, vf1, vf2; AT_VFRAG(vf0, 0); AT_VFRAG(vf1, 1); __builtin_amdgcn_s_setprio(1); __builtin_amdgcn_sched_barrier(0); \
            _Pragma("unroll") for (int i3 = 0; i3 < 18; i3 += 3) { \
                if (i3 + 2 < 16) AT_VFRAG(vf2, i3 + 2); __builtin_amdgcn_sched_barrier(0); if (i3 < 16) oacc[i3 & 3] = __builtin_amdgcn_mfma_f32_32x32x16_bf16(__builtin_bit_cast(bf16x8, vf0), PF[i3 >> 3][(i3 >> 2) & 1], oacc[i3 & 3], 0, 0, 0); __builtin_amdgcn_sched_barrier(0); \
                if (i3 + 3 < 16) AT_VFRAG(vf0, i3 + 3); __builtin_amdgcn_sched_barrier(0); if (i3 + 1 < 16) oacc[(i3 + 1) & 3] = __builtin_amdgcn_mfma_f32_32x32x16_bf16(__builtin_bit_cast(bf16x8, vf1), PF[(i3 + 1) >> 3][((i3 + 1) >> 2) & 1], oacc[(i3 + 1) & 3], 0, 0, 0); __builtin_amdgcn_sched_barrier(0); \
                if (i3 + 4 < 16) AT_VFRAG(vf1, i3 + 4); __builtin_amdgcn_sched_barrier(0); if (i3 + 2 < 16) oacc[(i3 + 2) & 3] = __builtin_amdgcn_mfma_f32_32x32x16_bf16(__builtin_bit_cast(bf16x8, vf2), PF[(i3 + 2) >> 3][((i3 + 2) >> 2) & 1], oacc[(i3 + 2) & 3], 0, 0, 0); __builtin_amdgcn_sched_barrier(0); } __builtin_amdgcn_s_setprio(0); } while (0)
        bf16x8 phold[2][2];
        __syncthreads();
        AT_LOADG(0); AT_STORES(0);
        __syncthreads();
#pragma unroll 1
        for (int kt = 0; kt < 36; ++kt) {
            if (kt < 35) AT_LOADG(kt + 1);
            const LAS unsigned char* Kt = lds + (kt & 1) * AT_KB;
            if (comp == 1 && kt > 0) { AT_PV(phold, lds + AT_V0 + ((kt - 1) % 3) * AT_VB); }
            f32x16 sacc[2];
#pragma unroll
            for (int kb = 0; kb < 2; ++kb)
#pragma unroll
                for (int q = 0; q < 16; ++q) sacc[kb][q] = -m_run;
#define AT_KFRAG(i_) (*(const LAS bf16x8*)(Kt + (32 * ((i_) & 1) + r) * AT_KP + comp * 128 + ((i_) >> 1) * 32 + hh * 16))
            { bf16x8 kf0 = AT_KFRAG(0), kf1 = AT_KFRAG(1), kf2; __builtin_amdgcn_s_setprio(1); __builtin_amdgcn_sched_barrier(0);
#pragma unroll
              for (int i3 = 0; i3 < 9; i3 += 3) {
                  if (i3 + 2 < 8) kf2 = AT_KFRAG(i3 + 2); __builtin_amdgcn_sched_barrier(0); if (i3 < 8) sacc[i3 & 1] = __builtin_amdgcn_mfma_f32_32x32x16_bf16(kf0, qf[i3 >> 1], sacc[i3 & 1], 0, 0, 0); __builtin_amdgcn_sched_barrier(0);
                  if (i3 + 3 < 8) kf0 = AT_KFRAG(i3 + 3); __builtin_amdgcn_sched_barrier(0); if (i3 + 1 < 8) sacc[(i3 + 1) & 1] = __builtin_amdgcn_mfma_f32_32x32x16_bf16(kf1, qf[(i3 + 1) >> 1], sacc[(i3 + 1) & 1], 0, 0, 0); __builtin_amdgcn_sched_barrier(0);
                  if (i3 + 4 < 8) kf1 = AT_KFRAG(i3 + 4); __builtin_amdgcn_sched_barrier(0); if (i3 + 2 < 8) sacc[(i3 + 2) & 1] = __builtin_amdgcn_mfma_f32_32x32x16_bf16(kf2, qf[(i3 + 2) >> 1], sacc[(i3 + 2) & 1], 0, 0, 0); __builtin_amdgcn_sched_barrier(0); } __builtin_amdgcn_s_setprio(0); }
#undef AT_KFRAG
            float mx = sacc[0][0];
#pragma unroll
            for (int kb = 0; kb < 2; ++kb)
#pragma unroll
                for (int q = 0; q < 16; ++q) mx = fmaxf(mx, sacc[kb][q]);
            mx = fmaxf(mx, shx(mx, 32));
            if (kt == 0 || __builtin_amdgcn_ballot_w64(mx > 0.f) != 0ull) {
                const float dm = kt == 0 ? mx : fmaxf(mx, 0.f), alpha = __builtin_amdgcn_exp2f(-dm); m_run += dm; l_run *= alpha;
#pragma unroll
                for (int kb = 0; kb < 2; ++kb) sacc[kb] = sacc[kb] - dm;
#pragma unroll
                for (int i = 0; i < 4; ++i) oacc[i] = oacc[i] * alpha; }
            f32x2 ps2 = (f32x2){0.f, 0.f};
#pragma unroll
            for (int kb = 0; kb < 2; ++kb)
#pragma unroll
                for (int q = 0; q < 8; ++q) { f32x2 e; e.x = __builtin_amdgcn_exp2f(sacc[kb][2 * q]); e.y = __builtin_amdgcn_exp2f(sacc[kb][2 * q + 1]); sacc[kb][2 * q] = e.x; sacc[kb][2 * q + 1] = e.y; ps2 += e; }
            l_run += ps2.x + ps2.y;
#pragma unroll
            for (int kb = 0; kb < 2; ++kb)
#pragma unroll
                for (int s = 0; s < 2; ++s) {
                    u32x4 pw; pw.x = cvt_pk_bf16(sacc[kb][8 * s + 0], sacc[kb][8 * s + 1]); pw.y = cvt_pk_bf16(sacc[kb][8 * s + 2], sacc[kb][8 * s + 3]);
                    pw.z = cvt_pk_bf16(sacc[kb][8 * s + 4], sacc[kb][8 * s + 5]); pw.w = cvt_pk_bf16(sacc[kb][8 * s + 6], sacc[kb][8 * s + 7]);
                    phold[kb][s] = __builtin_bit_cast(bf16x8, pw); }
            if (comp == 0) { AT_PV(phold, lds + AT_V0 + (kt % 3) * AT_VB); }
            if (kt < 35) AT_STORES(kt + 1);
            __syncthreads();
        }
        if (comp == 1) { AT_PV(phold, lds + AT_V0 + (35 % 3) * AT_VB); }
        __syncthreads();
#undef AT_LOADG
#undef AT_STORES
#undef AT_PV
#undef AT_VFRAG
        const float lsum = l_run + shx(l_run, 32), inv = __builtin_amdgcn_rcpf(lsum);
        LAS float* X = (LAS float*)lds;
        if (comp == 1) {
#pragma unroll
            for (int dvb = 0; dvb < 4; ++dvb)
#pragma unroll
                for (int q = 0; q < 16; ++q) X[(qw * 64 + dvb * 16 + q) * 64 + lane] = oacc[dvb][q] * inv; }
        __syncthreads();
        if (comp == 0) {
            float ss = 0.f;
#pragma unroll
            for (int dvb = 0; dvb < 4; ++dvb)
#pragma unroll
                for (int q = 0; q < 16; ++q) { const float o = oacc[dvb][q] * inv - lam * X[(qw * 64 + dvb * 16 + q) * 64 + lane]; oacc[dvb][q] = o; ss += o * o; }
            ss += shx(ss, 32);
            const float rn = rsqrtf(ss * (1.f / 128.f) + RMS_EPS) * 0.8f;
            const float* ga = p.in[I_HGA] + h * 128; bf16* orow = MIXIN + ((size_t)b * SEQ + q0 + r) * D + h * 128;
#pragma unroll
            for (int dvb = 0; dvb < 4; ++dvb)
#pragma unroll
                for (int g = 0; g < 4; ++g) { const int dv = 32 * dvb + 8 * g + 4 * hh; const f32x4 gg = *(const f32x4*)(ga + dv);
                    v2u w; w.x = pk2(oacc[dvb][4 * g + 0] * rn * gg[0], oacc[dvb][4 * g + 1] * rn * gg[1]); w.y = pk2(oacc[dvb][4 * g + 2] * rn * gg[2], oacc[dvb][4 * g + 3] * rn * gg[3]);
                    *(v2u*)(orow + dv) = w; }
        }
    }
    __syncthreads();
}

constexpr int ML_P = 272, ML_TILE = 64 * ML_P;
constexpr int ML_VOFF = 3 * ML_TILE, ML_VSZ = 64 * 256;
constexpr int ML_RQ = ML_VOFF + 2 * ML_VSZ, ML_RSZ = 68 * 256, ML_RK = ML_RQ + ML_RSZ;
constexpr int ML_NOFF = ML_RK + ML_RSZ, ML_AOFF = ML_NOFF + 2 * 512;
constexpr int ML_CW = ML_AOFF + 8 * 256;
static_assert(ML_CW + 8 * 512 <= LDS_TAB, "mLSTM LDS map");
__device__ __forceinline__ float logsigmoidf_(float x) { return x >= 0.f ? -__logf(1.f + __expf(-x)) : x - __logf(1.f + __expf(x)); }
__device__ __forceinline__ bf16x8 pack8(const f32x16& v, int s) { u32x4 w; w.x = cvt_pk_bf16(v[8 * s + 0], v[8 * s + 1]); w.y = cvt_pk_bf16(v[8 * s + 2], v[8 * s + 3]); w.z = cvt_pk_bf16(v[8 * s + 4], v[8 * s + 5]); w.w = cvt_pk_bf16(v[8 * s + 6], v[8 * s + 7]); return __builtin_bit_cast(bf16x8, w); }
__device__ __forceinline__ void ph_mlstm(const Params& p, unsigned char* big, LAS unsigned char* lds, int tid, int lane, int wave) {
    const int bid = blockIdx.x; if (bid >= 256) return;
    const int b = bid >> 3, h = (bid >> 1) & 3, dir = bid & 1;
    const bf16* BQ = (const bf16*)(big + A0_BQ) + (size_t)b * SEQ * 512 + h * 128;
    const bf16* BK = (const bf16*)(big + A0_BK) + (size_t)b * (SEQ + LC) * 512 + h * 128;
    const bf16* BV = (const bf16*)(big + A0_BV) + (size_t)b * (SEQ + LC) * 512 + h * 128;
    bf16* HB = (bf16*)(big + A0_HB) + (size_t)dir * T * 512 + (size_t)b * SEQ * 512 + h * 128;
    const float* GT = (const float*)(p.ws + WS_GATES);
    const float* cw = p.in[I_CONVABW]; const float* cb = p.in[I_CONVABB];
    const int eb = wave & 3, tb = wave >> 2, r = lane & 31, hh = lane >> 5;
    const int blk = (lane >> 4) & 1, tq = (lane & 15) >> 2, tp = lane & 3;
    LAS float* nbuf = (LAS float*)(lds + ML_NOFF); LAS float* aw = (LAS float*)(lds + ML_AOFF) + wave * 64;
    if (tid < 256) nbuf[tid] = 0.f;
    LAS float* cwl = (LAS float*)(lds + ML_CW);
    for (int i = tid; i < 1024; i += NTHR) { const int ten = i >> 9, j = (i >> 7) & 3, d = i & 127, ch = ten * 512 + h * 128 + d; cwl[i] = j < 3 ? cw[j * 1024 + ch] : cb[ch]; }
    f32x16 cacc[4];
#pragma unroll
    for (int i = 0; i < 4; ++i)
#pragma unroll
        for (int q = 0; q < 16; ++q) cacc[i][q] = 0.f;
    float m_state = 0.f;
#ifdef ML_PROBE
    unsigned long long accs[7] = {0, 0, 0, 0, 0, 0, 0}; unsigned long long tp0 = __builtin_amdgcn_s_memrealtime();
#define ML_T(i) do { const unsigned long long t1_ = __builtin_amdgcn_s_memrealtime(); accs[i] += t1_ - tp0; tp0 = t1_; } while (0)
#else
#define ML_T(i)
#endif
    float a_c = 0.f, M_c = 0.f, b_c = 0.f, decay_c = 1.f, m_after = 0.f;
    float a_n = 0.f, M_n = 0.f, b_n = 0.f, w_n = 0.f, decay_n = 1.f, m_next = 0.f;
#define ML_POS(cc, t) ((cc) < 4 ? (dir ? 255 - ((cc) * 64 + (t)) : (cc) * 64 + (t)) : (dir ? 2047 - (((cc) - 4) * 64 + (t)) : ((cc) - 4) * 64 + (t)))
#define ML_GLOAD(cc, li_, fp_) do { const int pos_ = ML_POS(cc, lane); const size_t grow_ = (cc) < 4 ? (size_t)T + b * LC + pos_ : (size_t)b * SEQ + pos_; \
        li_ = GT[grow_ * 16 + dir * 8 + h]; fp_ = GT[grow_ * 16 + dir * 8 + 4 + h]; } while (0)
#define ML_DPP(v_, id_, ctrl, rmask) __builtin_bit_cast(float, __builtin_amdgcn_update_dpp(__builtin_bit_cast(int, (float)(id_)), __builtin_bit_cast(int, v_), ctrl, rmask, 0xf, false))
#define ML_SCAN(li_, fp_, m_in) do { const float lf_ = logsigmoidf_(fp_); \
        float bs_ = lf_; bs_ += ML_DPP(bs_, 0.f, 0x111, 0xf); bs_ += ML_DPP(bs_, 0.f, 0x112, 0xf); bs_ += ML_DPP(bs_, 0.f, 0x114, 0xf); bs_ += ML_DPP(bs_, 0.f, 0x118, 0xf); bs_ += ML_DPP(bs_, 0.f, 0x142, 0xa); bs_ += ML_DPP(bs_, 0.f, 0x143, 0xc); \
        const float aa_ = (li_) - bs_; float pm_ = aa_; pm_ = fmaxf(pm_, ML_DPP(pm_, pm_, 0x111, 0xf)); pm_ = fmaxf(pm_, ML_DPP(pm_, pm_, 0x112, 0xf)); pm_ = fmaxf(pm_, ML_DPP(pm_, pm_, 0x114, 0xf)); pm_ = fmaxf(pm_, ML_DPP(pm_, pm_, 0x118, 0xf)); \
        pm_ = fmaxf(pm_, ML_DPP(pm_, pm_, 0x142, 0xa)); pm_ = fmaxf(pm_, ML_DPP(pm_, pm_, 0x143, 0xc)); \
        const float MM_ = fmaxf(m_in, pm_); const float M63_ = __builtin_bit_cast(float, __builtin_amdgcn_readlane(__builtin_bit_cast(int, MM_), 63)), b63_ = __builtin_bit_cast(float, __builtin_amdgcn_readlane(__builtin_bit_cast(int, bs_), 63)); \
        a_n = aa_; M_n = MM_; b_n = bs_; w_n = __expf(aa_ - M63_); decay_n = __expf((m_in) - M63_); m_next = b63_ + M63_; } while (0)
#define ML_DMA(cc, vbuf) do { const int lim_ = (cc) < 4 ? LC : SEQ, kvb_ = (cc) < 4 ? 0 : LC; \
        _Pragma("unroll 1") for (int ins_ = wave; ins_ < 17; ins_ += NWAVES) { const int rr_ = ins_ * 4 + (lane >> 4), pc_ = lane & 15; int pos_ = ML_POS(cc, rr_ - 1); pos_ = pos_ < 0 ? 0 : (pos_ >= lim_ ? lim_ - 1 : pos_); \
            __builtin_amdgcn_global_load_lds((const unsigned*)(BK + (size_t)(kvb_ + pos_) * 512 + pc_ * 8), (LAS unsigned*)(lds + ML_RK + ins_ * 1024), 16, 0, 0); \
            if ((cc) >= 4) __builtin_amdgcn_global_load_lds((const unsigned*)(BQ + (size_t)pos_ * 512 + pc_ * 8), (LAS unsigned*)(lds + ML_RQ + ins_ * 1024), 16, 0, 0); } \
        _Pragma("unroll") for (int q_ = 0; q_ < 2; ++q_) { const int ins_ = wave * 2 + q_, t_ = ins_ * 4 + (lane >> 4), pc_ = lane & 15; const int pos_ = ML_POS(cc, t_); \
            __builtin_amdgcn_global_load_lds((const unsigned*)(BV + (size_t)(kvb_ + pos_) * 512 + pc_ * 8), (LAS unsigned*)(lds + ML_VOFF + (vbuf) * ML_VSZ + ins_ * 1024), 16, 0, 0); } } while (0)
#define ML_CONV8(dst, rawoff, cc, t_, d8_, ten, scl) do { const int pos_ = ML_POS(cc, t_), lim_ = (cc) < 4 ? LC : SEQ; const int rm_ = dir ? (t_) + 2 : (t_), rp_ = dir ? (t_) : (t_) + 2; \
        v4u x_[3]; x_[0] = *(const LAS v4u*)(lds + (rawoff) + rm_ * 256 + (d8_) * 16); x_[1] = *(const LAS v4u*)(lds + (rawoff) + ((t_) + 1) * 256 + (d8_) * 16); x_[2] = *(const LAS v4u*)(lds + (rawoff) + rp_ * 256 + (d8_) * 16); \
        if (pos_ - 1 < 0) x_[0] = (v4u){0u, 0u, 0u, 0u}; if (pos_ + 1 >= lim_) x_[2] = (v4u){0u, 0u, 0u, 0u}; \
        const LAS float* wl_ = cwl + (ten) * 512 + (d8_) * 8; f32x4 wv_[4][2]; \
        _Pragma("unroll") for (int j_ = 0; j_ < 4; ++j_) { wv_[j_][0] = *(const LAS f32x4*)(wl_ + j_ * 128); wv_[j_][1] = *(const LAS f32x4*)(wl_ + j_ * 128 + 4); } \
        _Pragma("unroll") for (int e_ = 0; e_ < 8; ++e_) { float s_ = wv_[3][e_ >> 2][e_ & 3]; \
            _Pragma("unroll") for (int j_ = 0; j_ < 3; ++j_) { const unsigned w_ = e_ < 2 ? x_[j_].x : e_ < 4 ? x_[j_].y : e_ < 6 ? x_[j_].z : x_[j_].w; s_ += wv_[j_][e_ >> 2][e_ & 3] * ((e_ & 1) ? bf_hi(w_) : bf_lo(w_)); } \
            dst[e_] = s_ * __builtin_amdgcn_rcpf(1.f + __expf(-s_)) * (scl); } } while (0)
#define ML_BUILD(cc) do { _Pragma("unroll 1") for (int q_ = 0; q_ < 2; ++q_) { const int idx_ = tid + NTHR * q_, t_ = idx_ >> 4, d8_ = idx_ & 15; \
        float kk_[8]; ML_CONV8(kk_, ML_RK, cc, t_, d8_, 1, 1.f); const float wt_ = shidx(w_n, t_); \
        v4u o_; o_.x = pk2(kk_[0], kk_[1]); o_.y = pk2(kk_[2], kk_[3]); o_.z = pk2(kk_[4], kk_[5]); o_.w = pk2(kk_[6], kk_[7]); *(LAS v4u*)(lds + ML_TILE + t_ * ML_P + d8_ * 16) = o_; \
        o_.x = pk2(kk_[0] * wt_, kk_[1] * wt_); o_.y = pk2(kk_[2] * wt_, kk_[3] * wt_); o_.z = pk2(kk_[4] * wt_, kk_[5] * wt_); o_.w = pk2(kk_[6] * wt_, kk_[7] * wt_); *(LAS v4u*)(lds + 2 * ML_TILE + t_ * ML_P + d8_ * 16) = o_; \
        if ((cc) >= 4) { float qq_[8]; ML_CONV8(qq_, ML_RQ, cc, t_, d8_, 0, 0.08838834764831845f); \
            o_.x = pk2(qq_[0], qq_[1]); o_.y = pk2(qq_[2], qq_[3]); o_.z = pk2(qq_[4], qq_[5]); o_.w = pk2(qq_[6], qq_[7]); *(LAS v4u*)(lds + t_ * ML_P + d8_ * 16) = o_; } } } while (0)
    __syncthreads();
    { float li0, fp0; ML_GLOAD(0, li0, fp0); ML_DMA(0, 0); ML_SCAN(li0, fp0, m_state); }
    asm volatile("s_waitcnt vmcnt(0)" ::: "memory");
    __syncthreads();
    ML_BUILD(0);
    a_c = a_n; M_c = M_n; b_c = b_n; decay_c = decay_n; m_after = m_next;
    __syncthreads();
#pragma unroll 1
    for (int cc = 0; cc < 36; ++cc) {
        const LAS unsigned char* Qs = lds; const LAS unsigned char* Ks = lds + ML_TILE; const LAS unsigned char* Kw = lds + 2 * ML_TILE; const LAS unsigned char* Vs = lds + ML_VOFF + (cc & 1) * ML_VSZ;
        const LAS float* ncur = nbuf + (cc & 1) * 128; LAS float* nnew = nbuf + ((cc + 1) & 1) * 128;
        float li1 = 0.f, fp1 = 0.f;
        ML_T(5);
        if (cc < 35) { ML_GLOAD(cc + 1, li1, fp1); ML_DMA(cc + 1, (cc + 1) & 1); }
        ML_T(0);
        if (cc >= 4) {
            aw[lane] = a_c;
            const int tcol = 32 * tb + r; const float Mt = shidx(M_c, tcol), bt = shidx(b_c, tcol);
            f32x16 nacc;
#pragma unroll
            for (int q = 0; q < 16; ++q) nacc[q] = 0.f;
            { u32x4 qw[8];
#pragma unroll
              for (int i = 0; i < 8; ++i) { const LAS unsigned char* qp = Qs + tcol * ML_P + (32 * (i >> 1) + 16 * (i & 1) + 4 * hh) * 2; const u32x2 lo = *(const LAS u32x2*)qp, hi = *(const LAS u32x2*)(qp + 16); qw[i].x = lo.x; qw[i].y = lo.y; qw[i].z = hi.x; qw[i].w = hi.y; }
              __builtin_amdgcn_sched_barrier(0);
#pragma unroll
              for (int i = 0; i < 8; ++i) nacc = __builtin_amdgcn_mfma_f32_32x32x16_bf16(pack8(cacc[i >> 1], i & 1), __builtin_bit_cast(bf16x8, qw[i]), nacc, 0, 0, 0); }
            const float sc = __expf(m_state - Mt);
            nacc = nacc * sc;
            float rs = 0.f;
#pragma unroll
            for (int sb = 0; sb < 2; ++sb) if (sb <= tb) {
                f32x16 sacc;
#pragma unroll
                for (int q = 0; q < 16; ++q) sacc[q] = 0.f;
                u32x4 vw0, vw1;
                { bf16x8 kf[8], qf[8];
#pragma unroll
                  for (int ds = 0; ds < 8; ++ds) { kf[ds] = *(const LAS bf16x8*)(Ks + (32 * sb + r) * ML_P + (16 * ds + 8 * hh) * 2); qf[ds] = *(const LAS bf16x8*)(Qs + tcol * ML_P + (16 * ds + 8 * hh) * 2); }
                  __builtin_amdgcn_sched_barrier(0);
#pragma unroll
                  for (int ds = 0; ds < 8; ++ds) sacc = __builtin_amdgcn_mfma_f32_32x32x16_bf16(kf[ds], qf[ds], sacc, 0, 0, 0);
                  { const u32x2 t0 = tr16(Vs + (32 * sb + 4 * hh + tq) * 256 + (32 * eb + 16 * blk + 4 * tp) * 2), t1 = tr16(Vs + (32 * sb + 8 + 4 * hh + tq) * 256 + (32 * eb + 16 * blk + 4 * tp) * 2);
                    vw0.x = t0.x; vw0.y = t0.y; vw0.z = t1.x; vw0.w = t1.y; }
                  { const u32x2 t0 = tr16(Vs + (32 * sb + 16 + 4 * hh + tq) * 256 + (32 * eb + 16 * blk + 4 * tp) * 2), t1 = tr16(Vs + (32 * sb + 16 + 8 + 4 * hh + tq) * 256 + (32 * eb + 16 * blk + 4 * tp) * 2);
                    vw1.x = t0.x; vw1.y = t0.y; vw1.z = t1.x; vw1.w = t1.y; }
                  __builtin_amdgcn_sched_barrier(0); }
#pragma unroll
                for (int g = 0; g < 4; ++g) { const int s0 = 32 * sb + 8 * g + 4 * hh; const f32x4 av = *(const LAS f32x4*)(aw + s0);
#pragma unroll
                    for (int j = 0; j < 4; ++j) { const bool keep = (s0 + j) <= tcol; const float v = keep ? sacc[4 * g + j] * __expf(av[j] - Mt) : 0.f; sacc[4 * g + j] = v; rs += v; } }
                nacc = __builtin_amdgcn_mfma_f32_32x32x16_bf16(__builtin_bit_cast(bf16x8, vw0), pack8(sacc, 0), nacc, 0, 0, 0);
                nacc = __builtin_amdgcn_mfma_f32_32x32x16_bf16(__builtin_bit_cast(bf16x8, vw1), pack8(sacc, 1), nacc, 0, 0, 0); }
            rs += shx(rs, 32);
            float qn = 0.f;
            { const LAS unsigned char* qp = Qs + tcol * ML_P + (64 * hh) * 2;
#pragma unroll
              for (int c8 = 0; c8 < 8; ++c8) { const v4u w = *(const LAS v4u*)(qp + c8 * 16); const f32x4 n0 = *(const LAS f32x4*)(ncur + 64 * hh + 8 * c8), n1 = *(const LAS f32x4*)(ncur + 64 * hh + 8 * c8 + 4);
                  qn += bf_lo(w.x) * n0[0] + bf_hi(w.x) * n0[1] + bf_lo(w.y) * n0[2] + bf_hi(w.y) * n0[3] + bf_lo(w.z) * n1[0] + bf_hi(w.z) * n1[1] + bf_lo(w.w) * n1[2] + bf_hi(w.w) * n1[3]; } }
            qn += shx(qn, 32);
            const float den = sc * qn + rs; const float dd = __frcp_rn(fmaxf(fabsf(den), __expf(-(bt + Mt))));
            { const int pos = ML_POS(cc, tcol); bf16* hrow = HB + (size_t)pos * 512 + 32 * eb;
#pragma unroll
              for (int g = 0; g < 4; ++g) { v2u w; w.x = pk2(nacc[4 * g + 0] * dd, nacc[4 * g + 1] * dd); w.y = pk2(nacc[4 * g + 2] * dd, nacc[4 * g + 3] * dd); *(v2u*)(hrow + 8 * g + 4 * hh) = w; } }
        }
        ML_T(1);
        { u32x4 vb[4];
#pragma unroll
          for (int s4 = 0; s4 < 4; ++s4) { const u32x2 t0 = tr16(Vs + (16 * s4 + 8 * hh + tq) * 256 + (32 * eb + 16 * blk + 4 * tp) * 2), t1 = tr16(Vs + (16 * s4 + 8 * hh + 4 + tq) * 256 + (32 * eb + 16 * blk + 4 * tp) * 2);
              vb[s4].x = t0.x; vb[s4].y = t0.y; vb[s4].z = t1.x; vb[s4].w = t1.y; }
#pragma unroll
          for (int half = 0; half < 2; ++half) { u32x4 ka[8];
#pragma unroll
              for (int i = 0; i < 8; ++i) { const int db = 2 * half + (i >> 2), s4 = i & 3;
                  const u32x2 t0 = tr16(Kw + (16 * s4 + 8 * hh + tq) * ML_P + (32 * db + 16 * blk + 4 * tp) * 2), t1 = tr16(Kw + (16 * s4 + 8 * hh + 4 + tq) * ML_P + (32 * db + 16 * blk + 4 * tp) * 2);
                  ka[i].x = t0.x; ka[i].y = t0.y; ka[i].z = t1.x; ka[i].w = t1.y; }
              cacc[2 * half] = cacc[2 * half] * decay_c; cacc[2 * half + 1] = cacc[2 * half + 1] * decay_c;
              __builtin_amdgcn_sched_barrier(0);
#pragma unroll
              for (int i = 0; i < 8; ++i) { const int db = 2 * half + (i >> 2); cacc[db] = __builtin_amdgcn_mfma_f32_32x32x16_bf16(__builtin_bit_cast(bf16x8, ka[i]), __builtin_bit_cast(bf16x8, vb[i & 3]), cacc[db], 0, 0, 0); }
              __builtin_amdgcn_sched_barrier(0); } }
        { const int d = tid >> 2, part = tid & 3; float s = 0.f;
#pragma unroll
            for (int t = 0; t < 16; ++t) s += bf1(*(const LAS bf16*)(Kw + (part * 16 + t) * ML_P + d * 2));
            s += shx(s, 1); s += shx(s, 2);
            if (part == 0) nnew[d] = decay_c * ncur[d] + s; }
        m_state = m_after;
        ML_T(2);
        asm volatile("s_waitcnt vmcnt(0)" ::: "memory");
        __syncthreads();
        ML_T(3);
        if (cc < 35) { ML_SCAN(li1, fp1, m_state); ML_T(6); ML_BUILD(cc + 1); a_c = a_n; M_c = M_n; b_c = b_n; decay_c = decay_n; m_after = m_next; }
        ML_T(4);
        __syncthreads();
    }
#ifdef ML_PROBE
    if (blockIdx.x == 0 && tid == 256) { unsigned long long* ts = (unsigned long long*)(p.ws + WS_CTL + 32768); ts[50] = 0; unsigned long long c_ = 0; for (int i = 0; i < 7; ++i) { c_ += accs[i]; ts[51 + i] = c_; } }
#endif
#undef ML_T
#undef ML_POS
#undef ML_GLOAD
#undef ML_SCAN
#undef ML_DPP
#undef ML_DMA
#undef ML_CONV8
#undef ML_BUILD
}
__device__ __forceinline__ void ph_outb(const Params& p, unsigned char* big, int lane, int wave, int tile) {
    const int gw = tile * NWAVES + wave;
    const bf16* HBf = (const bf16*)(big + A0_HB); const bf16* HBb = HBf + (size_t)T * 512; const bf16* BO = (const bf16*)(big + A0_BO); bf16* MIXIN = (bf16*)(big + A0_MIXIN);
    const float* gb = p.in[I_HGB];
    const f32x4 g0 = *(const f32x4*)(gb + lane * 8), g1 = *(const f32x4*)(gb + lane * 8 + 4);
#pragma unroll 2
    for (int m = gw * 32; m < gw * 32 + 32; ++m) {
        const v4u f = *(const v4u*)(HBf + (size_t)m * 512 + lane * 8), bw = *(const v4u*)(HBb + (size_t)m * 512 + lane * 8), go = *(const v4u*)(BO + (size_t)m * 512 + lane * 8);
        float x[8], o[8]; x[0] = bf_lo(f.x) + bf_lo(bw.x); x[1] = bf_hi(f.x) + bf_hi(bw.x); x[2] = bf_lo(f.y) + bf_lo(bw.y); x[3] = bf_hi(f.y) + bf_hi(bw.y);
        x[4] = bf_lo(f.z) + bf_lo(bw.z); x[5] = bf_hi(f.z) + bf_hi(bw.z); x[6] = bf_lo(f.w) + bf_lo(bw.w); x[7] = bf_hi(f.w) + bf_hi(bw.w);
        o[0] = bf_lo(go.x); o[1] = bf_hi(go.x); o[2] = bf_lo(go.y); o[3] = bf_hi(go.y); o[4] = bf_lo(go.z); o[5] = bf_hi(go.z); o[6] = bf_lo(go.w); o[7] = bf_hi(go.w);
        float ss = 0.f;
#pragma unroll
        for (int j = 0; j < 8; ++j) ss += x[j] * x[j];
        ss += shx(ss, 1); ss += shx(ss, 2); ss += shx(ss, 4); ss += shx(ss, 8);
        const float rn = rsqrtf(ss * (1.f / 128.f) + RMS_EPS);
        float y[8];
#pragma unroll
        for (int j = 0; j < 8; ++j) y[j] = x[j] * rn * (j < 4 ? g0[j] : g1[j - 4]) * sigmoidf_(o[j]);
        v4u w; w.x = pk2(y[0], y[1]); w.y = pk2(y[2], y[3]); w.z = pk2(y[4], y[5]); w.w = pk2(y[6], y[7]);
        *(v4u*)(MIXIN + (size_t)m * D + 512 + lane * 8) = w;
    }
}

constexpr int CW_DBG = 16;
#ifndef DBG_MODE
#define DBG_MODE 0
#endif
#ifndef DBG_L
#define DBG_L 0
#endif
#ifndef DBG_CH
#define DBG_CH 0
#endif
__device__ __forceinline__ void dbg_report(const Params& p, float d) {
    if (!(d >= 0.f)) d = 1.0e6f;
    atomicMax((unsigned*)(p.ws + WS_CTL) + CW_DBG, __float_as_uint(d));
}
__device__ __forceinline__ float block_max(float v, LAS float* red, int tid) { v = wave_max(v); __syncthreads(); if ((tid & 63) == 0) red[tid >> 6] = v; __syncthreads(); float r = red[0];
#pragma unroll
    for (int w = 1; w < 8; ++w) r = fmaxf(r, red[w]); __syncthreads(); return r; }
__device__ __forceinline__ float block_sum(float v, LAS float* red, int tid) { v = wave_sum(v); __syncthreads(); if ((tid & 63) == 0) red[tid >> 6] = v; __syncthreads(); float r = 0.f;
#pragma unroll
    for (int w = 0; w < 8; ++w) r += red[w]; __syncthreads(); return r; }
__device__ __forceinline__ void dbg_moe_check(const Params& p, int l, int ch, const bf16* H2, const bf16* Y, LAS unsigned char* lds, int tid) {
    LAS float* hrow = (LAS float*)lds; LAS float* gu = hrow + 1024; LAS float* a = gu + 512; LAS float* red = a + 256;
    const int t = ch * CHT + blockIdx.x * 64 + 5;
    __syncthreads();
    for (int i = tid; i < 1024; i += NTHR) hrow[i] = bf1(H2[(size_t)t * D + i]);
    __syncthreads();
    const int* EIDX = (const int*)(p.ws + WS_EIDX); const float* WTS = (const float*)(p.ws + WS_WTS); const int* PSLOT = (const int*)(p.ws + WS_PSLOT);
    float yacc[2] = {0.f, 0.f};
#pragma unroll 1
    for (int k = 0; k < 9; ++k) {
        const int e = k < 8 ? (EIDX[(size_t)t * 8 + k] & 255) : 64; const float w = k < 8 ? WTS[(size_t)t * 8 + k] : 1.f;
        const float* Wgu = e < 64 ? p.in[I_EGU] + (size_t)(l * 64 + e) * 1024 * 512 : p.in[I_SGU] + (size_t)l * 1024 * 512;
        const float* Wdn = e < 64 ? p.in[I_EDN] + (size_t)(l * 64 + e) * 256 * 1024 : p.in[I_SDN] + (size_t)l * 256 * 1024;
        float s = 0.f;
#pragma unroll 4
        for (int kk = 0; kk < 1024; ++kk) s += hrow[kk] * Wgu[(size_t)kk * 512 + tid];
        gu[tid] = s;
        __syncthreads();
        if (tid < 256) a[tid] = siluf_(gu[tid]) * gu[256 + tid];
        __syncthreads();
#pragma unroll
        for (int q = 0; q < 2; ++q) { const int n = tid + 512 * q; float s2 = 0.f;
#pragma unroll 4
            for (int j = 0; j < 256; ++j) s2 += a[j] * Wdn[(size_t)j * 1024 + n];
            yacc[q] += w * s2; }
        __syncthreads();
    }
    float err = 0.f, ss = 0.f;
#pragma unroll
    for (int q = 0; q < 2; ++q) { const int n = tid + 512 * q; float f = 0.f;
#pragma unroll 1
        for (int k = 0; k < 9; ++k) { const int slot = PSLOT[(size_t)t * 16 + k]; const float w = k < 8 ? WTS[(size_t)t * 8 + k] : 1.f; f += w * bf1(Y[(size_t)slot * D + n]); }
        err = fmaxf(err, fabsf(f - yacc[q])); ss += yacc[q] * yacc[q]; }
    const float me = block_max(err, red, tid), sq = block_sum(ss, red, tid);
    if (tid == 0) dbg_report(p, me / sqrtf(sq * (1.f / 1024.f) + 1e-30f));
}
__device__ __forceinline__ void dbg_route_check(const Params& p, int l, const bf16* H2, const float* LOG, LAS unsigned char* lds, int tid) {
    LAS float* hrow = (LAS float*)lds; LAS float* lg = hrow + 1024; LAS float* bi = lg + 64; LAS float* sc = bi + 64; LAS float* red = sc + 64;
    const int t = blockIdx.x * 256 + 77;
    __syncthreads();
    for (int i = tid; i < 1024; i += NTHR) hrow[i] = bf1(H2[(size_t)t * D + i]);
    __syncthreads();
    if (tid < 64) { float s = 0.f; const float* W = p.in[I_RW] + (size_t)l * 1024 * 64;
#pragma unroll 4
        for (int k = 0; k < 1024; ++k) s += hrow[k] * W[k * 64 + tid];
        lg[tid] = s; sc[tid] = 1.f / (1.f + expf(-s)); bi[tid] = sc[tid] + p.in[I_RB][l * 64 + tid]; }
    __syncthreads();
    if (tid == 0) {
        float lerr = 0.f;
#pragma unroll 1
        for (int e = 0; e < 64; ++e) lerr = fmaxf(lerr, fabsf(lg[e] - LOG[(size_t)t * 64 + e]));
        float grp[8];
#pragma unroll
        for (int g = 0; g < 8; ++g) { float a = -1e30f, b = -1e30f;
#pragma unroll 1
            for (int j = 0; j < 8; ++j) { const float v = bi[g * 8 + j]; if (v > a) { b = a; a = v; } else if (v > b) b = v; } grp[g] = a + b; }
        unsigned gm = 0;
#pragma unroll 1
        for (int r = 0; r < 4; ++r) { int best = -1; float bv = 0.f;
#pragma unroll
            for (int g = 0; g < 8; ++g) if (!((gm >> g) & 1u) && (best < 0 || grp[g] > bv)) { best = g; bv = grp[g]; }
            gm |= 1u << best; }
        unsigned long long set_ref = 0ull; float ssum = 0.f;
#pragma unroll 1
        for (int r = 0; r < 8; ++r) { int best = -1; float bv = 0.f;
#pragma unroll 1
            for (int e = 0; e < 64; ++e) if (((gm >> (e >> 3)) & 1u) && !((set_ref >> e) & 1ull) && (best < 0 || bi[e] > bv)) { best = e; bv = bi[e]; }
            set_ref |= 1ull << best; ssum += sc[best]; }
        const int* EIDX = (const int*)(p.ws + WS_EIDX); const float* WTS = (const float*)(p.ws + WS_WTS);
        unsigned long long set_f = 0ull; float werr = 0.f, wsum = 0.f;
#pragma unroll 1
        for (int k = 0; k < 8; ++k) { const int e = EIDX[(size_t)t * 8 + k] & 255; set_f |= 1ull << e; const float wr = 2.5f * sc[e] / ssum; werr = fmaxf(werr, fabsf(wr - WTS[(size_t)t * 8 + k])); wsum += WTS[(size_t)t * 8 + k]; }
        float d = 0.f;
        if (DBG_MODE == 0) d = (set_f != set_ref) ? (1.f / 256.f) : 0.f;
        if (DBG_MODE == 1) d = (set_f != set_ref) ? 0.f : werr + fabsf(wsum - 2.5f);
        if (DBG_MODE == 2) d = lerr * (1.f / 256.f);
        atomicAdd((float*)((unsigned*)(p.ws + WS_CTL) + CW_DBG), d);
    }
    __syncthreads();
}
__device__ __forceinline__ unsigned dbg_hash(unsigned x) { x ^= x >> 16; x *= 0x7feb352du; x ^= x >> 15; x *= 0x846ca68bu; x ^= x >> 16; return x; }
__device__ __forceinline__ void dbg_report_wave(const Params& p, float d, int lane) { if (lane == 0) dbg_report(p, d); }
__device__ __forceinline__ void dbg_hyena_check(const Params& p, int mode, const bf16* HN, const bf16* UC, const bf16* ZT, const bf16* Y2T, const bf16* MIX, LAS unsigned char* lds, int lane, int wave) {
    const unsigned hsh = dbg_hash(blockIdx.x * 8u + wave + 12345u), h2 = dbg_hash(hsh), h3 = dbg_hash(h2);
    const bf16* FILT = (const bf16*)(p.ws + WS_FILT);
    float d = 0.f;
    if (mode == 0) {
        const int c = hsh % 3072u, b = h2 % 32u, s = h3 % 2048u; float acc = 0.f;
#pragma unroll 1
        for (int k = lane; k < 1024; k += 64) acc += bf1(HN[(size_t)(b * 2048 + s) * D + k]) * p.in[I_WINHY][(size_t)k * 3072 + c];
        acc = wave_sum(acc);
        const float got = bf1(UC[(size_t)c * T + b * 2048 + s]); d = fabsf(got - acc) / (fabsf(acc) + 0.1f);
    } else if (mode == 5) {
        const int c = hsh % 3072u, b = h2 % 32u; int s = h3 % 2048u; if ((h3 >> 20) % 8u == 0u) s = 0; if ((h3 >> 20) % 8u == 1u) s = 2047;
        float val = p.in[I_CONVHYB][c];
#pragma unroll 1
        for (int j = 0; j < 3; ++j) { const int sj = s + j - 1; if (sj < 0 || sj > 2047) continue; val += p.in[I_CONVHYW][j * 3072 + c] * bf1(ZT[(size_t)c * T + b * 2048 + sj]); }
        const float got = bf1(UC[(size_t)c * T + b * 2048 + s]); d = fabsf(got - val) / (fabsf(val) + 0.1f);
    } else if (mode == 1) {
        LAS float* Z = (LAS float*)(lds + wave * 1024); LAS float* A1 = Z + 64; LAS float* A2 = A1 + 64;
        const int o = hsh & 1u, c = h2 % 1024u, j = h3 % 2048u;
        float z = 0.f; if (lane == 0) z = (float)j / 2047.f; else if (lane < 33) { const int k = (lane - 1) & 15; const float fr = 1e-4f + (float)k * ((15.f - 1e-4f) / 15.f); const float ang = (6.283185307179586f / 2048.f) * (float)j * fr; z = lane < 17 ? cosf(ang) : -sinf(ang); }
        Z[lane] = z; LDS_WAIT(); asm volatile("" ::: "memory");
        float a = p.in[I_FB1][lane];
#pragma unroll 1
        for (int k = 0; k < 33; ++k) a += Z[k] * p.in[I_FW1][k * 64 + lane];
        A1[lane] = sinf(a); LDS_WAIT(); asm volatile("" ::: "memory");
        a = p.in[I_FB2][lane];
#pragma unroll 1
        for (int k = 0; k < 64; ++k) a += A1[k] * p.in[I_FW2][k * 64 + lane];
        A2[lane] = sinf(a); LDS_WAIT(); asm volatile("" ::: "memory");
        float v = wave_sum(A2[lane] * p.in[I_FW3][lane * 2048 + o * 1024 + c]);
        const float mind = -4.605170185988091f / 1.5f, maxd = -4.605170185988091f / 0.3f; const float delta = fabsf(mind + (float)c * ((maxd - mind) / 1023.f));
        v *= expf(-fabsf((float)j - 1024.f) / 1024.f * delta);
        const float got = bf1(FILT[(size_t)(o * 1024 + c) * 2048 + j]); d = fabsf(got - v) / (fabsf(v) + 1e-4f);
    } else if (mode == 2 || mode == 3) {
        const int o = mode - 2, c = hsh % 1024u, b = h2 % 32u; int t = h3 % 2048u; if ((h3 >> 20) % 8u == 0u) t = 0; if ((h3 >> 20) % 8u == 1u) t = 2047;
        const bf16* in = (o == 0 ? UC : ZT) + (size_t)c * T + b * 2048; const bf16* f = FILT + (size_t)(o * 1024 + c) * 2048; float acc = 0.f;
#pragma unroll 1
        for (int s = lane; s < 2048; s += 64) { const int x = 1024 + t - s; if (x >= 0 && x <= 2047) acc += bf1(f[x]) * bf1(in[s]); }
        acc = wave_sum(acc);
        const float gate = bf1(UC[(size_t)((1 + o) * 1024 + c) * T + b * 2048 + t]);
        const float val = gate * (acc + bf1(in[t]) * p.in[I_FBIAS][o * 1024 + c]);
        const float got = bf1((o == 0 ? ZT : Y2T)[(size_t)c * T + b * 2048 + t]); d = fabsf(got - val) / (fabsf(val) + 0.1f);
    } else if (mode == 4) {
        const int tok = hsh % 65536u, n = h2 % 1024u; float acc = 0.f;
#pragma unroll 1
        for (int c = lane; c < 1024; c += 64) acc += bf1(Y2T[(size_t)c * T + tok]) * p.in[I_WOUTHY][(size_t)c * 1024 + n];
        acc = wave_sum(acc);
        const float got = bf1(MIX[(size_t)tok * D + n]); d = fabsf(got - acc) / (fabsf(acc) + 0.1f);
    }
    dbg_report_wave(p, d, lane);
}
__device__ __forceinline__ void dbg_inproj_check(const Params& p, unsigned char* big, int lane, int wave) {
    const unsigned hsh = dbg_hash(blockIdx.x * 8u + wave + 777u), h2 = dbg_hash(hsh);
    const bf16* H0 = (const bf16*)(big + A0_H); const float* W = p.in[I_WINAB];
    int m = hsh % (unsigned)TT; int n = h2 % 3600u;
    const bool ctx = m >= T; if (ctx && n < 1536) n += 1536;
    const int b = ctx ? (m - T) / LC : m / SEQ, s = ctx ? (m - T) % LC : m % SEQ;
    float x = 0.f, xp = 0.f; const bool rope_col = (n < 512) || (n >= 1536 && n < 2048); const int np = rope_col ? (n ^ 16) : n;
#pragma unroll 1
    for (int k = lane; k < 1024; k += 64) { const float hv = bf1(H0[(size_t)m * D + k]); x += hv * W[(size_t)k * 3600 + n]; xp += hv * W[(size_t)k * 3600 + np]; }
    x = wave_sum(x); xp = wave_sum(xp);
    float val = x, got = 0.f;
    if (n >= 3584) { val = x + p.in[I_GATEB][n - 3584]; got = ((const float*)(p.ws + WS_GATES))[(size_t)m * 16 + (n - 3584)]; }
    else { const int t = n / 512, cn = n % 512; int pc = cn;
        if (rope_col) { const int o = cn & 31; pc = (cn & ~31) + (((o & 15) >> 2) * 8 + (o >> 4) * 4 + (o & 3));
            if (!ctx) { const int d = cn & 63, axis = d >> 5, half = (d >> 4) & 1, i = d & 15; const float pos = (float)(axis == 0 ? (s >> 6) : (s & 63)); const float ang = pos * powf(10000.f, -(float)i / 16.f);
                val = half == 0 ? x * cosf(ang) - xp * sinf(ang) : x * cosf(ang) + xp * sinf(ang); } }
        if (t == 0) val *= QSCALE;
        const size_t offs[7] = {A0_QA, A0_BQ, A0_BO, A0_KA, A0_VA, A0_BK, A0_BV}; const bool kv = t >= 3;
        const bf16* O = (const bf16*)(big + offs[t]) + (size_t)b * (kv ? (SEQ + LC) : SEQ) * 512 + (size_t)((kv && !ctx) ? LC : 0) * 512;
        got = bf1(O[(size_t)s * 512 + pc]); }
    dbg_report_wave(p, fabsf(got - val) / (fabsf(val) + 0.1f), lane);
}
__device__ __forceinline__ void dbg_attn_check(const Params& p, unsigned char* big, LAS unsigned char* lds, int lane, int wave) {
    const unsigned hsh = dbg_hash(blockIdx.x * 8u + wave + 4242u), h2 = dbg_hash(hsh);
    const int b = hsh % 32u, h = (hsh >> 8) % 4u, q = h2 % 2048u;
    const bf16* QA = (const bf16*)(big + A0_QA) + ((size_t)b * SEQ + q) * 512 + h * 128; const bf16* KA = (const bf16*)(big + A0_KA) + (size_t)b * 2304 * 512 + h * 128;
    const bf16* VA = (const bf16*)(big + A0_VA) + (size_t)b * 2304 * 512 + h * 128; const bf16* MIXIN = (const bf16*)(big + A0_MIXIN) + ((size_t)b * SEQ + q) * D + h * 128;
    LAS float* Aw = (LAS float*)(lds + wave * 18432);
    const float* lv = p.in[I_DLAM]; const float lam = expf(wave_sum(lv[lane] * lv[64 + lane])) - expf(wave_sum(lv[128 + lane] * lv[192 + lane])) + 0.2f;
    float mx0 = -1e30f, mx1 = -1e30f;
#pragma unroll 1
    for (int key = lane; key < 2304; key += 64) { float s0 = 0.f, s1 = 0.f;
#pragma unroll 1
        for (int d = 0; d < 64; ++d) { s0 += bf1(QA[d]) * bf1(KA[(size_t)key * 512 + d]); s1 += bf1(QA[64 + d]) * bf1(KA[(size_t)key * 512 + 64 + d]); }
        Aw[key] = s0; Aw[2304 + key] = s1; mx0 = fmaxf(mx0, s0); mx1 = fmaxf(mx1, s1); }
    mx0 = wave_max(mx0); mx1 = wave_max(mx1);
    float l0 = 0.f, l1 = 0.f;
#pragma unroll 1
    for (int key = lane; key < 2304; key += 64) { const float e0 = exp2f(Aw[key] - mx0), e1 = exp2f(Aw[2304 + key] - mx1); Aw[key] = e0; Aw[2304 + key] = e1; l0 += e0; l1 += e1; }
    l0 = wave_sum(l0); l1 = wave_sum(l1);
    LDS_WAIT(); asm volatile("" ::: "memory");
    float o[2] = {0.f, 0.f};
#pragma unroll 1
    for (int key = 0; key < 2304; ++key) { const float a = Aw[key] / l0 - lam * Aw[2304 + key] / l1; o[0] += a * bf1(VA[(size_t)key * 512 + lane]); o[1] += a * bf1(VA[(size_t)key * 512 + 64 + lane]); }
    const float ms = wave_sum(o[0] * o[0] + o[1] * o[1]) * (1.f / 128.f); const float rn = rsqrtf(ms + RMS_EPS) * 0.8f;
    float err = 0.f, sc = 0.f;
#pragma unroll
    for (int j = 0; j < 2; ++j) { const float val = o[j] * rn * p.in[I_HGA][h * 128 + 64 * j + lane]; err = fmaxf(err, fabsf(val - bf1(MIXIN[64 * j + lane]))); sc += val * val; }
    err = wave_max(err); sc = sqrtf(wave_sum(sc) * (1.f / 128.f));
    dbg_report_wave(p, err / (sc + 1e-3f), lane);
}
__device__ __forceinline__ float dbg_convsilu(const bf16* base, int pos, int lim, int ch, int d, const float* cw, const float* cb) {
    float s = cb[ch];
#pragma unroll
    for (int j = 0; j < 3; ++j) { const int pj = pos + j - 1; if (pj >= 0 && pj < lim) s += cw[j * 1024 + ch] * bf1(base[(size_t)pj * 512 + d]); }
    return s / (1.f + expf(-s));
}
__device__ __forceinline__ void dbg_mlstm_check(const Params& p, unsigned char* big, LAS unsigned char* lds, int lane, int wave) {
    const unsigned hsh = dbg_hash(blockIdx.x * 8u + wave + 991u), h2 = dbg_hash(hsh);
    const int b = hsh % 32u, h = (hsh >> 8) % 4u, dir = (hsh >> 12) & 1; int tau = h2 % 2048u; if ((h2 >> 16) % 4u == 0u) tau = (h2 >> 20) % 130u;
    const bf16* BQ = (const bf16*)(big + A0_BQ) + (size_t)b * SEQ * 512 + h * 128; const bf16* BK = (const bf16*)(big + A0_BK) + (size_t)b * (SEQ + LC) * 512 + h * 128;
    const bf16* BV = (const bf16*)(big + A0_BV) + (size_t)b * (SEQ + LC) * 512 + h * 128;
    const float* GT = (const float*)(p.ws + WS_GATES); const float* cw = p.in[I_CONVABW]; const float* cb = p.in[I_CONVABB];
    LAS float* F = (LAS float*)(lds + wave * 18432); LAS float* qv = F + 2304 + 64;
    const int N = 256 + tau + 1;
#define DBG_POS(u) ((u) < 256 ? (dir ? 255 - (u) : (u)) : (dir ? 2047 - ((u) - 256) : (u) - 256))
#define DBG_GROW(u) ((u) < 256 ? (size_t)T + b * LC + DBG_POS(u) : (size_t)b * SEQ + DBG_POS(u))
    float carry = 0.f;
#pragma unroll 1
    for (int u0 = 0; u0 < N; u0 += 64) { const int u = u0 + lane; float lf = 0.f;
        if (u < N) { const float x = GT[DBG_GROW(u) * 16 + dir * 8 + 4 + h]; lf = x >= 0.f ? -__logf(1.f + __expf(-x)) : x - __logf(1.f + __expf(x)); }
        float s = lf;
#pragma unroll
        for (int o = 1; o < 64; o <<= 1) { const float v = shup(s, o); if (lane >= o) s += v; }
        if (u < N) F[u] = carry + s; carry += shidx(s, 63); }
    LDS_WAIT(); asm volatile("" ::: "memory");
    const float Ft = F[N - 1];
    float mm = Ft;
#pragma unroll 1
    for (int u = lane; u < N; u += 64) mm = fmaxf(mm, Ft - F[u] + GT[DBG_GROW(u) * 16 + dir * 8 + h]);
    mm = wave_max(mm);
    { const int pos = DBG_POS(N - 1);
      for (int d = lane; d < 128; d += 64) qv[d] = dbg_convsilu(BQ, pos, SEQ, h * 128 + d, d, cw, cb) * 0.08838834764831845f; }
    LDS_WAIT(); asm volatile("" ::: "memory");
    float den = 0.f;
#pragma unroll 1
    for (int u = lane; u < N; u += 64) { const bool ctx = u < 256; const int pos = DBG_POS(u); const bf16* kb = ctx ? BK : BK + (size_t)LC * 512; float qk = 0.f;
#pragma unroll 1
        for (int d = 0; d < 128; ++d) qk += qv[d] * dbg_convsilu(kb, pos, ctx ? LC : SEQ, 512 + h * 128 + d, d, cw, cb);
        const float om = qk * expf(Ft - F[u] + GT[DBG_GROW(u) * 16 + dir * 8 + h] - mm); F[u] = om; den += om; }
    den = wave_sum(den);
    LDS_WAIT(); asm volatile("" ::: "memory");
    float num[2] = {0.f, 0.f};
#pragma unroll 1
    for (int u = 0; u < N; ++u) { const bool ctx = u < 256; const int pos = DBG_POS(u); const bf16* vb = BV + (size_t)((ctx ? 0 : LC) + pos) * 512; num[0] += F[u] * bf1(vb[lane]); num[1] += F[u] * bf1(vb[64 + lane]); }
    const float dd = 1.f / fmaxf(fabsf(den), expf(-mm));
    const bf16* HB = (const bf16*)(big + A0_HB) + (size_t)dir * T * 512 + ((size_t)b * SEQ + DBG_POS(N - 1)) * 512 + h * 128;
    float err = 0.f, sc = 0.f;
#pragma unroll
    for (int j = 0; j < 2; ++j) { const float val = num[j] * dd; err = fmaxf(err, fabsf(val - bf1(HB[64 * j + lane]))); sc += val * val; }
    err = wave_max(err); sc = sqrtf(wave_sum(sc) * (1.f / 128.f));
    dbg_report_wave(p, err / (sc + 1e-3f), lane);
#undef DBG_POS
#undef DBG_GROW
}

__global__ void __launch_bounds__(NTHR, 2) mk_fwd(Params p0) {
    extern __shared__ __attribute__((aligned(16))) unsigned char lds_raw[];
    LAS unsigned char* lds = (LAS unsigned char*)lds_raw;
    const int wave0 = __builtin_amdgcn_readfirstlane((int)threadIdx.x >> 6);
    if (threadIdx.x < 64) ((LAS unsigned*)(lds + LDS_MISC))[threadIdx.x] = 0u;
    __syncthreads();
    XcdBarrier bar = xcd_barrier_post((unsigned*)(p0.ws + WS_CTL) + CW_BAR, (volatile LAS unsigned*)(lds + LDS_MISC + 32));
    const int G = gridDim.x, cb = blockIdx.x;
    const int vcu = (G % 8 == 0) ? (cb % 8) * (G / 8) + cb / 8 : cb;
#ifdef TIMEK
    int phc = 0; if (blockIdx.x == 0 && threadIdx.x == 0) ((unsigned long long*)(p0.ws + WS_CTL + 32768))[0] = __builtin_amdgcn_s_memrealtime();
#endif
#ifdef DBL_PH
#define DBL_LOOP for (int rep_ = 0; rep_ < 1; ++rep_)
#define DBL_SYNC __syncthreads();
#else
#define DBL_LOOP
#define DBL_SYNC
#endif
#ifdef TIMEK
#define TS_REC { ++phc; if (blockIdx.x == 0 && wave0 == 0 && lane_opq() == 0) ((unsigned long long*)(p0.ws + WS_CTL + 32768))[phc] = __builtin_amdgcn_s_memrealtime(); }
#else
#define TS_REC
#endif
#define LAYER_PTRS bf16* H2 = (bf16*)big; float* LOG = nullptr; bf16* ACT = (bf16*)big; \
        bf16* Y = (bf16*)(big + 160 * MiB); bf16* HN = (bf16*)big; const bf16* MIX = (const bf16*)(big + (l == 0 ? A0_MIX : 160 * MiB)); \
        unsigned char* X8 = ws + WS_X8; bf16* UT = (bf16*)(big + 160 * MiB); bf16* UC = (bf16*)(big + 544 * MiB); bf16* ZT = (bf16*)(big + 544 * MiB); bf16* Y2T = (bf16*)big; bf16* Y2 = (bf16*)(big + 544 * MiB); \
        (void)X8; (void)H2; (void)LOG; (void)ACT; (void)Y; (void)HN; (void)MIX; (void)UT; (void)UC; (void)ZT; (void)Y2T; (void)Y2;
#define RUN(...) do { { { int tid_ = wave0 * 64 + lane_opq(); asm volatile("" : "+v"(tid_)); const int tid = tid_, lane = tid & 63, wave = __builtin_amdgcn_readfirstlane(tid >> 6); (void)lane; (void)wave; \
        Params p = p0; { size_t z_ = 0; asm volatile("" : "+s"(z_)); p.ws = p0.ws + z_; p.out = p0.out + z_; _Pragma("unroll") for (int i_ = 0; i_ < 31; ++i_) p.in[i_] = p0.in[i_] + z_; } unsigned char* ws = p.ws; unsigned char* big = ws + WS_BIG; (void)big; LAYER_PTRS DBL_LOOP { __VA_ARGS__; DBL_SYNC } } { XcdBarrier b2_ = bar; { size_t z_ = 0; asm volatile("" : "+s"(z_)); b2_.bar = bar.bar + z_; unsigned x_ = bar.x; asm volatile("" : "+s"(x_)); b2_.x = x_; } xcd_barrier(b2_, wave0 == 0 && lane_opq() == 0); } TS_REC } } while (0)

#ifdef PRO_PROBE
#define PP(i) do { if (blockIdx.x == 0 && tid == 0) ((unsigned long long*)(p0.ws + WS_CTL + 32768))[50 + (i)] = __builtin_amdgcn_s_memrealtime(); } while (0)
#else
#define PP(i)
#endif
    { const int l = 0; RUN({ PP(0); pro_mod(p, lds, tid, lane, wave); __syncthreads(); PP(1); pro_filters(p, lds, tid, lane, wave); PP(2); pro_rope(p, tid); pro_transposes(p, lds, lane, wave); PP(3); }); }

    for (int l = 0; l < 2; ++l) {
        if (l == 0) {
            RUN({ ph_l0_norm(p, lane, wave); });
            RUN({ Gemm g{(const bf16*)(big + A0_H), (const bf16*)(ws + WS_WIN0), 1024, 2048u}; InprojSched S{G, vcu};
                  EpiInproj E{big, (const float*)(ws + WS_ROPE), (float*)(ws + WS_GATES), p.in[I_GATEB]};
                  gemm_phase<EpiInproj, InprojSched>(lds, g, S, E, tid); });
#ifdef DBG_INPROJ
            RUN({ dbg_inproj_check(p, big, lane, wave); });
#endif
            RUN({ ph_attn(p, big, lds, tid, lane, wave, vcu); asm volatile("s_waitcnt vmcnt(0)" ::: "memory"); __syncthreads();
                  int t2_ = tid; asm volatile("" : "+v"(t2_)); const int tid = t2_, lane = tid & 63; (void)lane; ph_mlstm(p, big, lds, tid, lane, wave); });
#ifdef DBG_ATTN
            RUN({ dbg_attn_check(p, big, lds, lane, wave); });
#endif
#ifdef DBG_MLSTM
            RUN({ dbg_mlstm_check(p, big, lds, lane, wave); });
#endif
            RUN({ ph_outb(p, big, lane, wave, vcu); asm volatile("s_waitcnt vmcnt(0)" ::: "memory"); __syncthreads();
                  Gemm g{(const bf16*)(big + A0_MIXIN), (const bf16*)(ws + WS_WOUT0), 1024, 2048u}; PanelSched S{4, vcu}; EpiBf16 E{(bf16*)(big + A0_MIX), 1024, 3};
                  gemm_phase<EpiBf16, PanelSched>(lds, g, S, E, tid); });
        }
        if (l == 1) {
            RUN({ Gemm g{(const bf16*)(ws + WS_WIN1), HN, 1024, 2048u}; Inproj1Sched S{vcu}; EpiBf16T E{UT, (size_t)T};
                  gemm_phase<EpiBf16T, Inproj1Sched>(lds, g, S, E, tid); });
#ifdef DBG_HY
            if (DBG_MODE == 0) { RUN({ dbg_hyena_check(p, 0, HN, UT, UT, UT, UT, lds, lane, wave); }); }
#endif
#ifdef DBG_HY
            if (DBG_MODE == 5) { RUN({ dbg_hyena_check(p, 5, HN, UC, UT, UT, UT, lds, lane, wave); }); }
#endif
            RUN({ ph_lconv2(p, UT, ZT, Y2T, lds, tid, lane, wave); });
#ifdef DBG_HY
            if (DBG_MODE == 2) { RUN({ dbg_hyena_check(p, 2, HN, UC, ZT, Y2T, UT, lds, lane, wave); }); }
#endif
#ifdef DBG_HY
            if (DBG_MODE == 3) { RUN({ dbg_hyena_check(p, 3, HN, UC, ZT, Y2T, UT, lds, lane, wave); }); }
#endif
            RUN({ ph_transpose(Y2T, Y2, lds, lane, wave, vcu); asm volatile("s_waitcnt vmcnt(0)" ::: "memory"); __syncthreads();
                  Gemm g{Y2, (const bf16*)(ws + WS_WOUT1), 1024, 2048u}; PanelSched S{4, vcu}; EpiBf16 E{(bf16*)(big + 160 * MiB), 1024, 3};
                  gemm_phase<EpiBf16, PanelSched>(lds, g, S, E, tid); });
        }
#ifdef DBG_HY
        if (l == 1 && (DBG_MODE == 1 || DBG_MODE == 4)) { RUN({ dbg_hyena_check(p, DBG_MODE, HN, (const bf16*)(big + 384 * MiB), (const bf16*)big, (const bf16*)(big + 128 * MiB), (const bf16*)big, lds, lane, wave); }); }
#endif
        RUN({ ph_mid(p, l, MIX, H2, X8, true, lane, wave, vcu); asm volatile("s_waitcnt vmcnt(0)" ::: "memory"); __syncthreads();
              Gemm g{H2, (const bf16*)(ws + WS_WR) + (size_t)l * 256 * 1024, 1024, 2048u}; DenseSched S{1, 256, G, vcu, 0}; EpiRouterLds E{};
              gemm_phase<EpiRouterLds, DenseSched>(lds, g, S, E, tid); __syncthreads(); ph_route_a(p, l, nullptr, vcu, lds, tid); });
#ifdef DBG_ROUTE
        RUN({ if (l == DBG_L) dbg_route_check(p, l, H2, LOG, lds, tid); ph_route_b(p, lds, tid); });
#else
        RUN({ ph_route_b(p, lds, tid); });
#endif
#define DO_G1(chx) do { const int NT = moe_tables(p, chx, lds, tid); \
            Gemm g{(const bf16*)X8, (const bf16*)(ws + WS_GU + (size_t)l * (65 * 512) * 1024), 512, 1024u};        \
            MoeSched S{(const LAS int*)(lds + LDS_TAB), (const int*)(ws + WS_SORT) + (size_t)(chx) * CHROWS, NT * 2, G, vcu, 1, 2, nullptr}; EpiSwiglu E{(unsigned char*)ACT}; \
            gemm_phase<EpiSwiglu, MoeSched, true, true>(lds, g, S, E, tid); } while (0)
        RUN({ DO_G1(0); });
        for (int ch = 0; ch < NCH; ++ch) {
            RUN({ const int NT = moe_tables(p, ch, lds, tid);
                  int k_ = 128; asm volatile("" : "+s"(k_));
                  Gemm g{ACT, (const bf16*)(ws + WS_DN + (size_t)l * (65 * 1024) * 256), k_, 256u};
                  MoeSched S{(const LAS int*)(lds + LDS_TAB), nullptr, NT * 4, G, vcu, 2, 4, (l == 0 && ch == 0) ? (void*)(ws + WS_CTL + 32768) : nullptr}; EpiFp8 E{(unsigned char*)Y};
                  gemm_phase<EpiFp8, MoeSched, true, true>(lds, g, S, E, tid); });
            RUN({ const int par = (cb >> 3) & 1;
                  _Pragma("unroll 1") for (int part = 0; part < 2; ++part) { int t2_ = tid; asm volatile("" : "+v"(t2_)); const int tid = t2_, lane = tid & 63; (void)lane; if ((part ^ par) == 0) { if (ch + 1 < NCH) DO_G1(ch + 1); } else { ph_combine(p, l, ch, (const unsigned char*)Y, HN, lane, wave); } __syncthreads(); } });
        }
    }
#ifdef TIMEK
    if (blockIdx.x == 0) { const unsigned long long* ts = (const unsigned long long*)(p0.ws + WS_CTL + 32768); __syncthreads();
        const unsigned long long d = (__hip_atomic_load(ts + TIMEK, __ATOMIC_RELAXED, __HIP_MEMORY_SCOPE_AGENT) - __hip_atomic_load(ts + TIMEK0, __ATOMIC_RELAXED, __HIP_MEMORY_SCOPE_AGENT)) * 4ull, t0 = __builtin_amdgcn_s_memrealtime();
        while (__builtin_amdgcn_s_memrealtime() - t0 < d) __builtin_amdgcn_s_sleep(8); }
#endif
#ifdef DBG_ANY
    xcd_barrier(bar, threadIdx.x == 0);
    if (blockIdx.x == 0 && threadIdx.x == 0) p0.out[0] += 1.0e7f * __uint_as_float(((const unsigned*)(p0.ws + WS_CTL))[CW_DBG]);
#endif
#undef RUN
}
constexpr int NPHASES = 1 + 2 * (4 + 3 * NCH) + 6 + 64;
}

extern "C" void kernel_launch(void* const* d_in, const int* in_sizes, int n_in, void* d_out, int out_size, void* d_ws, size_t ws_size, hipStream_t stream) {
    using namespace mk;
    static int grid = 0;
    if (grid == 0) {
        if (n_in != 31 || out_size != T * D || ws_size < WS_END) { fprintf(stderr, "kernel_launch: unexpected shapes (n_in %d, out %d, ws %zu)\n", n_in, out_size, ws_size); grid = -1; return; }
        int dev = 0, cus = 0;
        if (hipGetDevice(&dev) != hipSuccess || hipDeviceGetAttribute(&cus, hipDeviceAttributeMultiprocessorCount, dev) != hipSuccess) { grid = -1; return; }
        if (hipFuncSetAttribute((const void*)mk_fwd, hipFuncAttributeMaxDynamicSharedMemorySize, LDS_BYTES) != hipSuccess) { fprintf(stderr, "kernel_launch: hipFuncSetAttribute failed\n"); grid = -1; return; }
        int per_cu = 0;
        if (hipOccupancyMaxActiveBlocksPerMultiprocessor(&per_cu, (const void*)mk_fwd, NTHR, LDS_BYTES) != hipSuccess || per_cu < 1) { fprintf(stderr, "kernel_launch: occupancy query says %d\n", per_cu); }
        (void)hipGetLastError();
        grid = cus;
        if (grid != 256) { fprintf(stderr, "kernel_launch: built for 256 CUs, found %d\n", grid); grid = -1; return; }
    }
    if (grid < 0) return;
    (void)hipMemsetAsync((char*)d_ws + WS_CTL, 0, CTL_ZERO_BYTES, stream);
    Params a{};
    for (int i = 0; i < 31; ++i) a.in[i] = (const float*)d_in[i];
    a.out = (float*)d_out; a.ws = (unsigned char*)d_ws; a.ph_lo = 0; a.ph_hi = NPHASES;
    hipLaunchKernelGGL(mk_fwd, dim3(grid), dim3(NTHR), LDS_BYTES, stream, a);
}
```
